# Optimizing an MI355X kernel written in HIP

```python
import math
import jax, jax.numpy as jnp
from jax import lax
import numpy as np

D_MODEL = 1024
BATCH = 16
SEQ = 2048
DEPTH = 1

CHUNK = 64
D_MIX = D_MODEL
D_HGRN = D_MIX // 2
HG_HEADS = 4
HG_DK = D_HGRN // HG_HEADS
D_SSM = D_MIX - D_HGRN
SSM_GROUP = 16
SSM_GROUPS = D_SSM // SSM_GROUP
SSM_STATE = 64
IN_COLS = 4 * D_HGRN + D_SSM
PEER_HEADS = 8
PEER_NKEYS = 128
PEER_EXPERTS = PEER_NKEYS * PEER_NKEYS
PEER_DKEY = 256
PEER_HALF = PEER_DKEY // 2
PEER_TOPK = 16
PEER_TOKEN_BLOCK = 128
DEEP_ALPHA = (2.0 * DEPTH) ** 0.25
DEEP_BETA = (8.0 * DEPTH) ** -0.25
LN_EPS = 1e-5
RMS_EPS = 1e-6

kernel_name = 'hymba_hgrn2_s5_peer_deepnorm_adaln'


def layer_norm(x, w, b):
    xf = x.astype(jnp.float32)
    mu = jnp.mean(xf, axis=-1, keepdims=True)
    var = jnp.mean(jnp.square(xf - mu), axis=-1, keepdims=True)
    y = (xf - mu) * lax.rsqrt(var + LN_EPS) * w.astype(jnp.float32) + b.astype(jnp.float32)
    return y.astype(x.dtype)


def rms_norm(x, w):
    xf = x.astype(jnp.float32)
    return xf * lax.rsqrt(jnp.mean(jnp.square(xf), axis=-1, keepdims=True) + RMS_EPS) * w.astype(jnp.float32)


def hgrn2_group(q, f_logit, i, g, lb, norm_w):
    B, S, _ = q.shape
    nc = S // CHUNK
    f32 = jnp.float32
    q = jax.nn.silu(q.astype(f32))
    f = lb + (1.0 - lb) * jax.nn.sigmoid(f_logit.astype(f32))
    log_f = jnp.log(f)
    k = 1.0 - f
    v = i.astype(f32)

    def to_chunks(t):
        return t.reshape(B, nc, CHUNK, HG_HEADS, HG_DK).transpose(1, 0, 3, 2, 4)

    qc, kc, vc, lc = to_chunks(q), to_chunks(k), to_chunks(v), to_chunks(log_f)
    causal = jnp.tril(jnp.ones((CHUNK, CHUNK), dtype=bool))[:, :, None]

    def step(state, inp):
        q_c, k_c, v_c, l_c = inp
        b = jnp.cumsum(l_c, axis=2)
        diff = b[:, :, :, None, :] - b[:, :, None, :, :]
        decay = jnp.exp(jnp.where(causal, diff, -jnp.inf))
        scores = jnp.einsum('bhtk,bhtsk,bhsk->bhts', q_c, decay, k_c)
        o = (jnp.einsum('bhts,bhsv->bhtv', scores, v_c)
             + jnp.einsum('bhtk,bhkv->bhtv', q_c * jnp.exp(b), state))
        b_last = b[:, :, -1:, :]
        state = (jnp.exp(b_last[:, :, 0, :])[..., None] * state
                 + jnp.einsum('bhsk,bhsv->bhkv', k_c * jnp.exp(b_last - b), v_c))
        return state, o

    s0 = jnp.zeros((B, HG_HEADS, HG_DK, HG_DK), f32)
    _, o = lax.scan(step, s0, (qc, kc, vc, lc))
    o = o.transpose(1, 0, 3, 2, 4).reshape(B, S, HG_HEADS, HG_DK)
    o = rms_norm(o, norm_w.reshape(HG_HEADS, HG_DK))
    o = o * jax.nn.silu(g.astype(f32).reshape(B, S, HG_HEADS, HG_DK))
    return o.reshape(B, S, D_HGRN)


def s5_group(u, a_re, a_im, log_dt, b_re, b_im, c_re, c_im, d_skip, glu_w, glu_b, norm_w):
    B, S, _ = u.shape
    f32 = jnp.float32
    uf = u.astype(f32).reshape(B, S, SSM_GROUPS, SSM_GROUP)
    ar, ai = a_re.astype(f32), a_im.astype(f32)
    dt = jnp.exp(log_dt.astype(f32))[:, None]
    mag = jnp.exp(ar * dt)
    lam_re = mag * jnp.cos(ai * dt)
    lam_im = mag * jnp.sin(ai * dt)
    den = ar * ar + ai * ai
    nr, ni = lam_re - 1.0, lam_im
    z_re = (nr * ar + ni * ai) / den
    z_im = (ni * ar - nr * ai) / den
    br, bi = b_re.astype(f32), b_im.astype(f32)
    bb_re = z_re[..., None] * br - z_im[..., None] * bi
    bb_im = z_re[..., None] * bi + z_im[..., None] * br
    bu_re = jnp.einsum('bsgi,gpi->bsgp', uf, bb_re)
    bu_im = jnp.einsum('bsgi,gpi->bsgp', uf, bb_im)
    lam_re_s = jnp.broadcast_to(lam_re, (S, SSM_GROUPS, SSM_STATE))
    lam_im_s = jnp.broadcast_to(lam_im, (S, SSM_GROUPS, SSM_STATE))

    def combine(e_i, e_j):
        ar_i, ai_i, br_i, bi_i = e_i
        ar_j, ai_j, br_j, bi_j = e_j
        return (ar_j * ar_i - ai_j * ai_i,
                ar_j * ai_i + ai_j * ar_i,
                ar_j * br_i - ai_j * bi_i + br_j,
                ar_j * bi_i + ai_j * br_i + bi_j)

    def scan_one(bre, bim):
        _, _, xr, xi = lax.associative_scan(combine, (lam_re_s, lam_im_s, bre, bim), axis=0)
        return xr, xi

    x_re, x_im = jax.vmap(scan_one)(bu_re, bu_im)
    y = (jnp.einsum('bsgp,gip->bsgi', x_re, c_re.astype(f32))
         - jnp.einsum('bsgp,gip->bsgi', x_im, c_im.astype(f32))
         + d_skip.astype(f32) * uf)
    y = jax.nn.gelu(y.reshape(B, S, D_SSM), approximate=False)
    y = y * jax.nn.sigmoid(y @ glu_w.astype(f32) + glu_b.astype(f32))
    return rms_norm(y, norm_w)


def peer_ffn(h, w_q, sub_keys, u_tab, v_tab):
    B, S, D = h.shape
    T = B * S
    f32 = jnp.float32
    ht = h.reshape(T, D)
    q = (ht @ w_q).astype(f32).reshape(T, PEER_HEADS, 2, PEER_HALF)
    scores = jnp.einsum('thpc,hpnc->thpn', q, sub_keys.astype(f32))
    top_s, top_i = lax.top_k(scores, PEER_TOPK)
    cand = (top_s[:, :, 0, :, None] + top_s[:, :, 1, None, :]).reshape(T, PEER_HEADS, PEER_TOPK * PEER_TOPK)
    best_s, best_c = lax.top_k(cand, PEER_TOPK)
    i1 = jnp.take_along_axis(top_i[:, :, 0], best_c // PEER_TOPK, axis=-1)
    i2 = jnp.take_along_axis(top_i[:, :, 1], best_c % PEER_TOPK, axis=-1)
    hk = PEER_HEADS * PEER_TOPK
    expert = (i1 * PEER_NKEYS + i2).reshape(T, hk)
    gate = jax.nn.softmax(best_s, axis=-1).reshape(T, hk)
    nb = T // PEER_TOKEN_BLOCK

    def block(args):
        hb, eb, gb = args
        u_sel = jnp.take(u_tab, eb, axis=0)
        z = jnp.einsum('ted,td->te', u_sel, hb)
        a = jax.nn.gelu(z.astype(f32), approximate=False) * gb
        v_sel = jnp.take(v_tab, eb, axis=0)
        return jnp.einsum('te,ted->td', a.astype(v_sel.dtype), v_sel)

    out = lax.map(block, (ht.reshape(nb, PEER_TOKEN_BLOCK, D),
                          expert.reshape(nb, PEER_TOKEN_BLOCK, hk),
                          gate.reshape(nb, PEER_TOKEN_BLOCK, hk)))
    return out.reshape(B, S, D).astype(h.dtype)


def setup_inputs(seed: int = 0) -> dict:
    key = jax.random.key(seed)
    ks = jax.random.split(key, 32)
    f32 = jnp.float32
    L, D = DEPTH, D_MODEL

    def nrm(k, shape, s):
        return jax.random.normal(k, shape, f32) * s

    n_idx = jnp.arange(SSM_STATE, dtype=f32)
    return {
        'x': nrm(ks[0], (BATCH, SEQ, D), 1.0),
        'c': nrm(ks[1], (BATCH, D), 1.0),
        'ada_w': nrm(ks[2], (L, D, 6 * D), 0.5 * D ** -0.5),
        'ada_b': nrm(ks[3], (L, 6 * D), 0.02),
        'w_in': nrm(ks[4], (L, D, IN_COLS), D ** -0.5),
        'hg_lower_bound': nrm(ks[5], (DEPTH + 1, D_HGRN), 1.0),
        'hg_norm_w': 1.0 + nrm(ks[6], (L, D_HGRN), 0.02),
        'ssm_a_re': -0.5 + nrm(ks[7], (L, SSM_GROUPS, SSM_STATE), 0.01),
        'ssm_a_im': jnp.pi * n_idx + nrm(ks[8], (L, SSM_GROUPS, SSM_STATE), 0.01),
        'ssm_log_dt': jax.random.uniform(ks[9], (L, SSM_GROUPS), f32, math.log(1e-3), math.log(1e-1)),
        'ssm_b_re': nrm(ks[10], (L, SSM_GROUPS, SSM_STATE, SSM_GROUP), (2.0 * SSM_GROUP) ** -0.5),
        'ssm_b_im': nrm(ks[11], (L, SSM_GROUPS, SSM_STATE, SSM_GROUP), (2.0 * SSM_GROUP) ** -0.5),
        'ssm_c_re': nrm(ks[12], (L, SSM_GROUPS, SSM_GROUP, SSM_STATE), SSM_STATE ** -0.5),
        'ssm_c_im': nrm(ks[13], (L, SSM_GROUPS, SSM_GROUP, SSM_STATE), SSM_STATE ** -0.5),
        'ssm_d': nrm(ks[14], (L, SSM_GROUPS, SSM_GROUP), 1.0),
        'ssm_glu_w': nrm(ks[15], (L, D_SSM, D_SSM), D_SSM ** -0.5),
        'ssm_glu_b': nrm(ks[16], (L, D_SSM), 0.02),
        'ssm_norm_w': 1.0 + nrm(ks[17], (L, D_SSM), 0.02),
        'w_out': nrm(ks[18], (L, D_MIX, D), DEEP_BETA * D_MIX ** -0.5),
        'ln1_w': 1.0 + nrm(ks[19], (L, D), 0.02),
        'ln1_b': nrm(ks[20], (L, D), 0.02),
        'peer_w_q': nrm(ks[21], (L, D, PEER_HEADS * PEER_DKEY), D ** -0.5),
        'peer_sub_keys': nrm(ks[22], (L, PEER_HEADS, 2, PEER_NKEYS, PEER_HALF), PEER_HALF ** -0.5),
        'peer_u': nrm(ks[23], (L, PEER_EXPERTS, D), D ** -0.5),
        'peer_v': nrm(ks[24], (L, PEER_EXPERTS, D), DEEP_BETA * PEER_HEADS ** -0.5),
        'ln2_w': 1.0 + nrm(ks[25], (L, D), 0.02),
        'ln2_b': nrm(ks[26], (L, D), 0.02),
    }


def reference(x, c, ada_w, ada_b, w_in, hg_lower_bound, hg_norm_w, ssm_a_re, ssm_a_im, ssm_log_dt,
              ssm_b_re, ssm_b_im, ssm_c_re, ssm_c_im, ssm_d, ssm_glu_w, ssm_glu_b, ssm_norm_w,
              w_out, ln1_w, ln1_b, peer_w_q, peer_sub_keys, peer_u, peer_v, ln2_w, ln2_b):
    lb_all = jnp.cumsum(jax.nn.softmax(hg_lower_bound.astype(jnp.float32), axis=0), axis=0)
    cond = jax.nn.silu(c)
    for l in range(DEPTH):
        mod = cond @ ada_w[l] + ada_b[l]
        sh1, sc1, g1, sh2, sc2, g2 = jnp.split(mod[:, None, :], 6, axis=-1)

        h = x * (1.0 + sc1) + sh1
        proj = h @ w_in[l]
        q, f, i, g, u = jnp.split(proj, [D_HGRN, 2 * D_HGRN, 3 * D_HGRN, 4 * D_HGRN], axis=-1)
        o_hg = hgrn2_group(q, f, i, g, lb_all[l], hg_norm_w[l])
        o_ssm = s5_group(u, ssm_a_re[l], ssm_a_im[l], ssm_log_dt[l], ssm_b_re[l], ssm_b_im[l],
                         ssm_c_re[l], ssm_c_im[l], ssm_d[l], ssm_glu_w[l], ssm_glu_b[l], ssm_norm_w[l])
        mixed = jnp.concatenate([o_hg, o_ssm], axis=-1).astype(x.dtype) @ w_out[l]
        x = layer_norm(DEEP_ALPHA * x + (1.0 + g1) * mixed, ln1_w[l], ln1_b[l])

        h2 = x * (1.0 + sc2) + sh2
        ffn = peer_ffn(h2, peer_w_q[l], peer_sub_keys[l], peer_u[l], peer_v[l])
        x = layer_norm(DEEP_ALPHA * x + (1.0 + g2) * ffn, ln2_w[l], ln2_b[l])
    return x
```

```cpp
#include <hip/hip_runtime.h>
#include <stdint.h>
#include <stdio.h>

#define DI __device__ __forceinline__
typedef unsigned short bf16_t;
typedef short bf16x8 __attribute__((ext_vector_type(8)));
typedef float f32x16 __attribute__((ext_vector_type(16)));
typedef unsigned u32x4 __attribute__((ext_vector_type(4)));

constexpr int NTH = 512;
constexpr int NB = 16, SEQ = 2048, DM = 1024, NTOK = NB * SEQ;
constexpr int DHG = 512, HGH = 4, HDK = 128;
constexpr int DSS = 512, SSG = 32, SSC = 16, SSP = 64;
constexpr int INC = 2560;
constexpr int PHEADS = 8, NKEYS = 128, TOPK = 16, NEXP = 16384;
constexpr float DEEP_ALPHA = 1.189207115002721f;
constexpr float LN_EPS = 1e-5f, RMS_EPS = 1e-6f;
constexpr int SMEM_BYTES = 104 * 1024;

constexpr size_t al256(size_t x) { return (x + 255) & ~(size_t)255; }
constexpr size_t OFF_MOD = 0;
constexpr size_t OFF_LB = al256(OFF_MOD + (size_t)NB * 6144 * 4);
constexpr size_t OFF_LAM = al256(OFF_LB + 512 * 4);
constexpr size_t OFF_BB = al256(OFF_LAM + 32 * 64 * 2 * 4);
constexpr size_t OFF_WIN = al256(OFF_BB + 32 * 64 * 16 * 2 * 4);
constexpr size_t OFF_GLU = al256(OFF_WIN + (size_t)INC * DM * 2);
constexpr size_t OFF_WOUT = al256(OFF_GLU + (size_t)512 * 512 * 2);
constexpr size_t OFF_WQ = al256(OFF_WOUT + (size_t)DM * DM * 2);
constexpr size_t OFF_SUBK = al256(OFF_WQ + (size_t)2048 * DM * 2);
constexpr size_t OFF_UT = al256(OFF_SUBK + (size_t)16 * 128 * 128 * 2);
constexpr size_t OFF_VT = al256(OFF_UT + (size_t)NEXP * DM * 2);
constexpr size_t OFF_H = al256(OFF_VT + (size_t)NEXP * DM * 2);
constexpr size_t OFF_PROJ = al256(OFF_H + (size_t)NTOK * DM * 2);
constexpr size_t OFF_ORAW = al256(OFF_PROJ + (size_t)NTOK * INC * 2);
constexpr size_t OFF_YSSM = al256(OFF_ORAW + (size_t)NTOK * DHG * 4);
constexpr size_t OFF_A2 = al256(OFF_YSSM + (size_t)NTOK * DSS * 2);
constexpr size_t WS_END = al256(OFF_A2 + (size_t)NTOK * DM * 2);
constexpr size_t OFF_TOPL = OFF_ORAW;
constexpr size_t OFF_EXPS = OFF_ORAW + (size_t)NTOK * 16 * 16 * 4;

struct Params {
    const float *x, *c, *ada_w, *ada_b, *w_in, *hg_lb, *hg_nw, *a_re, *a_im, *log_dt, *b_re, *b_im, *c_re, *c_im, *dsk,
        *glu_w, *glu_b, *ssm_nw, *w_out, *ln1w, *ln1b, *w_q, *subk, *pu, *pv, *ln2w, *ln2b;
    float* out;
    char* ws;
};

DI bf16_t f2bf(float x) { unsigned u = __float_as_uint(x); u += 0x7fffu + ((u >> 16) & 1u); return (bf16_t)(u >> 16); }
DI float bf2f(bf16_t b) { return __uint_as_float(((unsigned)b) << 16); }
DI float bflo(unsigned w) { return __uint_as_float(w << 16); }
DI float bfhi(unsigned w) { return __uint_as_float(w & 0xffff0000u); }
DI unsigned pack2(float a, float b) { return (unsigned)f2bf(a) | ((unsigned)f2bf(b) << 16); }
DI float sigmoidf_(float x) { return 1.0f / (1.0f + __expf(-x)); }
DI float siluf_(float x) { return x * sigmoidf_(x); }
DI float geluf_(float x) { return 0.5f * x * (1.0f + erff(x * 0.70710678118654752f)); }

template <int MT, int NT_, int WM, int WN, class Epi>
DI void gemm_block(const bf16_t* __restrict__ A, int lda, const bf16_t* __restrict__ Bt, int ldb, int K, char* smem, Epi epi) {
    constexpr int BM = WM * MT * 32, BN = WN * NT_ * 32, LS = 72;
    static_assert(WM * WN == 8, "8 waves");
    bf16_t* As = (bf16_t*)smem;
    bf16_t* Bs = As + BM * LS;
    const int tid = threadIdx.x, lane = tid & 63, wid = tid >> 6, r = lane & 31, h = lane >> 5;
    const int wm = wid / WN, wn = wid % WN;
    constexpr int PA = BM * 8 / NTH, PB = BN * 8 / NTH;
    u32x4 ra[PA], rb[PB];
    f32x16 acc[MT][NT_];
#pragma unroll
    for (int mi = 0; mi < MT; ++mi)
#pragma unroll
        for (int ni = 0; ni < NT_; ++ni)
#pragma unroll
            for (int i = 0; i < 16; ++i) acc[mi][ni][i] = 0.f;
#define GEMM_GLOAD(kt_) { \
    _Pragma("unroll") for (int q = 0; q < PA; ++q) { const int idx = tid + q * NTH, row = idx >> 3, ch = idx & 7; ra[q] = *(const u32x4*)(A + (size_t)row * lda + (kt_) * 64 + ch * 8); } \
    _Pragma("unroll") for (int q = 0; q < PB; ++q) { const int idx = tid + q * NTH, row = idx >> 3, ch = idx & 7; rb[q] = *(const u32x4*)(Bt + (size_t)row * ldb + (kt_) * 64 + ch * 8); } }
#define GEMM_LSTORE() { \
    _Pragma("unroll") for (int q = 0; q < PA; ++q) { const int idx = tid + q * NTH, row = idx >> 3, ch = idx & 7; *(u32x4*)(As + row * LS + ch * 8) = ra[q]; } \
    _Pragma("unroll") for (int q = 0; q < PB; ++q) { const int idx = tid + q * NTH, row = idx >> 3, ch = idx & 7; *(u32x4*)(Bs + row * LS + ch * 8) = rb[q]; } }
    GEMM_GLOAD(0); GEMM_LSTORE(); __syncthreads();
    const int nk = K / 64;
    for (int kt = 0; kt < nk; ++kt) {
        if (kt + 1 < nk) GEMM_GLOAD(kt + 1);
#pragma unroll
        for (int ks = 0; ks < 4; ++ks) {
            bf16x8 a[MT], b[NT_];
#pragma unroll
            for (int mi = 0; mi < MT; ++mi) a[mi] = *(const bf16x8*)(As + (wm * MT * 32 + mi * 32 + r) * LS + ks * 16 + h * 8);
#pragma unroll
            for (int ni = 0; ni < NT_; ++ni) b[ni] = *(const bf16x8*)(Bs + (wn * NT_ * 32 + ni * 32 + r) * LS + ks * 16 + h * 8);
#pragma unroll
            for (int mi = 0; mi < MT; ++mi)
#pragma unroll
                for (int ni = 0; ni < NT_; ++ni) acc[mi][ni] = __builtin_amdgcn_mfma_f32_32x32x16_bf16(a[mi], b[ni], acc[mi][ni], 0, 0, 0);
        }
        __syncthreads();
        if (kt + 1 < nk) { GEMM_LSTORE(); __syncthreads(); }
    }
#pragma unroll
    for (int mi = 0; mi < MT; ++mi)
#pragma unroll
        for (int ni = 0; ni < NT_; ++ni)
#pragma unroll
            for (int i = 0; i < 16; ++i) epi(wm * MT * 32 + mi * 32 + (i & 3) + 8 * (i >> 2) + 4 * h, wn * NT_ * 32 + ni * 32 + r, acc[mi][ni][i]);
}

DI void prep_mod_item(const Params& p, int item, char* smem) {
    float* cond = (float*)smem;
    const int tid = threadIdx.x;
    for (int i = tid; i < NB * DM; i += NTH) cond[i] = siluf_(p.c[i]);
    __syncthreads();
    const int b = tid >> 5, col = item * 32 + (tid & 31);
    float acc = 0.f;
    const float* w = p.ada_w + col;
    const float* cb = cond + b * DM;
#pragma unroll 8
    for (int k = 0; k < DM; ++k) acc += cb[k] * w[(size_t)k * 6144];
    ((float*)(p.ws + OFF_MOD))[b * 6144 + col] = acc + p.ada_b[col];
    __syncthreads();
}
DI void prep_s5_item(const Params& p, int g) {
    const int tid = threadIdx.x;
    if (tid < SSP) {
        const int pi = g * SSP + tid;
        const float dt = expf(p.log_dt[g]);
        const float ar = p.a_re[pi], ai = p.a_im[pi];
        const float mag = expf(ar * dt);
        const float lr = mag * cosf(ai * dt), li = mag * sinf(ai * dt);
        const float den = ar * ar + ai * ai, nr = lr - 1.0f, ni = li;
        const float zr = (nr * ar + ni * ai) / den, zi = (ni * ar - nr * ai) / den;
        float* lam = (float*)(p.ws + OFF_LAM) + pi * 2;
        lam[0] = lr; lam[1] = li;
        float* bb = (float*)(p.ws + OFF_BB) + (size_t)pi * 32;
        for (int i = 0; i < SSC; ++i) {
            const float br = p.b_re[pi * SSC + i], bi = p.b_im[pi * SSC + i];
            bb[i * 2] = zr * br - zi * bi; bb[i * 2 + 1] = zr * bi + zi * br;
        }
    }
}
DI void prep_transpose_tile(const float* __restrict__ W, bf16_t* __restrict__ Wt, int K, int N, int kt, int nt, char* smem) {
    float* tile = (float*)smem;
    const int tid = threadIdx.x;
#pragma unroll
    for (int q = 0; q < 2; ++q) {
        const int kk = (tid >> 4) + q * 32, c4 = (tid & 15) * 4;
        const float4 v = *(const float4*)(W + (size_t)(kt * 64 + kk) * N + nt * 64 + c4);
        tile[kk * 65 + c4] = v.x; tile[kk * 65 + c4 + 1] = v.y; tile[kk * 65 + c4 + 2] = v.z; tile[kk * 65 + c4 + 3] = v.w;
    }
    __syncthreads();
    const int n = tid >> 3, kc = tid & 7;
    uint4 o;
    o.x = pack2(tile[(kc * 8 + 0) * 65 + n], tile[(kc * 8 + 1) * 65 + n]);
    o.y = pack2(tile[(kc * 8 + 2) * 65 + n], tile[(kc * 8 + 3) * 65 + n]);
    o.z = pack2(tile[(kc * 8 + 4) * 65 + n], tile[(kc * 8 + 5) * 65 + n]);
    o.w = pack2(tile[(kc * 8 + 6) * 65 + n], tile[(kc * 8 + 7) * 65 + n]);
    *(uint4*)(Wt + (size_t)(nt * 64 + n) * K + kt * 64 + kc * 8) = o;
    __syncthreads();
}
DI void cvt_bf16_stream(const float* __restrict__ src, bf16_t* __restrict__ dst, size_t n8, int bid, int nb) {
    for (size_t i = (size_t)bid * NTH + threadIdx.x; i < n8; i += (size_t)nb * NTH) {
        const float4 a = *(const float4*)(src + i * 8), b = *(const float4*)(src + i * 8 + 4);
        uint4 o; o.x = pack2(a.x, a.y); o.y = pack2(a.z, a.w); o.z = pack2(b.x, b.y); o.w = pack2(b.z, b.w);
        *(uint4*)(dst + i * 8) = o;
    }
}
DI void phase_prep(const Params& p, int bid, int nb, char* smem) {
    constexpr int N_MOD = 192, N_LB = 1, N_S5 = 32, T_WIN = 16 * 40, T_GLU = 8 * 8, T_WOUT = 16 * 16, T_WQ = 16 * 32;
    constexpr int I_LB = N_MOD, I_S5 = I_LB + N_LB, I_WIN = I_S5 + N_S5, I_GLU = I_WIN + T_WIN, I_WOUT = I_GLU + T_GLU, I_WQ = I_WOUT + T_WOUT, I_END = I_WQ + T_WQ;
    for (int it = bid; it < I_END; it += nb) {
        if (it < N_MOD) prep_mod_item(p, it, smem);
        else if (it < I_S5) {
            const int j = threadIdx.x;
            const float a0 = p.hg_lb[j], a1 = p.hg_lb[512 + j], m = fmaxf(a0, a1);
            const float e0 = expf(a0 - m), e1 = expf(a1 - m);
            ((float*)(p.ws + OFF_LB))[j] = e0 / (e0 + e1);
        } else if (it < I_WIN) prep_s5_item(p, it - I_S5);
        else if (it < I_GLU) { const int t = it - I_WIN; prep_transpose_tile(p.w_in, (bf16_t*)(p.ws + OFF_WIN), DM, INC, t / 40, t % 40, smem); }
        else if (it < I_WOUT) { const int t = it - I_GLU; prep_transpose_tile(p.glu_w, (bf16_t*)(p.ws + OFF_GLU), 512, 512, t / 8, t % 8, smem); }
        else if (it < I_WQ) { const int t = it - I_WOUT; prep_transpose_tile(p.w_out, (bf16_t*)(p.ws + OFF_WOUT), DM, DM, t / 16, t % 16, smem); }
        else { const int t = it - I_WQ; prep_transpose_tile(p.w_q, (bf16_t*)(p.ws + OFF_WQ), DM, 2048, t / 32, t % 32, smem); }
    }
    cvt_bf16_stream(p.subk, (bf16_t*)(p.ws + OFF_SUBK), (size_t)16 * 128 * 128 / 8, bid, nb);
    cvt_bf16_stream(p.pu, (bf16_t*)(p.ws + OFF_UT), (size_t)NEXP * DM / 8, bid, nb);
    cvt_bf16_stream(p.pv, (bf16_t*)(p.ws + OFF_VT), (size_t)NEXP * DM / 8, bid, nb);
}

DI void phase_h(const Params& p, int bid, int nb) {
    const float* mod = (const float*)(p.ws + OFF_MOD);
    bf16_t* H = (bf16_t*)(p.ws + OFF_H);
    const size_t n8 = (size_t)NTOK * DM / 8;
    for (size_t i = (size_t)bid * NTH + threadIdx.x; i < n8; i += (size_t)nb * NTH) {
        const int row = (int)(i >> 7), c0 = (int)(i & 127) * 8, b = row / SEQ;
        const float* sh = mod + b * 6144 + c0;
        const float* sc = sh + 1024;
        const float4 a = *(const float4*)(p.x + i * 8), bq = *(const float4*)(p.x + i * 8 + 4);
        const float4 s0 = *(const float4*)sc, s1 = *(const float4*)(sc + 4), h0 = *(const float4*)sh, h1 = *(const float4*)(sh + 4);
        uint4 o;
        o.x = pack2(a.x * (1.f + s0.x) + h0.x, a.y * (1.f + s0.y) + h0.y);
        o.y = pack2(a.z * (1.f + s0.z) + h0.z, a.w * (1.f + s0.w) + h0.w);
        o.z = pack2(bq.x * (1.f + s1.x) + h1.x, bq.y * (1.f + s1.y) + h1.y);
        o.w = pack2(bq.z * (1.f + s1.z) + h1.z, bq.w * (1.f + s1.w) + h1.w);
        *(uint4*)(H + i * 8) = o;
    }
}

DI void phase_proj(const Params& p, int bid, int nb, char* smem) {
    const bf16_t* H = (const bf16_t*)(p.ws + OFF_H);
    const bf16_t* W = (const bf16_t*)(p.ws + OFF_WIN);
    bf16_t* P = (bf16_t*)(p.ws + OFF_PROJ);
    constexpr int NTN = INC / 128, NTM = NTOK / 128;
    for (int t = bid; t < NTM * NTN; t += nb) {
        const int mt = t / NTN, nt = t % NTN;
        bf16_t* Pt = P + (size_t)mt * 128 * INC + nt * 128;
        const bool act = (nt < 4) || (nt >= 12 && nt < 16);
        gemm_block<2, 1, 2, 4>(H + (size_t)mt * 128 * DM, DM, W + (size_t)nt * 128 * DM, DM, DM, smem,
                               [&](int r, int c, float v) { Pt[(size_t)r * INC + c] = f2bf(act ? siluf_(v) : v); });
        __syncthreads();
    }
}

DI void hgrn_item(const Params& p, int item, char* smem) {
    const int vs = item & 7, hd = (item >> 3) & 3, b = item >> 5;
    const bf16_t* P = (const bf16_t*)(p.ws + OFF_PROJ);
    const float* lb = (const float*)(p.ws + OFF_LB) + hd * HDK;
    float* ORAW = (float*)(p.ws + OFF_ORAW);
    float* sq = (float*)smem;
    float* sf = sq + 32 * 128;
    float* sv = sf + 32 * 128;
    float* sp = sv + 32 * 16;
    const int tid = threadIdx.x, lane = tid & 63, wid = tid >> 6, kq = tid >> 4, v = tid & 15;
    float S0 = 0.f, S1 = 0.f, S2 = 0.f, S3 = 0.f;
    for (int t0 = 0; t0 < SEQ; t0 += 32) {
        for (int i = tid; i < 32 * 128; i += NTH) {
            const int t = i >> 7, k = i & 127;
            const bf16_t* row = P + (size_t)(b * SEQ + t0 + t) * INC + hd * HDK + k;
            sq[i] = bf2f(row[0]);
            const float l = lb[k];
            sf[i] = l + (1.0f - l) * sigmoidf_(bf2f(row[512]));
        }
        { const int t = tid >> 4; sv[tid] = bf2f(P[(size_t)(b * SEQ + t0 + t) * INC + 1024 + hd * HDK + vs * 16 + v]); }
        __syncthreads();
        for (int t = 0; t < 32; ++t) {
            const float4 f4 = *(const float4*)(sf + t * 128 + kq * 4), q4 = *(const float4*)(sq + t * 128 + kq * 4);
            const float vv = sv[t * 16 + v];
            S0 = f4.x * S0 + (1.0f - f4.x) * vv; S1 = f4.y * S1 + (1.0f - f4.y) * vv;
            S2 = f4.z * S2 + (1.0f - f4.z) * vv; S3 = f4.w * S3 + (1.0f - f4.w) * vv;
            float part = q4.x * S0 + q4.y * S1 + q4.z * S2 + q4.w * S3;
            part += __shfl_xor(part, 16); part += __shfl_xor(part, 32);
            if (lane < 16) sp[(t * 8 + wid) * 16 + v] = part;
        }
        __syncthreads();
        {
            const int t = tid >> 4;
            float o = 0.f;
#pragma unroll
            for (int w = 0; w < 8; ++w) o += sp[(t * 8 + w) * 16 + v];
            ORAW[(size_t)(b * SEQ + t0 + t) * DHG + hd * HDK + vs * 16 + v] = o;
        }
        __syncthreads();
    }
}
DI void s5_item(const Params& p, int item, char* smem) {
    const int oct = item & 3, b = item >> 2;
    const int tid = threadIdx.x, lane = tid & 63, wid = tid >> 6, g = oct * 8 + wid;
    const bf16_t* P = (const bf16_t*)(p.ws + OFF_PROJ);
    bf16_t* Y = (bf16_t*)(p.ws + OFF_YSSM);
    float* su = (float*)smem + wid * 64 * 16;
    const float* lam = (const float*)(p.ws + OFF_LAM) + (g * SSP + lane) * 2;
    const float lr = lam[0], li = lam[1];
    const float* bb = (const float*)(p.ws + OFF_BB) + (size_t)(g * SSP + lane) * 32;
    float bbr[16], bbi[16], cr[16], ci[16];
#pragma unroll
    for (int i = 0; i < 16; ++i) { bbr[i] = bb[2 * i]; bbi[i] = bb[2 * i + 1]; cr[i] = p.c_re[(g * SSC + i) * SSP + lane]; ci[i] = p.c_im[(g * SSC + i) * SSP + lane]; }
    const int ch = (lane >> 2) & 15;
    const float dch = p.dsk[g * SSC + ch];
    float xr = 0.f, xi = 0.f;
    for (int t0 = 0; t0 < SEQ; t0 += 64) {
        {
            const uint4* src = (const uint4*)(P + (size_t)(b * SEQ + t0 + lane) * INC + 2048 + g * SSC);
            const uint4 a = src[0], c = src[1];
            float* d = su + lane * 16;
            d[0] = bflo(a.x); d[1] = bfhi(a.x); d[2] = bflo(a.y); d[3] = bfhi(a.y); d[4] = bflo(a.z); d[5] = bfhi(a.z); d[6] = bflo(a.w); d[7] = bfhi(a.w);
            d[8] = bflo(c.x); d[9] = bfhi(c.x); d[10] = bflo(c.y); d[11] = bfhi(c.y); d[12] = bflo(c.z); d[13] = bfhi(c.z); d[14] = bflo(c.w); d[15] = bfhi(c.w);
        }
        __syncthreads();
        for (int t = 0; t < 64; ++t) {
            float u[16];
            const float4* us = (const float4*)(su + t * 16);
            const float4 u0 = us[0], u1 = us[1], u2 = us[2], u3 = us[3];
            u[0] = u0.x; u[1] = u0.y; u[2] = u0.z; u[3] = u0.w; u[4] = u1.x; u[5] = u1.y; u[6] = u1.z; u[7] = u1.w;
            u[8] = u2.x; u[9] = u2.y; u[10] = u2.z; u[11] = u2.w; u[12] = u3.x; u[13] = u3.y; u[14] = u3.z; u[15] = u3.w;
            float bur = 0.f, bui = 0.f;
#pragma unroll
            for (int i = 0; i < 16; ++i) { bur += bbr[i] * u[i]; bui += bbi[i] * u[i]; }
            const float nxr = lr * xr - li * xi + bur, nxi = lr * xi + li * xr + bui;
            xr = nxr; xi = nxi;
            float y[16];
#pragma unroll
            for (int i = 0; i < 16; ++i) y[i] = cr[i] * xr - ci[i] * xi;
            const bool b5 = lane & 32, b4 = lane & 16, b3 = lane & 8, b2 = lane & 4;
            float y8[8], y4[4], y2[2];
#pragma unroll
            for (int j = 0; j < 8; ++j) { const float keep = b5 ? y[8 + j] : y[j], send = b5 ? y[j] : y[8 + j]; y8[j] = keep + __shfl_xor(send, 32); }
#pragma unroll
            for (int j = 0; j < 4; ++j) { const float keep = b4 ? y8[4 + j] : y8[j], send = b4 ? y8[j] : y8[4 + j]; y4[j] = keep + __shfl_xor(send, 16); }
#pragma unroll
            for (int j = 0; j < 2; ++j) { const float keep = b3 ? y4[2 + j] : y4[j], send = b3 ? y4[j] : y4[2 + j]; y2[j] = keep + __shfl_xor(send, 8); }
            float y1;
            { const float keep = b2 ? y2[1] : y2[0], send = b2 ? y2[0] : y2[1]; y1 = keep + __shfl_xor(send, 4); }
            y1 += __shfl_xor(y1, 1); y1 += __shfl_xor(y1, 2);
            if ((lane & 3) == 0) {
                const float uu = su[t * 16 + ch];
                Y[(size_t)(b * SEQ + t0 + t) * DSS + g * SSC + ch] = f2bf(geluf_(y1 + dch * uu));
            }
        }
        __syncthreads();
    }
}
DI void phase_mix(const Params& p, int bid, int nb, char* smem) {
    for (int it = bid; it < 512 + 64; it += nb) {
        if (it < 512) hgrn_item(p, it, smem); else s5_item(p, it - 512, smem);
        __syncthreads();
    }
}

DI void phase_glu(const Params& p, int bid, int nb, char* smem) {
    const bf16_t* Y = (const bf16_t*)(p.ws + OFF_YSSM);
    const bf16_t* W = (const bf16_t*)(p.ws + OFF_GLU);
    float* Y2 = (float*)(p.ws + OFF_H);
    constexpr int NTN = 4, NTM = NTOK / 128;
    for (int t = bid; t < NTM * NTN; t += nb) {
        const int mt = t / NTN, nt = t % NTN;
        const bf16_t* Yt = Y + (size_t)mt * 128 * DSS + nt * 128;
        float* Ot = Y2 + (size_t)mt * 128 * DSS + nt * 128;
        const float* gb = p.glu_b + nt * 128;
        gemm_block<2, 1, 2, 4>(Y + (size_t)mt * 128 * DSS, DSS, W + (size_t)nt * 128 * 512, 512, 512, smem,
                               [&](int r, int c, float v) { const float y = bf2f(Yt[(size_t)r * DSS + c]); Ot[(size_t)r * DSS + c] = y * sigmoidf_(v + gb[c]); });
        __syncthreads();
    }
}
DI void phase_a2(const Params& p, int bid, int nb) {
    const float* ORAW = (const float*)(p.ws + OFF_ORAW);
    const float* Y2 = (const float*)(p.ws + OFF_H);
    const bf16_t* P = (const bf16_t*)(p.ws + OFF_PROJ);
    bf16_t* A2 = (bf16_t*)(p.ws + OFF_A2);
    const int lane = threadIdx.x & 63, wid = threadIdx.x >> 6;
    for (int tok = bid * 8 + wid; tok < NTOK; tok += nb * 8) {
        const int c0 = lane * 8;
        {
            const float4 a = *(const float4*)(ORAW + (size_t)tok * DHG + c0), b = *(const float4*)(ORAW + (size_t)tok * DHG + c0 + 4);
            float ss = a.x * a.x + a.y * a.y + a.z * a.z + a.w * a.w + b.x * b.x + b.y * b.y + b.z * b.z + b.w * b.w;
            ss += __shfl_xor(ss, 1); ss += __shfl_xor(ss, 2); ss += __shfl_xor(ss, 4); ss += __shfl_xor(ss, 8);
            const float rs = rsqrtf(ss * (1.0f / 128.0f) + RMS_EPS);
            const uint4 gq = *(const uint4*)(P + (size_t)tok * INC + 1536 + c0);
            const float4 w0 = *(const float4*)(p.hg_nw + c0), w1 = *(const float4*)(p.hg_nw + c0 + 4);
            uint4 o;
            o.x = pack2(a.x * rs * w0.x * bflo(gq.x), a.y * rs * w0.y * bfhi(gq.x));
            o.y = pack2(a.z * rs * w0.z * bflo(gq.y), a.w * rs * w0.w * bfhi(gq.y));
            o.z = pack2(b.x * rs * w1.x * bflo(gq.z), b.y * rs * w1.y * bfhi(gq.z));
            o.w = pack2(b.z * rs * w1.z * bflo(gq.w), b.w * rs * w1.w * bfhi(gq.w));
            *(uint4*)(A2 + (size_t)tok * DM + c0) = o;
        }
        {
            const float4 a = *(const float4*)(Y2 + (size_t)tok * DSS + c0), b = *(const float4*)(Y2 + (size_t)tok * DSS + c0 + 4);
            float ss = a.x * a.x + a.y * a.y + a.z * a.z + a.w * a.w + b.x * b.x + b.y * b.y + b.z * b.z + b.w * b.w;
#pragma unroll
            for (int m = 1; m < 64; m <<= 1) ss += __shfl_xor(ss, m);
            const float rs = rsqrtf(ss * (1.0f / 512.0f) + RMS_EPS);
            const float4 w0 = *(const float4*)(p.ssm_nw + c0), w1 = *(const float4*)(p.ssm_nw + c0 + 4);
            uint4 o;
            o.x = pack2(a.x * rs * w0.x, a.y * rs * w0.y); o.y = pack2(a.z * rs * w0.z, a.w * rs * w0.w);
            o.z = pack2(b.x * rs * w1.x, b.y * rs * w1.y); o.w = pack2(b.z * rs * w1.z, b.w * rs * w1.w);
            *(uint4*)(A2 + (size_t)tok * DM + 512 + c0) = o;
        }
    }
}

DI void phase_outproj(const Params& p, int bid, int nb, char* smem) {
    const bf16_t* A2 = (const bf16_t*)(p.ws + OFF_A2);
    const bf16_t* W = (const bf16_t*)(p.ws + OFF_WOUT);
    const float* mod = (const float*)(p.ws + OFF_MOD);
    constexpr int NTN = 8, NTM = NTOK / 128;
    for (int t = bid; t < NTM * NTN; t += nb) {
        const int mt = t / NTN, nt = t % NTN, b = (mt * 128) / SEQ;
        const float* xt = p.x + (size_t)mt * 128 * DM + nt * 128;
        float* ot = p.out + (size_t)mt * 128 * DM + nt * 128;
        const float* g1 = mod + b * 6144 + 2048 + nt * 128;
        gemm_block<2, 1, 2, 4>(A2 + (size_t)mt * 128 * DM, DM, W + (size_t)nt * 128 * DM, DM, DM, smem,
                               [&](int r, int c, float v) { ot[(size_t)r * DM + c] = DEEP_ALPHA * xt[(size_t)r * DM + c] + (1.0f + g1[c]) * v; });
        __syncthreads();
    }
}
DI void phase_ln1(const Params& p, int bid, int nb) {
    const float* mod = (const float*)(p.ws + OFF_MOD);
    bf16_t* H2 = (bf16_t*)(p.ws + OFF_H);
    const int lane = threadIdx.x & 63, wid = threadIdx.x >> 6;
    for (int tok = bid * 8 + wid; tok < NTOK; tok += nb * 8) {
        const int b = tok / SEQ;
        float* row = p.out + (size_t)tok * DM;
        float4 v[4];
        float s = 0.f;
#pragma unroll
        for (int j = 0; j < 4; ++j) { v[j] = *(const float4*)(row + j * 256 + lane * 4); s += v[j].x + v[j].y + v[j].z + v[j].w; }
#pragma unroll
        for (int m = 1; m < 64; m <<= 1) s += __shfl_xor(s, m);
        const float mu = s * (1.0f / 1024.0f);
        float q = 0.f;
#pragma unroll
        for (int j = 0; j < 4; ++j) { const float a = v[j].x - mu, bb = v[j].y - mu, cc = v[j].z - mu, d = v[j].w - mu; q += a * a + bb * bb + cc * cc + d * d; }
#pragma unroll
        for (int m = 1; m < 64; m <<= 1) q += __shfl_xor(q, m);
        const float rstd = rsqrtf(q * (1.0f / 1024.0f) + LN_EPS);
        const float* sh2 = mod + b * 6144 + 3072;
        const float* sc2 = mod + b * 6144 + 4096;
#pragma unroll
        for (int j = 0; j < 4; ++j) {
            const int c = j * 256 + lane * 4;
            const float4 w = *(const float4*)(p.ln1w + c), bi = *(const float4*)(p.ln1b + c), sc = *(const float4*)(sc2 + c), sh = *(const float4*)(sh2 + c);
            float4 o;
            o.x = (v[j].x - mu) * rstd * w.x + bi.x; o.y = (v[j].y - mu) * rstd * w.y + bi.y; o.z = (v[j].z - mu) * rstd * w.z + bi.z; o.w = (v[j].w - mu) * rstd * w.w + bi.w;
            *(float4*)(row + c) = o;
            uint2 hh; hh.x = pack2(o.x * (1.f + sc.x) + sh.x, o.y * (1.f + sc.y) + sh.y); hh.y = pack2(o.z * (1.f + sc.z) + sh.z, o.w * (1.f + sc.w) + sh.w);
            *(uint2*)(H2 + (size_t)tok * DM + c) = hh;
        }
    }
}

DI void phase_q(const Params& p, int bid, int nb, char* smem) {
    const bf16_t* H2 = (const bf16_t*)(p.ws + OFF_H);
    const bf16_t* W = (const bf16_t*)(p.ws + OFF_WQ);
    bf16_t* Q = (bf16_t*)(p.ws + OFF_PROJ);
    constexpr int NTN = 16, NTM = NTOK / 128;
    for (int t = bid; t < NTM * NTN; t += nb) {
        const int mt = t / NTN, nt = t % NTN;
        bf16_t* Qt = Q + (size_t)mt * 128 * 2048 + nt * 128;
        gemm_block<2, 1, 2, 4>(H2 + (size_t)mt * 128 * DM, DM, W + (size_t)nt * 128 * DM, DM, DM, smem,
                               [&](int r, int c, float v) { Qt[(size_t)r * 2048 + c] = f2bf(v); });
        __syncthreads();
    }
}
DI void phase_topk(const Params& p, int bid, int nb, char* smem) {
    const bf16_t* Q = (const bf16_t*)(p.ws + OFF_PROJ);
    const bf16_t* SK = (const bf16_t*)(p.ws + OFF_SUBK);
    unsigned* TOPL = (unsigned*)(p.ws + OFF_TOPL);
    float* sc = (float*)(smem + 36864);
    constexpr int NTM = NTOK / 128;
    for (int t = bid; t < NTM * 16; t += nb) {
        const int mt = t >> 4, hp = t & 15;
        gemm_block<2, 1, 2, 4>(Q + (size_t)mt * 128 * 2048 + hp * 128, 2048, SK + (size_t)hp * 128 * 128, 128, 128, smem,
                               [&](int r, int c, float v) { sc[r * 129 + c] = v; });
        __syncthreads();
        if (threadIdx.x < 128) {
            const int r = threadIdx.x;
            float tk[16];
#pragma unroll
            for (int j = 0; j < 16; ++j) tk[j] = -3.0e38f;
            for (int n = 0; n < 128; ++n) {
                float xv = __uint_as_float((__float_as_uint(sc[r * 129 + n]) & ~0x7fu) | (unsigned)n);
#pragma unroll
                for (int j = 0; j < 16; ++j) { const float hi = fmaxf(tk[j], xv), lo = fminf(tk[j], xv); tk[j] = hi; xv = lo; }
            }
            uint4* dst = (uint4*)(TOPL + ((size_t)(mt * 128 + r) * 16 + hp) * 16);
            dst[0] = make_uint4(__float_as_uint(tk[0]), __float_as_uint(tk[1]), __float_as_uint(tk[2]), __float_as_uint(tk[3]));
            dst[1] = make_uint4(__float_as_uint(tk[4]), __float_as_uint(tk[5]), __float_as_uint(tk[6]), __float_as_uint(tk[7]));
            dst[2] = make_uint4(__float_as_uint(tk[8]), __float_as_uint(tk[9]), __float_as_uint(tk[10]), __float_as_uint(tk[11]));
            dst[3] = make_uint4(__float_as_uint(tk[12]), __float_as_uint(tk[13]), __float_as_uint(tk[14]), __float_as_uint(tk[15]));
        }
        __syncthreads();
    }
}
DI void phase_combine(const Params& p, int bid, int nb) {
    const unsigned* TOPL = (const unsigned*)(p.ws + OFF_TOPL);
    uint2* EX = (uint2*)(p.ws + OFF_EXPS);
    for (int i = bid * NTH + threadIdx.x; i < NTOK * PHEADS; i += nb * NTH) {
        const unsigned* l1 = TOPL + (size_t)i * 32;
        const unsigned* l2 = l1 + 16;
        float s2[16];
        {
            const uint4 a = ((const uint4*)l2)[0], b = ((const uint4*)l2)[1], c = ((const uint4*)l2)[2], d = ((const uint4*)l2)[3];
            const unsigned w[16] = {a.x, a.y, a.z, a.w, b.x, b.y, b.z, b.w, c.x, c.y, c.z, c.w, d.x, d.y, d.z, d.w};
#pragma unroll
            for (int j = 0; j < 16; ++j) s2[j] = __uint_as_float(w[j] & ~0x7fu);
        }
        float tk[16];
#pragma unroll
        for (int j = 0; j < 16; ++j) tk[j] = -3.0e38f;
        for (int a = 0; a < 16; ++a) {
            const float s1 = __uint_as_float(l1[a] & ~0x7fu);
#pragma unroll
            for (int b = 0; b < 16; ++b) {
                float xv = __uint_as_float((__float_as_uint(s1 + s2[b]) & ~0xffu) | (unsigned)(a * 16 + b));
#pragma unroll
                for (int j = 0; j < 16; ++j) { const float hi = fmaxf(tk[j], xv), lo = fminf(tk[j], xv); tk[j] = hi; xv = lo; }
            }
        }
        float e[16], sum = 0.f;
        const float mx = __uint_as_float(__float_as_uint(tk[0]) & ~0xffu);
#pragma unroll
        for (int j = 0; j < 16; ++j) { e[j] = __expf(__uint_as_float(__float_as_uint(tk[j]) & ~0xffu) - mx); sum += e[j]; }
        const float inv = 1.0f / sum;
#pragma unroll
        for (int j = 0; j < 16; ++j) {
            const unsigned ab = __float_as_uint(tk[j]) & 0xffu;
            const unsigned i1 = l1[ab >> 4] & 0x7fu, i2 = l2[ab & 15] & 0x7fu;
            EX[(size_t)i * 16 + j] = make_uint2(i1 * 128u + i2, __float_as_uint(e[j] * inv));
        }
    }
}

DI void phase_gather(const Params& p, int bid, int nb) {
    const float* mod = (const float*)(p.ws + OFF_MOD);
    const uint2* EX = (const uint2*)(p.ws + OFF_EXPS);
    const bf16_t* UT = (const bf16_t*)(p.ws + OFF_UT);
    const bf16_t* VT = (const bf16_t*)(p.ws + OFF_VT);
    const int lane = threadIdx.x & 63, wid = threadIdx.x >> 6;
    for (int tok = bid * 8 + wid; tok < NTOK; tok += nb * 8) {
        const int b = tok / SEQ;
        float* row = p.out + (size_t)tok * DM;
        const float* sh2 = mod + b * 6144 + 3072;
        const float* sc2 = mod + b * 6144 + 4096;
        const float* g2 = mod + b * 6144 + 5120;
        float x1[16], h2[16], acc[16];
#pragma unroll
        for (int j = 0; j < 2; ++j)
#pragma unroll
            for (int q = 0; q < 2; ++q) {
                const int c = j * 512 + lane * 8 + q * 4;
                const float4 xv = *(const float4*)(row + c), sc = *(const float4*)(sc2 + c), sh = *(const float4*)(sh2 + c);
                const int o = j * 8 + q * 4;
                x1[o] = xv.x; x1[o + 1] = xv.y; x1[o + 2] = xv.z; x1[o + 3] = xv.w;
                h2[o] = xv.x * (1.f + sc.x) + sh.x; h2[o + 1] = xv.y * (1.f + sc.y) + sh.y;
                h2[o + 2] = xv.z * (1.f + sc.z) + sh.z; h2[o + 3] = xv.w * (1.f + sc.w) + sh.w;
            }
#pragma unroll
        for (int i = 0; i < 16; ++i) acc[i] = 0.f;
        const uint2 e0 = EX[(size_t)tok * 128 + lane], e1 = EX[(size_t)tok * 128 + 64 + lane];
        for (int e = 0; e < 128; ++e) {
            const unsigned src = (e < 64) ? e0.x : e1.x, gsrc = (e < 64) ? e0.y : e1.y;
            const unsigned eid = __builtin_amdgcn_readlane(src, e & 63);
            const float gate = __uint_as_float(__builtin_amdgcn_readlane(gsrc, e & 63));
            const uint4 ua = *(const uint4*)(UT + (size_t)eid * DM + lane * 8), ub = *(const uint4*)(UT + (size_t)eid * DM + 512 + lane * 8);
            const uint4 va = *(const uint4*)(VT + (size_t)eid * DM + lane * 8), vb = *(const uint4*)(VT + (size_t)eid * DM + 512 + lane * 8);
            float z = bflo(ua.x) * h2[0] + bfhi(ua.x) * h2[1] + bflo(ua.y) * h2[2] + bfhi(ua.y) * h2[3] + bflo(ua.z) * h2[4] + bfhi(ua.z) * h2[5] + bflo(ua.w) * h2[6] + bfhi(ua.w) * h2[7]
                    + bflo(ub.x) * h2[8] + bfhi(ub.x) * h2[9] + bflo(ub.y) * h2[10] + bfhi(ub.y) * h2[11] + bflo(ub.z) * h2[12] + bfhi(ub.z) * h2[13] + bflo(ub.w) * h2[14] + bfhi(ub.w) * h2[15];
#pragma unroll
            for (int m = 1; m < 64; m <<= 1) z += __shfl_xor(z, m);
            const float a = geluf_(z) * gate;
            acc[0] += a * bflo(va.x); acc[1] += a * bfhi(va.x); acc[2] += a * bflo(va.y); acc[3] += a * bfhi(va.y);
            acc[4] += a * bflo(va.z); acc[5] += a * bfhi(va.z); acc[6] += a * bflo(va.w); acc[7] += a * bfhi(va.w);
            acc[8] += a * bflo(vb.x); acc[9] += a * bfhi(vb.x); acc[10] += a * bflo(vb.y); acc[11] += a * bfhi(vb.y);
            acc[12] += a * bflo(vb.z); acc[13] += a * bfhi(vb.z); acc[14] += a * bflo(vb.w); acc[15] += a * bfhi(vb.w);
        }
        float r[16], s = 0.f;
#pragma unroll
        for (int j = 0; j < 2; ++j)
#pragma unroll
            for (int q = 0; q < 2; ++q) {
                const int c = j * 512 + lane * 8 + q * 4;
                const float4 gg = *(const float4*)(g2 + c);
                const int o = j * 8 + q * 4;
                r[o] = DEEP_ALPHA * x1[o] + (1.f + gg.x) * acc[o]; r[o + 1] = DEEP_ALPHA * x1[o + 1] + (1.f + gg.y) * acc[o + 1];
                r[o + 2] = DEEP_ALPHA * x1[o + 2] + (1.f + gg.z) * acc[o + 2]; r[o + 3] = DEEP_ALPHA * x1[o + 3] + (1.f + gg.w) * acc[o + 3];
            }
#pragma unroll
        for (int i = 0; i < 16; ++i) s += r[i];
#pragma unroll
        for (int m = 1; m < 64; m <<= 1) s += __shfl_xor(s, m);
        const float mu = s * (1.0f / 1024.0f);
        float qq = 0.f;
#pragma unroll
        for (int i = 0; i < 16; ++i) { const float d = r[i] - mu; qq += d * d; }
#pragma unroll
        for (int m = 1; m < 64; m <<= 1) qq += __shfl_xor(qq, m);
        const float rstd = rsqrtf(qq * (1.0f / 1024.0f) + LN_EPS);
#pragma unroll
        for (int j = 0; j < 2; ++j)
#pragma unroll
            for (int q = 0; q < 2; ++q) {
                const int c = j * 512 + lane * 8 + q * 4, o = j * 8 + q * 4;
                const float4 w = *(const float4*)(p.ln2w + c), bi = *(const float4*)(p.ln2b + c);
                float4 ov;
                ov.x = (r[o] - mu) * rstd * w.x + bi.x; ov.y = (r[o + 1] - mu) * rstd * w.y + bi.y; ov.z = (r[o + 2] - mu) * rstd * w.z + bi.z; ov.w = (r[o + 3] - mu) * rstd * w.w + bi.w;
                *(float4*)(row + c) = ov;
            }
    }
}

#define SMEM_DECL __shared__ __attribute__((aligned(16))) char smem[SMEM_BYTES]
__global__ void __launch_bounds__(NTH) k_prep(Params p) { SMEM_DECL; phase_prep(p, blockIdx.x, gridDim.x, smem); }
__global__ void __launch_bounds__(NTH) k_h(Params p) { phase_h(p, blockIdx.x, gridDim.x); }
__global__ void __launch_bounds__(NTH) k_proj(Params p) { SMEM_DECL; phase_proj(p, blockIdx.x, gridDim.x, smem); }
__global__ void __launch_bounds__(NTH) k_mix(Params p) { SMEM_DECL; phase_mix(p, blockIdx.x, gridDim.x, smem); }
__global__ void __launch_bounds__(NTH) k_glu(Params p) { SMEM_DECL; phase_glu(p, blockIdx.x, gridDim.x, smem); }
__global__ void __launch_bounds__(NTH) k_a2(Params p) { phase_a2(p, blockIdx.x, gridDim.x); }
__global__ void __launch_bounds__(NTH) k_outproj(Params p) { SMEM_DECL; phase_outproj(p, blockIdx.x, gridDim.x, smem); }
__global__ void __launch_bounds__(NTH) k_ln1(Params p) { phase_ln1(p, blockIdx.x, gridDim.x); }
__global__ void __launch_bounds__(NTH) k_q(Params p) { SMEM_DECL; phase_q(p, blockIdx.x, gridDim.x, smem); }
__global__ void __launch_bounds__(NTH) k_topk(Params p) { SMEM_DECL; phase_topk(p, blockIdx.x, gridDim.x, smem); }
__global__ void __launch_bounds__(NTH) k_combine(Params p) { phase_combine(p, blockIdx.x, gridDim.x); }
__global__ void __launch_bounds__(NTH) k_gather(Params p) { phase_gather(p, blockIdx.x, gridDim.x); }

extern "C" void kernel_launch(void* const* d_in, const int* in_sizes, int n_in, void* d_out, int out_size, void* d_ws, size_t ws_size, hipStream_t stream) {
    if (n_in != 27 || ws_size < WS_END) { fprintf(stderr, "kernel_launch: unexpected n_in %d or ws_size %zu (< %zu)\n", n_in, ws_size, (size_t)WS_END); return; }
    Params p{};
    const float** f = (const float**)&p;
    for (int i = 0; i < 27; ++i) f[i] = (const float*)d_in[i];
    p.out = (float*)d_out; p.ws = (char*)d_ws;
    const dim3 blk(NTH);
    hipLaunchKernelGGL(k_prep, dim3(2048), blk, 0, stream, p);
    hipLaunchKernelGGL(k_h, dim3(2048), blk, 0, stream, p);
    hipLaunchKernelGGL(k_proj, dim3(5120), blk, 0, stream, p);
    hipLaunchKernelGGL(k_mix, dim3(576), blk, 0, stream, p);
    hipLaunchKernelGGL(k_glu, dim3(1024), blk, 0, stream, p);
    hipLaunchKernelGGL(k_a2, dim3(2048), blk, 0, stream, p);
    hipLaunchKernelGGL(k_outproj, dim3(2048), blk, 0, stream, p);
    hipLaunchKernelGGL(k_ln1, dim3(2048), blk, 0, stream, p);
    hipLaunchKernelGGL(k_q, dim3(4096), blk, 0, stream, p);
    hipLaunchKernelGGL(k_topk, dim3(4096), blk, 0, stream, p);
    hipLaunchKernelGGL(k_combine, dim3(512), blk, 0, stream, p);
    hipLaunchKernelGGL(k_gather, dim3(4096), blk, 0, stream, p);
}
```

```cpp
#include <hip/hip_runtime.h>
#include <hip/hip_cooperative_groups.h>
#include <stdint.h>
#include <stdio.h>

namespace cg = cooperative_groups;
#define DI __device__ __forceinline__
typedef unsigned short bf16_t;
typedef short bf16x8 __attribute__((ext_vector_type(8)));
typedef float f32x16 __attribute__((ext_vector_type(16)));
typedef unsigned u32x4 __attribute__((ext_vector_type(4)));

constexpr int NTH = 512;
constexpr int NB = 16, SEQ = 2048, DM = 1024, NTOK = NB * SEQ;
constexpr int DHG = 512, HGH = 4, HDK = 128;
constexpr int DSS = 512, SSG = 32, SSC = 16, SSP = 64;
constexpr int INC = 2560;
constexpr int PHEADS = 8, NKEYS = 128, TOPK = 16, NEXP = 16384;
constexpr float DEEP_ALPHA = 1.189207115002721f;
constexpr float LN_EPS = 1e-5f, RMS_EPS = 1e-6f;
constexpr int SMEM_BYTES = 104 * 1024;

constexpr size_t al256(size_t x) { return (x + 255) & ~(size_t)255; }
constexpr size_t OFF_MOD = 0;
constexpr size_t OFF_LB = al256(OFF_MOD + (size_t)NB * 6144 * 4);
constexpr size_t OFF_LAM = al256(OFF_LB + 512 * 4);
constexpr size_t OFF_BB = al256(OFF_LAM + 32 * 64 * 2 * 4);
constexpr size_t OFF_WIN = al256(OFF_BB + 32 * 64 * 16 * 2 * 4);
constexpr size_t OFF_GLU = al256(OFF_WIN + (size_t)INC * DM * 2);
constexpr size_t OFF_WOUT = al256(OFF_GLU + (size_t)512 * 512 * 2);
constexpr size_t OFF_WQ = al256(OFF_WOUT + (size_t)DM * DM * 2);
constexpr size_t OFF_SUBK = al256(OFF_WQ + (size_t)2048 * DM * 2);
constexpr size_t OFF_UT = al256(OFF_SUBK + (size_t)16 * 128 * 128 * 2);
constexpr size_t OFF_VT = al256(OFF_UT + (size_t)NEXP * DM * 2);
constexpr size_t OFF_H = al256(OFF_VT + (size_t)NEXP * DM * 2);
constexpr size_t OFF_PROJ = al256(OFF_H + (size_t)NTOK * DM * 2);
constexpr size_t OFF_ORAW = al256(OFF_PROJ + (size_t)NTOK * INC * 2);
constexpr size_t OFF_YSSM = al256(OFF_ORAW + (size_t)NTOK * DHG * 4);
constexpr size_t OFF_A2 = al256(OFF_YSSM + (size_t)NTOK * DSS * 2);
constexpr size_t WS_END = al256(OFF_A2 + (size_t)NTOK * DM * 2);
constexpr size_t OFF_TOPL = OFF_ORAW;
constexpr size_t OFF_EXPS = OFF_ORAW + (size_t)NTOK * 16 * 16 * 4;

struct Params {
    const float *x, *c, *ada_w, *ada_b, *w_in, *hg_lb, *hg_nw, *a_re, *a_im, *log_dt, *b_re, *b_im, *c_re, *c_im, *dsk,
        *glu_w, *glu_b, *ssm_nw, *w_out, *ln1w, *ln1b, *w_q, *subk, *pu, *pv, *ln2w, *ln2b;
    float* out;
    char* ws;
};

DI bf16_t f2bf(float x) { unsigned u = __float_as_uint(x); u += 0x7fffu + ((u >> 16) & 1u); return (bf16_t)(u >> 16); }
DI float bf2f(bf16_t b) { return __uint_as_float(((unsigned)b) << 16); }
DI float bflo(unsigned w) { return __uint_as_float(w << 16); }
DI float bfhi(unsigned w) { return __uint_as_float(w & 0xffff0000u); }
DI unsigned pack2(float a, float b) { return (unsigned)f2bf(a) | ((unsigned)f2bf(b) << 16); }
DI float sigmoidf_(float x) { return 1.0f / (1.0f + __expf(-x)); }
DI float siluf_(float x) { return x * sigmoidf_(x); }
DI float geluf_(float x) { return 0.5f * x * (1.0f + erff(x * 0.70710678118654752f)); }

template <int MT, int NT_, int WM, int WN, class Epi>
DI void gemm_block(const bf16_t* __restrict__ A, int lda, const bf16_t* __restrict__ Bt, int ldb, int K, char* smem, Epi epi) {
    constexpr int BM = WM * MT * 32, BN = WN * NT_ * 32, LS = 72;
    static_assert(WM * WN == 8, "8 waves");
    bf16_t* As = (bf16_t*)smem;
    bf16_t* Bs = As + BM * LS;
    const int tid = threadIdx.x, lane = tid & 63, wid = tid >> 6, r = lane & 31, h = lane >> 5;
    const int wm = wid / WN, wn = wid % WN;
    constexpr int PA = BM * 8 / NTH, PB = BN * 8 / NTH;
    u32x4 ra[PA], rb[PB];
    f32x16 acc[MT][NT_];
#pragma unroll
    for (int mi = 0; mi < MT; ++mi)
#pragma unroll
        for (int ni = 0; ni < NT_; ++ni)
#pragma unroll
            for (int i = 0; i < 16; ++i) acc[mi][ni][i] = 0.f;
#define GEMM_GLOAD(kt_) { \
    _Pragma("unroll") for (int q = 0; q < PA; ++q) { const int idx = tid + q * NTH, row = idx >> 3, ch = idx & 7; ra[q] = *(const u32x4*)(A + (size_t)row * lda + (kt_) * 64 + ch * 8); } \
    _Pragma("unroll") for (int q = 0; q < PB; ++q) { const int idx = tid + q * NTH, row = idx >> 3, ch = idx & 7; rb[q] = *(const u32x4*)(Bt + (size_t)row * ldb + (kt_) * 64 + ch * 8); } }
#define GEMM_LSTORE() { \
    _Pragma("unroll") for (int q = 0; q < PA; ++q) { const int idx = tid + q * NTH, row = idx >> 3, ch = idx & 7; *(u32x4*)(As + row * LS + ch * 8) = ra[q]; } \
    _Pragma("unroll") for (int q = 0; q < PB; ++q) { const int idx = tid + q * NTH, row = idx >> 3, ch = idx & 7; *(u32x4*)(Bs + row * LS + ch * 8) = rb[q]; } }
    GEMM_GLOAD(0); GEMM_LSTORE(); __syncthreads();
    const int nk = K / 64;
    for (int kt = 0; kt < nk; ++kt) {
        if (kt + 1 < nk) GEMM_GLOAD(kt + 1);
#pragma unroll
        for (int ks = 0; ks < 4; ++ks) {
            bf16x8 a[MT], b[NT_];
#pragma unroll
            for (int mi = 0; mi < MT; ++mi) a[mi] = *(const bf16x8*)(As + (wm * MT * 32 + mi * 32 + r) * LS + ks * 16 + h * 8);
#pragma unroll
            for (int ni = 0; ni < NT_; ++ni) b[ni] = *(const bf16x8*)(Bs + (wn * NT_ * 32 + ni * 32 + r) * LS + ks * 16 + h * 8);
#pragma unroll
            for (int mi = 0; mi < MT; ++mi)
#pragma unroll
                for (int ni = 0; ni < NT_; ++ni) acc[mi][ni] = __builtin_amdgcn_mfma_f32_32x32x16_bf16(a[mi], b[ni], acc[mi][ni], 0, 0, 0);
        }
        __syncthreads();
        if (kt + 1 < nk) { GEMM_LSTORE(); __syncthreads(); }
    }
#pragma unroll
    for (int mi = 0; mi < MT; ++mi)
#pragma unroll
        for (int ni = 0; ni < NT_; ++ni)
#pragma unroll
            for (int i = 0; i < 16; ++i) epi(wm * MT * 32 + mi * 32 + (i & 3) + 8 * (i >> 2) + 4 * h, wn * NT_ * 32 + ni * 32 + r, acc[mi][ni][i]);
}

DI void prep_mod_item(const Params& p, int item, char* smem) {
    float* cond = (float*)smem;
    const int tid = threadIdx.x;
    for (int i = tid; i < NB * DM; i += NTH) cond[i] = siluf_(p.c[i]);
    __syncthreads();
    const int b = tid >> 5, col = item * 32 + (tid & 31);
    float acc = 0.f;
    const float* w = p.ada_w + col;
    const float* cb = cond + b * DM;
#pragma unroll 8
    for (int k = 0; k < DM; ++k) acc += cb[k] * w[(size_t)k * 6144];
    ((float*)(p.ws + OFF_MOD))[b * 6144 + col] = acc + p.ada_b[col];
    __syncthreads();
}
DI void prep_s5_item(const Params& p, int g) {
    const int tid = threadIdx.x;
    if (tid < SSP) {
        const int pi = g * SSP + tid;
        const float dt = expf(p.log_dt[g]);
        const float ar = p.a_re[pi], ai = p.a_im[pi];
        const float mag = expf(ar * dt);
        const float lr = mag * cosf(ai * dt), li = mag * sinf(ai * dt);
        const float den = ar * ar + ai * ai, nr = lr - 1.0f, ni = li;
        const float zr = (nr * ar + ni * ai) / den, zi = (ni * ar - nr * ai) / den;
        float* lam = (float*)(p.ws + OFF_LAM) + pi * 2;
        lam[0] = lr; lam[1] = li;
        float* bb = (float*)(p.ws + OFF_BB) + (size_t)pi * 32;
        for (int i = 0; i < SSC; ++i) {
            const float br = p.b_re[pi * SSC + i], bi = p.b_im[pi * SSC + i];
            bb[i * 2] = zr * br - zi * bi; bb[i * 2 + 1] = zr * bi + zi * br;
        }
    }
}
DI void prep_transpose_tile(const float* __restrict__ W, bf16_t* __restrict__ Wt, int K, int N, int kt, int nt, char* smem) {
    float* tile = (float*)smem;
    const int tid = threadIdx.x;
#pragma unroll
    for (int q = 0; q < 2; ++q) {
        const int kk = (tid >> 4) + q * 32, c4 = (tid & 15) * 4;
        const float4 v = *(const float4*)(W + (size_t)(kt * 64 + kk) * N + nt * 64 + c4);
        tile[kk * 65 + c4] = v.x; tile[kk * 65 + c4 + 1] = v.y; tile[kk * 65 + c4 + 2] = v.z; tile[kk * 65 + c4 + 3] = v.w;
    }
    __syncthreads();
    const int n = tid >> 3, kc = tid & 7;
    uint4 o;
    o.x = pack2(tile[(kc * 8 + 0) * 65 + n], tile[(kc * 8 + 1) * 65 + n]);
    o.y = pack2(tile[(kc * 8 + 2) * 65 + n], tile[(kc * 8 + 3) * 65 + n]);
    o.z = pack2(tile[(kc * 8 + 4) * 65 + n], tile[(kc * 8 + 5) * 65 + n]);
    o.w = pack2(tile[(kc * 8 + 6) * 65 + n], tile[(kc * 8 + 7) * 65 + n]);
    *(uint4*)(Wt + (size_t)(nt * 64 + n) * K + kt * 64 + kc * 8) = o;
    __syncthreads();
}
DI void cvt_bf16_stream(const float* __restrict__ src, bf16_t* __restrict__ dst, size_t n8, int bid, int nb) {
    for (size_t i = (size_t)bid * NTH + threadIdx.x; i < n8; i += (size_t)nb * NTH) {
        const float4 a = *(const float4*)(src + i * 8), b = *(const float4*)(src + i * 8 + 4);
        uint4 o; o.x = pack2(a.x, a.y); o.y = pack2(a.z, a.w); o.z = pack2(b.x, b.y); o.w = pack2(b.z, b.w);
        *(uint4*)(dst + i * 8) = o;
    }
}
DI void phase_prep(const Params& p, int bid, int nb, char* smem) {
    constexpr int N_MOD = 192, N_LB = 1, N_S5 = 32, T_WIN = 16 * 40, T_GLU = 8 * 8, T_WOUT = 16 * 16, T_WQ = 16 * 32;
    constexpr int I_LB = N_MOD, I_S5 = I_LB + N_LB, I_WIN = I_S5 + N_S5, I_GLU = I_WIN + T_WIN, I_WOUT = I_GLU + T_GLU, I_WQ = I_WOUT + T_WOUT, I_END = I_WQ + T_WQ;
    for (int it = bid; it < I_END; it += nb) {
        if (it < N_MOD) prep_mod_item(p, it, smem);
        else if (it < I_S5) {
            const int j = threadIdx.x;
            const float a0 = p.hg_lb[j], a1 = p.hg_lb[512 + j], m = fmaxf(a0, a1);
            const float e0 = expf(a0 - m), e1 = expf(a1 - m);
            ((float*)(p.ws + OFF_LB))[j] = e0 / (e0 + e1);
        } else if (it < I_WIN) prep_s5_item(p, it - I_S5);
        else if (it < I_GLU) { const int t = it - I_WIN; prep_transpose_tile(p.w_in, (bf16_t*)(p.ws + OFF_WIN), DM, INC, t / 40, t % 40, smem); }
        else if (it < I_WOUT) { const int t = it - I_GLU; prep_transpose_tile(p.glu_w, (bf16_t*)(p.ws + OFF_GLU), 512, 512, t / 8, t % 8, smem); }
        else if (it < I_WQ) { const int t = it - I_WOUT; prep_transpose_tile(p.w_out, (bf16_t*)(p.ws + OFF_WOUT), DM, DM, t / 16, t % 16, smem); }
        else { const int t = it - I_WQ; prep_transpose_tile(p.w_q, (bf16_t*)(p.ws + OFF_WQ), DM, 2048, t / 32, t % 32, smem); }
    }
    cvt_bf16_stream(p.subk, (bf16_t*)(p.ws + OFF_SUBK), (size_t)16 * 128 * 128 / 8, bid, nb);
    cvt_bf16_stream(p.pu, (bf16_t*)(p.ws + OFF_UT), (size_t)NEXP * DM / 8, bid, nb);
    cvt_bf16_stream(p.pv, (bf16_t*)(p.ws + OFF_VT), (size_t)NEXP * DM / 8, bid, nb);
}

DI void phase_h(const Params& p, int bid, int nb) {
    const float* mod = (const float*)(p.ws + OFF_MOD);
    bf16_t* H = (bf16_t*)(p.ws + OFF_H);
    const size_t n8 = (size_t)NTOK * DM / 8;
    for (size_t i = (size_t)bid * NTH + threadIdx.x; i < n8; i += (size_t)nb * NTH) {
        const int row = (int)(i >> 7), c0 = (int)(i & 127) * 8, b = row / SEQ;
        const float* sh = mod + b * 6144 + c0;
        const float* sc = sh + 1024;
        const float4 a = *(const float4*)(p.x + i * 8), bq = *(const float4*)(p.x + i * 8 + 4);
        const float4 s0 = *(const float4*)sc, s1 = *(const float4*)(sc + 4), h0 = *(const float4*)sh, h1 = *(const float4*)(sh + 4);
        uint4 o;
        o.x = pack2(a.x * (1.f + s0.x) + h0.x, a.y * (1.f + s0.y) + h0.y);
        o.y = pack2(a.z * (1.f + s0.z) + h0.z, a.w * (1.f + s0.w) + h0.w);
        o.z = pack2(bq.x * (1.f + s1.x) + h1.x, bq.y * (1.f + s1.y) + h1.y);
        o.w = pack2(bq.z * (1.f + s1.z) + h1.z, bq.w * (1.f + s1.w) + h1.w);
        *(uint4*)(H + i * 8) = o;
    }
}

DI void phase_proj(const Params& p, int bid, int nb, char* smem) {
    const bf16_t* H = (const bf16_t*)(p.ws + OFF_H);
    const bf16_t* W = (const bf16_t*)(p.ws + OFF_WIN);
    bf16_t* P = (bf16_t*)(p.ws + OFF_PROJ);
    constexpr int NTN = INC / 128, NTM = NTOK / 128;
    for (int t = bid; t < NTM * NTN; t += nb) {
        const int mt = t / NTN, nt = t % NTN;
        bf16_t* Pt = P + (size_t)mt * 128 * INC + nt * 128;
        const bool act = (nt < 4) || (nt >= 12 && nt < 16);
        gemm_block<2, 1, 2, 4>(H + (size_t)mt * 128 * DM, DM, W + (size_t)nt * 128 * DM, DM, DM, smem,
                               [&](int r, int c, float v) { Pt[(size_t)r * INC + c] = f2bf(act ? siluf_(v) : v); });
        __syncthreads();
    }
}

DI void hgrn_item(const Params& p, int item, char* smem) {
    const int vs = item & 7, hd = (item >> 3) & 3, b = item >> 5;
    const bf16_t* P = (const bf16_t*)(p.ws + OFF_PROJ);
    const float* lb = (const float*)(p.ws + OFF_LB) + hd * HDK;
    float* ORAW = (float*)(p.ws + OFF_ORAW);
    float* sq = (float*)smem;
    float* sf = sq + 32 * 128;
    float* sv = sf + 32 * 128;
    float* sp = sv + 32 * 16;
    const int tid = threadIdx.x, lane = tid & 63, wid = tid >> 6, kq = tid >> 4, v = tid & 15;
    float S0 = 0.f, S1 = 0.f, S2 = 0.f, S3 = 0.f;
    for (int t0 = 0; t0 < SEQ; t0 += 32) {
        for (int i = tid; i < 32 * 128; i += NTH) {
            const int t = i >> 7, k = i & 127;
            const bf16_t* row = P + (size_t)(b * SEQ + t0 + t) * INC + hd * HDK + k;
            sq[i] = bf2f(row[0]);
            const float l = lb[k];
            sf[i] = l + (1.0f - l) * sigmoidf_(bf2f(row[512]));
        }
        { const int t = tid >> 4; sv[tid] = bf2f(P[(size_t)(b * SEQ + t0 + t) * INC + 1024 + hd * HDK + vs * 16 + v]); }
        __syncthreads();
        for (int t = 0; t < 32; ++t) {
            const float4 f4 = *(const float4*)(sf + t * 128 + kq * 4), q4 = *(const float4*)(sq + t * 128 + kq * 4);
            const float vv = sv[t * 16 + v];
            S0 = f4.x * S0 + (1.0f - f4.x) * vv; S1 = f4.y * S1 + (1.0f - f4.y) * vv;
            S2 = f4.z * S2 + (1.0f - f4.z) * vv; S3 = f4.w * S3 + (1.0f - f4.w) * vv;
            float part = q4.x * S0 + q4.y * S1 + q4.z * S2 + q4.w * S3;
            part += __shfl_xor(part, 16); part += __shfl_xor(part, 32);
            if (lane < 16) sp[(t * 8 + wid) * 16 + v] = part;
        }
        __syncthreads();
        {
            const int t = tid >> 4;
            float o = 0.f;
#pragma unroll
            for (int w = 0; w < 8; ++w) o += sp[(t * 8 + w) * 16 + v];
            ORAW[(size_t)(b * SEQ + t0 + t) * DHG + hd * HDK + vs * 16 + v] = o;
        }
        __syncthreads();
    }
}
DI void s5_item(const Params& p, int item, char* smem) {
    const int oct = item & 3, b = item >> 2;
    const int tid = threadIdx.x, lane = tid & 63, wid = tid >> 6, g = oct * 8 + wid;
    const bf16_t* P = (const bf16_t*)(p.ws + OFF_PROJ);
    bf16_t* Y = (bf16_t*)(p.ws + OFF_YSSM);
    float* su = (float*)smem + wid * 64 * 16;
    const float* lam = (const float*)(p.ws + OFF_LAM) + (g * SSP + lane) * 2;
    const float lr = lam[0], li = lam[1];
    const float* bb = (const float*)(p.ws + OFF_BB) + (size_t)(g * SSP + lane) * 32;
    float bbr[16], bbi[16], cr[16], ci[16];
#pragma unroll
    for (int i = 0; i < 16; ++i) { bbr[i] = bb[2 * i]; bbi[i] = bb[2 * i + 1]; cr[i] = p.c_re[(g * SSC + i) * SSP + lane]; ci[i] = p.c_im[(g * SSC + i) * SSP + lane]; }
    const int ch = (lane >> 2) & 15;
    const float dch = p.dsk[g * SSC + ch];
    float xr = 0.f, xi = 0.f;
    for (int t0 = 0; t0 < SEQ; t0 += 64) {
        {
            const uint4* src = (const uint4*)(P + (size_t)(b * SEQ + t0 + lane) * INC + 2048 + g * SSC);
            const uint4 a = src[0], c = src[1];
            float* d = su + lane * 16;
            d[0] = bflo(a.x); d[1] = bfhi(a.x); d[2] = bflo(a.y); d[3] = bfhi(a.y); d[4] = bflo(a.z); d[5] = bfhi(a.z); d[6] = bflo(a.w); d[7] = bfhi(a.w);
            d[8] = bflo(c.x); d[9] = bfhi(c.x); d[10] = bflo(c.y); d[11] = bfhi(c.y); d[12] = bflo(c.z); d[13] = bfhi(c.z); d[14] = bflo(c.w); d[15] = bfhi(c.w);
        }
        __syncthreads();
        for (int t = 0; t < 64; ++t) {
            float u[16];
            const float4* us = (const float4*)(su + t * 16);
            const float4 u0 = us[0], u1 = us[1], u2 = us[2], u3 = us[3];
            u[0] = u0.x; u[1] = u0.y; u[2] = u0.z; u[3] = u0.w; u[4] = u1.x; u[5] = u1.y; u[6] = u1.z; u[7] = u1.w;
            u[8] = u2.x; u[9] = u2.y; u[10] = u2.z; u[11] = u2.w; u[12] = u3.x; u[13] = u3.y; u[14] = u3.z; u[15] = u3.w;
            float bur = 0.f, bui = 0.f;
#pragma unroll
            for (int i = 0; i < 16; ++i) { bur += bbr[i] * u[i]; bui += bbi[i] * u[i]; }
            const float nxr = lr * xr - li * xi + bur, nxi = lr * xi + li * xr + bui;
            xr = nxr; xi = nxi;
            float y[16];
#pragma unroll
            for (int i = 0; i < 16; ++i) y[i] = cr[i] * xr - ci[i] * xi;
            const bool b5 = lane & 32, b4 = lane & 16, b3 = lane & 8, b2 = lane & 4;
            float y8[8], y4[4], y2[2];
#pragma unroll
            for (int j = 0; j < 8; ++j) { const float keep = b5 ? y[8 + j] : y[j], send = b5 ? y[j] : y[8 + j]; y8[j] = keep + __shfl_xor(send, 32); }
#pragma unroll
            for (int j = 0; j < 4; ++j) { const float keep = b4 ? y8[4 + j] : y8[j], send = b4 ? y8[j] : y8[4 + j]; y4[j] = keep + __shfl_xor(send, 16); }
#pragma unroll
            for (int j = 0; j < 2; ++j) { const float keep = b3 ? y4[2 + j] : y4[j], send = b3 ? y4[j] : y4[2 + j]; y2[j] = keep + __shfl_xor(send, 8); }
            float y1;
            { const float keep = b2 ? y2[1] : y2[0], send = b2 ? y2[0] : y2[1]; y1 = keep + __shfl_xor(send, 4); }
            y1 += __shfl_xor(y1, 1); y1 += __shfl_xor(y1, 2);
            if ((lane & 3) == 0) {
                const float uu = su[t * 16 + ch];
                Y[(size_t)(b * SEQ + t0 + t) * DSS + g * SSC + ch] = f2bf(geluf_(y1 + dch * uu));
            }
        }
        __syncthreads();
    }
}
DI void phase_mix(const Params& p, int bid, int nb, char* smem) {
    for (int it = bid; it < 512 + 64; it += nb) {
        if (it < 512) hgrn_item(p, it, smem); else s5_item(p, it - 512, smem);
        __syncthreads();
    }
}

DI void phase_glu(const Params& p, int bid, int nb, char* smem) {
    const bf16_t* Y = (const bf16_t*)(p.ws + OFF_YSSM);
    const bf16_t* W = (const bf16_t*)(p.ws + OFF_GLU);
    float* Y2 = (float*)(p.ws + OFF_H);
    constexpr int NTN = 4, NTM = NTOK / 128;
    for (int t = bid; t < NTM * NTN; t += nb) {
        const int mt = t / NTN, nt = t % NTN;
        const bf16_t* Yt = Y + (size_t)mt * 128 * DSS + nt * 128;
        float* Ot = Y2 + (size_t)mt * 128 * DSS + nt * 128;
        const float* gb = p.glu_b + nt * 128;
        gemm_block<2, 1, 2, 4>(Y + (size_t)mt * 128 * DSS, DSS, W + (size_t)nt * 128 * 512, 512, 512, smem,
                               [&](int r, int c, float v) { const float y = bf2f(Yt[(size_t)r * DSS + c]); Ot[(size_t)r * DSS + c] = y * sigmoidf_(v + gb[c]); });
        __syncthreads();
    }
}
DI void phase_a2(const Params& p, int bid, int nb) {
    const float* ORAW = (const float*)(p.ws + OFF_ORAW);
    const float* Y2 = (const float*)(p.ws + OFF_H);
    const bf16_t* P = (const bf16_t*)(p.ws + OFF_PROJ);
    bf16_t* A2 = (bf16_t*)(p.ws + OFF_A2);
    const int lane = threadIdx.x & 63, wid = threadIdx.x >> 6;
    for (int tok = bid * 8 + wid; tok < NTOK; tok += nb * 8) {
        const int c0 = lane * 8;
        {
            const float4 a = *(const float4*)(ORAW + (size_t)tok * DHG + c0), b = *(const float4*)(ORAW + (size_t)tok * DHG + c0 + 4);
            float ss = a.x * a.x + a.y * a.y + a.z * a.z + a.w * a.w + b.x * b.x + b.y * b.y + b.z * b.z + b.w * b.w;
            ss += __shfl_xor(ss, 1); ss += __shfl_xor(ss, 2); ss += __shfl_xor(ss, 4); ss += __shfl_xor(ss, 8);
            const float rs = rsqrtf(ss * (1.0f / 128.0f) + RMS_EPS);
            const uint4 gq = *(const uint4*)(P + (size_t)tok * INC + 1536 + c0);
            const float4 w0 = *(const float4*)(p.hg_nw + c0), w1 = *(const float4*)(p.hg_nw + c0 + 4);
            uint4 o;
            o.x = pack2(a.x * rs * w0.x * bflo(gq.x), a.y * rs * w0.y * bfhi(gq.x));
            o.y = pack2(a.z * rs * w0.z * bflo(gq.y), a.w * rs * w0.w * bfhi(gq.y));
            o.z = pack2(b.x * rs * w1.x * bflo(gq.z), b.y * rs * w1.y * bfhi(gq.z));
            o.w = pack2(b.z * rs * w1.z * bflo(gq.w), b.w * rs * w1.w * bfhi(gq.w));
            *(uint4*)(A2 + (size_t)tok * DM + c0) = o;
        }
        {
            const float4 a = *(const float4*)(Y2 + (size_t)tok * DSS + c0), b = *(const float4*)(Y2 + (size_t)tok * DSS + c0 + 4);
            float ss = a.x * a.x + a.y * a.y + a.z * a.z + a.w * a.w + b.x * b.x + b.y * b.y + b.z * b.z + b.w * b.w;
#pragma unroll
            for (int m = 1; m < 64; m <<= 1) ss += __shfl_xor(ss, m);
            const float rs = rsqrtf(ss * (1.0f / 512.0f) + RMS_EPS);
            const float4 w0 = *(const float4*)(p.ssm_nw + c0), w1 = *(const float4*)(p.ssm_nw + c0 + 4);
            uint4 o;
            o.x = pack2(a.x * rs * w0.x, a.y * rs * w0.y); o.y = pack2(a.z * rs * w0.z, a.w * rs * w0.w);
            o.z = pack2(b.x * rs * w1.x, b.y * rs * w1.y); o.w = pack2(b.z * rs * w1.z, b.w * rs * w1.w);
            *(uint4*)(A2 + (size_t)tok * DM + 512 + c0) = o;
        }
    }
}

DI void phase_outproj(const Params& p, int bid, int nb, char* smem) {
    const bf16_t* A2 = (const bf16_t*)(p.ws + OFF_A2);
    const bf16_t* W = (const bf16_t*)(p.ws + OFF_WOUT);
    const float* mod = (const float*)(p.ws + OFF_MOD);
    constexpr int NTN = 8, NTM = NTOK / 128;
    for (int t = bid; t < NTM * NTN; t += nb) {
        const int mt = t / NTN, nt = t % NTN, b = (mt * 128) / SEQ;
        const float* xt = p.x + (size_t)mt * 128 * DM + nt * 128;
        float* ot = p.out + (size_t)mt * 128 * DM + nt * 128;
        const float* g1 = mod + b * 6144 + 2048 + nt * 128;
        gemm_block<2, 1, 2, 4>(A2 + (size_t)mt * 128 * DM, DM, W + (size_t)nt * 128 * DM, DM, DM, smem,
                               [&](int r, int c, float v) { ot[(size_t)r * DM + c] = DEEP_ALPHA * xt[(size_t)r * DM + c] + (1.0f + g1[c]) * v; });
        __syncthreads();
    }
}
DI void phase_ln1(const Params& p, int bid, int nb) {
    const float* mod = (const float*)(p.ws + OFF_MOD);
    bf16_t* H2 = (bf16_t*)(p.ws + OFF_H);
    const int lane = threadIdx.x & 63, wid = threadIdx.x >> 6;
    for (int tok = bid * 8 + wid; tok < NTOK; tok += nb * 8) {
        const int b = tok / SEQ;
        float* row = p.out + (size_t)tok * DM;
        float4 v[4];
        float s = 0.f;
#pragma unroll
        for (int j = 0; j < 4; ++j) { v[j] = *(const float4*)(row + j * 256 + lane * 4); s += v[j].x + v[j].y + v[j].z + v[j].w; }
#pragma unroll
        for (int m = 1; m < 64; m <<= 1) s += __shfl_xor(s, m);
        const float mu = s * (1.0f / 1024.0f);
        float q = 0.f;
#pragma unroll
        for (int j = 0; j < 4; ++j) { const float a = v[j].x - mu, bb = v[j].y - mu, cc = v[j].z - mu, d = v[j].w - mu; q += a * a + bb * bb + cc * cc + d * d; }
#pragma unroll
        for (int m = 1; m < 64; m <<= 1) q += __shfl_xor(q, m);
        const float rstd = rsqrtf(q * (1.0f / 1024.0f) + LN_EPS);
        const float* sh2 = mod + b * 6144 + 3072;
        const float* sc2 = mod + b * 6144 + 4096;
#pragma unroll
        for (int j = 0; j < 4; ++j) {
            const int c = j * 256 + lane * 4;
            const float4 w = *(const float4*)(p.ln1w + c), bi = *(const float4*)(p.ln1b + c), sc = *(const float4*)(sc2 + c), sh = *(const float4*)(sh2 + c);
            float4 o;
            o.x = (v[j].x - mu) * rstd * w.x + bi.x; o.y = (v[j].y - mu) * rstd * w.y + bi.y; o.z = (v[j].z - mu) * rstd * w.z + bi.z; o.w = (v[j].w - mu) * rstd * w.w + bi.w;
            *(float4*)(row + c) = o;
            uint2 hh; hh.x = pack2(o.x * (1.f + sc.x) + sh.x, o.y * (1.f + sc.y) + sh.y); hh.y = pack2(o.z * (1.f + sc.z) + sh.z, o.w * (1.f + sc.w) + sh.w);
            *(uint2*)(H2 + (size_t)tok * DM + c) = hh;
        }
    }
}

DI void phase_q(const Params& p, int bid, int nb, char* smem) {
    const bf16_t* H2 = (const bf16_t*)(p.ws + OFF_H);
    const bf16_t* W = (const bf16_t*)(p.ws + OFF_WQ);
    bf16_t* Q = (bf16_t*)(p.ws + OFF_PROJ);
    constexpr int NTN = 16, NTM = NTOK / 128;
    for (int t = bid; t < NTM * NTN; t += nb) {
        const int mt = t / NTN, nt = t % NTN;
        bf16_t* Qt = Q + (size_t)mt * 128 * 2048 + nt * 128;
        gemm_block<2, 1, 2, 4>(H2 + (size_t)mt * 128 * DM, DM, W + (size_t)nt * 128 * DM, DM, DM, smem,
                               [&](int r, int c, float v) { Qt[(size_t)r * 2048 + c] = f2bf(v); });
        __syncthreads();
    }
}
DI void phase_topk(const Params& p, int bid, int nb, char* smem) {
    const bf16_t* Q = (const bf16_t*)(p.ws + OFF_PROJ);
    const bf16_t* SK = (const bf16_t*)(p.ws + OFF_SUBK);
    unsigned* TOPL = (unsigned*)(p.ws + OFF_TOPL);
    float* sc = (float*)(smem + 36864);
    constexpr int NTM = NTOK / 128;
    for (int t = bid; t < NTM * 16; t += nb) {
        const int mt = t >> 4, hp = t & 15;
        gemm_block<2, 1, 2, 4>(Q + (size_t)mt * 128 * 2048 + hp * 128, 2048, SK + (size_t)hp * 128 * 128, 128, 128, smem,
                               [&](int r, int c, float v) { sc[r * 129 + c] = v; });
        __syncthreads();
        if (threadIdx.x < 128) {
            const int r = threadIdx.x;
            float tk[16];
#pragma unroll
            for (int j = 0; j < 16; ++j) tk[j] = -3.0e38f;
            for (int n = 0; n < 128; ++n) {
                float xv = __uint_as_float((__float_as_uint(sc[r * 129 + n]) & ~0x7fu) | (unsigned)n);
#pragma unroll
                for (int j = 0; j < 16; ++j) { const float hi = fmaxf(tk[j], xv), lo = fminf(tk[j], xv); tk[j] = hi; xv = lo; }
            }
            uint4* dst = (uint4*)(TOPL + ((size_t)(mt * 128 + r) * 16 + hp) * 16);
            dst[0] = make_uint4(__float_as_uint(tk[0]), __float_as_uint(tk[1]), __float_as_uint(tk[2]), __float_as_uint(tk[3]));
            dst[1] = make_uint4(__float_as_uint(tk[4]), __float_as_uint(tk[5]), __float_as_uint(tk[6]), __float_as_uint(tk[7]));
            dst[2] = make_uint4(__float_as_uint(tk[8]), __float_as_uint(tk[9]), __float_as_uint(tk[10]), __float_as_uint(tk[11]));
            dst[3] = make_uint4(__float_as_uint(tk[12]), __float_as_uint(tk[13]), __float_as_uint(tk[14]), __float_as_uint(tk[15]));
        }
        __syncthreads();
    }
}
DI void phase_combine(const Params& p, int bid, int nb) {
    const unsigned* TOPL = (const unsigned*)(p.ws + OFF_TOPL);
    uint2* EX = (uint2*)(p.ws + OFF_EXPS);
    for (int i = bid * NTH + threadIdx.x; i < NTOK * PHEADS; i += nb * NTH) {
        const unsigned* l1 = TOPL + (size_t)i * 32;
        const unsigned* l2 = l1 + 16;
        float s2[16];
        {
            const uint4 a = ((const uint4*)l2)[0], b = ((const uint4*)l2)[1], c = ((const uint4*)l2)[2], d = ((const uint4*)l2)[3];
            const unsigned w[16] = {a.x, a.y, a.z, a.w, b.x, b.y, b.z, b.w, c.x, c.y, c.z, c.w, d.x, d.y, d.z, d.w};
#pragma unroll
            for (int j = 0; j < 16; ++j) s2[j] = __uint_as_float(w[j] & ~0x7fu);
        }
        float tk[16];
#pragma unroll
        for (int j = 0; j < 16; ++j) tk[j] = -3.0e38f;
        for (int a = 0; a < 16; ++a) {
            const float s1 = __uint_as_float(l1[a] & ~0x7fu);
#pragma unroll
            for (int b = 0; b < 16; ++b) {
                float xv = __uint_as_float((__float_as_uint(s1 + s2[b]) & ~0xffu) | (unsigned)(a * 16 + b));
#pragma unroll
                for (int j = 0; j < 16; ++j) { const float hi = fmaxf(tk[j], xv), lo = fminf(tk[j], xv); tk[j] = hi; xv = lo; }
            }
        }
        float e[16], sum = 0.f;
        const float mx = __uint_as_float(__float_as_uint(tk[0]) & ~0xffu);
#pragma unroll
        for (int j = 0; j < 16; ++j) { e[j] = __expf(__uint_as_float(__float_as_uint(tk[j]) & ~0xffu) - mx); sum += e[j]; }
        const float inv = 1.0f / sum;
#pragma unroll
        for (int j = 0; j < 16; ++j) {
            const unsigned ab = __float_as_uint(tk[j]) & 0xffu;
            const unsigned i1 = l1[ab >> 4] & 0x7fu, i2 = l2[ab & 15] & 0x7fu;
            EX[(size_t)i * 16 + j] = make_uint2(i1 * 128u + i2, __float_as_uint(e[j] * inv));
        }
    }
}

DI void phase_gather(const Params& p, int bid, int nb) {
    const float* mod = (const float*)(p.ws + OFF_MOD);
    const uint2* EX = (const uint2*)(p.ws + OFF_EXPS);
    const bf16_t* UT = (const bf16_t*)(p.ws + OFF_UT);
    const bf16_t* VT = (const bf16_t*)(p.ws + OFF_VT);
    const int lane = threadIdx.x & 63, wid = threadIdx.x >> 6;
    for (int tok = bid * 8 + wid; tok < NTOK; tok += nb * 8) {
        const int b = tok / SEQ;
        float* row = p.out + (size_t)tok * DM;
        const float* sh2 = mod + b * 6144 + 3072;
        const float* sc2 = mod + b * 6144 + 4096;
        const float* g2 = mod + b * 6144 + 5120;
        float x1[16], h2[16], acc[16];
#pragma unroll
        for (int j = 0; j < 2; ++j)
#pragma unroll
            for (int q = 0; q < 2; ++q) {
                const int c = j * 512 + lane * 8 + q * 4;
                const float4 xv = *(const float4*)(row + c), sc = *(const float4*)(sc2 + c), sh = *(const float4*)(sh2 + c);
                const int o = j * 8 + q * 4;
                x1[o] = xv.x; x1[o + 1] = xv.y; x1[o + 2] = xv.z; x1[o + 3] = xv.w;
                h2[o] = xv.x * (1.f + sc.x) + sh.x; h2[o + 1] = xv.y * (1.f + sc.y) + sh.y;
                h2[o + 2] = xv.z * (1.f + sc.z) + sh.z; h2[o + 3] = xv.w * (1.f + sc.w) + sh.w;
            }
#pragma unroll
        for (int i = 0; i < 16; ++i) acc[i] = 0.f;
        const uint2 e0 = EX[(size_t)tok * 128 + lane], e1 = EX[(size_t)tok * 128 + 64 + lane];
        for (int e = 0; e < 128; ++e) {
            const unsigned src = (e < 64) ? e0.x : e1.x, gsrc = (e < 64) ? e0.y : e1.y;
            const unsigned eid = __builtin_amdgcn_readlane(src, e & 63);
            const float gate = __uint_as_float(__builtin_amdgcn_readlane(gsrc, e & 63));
            const uint4 ua = *(const uint4*)(UT + (size_t)eid * DM + lane * 8), ub = *(const uint4*)(UT + (size_t)eid * DM + 512 + lane * 8);
            const uint4 va = *(const uint4*)(VT + (size_t)eid * DM + lane * 8), vb = *(const uint4*)(VT + (size_t)eid * DM + 512 + lane * 8);
            float z = bflo(ua.x) * h2[0] + bfhi(ua.x) * h2[1] + bflo(ua.y) * h2[2] + bfhi(ua.y) * h2[3] + bflo(ua.z) * h2[4] + bfhi(ua.z) * h2[5] + bflo(ua.w) * h2[6] + bfhi(ua.w) * h2[7]
                    + bflo(ub.x) * h2[8] + bfhi(ub.x) * h2[9] + bflo(ub.y) * h2[10] + bfhi(ub.y) * h2[11] + bflo(ub.z) * h2[12] + bfhi(ub.z) * h2[13] + bflo(ub.w) * h2[14] + bfhi(ub.w) * h2[15];
#pragma unroll
            for (int m = 1; m < 64; m <<= 1) z += __shfl_xor(z, m);
            const float a = geluf_(z) * gate;
            acc[0] += a * bflo(va.x); acc[1] += a * bfhi(va.x); acc[2] += a * bflo(va.y); acc[3] += a * bfhi(va.y);
            acc[4] += a * bflo(va.z); acc[5] += a * bfhi(va.z); acc[6] += a * bflo(va.w); acc[7] += a * bfhi(va.w);
            acc[8] += a * bflo(vb.x); acc[9] += a * bfhi(vb.x); acc[10] += a * bflo(vb.y); acc[11] += a * bfhi(vb.y);
            acc[12] += a * bflo(vb.z); acc[13] += a * bfhi(vb.z); acc[14] += a * bflo(vb.w); acc[15] += a * bfhi(vb.w);
        }
        float r[16], s = 0.f;
#pragma unroll
        for (int j = 0; j < 2; ++j)
#pragma unroll
            for (int q = 0; q < 2; ++q) {
                const int c = j * 512 + lane * 8 + q * 4;
                const float4 gg = *(const float4*)(g2 + c);
                const int o = j * 8 + q * 4;
                r[o] = DEEP_ALPHA * x1[o] + (1.f + gg.x) * acc[o]; r[o + 1] = DEEP_ALPHA * x1[o + 1] + (1.f + gg.y) * acc[o + 1];
                r[o + 2] = DEEP_ALPHA * x1[o + 2] + (1.f + gg.z) * acc[o + 2]; r[o + 3] = DEEP_ALPHA * x1[o + 3] + (1.f + gg.w) * acc[o + 3];
            }
#pragma unroll
        for (int i = 0; i < 16; ++i) s += r[i];
#pragma unroll
        for (int m = 1; m < 64; m <<= 1) s += __shfl_xor(s, m);
        const float mu = s * (1.0f / 1024.0f);
        float qq = 0.f;
#pragma unroll
        for (int i = 0; i < 16; ++i) { const float d = r[i] - mu; qq += d * d; }
#pragma unroll
        for (int m = 1; m < 64; m <<= 1) qq += __shfl_xor(qq, m);
        const float rstd = rsqrtf(qq * (1.0f / 1024.0f) + LN_EPS);
#pragma unroll
        for (int j = 0; j < 2; ++j)
#pragma unroll
            for (int q = 0; q < 2; ++q) {
                const int c = j * 512 + lane * 8 + q * 4, o = j * 8 + q * 4;
                const float4 w = *(const float4*)(p.ln2w + c), bi = *(const float4*)(p.ln2b + c);
                float4 ov;
                ov.x = (r[o] - mu) * rstd * w.x + bi.x; ov.y = (r[o + 1] - mu) * rstd * w.y + bi.y; ov.z = (r[o + 2] - mu) * rstd * w.z + bi.z; ov.w = (r[o + 3] - mu) * rstd * w.w + bi.w;
                *(float4*)(row + c) = ov;
            }
    }
}

__global__ void __launch_bounds__(NTH) k_mega(Params p) {
    __shared__ __attribute__((aligned(16))) char smem[SMEM_BYTES];
    cg::grid_group grid = cg::this_grid();
    const int bid = blockIdx.x, nb = gridDim.x;
    phase_prep(p, bid, nb, smem);    grid.sync();
    phase_h(p, bid, nb);             grid.sync();
    phase_proj(p, bid, nb, smem);    grid.sync();
    phase_mix(p, bid, nb, smem);     grid.sync();
    phase_glu(p, bid, nb, smem);     grid.sync();
    phase_a2(p, bid, nb);            grid.sync();
    phase_outproj(p, bid, nb, smem); grid.sync();
    phase_ln1(p, bid, nb);           grid.sync();
    phase_q(p, bid, nb, smem);       grid.sync();
    phase_topk(p, bid, nb, smem);    grid.sync();
    phase_combine(p, bid, nb);       grid.sync();
    phase_gather(p, bid, nb);
}

extern "C" void kernel_launch(void* const* d_in, const int* in_sizes, int n_in, void* d_out, int out_size, void* d_ws, size_t ws_size, hipStream_t stream) {
    if (n_in != 27 || ws_size < WS_END) { fprintf(stderr, "kernel_launch: unexpected n_in %d or ws_size %zu (< %zu)\n", n_in, ws_size, (size_t)WS_END); return; }
    static int grid_blocks = 0;
    if (!grid_blocks) {
        int dev = 0, cus = 0, per_cu = 0;
        (void)hipGetDevice(&dev);
        (void)hipDeviceGetAttribute(&cus, hipDeviceAttributeMultiprocessorCount, dev);
        (void)hipOccupancyMaxActiveBlocksPerMultiprocessor(&per_cu, k_mega, NTH, 0);
        if (cus <= 0) cus = 256;
        if (per_cu < 1) { fprintf(stderr, "kernel_launch: occupancy query says %d blocks/CU\n", per_cu); per_cu = 1; }
        grid_blocks = cus;
    }
    Params p{};
    const float** f = (const float**)&p;
    for (int i = 0; i < 27; ++i) f[i] = (const float*)d_in[i];
    p.out = (float*)d_out; p.ws = (char*)d_ws;
    void* args[] = {&p};
    hipError_t e = hipLaunchCooperativeKernel((void*)k_mega, dim3(grid_blocks), dim3(NTH), args, 0, stream);
    if (e != hipSuccess) fprintf(stderr, "cooperative launch failed: %s (grid %d)\n", hipGetErrorString(e), grid_blocks);
}
```

```cpp
#include <hip/hip_runtime.h>
#include <hip/hip_cooperative_groups.h>
#include <stdint.h>
#include <stdio.h>

namespace cg = cooperative_groups;
#define DI __device__ __forceinline__
typedef unsigned short bf16_t;
typedef short bf16x8 __attribute__((ext_vector_type(8)));
typedef float f32x16 __attribute__((ext_vector_type(16)));
typedef unsigned u32x4 __attribute__((ext_vector_type(4)));
typedef float f32x4 __attribute__((ext_vector_type(4)));
typedef float f32x2 __attribute__((ext_vector_type(2)));

constexpr int NTH = 512;
constexpr int NB = 16, SEQ = 2048, DM = 1024, NTOK = NB * SEQ;
constexpr int DHG = 512, HGH = 4, HDK = 128;
constexpr int DSS = 512, SSG = 32, SSC = 16, SSP = 64;
constexpr int INC = 2560;
constexpr int PHEADS = 8, NKEYS = 128, TOPK = 16, NEXP = 16384;
constexpr float DEEP_ALPHA = 1.189207115002721f;
constexpr float LN_EPS = 1e-5f, RMS_EPS = 1e-6f;
constexpr int SMEM_BYTES = 104 * 1024;

constexpr size_t al256(size_t x) { return (x + 255) & ~(size_t)255; }
constexpr size_t OFF_MOD = 0;
constexpr size_t OFF_LB = al256(OFF_MOD + (size_t)NB * 6144 * 4);
constexpr size_t OFF_LAM = al256(OFF_LB + 512 * 4);
constexpr size_t OFF_BB = al256(OFF_LAM + 32 * 64 * 2 * 4);
constexpr size_t OFF_WIN = al256(OFF_BB + 32 * 64 * 16 * 2 * 4);
constexpr size_t OFF_GLU = al256(OFF_WIN + (size_t)INC * DM * 2);
constexpr size_t OFF_WOUT = al256(OFF_GLU + (size_t)512 * 512 * 2);
constexpr size_t OFF_WQ = al256(OFF_WOUT + (size_t)DM * DM * 2);
constexpr size_t OFF_SUBK = al256(OFF_WQ + (size_t)2048 * DM * 2);
constexpr size_t OFF_SU = al256(OFF_SUBK + (size_t)16 * 128 * 128 * 2);
constexpr size_t OFF_SV = al256(OFF_SU + (size_t)NEXP * 4);
constexpr size_t OFF_UT = al256(OFF_SV + (size_t)NEXP * 4);
constexpr size_t OFF_VT = al256(OFF_UT + (size_t)NEXP * DM * 2);
constexpr size_t OFF_H = al256(OFF_VT + (size_t)NEXP * DM * 2);
constexpr size_t OFF_PROJ = al256(OFF_H + (size_t)NTOK * DM * 2);
constexpr size_t OFF_ORAW = al256(OFF_PROJ + (size_t)NTOK * INC * 2);
constexpr size_t OFF_YSSM = al256(OFF_ORAW + (size_t)NTOK * DHG * 4);
constexpr size_t OFF_A2 = al256(OFF_YSSM + (size_t)NTOK * DSS * 2);
constexpr size_t WS_END = al256(OFF_A2 + (size_t)NTOK * DM * 2);
constexpr size_t OFF_TOPL = OFF_ORAW;
constexpr size_t OFF_EXPS = OFF_ORAW + (size_t)NTOK * 16 * 16 * 4;

struct Params {
    const float *x, *c, *ada_w, *ada_b, *w_in, *hg_lb, *hg_nw, *a_re, *a_im, *log_dt, *b_re, *b_im, *c_re, *c_im, *dsk,
        *glu_w, *glu_b, *ssm_nw, *w_out, *ln1w, *ln1b, *w_q, *subk, *pu, *pv, *ln2w, *ln2b;
    float* out;
    char* ws;
};

DI bf16_t f2bf(float x) { unsigned u = __float_as_uint(x); u += 0x7fffu + ((u >> 16) & 1u); return (bf16_t)(u >> 16); }
DI float bf2f(bf16_t b) { return __uint_as_float(((unsigned)b) << 16); }
DI float bflo(unsigned w) { return __uint_as_float(w << 16); }
DI float bfhi(unsigned w) { return __uint_as_float(w & 0xffff0000u); }
DI unsigned pack2(float a, float b) { return (unsigned)f2bf(a) | ((unsigned)f2bf(b) << 16); }
DI float sigmoidf_(float x) { return 1.0f / (1.0f + __expf(-x)); }
DI float siluf_(float x) { return x * sigmoidf_(x); }
DI float geluf_(float x) { return 0.5f * x * (1.0f + erff(x * 0.70710678118654752f)); }

template <int MT, int NT_, int WM, int WN, class Epi>
DI void gemm_block(const bf16_t* __restrict__ A, int lda, const bf16_t* __restrict__ Bt, int ldb, int K, char* smem, Epi epi) {
    constexpr int BM = WM * MT * 32, BN = WN * NT_ * 32, LS = 72;
    static_assert(WM * WN == 8, "8 waves");
    bf16_t* As = (bf16_t*)smem;
    bf16_t* Bs = As + BM * LS;
    const int tid = threadIdx.x, lane = tid & 63, wid = tid >> 6, r = lane & 31, h = lane >> 5;
    const int wm = wid / WN, wn = wid % WN;
    constexpr int PA = BM * 8 / NTH, PB = BN * 8 / NTH;
    u32x4 ra[PA], rb[PB];
    f32x16 acc[MT][NT_];
#pragma unroll
    for (int mi = 0; mi < MT; ++mi)
#pragma unroll
        for (int ni = 0; ni < NT_; ++ni)
#pragma unroll
            for (int i = 0; i < 16; ++i) acc[mi][ni][i] = 0.f;
#define GEMM_GLOAD(kt_) { \
    _Pragma("unroll") for (int q = 0; q < PA; ++q) { const int idx = tid + q * NTH, row = idx >> 3, ch = idx & 7; ra[q] = *(const u32x4*)(A + (size_t)row * lda + (kt_) * 64 + ch * 8); } \
    _Pragma("unroll") for (int q = 0; q < PB; ++q) { const int idx = tid + q * NTH, row = idx >> 3, ch = idx & 7; rb[q] = *(const u32x4*)(Bt + (size_t)row * ldb + (kt_) * 64 + ch * 8); } }
#define GEMM_LSTORE() { \
    _Pragma("unroll") for (int q = 0; q < PA; ++q) { const int idx = tid + q * NTH, row = idx >> 3, ch = idx & 7; *(u32x4*)(As + row * LS + ch * 8) = ra[q]; } \
    _Pragma("unroll") for (int q = 0; q < PB; ++q) { const int idx = tid + q * NTH, row = idx >> 3, ch = idx & 7; *(u32x4*)(Bs + row * LS + ch * 8) = rb[q]; } }
    GEMM_GLOAD(0); GEMM_LSTORE(); __syncthreads();
    const int nk = K / 64;
    for (int kt = 0; kt < nk; ++kt) {
        if (kt + 1 < nk) GEMM_GLOAD(kt + 1);
#pragma unroll
        for (int ks = 0; ks < 4; ++ks) {
            bf16x8 a[MT], b[NT_];
#pragma unroll
            for (int mi = 0; mi < MT; ++mi) a[mi] = *(const bf16x8*)(As + (wm * MT * 32 + mi * 32 + r) * LS + ks * 16 + h * 8);
#pragma unroll
            for (int ni = 0; ni < NT_; ++ni) b[ni] = *(const bf16x8*)(Bs + (wn * NT_ * 32 + ni * 32 + r) * LS + ks * 16 + h * 8);
#pragma unroll
            for (int mi = 0; mi < MT; ++mi)
#pragma unroll
                for (int ni = 0; ni < NT_; ++ni) acc[mi][ni] = __builtin_amdgcn_mfma_f32_32x32x16_bf16(a[mi], b[ni], acc[mi][ni], 0, 0, 0);
        }
        __syncthreads();
        if (kt + 1 < nk) { GEMM_LSTORE(); __syncthreads(); }
    }
#pragma unroll
    for (int mi = 0; mi < MT; ++mi)
#pragma unroll
        for (int ni = 0; ni < NT_; ++ni)
#pragma unroll
            for (int i = 0; i < 16; ++i) epi(wm * MT * 32 + mi * 32 + (i & 3) + 8 * (i >> 2) + 4 * h, wn * NT_ * 32 + ni * 32 + r, acc[mi][ni][i]);
}

DI void prep_mod_item(const Params& p, int item, char* smem) {
    float* cond = (float*)smem;
    const int tid = threadIdx.x;
    for (int i = tid; i < NB * DM; i += NTH) cond[i] = siluf_(p.c[i]);
    __syncthreads();
    const int b = tid >> 5, col = item * 32 + (tid & 31);
    float acc = 0.f;
    const float* w = p.ada_w + col;
    const float* cb = cond + b * DM;
#pragma unroll 8
    for (int k = 0; k < DM; ++k) acc += cb[k] * w[(size_t)k * 6144];
    ((float*)(p.ws + OFF_MOD))[b * 6144 + col] = acc + p.ada_b[col];
    __syncthreads();
}
DI void prep_s5_item(const Params& p, int g) {
    const int tid = threadIdx.x;
    if (tid < SSP) {
        const int pi = g * SSP + tid;
        const float dt = expf(p.log_dt[g]);
        const float ar = p.a_re[pi], ai = p.a_im[pi];
        const float mag = expf(ar * dt);
        const float lr = mag * cosf(ai * dt), li = mag * sinf(ai * dt);
        const float den = ar * ar + ai * ai, nr = lr - 1.0f, ni = li;
        const float zr = (nr * ar + ni * ai) / den, zi = (ni * ar - nr * ai) / den;
        float* lam = (float*)(p.ws + OFF_LAM) + pi * 2;
        lam[0] = lr; lam[1] = li;
        float* bb = (float*)(p.ws + OFF_BB) + (size_t)pi * 32;
        for (int i = 0; i < SSC; ++i) {
            const float br = p.b_re[pi * SSC + i], bi = p.b_im[pi * SSC + i];
            bb[i * 2] = zr * br - zi * bi; bb[i * 2 + 1] = zr * bi + zi * br;
        }
    }
}
DI void prep_transpose_tile(const float* __restrict__ W, bf16_t* __restrict__ Wt, int K, int N, int kt, int nt, char* smem) {
    float* tile = (float*)smem;
    const int tid = threadIdx.x;
#pragma unroll
    for (int q = 0; q < 2; ++q) {
        const int kk = (tid >> 4) + q * 32, c4 = (tid & 15) * 4;
        const float4 v = *(const float4*)(W + (size_t)(kt * 64 + kk) * N + nt * 64 + c4);
        tile[kk * 65 + c4] = v.x; tile[kk * 65 + c4 + 1] = v.y; tile[kk * 65 + c4 + 2] = v.z; tile[kk * 65 + c4 + 3] = v.w;
    }
    __syncthreads();
    const int n = tid >> 3, kc = tid & 7;
    uint4 o;
    o.x = pack2(tile[(kc * 8 + 0) * 65 + n], tile[(kc * 8 + 1) * 65 + n]);
    o.y = pack2(tile[(kc * 8 + 2) * 65 + n], tile[(kc * 8 + 3) * 65 + n]);
    o.z = pack2(tile[(kc * 8 + 4) * 65 + n], tile[(kc * 8 + 5) * 65 + n]);
    o.w = pack2(tile[(kc * 8 + 6) * 65 + n], tile[(kc * 8 + 7) * 65 + n]);
    *(uint4*)(Wt + (size_t)(nt * 64 + n) * K + kt * 64 + kc * 8) = o;
    __syncthreads();
}
DI void cvt_bf16_stream(const float* __restrict__ src, bf16_t* __restrict__ dst, size_t n8, int bid, int nb) {
    for (size_t i = (size_t)bid * NTH + threadIdx.x; i < n8; i += (size_t)nb * NTH) {
        const float4 a = *(const float4*)(src + i * 8), b = *(const float4*)(src + i * 8 + 4);
        uint4 o; o.x = pack2(a.x, a.y); o.y = pack2(a.z, a.w); o.z = pack2(b.x, b.y); o.w = pack2(b.z, b.w);
        *(uint4*)(dst + i * 8) = o;
    }
}
DI void cvt_fp8_rows(const float* __restrict__ src, unsigned char* __restrict__ dst, float* __restrict__ inv, int bid, int nb) {
    const int lane = threadIdx.x & 63, wid = threadIdx.x >> 6;
    for (int row = bid * 8 + wid; row < NEXP; row += nb * 8) {
        const float* sp = src + (size_t)row * DM + lane * 16;
        const f32x4 a = *(const f32x4*)sp, b = *(const f32x4*)(sp + 4), c = *(const f32x4*)(sp + 8), d = *(const f32x4*)(sp + 12);
        float m = fmaxf(fmaxf(fmaxf(fabsf(a.x), fabsf(a.y)), fmaxf(fabsf(a.z), fabsf(a.w))), fmaxf(fmaxf(fabsf(b.x), fabsf(b.y)), fmaxf(fabsf(b.z), fabsf(b.w))));
        m = fmaxf(m, fmaxf(fmaxf(fmaxf(fabsf(c.x), fabsf(c.y)), fmaxf(fabsf(c.z), fabsf(c.w))), fmaxf(fmaxf(fabsf(d.x), fabsf(d.y)), fmaxf(fabsf(d.z), fabsf(d.w)))));
#pragma unroll
        for (int s = 1; s < 64; s <<= 1) m = fmaxf(m, __shfl_xor(m, s));
        float sc = 1.f, isc = 1.f;
        if (m > 1e-30f) {
            int k = (int)floorf(log2f(448.0f / m));
            k = k < -60 ? -60 : (k > 60 ? 60 : k);
            sc = ldexpf(1.0f, k); isc = ldexpf(1.0f, -k);
            if (m * sc > 448.0f) { sc *= 0.5f; isc *= 2.0f; }
        }
        u32x4 o;
        int w;
        w = __builtin_amdgcn_cvt_pk_fp8_f32(a.x * sc, a.y * sc, 0, false); w = __builtin_amdgcn_cvt_pk_fp8_f32(a.z * sc, a.w * sc, w, true); o.x = (unsigned)w;
        w = __builtin_amdgcn_cvt_pk_fp8_f32(b.x * sc, b.y * sc, 0, false); w = __builtin_amdgcn_cvt_pk_fp8_f32(b.z * sc, b.w * sc, w, true); o.y = (unsigned)w;
        w = __builtin_amdgcn_cvt_pk_fp8_f32(c.x * sc, c.y * sc, 0, false); w = __builtin_amdgcn_cvt_pk_fp8_f32(c.z * sc, c.w * sc, w, true); o.z = (unsigned)w;
        w = __builtin_amdgcn_cvt_pk_fp8_f32(d.x * sc, d.y * sc, 0, false); w = __builtin_amdgcn_cvt_pk_fp8_f32(d.z * sc, d.w * sc, w, true); o.w = (unsigned)w;
        *(u32x4*)(dst + (size_t)row * DM + lane * 16) = o;
        if (lane == 0) inv[row] = isc;
    }
}
DI void phase_prep(const Params& p, int bid, int nb, char* smem) {
    constexpr int N_MOD = 192, N_LB = 1, N_S5 = 32, T_WIN = 16 * 40, T_GLU = 8 * 8, T_WOUT = 16 * 16, T_WQ = 16 * 32;
    constexpr int I_LB = N_MOD, I_S5 = I_LB + N_LB, I_WIN = I_S5 + N_S5, I_GLU = I_WIN + T_WIN, I_WOUT = I_GLU + T_GLU, I_WQ = I_WOUT + T_WOUT, I_END = I_WQ + T_WQ;
    for (int it = bid; it < I_END; it += nb) {
        if (it < N_MOD) prep_mod_item(p, it, smem);
        else if (it < I_S5) {
            const int j = threadIdx.x;
            const float a0 = p.hg_lb[j], a1 = p.hg_lb[512 + j], m = fmaxf(a0, a1);
            const float e0 = expf(a0 - m), e1 = expf(a1 - m);
            ((float*)(p.ws + OFF_LB))[j] = e0 / (e0 + e1);
        } else if (it < I_WIN) prep_s5_item(p, it - I_S5);
        else if (it < I_GLU) { const int t = it - I_WIN; prep_transpose_tile(p.w_in, (bf16_t*)(p.ws + OFF_WIN), DM, INC, t / 40, t % 40, smem); }
        else if (it < I_WOUT) { const int t = it - I_GLU; prep_transpose_tile(p.glu_w, (bf16_t*)(p.ws + OFF_GLU), 512, 512, t / 8, t % 8, smem); }
        else if (it < I_WQ) { const int t = it - I_WOUT; prep_transpose_tile(p.w_out, (bf16_t*)(p.ws + OFF_WOUT), DM, DM, t / 16, t % 16, smem); }
        else { const int t = it - I_WQ; prep_transpose_tile(p.w_q, (bf16_t*)(p.ws + OFF_WQ), DM, 2048, t / 32, t % 32, smem); }
    }
    cvt_bf16_stream(p.subk, (bf16_t*)(p.ws + OFF_SUBK), (size_t)16 * 128 * 128 / 8, bid, nb);
    cvt_fp8_rows(p.pu, (unsigned char*)(p.ws + OFF_UT), (float*)(p.ws + OFF_SU), bid, nb);
    cvt_fp8_rows(p.pv, (unsigned char*)(p.ws + OFF_VT), (float*)(p.ws + OFF_SV), bid, nb);
}

DI void phase_h(const Params& p, int bid, int nb) {
    const float* mod = (const float*)(p.ws + OFF_MOD);
    bf16_t* H = (bf16_t*)(p.ws + OFF_H);
    const size_t n8 = (size_t)NTOK * DM / 8;
    for (size_t i = (size_t)bid * NTH + threadIdx.x; i < n8; i += (size_t)nb * NTH) {
        const int row = (int)(i >> 7), c0 = (int)(i & 127) * 8, b = row / SEQ;
        const float* sh = mod + b * 6144 + c0;
        const float* sc = sh + 1024;
        const float4 a = *(const float4*)(p.x + i * 8), bq = *(const float4*)(p.x + i * 8 + 4);
        const float4 s0 = *(const float4*)sc, s1 = *(const float4*)(sc + 4), h0 = *(const float4*)sh, h1 = *(const float4*)(sh + 4);
        uint4 o;
        o.x = pack2(a.x * (1.f + s0.x) + h0.x, a.y * (1.f + s0.y) + h0.y);
        o.y = pack2(a.z * (1.f + s0.z) + h0.z, a.w * (1.f + s0.w) + h0.w);
        o.z = pack2(bq.x * (1.f + s1.x) + h1.x, bq.y * (1.f + s1.y) + h1.y);
        o.w = pack2(bq.z * (1.f + s1.z) + h1.z, bq.w * (1.f + s1.w) + h1.w);
        *(uint4*)(H + i * 8) = o;
    }
}

DI void phase_proj(const Params& p, int bid, int nb, char* smem) {
    const bf16_t* H = (const bf16_t*)(p.ws + OFF_H);
    const bf16_t* W = (const bf16_t*)(p.ws + OFF_WIN);
    bf16_t* P = (bf16_t*)(p.ws + OFF_PROJ);
    constexpr int NTN = INC / 128, NTM = NTOK / 128;
    for (int t = bid; t < NTM * NTN; t += nb) {
        const int mt = t / NTN, nt = t % NTN;
        bf16_t* Pt = P + (size_t)mt * 128 * INC + nt * 128;
        const bool act = (nt < 4) || (nt >= 12 && nt < 16);
        gemm_block<2, 1, 2, 4>(H + (size_t)mt * 128 * DM, DM, W + (size_t)nt * 128 * DM, DM, DM, smem,
                               [&](int r, int c, float v) { Pt[(size_t)r * INC + c] = f2bf(act ? siluf_(v) : v); });
        __syncthreads();
    }
}

DI void hgrn_item(const Params& p, int item, char* smem) {
    const int vs = item & 7, hd = (item >> 3) & 3, b = item >> 5;
    const bf16_t* P = (const bf16_t*)(p.ws + OFF_PROJ);
    const float* lb = (const float*)(p.ws + OFF_LB) + hd * HDK;
    float* ORAW = (float*)(p.ws + OFF_ORAW);
    float* sq = (float*)smem;
    float* sf = sq + 32 * 128;
    float* sv = sf + 32 * 128;
    float* sp = sv + 32 * 16;
    const int tid = threadIdx.x, lane = tid & 63, wid = tid >> 6, kq = tid >> 4, v = tid & 15;
    float S0 = 0.f, S1 = 0.f, S2 = 0.f, S3 = 0.f;
    for (int t0 = 0; t0 < SEQ; t0 += 32) {
        for (int i = tid; i < 32 * 128; i += NTH) {
            const int t = i >> 7, k = i & 127;
            const bf16_t* row = P + (size_t)(b * SEQ + t0 + t) * INC + hd * HDK + k;
            sq[i] = bf2f(row[0]);
            const float l = lb[k];
            sf[i] = l + (1.0f - l) * sigmoidf_(bf2f(row[512]));
        }
        { const int t = tid >> 4; sv[tid] = bf2f(P[(size_t)(b * SEQ + t0 + t) * INC + 1024 + hd * HDK + vs * 16 + v]); }
        __syncthreads();
        for (int t = 0; t < 32; ++t) {
            const float4 f4 = *(const float4*)(sf + t * 128 + kq * 4), q4 = *(const float4*)(sq + t * 128 + kq * 4);
            const float vv = sv[t * 16 + v];
            S0 = f4.x * S0 + (1.0f - f4.x) * vv; S1 = f4.y * S1 + (1.0f - f4.y) * vv;
            S2 = f4.z * S2 + (1.0f - f4.z) * vv; S3 = f4.w * S3 + (1.0f - f4.w) * vv;
            float part = q4.x * S0 + q4.y * S1 + q4.z * S2 + q4.w * S3;
            part += __shfl_xor(part, 16); part += __shfl_xor(part, 32);
            if (lane < 16) sp[(t * 8 + wid) * 16 + v] = part;
        }
        __syncthreads();
        {
            const int t = tid >> 4;
            float o = 0.f;
#pragma unroll
            for (int w = 0; w < 8; ++w) o += sp[(t * 8 + w) * 16 + v];
            ORAW[(size_t)(b * SEQ + t0 + t) * DHG + hd * HDK + vs * 16 + v] = o;
        }
        __syncthreads();
    }
}
DI void s5_item(const Params& p, int item, char* smem) {
    const int oct = item & 3, b = item >> 2;
    const int tid = threadIdx.x, lane = tid & 63, wid = tid >> 6, g = oct * 8 + wid;
    const bf16_t* P = (const bf16_t*)(p.ws + OFF_PROJ);
    bf16_t* Y = (bf16_t*)(p.ws + OFF_YSSM);
    float* su = (float*)smem + wid * 64 * 16;
    const float* lam = (const float*)(p.ws + OFF_LAM) + (g * SSP + lane) * 2;
    const float lr = lam[0], li = lam[1];
    const float* bb = (const float*)(p.ws + OFF_BB) + (size_t)(g * SSP + lane) * 32;
    float bbr[16], bbi[16], cr[16], ci[16];
#pragma unroll
    for (int i = 0; i < 16; ++i) { bbr[i] = bb[2 * i]; bbi[i] = bb[2 * i + 1]; cr[i] = p.c_re[(g * SSC + i) * SSP + lane]; ci[i] = p.c_im[(g * SSC + i) * SSP + lane]; }
    const int ch = (lane >> 2) & 15;
    const float dch = p.dsk[g * SSC + ch];
    float xr = 0.f, xi = 0.f;
    for (int t0 = 0; t0 < SEQ; t0 += 64) {
        {
            const uint4* src = (const uint4*)(P + (size_t)(b * SEQ + t0 + lane) * INC + 2048 + g * SSC);
            const uint4 a = src[0], c = src[1];
            float* d = su + lane * 16;
            d[0] = bflo(a.x); d[1] = bfhi(a.x); d[2] = bflo(a.y); d[3] = bfhi(a.y); d[4] = bflo(a.z); d[5] = bfhi(a.z); d[6] = bflo(a.w); d[7] = bfhi(a.w);
            d[8] = bflo(c.x); d[9] = bfhi(c.x); d[10] = bflo(c.y); d[11] = bfhi(c.y); d[12] = bflo(c.z); d[13] = bfhi(c.z); d[14] = bflo(c.w); d[15] = bfhi(c.w);
        }
        __syncthreads();
        for (int t = 0; t < 64; ++t) {
            float u[16];
            const float4* us = (const float4*)(su + t * 16);
            const float4 u0 = us[0], u1 = us[1], u2 = us[2], u3 = us[3];
            u[0] = u0.x; u[1] = u0.y; u[2] = u0.z; u[3] = u0.w; u[4] = u1.x; u[5] = u1.y; u[6] = u1.z; u[7] = u1.w;
            u[8] = u2.x; u[9] = u2.y; u[10] = u2.z; u[11] = u2.w; u[12] = u3.x; u[13] = u3.y; u[14] = u3.z; u[15] = u3.w;
            float bur = 0.f, bui = 0.f;
#pragma unroll
            for (int i = 0; i < 16; ++i) { bur += bbr[i] * u[i]; bui += bbi[i] * u[i]; }
            const float nxr = lr * xr - li * xi + bur, nxi = lr * xi + li * xr + bui;
            xr = nxr; xi = nxi;
            float y[16];
#pragma unroll
            for (int i = 0; i < 16; ++i) y[i] = cr[i] * xr - ci[i] * xi;
            const bool b5 = lane & 32, b4 = lane & 16, b3 = lane & 8, b2 = lane & 4;
            float y8[8], y4[4], y2[2];
#pragma unroll
            for (int j = 0; j < 8; ++j) { const float keep = b5 ? y[8 + j] : y[j], send = b5 ? y[j] : y[8 + j]; y8[j] = keep + __shfl_xor(send, 32); }
#pragma unroll
            for (int j = 0; j < 4; ++j) { const float keep = b4 ? y8[4 + j] : y8[j], send = b4 ? y8[j] : y8[4 + j]; y4[j] = keep + __shfl_xor(send, 16); }
#pragma unroll
            for (int j = 0; j < 2; ++j) { const float keep = b3 ? y4[2 + j] : y4[j], send = b3 ? y4[j] : y4[2 + j]; y2[j] = keep + __shfl_xor(send, 8); }
            float y1;
            { const float keep = b2 ? y2[1] : y2[0], send = b2 ? y2[0] : y2[1]; y1 = keep + __shfl_xor(send, 4); }
            y1 += __shfl_xor(y1, 1); y1 += __shfl_xor(y1, 2);
            if ((lane & 3) == 0) {
                const float uu = su[t * 16 + ch];
                Y[(size_t)(b * SEQ + t0 + t) * DSS + g * SSC + ch] = f2bf(geluf_(y1 + dch * uu));
            }
        }
        __syncthreads();
    }
}
DI void phase_mix(const Params& p, int bid, int nb, char* smem) {
    for (int it = bid; it < 512 + 64; it += nb) {
        if (it < 512) hgrn_item(p, it, smem); else s5_item(p, it - 512, smem);
        __syncthreads();
    }
}

DI void phase_glu(const Params& p, int bid, int nb, char* smem) {
    const bf16_t* Y = (const bf16_t*)(p.ws + OFF_YSSM);
    const bf16_t* W = (const bf16_t*)(p.ws + OFF_GLU);
    float* Y2 = (float*)(p.ws + OFF_H);
    constexpr int NTN = 4, NTM = NTOK / 128;
    for (int t = bid; t < NTM * NTN; t += nb) {
        const int mt = t / NTN, nt = t % NTN;
        const bf16_t* Yt = Y + (size_t)mt * 128 * DSS + nt * 128;
        float* Ot = Y2 + (size_t)mt * 128 * DSS + nt * 128;
        const float* gb = p.glu_b + nt * 128;
        gemm_block<2, 1, 2, 4>(Y + (size_t)mt * 128 * DSS, DSS, W + (size_t)nt * 128 * 512, 512, 512, smem,
                               [&](int r, int c, float v) { const float y = bf2f(Yt[(size_t)r * DSS + c]); Ot[(size_t)r * DSS + c] = y * sigmoidf_(v + gb[c]); });
        __syncthreads();
    }
}
DI void phase_a2(const Params& p, int bid, int nb) {
    const float* ORAW = (const float*)(p.ws + OFF_ORAW);
    const float* Y2 = (const float*)(p.ws + OFF_H);
    const bf16_t* P = (const bf16_t*)(p.ws + OFF_PROJ);
    bf16_t* A2 = (bf16_t*)(p.ws + OFF_A2);
    const int lane = threadIdx.x & 63, wid = threadIdx.x >> 6;
    for (int tok = bid * 8 + wid; tok < NTOK; tok += nb * 8) {
        const int c0 = lane * 8;
        {
            const float4 a = *(const float4*)(ORAW + (size_t)tok * DHG + c0), b = *(const float4*)(ORAW + (size_t)tok * DHG + c0 + 4);
            float ss = a.x * a.x + a.y * a.y + a.z * a.z + a.w * a.w + b.x * b.x + b.y * b.y + b.z * b.z + b.w * b.w;
            ss += __shfl_xor(ss, 1); ss += __shfl_xor(ss, 2); ss += __shfl_xor(ss, 4); ss += __shfl_xor(ss, 8);
            const float rs = rsqrtf(ss * (1.0f / 128.0f) + RMS_EPS);
            const uint4 gq = *(const uint4*)(P + (size_t)tok * INC + 1536 + c0);
            const float4 w0 = *(const float4*)(p.hg_nw + c0), w1 = *(const float4*)(p.hg_nw + c0 + 4);
            uint4 o;
            o.x = pack2(a.x * rs * w0.x * bflo(gq.x), a.y * rs * w0.y * bfhi(gq.x));
            o.y = pack2(a.z * rs * w0.z * bflo(gq.y), a.w * rs * w0.w * bfhi(gq.y));
            o.z = pack2(b.x * rs * w1.x * bflo(gq.z), b.y * rs * w1.y * bfhi(gq.z));
            o.w = pack2(b.z * rs * w1.z * bflo(gq.w), b.w * rs * w1.w * bfhi(gq.w));
            *(uint4*)(A2 + (size_t)tok * DM + c0) = o;
        }
        {
            const float4 a = *(const float4*)(Y2 + (size_t)tok * DSS + c0), b = *(const float4*)(Y2 + (size_t)tok * DSS + c0 + 4);
            float ss = a.x * a.x + a.y * a.y + a.z * a.z + a.w * a.w + b.x * b.x + b.y * b.y + b.z * b.z + b.w * b.w;
#pragma unroll
            for (int m = 1; m < 64; m <<= 1) ss += __shfl_xor(ss, m);
            const float rs = rsqrtf(ss * (1.0f / 512.0f) + RMS_EPS);
            const float4 w0 = *(const float4*)(p.ssm_nw + c0), w1 = *(const float4*)(p.ssm_nw + c0 + 4);
            uint4 o;
            o.x = pack2(a.x * rs * w0.x, a.y * rs * w0.y); o.y = pack2(a.z * rs * w0.z, a.w * rs * w0.w);
            o.z = pack2(b.x * rs * w1.x, b.y * rs * w1.y); o.w = pack2(b.z * rs * w1.z, b.w * rs * w1.w);
            *(uint4*)(A2 + (size_t)tok * DM + 512 + c0) = o;
        }
    }
}

DI void phase_outproj(const Params& p, int bid, int nb, char* smem) {
    const bf16_t* A2 = (const bf16_t*)(p.ws + OFF_A2);
    const bf16_t* W = (const bf16_t*)(p.ws + OFF_WOUT);
    const float* mod = (const float*)(p.ws + OFF_MOD);
    constexpr int NTN = 8, NTM = NTOK / 128;
    for (int t = bid; t < NTM * NTN; t += nb) {
        const int mt = t / NTN, nt = t % NTN, b = (mt * 128) / SEQ;
        const float* xt = p.x + (size_t)mt * 128 * DM + nt * 128;
        float* ot = p.out + (size_t)mt * 128 * DM + nt * 128;
        const float* g1 = mod + b * 6144 + 2048 + nt * 128;
        gemm_block<2, 1, 2, 4>(A2 + (size_t)mt * 128 * DM, DM, W + (size_t)nt * 128 * DM, DM, DM, smem,
                               [&](int r, int c, float v) { ot[(size_t)r * DM + c] = DEEP_ALPHA * xt[(size_t)r * DM + c] + (1.0f + g1[c]) * v; });
        __syncthreads();
    }
}
DI void phase_ln1(const Params& p, int bid, int nb) {
    const float* mod = (const float*)(p.ws + OFF_MOD);
    bf16_t* H2 = (bf16_t*)(p.ws + OFF_H);
    const int lane = threadIdx.x & 63, wid = threadIdx.x >> 6;
    for (int tok = bid * 8 + wid; tok < NTOK; tok += nb * 8) {
        const int b = tok / SEQ;
        float* row = p.out + (size_t)tok * DM;
        float4 v[4];
        float s = 0.f;
#pragma unroll
        for (int j = 0; j < 4; ++j) { v[j] = *(const float4*)(row + j * 256 + lane * 4); s += v[j].x + v[j].y + v[j].z + v[j].w; }
#pragma unroll
        for (int m = 1; m < 64; m <<= 1) s += __shfl_xor(s, m);
        const float mu = s * (1.0f / 1024.0f);
        float q = 0.f;
#pragma unroll
        for (int j = 0; j < 4; ++j) { const float a = v[j].x - mu, bb = v[j].y - mu, cc = v[j].z - mu, d = v[j].w - mu; q += a * a + bb * bb + cc * cc + d * d; }
#pragma unroll
        for (int m = 1; m < 64; m <<= 1) q += __shfl_xor(q, m);
        const float rstd = rsqrtf(q * (1.0f / 1024.0f) + LN_EPS);
        const float* sh2 = mod + b * 6144 + 3072;
        const float* sc2 = mod + b * 6144 + 4096;
#pragma unroll
        for (int j = 0; j < 4; ++j) {
            const int c = j * 256 + lane * 4;
            const float4 w = *(const float4*)(p.ln1w + c), bi = *(const float4*)(p.ln1b + c), sc = *(const float4*)(sc2 + c), sh = *(const float4*)(sh2 + c);
            float4 o;
            o.x = (v[j].x - mu) * rstd * w.x + bi.x; o.y = (v[j].y - mu) * rstd * w.y + bi.y; o.z = (v[j].z - mu) * rstd * w.z + bi.z; o.w = (v[j].w - mu) * rstd * w.w + bi.w;
            *(float4*)(row + c) = o;
            uint2 hh; hh.x = pack2(o.x * (1.f + sc.x) + sh.x, o.y * (1.f + sc.y) + sh.y); hh.y = pack2(o.z * (1.f + sc.z) + sh.z, o.w * (1.f + sc.w) + sh.w);
            *(uint2*)(H2 + (size_t)tok * DM + c) = hh;
        }
    }
}

DI void phase_q(const Params& p, int bid, int nb, char* smem) {
    const bf16_t* H2 = (const bf16_t*)(p.ws + OFF_H);
    const bf16_t* W = (const bf16_t*)(p.ws + OFF_WQ);
    bf16_t* Q = (bf16_t*)(p.ws + OFF_PROJ);
    constexpr int NTN = 16, NTM = NTOK / 128;
    for (int t = bid; t < NTM * NTN; t += nb) {
        const int mt = t / NTN, nt = t % NTN;
        bf16_t* Qt = Q + (size_t)mt * 128 * 2048 + nt * 128;
        gemm_block<2, 1, 2, 4>(H2 + (size_t)mt * 128 * DM, DM, W + (size_t)nt * 128 * DM, DM, DM, smem,
                               [&](int r, int c, float v) { Qt[(size_t)r * 2048 + c] = f2bf(v); });
        __syncthreads();
    }
}
DI void phase_topk(const Params& p, int bid, int nb, char* smem) {
    const bf16_t* Q = (const bf16_t*)(p.ws + OFF_PROJ);
    const bf16_t* SK = (const bf16_t*)(p.ws + OFF_SUBK);
    unsigned* TOPL = (unsigned*)(p.ws + OFF_TOPL);
    float* sc = (float*)(smem + 36864);
    constexpr int NTM = NTOK / 128;
    for (int t = bid; t < NTM * 16; t += nb) {
        const int mt = t >> 4, hp = t & 15;
        gemm_block<2, 1, 2, 4>(Q + (size_t)mt * 128 * 2048 + hp * 128, 2048, SK + (size_t)hp * 128 * 128, 128, 128, smem,
                               [&](int r, int c, float v) { sc[r * 129 + c] = v; });
        __syncthreads();
        if (threadIdx.x < 128) {
            const int r = threadIdx.x;
            float tk[16];
#pragma unroll
            for (int j = 0; j < 16; ++j) tk[j] = -3.0e38f;
            for (int n = 0; n < 128; ++n) {
                float xv = __uint_as_float((__float_as_uint(sc[r * 129 + n]) & ~0x7fu) | (unsigned)n);
#pragma unroll
                for (int j = 0; j < 16; ++j) { const float hi = fmaxf(tk[j], xv), lo = fminf(tk[j], xv); tk[j] = hi; xv = lo; }
            }
            uint4* dst = (uint4*)(TOPL + ((size_t)(mt * 128 + r) * 16 + hp) * 16);
            dst[0] = make_uint4(__float_as_uint(tk[0]), __float_as_uint(tk[1]), __float_as_uint(tk[2]), __float_as_uint(tk[3]));
            dst[1] = make_uint4(__float_as_uint(tk[4]), __float_as_uint(tk[5]), __float_as_uint(tk[6]), __float_as_uint(tk[7]));
            dst[2] = make_uint4(__float_as_uint(tk[8]), __float_as_uint(tk[9]), __float_as_uint(tk[10]), __float_as_uint(tk[11]));
            dst[3] = make_uint4(__float_as_uint(tk[12]), __float_as_uint(tk[13]), __float_as_uint(tk[14]), __float_as_uint(tk[15]));
        }
        __syncthreads();
    }
}
DI void phase_combine(const Params& p, int bid, int nb) {
    const unsigned* TOPL = (const unsigned*)(p.ws + OFF_TOPL);
    uint2* EX = (uint2*)(p.ws + OFF_EXPS);
    const float* SU = (const float*)(p.ws + OFF_SU);
    const float* SV = (const float*)(p.ws + OFF_SV);
    for (int i = bid * NTH + threadIdx.x; i < NTOK * PHEADS; i += nb * NTH) {
        const unsigned* l1 = TOPL + (size_t)i * 32;
        const unsigned* l2 = l1 + 16;
        float s2[16];
        {
            const uint4 a = ((const uint4*)l2)[0], b = ((const uint4*)l2)[1], c = ((const uint4*)l2)[2], d = ((const uint4*)l2)[3];
            const unsigned w[16] = {a.x, a.y, a.z, a.w, b.x, b.y, b.z, b.w, c.x, c.y, c.z, c.w, d.x, d.y, d.z, d.w};
#pragma unroll
            for (int j = 0; j < 16; ++j) s2[j] = __uint_as_float(w[j] & ~0x7fu);
        }
        float tk[16];
#pragma unroll
        for (int j = 0; j < 16; ++j) tk[j] = -3.0e38f;
        for (int a = 0; a < 16; ++a) {
            const float s1 = __uint_as_float(l1[a] & ~0x7fu);
#pragma unroll
            for (int b = 0; b < 16; ++b) {
                float xv = __uint_as_float((__float_as_uint(s1 + s2[b]) & ~0xffu) | (unsigned)(a * 16 + b));
#pragma unroll
                for (int j = 0; j < 16; ++j) { const float hi = fmaxf(tk[j], xv), lo = fminf(tk[j], xv); tk[j] = hi; xv = lo; }
            }
        }
        float e[16], sum = 0.f;
        const float mx = __uint_as_float(__float_as_uint(tk[0]) & ~0xffu);
#pragma unroll
        for (int j = 0; j < 16; ++j) { e[j] = __expf(__uint_as_float(__float_as_uint(tk[j]) & ~0xffu) - mx); sum += e[j]; }
        const float inv = 1.0f / sum;
#pragma unroll
        for (int j = 0; j < 16; ++j) {
            const unsigned ab = __float_as_uint(tk[j]) & 0xffu;
            const unsigned i1 = l1[ab >> 4] & 0x7fu, i2 = l2[ab & 15] & 0x7fu;
            const unsigned eid = i1 * 128u + i2;
            EX[(size_t)i * 16 + j] = make_uint2(eid | (((__float_as_uint(SU[eid]) >> 23) & 0xffu) << 16), __float_as_uint(e[j] * inv * SV[eid]));
        }
    }
}

DI float dot16_fp8(const u32x4 w, const f32x2 (&h)[8]) {
    f32x2 acc = __builtin_amdgcn_cvt_pk_f32_fp8((int)w.x, false) * h[0];
    acc += __builtin_amdgcn_cvt_pk_f32_fp8((int)w.x, true) * h[1];
    acc += __builtin_amdgcn_cvt_pk_f32_fp8((int)w.y, false) * h[2];
    acc += __builtin_amdgcn_cvt_pk_f32_fp8((int)w.y, true) * h[3];
    acc += __builtin_amdgcn_cvt_pk_f32_fp8((int)w.z, false) * h[4];
    acc += __builtin_amdgcn_cvt_pk_f32_fp8((int)w.z, true) * h[5];
    acc += __builtin_amdgcn_cvt_pk_f32_fp8((int)w.w, false) * h[6];
    acc += __builtin_amdgcn_cvt_pk_f32_fp8((int)w.w, true) * h[7];
    return acc.x + acc.y;
}
DI void axpy16_fp8(const float a, const u32x4 w, f32x2 (&o)[8]) {
    const f32x2 aa = {a, a};
    o[0] += aa * __builtin_amdgcn_cvt_pk_f32_fp8((int)w.x, false); o[1] += aa * __builtin_amdgcn_cvt_pk_f32_fp8((int)w.x, true);
    o[2] += aa * __builtin_amdgcn_cvt_pk_f32_fp8((int)w.y, false); o[3] += aa * __builtin_amdgcn_cvt_pk_f32_fp8((int)w.y, true);
    o[4] += aa * __builtin_amdgcn_cvt_pk_f32_fp8((int)w.z, false); o[5] += aa * __builtin_amdgcn_cvt_pk_f32_fp8((int)w.z, true);
    o[6] += aa * __builtin_amdgcn_cvt_pk_f32_fp8((int)w.w, false); o[7] += aa * __builtin_amdgcn_cvt_pk_f32_fp8((int)w.w, true);
}
DI float butterfly64(float (&pz)[64], const int lane) {
    const bool b5 = lane & 32, b4 = lane & 16, b3 = lane & 8, b2 = lane & 4, b1 = lane & 2, b0 = lane & 1;
    float q32[32], q16[16], q8[8], q4[4], q2[2];
#pragma unroll
    for (int j = 0; j < 32; ++j) q32[j] = (b5 ? pz[32 + j] : pz[j]) + __shfl_xor(b5 ? pz[j] : pz[32 + j], 32);
#pragma unroll
    for (int j = 0; j < 16; ++j) q16[j] = (b4 ? q32[16 + j] : q32[j]) + __shfl_xor(b4 ? q32[j] : q32[16 + j], 16);
#pragma unroll
    for (int j = 0; j < 8; ++j) q8[j] = (b3 ? q16[8 + j] : q16[j]) + __shfl_xor(b3 ? q16[j] : q16[8 + j], 8);
#pragma unroll
    for (int j = 0; j < 4; ++j) q4[j] = (b2 ? q8[4 + j] : q8[j]) + __shfl_xor(b2 ? q8[j] : q8[4 + j], 4);
#pragma unroll
    for (int j = 0; j < 2; ++j) q2[j] = (b1 ? q4[2 + j] : q4[j]) + __shfl_xor(b1 ? q4[j] : q4[2 + j], 2);
    return (b0 ? q2[1] : q2[0]) + __shfl_xor(b0 ? q2[0] : q2[1], 1);
}
DI void phase_gather(const Params& p, int bid, int nb) {
    const float* mod = (const float*)(p.ws + OFF_MOD);
    const uint2* EX = (const uint2*)(p.ws + OFF_EXPS);
    const unsigned char* UT = (const unsigned char*)(p.ws + OFF_UT);
    const unsigned char* VT = (const unsigned char*)(p.ws + OFF_VT);
    const int lane = threadIdx.x & 63, wid = threadIdx.x >> 6;
    for (int tok = bid * 8 + wid; tok < NTOK; tok += nb * 8) {
        const int b = tok / SEQ, c0 = lane * 16;
        float* row = p.out + (size_t)tok * DM + c0;
        const float* sh2 = mod + b * 6144 + 3072 + c0;
        const float* sc2 = mod + b * 6144 + 4096 + c0;
        const float* g2 = mod + b * 6144 + 5120 + c0;
        f32x2 x1[8], h2[8], acc[8];
#pragma unroll
        for (int q = 0; q < 4; ++q) {
            const f32x4 xv = *(const f32x4*)(row + q * 4), sc = *(const f32x4*)(sc2 + q * 4), sh = *(const f32x4*)(sh2 + q * 4);
            x1[2 * q] = (f32x2){xv.x, xv.y}; x1[2 * q + 1] = (f32x2){xv.z, xv.w};
            h2[2 * q] = (f32x2){xv.x * (1.f + sc.x) + sh.x, xv.y * (1.f + sc.y) + sh.y};
            h2[2 * q + 1] = (f32x2){xv.z * (1.f + sc.z) + sh.z, xv.w * (1.f + sc.w) + sh.w};
        }
#pragma unroll
        for (int i = 0; i < 8; ++i) acc[i] = (f32x2){0.f, 0.f};
        const uint2 e0 = EX[(size_t)tok * 128 + lane], e1 = EX[(size_t)tok * 128 + 64 + lane];
        float a0, a1;
        {
            float pz[64];
#pragma unroll
            for (int e = 0; e < 64; ++e) {
                const unsigned eid = (unsigned)__builtin_amdgcn_readlane((int)e0.x, e) & 0xffffu;
                pz[e] = dot16_fp8(*(const u32x4*)(UT + (size_t)eid * DM + c0), h2);
            }
            const float z = butterfly64(pz, lane) * __uint_as_float(((e0.x >> 16) & 0xffu) << 23);
            a0 = geluf_(z) * __uint_as_float(e0.y);
        }
        {
            float pz[64];
#pragma unroll
            for (int e = 0; e < 64; ++e) {
                const unsigned eid = (unsigned)__builtin_amdgcn_readlane((int)e1.x, e) & 0xffffu;
                pz[e] = dot16_fp8(*(const u32x4*)(UT + (size_t)eid * DM + c0), h2);
            }
            const float z = butterfly64(pz, lane) * __uint_as_float(((e1.x >> 16) & 0xffu) << 23);
            a1 = geluf_(z) * __uint_as_float(e1.y);
        }
#pragma unroll 16
        for (int e = 0; e < 64; ++e) {
            const unsigned eid = (unsigned)__builtin_amdgcn_readlane((int)e0.x, e) & 0xffffu;
            const float a = __uint_as_float(__builtin_amdgcn_readlane((int)__float_as_uint(a0), e));
            axpy16_fp8(a, *(const u32x4*)(VT + (size_t)eid * DM + c0), acc);
        }
#pragma unroll 16
        for (int e = 0; e < 64; ++e) {
            const unsigned eid = (unsigned)__builtin_amdgcn_readlane((int)e1.x, e) & 0xffffu;
            const float a = __uint_as_float(__builtin_amdgcn_readlane((int)__float_as_uint(a1), e));
            axpy16_fp8(a, *(const u32x4*)(VT + (size_t)eid * DM + c0), acc);
        }
        f32x2 r[8];
        float s = 0.f;
#pragma unroll
        for (int q = 0; q < 4; ++q) {
            const f32x4 gg = *(const f32x4*)(g2 + q * 4);
            r[2 * q] = DEEP_ALPHA * x1[2 * q] + (f32x2){1.f + gg.x, 1.f + gg.y} * acc[2 * q];
            r[2 * q + 1] = DEEP_ALPHA * x1[2 * q + 1] + (f32x2){1.f + gg.z, 1.f + gg.w} * acc[2 * q + 1];
            s += r[2 * q].x + r[2 * q].y + r[2 * q + 1].x + r[2 * q + 1].y;
        }
#pragma unroll
        for (int m = 1; m < 64; m <<= 1) s += __shfl_xor(s, m);
        const float mu = s * (1.0f / 1024.0f);
        float qq = 0.f;
#pragma unroll
        for (int i = 0; i < 8; ++i) { const f32x2 d = r[i] - mu; qq += d.x * d.x + d.y * d.y; }
#pragma unroll
        for (int m = 1; m < 64; m <<= 1) qq += __shfl_xor(qq, m);
        const float rstd = rsqrtf(qq * (1.0f / 1024.0f) + LN_EPS);
#pragma unroll
        for (int q = 0; q < 4; ++q) {
            const f32x4 w = *(const f32x4*)(p.ln2w + c0 + q * 4), bi = *(const f32x4*)(p.ln2b + c0 + q * 4);
            f32x4 ov;
            ov.x = (r[2 * q].x - mu) * rstd * w.x + bi.x; ov.y = (r[2 * q].y - mu) * rstd * w.y + bi.y;
            ov.z = (r[2 * q + 1].x - mu) * rstd * w.z + bi.z; ov.w = (r[2 * q + 1].y - mu) * rstd * w.w + bi.w;
            *(f32x4*)(row + q * 4) = ov;
        }
    }
}

__global__ void __launch_bounds__(NTH) k_mega(Params p) {
    __shared__ __attribute__((aligned(16))) char smem[SMEM_BYTES];
    cg::grid_group grid = cg::this_grid();
    const int bid = blockIdx.x, nb = gridDim.x;
    phase_prep(p, bid, nb, smem);    grid.sync();
    phase_h(p, bid, nb);             grid.sync();
    phase_proj(p, bid, nb, smem);    grid.sync();
    phase_mix(p, bid, nb, smem);     grid.sync();
    phase_glu(p, bid, nb, smem);     grid.sync();
    phase_a2(p, bid, nb);            grid.sync();
    phase_outproj(p, bid, nb, smem); grid.sync();
    phase_ln1(p, bid, nb);           grid.sync();
    phase_q(p, bid, nb, smem);       grid.sync();
    phase_topk(p, bid, nb, smem);    grid.sync();
    phase_combine(p, bid, nb);       grid.sync();
    phase_gather(p, bid, nb);
}

extern "C" void kernel_launch(void* const* d_in, const int* in_sizes, int n_in, void* d_out, int out_size, void* d_ws, size_t ws_size, hipStream_t stream) {
    if (n_in != 27 || ws_size < WS_END) { fprintf(stderr, "kernel_launch: unexpected n_in %d or ws_size %zu (< %zu)\n", n_in, ws_size, (size_t)WS_END); return; }
    static int grid_blocks = 0;
    if (!grid_blocks) {
        int dev = 0, cus = 0, per_cu = 0;
        (void)hipGetDevice(&dev);
        (void)hipDeviceGetAttribute(&cus, hipDeviceAttributeMultiprocessorCount, dev);
        (void)hipOccupancyMaxActiveBlocksPerMultiprocessor(&per_cu, k_mega, NTH, 0);
        if (cus <= 0) cus = 256;
        if (per_cu < 1) { fprintf(stderr, "kernel_launch: occupancy query says %d blocks/CU\n", per_cu); per_cu = 1; }
        grid_blocks = cus;
    }
    Params p{};
    const float** f = (const float**)&p;
    for (int i = 0; i < 27; ++i) f[i] = (const float*)d_in[i];
    p.out = (float*)d_out; p.ws = (char*)d_ws;
    void* args[] = {&p};
    hipError_t e = hipLaunchCooperativeKernel((void*)k_mega, dim3(grid_blocks), dim3(NTH), args, 0, stream);
    if (e != hipSuccess) fprintf(stderr, "cooperative launch failed: %s (grid %d)\n", hipGetErrorString(e), grid_blocks);
}
```

```cpp
#include <hip/hip_runtime.h>
#include <hip/hip_cooperative_groups.h>
#include <stdint.h>
#include <stdio.h>

namespace cg = cooperative_groups;
#define DI __device__ __forceinline__
typedef unsigned short bf16_t;
typedef short bf16x8 __attribute__((ext_vector_type(8)));
typedef float f32x16 __attribute__((ext_vector_type(16)));
typedef unsigned u32x4 __attribute__((ext_vector_type(4)));
typedef float f32x4 __attribute__((ext_vector_type(4)));
typedef float f32x2 __attribute__((ext_vector_type(2)));

constexpr int NTH = 512;
constexpr int NB = 16, SEQ = 2048, DM = 1024, NTOK = NB * SEQ;
constexpr int DHG = 512, HGH = 4, HDK = 128;
constexpr int DSS = 512, SSG = 32, SSC = 16, SSP = 64;
constexpr int INC = 2560;
constexpr int PHEADS = 8, NKEYS = 128, TOPK = 16, NEXP = 16384;
constexpr float DEEP_ALPHA = 1.189207115002721f;
constexpr float LN_EPS = 1e-5f, RMS_EPS = 1e-6f;
constexpr int SMEM_BYTES = 128 * 1024;

constexpr size_t al256(size_t x) { return (x + 255) & ~(size_t)255; }
constexpr size_t OFF_MOD = 0;
constexpr size_t OFF_LB = al256(OFF_MOD + (size_t)NB * 6144 * 4);
constexpr size_t OFF_LAM = al256(OFF_LB + 512 * 4);
constexpr size_t OFF_BB = al256(OFF_LAM + 32 * 64 * 2 * 4);
constexpr size_t OFF_WIN = al256(OFF_BB + 32 * 64 * 16 * 2 * 4);
constexpr size_t OFF_GLU = al256(OFF_WIN + (size_t)INC * DM * 2);
constexpr size_t OFF_WOUT = al256(OFF_GLU + (size_t)512 * 512 * 2);
constexpr size_t OFF_WQ = al256(OFF_WOUT + (size_t)DM * DM * 2);
constexpr size_t OFF_SUBK = al256(OFF_WQ + (size_t)2048 * DM * 2);
constexpr size_t OFF_SU = al256(OFF_SUBK + (size_t)16 * 128 * 128 * 2);
constexpr size_t OFF_SV = al256(OFF_SU + (size_t)NEXP * 4);
constexpr size_t OFF_UT = al256(OFF_SV + (size_t)NEXP * 4);
constexpr size_t OFF_VT = al256(OFF_UT + (size_t)NEXP * DM * 2);
constexpr size_t OFF_H = al256(OFF_VT + (size_t)NEXP * DM * 2);
constexpr size_t OFF_PROJ = al256(OFF_H + (size_t)NTOK * DM * 2);
constexpr size_t OFF_ORAW = al256(OFF_PROJ + (size_t)NTOK * INC * 2);
constexpr size_t OFF_YSSM = al256(OFF_ORAW + (size_t)NTOK * DHG * 4);
constexpr size_t OFF_A2 = al256(OFF_YSSM + (size_t)NTOK * DSS * 2);
constexpr size_t OFF_HG = al256(OFF_A2 + (size_t)NTOK * DM * 2);
constexpr size_t OFF_S5K = al256(OFF_HG + (size_t)4096 * 128 * 4);
constexpr size_t OFF_S5N = al256(OFF_S5K + (size_t)32 * 4096 * 2);
constexpr size_t OFF_S5M = al256(OFF_S5N + (size_t)32 * 128 * 256 * 2);
constexpr size_t OFF_S5L = al256(OFF_S5M + (size_t)32 * 256 * 128 * 2);
constexpr size_t WS_END = al256(OFF_S5L + (size_t)32 * 64 * 2 * 4);
constexpr size_t OFF_HQ = OFF_H, OFF_HK = OFF_H + (size_t)NTOK * DHG * 2, OFF_HKT = OFF_A2, OFF_HVT = OFF_A2 + (size_t)NTOK * DHG * 2;
constexpr size_t OFF_TOPL = OFF_ORAW;
constexpr size_t OFF_EXPS = OFF_ORAW + (size_t)NTOK * 16 * 16 * 4;

struct Params {
    const float *x, *c, *ada_w, *ada_b, *w_in, *hg_lb, *hg_nw, *a_re, *a_im, *log_dt, *b_re, *b_im, *c_re, *c_im, *dsk,
        *glu_w, *glu_b, *ssm_nw, *w_out, *ln1w, *ln1b, *w_q, *subk, *pu, *pv, *ln2w, *ln2b;
    float* out;
    char* ws;
};

DI bf16_t f2bf(float x) { unsigned u = __float_as_uint(x); u += 0x7fffu + ((u >> 16) & 1u); return (bf16_t)(u >> 16); }
DI float bf2f(bf16_t b) { return __uint_as_float(((unsigned)b) << 16); }
DI float bflo(unsigned w) { return __uint_as_float(w << 16); }
DI float bfhi(unsigned w) { return __uint_as_float(w & 0xffff0000u); }
typedef __bf16 hwbf16x2 __attribute__((ext_vector_type(2)));
DI unsigned pack2(float a, float b) { const f32x2 v = {a, b}; return __builtin_bit_cast(unsigned, __builtin_convertvector(v, hwbf16x2)); }
DI bf16x8 pack8(const f32x16& x, const int base) {
    u32x4 o; o.x = pack2(x[base], x[base + 1]); o.y = pack2(x[base + 2], x[base + 3]); o.z = pack2(x[base + 4], x[base + 5]); o.w = pack2(x[base + 6], x[base + 7]);
    return __builtin_bit_cast(bf16x8, o);
}
DI float sigmoidf_(float x) { return 1.0f / (1.0f + __expf(-x)); }
DI float siluf_(float x) { return x * sigmoidf_(x); }
DI float geluf_(float x) { return 0.5f * x * (1.0f + erff(x * 0.70710678118654752f)); }
DI float gelu_as(float v) {
    const float t = __builtin_amdgcn_rcpf(fabsf(v) * 0.2316418882f + 1.0f);
    float q = t * 0.5307027145f + (-0.7265760135f); q = q * t + 0.7107068705f; q = q * t + (-0.142248368f); q = q * t + 0.127414796f; q = q * t;
    const float m = v * (q * __builtin_amdgcn_exp2f(v * v * (-0.72134752044f)));
    return v < 0.f ? m : v - m;
}

template <int MT, int NT_, int WM, int WN, class Epi>
DI void gemm_block(const bf16_t* __restrict__ A, int lda, const bf16_t* __restrict__ Bt, int ldb, int K, char* smem, Epi epi) {
    constexpr int BM = WM * MT * 32, BN = WN * NT_ * 32, LS = 72;
    static_assert(WM * WN == 8, "8 waves");
    bf16_t* As = (bf16_t*)smem;
    bf16_t* Bs = As + BM * LS;
    const int tid = threadIdx.x, lane = tid & 63, wid = tid >> 6, r = lane & 31, h = lane >> 5;
    const int wm = wid / WN, wn = wid % WN;
    constexpr int PA = BM * 8 / NTH, PB = BN * 8 / NTH;
    u32x4 ra[PA], rb[PB];
    f32x16 acc[MT][NT_];
#pragma unroll
    for (int mi = 0; mi < MT; ++mi)
#pragma unroll
        for (int ni = 0; ni < NT_; ++ni)
#pragma unroll
            for (int i = 0; i < 16; ++i) acc[mi][ni][i] = 0.f;
#define GEMM_GLOAD(kt_) { \
    _Pragma("unroll") for (int q = 0; q < PA; ++q) { const int idx = tid + q * NTH, row = idx >> 3, ch = idx & 7; ra[q] = *(const u32x4*)(A + (size_t)row * lda + (kt_) * 64 + ch * 8); } \
    _Pragma("unroll") for (int q = 0; q < PB; ++q) { const int idx = tid + q * NTH, row = idx >> 3, ch = idx & 7; rb[q] = *(const u32x4*)(Bt + (size_t)row * ldb + (kt_) * 64 + ch * 8); } }
#define GEMM_LSTORE() { \
    _Pragma("unroll") for (int q = 0; q < PA; ++q) { const int idx = tid + q * NTH, row = idx >> 3, ch = idx & 7; *(u32x4*)(As + row * LS + ch * 8) = ra[q]; } \
    _Pragma("unroll") for (int q = 0; q < PB; ++q) { const int idx = tid + q * NTH, row = idx >> 3, ch = idx & 7; *(u32x4*)(Bs + row * LS + ch * 8) = rb[q]; } }
    GEMM_GLOAD(0); GEMM_LSTORE(); __syncthreads();
    const int nk = K / 64;
    for (int kt = 0; kt < nk; ++kt) {
        if (kt + 1 < nk) GEMM_GLOAD(kt + 1);
#pragma unroll
        for (int ks = 0; ks < 4; ++ks) {
            bf16x8 a[MT], b[NT_];
#pragma unroll
            for (int mi = 0; mi < MT; ++mi) a[mi] = *(const bf16x8*)(As + (wm * MT * 32 + mi * 32 + r) * LS + ks * 16 + h * 8);
#pragma unroll
            for (int ni = 0; ni < NT_; ++ni) b[ni] = *(const bf16x8*)(Bs + (wn * NT_ * 32 + ni * 32 + r) * LS + ks * 16 + h * 8);
#pragma unroll
            for (int mi = 0; mi < MT; ++mi)
#pragma unroll
                for (int ni = 0; ni < NT_; ++ni) acc[mi][ni] = __builtin_amdgcn_mfma_f32_32x32x16_bf16(a[mi], b[ni], acc[mi][ni], 0, 0, 0);
        }
        __syncthreads();
        if (kt + 1 < nk) { GEMM_LSTORE(); __syncthreads(); }
    }
#pragma unroll
    for (int mi = 0; mi < MT; ++mi)
#pragma unroll
        for (int ni = 0; ni < NT_; ++ni)
#pragma unroll
            for (int i = 0; i < 16; ++i) epi(wm * MT * 32 + mi * 32 + (i & 3) + 8 * (i >> 2) + 4 * h, wn * NT_ * 32 + ni * 32 + r, acc[mi][ni][i]);
}

DI void prep_mod_item(const Params& p, int item, char* smem) {
    float* cond = (float*)smem;
    const int tid = threadIdx.x;
    for (int i = tid; i < NB * DM; i += NTH) cond[i] = siluf_(p.c[i]);
    __syncthreads();
    const int b = tid >> 5, col = item * 32 + (tid & 31);
    float acc = 0.f;
    const float* w = p.ada_w + col;
    const float* cb = cond + b * DM;
#pragma unroll 8
    for (int k = 0; k < DM; ++k) acc += cb[k] * w[(size_t)k * 6144];
    ((float*)(p.ws + OFF_MOD))[b * 6144 + col] = acc + p.ada_b[col];
    __syncthreads();
}
DI void prep_s5_gemm_item(const Params& p, int g, char* smem) {
    f32x2* pw = (f32x2*)smem;
    f32x2* bbL = pw + 17 * 64;
    f32x2* cL = bbL + 64 * 16;
    const int tid = threadIdx.x;
    const float dt = expf(p.log_dt[g]);
#pragma unroll 1
    for (int idx = tid; idx < 17 * 64; idx += NTH) {
        const int j = idx >> 6, pp = idx & 63;
        const float ar = p.a_re[g * 64 + pp], ai = p.a_im[g * 64 + pp];
        const float mag = expf(ar * dt * (float)j), ang = ai * dt * (float)j;
        pw[idx] = (f32x2){mag * cosf(ang), mag * sinf(ang)};
    }
    for (int idx = tid; idx < 16 * 64; idx += NTH) { const int i = idx >> 6, pp = idx & 63; cL[idx] = (f32x2){p.c_re[(g * 16 + i) * 64 + pp], p.c_im[(g * 16 + i) * 64 + pp]}; }
    __syncthreads();
    for (int idx = tid; idx < 64 * 16; idx += NTH) {
        const int pp = idx >> 4, i = idx & 15;
        const float ar = p.a_re[g * 64 + pp], ai = p.a_im[g * 64 + pp];
        const f32x2 lam = pw[64 + pp];
        const float den = ar * ar + ai * ai, nr = lam.x - 1.0f, ni = lam.y;
        const float zr = (nr * ar + ni * ai) / den, zi = (ni * ar - nr * ai) / den;
        const float br = p.b_re[(g * 64 + pp) * 16 + i], bi = p.b_im[(g * 64 + pp) * 16 + i];
        bbL[idx] = (f32x2){zr * br - zi * bi, zr * bi + zi * br};
    }
    __syncthreads();
    bf16_t* NBg = (bf16_t*)(p.ws + OFF_S5N) + (size_t)g * 128 * 256;
#pragma unroll 1
    for (int ch = tid; ch < 128 * 256 / 8; ch += NTH) {
        const int pq = ch >> 5, t = (ch >> 1) & 15, i0 = (ch & 1) * 8, pp = pq & 63;
        const f32x2 w = pw[(15 - t) * 64 + pp];
        float v[8];
#pragma unroll
        for (int e = 0; e < 8; ++e) { const f32x2 bb = bbL[pp * 16 + i0 + e]; v[e] = pq < 64 ? (w.x * bb.x - w.y * bb.y) : (w.x * bb.y + w.y * bb.x); }
        u32x4 o; o.x = pack2(v[0], v[1]); o.y = pack2(v[2], v[3]); o.z = pack2(v[4], v[5]); o.w = pack2(v[6], v[7]);
        *(u32x4*)(NBg + (size_t)pq * 256 + t * 16 + i0) = o;
    }
    bf16_t* MBg = (bf16_t*)(p.ws + OFF_S5M) + (size_t)g * 256 * 128;
#pragma unroll 1
    for (int ch = tid; ch < 256 * 128 / 8; ch += NTH) {
        const int ti = ch >> 4, p0 = (ch & 15) * 8, tq = ti >> 4, iq = ti & 15;
        float v[8];
#pragma unroll
        for (int e = 0; e < 8; ++e) {
            const int pq = p0 + e, pp = pq & 63;
            const f32x2 c = cL[iq * 64 + pp], w = pw[(tq + 1) * 64 + pp];
            v[e] = pq < 64 ? (c.x * w.x - c.y * w.y) : -(c.x * w.y + c.y * w.x);
        }
        u32x4 o; o.x = pack2(v[0], v[1]); o.y = pack2(v[2], v[3]); o.z = pack2(v[4], v[5]); o.w = pack2(v[6], v[7]);
        *(u32x4*)(MBg + (size_t)ti * 128 + p0) = o;
    }
    bf16_t* KTg = (bf16_t*)(p.ws + OFF_S5K) + (size_t)g * 4096;
#pragma unroll 1
    for (int idx = tid; idx < 4096; idx += NTH) {
        const int lag = idx >> 8, iq = (idx >> 4) & 15, i = idx & 15;
        float acc = (lag == 0 && iq == i) ? p.dsk[g * 16 + iq] : 0.f;
#pragma unroll 4
        for (int pp = 0; pp < 64; ++pp) {
            const f32x2 c = cL[iq * 64 + pp], w = pw[lag * 64 + pp], bb = bbL[pp * 16 + i];
            const float mr = c.x * w.x - c.y * w.y, mi_ = c.x * w.y + c.y * w.x;
            acc += mr * bb.x - mi_ * bb.y;
        }
        KTg[idx] = f2bf(acc);
    }
    if (tid < 64) { float* L = (float*)(p.ws + OFF_S5L) + (g * 64 + tid) * 2; const f32x2 w = pw[16 * 64 + tid]; L[0] = w.x; L[1] = w.y; }
    __syncthreads();
}
DI void prep_s5_item(const Params& p, int g) {
    const int tid = threadIdx.x;
    if (tid < SSP) {
        const int pi = g * SSP + tid;
        const float dt = expf(p.log_dt[g]);
        const float ar = p.a_re[pi], ai = p.a_im[pi];
        const float mag = expf(ar * dt);
        const float lr = mag * cosf(ai * dt), li = mag * sinf(ai * dt);
        const float den = ar * ar + ai * ai, nr = lr - 1.0f, ni = li;
        const float zr = (nr * ar + ni * ai) / den, zi = (ni * ar - nr * ai) / den;
        float* lam = (float*)(p.ws + OFF_LAM) + pi * 2;
        lam[0] = lr; lam[1] = li;
        float* bb = (float*)(p.ws + OFF_BB) + (size_t)pi * 32;
        for (int i = 0; i < SSC; ++i) {
            const float br = p.b_re[pi * SSC + i], bi = p.b_im[pi * SSC + i];
            bb[i * 2] = zr * br - zi * bi; bb[i * 2 + 1] = zr * bi + zi * br;
        }
    }
}
DI void prep_transpose_tile(const float* __restrict__ W, bf16_t* __restrict__ Wt, int K, int N, int kt, int nt, char* smem) {
    float* tile = (float*)smem;
    const int tid = threadIdx.x;
#pragma unroll
    for (int q = 0; q < 2; ++q) {
        const int kk = (tid >> 4) + q * 32, c4 = (tid & 15) * 4;
        const float4 v = *(const float4*)(W + (size_t)(kt * 64 + kk) * N + nt * 64 + c4);
        tile[kk * 65 + c4] = v.x; tile[kk * 65 + c4 + 1] = v.y; tile[kk * 65 + c4 + 2] = v.z; tile[kk * 65 + c4 + 3] = v.w;
    }
    __syncthreads();
    const int n = tid >> 3, kc = tid & 7;
    uint4 o;
    o.x = pack2(tile[(kc * 8 + 0) * 65 + n], tile[(kc * 8 + 1) * 65 + n]);
    o.y = pack2(tile[(kc * 8 + 2) * 65 + n], tile[(kc * 8 + 3) * 65 + n]);
    o.z = pack2(tile[(kc * 8 + 4) * 65 + n], tile[(kc * 8 + 5) * 65 + n]);
    o.w = pack2(tile[(kc * 8 + 6) * 65 + n], tile[(kc * 8 + 7) * 65 + n]);
    *(uint4*)(Wt + (size_t)(nt * 64 + n) * K + kt * 64 + kc * 8) = o;
    __syncthreads();
}
DI void cvt_bf16_stream(const float* __restrict__ src, bf16_t* __restrict__ dst, size_t n8, int bid, int nb) {
    for (size_t i = (size_t)bid * NTH + threadIdx.x; i < n8; i += (size_t)nb * NTH) {
        const float4 a = *(const float4*)(src + i * 8), b = *(const float4*)(src + i * 8 + 4);
        uint4 o; o.x = pack2(a.x, a.y); o.y = pack2(a.z, a.w); o.z = pack2(b.x, b.y); o.w = pack2(b.z, b.w);
        *(uint4*)(dst + i * 8) = o;
    }
}
DI void cvt_fp8_rows(const float* __restrict__ src, unsigned char* __restrict__ dst, float* __restrict__ inv, int bid, int nb) {
    const int lane = threadIdx.x & 63, wid = threadIdx.x >> 6;
    for (int row = bid * 8 + wid; row < NEXP; row += nb * 8) {
        const float* sp = src + (size_t)row * DM + lane * 16;
        const f32x4 a = *(const f32x4*)sp, b = *(const f32x4*)(sp + 4), c = *(const f32x4*)(sp + 8), d = *(const f32x4*)(sp + 12);
        float m = fmaxf(fmaxf(fmaxf(fabsf(a.x), fabsf(a.y)), fmaxf(fabsf(a.z), fabsf(a.w))), fmaxf(fmaxf(fabsf(b.x), fabsf(b.y)), fmaxf(fabsf(b.z), fabsf(b.w))));
        m = fmaxf(m, fmaxf(fmaxf(fmaxf(fabsf(c.x), fabsf(c.y)), fmaxf(fabsf(c.z), fabsf(c.w))), fmaxf(fmaxf(fabsf(d.x), fabsf(d.y)), fmaxf(fabsf(d.z), fabsf(d.w)))));
#pragma unroll
        for (int s = 1; s < 64; s <<= 1) m = fmaxf(m, __shfl_xor(m, s));
        float sc = 1.f, isc = 1.f;
        if (m > 1e-30f) {
            int k = (int)floorf(log2f(448.0f / m));
            k = k < -60 ? -60 : (k > 60 ? 60 : k);
            sc = ldexpf(1.0f, k); isc = ldexpf(1.0f, -k);
            if (m * sc > 448.0f) { sc *= 0.5f; isc *= 2.0f; }
        }
        u32x4 o;
        int w;
        w = __builtin_amdgcn_cvt_pk_fp8_f32(a.x * sc, a.y * sc, 0, false); w = __builtin_amdgcn_cvt_pk_fp8_f32(a.z * sc, a.w * sc, w, true); o.x = (unsigned)w;
        w = __builtin_amdgcn_cvt_pk_fp8_f32(b.x * sc, b.y * sc, 0, false); w = __builtin_amdgcn_cvt_pk_fp8_f32(b.z * sc, b.w * sc, w, true); o.y = (unsigned)w;
        w = __builtin_amdgcn_cvt_pk_fp8_f32(c.x * sc, c.y * sc, 0, false); w = __builtin_amdgcn_cvt_pk_fp8_f32(c.z * sc, c.w * sc, w, true); o.z = (unsigned)w;
        w = __builtin_amdgcn_cvt_pk_fp8_f32(d.x * sc, d.y * sc, 0, false); w = __builtin_amdgcn_cvt_pk_fp8_f32(d.z * sc, d.w * sc, w, true); o.w = (unsigned)w;
        *(u32x4*)(dst + (size_t)row * DM + lane * 16) = o;
        if (lane == 0) inv[row] = isc;
    }
}
DI void phase_prep(const Params& p, int bid, int nb, char* smem) {
    constexpr int N_MOD = 192, N_LB = 1, N_S5 = 32, T_WIN = 16 * 40, T_GLU = 8 * 8, T_WOUT = 16 * 16, T_WQ = 16 * 32;
    constexpr int I_LB = N_MOD, I_S5 = I_LB + N_LB, I_WIN = I_S5 + N_S5, I_GLU = I_WIN + T_WIN, I_WOUT = I_GLU + T_GLU, I_WQ = I_WOUT + T_WOUT, I_END = I_WQ + T_WQ;
    for (int it = bid; it < I_END; it += nb) {
        if (it < N_MOD) prep_mod_item(p, it, smem);
        else if (it < I_S5) {
            const int j = threadIdx.x;
            const float a0 = p.hg_lb[j], a1 = p.hg_lb[512 + j], m = fmaxf(a0, a1);
            const float e0 = expf(a0 - m), e1 = expf(a1 - m);
            ((float*)(p.ws + OFF_LB))[j] = e0 / (e0 + e1);
        } else if (it < I_WIN) { prep_s5_item(p, it - I_S5); prep_s5_gemm_item(p, it - I_S5, smem); }
        else if (it < I_GLU) { const int t = it - I_WIN; prep_transpose_tile(p.w_in, (bf16_t*)(p.ws + OFF_WIN), DM, INC, t / 40, t % 40, smem); }
        else if (it < I_WOUT) { const int t = it - I_GLU; prep_transpose_tile(p.glu_w, (bf16_t*)(p.ws + OFF_GLU), 512, 512, t / 8, t % 8, smem); }
        else if (it < I_WQ) { const int t = it - I_WOUT; prep_transpose_tile(p.w_out, (bf16_t*)(p.ws + OFF_WOUT), DM, DM, t / 16, t % 16, smem); }
        else { const int t = it - I_WQ; prep_transpose_tile(p.w_q, (bf16_t*)(p.ws + OFF_WQ), DM, 2048, t / 32, t % 32, smem); }
    }
    cvt_bf16_stream(p.subk, (bf16_t*)(p.ws + OFF_SUBK), (size_t)16 * 128 * 128 / 8, bid, nb);
    cvt_fp8_rows(p.pu, (unsigned char*)(p.ws + OFF_UT), (float*)(p.ws + OFF_SU), bid, nb);
    cvt_fp8_rows(p.pv, (unsigned char*)(p.ws + OFF_VT), (float*)(p.ws + OFF_SV), bid, nb);
}

DI void phase_h(const Params& p, int bid, int nb) {
    const float* mod = (const float*)(p.ws + OFF_MOD);
    bf16_t* H = (bf16_t*)(p.ws + OFF_H);
    const size_t n8 = (size_t)NTOK * DM / 8;
    for (size_t i = (size_t)bid * NTH + threadIdx.x; i < n8; i += (size_t)nb * NTH) {
        const int row = (int)(i >> 7), c0 = (int)(i & 127) * 8, b = row / SEQ;
        const float* sh = mod + b * 6144 + c0;
        const float* sc = sh + 1024;
        const float4 a = *(const float4*)(p.x + i * 8), bq = *(const float4*)(p.x + i * 8 + 4);
        const float4 s0 = *(const float4*)sc, s1 = *(const float4*)(sc + 4), h0 = *(const float4*)sh, h1 = *(const float4*)(sh + 4);
        uint4 o;
        o.x = pack2(a.x * (1.f + s0.x) + h0.x, a.y * (1.f + s0.y) + h0.y);
        o.y = pack2(a.z * (1.f + s0.z) + h0.z, a.w * (1.f + s0.w) + h0.w);
        o.z = pack2(bq.x * (1.f + s1.x) + h1.x, bq.y * (1.f + s1.y) + h1.y);
        o.w = pack2(bq.z * (1.f + s1.z) + h1.z, bq.w * (1.f + s1.w) + h1.w);
        *(uint4*)(H + i * 8) = o;
    }
}

DI void phase_proj(const Params& p, int bid, int nb, char* smem) {
    const bf16_t* H = (const bf16_t*)(p.ws + OFF_H);
    const bf16_t* W = (const bf16_t*)(p.ws + OFF_WIN);
    bf16_t* P = (bf16_t*)(p.ws + OFF_PROJ);
    constexpr int NTN = INC / 128, NTM = NTOK / 128;
    for (int t = bid; t < NTM * NTN; t += nb) {
        const int mt = t / NTN, nt = t % NTN;
        bf16_t* Pt = P + (size_t)mt * 128 * INC + nt * 128;
        const bool act = (nt < 4) || (nt >= 12 && nt < 16);
        gemm_block<2, 1, 2, 4>(H + (size_t)mt * 128 * DM, DM, W + (size_t)nt * 128 * DM, DM, DM, smem,
                               [&](int r, int c, float v) { Pt[(size_t)r * INC + c] = f2bf(act ? siluf_(v) : v); });
        __syncthreads();
    }
}

DI void hgrn_item(const Params& p, int item, char* smem) {
    const int vs = item & 7, hd = (item >> 3) & 3, b = item >> 5;
    const bf16_t* P = (const bf16_t*)(p.ws + OFF_PROJ);
    const float* lb = (const float*)(p.ws + OFF_LB) + hd * HDK;
    float* ORAW = (float*)(p.ws + OFF_ORAW);
    float* sq = (float*)smem;
    float* sf = sq + 32 * 128;
    float* sv = sf + 32 * 128;
    float* sp = sv + 32 * 16;
    const int tid = threadIdx.x, lane = tid & 63, wid = tid >> 6, kq = tid >> 4, v = tid & 15;
    float S0 = 0.f, S1 = 0.f, S2 = 0.f, S3 = 0.f;
    for (int t0 = 0; t0 < SEQ; t0 += 32) {
        for (int i = tid; i < 32 * 128; i += NTH) {
            const int t = i >> 7, k = i & 127;
            const bf16_t* row = P + (size_t)(b * SEQ + t0 + t) * INC + hd * HDK + k;
            sq[i] = bf2f(row[0]);
            const float l = lb[k];
            sf[i] = l + (1.0f - l) * sigmoidf_(bf2f(row[512]));
        }
        { const int t = tid >> 4; sv[tid] = bf2f(P[(size_t)(b * SEQ + t0 + t) * INC + 1024 + hd * HDK + vs * 16 + v]); }
        __syncthreads();
        for (int t = 0; t < 32; ++t) {
            const float4 f4 = *(const float4*)(sf + t * 128 + kq * 4), q4 = *(const float4*)(sq + t * 128 + kq * 4);
            const float vv = sv[t * 16 + v];
            S0 = f4.x * S0 + (1.0f - f4.x) * vv; S1 = f4.y * S1 + (1.0f - f4.y) * vv;
            S2 = f4.z * S2 + (1.0f - f4.z) * vv; S3 = f4.w * S3 + (1.0f - f4.w) * vv;
            float part = q4.x * S0 + q4.y * S1 + q4.z * S2 + q4.w * S3;
            part += __shfl_xor(part, 16); part += __shfl_xor(part, 32);
            if (lane < 16) sp[(t * 8 + wid) * 16 + v] = part;
        }
        __syncthreads();
        {
            const int t = tid >> 4;
            float o = 0.f;
#pragma unroll
            for (int w = 0; w < 8; ++w) o += sp[(t * 8 + w) * 16 + v];
            ORAW[(size_t)(b * SEQ + t0 + t) * DHG + hd * HDK + vs * 16 + v] = o;
        }
        __syncthreads();
    }
}
DI void s5_item(const Params& p, int item, char* smem) {
    const int oct = item & 3, b = item >> 2;
    const int tid = threadIdx.x, lane = tid & 63, wid = tid >> 6, g = oct * 8 + wid;
    const bf16_t* P = (const bf16_t*)(p.ws + OFF_PROJ);
    bf16_t* Y = (bf16_t*)(p.ws + OFF_YSSM);
    float* su = (float*)smem + wid * 64 * 16;
    const float* lam = (const float*)(p.ws + OFF_LAM) + (g * SSP + lane) * 2;
    const float lr = lam[0], li = lam[1];
    const float* bb = (const float*)(p.ws + OFF_BB) + (size_t)(g * SSP + lane) * 32;
    float bbr[16], bbi[16], cr[16], ci[16];
#pragma unroll
    for (int i = 0; i < 16; ++i) { bbr[i] = bb[2 * i]; bbi[i] = bb[2 * i + 1]; cr[i] = p.c_re[(g * SSC + i) * SSP + lane]; ci[i] = p.c_im[(g * SSC + i) * SSP + lane]; }
    const int ch = (lane >> 2) & 15;
    const float dch = p.dsk[g * SSC + ch];
    float xr = 0.f, xi = 0.f;
    for (int t0 = 0; t0 < SEQ; t0 += 64) {
        {
            const uint4* src = (const uint4*)(P + (size_t)(b * SEQ + t0 + lane) * INC + 2048 + g * SSC);
            const uint4 a = src[0], c = src[1];
            float* d = su + lane * 16;
            d[0] = bflo(a.x); d[1] = bfhi(a.x); d[2] = bflo(a.y); d[3] = bfhi(a.y); d[4] = bflo(a.z); d[5] = bfhi(a.z); d[6] = bflo(a.w); d[7] = bfhi(a.w);
            d[8] = bflo(c.x); d[9] = bfhi(c.x); d[10] = bflo(c.y); d[11] = bfhi(c.y); d[12] = bflo(c.z); d[13] = bfhi(c.z); d[14] = bflo(c.w); d[15] = bfhi(c.w);
        }
        __syncthreads();
        for (int t = 0; t < 64; ++t) {
            float u[16];
            const float4* us = (const float4*)(su + t * 16);
            const float4 u0 = us[0], u1 = us[1], u2 = us[2], u3 = us[3];
            u[0] = u0.x; u[1] = u0.y; u[2] = u0.z; u[3] = u0.w; u[4] = u1.x; u[5] = u1.y; u[6] = u1.z; u[7] = u1.w;
            u[8] = u2.x; u[9] = u2.y; u[10] = u2.z; u[11] = u2.w; u[12] = u3.x; u[13] = u3.y; u[14] = u3.z; u[15] = u3.w;
            float bur = 0.f, bui = 0.f;
#pragma unroll
            for (int i = 0; i < 16; ++i) { bur += bbr[i] * u[i]; bui += bbi[i] * u[i]; }
            const float nxr = lr * xr - li * xi + bur, nxi = lr * xi + li * xr + bui;
            xr = nxr; xi = nxi;
            float y[16];
#pragma unroll
            for (int i = 0; i < 16; ++i) y[i] = cr[i] * xr - ci[i] * xi;
            const bool b5 = lane & 32, b4 = lane & 16, b3 = lane & 8, b2 = lane & 4;
            float y8[8], y4[4], y2[2];
#pragma unroll
            for (int j = 0; j < 8; ++j) { const float keep = b5 ? y[8 + j] : y[j], send = b5 ? y[j] : y[8 + j]; y8[j] = keep + __shfl_xor(send, 32); }
#pragma unroll
            for (int j = 0; j < 4; ++j) { const float keep = b4 ? y8[4 + j] : y8[j], send = b4 ? y8[j] : y8[4 + j]; y4[j] = keep + __shfl_xor(send, 16); }
#pragma unroll
            for (int j = 0; j < 2; ++j) { const float keep = b3 ? y4[2 + j] : y4[j], send = b3 ? y4[j] : y4[2 + j]; y2[j] = keep + __shfl_xor(send, 8); }
            float y1;
            { const float keep = b2 ? y2[1] : y2[0], send = b2 ? y2[0] : y2[1]; y1 = keep + __shfl_xor(send, 4); }
            y1 += __shfl_xor(y1, 1); y1 += __shfl_xor(y1, 2);
            if ((lane & 3) == 0) {
                const float uu = su[t * 16 + ch];
                Y[(size_t)(b * SEQ + t0 + t) * DSS + g * SSC + ch] = f2bf(geluf_(y1 + dch * uu));
            }
        }
        __syncthreads();
    }
}
DI int crow(int i, int h) { return (i & 3) + 8 * (i >> 2) + 4 * h; }
template <int NJ>
DI void s5_gemm2_tile(const bf16x8 (&af)[16], const bf16_t* KTl, const bf16_t* Xin, const bf16_t* MBg, bf16_t* Yout, const int mi, const int r, const int h) {
    f32x16 y;
#pragma unroll
    for (int i = 0; i < 16; ++i) y[i] = 0.f;
    const int tsel = r >> 4, iq = r & 15;
#pragma unroll
    for (int ks = 0; ks <= 2 * NJ; ++ks) {
        const bf16x8 bk = *(const bf16x8*)(KTl + ((2 * NJ + tsel - ks) * 16 + iq) * 16 + 8 * h);
        y = __builtin_amdgcn_mfma_f32_32x32x16_bf16(af[ks], bk, y, 0, 0, 0);
    }
    {
        bf16x8 bk = *(const bf16x8*)(KTl + iq * 16 + 8 * h);
        if (tsel == 0) bk = (bf16x8){0, 0, 0, 0, 0, 0, 0, 0};
        y = __builtin_amdgcn_mfma_f32_32x32x16_bf16(af[2 * NJ + 1], bk, y, 0, 0, 0);
    }
#pragma unroll
    for (int ks = 0; ks < 8; ++ks) {
        const bf16x8 a = *(const bf16x8*)(Xin + (mi * 32 + r) * 136 + ks * 16 + 8 * h);
        const bf16x8 bm = *(const bf16x8*)(MBg + (size_t)(NJ * 32 + r) * 128 + ks * 16 + 8 * h);
        y = __builtin_amdgcn_mfma_f32_32x32x16_bf16(a, bm, y, 0, 0, 0);
    }
#pragma unroll
    for (int i = 0; i < 16; ++i) Yout[(size_t)((mi * 32 + crow(i, h)) * 16 + 2 * NJ + tsel) * DSS + iq] = f2bf(gelu_as(y[i]));
}
DI void s5_gemm_item(const Params& p, int b, int g, char* smem) {
    float* E = (float*)smem;
    bf16_t* Xin = (bf16_t*)(smem + 128 * 132 * 4);
    bf16_t* KTl = Xin + 128 * 136;
    const int tid = threadIdx.x, lane = tid & 63, wid = tid >> 6, r = lane & 31, h = lane >> 5;
    const int mi = wid >> 1, wh = wid & 1;
    const bf16_t* P = (const bf16_t*)(p.ws + OFF_PROJ);
    *(u32x4*)(KTl + tid * 8) = *(const u32x4*)((const bf16_t*)(p.ws + OFF_S5K) + (size_t)g * 4096 + tid * 8);
    bf16x8 af[16];
    {
        const bf16_t* ub = P + (size_t)(b * SEQ + (mi * 32 + r) * 16) * INC + 2048 + g * 16 + 8 * h;
#pragma unroll
        for (int ks = 0; ks < 16; ++ks) af[ks] = *(const bf16x8*)(ub + (size_t)ks * INC);
    }
    {
        f32x16 e0, e1;
#pragma unroll
        for (int i = 0; i < 16; ++i) { e0[i] = 0.f; e1[i] = 0.f; }
        const bf16_t* nb0 = (const bf16_t*)(p.ws + OFF_S5N) + ((size_t)g * 128 + wh * 64 + r) * 256 + 8 * h;
#pragma unroll
        for (int ks = 0; ks < 16; ++ks) {
            const bf16x8 b0 = *(const bf16x8*)(nb0 + ks * 16), b1 = *(const bf16x8*)(nb0 + 32 * 256 + ks * 16);
            e0 = __builtin_amdgcn_mfma_f32_32x32x16_bf16(af[ks], b0, e0, 0, 0, 0);
            e1 = __builtin_amdgcn_mfma_f32_32x32x16_bf16(af[ks], b1, e1, 0, 0, 0);
        }
#pragma unroll
        for (int i = 0; i < 16; ++i) { float* er = E + (mi * 32 + crow(i, h)) * 132 + wh * 64 + r; er[0] = e0[i]; er[32] = e1[i]; }
    }
    __syncthreads();
    if (wid == 0) {
        const float* L = (const float*)(p.ws + OFF_S5L) + (g * 64 + lane) * 2;
        const float lr = L[0], li = L[1];
        float xr = 0.f, xi = 0.f;
#pragma unroll 8
        for (int c = 0; c < 128; ++c) {
            const float er = E[c * 132 + lane], ei = E[c * 132 + 64 + lane];
            Xin[c * 136 + lane] = f2bf(xr); Xin[c * 136 + 64 + lane] = f2bf(xi);
            const float nr = lr * xr - li * xi + er, ni = lr * xi + li * xr + ei;
            xr = nr; xi = ni;
        }
    }
    __syncthreads();
    const bf16_t* MBg = (const bf16_t*)(p.ws + OFF_S5M) + (size_t)g * 256 * 128;
    bf16_t* Yout = (bf16_t*)(p.ws + OFF_YSSM) + (size_t)b * SEQ * DSS + g * 16;
    if (wh) {
        s5_gemm2_tile<1>(af, KTl, Xin, MBg, Yout, mi, r, h); s5_gemm2_tile<6>(af, KTl, Xin, MBg, Yout, mi, r, h);
        s5_gemm2_tile<3>(af, KTl, Xin, MBg, Yout, mi, r, h); s5_gemm2_tile<4>(af, KTl, Xin, MBg, Yout, mi, r, h);
    } else {
        s5_gemm2_tile<0>(af, KTl, Xin, MBg, Yout, mi, r, h); s5_gemm2_tile<7>(af, KTl, Xin, MBg, Yout, mi, r, h);
        s5_gemm2_tile<2>(af, KTl, Xin, MBg, Yout, mi, r, h); s5_gemm2_tile<5>(af, KTl, Xin, MBg, Yout, mi, r, h);
    }
    __syncthreads();
}
DI void phase_mix(const Params& p, int bid, int nb, char* smem) {
    for (int it = bid; it < 512; it += nb) { hgrn_item(p, it, smem); __syncthreads(); }
    if (nb == 256) {
        const int x = bid & 7, lb = bid >> 3;
        for (int q = lb; q < 64; q += 32) s5_gemm_item(p, q & 15, x * 4 + (q >> 4), smem);
    } else {
        for (int q = bid; q < 512; q += nb) s5_gemm_item(p, q & 15, q >> 4, smem);
    }
}

DI void phase_glu(const Params& p, int bid, int nb, char* smem) {
    const bf16_t* Y = (const bf16_t*)(p.ws + OFF_YSSM);
    const bf16_t* W = (const bf16_t*)(p.ws + OFF_GLU);
    float* Y2 = (float*)(p.ws + OFF_H);
    constexpr int NTN = 4, NTM = NTOK / 128;
    for (int t = bid; t < NTM * NTN; t += nb) {
        const int mt = t / NTN, nt = t % NTN;
        const bf16_t* Yt = Y + (size_t)mt * 128 * DSS + nt * 128;
        float* Ot = Y2 + (size_t)mt * 128 * DSS + nt * 128;
        const float* gb = p.glu_b + nt * 128;
        gemm_block<2, 1, 2, 4>(Y + (size_t)mt * 128 * DSS, DSS, W + (size_t)nt * 128 * 512, 512, 512, smem,
                               [&](int r, int c, float v) { const float y = bf2f(Yt[(size_t)r * DSS + c]); Ot[(size_t)r * DSS + c] = y * sigmoidf_(v + gb[c]); });
        __syncthreads();
    }
}
DI void phase_a2(const Params& p, int bid, int nb) {
    const float* ORAW = (const float*)(p.ws + OFF_ORAW);
    const float* Y2 = (const float*)(p.ws + OFF_H);
    const bf16_t* P = (const bf16_t*)(p.ws + OFF_PROJ);
    bf16_t* A2 = (bf16_t*)(p.ws + OFF_A2);
    const int lane = threadIdx.x & 63, wid = threadIdx.x >> 6;
    for (int tok = bid * 8 + wid; tok < NTOK; tok += nb * 8) {
        const int c0 = lane * 8;
        {
            const float4 a = *(const float4*)(ORAW + (size_t)tok * DHG + c0), b = *(const float4*)(ORAW + (size_t)tok * DHG + c0 + 4);
            float ss = a.x * a.x + a.y * a.y + a.z * a.z + a.w * a.w + b.x * b.x + b.y * b.y + b.z * b.z + b.w * b.w;
            ss += __shfl_xor(ss, 1); ss += __shfl_xor(ss, 2); ss += __shfl_xor(ss, 4); ss += __shfl_xor(ss, 8);
            const float rs = rsqrtf(ss * (1.0f / 128.0f) + RMS_EPS);
            const uint4 gq = *(const uint4*)(P + (size_t)tok * INC + 1536 + c0);
            const float4 w0 = *(const float4*)(p.hg_nw + c0), w1 = *(const float4*)(p.hg_nw + c0 + 4);
            uint4 o;
            o.x = pack2(a.x * rs * w0.x * bflo(gq.x), a.y * rs * w0.y * bfhi(gq.x));
            o.y = pack2(a.z * rs * w0.z * bflo(gq.y), a.w * rs * w0.w * bfhi(gq.y));
            o.z = pack2(b.x * rs * w1.x * bflo(gq.z), b.y * rs * w1.y * bfhi(gq.z));
            o.w = pack2(b.z * rs * w1.z * bflo(gq.w), b.w * rs * w1.w * bfhi(gq.w));
            *(uint4*)(A2 + (size_t)tok * DM + c0) = o;
        }
        {
            const float4 a = *(const float4*)(Y2 + (size_t)tok * DSS + c0), b = *(const float4*)(Y2 + (size_t)tok * DSS + c0 + 4);
            float ss = a.x * a.x + a.y * a.y + a.z * a.z + a.w * a.w + b.x * b.x + b.y * b.y + b.z * b.z + b.w * b.w;
#pragma unroll
            for (int m = 1; m < 64; m <<= 1) ss += __shfl_xor(ss, m);
            const float rs = rsqrtf(ss * (1.0f / 512.0f) + RMS_EPS);
            const float4 w0 = *(const float4*)(p.ssm_nw + c0), w1 = *(const float4*)(p.ssm_nw + c0 + 4);
            uint4 o;
            o.x = pack2(a.x * rs * w0.x, a.y * rs * w0.y); o.y = pack2(a.z * rs * w0.z, a.w * rs * w0.w);
            o.z = pack2(b.x * rs * w1.x, b.y * rs * w1.y); o.w = pack2(b.z * rs * w1.z, b.w * rs * w1.w);
            *(uint4*)(A2 + (size_t)tok * DM + 512 + c0) = o;
        }
    }
}

DI void phase_outproj(const Params& p, int bid, int nb, char* smem) {
    const bf16_t* A2 = (const bf16_t*)(p.ws + OFF_A2);
    const bf16_t* W = (const bf16_t*)(p.ws + OFF_WOUT);
    const float* mod = (const float*)(p.ws + OFF_MOD);
    constexpr int NTN = 8, NTM = NTOK / 128;
    for (int t = bid; t < NTM * NTN; t += nb) {
        const int mt = t / NTN, nt = t % NTN, b = (mt * 128) / SEQ;
        const float* xt = p.x + (size_t)mt * 128 * DM + nt * 128;
        float* ot = p.out + (size_t)mt * 128 * DM + nt * 128;
        const float* g1 = mod + b * 6144 + 2048 + nt * 128;
        gemm_block<2, 1, 2, 4>(A2 + (size_t)mt * 128 * DM, DM, W + (size_t)nt * 128 * DM, DM, DM, smem,
                               [&](int r, int c, float v) { ot[(size_t)r * DM + c] = DEEP_ALPHA * xt[(size_t)r * DM + c] + (1.0f + g1[c]) * v; });
        __syncthreads();
    }
}
DI void phase_ln1(const Params& p, int bid, int nb) {
    const float* mod = (const float*)(p.ws + OFF_MOD);
    bf16_t* H2 = (bf16_t*)(p.ws + OFF_H);
    const int lane = threadIdx.x & 63, wid = threadIdx.x >> 6;
    for (int tok = bid * 8 + wid; tok < NTOK; tok += nb * 8) {
        const int b = tok / SEQ;
        float* row = p.out + (size_t)tok * DM;
        float4 v[4];
        float s = 0.f;
#pragma unroll
        for (int j = 0; j < 4; ++j) { v[j] = *(const float4*)(row + j * 256 + lane * 4); s += v[j].x + v[j].y + v[j].z + v[j].w; }
#pragma unroll
        for (int m = 1; m < 64; m <<= 1) s += __shfl_xor(s, m);
        const float mu = s * (1.0f / 1024.0f);
        float q = 0.f;
#pragma unroll
        for (int j = 0; j < 4; ++j) { const float a = v[j].x - mu, bb = v[j].y - mu, cc = v[j].z - mu, d = v[j].w - mu; q += a * a + bb * bb + cc * cc + d * d; }
#pragma unroll
        for (int m = 1; m < 64; m <<= 1) q += __shfl_xor(q, m);
        const float rstd = rsqrtf(q * (1.0f / 1024.0f) + LN_EPS);
        const float* sh2 = mod + b * 6144 + 3072;
        const float* sc2 = mod + b * 6144 + 4096;
#pragma unroll
        for (int j = 0; j < 4; ++j) {
            const int c = j * 256 + lane * 4;
            const float4 w = *(const float4*)(p.ln1w + c), bi = *(const float4*)(p.ln1b + c), sc = *(const float4*)(sc2 + c), sh = *(const float4*)(sh2 + c);
            float4 o;
            o.x = (v[j].x - mu) * rstd * w.x + bi.x; o.y = (v[j].y - mu) * rstd * w.y + bi.y; o.z = (v[j].z - mu) * rstd * w.z + bi.z; o.w = (v[j].w - mu) * rstd * w.w + bi.w;
            *(float4*)(row + c) = o;
            uint2 hh; hh.x = pack2(o.x * (1.f + sc.x) + sh.x, o.y * (1.f + sc.y) + sh.y); hh.y = pack2(o.z * (1.f + sc.z) + sh.z, o.w * (1.f + sc.w) + sh.w);
            *(uint2*)(H2 + (size_t)tok * DM + c) = hh;
        }
    }
}

DI void phase_q(const Params& p, int bid, int nb, char* smem) {
    const bf16_t* H2 = (const bf16_t*)(p.ws + OFF_H);
    const bf16_t* W = (const bf16_t*)(p.ws + OFF_WQ);
    bf16_t* Q = (bf16_t*)(p.ws + OFF_PROJ);
    constexpr int NTN = 16, NTM = NTOK / 128;
    for (int t = bid; t < NTM * NTN; t += nb) {
        const int mt = t / NTN, nt = t % NTN;
        bf16_t* Qt = Q + (size_t)mt * 128 * 2048 + nt * 128;
        gemm_block<2, 1, 2, 4>(H2 + (size_t)mt * 128 * DM, DM, W + (size_t)nt * 128 * DM, DM, DM, smem,
                               [&](int r, int c, float v) { Qt[(size_t)r * 2048 + c] = f2bf(v); });
        __syncthreads();
    }
}
DI void phase_topk(const Params& p, int bid, int nb, char* smem) {
    const bf16_t* Q = (const bf16_t*)(p.ws + OFF_PROJ);
    const bf16_t* SK = (const bf16_t*)(p.ws + OFF_SUBK);
    unsigned* TOPL = (unsigned*)(p.ws + OFF_TOPL);
    float* sc = (float*)(smem + 36864);
    constexpr int NTM = NTOK / 128;
    for (int t = bid; t < NTM * 16; t += nb) {
        const int mt = t >> 4, hp = t & 15;
        gemm_block<2, 1, 2, 4>(Q + (size_t)mt * 128 * 2048 + hp * 128, 2048, SK + (size_t)hp * 128 * 128, 128, 128, smem,
                               [&](int r, int c, float v) { sc[r * 129 + c] = v; });
        __syncthreads();
        if (threadIdx.x < 128) {
            const int r = threadIdx.x;
            float tk[16];
#pragma unroll
            for (int j = 0; j < 16; ++j) tk[j] = -3.0e38f;
            for (int n = 0; n < 128; ++n) {
                float xv = __uint_as_float((__float_as_uint(sc[r * 129 + n]) & ~0x7fu) | (unsigned)n);
#pragma unroll
                for (int j = 0; j < 16; ++j) { const float hi = fmaxf(tk[j], xv), lo = fminf(tk[j], xv); tk[j] = hi; xv = lo; }
            }
            uint4* dst = (uint4*)(TOPL + ((size_t)(mt * 128 + r) * 16 + hp) * 16);
            dst[0] = make_uint4(__float_as_uint(tk[0]), __float_as_uint(tk[1]), __float_as_uint(tk[2]), __float_as_uint(tk[3]));
            dst[1] = make_uint4(__float_as_uint(tk[4]), __float_as_uint(tk[5]), __float_as_uint(tk[6]), __float_as_uint(tk[7]));
            dst[2] = make_uint4(__float_as_uint(tk[8]), __float_as_uint(tk[9]), __float_as_uint(tk[10]), __float_as_uint(tk[11]));
            dst[3] = make_uint4(__float_as_uint(tk[12]), __float_as_uint(tk[13]), __float_as_uint(tk[14]), __float_as_uint(tk[15]));
        }
        __syncthreads();
    }
}
DI void phase_combine(const Params& p, int bid, int nb) {
    const unsigned* TOPL = (const unsigned*)(p.ws + OFF_TOPL);
    uint2* EX = (uint2*)(p.ws + OFF_EXPS);
    const float* SU = (const float*)(p.ws + OFF_SU);
    const float* SV = (const float*)(p.ws + OFF_SV);
    for (int i = bid * NTH + threadIdx.x; i < NTOK * PHEADS; i += nb * NTH) {
        const unsigned* l1 = TOPL + (size_t)i * 32;
        const unsigned* l2 = l1 + 16;
        float s2[16];
        {
            const uint4 a = ((const uint4*)l2)[0], b = ((const uint4*)l2)[1], c = ((const uint4*)l2)[2], d = ((const uint4*)l2)[3];
            const unsigned w[16] = {a.x, a.y, a.z, a.w, b.x, b.y, b.z, b.w, c.x, c.y, c.z, c.w, d.x, d.y, d.z, d.w};
#pragma unroll
            for (int j = 0; j < 16; ++j) s2[j] = __uint_as_float(w[j] & ~0x7fu);
        }
        float tk[16];
#pragma unroll
        for (int j = 0; j < 16; ++j) tk[j] = -3.0e38f;
        for (int a = 0; a < 16; ++a) {
            const float s1 = __uint_as_float(l1[a] & ~0x7fu);
#pragma unroll
            for (int b = 0; b < 16; ++b) {
                float xv = __uint_as_float((__float_as_uint(s1 + s2[b]) & ~0xffu) | (unsigned)(a * 16 + b));
#pragma unroll
                for (int j = 0; j < 16; ++j) { const float hi = fmaxf(tk[j], xv), lo = fminf(tk[j], xv); tk[j] = hi; xv = lo; }
            }
        }
        float e[16], sum = 0.f;
        const float mx = __uint_as_float(__float_as_uint(tk[0]) & ~0xffu);
#pragma unroll
        for (int j = 0; j < 16; ++j) { e[j] = __expf(__uint_as_float(__float_as_uint(tk[j]) & ~0xffu) - mx); sum += e[j]; }
        const float inv = 1.0f / sum;
#pragma unroll
        for (int j = 0; j < 16; ++j) {
            const unsigned ab = __float_as_uint(tk[j]) & 0xffu;
            const unsigned i1 = l1[ab >> 4] & 0x7fu, i2 = l2[ab & 15] & 0x7fu;
            const unsigned eid = i1 * 128u + i2;
            EX[(size_t)i * 16 + j] = make_uint2(eid | (((__float_as_uint(SU[eid]) >> 23) & 0xffu) << 16), __float_as_uint(e[j] * inv * SV[eid]));
        }
    }
}

DI float dot16_fp8(const u32x4 w, const f32x2 (&h)[8]) {
    f32x2 acc = __builtin_amdgcn_cvt_pk_f32_fp8((int)w.x, false) * h[0];
    acc += __builtin_amdgcn_cvt_pk_f32_fp8((int)w.x, true) * h[1];
    acc += __builtin_amdgcn_cvt_pk_f32_fp8((int)w.y, false) * h[2];
    acc += __builtin_amdgcn_cvt_pk_f32_fp8((int)w.y, true) * h[3];
    acc += __builtin_amdgcn_cvt_pk_f32_fp8((int)w.z, false) * h[4];
    acc += __builtin_amdgcn_cvt_pk_f32_fp8((int)w.z, true) * h[5];
    acc += __builtin_amdgcn_cvt_pk_f32_fp8((int)w.w, false) * h[6];
    acc += __builtin_amdgcn_cvt_pk_f32_fp8((int)w.w, true) * h[7];
    return acc.x + acc.y;
}
DI void axpy16_fp8(const float a, const u32x4 w, f32x2 (&o)[8]) {
    const f32x2 aa = {a, a};
    o[0] += aa * __builtin_amdgcn_cvt_pk_f32_fp8((int)w.x, false); o[1] += aa * __builtin_amdgcn_cvt_pk_f32_fp8((int)w.x, true);
    o[2] += aa * __builtin_amdgcn_cvt_pk_f32_fp8((int)w.y, false); o[3] += aa * __builtin_amdgcn_cvt_pk_f32_fp8((int)w.y, true);
    o[4] += aa * __builtin_amdgcn_cvt_pk_f32_fp8((int)w.z, false); o[5] += aa * __builtin_amdgcn_cvt_pk_f32_fp8((int)w.z, true);
    o[6] += aa * __builtin_amdgcn_cvt_pk_f32_fp8((int)w.w, false); o[7] += aa * __builtin_amdgcn_cvt_pk_f32_fp8((int)w.w, true);
}
DI float butterfly64(float (&pz)[64], const int lane) {
    const bool b5 = lane & 32, b4 = lane & 16, b3 = lane & 8, b2 = lane & 4, b1 = lane & 2, b0 = lane & 1;
    float q32[32], q16[16], q8[8], q4[4], q2[2];
#pragma unroll
    for (int j = 0; j < 32; ++j) q32[j] = (b5 ? pz[32 + j] : pz[j]) + __shfl_xor(b5 ? pz[j] : pz[32 + j], 32);
#pragma unroll
    for (int j = 0; j < 16; ++j) q16[j] = (b4 ? q32[16 + j] : q32[j]) + __shfl_xor(b4 ? q32[j] : q32[16 + j], 16);
#pragma unroll
    for (int j = 0; j < 8; ++j) q8[j] = (b3 ? q16[8 + j] : q16[j]) + __shfl_xor(b3 ? q16[j] : q16[8 + j], 8);
#pragma unroll
    for (int j = 0; j < 4; ++j) q4[j] = (b2 ? q8[4 + j] : q8[j]) + __shfl_xor(b2 ? q8[j] : q8[4 + j], 4);
#pragma unroll
    for (int j = 0; j < 2; ++j) q2[j] = (b1 ? q4[2 + j] : q4[j]) + __shfl_xor(b1 ? q4[j] : q4[2 + j], 2);
    return (b0 ? q2[1] : q2[0]) + __shfl_xor(b0 ? q2[0] : q2[1], 1);
}
DI void phase_gather(const Params& p, int bid, int nb) {
    const float* mod = (const float*)(p.ws + OFF_MOD);
    const uint2* EX = (const uint2*)(p.ws + OFF_EXPS);
    const unsigned char* UT = (const unsigned char*)(p.ws + OFF_UT);
    const unsigned char* VT = (const unsigned char*)(p.ws + OFF_VT);
    const int lane = threadIdx.x & 63, wid = threadIdx.x >> 6;
    for (int tok = bid * 8 + wid; tok < NTOK; tok += nb * 8) {
        const int b = tok / SEQ, c0 = lane * 16;
        float* row = p.out + (size_t)tok * DM + c0;
        const float* sh2 = mod + b * 6144 + 3072 + c0;
        const float* sc2 = mod + b * 6144 + 4096 + c0;
        const float* g2 = mod + b * 6144 + 5120 + c0;
        f32x2 x1[8], h2[8], acc[8];
#pragma unroll
        for (int q = 0; q < 4; ++q) {
            const f32x4 xv = *(const f32x4*)(row + q * 4), sc = *(const f32x4*)(sc2 + q * 4), sh = *(const f32x4*)(sh2 + q * 4);
            x1[2 * q] = (f32x2){xv.x, xv.y}; x1[2 * q + 1] = (f32x2){xv.z, xv.w};
            h2[2 * q] = (f32x2){xv.x * (1.f + sc.x) + sh.x, xv.y * (1.f + sc.y) + sh.y};
            h2[2 * q + 1] = (f32x2){xv.z * (1.f + sc.z) + sh.z, xv.w * (1.f + sc.w) + sh.w};
        }
#pragma unroll
        for (int i = 0; i < 8; ++i) acc[i] = (f32x2){0.f, 0.f};
        const uint2 e0 = EX[(size_t)tok * 128 + lane], e1 = EX[(size_t)tok * 128 + 64 + lane];
        float a0, a1;
        {
            float pz[64];
#pragma unroll
            for (int e = 0; e < 64; ++e) {
                const unsigned eid = (unsigned)__builtin_amdgcn_readlane((int)e0.x, e) & 0xffffu;
                pz[e] = dot16_fp8(*(const u32x4*)(UT + (size_t)eid * DM + c0), h2);
            }
            const float z = butterfly64(pz, lane) * __uint_as_float(((e0.x >> 16) & 0xffu) << 23);
            a0 = geluf_(z) * __uint_as_float(e0.y);
        }
        {
            float pz[64];
#pragma unroll
            for (int e = 0; e < 64; ++e) {
                const unsigned eid = (unsigned)__builtin_amdgcn_readlane((int)e1.x, e) & 0xffffu;
                pz[e] = dot16_fp8(*(const u32x4*)(UT + (size_t)eid * DM + c0), h2);
            }
            const float z = butterfly64(pz, lane) * __uint_as_float(((e1.x >> 16) & 0xffu) << 23);
            a1 = geluf_(z) * __uint_as_float(e1.y);
        }
#pragma unroll 16
        for (int e = 0; e < 64; ++e) {
            const unsigned eid = (unsigned)__builtin_amdgcn_readlane((int)e0.x, e) & 0xffffu;
            const float a = __uint_as_float(__builtin_amdgcn_readlane((int)__float_as_uint(a0), e));
            axpy16_fp8(a, *(const u32x4*)(VT + (size_t)eid * DM + c0), acc);
        }
#pragma unroll 16
        for (int e = 0; e < 64; ++e) {
            const unsigned eid = (unsigned)__builtin_amdgcn_readlane((int)e1.x, e) & 0xffffu;
            const float a = __uint_as_float(__builtin_amdgcn_readlane((int)__float_as_uint(a1), e));
            axpy16_fp8(a, *(const u32x4*)(VT + (size_t)eid * DM + c0), acc);
        }
        f32x2 r[8];
        float s = 0.f;
#pragma unroll
        for (int q = 0; q < 4; ++q) {
            const f32x4 gg = *(const f32x4*)(g2 + q * 4);
            r[2 * q] = DEEP_ALPHA * x1[2 * q] + (f32x2){1.f + gg.x, 1.f + gg.y} * acc[2 * q];
            r[2 * q + 1] = DEEP_ALPHA * x1[2 * q + 1] + (f32x2){1.f + gg.z, 1.f + gg.w} * acc[2 * q + 1];
            s += r[2 * q].x + r[2 * q].y + r[2 * q + 1].x + r[2 * q + 1].y;
        }
#pragma unroll
        for (int m = 1; m < 64; m <<= 1) s += __shfl_xor(s, m);
        const float mu = s * (1.0f / 1024.0f);
        float qq = 0.f;
#pragma unroll
        for (int i = 0; i < 8; ++i) { const f32x2 d = r[i] - mu; qq += d.x * d.x + d.y * d.y; }
#pragma unroll
        for (int m = 1; m < 64; m <<= 1) qq += __shfl_xor(qq, m);
        const float rstd = rsqrtf(qq * (1.0f / 1024.0f) + LN_EPS);
#pragma unroll
        for (int q = 0; q < 4; ++q) {
            const f32x4 w = *(const f32x4*)(p.ln2w + c0 + q * 4), bi = *(const f32x4*)(p.ln2b + c0 + q * 4);
            f32x4 ov;
            ov.x = (r[2 * q].x - mu) * rstd * w.x + bi.x; ov.y = (r[2 * q].y - mu) * rstd * w.y + bi.y;
            ov.z = (r[2 * q + 1].x - mu) * rstd * w.z + bi.z; ov.w = (r[2 * q + 1].y - mu) * rstd * w.w + bi.w;
            *(f32x4*)(row + q * 4) = ov;
        }
    }
}

__global__ void __launch_bounds__(NTH) k_mega(Params p) {
    __shared__ __attribute__((aligned(16))) char smem[SMEM_BYTES];
    cg::grid_group grid = cg::this_grid();
    const int bid = blockIdx.x, nb = gridDim.x;
#ifndef PROBE_MASK
#define PROBE_MASK 0
#endif
#define REP(bit) for (int rep_ = 0; rep_ < ((PROBE_MASK & (bit)) ? 2 : 1); ++rep_)
    REP(64) { phase_prep(p, bid, nb, smem);    grid.sync(); }
    REP(64) { phase_h(p, bid, nb);             grid.sync(); }
    REP(1)  { phase_proj(p, bid, nb, smem);    grid.sync(); }
    REP(2)  { phase_mix(p, bid, nb, smem);     grid.sync(); }
    REP(4)  { phase_glu(p, bid, nb, smem);     grid.sync(); }
    REP(4)  { phase_a2(p, bid, nb);            grid.sync(); }
    REP(4)  { phase_outproj(p, bid, nb, smem); grid.sync(); }
    phase_ln1(p, bid, nb);           grid.sync();
    REP(8)  { phase_q(p, bid, nb, smem);       grid.sync(); }
    REP(16) { phase_topk(p, bid, nb, smem);    grid.sync(); }
    REP(32) { phase_combine(p, bid, nb);       grid.sync(); }
    phase_gather(p, bid, nb);
}

extern "C" void kernel_launch(void* const* d_in, const int* in_sizes, int n_in, void* d_out, int out_size, void* d_ws, size_t ws_size, hipStream_t stream) {
    if (n_in != 27 || ws_size < WS_END) { fprintf(stderr, "kernel_launch: unexpected n_in %d or ws_size %zu (< %zu)\n", n_in, ws_size, (size_t)WS_END); return; }
    static int grid_blocks = 0;
    if (!grid_blocks) {
        int dev = 0, cus = 0, per_cu = 0;
        (void)hipGetDevice(&dev);
        (void)hipDeviceGetAttribute(&cus, hipDeviceAttributeMultiprocessorCount, dev);
        (void)hipOccupancyMaxActiveBlocksPerMultiprocessor(&per_cu, k_mega, NTH, 0);
        if (cus <= 0) cus = 256;
        if (per_cu < 1) { fprintf(stderr, "kernel_launch: occupancy query says %d blocks/CU\n", per_cu); per_cu = 1; }
        grid_blocks = cus;
    }
    Params p{};
    const float** f = (const float**)&p;
    for (int i = 0; i < 27; ++i) f[i] = (const float*)d_in[i];
    p.out = (float*)d_out; p.ws = (char*)d_ws;
    void* args[] = {&p};
    hipError_t e = hipLaunchCooperativeKernel((void*)k_mega, dim3(grid_blocks), dim3(NTH), args, 0, stream);
    if (e != hipSuccess) fprintf(stderr, "cooperative launch failed: %s (grid %d)\n", hipGetErrorString(e), grid_blocks);
}
```

```cpp
#include <hip/hip_runtime.h>
#include <hip/hip_cooperative_groups.h>
#include <stdint.h>
#include <stdio.h>

namespace cg = cooperative_groups;
#define DI __device__ __forceinline__
typedef unsigned short bf16_t;
typedef short bf16x8 __attribute__((ext_vector_type(8)));
typedef float f32x16 __attribute__((ext_vector_type(16)));
typedef unsigned u32x4 __attribute__((ext_vector_type(4)));
typedef float f32x4 __attribute__((ext_vector_type(4)));
typedef float f32x2 __attribute__((ext_vector_type(2)));

constexpr int NTH = 512;
constexpr int NB = 16, SEQ = 2048, DM = 1024, NTOK = NB * SEQ;
constexpr int DHG = 512, HGH = 4, HDK = 128;
constexpr int DSS = 512, SSG = 32, SSC = 16, SSP = 64;
constexpr int INC = 2560;
constexpr int PHEADS = 8, NKEYS = 128, TOPK = 16, NEXP = 16384;
constexpr float DEEP_ALPHA = 1.189207115002721f;
constexpr float LN_EPS = 1e-5f, RMS_EPS = 1e-6f;
constexpr int SMEM_BYTES = 128 * 1024;

constexpr size_t al256(size_t x) { return (x + 255) & ~(size_t)255; }
constexpr size_t OFF_MOD = 0;
constexpr size_t OFF_LB = al256(OFF_MOD + (size_t)NB * 6144 * 4);
constexpr size_t OFF_LAM = al256(OFF_LB + 512 * 4);
constexpr size_t OFF_BB = al256(OFF_LAM + 32 * 64 * 2 * 4);
constexpr size_t OFF_WIN = al256(OFF_BB + 32 * 64 * 16 * 2 * 4);
constexpr size_t OFF_GLU = al256(OFF_WIN + (size_t)INC * DM * 2);
constexpr size_t OFF_WOUT = al256(OFF_GLU + (size_t)512 * 512 * 2);
constexpr size_t OFF_WQ = al256(OFF_WOUT + (size_t)DM * DM * 2);
constexpr size_t OFF_SUBK = al256(OFF_WQ + (size_t)2048 * DM * 2);
constexpr size_t OFF_SU = al256(OFF_SUBK + (size_t)16 * 128 * 128 * 2);
constexpr size_t OFF_SV = al256(OFF_SU + (size_t)NEXP * 4);
constexpr size_t OFF_UT = al256(OFF_SV + (size_t)NEXP * 4);
constexpr size_t OFF_VT = al256(OFF_UT + (size_t)NEXP * DM * 2);
constexpr size_t OFF_H = al256(OFF_VT + (size_t)NEXP * DM * 2);
constexpr size_t OFF_PROJ = al256(OFF_H + (size_t)NTOK * DM * 2);
constexpr size_t OFF_ORAW = al256(OFF_PROJ + (size_t)NTOK * INC * 2);
constexpr size_t OFF_YSSM = al256(OFF_ORAW + (size_t)NTOK * DHG * 4);
constexpr size_t OFF_A2 = al256(OFF_YSSM + (size_t)NTOK * DSS * 2);
constexpr size_t OFF_HG = al256(OFF_A2 + (size_t)NTOK * DM * 2);
constexpr size_t OFF_S5K = al256(OFF_HG + (size_t)4096 * 128 * 4);
constexpr size_t OFF_S5N = al256(OFF_S5K + (size_t)32 * 4096 * 2);
constexpr size_t OFF_S5M = al256(OFF_S5N + (size_t)32 * 128 * 256 * 2);
constexpr size_t OFF_S5L = al256(OFF_S5M + (size_t)32 * 256 * 128 * 2);
constexpr size_t WS_END = al256(OFF_S5L + (size_t)32 * 64 * 2 * 4);
constexpr size_t OFF_HQ = OFF_H, OFF_HK = OFF_H + (size_t)NTOK * DHG * 2, OFF_HKT = OFF_A2, OFF_HVT = OFF_A2 + (size_t)NTOK * DHG * 2;
constexpr size_t OFF_TOPL = OFF_ORAW;
constexpr size_t OFF_EXPS = OFF_ORAW + (size_t)NTOK * 16 * 16 * 4;

struct Params {
    const float *x, *c, *ada_w, *ada_b, *w_in, *hg_lb, *hg_nw, *a_re, *a_im, *log_dt, *b_re, *b_im, *c_re, *c_im, *dsk,
        *glu_w, *glu_b, *ssm_nw, *w_out, *ln1w, *ln1b, *w_q, *subk, *pu, *pv, *ln2w, *ln2b;
    float* out;
    char* ws;
};

DI int my_tid() { int t = (int)__builtin_amdgcn_workitem_id_x(); asm volatile("" : "+v"(t)); return t; }
DI bf16_t f2bf(float x) { unsigned u = __float_as_uint(x); u += 0x7fffu + ((u >> 16) & 1u); return (bf16_t)(u >> 16); }
DI float bf2f(bf16_t b) { return __uint_as_float(((unsigned)b) << 16); }
DI float bflo(unsigned w) { return __uint_as_float(w << 16); }
DI float bfhi(unsigned w) { return __uint_as_float(w & 0xffff0000u); }
typedef __bf16 hwbf16x2 __attribute__((ext_vector_type(2)));
DI unsigned pack2(float a, float b) { const f32x2 v = {a, b}; return __builtin_bit_cast(unsigned, __builtin_convertvector(v, hwbf16x2)); }
DI bf16x8 pack8(const f32x16& x, const int base) {
    u32x4 o; o.x = pack2(x[base], x[base + 1]); o.y = pack2(x[base + 2], x[base + 3]); o.z = pack2(x[base + 4], x[base + 5]); o.w = pack2(x[base + 6], x[base + 7]);
    return __builtin_bit_cast(bf16x8, o);
}
DI float sigmoidf_(float x) { return 1.0f / (1.0f + __expf(-x)); }
DI float siluf_(float x) { return x * sigmoidf_(x); }
DI float geluf_(float x) { return 0.5f * x * (1.0f + erff(x * 0.70710678118654752f)); }
DI float gelu_as(float v) {
    const float t = __builtin_amdgcn_rcpf(fabsf(v) * 0.2316418882f + 1.0f);
    float q = t * 0.5307027145f + (-0.7265760135f); q = q * t + 0.7107068705f; q = q * t + (-0.142248368f); q = q * t + 0.127414796f; q = q * t;
    const float m = v * (q * __builtin_amdgcn_exp2f(v * v * (-0.72134752044f)));
    return v < 0.f ? m : v - m;
}

template <int MT, int NT_, int WM, int WN, class Epi>
DI void gemm_block(const bf16_t* __restrict__ A, int lda, const bf16_t* __restrict__ Bt, int ldb, int K, char* smem, Epi epi) {
    constexpr int BM = WM * MT * 32, BN = WN * NT_ * 32, LS = 72;
    static_assert(WM * WN == 8, "8 waves");
    bf16_t* As = (bf16_t*)smem;
    bf16_t* Bs = As + BM * LS;
    const int tid = my_tid(), lane = tid & 63, wid = tid >> 6, r = lane & 31, h = lane >> 5;
    const int wm = wid / WN, wn = wid % WN;
    constexpr int PA = BM * 8 / NTH, PB = BN * 8 / NTH;
    u32x4 ra[PA], rb[PB];
    f32x16 acc[MT][NT_];
#pragma unroll
    for (int mi = 0; mi < MT; ++mi)
#pragma unroll
        for (int ni = 0; ni < NT_; ++ni)
#pragma unroll
            for (int i = 0; i < 16; ++i) acc[mi][ni][i] = 0.f;
#define GEMM_GLOAD(kt_) { \
    _Pragma("unroll") for (int q = 0; q < PA; ++q) { const int idx = tid + q * NTH, row = idx >> 3, ch = idx & 7; ra[q] = *(const u32x4*)(A + (size_t)row * lda + (kt_) * 64 + ch * 8); } \
    _Pragma("unroll") for (int q = 0; q < PB; ++q) { const int idx = tid + q * NTH, row = idx >> 3, ch = idx & 7; rb[q] = *(const u32x4*)(Bt + (size_t)row * ldb + (kt_) * 64 + ch * 8); } }
#define GEMM_LSTORE() { \
    _Pragma("unroll") for (int q = 0; q < PA; ++q) { const int idx = tid + q * NTH, row = idx >> 3, ch = idx & 7; *(u32x4*)(As + row * LS + ch * 8) = ra[q]; } \
    _Pragma("unroll") for (int q = 0; q < PB; ++q) { const int idx = tid + q * NTH, row = idx >> 3, ch = idx & 7; *(u32x4*)(Bs + row * LS + ch * 8) = rb[q]; } }
    GEMM_GLOAD(0); GEMM_LSTORE(); __syncthreads();
    const int nk = K / 64;
    for (int kt = 0; kt < nk; ++kt) {
        if (kt + 1 < nk) GEMM_GLOAD(kt + 1);
#pragma unroll
        for (int ks = 0; ks < 4; ++ks) {
            bf16x8 a[MT], b[NT_];
#pragma unroll
            for (int mi = 0; mi < MT; ++mi) a[mi] = *(const bf16x8*)(As + (wm * MT * 32 + mi * 32 + r) * LS + ks * 16 + h * 8);
#pragma unroll
            for (int ni = 0; ni < NT_; ++ni) b[ni] = *(const bf16x8*)(Bs + (wn * NT_ * 32 + ni * 32 + r) * LS + ks * 16 + h * 8);
#pragma unroll
            for (int mi = 0; mi < MT; ++mi)
#pragma unroll
                for (int ni = 0; ni < NT_; ++ni) acc[mi][ni] = __builtin_amdgcn_mfma_f32_32x32x16_bf16(a[mi], b[ni], acc[mi][ni], 0, 0, 0);
        }
        __syncthreads();
        if (kt + 1 < nk) { GEMM_LSTORE(); __syncthreads(); }
    }
#pragma unroll
    for (int mi = 0; mi < MT; ++mi)
#pragma unroll
        for (int ni = 0; ni < NT_; ++ni)
#pragma unroll
            for (int i = 0; i < 16; ++i) epi(wm * MT * 32 + mi * 32 + (i & 3) + 8 * (i >> 2) + 4 * h, wn * NT_ * 32 + ni * 32 + r, acc[mi][ni][i]);
}

DI void prep_mod_item(const Params& p, int item, char* smem) {
    float* cond = (float*)smem;
    const int tid = my_tid();
    for (int i = tid; i < NB * DM; i += NTH) cond[i] = siluf_(p.c[i]);
    __syncthreads();
    const int b = tid >> 5, col = item * 32 + (tid & 31);
    float acc = 0.f;
    const float* w = p.ada_w + col;
    const float* cb = cond + b * DM;
#pragma unroll 8
    for (int k = 0; k < DM; ++k) acc += cb[k] * w[(size_t)k * 6144];
    ((float*)(p.ws + OFF_MOD))[b * 6144 + col] = acc + p.ada_b[col];
    __syncthreads();
}
DI void prep_s5_gemm_item(const Params& p, int g, char* smem) {
    f32x2* pw = (f32x2*)smem;
    f32x2* bbL = pw + 17 * 64;
    f32x2* cL = bbL + 64 * 16;
    const int tid = my_tid();
    const float dt = expf(p.log_dt[g]);
#pragma unroll 1
    for (int idx = tid; idx < 17 * 64; idx += NTH) {
        const int j = idx >> 6, pp = idx & 63;
        const float ar = p.a_re[g * 64 + pp], ai = p.a_im[g * 64 + pp];
        const float mag = expf(ar * dt * (float)j), ang = ai * dt * (float)j;
        pw[idx] = (f32x2){mag * cosf(ang), mag * sinf(ang)};
    }
    for (int idx = tid; idx < 16 * 64; idx += NTH) { const int i = idx >> 6, pp = idx & 63; cL[idx] = (f32x2){p.c_re[(g * 16 + i) * 64 + pp], p.c_im[(g * 16 + i) * 64 + pp]}; }
    __syncthreads();
    for (int idx = tid; idx < 64 * 16; idx += NTH) {
        const int pp = idx >> 4, i = idx & 15;
        const float ar = p.a_re[g * 64 + pp], ai = p.a_im[g * 64 + pp];
        const f32x2 lam = pw[64 + pp];
        const float den = ar * ar + ai * ai, nr = lam.x - 1.0f, ni = lam.y;
        const float zr = (nr * ar + ni * ai) / den, zi = (ni * ar - nr * ai) / den;
        const float br = p.b_re[(g * 64 + pp) * 16 + i], bi = p.b_im[(g * 64 + pp) * 16 + i];
        bbL[idx] = (f32x2){zr * br - zi * bi, zr * bi + zi * br};
    }
    __syncthreads();
    bf16_t* NBg = (bf16_t*)(p.ws + OFF_S5N) + (size_t)g * 128 * 256;
#pragma unroll 1
    for (int ch = tid; ch < 128 * 256 / 8; ch += NTH) {
        const int pq = ch >> 5, t = (ch >> 1) & 15, i0 = (ch & 1) * 8, pp = pq & 63;
        const f32x2 w = pw[(15 - t) * 64 + pp];
        float v[8];
#pragma unroll
        for (int e = 0; e < 8; ++e) { const f32x2 bb = bbL[pp * 16 + i0 + e]; v[e] = pq < 64 ? (w.x * bb.x - w.y * bb.y) : (w.x * bb.y + w.y * bb.x); }
        u32x4 o; o.x = pack2(v[0], v[1]); o.y = pack2(v[2], v[3]); o.z = pack2(v[4], v[5]); o.w = pack2(v[6], v[7]);
        *(u32x4*)(NBg + (size_t)pq * 256 + t * 16 + i0) = o;
    }
    bf16_t* MBg = (bf16_t*)(p.ws + OFF_S5M) + (size_t)g * 256 * 128;
#pragma unroll 1
    for (int ch = tid; ch < 256 * 128 / 8; ch += NTH) {
        const int ti = ch >> 4, p0 = (ch & 15) * 8, tq = ti >> 4, iq = ti & 15;
        float v[8];
#pragma unroll
        for (int e = 0; e < 8; ++e) {
            const int pq = p0 + e, pp = pq & 63;
            const f32x2 c = cL[iq * 64 + pp], w = pw[(tq + 1) * 64 + pp];
            v[e] = pq < 64 ? (c.x * w.x - c.y * w.y) : -(c.x * w.y + c.y * w.x);
        }
        u32x4 o; o.x = pack2(v[0], v[1]); o.y = pack2(v[2], v[3]); o.z = pack2(v[4], v[5]); o.w = pack2(v[6], v[7]);
        *(u32x4*)(MBg + (size_t)ti * 128 + p0) = o;
    }
    bf16_t* KTg = (bf16_t*)(p.ws + OFF_S5K) + (size_t)g * 4096;
#pragma unroll 1
    for (int idx = tid; idx < 4096; idx += NTH) {
        const int lag = idx >> 8, iq = (idx >> 4) & 15, i = idx & 15;
        float acc = (lag == 0 && iq == i) ? p.dsk[g * 16 + iq] : 0.f;
#pragma unroll 4
        for (int pp = 0; pp < 64; ++pp) {
            const f32x2 c = cL[iq * 64 + pp], w = pw[lag * 64 + pp], bb = bbL[pp * 16 + i];
            const float mr = c.x * w.x - c.y * w.y, mi_ = c.x * w.y + c.y * w.x;
            acc += mr * bb.x - mi_ * bb.y;
        }
        KTg[idx] = f2bf(acc);
    }
    if (tid < 64) { float* L = (float*)(p.ws + OFF_S5L) + (g * 64 + tid) * 2; const f32x2 w = pw[16 * 64 + tid]; L[0] = w.x; L[1] = w.y; }
    __syncthreads();
}
DI void prep_s5_item(const Params& p, int g) {
    const int tid = my_tid();
    if (tid < SSP) {
        const int pi = g * SSP + tid;
        const float dt = expf(p.log_dt[g]);
        const float ar = p.a_re[pi], ai = p.a_im[pi];
        const float mag = expf(ar * dt);
        const float lr = mag * cosf(ai * dt), li = mag * sinf(ai * dt);
        const float den = ar * ar + ai * ai, nr = lr - 1.0f, ni = li;
        const float zr = (nr * ar + ni * ai) / den, zi = (ni * ar - nr * ai) / den;
        float* lam = (float*)(p.ws + OFF_LAM) + pi * 2;
        lam[0] = lr; lam[1] = li;
        float* bb = (float*)(p.ws + OFF_BB) + (size_t)pi * 32;
        for (int i = 0; i < SSC; ++i) {
            const float br = p.b_re[pi * SSC + i], bi = p.b_im[pi * SSC + i];
            bb[i * 2] = zr * br - zi * bi; bb[i * 2 + 1] = zr * bi + zi * br;
        }
    }
}
DI void prep_transpose_tile(const float* __restrict__ W, bf16_t* __restrict__ Wt, int K, int N, int kt, int nt, char* smem) {
    float* tile = (float*)smem;
    const int tid = my_tid();
#pragma unroll
    for (int q = 0; q < 2; ++q) {
        const int kk = (tid >> 4) + q * 32, c4 = (tid & 15) * 4;
        const float4 v = *(const float4*)(W + (size_t)(kt * 64 + kk) * N + nt * 64 + c4);
        tile[kk * 65 + c4] = v.x; tile[kk * 65 + c4 + 1] = v.y; tile[kk * 65 + c4 + 2] = v.z; tile[kk * 65 + c4 + 3] = v.w;
    }
    __syncthreads();
    const int n = tid >> 3, kc = tid & 7;
    uint4 o;
    o.x = pack2(tile[(kc * 8 + 0) * 65 + n], tile[(kc * 8 + 1) * 65 + n]);
    o.y = pack2(tile[(kc * 8 + 2) * 65 + n], tile[(kc * 8 + 3) * 65 + n]);
    o.z = pack2(tile[(kc * 8 + 4) * 65 + n], tile[(kc * 8 + 5) * 65 + n]);
    o.w = pack2(tile[(kc * 8 + 6) * 65 + n], tile[(kc * 8 + 7) * 65 + n]);
    *(uint4*)(Wt + (size_t)(nt * 64 + n) * K + kt * 64 + kc * 8) = o;
    __syncthreads();
}
DI void cvt_bf16_stream(const float* __restrict__ src, bf16_t* __restrict__ dst, size_t n8, int bid, int nb) {
    for (size_t i = (size_t)bid * NTH + my_tid(); i < n8; i += (size_t)nb * NTH) {
        const float4 a = *(const float4*)(src + i * 8), b = *(const float4*)(src + i * 8 + 4);
        uint4 o; o.x = pack2(a.x, a.y); o.y = pack2(a.z, a.w); o.z = pack2(b.x, b.y); o.w = pack2(b.z, b.w);
        *(uint4*)(dst + i * 8) = o;
    }
}
DI void cvt_fp8_rows(const float* __restrict__ src, unsigned char* __restrict__ dst, float* __restrict__ inv, int bid, int nb) {
    const int lane = my_tid() & 63, wid = my_tid() >> 6;
    for (int row = bid * 8 + wid; row < NEXP; row += nb * 8) {
        const float* sp = src + (size_t)row * DM + lane * 16;
        const f32x4 a = *(const f32x4*)sp, b = *(const f32x4*)(sp + 4), c = *(const f32x4*)(sp + 8), d = *(const f32x4*)(sp + 12);
        float m = fmaxf(fmaxf(fmaxf(fabsf(a.x), fabsf(a.y)), fmaxf(fabsf(a.z), fabsf(a.w))), fmaxf(fmaxf(fabsf(b.x), fabsf(b.y)), fmaxf(fabsf(b.z), fabsf(b.w))));
        m = fmaxf(m, fmaxf(fmaxf(fmaxf(fabsf(c.x), fabsf(c.y)), fmaxf(fabsf(c.z), fabsf(c.w))), fmaxf(fmaxf(fabsf(d.x), fabsf(d.y)), fmaxf(fabsf(d.z), fabsf(d.w)))));
#pragma unroll
        for (int s = 1; s < 64; s <<= 1) m = fmaxf(m, __shfl_xor(m, s));
        float sc = 1.f, isc = 1.f;
        if (m > 1e-30f) {
            int k = (int)floorf(log2f(448.0f / m));
            k = k < -60 ? -60 : (k > 60 ? 60 : k);
            sc = ldexpf(1.0f, k); isc = ldexpf(1.0f, -k);
            if (m * sc > 448.0f) { sc *= 0.5f; isc *= 2.0f; }
        }
        u32x4 o;
        int w;
        w = __builtin_amdgcn_cvt_pk_fp8_f32(a.x * sc, a.y * sc, 0, false); w = __builtin_amdgcn_cvt_pk_fp8_f32(a.z * sc, a.w * sc, w, true); o.x = (unsigned)w;
        w = __builtin_amdgcn_cvt_pk_fp8_f32(b.x * sc, b.y * sc, 0, false); w = __builtin_amdgcn_cvt_pk_fp8_f32(b.z * sc, b.w * sc, w, true); o.y = (unsigned)w;
        w = __builtin_amdgcn_cvt_pk_fp8_f32(c.x * sc, c.y * sc, 0, false); w = __builtin_amdgcn_cvt_pk_fp8_f32(c.z * sc, c.w * sc, w, true); o.z = (unsigned)w;
        w = __builtin_amdgcn_cvt_pk_fp8_f32(d.x * sc, d.y * sc, 0, false); w = __builtin_amdgcn_cvt_pk_fp8_f32(d.z * sc, d.w * sc, w, true); o.w = (unsigned)w;
        *(u32x4*)(dst + (size_t)row * DM + lane * 16) = o;
        if (lane == 0) inv[row] = isc;
    }
}
DI void phase_prep(const Params& p, int bid, int nb, char* smem) {
    constexpr int N_MOD = 192, N_LB = 1, N_S5 = 32, T_WIN = 16 * 40, T_GLU = 8 * 8, T_WOUT = 16 * 16, T_WQ = 16 * 32;
    constexpr int I_LB = N_MOD, I_S5 = I_LB + N_LB, I_WIN = I_S5 + N_S5, I_GLU = I_WIN + T_WIN, I_WOUT = I_GLU + T_GLU, I_WQ = I_WOUT + T_WOUT, I_END = I_WQ + T_WQ;
    for (int it = bid; it < I_END; it += nb) {
        if (it < N_MOD) prep_mod_item(p, it, smem);
        else if (it < I_S5) {
            const int j = my_tid();
            const float a0 = p.hg_lb[j], a1 = p.hg_lb[512 + j], m = fmaxf(a0, a1);
            const float e0 = expf(a0 - m), e1 = expf(a1 - m);
            ((float*)(p.ws + OFF_LB))[j] = e0 / (e0 + e1);
        } else if (it < I_WIN) { prep_s5_item(p, it - I_S5); prep_s5_gemm_item(p, it - I_S5, smem); }
        else if (it < I_GLU) { const int t = it - I_WIN; prep_transpose_tile(p.w_in, (bf16_t*)(p.ws + OFF_WIN), DM, INC, t / 40, t % 40, smem); }
        else if (it < I_WOUT) { const int t = it - I_GLU; prep_transpose_tile(p.glu_w, (bf16_t*)(p.ws + OFF_GLU), 512, 512, t / 8, t % 8, smem); }
        else if (it < I_WQ) { const int t = it - I_WOUT; prep_transpose_tile(p.w_out, (bf16_t*)(p.ws + OFF_WOUT), DM, DM, t / 16, t % 16, smem); }
        else { const int t = it - I_WQ; prep_transpose_tile(p.w_q, (bf16_t*)(p.ws + OFF_WQ), DM, 2048, t / 32, t % 32, smem); }
    }
    cvt_bf16_stream(p.subk, (bf16_t*)(p.ws + OFF_SUBK), (size_t)16 * 128 * 128 / 8, bid, nb);
    cvt_fp8_rows(p.pu, (unsigned char*)(p.ws + OFF_UT), (float*)(p.ws + OFF_SU), bid, nb);
    cvt_fp8_rows(p.pv, (unsigned char*)(p.ws + OFF_VT), (float*)(p.ws + OFF_SV), bid, nb);
}

DI void phase_h(const Params& p, int bid, int nb) {
    const float* mod = (const float*)(p.ws + OFF_MOD);
    bf16_t* H = (bf16_t*)(p.ws + OFF_H);
    const size_t n8 = (size_t)NTOK * DM / 8;
    for (size_t i = (size_t)bid * NTH + my_tid(); i < n8; i += (size_t)nb * NTH) {
        const int row = (int)(i >> 7), c0 = (int)(i & 127) * 8, b = row / SEQ;
        const float* sh = mod + b * 6144 + c0;
        const float* sc = sh + 1024;
        const float4 a = *(const float4*)(p.x + i * 8), bq = *(const float4*)(p.x + i * 8 + 4);
        const float4 s0 = *(const float4*)sc, s1 = *(const float4*)(sc + 4), h0 = *(const float4*)sh, h1 = *(const float4*)(sh + 4);
        uint4 o;
        o.x = pack2(a.x * (1.f + s0.x) + h0.x, a.y * (1.f + s0.y) + h0.y);
        o.y = pack2(a.z * (1.f + s0.z) + h0.z, a.w * (1.f + s0.w) + h0.w);
        o.z = pack2(bq.x * (1.f + s1.x) + h1.x, bq.y * (1.f + s1.y) + h1.y);
        o.w = pack2(bq.z * (1.f + s1.z) + h1.z, bq.w * (1.f + s1.w) + h1.w);
        *(uint4*)(H + i * 8) = o;
    }
}

DI void phase_proj(const Params& p, int bid, int nb, char* smem) {
    const bf16_t* H = (const bf16_t*)(p.ws + OFF_H);
    const bf16_t* W = (const bf16_t*)(p.ws + OFF_WIN);
    bf16_t* P = (bf16_t*)(p.ws + OFF_PROJ);
    constexpr int NTN = INC / 128, NTM = NTOK / 128;
    for (int t = bid; t < NTM * NTN; t += nb) {
        const int mt = t / NTN, nt = t % NTN;
        bf16_t* Pt = P + (size_t)mt * 128 * INC + nt * 128;
        const bool act = (nt < 4) || (nt >= 12 && nt < 16);
        gemm_block<2, 1, 2, 4>(H + (size_t)mt * 128 * DM, DM, W + (size_t)nt * 128 * DM, DM, DM, smem,
                               [&](int r, int c, float v) { Pt[(size_t)r * INC + c] = f2bf(act ? siluf_(v) : v); });
        __syncthreads();
    }
}

DI void hgrn_item(const Params& p, int item, char* smem) {
    const int vs = item & 7, hd = (item >> 3) & 3, b = item >> 5;
    const bf16_t* P = (const bf16_t*)(p.ws + OFF_PROJ);
    const float* lb = (const float*)(p.ws + OFF_LB) + hd * HDK;
    float* ORAW = (float*)(p.ws + OFF_ORAW);
    float* sq = (float*)smem;
    float* sf = sq + 32 * 128;
    float* sv = sf + 32 * 128;
    float* sp = sv + 32 * 16;
    const int tid = my_tid(), lane = tid & 63, wid = tid >> 6, kq = tid >> 4, v = tid & 15;
    float S0 = 0.f, S1 = 0.f, S2 = 0.f, S3 = 0.f;
    for (int t0 = 0; t0 < SEQ; t0 += 32) {
        for (int i = tid; i < 32 * 128; i += NTH) {
            const int t = i >> 7, k = i & 127;
            const bf16_t* row = P + (size_t)(b * SEQ + t0 + t) * INC + hd * HDK + k;
            sq[i] = bf2f(row[0]);
            const float l = lb[k];
            sf[i] = l + (1.0f - l) * sigmoidf_(bf2f(row[512]));
        }
        { const int t = tid >> 4; sv[tid] = bf2f(P[(size_t)(b * SEQ + t0 + t) * INC + 1024 + hd * HDK + vs * 16 + v]); }
        __syncthreads();
        for (int t = 0; t < 32; ++t) {
            const float4 f4 = *(const float4*)(sf + t * 128 + kq * 4), q4 = *(const float4*)(sq + t * 128 + kq * 4);
            const float vv = sv[t * 16 + v];
            S0 = f4.x * S0 + (1.0f - f4.x) * vv; S1 = f4.y * S1 + (1.0f - f4.y) * vv;
            S2 = f4.z * S2 + (1.0f - f4.z) * vv; S3 = f4.w * S3 + (1.0f - f4.w) * vv;
            float part = q4.x * S0 + q4.y * S1 + q4.z * S2 + q4.w * S3;
            part += __shfl_xor(part, 16); part += __shfl_xor(part, 32);
            if (lane < 16) sp[(t * 8 + wid) * 16 + v] = part;
        }
        __syncthreads();
        {
            const int t = tid >> 4;
            float o = 0.f;
#pragma unroll
            for (int w = 0; w < 8; ++w) o += sp[(t * 8 + w) * 16 + v];
            ORAW[(size_t)(b * SEQ + t0 + t) * DHG + hd * HDK + vs * 16 + v] = o;
        }
        __syncthreads();
    }
}
DI void s5_item(const Params& p, int item, char* smem) {
    const int oct = item & 3, b = item >> 2;
    const int tid = my_tid(), lane = tid & 63, wid = tid >> 6, g = oct * 8 + wid;
    const bf16_t* P = (const bf16_t*)(p.ws + OFF_PROJ);
    bf16_t* Y = (bf16_t*)(p.ws + OFF_YSSM);
    float* su = (float*)smem + wid * 64 * 16;
    const float* lam = (const float*)(p.ws + OFF_LAM) + (g * SSP + lane) * 2;
    const float lr = lam[0], li = lam[1];
    const float* bb = (const float*)(p.ws + OFF_BB) + (size_t)(g * SSP + lane) * 32;
    float bbr[16], bbi[16], cr[16], ci[16];
#pragma unroll
    for (int i = 0; i < 16; ++i) { bbr[i] = bb[2 * i]; bbi[i] = bb[2 * i + 1]; cr[i] = p.c_re[(g * SSC + i) * SSP + lane]; ci[i] = p.c_im[(g * SSC + i) * SSP + lane]; }
    const int ch = (lane >> 2) & 15;
    const float dch = p.dsk[g * SSC + ch];
    float xr = 0.f, xi = 0.f;
    for (int t0 = 0; t0 < SEQ; t0 += 64) {
        {
            const uint4* src = (const uint4*)(P + (size_t)(b * SEQ + t0 + lane) * INC + 2048 + g * SSC);
            const uint4 a = src[0], c = src[1];
            float* d = su + lane * 16;
            d[0] = bflo(a.x); d[1] = bfhi(a.x); d[2] = bflo(a.y); d[3] = bfhi(a.y); d[4] = bflo(a.z); d[5] = bfhi(a.z); d[6] = bflo(a.w); d[7] = bfhi(a.w);
            d[8] = bflo(c.x); d[9] = bfhi(c.x); d[10] = bflo(c.y); d[11] = bfhi(c.y); d[12] = bflo(c.z); d[13] = bfhi(c.z); d[14] = bflo(c.w); d[15] = bfhi(c.w);
        }
        __syncthreads();
        for (int t = 0; t < 64; ++t) {
            float u[16];
            const float4* us = (const float4*)(su + t * 16);
            const float4 u0 = us[0], u1 = us[1], u2 = us[2], u3 = us[3];
            u[0] = u0.x; u[1] = u0.y; u[2] = u0.z; u[3] = u0.w; u[4] = u1.x; u[5] = u1.y; u[6] = u1.z; u[7] = u1.w;
            u[8] = u2.x; u[9] = u2.y; u[10] = u2.z; u[11] = u2.w; u[12] = u3.x; u[13] = u3.y; u[14] = u3.z; u[15] = u3.w;
            float bur = 0.f, bui = 0.f;
#pragma unroll
            for (int i = 0; i < 16; ++i) { bur += bbr[i] * u[i]; bui += bbi[i] * u[i]; }
            const float nxr = lr * xr - li * xi + bur, nxi = lr * xi + li * xr + bui;
            xr = nxr; xi = nxi;
            float y[16];
#pragma unroll
            for (int i = 0; i < 16; ++i) y[i] = cr[i] * xr - ci[i] * xi;
            const bool b5 = lane & 32, b4 = lane & 16, b3 = lane & 8, b2 = lane & 4;
            float y8[8], y4[4], y2[2];
#pragma unroll
            for (int j = 0; j < 8; ++j) { const float keep = b5 ? y[8 + j] : y[j], send = b5 ? y[j] : y[8 + j]; y8[j] = keep + __shfl_xor(send, 32); }
#pragma unroll
            for (int j = 0; j < 4; ++j) { const float keep = b4 ? y8[4 + j] : y8[j], send = b4 ? y8[j] : y8[4 + j]; y4[j] = keep + __shfl_xor(send, 16); }
#pragma unroll
            for (int j = 0; j < 2; ++j) { const float keep = b3 ? y4[2 + j] : y4[j], send = b3 ? y4[j] : y4[2 + j]; y2[j] = keep + __shfl_xor(send, 8); }
            float y1;
            { const float keep = b2 ? y2[1] : y2[0], send = b2 ? y2[0] : y2[1]; y1 = keep + __shfl_xor(send, 4); }
            y1 += __shfl_xor(y1, 1); y1 += __shfl_xor(y1, 2);
            if ((lane & 3) == 0) {
                const float uu = su[t * 16 + ch];
                Y[(size_t)(b * SEQ + t0 + t) * DSS + g * SSC + ch] = f2bf(geluf_(y1 + dch * uu));
            }
        }
        __syncthreads();
    }
}
DI int crow(int i, int h) { return (i & 3) + 8 * (i >> 2) + 4 * h; }
DI void phase_hgprep(const Params& p, int bid, int nb) {
    const bf16_t* P = (const bf16_t*)(p.ws + OFF_PROJ);
    const float* lbp = (const float*)(p.ws + OFF_LB);
    const int tid = my_tid(), cl = tid >> 7, k = tid & 127;
    for (int it = bid; it < 1024; it += nb) {
        const int cq = it & 15, hd = (it >> 4) & 3, b = it >> 6, c = cq * 4 + cl;
        const bf16_t* base = P + (size_t)(b * SEQ + c * 32) * INC + hd * HDK + k;
        const float l = lbp[hd * HDK + k];
        const size_t tile = ((size_t)(b * 4 + hd) * 64 + c);
        bf16_t* HQ = (bf16_t*)(p.ws + OFF_HQ) + tile * 4096;
        bf16_t* HK = (bf16_t*)(p.ws + OFF_HK) + tile * 4096;
        bf16_t* HKT = (bf16_t*)(p.ws + OFF_HKT) + tile * 4096;
        bf16_t* HVT = (bf16_t*)(p.ws + OFF_HVT) + tile * 4096;
        float bc[32], kk[32];
        float bs = 0.f;
#pragma unroll
        for (int t = 0; t < 32; ++t) {
            const float f = l + (1.0f - l) * sigmoidf_(bf2f(base[(size_t)t * INC + 512]));
            bs += __logf(f); bc[t] = bs; kk[t] = 1.0f - f;
        }
#pragma unroll
        for (int t = 0; t < 32; ++t) {
            const float qv = bf2f(base[(size_t)t * INC]);
            HQ[t * 128 + k] = f2bf(qv * __expf(bc[t]));
            HK[t * 128 + k] = f2bf(kk[t] * __expf(fminf(-bc[t], 80.0f)));
        }
#pragma unroll
        for (int q = 0; q < 4; ++q) {
            u32x4 o;
            o.x = pack2(kk[q * 8 + 0] * __expf(bs - bc[q * 8 + 0]), kk[q * 8 + 1] * __expf(bs - bc[q * 8 + 1]));
            o.y = pack2(kk[q * 8 + 2] * __expf(bs - bc[q * 8 + 2]), kk[q * 8 + 3] * __expf(bs - bc[q * 8 + 3]));
            o.z = pack2(kk[q * 8 + 4] * __expf(bs - bc[q * 8 + 4]), kk[q * 8 + 5] * __expf(bs - bc[q * 8 + 5]));
            o.w = pack2(kk[q * 8 + 6] * __expf(bs - bc[q * 8 + 6]), kk[q * 8 + 7] * __expf(bs - bc[q * 8 + 7]));
            *(u32x4*)(HKT + k * 32 + q * 8) = o;
        }
        ((float*)(p.ws + OFF_HG))[tile * 128 + k] = __expf(bs);
#pragma unroll
        for (int q = 0; q < 4; ++q) {
            unsigned w[4];
#pragma unroll
            for (int e = 0; e < 4; ++e) w[e] = (unsigned)base[(size_t)(q * 8 + 2 * e) * INC + 1024] | ((unsigned)base[(size_t)(q * 8 + 2 * e + 1) * INC + 1024] << 16);
            *(u32x4*)(HVT + k * 32 + q * 8) = (u32x4){w[0], w[1], w[2], w[3]};
        }
    }
}
typedef short s16x4 __attribute__((ext_vector_type(4)));
DI bf16x8 cat8(const s16x4 lo, const s16x4 hi) { return (bf16x8){lo.x, lo.y, lo.z, lo.w, hi.x, hi.y, hi.z, hi.w}; }
DI void hgrn_mfma_item(const Params& p, int item, char* smem) {
    constexpr int QP_OFF = 0, KP_OFF = 8704, KT_OFF = 17408, VT_OFF = 27648, G_OFF = 37888, BUF = 38400;
    const int tid = my_tid(), lane = tid & 63, wid = tid >> 6, r = lane & 31, h = lane >> 5;
    const int b = item >> 2, hd = item & 3;
    const size_t tile0 = (size_t)item * 64;
    const bf16_t* HQ = (const bf16_t*)(p.ws + OFF_HQ) + tile0 * 4096;
    const bf16_t* HK = (const bf16_t*)(p.ws + OFF_HK) + tile0 * 4096;
    const bf16_t* HKT = (const bf16_t*)(p.ws + OFF_HKT) + tile0 * 4096;
    const bf16_t* HVT = (const bf16_t*)(p.ws + OFF_HVT) + tile0 * 4096;
    const float* HG = (const float*)(p.ws + OFF_HG) + tile0 * 128;
    float* ORAW = (float*)(p.ws + OFF_ORAW) + (size_t)b * SEQ * DHG + hd * HDK;
    const bool helper = wid >= 4;
    const int ht = tid - 256;
    u32x4 sq0, sq1, sk0, sk1, st0, st1, sv0, sv1, sg;
    sq0 = sq1 = sk0 = sk1 = st0 = st1 = sv0 = sv1 = sg = (u32x4){0, 0, 0, 0};
    f32x16 S[4];
#pragma unroll
    for (int kb = 0; kb < 4; ++kb)
#pragma unroll
        for (int i = 0; i < 16; ++i) S[kb][i] = 0.f;
#define HG_LOAD(c_) { const size_t o_ = (size_t)(c_) * 4096; \
        sq0 = *(const u32x4*)(HQ + o_ + ht * 8); sq1 = *(const u32x4*)(HQ + o_ + (ht + 256) * 8); \
        sk0 = *(const u32x4*)(HK + o_ + ht * 8); sk1 = *(const u32x4*)(HK + o_ + (ht + 256) * 8); \
        st0 = *(const u32x4*)(HKT + o_ + ht * 8); st1 = *(const u32x4*)(HKT + o_ + (ht + 256) * 8); \
        sv0 = *(const u32x4*)(HVT + o_ + ht * 8); sv1 = *(const u32x4*)(HVT + o_ + (ht + 256) * 8); \
        if (ht < 32) sg = *(const u32x4*)(HG + (size_t)(c_) * 128 + ht * 4); }
#define HG_STORE(buf_) { char* B_ = smem + (buf_) * BUF; \
        { const int i0 = ht, i1 = ht + 256; \
          *(u32x4*)(B_ + QP_OFF + (i0 >> 4) * 272 + (i0 & 15) * 16) = sq0; *(u32x4*)(B_ + QP_OFF + (i1 >> 4) * 272 + (i1 & 15) * 16) = sq1; \
          *(u32x4*)(B_ + KP_OFF + (i0 >> 4) * 272 + (i0 & 15) * 16) = sk0; *(u32x4*)(B_ + KP_OFF + (i1 >> 4) * 272 + (i1 & 15) * 16) = sk1; \
          *(u32x4*)(B_ + KT_OFF + (i0 >> 2) * 80 + (i0 & 3) * 16) = st0; *(u32x4*)(B_ + KT_OFF + (i1 >> 2) * 80 + (i1 & 3) * 16) = st1; \
          *(u32x4*)(B_ + VT_OFF + (i0 >> 2) * 80 + (i0 & 3) * 16) = sv0; *(u32x4*)(B_ + VT_OFF + (i1 >> 2) * 80 + (i1 & 3) * 16) = sv1; \
          if (ht < 32) *(u32x4*)(B_ + G_OFF + ht * 16) = sg; } }
    if (helper) { HG_LOAD(0); HG_STORE(0); }
    __syncthreads();
    for (int c = 0; c < 64; ++c) {
        if (helper) {
            if (c + 1 < 64) HG_LOAD(c + 1);
        } else {
            const char* B = smem + (c & 1) * BUF;
            const int w = wid;
            f32x16 pt;
#pragma unroll
            for (int i = 0; i < 16; ++i) pt[i] = 0.f;
#pragma unroll
            for (int ks = 0; ks < 8; ++ks) {
                const bf16x8 a = *(const bf16x8*)(B + KP_OFF + r * 272 + ks * 32 + h * 16);
                const bf16x8 bq = *(const bf16x8*)(B + QP_OFF + r * 272 + ks * 32 + h * 16);
                pt = __builtin_amdgcn_mfma_f32_32x32x16_bf16(a, bq, pt, 0, 0, 0);
            }
#pragma unroll
            for (int i = 0; i < 16; ++i) if (crow(i, h) > r) pt[i] = 0.f;
            f32x16 o;
#pragma unroll
            for (int i = 0; i < 16; ++i) o[i] = 0.f;
#pragma unroll
            for (int sp = 0; sp < 2; ++sp) {
                const char* vb = B + VT_OFF + (32 * w + r) * 80 + sp * 32 + h * 8;
                const bf16x8 bv = cat8(*(const s16x4*)vb, *(const s16x4*)(vb + 16));
                o = __builtin_amdgcn_mfma_f32_32x32x16_bf16(pack8(pt, 8 * sp), bv, o, 0, 0, 0);
            }
#pragma unroll
            for (int kb = 0; kb < 4; ++kb)
#pragma unroll
                for (int sp = 0; sp < 2; ++sp) {
                    const char* qb = B + QP_OFF + r * 272 + kb * 64 + sp * 32 + h * 8;
                    const bf16x8 aq = cat8(*(const s16x4*)qb, *(const s16x4*)(qb + 16));
                    o = __builtin_amdgcn_mfma_f32_32x32x16_bf16(aq, pack8(S[kb], 8 * sp), o, 0, 0, 0);
                }
#pragma unroll
            for (int i = 0; i < 16; ++i) ORAW[(size_t)(c * 32 + crow(i, h)) * DHG + 32 * w + r] = o[i];
#pragma unroll
            for (int kb = 0; kb < 4; ++kb) {
#pragma unroll
                for (int j = 0; j < 4; ++j) {
                    const f32x4 g4 = *(const f32x4*)(B + G_OFF + (kb * 32 + 8 * j + 4 * h) * 4);
                    S[kb][4 * j] *= g4.x; S[kb][4 * j + 1] *= g4.y; S[kb][4 * j + 2] *= g4.z; S[kb][4 * j + 3] *= g4.w;
                }
#pragma unroll
                for (int ks = 0; ks < 2; ++ks) {
                    const bf16x8 a = *(const bf16x8*)(B + KT_OFF + (kb * 32 + r) * 80 + ks * 32 + h * 16);
                    const bf16x8 bv = *(const bf16x8*)(B + VT_OFF + (32 * w + r) * 80 + ks * 32 + h * 16);
                    S[kb] = __builtin_amdgcn_mfma_f32_32x32x16_bf16(a, bv, S[kb], 0, 0, 0);
                }
            }
        }
        if (helper) { if (c + 1 < 64) HG_STORE((c + 1) & 1); }
        __syncthreads();
    }
}
template <int NJ>
DI void s5_gemm2_tile(const bf16x8 (&af)[16], const bf16_t* KTl, const bf16_t* Xin, const bf16_t* MBg, bf16_t* Yout, const int mi, const int r, const int h) {
    f32x16 y;
#pragma unroll
    for (int i = 0; i < 16; ++i) y[i] = 0.f;
    const int tsel = r >> 4, iq = r & 15;
#pragma unroll
    for (int ks = 0; ks <= 2 * NJ; ++ks) {
        const bf16x8 bk = *(const bf16x8*)(KTl + ((2 * NJ + tsel - ks) * 16 + iq) * 16 + 8 * h);
        y = __builtin_amdgcn_mfma_f32_32x32x16_bf16(af[ks], bk, y, 0, 0, 0);
    }
    {
        bf16x8 bk = *(const bf16x8*)(KTl + iq * 16 + 8 * h);
        if (tsel == 0) bk = (bf16x8){0, 0, 0, 0, 0, 0, 0, 0};
        y = __builtin_amdgcn_mfma_f32_32x32x16_bf16(af[2 * NJ + 1], bk, y, 0, 0, 0);
    }
#pragma unroll
    for (int ks = 0; ks < 8; ++ks) {
        const bf16x8 a = *(const bf16x8*)(Xin + (mi * 32 + r) * 136 + ks * 16 + 8 * h);
        const bf16x8 bm = *(const bf16x8*)(MBg + (size_t)(NJ * 32 + r) * 128 + ks * 16 + 8 * h);
        y = __builtin_amdgcn_mfma_f32_32x32x16_bf16(a, bm, y, 0, 0, 0);
    }
#pragma unroll
    for (int i = 0; i < 16; ++i) Yout[(size_t)((mi * 32 + crow(i, h)) * 16 + 2 * NJ + tsel) * DSS + iq] = f2bf(gelu_as(y[i]));
}
DI void s5_gemm_item(const Params& p, int b, int g, char* smem) {
    float* E = (float*)smem;
    bf16_t* Xin = (bf16_t*)(smem + 128 * 132 * 4);
    bf16_t* KTl = Xin + 128 * 136;
    const int tid = my_tid(), lane = tid & 63, wid = tid >> 6, r = lane & 31, h = lane >> 5;
    const int mi = wid >> 1, wh = wid & 1;
    const bf16_t* P = (const bf16_t*)(p.ws + OFF_PROJ);
    *(u32x4*)(KTl + tid * 8) = *(const u32x4*)((const bf16_t*)(p.ws + OFF_S5K) + (size_t)g * 4096 + tid * 8);
    bf16x8 af[16];
    {
        const bf16_t* ub = P + (size_t)(b * SEQ + (mi * 32 + r) * 16) * INC + 2048 + g * 16 + 8 * h;
#pragma unroll
        for (int ks = 0; ks < 16; ++ks) af[ks] = *(const bf16x8*)(ub + (size_t)ks * INC);
    }
    {
        f32x16 e0, e1;
#pragma unroll
        for (int i = 0; i < 16; ++i) { e0[i] = 0.f; e1[i] = 0.f; }
        const bf16_t* nb0 = (const bf16_t*)(p.ws + OFF_S5N) + ((size_t)g * 128 + wh * 64 + r) * 256 + 8 * h;
#pragma unroll
        for (int ks = 0; ks < 16; ++ks) {
            const bf16x8 b0 = *(const bf16x8*)(nb0 + ks * 16), b1 = *(const bf16x8*)(nb0 + 32 * 256 + ks * 16);
            e0 = __builtin_amdgcn_mfma_f32_32x32x16_bf16(af[ks], b0, e0, 0, 0, 0);
            e1 = __builtin_amdgcn_mfma_f32_32x32x16_bf16(af[ks], b1, e1, 0, 0, 0);
        }
#pragma unroll
        for (int i = 0; i < 16; ++i) { float* er = E + (mi * 32 + crow(i, h)) * 132 + wh * 64 + r; er[0] = e0[i]; er[32] = e1[i]; }
    }
    __syncthreads();
    if (wid == 0) {
        const float* L = (const float*)(p.ws + OFF_S5L) + (g * 64 + lane) * 2;
        const float lr = L[0], li = L[1];
        float xr = 0.f, xi = 0.f;
#pragma unroll 8
        for (int c = 0; c < 128; ++c) {
            const float er = E[c * 132 + lane], ei = E[c * 132 + 64 + lane];
            Xin[c * 136 + lane] = f2bf(xr); Xin[c * 136 + 64 + lane] = f2bf(xi);
            const float nr = lr * xr - li * xi + er, ni = lr * xi + li * xr + ei;
            xr = nr; xi = ni;
        }
    }
    __syncthreads();
    const bf16_t* MBg = (const bf16_t*)(p.ws + OFF_S5M) + (size_t)g * 256 * 128;
    bf16_t* Yout = (bf16_t*)(p.ws + OFF_YSSM) + (size_t)b * SEQ * DSS + g * 16;
    if (wh) {
        s5_gemm2_tile<1>(af, KTl, Xin, MBg, Yout, mi, r, h); s5_gemm2_tile<6>(af, KTl, Xin, MBg, Yout, mi, r, h);
        s5_gemm2_tile<3>(af, KTl, Xin, MBg, Yout, mi, r, h); s5_gemm2_tile<4>(af, KTl, Xin, MBg, Yout, mi, r, h);
    } else {
        s5_gemm2_tile<0>(af, KTl, Xin, MBg, Yout, mi, r, h); s5_gemm2_tile<7>(af, KTl, Xin, MBg, Yout, mi, r, h);
        s5_gemm2_tile<2>(af, KTl, Xin, MBg, Yout, mi, r, h); s5_gemm2_tile<5>(af, KTl, Xin, MBg, Yout, mi, r, h);
    }
    __syncthreads();
}
DI void phase_mix(const Params& p, int bid, int nb, char* smem) {
    if (nb == 256) {
        if (bid < 64) { hgrn_mfma_item(p, bid, smem); return; }
        const int j = bid - 64, x = j & 7, lb = j >> 3;
        for (int q = lb; q < 64; q += 24) s5_gemm_item(p, q & 15, x * 4 + (q >> 4), smem);
    } else {
        for (int it = bid; it < 64; it += nb) hgrn_mfma_item(p, it, smem);
        for (int q = bid; q < 512; q += nb) s5_gemm_item(p, q & 15, q >> 4, smem);
    }
}

DI void phase_glu(const Params& p, int bid, int nb, char* smem) {
    const bf16_t* Y = (const bf16_t*)(p.ws + OFF_YSSM);
    const bf16_t* W = (const bf16_t*)(p.ws + OFF_GLU);
    float* Y2 = (float*)(p.ws + OFF_H);
    constexpr int NTN = 4, NTM = NTOK / 128;
    for (int t = bid; t < NTM * NTN; t += nb) {
        const int mt = t / NTN, nt = t % NTN;
        const bf16_t* Yt = Y + (size_t)mt * 128 * DSS + nt * 128;
        float* Ot = Y2 + (size_t)mt * 128 * DSS + nt * 128;
        const float* gb = p.glu_b + nt * 128;
        gemm_block<2, 1, 2, 4>(Y + (size_t)mt * 128 * DSS, DSS, W + (size_t)nt * 128 * 512, 512, 512, smem,
                               [&](int r, int c, float v) { const float y = bf2f(Yt[(size_t)r * DSS + c]); Ot[(size_t)r * DSS + c] = y * sigmoidf_(v + gb[c]); });
        __syncthreads();
    }
}
DI void phase_a2(const Params& p, int bid, int nb) {
    const float* ORAW = (const float*)(p.ws + OFF_ORAW);
    const float* Y2 = (const float*)(p.ws + OFF_H);
    const bf16_t* P = (const bf16_t*)(p.ws + OFF_PROJ);
    bf16_t* A2 = (bf16_t*)(p.ws + OFF_A2);
    const int lane = my_tid() & 63, wid = my_tid() >> 6;
    for (int tok = bid * 8 + wid; tok < NTOK; tok += nb * 8) {
        const int c0 = lane * 8;
        {
            const float4 a = *(const float4*)(ORAW + (size_t)tok * DHG + c0), b = *(const float4*)(ORAW + (size_t)tok * DHG + c0 + 4);
            float ss = a.x * a.x + a.y * a.y + a.z * a.z + a.w * a.w + b.x * b.x + b.y * b.y + b.z * b.z + b.w * b.w;
            ss += __shfl_xor(ss, 1); ss += __shfl_xor(ss, 2); ss += __shfl_xor(ss, 4); ss += __shfl_xor(ss, 8);
            const float rs = rsqrtf(ss * (1.0f / 128.0f) + RMS_EPS);
            const uint4 gq = *(const uint4*)(P + (size_t)tok * INC + 1536 + c0);
            const float4 w0 = *(const float4*)(p.hg_nw + c0), w1 = *(const float4*)(p.hg_nw + c0 + 4);
            uint4 o;
            o.x = pack2(a.x * rs * w0.x * bflo(gq.x), a.y * rs * w0.y * bfhi(gq.x));
            o.y = pack2(a.z * rs * w0.z * bflo(gq.y), a.w * rs * w0.w * bfhi(gq.y));
            o.z = pack2(b.x * rs * w1.x * bflo(gq.z), b.y * rs * w1.y * bfhi(gq.z));
            o.w = pack2(b.z * rs * w1.z * bflo(gq.w), b.w * rs * w1.w * bfhi(gq.w));
            *(uint4*)(A2 + (size_t)tok * DM + c0) = o;
        }
        {
            const float4 a = *(const float4*)(Y2 + (size_t)tok * DSS + c0), b = *(const float4*)(Y2 + (size_t)tok * DSS + c0 + 4);
            float ss = a.x * a.x + a.y * a.y + a.z * a.z + a.w * a.w + b.x * b.x + b.y * b.y + b.z * b.z + b.w * b.w;
#pragma unroll
            for (int m = 1; m < 64; m <<= 1) ss += __shfl_xor(ss, m);
            const float rs = rsqrtf(ss * (1.0f / 512.0f) + RMS_EPS);
            const float4 w0 = *(const float4*)(p.ssm_nw + c0), w1 = *(const float4*)(p.ssm_nw + c0 + 4);
            uint4 o;
            o.x = pack2(a.x * rs * w0.x, a.y * rs * w0.y); o.y = pack2(a.z * rs * w0.z, a.w * rs * w0.w);
            o.z = pack2(b.x * rs * w1.x, b.y * rs * w1.y); o.w = pack2(b.z * rs * w1.z, b.w * rs * w1.w);
            *(uint4*)(A2 + (size_t)tok * DM + 512 + c0) = o;
        }
    }
}

DI void phase_outproj(const Params& p, int bid, int nb, char* smem) {
    const bf16_t* A2 = (const bf16_t*)(p.ws + OFF_A2);
    const bf16_t* W = (const bf16_t*)(p.ws + OFF_WOUT);
    const float* mod = (const float*)(p.ws + OFF_MOD);
    constexpr int NTN = 8, NTM = NTOK / 128;
    for (int t = bid; t < NTM * NTN; t += nb) {
        const int mt = t / NTN, nt = t % NTN, b = (mt * 128) / SEQ;
        const float* xt = p.x + (size_t)mt * 128 * DM + nt * 128;
        float* ot = p.out + (size_t)mt * 128 * DM + nt * 128;
        const float* g1 = mod + b * 6144 + 2048 + nt * 128;
        gemm_block<2, 1, 2, 4>(A2 + (size_t)mt * 128 * DM, DM, W + (size_t)nt * 128 * DM, DM, DM, smem,
                               [&](int r, int c, float v) { ot[(size_t)r * DM + c] = DEEP_ALPHA * xt[(size_t)r * DM + c] + (1.0f + g1[c]) * v; });
        __syncthreads();
    }
}
DI void phase_ln1(const Params& p, int bid, int nb) {
    const float* mod = (const float*)(p.ws + OFF_MOD);
    bf16_t* H2 = (bf16_t*)(p.ws + OFF_H);
    const int lane = my_tid() & 63, wid = my_tid() >> 6;
    for (int tok = bid * 8 + wid; tok < NTOK; tok += nb * 8) {
        const int b = tok / SEQ;
        float* row = p.out + (size_t)tok * DM;
        float4 v[4];
        float s = 0.f;
#pragma unroll
        for (int j = 0; j < 4; ++j) { v[j] = *(const float4*)(row + j * 256 + lane * 4); s += v[j].x + v[j].y + v[j].z + v[j].w; }
#pragma unroll
        for (int m = 1; m < 64; m <<= 1) s += __shfl_xor(s, m);
        const float mu = s * (1.0f / 1024.0f);
        float q = 0.f;
#pragma unroll
        for (int j = 0; j < 4; ++j) { const float a = v[j].x - mu, bb = v[j].y - mu, cc = v[j].z - mu, d = v[j].w - mu; q += a * a + bb * bb + cc * cc + d * d; }
#pragma unroll
        for (int m = 1; m < 64; m <<= 1) q += __shfl_xor(q, m);
        const float rstd = rsqrtf(q * (1.0f / 1024.0f) + LN_EPS);
        const float* sh2 = mod + b * 6144 + 3072;
        const float* sc2 = mod + b * 6144 + 4096;
#pragma unroll
        for (int j = 0; j < 4; ++j) {
            const int c = j * 256 + lane * 4;
            const float4 w = *(const float4*)(p.ln1w + c), bi = *(const float4*)(p.ln1b + c), sc = *(const float4*)(sc2 + c), sh = *(const float4*)(sh2 + c);
            float4 o;
            o.x = (v[j].x - mu) * rstd * w.x + bi.x; o.y = (v[j].y - mu) * rstd * w.y + bi.y; o.z = (v[j].z - mu) * rstd * w.z + bi.z; o.w = (v[j].w - mu) * rstd * w.w + bi.w;
            *(float4*)(row + c) = o;
            uint2 hh; hh.x = pack2(o.x * (1.f + sc.x) + sh.x, o.y * (1.f + sc.y) + sh.y); hh.y = pack2(o.z * (1.f + sc.z) + sh.z, o.w * (1.f + sc.w) + sh.w);
            *(uint2*)(H2 + (size_t)tok * DM + c) = hh;
        }
    }
}

DI void phase_q(const Params& p, int bid, int nb, char* smem) {
    const bf16_t* H2 = (const bf16_t*)(p.ws + OFF_H);
    const bf16_t* W = (const bf16_t*)(p.ws + OFF_WQ);
    bf16_t* Q = (bf16_t*)(p.ws + OFF_PROJ);
    constexpr int NTN = 16, NTM = NTOK / 128;
    for (int t = bid; t < NTM * NTN; t += nb) {
        const int mt = t / NTN, nt = t % NTN;
        bf16_t* Qt = Q + (size_t)mt * 128 * 2048 + nt * 128;
        gemm_block<2, 1, 2, 4>(H2 + (size_t)mt * 128 * DM, DM, W + (size_t)nt * 128 * DM, DM, DM, smem,
                               [&](int r, int c, float v) { Qt[(size_t)r * 2048 + c] = f2bf(v); });
        __syncthreads();
    }
}
DI void phase_topk(const Params& p, int bid, int nb, char* smem) {
    const bf16_t* Q = (const bf16_t*)(p.ws + OFF_PROJ);
    const bf16_t* SK = (const bf16_t*)(p.ws + OFF_SUBK);
    unsigned* TOPL = (unsigned*)(p.ws + OFF_TOPL);
    float* sc = (float*)(smem + 36864);
    constexpr int NTM = NTOK / 128;
    for (int t = bid; t < NTM * 16; t += nb) {
        const int mt = t >> 4, hp = t & 15;
        gemm_block<2, 1, 2, 4>(Q + (size_t)mt * 128 * 2048 + hp * 128, 2048, SK + (size_t)hp * 128 * 128, 128, 128, smem,
                               [&](int r, int c, float v) { sc[r * 129 + c] = v; });
        __syncthreads();
        if (my_tid() < 128) {
            const int r = my_tid();
            float tk[16];
#pragma unroll
            for (int j = 0; j < 16; ++j) tk[j] = -3.0e38f;
            for (int n = 0; n < 128; ++n) {
                float xv = __uint_as_float((__float_as_uint(sc[r * 129 + n]) & ~0x7fu) | (unsigned)n);
#pragma unroll
                for (int j = 0; j < 16; ++j) { const float hi = fmaxf(tk[j], xv), lo = fminf(tk[j], xv); tk[j] = hi; xv = lo; }
            }
            uint4* dst = (uint4*)(TOPL + ((size_t)(mt * 128 + r) * 16 + hp) * 16);
            dst[0] = make_uint4(__float_as_uint(tk[0]), __float_as_uint(tk[1]), __float_as_uint(tk[2]), __float_as_uint(tk[3]));
            dst[1] = make_uint4(__float_as_uint(tk[4]), __float_as_uint(tk[5]), __float_as_uint(tk[6]), __float_as_uint(tk[7]));
            dst[2] = make_uint4(__float_as_uint(tk[8]), __float_as_uint(tk[9]), __float_as_uint(tk[10]), __float_as_uint(tk[11]));
            dst[3] = make_uint4(__float_as_uint(tk[12]), __float_as_uint(tk[13]), __float_as_uint(tk[14]), __float_as_uint(tk[15]));
        }
        __syncthreads();
    }
}
DI void phase_combine(const Params& p, int bid, int nb) {
    const unsigned* TOPL = (const unsigned*)(p.ws + OFF_TOPL);
    uint2* EX = (uint2*)(p.ws + OFF_EXPS);
    const float* SU = (const float*)(p.ws + OFF_SU);
    const float* SV = (const float*)(p.ws + OFF_SV);
    for (int i = bid * NTH + my_tid(); i < NTOK * PHEADS; i += nb * NTH) {
        const unsigned* l1 = TOPL + (size_t)i * 32;
        const unsigned* l2 = l1 + 16;
        float s2[16];
        {
            const uint4 a = ((const uint4*)l2)[0], b = ((const uint4*)l2)[1], c = ((const uint4*)l2)[2], d = ((const uint4*)l2)[3];
            const unsigned w[16] = {a.x, a.y, a.z, a.w, b.x, b.y, b.z, b.w, c.x, c.y, c.z, c.w, d.x, d.y, d.z, d.w};
#pragma unroll
            for (int j = 0; j < 16; ++j) s2[j] = __uint_as_float(w[j] & ~0x7fu);
        }
        float tk[16];
#pragma unroll
        for (int j = 0; j < 16; ++j) tk[j] = -3.0e38f;
        for (int a = 0; a < 16; ++a) {
            const float s1 = __uint_as_float(l1[a] & ~0x7fu);
#pragma unroll
            for (int b = 0; b < 16; ++b) {
                float xv = __uint_as_float((__float_as_uint(s1 + s2[b]) & ~0xffu) | (unsigned)(a * 16 + b));
#pragma unroll
                for (int j = 0; j < 16; ++j) { const float hi = fmaxf(tk[j], xv), lo = fminf(tk[j], xv); tk[j] = hi; xv = lo; }
            }
        }
        float e[16], sum = 0.f;
        const float mx = __uint_as_float(__float_as_uint(tk[0]) & ~0xffu);
#pragma unroll
        for (int j = 0; j < 16; ++j) { e[j] = __expf(__uint_as_float(__float_as_uint(tk[j]) & ~0xffu) - mx); sum += e[j]; }
        const float inv = 1.0f / sum;
#pragma unroll
        for (int j = 0; j < 16; ++j) {
            const unsigned ab = __float_as_uint(tk[j]) & 0xffu;
            const unsigned i1 = l1[ab >> 4] & 0x7fu, i2 = l2[ab & 15] & 0x7fu;
            const unsigned eid = i1 * 128u + i2;
            EX[(size_t)i * 16 + j] = make_uint2(eid | (((__float_as_uint(SU[eid]) >> 23) & 0xffu) << 16), __float_as_uint(e[j] * inv * SV[eid]));
        }
    }
}

DI float dot16_fp8(const u32x4 w, const f32x2 (&h)[8]) {
    f32x2 acc = __builtin_amdgcn_cvt_pk_f32_fp8((int)w.x, false) * h[0];
    acc += __builtin_amdgcn_cvt_pk_f32_fp8((int)w.x, true) * h[1];
    acc += __builtin_amdgcn_cvt_pk_f32_fp8((int)w.y, false) * h[2];
    acc += __builtin_amdgcn_cvt_pk_f32_fp8((int)w.y, true) * h[3];
    acc += __builtin_amdgcn_cvt_pk_f32_fp8((int)w.z, false) * h[4];
    acc += __builtin_amdgcn_cvt_pk_f32_fp8((int)w.z, true) * h[5];
    acc += __builtin_amdgcn_cvt_pk_f32_fp8((int)w.w, false) * h[6];
    acc += __builtin_amdgcn_cvt_pk_f32_fp8((int)w.w, true) * h[7];
    return acc.x + acc.y;
}
DI void axpy16_fp8(const float a, const u32x4 w, f32x2 (&o)[8]) {
    const f32x2 aa = {a, a};
    o[0] += aa * __builtin_amdgcn_cvt_pk_f32_fp8((int)w.x, false); o[1] += aa * __builtin_amdgcn_cvt_pk_f32_fp8((int)w.x, true);
    o[2] += aa * __builtin_amdgcn_cvt_pk_f32_fp8((int)w.y, false); o[3] += aa * __builtin_amdgcn_cvt_pk_f32_fp8((int)w.y, true);
    o[4] += aa * __builtin_amdgcn_cvt_pk_f32_fp8((int)w.z, false); o[5] += aa * __builtin_amdgcn_cvt_pk_f32_fp8((int)w.z, true);
    o[6] += aa * __builtin_amdgcn_cvt_pk_f32_fp8((int)w.w, false); o[7] += aa * __builtin_amdgcn_cvt_pk_f32_fp8((int)w.w, true);
}
DI float butterfly64(float (&pz)[64], const int lane) {
    const bool b5 = lane & 32, b4 = lane & 16, b3 = lane & 8, b2 = lane & 4, b1 = lane & 2, b0 = lane & 1;
    float q32[32], q16[16], q8[8], q4[4], q2[2];
#pragma unroll
    for (int j = 0; j < 32; ++j) q32[j] = (b5 ? pz[32 + j] : pz[j]) + __shfl_xor(b5 ? pz[j] : pz[32 + j], 32);
#pragma unroll
    for (int j = 0; j < 16; ++j) q16[j] = (b4 ? q32[16 + j] : q32[j]) + __shfl_xor(b4 ? q32[j] : q32[16 + j], 16);
#pragma unroll
    for (int j = 0; j < 8; ++j) q8[j] = (b3 ? q16[8 + j] : q16[j]) + __shfl_xor(b3 ? q16[j] : q16[8 + j], 8);
#pragma unroll
    for (int j = 0; j < 4; ++j) q4[j] = (b2 ? q8[4 + j] : q8[j]) + __shfl_xor(b2 ? q8[j] : q8[4 + j], 4);
#pragma unroll
    for (int j = 0; j < 2; ++j) q2[j] = (b1 ? q4[2 + j] : q4[j]) + __shfl_xor(b1 ? q4[j] : q4[2 + j], 2);
    return (b0 ? q2[1] : q2[0]) + __shfl_xor(b0 ? q2[0] : q2[1], 1);
}
DI void phase_gather(const Params& p, int bid, int nb) {
    const float* mod = (const float*)(p.ws + OFF_MOD);
    const uint2* EX = (const uint2*)(p.ws + OFF_EXPS);
    const unsigned char* UT = (const unsigned char*)(p.ws + OFF_UT);
    const unsigned char* VT = (const unsigned char*)(p.ws + OFF_VT);
    const int lane = my_tid() & 63, wid = my_tid() >> 6;
    for (int tok = bid * 8 + wid; tok < NTOK; tok += nb * 8) {
        const int b = tok / SEQ, c0 = lane * 16;
        float* row = p.out + (size_t)tok * DM + c0;
        const float* sh2 = mod + b * 6144 + 3072 + c0;
        const float* sc2 = mod + b * 6144 + 4096 + c0;
        const float* g2 = mod + b * 6144 + 5120 + c0;
        f32x2 x1[8], h2[8], acc[8];
#pragma unroll
        for (int q = 0; q < 4; ++q) {
            const f32x4 xv = *(const f32x4*)(row + q * 4), sc = *(const f32x4*)(sc2 + q * 4), sh = *(const f32x4*)(sh2 + q * 4);
            x1[2 * q] = (f32x2){xv.x, xv.y}; x1[2 * q + 1] = (f32x2){xv.z, xv.w};
            h2[2 * q] = (f32x2){xv.x * (1.f + sc.x) + sh.x, xv.y * (1.f + sc.y) + sh.y};
            h2[2 * q + 1] = (f32x2){xv.z * (1.f + sc.z) + sh.z, xv.w * (1.f + sc.w) + sh.w};
        }
#pragma unroll
        for (int i = 0; i < 8; ++i) acc[i] = (f32x2){0.f, 0.f};
        const uint2 e0 = EX[(size_t)tok * 128 + lane], e1 = EX[(size_t)tok * 128 + 64 + lane];
        float a0, a1;
        {
            float pz[64];
#pragma unroll
            for (int e = 0; e < 64; ++e) {
                const unsigned eid = (unsigned)__builtin_amdgcn_readlane((int)e0.x, e) & 0xffffu;
                pz[e] = dot16_fp8(*(const u32x4*)(UT + (size_t)eid * DM + c0), h2);
            }
            const float z = butterfly64(pz, lane) * __uint_as_float(((e0.x >> 16) & 0xffu) << 23);
            a0 = geluf_(z) * __uint_as_float(e0.y);
        }
        {
            float pz[64];
#pragma unroll
            for (int e = 0; e < 64; ++e) {
                const unsigned eid = (unsigned)__builtin_amdgcn_readlane((int)e1.x, e) & 0xffffu;
                pz[e] = dot16_fp8(*(const u32x4*)(UT + (size_t)eid * DM + c0), h2);
            }
            const float z = butterfly64(pz, lane) * __uint_as_float(((e1.x >> 16) & 0xffu) << 23);
            a1 = geluf_(z) * __uint_as_float(e1.y);
        }
#pragma unroll 16
        for (int e = 0; e < 64; ++e) {
            const unsigned eid = (unsigned)__builtin_amdgcn_readlane((int)e0.x, e) & 0xffffu;
            const float a = __uint_as_float(__builtin_amdgcn_readlane((int)__float_as_uint(a0), e));
            axpy16_fp8(a, *(const u32x4*)(VT + (size_t)eid * DM + c0), acc);
        }
#pragma unroll 16
        for (int e = 0; e < 64; ++e) {
            const unsigned eid = (unsigned)__builtin_amdgcn_readlane((int)e1.x, e) & 0xffffu;
            const float a = __uint_as_float(__builtin_amdgcn_readlane((int)__float_as_uint(a1), e));
            axpy16_fp8(a, *(const u32x4*)(VT + (size_t)eid * DM + c0), acc);
        }
        f32x2 r[8];
        float s = 0.f;
#pragma unroll
        for (int q = 0; q < 4; ++q) {
            const f32x4 gg = *(const f32x4*)(g2 + q * 4);
            r[2 * q] = DEEP_ALPHA * x1[2 * q] + (f32x2){1.f + gg.x, 1.f + gg.y} * acc[2 * q];
            r[2 * q + 1] = DEEP_ALPHA * x1[2 * q + 1] + (f32x2){1.f + gg.z, 1.f + gg.w} * acc[2 * q + 1];
            s += r[2 * q].x + r[2 * q].y + r[2 * q + 1].x + r[2 * q + 1].y;
        }
#pragma unroll
        for (int m = 1; m < 64; m <<= 1) s += __shfl_xor(s, m);
        const float mu = s * (1.0f / 1024.0f);
        float qq = 0.f;
#pragma unroll
        for (int i = 0; i < 8; ++i) { const f32x2 d = r[i] - mu; qq += d.x * d.x + d.y * d.y; }
#pragma unroll
        for (int m = 1; m < 64; m <<= 1) qq += __shfl_xor(qq, m);
        const float rstd = rsqrtf(qq * (1.0f / 1024.0f) + LN_EPS);
#pragma unroll
        for (int q = 0; q < 4; ++q) {
            const f32x4 w = *(const f32x4*)(p.ln2w + c0 + q * 4), bi = *(const f32x4*)(p.ln2b + c0 + q * 4);
            f32x4 ov;
            ov.x = (r[2 * q].x - mu) * rstd * w.x + bi.x; ov.y = (r[2 * q].y - mu) * rstd * w.y + bi.y;
            ov.z = (r[2 * q + 1].x - mu) * rstd * w.z + bi.z; ov.w = (r[2 * q + 1].y - mu) * rstd * w.w + bi.w;
            *(f32x4*)(row + q * 4) = ov;
        }
    }
}

__global__ void __launch_bounds__(NTH) k_mega(Params p) {
    __shared__ __attribute__((aligned(16))) char smem[SMEM_BYTES];
    cg::grid_group grid = cg::this_grid();
    const int bid = blockIdx.x, nb = gridDim.x;
#ifndef PROBE_MASK
#define PROBE_MASK 0
#endif
#define REP(bit) for (int rep_ = 0; rep_ < ((PROBE_MASK & (bit)) ? 2 : 1); ++rep_)
    REP(64) { phase_prep(p, bid, nb, smem);    grid.sync(); }
    REP(64) { phase_h(p, bid, nb);             grid.sync(); }
    REP(1)  { phase_proj(p, bid, nb, smem);    grid.sync(); }
    REP(2)  { phase_hgprep(p, bid, nb);        grid.sync(); }
    REP(2)  { phase_mix(p, bid, nb, smem);     grid.sync(); }
    REP(4)  { phase_glu(p, bid, nb, smem);     grid.sync(); }
    REP(4)  { phase_a2(p, bid, nb);            grid.sync(); }
    REP(4)  { phase_outproj(p, bid, nb, smem); grid.sync(); }
    phase_ln1(p, bid, nb);           grid.sync();
    REP(8)  { phase_q(p, bid, nb, smem);       grid.sync(); }
    REP(16) { phase_topk(p, bid, nb, smem);    grid.sync(); }
    REP(32) { phase_combine(p, bid, nb);       grid.sync(); }
    phase_gather(p, bid, nb);
}

extern "C" void kernel_launch(void* const* d_in, const int* in_sizes, int n_in, void* d_out, int out_size, void* d_ws, size_t ws_size, hipStream_t stream) {
    if (n_in != 27 || ws_size < WS_END) { fprintf(stderr, "kernel_launch: unexpected n_in %d or ws_size %zu (< %zu)\n", n_in, ws_size, (size_t)WS_END); return; }
    static int grid_blocks = 0;
    if (!grid_blocks) {
        int dev = 0, cus = 0, per_cu = 0;
        (void)hipGetDevice(&dev);
        (void)hipDeviceGetAttribute(&cus, hipDeviceAttributeMultiprocessorCount, dev);
        (void)hipOccupancyMaxActiveBlocksPerMultiprocessor(&per_cu, k_mega, NTH, 0);
        if (cus <= 0) cus = 256;
        if (per_cu < 1) { fprintf(stderr, "kernel_launch: occupancy query says %d blocks/CU\n", per_cu); per_cu = 1; }
        grid_blocks = cus;
    }
    Params p{};
    const float** f = (const float**)&p;
    for (int i = 0; i < 27; ++i) f[i] = (const float*)d_in[i];
    p.out = (float*)d_out; p.ws = (char*)d_ws;
    void* args[] = {&p};
    hipError_t e = hipLaunchCooperativeKernel((void*)k_mega, dim3(grid_blocks), dim3(NTH), args, 0, stream);
    if (e != hipSuccess) fprintf(stderr, "cooperative launch failed: %s (grid %d)\n", hipGetErrorString(e), grid_blocks);
}
```

```cpp
#include <hip/hip_runtime.h>
#include <hip/hip_cooperative_groups.h>
#include <stdint.h>
#include <stdio.h>

namespace cg = cooperative_groups;
#define DI __device__ __forceinline__
typedef unsigned short bf16_t;
typedef short bf16x8 __attribute__((ext_vector_type(8)));
typedef float f32x16 __attribute__((ext_vector_type(16)));
typedef unsigned u32x4 __attribute__((ext_vector_type(4)));
typedef float f32x4 __attribute__((ext_vector_type(4)));
typedef float f32x2 __attribute__((ext_vector_type(2)));

constexpr int NTH = 512;
constexpr int NB = 16, SEQ = 2048, DM = 1024, NTOK = NB * SEQ;
constexpr int DHG = 512, HGH = 4, HDK = 128;
constexpr int DSS = 512, SSG = 32, SSC = 16, SSP = 64;
constexpr int INC = 2560;
constexpr int PHEADS = 8, NKEYS = 128, TOPK = 16, NEXP = 16384;
constexpr float DEEP_ALPHA = 1.189207115002721f;
constexpr float LN_EPS = 1e-5f, RMS_EPS = 1e-6f;
constexpr int SMEM_BYTES = 128 * 1024;

constexpr size_t al256(size_t x) { return (x + 255) & ~(size_t)255; }
constexpr size_t OFF_MOD = 0;
constexpr size_t OFF_LB = al256(OFF_MOD + (size_t)NB * 6144 * 4);
constexpr size_t OFF_LAM = al256(OFF_LB + 512 * 4);
constexpr size_t OFF_BB = al256(OFF_LAM + 32 * 64 * 2 * 4);
constexpr size_t OFF_WIN = al256(OFF_BB + 32 * 64 * 16 * 2 * 4);
constexpr size_t OFF_GLU = al256(OFF_WIN + (size_t)INC * DM * 2);
constexpr size_t OFF_WOUT = al256(OFF_GLU + (size_t)512 * 512 * 2);
constexpr size_t OFF_WQ = al256(OFF_WOUT + (size_t)DM * DM * 2);
constexpr size_t OFF_SUBK = al256(OFF_WQ + (size_t)2048 * DM * 2);
constexpr size_t OFF_SU = al256(OFF_SUBK + (size_t)16 * 128 * 128 * 2);
constexpr size_t OFF_SV = al256(OFF_SU + (size_t)NEXP * 4);
constexpr size_t OFF_UT = al256(OFF_SV + (size_t)NEXP * 4);
constexpr size_t OFF_VT = al256(OFF_UT + (size_t)NEXP * DM * 2);
constexpr size_t OFF_H = al256(OFF_VT + (size_t)NEXP * DM * 2);
constexpr size_t OFF_PROJ = al256(OFF_H + (size_t)NTOK * DM * 2);
constexpr size_t OFF_ORAW = al256(OFF_PROJ + (size_t)NTOK * INC * 2);
constexpr size_t OFF_YSSM = al256(OFF_ORAW + (size_t)NTOK * DHG * 4);
constexpr size_t OFF_A2 = al256(OFF_YSSM + (size_t)NTOK * DSS * 2);
constexpr size_t OFF_HG = al256(OFF_A2 + (size_t)NTOK * DM * 2);
constexpr size_t OFF_S5K = al256(OFF_HG + (size_t)4096 * 128 * 4);
constexpr size_t OFF_S5N = al256(OFF_S5K + (size_t)32 * 4096 * 2);
constexpr size_t OFF_S5M = al256(OFF_S5N + (size_t)32 * 128 * 256 * 2);
constexpr size_t OFF_S5L = al256(OFF_S5M + (size_t)32 * 256 * 128 * 2);
constexpr size_t OFF_BAR = al256(OFF_S5L + (size_t)32 * 64 * 2 * 4);
constexpr size_t WS_END = al256(OFF_BAR + (size_t)3456 * 4);
constexpr size_t OFF_HQ = OFF_H, OFF_HK = OFF_H + (size_t)NTOK * DHG * 2, OFF_HKT = OFF_A2, OFF_HVT = OFF_A2 + (size_t)NTOK * DHG * 2;
constexpr size_t OFF_TOPL = OFF_ORAW;
constexpr size_t OFF_EXPS = OFF_ORAW + (size_t)NTOK * 16 * 16 * 4;

struct Params {
    const float *x, *c, *ada_w, *ada_b, *w_in, *hg_lb, *hg_nw, *a_re, *a_im, *log_dt, *b_re, *b_im, *c_re, *c_im, *dsk,
        *glu_w, *glu_b, *ssm_nw, *w_out, *ln1w, *ln1b, *w_q, *subk, *pu, *pv, *ln2w, *ln2b;
    float* out;
    char* ws;
};

DI int my_tid() { int t = (int)__builtin_amdgcn_workitem_id_x(); asm volatile("" : "+v"(t)); return t; }
DI bf16_t f2bf(float x) { unsigned u = __float_as_uint(x); u += 0x7fffu + ((u >> 16) & 1u); return (bf16_t)(u >> 16); }
DI float bf2f(bf16_t b) { return __uint_as_float(((unsigned)b) << 16); }
DI float bflo(unsigned w) { return __uint_as_float(w << 16); }
DI float bfhi(unsigned w) { return __uint_as_float(w & 0xffff0000u); }
typedef __bf16 hwbf16x2 __attribute__((ext_vector_type(2)));
DI unsigned pack2(float a, float b) { const f32x2 v = {a, b}; return __builtin_bit_cast(unsigned, __builtin_convertvector(v, hwbf16x2)); }
DI bf16x8 pack8(const f32x16& x, const int base) {
    u32x4 o; o.x = pack2(x[base], x[base + 1]); o.y = pack2(x[base + 2], x[base + 3]); o.z = pack2(x[base + 4], x[base + 5]); o.w = pack2(x[base + 6], x[base + 7]);
    return __builtin_bit_cast(bf16x8, o);
}
DI float sigmoidf_(float x) { return 1.0f / (1.0f + __expf(-x)); }
DI float siluf_(float x) { return x * sigmoidf_(x); }
DI float geluf_(float x) { return 0.5f * x * (1.0f + erff(x * 0.70710678118654752f)); }
DI float gelu_as(float v) {
    const float t = __builtin_amdgcn_rcpf(fabsf(v) * 0.2316418882f + 1.0f);
    float q = t * 0.5307027145f + (-0.7265760135f); q = q * t + 0.7107068705f; q = q * t + (-0.142248368f); q = q * t + 0.127414796f; q = q * t;
    const float m = v * (q * __builtin_amdgcn_exp2f(v * v * (-0.72134752044f)));
    return v < 0.f ? m : v - m;
}

template <int MT, int NT_, int WM, int WN, class Epi>
DI void gemm_block(const bf16_t* __restrict__ A, int lda, const bf16_t* __restrict__ Bt, int ldb, int K, char* smem, Epi epi) {
    constexpr int BM = WM * MT * 32, BN = WN * NT_ * 32, LS = 72;
    static_assert(WM * WN == 8, "8 waves");
    bf16_t* As = (bf16_t*)smem;
    bf16_t* Bs = As + BM * LS;
    const int tid = my_tid(), lane = tid & 63, wid = tid >> 6, r = lane & 31, h = lane >> 5;
    const int wm = wid / WN, wn = wid % WN;
    constexpr int PA = BM * 8 / NTH, PB = BN * 8 / NTH;
    u32x4 ra[PA], rb[PB];
    f32x16 acc[MT][NT_];
#pragma unroll
    for (int mi = 0; mi < MT; ++mi)
#pragma unroll
        for (int ni = 0; ni < NT_; ++ni)
#pragma unroll
            for (int i = 0; i < 16; ++i) acc[mi][ni][i] = 0.f;
#define GEMM_GLOAD(kt_) { \
    _Pragma("unroll") for (int q = 0; q < PA; ++q) { const int idx = tid + q * NTH, row = idx >> 3, ch = idx & 7; ra[q] = *(const u32x4*)(A + (size_t)row * lda + (kt_) * 64 + ch * 8); } \
    _Pragma("unroll") for (int q = 0; q < PB; ++q) { const int idx = tid + q * NTH, row = idx >> 3, ch = idx & 7; rb[q] = *(const u32x4*)(Bt + (size_t)row * ldb + (kt_) * 64 + ch * 8); } }
#define GEMM_LSTORE() { \
    _Pragma("unroll") for (int q = 0; q < PA; ++q) { const int idx = tid + q * NTH, row = idx >> 3, ch = idx & 7; *(u32x4*)(As + row * LS + ch * 8) = ra[q]; } \
    _Pragma("unroll") for (int q = 0; q < PB; ++q) { const int idx = tid + q * NTH, row = idx >> 3, ch = idx & 7; *(u32x4*)(Bs + row * LS + ch * 8) = rb[q]; } }
    GEMM_GLOAD(0); GEMM_LSTORE(); __syncthreads();
    const int nk = K / 64;
    for (int kt = 0; kt < nk; ++kt) {
        if (kt + 1 < nk) GEMM_GLOAD(kt + 1);
#pragma unroll
        for (int ks = 0; ks < 4; ++ks) {
            bf16x8 a[MT], b[NT_];
#pragma unroll
            for (int mi = 0; mi < MT; ++mi) a[mi] = *(const bf16x8*)(As + (wm * MT * 32 + mi * 32 + r) * LS + ks * 16 + h * 8);
#pragma unroll
            for (int ni = 0; ni < NT_; ++ni) b[ni] = *(const bf16x8*)(Bs + (wn * NT_ * 32 + ni * 32 + r) * LS + ks * 16 + h * 8);
#pragma unroll
            for (int mi = 0; mi < MT; ++mi)
#pragma unroll
                for (int ni = 0; ni < NT_; ++ni) acc[mi][ni] = __builtin_amdgcn_mfma_f32_32x32x16_bf16(a[mi], b[ni], acc[mi][ni], 0, 0, 0);
        }
        __syncthreads();
        if (kt + 1 < nk) { GEMM_LSTORE(); __syncthreads(); }
    }
#pragma unroll
    for (int mi = 0; mi < MT; ++mi)
#pragma unroll
        for (int ni = 0; ni < NT_; ++ni)
#pragma unroll
            for (int i = 0; i < 16; ++i) epi(wm * MT * 32 + mi * 32 + (i & 3) + 8 * (i >> 2) + 4 * h, wn * NT_ * 32 + ni * 32 + r, acc[mi][ni][i]);
}

DI void prep_mod_item(const Params& p, int item, char* smem) {
    float* cond = (float*)smem;
    const int tid = my_tid();
    for (int i = tid; i < NB * DM; i += NTH) cond[i] = siluf_(p.c[i]);
    __syncthreads();
    const int b = tid >> 5, col = item * 32 + (tid & 31);
    float acc = 0.f;
    const float* w = p.ada_w + col;
    const float* cb = cond + b * DM;
#pragma unroll 8
    for (int k = 0; k < DM; ++k) acc += cb[k] * w[(size_t)k * 6144];
    ((float*)(p.ws + OFF_MOD))[b * 6144 + col] = acc + p.ada_b[col];
    __syncthreads();
}
DI void prep_s5_gemm_item(const Params& p, int g, char* smem) {
    f32x2* pw = (f32x2*)smem;
    f32x2* bbL = pw + 17 * 64;
    f32x2* cL = bbL + 64 * 16;
    const int tid = my_tid();
    const float dt = expf(p.log_dt[g]);
#pragma unroll 1
    for (int idx = tid; idx < 17 * 64; idx += NTH) {
        const int j = idx >> 6, pp = idx & 63;
        const float ar = p.a_re[g * 64 + pp], ai = p.a_im[g * 64 + pp];
        const float mag = expf(ar * dt * (float)j), ang = ai * dt * (float)j;
        pw[idx] = (f32x2){mag * cosf(ang), mag * sinf(ang)};
    }
    for (int idx = tid; idx < 16 * 64; idx += NTH) { const int i = idx >> 6, pp = idx & 63; cL[idx] = (f32x2){p.c_re[(g * 16 + i) * 64 + pp], p.c_im[(g * 16 + i) * 64 + pp]}; }
    __syncthreads();
    for (int idx = tid; idx < 64 * 16; idx += NTH) {
        const int pp = idx >> 4, i = idx & 15;
        const float ar = p.a_re[g * 64 + pp], ai = p.a_im[g * 64 + pp];
        const f32x2 lam = pw[64 + pp];
        const float den = ar * ar + ai * ai, nr = lam.x - 1.0f, ni = lam.y;
        const float zr = (nr * ar + ni * ai) / den, zi = (ni * ar - nr * ai) / den;
        const float br = p.b_re[(g * 64 + pp) * 16 + i], bi = p.b_im[(g * 64 + pp) * 16 + i];
        bbL[idx] = (f32x2){zr * br - zi * bi, zr * bi + zi * br};
    }
    __syncthreads();
    bf16_t* NBg = (bf16_t*)(p.ws + OFF_S5N) + (size_t)g * 128 * 256;
#pragma unroll 1
    for (int ch = tid; ch < 128 * 256 / 8; ch += NTH) {
        const int pq = ch >> 5, t = (ch >> 1) & 15, i0 = (ch & 1) * 8, pp = pq & 63;
        const f32x2 w = pw[(15 - t) * 64 + pp];
        float v[8];
#pragma unroll
        for (int e = 0; e < 8; ++e) { const f32x2 bb = bbL[pp * 16 + i0 + e]; v[e] = pq < 64 ? (w.x * bb.x - w.y * bb.y) : (w.x * bb.y + w.y * bb.x); }
        u32x4 o; o.x = pack2(v[0], v[1]); o.y = pack2(v[2], v[3]); o.z = pack2(v[4], v[5]); o.w = pack2(v[6], v[7]);
        *(u32x4*)(NBg + (size_t)pq * 256 + t * 16 + i0) = o;
    }
    bf16_t* MBg = (bf16_t*)(p.ws + OFF_S5M) + (size_t)g * 256 * 128;
#pragma unroll 1
    for (int ch = tid; ch < 256 * 128 / 8; ch += NTH) {
        const int ti = ch >> 4, p0 = (ch & 15) * 8, tq = ti >> 4, iq = ti & 15;
        float v[8];
#pragma unroll
        for (int e = 0; e < 8; ++e) {
            const int pq = p0 + e, pp = pq & 63;
            const f32x2 c = cL[iq * 64 + pp], w = pw[(tq + 1) * 64 + pp];
            v[e] = pq < 64 ? (c.x * w.x - c.y * w.y) : -(c.x * w.y + c.y * w.x);
        }
        u32x4 o; o.x = pack2(v[0], v[1]); o.y = pack2(v[2], v[3]); o.z = pack2(v[4], v[5]); o.w = pack2(v[6], v[7]);
        *(u32x4*)(MBg + (size_t)ti * 128 + p0) = o;
    }
    bf16_t* KTg = (bf16_t*)(p.ws + OFF_S5K) + (size_t)g * 4096;
#pragma unroll 1
    for (int idx = tid; idx < 4096; idx += NTH) {
        const int lag = idx >> 8, iq = (idx >> 4) & 15, i = idx & 15;
        float acc = (lag == 0 && iq == i) ? p.dsk[g * 16 + iq] : 0.f;
#pragma unroll 4
        for (int pp = 0; pp < 64; ++pp) {
            const f32x2 c = cL[iq * 64 + pp], w = pw[lag * 64 + pp], bb = bbL[pp * 16 + i];
            const float mr = c.x * w.x - c.y * w.y, mi_ = c.x * w.y + c.y * w.x;
            acc += mr * bb.x - mi_ * bb.y;
        }
        KTg[idx] = f2bf(acc);
    }
    if (tid < 64) { float* L = (float*)(p.ws + OFF_S5L) + (g * 64 + tid) * 2; const f32x2 w = pw[16 * 64 + tid]; L[0] = w.x; L[1] = w.y; }
    __syncthreads();
}
DI void prep_s5_item(const Params& p, int g) {
    const int tid = my_tid();
    if (tid < SSP) {
        const int pi = g * SSP + tid;
        const float dt = expf(p.log_dt[g]);
        const float ar = p.a_re[pi], ai = p.a_im[pi];
        const float mag = expf(ar * dt);
        const float lr = mag * cosf(ai * dt), li = mag * sinf(ai * dt);
        const float den = ar * ar + ai * ai, nr = lr - 1.0f, ni = li;
        const float zr = (nr * ar + ni * ai) / den, zi = (ni * ar - nr * ai) / den;
        float* lam = (float*)(p.ws + OFF_LAM) + pi * 2;
        lam[0] = lr; lam[1] = li;
        float* bb = (float*)(p.ws + OFF_BB) + (size_t)pi * 32;
        for (int i = 0; i < SSC; ++i) {
            const float br = p.b_re[pi * SSC + i], bi = p.b_im[pi * SSC + i];
            bb[i * 2] = zr * br - zi * bi; bb[i * 2 + 1] = zr * bi + zi * br;
        }
    }
}
DI void prep_transpose_tile(const float* __restrict__ W, bf16_t* __restrict__ Wt, int K, int N, int kt, int nt, char* smem) {
    float* tile = (float*)smem;
    const int tid = my_tid();
#pragma unroll
    for (int q = 0; q < 2; ++q) {
        const int kk = (tid >> 4) + q * 32, c4 = (tid & 15) * 4;
        const float4 v = *(const float4*)(W + (size_t)(kt * 64 + kk) * N + nt * 64 + c4);
        tile[kk * 65 + c4] = v.x; tile[kk * 65 + c4 + 1] = v.y; tile[kk * 65 + c4 + 2] = v.z; tile[kk * 65 + c4 + 3] = v.w;
    }
    __syncthreads();
    const int n = tid >> 3, kc = tid & 7;
    uint4 o;
    o.x = pack2(tile[(kc * 8 + 0) * 65 + n], tile[(kc * 8 + 1) * 65 + n]);
    o.y = pack2(tile[(kc * 8 + 2) * 65 + n], tile[(kc * 8 + 3) * 65 + n]);
    o.z = pack2(tile[(kc * 8 + 4) * 65 + n], tile[(kc * 8 + 5) * 65 + n]);
    o.w = pack2(tile[(kc * 8 + 6) * 65 + n], tile[(kc * 8 + 7) * 65 + n]);
    *(uint4*)(Wt + (size_t)(nt * 64 + n) * K + kt * 64 + kc * 8) = o;
    __syncthreads();
}
DI void cvt_bf16_stream(const float* __restrict__ src, bf16_t* __restrict__ dst, size_t n8, int bid, int nb) {
    for (size_t i = (size_t)bid * NTH + my_tid(); i < n8; i += (size_t)nb * NTH) {
        const float4 a = *(const float4*)(src + i * 8), b = *(const float4*)(src + i * 8 + 4);
        uint4 o; o.x = pack2(a.x, a.y); o.y = pack2(a.z, a.w); o.z = pack2(b.x, b.y); o.w = pack2(b.z, b.w);
        *(uint4*)(dst + i * 8) = o;
    }
}
DI void cvt_fp8_rows(const float* __restrict__ src, unsigned char* __restrict__ dst, float* __restrict__ inv, int bid, int nb) {
    const int lane = my_tid() & 63, wid = my_tid() >> 6;
    for (int row = bid * 8 + wid; row < NEXP; row += nb * 8) {
        const float* sp = src + (size_t)row * DM + lane * 16;
        const f32x4 a = *(const f32x4*)sp, b = *(const f32x4*)(sp + 4), c = *(const f32x4*)(sp + 8), d = *(const f32x4*)(sp + 12);
        float m = fmaxf(fmaxf(fmaxf(fabsf(a.x), fabsf(a.y)), fmaxf(fabsf(a.z), fabsf(a.w))), fmaxf(fmaxf(fabsf(b.x), fabsf(b.y)), fmaxf(fabsf(b.z), fabsf(b.w))));
        m = fmaxf(m, fmaxf(fmaxf(fmaxf(fabsf(c.x), fabsf(c.y)), fmaxf(fabsf(c.z), fabsf(c.w))), fmaxf(fmaxf(fabsf(d.x), fabsf(d.y)), fmaxf(fabsf(d.z), fabsf(d.w)))));
#pragma unroll
        for (int s = 1; s < 64; s <<= 1) m = fmaxf(m, __shfl_xor(m, s));
        float sc = 1.f, isc = 1.f;
        if (m > 1e-30f) {
            int k = (int)floorf(log2f(448.0f / m));
            k = k < -60 ? -60 : (k > 60 ? 60 : k);
            sc = ldexpf(1.0f, k); isc = ldexpf(1.0f, -k);
            if (m * sc > 448.0f) { sc *= 0.5f; isc *= 2.0f; }
        }
        u32x4 o;
        int w;
        w = __builtin_amdgcn_cvt_pk_fp8_f32(a.x * sc, a.y * sc, 0, false); w = __builtin_amdgcn_cvt_pk_fp8_f32(a.z * sc, a.w * sc, w, true); o.x = (unsigned)w;
        w = __builtin_amdgcn_cvt_pk_fp8_f32(b.x * sc, b.y * sc, 0, false); w = __builtin_amdgcn_cvt_pk_fp8_f32(b.z * sc, b.w * sc, w, true); o.y = (unsigned)w;
        w = __builtin_amdgcn_cvt_pk_fp8_f32(c.x * sc, c.y * sc, 0, false); w = __builtin_amdgcn_cvt_pk_fp8_f32(c.z * sc, c.w * sc, w, true); o.z = (unsigned)w;
        w = __builtin_amdgcn_cvt_pk_fp8_f32(d.x * sc, d.y * sc, 0, false); w = __builtin_amdgcn_cvt_pk_fp8_f32(d.z * sc, d.w * sc, w, true); o.w = (unsigned)w;
        *(u32x4*)(dst + (size_t)row * DM + lane * 16) = o;
        if (lane == 0) inv[row] = isc;
    }
}
DI void phase_prep(const Params& p, int bid, int nb, char* smem) {
    constexpr int N_MOD = 192, N_LB = 1, N_S5 = 32, T_WIN = 16 * 40, T_GLU = 8 * 8, T_WOUT = 16 * 16, T_WQ = 16 * 32;
    constexpr int I_LB = N_MOD, I_S5 = I_LB + N_LB, I_WIN = I_S5 + N_S5, I_GLU = I_WIN + T_WIN, I_WOUT = I_GLU + T_GLU, I_WQ = I_WOUT + T_WOUT, I_END = I_WQ + T_WQ;
    for (int it = bid; it < I_END; it += nb) {
        if (it < N_MOD) prep_mod_item(p, it, smem);
        else if (it < I_S5) {
            const int j = my_tid();
            const float a0 = p.hg_lb[j], a1 = p.hg_lb[512 + j], m = fmaxf(a0, a1);
            const float e0 = expf(a0 - m), e1 = expf(a1 - m);
            ((float*)(p.ws + OFF_LB))[j] = e0 / (e0 + e1);
        } else if (it < I_WIN) { prep_s5_item(p, it - I_S5); prep_s5_gemm_item(p, it - I_S5, smem); }
        else if (it < I_GLU) { const int t = it - I_WIN; prep_transpose_tile(p.w_in, (bf16_t*)(p.ws + OFF_WIN), DM, INC, t / 40, t % 40, smem); }
        else if (it < I_WOUT) { const int t = it - I_GLU; prep_transpose_tile(p.glu_w, (bf16_t*)(p.ws + OFF_GLU), 512, 512, t / 8, t % 8, smem); }
        else if (it < I_WQ) { const int t = it - I_WOUT; prep_transpose_tile(p.w_out, (bf16_t*)(p.ws + OFF_WOUT), DM, DM, t / 16, t % 16, smem); }
        else { const int t = it - I_WQ; prep_transpose_tile(p.w_q, (bf16_t*)(p.ws + OFF_WQ), DM, 2048, t / 32, t % 32, smem); }
    }
    cvt_bf16_stream(p.subk, (bf16_t*)(p.ws + OFF_SUBK), (size_t)16 * 128 * 128 / 8, bid, nb);
    cvt_fp8_rows(p.pu, (unsigned char*)(p.ws + OFF_UT), (float*)(p.ws + OFF_SU), bid, nb);
    cvt_fp8_rows(p.pv, (unsigned char*)(p.ws + OFF_VT), (float*)(p.ws + OFF_SV), bid, nb);
}

DI void phase_h(const Params& p, int bid, int nb) {
    const float* mod = (const float*)(p.ws + OFF_MOD);
    bf16_t* H = (bf16_t*)(p.ws + OFF_H);
    const size_t n8 = (size_t)NTOK * DM / 8;
    for (size_t i = (size_t)bid * NTH + my_tid(); i < n8; i += (size_t)nb * NTH) {
        const int row = (int)(i >> 7), c0 = (int)(i & 127) * 8, b = row / SEQ;
        const float* sh = mod + b * 6144 + c0;
        const float* sc = sh + 1024;
        const float4 a = *(const float4*)(p.x + i * 8), bq = *(const float4*)(p.x + i * 8 + 4);
        const float4 s0 = *(const float4*)sc, s1 = *(const float4*)(sc + 4), h0 = *(const float4*)sh, h1 = *(const float4*)(sh + 4);
        uint4 o;
        o.x = pack2(a.x * (1.f + s0.x) + h0.x, a.y * (1.f + s0.y) + h0.y);
        o.y = pack2(a.z * (1.f + s0.z) + h0.z, a.w * (1.f + s0.w) + h0.w);
        o.z = pack2(bq.x * (1.f + s1.x) + h1.x, bq.y * (1.f + s1.y) + h1.y);
        o.w = pack2(bq.z * (1.f + s1.z) + h1.z, bq.w * (1.f + s1.w) + h1.w);
        *(uint4*)(H + i * 8) = o;
    }
}

DI void phase_proj(const Params& p, int bid, int nb, char* smem) {
    const bf16_t* H = (const bf16_t*)(p.ws + OFF_H);
    const bf16_t* W = (const bf16_t*)(p.ws + OFF_WIN);
    bf16_t* P = (bf16_t*)(p.ws + OFF_PROJ);
    constexpr int NTN = INC / 128, NTM = NTOK / 128;
    for (int t = bid; t < NTM * NTN; t += nb) {
        const int mt = t / NTN, nt = t % NTN;
        bf16_t* Pt = P + (size_t)mt * 128 * INC + nt * 128;
        const bool act = (nt < 4) || (nt >= 12 && nt < 16);
        gemm_block<2, 1, 2, 4>(H + (size_t)mt * 128 * DM, DM, W + (size_t)nt * 128 * DM, DM, DM, smem,
                               [&](int r, int c, float v) { Pt[(size_t)r * INC + c] = f2bf(act ? siluf_(v) : v); });
        __syncthreads();
    }
}

DI void hgrn_item(const Params& p, int item, char* smem) {
    const int vs = item & 7, hd = (item >> 3) & 3, b = item >> 5;
    const bf16_t* P = (const bf16_t*)(p.ws + OFF_PROJ);
    const float* lb = (const float*)(p.ws + OFF_LB) + hd * HDK;
    float* ORAW = (float*)(p.ws + OFF_ORAW);
    float* sq = (float*)smem;
    float* sf = sq + 32 * 128;
    float* sv = sf + 32 * 128;
    float* sp = sv + 32 * 16;
    const int tid = my_tid(), lane = tid & 63, wid = tid >> 6, kq = tid >> 4, v = tid & 15;
    float S0 = 0.f, S1 = 0.f, S2 = 0.f, S3 = 0.f;
    for (int t0 = 0; t0 < SEQ; t0 += 32) {
        for (int i = tid; i < 32 * 128; i += NTH) {
            const int t = i >> 7, k = i & 127;
            const bf16_t* row = P + (size_t)(b * SEQ + t0 + t) * INC + hd * HDK + k;
            sq[i] = bf2f(row[0]);
            const float l = lb[k];
            sf[i] = l + (1.0f - l) * sigmoidf_(bf2f(row[512]));
        }
        { const int t = tid >> 4; sv[tid] = bf2f(P[(size_t)(b * SEQ + t0 + t) * INC + 1024 + hd * HDK + vs * 16 + v]); }
        __syncthreads();
        for (int t = 0; t < 32; ++t) {
            const float4 f4 = *(const float4*)(sf + t * 128 + kq * 4), q4 = *(const float4*)(sq + t * 128 + kq * 4);
            const float vv = sv[t * 16 + v];
            S0 = f4.x * S0 + (1.0f - f4.x) * vv; S1 = f4.y * S1 + (1.0f - f4.y) * vv;
            S2 = f4.z * S2 + (1.0f - f4.z) * vv; S3 = f4.w * S3 + (1.0f - f4.w) * vv;
            float part = q4.x * S0 + q4.y * S1 + q4.z * S2 + q4.w * S3;
            part += __shfl_xor(part, 16); part += __shfl_xor(part, 32);
            if (lane < 16) sp[(t * 8 + wid) * 16 + v] = part;
        }
        __syncthreads();
        {
            const int t = tid >> 4;
            float o = 0.f;
#pragma unroll
            for (int w = 0; w < 8; ++w) o += sp[(t * 8 + w) * 16 + v];
            ORAW[(size_t)(b * SEQ + t0 + t) * DHG + hd * HDK + vs * 16 + v] = o;
        }
        __syncthreads();
    }
}
DI void s5_item(const Params& p, int item, char* smem) {
    const int oct = item & 3, b = item >> 2;
    const int tid = my_tid(), lane = tid & 63, wid = tid >> 6, g = oct * 8 + wid;
    const bf16_t* P = (const bf16_t*)(p.ws + OFF_PROJ);
    bf16_t* Y = (bf16_t*)(p.ws + OFF_YSSM);
    float* su = (float*)smem + wid * 64 * 16;
    const float* lam = (const float*)(p.ws + OFF_LAM) + (g * SSP + lane) * 2;
    const float lr = lam[0], li = lam[1];
    const float* bb = (const float*)(p.ws + OFF_BB) + (size_t)(g * SSP + lane) * 32;
    float bbr[16], bbi[16], cr[16], ci[16];
#pragma unroll
    for (int i = 0; i < 16; ++i) { bbr[i] = bb[2 * i]; bbi[i] = bb[2 * i + 1]; cr[i] = p.c_re[(g * SSC + i) * SSP + lane]; ci[i] = p.c_im[(g * SSC + i) * SSP + lane]; }
    const int ch = (lane >> 2) & 15;
    const float dch = p.dsk[g * SSC + ch];
    float xr = 0.f, xi = 0.f;
    for (int t0 = 0; t0 < SEQ; t0 += 64) {
        {
            const uint4* src = (const uint4*)(P + (size_t)(b * SEQ + t0 + lane) * INC + 2048 + g * SSC);
            const uint4 a = src[0], c = src[1];
            float* d = su + lane * 16;
            d[0] = bflo(a.x); d[1] = bfhi(a.x); d[2] = bflo(a.y); d[3] = bfhi(a.y); d[4] = bflo(a.z); d[5] = bfhi(a.z); d[6] = bflo(a.w); d[7] = bfhi(a.w);
            d[8] = bflo(c.x); d[9] = bfhi(c.x); d[10] = bflo(c.y); d[11] = bfhi(c.y); d[12] = bflo(c.z); d[13] = bfhi(c.z); d[14] = bflo(c.w); d[15] = bfhi(c.w);
        }
        __syncthreads();
        for (int t = 0; t < 64; ++t) {
            float u[16];
            const float4* us = (const float4*)(su + t * 16);
            const float4 u0 = us[0], u1 = us[1], u2 = us[2], u3 = us[3];
            u[0] = u0.x; u[1] = u0.y; u[2] = u0.z; u[3] = u0.w; u[4] = u1.x; u[5] = u1.y; u[6] = u1.z; u[7] = u1.w;
            u[8] = u2.x; u[9] = u2.y; u[10] = u2.z; u[11] = u2.w; u[12] = u3.x; u[13] = u3.y; u[14] = u3.z; u[15] = u3.w;
            float bur = 0.f, bui = 0.f;
#pragma unroll
            for (int i = 0; i < 16; ++i) { bur += bbr[i] * u[i]; bui += bbi[i] * u[i]; }
            const float nxr = lr * xr - li * xi + bur, nxi = lr * xi + li * xr + bui;
            xr = nxr; xi = nxi;
            float y[16];
#pragma unroll
            for (int i = 0; i < 16; ++i) y[i] = cr[i] * xr - ci[i] * xi;
            const bool b5 = lane & 32, b4 = lane & 16, b3 = lane & 8, b2 = lane & 4;
            float y8[8], y4[4], y2[2];
#pragma unroll
            for (int j = 0; j < 8; ++j) { const float keep = b5 ? y[8 + j] : y[j], send = b5 ? y[j] : y[8 + j]; y8[j] = keep + __shfl_xor(send, 32); }
#pragma unroll
            for (int j = 0; j < 4; ++j) { const float keep = b4 ? y8[4 + j] : y8[j], send = b4 ? y8[j] : y8[4 + j]; y4[j] = keep + __shfl_xor(send, 16); }
#pragma unroll
            for (int j = 0; j < 2; ++j) { const float keep = b3 ? y4[2 + j] : y4[j], send = b3 ? y4[j] : y4[2 + j]; y2[j] = keep + __shfl_xor(send, 8); }
            float y1;
            { const float keep = b2 ? y2[1] : y2[0], send = b2 ? y2[0] : y2[1]; y1 = keep + __shfl_xor(send, 4); }
            y1 += __shfl_xor(y1, 1); y1 += __shfl_xor(y1, 2);
            if ((lane & 3) == 0) {
                const float uu = su[t * 16 + ch];
                Y[(size_t)(b * SEQ + t0 + t) * DSS + g * SSC + ch] = f2bf(geluf_(y1 + dch * uu));
            }
        }
        __syncthreads();
    }
}
DI int crow(int i, int h) { return (i & 3) + 8 * (i >> 2) + 4 * h; }
DI void phase_hgprep(const Params& p, int bid, int nb) {
    const bf16_t* P = (const bf16_t*)(p.ws + OFF_PROJ);
    const float* lbp = (const float*)(p.ws + OFF_LB);
    const int tid = my_tid(), cl = tid >> 7, k = tid & 127;
    for (int it = bid; it < 1024; it += nb) {
        const int cq = it & 15, hd = (it >> 4) & 3, b = it >> 6, c = cq * 4 + cl;
        const bf16_t* base = P + (size_t)(b * SEQ + c * 32) * INC + hd * HDK + k;
        const float l = lbp[hd * HDK + k];
        const size_t tile = ((size_t)(b * 4 + hd) * 64 + c);
        bf16_t* HQ = (bf16_t*)(p.ws + OFF_HQ) + tile * 4096;
        bf16_t* HK = (bf16_t*)(p.ws + OFF_HK) + tile * 4096;
        bf16_t* HKT = (bf16_t*)(p.ws + OFF_HKT) + tile * 4096;
        bf16_t* HVT = (bf16_t*)(p.ws + OFF_HVT) + tile * 4096;
        float bc[32], kk[32];
        float bs = 0.f;
#pragma unroll
        for (int t = 0; t < 32; ++t) {
            const float f = l + (1.0f - l) * sigmoidf_(bf2f(base[(size_t)t * INC + 512]));
            bs += __logf(f); bc[t] = bs; kk[t] = 1.0f - f;
        }
#pragma unroll
        for (int t = 0; t < 32; ++t) {
            const float qv = bf2f(base[(size_t)t * INC]);
            HQ[t * 128 + k] = f2bf(qv * __expf(bc[t]));
            HK[t * 128 + k] = f2bf(kk[t] * __expf(fminf(-bc[t], 80.0f)));
        }
#pragma unroll
        for (int q = 0; q < 4; ++q) {
            u32x4 o;
            o.x = pack2(kk[q * 8 + 0] * __expf(bs - bc[q * 8 + 0]), kk[q * 8 + 1] * __expf(bs - bc[q * 8 + 1]));
            o.y = pack2(kk[q * 8 + 2] * __expf(bs - bc[q * 8 + 2]), kk[q * 8 + 3] * __expf(bs - bc[q * 8 + 3]));
            o.z = pack2(kk[q * 8 + 4] * __expf(bs - bc[q * 8 + 4]), kk[q * 8 + 5] * __expf(bs - bc[q * 8 + 5]));
            o.w = pack2(kk[q * 8 + 6] * __expf(bs - bc[q * 8 + 6]), kk[q * 8 + 7] * __expf(bs - bc[q * 8 + 7]));
            *(u32x4*)(HKT + k * 32 + q * 8) = o;
        }
        ((float*)(p.ws + OFF_HG))[tile * 128 + k] = __expf(bs);
#pragma unroll
        for (int q = 0; q < 4; ++q) {
            unsigned w[4];
#pragma unroll
            for (int e = 0; e < 4; ++e) w[e] = (unsigned)base[(size_t)(q * 8 + 2 * e) * INC + 1024] | ((unsigned)base[(size_t)(q * 8 + 2 * e + 1) * INC + 1024] << 16);
            *(u32x4*)(HVT + k * 32 + q * 8) = (u32x4){w[0], w[1], w[2], w[3]};
        }
    }
}
typedef short s16x4 __attribute__((ext_vector_type(4)));
DI bf16x8 cat8(const s16x4 lo, const s16x4 hi) { return (bf16x8){lo.x, lo.y, lo.z, lo.w, hi.x, hi.y, hi.z, hi.w}; }
DI void hgrn_mfma_item(const Params& p, int item, char* smem) {
    constexpr int QP_OFF = 0, KP_OFF = 8704, KT_OFF = 17408, VT_OFF = 27648, G_OFF = 37888, BUF = 38400;
    const int tid = my_tid(), lane = tid & 63, wid = tid >> 6, r = lane & 31, h = lane >> 5;
    const int b = item >> 2, hd = item & 3;
    const size_t tile0 = (size_t)item * 64;
    const bf16_t* HQ = (const bf16_t*)(p.ws + OFF_HQ) + tile0 * 4096;
    const bf16_t* HK = (const bf16_t*)(p.ws + OFF_HK) + tile0 * 4096;
    const bf16_t* HKT = (const bf16_t*)(p.ws + OFF_HKT) + tile0 * 4096;
    const bf16_t* HVT = (const bf16_t*)(p.ws + OFF_HVT) + tile0 * 4096;
    const float* HG = (const float*)(p.ws + OFF_HG) + tile0 * 128;
    float* ORAW = (float*)(p.ws + OFF_ORAW) + (size_t)b * SEQ * DHG + hd * HDK;
    const bool helper = wid >= 4;
    const int ht = tid - 256;
    u32x4 sq0, sq1, sk0, sk1, st0, st1, sv0, sv1, sg;
    sq0 = sq1 = sk0 = sk1 = st0 = st1 = sv0 = sv1 = sg = (u32x4){0, 0, 0, 0};
    f32x16 S[4];
#pragma unroll
    for (int kb = 0; kb < 4; ++kb)
#pragma unroll
        for (int i = 0; i < 16; ++i) S[kb][i] = 0.f;
#define HG_LOAD(c_) { const size_t o_ = (size_t)(c_) * 4096; \
        sq0 = *(const u32x4*)(HQ + o_ + ht * 8); sq1 = *(const u32x4*)(HQ + o_ + (ht + 256) * 8); \
        sk0 = *(const u32x4*)(HK + o_ + ht * 8); sk1 = *(const u32x4*)(HK + o_ + (ht + 256) * 8); \
        st0 = *(const u32x4*)(HKT + o_ + ht * 8); st1 = *(const u32x4*)(HKT + o_ + (ht + 256) * 8); \
        sv0 = *(const u32x4*)(HVT + o_ + ht * 8); sv1 = *(const u32x4*)(HVT + o_ + (ht + 256) * 8); \
        if (ht < 32) sg = *(const u32x4*)(HG + (size_t)(c_) * 128 + ht * 4); }
#define HG_STORE(buf_) { char* B_ = smem + (buf_) * BUF; \
        { const int i0 = ht, i1 = ht + 256; \
          *(u32x4*)(B_ + QP_OFF + (i0 >> 4) * 272 + (i0 & 15) * 16) = sq0; *(u32x4*)(B_ + QP_OFF + (i1 >> 4) * 272 + (i1 & 15) * 16) = sq1; \
          *(u32x4*)(B_ + KP_OFF + (i0 >> 4) * 272 + (i0 & 15) * 16) = sk0; *(u32x4*)(B_ + KP_OFF + (i1 >> 4) * 272 + (i1 & 15) * 16) = sk1; \
          *(u32x4*)(B_ + KT_OFF + (i0 >> 2) * 80 + (i0 & 3) * 16) = st0; *(u32x4*)(B_ + KT_OFF + (i1 >> 2) * 80 + (i1 & 3) * 16) = st1; \
          *(u32x4*)(B_ + VT_OFF + (i0 >> 2) * 80 + (i0 & 3) * 16) = sv0; *(u32x4*)(B_ + VT_OFF + (i1 >> 2) * 80 + (i1 & 3) * 16) = sv1; \
          if (ht < 32) *(u32x4*)(B_ + G_OFF + ht * 16) = sg; } }
    if (helper) { HG_LOAD(0); HG_STORE(0); }
    __syncthreads();
    for (int c = 0; c < 64; ++c) {
        if (helper) {
            if (c + 1 < 64) HG_LOAD(c + 1);
        } else {
            const char* B = smem + (c & 1) * BUF;
            const int w = wid;
            f32x16 pt;
#pragma unroll
            for (int i = 0; i < 16; ++i) pt[i] = 0.f;
#pragma unroll
            for (int ks = 0; ks < 8; ++ks) {
                const bf16x8 a = *(const bf16x8*)(B + KP_OFF + r * 272 + ks * 32 + h * 16);
                const bf16x8 bq = *(const bf16x8*)(B + QP_OFF + r * 272 + ks * 32 + h * 16);
                pt = __builtin_amdgcn_mfma_f32_32x32x16_bf16(a, bq, pt, 0, 0, 0);
            }
#pragma unroll
            for (int i = 0; i < 16; ++i) if (crow(i, h) > r) pt[i] = 0.f;
            f32x16 o;
#pragma unroll
            for (int i = 0; i < 16; ++i) o[i] = 0.f;
#pragma unroll
            for (int sp = 0; sp < 2; ++sp) {
                const char* vb = B + VT_OFF + (32 * w + r) * 80 + sp * 32 + h * 8;
                const bf16x8 bv = cat8(*(const s16x4*)vb, *(const s16x4*)(vb + 16));
                o = __builtin_amdgcn_mfma_f32_32x32x16_bf16(pack8(pt, 8 * sp), bv, o, 0, 0, 0);
            }
#pragma unroll
            for (int kb = 0; kb < 4; ++kb)
#pragma unroll
                for (int sp = 0; sp < 2; ++sp) {
                    const char* qb = B + QP_OFF + r * 272 + kb * 64 + sp * 32 + h * 8;
                    const bf16x8 aq = cat8(*(const s16x4*)qb, *(const s16x4*)(qb + 16));
                    o = __builtin_amdgcn_mfma_f32_32x32x16_bf16(aq, pack8(S[kb], 8 * sp), o, 0, 0, 0);
                }
#pragma unroll
            for (int i = 0; i < 16; ++i) ORAW[(size_t)(c * 32 + crow(i, h)) * DHG + 32 * w + r] = o[i];
#pragma unroll
            for (int kb = 0; kb < 4; ++kb) {
#pragma unroll
                for (int j = 0; j < 4; ++j) {
                    const f32x4 g4 = *(const f32x4*)(B + G_OFF + (kb * 32 + 8 * j + 4 * h) * 4);
                    S[kb][4 * j] *= g4.x; S[kb][4 * j + 1] *= g4.y; S[kb][4 * j + 2] *= g4.z; S[kb][4 * j + 3] *= g4.w;
                }
#pragma unroll
                for (int ks = 0; ks < 2; ++ks) {
                    const bf16x8 a = *(const bf16x8*)(B + KT_OFF + (kb * 32 + r) * 80 + ks * 32 + h * 16);
                    const bf16x8 bv = *(const bf16x8*)(B + VT_OFF + (32 * w + r) * 80 + ks * 32 + h * 16);
                    S[kb] = __builtin_amdgcn_mfma_f32_32x32x16_bf16(a, bv, S[kb], 0, 0, 0);
                }
            }
        }
        if (helper) { if (c + 1 < 64) HG_STORE((c + 1) & 1); }
        __syncthreads();
    }
}
template <int NJ>
DI void s5_gemm2_tile(const bf16x8 (&af)[16], const bf16_t* KTl, const bf16_t* Xin, const bf16_t* MBg, bf16_t* Yout, const int mi, const int r, const int h) {
    f32x16 y;
#pragma unroll
    for (int i = 0; i < 16; ++i) y[i] = 0.f;
    const int tsel = r >> 4, iq = r & 15;
#pragma unroll
    for (int ks = 0; ks <= 2 * NJ; ++ks) {
        const bf16x8 bk = *(const bf16x8*)(KTl + ((2 * NJ + tsel - ks) * 16 + iq) * 16 + 8 * h);
        y = __builtin_amdgcn_mfma_f32_32x32x16_bf16(af[ks], bk, y, 0, 0, 0);
    }
    {
        bf16x8 bk = *(const bf16x8*)(KTl + iq * 16 + 8 * h);
        if (tsel == 0) bk = (bf16x8){0, 0, 0, 0, 0, 0, 0, 0};
        y = __builtin_amdgcn_mfma_f32_32x32x16_bf16(af[2 * NJ + 1], bk, y, 0, 0, 0);
    }
#pragma unroll
    for (int ks = 0; ks < 8; ++ks) {
        const bf16x8 a = *(const bf16x8*)(Xin + (mi * 32 + r) * 136 + ks * 16 + 8 * h);
        const bf16x8 bm = *(const bf16x8*)(MBg + (size_t)(NJ * 32 + r) * 128 + ks * 16 + 8 * h);
        y = __builtin_amdgcn_mfma_f32_32x32x16_bf16(a, bm, y, 0, 0, 0);
    }
#pragma unroll
    for (int i = 0; i < 16; ++i) Yout[(size_t)((mi * 32 + crow(i, h)) * 16 + 2 * NJ + tsel) * DSS + iq] = f2bf(gelu_as(y[i]));
}
DI void s5_gemm_item(const Params& p, int b, int g, char* smem) {
    float* E = (float*)smem;
    bf16_t* Xin = (bf16_t*)(smem + 128 * 132 * 4);
    bf16_t* KTl = Xin + 128 * 136;
    const int tid = my_tid(), lane = tid & 63, wid = tid >> 6, r = lane & 31, h = lane >> 5;
    const int mi = wid >> 1, wh = wid & 1;
    const bf16_t* P = (const bf16_t*)(p.ws + OFF_PROJ);
    *(u32x4*)(KTl + tid * 8) = *(const u32x4*)((const bf16_t*)(p.ws + OFF_S5K) + (size_t)g * 4096 + tid * 8);
    bf16x8 af[16];
    {
        const bf16_t* ub = P + (size_t)(b * SEQ + (mi * 32 + r) * 16) * INC + 2048 + g * 16 + 8 * h;
#pragma unroll
        for (int ks = 0; ks < 16; ++ks) af[ks] = *(const bf16x8*)(ub + (size_t)ks * INC);
    }
    {
        f32x16 e0, e1;
#pragma unroll
        for (int i = 0; i < 16; ++i) { e0[i] = 0.f; e1[i] = 0.f; }
        const bf16_t* nb0 = (const bf16_t*)(p.ws + OFF_S5N) + ((size_t)g * 128 + wh * 64 + r) * 256 + 8 * h;
#pragma unroll
        for (int ks = 0; ks < 16; ++ks) {
            const bf16x8 b0 = *(const bf16x8*)(nb0 + ks * 16), b1 = *(const bf16x8*)(nb0 + 32 * 256 + ks * 16);
            e0 = __builtin_amdgcn_mfma_f32_32x32x16_bf16(af[ks], b0, e0, 0, 0, 0);
            e1 = __builtin_amdgcn_mfma_f32_32x32x16_bf16(af[ks], b1, e1, 0, 0, 0);
        }
#pragma unroll
        for (int i = 0; i < 16; ++i) { float* er = E + (mi * 32 + crow(i, h)) * 132 + wh * 64 + r; er[0] = e0[i]; er[32] = e1[i]; }
    }
    __syncthreads();
    if (wid == 0) {
        const float* L = (const float*)(p.ws + OFF_S5L) + (g * 64 + lane) * 2;
        const float lr = L[0], li = L[1];
        float xr = 0.f, xi = 0.f;
#pragma unroll 8
        for (int c = 0; c < 128; ++c) {
            const float er = E[c * 132 + lane], ei = E[c * 132 + 64 + lane];
            Xin[c * 136 + lane] = f2bf(xr); Xin[c * 136 + 64 + lane] = f2bf(xi);
            const float nr = lr * xr - li * xi + er, ni = lr * xi + li * xr + ei;
            xr = nr; xi = ni;
        }
    }
    __syncthreads();
    const bf16_t* MBg = (const bf16_t*)(p.ws + OFF_S5M) + (size_t)g * 256 * 128;
    bf16_t* Yout = (bf16_t*)(p.ws + OFF_YSSM) + (size_t)b * SEQ * DSS + g * 16;
    if (wh) {
        s5_gemm2_tile<1>(af, KTl, Xin, MBg, Yout, mi, r, h); s5_gemm2_tile<6>(af, KTl, Xin, MBg, Yout, mi, r, h);
        s5_gemm2_tile<3>(af, KTl, Xin, MBg, Yout, mi, r, h); s5_gemm2_tile<4>(af, KTl, Xin, MBg, Yout, mi, r, h);
    } else {
        s5_gemm2_tile<0>(af, KTl, Xin, MBg, Yout, mi, r, h); s5_gemm2_tile<7>(af, KTl, Xin, MBg, Yout, mi, r, h);
        s5_gemm2_tile<2>(af, KTl, Xin, MBg, Yout, mi, r, h); s5_gemm2_tile<5>(af, KTl, Xin, MBg, Yout, mi, r, h);
    }
    __syncthreads();
}
DI void phase_mix(const Params& p, int bid, int nb, char* smem) {
    if (nb == 256) {
        if (bid < 64) { hgrn_mfma_item(p, bid, smem); return; }
        const int j = bid - 64, x = j & 7, lb = j >> 3;
        for (int q = lb; q < 64; q += 24) s5_gemm_item(p, q & 15, x * 4 + (q >> 4), smem);
    } else {
        for (int it = bid; it < 64; it += nb) hgrn_mfma_item(p, it, smem);
        for (int q = bid; q < 512; q += nb) s5_gemm_item(p, q & 15, q >> 4, smem);
    }
}

DI void phase_glu(const Params& p, int bid, int nb, char* smem) {
    const bf16_t* Y = (const bf16_t*)(p.ws + OFF_YSSM);
    const bf16_t* W = (const bf16_t*)(p.ws + OFF_GLU);
    float* Y2 = (float*)(p.ws + OFF_H);
    constexpr int NTN = 4, NTM = NTOK / 128;
    for (int t = bid; t < NTM * NTN; t += nb) {
        const int mt = t / NTN, nt = t % NTN;
        const bf16_t* Yt = Y + (size_t)mt * 128 * DSS + nt * 128;
        float* Ot = Y2 + (size_t)mt * 128 * DSS + nt * 128;
        const float* gb = p.glu_b + nt * 128;
        gemm_block<2, 1, 2, 4>(Y + (size_t)mt * 128 * DSS, DSS, W + (size_t)nt * 128 * 512, 512, 512, smem,
                               [&](int r, int c, float v) { const float y = bf2f(Yt[(size_t)r * DSS + c]); Ot[(size_t)r * DSS + c] = y * sigmoidf_(v + gb[c]); });
        __syncthreads();
    }
}
DI void phase_a2(const Params& p, int bid, int nb) {
    const float* ORAW = (const float*)(p.ws + OFF_ORAW);
    const float* Y2 = (const float*)(p.ws + OFF_H);
    const bf16_t* P = (const bf16_t*)(p.ws + OFF_PROJ);
    bf16_t* A2 = (bf16_t*)(p.ws + OFF_A2);
    const int lane = my_tid() & 63, wid = my_tid() >> 6;
    for (int tok = bid * 8 + wid; tok < NTOK; tok += nb * 8) {
        const int c0 = lane * 8;
        {
            const float4 a = *(const float4*)(ORAW + (size_t)tok * DHG + c0), b = *(const float4*)(ORAW + (size_t)tok * DHG + c0 + 4);
            float ss = a.x * a.x + a.y * a.y + a.z * a.z + a.w * a.w + b.x * b.x + b.y * b.y + b.z * b.z + b.w * b.w;
            ss += __shfl_xor(ss, 1); ss += __shfl_xor(ss, 2); ss += __shfl_xor(ss, 4); ss += __shfl_xor(ss, 8);
            const float rs = rsqrtf(ss * (1.0f / 128.0f) + RMS_EPS);
            const uint4 gq = *(const uint4*)(P + (size_t)tok * INC + 1536 + c0);
            const float4 w0 = *(const float4*)(p.hg_nw + c0), w1 = *(const float4*)(p.hg_nw + c0 + 4);
            uint4 o;
            o.x = pack2(a.x * rs * w0.x * bflo(gq.x), a.y * rs * w0.y * bfhi(gq.x));
            o.y = pack2(a.z * rs * w0.z * bflo(gq.y), a.w * rs * w0.w * bfhi(gq.y));
            o.z = pack2(b.x * rs * w1.x * bflo(gq.z), b.y * rs * w1.y * bfhi(gq.z));
            o.w = pack2(b.z * rs * w1.z * bflo(gq.w), b.w * rs * w1.w * bfhi(gq.w));
            *(uint4*)(A2 + (size_t)tok * DM + c0) = o;
        }
        {
            const float4 a = *(const float4*)(Y2 + (size_t)tok * DSS + c0), b = *(const float4*)(Y2 + (size_t)tok * DSS + c0 + 4);
            float ss = a.x * a.x + a.y * a.y + a.z * a.z + a.w * a.w + b.x * b.x + b.y * b.y + b.z * b.z + b.w * b.w;
#pragma unroll
            for (int m = 1; m < 64; m <<= 1) ss += __shfl_xor(ss, m);
            const float rs = rsqrtf(ss * (1.0f / 512.0f) + RMS_EPS);
            const float4 w0 = *(const float4*)(p.ssm_nw + c0), w1 = *(const float4*)(p.ssm_nw + c0 + 4);
            uint4 o;
            o.x = pack2(a.x * rs * w0.x, a.y * rs * w0.y); o.y = pack2(a.z * rs * w0.z, a.w * rs * w0.w);
            o.z = pack2(b.x * rs * w1.x, b.y * rs * w1.y); o.w = pack2(b.z * rs * w1.z, b.w * rs * w1.w);
            *(uint4*)(A2 + (size_t)tok * DM + 512 + c0) = o;
        }
    }
}

DI void phase_outproj(const Params& p, int bid, int nb, char* smem) {
    const bf16_t* A2 = (const bf16_t*)(p.ws + OFF_A2);
    const bf16_t* W = (const bf16_t*)(p.ws + OFF_WOUT);
    const float* mod = (const float*)(p.ws + OFF_MOD);
    constexpr int NTN = 8, NTM = NTOK / 128;
    for (int t = bid; t < NTM * NTN; t += nb) {
        const int mt = t / NTN, nt = t % NTN, b = (mt * 128) / SEQ;
        const float* xt = p.x + (size_t)mt * 128 * DM + nt * 128;
        float* ot = p.out + (size_t)mt * 128 * DM + nt * 128;
        const float* g1 = mod + b * 6144 + 2048 + nt * 128;
        gemm_block<2, 1, 2, 4>(A2 + (size_t)mt * 128 * DM, DM, W + (size_t)nt * 128 * DM, DM, DM, smem,
                               [&](int r, int c, float v) { ot[(size_t)r * DM + c] = DEEP_ALPHA * xt[(size_t)r * DM + c] + (1.0f + g1[c]) * v; });
        __syncthreads();
    }
}
DI void phase_ln1(const Params& p, int bid, int nb) {
    const float* mod = (const float*)(p.ws + OFF_MOD);
    bf16_t* H2 = (bf16_t*)(p.ws + OFF_H);
    const int lane = my_tid() & 63, wid = my_tid() >> 6;
    for (int tok = bid * 8 + wid; tok < NTOK; tok += nb * 8) {
        const int b = tok / SEQ;
        float* row = p.out + (size_t)tok * DM;
        float4 v[4];
        float s = 0.f;
#pragma unroll
        for (int j = 0; j < 4; ++j) { v[j] = *(const float4*)(row + j * 256 + lane * 4); s += v[j].x + v[j].y + v[j].z + v[j].w; }
#pragma unroll
        for (int m = 1; m < 64; m <<= 1) s += __shfl_xor(s, m);
        const float mu = s * (1.0f / 1024.0f);
        float q = 0.f;
#pragma unroll
        for (int j = 0; j < 4; ++j) { const float a = v[j].x - mu, bb = v[j].y - mu, cc = v[j].z - mu, d = v[j].w - mu; q += a * a + bb * bb + cc * cc + d * d; }
#pragma unroll
        for (int m = 1; m < 64; m <<= 1) q += __shfl_xor(q, m);
        const float rstd = rsqrtf(q * (1.0f / 1024.0f) + LN_EPS);
        const float* sh2 = mod + b * 6144 + 3072;
        const float* sc2 = mod + b * 6144 + 4096;
#pragma unroll
        for (int j = 0; j < 4; ++j) {
            const int c = j * 256 + lane * 4;
            const float4 w = *(const float4*)(p.ln1w + c), bi = *(const float4*)(p.ln1b + c), sc = *(const float4*)(sc2 + c), sh = *(const float4*)(sh2 + c);
            float4 o;
            o.x = (v[j].x - mu) * rstd * w.x + bi.x; o.y = (v[j].y - mu) * rstd * w.y + bi.y; o.z = (v[j].z - mu) * rstd * w.z + bi.z; o.w = (v[j].w - mu) * rstd * w.w + bi.w;
            *(float4*)(row + c) = o;
            uint2 hh; hh.x = pack2(o.x * (1.f + sc.x) + sh.x, o.y * (1.f + sc.y) + sh.y); hh.y = pack2(o.z * (1.f + sc.z) + sh.z, o.w * (1.f + sc.w) + sh.w);
            *(uint2*)(H2 + (size_t)tok * DM + c) = hh;
        }
    }
}

DI void phase_q(const Params& p, int bid, int nb, char* smem) {
    const bf16_t* H2 = (const bf16_t*)(p.ws + OFF_H);
    const bf16_t* W = (const bf16_t*)(p.ws + OFF_WQ);
    bf16_t* Q = (bf16_t*)(p.ws + OFF_PROJ);
    constexpr int NTN = 16, NTM = NTOK / 128;
    for (int t = bid; t < NTM * NTN; t += nb) {
        const int mt = t / NTN, nt = t % NTN;
        bf16_t* Qt = Q + (size_t)mt * 128 * 2048 + nt * 128;
        gemm_block<2, 1, 2, 4>(H2 + (size_t)mt * 128 * DM, DM, W + (size_t)nt * 128 * DM, DM, DM, smem,
                               [&](int r, int c, float v) { Qt[(size_t)r * 2048 + c] = f2bf(v); });
        __syncthreads();
    }
}
DI void phase_topk(const Params& p, int bid, int nb, char* smem) {
    const bf16_t* Q = (const bf16_t*)(p.ws + OFF_PROJ);
    const bf16_t* SK = (const bf16_t*)(p.ws + OFF_SUBK);
    unsigned* TOPL = (unsigned*)(p.ws + OFF_TOPL);
    float* sc = (float*)(smem + 36864);
    constexpr int NTM = NTOK / 128;
    for (int t = bid; t < NTM * 16; t += nb) {
        const int mt = t >> 4, hp = t & 15;
        gemm_block<2, 1, 2, 4>(Q + (size_t)mt * 128 * 2048 + hp * 128, 2048, SK + (size_t)hp * 128 * 128, 128, 128, smem,
                               [&](int r, int c, float v) { sc[r * 129 + c] = v; });
        __syncthreads();
        if (my_tid() < 128) {
            const int r = my_tid();
            float tk[16];
#pragma unroll
            for (int j = 0; j < 16; ++j) tk[j] = -3.0e38f;
            for (int n = 0; n < 128; ++n) {
                float xv = __uint_as_float((__float_as_uint(sc[r * 129 + n]) & ~0x7fu) | (unsigned)n);
#pragma unroll
                for (int j = 0; j < 16; ++j) { const float hi = fmaxf(tk[j], xv), lo = fminf(tk[j], xv); tk[j] = hi; xv = lo; }
            }
            uint4* dst = (uint4*)(TOPL + ((size_t)(mt * 128 + r) * 16 + hp) * 16);
            dst[0] = make_uint4(__float_as_uint(tk[0]), __float_as_uint(tk[1]), __float_as_uint(tk[2]), __float_as_uint(tk[3]));
            dst[1] = make_uint4(__float_as_uint(tk[4]), __float_as_uint(tk[5]), __float_as_uint(tk[6]), __float_as_uint(tk[7]));
            dst[2] = make_uint4(__float_as_uint(tk[8]), __float_as_uint(tk[9]), __float_as_uint(tk[10]), __float_as_uint(tk[11]));
            dst[3] = make_uint4(__float_as_uint(tk[12]), __float_as_uint(tk[13]), __float_as_uint(tk[14]), __float_as_uint(tk[15]));
        }
        __syncthreads();
    }
}
DI void phase_combine(const Params& p, int bid, int nb) {
    const unsigned* TOPL = (const unsigned*)(p.ws + OFF_TOPL);
    uint2* EX = (uint2*)(p.ws + OFF_EXPS);
    const float* SU = (const float*)(p.ws + OFF_SU);
    const float* SV = (const float*)(p.ws + OFF_SV);
    for (int i = bid * NTH + my_tid(); i < NTOK * PHEADS; i += nb * NTH) {
        const unsigned* l1 = TOPL + (size_t)i * 32;
        const unsigned* l2 = l1 + 16;
        float s2[16];
        {
            const uint4 a = ((const uint4*)l2)[0], b = ((const uint4*)l2)[1], c = ((const uint4*)l2)[2], d = ((const uint4*)l2)[3];
            const unsigned w[16] = {a.x, a.y, a.z, a.w, b.x, b.y, b.z, b.w, c.x, c.y, c.z, c.w, d.x, d.y, d.z, d.w};
#pragma unroll
            for (int j = 0; j < 16; ++j) s2[j] = __uint_as_float(w[j] & ~0x7fu);
        }
        float tk[16];
#pragma unroll
        for (int j = 0; j < 16; ++j) tk[j] = -3.0e38f;
        for (int a = 0; a < 16; ++a) {
            const float s1 = __uint_as_float(l1[a] & ~0x7fu);
#pragma unroll
            for (int b = 0; b < 16; ++b) {
                float xv = __uint_as_float((__float_as_uint(s1 + s2[b]) & ~0xffu) | (unsigned)(a * 16 + b));
#pragma unroll
                for (int j = 0; j < 16; ++j) { const float hi = fmaxf(tk[j], xv), lo = fminf(tk[j], xv); tk[j] = hi; xv = lo; }
            }
        }
        float e[16], sum = 0.f;
        const float mx = __uint_as_float(__float_as_uint(tk[0]) & ~0xffu);
#pragma unroll
        for (int j = 0; j < 16; ++j) { e[j] = __expf(__uint_as_float(__float_as_uint(tk[j]) & ~0xffu) - mx); sum += e[j]; }
        const float inv = 1.0f / sum;
#pragma unroll
        for (int j = 0; j < 16; ++j) {
            const unsigned ab = __float_as_uint(tk[j]) & 0xffu;
            const unsigned i1 = l1[ab >> 4] & 0x7fu, i2 = l2[ab & 15] & 0x7fu;
            const unsigned eid = i1 * 128u + i2;
            EX[(size_t)i * 16 + j] = make_uint2(eid | (((__float_as_uint(SU[eid]) >> 23) & 0xffu) << 16), __float_as_uint(e[j] * inv * SV[eid]));
        }
    }
}

DI float dot16_fp8(const u32x4 w, const f32x2 (&h)[8]) {
    f32x2 acc = __builtin_amdgcn_cvt_pk_f32_fp8((int)w.x, false) * h[0];
    acc += __builtin_amdgcn_cvt_pk_f32_fp8((int)w.x, true) * h[1];
    acc += __builtin_amdgcn_cvt_pk_f32_fp8((int)w.y, false) * h[2];
    acc += __builtin_amdgcn_cvt_pk_f32_fp8((int)w.y, true) * h[3];
    acc += __builtin_amdgcn_cvt_pk_f32_fp8((int)w.z, false) * h[4];
    acc += __builtin_amdgcn_cvt_pk_f32_fp8((int)w.z, true) * h[5];
    acc += __builtin_amdgcn_cvt_pk_f32_fp8((int)w.w, false) * h[6];
    acc += __builtin_amdgcn_cvt_pk_f32_fp8((int)w.w, true) * h[7];
    return acc.x + acc.y;
}
DI void axpy16_fp8(const float a, const u32x4 w, f32x2 (&o)[8]) {
    const f32x2 aa = {a, a};
    o[0] += aa * __builtin_amdgcn_cvt_pk_f32_fp8((int)w.x, false); o[1] += aa * __builtin_amdgcn_cvt_pk_f32_fp8((int)w.x, true);
    o[2] += aa * __builtin_amdgcn_cvt_pk_f32_fp8((int)w.y, false); o[3] += aa * __builtin_amdgcn_cvt_pk_f32_fp8((int)w.y, true);
    o[4] += aa * __builtin_amdgcn_cvt_pk_f32_fp8((int)w.z, false); o[5] += aa * __builtin_amdgcn_cvt_pk_f32_fp8((int)w.z, true);
    o[6] += aa * __builtin_amdgcn_cvt_pk_f32_fp8((int)w.w, false); o[7] += aa * __builtin_amdgcn_cvt_pk_f32_fp8((int)w.w, true);
}
DI float butterfly64(float (&pz)[64], const int lane) {
    const bool b5 = lane & 32, b4 = lane & 16, b3 = lane & 8, b2 = lane & 4, b1 = lane & 2, b0 = lane & 1;
    float q32[32], q16[16], q8[8], q4[4], q2[2];
#pragma unroll
    for (int j = 0; j < 32; ++j) q32[j] = (b5 ? pz[32 + j] : pz[j]) + __shfl_xor(b5 ? pz[j] : pz[32 + j], 32);
#pragma unroll
    for (int j = 0; j < 16; ++j) q16[j] = (b4 ? q32[16 + j] : q32[j]) + __shfl_xor(b4 ? q32[j] : q32[16 + j], 16);
#pragma unroll
    for (int j = 0; j < 8; ++j) q8[j] = (b3 ? q16[8 + j] : q16[j]) + __shfl_xor(b3 ? q16[j] : q16[8 + j], 8);
#pragma unroll
    for (int j = 0; j < 4; ++j) q4[j] = (b2 ? q8[4 + j] : q8[j]) + __shfl_xor(b2 ? q8[j] : q8[4 + j], 4);
#pragma unroll
    for (int j = 0; j < 2; ++j) q2[j] = (b1 ? q4[2 + j] : q4[j]) + __shfl_xor(b1 ? q4[j] : q4[2 + j], 2);
    return (b0 ? q2[1] : q2[0]) + __shfl_xor(b0 ? q2[0] : q2[1], 1);
}
DI void phase_gather(const Params& p, int bid, int nb) {
    const float* mod = (const float*)(p.ws + OFF_MOD);
    const uint2* EX = (const uint2*)(p.ws + OFF_EXPS);
    const unsigned char* UT = (const unsigned char*)(p.ws + OFF_UT);
    const unsigned char* VT = (const unsigned char*)(p.ws + OFF_VT);
    const int lane = my_tid() & 63, wid = my_tid() >> 6;
    for (int tok = bid * 8 + wid; tok < NTOK; tok += nb * 8) {
        const int b = tok / SEQ, c0 = lane * 16;
        float* row = p.out + (size_t)tok * DM + c0;
        const float* sh2 = mod + b * 6144 + 3072 + c0;
        const float* sc2 = mod + b * 6144 + 4096 + c0;
        const float* g2 = mod + b * 6144 + 5120 + c0;
        f32x2 x1[8], h2[8], acc[8];
#pragma unroll
        for (int q = 0; q < 4; ++q) {
            const f32x4 xv = *(const f32x4*)(row + q * 4), sc = *(const f32x4*)(sc2 + q * 4), sh = *(const f32x4*)(sh2 + q * 4);
            x1[2 * q] = (f32x2){xv.x, xv.y}; x1[2 * q + 1] = (f32x2){xv.z, xv.w};
            h2[2 * q] = (f32x2){xv.x * (1.f + sc.x) + sh.x, xv.y * (1.f + sc.y) + sh.y};
            h2[2 * q + 1] = (f32x2){xv.z * (1.f + sc.z) + sh.z, xv.w * (1.f + sc.w) + sh.w};
        }
#pragma unroll
        for (int i = 0; i < 8; ++i) acc[i] = (f32x2){0.f, 0.f};
        const uint2 e0 = EX[(size_t)tok * 128 + lane], e1 = EX[(size_t)tok * 128 + 64 + lane];
        float a0, a1;
        {
            float pz[64];
#pragma unroll
            for (int e = 0; e < 64; ++e) {
                const unsigned eid = (unsigned)__builtin_amdgcn_readlane((int)e0.x, e) & 0xffffu;
                pz[e] = dot16_fp8(*(const u32x4*)(UT + (size_t)eid * DM + c0), h2);
            }
            const float z = butterfly64(pz, lane) * __uint_as_float(((e0.x >> 16) & 0xffu) << 23);
            a0 = geluf_(z) * __uint_as_float(e0.y);
        }
        {
            float pz[64];
#pragma unroll
            for (int e = 0; e < 64; ++e) {
                const unsigned eid = (unsigned)__builtin_amdgcn_readlane((int)e1.x, e) & 0xffffu;
                pz[e] = dot16_fp8(*(const u32x4*)(UT + (size_t)eid * DM + c0), h2);
            }
            const float z = butterfly64(pz, lane) * __uint_as_float(((e1.x >> 16) & 0xffu) << 23);
            a1 = geluf_(z) * __uint_as_float(e1.y);
        }
#pragma unroll 16
        for (int e = 0; e < 64; ++e) {
            const unsigned eid = (unsigned)__builtin_amdgcn_readlane((int)e0.x, e) & 0xffffu;
            const float a = __uint_as_float(__builtin_amdgcn_readlane((int)__float_as_uint(a0), e));
            axpy16_fp8(a, *(const u32x4*)(VT + (size_t)eid * DM + c0), acc);
        }
#pragma unroll 16
        for (int e = 0; e < 64; ++e) {
            const unsigned eid = (unsigned)__builtin_amdgcn_readlane((int)e1.x, e) & 0xffffu;
            const float a = __uint_as_float(__builtin_amdgcn_readlane((int)__float_as_uint(a1), e));
            axpy16_fp8(a, *(const u32x4*)(VT + (size_t)eid * DM + c0), acc);
        }
        f32x2 r[8];
        float s = 0.f;
#pragma unroll
        for (int q = 0; q < 4; ++q) {
            const f32x4 gg = *(const f32x4*)(g2 + q * 4);
            r[2 * q] = DEEP_ALPHA * x1[2 * q] + (f32x2){1.f + gg.x, 1.f + gg.y} * acc[2 * q];
            r[2 * q + 1] = DEEP_ALPHA * x1[2 * q + 1] + (f32x2){1.f + gg.z, 1.f + gg.w} * acc[2 * q + 1];
            s += r[2 * q].x + r[2 * q].y + r[2 * q + 1].x + r[2 * q + 1].y;
        }
#pragma unroll
        for (int m = 1; m < 64; m <<= 1) s += __shfl_xor(s, m);
        const float mu = s * (1.0f / 1024.0f);
        float qq = 0.f;
#pragma unroll
        for (int i = 0; i < 8; ++i) { const f32x2 d = r[i] - mu; qq += d.x * d.x + d.y * d.y; }
#pragma unroll
        for (int m = 1; m < 64; m <<= 1) qq += __shfl_xor(qq, m);
        const float rstd = rsqrtf(qq * (1.0f / 1024.0f) + LN_EPS);
#pragma unroll
        for (int q = 0; q < 4; ++q) {
            const f32x4 w = *(const f32x4*)(p.ln2w + c0 + q * 4), bi = *(const f32x4*)(p.ln2b + c0 + q * 4);
            f32x4 ov;
            ov.x = (r[2 * q].x - mu) * rstd * w.x + bi.x; ov.y = (r[2 * q].y - mu) * rstd * w.y + bi.y;
            ov.z = (r[2 * q + 1].x - mu) * rstd * w.z + bi.z; ov.w = (r[2 * q + 1].y - mu) * rstd * w.w + bi.w;
            *(f32x4*)(row + q * 4) = ov;
        }
    }
}

#define XB_TMO      128
#define XB_XCNT(j)  (256  + 64 * (j))
#define XB_XSUB(j)  (1280 + 64 * (j))
#define XB_XGEN(j)  (2304 + 64 * (j))
#define XB_TOP      3328
#define XB_TOPGEN   3392
#define XCD_BAR_WORDS 3456
#define XB_SPIN_CAP (1u << 22)
#define LAS __attribute__((address_space(3)))
DI unsigned xb_ld(unsigned* p) { return __hip_atomic_load(p, __ATOMIC_RELAXED, __HIP_MEMORY_SCOPE_AGENT); }
DI unsigned xb_add(unsigned* p, unsigned v) { return __hip_atomic_fetch_add(p, v, __ATOMIC_RELAXED, __HIP_MEMORY_SCOPE_AGENT); }
DI unsigned xb_xcc_id() { return (unsigned)__builtin_amdgcn_s_getreg((3 << 11) | 20) & 0xFu; }
#define XB_SPIN(cond, bar) do { unsigned _sp = 0; while (cond) { __builtin_amdgcn_s_sleep(1); \
    if ((++_sp & 255u) == 0u) { if (xb_ld(&(bar)[XB_TMO])) break; if (_sp > XB_SPIN_CAP) { atomicAdd(&(bar)[XB_TMO], 1u); break; } } } } while (0)
struct XcdBarrier { unsigned* bar; unsigned x; volatile LAS unsigned* st; };
DI XcdBarrier xcd_barrier_post(unsigned* bar, volatile LAS unsigned* st) {
    XcdBarrier b; b.bar = bar; b.x = xb_xcc_id(); b.st = st;
    if (__builtin_amdgcn_workitem_id_x() == 0) (void)xb_add(&bar[XB_XCNT(b.x)], 1u);
    return b;
}
DI void xcd_barrier_complete(unsigned* bar, unsigned x, unsigned& nloc, unsigned& nx) {
    const unsigned G = gridDim.x * gridDim.y * gridDim.z;
    unsigned sum, cnt, mine, sp = 0u;
    for (;;) {
        sum = 0u; cnt = 0u; mine = 0u;
#pragma unroll
        for (unsigned j = 0; j < 16; ++j) { const unsigned c = xb_ld(&bar[XB_XCNT(j)]); sum += c; cnt += (c > 0u) ? 1u : 0u; mine = (j == x) ? c : mine; }
        if (sum == G) break;
        __builtin_amdgcn_s_sleep(1);
        if ((++sp & 255u) == 0u) { if (xb_ld(&bar[XB_TMO])) break; if (sp > XB_SPIN_CAP) { atomicAdd(&bar[XB_TMO], 1u); break; } }
    }
    nloc = mine > 0u ? mine : 1u; nx = cnt > 0u ? cnt : 1u;
}
DI void xcd_barrier(const XcdBarrier& b) {
    asm volatile("s_waitcnt vmcnt(0)" ::: "memory");
    __syncthreads();
    if (__builtin_amdgcn_workitem_id_x() == 0) {
        unsigned* bar = b.bar;
        __builtin_amdgcn_s_waitcnt(0);
        unsigned nloc = b.st[0], nx = b.st[1];
        if (nloc == 0u) { xcd_barrier_complete(bar, b.x, nloc, nx); b.st[0] = nloc; b.st[1] = nx; }
        const unsigned old = xb_add(&bar[XB_XSUB(b.x)], 1u);
        const unsigned gen = old / nloc;
        if (old + 1u == (gen + 1u) * nloc) {
            __builtin_amdgcn_fence(__ATOMIC_RELEASE, "agent");
            asm volatile("s_waitcnt vmcnt(0)" ::: "memory");
            const unsigned og = xb_add(&bar[XB_TOP], 1u);
            const unsigned tg = og / nx;
            if (og + 1u == (tg + 1u) * nx) xb_add(&bar[XB_TOPGEN], 1u);
            else XB_SPIN(xb_ld(&bar[XB_TOPGEN]) == tg, bar);
            __builtin_amdgcn_fence(__ATOMIC_ACQUIRE, "agent");
            xb_add(&bar[XB_XGEN(b.x)], 1u);
            asm volatile("s_waitcnt vmcnt(0)" ::: "memory");
        } else {
            XB_SPIN(xb_ld(&bar[XB_XGEN(b.x)]) == gen, bar);
            __builtin_amdgcn_fence(__ATOMIC_ACQUIRE, "agent");
            asm volatile("s_waitcnt vmcnt(0)" ::: "memory");
        }
    }
    __syncthreads();
}

__global__ void __launch_bounds__(NTH) k_mega(Params p) {
    __shared__ __attribute__((aligned(16))) char smem[SMEM_BYTES];
    volatile LAS unsigned* xst = (volatile LAS unsigned*)(smem + SMEM_BYTES - 16);
    if (__builtin_amdgcn_workitem_id_x() == 0) { xst[0] = 0u; xst[1] = 0u; }
    __syncthreads();
    const XcdBarrier xb = xcd_barrier_post((unsigned*)(p.ws + OFF_BAR), xst);
    const int bid = blockIdx.x, nb = gridDim.x;
#ifndef PROBE_MASK
#define PROBE_MASK 0
#endif
#define REP(bit) for (int rep_ = 0; rep_ < ((PROBE_MASK & (bit)) ? 2 : 1); ++rep_)
    REP(64) { phase_prep(p, bid, nb, smem);    xcd_barrier(xb); }
    REP(64) { phase_h(p, bid, nb);             xcd_barrier(xb); }
    REP(1)  { phase_proj(p, bid, nb, smem);    xcd_barrier(xb); }
    REP(2)  { phase_hgprep(p, bid, nb);        xcd_barrier(xb); }
    REP(2)  { phase_mix(p, bid, nb, smem);     xcd_barrier(xb); }
    REP(4)  { phase_glu(p, bid, nb, smem);     xcd_barrier(xb); }
    REP(4)  { phase_a2(p, bid, nb);            xcd_barrier(xb); }
    REP(4)  { phase_outproj(p, bid, nb, smem); xcd_barrier(xb); }
    phase_ln1(p, bid, nb);           xcd_barrier(xb);
    REP(8)  { phase_q(p, bid, nb, smem);       xcd_barrier(xb); }
    REP(16) { phase_topk(p, bid, nb, smem);    xcd_barrier(xb); }
    REP(32) { phase_combine(p, bid, nb);       xcd_barrier(xb); }
    phase_gather(p, bid, nb);
}

extern "C" void kernel_launch(void* const* d_in, const int* in_sizes, int n_in, void* d_out, int out_size, void* d_ws, size_t ws_size, hipStream_t stream) {
    if (n_in != 27 || ws_size < WS_END) { fprintf(stderr, "kernel_launch: unexpected n_in %d or ws_size %zu (< %zu)\n", n_in, ws_size, (size_t)WS_END); return; }
    static int grid_blocks = 0;
    if (!grid_blocks) {
        int dev = 0, cus = 0, per_cu = 0;
        (void)hipGetDevice(&dev);
        (void)hipDeviceGetAttribute(&cus, hipDeviceAttributeMultiprocessorCount, dev);
        (void)hipOccupancyMaxActiveBlocksPerMultiprocessor(&per_cu, k_mega, NTH, 0);
        if (cus <= 0) cus = 256;
        if (per_cu < 1) { fprintf(stderr, "kernel_launch: occupancy query says %d blocks/CU\n", per_cu); per_cu = 1; }
        grid_blocks = cus;
    }
    Params p{};
    const float** f = (const float**)&p;
    for (int i = 0; i < 27; ++i) f[i] = (const float*)d_in[i];
    p.out = (float*)d_out; p.ws = (char*)d_ws;
    hipError_t e = hipMemsetAsync((char*)d_ws + OFF_BAR, 0, (size_t)3456 * 4, stream);
    if (e == hipSuccess) { hipLaunchKernelGGL(k_mega, dim3(grid_blocks), dim3(NTH), 0, stream, p); e = hipPeekAtLastError(); }
    if (e != hipSuccess) fprintf(stderr, "launch failed: %s (grid %d)\n", hipGetErrorString(e), grid_blocks);
}
```

```cpp
#include <hip/hip_runtime.h>
#include <hip/hip_cooperative_groups.h>
#include <stdint.h>
#include <stdio.h>

namespace cg = cooperative_groups;
#define DI __device__ __forceinline__
typedef unsigned short bf16_t;
typedef short bf16x8 __attribute__((ext_vector_type(8)));
typedef float f32x16 __attribute__((ext_vector_type(16)));
typedef unsigned u32x4 __attribute__((ext_vector_type(4)));
typedef float f32x4 __attribute__((ext_vector_type(4)));
typedef float f32x2 __attribute__((ext_vector_type(2)));

constexpr int NTH = 512;
constexpr int NB = 16, SEQ = 2048, DM = 1024, NTOK = NB * SEQ;
constexpr int DHG = 512, HGH = 4, HDK = 128;
constexpr int DSS = 512, SSG = 32, SSC = 16, SSP = 64;
constexpr int INC = 2560;
constexpr int PHEADS = 8, NKEYS = 128, TOPK = 16, NEXP = 16384;
constexpr float DEEP_ALPHA = 1.189207115002721f;
constexpr float LN_EPS = 1e-5f, RMS_EPS = 1e-6f;
constexpr int SMEM_BYTES = 128 * 1024 + 256;

constexpr size_t al256(size_t x) { return (x + 255) & ~(size_t)255; }
constexpr size_t OFF_MOD = 0;
constexpr size_t OFF_LB = al256(OFF_MOD + (size_t)NB * 6144 * 4);
constexpr size_t OFF_LAM = al256(OFF_LB + 512 * 4);
constexpr size_t OFF_BB = al256(OFF_LAM + 32 * 64 * 2 * 4);
constexpr size_t OFF_WIN = al256(OFF_BB + 32 * 64 * 16 * 2 * 4);
constexpr size_t OFF_GLU = al256(OFF_WIN + (size_t)INC * DM * 2);
constexpr size_t OFF_WOUT = al256(OFF_GLU + (size_t)512 * 512 * 2);
constexpr size_t OFF_WQ = al256(OFF_WOUT + (size_t)DM * DM * 2);
constexpr size_t OFF_SUBK = al256(OFF_WQ + (size_t)2048 * DM * 2);
constexpr size_t OFF_SU = al256(OFF_SUBK + (size_t)16 * 128 * 128 * 2);
constexpr size_t OFF_SV = al256(OFF_SU + (size_t)NEXP * 4);
constexpr size_t OFF_UT = al256(OFF_SV + (size_t)NEXP * 4);
constexpr size_t OFF_VT = al256(OFF_UT + (size_t)NEXP * DM * 2);
constexpr size_t OFF_H = al256(OFF_VT + (size_t)NEXP * DM * 2);
constexpr size_t OFF_PROJ = al256(OFF_H + (size_t)NTOK * DM * 2);
constexpr size_t OFF_ORAW = al256(OFF_PROJ + (size_t)NTOK * INC * 2);
constexpr size_t OFF_YSSM = al256(OFF_ORAW + (size_t)NTOK * DHG * 4);
constexpr size_t OFF_A2 = al256(OFF_YSSM + (size_t)NTOK * DSS * 2);
constexpr size_t OFF_HG = al256(OFF_A2 + (size_t)NTOK * DM * 2);
constexpr size_t OFF_S5K = al256(OFF_HG + (size_t)4096 * 128 * 4);
constexpr size_t OFF_S5N = al256(OFF_S5K + (size_t)32 * 4096 * 2);
constexpr size_t OFF_S5M = al256(OFF_S5N + (size_t)32 * 128 * 256 * 2);
constexpr size_t OFF_S5L = al256(OFF_S5M + (size_t)32 * 256 * 128 * 2);
constexpr size_t OFF_BAR = al256(OFF_S5L + (size_t)32 * 64 * 2 * 4);
constexpr size_t WS_END = al256(OFF_BAR + (size_t)3456 * 4);
constexpr size_t OFF_HQ = OFF_H, OFF_HK = OFF_H + (size_t)NTOK * DHG * 2, OFF_HKT = OFF_A2, OFF_HVT = OFF_A2 + (size_t)NTOK * DHG * 2;
constexpr size_t OFF_TOPL = OFF_ORAW;
constexpr size_t OFF_EXPS = OFF_ORAW + (size_t)NTOK * 16 * 16 * 4;

struct Params {
    const float *x, *c, *ada_w, *ada_b, *w_in, *hg_lb, *hg_nw, *a_re, *a_im, *log_dt, *b_re, *b_im, *c_re, *c_im, *dsk,
        *glu_w, *glu_b, *ssm_nw, *w_out, *ln1w, *ln1b, *w_q, *subk, *pu, *pv, *ln2w, *ln2b;
    float* out;
    char* ws;
};

DI int my_tid() { int t = (int)__builtin_amdgcn_workitem_id_x(); asm volatile("" : "+v"(t)); return t; }
DI bf16_t f2bf(float x) { unsigned u = __float_as_uint(x); u += 0x7fffu + ((u >> 16) & 1u); return (bf16_t)(u >> 16); }
DI float bf2f(bf16_t b) { return __uint_as_float(((unsigned)b) << 16); }
DI float bflo(unsigned w) { return __uint_as_float(w << 16); }
DI float bfhi(unsigned w) { return __uint_as_float(w & 0xffff0000u); }
typedef __bf16 hwbf16x2 __attribute__((ext_vector_type(2)));
DI unsigned pack2(float a, float b) { const f32x2 v = {a, b}; return __builtin_bit_cast(unsigned, __builtin_convertvector(v, hwbf16x2)); }
DI bf16x8 pack8(const f32x16& x, const int base) {
    u32x4 o; o.x = pack2(x[base], x[base + 1]); o.y = pack2(x[base + 2], x[base + 3]); o.z = pack2(x[base + 4], x[base + 5]); o.w = pack2(x[base + 6], x[base + 7]);
    return __builtin_bit_cast(bf16x8, o);
}
DI float sigmoidf_(float x) { return 1.0f / (1.0f + __expf(-x)); }
DI float siluf_(float x) { return x * sigmoidf_(x); }
DI float geluf_(float x) { return 0.5f * x * (1.0f + erff(x * 0.70710678118654752f)); }
DI float gelu_as(float v) {
    const float t = __builtin_amdgcn_rcpf(fabsf(v) * 0.2316418882f + 1.0f);
    float q = t * 0.5307027145f + (-0.7265760135f); q = q * t + 0.7107068705f; q = q * t + (-0.142248368f); q = q * t + 0.127414796f; q = q * t;
    const float m = v * (q * __builtin_amdgcn_exp2f(v * v * (-0.72134752044f)));
    return v < 0.f ? m : v - m;
}

template <int MT, int NT_, int WM, int WN, class Epi>
DI void gemm_block(const bf16_t* __restrict__ A, int lda, const bf16_t* __restrict__ Bt, int ldb, int K, char* smem, Epi epi) {
    constexpr int BM = WM * MT * 32, BN = WN * NT_ * 32, LS = 72;
    static_assert(WM * WN == 8, "8 waves");
    bf16_t* As = (bf16_t*)smem;
    bf16_t* Bs = As + BM * LS;
    const int tid = my_tid(), lane = tid & 63, wid = tid >> 6, r = lane & 31, h = lane >> 5;
    const int wm = wid / WN, wn = wid % WN;
    constexpr int PA = BM * 8 / NTH, PB = BN * 8 / NTH;
    u32x4 ra[PA], rb[PB];
    f32x16 acc[MT][NT_];
#pragma unroll
    for (int mi = 0; mi < MT; ++mi)
#pragma unroll
        for (int ni = 0; ni < NT_; ++ni)
#pragma unroll
            for (int i = 0; i < 16; ++i) acc[mi][ni][i] = 0.f;
#define GEMM_GLOAD(kt_) { \
    _Pragma("unroll") for (int q = 0; q < PA; ++q) { const int idx = tid + q * NTH, row = idx >> 3, ch = idx & 7; ra[q] = *(const u32x4*)(A + (size_t)row * lda + (kt_) * 64 + ch * 8); } \
    _Pragma("unroll") for (int q = 0; q < PB; ++q) { const int idx = tid + q * NTH, row = idx >> 3, ch = idx & 7; rb[q] = *(const u32x4*)(Bt + (size_t)row * ldb + (kt_) * 64 + ch * 8); } }
#define GEMM_LSTORE() { \
    _Pragma("unroll") for (int q = 0; q < PA; ++q) { const int idx = tid + q * NTH, row = idx >> 3, ch = idx & 7; *(u32x4*)(As + row * LS + ch * 8) = ra[q]; } \
    _Pragma("unroll") for (int q = 0; q < PB; ++q) { const int idx = tid + q * NTH, row = idx >> 3, ch = idx & 7; *(u32x4*)(Bs + row * LS + ch * 8) = rb[q]; } }
    GEMM_GLOAD(0); GEMM_LSTORE(); __syncthreads();
    const int nk = K / 64;
    for (int kt = 0; kt < nk; ++kt) {
        if (kt + 1 < nk) GEMM_GLOAD(kt + 1);
#pragma unroll
        for (int ks = 0; ks < 4; ++ks) {
            bf16x8 a[MT], b[NT_];
#pragma unroll
            for (int mi = 0; mi < MT; ++mi) a[mi] = *(const bf16x8*)(As + (wm * MT * 32 + mi * 32 + r) * LS + ks * 16 + h * 8);
#pragma unroll
            for (int ni = 0; ni < NT_; ++ni) b[ni] = *(const bf16x8*)(Bs + (wn * NT_ * 32 + ni * 32 + r) * LS + ks * 16 + h * 8);
#pragma unroll
            for (int mi = 0; mi < MT; ++mi)
#pragma unroll
                for (int ni = 0; ni < NT_; ++ni) acc[mi][ni] = __builtin_amdgcn_mfma_f32_32x32x16_bf16(a[mi], b[ni], acc[mi][ni], 0, 0, 0);
        }
        __syncthreads();
        if (kt + 1 < nk) { GEMM_LSTORE(); __syncthreads(); }
    }
#pragma unroll
    for (int mi = 0; mi < MT; ++mi)
#pragma unroll
        for (int ni = 0; ni < NT_; ++ni)
#pragma unroll
            for (int i = 0; i < 16; ++i) epi(wm * MT * 32 + mi * 32 + (i & 3) + 8 * (i >> 2) + 4 * h, wn * NT_ * 32 + ni * 32 + r, acc[mi][ni][i]);
}

namespace pg8 {
#define PG8_LAS __attribute__((address_space(3)))
typedef unsigned short bf16_t;
typedef short bf16x8 __attribute__((ext_vector_type(8)));
typedef float f32x4 __attribute__((ext_vector_type(4)));
typedef unsigned u32x4 __attribute__((ext_vector_type(4)));
constexpr int BM = 256, BK = 64, HALF = 128, HTB = HALF * BK * 2  , STAGE_BYTES = 8 * HTB, NXCD = 8, WGM = 8;

__host__ __device__ __forceinline__ int lds_byte(int r, int c) { const int st = (r >> 4) * 2 + (c >> 5), rr = r & 15, cc = c & 31, ob = rr * 64 + cc * 2; return st * 1024 + (ob ^ (((ob >> 9) & 1) << 5)); }
__host__ __device__ __forceinline__ void stage_rc(int b, int& R, int& C) { const int st = b / 1024, sb = b % 1024, swz = sb ^ (((sb >> 9) & 1) << 5); R = (st >> 1) * 16 + swz / 64; C = (st & 1) * 32 + (swz % 64) / 2; }
__host__ __device__ __forceinline__ int perm32(int rho) { const int n = rho >> 4, i = rho & 15; return 8 * (i >> 2) + 4 * n + (i & 3); }

struct Unit { int pm, pn; };
struct Gemm { const bf16_t* A; const bf16_t* Bt; int M, N, K; };

struct StaticOrder {
    int nM, nN, nwg, G, c;
    __host__ __device__ void init(int M, int N, int G_, int c_) { nM = M / BM; nN = N / BM; nwg = nM * nN; G = G_; c = c_; }
    __host__ __device__ bool next(int i, Unit& u) const {
        const long L = (long)i * G + c; if (L >= nwg) return false;
        int wgid = (int)L; { const int q = nwg / NXCD, r = nwg % NXCD, xcd = wgid % NXCD, off = wgid / NXCD; wgid = (xcd < r ? xcd * (q + 1) : r * (q + 1) + (xcd - r) * q) + off; }
        const int nig = WGM * nN, gid = wgid / nig, fm = gid * WGM, gsz = (nM - fm) < WGM ? (nM - fm) : WGM;
        u.pm = fm + ((wgid % nig) % gsz); u.pn = (wgid % nig) / gsz; return true;
    }
    __device__ __forceinline__ void a_ready(const Unit&) const {}
    __device__ __forceinline__ void done(const Unit&) const {}
};
template <class Epi, class Sched, bool STAMP = false>
__device__ __forceinline__ void gemm_phase(PG8_LAS unsigned char* lds, const Gemm g, const Sched& S, const Epi& E, unsigned long long* stamps) {
    const int tid = (int)__builtin_amdgcn_workitem_id_x(), wid = __builtin_amdgcn_readfirstlane(tid >> 6), lane = tid & 63, wr = wid >> 2, wc = wid & 3, fr = lane & 15, fq = lane >> 4;
    const int K = g.K, nt = K / BK;
    int ts_lo = 0, ts_hi = 0, nts = 0; const unsigned long long rt_entry = STAMP ? (unsigned long long)wall_clock64() : 0ull;
#define PG8_STAMP() do { if (STAMP && wid == 0 && nts < 64) { const unsigned long long _c = (unsigned long long)clock64(); \
        ts_lo = (lane == nts) ? (int)(unsigned)_c : ts_lo; ts_hi = (lane == nts) ? (int)(unsigned)(_c >> 32) : ts_hi; ++nts; } } while (0)
    PG8_STAMP();
    unsigned voffA[2], voffB[2];
#pragma unroll
    for (int i = 0; i < 2; ++i) { int R, C; stage_rc(tid * 16 + i * 8192, R, C); const int Rb = Epi::PERM ? ((R & ~31) + perm32(R & 31)) : R;
        voffA[i] = (unsigned)(R * K + C) * 2u; voffB[i] = (unsigned)(Rb * K + C) * 2u; }
    const size_t kstep = (size_t)(BK * 2);
    const size_t hstep = (size_t)HALF * K * 2;
    const size_t tstep = 2 * hstep;
    const unsigned ldsw = (unsigned)wid * 1024u;
    const int aoff = lds_byte(wr * 64 + fr, fq * 8), boff = lds_byte(wc * 32 + fr, fq * 8);
#define PG8_SA(b, h) (((b) * 2 + (h)) * HTB)
#define PG8_SB(b, h) ((4 + (b) * 2 + (h)) * HTB)
#define PG8_STAGE(bufoff, gbase, voff) do { _Pragma("unroll") for (int _i = 0; _i < 2; ++_i) \
        __builtin_amdgcn_global_load_lds((const unsigned*)((const char*)(gbase) + (voff)[_i]), (PG8_LAS unsigned*)(lds + (bufoff) + ldsw + _i * 8192), 16, 0, 0); } while (0)
#define PG8_LDA(dst, b, h) do { _Pragma("unroll") for (int m = 0; m < 4; ++m) _Pragma("unroll") for (int k = 0; k < 2; ++k) dst[m][k] = *(const PG8_LAS bf16x8*)(lds + PG8_SA(b, h) + aoff + m * 2048 + k * 1024); } while (0)
#define PG8_LDB(dst, b, h) do { _Pragma("unroll") for (int n = 0; n < 2; ++n) _Pragma("unroll") for (int k = 0; k < 2; ++k) dst[n][k] = *(const PG8_LAS bf16x8*)(lds + PG8_SB(b, h) + boff + n * 2048 + k * 1024); } while (0)
#define PG8_MMA(ai, bj, At, Bt) do { __builtin_amdgcn_s_setprio(1); _Pragma("unroll") for (int m = 0; m < 4; ++m) _Pragma("unroll") for (int n = 0; n < 2; ++n) _Pragma("unroll") for (int k = 0; k < 2; ++k) \
        acc[ai][bj][m][n] = __builtin_amdgcn_mfma_f32_16x16x32_bf16(Bt[n][k], At[m][k], acc[ai][bj][m][n], 0, 0, 0); __builtin_amdgcn_s_setprio(0); } while (0)
#define PG8_WAIT_V(n) asm volatile("s_waitcnt vmcnt(" #n ")" ::: "memory")
#define PG8_WAIT_L(n) asm volatile("s_waitcnt lgkmcnt(" #n ")" ::: "memory")
#define PG8_BAR __builtin_amdgcn_s_barrier()
#define PG8_SCHED __builtin_amdgcn_sched_barrier(0)
    Unit cur, nxt; int ui = 0;
    if (!S.next(0, cur)) return;
    f32x4 acc[2][2][4][2];
#pragma unroll
    for (int a = 0; a < 2; ++a)
#pragma unroll
        for (int b = 0; b < 2; ++b)
#pragma unroll
            for (int m = 0; m < 4; ++m)
#pragma unroll
                for (int n = 0; n < 2; ++n) acc[a][b][m][n] = (f32x4){0.f, 0.f, 0.f, 0.f};
    bf16x8 At[4][2], B0[2][2], B1[2][2];
    const char* cA = (const char*)g.A + (size_t)cur.pm * tstep; const char* cB = (const char*)g.Bt + (size_t)cur.pn * tstep;
    S.a_ready(cur);
    PG8_STAGE(PG8_SB(0, 0), cB, voffB); PG8_STAGE(PG8_SA(0, 0), cA, voffA); PG8_STAGE(PG8_SB(0, 1), cB + hstep, voffB); PG8_STAGE(PG8_SA(0, 1), cA + hstep, voffA);
    if (wr == 1) PG8_BAR;
    PG8_WAIT_V(4); PG8_BAR;
    PG8_STAGE(PG8_SB(1, 0), cB + kstep, voffB); PG8_STAGE(PG8_SA(1, 0), cA + kstep, voffA); PG8_STAGE(PG8_SB(1, 1), cB + hstep + kstep, voffB);
    PG8_WAIT_V(6); PG8_BAR;
    PG8_STAMP();
    for (;;) {
        const bool has_next = S.next(ui + 1, nxt);
        const char* nA = has_next ? (const char*)g.A + (size_t)nxt.pm * tstep : cA; const char* nB = has_next ? (const char*)g.Bt + (size_t)nxt.pn * tstep : cB;
        for (int t = 0; t < nt; t += 2) {
            const bool last = (t == nt - 2);
            const char* a1 = cA + (size_t)(t + 1) * kstep;
            const char* a2 = last ? nA : cA + (size_t)(t + 2) * kstep; const char* b2 = last ? nB : cB + (size_t)(t + 2) * kstep;
            const char* a3 = a2 + kstep; const char* b3 = b2 + kstep;
            if (last && has_next) S.a_ready(nxt);
            PG8_LDB(B0, 0, 0); PG8_SCHED; PG8_LDA(At, 0, 0); PG8_STAGE(PG8_SA(1, 1), a1 + hstep, voffA);
            PG8_WAIT_L(8); PG8_BAR; PG8_WAIT_L(0); PG8_MMA(0, 0, At, B0); PG8_BAR; PG8_SCHED;
            PG8_LDB(B1, 0, 1); PG8_STAGE(PG8_SB(0, 0), b2, voffB);
            PG8_BAR; PG8_WAIT_L(0); PG8_MMA(0, 1, At, B1); PG8_BAR;
            PG8_LDA(At, 0, 1); PG8_STAGE(PG8_SA(0, 0), a2, voffA);
            PG8_BAR; PG8_WAIT_L(0); PG8_MMA(1, 0, At, B0); PG8_BAR; PG8_SCHED;
            PG8_STAGE(PG8_SB(0, 1), b2 + hstep, voffB);
            PG8_WAIT_V(6); PG8_BAR; PG8_MMA(1, 1, At, B1); PG8_BAR;
            PG8_LDB(B0, 1, 0); PG8_SCHED; PG8_LDA(At, 1, 0); PG8_STAGE(PG8_SA(0, 1), a2 + hstep, voffA);
            PG8_WAIT_L(8); PG8_BAR; PG8_WAIT_L(0); PG8_MMA(0, 0, At, B0); PG8_BAR; PG8_SCHED;
            PG8_LDB(B1, 1, 1); PG8_STAGE(PG8_SB(1, 0), b3, voffB);
            PG8_BAR; PG8_WAIT_L(0); PG8_MMA(0, 1, At, B1); PG8_BAR;
            PG8_LDA(At, 1, 1); PG8_STAGE(PG8_SA(1, 0), a3, voffA);
            PG8_BAR; PG8_WAIT_L(0); PG8_MMA(1, 0, At, B0); PG8_BAR; PG8_SCHED;
            PG8_STAGE(PG8_SB(1, 1), b3 + hstep, voffB);
            PG8_WAIT_V(6); PG8_BAR; PG8_MMA(1, 1, At, B1); PG8_BAR;
        }
        PG8_STAMP();
        if constexpr (!Epi::AFTER_DRAIN) { E(acc, cur, wr, wc, fr, fq); S.done(cur); }
        PG8_STAMP();
        if (!has_next) break;
#pragma unroll
        for (int a = 0; a < 2; ++a)
#pragma unroll
            for (int b = 0; b < 2; ++b)
#pragma unroll
                for (int m = 0; m < 4; ++m)
#pragma unroll
                    for (int n = 0; n < 2; ++n) acc[a][b][m][n] = (f32x4){0.f, 0.f, 0.f, 0.f};
        cur = nxt; cA = nA; cB = nB; ++ui;
    }
    PG8_WAIT_V(0);
    if (wr == 0) PG8_BAR;
    PG8_BAR;
    if constexpr (Epi::AFTER_DRAIN) { E.fused(acc, cur, wr, wc, fr, fq, lds, wid, lane); S.done(cur); }
    PG8_STAMP();
    if (STAMP && wid == 0) { stamps[lane] = lane < nts ? (((unsigned long long)(unsigned)ts_hi << 32) | (unsigned)ts_lo) : 0ull;
        if (lane == 62) stamps[62] = rt_entry; if (lane == 63) stamps[63] = (unsigned long long)wall_clock64(); }
#undef PG8_STAMP
#undef PG8_SA
#undef PG8_SB
#undef PG8_STAGE
#undef PG8_LDA
#undef PG8_LDB
#undef PG8_MMA
#undef PG8_WAIT_V
#undef PG8_WAIT_L
#undef PG8_BAR
#undef PG8_SCHED
}

__device__ __forceinline__ unsigned pk_bf16(float lo, float hi) { typedef float v2f __attribute__((ext_vector_type(2))); typedef __bf16 v2b __attribute__((ext_vector_type(2))); const v2f v = {lo, hi}; return __builtin_bit_cast(unsigned, __builtin_convertvector(v, v2b)); }
__device__ __forceinline__ float silu1(float x) { return x * __builtin_amdgcn_rcpf(1.0f + __expf(-x)); }
struct EpiBf16Act {
    static constexpr bool PERM = true, AFTER_DRAIN = false;
    bf16_t* O; int ldc; unsigned silu_mask;
    __device__ __forceinline__ void operator()(const f32x4 (&acc)[2][2][4][2], const Unit& u, int wr, int wc, int fr, int fq) const {
        const int row0 = u.pm * BM + wr * 64 + fr, col0 = u.pn * BM + wc * 32 + 8 * fq;
        const bool act = (silu_mask >> u.pn) & 1u;
#pragma unroll
        for (int ai = 0; ai < 2; ++ai)
#pragma unroll
            for (int m = 0; m < 4; ++m) { bf16_t* rowp = O + (size_t)(row0 + ai * HALF + m * 16) * ldc + col0;
#pragma unroll
                for (int bj = 0; bj < 2; ++bj) { f32x4 v0 = acc[ai][bj][m][0], v1 = acc[ai][bj][m][1];
                    if (act) {
#pragma unroll
                        for (int j = 0; j < 4; ++j) { v0[j] = silu1(v0[j]); v1[j] = silu1(v1[j]); } }
                    u32x4 w; w.x = pk_bf16(v0[0], v0[1]); w.y = pk_bf16(v0[2], v0[3]); w.z = pk_bf16(v1[0], v1[1]); w.w = pk_bf16(v1[2], v1[3]);
                    *(u32x4*)(rowp + bj * HALF) = w; } }
    }
};
struct EpiResid {
    static constexpr bool PERM = false, AFTER_DRAIN = false;
    float* C; const float* X; const float* mod_g;
    float alpha;
    __device__ __forceinline__ void operator()(const f32x4 (&acc)[2][2][4][2], const Unit& u, int wr, int wc, int fr, int fq) const {
        const int row0 = u.pm * BM + wr * 64 + fr, col0 = u.pn * BM + wc * 32 + 4 * fq;
        const float* gb = mod_g + (size_t)((u.pm * BM) / 2048) * 6144 + col0;
        f32x4 gv[2][2];
#pragma unroll
        for (int bj = 0; bj < 2; ++bj)
#pragma unroll
            for (int n = 0; n < 2; ++n) gv[bj][n] = *(const f32x4*)(gb + bj * HALF + n * 16) + 1.0f;
#pragma unroll
        for (int ai = 0; ai < 2; ++ai)
#pragma unroll
            for (int m = 0; m < 4; ++m) { const size_t ro = (size_t)(row0 + ai * HALF + m * 16) * 1024 + col0;
#pragma unroll
                for (int bj = 0; bj < 2; ++bj)
#pragma unroll
                    for (int n = 0; n < 2; ++n) { const f32x4 xv = *(const f32x4*)(X + ro + bj * HALF + n * 16); *(f32x4*)(C + ro + bj * HALF + n * 16) = alpha * xv + gv[bj][n] * acc[ai][bj][m][n]; } }
    }
};
struct EpiGlu {
    static constexpr bool PERM = false, AFTER_DRAIN = false;
    float* C; const bf16_t* Y; const float* bias;
    __device__ __forceinline__ void operator()(const f32x4 (&acc)[2][2][4][2], const Unit& u, int wr, int wc, int fr, int fq) const {
        const int row0 = u.pm * BM + wr * 64 + fr, col0 = u.pn * BM + wc * 32 + 4 * fq;
        f32x4 bv[2][2];
#pragma unroll
        for (int bj = 0; bj < 2; ++bj)
#pragma unroll
            for (int n = 0; n < 2; ++n) bv[bj][n] = *(const f32x4*)(bias + col0 + bj * HALF + n * 16);
#pragma unroll
        for (int ai = 0; ai < 2; ++ai)
#pragma unroll
            for (int m = 0; m < 4; ++m) { const size_t ro = (size_t)(row0 + ai * HALF + m * 16) * 512 + col0;
#pragma unroll
                for (int bj = 0; bj < 2; ++bj)
#pragma unroll
                    for (int n = 0; n < 2; ++n) {
                        const uint2 yw = *(const uint2*)(Y + ro + bj * HALF + n * 16);
                        const f32x4 z = acc[ai][bj][m][n] + bv[bj][n];
                        f32x4 o;
                        o[0] = __uint_as_float(yw.x << 16) * __builtin_amdgcn_rcpf(1.0f + __expf(-z[0])); o[1] = __uint_as_float(yw.x & 0xffff0000u) * __builtin_amdgcn_rcpf(1.0f + __expf(-z[1]));
                        o[2] = __uint_as_float(yw.y << 16) * __builtin_amdgcn_rcpf(1.0f + __expf(-z[2])); o[3] = __uint_as_float(yw.y & 0xffff0000u) * __builtin_amdgcn_rcpf(1.0f + __expf(-z[3]));
                        *(f32x4*)(C + ro + bj * HALF + n * 16) = o; } }
    }
};
}

DI void prep_mod_item(const Params& p, int item, char* smem) {
    float* cond = (float*)smem;
    const int tid = my_tid();
    for (int i = tid; i < NB * DM; i += NTH) cond[i] = siluf_(p.c[i]);
    __syncthreads();
    const int b = tid >> 5, col = item * 32 + (tid & 31);
    float acc = 0.f;
    const float* w = p.ada_w + col;
    const float* cb = cond + b * DM;
#pragma unroll 8
    for (int k = 0; k < DM; ++k) acc += cb[k] * w[(size_t)k * 6144];
    ((float*)(p.ws + OFF_MOD))[b * 6144 + col] = acc + p.ada_b[col];
    __syncthreads();
}
DI void prep_s5_gemm_item(const Params& p, int g, char* smem) {
    f32x2* pw = (f32x2*)smem;
    f32x2* bbL = pw + 17 * 64;
    f32x2* cL = bbL + 64 * 16;
    const int tid = my_tid();
    const float dt = expf(p.log_dt[g]);
#pragma unroll 1
    for (int idx = tid; idx < 17 * 64; idx += NTH) {
        const int j = idx >> 6, pp = idx & 63;
        const float ar = p.a_re[g * 64 + pp], ai = p.a_im[g * 64 + pp];
        const float mag = expf(ar * dt * (float)j), ang = ai * dt * (float)j;
        pw[idx] = (f32x2){mag * cosf(ang), mag * sinf(ang)};
    }
    for (int idx = tid; idx < 16 * 64; idx += NTH) { const int i = idx >> 6, pp = idx & 63; cL[idx] = (f32x2){p.c_re[(g * 16 + i) * 64 + pp], p.c_im[(g * 16 + i) * 64 + pp]}; }
    __syncthreads();
    for (int idx = tid; idx < 64 * 16; idx += NTH) {
        const int pp = idx >> 4, i = idx & 15;
        const float ar = p.a_re[g * 64 + pp], ai = p.a_im[g * 64 + pp];
        const f32x2 lam = pw[64 + pp];
        const float den = ar * ar + ai * ai, nr = lam.x - 1.0f, ni = lam.y;
        const float zr = (nr * ar + ni * ai) / den, zi = (ni * ar - nr * ai) / den;
        const float br = p.b_re[(g * 64 + pp) * 16 + i], bi = p.b_im[(g * 64 + pp) * 16 + i];
        bbL[idx] = (f32x2){zr * br - zi * bi, zr * bi + zi * br};
    }
    __syncthreads();
    bf16_t* NBg = (bf16_t*)(p.ws + OFF_S5N) + (size_t)g * 128 * 256;
#pragma unroll 1
    for (int ch = tid; ch < 128 * 256 / 8; ch += NTH) {
        const int pq = ch >> 5, t = (ch >> 1) & 15, i0 = (ch & 1) * 8, pp = pq & 63;
        const f32x2 w = pw[(15 - t) * 64 + pp];
        float v[8];
#pragma unroll
        for (int e = 0; e < 8; ++e) { const f32x2 bb = bbL[pp * 16 + i0 + e]; v[e] = pq < 64 ? (w.x * bb.x - w.y * bb.y) : (w.x * bb.y + w.y * bb.x); }
        u32x4 o; o.x = pack2(v[0], v[1]); o.y = pack2(v[2], v[3]); o.z = pack2(v[4], v[5]); o.w = pack2(v[6], v[7]);
        *(u32x4*)(NBg + (size_t)pq * 256 + t * 16 + i0) = o;
    }
    bf16_t* MBg = (bf16_t*)(p.ws + OFF_S5M) + (size_t)g * 256 * 128;
#pragma unroll 1
    for (int ch = tid; ch < 256 * 128 / 8; ch += NTH) {
        const int ti = ch >> 4, p0 = (ch & 15) * 8, tq = ti >> 4, iq = ti & 15;
        float v[8];
#pragma unroll
        for (int e = 0; e < 8; ++e) {
            const int pq = p0 + e, pp = pq & 63;
            const f32x2 c = cL[iq * 64 + pp], w = pw[(tq + 1) * 64 + pp];
            v[e] = pq < 64 ? (c.x * w.x - c.y * w.y) : -(c.x * w.y + c.y * w.x);
        }
        u32x4 o; o.x = pack2(v[0], v[1]); o.y = pack2(v[2], v[3]); o.z = pack2(v[4], v[5]); o.w = pack2(v[6], v[7]);
        *(u32x4*)(MBg + (size_t)ti * 128 + p0) = o;
    }
    bf16_t* KTg = (bf16_t*)(p.ws + OFF_S5K) + (size_t)g * 4096;
#pragma unroll 1
    for (int idx = tid; idx < 4096; idx += NTH) {
        const int lag = idx >> 8, iq = (idx >> 4) & 15, i = idx & 15;
        float acc = (lag == 0 && iq == i) ? p.dsk[g * 16 + iq] : 0.f;
#pragma unroll 4
        for (int pp = 0; pp < 64; ++pp) {
            const f32x2 c = cL[iq * 64 + pp], w = pw[lag * 64 + pp], bb = bbL[pp * 16 + i];
            const float mr = c.x * w.x - c.y * w.y, mi_ = c.x * w.y + c.y * w.x;
            acc += mr * bb.x - mi_ * bb.y;
        }
        KTg[idx] = f2bf(acc);
    }
    if (tid < 64) { float* L = (float*)(p.ws + OFF_S5L) + (g * 64 + tid) * 2; const f32x2 w = pw[16 * 64 + tid]; L[0] = w.x; L[1] = w.y; }
    __syncthreads();
}
DI void prep_s5_item(const Params& p, int g) {
    const int tid = my_tid();
    if (tid < SSP) {
        const int pi = g * SSP + tid;
        const float dt = expf(p.log_dt[g]);
        const float ar = p.a_re[pi], ai = p.a_im[pi];
        const float mag = expf(ar * dt);
        const float lr = mag * cosf(ai * dt), li = mag * sinf(ai * dt);
        const float den = ar * ar + ai * ai, nr = lr - 1.0f, ni = li;
        const float zr = (nr * ar + ni * ai) / den, zi = (ni * ar - nr * ai) / den;
        float* lam = (float*)(p.ws + OFF_LAM) + pi * 2;
        lam[0] = lr; lam[1] = li;
        float* bb = (float*)(p.ws + OFF_BB) + (size_t)pi * 32;
        for (int i = 0; i < SSC; ++i) {
            const float br = p.b_re[pi * SSC + i], bi = p.b_im[pi * SSC + i];
            bb[i * 2] = zr * br - zi * bi; bb[i * 2 + 1] = zr * bi + zi * br;
        }
    }
}
DI void prep_transpose_tile(const float* __restrict__ W, bf16_t* __restrict__ Wt, int K, int N, int kt, int nt, char* smem) {
    float* tile = (float*)smem;
    const int tid = my_tid();
#pragma unroll
    for (int q = 0; q < 2; ++q) {
        const int kk = (tid >> 4) + q * 32, c4 = (tid & 15) * 4;
        const float4 v = *(const float4*)(W + (size_t)(kt * 64 + kk) * N + nt * 64 + c4);
        tile[kk * 65 + c4] = v.x; tile[kk * 65 + c4 + 1] = v.y; tile[kk * 65 + c4 + 2] = v.z; tile[kk * 65 + c4 + 3] = v.w;
    }
    __syncthreads();
    const int n = tid >> 3, kc = tid & 7;
    uint4 o;
    o.x = pack2(tile[(kc * 8 + 0) * 65 + n], tile[(kc * 8 + 1) * 65 + n]);
    o.y = pack2(tile[(kc * 8 + 2) * 65 + n], tile[(kc * 8 + 3) * 65 + n]);
    o.z = pack2(tile[(kc * 8 + 4) * 65 + n], tile[(kc * 8 + 5) * 65 + n]);
    o.w = pack2(tile[(kc * 8 + 6) * 65 + n], tile[(kc * 8 + 7) * 65 + n]);
    *(uint4*)(Wt + (size_t)(nt * 64 + n) * K + kt * 64 + kc * 8) = o;
    __syncthreads();
}
DI void cvt_bf16_stream(const float* __restrict__ src, bf16_t* __restrict__ dst, size_t n8, int bid, int nb) {
    for (size_t i = (size_t)bid * NTH + my_tid(); i < n8; i += (size_t)nb * NTH) {
        const float4 a = *(const float4*)(src + i * 8), b = *(const float4*)(src + i * 8 + 4);
        uint4 o; o.x = pack2(a.x, a.y); o.y = pack2(a.z, a.w); o.z = pack2(b.x, b.y); o.w = pack2(b.z, b.w);
        *(uint4*)(dst + i * 8) = o;
    }
}
DI void cvt_fp8_rows(const float* __restrict__ src, unsigned char* __restrict__ dst, float* __restrict__ inv, int bid, int nb) {
    const int lane = my_tid() & 63, wid = my_tid() >> 6;
    for (int row = bid * 8 + wid; row < NEXP; row += nb * 8) {
        const float* sp = src + (size_t)row * DM + lane * 16;
        const f32x4 a = *(const f32x4*)sp, b = *(const f32x4*)(sp + 4), c = *(const f32x4*)(sp + 8), d = *(const f32x4*)(sp + 12);
        float m = fmaxf(fmaxf(fmaxf(fabsf(a.x), fabsf(a.y)), fmaxf(fabsf(a.z), fabsf(a.w))), fmaxf(fmaxf(fabsf(b.x), fabsf(b.y)), fmaxf(fabsf(b.z), fabsf(b.w))));
        m = fmaxf(m, fmaxf(fmaxf(fmaxf(fabsf(c.x), fabsf(c.y)), fmaxf(fabsf(c.z), fabsf(c.w))), fmaxf(fmaxf(fabsf(d.x), fabsf(d.y)), fmaxf(fabsf(d.z), fabsf(d.w)))));
#pragma unroll
        for (int s = 1; s < 64; s <<= 1) m = fmaxf(m, __shfl_xor(m, s));
        float sc = 1.f, isc = 1.f;
        if (m > 1e-30f) {
            int k = (int)floorf(log2f(448.0f / m));
            k = k < -60 ? -60 : (k > 60 ? 60 : k);
            sc = ldexpf(1.0f, k); isc = ldexpf(1.0f, -k);
            if (m * sc > 448.0f) { sc *= 0.5f; isc *= 2.0f; }
        }
        u32x4 o;
        int w;
        w = __builtin_amdgcn_cvt_pk_fp8_f32(a.x * sc, a.y * sc, 0, false); w = __builtin_amdgcn_cvt_pk_fp8_f32(a.z * sc, a.w * sc, w, true); o.x = (unsigned)w;
        w = __builtin_amdgcn_cvt_pk_fp8_f32(b.x * sc, b.y * sc, 0, false); w = __builtin_amdgcn_cvt_pk_fp8_f32(b.z * sc, b.w * sc, w, true); o.y = (unsigned)w;
        w = __builtin_amdgcn_cvt_pk_fp8_f32(c.x * sc, c.y * sc, 0, false); w = __builtin_amdgcn_cvt_pk_fp8_f32(c.z * sc, c.w * sc, w, true); o.z = (unsigned)w;
        w = __builtin_amdgcn_cvt_pk_fp8_f32(d.x * sc, d.y * sc, 0, false); w = __builtin_amdgcn_cvt_pk_fp8_f32(d.z * sc, d.w * sc, w, true); o.w = (unsigned)w;
        *(u32x4*)(dst + (size_t)row * DM + lane * 16) = o;
        if (lane == 0) inv[row] = isc;
    }
}
DI void phase_prep(const Params& p, int bid, int nb, char* smem) {
    constexpr int N_MOD = 192, N_LB = 1, N_S5 = 32, T_WIN = 16 * 40, T_GLU = 8 * 8, T_WOUT = 16 * 16, T_WQ = 16 * 32;
    constexpr int I_LB = N_MOD, I_S5 = I_LB + N_LB, I_WIN = I_S5 + N_S5, I_GLU = I_WIN + T_WIN, I_WOUT = I_GLU + T_GLU, I_WQ = I_WOUT + T_WOUT, I_END = I_WQ + T_WQ;
    for (int it = bid; it < I_END; it += nb) {
        if (it < N_MOD) prep_mod_item(p, it, smem);
        else if (it < I_S5) {
            const int j = my_tid();
            const float a0 = p.hg_lb[j], a1 = p.hg_lb[512 + j], m = fmaxf(a0, a1);
            const float e0 = expf(a0 - m), e1 = expf(a1 - m);
            ((float*)(p.ws + OFF_LB))[j] = e0 / (e0 + e1);
        } else if (it < I_WIN) { prep_s5_item(p, it - I_S5); prep_s5_gemm_item(p, it - I_S5, smem); }
        else if (it < I_GLU) { const int t = it - I_WIN; prep_transpose_tile(p.w_in, (bf16_t*)(p.ws + OFF_WIN), DM, INC, t / 40, t % 40, smem); }
        else if (it < I_WOUT) { const int t = it - I_GLU; prep_transpose_tile(p.glu_w, (bf16_t*)(p.ws + OFF_GLU), 512, 512, t / 8, t % 8, smem); }
        else if (it < I_WQ) { const int t = it - I_WOUT; prep_transpose_tile(p.w_out, (bf16_t*)(p.ws + OFF_WOUT), DM, DM, t / 16, t % 16, smem); }
        else { const int t = it - I_WQ; prep_transpose_tile(p.w_q, (bf16_t*)(p.ws + OFF_WQ), DM, 2048, t / 32, t % 32, smem); }
    }
    cvt_bf16_stream(p.subk, (bf16_t*)(p.ws + OFF_SUBK), (size_t)16 * 128 * 128 / 8, bid, nb);
    cvt_fp8_rows(p.pu, (unsigned char*)(p.ws + OFF_UT), (float*)(p.ws + OFF_SU), bid, nb);
    cvt_fp8_rows(p.pv, (unsigned char*)(p.ws + OFF_VT), (float*)(p.ws + OFF_SV), bid, nb);
}

DI void phase_h(const Params& p, int bid, int nb) {
    const float* mod = (const float*)(p.ws + OFF_MOD);
    bf16_t* H = (bf16_t*)(p.ws + OFF_H);
    const size_t n8 = (size_t)NTOK * DM / 8;
    for (size_t i = (size_t)bid * NTH + my_tid(); i < n8; i += (size_t)nb * NTH) {
        const int row = (int)(i >> 7), c0 = (int)(i & 127) * 8, b = row / SEQ;
        const float* sh = mod + b * 6144 + c0;
        const float* sc = sh + 1024;
        const float4 a = *(const float4*)(p.x + i * 8), bq = *(const float4*)(p.x + i * 8 + 4);
        const float4 s0 = *(const float4*)sc, s1 = *(const float4*)(sc + 4), h0 = *(const float4*)sh, h1 = *(const float4*)(sh + 4);
        uint4 o;
        o.x = pack2(a.x * (1.f + s0.x) + h0.x, a.y * (1.f + s0.y) + h0.y);
        o.y = pack2(a.z * (1.f + s0.z) + h0.z, a.w * (1.f + s0.w) + h0.w);
        o.z = pack2(bq.x * (1.f + s1.x) + h1.x, bq.y * (1.f + s1.y) + h1.y);
        o.w = pack2(bq.z * (1.f + s1.z) + h1.z, bq.w * (1.f + s1.w) + h1.w);
        *(uint4*)(H + i * 8) = o;
    }
}

DI void phase_proj(const Params& p, int bid, int nb, char* smem) {
    pg8::Gemm g{(const bf16_t*)(p.ws + OFF_H), (const bf16_t*)(p.ws + OFF_WIN), NTOK, INC, DM};
    pg8::StaticOrder S; S.init(NTOK, INC, nb, bid);
    pg8::EpiBf16Act E{(bf16_t*)(p.ws + OFF_PROJ), INC, 0xC3u};
    pg8::gemm_phase<pg8::EpiBf16Act, pg8::StaticOrder, false>((PG8_LAS unsigned char*)smem, g, S, E, nullptr);
}

DI void hgrn_item(const Params& p, int item, char* smem) {
    const int vs = item & 7, hd = (item >> 3) & 3, b = item >> 5;
    const bf16_t* P = (const bf16_t*)(p.ws + OFF_PROJ);
    const float* lb = (const float*)(p.ws + OFF_LB) + hd * HDK;
    float* ORAW = (float*)(p.ws + OFF_ORAW);
    float* sq = (float*)smem;
    float* sf = sq + 32 * 128;
    float* sv = sf + 32 * 128;
    float* sp = sv + 32 * 16;
    const int tid = my_tid(), lane = tid & 63, wid = tid >> 6, kq = tid >> 4, v = tid & 15;
    float S0 = 0.f, S1 = 0.f, S2 = 0.f, S3 = 0.f;
    for (int t0 = 0; t0 < SEQ; t0 += 32) {
        for (int i = tid; i < 32 * 128; i += NTH) {
            const int t = i >> 7, k = i & 127;
            const bf16_t* row = P + (size_t)(b * SEQ + t0 + t) * INC + hd * HDK + k;
            sq[i] = bf2f(row[0]);
            const float l = lb[k];
            sf[i] = l + (1.0f - l) * sigmoidf_(bf2f(row[512]));
        }
        { const int t = tid >> 4; sv[tid] = bf2f(P[(size_t)(b * SEQ + t0 + t) * INC + 1024 + hd * HDK + vs * 16 + v]); }
        __syncthreads();
        for (int t = 0; t < 32; ++t) {
            const float4 f4 = *(const float4*)(sf + t * 128 + kq * 4), q4 = *(const float4*)(sq + t * 128 + kq * 4);
            const float vv = sv[t * 16 + v];
            S0 = f4.x * S0 + (1.0f - f4.x) * vv; S1 = f4.y * S1 + (1.0f - f4.y) * vv;
            S2 = f4.z * S2 + (1.0f - f4.z) * vv; S3 = f4.w * S3 + (1.0f - f4.w) * vv;
            float part = q4.x * S0 + q4.y * S1 + q4.z * S2 + q4.w * S3;
            part += __shfl_xor(part, 16); part += __shfl_xor(part, 32);
            if (lane < 16) sp[(t * 8 + wid) * 16 + v] = part;
        }
        __syncthreads();
        {
            const int t = tid >> 4;
            float o = 0.f;
#pragma unroll
            for (int w = 0; w < 8; ++w) o += sp[(t * 8 + w) * 16 + v];
            ORAW[(size_t)(b * SEQ + t0 + t) * DHG + hd * HDK + vs * 16 + v] = o;
        }
        __syncthreads();
    }
}
DI void s5_item(const Params& p, int item, char* smem) {
    const int oct = item & 3, b = item >> 2;
    const int tid = my_tid(), lane = tid & 63, wid = tid >> 6, g = oct * 8 + wid;
    const bf16_t* P = (const bf16_t*)(p.ws + OFF_PROJ);
    bf16_t* Y = (bf16_t*)(p.ws + OFF_YSSM);
    float* su = (float*)smem + wid * 64 * 16;
    const float* lam = (const float*)(p.ws + OFF_LAM) + (g * SSP + lane) * 2;
    const float lr = lam[0], li = lam[1];
    const float* bb = (const float*)(p.ws + OFF_BB) + (size_t)(g * SSP + lane) * 32;
    float bbr[16], bbi[16], cr[16], ci[16];
#pragma unroll
    for (int i = 0; i < 16; ++i) { bbr[i] = bb[2 * i]; bbi[i] = bb[2 * i + 1]; cr[i] = p.c_re[(g * SSC + i) * SSP + lane]; ci[i] = p.c_im[(g * SSC + i) * SSP + lane]; }
    const int ch = (lane >> 2) & 15;
    const float dch = p.dsk[g * SSC + ch];
    float xr = 0.f, xi = 0.f;
    for (int t0 = 0; t0 < SEQ; t0 += 64) {
        {
            const uint4* src = (const uint4*)(P + (size_t)(b * SEQ + t0 + lane) * INC + 2048 + g * SSC);
            const uint4 a = src[0], c = src[1];
            float* d = su + lane * 16;
            d[0] = bflo(a.x); d[1] = bfhi(a.x); d[2] = bflo(a.y); d[3] = bfhi(a.y); d[4] = bflo(a.z); d[5] = bfhi(a.z); d[6] = bflo(a.w); d[7] = bfhi(a.w);
            d[8] = bflo(c.x); d[9] = bfhi(c.x); d[10] = bflo(c.y); d[11] = bfhi(c.y); d[12] = bflo(c.z); d[13] = bfhi(c.z); d[14] = bflo(c.w); d[15] = bfhi(c.w);
        }
        __syncthreads();
        for (int t = 0; t < 64; ++t) {
            float u[16];
            const float4* us = (const float4*)(su + t * 16);
            const float4 u0 = us[0], u1 = us[1], u2 = us[2], u3 = us[3];
            u[0] = u0.x; u[1] = u0.y; u[2] = u0.z; u[3] = u0.w; u[4] = u1.x; u[5] = u1.y; u[6] = u1.z; u[7] = u1.w;
            u[8] = u2.x; u[9] = u2.y; u[10] = u2.z; u[11] = u2.w; u[12] = u3.x; u[13] = u3.y; u[14] = u3.z; u[15] = u3.w;
            float bur = 0.f, bui = 0.f;
#pragma unroll
            for (int i = 0; i < 16; ++i) { bur += bbr[i] * u[i]; bui += bbi[i] * u[i]; }
            const float nxr = lr * xr - li * xi + bur, nxi = lr * xi + li * xr + bui;
            xr = nxr; xi = nxi;
            float y[16];
#pragma unroll
            for (int i = 0; i < 16; ++i) y[i] = cr[i] * xr - ci[i] * xi;
            const bool b5 = lane & 32, b4 = lane & 16, b3 = lane & 8, b2 = lane & 4;
            float y8[8], y4[4], y2[2];
#pragma unroll
            for (int j = 0; j < 8; ++j) { const float keep = b5 ? y[8 + j] : y[j], send = b5 ? y[j] : y[8 + j]; y8[j] = keep + __shfl_xor(send, 32); }
#pragma unroll
            for (int j = 0; j < 4; ++j) { const float keep = b4 ? y8[4 + j] : y8[j], send = b4 ? y8[j] : y8[4 + j]; y4[j] = keep + __shfl_xor(send, 16); }
#pragma unroll
            for (int j = 0; j < 2; ++j) { const float keep = b3 ? y4[2 + j] : y4[j], send = b3 ? y4[j] : y4[2 + j]; y2[j] = keep + __shfl_xor(send, 8); }
            float y1;
            { const float keep = b2 ? y2[1] : y2[0], send = b2 ? y2[0] : y2[1]; y1 = keep + __shfl_xor(send, 4); }
            y1 += __shfl_xor(y1, 1); y1 += __shfl_xor(y1, 2);
            if ((lane & 3) == 0) {
                const float uu = su[t * 16 + ch];
                Y[(size_t)(b * SEQ + t0 + t) * DSS + g * SSC + ch] = f2bf(geluf_(y1 + dch * uu));
            }
        }
        __syncthreads();
    }
}
DI int crow(int i, int h) { return (i & 3) + 8 * (i >> 2) + 4 * h; }
DI void phase_hgprep(const Params& p, int bid, int nb) {
    const bf16_t* P = (const bf16_t*)(p.ws + OFF_PROJ);
    const float* lbp = (const float*)(p.ws + OFF_LB);
    const int tid = my_tid(), cl = tid >> 7, k = tid & 127;
    for (int it = bid; it < 1024; it += nb) {
        const int cq = it & 15, hd = (it >> 4) & 3, b = it >> 6, c = cq * 4 + cl;
        const bf16_t* base = P + (size_t)(b * SEQ + c * 32) * INC + hd * HDK + k;
        const float l = lbp[hd * HDK + k];
        const size_t tile = ((size_t)(b * 4 + hd) * 64 + c);
        bf16_t* HQ = (bf16_t*)(p.ws + OFF_HQ) + tile * 4096;
        bf16_t* HK = (bf16_t*)(p.ws + OFF_HK) + tile * 4096;
        bf16_t* HKT = (bf16_t*)(p.ws + OFF_HKT) + tile * 4096;
        bf16_t* HVT = (bf16_t*)(p.ws + OFF_HVT) + tile * 4096;
        float bc[32], kk[32];
        float bs = 0.f;
#pragma unroll
        for (int t = 0; t < 32; ++t) {
            const float f = l + (1.0f - l) * sigmoidf_(bf2f(base[(size_t)t * INC + 512]));
            bs += __logf(f); bc[t] = bs; kk[t] = 1.0f - f;
        }
#pragma unroll
        for (int t = 0; t < 32; ++t) {
            const float qv = bf2f(base[(size_t)t * INC]);
            HQ[t * 128 + k] = f2bf(qv * __expf(bc[t]));
            HK[t * 128 + k] = f2bf(kk[t] * __expf(fminf(-bc[t], 80.0f)));
        }
#pragma unroll
        for (int q = 0; q < 4; ++q) {
            u32x4 o;
            o.x = pack2(kk[q * 8 + 0] * __expf(bs - bc[q * 8 + 0]), kk[q * 8 + 1] * __expf(bs - bc[q * 8 + 1]));
            o.y = pack2(kk[q * 8 + 2] * __expf(bs - bc[q * 8 + 2]), kk[q * 8 + 3] * __expf(bs - bc[q * 8 + 3]));
            o.z = pack2(kk[q * 8 + 4] * __expf(bs - bc[q * 8 + 4]), kk[q * 8 + 5] * __expf(bs - bc[q * 8 + 5]));
            o.w = pack2(kk[q * 8 + 6] * __expf(bs - bc[q * 8 + 6]), kk[q * 8 + 7] * __expf(bs - bc[q * 8 + 7]));
            *(u32x4*)(HKT + k * 32 + q * 8) = o;
        }
        ((float*)(p.ws + OFF_HG))[tile * 128 + k] = __expf(bs);
#pragma unroll
        for (int q = 0; q < 4; ++q) {
            unsigned w[4];
#pragma unroll
            for (int e = 0; e < 4; ++e) w[e] = (unsigned)base[(size_t)(q * 8 + 2 * e) * INC + 1024] | ((unsigned)base[(size_t)(q * 8 + 2 * e + 1) * INC + 1024] << 16);
            *(u32x4*)(HVT + k * 32 + q * 8) = (u32x4){w[0], w[1], w[2], w[3]};
        }
    }
}
typedef short s16x4 __attribute__((ext_vector_type(4)));
DI bf16x8 cat8(const s16x4 lo, const s16x4 hi) { return (bf16x8){lo.x, lo.y, lo.z, lo.w, hi.x, hi.y, hi.z, hi.w}; }
DI void hgrn_mfma_item(const Params& p, int item, char* smem) {
    constexpr int QP_OFF = 0, KP_OFF = 8704, KT_OFF = 17408, VT_OFF = 27648, G_OFF = 37888, BUF = 38400;
    const int tid = my_tid(), lane = tid & 63, wid = tid >> 6, r = lane & 31, h = lane >> 5;
    const int b = item >> 2, hd = item & 3;
    const size_t tile0 = (size_t)item * 64;
    const bf16_t* HQ = (const bf16_t*)(p.ws + OFF_HQ) + tile0 * 4096;
    const bf16_t* HK = (const bf16_t*)(p.ws + OFF_HK) + tile0 * 4096;
    const bf16_t* HKT = (const bf16_t*)(p.ws + OFF_HKT) + tile0 * 4096;
    const bf16_t* HVT = (const bf16_t*)(p.ws + OFF_HVT) + tile0 * 4096;
    const float* HG = (const float*)(p.ws + OFF_HG) + tile0 * 128;
    float* ORAW = (float*)(p.ws + OFF_ORAW) + (size_t)b * SEQ * DHG + hd * HDK;
    const bool helper = wid >= 4;
    const int ht = tid - 256;
    u32x4 sq0, sq1, sk0, sk1, st0, st1, sv0, sv1, sg;
    sq0 = sq1 = sk0 = sk1 = st0 = st1 = sv0 = sv1 = sg = (u32x4){0, 0, 0, 0};
    f32x16 S[4];
#pragma unroll
    for (int kb = 0; kb < 4; ++kb)
#pragma unroll
        for (int i = 0; i < 16; ++i) S[kb][i] = 0.f;
#define HG_LOAD(c_) { const size_t o_ = (size_t)(c_) * 4096; \
        sq0 = *(const u32x4*)(HQ + o_ + ht * 8); sq1 = *(const u32x4*)(HQ + o_ + (ht + 256) * 8); \
        sk0 = *(const u32x4*)(HK + o_ + ht * 8); sk1 = *(const u32x4*)(HK + o_ + (ht + 256) * 8); \
        st0 = *(const u32x4*)(HKT + o_ + ht * 8); st1 = *(const u32x4*)(HKT + o_ + (ht + 256) * 8); \
        sv0 = *(const u32x4*)(HVT + o_ + ht * 8); sv1 = *(const u32x4*)(HVT + o_ + (ht + 256) * 8); \
        if (ht < 32) sg = *(const u32x4*)(HG + (size_t)(c_) * 128 + ht * 4); }
#define HG_STORE(buf_) { char* B_ = smem + (buf_) * BUF; \
        { const int i0 = ht, i1 = ht + 256; \
          *(u32x4*)(B_ + QP_OFF + (i0 >> 4) * 272 + (i0 & 15) * 16) = sq0; *(u32x4*)(B_ + QP_OFF + (i1 >> 4) * 272 + (i1 & 15) * 16) = sq1; \
          *(u32x4*)(B_ + KP_OFF + (i0 >> 4) * 272 + (i0 & 15) * 16) = sk0; *(u32x4*)(B_ + KP_OFF + (i1 >> 4) * 272 + (i1 & 15) * 16) = sk1; \
          *(u32x4*)(B_ + KT_OFF + (i0 >> 2) * 80 + (i0 & 3) * 16) = st0; *(u32x4*)(B_ + KT_OFF + (i1 >> 2) * 80 + (i1 & 3) * 16) = st1; \
          *(u32x4*)(B_ + VT_OFF + (i0 >> 2) * 80 + (i0 & 3) * 16) = sv0; *(u32x4*)(B_ + VT_OFF + (i1 >> 2) * 80 + (i1 & 3) * 16) = sv1; \
          if (ht < 32) *(u32x4*)(B_ + G_OFF + ht * 16) = sg; } }
    if (helper) { HG_LOAD(0); HG_STORE(0); }
    __syncthreads();
    for (int c = 0; c < 64; ++c) {
        if (helper) {
            if (c + 1 < 64) HG_LOAD(c + 1);
        } else {
            const char* B = smem + (c & 1) * BUF;
            const int w = wid;
            f32x16 pt;
#pragma unroll
            for (int i = 0; i < 16; ++i) pt[i] = 0.f;
#pragma unroll
            for (int ks = 0; ks < 8; ++ks) {
                const bf16x8 a = *(const bf16x8*)(B + KP_OFF + r * 272 + ks * 32 + h * 16);
                const bf16x8 bq = *(const bf16x8*)(B + QP_OFF + r * 272 + ks * 32 + h * 16);
                pt = __builtin_amdgcn_mfma_f32_32x32x16_bf16(a, bq, pt, 0, 0, 0);
            }
#pragma unroll
            for (int i = 0; i < 16; ++i) if (crow(i, h) > r) pt[i] = 0.f;
            f32x16 o;
#pragma unroll
            for (int i = 0; i < 16; ++i) o[i] = 0.f;
#pragma unroll
            for (int sp = 0; sp < 2; ++sp) {
                const char* vb = B + VT_OFF + (32 * w + r) * 80 + sp * 32 + h * 8;
                const bf16x8 bv = cat8(*(const s16x4*)vb, *(const s16x4*)(vb + 16));
                o = __builtin_amdgcn_mfma_f32_32x32x16_bf16(pack8(pt, 8 * sp), bv, o, 0, 0, 0);
            }
#pragma unroll
            for (int kb = 0; kb < 4; ++kb)
#pragma unroll
                for (int sp = 0; sp < 2; ++sp) {
                    const char* qb = B + QP_OFF + r * 272 + kb * 64 + sp * 32 + h * 8;
                    const bf16x8 aq = cat8(*(const s16x4*)qb, *(const s16x4*)(qb + 16));
                    o = __builtin_amdgcn_mfma_f32_32x32x16_bf16(aq, pack8(S[kb], 8 * sp), o, 0, 0, 0);
                }
#pragma unroll
            for (int i = 0; i < 16; ++i) ORAW[(size_t)(c * 32 + crow(i, h)) * DHG + 32 * w + r] = o[i];
#pragma unroll
            for (int kb = 0; kb < 4; ++kb) {
#pragma unroll
                for (int j = 0; j < 4; ++j) {
                    const f32x4 g4 = *(const f32x4*)(B + G_OFF + (kb * 32 + 8 * j + 4 * h) * 4);
                    S[kb][4 * j] *= g4.x; S[kb][4 * j + 1] *= g4.y; S[kb][4 * j + 2] *= g4.z; S[kb][4 * j + 3] *= g4.w;
                }
#pragma unroll
                for (int ks = 0; ks < 2; ++ks) {
                    const bf16x8 a = *(const bf16x8*)(B + KT_OFF + (kb * 32 + r) * 80 + ks * 32 + h * 16);
                    const bf16x8 bv = *(const bf16x8*)(B + VT_OFF + (32 * w + r) * 80 + ks * 32 + h * 16);
                    S[kb] = __builtin_amdgcn_mfma_f32_32x32x16_bf16(a, bv, S[kb], 0, 0, 0);
                }
            }
        }
        if (helper) { if (c + 1 < 64) HG_STORE((c + 1) & 1); }
        __syncthreads();
    }
}
template <int NJ>
DI void s5_gemm2_tile(const bf16x8 (&af)[16], const bf16_t* KTl, const bf16_t* Xin, const bf16_t* MBg, bf16_t* Yout, const int mi, const int r, const int h) {
    f32x16 y;
#pragma unroll
    for (int i = 0; i < 16; ++i) y[i] = 0.f;
    const int tsel = r >> 4, iq = r & 15;
#pragma unroll
    for (int ks = 0; ks <= 2 * NJ; ++ks) {
        const bf16x8 bk = *(const bf16x8*)(KTl + ((2 * NJ + tsel - ks) * 16 + iq) * 16 + 8 * h);
        y = __builtin_amdgcn_mfma_f32_32x32x16_bf16(af[ks], bk, y, 0, 0, 0);
    }
    {
        bf16x8 bk = *(const bf16x8*)(KTl + iq * 16 + 8 * h);
        if (tsel == 0) bk = (bf16x8){0, 0, 0, 0, 0, 0, 0, 0};
        y = __builtin_amdgcn_mfma_f32_32x32x16_bf16(af[2 * NJ + 1], bk, y, 0, 0, 0);
    }
#pragma unroll
    for (int ks = 0; ks < 8; ++ks) {
        const bf16x8 a = *(const bf16x8*)(Xin + (mi * 32 + r) * 136 + ks * 16 + 8 * h);
        const bf16x8 bm = *(const bf16x8*)(MBg + (size_t)(NJ * 32 + r) * 128 + ks * 16 + 8 * h);
        y = __builtin_amdgcn_mfma_f32_32x32x16_bf16(a, bm, y, 0, 0, 0);
    }
#pragma unroll
    for (int i = 0; i < 16; ++i) Yout[(size_t)((mi * 32 + crow(i, h)) * 16 + 2 * NJ + tsel) * DSS + iq] = f2bf(gelu_as(y[i]));
}
DI void s5_gemm_item(const Params& p, int b, int g, char* smem) {
    float* E = (float*)smem;
    bf16_t* Xin = (bf16_t*)(smem + 128 * 132 * 4);
    bf16_t* KTl = Xin + 128 * 136;
    const int tid = my_tid(), lane = tid & 63, wid = tid >> 6, r = lane & 31, h = lane >> 5;
    const int mi = wid >> 1, wh = wid & 1;
    const bf16_t* P = (const bf16_t*)(p.ws + OFF_PROJ);
    *(u32x4*)(KTl + tid * 8) = *(const u32x4*)((const bf16_t*)(p.ws + OFF_S5K) + (size_t)g * 4096 + tid * 8);
    bf16x8 af[16];
    {
        const bf16_t* ub = P + (size_t)(b * SEQ + (mi * 32 + r) * 16) * INC + 2048 + g * 16 + 8 * h;
#pragma unroll
        for (int ks = 0; ks < 16; ++ks) af[ks] = *(const bf16x8*)(ub + (size_t)ks * INC);
    }
    {
        f32x16 e0, e1;
#pragma unroll
        for (int i = 0; i < 16; ++i) { e0[i] = 0.f; e1[i] = 0.f; }
        const bf16_t* nb0 = (const bf16_t*)(p.ws + OFF_S5N) + ((size_t)g * 128 + wh * 64 + r) * 256 + 8 * h;
#pragma unroll
        for (int ks = 0; ks < 16; ++ks) {
            const bf16x8 b0 = *(const bf16x8*)(nb0 + ks * 16), b1 = *(const bf16x8*)(nb0 + 32 * 256 + ks * 16);
            e0 = __builtin_amdgcn_mfma_f32_32x32x16_bf16(af[ks], b0, e0, 0, 0, 0);
            e1 = __builtin_amdgcn_mfma_f32_32x32x16_bf16(af[ks], b1, e1, 0, 0, 0);
        }
#pragma unroll
        for (int i = 0; i < 16; ++i) { float* er = E + (mi * 32 + crow(i, h)) * 132 + wh * 64 + r; er[0] = e0[i]; er[32] = e1[i]; }
    }
    __syncthreads();
    if (wid == 0) {
        const float* L = (const float*)(p.ws + OFF_S5L) + (g * 64 + lane) * 2;
        const float lr = L[0], li = L[1];
        float xr = 0.f, xi = 0.f;
#pragma unroll 8
        for (int c = 0; c < 128; ++c) {
            const float er = E[c * 132 + lane], ei = E[c * 132 + 64 + lane];
            Xin[c * 136 + lane] = f2bf(xr); Xin[c * 136 + 64 + lane] = f2bf(xi);
            const float nr = lr * xr - li * xi + er, ni = lr * xi + li * xr + ei;
            xr = nr; xi = ni;
        }
    }
    __syncthreads();
    const bf16_t* MBg = (const bf16_t*)(p.ws + OFF_S5M) + (size_t)g * 256 * 128;
    bf16_t* Yout = (bf16_t*)(p.ws + OFF_YSSM) + (size_t)b * SEQ * DSS + g * 16;
    if (wh) {
        s5_gemm2_tile<1>(af, KTl, Xin, MBg, Yout, mi, r, h); s5_gemm2_tile<6>(af, KTl, Xin, MBg, Yout, mi, r, h);
        s5_gemm2_tile<3>(af, KTl, Xin, MBg, Yout, mi, r, h); s5_gemm2_tile<4>(af, KTl, Xin, MBg, Yout, mi, r, h);
    } else {
        s5_gemm2_tile<0>(af, KTl, Xin, MBg, Yout, mi, r, h); s5_gemm2_tile<7>(af, KTl, Xin, MBg, Yout, mi, r, h);
        s5_gemm2_tile<2>(af, KTl, Xin, MBg, Yout, mi, r, h); s5_gemm2_tile<5>(af, KTl, Xin, MBg, Yout, mi, r, h);
    }
    __syncthreads();
}
DI void phase_mix(const Params& p, int bid, int nb, char* smem) {
    if (nb == 256) {
        if (bid < 64) { hgrn_mfma_item(p, bid, smem); return; }
        const int j = bid - 64, x = j & 7, lb = j >> 3;
        for (int q = lb; q < 64; q += 24) s5_gemm_item(p, q & 15, x * 4 + (q >> 4), smem);
    } else {
        for (int it = bid; it < 64; it += nb) hgrn_mfma_item(p, it, smem);
        for (int q = bid; q < 512; q += nb) s5_gemm_item(p, q & 15, q >> 4, smem);
    }
}

DI void phase_glu(const Params& p, int bid, int nb, char* smem) {
    pg8::Gemm g{(const bf16_t*)(p.ws + OFF_YSSM), (const bf16_t*)(p.ws + OFF_GLU), NTOK, 512, 512};
    pg8::StaticOrder S; S.init(NTOK, 512, nb, bid);
    pg8::EpiGlu E{(float*)(p.ws + OFF_H), (const bf16_t*)(p.ws + OFF_YSSM), p.glu_b};
    pg8::gemm_phase<pg8::EpiGlu, pg8::StaticOrder, false>((PG8_LAS unsigned char*)smem, g, S, E, nullptr);
}
DI void phase_a2(const Params& p, int bid, int nb) {
    const float* ORAW = (const float*)(p.ws + OFF_ORAW);
    const float* Y2 = (const float*)(p.ws + OFF_H);
    const bf16_t* P = (const bf16_t*)(p.ws + OFF_PROJ);
    bf16_t* A2 = (bf16_t*)(p.ws + OFF_A2);
    const int lane = my_tid() & 63, wid = my_tid() >> 6;
    for (int tok = bid * 8 + wid; tok < NTOK; tok += nb * 8) {
        const int c0 = lane * 8;
        {
            const float4 a = *(const float4*)(ORAW + (size_t)tok * DHG + c0), b = *(const float4*)(ORAW + (size_t)tok * DHG + c0 + 4);
            float ss = a.x * a.x + a.y * a.y + a.z * a.z + a.w * a.w + b.x * b.x + b.y * b.y + b.z * b.z + b.w * b.w;
            ss += __shfl_xor(ss, 1); ss += __shfl_xor(ss, 2); ss += __shfl_xor(ss, 4); ss += __shfl_xor(ss, 8);
            const float rs = rsqrtf(ss * (1.0f / 128.0f) + RMS_EPS);
            const uint4 gq = *(const uint4*)(P + (size_t)tok * INC + 1536 + c0);
            const float4 w0 = *(const float4*)(p.hg_nw + c0), w1 = *(const float4*)(p.hg_nw + c0 + 4);
            uint4 o;
            o.x = pack2(a.x * rs * w0.x * bflo(gq.x), a.y * rs * w0.y * bfhi(gq.x));
            o.y = pack2(a.z * rs * w0.z * bflo(gq.y), a.w * rs * w0.w * bfhi(gq.y));
            o.z = pack2(b.x * rs * w1.x * bflo(gq.z), b.y * rs * w1.y * bfhi(gq.z));
            o.w = pack2(b.z * rs * w1.z * bflo(gq.w), b.w * rs * w1.w * bfhi(gq.w));
            *(uint4*)(A2 + (size_t)tok * DM + c0) = o;
        }
        {
            const float4 a = *(const float4*)(Y2 + (size_t)tok * DSS + c0), b = *(const float4*)(Y2 + (size_t)tok * DSS + c0 + 4);
            float ss = a.x * a.x + a.y * a.y + a.z * a.z + a.w * a.w + b.x * b.x + b.y * b.y + b.z * b.z + b.w * b.w;
#pragma unroll
            for (int m = 1; m < 64; m <<= 1) ss += __shfl_xor(ss, m);
            const float rs = rsqrtf(ss * (1.0f / 512.0f) + RMS_EPS);
            const float4 w0 = *(const float4*)(p.ssm_nw + c0), w1 = *(const float4*)(p.ssm_nw + c0 + 4);
            uint4 o;
            o.x = pack2(a.x * rs * w0.x, a.y * rs * w0.y); o.y = pack2(a.z * rs * w0.z, a.w * rs * w0.w);
            o.z = pack2(b.x * rs * w1.x, b.y * rs * w1.y); o.w = pack2(b.z * rs * w1.z, b.w * rs * w1.w);
            *(uint4*)(A2 + (size_t)tok * DM + 512 + c0) = o;
        }
    }
}

DI void phase_outproj(const Params& p, int bid, int nb, char* smem) {
    pg8::Gemm g{(const bf16_t*)(p.ws + OFF_A2), (const bf16_t*)(p.ws + OFF_WOUT), NTOK, DM, DM};
    pg8::StaticOrder S; S.init(NTOK, DM, nb, bid);
    pg8::EpiResid E{p.out, p.x, (const float*)(p.ws + OFF_MOD) + 2048, DEEP_ALPHA};
    pg8::gemm_phase<pg8::EpiResid, pg8::StaticOrder, false>((PG8_LAS unsigned char*)smem, g, S, E, nullptr);
}
DI void phase_ln1(const Params& p, int bid, int nb) {
    const float* mod = (const float*)(p.ws + OFF_MOD);
    bf16_t* H2 = (bf16_t*)(p.ws + OFF_H);
    const int lane = my_tid() & 63, wid = my_tid() >> 6;
    for (int tok = bid * 8 + wid; tok < NTOK; tok += nb * 8) {
        const int b = tok / SEQ;
        float* row = p.out + (size_t)tok * DM;
        float4 v[4];
        float s = 0.f;
#pragma unroll
        for (int j = 0; j < 4; ++j) { v[j] = *(const float4*)(row + j * 256 + lane * 4); s += v[j].x + v[j].y + v[j].z + v[j].w; }
#pragma unroll
        for (int m = 1; m < 64; m <<= 1) s += __shfl_xor(s, m);
        const float mu = s * (1.0f / 1024.0f);
        float q = 0.f;
#pragma unroll
        for (int j = 0; j < 4; ++j) { const float a = v[j].x - mu, bb = v[j].y - mu, cc = v[j].z - mu, d = v[j].w - mu; q += a * a + bb * bb + cc * cc + d * d; }
#pragma unroll
        for (int m = 1; m < 64; m <<= 1) q += __shfl_xor(q, m);
        const float rstd = rsqrtf(q * (1.0f / 1024.0f) + LN_EPS);
        const float* sh2 = mod + b * 6144 + 3072;
        const float* sc2 = mod + b * 6144 + 4096;
#pragma unroll
        for (int j = 0; j < 4; ++j) {
            const int c = j * 256 + lane * 4;
            const float4 w = *(const float4*)(p.ln1w + c), bi = *(const float4*)(p.ln1b + c), sc = *(const float4*)(sc2 + c), sh = *(const float4*)(sh2 + c);
            float4 o;
            o.x = (v[j].x - mu) * rstd * w.x + bi.x; o.y = (v[j].y - mu) * rstd * w.y + bi.y; o.z = (v[j].z - mu) * rstd * w.z + bi.z; o.w = (v[j].w - mu) * rstd * w.w + bi.w;
            *(float4*)(row + c) = o;
            uint2 hh; hh.x = pack2(o.x * (1.f + sc.x) + sh.x, o.y * (1.f + sc.y) + sh.y); hh.y = pack2(o.z * (1.f + sc.z) + sh.z, o.w * (1.f + sc.w) + sh.w);
            *(uint2*)(H2 + (size_t)tok * DM + c) = hh;
        }
    }
}

DI void phase_q(const Params& p, int bid, int nb, char* smem) {
    pg8::Gemm g{(const bf16_t*)(p.ws + OFF_H), (const bf16_t*)(p.ws + OFF_WQ), NTOK, 2048, DM};
    pg8::StaticOrder S; S.init(NTOK, 2048, nb, bid);
    pg8::EpiBf16Act E{(bf16_t*)(p.ws + OFF_PROJ), 2048, 0u};
    pg8::gemm_phase<pg8::EpiBf16Act, pg8::StaticOrder, false>((PG8_LAS unsigned char*)smem, g, S, E, nullptr);
}
DI void phase_topk(const Params& p, int bid, int nb, char* smem) {
    const bf16_t* Q = (const bf16_t*)(p.ws + OFF_PROJ);
    const bf16_t* SK = (const bf16_t*)(p.ws + OFF_SUBK);
    unsigned* TOPL = (unsigned*)(p.ws + OFF_TOPL);
    float* sc = (float*)(smem + 36864);
    constexpr int NTM = NTOK / 128;
    for (int t = bid; t < NTM * 16; t += nb) {
        const int mt = t >> 4, hp = t & 15;
        gemm_block<2, 1, 2, 4>(Q + (size_t)mt * 128 * 2048 + hp * 128, 2048, SK + (size_t)hp * 128 * 128, 128, 128, smem,
                               [&](int r, int c, float v) { sc[r * 129 + c] = v; });
        __syncthreads();
        if (my_tid() < 128) {
            const int r = my_tid();
            float tk[16];
#pragma unroll
            for (int j = 0; j < 16; ++j) tk[j] = -3.0e38f;
            for (int n = 0; n < 128; ++n) {
                float xv = __uint_as_float((__float_as_uint(sc[r * 129 + n]) & ~0x7fu) | (unsigned)n);
#pragma unroll
                for (int j = 0; j < 16; ++j) { const float hi = fmaxf(tk[j], xv), lo = fminf(tk[j], xv); tk[j] = hi; xv = lo; }
            }
            uint4* dst = (uint4*)(TOPL + ((size_t)(mt * 128 + r) * 16 + hp) * 16);
            dst[0] = make_uint4(__float_as_uint(tk[0]), __float_as_uint(tk[1]), __float_as_uint(tk[2]), __float_as_uint(tk[3]));
            dst[1] = make_uint4(__float_as_uint(tk[4]), __float_as_uint(tk[5]), __float_as_uint(tk[6]), __float_as_uint(tk[7]));
            dst[2] = make_uint4(__float_as_uint(tk[8]), __float_as_uint(tk[9]), __float_as_uint(tk[10]), __float_as_uint(tk[11]));
            dst[3] = make_uint4(__float_as_uint(tk[12]), __float_as_uint(tk[13]), __float_as_uint(tk[14]), __float_as_uint(tk[15]));
        }
        __syncthreads();
    }
}
DI void phase_combine(const Params& p, int bid, int nb) {
    const unsigned* TOPL = (const unsigned*)(p.ws + OFF_TOPL);
    uint2* EX = (uint2*)(p.ws + OFF_EXPS);
    const float* SU = (const float*)(p.ws + OFF_SU);
    const float* SV = (const float*)(p.ws + OFF_SV);
    for (int i = bid * NTH + my_tid(); i < NTOK * PHEADS; i += nb * NTH) {
        const unsigned* l1 = TOPL + (size_t)i * 32;
        const unsigned* l2 = l1 + 16;
        float s2[16];
        {
            const uint4 a = ((const uint4*)l2)[0], b = ((const uint4*)l2)[1], c = ((const uint4*)l2)[2], d = ((const uint4*)l2)[3];
            const unsigned w[16] = {a.x, a.y, a.z, a.w, b.x, b.y, b.z, b.w, c.x, c.y, c.z, c.w, d.x, d.y, d.z, d.w};
#pragma unroll
            for (int j = 0; j < 16; ++j) s2[j] = __uint_as_float(w[j] & ~0x7fu);
        }
        float tk[16];
#pragma unroll
        for (int j = 0; j < 16; ++j) tk[j] = -3.0e38f;
        for (int a = 0; a < 16; ++a) {
            const float s1 = __uint_as_float(l1[a] & ~0x7fu);
#pragma unroll
            for (int b = 0; b < 16; ++b) {
                float xv = __uint_as_float((__float_as_uint(s1 + s2[b]) & ~0xffu) | (unsigned)(a * 16 + b));
#pragma unroll
                for (int j = 0; j < 16; ++j) { const float hi = fmaxf(tk[j], xv), lo = fminf(tk[j], xv); tk[j] = hi; xv = lo; }
            }
        }
        float e[16], sum = 0.f;
        const float mx = __uint_as_float(__float_as_uint(tk[0]) & ~0xffu);
#pragma unroll
        for (int j = 0; j < 16; ++j) { e[j] = __expf(__uint_as_float(__float_as_uint(tk[j]) & ~0xffu) - mx); sum += e[j]; }
        const float inv = 1.0f / sum;
#pragma unroll
        for (int j = 0; j < 16; ++j) {
            const unsigned ab = __float_as_uint(tk[j]) & 0xffu;
            const unsigned i1 = l1[ab >> 4] & 0x7fu, i2 = l2[ab & 15] & 0x7fu;
            const unsigned eid = i1 * 128u + i2;
            EX[(size_t)i * 16 + j] = make_uint2(eid | (((__float_as_uint(SU[eid]) >> 23) & 0xffu) << 16), __float_as_uint(e[j] * inv * SV[eid]));
        }
    }
}

DI float dot16_fp8(const u32x4 w, const f32x2 (&h)[8]) {
    f32x2 acc = __builtin_amdgcn_cvt_pk_f32_fp8((int)w.x, false) * h[0];
    acc += __builtin_amdgcn_cvt_pk_f32_fp8((int)w.x, true) * h[1];
    acc += __builtin_amdgcn_cvt_pk_f32_fp8((int)w.y, false) * h[2];
    acc += __builtin_amdgcn_cvt_pk_f32_fp8((int)w.y, true) * h[3];
    acc += __builtin_amdgcn_cvt_pk_f32_fp8((int)w.z, false) * h[4];
    acc += __builtin_amdgcn_cvt_pk_f32_fp8((int)w.z, true) * h[5];
    acc += __builtin_amdgcn_cvt_pk_f32_fp8((int)w.w, false) * h[6];
    acc += __builtin_amdgcn_cvt_pk_f32_fp8((int)w.w, true) * h[7];
    return acc.x + acc.y;
}
DI void axpy16_fp8(const float a, const u32x4 w, f32x2 (&o)[8]) {
    const f32x2 aa = {a, a};
    o[0] += aa * __builtin_amdgcn_cvt_pk_f32_fp8((int)w.x, false); o[1] += aa * __builtin_amdgcn_cvt_pk_f32_fp8((int)w.x, true);
    o[2] += aa * __builtin_amdgcn_cvt_pk_f32_fp8((int)w.y, false); o[3] += aa * __builtin_amdgcn_cvt_pk_f32_fp8((int)w.y, true);
    o[4] += aa * __builtin_amdgcn_cvt_pk_f32_fp8((int)w.z, false); o[5] += aa * __builtin_amdgcn_cvt_pk_f32_fp8((int)w.z, true);
    o[6] += aa * __builtin_amdgcn_cvt_pk_f32_fp8((int)w.w, false); o[7] += aa * __builtin_amdgcn_cvt_pk_f32_fp8((int)w.w, true);
}
DI float butterfly64(float (&pz)[64], const int lane) {
    const bool b5 = lane & 32, b4 = lane & 16, b3 = lane & 8, b2 = lane & 4, b1 = lane & 2, b0 = lane & 1;
    float q32[32], q16[16], q8[8], q4[4], q2[2];
#pragma unroll
    for (int j = 0; j < 32; ++j) q32[j] = (b5 ? pz[32 + j] : pz[j]) + __shfl_xor(b5 ? pz[j] : pz[32 + j], 32);
#pragma unroll
    for (int j = 0; j < 16; ++j) q16[j] = (b4 ? q32[16 + j] : q32[j]) + __shfl_xor(b4 ? q32[j] : q32[16 + j], 16);
#pragma unroll
    for (int j = 0; j < 8; ++j) q8[j] = (b3 ? q16[8 + j] : q16[j]) + __shfl_xor(b3 ? q16[j] : q16[8 + j], 8);
#pragma unroll
    for (int j = 0; j < 4; ++j) q4[j] = (b2 ? q8[4 + j] : q8[j]) + __shfl_xor(b2 ? q8[j] : q8[4 + j], 4);
#pragma unroll
    for (int j = 0; j < 2; ++j) q2[j] = (b1 ? q4[2 + j] : q4[j]) + __shfl_xor(b1 ? q4[j] : q4[2 + j], 2);
    return (b0 ? q2[1] : q2[0]) + __shfl_xor(b0 ? q2[0] : q2[1], 1);
}
DI void phase_gather(const Params& p, int bid, int nb) {
    const float* mod = (const float*)(p.ws + OFF_MOD);
    const uint2* EX = (const uint2*)(p.ws + OFF_EXPS);
    const unsigned char* UT = (const unsigned char*)(p.ws + OFF_UT);
    const unsigned char* VT = (const unsigned char*)(p.ws + OFF_VT);
    const int lane = my_tid() & 63, wid = my_tid() >> 6;
    for (int tok = bid * 8 + wid; tok < NTOK; tok += nb * 8) {
        const int b = tok / SEQ, c0 = lane * 16;
        float* row = p.out + (size_t)tok * DM + c0;
        const float* sh2 = mod + b * 6144 + 3072 + c0;
        const float* sc2 = mod + b * 6144 + 4096 + c0;
        const float* g2 = mod + b * 6144 + 5120 + c0;
        f32x2 x1[8], h2[8], acc[8];
#pragma unroll
        for (int q = 0; q < 4; ++q) {
            const f32x4 xv = *(const f32x4*)(row + q * 4), sc = *(const f32x4*)(sc2 + q * 4), sh = *(const f32x4*)(sh2 + q * 4);
            x1[2 * q] = (f32x2){xv.x, xv.y}; x1[2 * q + 1] = (f32x2){xv.z, xv.w};
            h2[2 * q] = (f32x2){xv.x * (1.f + sc.x) + sh.x, xv.y * (1.f + sc.y) + sh.y};
            h2[2 * q + 1] = (f32x2){xv.z * (1.f + sc.z) + sh.z, xv.w * (1.f + sc.w) + sh.w};
        }
#pragma unroll
        for (int i = 0; i < 8; ++i) acc[i] = (f32x2){0.f, 0.f};
        const uint2 e0 = EX[(size_t)tok * 128 + lane], e1 = EX[(size_t)tok * 128 + 64 + lane];
        float a0, a1;
        {
            float pz[64];
#pragma unroll
            for (int e = 0; e < 64; ++e) {
                const unsigned eid = (unsigned)__builtin_amdgcn_readlane((int)e0.x, e) & 0xffffu;
                pz[e] = dot16_fp8(*(const u32x4*)(UT + (size_t)eid * DM + c0), h2);
            }
            const float z = butterfly64(pz, lane) * __uint_as_float(((e0.x >> 16) & 0xffu) << 23);
            a0 = geluf_(z) * __uint_as_float(e0.y);
        }
        {
            float pz[64];
#pragma unroll
            for (int e = 0; e < 64; ++e) {
                const unsigned eid = (unsigned)__builtin_amdgcn_readlane((int)e1.x, e) & 0xffffu;
                pz[e] = dot16_fp8(*(const u32x4*)(UT + (size_t)eid * DM + c0), h2);
            }
            const float z = butterfly64(pz, lane) * __uint_as_float(((e1.x >> 16) & 0xffu) << 23);
            a1 = geluf_(z) * __uint_as_float(e1.y);
        }
#pragma unroll 16
        for (int e = 0; e < 64; ++e) {
            const unsigned eid = (unsigned)__builtin_amdgcn_readlane((int)e0.x, e) & 0xffffu;
            const float a = __uint_as_float(__builtin_amdgcn_readlane((int)__float_as_uint(a0), e));
            axpy16_fp8(a, *(const u32x4*)(VT + (size_t)eid * DM + c0), acc);
        }
#pragma unroll 16
        for (int e = 0; e < 64; ++e) {
            const unsigned eid = (unsigned)__builtin_amdgcn_readlane((int)e1.x, e) & 0xffffu;
            const float a = __uint_as_float(__builtin_amdgcn_readlane((int)__float_as_uint(a1), e));
            axpy16_fp8(a, *(const u32x4*)(VT + (size_t)eid * DM + c0), acc);
        }
        f32x2 r[8];
        float s = 0.f;
#pragma unroll
        for (int q = 0; q < 4; ++q) {
            const f32x4 gg = *(const f32x4*)(g2 + q * 4);
            r[2 * q] = DEEP_ALPHA * x1[2 * q] + (f32x2){1.f + gg.x, 1.f + gg.y} * acc[2 * q];
            r[2 * q + 1] = DEEP_ALPHA * x1[2 * q + 1] + (f32x2){1.f + gg.z, 1.f + gg.w} * acc[2 * q + 1];
            s += r[2 * q].x + r[2 * q].y + r[2 * q + 1].x + r[2 * q + 1].y;
        }
#pragma unroll
        for (int m = 1; m < 64; m <<= 1) s += __shfl_xor(s, m);
        const float mu = s * (1.0f / 1024.0f);
        float qq = 0.f;
#pragma unroll
        for (int i = 0; i < 8; ++i) { const f32x2 d = r[i] - mu; qq += d.x * d.x + d.y * d.y; }
#pragma unroll
        for (int m = 1; m < 64; m <<= 1) qq += __shfl_xor(qq, m);
        const float rstd = rsqrtf(qq * (1.0f / 1024.0f) + LN_EPS);
#pragma unroll
        for (int q = 0; q < 4; ++q) {
            const f32x4 w = *(const f32x4*)(p.ln2w + c0 + q * 4), bi = *(const f32x4*)(p.ln2b + c0 + q * 4);
            f32x4 ov;
            ov.x = (r[2 * q].x - mu) * rstd * w.x + bi.x; ov.y = (r[2 * q].y - mu) * rstd * w.y + bi.y;
            ov.z = (r[2 * q + 1].x - mu) * rstd * w.z + bi.z; ov.w = (r[2 * q + 1].y - mu) * rstd * w.w + bi.w;
            *(f32x4*)(row + q * 4) = ov;
        }
    }
}

#define XB_TMO      128
#define XB_XCNT(j)  (256  + 64 * (j))
#define XB_XSUB(j)  (1280 + 64 * (j))
#define XB_XGEN(j)  (2304 + 64 * (j))
#define XB_TOP      3328
#define XB_TOPGEN   3392
#define XCD_BAR_WORDS 3456
#define XB_SPIN_CAP (1u << 22)
#define LAS __attribute__((address_space(3)))
DI unsigned xb_ld(unsigned* p) { return __hip_atomic_load(p, __ATOMIC_RELAXED, __HIP_MEMORY_SCOPE_AGENT); }
DI unsigned xb_add(unsigned* p, unsigned v) { return __hip_atomic_fetch_add(p, v, __ATOMIC_RELAXED, __HIP_MEMORY_SCOPE_AGENT); }
DI unsigned xb_xcc_id() { return (unsigned)__builtin_amdgcn_s_getreg((3 << 11) | 20) & 0xFu; }
#define XB_SPIN(cond, bar) do { unsigned _sp = 0; while (cond) { __builtin_amdgcn_s_sleep(1); \
    if ((++_sp & 255u) == 0u) { if (xb_ld(&(bar)[XB_TMO])) break; if (_sp > XB_SPIN_CAP) { atomicAdd(&(bar)[XB_TMO], 1u); break; } } } } while (0)
struct XcdBarrier { unsigned* bar; unsigned x; volatile LAS unsigned* st; };
DI XcdBarrier xcd_barrier_post(unsigned* bar, volatile LAS unsigned* st) {
    XcdBarrier b; b.bar = bar; b.x = xb_xcc_id(); b.st = st;
    if (__builtin_amdgcn_workitem_id_x() == 0) (void)xb_add(&bar[XB_XCNT(b.x)], 1u);
    return b;
}
DI void xcd_barrier_complete(unsigned* bar, unsigned x, unsigned& nloc, unsigned& nx) {
    const unsigned G = gridDim.x * gridDim.y * gridDim.z;
    unsigned sum, cnt, mine, sp = 0u;
    for (;;) {
        sum = 0u; cnt = 0u; mine = 0u;
#pragma unroll
        for (unsigned j = 0; j < 16; ++j) { const unsigned c = xb_ld(&bar[XB_XCNT(j)]); sum += c; cnt += (c > 0u) ? 1u : 0u; mine = (j == x) ? c : mine; }
        if (sum == G) break;
        __builtin_amdgcn_s_sleep(1);
        if ((++sp & 255u) == 0u) { if (xb_ld(&bar[XB_TMO])) break; if (sp > XB_SPIN_CAP) { atomicAdd(&bar[XB_TMO], 1u); break; } }
    }
    nloc = mine > 0u ? mine : 1u; nx = cnt > 0u ? cnt : 1u;
}
DI void xcd_barrier(const XcdBarrier& b) {
    asm volatile("s_waitcnt vmcnt(0)" ::: "memory");
    __syncthreads();
    if (__builtin_amdgcn_workitem_id_x() == 0) {
        unsigned* bar = b.bar;
        __builtin_amdgcn_s_waitcnt(0);
        unsigned nloc = b.st[0], nx = b.st[1];
        if (nloc == 0u) { xcd_barrier_complete(bar, b.x, nloc, nx); b.st[0] = nloc; b.st[1] = nx; }
        const unsigned old = xb_add(&bar[XB_XSUB(b.x)], 1u);
        const unsigned gen = old / nloc;
        if (old + 1u == (gen + 1u) * nloc) {
            __builtin_amdgcn_fence(__ATOMIC_RELEASE, "agent");
            asm volatile("s_waitcnt vmcnt(0)" ::: "memory");
            const unsigned og = xb_add(&bar[XB_TOP], 1u);
            const unsigned tg = og / nx;
            if (og + 1u == (tg + 1u) * nx) xb_add(&bar[XB_TOPGEN], 1u);
            else XB_SPIN(xb_ld(&bar[XB_TOPGEN]) == tg, bar);
            __builtin_amdgcn_fence(__ATOMIC_ACQUIRE, "agent");
            xb_add(&bar[XB_XGEN(b.x)], 1u);
            asm volatile("s_waitcnt vmcnt(0)" ::: "memory");
        } else {
            XB_SPIN(xb_ld(&bar[XB_XGEN(b.x)]) == gen, bar);
            __builtin_amdgcn_fence(__ATOMIC_ACQUIRE, "agent");
            asm volatile("s_waitcnt vmcnt(0)" ::: "memory");
        }
    }
    __syncthreads();
}

__global__ void __launch_bounds__(NTH) k_mega(Params p) {
    __shared__ __attribute__((aligned(16))) char smem[SMEM_BYTES];
    volatile LAS unsigned* xst = (volatile LAS unsigned*)(smem + SMEM_BYTES - 16);
    if (__builtin_amdgcn_workitem_id_x() == 0) { xst[0] = 0u; xst[1] = 0u; }
    __syncthreads();
    const XcdBarrier xb = xcd_barrier_post((unsigned*)(p.ws + OFF_BAR), xst);
    const int bid = blockIdx.x, nb = gridDim.x;
#ifndef PROBE_MASK
#define PROBE_MASK 0
#endif
#define REP(bit) for (int rep_ = 0; rep_ < ((PROBE_MASK & (bit)) ? 2 : 1); ++rep_)
    REP(64) { phase_prep(p, bid, nb, smem);    xcd_barrier(xb); }
    REP(64) { phase_h(p, bid, nb);             xcd_barrier(xb); }
    REP(1)  { phase_proj(p, bid, nb, smem);    xcd_barrier(xb); }
    REP(2)  { phase_hgprep(p, bid, nb);        xcd_barrier(xb); }
    REP(2)  { phase_mix(p, bid, nb, smem);     xcd_barrier(xb); }
    REP(4)  { phase_glu(p, bid, nb, smem);     xcd_barrier(xb); }
    REP(4)  { phase_a2(p, bid, nb);            xcd_barrier(xb); }
    REP(4)  { phase_outproj(p, bid, nb, smem); xcd_barrier(xb); }
    phase_ln1(p, bid, nb);           xcd_barrier(xb);
    REP(8)  { phase_q(p, bid, nb, smem);       xcd_barrier(xb); }
    REP(16) { phase_topk(p, bid, nb, smem);    xcd_barrier(xb); }
    REP(32) { phase_combine(p, bid, nb);       xcd_barrier(xb); }
    phase_gather(p, bid, nb);
}

extern "C" void kernel_launch(void* const* d_in, const int* in_sizes, int n_in, void* d_out, int out_size, void* d_ws, size_t ws_size, hipStream_t stream) {
    if (n_in != 27 || ws_size < WS_END) { fprintf(stderr, "kernel_launch: unexpected n_in %d or ws_size %zu (< %zu)\n", n_in, ws_size, (size_t)WS_END); return; }
    static int grid_blocks = 0;
    if (!grid_blocks) {
        int dev = 0, cus = 0, per_cu = 0;
        (void)hipGetDevice(&dev);
        (void)hipDeviceGetAttribute(&cus, hipDeviceAttributeMultiprocessorCount, dev);
        (void)hipOccupancyMaxActiveBlocksPerMultiprocessor(&per_cu, k_mega, NTH, 0);
        if (cus <= 0) cus = 256;
        if (per_cu < 1) { fprintf(stderr, "kernel_launch: occupancy query says %d blocks/CU\n", per_cu); per_cu = 1; }
        grid_blocks = cus;
    }
    Params p{};
    const float** f = (const float**)&p;
    for (int i = 0; i < 27; ++i) f[i] = (const float*)d_in[i];
    p.out = (float*)d_out; p.ws = (char*)d_ws;
    hipError_t e = hipMemsetAsync((char*)d_ws + OFF_BAR, 0, (size_t)3456 * 4, stream);
    if (e == hipSuccess) { hipLaunchKernelGGL(k_mega, dim3(grid_blocks), dim3(NTH), 0, stream, p); e = hipPeekAtLastError(); }
    if (e != hipSuccess) fprintf(stderr, "launch failed: %s (grid %d)\n", hipGetErrorString(e), grid_blocks);
}
```

```cpp
#include <hip/hip_runtime.h>
#include <hip/hip_cooperative_groups.h>
#include <stdint.h>
#include <stdio.h>

namespace cg = cooperative_groups;
#define DI __device__ __forceinline__
typedef unsigned short bf16_t;
typedef short bf16x8 __attribute__((ext_vector_type(8)));
typedef float f32x16 __attribute__((ext_vector_type(16)));
typedef unsigned u32x4 __attribute__((ext_vector_type(4)));
typedef float f32x4 __attribute__((ext_vector_type(4)));
typedef float f32x2 __attribute__((ext_vector_type(2)));

constexpr int NTH = 512;
constexpr int NB = 16, SEQ = 2048, DM = 1024, NTOK = NB * SEQ;
constexpr int DHG = 512, HGH = 4, HDK = 128;
constexpr int DSS = 512, SSG = 32, SSC = 16, SSP = 64;
constexpr int INC = 2560;
constexpr int PHEADS = 8, NKEYS = 128, TOPK = 16, NEXP = 16384;
constexpr float DEEP_ALPHA = 1.189207115002721f;
constexpr float LN_EPS = 1e-5f, RMS_EPS = 1e-6f;
constexpr int SMEM_BYTES = 128 * 1024 + 256;

constexpr size_t al256(size_t x) { return (x + 255) & ~(size_t)255; }
constexpr size_t OFF_MOD = 0;
constexpr size_t OFF_LB = al256(OFF_MOD + (size_t)NB * 6144 * 4);
constexpr size_t OFF_LAM = al256(OFF_LB + 512 * 4);
constexpr size_t OFF_BB = al256(OFF_LAM + 32 * 64 * 2 * 4);
constexpr size_t OFF_WIN = al256(OFF_BB + 32 * 64 * 16 * 2 * 4);
constexpr size_t OFF_GLU = al256(OFF_WIN + (size_t)INC * DM * 2);
constexpr size_t OFF_WOUT = al256(OFF_GLU + (size_t)512 * 512 * 2);
constexpr size_t OFF_WQ = al256(OFF_WOUT + (size_t)DM * DM * 2);
constexpr size_t OFF_SUBK = al256(OFF_WQ + (size_t)2048 * DM * 2);
constexpr size_t OFF_SU = al256(OFF_SUBK + (size_t)16 * 128 * 128 * 2);
constexpr size_t OFF_SV = al256(OFF_SU + (size_t)NEXP * 4);
constexpr size_t OFF_UT = al256(OFF_SV + (size_t)NEXP * 4);
constexpr size_t OFF_VT = al256(OFF_UT + (size_t)NEXP * DM * 2);
constexpr size_t OFF_H = al256(OFF_VT + (size_t)NEXP * DM * 2);
constexpr size_t OFF_PROJ = al256(OFF_H + (size_t)NTOK * DM * 2);
constexpr size_t OFF_ORAW = al256(OFF_PROJ + (size_t)NTOK * INC * 2);
constexpr size_t OFF_YSSM = al256(OFF_ORAW + (size_t)NTOK * DHG * 4);
constexpr size_t OFF_A2 = al256(OFF_YSSM + (size_t)NTOK * DSS * 2);
constexpr size_t OFF_HG = al256(OFF_A2 + (size_t)NTOK * DM * 2);
constexpr size_t OFF_S5K = al256(OFF_HG + (size_t)4096 * 128 * 4);
constexpr size_t OFF_S5N = al256(OFF_S5K + (size_t)32 * 4096 * 2);
constexpr size_t OFF_S5M = al256(OFF_S5N + (size_t)32 * 128 * 256 * 2);
constexpr size_t OFF_S5L = al256(OFF_S5M + (size_t)32 * 256 * 128 * 2);
constexpr size_t OFF_BAR = al256(OFF_S5L + (size_t)32 * 64 * 2 * 4);
constexpr size_t WS_END = al256(OFF_BAR + (size_t)3456 * 4);
constexpr size_t OFF_HQ = OFF_H, OFF_HK = OFF_H + (size_t)NTOK * DHG * 2, OFF_HKT = OFF_A2, OFF_HVT = OFF_A2 + (size_t)NTOK * DHG * 2;
constexpr size_t OFF_TOPL = OFF_ORAW;
constexpr size_t OFF_EXPS = OFF_ORAW + (size_t)NTOK * 16 * 16 * 4;

struct Params {
    const float *x, *c, *ada_w, *ada_b, *w_in, *hg_lb, *hg_nw, *a_re, *a_im, *log_dt, *b_re, *b_im, *c_re, *c_im, *dsk,
        *glu_w, *glu_b, *ssm_nw, *w_out, *ln1w, *ln1b, *w_q, *subk, *pu, *pv, *ln2w, *ln2b;
    float* out;
    char* ws;
};

DI int my_tid() { int t = (int)__builtin_amdgcn_workitem_id_x(); asm volatile("" : "+v"(t)); return t; }
DI bf16_t f2bf(float x) { unsigned u = __float_as_uint(x); u += 0x7fffu + ((u >> 16) & 1u); return (bf16_t)(u >> 16); }
DI float bf2f(bf16_t b) { return __uint_as_float(((unsigned)b) << 16); }
DI float bflo(unsigned w) { return __uint_as_float(w << 16); }
DI float bfhi(unsigned w) { return __uint_as_float(w & 0xffff0000u); }
typedef __bf16 hwbf16x2 __attribute__((ext_vector_type(2)));
DI unsigned pack2(float a, float b) { const f32x2 v = {a, b}; return __builtin_bit_cast(unsigned, __builtin_convertvector(v, hwbf16x2)); }
DI bf16x8 pack8(const f32x16& x, const int base) {
    u32x4 o; o.x = pack2(x[base], x[base + 1]); o.y = pack2(x[base + 2], x[base + 3]); o.z = pack2(x[base + 4], x[base + 5]); o.w = pack2(x[base + 6], x[base + 7]);
    return __builtin_bit_cast(bf16x8, o);
}
DI float sigmoidf_(float x) { return 1.0f / (1.0f + __expf(-x)); }
DI float siluf_(float x) { return x * sigmoidf_(x); }
DI float geluf_(float x) { return 0.5f * x * (1.0f + erff(x * 0.70710678118654752f)); }
DI float gelu_as(float v) {
    const float t = __builtin_amdgcn_rcpf(fabsf(v) * 0.2316418882f + 1.0f);
    float q = t * 0.5307027145f + (-0.7265760135f); q = q * t + 0.7107068705f; q = q * t + (-0.142248368f); q = q * t + 0.127414796f; q = q * t;
    const float m = v * (q * __builtin_amdgcn_exp2f(v * v * (-0.72134752044f)));
    return v < 0.f ? m : v - m;
}

template <int MT, int NT_, int WM, int WN, class Epi>
DI void gemm_block(const bf16_t* __restrict__ A, int lda, const bf16_t* __restrict__ Bt, int ldb, int K, char* smem, Epi epi) {
    constexpr int BM = WM * MT * 32, BN = WN * NT_ * 32, LS = 72;
    static_assert(WM * WN == 8, "8 waves");
    bf16_t* As = (bf16_t*)smem;
    bf16_t* Bs = As + BM * LS;
    const int tid = my_tid(), lane = tid & 63, wid = tid >> 6, r = lane & 31, h = lane >> 5;
    const int wm = wid / WN, wn = wid % WN;
    constexpr int PA = BM * 8 / NTH, PB = BN * 8 / NTH;
    u32x4 ra[PA], rb[PB];
    f32x16 acc[MT][NT_];
#pragma unroll
    for (int mi = 0; mi < MT; ++mi)
#pragma unroll
        for (int ni = 0; ni < NT_; ++ni)
#pragma unroll
            for (int i = 0; i < 16; ++i) acc[mi][ni][i] = 0.f;
#define GEMM_GLOAD(kt_) { \
    _Pragma("unroll") for (int q = 0; q < PA; ++q) { const int idx = tid + q * NTH, row = idx >> 3, ch = idx & 7; ra[q] = *(const u32x4*)(A + (size_t)row * lda + (kt_) * 64 + ch * 8); } \
    _Pragma("unroll") for (int q = 0; q < PB; ++q) { const int idx = tid + q * NTH, row = idx >> 3, ch = idx & 7; rb[q] = *(const u32x4*)(Bt + (size_t)row * ldb + (kt_) * 64 + ch * 8); } }
#define GEMM_LSTORE() { \
    _Pragma("unroll") for (int q = 0; q < PA; ++q) { const int idx = tid + q * NTH, row = idx >> 3, ch = idx & 7; *(u32x4*)(As + row * LS + ch * 8) = ra[q]; } \
    _Pragma("unroll") for (int q = 0; q < PB; ++q) { const int idx = tid + q * NTH, row = idx >> 3, ch = idx & 7; *(u32x4*)(Bs + row * LS + ch * 8) = rb[q]; } }
    GEMM_GLOAD(0); GEMM_LSTORE(); __syncthreads();
    const int nk = K / 64;
    for (int kt = 0; kt < nk; ++kt) {
        if (kt + 1 < nk) GEMM_GLOAD(kt + 1);
#pragma unroll
        for (int ks = 0; ks < 4; ++ks) {
            bf16x8 a[MT], b[NT_];
#pragma unroll
            for (int mi = 0; mi < MT; ++mi) a[mi] = *(const bf16x8*)(As + (wm * MT * 32 + mi * 32 + r) * LS + ks * 16 + h * 8);
#pragma unroll
            for (int ni = 0; ni < NT_; ++ni) b[ni] = *(const bf16x8*)(Bs + (wn * NT_ * 32 + ni * 32 + r) * LS + ks * 16 + h * 8);
#pragma unroll
            for (int mi = 0; mi < MT; ++mi)
#pragma unroll
                for (int ni = 0; ni < NT_; ++ni) acc[mi][ni] = __builtin_amdgcn_mfma_f32_32x32x16_bf16(a[mi], b[ni], acc[mi][ni], 0, 0, 0);
        }
        __syncthreads();
        if (kt + 1 < nk) { GEMM_LSTORE(); __syncthreads(); }
    }
#pragma unroll
    for (int mi = 0; mi < MT; ++mi)
#pragma unroll
        for (int ni = 0; ni < NT_; ++ni)
#pragma unroll
            for (int i = 0; i < 16; ++i) epi(wm * MT * 32 + mi * 32 + (i & 3) + 8 * (i >> 2) + 4 * h, wn * NT_ * 32 + ni * 32 + r, acc[mi][ni][i]);
}

namespace pg8 {
#define PG8_LAS __attribute__((address_space(3)))
typedef unsigned short bf16_t;
typedef short bf16x8 __attribute__((ext_vector_type(8)));
typedef float f32x4 __attribute__((ext_vector_type(4)));
typedef unsigned u32x4 __attribute__((ext_vector_type(4)));
constexpr int BM = 256, BK = 64, HALF = 128, HTB = HALF * BK * 2  , STAGE_BYTES = 8 * HTB, NXCD = 8, WGM = 8;

__host__ __device__ __forceinline__ int lds_byte(int r, int c) { const int st = (r >> 4) * 2 + (c >> 5), rr = r & 15, cc = c & 31, ob = rr * 64 + cc * 2; return st * 1024 + (ob ^ (((ob >> 9) & 1) << 5)); }
__host__ __device__ __forceinline__ void stage_rc(int b, int& R, int& C) { const int st = b / 1024, sb = b % 1024, swz = sb ^ (((sb >> 9) & 1) << 5); R = (st >> 1) * 16 + swz / 64; C = (st & 1) * 32 + (swz % 64) / 2; }
__host__ __device__ __forceinline__ int perm32(int rho) { const int n = rho >> 4, i = rho & 15; return 8 * (i >> 2) + 4 * n + (i & 3); }

struct Unit { int pm, pn; };
struct Gemm { const bf16_t* A; const bf16_t* Bt; int M, N, K; };

struct StaticOrder {
    int nM, nN, nwg, G, c;
    __host__ __device__ void init(int M, int N, int G_, int c_) { nM = M / BM; nN = N / BM; nwg = nM * nN; G = G_; c = c_; }
    __host__ __device__ bool next(int i, Unit& u) const {
        const long L = (long)i * G + c; if (L >= nwg) return false;
        int wgid = (int)L; { const int q = nwg / NXCD, r = nwg % NXCD, xcd = wgid % NXCD, off = wgid / NXCD; wgid = (xcd < r ? xcd * (q + 1) : r * (q + 1) + (xcd - r) * q) + off; }
        const int nig = WGM * nN, gid = wgid / nig, fm = gid * WGM, gsz = (nM - fm) < WGM ? (nM - fm) : WGM;
        u.pm = fm + ((wgid % nig) % gsz); u.pn = (wgid % nig) / gsz; return true;
    }
    __device__ __forceinline__ void a_ready(const Unit&) const {}
    __device__ __forceinline__ void done(const Unit&) const {}
};
template <class Epi, class Sched, bool STAMP = false>
__device__ __forceinline__ void gemm_phase(PG8_LAS unsigned char* lds, const Gemm g, const Sched& S, const Epi& E, unsigned long long* stamps) {
    const int tid = (int)__builtin_amdgcn_workitem_id_x(), wid = __builtin_amdgcn_readfirstlane(tid >> 6), lane = tid & 63, wr = wid >> 2, wc = wid & 3, fr = lane & 15, fq = lane >> 4;
    const int K = g.K, nt = K / BK;
    int ts_lo = 0, ts_hi = 0, nts = 0; const unsigned long long rt_entry = STAMP ? (unsigned long long)wall_clock64() : 0ull;
#define PG8_STAMP() do { if (STAMP && wid == 0 && nts < 64) { const unsigned long long _c = (unsigned long long)clock64(); \
        ts_lo = (lane == nts) ? (int)(unsigned)_c : ts_lo; ts_hi = (lane == nts) ? (int)(unsigned)(_c >> 32) : ts_hi; ++nts; } } while (0)
    PG8_STAMP();
    unsigned voffA[2], voffB[2];
#pragma unroll
    for (int i = 0; i < 2; ++i) { int R, C; stage_rc(tid * 16 + i * 8192, R, C); const int Rb = Epi::PERM ? ((R & ~31) + perm32(R & 31)) : R;
        voffA[i] = (unsigned)(R * K + C) * 2u; voffB[i] = (unsigned)(Rb * K + C) * 2u; }
    const size_t kstep = (size_t)(BK * 2);
    const size_t hstep = (size_t)HALF * K * 2;
    const size_t tstep = 2 * hstep;
    const unsigned ldsw = (unsigned)wid * 1024u;
    const int aoff = lds_byte(wr * 64 + fr, fq * 8), boff = lds_byte(wc * 32 + fr, fq * 8);
#define PG8_SA(b, h) (((b) * 2 + (h)) * HTB)
#define PG8_SB(b, h) ((4 + (b) * 2 + (h)) * HTB)
#define PG8_STAGE(bufoff, gbase, voff) do { _Pragma("unroll") for (int _i = 0; _i < 2; ++_i) \
        __builtin_amdgcn_global_load_lds((const unsigned*)((const char*)(gbase) + (voff)[_i]), (PG8_LAS unsigned*)(lds + (bufoff) + ldsw + _i * 8192), 16, 0, 0); } while (0)
#define PG8_LDA(dst, b, h) do { _Pragma("unroll") for (int m = 0; m < 4; ++m) _Pragma("unroll") for (int k = 0; k < 2; ++k) dst[m][k] = *(const PG8_LAS bf16x8*)(lds + PG8_SA(b, h) + aoff + m * 2048 + k * 1024); } while (0)
#define PG8_LDB(dst, b, h) do { _Pragma("unroll") for (int n = 0; n < 2; ++n) _Pragma("unroll") for (int k = 0; k < 2; ++k) dst[n][k] = *(const PG8_LAS bf16x8*)(lds + PG8_SB(b, h) + boff + n * 2048 + k * 1024); } while (0)
#define PG8_MMA(ai, bj, At, Bt) do { __builtin_amdgcn_s_setprio(1); _Pragma("unroll") for (int m = 0; m < 4; ++m) _Pragma("unroll") for (int n = 0; n < 2; ++n) _Pragma("unroll") for (int k = 0; k < 2; ++k) \
        acc[ai][bj][m][n] = __builtin_amdgcn_mfma_f32_16x16x32_bf16(Bt[n][k], At[m][k], acc[ai][bj][m][n], 0, 0, 0); __builtin_amdgcn_s_setprio(0); } while (0)
#define PG8_WAIT_V(n) asm volatile("s_waitcnt vmcnt(" #n ")" ::: "memory")
#define PG8_WAIT_L(n) asm volatile("s_waitcnt lgkmcnt(" #n ")" ::: "memory")
#define PG8_BAR __builtin_amdgcn_s_barrier()
#define PG8_SCHED __builtin_amdgcn_sched_barrier(0)
    Unit cur, nxt; int ui = 0;
    if (!S.next(0, cur)) return;
    f32x4 acc[2][2][4][2];
#pragma unroll
    for (int a = 0; a < 2; ++a)
#pragma unroll
        for (int b = 0; b < 2; ++b)
#pragma unroll
            for (int m = 0; m < 4; ++m)
#pragma unroll
                for (int n = 0; n < 2; ++n) acc[a][b][m][n] = (f32x4){0.f, 0.f, 0.f, 0.f};
    bf16x8 At[4][2], B0[2][2], B1[2][2];
    const char* cA = (const char*)g.A + (size_t)cur.pm * tstep; const char* cB = (const char*)g.Bt + (size_t)cur.pn * tstep;
    S.a_ready(cur);
    PG8_STAGE(PG8_SB(0, 0), cB, voffB); PG8_STAGE(PG8_SA(0, 0), cA, voffA); PG8_STAGE(PG8_SB(0, 1), cB + hstep, voffB); PG8_STAGE(PG8_SA(0, 1), cA + hstep, voffA);
    if (wr == 1) PG8_BAR;
    PG8_WAIT_V(4); PG8_BAR;
    PG8_STAGE(PG8_SB(1, 0), cB + kstep, voffB); PG8_STAGE(PG8_SA(1, 0), cA + kstep, voffA); PG8_STAGE(PG8_SB(1, 1), cB + hstep + kstep, voffB);
    PG8_WAIT_V(6); PG8_BAR;
    PG8_STAMP();
    for (;;) {
        const bool has_next = S.next(ui + 1, nxt);
        const char* nA = has_next ? (const char*)g.A + (size_t)nxt.pm * tstep : cA; const char* nB = has_next ? (const char*)g.Bt + (size_t)nxt.pn * tstep : cB;
        for (int t = 0; t < nt; t += 2) {
            const bool last = (t == nt - 2);
            const char* a1 = cA + (size_t)(t + 1) * kstep;
            const char* a2 = last ? nA : cA + (size_t)(t + 2) * kstep; const char* b2 = last ? nB : cB + (size_t)(t + 2) * kstep;
            const char* a3 = a2 + kstep; const char* b3 = b2 + kstep;
            if (last && has_next) S.a_ready(nxt);
            PG8_LDB(B0, 0, 0); PG8_SCHED; PG8_LDA(At, 0, 0); PG8_STAGE(PG8_SA(1, 1), a1 + hstep, voffA);
            PG8_WAIT_L(8); PG8_BAR; PG8_WAIT_L(0); PG8_MMA(0, 0, At, B0); PG8_BAR; PG8_SCHED;
            PG8_LDB(B1, 0, 1); PG8_STAGE(PG8_SB(0, 0), b2, voffB);
            PG8_BAR; PG8_WAIT_L(0); PG8_MMA(0, 1, At, B1); PG8_BAR;
            PG8_LDA(At, 0, 1); PG8_STAGE(PG8_SA(0, 0), a2, voffA);
            PG8_BAR; PG8_WAIT_L(0); PG8_MMA(1, 0, At, B0); PG8_BAR; PG8_SCHED;
            PG8_STAGE(PG8_SB(0, 1), b2 + hstep, voffB);
            PG8_WAIT_V(6); PG8_BAR; PG8_MMA(1, 1, At, B1); PG8_BAR;
            PG8_LDB(B0, 1, 0); PG8_SCHED; PG8_LDA(At, 1, 0); PG8_STAGE(PG8_SA(0, 1), a2 + hstep, voffA);
            PG8_WAIT_L(8); PG8_BAR; PG8_WAIT_L(0); PG8_MMA(0, 0, At, B0); PG8_BAR; PG8_SCHED;
            PG8_LDB(B1, 1, 1); PG8_STAGE(PG8_SB(1, 0), b3, voffB);
            PG8_BAR; PG8_WAIT_L(0); PG8_MMA(0, 1, At, B1); PG8_BAR;
            PG8_LDA(At, 1, 1); PG8_STAGE(PG8_SA(1, 0), a3, voffA);
            PG8_BAR; PG8_WAIT_L(0); PG8_MMA(1, 0, At, B0); PG8_BAR; PG8_SCHED;
            PG8_STAGE(PG8_SB(1, 1), b3 + hstep, voffB);
            PG8_WAIT_V(6); PG8_BAR; PG8_MMA(1, 1, At, B1); PG8_BAR;
        }
        PG8_STAMP();
        if constexpr (!Epi::AFTER_DRAIN) { E(acc, cur, wr, wc, fr, fq); S.done(cur); }
        PG8_STAMP();
        if (!has_next) break;
#pragma unroll
        for (int a = 0; a < 2; ++a)
#pragma unroll
            for (int b = 0; b < 2; ++b)
#pragma unroll
                for (int m = 0; m < 4; ++m)
#pragma unroll
                    for (int n = 0; n < 2; ++n) acc[a][b][m][n] = (f32x4){0.f, 0.f, 0.f, 0.f};
        cur = nxt; cA = nA; cB = nB; ++ui;
    }
    PG8_WAIT_V(0);
    if (wr == 0) PG8_BAR;
    PG8_BAR;
    if constexpr (Epi::AFTER_DRAIN) { E.fused(acc, cur, wr, wc, fr, fq, lds, wid, lane); S.done(cur); }
    PG8_STAMP();
    if (STAMP && wid == 0) { stamps[lane] = lane < nts ? (((unsigned long long)(unsigned)ts_hi << 32) | (unsigned)ts_lo) : 0ull;
        if (lane == 62) stamps[62] = rt_entry; if (lane == 63) stamps[63] = (unsigned long long)wall_clock64(); }
#undef PG8_STAMP
#undef PG8_SA
#undef PG8_SB
#undef PG8_STAGE
#undef PG8_LDA
#undef PG8_LDB
#undef PG8_MMA
#undef PG8_WAIT_V
#undef PG8_WAIT_L
#undef PG8_BAR
#undef PG8_SCHED
}

__device__ __forceinline__ unsigned pk_bf16(float lo, float hi) { typedef float v2f __attribute__((ext_vector_type(2))); typedef __bf16 v2b __attribute__((ext_vector_type(2))); const v2f v = {lo, hi}; return __builtin_bit_cast(unsigned, __builtin_convertvector(v, v2b)); }
__device__ __forceinline__ float silu1(float x) { return x * __builtin_amdgcn_rcpf(1.0f + __expf(-x)); }
struct EpiBf16Act {
    static constexpr bool PERM = true, AFTER_DRAIN = false;
    bf16_t* O; int ldc; unsigned silu_mask;
    __device__ __forceinline__ void operator()(const f32x4 (&acc)[2][2][4][2], const Unit& u, int wr, int wc, int fr, int fq) const {
        const int row0 = u.pm * BM + wr * 64 + fr, col0 = u.pn * BM + wc * 32 + 8 * fq;
        const bool act = (silu_mask >> u.pn) & 1u;
#pragma unroll
        for (int ai = 0; ai < 2; ++ai)
#pragma unroll
            for (int m = 0; m < 4; ++m) { bf16_t* rowp = O + (size_t)(row0 + ai * HALF + m * 16) * ldc + col0;
#pragma unroll
                for (int bj = 0; bj < 2; ++bj) { f32x4 v0 = acc[ai][bj][m][0], v1 = acc[ai][bj][m][1];
                    if (act) {
#pragma unroll
                        for (int j = 0; j < 4; ++j) { v0[j] = silu1(v0[j]); v1[j] = silu1(v1[j]); } }
                    u32x4 w; w.x = pk_bf16(v0[0], v0[1]); w.y = pk_bf16(v0[2], v0[3]); w.z = pk_bf16(v1[0], v1[1]); w.w = pk_bf16(v1[2], v1[3]);
                    *(u32x4*)(rowp + bj * HALF) = w; } }
    }
};
struct EpiResid {
    static constexpr bool PERM = false, AFTER_DRAIN = false;
    float* C; const float* X; const float* mod_g;
    float alpha;
    __device__ __forceinline__ void operator()(const f32x4 (&acc)[2][2][4][2], const Unit& u, int wr, int wc, int fr, int fq) const {
        const int row0 = u.pm * BM + wr * 64 + fr, col0 = u.pn * BM + wc * 32 + 4 * fq;
        const float* gb = mod_g + (size_t)((u.pm * BM) / 2048) * 6144 + col0;
        f32x4 gv[2][2];
#pragma unroll
        for (int bj = 0; bj < 2; ++bj)
#pragma unroll
            for (int n = 0; n < 2; ++n) gv[bj][n] = *(const f32x4*)(gb + bj * HALF + n * 16) + 1.0f;
#pragma unroll
        for (int ai = 0; ai < 2; ++ai)
#pragma unroll
            for (int m = 0; m < 4; ++m) { const size_t ro = (size_t)(row0 + ai * HALF + m * 16) * 1024 + col0;
#pragma unroll
                for (int bj = 0; bj < 2; ++bj)
#pragma unroll
                    for (int n = 0; n < 2; ++n) { const f32x4 xv = *(const f32x4*)(X + ro + bj * HALF + n * 16); *(f32x4*)(C + ro + bj * HALF + n * 16) = alpha * xv + gv[bj][n] * acc[ai][bj][m][n]; } }
    }
};
struct EpiGlu {
    static constexpr bool PERM = false, AFTER_DRAIN = false;
    float* C; const bf16_t* Y; const float* bias;
    __device__ __forceinline__ void operator()(const f32x4 (&acc)[2][2][4][2], const Unit& u, int wr, int wc, int fr, int fq) const {
        const int row0 = u.pm * BM + wr * 64 + fr, col0 = u.pn * BM + wc * 32 + 4 * fq;
        f32x4 bv[2][2];
#pragma unroll
        for (int bj = 0; bj < 2; ++bj)
#pragma unroll
            for (int n = 0; n < 2; ++n) bv[bj][n] = *(const f32x4*)(bias + col0 + bj * HALF + n * 16);
#pragma unroll
        for (int ai = 0; ai < 2; ++ai)
#pragma unroll
            for (int m = 0; m < 4; ++m) { const size_t ro = (size_t)(row0 + ai * HALF + m * 16) * 512 + col0;
#pragma unroll
                for (int bj = 0; bj < 2; ++bj)
#pragma unroll
                    for (int n = 0; n < 2; ++n) {
                        const uint2 yw = *(const uint2*)(Y + ro + bj * HALF + n * 16);
                        const f32x4 z = acc[ai][bj][m][n] + bv[bj][n];
                        f32x4 o;
                        o[0] = __uint_as_float(yw.x << 16) * __builtin_amdgcn_rcpf(1.0f + __expf(-z[0])); o[1] = __uint_as_float(yw.x & 0xffff0000u) * __builtin_amdgcn_rcpf(1.0f + __expf(-z[1]));
                        o[2] = __uint_as_float(yw.y << 16) * __builtin_amdgcn_rcpf(1.0f + __expf(-z[2])); o[3] = __uint_as_float(yw.y & 0xffff0000u) * __builtin_amdgcn_rcpf(1.0f + __expf(-z[3]));
                        *(f32x4*)(C + ro + bj * HALF + n * 16) = o; } }
    }
};
}

DI void prep_mod_item(const Params& p, int item, char* smem) {
    float* cond = (float*)smem;
    const int tid = my_tid();
    for (int i = tid; i < NB * DM; i += NTH) cond[i] = siluf_(p.c[i]);
    __syncthreads();
    const int b = tid >> 5, col = item * 32 + (tid & 31);
    float acc = 0.f;
    const float* w = p.ada_w + col;
    const float* cb = cond + b * DM;
#pragma unroll 8
    for (int k = 0; k < DM; ++k) acc += cb[k] * w[(size_t)k * 6144];
    ((float*)(p.ws + OFF_MOD))[b * 6144 + col] = acc + p.ada_b[col];
    __syncthreads();
}
DI void prep_s5_gemm_item(const Params& p, int g, char* smem) {
    f32x2* pw = (f32x2*)smem;
    f32x2* bbL = pw + 17 * 64;
    f32x2* cL = bbL + 64 * 16;
    const int tid = my_tid();
    const float dt = expf(p.log_dt[g]);
#pragma unroll 1
    for (int idx = tid; idx < 17 * 64; idx += NTH) {
        const int j = idx >> 6, pp = idx & 63;
        const float ar = p.a_re[g * 64 + pp], ai = p.a_im[g * 64 + pp];
        const float mag = expf(ar * dt * (float)j), ang = ai * dt * (float)j;
        pw[idx] = (f32x2){mag * cosf(ang), mag * sinf(ang)};
    }
    for (int idx = tid; idx < 16 * 64; idx += NTH) { const int i = idx >> 6, pp = idx & 63; cL[idx] = (f32x2){p.c_re[(g * 16 + i) * 64 + pp], p.c_im[(g * 16 + i) * 64 + pp]}; }
    __syncthreads();
    for (int idx = tid; idx < 64 * 16; idx += NTH) {
        const int pp = idx >> 4, i = idx & 15;
        const float ar = p.a_re[g * 64 + pp], ai = p.a_im[g * 64 + pp];
        const f32x2 lam = pw[64 + pp];
        const float den = ar * ar + ai * ai, nr = lam.x - 1.0f, ni = lam.y;
        const float zr = (nr * ar + ni * ai) / den, zi = (ni * ar - nr * ai) / den;
        const float br = p.b_re[(g * 64 + pp) * 16 + i], bi = p.b_im[(g * 64 + pp) * 16 + i];
        bbL[idx] = (f32x2){zr * br - zi * bi, zr * bi + zi * br};
    }
    __syncthreads();
    bf16_t* NBg = (bf16_t*)(p.ws + OFF_S5N) + (size_t)g * 128 * 256;
#pragma unroll 1
    for (int ch = tid; ch < 128 * 256 / 8; ch += NTH) {
        const int pq = ch >> 5, t = (ch >> 1) & 15, i0 = (ch & 1) * 8, pp = pq & 63;
        const f32x2 w = pw[(15 - t) * 64 + pp];
        float v[8];
#pragma unroll
        for (int e = 0; e < 8; ++e) { const f32x2 bb = bbL[pp * 16 + i0 + e]; v[e] = pq < 64 ? (w.x * bb.x - w.y * bb.y) : (w.x * bb.y + w.y * bb.x); }
        u32x4 o; o.x = pack2(v[0], v[1]); o.y = pack2(v[2], v[3]); o.z = pack2(v[4], v[5]); o.w = pack2(v[6], v[7]);
        *(u32x4*)(NBg + (size_t)pq * 256 + t * 16 + i0) = o;
    }
    bf16_t* MBg = (bf16_t*)(p.ws + OFF_S5M) + (size_t)g * 256 * 128;
#pragma unroll 1
    for (int ch = tid; ch < 256 * 128 / 8; ch += NTH) {
        const int ti = ch >> 4, p0 = (ch & 15) * 8, tq = ti >> 4, iq = ti & 15;
        float v[8];
#pragma unroll
        for (int e = 0; e < 8; ++e) {
            const int pq = p0 + e, pp = pq & 63;
            const f32x2 c = cL[iq * 64 + pp], w = pw[(tq + 1) * 64 + pp];
            v[e] = pq < 64 ? (c.x * w.x - c.y * w.y) : -(c.x * w.y + c.y * w.x);
        }
        u32x4 o; o.x = pack2(v[0], v[1]); o.y = pack2(v[2], v[3]); o.z = pack2(v[4], v[5]); o.w = pack2(v[6], v[7]);
        *(u32x4*)(MBg + (size_t)ti * 128 + p0) = o;
    }
    bf16_t* KTg = (bf16_t*)(p.ws + OFF_S5K) + (size_t)g * 4096;
#pragma unroll 1
    for (int idx = tid; idx < 4096; idx += NTH) {
        const int lag = idx >> 8, iq = (idx >> 4) & 15, i = idx & 15;
        float acc = (lag == 0 && iq == i) ? p.dsk[g * 16 + iq] : 0.f;
#pragma unroll 4
        for (int pp = 0; pp < 64; ++pp) {
            const f32x2 c = cL[iq * 64 + pp], w = pw[lag * 64 + pp], bb = bbL[pp * 16 + i];
            const float mr = c.x * w.x - c.y * w.y, mi_ = c.x * w.y + c.y * w.x;
            acc += mr * bb.x - mi_ * bb.y;
        }
        KTg[idx] = f2bf(acc);
    }
    if (tid < 64) { float* L = (float*)(p.ws + OFF_S5L) + (g * 64 + tid) * 2; const f32x2 w = pw[16 * 64 + tid]; L[0] = w.x; L[1] = w.y; }
    __syncthreads();
}
DI void prep_s5_item(const Params& p, int g) {
    const int tid = my_tid();
    if (tid < SSP) {
        const int pi = g * SSP + tid;
        const float dt = expf(p.log_dt[g]);
        const float ar = p.a_re[pi], ai = p.a_im[pi];
        const float mag = expf(ar * dt);
        const float lr = mag * cosf(ai * dt), li = mag * sinf(ai * dt);
        const float den = ar * ar + ai * ai, nr = lr - 1.0f, ni = li;
        const float zr = (nr * ar + ni * ai) / den, zi = (ni * ar - nr * ai) / den;
        float* lam = (float*)(p.ws + OFF_LAM) + pi * 2;
        lam[0] = lr; lam[1] = li;
        float* bb = (float*)(p.ws + OFF_BB) + (size_t)pi * 32;
        for (int i = 0; i < SSC; ++i) {
            const float br = p.b_re[pi * SSC + i], bi = p.b_im[pi * SSC + i];
            bb[i * 2] = zr * br - zi * bi; bb[i * 2 + 1] = zr * bi + zi * br;
        }
    }
}
DI void prep_transpose_tile(const float* __restrict__ W, bf16_t* __restrict__ Wt, int K, int N, int kt, int nt, char* smem) {
    float* tile = (float*)smem;
    const int tid = my_tid();
#pragma unroll
    for (int q = 0; q < 2; ++q) {
        const int kk = (tid >> 4) + q * 32, c4 = (tid & 15) * 4;
        const float4 v = *(const float4*)(W + (size_t)(kt * 64 + kk) * N + nt * 64 + c4);
        tile[kk * 65 + c4] = v.x; tile[kk * 65 + c4 + 1] = v.y; tile[kk * 65 + c4 + 2] = v.z; tile[kk * 65 + c4 + 3] = v.w;
    }
    __syncthreads();
    const int n = tid >> 3, kc = tid & 7;
    uint4 o;
    o.x = pack2(tile[(kc * 8 + 0) * 65 + n], tile[(kc * 8 + 1) * 65 + n]);
    o.y = pack2(tile[(kc * 8 + 2) * 65 + n], tile[(kc * 8 + 3) * 65 + n]);
    o.z = pack2(tile[(kc * 8 + 4) * 65 + n], tile[(kc * 8 + 5) * 65 + n]);
    o.w = pack2(tile[(kc * 8 + 6) * 65 + n], tile[(kc * 8 + 7) * 65 + n]);
    *(uint4*)(Wt + (size_t)(nt * 64 + n) * K + kt * 64 + kc * 8) = o;
    __syncthreads();
}
DI void cvt_bf16_stream(const float* __restrict__ src, bf16_t* __restrict__ dst, size_t n8, int bid, int nb) {
    for (size_t i = (size_t)bid * NTH + my_tid(); i < n8; i += (size_t)nb * NTH) {
        const float4 a = *(const float4*)(src + i * 8), b = *(const float4*)(src + i * 8 + 4);
        uint4 o; o.x = pack2(a.x, a.y); o.y = pack2(a.z, a.w); o.z = pack2(b.x, b.y); o.w = pack2(b.z, b.w);
        *(uint4*)(dst + i * 8) = o;
    }
}
DI void cvt_fp8_rows(const float* __restrict__ src, unsigned char* __restrict__ dst, float* __restrict__ inv, int bid, int nb) {
    const int lane = my_tid() & 63, wid = my_tid() >> 6;
    for (int row = bid * 8 + wid; row < NEXP; row += nb * 8) {
        const float* sp = src + (size_t)row * DM + lane * 16;
        const f32x4 a = *(const f32x4*)sp, b = *(const f32x4*)(sp + 4), c = *(const f32x4*)(sp + 8), d = *(const f32x4*)(sp + 12);
        float m = fmaxf(fmaxf(fmaxf(fabsf(a.x), fabsf(a.y)), fmaxf(fabsf(a.z), fabsf(a.w))), fmaxf(fmaxf(fabsf(b.x), fabsf(b.y)), fmaxf(fabsf(b.z), fabsf(b.w))));
        m = fmaxf(m, fmaxf(fmaxf(fmaxf(fabsf(c.x), fabsf(c.y)), fmaxf(fabsf(c.z), fabsf(c.w))), fmaxf(fmaxf(fabsf(d.x), fabsf(d.y)), fmaxf(fabsf(d.z), fabsf(d.w)))));
#pragma unroll
        for (int s = 1; s < 64; s <<= 1) m = fmaxf(m, __shfl_xor(m, s));
        float sc = 1.f, isc = 1.f;
        if (m > 1e-30f) {
            int k = (int)floorf(log2f(448.0f / m));
            k = k < -60 ? -60 : (k > 60 ? 60 : k);
            sc = ldexpf(1.0f, k); isc = ldexpf(1.0f, -k);
            if (m * sc > 448.0f) { sc *= 0.5f; isc *= 2.0f; }
        }
        u32x4 o;
        int w;
        w = __builtin_amdgcn_cvt_pk_fp8_f32(a.x * sc, a.y * sc, 0, false); w = __builtin_amdgcn_cvt_pk_fp8_f32(a.z * sc, a.w * sc, w, true); o.x = (unsigned)w;
        w = __builtin_amdgcn_cvt_pk_fp8_f32(b.x * sc, b.y * sc, 0, false); w = __builtin_amdgcn_cvt_pk_fp8_f32(b.z * sc, b.w * sc, w, true); o.y = (unsigned)w;
        w = __builtin_amdgcn_cvt_pk_fp8_f32(c.x * sc, c.y * sc, 0, false); w = __builtin_amdgcn_cvt_pk_fp8_f32(c.z * sc, c.w * sc, w, true); o.z = (unsigned)w;
        w = __builtin_amdgcn_cvt_pk_fp8_f32(d.x * sc, d.y * sc, 0, false); w = __builtin_amdgcn_cvt_pk_fp8_f32(d.z * sc, d.w * sc, w, true); o.w = (unsigned)w;
        *(u32x4*)(dst + (size_t)row * DM + lane * 16) = o;
        if (lane == 0) inv[row] = isc;
    }
}
DI void phase_prep(const Params& p, int bid, int nb, char* smem) {
    constexpr int N_MOD = 192, N_LB = 1, N_S5 = 32, T_WIN = 16 * 40, T_GLU = 8 * 8, T_WOUT = 16 * 16, T_WQ = 16 * 32;
    constexpr int I_LB = N_MOD, I_S5 = I_LB + N_LB, I_WIN = I_S5 + N_S5, I_GLU = I_WIN + T_WIN, I_WOUT = I_GLU + T_GLU, I_WQ = I_WOUT + T_WOUT, I_END = I_WQ + T_WQ;
    for (int it = bid; it < I_END; it += nb) {
        if (it < N_MOD) prep_mod_item(p, it, smem);
        else if (it < I_S5) {
            const int j = my_tid();
            const float a0 = p.hg_lb[j], a1 = p.hg_lb[512 + j], m = fmaxf(a0, a1);
            const float e0 = expf(a0 - m), e1 = expf(a1 - m);
            ((float*)(p.ws + OFF_LB))[j] = e0 / (e0 + e1);
        } else if (it < I_WIN) { prep_s5_item(p, it - I_S5); prep_s5_gemm_item(p, it - I_S5, smem); }
        else if (it < I_GLU) { const int t = it - I_WIN; prep_transpose_tile(p.w_in, (bf16_t*)(p.ws + OFF_WIN), DM, INC, t / 40, t % 40, smem); }
        else if (it < I_WOUT) { const int t = it - I_GLU; prep_transpose_tile(p.glu_w, (bf16_t*)(p.ws + OFF_GLU), 512, 512, t / 8, t % 8, smem); }
        else if (it < I_WQ) { const int t = it - I_WOUT; prep_transpose_tile(p.w_out, (bf16_t*)(p.ws + OFF_WOUT), DM, DM, t / 16, t % 16, smem); }
        else { const int t = it - I_WQ; prep_transpose_tile(p.w_q, (bf16_t*)(p.ws + OFF_WQ), DM, 2048, t / 32, t % 32, smem); }
    }
    cvt_bf16_stream(p.subk, (bf16_t*)(p.ws + OFF_SUBK), (size_t)16 * 128 * 128 / 8, bid, nb);
    cvt_fp8_rows(p.pu, (unsigned char*)(p.ws + OFF_UT), (float*)(p.ws + OFF_SU), bid, nb);
    cvt_fp8_rows(p.pv, (unsigned char*)(p.ws + OFF_VT), (float*)(p.ws + OFF_SV), bid, nb);
}

DI void phase_h(const Params& p, int bid, int nb) {
    const float* mod = (const float*)(p.ws + OFF_MOD);
    bf16_t* H = (bf16_t*)(p.ws + OFF_H);
    const size_t n8 = (size_t)NTOK * DM / 8;
    for (size_t i = (size_t)bid * NTH + my_tid(); i < n8; i += (size_t)nb * NTH) {
        const int row = (int)(i >> 7), c0 = (int)(i & 127) * 8, b = row / SEQ;
        const float* sh = mod + b * 6144 + c0;
        const float* sc = sh + 1024;
        const float4 a = *(const float4*)(p.x + i * 8), bq = *(const float4*)(p.x + i * 8 + 4);
        const float4 s0 = *(const float4*)sc, s1 = *(const float4*)(sc + 4), h0 = *(const float4*)sh, h1 = *(const float4*)(sh + 4);
        uint4 o;
        o.x = pack2(a.x * (1.f + s0.x) + h0.x, a.y * (1.f + s0.y) + h0.y);
        o.y = pack2(a.z * (1.f + s0.z) + h0.z, a.w * (1.f + s0.w) + h0.w);
        o.z = pack2(bq.x * (1.f + s1.x) + h1.x, bq.y * (1.f + s1.y) + h1.y);
        o.w = pack2(bq.z * (1.f + s1.z) + h1.z, bq.w * (1.f + s1.w) + h1.w);
        *(uint4*)(H + i * 8) = o;
    }
}

DI void phase_proj(const Params& p, int bid, int nb, char* smem) {
    pg8::Gemm g{(const bf16_t*)(p.ws + OFF_H), (const bf16_t*)(p.ws + OFF_WIN), NTOK, INC, DM};
    pg8::StaticOrder S; S.init(NTOK, INC, nb, bid);
    pg8::EpiBf16Act E{(bf16_t*)(p.ws + OFF_PROJ), INC, 0xC3u};
    pg8::gemm_phase<pg8::EpiBf16Act, pg8::StaticOrder, false>((PG8_LAS unsigned char*)smem, g, S, E, nullptr);
}

DI void hgrn_item(const Params& p, int item, char* smem) {
    const int vs = item & 7, hd = (item >> 3) & 3, b = item >> 5;
    const bf16_t* P = (const bf16_t*)(p.ws + OFF_PROJ);
    const float* lb = (const float*)(p.ws + OFF_LB) + hd * HDK;
    float* ORAW = (float*)(p.ws + OFF_ORAW);
    float* sq = (float*)smem;
    float* sf = sq + 32 * 128;
    float* sv = sf + 32 * 128;
    float* sp = sv + 32 * 16;
    const int tid = my_tid(), lane = tid & 63, wid = tid >> 6, kq = tid >> 4, v = tid & 15;
    float S0 = 0.f, S1 = 0.f, S2 = 0.f, S3 = 0.f;
    for (int t0 = 0; t0 < SEQ; t0 += 32) {
        for (int i = tid; i < 32 * 128; i += NTH) {
            const int t = i >> 7, k = i & 127;
            const bf16_t* row = P + (size_t)(b * SEQ + t0 + t) * INC + hd * HDK + k;
            sq[i] = bf2f(row[0]);
            const float l = lb[k];
            sf[i] = l + (1.0f - l) * sigmoidf_(bf2f(row[512]));
        }
        { const int t = tid >> 4; sv[tid] = bf2f(P[(size_t)(b * SEQ + t0 + t) * INC + 1024 + hd * HDK + vs * 16 + v]); }
        __syncthreads();
        for (int t = 0; t < 32; ++t) {
            const float4 f4 = *(const float4*)(sf + t * 128 + kq * 4), q4 = *(const float4*)(sq + t * 128 + kq * 4);
            const float vv = sv[t * 16 + v];
            S0 = f4.x * S0 + (1.0f - f4.x) * vv; S1 = f4.y * S1 + (1.0f - f4.y) * vv;
            S2 = f4.z * S2 + (1.0f - f4.z) * vv; S3 = f4.w * S3 + (1.0f - f4.w) * vv;
            float part = q4.x * S0 + q4.y * S1 + q4.z * S2 + q4.w * S3;
            part += __shfl_xor(part, 16); part += __shfl_xor(part, 32);
            if (lane < 16) sp[(t * 8 + wid) * 16 + v] = part;
        }
        __syncthreads();
        {
            const int t = tid >> 4;
            float o = 0.f;
#pragma unroll
            for (int w = 0; w < 8; ++w) o += sp[(t * 8 + w) * 16 + v];
            ORAW[(size_t)(b * SEQ + t0 + t) * DHG + hd * HDK + vs * 16 + v] = o;
        }
        __syncthreads();
    }
}
DI void s5_item(const Params& p, int item, char* smem) {
    const int oct = item & 3, b = item >> 2;
    const int tid = my_tid(), lane = tid & 63, wid = tid >> 6, g = oct * 8 + wid;
    const bf16_t* P = (const bf16_t*)(p.ws + OFF_PROJ);
    bf16_t* Y = (bf16_t*)(p.ws + OFF_YSSM);
    float* su = (float*)smem + wid * 64 * 16;
    const float* lam = (const float*)(p.ws + OFF_LAM) + (g * SSP + lane) * 2;
    const float lr = lam[0], li = lam[1];
    const float* bb = (const float*)(p.ws + OFF_BB) + (size_t)(g * SSP + lane) * 32;
    float bbr[16], bbi[16], cr[16], ci[16];
#pragma unroll
    for (int i = 0; i < 16; ++i) { bbr[i] = bb[2 * i]; bbi[i] = bb[2 * i + 1]; cr[i] = p.c_re[(g * SSC + i) * SSP + lane]; ci[i] = p.c_im[(g * SSC + i) * SSP + lane]; }
    const int ch = (lane >> 2) & 15;
    const float dch = p.dsk[g * SSC + ch];
    float xr = 0.f, xi = 0.f;
    for (int t0 = 0; t0 < SEQ; t0 += 64) {
        {
            const uint4* src = (const uint4*)(P + (size_t)(b * SEQ + t0 + lane) * INC + 2048 + g * SSC);
            const uint4 a = src[0], c = src[1];
            float* d = su + lane * 16;
            d[0] = bflo(a.x); d[1] = bfhi(a.x); d[2] = bflo(a.y); d[3] = bfhi(a.y); d[4] = bflo(a.z); d[5] = bfhi(a.z); d[6] = bflo(a.w); d[7] = bfhi(a.w);
            d[8] = bflo(c.x); d[9] = bfhi(c.x); d[10] = bflo(c.y); d[11] = bfhi(c.y); d[12] = bflo(c.z); d[13] = bfhi(c.z); d[14] = bflo(c.w); d[15] = bfhi(c.w);
        }
        __syncthreads();
        for (int t = 0; t < 64; ++t) {
            float u[16];
            const float4* us = (const float4*)(su + t * 16);
            const float4 u0 = us[0], u1 = us[1], u2 = us[2], u3 = us[3];
            u[0] = u0.x; u[1] = u0.y; u[2] = u0.z; u[3] = u0.w; u[4] = u1.x; u[5] = u1.y; u[6] = u1.z; u[7] = u1.w;
            u[8] = u2.x; u[9] = u2.y; u[10] = u2.z; u[11] = u2.w; u[12] = u3.x; u[13] = u3.y; u[14] = u3.z; u[15] = u3.w;
            float bur = 0.f, bui = 0.f;
#pragma unroll
            for (int i = 0; i < 16; ++i) { bur += bbr[i] * u[i]; bui += bbi[i] * u[i]; }
            const float nxr = lr * xr - li * xi + bur, nxi = lr * xi + li * xr + bui;
            xr = nxr; xi = nxi;
            float y[16];
#pragma unroll
            for (int i = 0; i < 16; ++i) y[i] = cr[i] * xr - ci[i] * xi;
            const bool b5 = lane & 32, b4 = lane & 16, b3 = lane & 8, b2 = lane & 4;
            float y8[8], y4[4], y2[2];
#pragma unroll
            for (int j = 0; j < 8; ++j) { const float keep = b5 ? y[8 + j] : y[j], send = b5 ? y[j] : y[8 + j]; y8[j] = keep + __shfl_xor(send, 32); }
#pragma unroll
            for (int j = 0; j < 4; ++j) { const float keep = b4 ? y8[4 + j] : y8[j], send = b4 ? y8[j] : y8[4 + j]; y4[j] = keep + __shfl_xor(send, 16); }
#pragma unroll
            for (int j = 0; j < 2; ++j) { const float keep = b3 ? y4[2 + j] : y4[j], send = b3 ? y4[j] : y4[2 + j]; y2[j] = keep + __shfl_xor(send, 8); }
            float y1;
            { const float keep = b2 ? y2[1] : y2[0], send = b2 ? y2[0] : y2[1]; y1 = keep + __shfl_xor(send, 4); }
            y1 += __shfl_xor(y1, 1); y1 += __shfl_xor(y1, 2);
            if ((lane & 3) == 0) {
                const float uu = su[t * 16 + ch];
                Y[(size_t)(b * SEQ + t0 + t) * DSS + g * SSC + ch] = f2bf(geluf_(y1 + dch * uu));
            }
        }
        __syncthreads();
    }
}
DI int crow(int i, int h) { return (i & 3) + 8 * (i >> 2) + 4 * h; }
DI void phase_hgprep(const Params& p, int bid, int nb) {
    const bf16_t* P = (const bf16_t*)(p.ws + OFF_PROJ);
    const float* lbp = (const float*)(p.ws + OFF_LB);
    const int tid = my_tid(), cl = tid >> 7, k = tid & 127;
    for (int it = bid; it < 1024; it += nb) {
        const int cq = it & 15, hd = (it >> 4) & 3, b = it >> 6, c = cq * 4 + cl;
        const bf16_t* base = P + (size_t)(b * SEQ + c * 32) * INC + hd * HDK + k;
        const float l = lbp[hd * HDK + k];
        const size_t tile = ((size_t)(b * 4 + hd) * 64 + c);
        bf16_t* HQ = (bf16_t*)(p.ws + OFF_HQ) + tile * 4096;
        bf16_t* HK = (bf16_t*)(p.ws + OFF_HK) + tile * 4096;
        bf16_t* HKT = (bf16_t*)(p.ws + OFF_HKT) + tile * 4096;
        bf16_t* HVT = (bf16_t*)(p.ws + OFF_HVT) + tile * 4096;
        float bc[32], kk[32];
        float bs = 0.f;
#pragma unroll
        for (int t = 0; t < 32; ++t) {
            const float f = l + (1.0f - l) * sigmoidf_(bf2f(base[(size_t)t * INC + 512]));
            bs += __logf(f); bc[t] = bs; kk[t] = 1.0f - f;
        }
#pragma unroll
        for (int t = 0; t < 32; ++t) {
            const float qv = bf2f(base[(size_t)t * INC]);
            HQ[t * 128 + k] = f2bf(qv * __expf(bc[t]));
            HK[t * 128 + k] = f2bf(kk[t] * __expf(fminf(-bc[t], 80.0f)));
        }
#pragma unroll
        for (int q = 0; q < 4; ++q) {
            u32x4 o;
            o.x = pack2(kk[q * 8 + 0] * __expf(bs - bc[q * 8 + 0]), kk[q * 8 + 1] * __expf(bs - bc[q * 8 + 1]));
            o.y = pack2(kk[q * 8 + 2] * __expf(bs - bc[q * 8 + 2]), kk[q * 8 + 3] * __expf(bs - bc[q * 8 + 3]));
            o.z = pack2(kk[q * 8 + 4] * __expf(bs - bc[q * 8 + 4]), kk[q * 8 + 5] * __expf(bs - bc[q * 8 + 5]));
            o.w = pack2(kk[q * 8 + 6] * __expf(bs - bc[q * 8 + 6]), kk[q * 8 + 7] * __expf(bs - bc[q * 8 + 7]));
            *(u32x4*)(HKT + k * 32 + q * 8) = o;
        }
        ((float*)(p.ws + OFF_HG))[tile * 128 + k] = __expf(bs);
#pragma unroll
        for (int q = 0; q < 4; ++q) {
            unsigned w[4];
#pragma unroll
            for (int e = 0; e < 4; ++e) w[e] = (unsigned)base[(size_t)(q * 8 + 2 * e) * INC + 1024] | ((unsigned)base[(size_t)(q * 8 + 2 * e + 1) * INC + 1024] << 16);
            *(u32x4*)(HVT + k * 32 + q * 8) = (u32x4){w[0], w[1], w[2], w[3]};
        }
    }
}
typedef short s16x4 __attribute__((ext_vector_type(4)));
DI bf16x8 cat8(const s16x4 lo, const s16x4 hi) { return (bf16x8){lo.x, lo.y, lo.z, lo.w, hi.x, hi.y, hi.z, hi.w}; }
DI void hgrn_mfma_item(const Params& p, int item, char* smem) {
    constexpr int QP_OFF = 0, KP_OFF = 8704, KT_OFF = 17408, VT_OFF = 27648, G_OFF = 37888, BUF = 38400;
    const int tid = my_tid(), lane = tid & 63, wid = tid >> 6, r = lane & 31, h = lane >> 5;
    const int b = item >> 2, hd = item & 3;
    const size_t tile0 = (size_t)item * 64;
    const bf16_t* HQ = (const bf16_t*)(p.ws + OFF_HQ) + tile0 * 4096;
    const bf16_t* HK = (const bf16_t*)(p.ws + OFF_HK) + tile0 * 4096;
    const bf16_t* HKT = (const bf16_t*)(p.ws + OFF_HKT) + tile0 * 4096;
    const bf16_t* HVT = (const bf16_t*)(p.ws + OFF_HVT) + tile0 * 4096;
    const float* HG = (const float*)(p.ws + OFF_HG) + tile0 * 128;
    float* ORAW = (float*)(p.ws + OFF_ORAW) + (size_t)b * SEQ * DHG + hd * HDK;
    const bool helper = wid >= 4;
    const int ht = tid - 256;
    u32x4 sq0, sq1, sk0, sk1, st0, st1, sv0, sv1, sg;
    sq0 = sq1 = sk0 = sk1 = st0 = st1 = sv0 = sv1 = sg = (u32x4){0, 0, 0, 0};
    f32x16 S[4];
#pragma unroll
    for (int kb = 0; kb < 4; ++kb)
#pragma unroll
        for (int i = 0; i < 16; ++i) S[kb][i] = 0.f;
#define HG_LOAD(c_) { const size_t o_ = (size_t)(c_) * 4096; \
        sq0 = *(const u32x4*)(HQ + o_ + ht * 8); sq1 = *(const u32x4*)(HQ + o_ + (ht + 256) * 8); \
        sk0 = *(const u32x4*)(HK + o_ + ht * 8); sk1 = *(const u32x4*)(HK + o_ + (ht + 256) * 8); \
        st0 = *(const u32x4*)(HKT + o_ + ht * 8); st1 = *(const u32x4*)(HKT + o_ + (ht + 256) * 8); \
        sv0 = *(const u32x4*)(HVT + o_ + ht * 8); sv1 = *(const u32x4*)(HVT + o_ + (ht + 256) * 8); \
        if (ht < 32) sg = *(const u32x4*)(HG + (size_t)(c_) * 128 + ht * 4); }
#define HG_STORE(buf_) { char* B_ = smem + (buf_) * BUF; \
        { const int i0 = ht, i1 = ht + 256; \
          *(u32x4*)(B_ + QP_OFF + (i0 >> 4) * 272 + (i0 & 15) * 16) = sq0; *(u32x4*)(B_ + QP_OFF + (i1 >> 4) * 272 + (i1 & 15) * 16) = sq1; \
          *(u32x4*)(B_ + KP_OFF + (i0 >> 4) * 272 + (i0 & 15) * 16) = sk0; *(u32x4*)(B_ + KP_OFF + (i1 >> 4) * 272 + (i1 & 15) * 16) = sk1; \
          *(u32x4*)(B_ + KT_OFF + (i0 >> 2) * 80 + (i0 & 3) * 16) = st0; *(u32x4*)(B_ + KT_OFF + (i1 >> 2) * 80 + (i1 & 3) * 16) = st1; \
          *(u32x4*)(B_ + VT_OFF + (i0 >> 2) * 80 + (i0 & 3) * 16) = sv0; *(u32x4*)(B_ + VT_OFF + (i1 >> 2) * 80 + (i1 & 3) * 16) = sv1; \
          if (ht < 32) *(u32x4*)(B_ + G_OFF + ht * 16) = sg; } }
    if (helper) { HG_LOAD(0); HG_STORE(0); }
    __syncthreads();
    for (int c = 0; c < 64; ++c) {
        if (helper) {
            if (c + 1 < 64) HG_LOAD(c + 1);
        } else {
            const char* B = smem + (c & 1) * BUF;
            const int w = wid;
            f32x16 pt;
#pragma unroll
            for (int i = 0; i < 16; ++i) pt[i] = 0.f;
#pragma unroll
            for (int ks = 0; ks < 8; ++ks) {
                const bf16x8 a = *(const bf16x8*)(B + KP_OFF + r * 272 + ks * 32 + h * 16);
                const bf16x8 bq = *(const bf16x8*)(B + QP_OFF + r * 272 + ks * 32 + h * 16);
                pt = __builtin_amdgcn_mfma_f32_32x32x16_bf16(a, bq, pt, 0, 0, 0);
            }
#pragma unroll
            for (int i = 0; i < 16; ++i) if (crow(i, h) > r) pt[i] = 0.f;
            f32x16 o;
#pragma unroll
            for (int i = 0; i < 16; ++i) o[i] = 0.f;
#pragma unroll
            for (int sp = 0; sp < 2; ++sp) {
                const char* vb = B + VT_OFF + (32 * w + r) * 80 + sp * 32 + h * 8;
                const bf16x8 bv = cat8(*(const s16x4*)vb, *(const s16x4*)(vb + 16));
                o = __builtin_amdgcn_mfma_f32_32x32x16_bf16(pack8(pt, 8 * sp), bv, o, 0, 0, 0);
            }
#pragma unroll
            for (int kb = 0; kb < 4; ++kb)
#pragma unroll
                for (int sp = 0; sp < 2; ++sp) {
                    const char* qb = B + QP_OFF + r * 272 + kb * 64 + sp * 32 + h * 8;
                    const bf16x8 aq = cat8(*(const s16x4*)qb, *(const s16x4*)(qb + 16));
                    o = __builtin_amdgcn_mfma_f32_32x32x16_bf16(aq, pack8(S[kb], 8 * sp), o, 0, 0, 0);
                }
#pragma unroll
            for (int i = 0; i < 16; ++i) ORAW[(size_t)(c * 32 + crow(i, h)) * DHG + 32 * w + r] = o[i];
#pragma unroll
            for (int kb = 0; kb < 4; ++kb) {
#pragma unroll
                for (int j = 0; j < 4; ++j) {
                    const f32x4 g4 = *(const f32x4*)(B + G_OFF + (kb * 32 + 8 * j + 4 * h) * 4);
                    S[kb][4 * j] *= g4.x; S[kb][4 * j + 1] *= g4.y; S[kb][4 * j + 2] *= g4.z; S[kb][4 * j + 3] *= g4.w;
                }
#pragma unroll
                for (int ks = 0; ks < 2; ++ks) {
                    const bf16x8 a = *(const bf16x8*)(B + KT_OFF + (kb * 32 + r) * 80 + ks * 32 + h * 16);
                    const bf16x8 bv = *(const bf16x8*)(B + VT_OFF + (32 * w + r) * 80 + ks * 32 + h * 16);
                    S[kb] = __builtin_amdgcn_mfma_f32_32x32x16_bf16(a, bv, S[kb], 0, 0, 0);
                }
            }
        }
        if (helper) { if (c + 1 < 64) HG_STORE((c + 1) & 1); }
        __syncthreads();
    }
}
template <int NJ>
DI void s5_gemm2_tile(const bf16x8 (&af)[16], const bf16_t* KTl, const bf16_t* Xin, const bf16_t* MBg, bf16_t* Yout, const int mi, const int r, const int h) {
    f32x16 y;
#pragma unroll
    for (int i = 0; i < 16; ++i) y[i] = 0.f;
    const int tsel = r >> 4, iq = r & 15;
#pragma unroll
    for (int ks = 0; ks <= 2 * NJ; ++ks) {
        const bf16x8 bk = *(const bf16x8*)(KTl + ((2 * NJ + tsel - ks) * 16 + iq) * 16 + 8 * h);
        y = __builtin_amdgcn_mfma_f32_32x32x16_bf16(af[ks], bk, y, 0, 0, 0);
    }
    {
        bf16x8 bk = *(const bf16x8*)(KTl + iq * 16 + 8 * h);
        if (tsel == 0) bk = (bf16x8){0, 0, 0, 0, 0, 0, 0, 0};
        y = __builtin_amdgcn_mfma_f32_32x32x16_bf16(af[2 * NJ + 1], bk, y, 0, 0, 0);
    }
#pragma unroll
    for (int ks = 0; ks < 8; ++ks) {
        const bf16x8 a = *(const bf16x8*)(Xin + (mi * 32 + r) * 136 + ks * 16 + 8 * h);
        const bf16x8 bm = *(const bf16x8*)(MBg + (size_t)(NJ * 32 + r) * 128 + ks * 16 + 8 * h);
        y = __builtin_amdgcn_mfma_f32_32x32x16_bf16(a, bm, y, 0, 0, 0);
    }
#pragma unroll
    for (int i = 0; i < 16; ++i) Yout[(size_t)((mi * 32 + crow(i, h)) * 16 + 2 * NJ + tsel) * DSS + iq] = f2bf(gelu_as(y[i]));
}
DI void s5_gemm_item(const Params& p, int b, int g, char* smem) {
    float* E = (float*)smem;
    bf16_t* Xin = (bf16_t*)(smem + 128 * 132 * 4);
    bf16_t* KTl = Xin + 128 * 136;
    const int tid = my_tid(), lane = tid & 63, wid = tid >> 6, r = lane & 31, h = lane >> 5;
    const int mi = wid >> 1, wh = wid & 1;
    const bf16_t* P = (const bf16_t*)(p.ws + OFF_PROJ);
    *(u32x4*)(KTl + tid * 8) = *(const u32x4*)((const bf16_t*)(p.ws + OFF_S5K) + (size_t)g * 4096 + tid * 8);
    bf16x8 af[16];
    {
        const bf16_t* ub = P + (size_t)(b * SEQ + (mi * 32 + r) * 16) * INC + 2048 + g * 16 + 8 * h;
#pragma unroll
        for (int ks = 0; ks < 16; ++ks) af[ks] = *(const bf16x8*)(ub + (size_t)ks * INC);
    }
    {
        f32x16 e0, e1;
#pragma unroll
        for (int i = 0; i < 16; ++i) { e0[i] = 0.f; e1[i] = 0.f; }
        const bf16_t* nb0 = (const bf16_t*)(p.ws + OFF_S5N) + ((size_t)g * 128 + wh * 64 + r) * 256 + 8 * h;
#pragma unroll
        for (int ks = 0; ks < 16; ++ks) {
            const bf16x8 b0 = *(const bf16x8*)(nb0 + ks * 16), b1 = *(const bf16x8*)(nb0 + 32 * 256 + ks * 16);
            e0 = __builtin_amdgcn_mfma_f32_32x32x16_bf16(af[ks], b0, e0, 0, 0, 0);
            e1 = __builtin_amdgcn_mfma_f32_32x32x16_bf16(af[ks], b1, e1, 0, 0, 0);
        }
#pragma unroll
        for (int i = 0; i < 16; ++i) { float* er = E + (mi * 32 + crow(i, h)) * 132 + wh * 64 + r; er[0] = e0[i]; er[32] = e1[i]; }
    }
    __syncthreads();
    if (wid == 0) {
        const float* L = (const float*)(p.ws + OFF_S5L) + (g * 64 + lane) * 2;
        const float lr = L[0], li = L[1];
        float xr = 0.f, xi = 0.f;
#pragma unroll 8
        for (int c = 0; c < 128; ++c) {
            const float er = E[c * 132 + lane], ei = E[c * 132 + 64 + lane];
            Xin[c * 136 + lane] = f2bf(xr); Xin[c * 136 + 64 + lane] = f2bf(xi);
            const float nr = lr * xr - li * xi + er, ni = lr * xi + li * xr + ei;
            xr = nr; xi = ni;
        }
    }
    __syncthreads();
    const bf16_t* MBg = (const bf16_t*)(p.ws + OFF_S5M) + (size_t)g * 256 * 128;
    bf16_t* Yout = (bf16_t*)(p.ws + OFF_YSSM) + (size_t)b * SEQ * DSS + g * 16;
    if (wh) {
        s5_gemm2_tile<1>(af, KTl, Xin, MBg, Yout, mi, r, h); s5_gemm2_tile<6>(af, KTl, Xin, MBg, Yout, mi, r, h);
        s5_gemm2_tile<3>(af, KTl, Xin, MBg, Yout, mi, r, h); s5_gemm2_tile<4>(af, KTl, Xin, MBg, Yout, mi, r, h);
    } else {
        s5_gemm2_tile<0>(af, KTl, Xin, MBg, Yout, mi, r, h); s5_gemm2_tile<7>(af, KTl, Xin, MBg, Yout, mi, r, h);
        s5_gemm2_tile<2>(af, KTl, Xin, MBg, Yout, mi, r, h); s5_gemm2_tile<5>(af, KTl, Xin, MBg, Yout, mi, r, h);
    }
    __syncthreads();
}
DI void phase_mix(const Params& p, int bid, int nb, char* smem) {
    if (nb == 256) {
        if (bid < 64) { hgrn_mfma_item(p, bid, smem); return; }
        const int j = bid - 64, x = j & 7, lb = j >> 3;
        for (int q = lb; q < 64; q += 24) s5_gemm_item(p, q & 15, x * 4 + (q >> 4), smem);
    } else {
        for (int it = bid; it < 64; it += nb) hgrn_mfma_item(p, it, smem);
        for (int q = bid; q < 512; q += nb) s5_gemm_item(p, q & 15, q >> 4, smem);
    }
}

DI void phase_glu(const Params& p, int bid, int nb, char* smem) {
    pg8::Gemm g{(const bf16_t*)(p.ws + OFF_YSSM), (const bf16_t*)(p.ws + OFF_GLU), NTOK, 512, 512};
    pg8::StaticOrder S; S.init(NTOK, 512, nb, bid);
    pg8::EpiGlu E{(float*)(p.ws + OFF_H), (const bf16_t*)(p.ws + OFF_YSSM), p.glu_b};
    pg8::gemm_phase<pg8::EpiGlu, pg8::StaticOrder, false>((PG8_LAS unsigned char*)smem, g, S, E, nullptr);
}
DI void phase_a2(const Params& p, int bid, int nb) {
    const float* ORAW = (const float*)(p.ws + OFF_ORAW);
    const float* Y2 = (const float*)(p.ws + OFF_H);
    const bf16_t* P = (const bf16_t*)(p.ws + OFF_PROJ);
    bf16_t* A2 = (bf16_t*)(p.ws + OFF_A2);
    const int lane = my_tid() & 63, wid = my_tid() >> 6;
    for (int tok = bid * 8 + wid; tok < NTOK; tok += nb * 8) {
        const int c0 = lane * 8;
        {
            const float4 a = *(const float4*)(ORAW + (size_t)tok * DHG + c0), b = *(const float4*)(ORAW + (size_t)tok * DHG + c0 + 4);
            float ss = a.x * a.x + a.y * a.y + a.z * a.z + a.w * a.w + b.x * b.x + b.y * b.y + b.z * b.z + b.w * b.w;
            ss += __shfl_xor(ss, 1); ss += __shfl_xor(ss, 2); ss += __shfl_xor(ss, 4); ss += __shfl_xor(ss, 8);
            const float rs = rsqrtf(ss * (1.0f / 128.0f) + RMS_EPS);
            const uint4 gq = *(const uint4*)(P + (size_t)tok * INC + 1536 + c0);
            const float4 w0 = *(const float4*)(p.hg_nw + c0), w1 = *(const float4*)(p.hg_nw + c0 + 4);
            uint4 o;
            o.x = pack2(a.x * rs * w0.x * bflo(gq.x), a.y * rs * w0.y * bfhi(gq.x));
            o.y = pack2(a.z * rs * w0.z * bflo(gq.y), a.w * rs * w0.w * bfhi(gq.y));
            o.z = pack2(b.x * rs * w1.x * bflo(gq.z), b.y * rs * w1.y * bfhi(gq.z));
            o.w = pack2(b.z * rs * w1.z * bflo(gq.w), b.w * rs * w1.w * bfhi(gq.w));
            *(uint4*)(A2 + (size_t)tok * DM + c0) = o;
        }
        {
            const float4 a = *(const float4*)(Y2 + (size_t)tok * DSS + c0), b = *(const float4*)(Y2 + (size_t)tok * DSS + c0 + 4);
            float ss = a.x * a.x + a.y * a.y + a.z * a.z + a.w * a.w + b.x * b.x + b.y * b.y + b.z * b.z + b.w * b.w;
#pragma unroll
            for (int m = 1; m < 64; m <<= 1) ss += __shfl_xor(ss, m);
            const float rs = rsqrtf(ss * (1.0f / 512.0f) + RMS_EPS);
            const float4 w0 = *(const float4*)(p.ssm_nw + c0), w1 = *(const float4*)(p.ssm_nw + c0 + 4);
            uint4 o;
            o.x = pack2(a.x * rs * w0.x, a.y * rs * w0.y); o.y = pack2(a.z * rs * w0.z, a.w * rs * w0.w);
            o.z = pack2(b.x * rs * w1.x, b.y * rs * w1.y); o.w = pack2(b.z * rs * w1.z, b.w * rs * w1.w);
            *(uint4*)(A2 + (size_t)tok * DM + 512 + c0) = o;
        }
    }
}

DI void phase_outproj(const Params& p, int bid, int nb, char* smem) {
    pg8::Gemm g{(const bf16_t*)(p.ws + OFF_A2), (const bf16_t*)(p.ws + OFF_WOUT), NTOK, DM, DM};
    pg8::StaticOrder S; S.init(NTOK, DM, nb, bid);
    pg8::EpiResid E{p.out, p.x, (const float*)(p.ws + OFF_MOD) + 2048, DEEP_ALPHA};
    pg8::gemm_phase<pg8::EpiResid, pg8::StaticOrder, false>((PG8_LAS unsigned char*)smem, g, S, E, nullptr);
}
DI void phase_ln1(const Params& p, int bid, int nb) {
    const float* mod = (const float*)(p.ws + OFF_MOD);
    bf16_t* H2 = (bf16_t*)(p.ws + OFF_H);
    const int lane = my_tid() & 63, wid = my_tid() >> 6;
    for (int tok = bid * 8 + wid; tok < NTOK; tok += nb * 8) {
        const int b = tok / SEQ;
        float* row = p.out + (size_t)tok * DM;
        float4 v[4];
        float s = 0.f;
#pragma unroll
        for (int j = 0; j < 4; ++j) { v[j] = *(const float4*)(row + j * 256 + lane * 4); s += v[j].x + v[j].y + v[j].z + v[j].w; }
#pragma unroll
        for (int m = 1; m < 64; m <<= 1) s += __shfl_xor(s, m);
        const float mu = s * (1.0f / 1024.0f);
        float q = 0.f;
#pragma unroll
        for (int j = 0; j < 4; ++j) { const float a = v[j].x - mu, bb = v[j].y - mu, cc = v[j].z - mu, d = v[j].w - mu; q += a * a + bb * bb + cc * cc + d * d; }
#pragma unroll
        for (int m = 1; m < 64; m <<= 1) q += __shfl_xor(q, m);
        const float rstd = rsqrtf(q * (1.0f / 1024.0f) + LN_EPS);
        const float* sh2 = mod + b * 6144 + 3072;
        const float* sc2 = mod + b * 6144 + 4096;
#pragma unroll
        for (int j = 0; j < 4; ++j) {
            const int c = j * 256 + lane * 4;
            const float4 w = *(const float4*)(p.ln1w + c), bi = *(const float4*)(p.ln1b + c), sc = *(const float4*)(sc2 + c), sh = *(const float4*)(sh2 + c);
            float4 o;
            o.x = (v[j].x - mu) * rstd * w.x + bi.x; o.y = (v[j].y - mu) * rstd * w.y + bi.y; o.z = (v[j].z - mu) * rstd * w.z + bi.z; o.w = (v[j].w - mu) * rstd * w.w + bi.w;
            *(float4*)(row + c) = o;
            uint2 hh; hh.x = pack2(o.x * (1.f + sc.x) + sh.x, o.y * (1.f + sc.y) + sh.y); hh.y = pack2(o.z * (1.f + sc.z) + sh.z, o.w * (1.f + sc.w) + sh.w);
            *(uint2*)(H2 + (size_t)tok * DM + c) = hh;
        }
    }
}

DI void phase_q(const Params& p, int bid, int nb, char* smem) {
    pg8::Gemm g{(const bf16_t*)(p.ws + OFF_H), (const bf16_t*)(p.ws + OFF_WQ), NTOK, 2048, DM};
    pg8::StaticOrder S; S.init(NTOK, 2048, nb, bid);
    pg8::EpiBf16Act E{(bf16_t*)(p.ws + OFF_PROJ), 2048, 0u};
    pg8::gemm_phase<pg8::EpiBf16Act, pg8::StaticOrder, false>((PG8_LAS unsigned char*)smem, g, S, E, nullptr);
}
DI void phase_topk(const Params& p, int bid, int nb, char* smem) {
    const bf16_t* Q = (const bf16_t*)(p.ws + OFF_PROJ);
    const bf16_t* SK = (const bf16_t*)(p.ws + OFF_SUBK);
    unsigned* TOPL = (unsigned*)(p.ws + OFF_TOPL);
    float* sc = (float*)(smem + 36864);
    constexpr int NTM = NTOK / 128;
    for (int t = bid; t < NTM * 16; t += nb) {
        const int mt = t >> 4, hp = t & 15;
        gemm_block<2, 1, 2, 4>(Q + (size_t)mt * 128 * 2048 + hp * 128, 2048, SK + (size_t)hp * 128 * 128, 128, 128, smem,
                               [&](int r, int c, float v) { sc[r * 129 + c] = v; });
        __syncthreads();
        if (my_tid() < 128) {
            const int r = my_tid();
            float tk[16];
#pragma unroll
            for (int j = 0; j < 16; ++j) tk[j] = -3.0e38f;
            for (int n = 0; n < 128; ++n) {
                float xv = __uint_as_float((__float_as_uint(sc[r * 129 + n]) & ~0x7fu) | (unsigned)n);
#pragma unroll
                for (int j = 0; j < 16; ++j) { const float hi = fmaxf(tk[j], xv), lo = fminf(tk[j], xv); tk[j] = hi; xv = lo; }
            }
            uint4* dst = (uint4*)(TOPL + ((size_t)(mt * 128 + r) * 16 + hp) * 16);
            dst[0] = make_uint4(__float_as_uint(tk[0]), __float_as_uint(tk[1]), __float_as_uint(tk[2]), __float_as_uint(tk[3]));
            dst[1] = make_uint4(__float_as_uint(tk[4]), __float_as_uint(tk[5]), __float_as_uint(tk[6]), __float_as_uint(tk[7]));
            dst[2] = make_uint4(__float_as_uint(tk[8]), __float_as_uint(tk[9]), __float_as_uint(tk[10]), __float_as_uint(tk[11]));
            dst[3] = make_uint4(__float_as_uint(tk[12]), __float_as_uint(tk[13]), __float_as_uint(tk[14]), __float_as_uint(tk[15]));
        }
        __syncthreads();
    }
}
DI void phase_combine(const Params& p, int bid, int nb) {
    const unsigned* TOPL = (const unsigned*)(p.ws + OFF_TOPL);
    uint2* EX = (uint2*)(p.ws + OFF_EXPS);
    const float* SU = (const float*)(p.ws + OFF_SU);
    const float* SV = (const float*)(p.ws + OFF_SV);
    for (int i = bid * NTH + my_tid(); i < NTOK * PHEADS; i += nb * NTH) {
        const unsigned* l1 = TOPL + (size_t)i * 32;
        const unsigned* l2 = l1 + 16;
        float s2[16];
        {
            const uint4 a = ((const uint4*)l2)[0], b = ((const uint4*)l2)[1], c = ((const uint4*)l2)[2], d = ((const uint4*)l2)[3];
            const unsigned w[16] = {a.x, a.y, a.z, a.w, b.x, b.y, b.z, b.w, c.x, c.y, c.z, c.w, d.x, d.y, d.z, d.w};
#pragma unroll
            for (int j = 0; j < 16; ++j) s2[j] = __uint_as_float(w[j] & ~0x7fu);
        }
        float tk[16];
#pragma unroll
        for (int j = 0; j < 16; ++j) tk[j] = -3.0e38f;
        for (int a = 0; a < 16; ++a) {
            const float s1 = __uint_as_float(l1[a] & ~0x7fu);
#pragma unroll
            for (int b = 0; b < 16; ++b) {
                float xv = __uint_as_float((__float_as_uint(s1 + s2[b]) & ~0xffu) | (unsigned)(a * 16 + b));
#pragma unroll
                for (int j = 0; j < 16; ++j) { const float hi = fmaxf(tk[j], xv), lo = fminf(tk[j], xv); tk[j] = hi; xv = lo; }
            }
        }
        float e[16], sum = 0.f;
        const float mx = __uint_as_float(__float_as_uint(tk[0]) & ~0xffu);
#pragma unroll
        for (int j = 0; j < 16; ++j) { e[j] = __expf(__uint_as_float(__float_as_uint(tk[j]) & ~0xffu) - mx); sum += e[j]; }
        const float inv = 1.0f / sum;
#pragma unroll
        for (int j = 0; j < 16; ++j) {
            const unsigned ab = __float_as_uint(tk[j]) & 0xffu;
            const unsigned i1 = l1[ab >> 4] & 0x7fu, i2 = l2[ab & 15] & 0x7fu;
            const unsigned eid = i1 * 128u + i2;
            EX[(size_t)i * 16 + j] = make_uint2(eid | (((__float_as_uint(SU[eid]) >> 23) & 0xffu) << 16), __float_as_uint(e[j] * inv * SV[eid]));
        }
    }
}

DI void ce_desc(float& a, float& b) { const float hi = fmaxf(a, b), lo = fminf(a, b); a = hi; b = lo; }
template <int N> DI void bitonic_sort_desc(float (&v)[N]) {
#pragma unroll
    for (int k = 2; k <= N; k <<= 1)
#pragma unroll
        for (int j = k >> 1; j > 0; j >>= 1)
#pragma unroll
            for (int i = 0; i < N; ++i) { const int l = i ^ j; if (l > i) { if ((i & k) == 0 || k == N) ce_desc(v[i], v[l]); else ce_desc(v[l], v[i]); } }
}
DI void merge_top16(float (&a)[16], const float (&b)[16]) {
#pragma unroll
    for (int i = 0; i < 16; ++i) a[i] = fmaxf(a[i], b[15 - i]);
#pragma unroll
    for (int j = 8; j > 0; j >>= 1)
#pragma unroll
        for (int i = 0; i < 16; ++i) { const int l = i ^ j; if (l > i) ce_desc(a[i], a[l]); }
}
DI void xlane_merge16(float (&a)[16]) {
    float o[16];
#pragma unroll
    for (int i = 0; i < 16; ++i) o[i] = __shfl_xor(a[i], 32);
    merge_top16(a, o);
}
DI void retrieve_topk_hp(const bf16_t* Q, const bf16_t* SK, const int tok, const int hp, const int r, const int h, unsigned char* lutp, float (&out)[16]) {
                f32x16 acc[4];
#pragma unroll
                for (int mi = 0; mi < 4; ++mi)
#pragma unroll
                    for (int i = 0; i < 16; ++i) acc[mi][i] = 0.f;
                const bf16_t* qb = Q + (size_t)tok * 2048 + hp * 128 + 8 * h;
                const bf16_t* kb = SK + (size_t)hp * 128 * 128 + (size_t)r * 128 + 8 * h;
#pragma unroll
                for (int ks = 0; ks < 8; ++ks) {
                    const bf16x8 bq = *(const bf16x8*)(qb + ks * 16);
#pragma unroll
                    for (int mi = 0; mi < 4; ++mi) {
                        const bf16x8 a = *(const bf16x8*)(kb + mi * 32 * 128 + ks * 16);
                        acc[mi] = __builtin_amdgcn_mfma_f32_32x32x16_bf16(a, bq, acc[mi], 0, 0, 0);
                    }
                }
                float v0[16], v1[16], v2[16], v3[16];
#pragma unroll
                for (int i = 0; i < 16; ++i) {
                    const unsigned n = (unsigned)crow(i, h);
                    v0[i] = __uint_as_float((__float_as_uint(acc[0][i]) & ~0x7fu) | n);
                    v1[i] = __uint_as_float((__float_as_uint(acc[1][i]) & ~0x7fu) | (n + 32u));
                    v2[i] = __uint_as_float((__float_as_uint(acc[2][i]) & ~0x7fu) | (n + 64u));
                    v3[i] = __uint_as_float((__float_as_uint(acc[3][i]) & ~0x7fu) | (n + 96u));
                }
                bitonic_sort_desc<16>(v0); bitonic_sort_desc<16>(v1); bitonic_sort_desc<16>(v2); bitonic_sort_desc<16>(v3);
                merge_top16(v0, v1); merge_top16(v2, v3); merge_top16(v0, v2);
                xlane_merge16(v0);
#pragma unroll
                for (int i = 0; i < 16; ++i) out[i] = v0[i];
                u32x4 ix;
                ix.x = (__float_as_uint(v0[0]) & 0x7fu) | ((__float_as_uint(v0[1]) & 0x7fu) << 8) | ((__float_as_uint(v0[2]) & 0x7fu) << 16) | ((__float_as_uint(v0[3]) & 0x7fu) << 24);
                ix.y = (__float_as_uint(v0[4]) & 0x7fu) | ((__float_as_uint(v0[5]) & 0x7fu) << 8) | ((__float_as_uint(v0[6]) & 0x7fu) << 16) | ((__float_as_uint(v0[7]) & 0x7fu) << 24);
                ix.z = (__float_as_uint(v0[8]) & 0x7fu) | ((__float_as_uint(v0[9]) & 0x7fu) << 8) | ((__float_as_uint(v0[10]) & 0x7fu) << 16) | ((__float_as_uint(v0[11]) & 0x7fu) << 24);
                ix.w = (__float_as_uint(v0[12]) & 0x7fu) | ((__float_as_uint(v0[13]) & 0x7fu) << 8) | ((__float_as_uint(v0[14]) & 0x7fu) << 16) | ((__float_as_uint(v0[15]) & 0x7fu) << 24);
                *(u32x4*)lutp = ix;
}
DI void phase_retrieve(const Params& p, int bid, int nb, char* smem) {
    const bf16_t* Q = (const bf16_t*)(p.ws + OFF_PROJ);
    const bf16_t* SK = (const bf16_t*)(p.ws + OFF_SUBK);
    const float* SU = (const float*)(p.ws + OFF_SU);
    const float* SV = (const float*)(p.ws + OFF_SV);
    uint2* EX = (uint2*)(p.ws + OFF_EXPS);
    const int tid = my_tid(), lane = tid & 63, wid = tid >> 6, r = lane & 31, h = lane >> 5;
    unsigned char* lut = (unsigned char*)smem + wid * 2048 + lane * 32;
    for (int it = bid * 8 + wid; it < (NTOK / 32) * 2; it += nb * 8) {
        const int tg = it >> 1, hq = it & 1;
        const int tok = tg * 32 + r;
#pragma unroll 1
        for (int hd = hq * 4; hd < hq * 4 + 4; ++hd) {
            float L0[16], L1[16];
            retrieve_topk_hp(Q, SK, tok, hd * 2, r, h, lut, L0);
            retrieve_topk_hp(Q, SK, tok, hd * 2 + 1, r, h, lut + 16, L1);
            float c[32];
            {
                constexpr int PA[50] = {0, 0, 0, 0, 0, 0, 0, 0, 0, 0, 0, 0, 0, 0, 0, 0, 1, 1, 1, 1, 1, 1, 1, 1, 2, 2, 2, 2, 2, 3, 3, 3, 3, 4, 4, 4, 5, 5, 6, 6, 7, 7, 8, 9, 10, 11, 12, 13, 14, 15};
                constexpr int PB[50] = {0, 1, 2, 3, 4, 5, 6, 7, 8, 9, 10, 11, 12, 13, 14, 15, 0, 1, 2, 3, 4, 5, 6, 7, 0, 1, 2, 3, 4, 0, 1, 2, 3, 0, 1, 2, 0, 1, 0, 1, 0, 1, 0, 0, 0, 0, 0, 0, 0, 0};
#pragma unroll
                for (int q = 0; q < 25; ++q) {
                    const float s0 = __uint_as_float(__float_as_uint(L0[PA[2 * q]]) & ~0x7fu) + __uint_as_float(__float_as_uint(L1[PB[2 * q]]) & ~0x7fu);
                    const float s1 = __uint_as_float(__float_as_uint(L0[PA[2 * q + 1]]) & ~0x7fu) + __uint_as_float(__float_as_uint(L1[PB[2 * q + 1]]) & ~0x7fu);
                    const float p0 = __uint_as_float((__float_as_uint(s0) & ~0xffu) | (unsigned)(PA[2 * q] * 16 + PB[2 * q]));
                    const float p1 = __uint_as_float((__float_as_uint(s1) & ~0xffu) | (unsigned)(PA[2 * q + 1] * 16 + PB[2 * q + 1]));
                    c[q] = h ? p1 : p0;
                }
#pragma unroll
                for (int i = 25; i < 32; ++i) c[i] = -3.0e38f;
            }
            bitonic_sort_desc<32>(c);
            float t16[16];
#pragma unroll
            for (int i = 0; i < 16; ++i) t16[i] = c[i];
            xlane_merge16(t16);
            const float mx = __uint_as_float(__float_as_uint(t16[0]) & ~0xffu);
            float e[16], sum = 0.f;
#pragma unroll
            for (int j = 0; j < 16; ++j) { e[j] = __expf(__uint_as_float(__float_as_uint(t16[j]) & ~0xffu) - mx); sum += e[j]; }
            const float inv = 1.0f / sum;
            uint2* dst = EX + ((size_t)tok * 8 + hd) * 16 + 8 * h;
#pragma unroll
            for (int j = 0; j < 8; ++j) {
                float tlo = t16[j], thi = t16[8 + j], elo = e[j], ehi = e[8 + j];
                asm volatile("" : "+v"(tlo), "+v"(thi), "+v"(elo), "+v"(ehi));
                const float tv = h ? thi : tlo, ev = h ? ehi : elo;
                const unsigned ab = __float_as_uint(tv) & 0xffu;
                const unsigned eid = (unsigned)lut[ab >> 4] * 128u + (unsigned)lut[16 + (ab & 15u)];
                dst[j] = make_uint2(eid | (((__float_as_uint(SU[eid]) >> 23) & 0xffu) << 16), __float_as_uint(ev * inv * SV[eid]));
            }
        }
    }
}

DI float dot16_fp8(const u32x4 w, const f32x2 (&h)[8]) {
    f32x2 acc = __builtin_amdgcn_cvt_pk_f32_fp8((int)w.x, false) * h[0];
    acc += __builtin_amdgcn_cvt_pk_f32_fp8((int)w.x, true) * h[1];
    acc += __builtin_amdgcn_cvt_pk_f32_fp8((int)w.y, false) * h[2];
    acc += __builtin_amdgcn_cvt_pk_f32_fp8((int)w.y, true) * h[3];
    acc += __builtin_amdgcn_cvt_pk_f32_fp8((int)w.z, false) * h[4];
    acc += __builtin_amdgcn_cvt_pk_f32_fp8((int)w.z, true) * h[5];
    acc += __builtin_amdgcn_cvt_pk_f32_fp8((int)w.w, false) * h[6];
    acc += __builtin_amdgcn_cvt_pk_f32_fp8((int)w.w, true) * h[7];
    return acc.x + acc.y;
}
DI void axpy16_fp8(const float a, const u32x4 w, f32x2 (&o)[8]) {
    const f32x2 aa = {a, a};
    o[0] += aa * __builtin_amdgcn_cvt_pk_f32_fp8((int)w.x, false); o[1] += aa * __builtin_amdgcn_cvt_pk_f32_fp8((int)w.x, true);
    o[2] += aa * __builtin_amdgcn_cvt_pk_f32_fp8((int)w.y, false); o[3] += aa * __builtin_amdgcn_cvt_pk_f32_fp8((int)w.y, true);
    o[4] += aa * __builtin_amdgcn_cvt_pk_f32_fp8((int)w.z, false); o[5] += aa * __builtin_amdgcn_cvt_pk_f32_fp8((int)w.z, true);
    o[6] += aa * __builtin_amdgcn_cvt_pk_f32_fp8((int)w.w, false); o[7] += aa * __builtin_amdgcn_cvt_pk_f32_fp8((int)w.w, true);
}
DI float butterfly64(float (&pz)[64], const int lane) {
    const bool b5 = lane & 32, b4 = lane & 16, b3 = lane & 8, b2 = lane & 4, b1 = lane & 2, b0 = lane & 1;
    float q32[32], q16[16], q8[8], q4[4], q2[2];
#pragma unroll
    for (int j = 0; j < 32; ++j) q32[j] = (b5 ? pz[32 + j] : pz[j]) + __shfl_xor(b5 ? pz[j] : pz[32 + j], 32);
#pragma unroll
    for (int j = 0; j < 16; ++j) q16[j] = (b4 ? q32[16 + j] : q32[j]) + __shfl_xor(b4 ? q32[j] : q32[16 + j], 16);
#pragma unroll
    for (int j = 0; j < 8; ++j) q8[j] = (b3 ? q16[8 + j] : q16[j]) + __shfl_xor(b3 ? q16[j] : q16[8 + j], 8);
#pragma unroll
    for (int j = 0; j < 4; ++j) q4[j] = (b2 ? q8[4 + j] : q8[j]) + __shfl_xor(b2 ? q8[j] : q8[4 + j], 4);
#pragma unroll
    for (int j = 0; j < 2; ++j) q2[j] = (b1 ? q4[2 + j] : q4[j]) + __shfl_xor(b1 ? q4[j] : q4[2 + j], 2);
    return (b0 ? q2[1] : q2[0]) + __shfl_xor(b0 ? q2[0] : q2[1], 1);
}
DI void phase_gather(const Params& p, int bid, int nb) {
    const float* mod = (const float*)(p.ws + OFF_MOD);
    const uint2* EX = (const uint2*)(p.ws + OFF_EXPS);
    const unsigned char* UT = (const unsigned char*)(p.ws + OFF_UT);
    const unsigned char* VT = (const unsigned char*)(p.ws + OFF_VT);
    const int lane = my_tid() & 63, wid = my_tid() >> 6;
    for (int tok = bid * 8 + wid; tok < NTOK; tok += nb * 8) {
        const int b = tok / SEQ, c0 = lane * 16;
        float* row = p.out + (size_t)tok * DM + c0;
        const float* sh2 = mod + b * 6144 + 3072 + c0;
        const float* sc2 = mod + b * 6144 + 4096 + c0;
        const float* g2 = mod + b * 6144 + 5120 + c0;
        f32x2 x1[8], h2[8], acc[8];
#pragma unroll
        for (int q = 0; q < 4; ++q) {
            const f32x4 xv = *(const f32x4*)(row + q * 4), sc = *(const f32x4*)(sc2 + q * 4), sh = *(const f32x4*)(sh2 + q * 4);
            x1[2 * q] = (f32x2){xv.x, xv.y}; x1[2 * q + 1] = (f32x2){xv.z, xv.w};
            h2[2 * q] = (f32x2){xv.x * (1.f + sc.x) + sh.x, xv.y * (1.f + sc.y) + sh.y};
            h2[2 * q + 1] = (f32x2){xv.z * (1.f + sc.z) + sh.z, xv.w * (1.f + sc.w) + sh.w};
        }
#pragma unroll
        for (int i = 0; i < 8; ++i) acc[i] = (f32x2){0.f, 0.f};
        const uint2 e0 = EX[(size_t)tok * 128 + lane], e1 = EX[(size_t)tok * 128 + 64 + lane];
        float a0, a1;
        {
            float pz[64];
#pragma unroll
            for (int e = 0; e < 64; ++e) {
                const unsigned eid = (unsigned)__builtin_amdgcn_readlane((int)e0.x, e) & 0xffffu;
                pz[e] = dot16_fp8(*(const u32x4*)(UT + (size_t)eid * DM + c0), h2);
            }
            const float z = butterfly64(pz, lane) * __uint_as_float(((e0.x >> 16) & 0xffu) << 23);
            a0 = geluf_(z) * __uint_as_float(e0.y);
        }
        {
            float pz[64];
#pragma unroll
            for (int e = 0; e < 64; ++e) {
                const unsigned eid = (unsigned)__builtin_amdgcn_readlane((int)e1.x, e) & 0xffffu;
                pz[e] = dot16_fp8(*(const u32x4*)(UT + (size_t)eid * DM + c0), h2);
            }
            const float z = butterfly64(pz, lane) * __uint_as_float(((e1.x >> 16) & 0xffu) << 23);
            a1 = geluf_(z) * __uint_as_float(e1.y);
        }
#pragma unroll 16
        for (int e = 0; e < 64; ++e) {
            const unsigned eid = (unsigned)__builtin_amdgcn_readlane((int)e0.x, e) & 0xffffu;
            const float a = __uint_as_float(__builtin_amdgcn_readlane((int)__float_as_uint(a0), e));
            axpy16_fp8(a, *(const u32x4*)(VT + (size_t)eid * DM + c0), acc);
        }
#pragma unroll 16
        for (int e = 0; e < 64; ++e) {
            const unsigned eid = (unsigned)__builtin_amdgcn_readlane((int)e1.x, e) & 0xffffu;
            const float a = __uint_as_float(__builtin_amdgcn_readlane((int)__float_as_uint(a1), e));
            axpy16_fp8(a, *(const u32x4*)(VT + (size_t)eid * DM + c0), acc);
        }
        f32x2 r[8];
        float s = 0.f;
#pragma unroll
        for (int q = 0; q < 4; ++q) {
            const f32x4 gg = *(const f32x4*)(g2 + q * 4);
            r[2 * q] = DEEP_ALPHA * x1[2 * q] + (f32x2){1.f + gg.x, 1.f + gg.y} * acc[2 * q];
            r[2 * q + 1] = DEEP_ALPHA * x1[2 * q + 1] + (f32x2){1.f + gg.z, 1.f + gg.w} * acc[2 * q + 1];
            s += r[2 * q].x + r[2 * q].y + r[2 * q + 1].x + r[2 * q + 1].y;
        }
#pragma unroll
        for (int m = 1; m < 64; m <<= 1) s += __shfl_xor(s, m);
        const float mu = s * (1.0f / 1024.0f);
        float qq = 0.f;
#pragma unroll
        for (int i = 0; i < 8; ++i) { const f32x2 d = r[i] - mu; qq += d.x * d.x + d.y * d.y; }
#pragma unroll
        for (int m = 1; m < 64; m <<= 1) qq += __shfl_xor(qq, m);
        const float rstd = rsqrtf(qq * (1.0f / 1024.0f) + LN_EPS);
#pragma unroll
        for (int q = 0; q < 4; ++q) {
            const f32x4 w = *(const f32x4*)(p.ln2w + c0 + q * 4), bi = *(const f32x4*)(p.ln2b + c0 + q * 4);
            f32x4 ov;
            ov.x = (r[2 * q].x - mu) * rstd * w.x + bi.x; ov.y = (r[2 * q].y - mu) * rstd * w.y + bi.y;
            ov.z = (r[2 * q + 1].x - mu) * rstd * w.z + bi.z; ov.w = (r[2 * q + 1].y - mu) * rstd * w.w + bi.w;
            *(f32x4*)(row + q * 4) = ov;
        }
    }
}

#define XB_TMO      128
#define XB_XCNT(j)  (256  + 64 * (j))
#define XB_XSUB(j)  (1280 + 64 * (j))
#define XB_XGEN(j)  (2304 + 64 * (j))
#define XB_TOP      3328
#define XB_TOPGEN   3392
#define XCD_BAR_WORDS 3456
#define XB_SPIN_CAP (1u << 22)
#define LAS __attribute__((address_space(3)))
DI unsigned xb_ld(unsigned* p) { return __hip_atomic_load(p, __ATOMIC_RELAXED, __HIP_MEMORY_SCOPE_AGENT); }
DI unsigned xb_add(unsigned* p, unsigned v) { return __hip_atomic_fetch_add(p, v, __ATOMIC_RELAXED, __HIP_MEMORY_SCOPE_AGENT); }
DI unsigned xb_xcc_id() { return (unsigned)__builtin_amdgcn_s_getreg((3 << 11) | 20) & 0xFu; }
#define XB_SPIN(cond, bar) do { unsigned _sp = 0; while (cond) { __builtin_amdgcn_s_sleep(1); \
    if ((++_sp & 255u) == 0u) { if (xb_ld(&(bar)[XB_TMO])) break; if (_sp > XB_SPIN_CAP) { atomicAdd(&(bar)[XB_TMO], 1u); break; } } } } while (0)
struct XcdBarrier { unsigned* bar; unsigned x; volatile LAS unsigned* st; };
DI XcdBarrier xcd_barrier_post(unsigned* bar, volatile LAS unsigned* st) {
    XcdBarrier b; b.bar = bar; b.x = xb_xcc_id(); b.st = st;
    if (__builtin_amdgcn_workitem_id_x() == 0) (void)xb_add(&bar[XB_XCNT(b.x)], 1u);
    return b;
}
DI void xcd_barrier_complete(unsigned* bar, unsigned x, unsigned& nloc, unsigned& nx) {
    const unsigned G = gridDim.x * gridDim.y * gridDim.z;
    unsigned sum, cnt, mine, sp = 0u;
    for (;;) {
        sum = 0u; cnt = 0u; mine = 0u;
#pragma unroll
        for (unsigned j = 0; j < 16; ++j) { const unsigned c = xb_ld(&bar[XB_XCNT(j)]); sum += c; cnt += (c > 0u) ? 1u : 0u; mine = (j == x) ? c : mine; }
        if (sum == G) break;
        __builtin_amdgcn_s_sleep(1);
        if ((++sp & 255u) == 0u) { if (xb_ld(&bar[XB_TMO])) break; if (sp > XB_SPIN_CAP) { atomicAdd(&bar[XB_TMO], 1u); break; } }
    }
    nloc = mine > 0u ? mine : 1u; nx = cnt > 0u ? cnt : 1u;
}
DI void xcd_barrier(const XcdBarrier& b) {
    asm volatile("s_waitcnt vmcnt(0)" ::: "memory");
    __syncthreads();
    if (__builtin_amdgcn_workitem_id_x() == 0) {
        unsigned* bar = b.bar;
        __builtin_amdgcn_s_waitcnt(0);
        unsigned nloc = b.st[0], nx = b.st[1];
        if (nloc == 0u) { xcd_barrier_complete(bar, b.x, nloc, nx); b.st[0] = nloc; b.st[1] = nx; }
        const unsigned old = xb_add(&bar[XB_XSUB(b.x)], 1u);
        const unsigned gen = old / nloc;
        if (old + 1u == (gen + 1u) * nloc) {
            __builtin_amdgcn_fence(__ATOMIC_RELEASE, "agent");
            asm volatile("s_waitcnt vmcnt(0)" ::: "memory");
            const unsigned og = xb_add(&bar[XB_TOP], 1u);
            const unsigned tg = og / nx;
            if (og + 1u == (tg + 1u) * nx) xb_add(&bar[XB_TOPGEN], 1u);
            else XB_SPIN(xb_ld(&bar[XB_TOPGEN]) == tg, bar);
            __builtin_amdgcn_fence(__ATOMIC_ACQUIRE, "agent");
            xb_add(&bar[XB_XGEN(b.x)], 1u);
            asm volatile("s_waitcnt vmcnt(0)" ::: "memory");
        } else {
            XB_SPIN(xb_ld(&bar[XB_XGEN(b.x)]) == gen, bar);
            __builtin_amdgcn_fence(__ATOMIC_ACQUIRE, "agent");
            asm volatile("s_waitcnt vmcnt(0)" ::: "memory");
        }
    }
    __syncthreads();
}

__global__ void __launch_bounds__(NTH) k_mega(Params p) {
    __shared__ __attribute__((aligned(16))) char smem[SMEM_BYTES];
    volatile LAS unsigned* xst = (volatile LAS unsigned*)(smem + SMEM_BYTES - 16);
    if (__builtin_amdgcn_workitem_id_x() == 0) { xst[0] = 0u; xst[1] = 0u; }
    __syncthreads();
    const XcdBarrier xb = xcd_barrier_post((unsigned*)(p.ws + OFF_BAR), xst);
    const int bid = blockIdx.x, nb = gridDim.x;
#ifndef PROBE_MASK
#define PROBE_MASK 0
#endif
#define REP(bit) for (int rep_ = 0; rep_ < ((PROBE_MASK & (bit)) ? 2 : 1); ++rep_)
    REP(64) { phase_prep(p, bid, nb, smem);    xcd_barrier(xb); }
    REP(64) { phase_h(p, bid, nb);             xcd_barrier(xb); }
    REP(1)  { phase_proj(p, bid, nb, smem);    xcd_barrier(xb); }
    REP(2)  { phase_hgprep(p, bid, nb);        xcd_barrier(xb); }
    REP(2)  { phase_mix(p, bid, nb, smem);     xcd_barrier(xb); }
    REP(4)  { phase_glu(p, bid, nb, smem);     xcd_barrier(xb); }
    REP(4)  { phase_a2(p, bid, nb);            xcd_barrier(xb); }
    REP(4)  { phase_outproj(p, bid, nb, smem); xcd_barrier(xb); }
    phase_ln1(p, bid, nb);           xcd_barrier(xb);
    REP(8)  { phase_q(p, bid, nb, smem);       xcd_barrier(xb); }
    REP(16) { phase_retrieve(p, bid, nb, smem); xcd_barrier(xb); }
    phase_gather(p, bid, nb);
}

extern "C" void kernel_launch(void* const* d_in, const int* in_sizes, int n_in, void* d_out, int out_size, void* d_ws, size_t ws_size, hipStream_t stream) {
    if (n_in != 27 || ws_size < WS_END) { fprintf(stderr, "kernel_launch: unexpected n_in %d or ws_size %zu (< %zu)\n", n_in, ws_size, (size_t)WS_END); return; }
    static int grid_blocks = 0;
    if (!grid_blocks) {
        int dev = 0, cus = 0, per_cu = 0;
        (void)hipGetDevice(&dev);
        (void)hipDeviceGetAttribute(&cus, hipDeviceAttributeMultiprocessorCount, dev);
        (void)hipOccupancyMaxActiveBlocksPerMultiprocessor(&per_cu, k_mega, NTH, 0);
        if (cus <= 0) cus = 256;
        if (per_cu < 1) { fprintf(stderr, "kernel_launch: occupancy query says %d blocks/CU\n", per_cu); per_cu = 1; }
        grid_blocks = cus;
    }
    Params p{};
    const float** f = (const float**)&p;
    for (int i = 0; i < 27; ++i) f[i] = (const float*)d_in[i];
    p.out = (float*)d_out; p.ws = (char*)d_ws;
    hipError_t e = hipMemsetAsync((char*)d_ws + OFF_BAR, 0, (size_t)3456 * 4, stream);
    if (e == hipSuccess) { hipLaunchKernelGGL(k_mega, dim3(grid_blocks), dim3(NTH), 0, stream, p); e = hipPeekAtLastError(); }
    if (e != hipSuccess) fprintf(stderr, "launch failed: %s (grid %d)\n", hipGetErrorString(e), grid_blocks);
}
```

```cpp
#include <hip/hip_runtime.h>
#include <hip/hip_cooperative_groups.h>
#include <stdint.h>
#include <stdio.h>

namespace cg = cooperative_groups;
#define DI __device__ __forceinline__
typedef unsigned short bf16_t;
typedef short bf16x8 __attribute__((ext_vector_type(8)));
typedef float f32x16 __attribute__((ext_vector_type(16)));
typedef unsigned u32x4 __attribute__((ext_vector_type(4)));
typedef float f32x4 __attribute__((ext_vector_type(4)));
typedef float f32x2 __attribute__((ext_vector_type(2)));

constexpr int NTH = 512;
constexpr int NB = 16, SEQ = 2048, DM = 1024, NTOK = NB * SEQ;
constexpr int DHG = 512, HGH = 4, HDK = 128;
constexpr int DSS = 512, SSG = 32, SSC = 16, SSP = 64;
constexpr int INC = 2560;
constexpr int PHEADS = 8, NKEYS = 128, TOPK = 16, NEXP = 16384;
constexpr float DEEP_ALPHA = 1.189207115002721f;
constexpr float LN_EPS = 1e-5f, RMS_EPS = 1e-6f;
constexpr int SMEM_BYTES = 128 * 1024 + 256;

constexpr size_t al256(size_t x) { return (x + 255) & ~(size_t)255; }
constexpr size_t OFF_MOD = 0;
constexpr size_t OFF_LB = al256(OFF_MOD + (size_t)NB * 6144 * 4);
constexpr size_t OFF_LAM = al256(OFF_LB + 512 * 4);
constexpr size_t OFF_BB = al256(OFF_LAM + 32 * 64 * 2 * 4);
constexpr size_t OFF_WIN = al256(OFF_BB + 32 * 64 * 16 * 2 * 4);
constexpr size_t OFF_GLU = al256(OFF_WIN + (size_t)INC * DM * 2);
constexpr size_t OFF_WOUT = al256(OFF_GLU + (size_t)512 * 512 * 2);
constexpr size_t OFF_WQ = al256(OFF_WOUT + (size_t)DM * DM * 2);
constexpr size_t OFF_SUBK = al256(OFF_WQ + (size_t)2048 * DM * 2);
constexpr size_t OFF_SU = al256(OFF_SUBK + (size_t)16 * 128 * 128 * 2);
constexpr size_t OFF_SV = al256(OFF_SU + (size_t)NEXP * 4);
constexpr size_t OFF_UT = al256(OFF_SV + (size_t)NEXP * 4);
constexpr size_t OFF_VT = al256(OFF_UT + (size_t)NEXP * DM * 2);
constexpr size_t OFF_H = al256(OFF_VT + (size_t)NEXP * DM * 2);
constexpr size_t OFF_PROJ = al256(OFF_H + (size_t)NTOK * DM * 2);
constexpr size_t OFF_ORAW = al256(OFF_PROJ + (size_t)NTOK * INC * 2);
constexpr size_t OFF_YSSM = al256(OFF_ORAW + (size_t)NTOK * DHG * 4);
constexpr size_t OFF_A2 = al256(OFF_YSSM + (size_t)NTOK * DSS * 2);
constexpr size_t OFF_HG = al256(OFF_A2 + (size_t)NTOK * DM * 2);
constexpr size_t OFF_S5K = al256(OFF_HG + (size_t)4096 * 128 * 4);
constexpr size_t OFF_S5N = al256(OFF_S5K + (size_t)32 * 4096 * 2);
constexpr size_t OFF_S5M = al256(OFF_S5N + (size_t)32 * 128 * 256 * 2);
constexpr size_t OFF_S5L = al256(OFF_S5M + (size_t)32 * 256 * 128 * 2);
constexpr size_t OFF_BAR = al256(OFF_S5L + (size_t)32 * 64 * 2 * 4);
constexpr size_t WS_END = al256(OFF_BAR + (size_t)3456 * 4);
constexpr size_t OFF_HQ = OFF_H, OFF_HK = OFF_H + (size_t)NTOK * DHG * 2, OFF_HKT = OFF_A2, OFF_HVT = OFF_A2 + (size_t)NTOK * DHG * 2;
constexpr size_t OFF_TOPL = OFF_ORAW;
constexpr size_t OFF_EXPS = OFF_ORAW + (size_t)NTOK * 16 * 16 * 4;

struct Params {
    const float *x, *c, *ada_w, *ada_b, *w_in, *hg_lb, *hg_nw, *a_re, *a_im, *log_dt, *b_re, *b_im, *c_re, *c_im, *dsk,
        *glu_w, *glu_b, *ssm_nw, *w_out, *ln1w, *ln1b, *w_q, *subk, *pu, *pv, *ln2w, *ln2b;
    float* out;
    char* ws;
};

DI int my_tid() { int t = (int)__builtin_amdgcn_workitem_id_x(); asm volatile("" : "+v"(t)); return t; }
DI bf16_t f2bf(float x) { unsigned u = __float_as_uint(x); u += 0x7fffu + ((u >> 16) & 1u); return (bf16_t)(u >> 16); }
DI float bf2f(bf16_t b) { return __uint_as_float(((unsigned)b) << 16); }
DI float bflo(unsigned w) { return __uint_as_float(w << 16); }
DI float bfhi(unsigned w) { return __uint_as_float(w & 0xffff0000u); }
typedef __bf16 hwbf16x2 __attribute__((ext_vector_type(2)));
DI unsigned pack2(float a, float b) { const f32x2 v = {a, b}; return __builtin_bit_cast(unsigned, __builtin_convertvector(v, hwbf16x2)); }
DI bf16x8 pack8(const f32x16& x, const int base) {
    u32x4 o; o.x = pack2(x[base], x[base + 1]); o.y = pack2(x[base + 2], x[base + 3]); o.z = pack2(x[base + 4], x[base + 5]); o.w = pack2(x[base + 6], x[base + 7]);
    return __builtin_bit_cast(bf16x8, o);
}
DI float sigmoidf_(float x) { return 1.0f / (1.0f + __expf(-x)); }
DI float siluf_(float x) { return x * sigmoidf_(x); }
DI float geluf_(float x) { return 0.5f * x * (1.0f + erff(x * 0.70710678118654752f)); }
DI float gelu_as(float v) {
    const float t = __builtin_amdgcn_rcpf(fabsf(v) * 0.2316418882f + 1.0f);
    float q = t * 0.5307027145f + (-0.7265760135f); q = q * t + 0.7107068705f; q = q * t + (-0.142248368f); q = q * t + 0.127414796f; q = q * t;
    const float m = v * (q * __builtin_amdgcn_exp2f(v * v * (-0.72134752044f)));
    return v < 0.f ? m : v - m;
}

template <int MT, int NT_, int WM, int WN, class Epi>
DI void gemm_block(const bf16_t* __restrict__ A, int lda, const bf16_t* __restrict__ Bt, int ldb, int K, char* smem, Epi epi) {
    constexpr int BM = WM * MT * 32, BN = WN * NT_ * 32, LS = 72;
    static_assert(WM * WN == 8, "8 waves");
    bf16_t* As = (bf16_t*)smem;
    bf16_t* Bs = As + BM * LS;
    const int tid = my_tid(), lane = tid & 63, wid = tid >> 6, r = lane & 31, h = lane >> 5;
    const int wm = wid / WN, wn = wid % WN;
    constexpr int PA = BM * 8 / NTH, PB = BN * 8 / NTH;
    u32x4 ra[PA], rb[PB];
    f32x16 acc[MT][NT_];
#pragma unroll
    for (int mi = 0; mi < MT; ++mi)
#pragma unroll
        for (int ni = 0; ni < NT_; ++ni)
#pragma unroll
            for (int i = 0; i < 16; ++i) acc[mi][ni][i] = 0.f;
#define GEMM_GLOAD(kt_) { \
    _Pragma("unroll") for (int q = 0; q < PA; ++q) { const int idx = tid + q * NTH, row = idx >> 3, ch = idx & 7; ra[q] = *(const u32x4*)(A + (size_t)row * lda + (kt_) * 64 + ch * 8); } \
    _Pragma("unroll") for (int q = 0; q < PB; ++q) { const int idx = tid + q * NTH, row = idx >> 3, ch = idx & 7; rb[q] = *(const u32x4*)(Bt + (size_t)row * ldb + (kt_) * 64 + ch * 8); } }
#define GEMM_LSTORE() { \
    _Pragma("unroll") for (int q = 0; q < PA; ++q) { const int idx = tid + q * NTH, row = idx >> 3, ch = idx & 7; *(u32x4*)(As + row * LS + ch * 8) = ra[q]; } \
    _Pragma("unroll") for (int q = 0; q < PB; ++q) { const int idx = tid + q * NTH, row = idx >> 3, ch = idx & 7; *(u32x4*)(Bs + row * LS + ch * 8) = rb[q]; } }
    GEMM_GLOAD(0); GEMM_LSTORE(); __syncthreads();
    const int nk = K / 64;
    for (int kt = 0; kt < nk; ++kt) {
        if (kt + 1 < nk) GEMM_GLOAD(kt + 1);
#pragma unroll
        for (int ks = 0; ks < 4; ++ks) {
            bf16x8 a[MT], b[NT_];
#pragma unroll
            for (int mi = 0; mi < MT; ++mi) a[mi] = *(const bf16x8*)(As + (wm * MT * 32 + mi * 32 + r) * LS + ks * 16 + h * 8);
#pragma unroll
            for (int ni = 0; ni < NT_; ++ni) b[ni] = *(const bf16x8*)(Bs + (wn * NT_ * 32 + ni * 32 + r) * LS + ks * 16 + h * 8);
#pragma unroll
            for (int mi = 0; mi < MT; ++mi)
#pragma unroll
                for (int ni = 0; ni < NT_; ++ni) acc[mi][ni] = __builtin_amdgcn_mfma_f32_32x32x16_bf16(a[mi], b[ni], acc[mi][ni], 0, 0, 0);
        }
        __syncthreads();
        if (kt + 1 < nk) { GEMM_LSTORE(); __syncthreads(); }
    }
#pragma unroll
    for (int mi = 0; mi < MT; ++mi)
#pragma unroll
        for (int ni = 0; ni < NT_; ++ni)
#pragma unroll
            for (int i = 0; i < 16; ++i) epi(wm * MT * 32 + mi * 32 + (i & 3) + 8 * (i >> 2) + 4 * h, wn * NT_ * 32 + ni * 32 + r, acc[mi][ni][i]);
}

namespace pg8 {
#define PG8_LAS __attribute__((address_space(3)))
typedef unsigned short bf16_t;
typedef short bf16x8 __attribute__((ext_vector_type(8)));
typedef float f32x4 __attribute__((ext_vector_type(4)));
typedef unsigned u32x4 __attribute__((ext_vector_type(4)));
constexpr int BM = 256, BK = 64, HALF = 128, HTB = HALF * BK * 2  , STAGE_BYTES = 8 * HTB, NXCD = 8, WGM = 8;

__host__ __device__ __forceinline__ int lds_byte(int r, int c) { const int st = (r >> 4) * 2 + (c >> 5), rr = r & 15, cc = c & 31, ob = rr * 64 + cc * 2; return st * 1024 + (ob ^ (((ob >> 9) & 1) << 5)); }
__host__ __device__ __forceinline__ void stage_rc(int b, int& R, int& C) { const int st = b / 1024, sb = b % 1024, swz = sb ^ (((sb >> 9) & 1) << 5); R = (st >> 1) * 16 + swz / 64; C = (st & 1) * 32 + (swz % 64) / 2; }
__host__ __device__ __forceinline__ int perm32(int rho) { const int n = rho >> 4, i = rho & 15; return 8 * (i >> 2) + 4 * n + (i & 3); }

struct Unit { int pm, pn; };
struct Gemm { const bf16_t* A; const bf16_t* Bt; int M, N, K; };

struct StaticOrder {
    int nM, nN, nwg, G, c;
    __host__ __device__ void init(int M, int N, int G_, int c_) { nM = M / BM; nN = N / BM; nwg = nM * nN; G = G_; c = c_; }
    __host__ __device__ bool next(int i, Unit& u) const {
        const long L = (long)i * G + c; if (L >= nwg) return false;
        int wgid = (int)L; { const int q = nwg / NXCD, r = nwg % NXCD, xcd = wgid % NXCD, off = wgid / NXCD; wgid = (xcd < r ? xcd * (q + 1) : r * (q + 1) + (xcd - r) * q) + off; }
        const int nig = WGM * nN, gid = wgid / nig, fm = gid * WGM, gsz = (nM - fm) < WGM ? (nM - fm) : WGM;
        u.pm = fm + ((wgid % nig) % gsz); u.pn = (wgid % nig) / gsz; return true;
    }
    __device__ __forceinline__ void a_ready(const Unit&) const {}
    __device__ __forceinline__ void done(const Unit&) const {}
};
template <class Epi, class Sched, bool STAMP = false>
__device__ __forceinline__ void gemm_phase(PG8_LAS unsigned char* lds, const Gemm g, const Sched& S, const Epi& E, unsigned long long* stamps) {
    const int tid = (int)__builtin_amdgcn_workitem_id_x(), wid = __builtin_amdgcn_readfirstlane(tid >> 6), lane = tid & 63, wr = wid >> 2, wc = wid & 3, fr = lane & 15, fq = lane >> 4;
    const int K = g.K, nt = K / BK;
    int ts_lo = 0, ts_hi = 0, nts = 0; const unsigned long long rt_entry = STAMP ? (unsigned long long)wall_clock64() : 0ull;
#define PG8_STAMP() do { if (STAMP && wid == 0 && nts < 64) { const unsigned long long _c = (unsigned long long)clock64(); \
        ts_lo = (lane == nts) ? (int)(unsigned)_c : ts_lo; ts_hi = (lane == nts) ? (int)(unsigned)(_c >> 32) : ts_hi; ++nts; } } while (0)
    PG8_STAMP();
    unsigned voffA[2], voffB[2];
#pragma unroll
    for (int i = 0; i < 2; ++i) { int R, C; stage_rc(tid * 16 + i * 8192, R, C); const int Rb = Epi::PERM ? ((R & ~31) + perm32(R & 31)) : R;
        voffA[i] = (unsigned)(R * K + C) * 2u; voffB[i] = (unsigned)(Rb * K + C) * 2u; }
    const size_t kstep = (size_t)(BK * 2);
    const size_t hstep = (size_t)HALF * K * 2;
    const size_t tstep = 2 * hstep;
    const unsigned ldsw = (unsigned)wid * 1024u;
    const int aoff = lds_byte(wr * 64 + fr, fq * 8), boff = lds_byte(wc * 32 + fr, fq * 8);
#define PG8_SA(b, h) (((b) * 2 + (h)) * HTB)
#define PG8_SB(b, h) ((4 + (b) * 2 + (h)) * HTB)
#define PG8_STAGE(bufoff, gbase, voff) do { _Pragma("unroll") for (int _i = 0; _i < 2; ++_i) \
        __builtin_amdgcn_global_load_lds((const unsigned*)((const char*)(gbase) + (voff)[_i]), (PG8_LAS unsigned*)(lds + (bufoff) + ldsw + _i * 8192), 16, 0, 0); } while (0)
#define PG8_LDA(dst, b, h) do { _Pragma("unroll") for (int m = 0; m < 4; ++m) _Pragma("unroll") for (int k = 0; k < 2; ++k) dst[m][k] = *(const PG8_LAS bf16x8*)(lds + PG8_SA(b, h) + aoff + m * 2048 + k * 1024); } while (0)
#define PG8_LDB(dst, b, h) do { _Pragma("unroll") for (int n = 0; n < 2; ++n) _Pragma("unroll") for (int k = 0; k < 2; ++k) dst[n][k] = *(const PG8_LAS bf16x8*)(lds + PG8_SB(b, h) + boff + n * 2048 + k * 1024); } while (0)
#define PG8_MMA(ai, bj, At, Bt) do { __builtin_amdgcn_s_setprio(1); _Pragma("unroll") for (int m = 0; m < 4; ++m) _Pragma("unroll") for (int n = 0; n < 2; ++n) _Pragma("unroll") for (int k = 0; k < 2; ++k) \
        acc[ai][bj][m][n] = __builtin_amdgcn_mfma_f32_16x16x32_bf16(Bt[n][k], At[m][k], acc[ai][bj][m][n], 0, 0, 0); __builtin_amdgcn_s_setprio(0); } while (0)
#define PG8_WAIT_V(n) asm volatile("s_waitcnt vmcnt(" #n ")" ::: "memory")
#define PG8_WAIT_L(n) asm volatile("s_waitcnt lgkmcnt(" #n ")" ::: "memory")
#define PG8_BAR __builtin_amdgcn_s_barrier()
#define PG8_SCHED __builtin_amdgcn_sched_barrier(0)
    Unit cur, nxt; int ui = 0;
    if (!S.next(0, cur)) return;
    f32x4 acc[2][2][4][2];
#pragma unroll
    for (int a = 0; a < 2; ++a)
#pragma unroll
        for (int b = 0; b < 2; ++b)
#pragma unroll
            for (int m = 0; m < 4; ++m)
#pragma unroll
                for (int n = 0; n < 2; ++n) acc[a][b][m][n] = (f32x4){0.f, 0.f, 0.f, 0.f};
    bf16x8 At[4][2], B0[2][2], B1[2][2];
    const char* cA = (const char*)g.A + (size_t)cur.pm * tstep; const char* cB = (const char*)g.Bt + (size_t)cur.pn * tstep;
    S.a_ready(cur);
    PG8_STAGE(PG8_SB(0, 0), cB, voffB); PG8_STAGE(PG8_SA(0, 0), cA, voffA); PG8_STAGE(PG8_SB(0, 1), cB + hstep, voffB); PG8_STAGE(PG8_SA(0, 1), cA + hstep, voffA);
    if (wr == 1) PG8_BAR;
    PG8_WAIT_V(4); PG8_BAR;
    PG8_STAGE(PG8_SB(1, 0), cB + kstep, voffB); PG8_STAGE(PG8_SA(1, 0), cA + kstep, voffA); PG8_STAGE(PG8_SB(1, 1), cB + hstep + kstep, voffB);
    PG8_WAIT_V(6); PG8_BAR;
    PG8_STAMP();
    for (;;) {
        const bool has_next = S.next(ui + 1, nxt);
        const char* nA = has_next ? (const char*)g.A + (size_t)nxt.pm * tstep : cA; const char* nB = has_next ? (const char*)g.Bt + (size_t)nxt.pn * tstep : cB;
        for (int t = 0; t < nt; t += 2) {
            const bool last = (t == nt - 2);
            const char* a1 = cA + (size_t)(t + 1) * kstep;
            const char* a2 = last ? nA : cA + (size_t)(t + 2) * kstep; const char* b2 = last ? nB : cB + (size_t)(t + 2) * kstep;
            const char* a3 = a2 + kstep; const char* b3 = b2 + kstep;
            if (last && has_next) S.a_ready(nxt);
            PG8_LDB(B0, 0, 0); PG8_SCHED; PG8_LDA(At, 0, 0); PG8_STAGE(PG8_SA(1, 1), a1 + hstep, voffA);
            PG8_WAIT_L(8); PG8_BAR; PG8_WAIT_L(0); PG8_MMA(0, 0, At, B0); PG8_BAR; PG8_SCHED;
            PG8_LDB(B1, 0, 1); PG8_STAGE(PG8_SB(0, 0), b2, voffB);
            PG8_BAR; PG8_WAIT_L(0); PG8_MMA(0, 1, At, B1); PG8_BAR;
            PG8_LDA(At, 0, 1); PG8_STAGE(PG8_SA(0, 0), a2, voffA);
            PG8_BAR; PG8_WAIT_L(0); PG8_MMA(1, 0, At, B0); PG8_BAR; PG8_SCHED;
            PG8_STAGE(PG8_SB(0, 1), b2 + hstep, voffB);
            PG8_WAIT_V(6); PG8_BAR; PG8_MMA(1, 1, At, B1); PG8_BAR;
            PG8_LDB(B0, 1, 0); PG8_SCHED; PG8_LDA(At, 1, 0); PG8_STAGE(PG8_SA(0, 1), a2 + hstep, voffA);
            PG8_WAIT_L(8); PG8_BAR; PG8_WAIT_L(0); PG8_MMA(0, 0, At, B0); PG8_BAR; PG8_SCHED;
            PG8_LDB(B1, 1, 1); PG8_STAGE(PG8_SB(1, 0), b3, voffB);
            PG8_BAR; PG8_WAIT_L(0); PG8_MMA(0, 1, At, B1); PG8_BAR;
            PG8_LDA(At, 1, 1); PG8_STAGE(PG8_SA(1, 0), a3, voffA);
            PG8_BAR; PG8_WAIT_L(0); PG8_MMA(1, 0, At, B0); PG8_BAR; PG8_SCHED;
            PG8_STAGE(PG8_SB(1, 1), b3 + hstep, voffB);
            PG8_WAIT_V(6); PG8_BAR; PG8_MMA(1, 1, At, B1); PG8_BAR;
        }
        PG8_STAMP();
        if constexpr (!Epi::AFTER_DRAIN) { E(acc, cur, wr, wc, fr, fq); S.done(cur); }
        PG8_STAMP();
        if (!has_next) break;
#pragma unroll
        for (int a = 0; a < 2; ++a)
#pragma unroll
            for (int b = 0; b < 2; ++b)
#pragma unroll
                for (int m = 0; m < 4; ++m)
#pragma unroll
                    for (int n = 0; n < 2; ++n) acc[a][b][m][n] = (f32x4){0.f, 0.f, 0.f, 0.f};
        cur = nxt; cA = nA; cB = nB; ++ui;
    }
    PG8_WAIT_V(0);
    if (wr == 0) PG8_BAR;
    PG8_BAR;
    if constexpr (Epi::AFTER_DRAIN) { E.fused(acc, cur, wr, wc, fr, fq, lds, wid, lane); S.done(cur); }
    PG8_STAMP();
    if (STAMP && wid == 0) { stamps[lane] = lane < nts ? (((unsigned long long)(unsigned)ts_hi << 32) | (unsigned)ts_lo) : 0ull;
        if (lane == 62) stamps[62] = rt_entry; if (lane == 63) stamps[63] = (unsigned long long)wall_clock64(); }
#undef PG8_STAMP
#undef PG8_SA
#undef PG8_SB
#undef PG8_STAGE
#undef PG8_LDA
#undef PG8_LDB
#undef PG8_MMA
#undef PG8_WAIT_V
#undef PG8_WAIT_L
#undef PG8_BAR
#undef PG8_SCHED
}

__device__ __forceinline__ unsigned pk_bf16(float lo, float hi) { typedef float v2f __attribute__((ext_vector_type(2))); typedef __bf16 v2b __attribute__((ext_vector_type(2))); const v2f v = {lo, hi}; return __builtin_bit_cast(unsigned, __builtin_convertvector(v, v2b)); }
__device__ __forceinline__ float silu1(float x) { return x * __builtin_amdgcn_rcpf(1.0f + __expf(-x)); }
struct EpiBf16Act {
    static constexpr bool PERM = true, AFTER_DRAIN = false;
    bf16_t* O; int ldc; unsigned silu_mask;
    __device__ __forceinline__ void operator()(const f32x4 (&acc)[2][2][4][2], const Unit& u, int wr, int wc, int fr, int fq) const {
        const int row0 = u.pm * BM + wr * 64 + fr, col0 = u.pn * BM + wc * 32 + 8 * fq;
        const bool act = (silu_mask >> u.pn) & 1u;
#pragma unroll
        for (int ai = 0; ai < 2; ++ai)
#pragma unroll
            for (int m = 0; m < 4; ++m) { bf16_t* rowp = O + (size_t)(row0 + ai * HALF + m * 16) * ldc + col0;
#pragma unroll
                for (int bj = 0; bj < 2; ++bj) { f32x4 v0 = acc[ai][bj][m][0], v1 = acc[ai][bj][m][1];
                    if (act) {
#pragma unroll
                        for (int j = 0; j < 4; ++j) { v0[j] = silu1(v0[j]); v1[j] = silu1(v1[j]); } }
                    u32x4 w; w.x = pk_bf16(v0[0], v0[1]); w.y = pk_bf16(v0[2], v0[3]); w.z = pk_bf16(v1[0], v1[1]); w.w = pk_bf16(v1[2], v1[3]);
                    *(u32x4*)(rowp + bj * HALF) = w; } }
    }
};
struct EpiResid {
    static constexpr bool PERM = false, AFTER_DRAIN = false;
    float* C; const float* X; const float* mod_g;
    float alpha;
    __device__ __forceinline__ void operator()(const f32x4 (&acc)[2][2][4][2], const Unit& u, int wr, int wc, int fr, int fq) const {
        const int row0 = u.pm * BM + wr * 64 + fr, col0 = u.pn * BM + wc * 32 + 4 * fq;
        const float* gb = mod_g + (size_t)((u.pm * BM) / 2048) * 6144 + col0;
        f32x4 gv[2][2];
#pragma unroll
        for (int bj = 0; bj < 2; ++bj)
#pragma unroll
            for (int n = 0; n < 2; ++n) gv[bj][n] = *(const f32x4*)(gb + bj * HALF + n * 16) + 1.0f;
#pragma unroll
        for (int ai = 0; ai < 2; ++ai)
#pragma unroll
            for (int m = 0; m < 4; ++m) { const size_t ro = (size_t)(row0 + ai * HALF + m * 16) * 1024 + col0;
#pragma unroll
                for (int bj = 0; bj < 2; ++bj)
#pragma unroll
                    for (int n = 0; n < 2; ++n) { const f32x4 xv = *(const f32x4*)(X + ro + bj * HALF + n * 16); *(f32x4*)(C + ro + bj * HALF + n * 16) = alpha * xv + gv[bj][n] * acc[ai][bj][m][n]; } }
    }
};
struct EpiGlu {
    static constexpr bool PERM = false, AFTER_DRAIN = false;
    float* C; const bf16_t* Y; const float* bias;
    __device__ __forceinline__ void operator()(const f32x4 (&acc)[2][2][4][2], const Unit& u, int wr, int wc, int fr, int fq) const {
        const int row0 = u.pm * BM + wr * 64 + fr, col0 = u.pn * BM + wc * 32 + 4 * fq;
        f32x4 bv[2][2];
#pragma unroll
        for (int bj = 0; bj < 2; ++bj)
#pragma unroll
            for (int n = 0; n < 2; ++n) bv[bj][n] = *(const f32x4*)(bias + col0 + bj * HALF + n * 16);
#pragma unroll
        for (int ai = 0; ai < 2; ++ai)
#pragma unroll
            for (int m = 0; m < 4; ++m) { const size_t ro = (size_t)(row0 + ai * HALF + m * 16) * 512 + col0;
#pragma unroll
                for (int bj = 0; bj < 2; ++bj)
#pragma unroll
                    for (int n = 0; n < 2; ++n) {
                        const uint2 yw = *(const uint2*)(Y + ro + bj * HALF + n * 16);
                        const f32x4 z = acc[ai][bj][m][n] + bv[bj][n];
                        f32x4 o;
                        o[0] = __uint_as_float(yw.x << 16) * __builtin_amdgcn_rcpf(1.0f + __expf(-z[0])); o[1] = __uint_as_float(yw.x & 0xffff0000u) * __builtin_amdgcn_rcpf(1.0f + __expf(-z[1]));
                        o[2] = __uint_as_float(yw.y << 16) * __builtin_amdgcn_rcpf(1.0f + __expf(-z[2])); o[3] = __uint_as_float(yw.y & 0xffff0000u) * __builtin_amdgcn_rcpf(1.0f + __expf(-z[3]));
                        *(f32x4*)(C + ro + bj * HALF + n * 16) = o; } }
    }
};
}

DI void prep_mod_item(const Params& p, int item, char* smem) {
    float* cond = (float*)smem;
    const int tid = my_tid();
    for (int i = tid; i < NB * DM; i += NTH) cond[i] = siluf_(p.c[i]);
    __syncthreads();
    const int b = tid >> 5, col = item * 32 + (tid & 31);
    float acc = 0.f;
    const float* w = p.ada_w + col;
    const float* cb = cond + b * DM;
#pragma unroll 8
    for (int k = 0; k < DM; ++k) acc += cb[k] * w[(size_t)k * 6144];
    ((float*)(p.ws + OFF_MOD))[b * 6144 + col] = acc + p.ada_b[col];
    __syncthreads();
}
DI void prep_s5_gemm_item(const Params& p, int g, char* smem) {
    f32x2* pw = (f32x2*)smem;
    f32x2* bbL = pw + 17 * 64;
    f32x2* cL = bbL + 64 * 16;
    const int tid = my_tid();
    const float dt = expf(p.log_dt[g]);
#pragma unroll 1
    for (int idx = tid; idx < 17 * 64; idx += NTH) {
        const int j = idx >> 6, pp = idx & 63;
        const float ar = p.a_re[g * 64 + pp], ai = p.a_im[g * 64 + pp];
        const float mag = expf(ar * dt * (float)j), ang = ai * dt * (float)j;
        pw[idx] = (f32x2){mag * cosf(ang), mag * sinf(ang)};
    }
    for (int idx = tid; idx < 16 * 64; idx += NTH) { const int i = idx >> 6, pp = idx & 63; cL[idx] = (f32x2){p.c_re[(g * 16 + i) * 64 + pp], p.c_im[(g * 16 + i) * 64 + pp]}; }
    __syncthreads();
    for (int idx = tid; idx < 64 * 16; idx += NTH) {
        const int pp = idx >> 4, i = idx & 15;
        const float ar = p.a_re[g * 64 + pp], ai = p.a_im[g * 64 + pp];
        const f32x2 lam = pw[64 + pp];
        const float den = ar * ar + ai * ai, nr = lam.x - 1.0f, ni = lam.y;
        const float zr = (nr * ar + ni * ai) / den, zi = (ni * ar - nr * ai) / den;
        const float br = p.b_re[(g * 64 + pp) * 16 + i], bi = p.b_im[(g * 64 + pp) * 16 + i];
        bbL[idx] = (f32x2){zr * br - zi * bi, zr * bi + zi * br};
    }
    __syncthreads();
    bf16_t* NBg = (bf16_t*)(p.ws + OFF_S5N) + (size_t)g * 128 * 256;
#pragma unroll 1
    for (int ch = tid; ch < 128 * 256 / 8; ch += NTH) {
        const int pq = ch >> 5, t = (ch >> 1) & 15, i0 = (ch & 1) * 8, pp = pq & 63;
        const f32x2 w = pw[(15 - t) * 64 + pp];
        float v[8];
#pragma unroll
        for (int e = 0; e < 8; ++e) { const f32x2 bb = bbL[pp * 16 + i0 + e]; v[e] = pq < 64 ? (w.x * bb.x - w.y * bb.y) : (w.x * bb.y + w.y * bb.x); }
        u32x4 o; o.x = pack2(v[0], v[1]); o.y = pack2(v[2], v[3]); o.z = pack2(v[4], v[5]); o.w = pack2(v[6], v[7]);
        *(u32x4*)(NBg + (size_t)pq * 256 + t * 16 + i0) = o;
    }
    bf16_t* MBg = (bf16_t*)(p.ws + OFF_S5M) + (size_t)g * 256 * 128;
#pragma unroll 1
    for (int ch = tid; ch < 256 * 128 / 8; ch += NTH) {
        const int ti = ch >> 4, p0 = (ch & 15) * 8, tq = ti >> 4, iq = ti & 15;
        float v[8];
#pragma unroll
        for (int e = 0; e < 8; ++e) {
            const int pq = p0 + e, pp = pq & 63;
            const f32x2 c = cL[iq * 64 + pp], w = pw[(tq + 1) * 64 + pp];
            v[e] = pq < 64 ? (c.x * w.x - c.y * w.y) : -(c.x * w.y + c.y * w.x);
        }
        u32x4 o; o.x = pack2(v[0], v[1]); o.y = pack2(v[2], v[3]); o.z = pack2(v[4], v[5]); o.w = pack2(v[6], v[7]);
        *(u32x4*)(MBg + (size_t)ti * 128 + p0) = o;
    }
    bf16_t* KTg = (bf16_t*)(p.ws + OFF_S5K) + (size_t)g * 4096;
#pragma unroll 1
    for (int idx = tid; idx < 4096; idx += NTH) {
        const int lag = idx >> 8, iq = (idx >> 4) & 15, i = idx & 15;
        float acc = (lag == 0 && iq == i) ? p.dsk[g * 16 + iq] : 0.f;
#pragma unroll 4
        for (int pp = 0; pp < 64; ++pp) {
            const f32x2 c = cL[iq * 64 + pp], w = pw[lag * 64 + pp], bb = bbL[pp * 16 + i];
            const float mr = c.x * w.x - c.y * w.y, mi_ = c.x * w.y + c.y * w.x;
            acc += mr * bb.x - mi_ * bb.y;
        }
        KTg[idx] = f2bf(acc);
    }
    if (tid < 64) { float* L = (float*)(p.ws + OFF_S5L) + (g * 64 + tid) * 2; const f32x2 w = pw[16 * 64 + tid]; L[0] = w.x; L[1] = w.y; }
    __syncthreads();
}
DI void prep_s5_item(const Params& p, int g) {
    const int tid = my_tid();
    if (tid < SSP) {
        const int pi = g * SSP + tid;
        const float dt = expf(p.log_dt[g]);
        const float ar = p.a_re[pi], ai = p.a_im[pi];
        const float mag = expf(ar * dt);
        const float lr = mag * cosf(ai * dt), li = mag * sinf(ai * dt);
        const float den = ar * ar + ai * ai, nr = lr - 1.0f, ni = li;
        const float zr = (nr * ar + ni * ai) / den, zi = (ni * ar - nr * ai) / den;
        float* lam = (float*)(p.ws + OFF_LAM) + pi * 2;
        lam[0] = lr; lam[1] = li;
        float* bb = (float*)(p.ws + OFF_BB) + (size_t)pi * 32;
        for (int i = 0; i < SSC; ++i) {
            const float br = p.b_re[pi * SSC + i], bi = p.b_im[pi * SSC + i];
            bb[i * 2] = zr * br - zi * bi; bb[i * 2 + 1] = zr * bi + zi * br;
        }
    }
}
DI void prep_transpose_tile(const float* __restrict__ W, bf16_t* __restrict__ Wt, int K, int N, int kt, int nt, char* smem) {
    float* tile = (float*)smem;
    const int tid = my_tid();
#pragma unroll
    for (int q = 0; q < 2; ++q) {
        const int kk = (tid >> 4) + q * 32, c4 = (tid & 15) * 4;
        const float4 v = *(const float4*)(W + (size_t)(kt * 64 + kk) * N + nt * 64 + c4);
        tile[kk * 65 + c4] = v.x; tile[kk * 65 + c4 + 1] = v.y; tile[kk * 65 + c4 + 2] = v.z; tile[kk * 65 + c4 + 3] = v.w;
    }
    __syncthreads();
    const int n = tid >> 3, kc = tid & 7;
    uint4 o;
    o.x = pack2(tile[(kc * 8 + 0) * 65 + n], tile[(kc * 8 + 1) * 65 + n]);
    o.y = pack2(tile[(kc * 8 + 2) * 65 + n], tile[(kc * 8 + 3) * 65 + n]);
    o.z = pack2(tile[(kc * 8 + 4) * 65 + n], tile[(kc * 8 + 5) * 65 + n]);
    o.w = pack2(tile[(kc * 8 + 6) * 65 + n], tile[(kc * 8 + 7) * 65 + n]);
    *(uint4*)(Wt + (size_t)(nt * 64 + n) * K + kt * 64 + kc * 8) = o;
    __syncthreads();
}
DI void cvt_bf16_stream(const float* __restrict__ src, bf16_t* __restrict__ dst, size_t n8, int bid, int nb) {
    for (size_t i = (size_t)bid * NTH + my_tid(); i < n8; i += (size_t)nb * NTH) {
        const float4 a = *(const float4*)(src + i * 8), b = *(const float4*)(src + i * 8 + 4);
        uint4 o; o.x = pack2(a.x, a.y); o.y = pack2(a.z, a.w); o.z = pack2(b.x, b.y); o.w = pack2(b.z, b.w);
        *(uint4*)(dst + i * 8) = o;
    }
}
DI void cvt_fp8_rows(const float* __restrict__ src, unsigned char* __restrict__ dst, float* __restrict__ inv, int bid, int nb) {
    const int lane = my_tid() & 63, wid = my_tid() >> 6;
    for (int row = bid * 8 + wid; row < NEXP; row += nb * 8) {
        const float* sp = src + (size_t)row * DM + lane * 16;
        const f32x4 a = *(const f32x4*)sp, b = *(const f32x4*)(sp + 4), c = *(const f32x4*)(sp + 8), d = *(const f32x4*)(sp + 12);
        float m = fmaxf(fmaxf(fmaxf(fabsf(a.x), fabsf(a.y)), fmaxf(fabsf(a.z), fabsf(a.w))), fmaxf(fmaxf(fabsf(b.x), fabsf(b.y)), fmaxf(fabsf(b.z), fabsf(b.w))));
        m = fmaxf(m, fmaxf(fmaxf(fmaxf(fabsf(c.x), fabsf(c.y)), fmaxf(fabsf(c.z), fabsf(c.w))), fmaxf(fmaxf(fabsf(d.x), fabsf(d.y)), fmaxf(fabsf(d.z), fabsf(d.w)))));
#pragma unroll
        for (int s = 1; s < 64; s <<= 1) m = fmaxf(m, __shfl_xor(m, s));
        float sc = 1.f, isc = 1.f;
        if (m > 1e-30f) {
            int k = (int)floorf(log2f(448.0f / m));
            k = k < -60 ? -60 : (k > 60 ? 60 : k);
            sc = ldexpf(1.0f, k); isc = ldexpf(1.0f, -k);
            if (m * sc > 448.0f) { sc *= 0.5f; isc *= 2.0f; }
        }
        u32x4 o;
        int w;
        w = __builtin_amdgcn_cvt_pk_fp8_f32(a.x * sc, a.y * sc, 0, false); w = __builtin_amdgcn_cvt_pk_fp8_f32(a.z * sc, a.w * sc, w, true); o.x = (unsigned)w;
        w = __builtin_amdgcn_cvt_pk_fp8_f32(b.x * sc, b.y * sc, 0, false); w = __builtin_amdgcn_cvt_pk_fp8_f32(b.z * sc, b.w * sc, w, true); o.y = (unsigned)w;
        w = __builtin_amdgcn_cvt_pk_fp8_f32(c.x * sc, c.y * sc, 0, false); w = __builtin_amdgcn_cvt_pk_fp8_f32(c.z * sc, c.w * sc, w, true); o.z = (unsigned)w;
        w = __builtin_amdgcn_cvt_pk_fp8_f32(d.x * sc, d.y * sc, 0, false); w = __builtin_amdgcn_cvt_pk_fp8_f32(d.z * sc, d.w * sc, w, true); o.w = (unsigned)w;
        *(u32x4*)(dst + (size_t)row * DM + lane * 16) = o;
        if (lane == 0) inv[row] = isc;
    }
}
DI void phase_prep(const Params& p, int bid, int nb, char* smem) {
    constexpr int N_MOD = 192, N_LB = 1, N_S5 = 32, T_WIN = 16 * 40, T_GLU = 8 * 8, T_WOUT = 16 * 16, T_WQ = 16 * 32;
    constexpr int I_LB = N_MOD, I_S5 = I_LB + N_LB, I_WIN = I_S5 + N_S5, I_GLU = I_WIN + T_WIN, I_WOUT = I_GLU + T_GLU, I_WQ = I_WOUT + T_WOUT, I_END = I_WQ + T_WQ;
    for (int it = bid; it < I_END; it += nb) {
        if (it < N_MOD) prep_mod_item(p, it, smem);
        else if (it < I_S5) {
            const int j = my_tid();
            const float a0 = p.hg_lb[j], a1 = p.hg_lb[512 + j], m = fmaxf(a0, a1);
            const float e0 = expf(a0 - m), e1 = expf(a1 - m);
            ((float*)(p.ws + OFF_LB))[j] = e0 / (e0 + e1);
        } else if (it < I_WIN) { prep_s5_item(p, it - I_S5); prep_s5_gemm_item(p, it - I_S5, smem); }
        else if (it < I_GLU) { const int t = it - I_WIN; prep_transpose_tile(p.w_in, (bf16_t*)(p.ws + OFF_WIN), DM, INC, t / 40, t % 40, smem); }
        else if (it < I_WOUT) { const int t = it - I_GLU; prep_transpose_tile(p.glu_w, (bf16_t*)(p.ws + OFF_GLU), 512, 512, t / 8, t % 8, smem); }
        else if (it < I_WQ) { const int t = it - I_WOUT; prep_transpose_tile(p.w_out, (bf16_t*)(p.ws + OFF_WOUT), DM, DM, t / 16, t % 16, smem); }
        else { const int t = it - I_WQ; prep_transpose_tile(p.w_q, (bf16_t*)(p.ws + OFF_WQ), DM, 2048, t / 32, t % 32, smem); }
    }
    cvt_bf16_stream(p.subk, (bf16_t*)(p.ws + OFF_SUBK), (size_t)16 * 128 * 128 / 8, bid, nb);
    cvt_fp8_rows(p.pu, (unsigned char*)(p.ws + OFF_UT), (float*)(p.ws + OFF_SU), bid, nb);
    cvt_fp8_rows(p.pv, (unsigned char*)(p.ws + OFF_VT), (float*)(p.ws + OFF_SV), bid, nb);
}

DI void phase_h(const Params& p, int bid, int nb) {
    const float* mod = (const float*)(p.ws + OFF_MOD);
    bf16_t* H = (bf16_t*)(p.ws + OFF_H);
    const size_t n8 = (size_t)NTOK * DM / 8;
    for (size_t i = (size_t)bid * NTH + my_tid(); i < n8; i += (size_t)nb * NTH) {
        const int row = (int)(i >> 7), c0 = (int)(i & 127) * 8, b = row / SEQ;
        const float* sh = mod + b * 6144 + c0;
        const float* sc = sh + 1024;
        const float4 a = *(const float4*)(p.x + i * 8), bq = *(const float4*)(p.x + i * 8 + 4);
        const float4 s0 = *(const float4*)sc, s1 = *(const float4*)(sc + 4), h0 = *(const float4*)sh, h1 = *(const float4*)(sh + 4);
        uint4 o;
        o.x = pack2(a.x * (1.f + s0.x) + h0.x, a.y * (1.f + s0.y) + h0.y);
        o.y = pack2(a.z * (1.f + s0.z) + h0.z, a.w * (1.f + s0.w) + h0.w);
        o.z = pack2(bq.x * (1.f + s1.x) + h1.x, bq.y * (1.f + s1.y) + h1.y);
        o.w = pack2(bq.z * (1.f + s1.z) + h1.z, bq.w * (1.f + s1.w) + h1.w);
        *(uint4*)(H + i * 8) = o;
    }
}

DI void phase_proj(const Params& p, int bid, int nb, char* smem) {
    pg8::Gemm g{(const bf16_t*)(p.ws + OFF_H), (const bf16_t*)(p.ws + OFF_WIN), NTOK, INC, DM};
    pg8::StaticOrder S; S.init(NTOK, INC, nb, bid);
    pg8::EpiBf16Act E{(bf16_t*)(p.ws + OFF_PROJ), INC, 0xC3u};
    pg8::gemm_phase<pg8::EpiBf16Act, pg8::StaticOrder, false>((PG8_LAS unsigned char*)smem, g, S, E, nullptr);
}

DI void hgrn_item(const Params& p, int item, char* smem) {
    const int vs = item & 7, hd = (item >> 3) & 3, b = item >> 5;
    const bf16_t* P = (const bf16_t*)(p.ws + OFF_PROJ);
    const float* lb = (const float*)(p.ws + OFF_LB) + hd * HDK;
    float* ORAW = (float*)(p.ws + OFF_ORAW);
    float* sq = (float*)smem;
    float* sf = sq + 32 * 128;
    float* sv = sf + 32 * 128;
    float* sp = sv + 32 * 16;
    const int tid = my_tid(), lane = tid & 63, wid = tid >> 6, kq = tid >> 4, v = tid & 15;
    float S0 = 0.f, S1 = 0.f, S2 = 0.f, S3 = 0.f;
    for (int t0 = 0; t0 < SEQ; t0 += 32) {
        for (int i = tid; i < 32 * 128; i += NTH) {
            const int t = i >> 7, k = i & 127;
            const bf16_t* row = P + (size_t)(b * SEQ + t0 + t) * INC + hd * HDK + k;
            sq[i] = bf2f(row[0]);
            const float l = lb[k];
            sf[i] = l + (1.0f - l) * sigmoidf_(bf2f(row[512]));
        }
        { const int t = tid >> 4; sv[tid] = bf2f(P[(size_t)(b * SEQ + t0 + t) * INC + 1024 + hd * HDK + vs * 16 + v]); }
        __syncthreads();
        for (int t = 0; t < 32; ++t) {
            const float4 f4 = *(const float4*)(sf + t * 128 + kq * 4), q4 = *(const float4*)(sq + t * 128 + kq * 4);
            const float vv = sv[t * 16 + v];
            S0 = f4.x * S0 + (1.0f - f4.x) * vv; S1 = f4.y * S1 + (1.0f - f4.y) * vv;
            S2 = f4.z * S2 + (1.0f - f4.z) * vv; S3 = f4.w * S3 + (1.0f - f4.w) * vv;
            float part = q4.x * S0 + q4.y * S1 + q4.z * S2 + q4.w * S3;
            part += __shfl_xor(part, 16); part += __shfl_xor(part, 32);
            if (lane < 16) sp[(t * 8 + wid) * 16 + v] = part;
        }
        __syncthreads();
        {
            const int t = tid >> 4;
            float o = 0.f;
#pragma unroll
            for (int w = 0; w < 8; ++w) o += sp[(t * 8 + w) * 16 + v];
            ORAW[(size_t)(b * SEQ + t0 + t) * DHG + hd * HDK + vs * 16 + v] = o;
        }
        __syncthreads();
    }
}
DI void s5_item(const Params& p, int item, char* smem) {
    const int oct = item & 3, b = item >> 2;
    const int tid = my_tid(), lane = tid & 63, wid = tid >> 6, g = oct * 8 + wid;
    const bf16_t* P = (const bf16_t*)(p.ws + OFF_PROJ);
    bf16_t* Y = (bf16_t*)(p.ws + OFF_YSSM);
    float* su = (float*)smem + wid * 64 * 16;
    const float* lam = (const float*)(p.ws + OFF_LAM) + (g * SSP + lane) * 2;
    const float lr = lam[0], li = lam[1];
    const float* bb = (const float*)(p.ws + OFF_BB) + (size_t)(g * SSP + lane) * 32;
    float bbr[16], bbi[16], cr[16], ci[16];
#pragma unroll
    for (int i = 0; i < 16; ++i) { bbr[i] = bb[2 * i]; bbi[i] = bb[2 * i + 1]; cr[i] = p.c_re[(g * SSC + i) * SSP + lane]; ci[i] = p.c_im[(g * SSC + i) * SSP + lane]; }
    const int ch = (lane >> 2) & 15;
    const float dch = p.dsk[g * SSC + ch];
    float xr = 0.f, xi = 0.f;
    for (int t0 = 0; t0 < SEQ; t0 += 64) {
        {
            const uint4* src = (const uint4*)(P + (size_t)(b * SEQ + t0 + lane) * INC + 2048 + g * SSC);
            const uint4 a = src[0], c = src[1];
            float* d = su + lane * 16;
            d[0] = bflo(a.x); d[1] = bfhi(a.x); d[2] = bflo(a.y); d[3] = bfhi(a.y); d[4] = bflo(a.z); d[5] = bfhi(a.z); d[6] = bflo(a.w); d[7] = bfhi(a.w);
            d[8] = bflo(c.x); d[9] = bfhi(c.x); d[10] = bflo(c.y); d[11] = bfhi(c.y); d[12] = bflo(c.z); d[13] = bfhi(c.z); d[14] = bflo(c.w); d[15] = bfhi(c.w);
        }
        __syncthreads();
        for (int t = 0; t < 64; ++t) {
            float u[16];
            const float4* us = (const float4*)(su + t * 16);
            const float4 u0 = us[0], u1 = us[1], u2 = us[2], u3 = us[3];
            u[0] = u0.x; u[1] = u0.y; u[2] = u0.z; u[3] = u0.w; u[4] = u1.x; u[5] = u1.y; u[6] = u1.z; u[7] = u1.w;
            u[8] = u2.x; u[9] = u2.y; u[10] = u2.z; u[11] = u2.w; u[12] = u3.x; u[13] = u3.y; u[14] = u3.z; u[15] = u3.w;
            float bur = 0.f, bui = 0.f;
#pragma unroll
            for (int i = 0; i < 16; ++i) { bur += bbr[i] * u[i]; bui += bbi[i] * u[i]; }
            const float nxr = lr * xr - li * xi + bur, nxi = lr * xi + li * xr + bui;
            xr = nxr; xi = nxi;
            float y[16];
#pragma unroll
            for (int i = 0; i < 16; ++i) y[i] = cr[i] * xr - ci[i] * xi;
            const bool b5 = lane & 32, b4 = lane & 16, b3 = lane & 8, b2 = lane & 4;
            float y8[8], y4[4], y2[2];
#pragma unroll
            for (int j = 0; j < 8; ++j) { const float keep = b5 ? y[8 + j] : y[j], send = b5 ? y[j] : y[8 + j]; y8[j] = keep + __shfl_xor(send, 32); }
#pragma unroll
            for (int j = 0; j < 4; ++j) { const float keep = b4 ? y8[4 + j] : y8[j], send = b4 ? y8[j] : y8[4 + j]; y4[j] = keep + __shfl_xor(send, 16); }
#pragma unroll
            for (int j = 0; j < 2; ++j) { const float keep = b3 ? y4[2 + j] : y4[j], send = b3 ? y4[j] : y4[2 + j]; y2[j] = keep + __shfl_xor(send, 8); }
            float y1;
            { const float keep = b2 ? y2[1] : y2[0], send = b2 ? y2[0] : y2[1]; y1 = keep + __shfl_xor(send, 4); }
            y1 += __shfl_xor(y1, 1); y1 += __shfl_xor(y1, 2);
            if ((lane & 3) == 0) {
                const float uu = su[t * 16 + ch];
                Y[(size_t)(b * SEQ + t0 + t) * DSS + g * SSC + ch] = f2bf(geluf_(y1 + dch * uu));
            }
        }
        __syncthreads();
    }
}
DI int crow(int i, int h) { return (i & 3) + 8 * (i >> 2) + 4 * h; }
DI void phase_hgprep(const Params& p, int bid, int nb) {
    const bf16_t* P = (const bf16_t*)(p.ws + OFF_PROJ);
    const float* lbp = (const float*)(p.ws + OFF_LB);
    const int tid = my_tid(), lane = tid & 63, wid = tid >> 6, tq = lane >> 4, cg = lane & 15;
#pragma unroll 1
    for (int it = bid * 8 + wid; it < 8192; it += nb * 8) {
        const int tile = it >> 1, c = tile & 63, hd = (tile >> 6) & 3, b = tile >> 8, k0 = (it & 1) * 64 + cg * 4;
        const bf16_t* base = P + (size_t)(b * SEQ + c * 32 + tq * 8) * INC + hd * HDK + k0;
        uint2 qw[8], fw[8];
#pragma unroll
        for (int tt = 0; tt < 8; ++tt) { qw[tt] = *(const uint2*)(base + (size_t)tt * INC); fw[tt] = *(const uint2*)(base + (size_t)tt * INC + 512); }
        const f32x4 l4 = *(const f32x4*)(lbp + hd * HDK + k0);
        const float lb4[4] = {l4.x, l4.y, l4.z, l4.w};
        float bl[8][4], kk[8][4], run[4];
#pragma unroll
        for (int e = 0; e < 4; ++e) run[e] = 0.f;
#pragma unroll
        for (int tt = 0; tt < 8; ++tt) {
            const float fl[4] = {bflo(fw[tt].x), bfhi(fw[tt].x), bflo(fw[tt].y), bfhi(fw[tt].y)};
#pragma unroll
            for (int e = 0; e < 4; ++e) {
                const float f = lb4[e] + (1.0f - lb4[e]) * sigmoidf_(fl[e]);
                run[e] += __logf(f); bl[tt][e] = run[e]; kk[tt][e] = 1.0f - f;
            }
        }
        float off[4], tot[4];
#pragma unroll
        for (int e = 0; e < 4; ++e) {
            const float t0 = __shfl(run[e], cg), t1 = __shfl(run[e], cg + 16), t2 = __shfl(run[e], cg + 32), t3 = __shfl(run[e], cg + 48);
            off[e] = (tq > 0 ? t0 : 0.f) + (tq > 1 ? t1 : 0.f) + (tq > 2 ? t2 : 0.f);
            tot[e] = (t0 + t1) + (t2 + t3);
        }
        bf16_t* HQ = (bf16_t*)(p.ws + OFF_HQ) + (size_t)tile * 4096 + (tq * 8) * 128 + k0;
        bf16_t* HK = (bf16_t*)(p.ws + OFF_HK) + (size_t)tile * 4096 + (tq * 8) * 128 + k0;
#pragma unroll
        for (int tt = 0; tt < 8; ++tt) {
            const float qv[4] = {bflo(qw[tt].x), bfhi(qw[tt].x), bflo(qw[tt].y), bfhi(qw[tt].y)};
            float qo[4], ko[4];
#pragma unroll
            for (int e = 0; e < 4; ++e) { const float bb = off[e] + bl[tt][e]; qo[e] = qv[e] * __expf(bb); ko[e] = kk[tt][e] * __expf(fminf(-bb, 80.0f)); }
            *(uint2*)(HQ + tt * 128) = make_uint2(pack2(qo[0], qo[1]), pack2(qo[2], qo[3]));
            *(uint2*)(HK + tt * 128) = make_uint2(pack2(ko[0], ko[1]), pack2(ko[2], ko[3]));
        }
        if (tq == 0) *(f32x4*)((float*)(p.ws + OFF_HG) + (size_t)tile * 128 + k0) = (f32x4){__expf(tot[0]), __expf(tot[1]), __expf(tot[2]), __expf(tot[3])};
    }
}
typedef short s16x4 __attribute__((ext_vector_type(4)));
DI bf16x8 cat8(const s16x4 lo, const s16x4 hi) { return (bf16x8){lo.x, lo.y, lo.z, lo.w, hi.x, hi.y, hi.z, hi.w}; }
DI s16x4 lds_tr(const char* a) { return __builtin_amdgcn_ds_read_tr16_b64_v4i16((__attribute__((address_space(3))) s16x4*)a); }
DI void hgrn_mfma_item(const Params& p, int item, char* smem) {
    constexpr int QP_OFF = 0, KP_OFF = 8704, V_OFF = 17408, G_OFF = 26112, BUF = 26624;
    const int tid = my_tid(), lane = tid & 63, wid = tid >> 6, r = lane & 31, h = lane >> 5;
    const int b = item >> 2, hd = item & 3;
    const size_t tile0 = (size_t)item * 64;
    const bf16_t* HQ = (const bf16_t*)(p.ws + OFF_HQ) + tile0 * 4096;
    const bf16_t* HK = (const bf16_t*)(p.ws + OFF_HK) + tile0 * 4096;
    const bf16_t* PV = (const bf16_t*)(p.ws + OFF_PROJ) + (size_t)b * SEQ * INC + 1024 + hd * HDK;
    const float* HG = (const float*)(p.ws + OFF_HG) + tile0 * 128;
    float* ORAW = (float*)(p.ws + OFF_ORAW) + (size_t)b * SEQ * DHG + hd * HDK;
    const bool helper = wid >= 4;
    const int ht = tid - 256;
    const int i0 = ht, i1 = ht + 256;
    const int lo0 = (i0 >> 4) * 272 + (i0 & 15) * 16, lo1 = (i1 >> 4) * 272 + (i1 & 15) * 16;
    u32x4 A0, A1, A2, A3, A4, A5, A6, B0, B1, B2, B3, B4, B5, B6;
    A0 = A1 = A2 = A3 = A4 = A5 = A6 = B0 = B1 = B2 = B3 = B4 = B5 = B6 = (u32x4){0, 0, 0, 0};
    f32x16 S[4];
#pragma unroll
    for (int kb = 0; kb < 4; ++kb)
#pragma unroll
        for (int i = 0; i < 16; ++i) S[kb][i] = 0.f;
#define HG_LOAD(X, c_) { const size_t o_ = (size_t)(c_) * 4096; \
        X##0 = *(const u32x4*)(HQ + o_ + i0 * 8); X##1 = *(const u32x4*)(HQ + o_ + i1 * 8); \
        X##2 = *(const u32x4*)(HK + o_ + i0 * 8); X##3 = *(const u32x4*)(HK + o_ + i1 * 8); \
        X##4 = *(const u32x4*)(PV + (size_t)((c_) * 32 + (i0 >> 4)) * INC + (i0 & 15) * 8); X##5 = *(const u32x4*)(PV + (size_t)((c_) * 32 + (i1 >> 4)) * INC + (i1 & 15) * 8); \
        if (ht < 32) X##6 = *(const u32x4*)(HG + (size_t)(c_) * 128 + ht * 4); }
#define HG_STORE(X, buf_) { char* B_ = smem + (buf_) * BUF; \
        *(u32x4*)(B_ + QP_OFF + lo0) = X##0; *(u32x4*)(B_ + QP_OFF + lo1) = X##1; \
        *(u32x4*)(B_ + KP_OFF + lo0) = X##2; *(u32x4*)(B_ + KP_OFF + lo1) = X##3; \
        *(u32x4*)(B_ + V_OFF + lo0) = X##4; *(u32x4*)(B_ + V_OFF + lo1) = X##5; \
        if (ht < 32) *(u32x4*)(B_ + G_OFF + ht * 16) = X##6; }
    const int tq = (lane >> 2) & 3, tp = lane & 3, tg = lane >> 4;
    const int tr_nat = (8 * (tg >> 1) + tq) * 272 + (16 * (tg & 1) + 4 * tp) * 2;
    const int tr_krw = (4 * (tg >> 1) + tq) * 272 + (16 * (tg & 1) + 4 * tp) * 2;
    if (helper) { HG_LOAD(A, 0); HG_STORE(A, 0); HG_LOAD(A, 1); HG_STORE(A, 1); HG_LOAD(A, 2); HG_LOAD(B, 3); }
    __syncthreads();
#define HG_COMPUTE(c_) { \
        const char* B = smem + ((c_) % 3) * BUF; const int w = wid; \
        f32x16 pt; _Pragma("unroll") for (int i = 0; i < 16; ++i) pt[i] = 0.f; \
        _Pragma("unroll") for (int ks = 0; ks < 8; ++ks) { \
            const bf16x8 a = *(const bf16x8*)(B + KP_OFF + r * 272 + ks * 32 + h * 16); \
            const bf16x8 bq = *(const bf16x8*)(B + QP_OFF + r * 272 + ks * 32 + h * 16); \
            pt = __builtin_amdgcn_mfma_f32_32x32x16_bf16(a, bq, pt, 0, 0, 0); } \
        _Pragma("unroll") for (int i = 0; i < 16; ++i) if (crow(i, h) > r) pt[i] = 0.f; \
        f32x16 o; _Pragma("unroll") for (int i = 0; i < 16; ++i) o[i] = 0.f; \
        _Pragma("unroll") for (int sp = 0; sp < 2; ++sp) { \
            const char* vb = B + V_OFF + (16 * sp) * 272 + (32 * w) * 2 + tr_krw; \
            const bf16x8 bv = cat8(lds_tr(vb), lds_tr(vb + 8 * 272)); \
            o = __builtin_amdgcn_mfma_f32_32x32x16_bf16(pack8(pt, 8 * sp), bv, o, 0, 0, 0); } \
        _Pragma("unroll") for (int kb = 0; kb < 4; ++kb) _Pragma("unroll") for (int sp = 0; sp < 2; ++sp) { \
            const char* qb = B + QP_OFF + r * 272 + kb * 64 + sp * 32 + h * 8; \
            const bf16x8 aq = cat8(*(const s16x4*)qb, *(const s16x4*)(qb + 16)); \
            o = __builtin_amdgcn_mfma_f32_32x32x16_bf16(aq, pack8(S[kb], 8 * sp), o, 0, 0, 0); } \
        _Pragma("unroll") for (int i = 0; i < 16; ++i) ORAW[(size_t)((c_) * 32 + crow(i, h)) * DHG + 32 * w + r] = o[i]; \
        bf16x8 bvn[2]; \
        _Pragma("unroll") for (int ks = 0; ks < 2; ++ks) { const char* vb = B + V_OFF + (16 * ks) * 272 + (32 * w) * 2 + tr_nat; bvn[ks] = cat8(lds_tr(vb), lds_tr(vb + 4 * 272)); } \
        _Pragma("unroll") for (int kb = 0; kb < 4; ++kb) { \
            _Pragma("unroll") for (int ks = 0; ks < 2; ++ks) { \
                const char* kp = B + KP_OFF + (16 * ks) * 272 + (32 * kb) * 2 + tr_nat; \
                const bf16x8 a = cat8(lds_tr(kp), lds_tr(kp + 4 * 272)); \
                S[kb] = __builtin_amdgcn_mfma_f32_32x32x16_bf16(a, bvn[ks], S[kb], 0, 0, 0); } \
            _Pragma("unroll") for (int j = 0; j < 4; ++j) { \
                const f32x4 g4 = *(const f32x4*)(B + G_OFF + (kb * 32 + 8 * j + 4 * h) * 4); \
                S[kb][4 * j] *= g4.x; S[kb][4 * j + 1] *= g4.y; S[kb][4 * j + 2] *= g4.z; S[kb][4 * j + 3] *= g4.w; } } }
    for (int c = 0; c < 64; c += 2) {
        if (helper) { if (c + 2 < 64) HG_STORE(A, (c + 2) % 3); if (c + 4 < 64) HG_LOAD(A, c + 4); } else HG_COMPUTE(c);
        __syncthreads();
        if (helper) { if (c + 3 < 64) HG_STORE(B, (c + 3) % 3); if (c + 5 < 64) HG_LOAD(B, c + 5); } else HG_COMPUTE(c + 1);
        __syncthreads();
    }
#undef HG_LOAD
#undef HG_STORE
#undef HG_COMPUTE
}
template <int NJ>
DI void s5_gemm2_tile(const bf16x8 (&af)[16], const bf16_t* KTl, const bf16_t* Xin, const bf16_t* MBg, bf16_t* Yout, const int mi, const int r, const int h) {
    f32x16 y;
#pragma unroll
    for (int i = 0; i < 16; ++i) y[i] = 0.f;
    const int tsel = r >> 4, iq = r & 15;
#pragma unroll
    for (int ks = 0; ks <= 2 * NJ; ++ks) {
        const bf16x8 bk = *(const bf16x8*)(KTl + ((2 * NJ + tsel - ks) * 16 + iq) * 16 + 8 * h);
        y = __builtin_amdgcn_mfma_f32_32x32x16_bf16(af[ks], bk, y, 0, 0, 0);
    }
    {
        bf16x8 bk = *(const bf16x8*)(KTl + iq * 16 + 8 * h);
        if (tsel == 0) bk = (bf16x8){0, 0, 0, 0, 0, 0, 0, 0};
        y = __builtin_amdgcn_mfma_f32_32x32x16_bf16(af[2 * NJ + 1], bk, y, 0, 0, 0);
    }
#pragma unroll
    for (int ks = 0; ks < 8; ++ks) {
        const bf16x8 a = *(const bf16x8*)(Xin + (mi * 32 + r) * 136 + ks * 16 + 8 * h);
        const bf16x8 bm = *(const bf16x8*)(MBg + (size_t)(NJ * 32 + r) * 128 + ks * 16 + 8 * h);
        y = __builtin_amdgcn_mfma_f32_32x32x16_bf16(a, bm, y, 0, 0, 0);
    }
#pragma unroll
    for (int i = 0; i < 16; ++i) Yout[(size_t)((mi * 32 + crow(i, h)) * 16 + 2 * NJ + tsel) * DSS + iq] = f2bf(gelu_as(y[i]));
}
DI void s5_gemm_item(const Params& p, int b, int g, char* smem) {
    float* E = (float*)smem;
    bf16_t* Xin = (bf16_t*)(smem + 128 * 132 * 4);
    bf16_t* KTl = Xin + 128 * 136;
    const int tid = my_tid(), lane = tid & 63, wid = tid >> 6, r = lane & 31, h = lane >> 5;
    const int mi = wid >> 1, wh = wid & 1;
    const bf16_t* P = (const bf16_t*)(p.ws + OFF_PROJ);
    *(u32x4*)(KTl + tid * 8) = *(const u32x4*)((const bf16_t*)(p.ws + OFF_S5K) + (size_t)g * 4096 + tid * 8);
    bf16x8 af[16];
    {
        const bf16_t* ub = P + (size_t)(b * SEQ + (mi * 32 + r) * 16) * INC + 2048 + g * 16 + 8 * h;
#pragma unroll
        for (int ks = 0; ks < 16; ++ks) af[ks] = *(const bf16x8*)(ub + (size_t)ks * INC);
    }
    {
        f32x16 e0, e1;
#pragma unroll
        for (int i = 0; i < 16; ++i) { e0[i] = 0.f; e1[i] = 0.f; }
        const bf16_t* nb0 = (const bf16_t*)(p.ws + OFF_S5N) + ((size_t)g * 128 + wh * 64 + r) * 256 + 8 * h;
#pragma unroll
        for (int ks = 0; ks < 16; ++ks) {
            const bf16x8 b0 = *(const bf16x8*)(nb0 + ks * 16), b1 = *(const bf16x8*)(nb0 + 32 * 256 + ks * 16);
            e0 = __builtin_amdgcn_mfma_f32_32x32x16_bf16(af[ks], b0, e0, 0, 0, 0);
            e1 = __builtin_amdgcn_mfma_f32_32x32x16_bf16(af[ks], b1, e1, 0, 0, 0);
        }
#pragma unroll
        for (int i = 0; i < 16; ++i) { float* er = E + (mi * 32 + crow(i, h)) * 132 + wh * 64 + r; er[0] = e0[i]; er[32] = e1[i]; }
    }
    __syncthreads();
    if (wid == 0) {
        const float* L = (const float*)(p.ws + OFF_S5L) + (g * 64 + lane) * 2;
        const float lr = L[0], li = L[1];
        float xr = 0.f, xi = 0.f;
#pragma unroll 8
        for (int c = 0; c < 128; ++c) {
            const float er = E[c * 132 + lane], ei = E[c * 132 + 64 + lane];
            Xin[c * 136 + lane] = f2bf(xr); Xin[c * 136 + 64 + lane] = f2bf(xi);
            const float nr = lr * xr - li * xi + er, ni = lr * xi + li * xr + ei;
            xr = nr; xi = ni;
        }
    }
    __syncthreads();
    const bf16_t* MBg = (const bf16_t*)(p.ws + OFF_S5M) + (size_t)g * 256 * 128;
    bf16_t* Yout = (bf16_t*)(p.ws + OFF_YSSM) + (size_t)b * SEQ * DSS + g * 16;
    if (wh) {
        s5_gemm2_tile<1>(af, KTl, Xin, MBg, Yout, mi, r, h); s5_gemm2_tile<6>(af, KTl, Xin, MBg, Yout, mi, r, h);
        s5_gemm2_tile<3>(af, KTl, Xin, MBg, Yout, mi, r, h); s5_gemm2_tile<4>(af, KTl, Xin, MBg, Yout, mi, r, h);
    } else {
        s5_gemm2_tile<0>(af, KTl, Xin, MBg, Yout, mi, r, h); s5_gemm2_tile<7>(af, KTl, Xin, MBg, Yout, mi, r, h);
        s5_gemm2_tile<2>(af, KTl, Xin, MBg, Yout, mi, r, h); s5_gemm2_tile<5>(af, KTl, Xin, MBg, Yout, mi, r, h);
    }
    __syncthreads();
}
DI void phase_mix(const Params& p, int bid, int nb, char* smem) {
    if (nb == 256) {
        if (bid < 64) { hgrn_mfma_item(p, bid, smem); return; }
        const int j = bid - 64, x = j & 7, lb = j >> 3;
        for (int q = lb; q < 64; q += 24) s5_gemm_item(p, q & 15, x * 4 + (q >> 4), smem);
    } else {
        for (int it = bid; it < 64; it += nb) hgrn_mfma_item(p, it, smem);
        for (int q = bid; q < 512; q += nb) s5_gemm_item(p, q & 15, q >> 4, smem);
    }
}

DI void phase_glu(const Params& p, int bid, int nb, char* smem) {
    pg8::Gemm g{(const bf16_t*)(p.ws + OFF_YSSM), (const bf16_t*)(p.ws + OFF_GLU), NTOK, 512, 512};
    pg8::StaticOrder S; S.init(NTOK, 512, nb, bid);
    pg8::EpiGlu E{(float*)(p.ws + OFF_H), (const bf16_t*)(p.ws + OFF_YSSM), p.glu_b};
    pg8::gemm_phase<pg8::EpiGlu, pg8::StaticOrder, false>((PG8_LAS unsigned char*)smem, g, S, E, nullptr);
}
DI void phase_a2(const Params& p, int bid, int nb) {
    const float* ORAW = (const float*)(p.ws + OFF_ORAW);
    const float* Y2 = (const float*)(p.ws + OFF_H);
    const bf16_t* P = (const bf16_t*)(p.ws + OFF_PROJ);
    bf16_t* A2 = (bf16_t*)(p.ws + OFF_A2);
    const int lane = my_tid() & 63, wid = my_tid() >> 6;
    for (int tok = bid * 8 + wid; tok < NTOK; tok += nb * 8) {
        const int c0 = lane * 8;
        {
            const float4 a = *(const float4*)(ORAW + (size_t)tok * DHG + c0), b = *(const float4*)(ORAW + (size_t)tok * DHG + c0 + 4);
            float ss = a.x * a.x + a.y * a.y + a.z * a.z + a.w * a.w + b.x * b.x + b.y * b.y + b.z * b.z + b.w * b.w;
            ss += __shfl_xor(ss, 1); ss += __shfl_xor(ss, 2); ss += __shfl_xor(ss, 4); ss += __shfl_xor(ss, 8);
            const float rs = rsqrtf(ss * (1.0f / 128.0f) + RMS_EPS);
            const uint4 gq = *(const uint4*)(P + (size_t)tok * INC + 1536 + c0);
            const float4 w0 = *(const float4*)(p.hg_nw + c0), w1 = *(const float4*)(p.hg_nw + c0 + 4);
            uint4 o;
            o.x = pack2(a.x * rs * w0.x * bflo(gq.x), a.y * rs * w0.y * bfhi(gq.x));
            o.y = pack2(a.z * rs * w0.z * bflo(gq.y), a.w * rs * w0.w * bfhi(gq.y));
            o.z = pack2(b.x * rs * w1.x * bflo(gq.z), b.y * rs * w1.y * bfhi(gq.z));
            o.w = pack2(b.z * rs * w1.z * bflo(gq.w), b.w * rs * w1.w * bfhi(gq.w));
            *(uint4*)(A2 + (size_t)tok * DM + c0) = o;
        }
        {
            const float4 a = *(const float4*)(Y2 + (size_t)tok * DSS + c0), b = *(const float4*)(Y2 + (size_t)tok * DSS + c0 + 4);
            float ss = a.x * a.x + a.y * a.y + a.z * a.z + a.w * a.w + b.x * b.x + b.y * b.y + b.z * b.z + b.w * b.w;
#pragma unroll
            for (int m = 1; m < 64; m <<= 1) ss += __shfl_xor(ss, m);
            const float rs = rsqrtf(ss * (1.0f / 512.0f) + RMS_EPS);
            const float4 w0 = *(const float4*)(p.ssm_nw + c0), w1 = *(const float4*)(p.ssm_nw + c0 + 4);
            uint4 o;
            o.x = pack2(a.x * rs * w0.x, a.y * rs * w0.y); o.y = pack2(a.z * rs * w0.z, a.w * rs * w0.w);
            o.z = pack2(b.x * rs * w1.x, b.y * rs * w1.y); o.w = pack2(b.z * rs * w1.z, b.w * rs * w1.w);
            *(uint4*)(A2 + (size_t)tok * DM + 512 + c0) = o;
        }
    }
}

DI void phase_outproj(const Params& p, int bid, int nb, char* smem) {
    pg8::Gemm g{(const bf16_t*)(p.ws + OFF_A2), (const bf16_t*)(p.ws + OFF_WOUT), NTOK, DM, DM};
    pg8::StaticOrder S; S.init(NTOK, DM, nb, bid);
    pg8::EpiResid E{p.out, p.x, (const float*)(p.ws + OFF_MOD) + 2048, DEEP_ALPHA};
    pg8::gemm_phase<pg8::EpiResid, pg8::StaticOrder, false>((PG8_LAS unsigned char*)smem, g, S, E, nullptr);
}
DI void phase_ln1(const Params& p, int bid, int nb) {
    const float* mod = (const float*)(p.ws + OFF_MOD);
    bf16_t* H2 = (bf16_t*)(p.ws + OFF_H);
    const int lane = my_tid() & 63, wid = my_tid() >> 6;
    for (int tok = bid * 8 + wid; tok < NTOK; tok += nb * 8) {
        const int b = tok / SEQ;
        float* row = p.out + (size_t)tok * DM;
        float4 v[4];
        float s = 0.f;
#pragma unroll
        for (int j = 0; j < 4; ++j) { v[j] = *(const float4*)(row + j * 256 + lane * 4); s += v[j].x + v[j].y + v[j].z + v[j].w; }
#pragma unroll
        for (int m = 1; m < 64; m <<= 1) s += __shfl_xor(s, m);
        const float mu = s * (1.0f / 1024.0f);
        float q = 0.f;
#pragma unroll
        for (int j = 0; j < 4; ++j) { const float a = v[j].x - mu, bb = v[j].y - mu, cc = v[j].z - mu, d = v[j].w - mu; q += a * a + bb * bb + cc * cc + d * d; }
#pragma unroll
        for (int m = 1; m < 64; m <<= 1) q += __shfl_xor(q, m);
        const float rstd = rsqrtf(q * (1.0f / 1024.0f) + LN_EPS);
        const float* sh2 = mod + b * 6144 + 3072;
        const float* sc2 = mod + b * 6144 + 4096;
#pragma unroll
        for (int j = 0; j < 4; ++j) {
            const int c = j * 256 + lane * 4;
            const float4 w = *(const float4*)(p.ln1w + c), bi = *(const float4*)(p.ln1b + c), sc = *(const float4*)(sc2 + c), sh = *(const float4*)(sh2 + c);
            float4 o;
            o.x = (v[j].x - mu) * rstd * w.x + bi.x; o.y = (v[j].y - mu) * rstd * w.y + bi.y; o.z = (v[j].z - mu) * rstd * w.z + bi.z; o.w = (v[j].w - mu) * rstd * w.w + bi.w;
            *(float4*)(row + c) = o;
            uint2 hh; hh.x = pack2(o.x * (1.f + sc.x) + sh.x, o.y * (1.f + sc.y) + sh.y); hh.y = pack2(o.z * (1.f + sc.z) + sh.z, o.w * (1.f + sc.w) + sh.w);
            *(uint2*)(H2 + (size_t)tok * DM + c) = hh;
        }
    }
}

DI void phase_q(const Params& p, int bid, int nb, char* smem) {
    pg8::Gemm g{(const bf16_t*)(p.ws + OFF_H), (const bf16_t*)(p.ws + OFF_WQ), NTOK, 2048, DM};
    pg8::StaticOrder S; S.init(NTOK, 2048, nb, bid);
    pg8::EpiBf16Act E{(bf16_t*)(p.ws + OFF_PROJ), 2048, 0u};
    pg8::gemm_phase<pg8::EpiBf16Act, pg8::StaticOrder, false>((PG8_LAS unsigned char*)smem, g, S, E, nullptr);
}
DI void phase_topk(const Params& p, int bid, int nb, char* smem) {
    const bf16_t* Q = (const bf16_t*)(p.ws + OFF_PROJ);
    const bf16_t* SK = (const bf16_t*)(p.ws + OFF_SUBK);
    unsigned* TOPL = (unsigned*)(p.ws + OFF_TOPL);
    float* sc = (float*)(smem + 36864);
    constexpr int NTM = NTOK / 128;
    for (int t = bid; t < NTM * 16; t += nb) {
        const int mt = t >> 4, hp = t & 15;
        gemm_block<2, 1, 2, 4>(Q + (size_t)mt * 128 * 2048 + hp * 128, 2048, SK + (size_t)hp * 128 * 128, 128, 128, smem,
                               [&](int r, int c, float v) { sc[r * 129 + c] = v; });
        __syncthreads();
        if (my_tid() < 128) {
            const int r = my_tid();
            float tk[16];
#pragma unroll
            for (int j = 0; j < 16; ++j) tk[j] = -3.0e38f;
            for (int n = 0; n < 128; ++n) {
                float xv = __uint_as_float((__float_as_uint(sc[r * 129 + n]) & ~0x7fu) | (unsigned)n);
#pragma unroll
                for (int j = 0; j < 16; ++j) { const float hi = fmaxf(tk[j], xv), lo = fminf(tk[j], xv); tk[j] = hi; xv = lo; }
            }
            uint4* dst = (uint4*)(TOPL + ((size_t)(mt * 128 + r) * 16 + hp) * 16);
            dst[0] = make_uint4(__float_as_uint(tk[0]), __float_as_uint(tk[1]), __float_as_uint(tk[2]), __float_as_uint(tk[3]));
            dst[1] = make_uint4(__float_as_uint(tk[4]), __float_as_uint(tk[5]), __float_as_uint(tk[6]), __float_as_uint(tk[7]));
            dst[2] = make_uint4(__float_as_uint(tk[8]), __float_as_uint(tk[9]), __float_as_uint(tk[10]), __float_as_uint(tk[11]));
            dst[3] = make_uint4(__float_as_uint(tk[12]), __float_as_uint(tk[13]), __float_as_uint(tk[14]), __float_as_uint(tk[15]));
        }
        __syncthreads();
    }
}
DI void phase_combine(const Params& p, int bid, int nb) {
    const unsigned* TOPL = (const unsigned*)(p.ws + OFF_TOPL);
    uint2* EX = (uint2*)(p.ws + OFF_EXPS);
    const float* SU = (const float*)(p.ws + OFF_SU);
    const float* SV = (const float*)(p.ws + OFF_SV);
    for (int i = bid * NTH + my_tid(); i < NTOK * PHEADS; i += nb * NTH) {
        const unsigned* l1 = TOPL + (size_t)i * 32;
        const unsigned* l2 = l1 + 16;
        float s2[16];
        {
            const uint4 a = ((const uint4*)l2)[0], b = ((const uint4*)l2)[1], c = ((const uint4*)l2)[2], d = ((const uint4*)l2)[3];
            const unsigned w[16] = {a.x, a.y, a.z, a.w, b.x, b.y, b.z, b.w, c.x, c.y, c.z, c.w, d.x, d.y, d.z, d.w};
#pragma unroll
            for (int j = 0; j < 16; ++j) s2[j] = __uint_as_float(w[j] & ~0x7fu);
        }
        float tk[16];
#pragma unroll
        for (int j = 0; j < 16; ++j) tk[j] = -3.0e38f;
        for (int a = 0; a < 16; ++a) {
            const float s1 = __uint_as_float(l1[a] & ~0x7fu);
#pragma unroll
            for (int b = 0; b < 16; ++b) {
                float xv = __uint_as_float((__float_as_uint(s1 + s2[b]) & ~0xffu) | (unsigned)(a * 16 + b));
#pragma unroll
                for (int j = 0; j < 16; ++j) { const float hi = fmaxf(tk[j], xv), lo = fminf(tk[j], xv); tk[j] = hi; xv = lo; }
            }
        }
        float e[16], sum = 0.f;
        const float mx = __uint_as_float(__float_as_uint(tk[0]) & ~0xffu);
#pragma unroll
        for (int j = 0; j < 16; ++j) { e[j] = __expf(__uint_as_float(__float_as_uint(tk[j]) & ~0xffu) - mx); sum += e[j]; }
        const float inv = 1.0f / sum;
#pragma unroll
        for (int j = 0; j < 16; ++j) {
            const unsigned ab = __float_as_uint(tk[j]) & 0xffu;
            const unsigned i1 = l1[ab >> 4] & 0x7fu, i2 = l2[ab & 15] & 0x7fu;
            const unsigned eid = i1 * 128u + i2;
            EX[(size_t)i * 16 + j] = make_uint2(eid | (((__float_as_uint(SU[eid]) >> 23) & 0xffu) << 16), __float_as_uint(e[j] * inv * SV[eid]));
        }
    }
}

DI void ce_desc(float& a, float& b) { const float hi = fmaxf(a, b), lo = fminf(a, b); a = hi; b = lo; }
template <int N> DI void bitonic_sort_desc(float (&v)[N]) {
#pragma unroll
    for (int k = 2; k <= N; k <<= 1)
#pragma unroll
        for (int j = k >> 1; j > 0; j >>= 1)
#pragma unroll
            for (int i = 0; i < N; ++i) { const int l = i ^ j; if (l > i) { if ((i & k) == 0 || k == N) ce_desc(v[i], v[l]); else ce_desc(v[l], v[i]); } }
}
DI void merge_top16(float (&a)[16], const float (&b)[16]) {
#pragma unroll
    for (int i = 0; i < 16; ++i) a[i] = fmaxf(a[i], b[15 - i]);
#pragma unroll
    for (int j = 8; j > 0; j >>= 1)
#pragma unroll
        for (int i = 0; i < 16; ++i) { const int l = i ^ j; if (l > i) ce_desc(a[i], a[l]); }
}
DI void xlane_merge16(float (&a)[16]) {
    float o[16];
#pragma unroll
    for (int i = 0; i < 16; ++i) o[i] = __shfl_xor(a[i], 32);
    merge_top16(a, o);
}
DI void retrieve_topk_hp(const bf16_t* Q, const bf16_t* SK, const int tok, const int hp, const int r, const int h, unsigned char* lutp, float (&out)[16]) {
                f32x16 acc[4];
#pragma unroll
                for (int mi = 0; mi < 4; ++mi)
#pragma unroll
                    for (int i = 0; i < 16; ++i) acc[mi][i] = 0.f;
                const bf16_t* qb = Q + (size_t)tok * 2048 + hp * 128 + 8 * h;
                const bf16_t* kb = SK + (size_t)hp * 128 * 128 + (size_t)r * 128 + 8 * h;
#pragma unroll
                for (int ks = 0; ks < 8; ++ks) {
                    const bf16x8 bq = *(const bf16x8*)(qb + ks * 16);
#pragma unroll
                    for (int mi = 0; mi < 4; ++mi) {
                        const bf16x8 a = *(const bf16x8*)(kb + mi * 32 * 128 + ks * 16);
                        acc[mi] = __builtin_amdgcn_mfma_f32_32x32x16_bf16(a, bq, acc[mi], 0, 0, 0);
                    }
                }
                float v0[16], v1[16], v2[16], v3[16];
#pragma unroll
                for (int i = 0; i < 16; ++i) {
                    const unsigned n = (unsigned)crow(i, h);
                    v0[i] = __uint_as_float((__float_as_uint(acc[0][i]) & ~0x7fu) | n);
                    v1[i] = __uint_as_float((__float_as_uint(acc[1][i]) & ~0x7fu) | (n + 32u));
                    v2[i] = __uint_as_float((__float_as_uint(acc[2][i]) & ~0x7fu) | (n + 64u));
                    v3[i] = __uint_as_float((__float_as_uint(acc[3][i]) & ~0x7fu) | (n + 96u));
                }
                bitonic_sort_desc<16>(v0); bitonic_sort_desc<16>(v1); bitonic_sort_desc<16>(v2); bitonic_sort_desc<16>(v3);
                merge_top16(v0, v1); merge_top16(v2, v3); merge_top16(v0, v2);
                xlane_merge16(v0);
#pragma unroll
                for (int i = 0; i < 16; ++i) out[i] = v0[i];
                u32x4 ix;
                ix.x = (__float_as_uint(v0[0]) & 0x7fu) | ((__float_as_uint(v0[1]) & 0x7fu) << 8) | ((__float_as_uint(v0[2]) & 0x7fu) << 16) | ((__float_as_uint(v0[3]) & 0x7fu) << 24);
                ix.y = (__float_as_uint(v0[4]) & 0x7fu) | ((__float_as_uint(v0[5]) & 0x7fu) << 8) | ((__float_as_uint(v0[6]) & 0x7fu) << 16) | ((__float_as_uint(v0[7]) & 0x7fu) << 24);
                ix.z = (__float_as_uint(v0[8]) & 0x7fu) | ((__float_as_uint(v0[9]) & 0x7fu) << 8) | ((__float_as_uint(v0[10]) & 0x7fu) << 16) | ((__float_as_uint(v0[11]) & 0x7fu) << 24);
                ix.w = (__float_as_uint(v0[12]) & 0x7fu) | ((__float_as_uint(v0[13]) & 0x7fu) << 8) | ((__float_as_uint(v0[14]) & 0x7fu) << 16) | ((__float_as_uint(v0[15]) & 0x7fu) << 24);
                *(u32x4*)lutp = ix;
}
DI void phase_retrieve(const Params& p, int bid, int nb, char* smem) {
    const bf16_t* Q = (const bf16_t*)(p.ws + OFF_PROJ);
    const bf16_t* SK = (const bf16_t*)(p.ws + OFF_SUBK);
    const float* SU = (const float*)(p.ws + OFF_SU);
    const float* SV = (const float*)(p.ws + OFF_SV);
    uint2* EX = (uint2*)(p.ws + OFF_EXPS);
    const int tid = my_tid(), lane = tid & 63, wid = tid >> 6, r = lane & 31, h = lane >> 5;
    unsigned char* lut = (unsigned char*)smem + wid * 2048 + lane * 32;
    for (int it = bid * 8 + wid; it < (NTOK / 32) * 2; it += nb * 8) {
        const int tg = it >> 1, hq = it & 1;
        const int tok = tg * 32 + r;
#pragma unroll 1
        for (int hd = hq * 4; hd < hq * 4 + 4; ++hd) {
            float L0[16], L1[16];
            retrieve_topk_hp(Q, SK, tok, hd * 2, r, h, lut, L0);
            retrieve_topk_hp(Q, SK, tok, hd * 2 + 1, r, h, lut + 16, L1);
            float c[32];
            {
                constexpr int PA[50] = {0, 0, 0, 0, 0, 0, 0, 0, 0, 0, 0, 0, 0, 0, 0, 0, 1, 1, 1, 1, 1, 1, 1, 1, 2, 2, 2, 2, 2, 3, 3, 3, 3, 4, 4, 4, 5, 5, 6, 6, 7, 7, 8, 9, 10, 11, 12, 13, 14, 15};
                constexpr int PB[50] = {0, 1, 2, 3, 4, 5, 6, 7, 8, 9, 10, 11, 12, 13, 14, 15, 0, 1, 2, 3, 4, 5, 6, 7, 0, 1, 2, 3, 4, 0, 1, 2, 3, 0, 1, 2, 0, 1, 0, 1, 0, 1, 0, 0, 0, 0, 0, 0, 0, 0};
#pragma unroll
                for (int q = 0; q < 25; ++q) {
                    const float s0 = __uint_as_float(__float_as_uint(L0[PA[2 * q]]) & ~0x7fu) + __uint_as_float(__float_as_uint(L1[PB[2 * q]]) & ~0x7fu);
                    const float s1 = __uint_as_float(__float_as_uint(L0[PA[2 * q + 1]]) & ~0x7fu) + __uint_as_float(__float_as_uint(L1[PB[2 * q + 1]]) & ~0x7fu);
                    const float p0 = __uint_as_float((__float_as_uint(s0) & ~0xffu) | (unsigned)(PA[2 * q] * 16 + PB[2 * q]));
                    const float p1 = __uint_as_float((__float_as_uint(s1) & ~0xffu) | (unsigned)(PA[2 * q + 1] * 16 + PB[2 * q + 1]));
                    c[q] = h ? p1 : p0;
                }
#pragma unroll
                for (int i = 25; i < 32; ++i) c[i] = -3.0e38f;
            }
            bitonic_sort_desc<32>(c);
            float t16[16];
#pragma unroll
            for (int i = 0; i < 16; ++i) t16[i] = c[i];
            xlane_merge16(t16);
            const float mx = __uint_as_float(__float_as_uint(t16[0]) & ~0xffu);
            float e[16], sum = 0.f;
#pragma unroll
            for (int j = 0; j < 16; ++j) { e[j] = __expf(__uint_as_float(__float_as_uint(t16[j]) & ~0xffu) - mx); sum += e[j]; }
            const float inv = 1.0f / sum;
            uint2* dst = EX + ((size_t)tok * 8 + hd) * 16 + 8 * h;
#pragma unroll
            for (int j = 0; j < 8; ++j) {
                float tlo = t16[j], thi = t16[8 + j], elo = e[j], ehi = e[8 + j];
                asm volatile("" : "+v"(tlo), "+v"(thi), "+v"(elo), "+v"(ehi));
                const float tv = h ? thi : tlo, ev = h ? ehi : elo;
                const unsigned ab = __float_as_uint(tv) & 0xffu;
                const unsigned eid = (unsigned)lut[ab >> 4] * 128u + (unsigned)lut[16 + (ab & 15u)];
                dst[j] = make_uint2(eid | (((__float_as_uint(SU[eid]) >> 23) & 0xffu) << 16), __float_as_uint(ev * inv * SV[eid]));
            }
        }
    }
}

DI float dot16_fp8(const u32x4 w, const f32x2 (&h)[8]) {
    f32x2 acc = __builtin_amdgcn_cvt_pk_f32_fp8((int)w.x, false) * h[0];
    acc += __builtin_amdgcn_cvt_pk_f32_fp8((int)w.x, true) * h[1];
    acc += __builtin_amdgcn_cvt_pk_f32_fp8((int)w.y, false) * h[2];
    acc += __builtin_amdgcn_cvt_pk_f32_fp8((int)w.y, true) * h[3];
    acc += __builtin_amdgcn_cvt_pk_f32_fp8((int)w.z, false) * h[4];
    acc += __builtin_amdgcn_cvt_pk_f32_fp8((int)w.z, true) * h[5];
    acc += __builtin_amdgcn_cvt_pk_f32_fp8((int)w.w, false) * h[6];
    acc += __builtin_amdgcn_cvt_pk_f32_fp8((int)w.w, true) * h[7];
    return acc.x + acc.y;
}
DI void axpy16_fp8(const float a, const u32x4 w, f32x2 (&o)[8]) {
    const f32x2 aa = {a, a};
    o[0] += aa * __builtin_amdgcn_cvt_pk_f32_fp8((int)w.x, false); o[1] += aa * __builtin_amdgcn_cvt_pk_f32_fp8((int)w.x, true);
    o[2] += aa * __builtin_amdgcn_cvt_pk_f32_fp8((int)w.y, false); o[3] += aa * __builtin_amdgcn_cvt_pk_f32_fp8((int)w.y, true);
    o[4] += aa * __builtin_amdgcn_cvt_pk_f32_fp8((int)w.z, false); o[5] += aa * __builtin_amdgcn_cvt_pk_f32_fp8((int)w.z, true);
    o[6] += aa * __builtin_amdgcn_cvt_pk_f32_fp8((int)w.w, false); o[7] += aa * __builtin_amdgcn_cvt_pk_f32_fp8((int)w.w, true);
}
DI float butterfly64(float (&pz)[64], const int lane) {
    const bool b5 = lane & 32, b4 = lane & 16, b3 = lane & 8, b2 = lane & 4, b1 = lane & 2, b0 = lane & 1;
    float q32[32], q16[16], q8[8], q4[4], q2[2];
#pragma unroll
    for (int j = 0; j < 32; ++j) q32[j] = (b5 ? pz[32 + j] : pz[j]) + __shfl_xor(b5 ? pz[j] : pz[32 + j], 32);
#pragma unroll
    for (int j = 0; j < 16; ++j) q16[j] = (b4 ? q32[16 + j] : q32[j]) + __shfl_xor(b4 ? q32[j] : q32[16 + j], 16);
#pragma unroll
    for (int j = 0; j < 8; ++j) q8[j] = (b3 ? q16[8 + j] : q16[j]) + __shfl_xor(b3 ? q16[j] : q16[8 + j], 8);
#pragma unroll
    for (int j = 0; j < 4; ++j) q4[j] = (b2 ? q8[4 + j] : q8[j]) + __shfl_xor(b2 ? q8[j] : q8[4 + j], 4);
#pragma unroll
    for (int j = 0; j < 2; ++j) q2[j] = (b1 ? q4[2 + j] : q4[j]) + __shfl_xor(b1 ? q4[j] : q4[2 + j], 2);
    return (b0 ? q2[1] : q2[0]) + __shfl_xor(b0 ? q2[0] : q2[1], 1);
}
DI void phase_gather(const Params& p, int bid, int nb) {
    const float* mod = (const float*)(p.ws + OFF_MOD);
    const uint2* EX = (const uint2*)(p.ws + OFF_EXPS);
    const unsigned char* UT = (const unsigned char*)(p.ws + OFF_UT);
    const unsigned char* VT = (const unsigned char*)(p.ws + OFF_VT);
    const int lane = my_tid() & 63, wid = my_tid() >> 6;
    for (int tok = bid * 8 + wid; tok < NTOK; tok += nb * 8) {
        const int b = tok / SEQ, c0 = lane * 16;
        float* row = p.out + (size_t)tok * DM + c0;
        const float* sh2 = mod + b * 6144 + 3072 + c0;
        const float* sc2 = mod + b * 6144 + 4096 + c0;
        const float* g2 = mod + b * 6144 + 5120 + c0;
        f32x2 x1[8], h2[8], acc[8];
#pragma unroll
        for (int q = 0; q < 4; ++q) {
            const f32x4 xv = *(const f32x4*)(row + q * 4), sc = *(const f32x4*)(sc2 + q * 4), sh = *(const f32x4*)(sh2 + q * 4);
            x1[2 * q] = (f32x2){xv.x, xv.y}; x1[2 * q + 1] = (f32x2){xv.z, xv.w};
            h2[2 * q] = (f32x2){xv.x * (1.f + sc.x) + sh.x, xv.y * (1.f + sc.y) + sh.y};
            h2[2 * q + 1] = (f32x2){xv.z * (1.f + sc.z) + sh.z, xv.w * (1.f + sc.w) + sh.w};
        }
#pragma unroll
        for (int i = 0; i < 8; ++i) acc[i] = (f32x2){0.f, 0.f};
        const uint2 e0 = EX[(size_t)tok * 128 + lane], e1 = EX[(size_t)tok * 128 + 64 + lane];
        float a0, a1;
        {
            float pz[64];
#pragma unroll
            for (int e = 0; e < 64; ++e) {
                const unsigned eid = (unsigned)__builtin_amdgcn_readlane((int)e0.x, e) & 0xffffu;
                pz[e] = dot16_fp8(*(const u32x4*)(UT + (size_t)eid * DM + c0), h2);
            }
            const float z = butterfly64(pz, lane) * __uint_as_float(((e0.x >> 16) & 0xffu) << 23);
            a0 = geluf_(z) * __uint_as_float(e0.y);
        }
        {
            float pz[64];
#pragma unroll
            for (int e = 0; e < 64; ++e) {
                const unsigned eid = (unsigned)__builtin_amdgcn_readlane((int)e1.x, e) & 0xffffu;
                pz[e] = dot16_fp8(*(const u32x4*)(UT + (size_t)eid * DM + c0), h2);
            }
            const float z = butterfly64(pz, lane) * __uint_as_float(((e1.x >> 16) & 0xffu) << 23);
            a1 = geluf_(z) * __uint_as_float(e1.y);
        }
#pragma unroll 16
        for (int e = 0; e < 64; ++e) {
            const unsigned eid = (unsigned)__builtin_amdgcn_readlane((int)e0.x, e) & 0xffffu;
            const float a = __uint_as_float(__builtin_amdgcn_readlane((int)__float_as_uint(a0), e));
            axpy16_fp8(a, *(const u32x4*)(VT + (size_t)eid * DM + c0), acc);
        }
#pragma unroll 16
        for (int e = 0; e < 64; ++e) {
            const unsigned eid = (unsigned)__builtin_amdgcn_readlane((int)e1.x, e) & 0xffffu;
            const float a = __uint_as_float(__builtin_amdgcn_readlane((int)__float_as_uint(a1), e));
            axpy16_fp8(a, *(const u32x4*)(VT + (size_t)eid * DM + c0), acc);
        }
        f32x2 r[8];
        float s = 0.f;
#pragma unroll
        for (int q = 0; q < 4; ++q) {
            const f32x4 gg = *(const f32x4*)(g2 + q * 4);
            r[2 * q] = DEEP_ALPHA * x1[2 * q] + (f32x2){1.f + gg.x, 1.f + gg.y} * acc[2 * q];
            r[2 * q + 1] = DEEP_ALPHA * x1[2 * q + 1] + (f32x2){1.f + gg.z, 1.f + gg.w} * acc[2 * q + 1];
            s += r[2 * q].x + r[2 * q].y + r[2 * q + 1].x + r[2 * q + 1].y;
        }
#pragma unroll
        for (int m = 1; m < 64; m <<= 1) s += __shfl_xor(s, m);
        const float mu = s * (1.0f / 1024.0f);
        float qq = 0.f;
#pragma unroll
        for (int i = 0; i < 8; ++i) { const f32x2 d = r[i] - mu; qq += d.x * d.x + d.y * d.y; }
#pragma unroll
        for (int m = 1; m < 64; m <<= 1) qq += __shfl_xor(qq, m);
        const float rstd = rsqrtf(qq * (1.0f / 1024.0f) + LN_EPS);
#pragma unroll
        for (int q = 0; q < 4; ++q) {
            const f32x4 w = *(const f32x4*)(p.ln2w + c0 + q * 4), bi = *(const f32x4*)(p.ln2b + c0 + q * 4);
            f32x4 ov;
            ov.x = (r[2 * q].x - mu) * rstd * w.x + bi.x; ov.y = (r[2 * q].y - mu) * rstd * w.y + bi.y;
            ov.z = (r[2 * q + 1].x - mu) * rstd * w.z + bi.z; ov.w = (r[2 * q + 1].y - mu) * rstd * w.w + bi.w;
            *(f32x4*)(row + q * 4) = ov;
        }
    }
}

#define XB_TMO      128
#define XB_XCNT(j)  (256  + 64 * (j))
#define XB_XSUB(j)  (1280 + 64 * (j))
#define XB_XGEN(j)  (2304 + 64 * (j))
#define XB_TOP      3328
#define XB_TOPGEN   3392
#define XCD_BAR_WORDS 3456
#define XB_SPIN_CAP (1u << 22)
#define LAS __attribute__((address_space(3)))
DI unsigned xb_ld(unsigned* p) { return __hip_atomic_load(p, __ATOMIC_RELAXED, __HIP_MEMORY_SCOPE_AGENT); }
DI unsigned xb_add(unsigned* p, unsigned v) { return __hip_atomic_fetch_add(p, v, __ATOMIC_RELAXED, __HIP_MEMORY_SCOPE_AGENT); }
DI unsigned xb_xcc_id() { return (unsigned)__builtin_amdgcn_s_getreg((3 << 11) | 20) & 0xFu; }
#define XB_SPIN(cond, bar) do { unsigned _sp = 0; while (cond) { __builtin_amdgcn_s_sleep(1); \
    if ((++_sp & 255u) == 0u) { if (xb_ld(&(bar)[XB_TMO])) break; if (_sp > XB_SPIN_CAP) { atomicAdd(&(bar)[XB_TMO], 1u); break; } } } } while (0)
struct XcdBarrier { unsigned* bar; unsigned x; volatile LAS unsigned* st; };
DI XcdBarrier xcd_barrier_post(unsigned* bar, volatile LAS unsigned* st) {
    XcdBarrier b; b.bar = bar; b.x = xb_xcc_id(); b.st = st;
    if (__builtin_amdgcn_workitem_id_x() == 0) (void)xb_add(&bar[XB_XCNT(b.x)], 1u);
    return b;
}
DI void xcd_barrier_complete(unsigned* bar, unsigned x, unsigned& nloc, unsigned& nx) {
    const unsigned G = gridDim.x * gridDim.y * gridDim.z;
    unsigned sum, cnt, mine, sp = 0u;
    for (;;) {
        sum = 0u; cnt = 0u; mine = 0u;
#pragma unroll
        for (unsigned j = 0; j < 16; ++j) { const unsigned c = xb_ld(&bar[XB_XCNT(j)]); sum += c; cnt += (c > 0u) ? 1u : 0u; mine = (j == x) ? c : mine; }
        if (sum == G) break;
        __builtin_amdgcn_s_sleep(1);
        if ((++sp & 255u) == 0u) { if (xb_ld(&bar[XB_TMO])) break; if (sp > XB_SPIN_CAP) { atomicAdd(&bar[XB_TMO], 1u); break; } }
    }
    nloc = mine > 0u ? mine : 1u; nx = cnt > 0u ? cnt : 1u;
}
DI void xcd_barrier(const XcdBarrier& b) {
    asm volatile("s_waitcnt vmcnt(0)" ::: "memory");
    __syncthreads();
    if (__builtin_amdgcn_workitem_id_x() == 0) {
        unsigned* bar = b.bar;
        __builtin_amdgcn_s_waitcnt(0);
        unsigned nloc = b.st[0], nx = b.st[1];
        if (nloc == 0u) { xcd_barrier_complete(bar, b.x, nloc, nx); b.st[0] = nloc; b.st[1] = nx; }
        const unsigned old = xb_add(&bar[XB_XSUB(b.x)], 1u);
        const unsigned gen = old / nloc;
        if (old + 1u == (gen + 1u) * nloc) {
            __builtin_amdgcn_fence(__ATOMIC_RELEASE, "agent");
            asm volatile("s_waitcnt vmcnt(0)" ::: "memory");
            const unsigned og = xb_add(&bar[XB_TOP], 1u);
            const unsigned tg = og / nx;
            if (og + 1u == (tg + 1u) * nx) xb_add(&bar[XB_TOPGEN], 1u);
            else XB_SPIN(xb_ld(&bar[XB_TOPGEN]) == tg, bar);
            __builtin_amdgcn_fence(__ATOMIC_ACQUIRE, "agent");
            xb_add(&bar[XB_XGEN(b.x)], 1u);
            asm volatile("s_waitcnt vmcnt(0)" ::: "memory");
        } else {
            XB_SPIN(xb_ld(&bar[XB_XGEN(b.x)]) == gen, bar);
            __builtin_amdgcn_fence(__ATOMIC_ACQUIRE, "agent");
            asm volatile("s_waitcnt vmcnt(0)" ::: "memory");
        }
    }
    __syncthreads();
}

__global__ void __launch_bounds__(NTH) k_mega(Params p) {
    __shared__ __attribute__((aligned(16))) char smem[SMEM_BYTES];
    volatile LAS unsigned* xst = (volatile LAS unsigned*)(smem + SMEM_BYTES - 16);
    if (__builtin_amdgcn_workitem_id_x() == 0) { xst[0] = 0u; xst[1] = 0u; }
    __syncthreads();
    const XcdBarrier xb = xcd_barrier_post((unsigned*)(p.ws + OFF_BAR), xst);
    const int bid = blockIdx.x, nb = gridDim.x;
#ifndef PROBE_MASK
#define PROBE_MASK 0
#endif
#define REP(bit) for (int rep_ = 0; rep_ < ((PROBE_MASK & (bit)) ? 2 : 1); ++rep_)
    REP(64) { phase_prep(p, bid, nb, smem);    xcd_barrier(xb); }
    REP(64) { phase_h(p, bid, nb);             xcd_barrier(xb); }
    REP(1)  { phase_proj(p, bid, nb, smem);    xcd_barrier(xb); }
    REP(128) { phase_hgprep(p, bid, nb);       xcd_barrier(xb); }
    REP(2)  { phase_mix(p, bid, nb, smem);     xcd_barrier(xb); }
    REP(4)  { phase_glu(p, bid, nb, smem);     xcd_barrier(xb); }
    REP(4)  { phase_a2(p, bid, nb);            xcd_barrier(xb); }
    REP(4)  { phase_outproj(p, bid, nb, smem); xcd_barrier(xb); }
    phase_ln1(p, bid, nb);           xcd_barrier(xb);
    REP(8)  { phase_q(p, bid, nb, smem);       xcd_barrier(xb); }
    REP(16) { phase_retrieve(p, bid, nb, smem); xcd_barrier(xb); }
    phase_gather(p, bid, nb);
}

extern "C" void kernel_launch(void* const* d_in, const int* in_sizes, int n_in, void* d_out, int out_size, void* d_ws, size_t ws_size, hipStream_t stream) {
    if (n_in != 27 || ws_size < WS_END) { fprintf(stderr, "kernel_launch: unexpected n_in %d or ws_size %zu (< %zu)\n", n_in, ws_size, (size_t)WS_END); return; }
    static int grid_blocks = 0;
    if (!grid_blocks) {
        int dev = 0, cus = 0, per_cu = 0;
        (void)hipGetDevice(&dev);
        (void)hipDeviceGetAttribute(&cus, hipDeviceAttributeMultiprocessorCount, dev);
        (void)hipOccupancyMaxActiveBlocksPerMultiprocessor(&per_cu, k_mega, NTH, 0);
        if (cus <= 0) cus = 256;
        if (per_cu < 1) { fprintf(stderr, "kernel_launch: occupancy query says %d blocks/CU\n", per_cu); per_cu = 1; }
        grid_blocks = cus;
    }
    Params p{};
    const float** f = (const float**)&p;
    for (int i = 0; i < 27; ++i) f[i] = (const float*)d_in[i];
    p.out = (float*)d_out; p.ws = (char*)d_ws;
    hipError_t e = hipMemsetAsync((char*)d_ws + OFF_BAR, 0, (size_t)3456 * 4, stream);
    if (e == hipSuccess) { hipLaunchKernelGGL(k_mega, dim3(grid_blocks), dim3(NTH), 0, stream, p); e = hipPeekAtLastError(); }
    if (e != hipSuccess) fprintf(stderr, "launch failed: %s (grid %d)\n", hipGetErrorString(e), grid_blocks);
}
```

```cpp
#include <hip/hip_runtime.h>
#include <hip/hip_cooperative_groups.h>
#include <stdint.h>
#include <stdio.h>

namespace cg = cooperative_groups;
#define DI __device__ __forceinline__
typedef unsigned short bf16_t;
typedef short bf16x8 __attribute__((ext_vector_type(8)));
typedef float f32x16 __attribute__((ext_vector_type(16)));
typedef unsigned u32x4 __attribute__((ext_vector_type(4)));
typedef float f32x4 __attribute__((ext_vector_type(4)));
typedef float f32x2 __attribute__((ext_vector_type(2)));

constexpr int NTH = 512;
constexpr int NB = 16, SEQ = 2048, DM = 1024, NTOK = NB * SEQ;
constexpr int DHG = 512, HGH = 4, HDK = 128;
constexpr int DSS = 512, SSG = 32, SSC = 16, SSP = 64;
constexpr int INC = 2560;
constexpr int PHEADS = 8, NKEYS = 128, TOPK = 16, NEXP = 16384;
constexpr float DEEP_ALPHA = 1.189207115002721f;
constexpr float LN_EPS = 1e-5f, RMS_EPS = 1e-6f;
constexpr int SMEM_BYTES = 128 * 1024 + 256;

constexpr size_t al256(size_t x) { return (x + 255) & ~(size_t)255; }
constexpr size_t OFF_MOD = 0;
constexpr size_t OFF_LB = al256(OFF_MOD + (size_t)NB * 6144 * 4);
constexpr size_t OFF_LAM = al256(OFF_LB + 512 * 4);
constexpr size_t OFF_BB = al256(OFF_LAM + 32 * 64 * 2 * 4);
constexpr size_t OFF_WIN = al256(OFF_BB + 32 * 64 * 16 * 2 * 4);
constexpr size_t OFF_GLU = al256(OFF_WIN + (size_t)INC * DM * 2);
constexpr size_t OFF_WOUT = al256(OFF_GLU + (size_t)512 * 512 * 2);
constexpr size_t OFF_WQ = al256(OFF_WOUT + (size_t)DM * DM * 2);
constexpr size_t OFF_SUBK = al256(OFF_WQ + (size_t)2048 * DM * 2);
constexpr size_t OFF_SU = al256(OFF_SUBK + (size_t)16 * 128 * 128 * 2);
constexpr size_t OFF_SV = al256(OFF_SU + (size_t)NEXP * 4);
constexpr size_t OFF_UT = al256(OFF_SV + (size_t)NEXP * 4);
constexpr size_t OFF_VT = al256(OFF_UT + (size_t)NEXP * DM * 2);
constexpr size_t OFF_H = al256(OFF_VT + (size_t)NEXP * DM * 2);
constexpr size_t OFF_PROJ = al256(OFF_H + (size_t)NTOK * DM * 2);
constexpr size_t OFF_ORAW = al256(OFF_PROJ + (size_t)NTOK * INC * 2);
constexpr size_t OFF_YSSM = al256(OFF_ORAW + (size_t)NTOK * DHG * 4);
constexpr size_t OFF_A2 = al256(OFF_YSSM + (size_t)NTOK * DSS * 2);
constexpr size_t OFF_HG = al256(OFF_A2 + (size_t)NTOK * DM * 2);
constexpr size_t OFF_S5K = al256(OFF_HG + (size_t)4096 * 128 * 4);
constexpr size_t OFF_S5N = al256(OFF_S5K + (size_t)32 * 4096 * 2);
constexpr size_t OFF_S5M = al256(OFF_S5N + (size_t)32 * 128 * 256 * 2);
constexpr size_t OFF_S5L = al256(OFF_S5M + (size_t)32 * 256 * 128 * 2);
constexpr size_t OFF_BAR = al256(OFF_S5L + (size_t)32 * 64 * 2 * 4);
constexpr size_t WS_END = al256(OFF_BAR + (size_t)3456 * 4);
constexpr size_t OFF_HQ = OFF_H, OFF_HK = OFF_H + (size_t)NTOK * DHG * 2, OFF_HKT = OFF_A2, OFF_HVT = OFF_A2 + (size_t)NTOK * DHG * 2;
constexpr size_t OFF_TOPL = OFF_ORAW;
constexpr size_t OFF_EXPS = OFF_ORAW + (size_t)NTOK * 16 * 16 * 4;

struct Params {
    const float *x, *c, *ada_w, *ada_b, *w_in, *hg_lb, *hg_nw, *a_re, *a_im, *log_dt, *b_re, *b_im, *c_re, *c_im, *dsk,
        *glu_w, *glu_b, *ssm_nw, *w_out, *ln1w, *ln1b, *w_q, *subk, *pu, *pv, *ln2w, *ln2b;
    float* out;
    char* ws;
};

DI int my_tid() { int t = (int)__builtin_amdgcn_workitem_id_x(); asm volatile("" : "+v"(t)); return t; }
DI bf16_t f2bf(float x) { unsigned u = __float_as_uint(x); u += 0x7fffu + ((u >> 16) & 1u); return (bf16_t)(u >> 16); }
DI float bf2f(bf16_t b) { return __uint_as_float(((unsigned)b) << 16); }
DI float bflo(unsigned w) { return __uint_as_float(w << 16); }
DI float bfhi(unsigned w) { return __uint_as_float(w & 0xffff0000u); }
typedef __bf16 hwbf16x2 __attribute__((ext_vector_type(2)));
DI unsigned pack2(float a, float b) { const f32x2 v = {a, b}; return __builtin_bit_cast(unsigned, __builtin_convertvector(v, hwbf16x2)); }
DI bf16x8 pack8(const f32x16& x, const int base) {
    u32x4 o; o.x = pack2(x[base], x[base + 1]); o.y = pack2(x[base + 2], x[base + 3]); o.z = pack2(x[base + 4], x[base + 5]); o.w = pack2(x[base + 6], x[base + 7]);
    return __builtin_bit_cast(bf16x8, o);
}
DI float sigmoidf_(float x) { return 1.0f / (1.0f + __expf(-x)); }
DI float siluf_(float x) { return x * sigmoidf_(x); }
DI float geluf_(float x) { return 0.5f * x * (1.0f + erff(x * 0.70710678118654752f)); }
DI float gelu_as(float v) {
    const float t = __builtin_amdgcn_rcpf(fabsf(v) * 0.2316418882f + 1.0f);
    float q = t * 0.5307027145f + (-0.7265760135f); q = q * t + 0.7107068705f; q = q * t + (-0.142248368f); q = q * t + 0.127414796f; q = q * t;
    const float m = v * (q * __builtin_amdgcn_exp2f(v * v * (-0.72134752044f)));
    return v < 0.f ? m : v - m;
}

template <int MT, int NT_, int WM, int WN, class Epi>
DI void gemm_block(const bf16_t* __restrict__ A, int lda, const bf16_t* __restrict__ Bt, int ldb, int K, char* smem, Epi epi) {
    constexpr int BM = WM * MT * 32, BN = WN * NT_ * 32, LS = 72;
    static_assert(WM * WN == 8, "8 waves");
    bf16_t* As = (bf16_t*)smem;
    bf16_t* Bs = As + BM * LS;
    const int tid = my_tid(), lane = tid & 63, wid = tid >> 6, r = lane & 31, h = lane >> 5;
    const int wm = wid / WN, wn = wid % WN;
    constexpr int PA = BM * 8 / NTH, PB = BN * 8 / NTH;
    u32x4 ra[PA], rb[PB];
    f32x16 acc[MT][NT_];
#pragma unroll
    for (int mi = 0; mi < MT; ++mi)
#pragma unroll
        for (int ni = 0; ni < NT_; ++ni)
#pragma unroll
            for (int i = 0; i < 16; ++i) acc[mi][ni][i] = 0.f;
#define GEMM_GLOAD(kt_) { \
    _Pragma("unroll") for (int q = 0; q < PA; ++q) { const int idx = tid + q * NTH, row = idx >> 3, ch = idx & 7; ra[q] = *(const u32x4*)(A + (size_t)row * lda + (kt_) * 64 + ch * 8); } \
    _Pragma("unroll") for (int q = 0; q < PB; ++q) { const int idx = tid + q * NTH, row = idx >> 3, ch = idx & 7; rb[q] = *(const u32x4*)(Bt + (size_t)row * ldb + (kt_) * 64 + ch * 8); } }
#define GEMM_LSTORE() { \
    _Pragma("unroll") for (int q = 0; q < PA; ++q) { const int idx = tid + q * NTH, row = idx >> 3, ch = idx & 7; *(u32x4*)(As + row * LS + ch * 8) = ra[q]; } \
    _Pragma("unroll") for (int q = 0; q < PB; ++q) { const int idx = tid + q * NTH, row = idx >> 3, ch = idx & 7; *(u32x4*)(Bs + row * LS + ch * 8) = rb[q]; } }
    GEMM_GLOAD(0); GEMM_LSTORE(); __syncthreads();
    const int nk = K / 64;
    for (int kt = 0; kt < nk; ++kt) {
        if (kt + 1 < nk) GEMM_GLOAD(kt + 1);
#pragma unroll
        for (int ks = 0; ks < 4; ++ks) {
            bf16x8 a[MT], b[NT_];
#pragma unroll
            for (int mi = 0; mi < MT; ++mi) a[mi] = *(const bf16x8*)(As + (wm * MT * 32 + mi * 32 + r) * LS + ks * 16 + h * 8);
#pragma unroll
            for (int ni = 0; ni < NT_; ++ni) b[ni] = *(const bf16x8*)(Bs + (wn * NT_ * 32 + ni * 32 + r) * LS + ks * 16 + h * 8);
#pragma unroll
            for (int mi = 0; mi < MT; ++mi)
#pragma unroll
                for (int ni = 0; ni < NT_; ++ni) acc[mi][ni] = __builtin_amdgcn_mfma_f32_32x32x16_bf16(a[mi], b[ni], acc[mi][ni], 0, 0, 0);
        }
        __syncthreads();
        if (kt + 1 < nk) { GEMM_LSTORE(); __syncthreads(); }
    }
#pragma unroll
    for (int mi = 0; mi < MT; ++mi)
#pragma unroll
        for (int ni = 0; ni < NT_; ++ni)
#pragma unroll
            for (int i = 0; i < 16; ++i) epi(wm * MT * 32 + mi * 32 + (i & 3) + 8 * (i >> 2) + 4 * h, wn * NT_ * 32 + ni * 32 + r, acc[mi][ni][i]);
}

namespace pg8 {
#define PG8_LAS __attribute__((address_space(3)))
typedef unsigned short bf16_t;
typedef short bf16x8 __attribute__((ext_vector_type(8)));
typedef float f32x4 __attribute__((ext_vector_type(4)));
typedef unsigned u32x4 __attribute__((ext_vector_type(4)));
constexpr int BM = 256, BK = 64, HALF = 128, HTB = HALF * BK * 2  , STAGE_BYTES = 8 * HTB, NXCD = 8, WGM = 8;

__host__ __device__ __forceinline__ int lds_byte(int r, int c) { const int st = (r >> 4) * 2 + (c >> 5), rr = r & 15, cc = c & 31, ob = rr * 64 + cc * 2; return st * 1024 + (ob ^ (((ob >> 9) & 1) << 5)); }
__host__ __device__ __forceinline__ void stage_rc(int b, int& R, int& C) { const int st = b / 1024, sb = b % 1024, swz = sb ^ (((sb >> 9) & 1) << 5); R = (st >> 1) * 16 + swz / 64; C = (st & 1) * 32 + (swz % 64) / 2; }
__host__ __device__ __forceinline__ int perm32(int rho) { const int n = rho >> 4, i = rho & 15; return 8 * (i >> 2) + 4 * n + (i & 3); }

struct Unit { int pm, pn; };
struct Gemm { const bf16_t* A; const bf16_t* Bt; int M, N, K; };

struct StaticOrder {
    int nM, nN, nwg, G, c;
    __host__ __device__ void init(int M, int N, int G_, int c_) { nM = M / BM; nN = N / BM; nwg = nM * nN; G = G_; c = c_; }
    __host__ __device__ bool next(int i, Unit& u) const {
        const long L = (long)i * G + c; if (L >= nwg) return false;
        int wgid = (int)L; { const int q = nwg / NXCD, r = nwg % NXCD, xcd = wgid % NXCD, off = wgid / NXCD; wgid = (xcd < r ? xcd * (q + 1) : r * (q + 1) + (xcd - r) * q) + off; }
        const int nig = WGM * nN, gid = wgid / nig, fm = gid * WGM, gsz = (nM - fm) < WGM ? (nM - fm) : WGM;
        u.pm = fm + ((wgid % nig) % gsz); u.pn = (wgid % nig) / gsz; return true;
    }
    __device__ __forceinline__ void a_ready(const Unit&) const {}
    __device__ __forceinline__ void done(const Unit&) const {}
};
template <class Epi, class Sched, bool STAMP = false>
__device__ __forceinline__ void gemm_phase(PG8_LAS unsigned char* lds, const Gemm g, const Sched& S, const Epi& E, unsigned long long* stamps) {
    const int tid = (int)__builtin_amdgcn_workitem_id_x(), wid = __builtin_amdgcn_readfirstlane(tid >> 6), lane = tid & 63, wr = wid >> 2, wc = wid & 3, fr = lane & 15, fq = lane >> 4;
    const int K = g.K, nt = K / BK;
    int ts_lo = 0, ts_hi = 0, nts = 0; const unsigned long long rt_entry = STAMP ? (unsigned long long)wall_clock64() : 0ull;
#define PG8_STAMP() do { if (STAMP && wid == 0 && nts < 64) { const unsigned long long _c = (unsigned long long)clock64(); \
        ts_lo = (lane == nts) ? (int)(unsigned)_c : ts_lo; ts_hi = (lane == nts) ? (int)(unsigned)(_c >> 32) : ts_hi; ++nts; } } while (0)
    PG8_STAMP();
    unsigned voffA[2], voffB[2];
#pragma unroll
    for (int i = 0; i < 2; ++i) { int R, C; stage_rc(tid * 16 + i * 8192, R, C); const int Rb = Epi::PERM ? ((R & ~31) + perm32(R & 31)) : R;
        voffA[i] = (unsigned)(R * K + C) * 2u; voffB[i] = (unsigned)(Rb * K + C) * 2u; }
    const size_t kstep = (size_t)(BK * 2);
    const size_t hstep = (size_t)HALF * K * 2;
    const size_t tstep = 2 * hstep;
    const unsigned ldsw = (unsigned)wid * 1024u;
    const int aoff = lds_byte(wr * 64 + fr, fq * 8), boff = lds_byte(wc * 32 + fr, fq * 8);
#define PG8_SA(b, h) (((b) * 2 + (h)) * HTB)
#define PG8_SB(b, h) ((4 + (b) * 2 + (h)) * HTB)
#define PG8_STAGE(bufoff, gbase, voff) do { _Pragma("unroll") for (int _i = 0; _i < 2; ++_i) \
        __builtin_amdgcn_global_load_lds((const unsigned*)((const char*)(gbase) + (voff)[_i]), (PG8_LAS unsigned*)(lds + (bufoff) + ldsw + _i * 8192), 16, 0, 0); } while (0)
#define PG8_LDA(dst, b, h) do { _Pragma("unroll") for (int m = 0; m < 4; ++m) _Pragma("unroll") for (int k = 0; k < 2; ++k) dst[m][k] = *(const PG8_LAS bf16x8*)(lds + PG8_SA(b, h) + aoff + m * 2048 + k * 1024); } while (0)
#define PG8_LDB(dst, b, h) do { _Pragma("unroll") for (int n = 0; n < 2; ++n) _Pragma("unroll") for (int k = 0; k < 2; ++k) dst[n][k] = *(const PG8_LAS bf16x8*)(lds + PG8_SB(b, h) + boff + n * 2048 + k * 1024); } while (0)
#define PG8_MMA(ai, bj, At, Bt) do { __builtin_amdgcn_s_setprio(1); _Pragma("unroll") for (int m = 0; m < 4; ++m) _Pragma("unroll") for (int n = 0; n < 2; ++n) _Pragma("unroll") for (int k = 0; k < 2; ++k) \
        acc[ai][bj][m][n] = __builtin_amdgcn_mfma_f32_16x16x32_bf16(Bt[n][k], At[m][k], acc[ai][bj][m][n], 0, 0, 0); __builtin_amdgcn_s_setprio(0); } while (0)
#define PG8_WAIT_V(n) asm volatile("s_waitcnt vmcnt(" #n ")" ::: "memory")
#define PG8_WAIT_L(n) asm volatile("s_waitcnt lgkmcnt(" #n ")" ::: "memory")
#define PG8_BAR __builtin_amdgcn_s_barrier()
#define PG8_SCHED __builtin_amdgcn_sched_barrier(0)
    Unit cur, nxt; int ui = 0;
    if (!S.next(0, cur)) return;
    f32x4 acc[2][2][4][2];
#pragma unroll
    for (int a = 0; a < 2; ++a)
#pragma unroll
        for (int b = 0; b < 2; ++b)
#pragma unroll
            for (int m = 0; m < 4; ++m)
#pragma unroll
                for (int n = 0; n < 2; ++n) acc[a][b][m][n] = (f32x4){0.f, 0.f, 0.f, 0.f};
    bf16x8 At[4][2], B0[2][2], B1[2][2];
    const char* cA = (const char*)g.A + (size_t)cur.pm * tstep; const char* cB = (const char*)g.Bt + (size_t)cur.pn * tstep;
    S.a_ready(cur);
    PG8_STAGE(PG8_SB(0, 0), cB, voffB); PG8_STAGE(PG8_SA(0, 0), cA, voffA); PG8_STAGE(PG8_SB(0, 1), cB + hstep, voffB); PG8_STAGE(PG8_SA(0, 1), cA + hstep, voffA);
    if (wr == 1) PG8_BAR;
    PG8_WAIT_V(4); PG8_BAR;
    PG8_STAGE(PG8_SB(1, 0), cB + kstep, voffB); PG8_STAGE(PG8_SA(1, 0), cA + kstep, voffA); PG8_STAGE(PG8_SB(1, 1), cB + hstep + kstep, voffB);
    PG8_WAIT_V(6); PG8_BAR;
    PG8_STAMP();
    for (;;) {
        const bool has_next = S.next(ui + 1, nxt);
        const char* nA = has_next ? (const char*)g.A + (size_t)nxt.pm * tstep : cA; const char* nB = has_next ? (const char*)g.Bt + (size_t)nxt.pn * tstep : cB;
        for (int t = 0; t < nt; t += 2) {
            const bool last = (t == nt - 2);
            const char* a1 = cA + (size_t)(t + 1) * kstep;
            const char* a2 = last ? nA : cA + (size_t)(t + 2) * kstep; const char* b2 = last ? nB : cB + (size_t)(t + 2) * kstep;
            const char* a3 = a2 + kstep; const char* b3 = b2 + kstep;
            if (last && has_next) S.a_ready(nxt);
            PG8_LDB(B0, 0, 0); PG8_SCHED; PG8_LDA(At, 0, 0); PG8_STAGE(PG8_SA(1, 1), a1 + hstep, voffA);
            PG8_WAIT_L(8); PG8_BAR; PG8_WAIT_L(0); PG8_MMA(0, 0, At, B0); PG8_BAR; PG8_SCHED;
            PG8_LDB(B1, 0, 1); PG8_STAGE(PG8_SB(0, 0), b2, voffB);
            PG8_BAR; PG8_WAIT_L(0); PG8_MMA(0, 1, At, B1); PG8_BAR;
            PG8_LDA(At, 0, 1); PG8_STAGE(PG8_SA(0, 0), a2, voffA);
            PG8_BAR; PG8_WAIT_L(0); PG8_MMA(1, 0, At, B0); PG8_BAR; PG8_SCHED;
            PG8_STAGE(PG8_SB(0, 1), b2 + hstep, voffB);
            PG8_WAIT_V(6); PG8_BAR; PG8_MMA(1, 1, At, B1); PG8_BAR;
            PG8_LDB(B0, 1, 0); PG8_SCHED; PG8_LDA(At, 1, 0); PG8_STAGE(PG8_SA(0, 1), a2 + hstep, voffA);
            PG8_WAIT_L(8); PG8_BAR; PG8_WAIT_L(0); PG8_MMA(0, 0, At, B0); PG8_BAR; PG8_SCHED;
            PG8_LDB(B1, 1, 1); PG8_STAGE(PG8_SB(1, 0), b3, voffB);
            PG8_BAR; PG8_WAIT_L(0); PG8_MMA(0, 1, At, B1); PG8_BAR;
            PG8_LDA(At, 1, 1); PG8_STAGE(PG8_SA(1, 0), a3, voffA);
            PG8_BAR; PG8_WAIT_L(0); PG8_MMA(1, 0, At, B0); PG8_BAR; PG8_SCHED;
            PG8_STAGE(PG8_SB(1, 1), b3 + hstep, voffB);
            PG8_WAIT_V(6); PG8_BAR; PG8_MMA(1, 1, At, B1); PG8_BAR;
        }
        PG8_STAMP();
        if constexpr (!Epi::AFTER_DRAIN) { E(acc, cur, wr, wc, fr, fq); S.done(cur); }
        PG8_STAMP();
        if (!has_next) break;
#pragma unroll
        for (int a = 0; a < 2; ++a)
#pragma unroll
            for (int b = 0; b < 2; ++b)
#pragma unroll
                for (int m = 0; m < 4; ++m)
#pragma unroll
                    for (int n = 0; n < 2; ++n) acc[a][b][m][n] = (f32x4){0.f, 0.f, 0.f, 0.f};
        cur = nxt; cA = nA; cB = nB; ++ui;
    }
    PG8_WAIT_V(0);
    if (wr == 0) PG8_BAR;
    PG8_BAR;
    if constexpr (Epi::AFTER_DRAIN) { E.fused(acc, cur, wr, wc, fr, fq, lds, wid, lane); S.done(cur); }
    PG8_STAMP();
    if (STAMP && wid == 0) { stamps[lane] = lane < nts ? (((unsigned long long)(unsigned)ts_hi << 32) | (unsigned)ts_lo) : 0ull;
        if (lane == 62) stamps[62] = rt_entry; if (lane == 63) stamps[63] = (unsigned long long)wall_clock64(); }
#undef PG8_STAMP
#undef PG8_SA
#undef PG8_SB
#undef PG8_STAGE
#undef PG8_LDA
#undef PG8_LDB
#undef PG8_MMA
#undef PG8_WAIT_V
#undef PG8_WAIT_L
#undef PG8_BAR
#undef PG8_SCHED
}

__device__ __forceinline__ unsigned pk_bf16(float lo, float hi) { typedef float v2f __attribute__((ext_vector_type(2))); typedef __bf16 v2b __attribute__((ext_vector_type(2))); const v2f v = {lo, hi}; return __builtin_bit_cast(unsigned, __builtin_convertvector(v, v2b)); }
__device__ __forceinline__ float silu1(float x) { return x * __builtin_amdgcn_rcpf(1.0f + __expf(-x)); }
struct EpiBf16Act {
    static constexpr bool PERM = true, AFTER_DRAIN = false;
    bf16_t* O; int ldc; unsigned silu_mask;
    __device__ __forceinline__ void operator()(const f32x4 (&acc)[2][2][4][2], const Unit& u, int wr, int wc, int fr, int fq) const {
        const int row0 = u.pm * BM + wr * 64 + fr, col0 = u.pn * BM + wc * 32 + 8 * fq;
        const bool act = (silu_mask >> u.pn) & 1u;
#pragma unroll
        for (int ai = 0; ai < 2; ++ai)
#pragma unroll
            for (int m = 0; m < 4; ++m) { bf16_t* rowp = O + (size_t)(row0 + ai * HALF + m * 16) * ldc + col0;
#pragma unroll
                for (int bj = 0; bj < 2; ++bj) { f32x4 v0 = acc[ai][bj][m][0], v1 = acc[ai][bj][m][1];
                    if (act) {
#pragma unroll
                        for (int j = 0; j < 4; ++j) { v0[j] = silu1(v0[j]); v1[j] = silu1(v1[j]); } }
                    u32x4 w; w.x = pk_bf16(v0[0], v0[1]); w.y = pk_bf16(v0[2], v0[3]); w.z = pk_bf16(v1[0], v1[1]); w.w = pk_bf16(v1[2], v1[3]);
                    *(u32x4*)(rowp + bj * HALF) = w; } }
    }
};
struct EpiResid {
    static constexpr bool PERM = false, AFTER_DRAIN = false;
    float* C; const float* X; const float* mod_g;
    float alpha;
    __device__ __forceinline__ void operator()(const f32x4 (&acc)[2][2][4][2], const Unit& u, int wr, int wc, int fr, int fq) const {
        const int row0 = u.pm * BM + wr * 64 + fr, col0 = u.pn * BM + wc * 32 + 4 * fq;
        const float* gb = mod_g + (size_t)((u.pm * BM) / 2048) * 6144 + col0;
        f32x4 gv[2][2];
#pragma unroll
        for (int bj = 0; bj < 2; ++bj)
#pragma unroll
            for (int n = 0; n < 2; ++n) gv[bj][n] = *(const f32x4*)(gb + bj * HALF + n * 16) + 1.0f;
#pragma unroll
        for (int ai = 0; ai < 2; ++ai)
#pragma unroll
            for (int m = 0; m < 4; ++m) { const size_t ro = (size_t)(row0 + ai * HALF + m * 16) * 1024 + col0;
#pragma unroll
                for (int bj = 0; bj < 2; ++bj)
#pragma unroll
                    for (int n = 0; n < 2; ++n) { const f32x4 xv = *(const f32x4*)(X + ro + bj * HALF + n * 16); *(f32x4*)(C + ro + bj * HALF + n * 16) = alpha * xv + gv[bj][n] * acc[ai][bj][m][n]; } }
    }
};
struct EpiGlu {
    static constexpr bool PERM = false, AFTER_DRAIN = false;
    float* C; const bf16_t* Y; const float* bias;
    __device__ __forceinline__ void operator()(const f32x4 (&acc)[2][2][4][2], const Unit& u, int wr, int wc, int fr, int fq) const {
        const int row0 = u.pm * BM + wr * 64 + fr, col0 = u.pn * BM + wc * 32 + 4 * fq;
        f32x4 bv[2][2];
#pragma unroll
        for (int bj = 0; bj < 2; ++bj)
#pragma unroll
            for (int n = 0; n < 2; ++n) bv[bj][n] = *(const f32x4*)(bias + col0 + bj * HALF + n * 16);
#pragma unroll
        for (int ai = 0; ai < 2; ++ai)
#pragma unroll
            for (int m = 0; m < 4; ++m) { const size_t ro = (size_t)(row0 + ai * HALF + m * 16) * 512 + col0;
#pragma unroll
                for (int bj = 0; bj < 2; ++bj)
#pragma unroll
                    for (int n = 0; n < 2; ++n) {
                        const uint2 yw = *(const uint2*)(Y + ro + bj * HALF + n * 16);
                        const f32x4 z = acc[ai][bj][m][n] + bv[bj][n];
                        f32x4 o;
                        o[0] = __uint_as_float(yw.x << 16) * __builtin_amdgcn_rcpf(1.0f + __expf(-z[0])); o[1] = __uint_as_float(yw.x & 0xffff0000u) * __builtin_amdgcn_rcpf(1.0f + __expf(-z[1]));
                        o[2] = __uint_as_float(yw.y << 16) * __builtin_amdgcn_rcpf(1.0f + __expf(-z[2])); o[3] = __uint_as_float(yw.y & 0xffff0000u) * __builtin_amdgcn_rcpf(1.0f + __expf(-z[3]));
                        *(f32x4*)(C + ro + bj * HALF + n * 16) = o; } }
    }
};
}

DI void prep_mod_item(const Params& p, int item, char* smem) {
    float* cond = (float*)smem;
    const int tid = my_tid();
    for (int i = tid; i < NB * DM; i += NTH) cond[i] = siluf_(p.c[i]);
    __syncthreads();
    const int b = tid >> 5, col = item * 32 + (tid & 31);
    float acc = 0.f;
    const float* w = p.ada_w + col;
    const float* cb = cond + b * DM;
#pragma unroll 8
    for (int k = 0; k < DM; ++k) acc += cb[k] * w[(size_t)k * 6144];
    ((float*)(p.ws + OFF_MOD))[b * 6144 + col] = acc + p.ada_b[col];
    __syncthreads();
}
DI void prep_s5_gemm_item(const Params& p, int g, char* smem) {
    f32x2* pw = (f32x2*)smem;
    f32x2* bbL = pw + 17 * 64;
    f32x2* cL = bbL + 64 * 16;
    const int tid = my_tid();
    const float dt = expf(p.log_dt[g]);
#pragma unroll 1
    for (int idx = tid; idx < 17 * 64; idx += NTH) {
        const int j = idx >> 6, pp = idx & 63;
        const float ar = p.a_re[g * 64 + pp], ai = p.a_im[g * 64 + pp];
        const float mag = expf(ar * dt * (float)j), ang = ai * dt * (float)j;
        pw[idx] = (f32x2){mag * cosf(ang), mag * sinf(ang)};
    }
    for (int idx = tid; idx < 16 * 64; idx += NTH) { const int i = idx >> 6, pp = idx & 63; cL[idx] = (f32x2){p.c_re[(g * 16 + i) * 64 + pp], p.c_im[(g * 16 + i) * 64 + pp]}; }
    __syncthreads();
    for (int idx = tid; idx < 64 * 16; idx += NTH) {
        const int pp = idx >> 4, i = idx & 15;
        const float ar = p.a_re[g * 64 + pp], ai = p.a_im[g * 64 + pp];
        const f32x2 lam = pw[64 + pp];
        const float den = ar * ar + ai * ai, nr = lam.x - 1.0f, ni = lam.y;
        const float zr = (nr * ar + ni * ai) / den, zi = (ni * ar - nr * ai) / den;
        const float br = p.b_re[(g * 64 + pp) * 16 + i], bi = p.b_im[(g * 64 + pp) * 16 + i];
        bbL[idx] = (f32x2){zr * br - zi * bi, zr * bi + zi * br};
    }
    __syncthreads();
    bf16_t* NBg = (bf16_t*)(p.ws + OFF_S5N) + (size_t)g * 128 * 256;
#pragma unroll 1
    for (int ch = tid; ch < 128 * 256 / 8; ch += NTH) {
        const int pq = ch >> 5, t = (ch >> 1) & 15, i0 = (ch & 1) * 8, pp = pq & 63;
        const f32x2 w = pw[(15 - t) * 64 + pp];
        float v[8];
#pragma unroll
        for (int e = 0; e < 8; ++e) { const f32x2 bb = bbL[pp * 16 + i0 + e]; v[e] = pq < 64 ? (w.x * bb.x - w.y * bb.y) : (w.x * bb.y + w.y * bb.x); }
        u32x4 o; o.x = pack2(v[0], v[1]); o.y = pack2(v[2], v[3]); o.z = pack2(v[4], v[5]); o.w = pack2(v[6], v[7]);
        *(u32x4*)(NBg + (size_t)((((pq >> 5) * 16 + t) * 64) + (i0 >> 3) * 32 + (pq & 31)) * 8) = o;
    }
    bf16_t* MBg = (bf16_t*)(p.ws + OFF_S5M) + (size_t)g * 256 * 128;
#pragma unroll 1
    for (int ch = tid; ch < 256 * 128 / 8; ch += NTH) {
        const int ti = ch >> 4, p0 = (ch & 15) * 8, tq = ti >> 4, iq = ti & 15;
        float v[8];
#pragma unroll
        for (int e = 0; e < 8; ++e) {
            const int pq = p0 + e, pp = pq & 63;
            const f32x2 c = cL[iq * 64 + pp], w = pw[(tq + 1) * 64 + pp];
            v[e] = pq < 64 ? (c.x * w.x - c.y * w.y) : -(c.x * w.y + c.y * w.x);
        }
        u32x4 o; o.x = pack2(v[0], v[1]); o.y = pack2(v[2], v[3]); o.z = pack2(v[4], v[5]); o.w = pack2(v[6], v[7]);
        *(u32x4*)(MBg + (size_t)((((ti >> 5) * 8 + (p0 >> 4)) * 64) + ((p0 >> 3) & 1) * 32 + (ti & 31)) * 8) = o;
    }
    bf16_t* KTg = (bf16_t*)(p.ws + OFF_S5K) + (size_t)g * 4096;
#pragma unroll 1
    for (int idx = tid; idx < 4096; idx += NTH) {
        const int lag = idx >> 8, iq = (idx >> 4) & 15, i = idx & 15;
        float acc = (lag == 0 && iq == i) ? p.dsk[g * 16 + iq] : 0.f;
#pragma unroll 4
        for (int pp = 0; pp < 64; ++pp) {
            const f32x2 c = cL[iq * 64 + pp], w = pw[lag * 64 + pp], bb = bbL[pp * 16 + i];
            const float mr = c.x * w.x - c.y * w.y, mi_ = c.x * w.y + c.y * w.x;
            acc += mr * bb.x - mi_ * bb.y;
        }
        KTg[idx] = f2bf(acc);
    }
    if (tid < 64) { float* L = (float*)(p.ws + OFF_S5L) + (g * 64 + tid) * 2; const f32x2 w = pw[16 * 64 + tid]; L[0] = w.x; L[1] = w.y; }
    __syncthreads();
}
DI void prep_s5_item(const Params& p, int g) {
    const int tid = my_tid();
    if (tid < SSP) {
        const int pi = g * SSP + tid;
        const float dt = expf(p.log_dt[g]);
        const float ar = p.a_re[pi], ai = p.a_im[pi];
        const float mag = expf(ar * dt);
        const float lr = mag * cosf(ai * dt), li = mag * sinf(ai * dt);
        const float den = ar * ar + ai * ai, nr = lr - 1.0f, ni = li;
        const float zr = (nr * ar + ni * ai) / den, zi = (ni * ar - nr * ai) / den;
        float* lam = (float*)(p.ws + OFF_LAM) + pi * 2;
        lam[0] = lr; lam[1] = li;
        float* bb = (float*)(p.ws + OFF_BB) + (size_t)pi * 32;
        for (int i = 0; i < SSC; ++i) {
            const float br = p.b_re[pi * SSC + i], bi = p.b_im[pi * SSC + i];
            bb[i * 2] = zr * br - zi * bi; bb[i * 2 + 1] = zr * bi + zi * br;
        }
    }
}
DI void prep_transpose_tile(const float* __restrict__ W, bf16_t* __restrict__ Wt, int K, int N, int kt, int nt, char* smem) {
    float* tile = (float*)smem;
    const int tid = my_tid();
#pragma unroll
    for (int q = 0; q < 2; ++q) {
        const int kk = (tid >> 4) + q * 32, c4 = (tid & 15) * 4;
        const float4 v = *(const float4*)(W + (size_t)(kt * 64 + kk) * N + nt * 64 + c4);
        tile[kk * 65 + c4] = v.x; tile[kk * 65 + c4 + 1] = v.y; tile[kk * 65 + c4 + 2] = v.z; tile[kk * 65 + c4 + 3] = v.w;
    }
    __syncthreads();
    const int n = tid >> 3, kc = tid & 7;
    uint4 o;
    o.x = pack2(tile[(kc * 8 + 0) * 65 + n], tile[(kc * 8 + 1) * 65 + n]);
    o.y = pack2(tile[(kc * 8 + 2) * 65 + n], tile[(kc * 8 + 3) * 65 + n]);
    o.z = pack2(tile[(kc * 8 + 4) * 65 + n], tile[(kc * 8 + 5) * 65 + n]);
    o.w = pack2(tile[(kc * 8 + 6) * 65 + n], tile[(kc * 8 + 7) * 65 + n]);
    *(uint4*)(Wt + (size_t)(nt * 64 + n) * K + kt * 64 + kc * 8) = o;
    __syncthreads();
}
DI void cvt_bf16_stream(const float* __restrict__ src, bf16_t* __restrict__ dst, size_t n8, int bid, int nb) {
    for (size_t i = (size_t)bid * NTH + my_tid(); i < n8; i += (size_t)nb * NTH) {
        const float4 a = *(const float4*)(src + i * 8), b = *(const float4*)(src + i * 8 + 4);
        uint4 o; o.x = pack2(a.x, a.y); o.y = pack2(a.z, a.w); o.z = pack2(b.x, b.y); o.w = pack2(b.z, b.w);
        *(uint4*)(dst + i * 8) = o;
    }
}
DI void cvt_fp8_rows(const float* __restrict__ src, unsigned char* __restrict__ dst, float* __restrict__ inv, int bid, int nb) {
    const int lane = my_tid() & 63, wid = my_tid() >> 6;
    for (int row = bid * 8 + wid; row < NEXP; row += nb * 8) {
        const float* sp = src + (size_t)row * DM + lane * 16;
        const f32x4 a = *(const f32x4*)sp, b = *(const f32x4*)(sp + 4), c = *(const f32x4*)(sp + 8), d = *(const f32x4*)(sp + 12);
        float m = fmaxf(fmaxf(fmaxf(fabsf(a.x), fabsf(a.y)), fmaxf(fabsf(a.z), fabsf(a.w))), fmaxf(fmaxf(fabsf(b.x), fabsf(b.y)), fmaxf(fabsf(b.z), fabsf(b.w))));
        m = fmaxf(m, fmaxf(fmaxf(fmaxf(fabsf(c.x), fabsf(c.y)), fmaxf(fabsf(c.z), fabsf(c.w))), fmaxf(fmaxf(fabsf(d.x), fabsf(d.y)), fmaxf(fabsf(d.z), fabsf(d.w)))));
#pragma unroll
        for (int s = 1; s < 64; s <<= 1) m = fmaxf(m, __shfl_xor(m, s));
        float sc = 1.f, isc = 1.f;
        if (m > 1e-30f) {
            int k = (int)floorf(log2f(448.0f / m));
            k = k < -60 ? -60 : (k > 60 ? 60 : k);
            sc = ldexpf(1.0f, k); isc = ldexpf(1.0f, -k);
            if (m * sc > 448.0f) { sc *= 0.5f; isc *= 2.0f; }
        }
        u32x4 o;
        int w;
        w = __builtin_amdgcn_cvt_pk_fp8_f32(a.x * sc, a.y * sc, 0, false); w = __builtin_amdgcn_cvt_pk_fp8_f32(a.z * sc, a.w * sc, w, true); o.x = (unsigned)w;
        w = __builtin_amdgcn_cvt_pk_fp8_f32(b.x * sc, b.y * sc, 0, false); w = __builtin_amdgcn_cvt_pk_fp8_f32(b.z * sc, b.w * sc, w, true); o.y = (unsigned)w;
        w = __builtin_amdgcn_cvt_pk_fp8_f32(c.x * sc, c.y * sc, 0, false); w = __builtin_amdgcn_cvt_pk_fp8_f32(c.z * sc, c.w * sc, w, true); o.z = (unsigned)w;
        w = __builtin_amdgcn_cvt_pk_fp8_f32(d.x * sc, d.y * sc, 0, false); w = __builtin_amdgcn_cvt_pk_fp8_f32(d.z * sc, d.w * sc, w, true); o.w = (unsigned)w;
        *(u32x4*)(dst + (size_t)row * DM + lane * 16) = o;
        if (lane == 0) inv[row] = isc;
    }
}
DI void phase_prep(const Params& p, int bid, int nb, char* smem) {
    constexpr int N_MOD = 192, N_LB = 1, N_S5 = 32, T_WIN = 16 * 40, T_GLU = 8 * 8, T_WOUT = 16 * 16, T_WQ = 16 * 32;
    constexpr int I_LB = N_MOD, I_S5 = I_LB + N_LB, I_WIN = I_S5 + N_S5, I_GLU = I_WIN + T_WIN, I_WOUT = I_GLU + T_GLU, I_WQ = I_WOUT + T_WOUT, I_END = I_WQ + T_WQ;
    for (int it = bid; it < I_END; it += nb) {
        if (it < N_MOD) prep_mod_item(p, it, smem);
        else if (it < I_S5) {
            const int j = my_tid();
            const float a0 = p.hg_lb[j], a1 = p.hg_lb[512 + j], m = fmaxf(a0, a1);
            const float e0 = expf(a0 - m), e1 = expf(a1 - m);
            ((float*)(p.ws + OFF_LB))[j] = e0 / (e0 + e1);
        } else if (it < I_WIN) { prep_s5_item(p, it - I_S5); prep_s5_gemm_item(p, it - I_S5, smem); }
        else if (it < I_GLU) { const int t = it - I_WIN; prep_transpose_tile(p.w_in, (bf16_t*)(p.ws + OFF_WIN), DM, INC, t / 40, t % 40, smem); }
        else if (it < I_WOUT) { const int t = it - I_GLU; prep_transpose_tile(p.glu_w, (bf16_t*)(p.ws + OFF_GLU), 512, 512, t / 8, t % 8, smem); }
        else if (it < I_WQ) { const int t = it - I_WOUT; prep_transpose_tile(p.w_out, (bf16_t*)(p.ws + OFF_WOUT), DM, DM, t / 16, t % 16, smem); }
        else { const int t = it - I_WQ; prep_transpose_tile(p.w_q, (bf16_t*)(p.ws + OFF_WQ), DM, 2048, t / 32, t % 32, smem); }
    }
    cvt_bf16_stream(p.subk, (bf16_t*)(p.ws + OFF_SUBK), (size_t)16 * 128 * 128 / 8, bid, nb);
    cvt_fp8_rows(p.pu, (unsigned char*)(p.ws + OFF_UT), (float*)(p.ws + OFF_SU), bid, nb);
    cvt_fp8_rows(p.pv, (unsigned char*)(p.ws + OFF_VT), (float*)(p.ws + OFF_SV), bid, nb);
}

DI void phase_h(const Params& p, int bid, int nb) {
    const float* mod = (const float*)(p.ws + OFF_MOD);
    bf16_t* H = (bf16_t*)(p.ws + OFF_H);
    const size_t n8 = (size_t)NTOK * DM / 8;
    for (size_t i = (size_t)bid * NTH + my_tid(); i < n8; i += (size_t)nb * NTH) {
        const int row = (int)(i >> 7), c0 = (int)(i & 127) * 8, b = row / SEQ;
        const float* sh = mod + b * 6144 + c0;
        const float* sc = sh + 1024;
        const float4 a = *(const float4*)(p.x + i * 8), bq = *(const float4*)(p.x + i * 8 + 4);
        const float4 s0 = *(const float4*)sc, s1 = *(const float4*)(sc + 4), h0 = *(const float4*)sh, h1 = *(const float4*)(sh + 4);
        uint4 o;
        o.x = pack2(a.x * (1.f + s0.x) + h0.x, a.y * (1.f + s0.y) + h0.y);
        o.y = pack2(a.z * (1.f + s0.z) + h0.z, a.w * (1.f + s0.w) + h0.w);
        o.z = pack2(bq.x * (1.f + s1.x) + h1.x, bq.y * (1.f + s1.y) + h1.y);
        o.w = pack2(bq.z * (1.f + s1.z) + h1.z, bq.w * (1.f + s1.w) + h1.w);
        *(uint4*)(H + i * 8) = o;
    }
}

DI void phase_proj(const Params& p, int bid, int nb, char* smem) {
    pg8::Gemm g{(const bf16_t*)(p.ws + OFF_H), (const bf16_t*)(p.ws + OFF_WIN), NTOK, INC, DM};
    pg8::StaticOrder S; S.init(NTOK, INC, nb, bid);
    pg8::EpiBf16Act E{(bf16_t*)(p.ws + OFF_PROJ), INC, 0xC3u};
    pg8::gemm_phase<pg8::EpiBf16Act, pg8::StaticOrder, false>((PG8_LAS unsigned char*)smem, g, S, E, nullptr);
}

DI void hgrn_item(const Params& p, int item, char* smem) {
    const int vs = item & 7, hd = (item >> 3) & 3, b = item >> 5;
    const bf16_t* P = (const bf16_t*)(p.ws + OFF_PROJ);
    const float* lb = (const float*)(p.ws + OFF_LB) + hd * HDK;
    float* ORAW = (float*)(p.ws + OFF_ORAW);
    float* sq = (float*)smem;
    float* sf = sq + 32 * 128;
    float* sv = sf + 32 * 128;
    float* sp = sv + 32 * 16;
    const int tid = my_tid(), lane = tid & 63, wid = tid >> 6, kq = tid >> 4, v = tid & 15;
    float S0 = 0.f, S1 = 0.f, S2 = 0.f, S3 = 0.f;
    for (int t0 = 0; t0 < SEQ; t0 += 32) {
        for (int i = tid; i < 32 * 128; i += NTH) {
            const int t = i >> 7, k = i & 127;
            const bf16_t* row = P + (size_t)(b * SEQ + t0 + t) * INC + hd * HDK + k;
            sq[i] = bf2f(row[0]);
            const float l = lb[k];
            sf[i] = l + (1.0f - l) * sigmoidf_(bf2f(row[512]));
        }
        { const int t = tid >> 4; sv[tid] = bf2f(P[(size_t)(b * SEQ + t0 + t) * INC + 1024 + hd * HDK + vs * 16 + v]); }
        __syncthreads();
        for (int t = 0; t < 32; ++t) {
            const float4 f4 = *(const float4*)(sf + t * 128 + kq * 4), q4 = *(const float4*)(sq + t * 128 + kq * 4);
            const float vv = sv[t * 16 + v];
            S0 = f4.x * S0 + (1.0f - f4.x) * vv; S1 = f4.y * S1 + (1.0f - f4.y) * vv;
            S2 = f4.z * S2 + (1.0f - f4.z) * vv; S3 = f4.w * S3 + (1.0f - f4.w) * vv;
            float part = q4.x * S0 + q4.y * S1 + q4.z * S2 + q4.w * S3;
            part += __shfl_xor(part, 16); part += __shfl_xor(part, 32);
            if (lane < 16) sp[(t * 8 + wid) * 16 + v] = part;
        }
        __syncthreads();
        {
            const int t = tid >> 4;
            float o = 0.f;
#pragma unroll
            for (int w = 0; w < 8; ++w) o += sp[(t * 8 + w) * 16 + v];
            ORAW[(size_t)(b * SEQ + t0 + t) * DHG + hd * HDK + vs * 16 + v] = o;
        }
        __syncthreads();
    }
}
DI void s5_item(const Params& p, int item, char* smem) {
    const int oct = item & 3, b = item >> 2;
    const int tid = my_tid(), lane = tid & 63, wid = tid >> 6, g = oct * 8 + wid;
    const bf16_t* P = (const bf16_t*)(p.ws + OFF_PROJ);
    bf16_t* Y = (bf16_t*)(p.ws + OFF_YSSM);
    float* su = (float*)smem + wid * 64 * 16;
    const float* lam = (const float*)(p.ws + OFF_LAM) + (g * SSP + lane) * 2;
    const float lr = lam[0], li = lam[1];
    const float* bb = (const float*)(p.ws + OFF_BB) + (size_t)(g * SSP + lane) * 32;
    float bbr[16], bbi[16], cr[16], ci[16];
#pragma unroll
    for (int i = 0; i < 16; ++i) { bbr[i] = bb[2 * i]; bbi[i] = bb[2 * i + 1]; cr[i] = p.c_re[(g * SSC + i) * SSP + lane]; ci[i] = p.c_im[(g * SSC + i) * SSP + lane]; }
    const int ch = (lane >> 2) & 15;
    const float dch = p.dsk[g * SSC + ch];
    float xr = 0.f, xi = 0.f;
    for (int t0 = 0; t0 < SEQ; t0 += 64) {
        {
            const uint4* src = (const uint4*)(P + (size_t)(b * SEQ + t0 + lane) * INC + 2048 + g * SSC);
            const uint4 a = src[0], c = src[1];
            float* d = su + lane * 16;
            d[0] = bflo(a.x); d[1] = bfhi(a.x); d[2] = bflo(a.y); d[3] = bfhi(a.y); d[4] = bflo(a.z); d[5] = bfhi(a.z); d[6] = bflo(a.w); d[7] = bfhi(a.w);
            d[8] = bflo(c.x); d[9] = bfhi(c.x); d[10] = bflo(c.y); d[11] = bfhi(c.y); d[12] = bflo(c.z); d[13] = bfhi(c.z); d[14] = bflo(c.w); d[15] = bfhi(c.w);
        }
        __syncthreads();
        for (int t = 0; t < 64; ++t) {
            float u[16];
            const float4* us = (const float4*)(su + t * 16);
            const float4 u0 = us[0], u1 = us[1], u2 = us[2], u3 = us[3];
            u[0] = u0.x; u[1] = u0.y; u[2] = u0.z; u[3] = u0.w; u[4] = u1.x; u[5] = u1.y; u[6] = u1.z; u[7] = u1.w;
            u[8] = u2.x; u[9] = u2.y; u[10] = u2.z; u[11] = u2.w; u[12] = u3.x; u[13] = u3.y; u[14] = u3.z; u[15] = u3.w;
            float bur = 0.f, bui = 0.f;
#pragma unroll
            for (int i = 0; i < 16; ++i) { bur += bbr[i] * u[i]; bui += bbi[i] * u[i]; }
            const float nxr = lr * xr - li * xi + bur, nxi = lr * xi + li * xr + bui;
            xr = nxr; xi = nxi;
            float y[16];
#pragma unroll
            for (int i = 0; i < 16; ++i) y[i] = cr[i] * xr - ci[i] * xi;
            const bool b5 = lane & 32, b4 = lane & 16, b3 = lane & 8, b2 = lane & 4;
            float y8[8], y4[4], y2[2];
#pragma unroll
            for (int j = 0; j < 8; ++j) { const float keep = b5 ? y[8 + j] : y[j], send = b5 ? y[j] : y[8 + j]; y8[j] = keep + __shfl_xor(send, 32); }
#pragma unroll
            for (int j = 0; j < 4; ++j) { const float keep = b4 ? y8[4 + j] : y8[j], send = b4 ? y8[j] : y8[4 + j]; y4[j] = keep + __shfl_xor(send, 16); }
#pragma unroll
            for (int j = 0; j < 2; ++j) { const float keep = b3 ? y4[2 + j] : y4[j], send = b3 ? y4[j] : y4[2 + j]; y2[j] = keep + __shfl_xor(send, 8); }
            float y1;
            { const float keep = b2 ? y2[1] : y2[0], send = b2 ? y2[0] : y2[1]; y1 = keep + __shfl_xor(send, 4); }
            y1 += __shfl_xor(y1, 1); y1 += __shfl_xor(y1, 2);
            if ((lane & 3) == 0) {
                const float uu = su[t * 16 + ch];
                Y[(size_t)(b * SEQ + t0 + t) * DSS + g * SSC + ch] = f2bf(geluf_(y1 + dch * uu));
            }
        }
        __syncthreads();
    }
}
DI int crow(int i, int h) { return (i & 3) + 8 * (i >> 2) + 4 * h; }
DI void phase_hgprep(const Params& p, int bid, int nb) {
    const bf16_t* P = (const bf16_t*)(p.ws + OFF_PROJ);
    const float* lbp = (const float*)(p.ws + OFF_LB);
    const int tid = my_tid(), lane = tid & 63, wid = tid >> 6, tq = lane >> 4, cg = lane & 15;
#pragma unroll 1
    for (int it = bid * 8 + wid; it < 8192; it += nb * 8) {
        const int tile = it >> 1, c = tile & 63, hd = (tile >> 6) & 3, b = tile >> 8, k0 = (it & 1) * 64 + cg * 4;
        const bf16_t* base = P + (size_t)(b * SEQ + c * 32 + tq * 8) * INC + hd * HDK + k0;
        uint2 qw[8], fw[8];
#pragma unroll
        for (int tt = 0; tt < 8; ++tt) { qw[tt] = *(const uint2*)(base + (size_t)tt * INC); fw[tt] = *(const uint2*)(base + (size_t)tt * INC + 512); }
        const f32x4 l4 = *(const f32x4*)(lbp + hd * HDK + k0);
        const float lb4[4] = {l4.x, l4.y, l4.z, l4.w};
        float bl[8][4], kk[8][4], run[4];
#pragma unroll
        for (int e = 0; e < 4; ++e) run[e] = 0.f;
#pragma unroll
        for (int tt = 0; tt < 8; ++tt) {
            const float fl[4] = {bflo(fw[tt].x), bfhi(fw[tt].x), bflo(fw[tt].y), bfhi(fw[tt].y)};
#pragma unroll
            for (int e = 0; e < 4; ++e) {
                const float f = lb4[e] + (1.0f - lb4[e]) * sigmoidf_(fl[e]);
                run[e] += __logf(f); bl[tt][e] = run[e]; kk[tt][e] = 1.0f - f;
            }
        }
        float off[4], tot[4];
#pragma unroll
        for (int e = 0; e < 4; ++e) {
            const float t0 = __shfl(run[e], cg), t1 = __shfl(run[e], cg + 16), t2 = __shfl(run[e], cg + 32), t3 = __shfl(run[e], cg + 48);
            off[e] = (tq > 0 ? t0 : 0.f) + (tq > 1 ? t1 : 0.f) + (tq > 2 ? t2 : 0.f);
            tot[e] = (t0 + t1) + (t2 + t3);
        }
        bf16_t* HQ = (bf16_t*)(p.ws + OFF_HQ) + (size_t)tile * 4096 + (tq * 8) * 128 + k0;
        bf16_t* HK = (bf16_t*)(p.ws + OFF_HK) + (size_t)tile * 4096 + (tq * 8) * 128 + k0;
#pragma unroll
        for (int tt = 0; tt < 8; ++tt) {
            const float qv[4] = {bflo(qw[tt].x), bfhi(qw[tt].x), bflo(qw[tt].y), bfhi(qw[tt].y)};
            float qo[4], ko[4];
#pragma unroll
            for (int e = 0; e < 4; ++e) { const float bb = off[e] + bl[tt][e]; qo[e] = qv[e] * __expf(bb); ko[e] = kk[tt][e] * __expf(fminf(-bb, 80.0f)); }
            *(uint2*)(HQ + tt * 128) = make_uint2(pack2(qo[0], qo[1]), pack2(qo[2], qo[3]));
            *(uint2*)(HK + tt * 128) = make_uint2(pack2(ko[0], ko[1]), pack2(ko[2], ko[3]));
        }
        if (tq == 0) *(f32x4*)((float*)(p.ws + OFF_HG) + (size_t)tile * 128 + k0) = (f32x4){__expf(tot[0]), __expf(tot[1]), __expf(tot[2]), __expf(tot[3])};
    }
}
typedef short s16x4 __attribute__((ext_vector_type(4)));
DI bf16x8 cat8(const s16x4 lo, const s16x4 hi) { return (bf16x8){lo.x, lo.y, lo.z, lo.w, hi.x, hi.y, hi.z, hi.w}; }
DI s16x4 lds_tr(const char* a) { return __builtin_amdgcn_ds_read_tr16_b64_v4i16((__attribute__((address_space(3))) s16x4*)a); }
DI void hgrn_mfma_item(const Params& p, int item, char* smem) {
    constexpr int QP_OFF = 0, KP_OFF = 8704, V_OFF = 17408, G_OFF = 26112, BUF = 26624;
    const int tid = my_tid(), lane = tid & 63, wid = tid >> 6, r = lane & 31, h = lane >> 5;
    const int b = item >> 2, hd = item & 3;
    const size_t tile0 = (size_t)item * 64;
    const bf16_t* HQ = (const bf16_t*)(p.ws + OFF_HQ) + tile0 * 4096;
    const bf16_t* HK = (const bf16_t*)(p.ws + OFF_HK) + tile0 * 4096;
    const bf16_t* PV = (const bf16_t*)(p.ws + OFF_PROJ) + (size_t)b * SEQ * INC + 1024 + hd * HDK;
    const float* HG = (const float*)(p.ws + OFF_HG) + tile0 * 128;
    float* ORAW = (float*)(p.ws + OFF_ORAW) + (size_t)b * SEQ * DHG + hd * HDK;
    const bool helper = wid >= 4;
    const int ht = tid - 256;
    const int i0 = ht, i1 = ht + 256;
    const int lo0 = (i0 >> 4) * 272 + (i0 & 15) * 16, lo1 = (i1 >> 4) * 272 + (i1 & 15) * 16;
    u32x4 A0, A1, A2, A3, A4, A5, A6, B0, B1, B2, B3, B4, B5, B6;
    A0 = A1 = A2 = A3 = A4 = A5 = A6 = B0 = B1 = B2 = B3 = B4 = B5 = B6 = (u32x4){0, 0, 0, 0};
    f32x16 S[4];
#pragma unroll
    for (int kb = 0; kb < 4; ++kb)
#pragma unroll
        for (int i = 0; i < 16; ++i) S[kb][i] = 0.f;
#define HG_LOAD(X, c_) { const size_t o_ = (size_t)(c_) * 4096; \
        X##0 = *(const u32x4*)(HQ + o_ + i0 * 8); X##1 = *(const u32x4*)(HQ + o_ + i1 * 8); \
        X##2 = *(const u32x4*)(HK + o_ + i0 * 8); X##3 = *(const u32x4*)(HK + o_ + i1 * 8); \
        X##4 = *(const u32x4*)(PV + (size_t)((c_) * 32 + (i0 >> 4)) * INC + (i0 & 15) * 8); X##5 = *(const u32x4*)(PV + (size_t)((c_) * 32 + (i1 >> 4)) * INC + (i1 & 15) * 8); \
        if (ht < 32) X##6 = *(const u32x4*)(HG + (size_t)(c_) * 128 + ht * 4); }
#define HG_STORE(X, buf_) { char* B_ = smem + (buf_) * BUF; \
        *(u32x4*)(B_ + QP_OFF + lo0) = X##0; *(u32x4*)(B_ + QP_OFF + lo1) = X##1; \
        *(u32x4*)(B_ + KP_OFF + lo0) = X##2; *(u32x4*)(B_ + KP_OFF + lo1) = X##3; \
        *(u32x4*)(B_ + V_OFF + lo0) = X##4; *(u32x4*)(B_ + V_OFF + lo1) = X##5; \
        if (ht < 32) *(u32x4*)(B_ + G_OFF + ht * 16) = X##6; }
    const int tq = (lane >> 2) & 3, tp = lane & 3, tg = lane >> 4;
    const int tr_nat = (8 * (tg >> 1) + tq) * 272 + (16 * (tg & 1) + 4 * tp) * 2;
    const int tr_krw = (4 * (tg >> 1) + tq) * 272 + (16 * (tg & 1) + 4 * tp) * 2;
    if (helper) { HG_LOAD(A, 0); HG_STORE(A, 0); HG_LOAD(A, 1); HG_STORE(A, 1); HG_LOAD(A, 2); HG_LOAD(B, 3); }
    __syncthreads();
#define HG_COMPUTE(c_) { \
        const char* B = smem + ((c_) % 3) * BUF; const int w = wid; \
        f32x16 pt; _Pragma("unroll") for (int i = 0; i < 16; ++i) pt[i] = 0.f; \
        _Pragma("unroll") for (int ks = 0; ks < 8; ++ks) { \
            const bf16x8 a = *(const bf16x8*)(B + KP_OFF + r * 272 + ks * 32 + h * 16); \
            const bf16x8 bq = *(const bf16x8*)(B + QP_OFF + r * 272 + ks * 32 + h * 16); \
            pt = __builtin_amdgcn_mfma_f32_32x32x16_bf16(a, bq, pt, 0, 0, 0); } \
        _Pragma("unroll") for (int i = 0; i < 16; ++i) if (crow(i, h) > r) pt[i] = 0.f; \
        f32x16 o; _Pragma("unroll") for (int i = 0; i < 16; ++i) o[i] = 0.f; \
        _Pragma("unroll") for (int sp = 0; sp < 2; ++sp) { \
            const char* vb = B + V_OFF + (16 * sp) * 272 + (32 * w) * 2 + tr_krw; \
            const bf16x8 bv = cat8(lds_tr(vb), lds_tr(vb + 8 * 272)); \
            o = __builtin_amdgcn_mfma_f32_32x32x16_bf16(pack8(pt, 8 * sp), bv, o, 0, 0, 0); } \
        _Pragma("unroll") for (int kb = 0; kb < 4; ++kb) _Pragma("unroll") for (int sp = 0; sp < 2; ++sp) { \
            const char* qb = B + QP_OFF + r * 272 + kb * 64 + sp * 32 + h * 8; \
            const bf16x8 aq = cat8(*(const s16x4*)qb, *(const s16x4*)(qb + 16)); \
            o = __builtin_amdgcn_mfma_f32_32x32x16_bf16(aq, pack8(S[kb], 8 * sp), o, 0, 0, 0); } \
        _Pragma("unroll") for (int i = 0; i < 16; ++i) ORAW[(size_t)((c_) * 32 + crow(i, h)) * DHG + 32 * w + r] = o[i]; \
        bf16x8 bvn[2]; \
        _Pragma("unroll") for (int ks = 0; ks < 2; ++ks) { const char* vb = B + V_OFF + (16 * ks) * 272 + (32 * w) * 2 + tr_nat; bvn[ks] = cat8(lds_tr(vb), lds_tr(vb + 4 * 272)); } \
        _Pragma("unroll") for (int kb = 0; kb < 4; ++kb) { \
            _Pragma("unroll") for (int ks = 0; ks < 2; ++ks) { \
                const char* kp = B + KP_OFF + (16 * ks) * 272 + (32 * kb) * 2 + tr_nat; \
                const bf16x8 a = cat8(lds_tr(kp), lds_tr(kp + 4 * 272)); \
                S[kb] = __builtin_amdgcn_mfma_f32_32x32x16_bf16(a, bvn[ks], S[kb], 0, 0, 0); } \
            _Pragma("unroll") for (int j = 0; j < 4; ++j) { \
                const f32x4 g4 = *(const f32x4*)(B + G_OFF + (kb * 32 + 8 * j + 4 * h) * 4); \
                S[kb][4 * j] *= g4.x; S[kb][4 * j + 1] *= g4.y; S[kb][4 * j + 2] *= g4.z; S[kb][4 * j + 3] *= g4.w; } } }
    for (int c = 0; c < 64; c += 2) {
        if (helper) { if (c + 2 < 64) HG_STORE(A, (c + 2) % 3); if (c + 4 < 64) HG_LOAD(A, c + 4); } else HG_COMPUTE(c);
        __syncthreads();
        if (helper) { if (c + 3 < 64) HG_STORE(B, (c + 3) % 3); if (c + 5 < 64) HG_LOAD(B, c + 5); } else HG_COMPUTE(c + 1);
        __syncthreads();
    }
#undef HG_LOAD
#undef HG_STORE
#undef HG_COMPUTE
}
template <int NJ>
DI void s5_gemm2_tile(const bf16x8 (&af)[16], const bf16_t* KTl, const bf16_t* Xin, const bf16_t* MBg, bf16_t* Yout, bf16_t* stg, const int mi, const int r, const int h) {
    f32x16 y;
#pragma unroll
    for (int i = 0; i < 16; ++i) y[i] = 0.f;
    const int tsel = r >> 4, iq = r & 15;
    bf16x8 bm[8];
#pragma unroll
    for (int ks = 0; ks < 8; ++ks) bm[ks] = *(const bf16x8*)(MBg + (size_t)((NJ * 8 + ks) * 64 + h * 32 + r) * 8);
#pragma unroll
    for (int ks = 0; ks <= 2 * NJ; ++ks) {
        const bf16x8 bk = *(const bf16x8*)(KTl + ((2 * NJ + tsel - ks) * 16 + iq) * 16 + 8 * h);
        y = __builtin_amdgcn_mfma_f32_32x32x16_bf16(af[ks], bk, y, 0, 0, 0);
    }
    {
        bf16x8 bk = *(const bf16x8*)(KTl + iq * 16 + 8 * h);
        if (tsel == 0) bk = (bf16x8){0, 0, 0, 0, 0, 0, 0, 0};
        y = __builtin_amdgcn_mfma_f32_32x32x16_bf16(af[2 * NJ + 1], bk, y, 0, 0, 0);
    }
#pragma unroll
    for (int ks = 0; ks < 8; ++ks) {
        const bf16x8 a = *(const bf16x8*)(Xin + (mi * 32 + r) * 136 + ks * 16 + 8 * h);
        y = __builtin_amdgcn_mfma_f32_32x32x16_bf16(a, bm[ks], y, 0, 0, 0);
    }
#pragma unroll
    for (int i = 0; i < 16; ++i) stg[((crow(i, h) * 2 + tsel) * 16) + iq] = f2bf(gelu_as(y[i]));
    {
        const int lane = h * 32 + r, cl = lane >> 1, ts = lane & 1;
        const u32x4 lo = *(const u32x4*)(stg + lane * 16), hi = *(const u32x4*)(stg + lane * 16 + 8);
        bf16_t* dst = Yout + (size_t)((mi * 32 + cl) * 16 + 2 * NJ + ts) * DSS;
        *(u32x4*)dst = lo; *(u32x4*)(dst + 8) = hi;
    }
}
DI void s5_gemm_item(const Params& p, int b, int g, char* smem) {
    float* E = (float*)smem;
    bf16_t* Xin = (bf16_t*)(smem + 128 * 132 * 4);
    bf16_t* KTl = Xin + 128 * 136;
    const int tid = my_tid(), lane = tid & 63, wid = tid >> 6, r = lane & 31, h = lane >> 5;
    const int mi = wid >> 1, wh = wid & 1;
    const bf16_t* P = (const bf16_t*)(p.ws + OFF_PROJ);
    *(u32x4*)(KTl + tid * 8) = *(const u32x4*)((const bf16_t*)(p.ws + OFF_S5K) + (size_t)g * 4096 + tid * 8);
    bf16x8 af[16];
    {
        const bf16_t* ub = P + (size_t)(b * SEQ + (mi * 32 + r) * 16) * INC + 2048 + g * 16 + 8 * h;
#pragma unroll
        for (int ks = 0; ks < 16; ++ks) af[ks] = *(const bf16x8*)(ub + (size_t)ks * INC);
    }
#ifndef S5_REP_G1
#define S5_REP_G1 1
#define S5_REP_SC 1
#define S5_REP_G2 1
#endif
    for (int rp1 = 0; rp1 < S5_REP_G1; ++rp1)
    {
        f32x16 e0, e1;
#pragma unroll
        for (int i = 0; i < 16; ++i) { e0[i] = 0.f; e1[i] = 0.f; }
        const bf16_t* nb0 = (const bf16_t*)(p.ws + OFF_S5N) + (size_t)g * 128 * 256 + (size_t)(wh * 2) * 16 * 512 + lane * 8;
#pragma unroll
        for (int ks = 0; ks < 16; ++ks) {
            const bf16x8 b0 = *(const bf16x8*)(nb0 + ks * 512), b1 = *(const bf16x8*)(nb0 + 16 * 512 + ks * 512);
            e0 = __builtin_amdgcn_mfma_f32_32x32x16_bf16(af[ks], b0, e0, 0, 0, 0);
            e1 = __builtin_amdgcn_mfma_f32_32x32x16_bf16(af[ks], b1, e1, 0, 0, 0);
        }
#pragma unroll
        for (int i = 0; i < 16; ++i) { float* er = E + (mi * 32 + crow(i, h)) * 132 + wh * 64 + r; er[0] = e0[i]; er[32] = e1[i]; }
    }
    __syncthreads();
    for (int rp2 = 0; rp2 < S5_REP_SC; ++rp2)
    if (wid == 0) {
        const float* L = (const float*)(p.ws + OFF_S5L) + (g * 64 + lane) * 2;
        const float lr = L[0], li = L[1];
        float xr = 0.f, xi = 0.f;
#pragma unroll 8
        for (int c = 0; c < 128; ++c) {
            const float er = E[c * 132 + lane], ei = E[c * 132 + 64 + lane];
            Xin[c * 136 + lane] = f2bf(xr); Xin[c * 136 + 64 + lane] = f2bf(xi);
            const float nr = lr * xr - li * xi + er, ni = lr * xi + li * xr + ei;
            xr = nr; xi = ni;
        }
    }
    __syncthreads();
    const bf16_t* MBg = (const bf16_t*)(p.ws + OFF_S5M) + (size_t)g * 256 * 128;
    bf16_t* Yout = (bf16_t*)(p.ws + OFF_YSSM) + (size_t)b * SEQ * DSS + g * 16;
    bf16_t* stg = (bf16_t*)smem + wid * 1024;
    for (int rp3 = 0; rp3 < S5_REP_G2; ++rp3)
    if (wh) {
        s5_gemm2_tile<1>(af, KTl, Xin, MBg, Yout, stg, mi, r, h); s5_gemm2_tile<6>(af, KTl, Xin, MBg, Yout, stg, mi, r, h);
        s5_gemm2_tile<3>(af, KTl, Xin, MBg, Yout, stg, mi, r, h); s5_gemm2_tile<4>(af, KTl, Xin, MBg, Yout, stg, mi, r, h);
    } else {
        s5_gemm2_tile<0>(af, KTl, Xin, MBg, Yout, stg, mi, r, h); s5_gemm2_tile<7>(af, KTl, Xin, MBg, Yout, stg, mi, r, h);
        s5_gemm2_tile<2>(af, KTl, Xin, MBg, Yout, stg, mi, r, h); s5_gemm2_tile<5>(af, KTl, Xin, MBg, Yout, stg, mi, r, h);
    }
    __syncthreads();
}
DI void phase_mix(const Params& p, int bid, int nb, char* smem) {
    if (nb == 256) {
#ifndef PROBE_HGX
#define PROBE_HGX 1
#endif
        if (bid < 64) { for (int rep = 0; rep < PROBE_HGX; ++rep) hgrn_mfma_item(p, bid, smem); return; }
        const int j = bid - 64, x = j & 7, lb = j >> 3;
#ifndef PROBE_S5X
#define PROBE_S5X 1
#endif
        for (int rep = 0; rep < PROBE_S5X; ++rep)
        for (int q = lb; q < 64; q += 24) s5_gemm_item(p, q & 15, x * 4 + (q >> 4), smem);
    } else {
        for (int it = bid; it < 64; it += nb) hgrn_mfma_item(p, it, smem);
        for (int q = bid; q < 512; q += nb) s5_gemm_item(p, q & 15, q >> 4, smem);
    }
}

DI void phase_glu(const Params& p, int bid, int nb, char* smem) {
    pg8::Gemm g{(const bf16_t*)(p.ws + OFF_YSSM), (const bf16_t*)(p.ws + OFF_GLU), NTOK, 512, 512};
    pg8::StaticOrder S; S.init(NTOK, 512, nb, bid);
    pg8::EpiGlu E{(float*)(p.ws + OFF_H), (const bf16_t*)(p.ws + OFF_YSSM), p.glu_b};
    pg8::gemm_phase<pg8::EpiGlu, pg8::StaticOrder, false>((PG8_LAS unsigned char*)smem, g, S, E, nullptr);
}
DI void phase_a2(const Params& p, int bid, int nb) {
    const float* ORAW = (const float*)(p.ws + OFF_ORAW);
    const float* Y2 = (const float*)(p.ws + OFF_H);
    const bf16_t* P = (const bf16_t*)(p.ws + OFF_PROJ);
    bf16_t* A2 = (bf16_t*)(p.ws + OFF_A2);
    const int lane = my_tid() & 63, wid = my_tid() >> 6;
    for (int tok = bid * 8 + wid; tok < NTOK; tok += nb * 8) {
        const int c0 = lane * 8;
        {
            const float4 a = *(const float4*)(ORAW + (size_t)tok * DHG + c0), b = *(const float4*)(ORAW + (size_t)tok * DHG + c0 + 4);
            float ss = a.x * a.x + a.y * a.y + a.z * a.z + a.w * a.w + b.x * b.x + b.y * b.y + b.z * b.z + b.w * b.w;
            ss += __shfl_xor(ss, 1); ss += __shfl_xor(ss, 2); ss += __shfl_xor(ss, 4); ss += __shfl_xor(ss, 8);
            const float rs = rsqrtf(ss * (1.0f / 128.0f) + RMS_EPS);
            const uint4 gq = *(const uint4*)(P + (size_t)tok * INC + 1536 + c0);
            const float4 w0 = *(const float4*)(p.hg_nw + c0), w1 = *(const float4*)(p.hg_nw + c0 + 4);
            uint4 o;
            o.x = pack2(a.x * rs * w0.x * bflo(gq.x), a.y * rs * w0.y * bfhi(gq.x));
            o.y = pack2(a.z * rs * w0.z * bflo(gq.y), a.w * rs * w0.w * bfhi(gq.y));
            o.z = pack2(b.x * rs * w1.x * bflo(gq.z), b.y * rs * w1.y * bfhi(gq.z));
            o.w = pack2(b.z * rs * w1.z * bflo(gq.w), b.w * rs * w1.w * bfhi(gq.w));
            *(uint4*)(A2 + (size_t)tok * DM + c0) = o;
        }
        {
            const float4 a = *(const float4*)(Y2 + (size_t)tok * DSS + c0), b = *(const float4*)(Y2 + (size_t)tok * DSS + c0 + 4);
            float ss = a.x * a.x + a.y * a.y + a.z * a.z + a.w * a.w + b.x * b.x + b.y * b.y + b.z * b.z + b.w * b.w;
#pragma unroll
            for (int m = 1; m < 64; m <<= 1) ss += __shfl_xor(ss, m);
            const float rs = rsqrtf(ss * (1.0f / 512.0f) + RMS_EPS);
            const float4 w0 = *(const float4*)(p.ssm_nw + c0), w1 = *(const float4*)(p.ssm_nw + c0 + 4);
            uint4 o;
            o.x = pack2(a.x * rs * w0.x, a.y * rs * w0.y); o.y = pack2(a.z * rs * w0.z, a.w * rs * w0.w);
            o.z = pack2(b.x * rs * w1.x, b.y * rs * w1.y); o.w = pack2(b.z * rs * w1.z, b.w * rs * w1.w);
            *(uint4*)(A2 + (size_t)tok * DM + 512 + c0) = o;
        }
    }
}

DI void phase_outproj(const Params& p, int bid, int nb, char* smem) {
    pg8::Gemm g{(const bf16_t*)(p.ws + OFF_A2), (const bf16_t*)(p.ws + OFF_WOUT), NTOK, DM, DM};
    pg8::StaticOrder S; S.init(NTOK, DM, nb, bid);
    pg8::EpiResid E{p.out, p.x, (const float*)(p.ws + OFF_MOD) + 2048, DEEP_ALPHA};
    pg8::gemm_phase<pg8::EpiResid, pg8::StaticOrder, false>((PG8_LAS unsigned char*)smem, g, S, E, nullptr);
}
DI void phase_ln1(const Params& p, int bid, int nb) {
    const float* mod = (const float*)(p.ws + OFF_MOD);
    bf16_t* H2 = (bf16_t*)(p.ws + OFF_H);
    const int lane = my_tid() & 63, wid = my_tid() >> 6;
    for (int tok = bid * 8 + wid; tok < NTOK; tok += nb * 8) {
        const int b = tok / SEQ;
        float* row = p.out + (size_t)tok * DM;
        float4 v[4];
        float s = 0.f;
#pragma unroll
        for (int j = 0; j < 4; ++j) { v[j] = *(const float4*)(row + j * 256 + lane * 4); s += v[j].x + v[j].y + v[j].z + v[j].w; }
#pragma unroll
        for (int m = 1; m < 64; m <<= 1) s += __shfl_xor(s, m);
        const float mu = s * (1.0f / 1024.0f);
        float q = 0.f;
#pragma unroll
        for (int j = 0; j < 4; ++j) { const float a = v[j].x - mu, bb = v[j].y - mu, cc = v[j].z - mu, d = v[j].w - mu; q += a * a + bb * bb + cc * cc + d * d; }
#pragma unroll
        for (int m = 1; m < 64; m <<= 1) q += __shfl_xor(q, m);
        const float rstd = rsqrtf(q * (1.0f / 1024.0f) + LN_EPS);
        const float* sh2 = mod + b * 6144 + 3072;
        const float* sc2 = mod + b * 6144 + 4096;
#pragma unroll
        for (int j = 0; j < 4; ++j) {
            const int c = j * 256 + lane * 4;
            const float4 w = *(const float4*)(p.ln1w + c), bi = *(const float4*)(p.ln1b + c), sc = *(const float4*)(sc2 + c), sh = *(const float4*)(sh2 + c);
            float4 o;
            o.x = (v[j].x - mu) * rstd * w.x + bi.x; o.y = (v[j].y - mu) * rstd * w.y + bi.y; o.z = (v[j].z - mu) * rstd * w.z + bi.z; o.w = (v[j].w - mu) * rstd * w.w + bi.w;
            *(float4*)(row + c) = o;
            uint2 hh; hh.x = pack2(o.x * (1.f + sc.x) + sh.x, o.y * (1.f + sc.y) + sh.y); hh.y = pack2(o.z * (1.f + sc.z) + sh.z, o.w * (1.f + sc.w) + sh.w);
            *(uint2*)(H2 + (size_t)tok * DM + c) = hh;
        }
    }
}

DI void phase_q(const Params& p, int bid, int nb, char* smem) {
    pg8::Gemm g{(const bf16_t*)(p.ws + OFF_H), (const bf16_t*)(p.ws + OFF_WQ), NTOK, 2048, DM};
    pg8::StaticOrder S; S.init(NTOK, 2048, nb, bid);
    pg8::EpiBf16Act E{(bf16_t*)(p.ws + OFF_PROJ), 2048, 0u};
    pg8::gemm_phase<pg8::EpiBf16Act, pg8::StaticOrder, false>((PG8_LAS unsigned char*)smem, g, S, E, nullptr);
}
DI void phase_topk(const Params& p, int bid, int nb, char* smem) {
    const bf16_t* Q = (const bf16_t*)(p.ws + OFF_PROJ);
    const bf16_t* SK = (const bf16_t*)(p.ws + OFF_SUBK);
    unsigned* TOPL = (unsigned*)(p.ws + OFF_TOPL);
    float* sc = (float*)(smem + 36864);
    constexpr int NTM = NTOK / 128;
    for (int t = bid; t < NTM * 16; t += nb) {
        const int mt = t >> 4, hp = t & 15;
        gemm_block<2, 1, 2, 4>(Q + (size_t)mt * 128 * 2048 + hp * 128, 2048, SK + (size_t)hp * 128 * 128, 128, 128, smem,
                               [&](int r, int c, float v) { sc[r * 129 + c] = v; });
        __syncthreads();
        if (my_tid() < 128) {
            const int r = my_tid();
            float tk[16];
#pragma unroll
            for (int j = 0; j < 16; ++j) tk[j] = -3.0e38f;
            for (int n = 0; n < 128; ++n) {
                float xv = __uint_as_float((__float_as_uint(sc[r * 129 + n]) & ~0x7fu) | (unsigned)n);
#pragma unroll
                for (int j = 0; j < 16; ++j) { const float hi = fmaxf(tk[j], xv), lo = fminf(tk[j], xv); tk[j] = hi; xv = lo; }
            }
            uint4* dst = (uint4*)(TOPL + ((size_t)(mt * 128 + r) * 16 + hp) * 16);
            dst[0] = make_uint4(__float_as_uint(tk[0]), __float_as_uint(tk[1]), __float_as_uint(tk[2]), __float_as_uint(tk[3]));
            dst[1] = make_uint4(__float_as_uint(tk[4]), __float_as_uint(tk[5]), __float_as_uint(tk[6]), __float_as_uint(tk[7]));
            dst[2] = make_uint4(__float_as_uint(tk[8]), __float_as_uint(tk[9]), __float_as_uint(tk[10]), __float_as_uint(tk[11]));
            dst[3] = make_uint4(__float_as_uint(tk[12]), __float_as_uint(tk[13]), __float_as_uint(tk[14]), __float_as_uint(tk[15]));
        }
        __syncthreads();
    }
}
DI void phase_combine(const Params& p, int bid, int nb) {
    const unsigned* TOPL = (const unsigned*)(p.ws + OFF_TOPL);
    uint2* EX = (uint2*)(p.ws + OFF_EXPS);
    const float* SU = (const float*)(p.ws + OFF_SU);
    const float* SV = (const float*)(p.ws + OFF_SV);
    for (int i = bid * NTH + my_tid(); i < NTOK * PHEADS; i += nb * NTH) {
        const unsigned* l1 = TOPL + (size_t)i * 32;
        const unsigned* l2 = l1 + 16;
        float s2[16];
        {
            const uint4 a = ((const uint4*)l2)[0], b = ((const uint4*)l2)[1], c = ((const uint4*)l2)[2], d = ((const uint4*)l2)[3];
            const unsigned w[16] = {a.x, a.y, a.z, a.w, b.x, b.y, b.z, b.w, c.x, c.y, c.z, c.w, d.x, d.y, d.z, d.w};
#pragma unroll
            for (int j = 0; j < 16; ++j) s2[j] = __uint_as_float(w[j] & ~0x7fu);
        }
        float tk[16];
#pragma unroll
        for (int j = 0; j < 16; ++j) tk[j] = -3.0e38f;
        for (int a = 0; a < 16; ++a) {
            const float s1 = __uint_as_float(l1[a] & ~0x7fu);
#pragma unroll
            for (int b = 0; b < 16; ++b) {
                float xv = __uint_as_float((__float_as_uint(s1 + s2[b]) & ~0xffu) | (unsigned)(a * 16 + b));
#pragma unroll
                for (int j = 0; j < 16; ++j) { const float hi = fmaxf(tk[j], xv), lo = fminf(tk[j], xv); tk[j] = hi; xv = lo; }
            }
        }
        float e[16], sum = 0.f;
        const float mx = __uint_as_float(__float_as_uint(tk[0]) & ~0xffu);
#pragma unroll
        for (int j = 0; j < 16; ++j) { e[j] = __expf(__uint_as_float(__float_as_uint(tk[j]) & ~0xffu) - mx); sum += e[j]; }
        const float inv = 1.0f / sum;
#pragma unroll
        for (int j = 0; j < 16; ++j) {
            const unsigned ab = __float_as_uint(tk[j]) & 0xffu;
            const unsigned i1 = l1[ab >> 4] & 0x7fu, i2 = l2[ab & 15] & 0x7fu;
            const unsigned eid = i1 * 128u + i2;
            EX[(size_t)i * 16 + j] = make_uint2(eid | (((__float_as_uint(SU[eid]) >> 23) & 0xffu) << 16), __float_as_uint(e[j] * inv * SV[eid]));
        }
    }
}

DI void ce_desc(float& a, float& b) { const float hi = fmaxf(a, b), lo = fminf(a, b); a = hi; b = lo; }
template <int N> DI void bitonic_sort_desc(float (&v)[N]) {
#pragma unroll
    for (int k = 2; k <= N; k <<= 1)
#pragma unroll
        for (int j = k >> 1; j > 0; j >>= 1)
#pragma unroll
            for (int i = 0; i < N; ++i) { const int l = i ^ j; if (l > i) { if ((i & k) == 0 || k == N) ce_desc(v[i], v[l]); else ce_desc(v[l], v[i]); } }
}
DI void merge_top16(float (&a)[16], const float (&b)[16]) {
#pragma unroll
    for (int i = 0; i < 16; ++i) a[i] = fmaxf(a[i], b[15 - i]);
#pragma unroll
    for (int j = 8; j > 0; j >>= 1)
#pragma unroll
        for (int i = 0; i < 16; ++i) { const int l = i ^ j; if (l > i) ce_desc(a[i], a[l]); }
}
DI void xlane_merge16(float (&a)[16]) {
    float o[16];
#pragma unroll
    for (int i = 0; i < 16; ++i) o[i] = __shfl_xor(a[i], 32);
    merge_top16(a, o);
}
DI void retrieve_topk_hp(const bf16_t* Q, const bf16_t* SK, const int tok, const int hp, const int r, const int h, unsigned char* lutp, float (&out)[16]) {
                f32x16 acc[4];
#pragma unroll
                for (int mi = 0; mi < 4; ++mi)
#pragma unroll
                    for (int i = 0; i < 16; ++i) acc[mi][i] = 0.f;
                const bf16_t* qb = Q + (size_t)tok * 2048 + hp * 128 + 8 * h;
                const bf16_t* kb = SK + (size_t)hp * 128 * 128 + (size_t)r * 128 + 8 * h;
#pragma unroll
                for (int ks = 0; ks < 8; ++ks) {
                    const bf16x8 bq = *(const bf16x8*)(qb + ks * 16);
#pragma unroll
                    for (int mi = 0; mi < 4; ++mi) {
                        const bf16x8 a = *(const bf16x8*)(kb + mi * 32 * 128 + ks * 16);
                        acc[mi] = __builtin_amdgcn_mfma_f32_32x32x16_bf16(a, bq, acc[mi], 0, 0, 0);
                    }
                }
                float v0[16], v1[16], v2[16], v3[16];
#pragma unroll
                for (int i = 0; i < 16; ++i) {
                    const unsigned n = (unsigned)crow(i, h);
                    v0[i] = __uint_as_float((__float_as_uint(acc[0][i]) & ~0x7fu) | n);
                    v1[i] = __uint_as_float((__float_as_uint(acc[1][i]) & ~0x7fu) | (n + 32u));
                    v2[i] = __uint_as_float((__float_as_uint(acc[2][i]) & ~0x7fu) | (n + 64u));
                    v3[i] = __uint_as_float((__float_as_uint(acc[3][i]) & ~0x7fu) | (n + 96u));
                }
                bitonic_sort_desc<16>(v0); bitonic_sort_desc<16>(v1); bitonic_sort_desc<16>(v2); bitonic_sort_desc<16>(v3);
                merge_top16(v0, v1); merge_top16(v2, v3); merge_top16(v0, v2);
                xlane_merge16(v0);
#pragma unroll
                for (int i = 0; i < 16; ++i) out[i] = v0[i];
                u32x4 ix;
                ix.x = (__float_as_uint(v0[0]) & 0x7fu) | ((__float_as_uint(v0[1]) & 0x7fu) << 8) | ((__float_as_uint(v0[2]) & 0x7fu) << 16) | ((__float_as_uint(v0[3]) & 0x7fu) << 24);
                ix.y = (__float_as_uint(v0[4]) & 0x7fu) | ((__float_as_uint(v0[5]) & 0x7fu) << 8) | ((__float_as_uint(v0[6]) & 0x7fu) << 16) | ((__float_as_uint(v0[7]) & 0x7fu) << 24);
                ix.z = (__float_as_uint(v0[8]) & 0x7fu) | ((__float_as_uint(v0[9]) & 0x7fu) << 8) | ((__float_as_uint(v0[10]) & 0x7fu) << 16) | ((__float_as_uint(v0[11]) & 0x7fu) << 24);
                ix.w = (__float_as_uint(v0[12]) & 0x7fu) | ((__float_as_uint(v0[13]) & 0x7fu) << 8) | ((__float_as_uint(v0[14]) & 0x7fu) << 16) | ((__float_as_uint(v0[15]) & 0x7fu) << 24);
                *(u32x4*)lutp = ix;
}
DI void phase_retrieve(const Params& p, int bid, int nb, char* smem) {
    const bf16_t* Q = (const bf16_t*)(p.ws + OFF_PROJ);
    const bf16_t* SK = (const bf16_t*)(p.ws + OFF_SUBK);
    const float* SU = (const float*)(p.ws + OFF_SU);
    const float* SV = (const float*)(p.ws + OFF_SV);
    uint2* EX = (uint2*)(p.ws + OFF_EXPS);
    const int tid = my_tid(), lane = tid & 63, wid = tid >> 6, r = lane & 31, h = lane >> 5;
    unsigned char* lut = (unsigned char*)smem + wid * 2048 + lane * 32;
    for (int it = bid * 8 + wid; it < (NTOK / 32) * 2; it += nb * 8) {
        const int tg = it >> 1, hq = it & 1;
        const int tok = tg * 32 + r;
#pragma unroll 1
        for (int hd = hq * 4; hd < hq * 4 + 4; ++hd) {
            float L0[16], L1[16];
            retrieve_topk_hp(Q, SK, tok, hd * 2, r, h, lut, L0);
            retrieve_topk_hp(Q, SK, tok, hd * 2 + 1, r, h, lut + 16, L1);
            float c[32];
            {
                constexpr int PA[50] = {0, 0, 0, 0, 0, 0, 0, 0, 0, 0, 0, 0, 0, 0, 0, 0, 1, 1, 1, 1, 1, 1, 1, 1, 2, 2, 2, 2, 2, 3, 3, 3, 3, 4, 4, 4, 5, 5, 6, 6, 7, 7, 8, 9, 10, 11, 12, 13, 14, 15};
                constexpr int PB[50] = {0, 1, 2, 3, 4, 5, 6, 7, 8, 9, 10, 11, 12, 13, 14, 15, 0, 1, 2, 3, 4, 5, 6, 7, 0, 1, 2, 3, 4, 0, 1, 2, 3, 0, 1, 2, 0, 1, 0, 1, 0, 1, 0, 0, 0, 0, 0, 0, 0, 0};
#pragma unroll
                for (int q = 0; q < 25; ++q) {
                    const float s0 = __uint_as_float(__float_as_uint(L0[PA[2 * q]]) & ~0x7fu) + __uint_as_float(__float_as_uint(L1[PB[2 * q]]) & ~0x7fu);
                    const float s1 = __uint_as_float(__float_as_uint(L0[PA[2 * q + 1]]) & ~0x7fu) + __uint_as_float(__float_as_uint(L1[PB[2 * q + 1]]) & ~0x7fu);
                    const float p0 = __uint_as_float((__float_as_uint(s0) & ~0xffu) | (unsigned)(PA[2 * q] * 16 + PB[2 * q]));
                    const float p1 = __uint_as_float((__float_as_uint(s1) & ~0xffu) | (unsigned)(PA[2 * q + 1] * 16 + PB[2 * q + 1]));
                    c[q] = h ? p1 : p0;
                }
#pragma unroll
                for (int i = 25; i < 32; ++i) c[i] = -3.0e38f;
            }
            bitonic_sort_desc<32>(c);
            float t16[16];
#pragma unroll
            for (int i = 0; i < 16; ++i) t16[i] = c[i];
            xlane_merge16(t16);
            const float mx = __uint_as_float(__float_as_uint(t16[0]) & ~0xffu);
            float e[16], sum = 0.f;
#pragma unroll
            for (int j = 0; j < 16; ++j) { e[j] = __expf(__uint_as_float(__float_as_uint(t16[j]) & ~0xffu) - mx); sum += e[j]; }
            const float inv = 1.0f / sum;
            uint2* dst = EX + ((size_t)tok * 8 + hd) * 16 + 8 * h;
#pragma unroll
            for (int j = 0; j < 8; ++j) {
                float tlo = t16[j], thi = t16[8 + j], elo = e[j], ehi = e[8 + j];
                asm volatile("" : "+v"(tlo), "+v"(thi), "+v"(elo), "+v"(ehi));
                const float tv = h ? thi : tlo, ev = h ? ehi : elo;
                const unsigned ab = __float_as_uint(tv) & 0xffu;
                const unsigned eid = (unsigned)lut[ab >> 4] * 128u + (unsigned)lut[16 + (ab & 15u)];
                dst[j] = make_uint2(eid | (((__float_as_uint(SU[eid]) >> 23) & 0xffu) << 16), __float_as_uint(ev * inv * SV[eid]));
            }
        }
    }
}

DI float dot16_fp8(const u32x4 w, const f32x2 (&h)[8]) {
    f32x2 acc = __builtin_amdgcn_cvt_pk_f32_fp8((int)w.x, false) * h[0];
    acc += __builtin_amdgcn_cvt_pk_f32_fp8((int)w.x, true) * h[1];
    acc += __builtin_amdgcn_cvt_pk_f32_fp8((int)w.y, false) * h[2];
    acc += __builtin_amdgcn_cvt_pk_f32_fp8((int)w.y, true) * h[3];
    acc += __builtin_amdgcn_cvt_pk_f32_fp8((int)w.z, false) * h[4];
    acc += __builtin_amdgcn_cvt_pk_f32_fp8((int)w.z, true) * h[5];
    acc += __builtin_amdgcn_cvt_pk_f32_fp8((int)w.w, false) * h[6];
    acc += __builtin_amdgcn_cvt_pk_f32_fp8((int)w.w, true) * h[7];
    return acc.x + acc.y;
}
DI void axpy16_fp8(const float a, const u32x4 w, f32x2 (&o)[8]) {
    const f32x2 aa = {a, a};
    o[0] += aa * __builtin_amdgcn_cvt_pk_f32_fp8((int)w.x, false); o[1] += aa * __builtin_amdgcn_cvt_pk_f32_fp8((int)w.x, true);
    o[2] += aa * __builtin_amdgcn_cvt_pk_f32_fp8((int)w.y, false); o[3] += aa * __builtin_amdgcn_cvt_pk_f32_fp8((int)w.y, true);
    o[4] += aa * __builtin_amdgcn_cvt_pk_f32_fp8((int)w.z, false); o[5] += aa * __builtin_amdgcn_cvt_pk_f32_fp8((int)w.z, true);
    o[6] += aa * __builtin_amdgcn_cvt_pk_f32_fp8((int)w.w, false); o[7] += aa * __builtin_amdgcn_cvt_pk_f32_fp8((int)w.w, true);
}
DI float butterfly64(float (&pz)[64], const int lane) {
    const bool b5 = lane & 32, b4 = lane & 16, b3 = lane & 8, b2 = lane & 4, b1 = lane & 2, b0 = lane & 1;
    float q32[32], q16[16], q8[8], q4[4], q2[2];
#pragma unroll
    for (int j = 0; j < 32; ++j) q32[j] = (b5 ? pz[32 + j] : pz[j]) + __shfl_xor(b5 ? pz[j] : pz[32 + j], 32);
#pragma unroll
    for (int j = 0; j < 16; ++j) q16[j] = (b4 ? q32[16 + j] : q32[j]) + __shfl_xor(b4 ? q32[j] : q32[16 + j], 16);
#pragma unroll
    for (int j = 0; j < 8; ++j) q8[j] = (b3 ? q16[8 + j] : q16[j]) + __shfl_xor(b3 ? q16[j] : q16[8 + j], 8);
#pragma unroll
    for (int j = 0; j < 4; ++j) q4[j] = (b2 ? q8[4 + j] : q8[j]) + __shfl_xor(b2 ? q8[j] : q8[4 + j], 4);
#pragma unroll
    for (int j = 0; j < 2; ++j) q2[j] = (b1 ? q4[2 + j] : q4[j]) + __shfl_xor(b1 ? q4[j] : q4[2 + j], 2);
    return (b0 ? q2[1] : q2[0]) + __shfl_xor(b0 ? q2[0] : q2[1], 1);
}
DI void phase_gather_flat(const Params& p, int bid, int nb) {
    const float* mod = (const float*)(p.ws + OFF_MOD);
    const uint2* EX = (const uint2*)(p.ws + OFF_EXPS);
    const unsigned char* UT = (const unsigned char*)(p.ws + OFF_UT);
    const unsigned char* VT = (const unsigned char*)(p.ws + OFF_VT);
    const int lane = my_tid() & 63, wid = my_tid() >> 6;
    for (int tok = bid * 8 + wid; tok < NTOK; tok += nb * 8) {
        const int b = tok / SEQ, c0 = lane * 16;
        float* row = p.out + (size_t)tok * DM + c0;
        const float* sh2 = mod + b * 6144 + 3072 + c0;
        const float* sc2 = mod + b * 6144 + 4096 + c0;
        const float* g2 = mod + b * 6144 + 5120 + c0;
        f32x2 x1[8], h2[8], acc[8];
#pragma unroll
        for (int q = 0; q < 4; ++q) {
            const f32x4 xv = *(const f32x4*)(row + q * 4), sc = *(const f32x4*)(sc2 + q * 4), sh = *(const f32x4*)(sh2 + q * 4);
            x1[2 * q] = (f32x2){xv.x, xv.y}; x1[2 * q + 1] = (f32x2){xv.z, xv.w};
            h2[2 * q] = (f32x2){xv.x * (1.f + sc.x) + sh.x, xv.y * (1.f + sc.y) + sh.y};
            h2[2 * q + 1] = (f32x2){xv.z * (1.f + sc.z) + sh.z, xv.w * (1.f + sc.w) + sh.w};
        }
#pragma unroll
        for (int i = 0; i < 8; ++i) acc[i] = (f32x2){0.f, 0.f};
        const uint2 e0 = EX[(size_t)tok * 128 + lane], e1 = EX[(size_t)tok * 128 + 64 + lane];
        float a0, a1;
        {
            float pz[64];
#pragma unroll
            for (int e = 0; e < 64; ++e) {
                const unsigned eid = (unsigned)__builtin_amdgcn_readlane((int)e0.x, e) & 0xffffu;
                pz[e] = dot16_fp8(*(const u32x4*)(UT + (size_t)eid * DM + c0), h2);
            }
            const float z = butterfly64(pz, lane) * __uint_as_float(((e0.x >> 16) & 0xffu) << 23);
            a0 = geluf_(z) * __uint_as_float(e0.y);
        }
        {
            float pz[64];
#pragma unroll
            for (int e = 0; e < 64; ++e) {
                const unsigned eid = (unsigned)__builtin_amdgcn_readlane((int)e1.x, e) & 0xffffu;
                pz[e] = dot16_fp8(*(const u32x4*)(UT + (size_t)eid * DM + c0), h2);
            }
            const float z = butterfly64(pz, lane) * __uint_as_float(((e1.x >> 16) & 0xffu) << 23);
            a1 = geluf_(z) * __uint_as_float(e1.y);
        }
#pragma unroll 16
        for (int e = 0; e < 64; ++e) {
            const unsigned eid = (unsigned)__builtin_amdgcn_readlane((int)e0.x, e) & 0xffffu;
            const float a = __uint_as_float(__builtin_amdgcn_readlane((int)__float_as_uint(a0), e));
            axpy16_fp8(a, *(const u32x4*)(VT + (size_t)eid * DM + c0), acc);
        }
#pragma unroll 16
        for (int e = 0; e < 64; ++e) {
            const unsigned eid = (unsigned)__builtin_amdgcn_readlane((int)e1.x, e) & 0xffffu;
            const float a = __uint_as_float(__builtin_amdgcn_readlane((int)__float_as_uint(a1), e));
            axpy16_fp8(a, *(const u32x4*)(VT + (size_t)eid * DM + c0), acc);
        }
        f32x2 r[8];
        float s = 0.f;
#pragma unroll
        for (int q = 0; q < 4; ++q) {
            const f32x4 gg = *(const f32x4*)(g2 + q * 4);
            r[2 * q] = DEEP_ALPHA * x1[2 * q] + (f32x2){1.f + gg.x, 1.f + gg.y} * acc[2 * q];
            r[2 * q + 1] = DEEP_ALPHA * x1[2 * q + 1] + (f32x2){1.f + gg.z, 1.f + gg.w} * acc[2 * q + 1];
            s += r[2 * q].x + r[2 * q].y + r[2 * q + 1].x + r[2 * q + 1].y;
        }
#pragma unroll
        for (int m = 1; m < 64; m <<= 1) s += __shfl_xor(s, m);
        const float mu = s * (1.0f / 1024.0f);
        float qq = 0.f;
#pragma unroll
        for (int i = 0; i < 8; ++i) { const f32x2 d = r[i] - mu; qq += d.x * d.x + d.y * d.y; }
#pragma unroll
        for (int m = 1; m < 64; m <<= 1) qq += __shfl_xor(qq, m);
        const float rstd = rsqrtf(qq * (1.0f / 1024.0f) + LN_EPS);
#pragma unroll
        for (int q = 0; q < 4; ++q) {
            const f32x4 w = *(const f32x4*)(p.ln2w + c0 + q * 4), bi = *(const f32x4*)(p.ln2b + c0 + q * 4);
            f32x4 ov;
            ov.x = (r[2 * q].x - mu) * rstd * w.x + bi.x; ov.y = (r[2 * q].y - mu) * rstd * w.y + bi.y;
            ov.z = (r[2 * q + 1].x - mu) * rstd * w.z + bi.z; ov.w = (r[2 * q + 1].y - mu) * rstd * w.w + bi.w;
            *(f32x4*)(row + q * 4) = ov;
        }
    }
}

DI float bfly8(float (&pz)[8], const int lane) {
    const bool b2 = lane & 4, b1 = lane & 2, b0 = lane & 1;
    float q4[4], q2[2];
#pragma unroll
    for (int i = 0; i < 4; ++i) q4[i] = (b2 ? pz[4 + i] : pz[i]) + __shfl_xor(b2 ? pz[i] : pz[4 + i], 4);
#pragma unroll
    for (int i = 0; i < 2; ++i) q2[i] = (b1 ? q4[2 + i] : q4[i]) + __shfl_xor(b1 ? q4[i] : q4[2 + i], 2);
    float q = (b0 ? q2[1] : q2[0]) + __shfl_xor(b0 ? q2[0] : q2[1], 1);
    q += __shfl_xor(q, 8); q += __shfl_xor(q, 16); q += __shfl_xor(q, 32);
    return q;
}
DI void gs_issue(const __amdgpu_buffer_rsrc_t T, const uint2* ent, const unsigned d, const int lane, u32x4 (&w)[8], unsigned& ca) {
    const int cnt = (int)((d >> 16) & 0xfu), k = lane & 7;
    const uint2 e = ent[(d & 0xffffu) + (unsigned)(k < cnt ? k : cnt - 1)];
    ca = (k < cnt && !(d >> 31)) ? e.y : 0u;
#pragma unroll
    for (int q = 0; q < 8; ++q) {
        const int eid = __builtin_amdgcn_readlane((int)e.x, q) & 0xffff;
        w[q] = __builtin_amdgcn_raw_buffer_load_b128(T, lane * 16, eid * DM, 0);
    }
}
DI void gs_ucompute(const u32x4 (&w)[8], const f32x2 (&h2)[8], float* zb, const unsigned d, const int lane) {
    float pz[8];
#pragma unroll
    for (int k = 0; k < 8; ++k) { pz[k] = dot16_fp8(w[k], h2); if (k & 1) __builtin_amdgcn_sched_barrier(0); }
    const float z = bfly8(pz, lane);
    if (lane < (int)((d >> 16) & 0xfu) && !(d >> 31)) zb[(d & 0xffffu) + lane] = z;
}
DI void gs_vcompute(const u32x4 (&w)[8], const unsigned ca, f32x2 (&acc)[8]) {
#pragma unroll
    for (int k = 0; k < 8; ++k) { axpy16_fp8(__uint_as_float((unsigned)__builtin_amdgcn_readlane((int)ca, k)), w[k], acc); if (k & 1) __builtin_amdgcn_sched_barrier(0); }
}
constexpr int GT = 4;
DI void phase_gather(const Params& p, int bid, int nb, char* smem) {
    const float* mod = (const float*)(p.ws + OFF_MOD);
    const uint2* EX = (const uint2*)(p.ws + OFF_EXPS);
    const __amdgpu_buffer_rsrc_t UT = __builtin_amdgcn_make_buffer_rsrc((void*)(p.ws + OFF_UT), 0, NEXP * DM, 0x00020000);
    const __amdgpu_buffer_rsrc_t VT = __builtin_amdgcn_make_buffer_rsrc((void*)(p.ws + OFF_VT), 0, NEXP * DM, 0x00020000);
    const int lane = my_tid() & 63, wid = my_tid() >> 6, c0 = lane * 16;
    char* wl = smem + wid * 7168;
    uint2* ent = (uint2*)wl; float* zb = (float*)(wl + 4096); int* offs = (int*)(wl + 6144); unsigned* sched = (unsigned*)(wl + 6144 + 256);
#pragma unroll 1
    for (int t0 = (bid * 8 + wid) * GT; t0 < NTOK; t0 += nb * 8 * GT) {
        f32x2 h2[GT][8], acc[GT][8];
        f32x4 scv[4], shv[4];
        {
            const int b = t0 / SEQ;
#pragma unroll
            for (int q = 0; q < 4; ++q) { scv[q] = *(const f32x4*)(mod + b * 6144 + 4096 + c0 + q * 4) + 1.0f; shv[q] = *(const f32x4*)(mod + b * 6144 + 3072 + c0 + q * 4); }
        }
#pragma unroll
        for (int j = 0; j < GT; ++j) {
            const int tok = t0 + j;
            const float* row = p.out + (size_t)tok * DM + c0;
            __builtin_amdgcn_sched_barrier(0);
#pragma unroll
            for (int q = 0; q < 4; ++q) {
                const f32x4 xv = *(const f32x4*)(row + q * 4), hv = xv * scv[q] + shv[q];
                h2[j][2 * q] = (f32x2){hv.x, hv.y}; h2[j][2 * q + 1] = (f32x2){hv.z, hv.w};
            }
            const uint2 e0 = EX[(size_t)tok * 128 + lane], e1 = EX[(size_t)tok * 128 + 64 + lane];
            const int s0 = (int)((e0.x & 0xffffu) >> 11), s1 = (int)((e1.x & 0xffffu) >> 11);
            int run = 0, pos0 = 0, pos1 = 0;
#pragma unroll
            for (int s = 0; s < 8; ++s) {
                const unsigned long long m0 = __ballot(s0 == s), m1 = __ballot(s1 == s);
                const int c0n = __popcll(m0), c1n = __popcll(m1);
                const int below0 = (int)__builtin_amdgcn_mbcnt_hi((unsigned)(m0 >> 32), __builtin_amdgcn_mbcnt_lo((unsigned)m0, 0u));
                const int below1 = (int)__builtin_amdgcn_mbcnt_hi((unsigned)(m1 >> 32), __builtin_amdgcn_mbcnt_lo((unsigned)m1, 0u));
                if (lane == 0) offs[j * 9 + s] = run;
                pos0 = (s0 == s) ? run + below0 : pos0;
                pos1 = (s1 == s) ? run + c0n + below1 : pos1;
                run += c0n + c1n;
            }
            if (lane == 0) offs[j * 9 + 8] = 128;
            ent[j * 128 + pos0] = e0; ent[j * 128 + pos1] = e1;
        }
        int nbat;
        {
            const int gs = (lane / GT) & 7, gj = lane % GT;
            const int gb = offs[gj * 9 + gs], ge = offs[gj * 9 + gs + 1], cnt = lane < 8 * GT ? ge - gb : 0, nbt = (cnt + 7) >> 3;
            int incl = nbt;
#pragma unroll
            for (int m = 1; m < 32; m <<= 1) { const int o = __shfl_up(incl, m); if ((lane & 31) >= m) incl += o; }
            nbat = __builtin_amdgcn_readlane(incl, 8 * GT - 1);
            const int st = incl - nbt;
            for (int q = 0; q < nbt; ++q) { const int rem = cnt - 8 * q; sched[st + q] = (unsigned)(gj * 128 + gb + 8 * q) | ((unsigned)(rem < 8 ? rem : 8) << 16); }
            if (lane < 3) sched[nbat + lane] = 0x80010000u;
        }
        {
            u32x4 wa[8], wb[8]; unsigned ca, cb;
#define GS_UC(W_, D_) { const unsigned j_ = ((D_) & 0xffffu) >> 7; \
                if (j_ == 0) gs_ucompute(W_, h2[0], zb, D_, lane); else if (j_ == 1) gs_ucompute(W_, h2[1], zb, D_, lane); \
                else if (j_ == 2) gs_ucompute(W_, h2[2], zb, D_, lane); else gs_ucompute(W_, h2[3], zb, D_, lane); }
            unsigned da = (unsigned)__builtin_amdgcn_readfirstlane((int)sched[0]);
            gs_issue(UT, ent, da, lane, wa, ca);
#pragma unroll 1
            for (int i = 0; i < nbat; i += 2) {
                const unsigned db = (unsigned)__builtin_amdgcn_readfirstlane((int)sched[i + 1]);
                gs_issue(UT, ent, db, lane, wb, cb);
                __builtin_amdgcn_sched_barrier(0);
                GS_UC(wa, da);
                da = (unsigned)__builtin_amdgcn_readfirstlane((int)sched[i + 2]);
                gs_issue(UT, ent, da, lane, wa, ca);
                __builtin_amdgcn_sched_barrier(0);
                GS_UC(wb, db);
            }
#undef GS_UC
        }
#pragma unroll
        for (int j = 0; j < GT; ++j)
#pragma unroll
            for (int q = 0; q < 2; ++q) {
                const int pos = j * 128 + q * 64 + lane;
                const uint2 e = ent[pos];
                const float z = zb[pos] * __uint_as_float(((e.x >> 16) & 0xffu) << 23);
                ent[pos].y = __float_as_uint(gelu_as(z) * __uint_as_float(e.y));
            }
#pragma unroll
        for (int j = 0; j < GT; ++j)
#pragma unroll
            for (int q = 0; q < 8; ++q) acc[j][q] = (f32x2){0.f, 0.f};
        {
            u32x4 wa[8], wb[8]; unsigned ca, cb;
#define GS_VC(W_, D_, C_) { const unsigned j_ = ((D_) & 0xffffu) >> 7; \
                if (j_ == 0) gs_vcompute(W_, C_, acc[0]); else if (j_ == 1) gs_vcompute(W_, C_, acc[1]); \
                else if (j_ == 2) gs_vcompute(W_, C_, acc[2]); else gs_vcompute(W_, C_, acc[3]); }
            unsigned da = (unsigned)__builtin_amdgcn_readfirstlane((int)sched[0]);
            gs_issue(VT, ent, da, lane, wa, ca);
#pragma unroll 1
            for (int i = 0; i < nbat; i += 2) {
                const unsigned db = (unsigned)__builtin_amdgcn_readfirstlane((int)sched[i + 1]);
                gs_issue(VT, ent, db, lane, wb, cb);
                __builtin_amdgcn_sched_barrier(0);
                GS_VC(wa, da, ca);
                da = (unsigned)__builtin_amdgcn_readfirstlane((int)sched[i + 2]);
                gs_issue(VT, ent, da, lane, wa, ca);
                __builtin_amdgcn_sched_barrier(0);
                GS_VC(wb, db, cb);
            }
#undef GS_VC
        }
#pragma unroll
        for (int j = 0; j < GT; ++j) {
            asm volatile("" ::: "memory");
            __builtin_amdgcn_sched_barrier(0);
            const int tok = t0 + j, b = tok / SEQ;
            float* row = p.out + (size_t)tok * DM + c0;
            const float* g2 = mod + b * 6144 + 5120 + c0;
            f32x2 r[8];
            float sm = 0.f;
#pragma unroll
            for (int q = 0; q < 4; ++q) {
                const f32x4 xv = *(const f32x4*)(row + q * 4), gg = *(const f32x4*)(g2 + q * 4);
                r[2 * q] = DEEP_ALPHA * (f32x2){xv.x, xv.y} + (f32x2){1.f + gg.x, 1.f + gg.y} * acc[j][2 * q];
                r[2 * q + 1] = DEEP_ALPHA * (f32x2){xv.z, xv.w} + (f32x2){1.f + gg.z, 1.f + gg.w} * acc[j][2 * q + 1];
                sm += r[2 * q].x + r[2 * q].y + r[2 * q + 1].x + r[2 * q + 1].y;
            }
#pragma unroll
            for (int m = 1; m < 64; m <<= 1) sm += __shfl_xor(sm, m);
            const float mu = sm * (1.0f / 1024.0f);
            float qq = 0.f;
#pragma unroll
            for (int i = 0; i < 8; ++i) { const f32x2 dd = r[i] - mu; qq += dd.x * dd.x + dd.y * dd.y; }
#pragma unroll
            for (int m = 1; m < 64; m <<= 1) qq += __shfl_xor(qq, m);
            const float rstd = rsqrtf(qq * (1.0f / 1024.0f) + LN_EPS);
#pragma unroll
            for (int q = 0; q < 4; ++q) {
                const f32x4 w4 = *(const f32x4*)(p.ln2w + c0 + q * 4), bi = *(const f32x4*)(p.ln2b + c0 + q * 4);
                f32x4 ov;
                ov.x = (r[2 * q].x - mu) * rstd * w4.x + bi.x; ov.y = (r[2 * q].y - mu) * rstd * w4.y + bi.y;
                ov.z = (r[2 * q + 1].x - mu) * rstd * w4.z + bi.z; ov.w = (r[2 * q + 1].y - mu) * rstd * w4.w + bi.w;
                *(f32x4*)(row + q * 4) = ov;
            }
        }
    }
}

#define XB_TMO      128
#define XB_XCNT(j)  (256  + 64 * (j))
#define XB_XSUB(j)  (1280 + 64 * (j))
#define XB_XGEN(j)  (2304 + 64 * (j))
#define XB_TOP      3328
#define XB_TOPGEN   3392
#define XCD_BAR_WORDS 3456
#define XB_SPIN_CAP (1u << 22)
#define LAS __attribute__((address_space(3)))
DI unsigned xb_ld(unsigned* p) { return __hip_atomic_load(p, __ATOMIC_RELAXED, __HIP_MEMORY_SCOPE_AGENT); }
DI unsigned xb_add(unsigned* p, unsigned v) { return __hip_atomic_fetch_add(p, v, __ATOMIC_RELAXED, __HIP_MEMORY_SCOPE_AGENT); }
DI unsigned xb_xcc_id() { return (unsigned)__builtin_amdgcn_s_getreg((3 << 11) | 20) & 0xFu; }
#define XB_SPIN(cond, bar) do { unsigned _sp = 0; while (cond) { __builtin_amdgcn_s_sleep(1); \
    if ((++_sp & 255u) == 0u) { if (xb_ld(&(bar)[XB_TMO])) break; if (_sp > XB_SPIN_CAP) { atomicAdd(&(bar)[XB_TMO], 1u); break; } } } } while (0)
struct XcdBarrier { unsigned* bar; unsigned x; volatile LAS unsigned* st; };
DI XcdBarrier xcd_barrier_post(unsigned* bar, volatile LAS unsigned* st) {
    XcdBarrier b; b.bar = bar; b.x = xb_xcc_id(); b.st = st;
    if (__builtin_amdgcn_workitem_id_x() == 0) (void)xb_add(&bar[XB_XCNT(b.x)], 1u);
    return b;
}
DI void xcd_barrier_complete(unsigned* bar, unsigned x, unsigned& nloc, unsigned& nx) {
    const unsigned G = gridDim.x * gridDim.y * gridDim.z;
    unsigned sum, cnt, mine, sp = 0u;
    for (;;) {
        sum = 0u; cnt = 0u; mine = 0u;
#pragma unroll
        for (unsigned j = 0; j < 16; ++j) { const unsigned c = xb_ld(&bar[XB_XCNT(j)]); sum += c; cnt += (c > 0u) ? 1u : 0u; mine = (j == x) ? c : mine; }
        if (sum == G) break;
        __builtin_amdgcn_s_sleep(1);
        if ((++sp & 255u) == 0u) { if (xb_ld(&bar[XB_TMO])) break; if (sp > XB_SPIN_CAP) { atomicAdd(&bar[XB_TMO], 1u); break; } }
    }
    nloc = mine > 0u ? mine : 1u; nx = cnt > 0u ? cnt : 1u;
}
DI void xcd_barrier(const XcdBarrier& b) {
    asm volatile("s_waitcnt vmcnt(0)" ::: "memory");
    __syncthreads();
    if (__builtin_amdgcn_workitem_id_x() == 0) {
        unsigned* bar = b.bar;
        __builtin_amdgcn_s_waitcnt(0);
        unsigned nloc = b.st[0], nx = b.st[1];
        if (nloc == 0u) { xcd_barrier_complete(bar, b.x, nloc, nx); b.st[0] = nloc; b.st[1] = nx; }
        const unsigned old = xb_add(&bar[XB_XSUB(b.x)], 1u);
        const unsigned gen = old / nloc;
        if (old + 1u == (gen + 1u) * nloc) {
            __builtin_amdgcn_fence(__ATOMIC_RELEASE, "agent");
            asm volatile("s_waitcnt vmcnt(0)" ::: "memory");
            const unsigned og = xb_add(&bar[XB_TOP], 1u);
            const unsigned tg = og / nx;
            if (og + 1u == (tg + 1u) * nx) xb_add(&bar[XB_TOPGEN], 1u);
            else XB_SPIN(xb_ld(&bar[XB_TOPGEN]) == tg, bar);
            __builtin_amdgcn_fence(__ATOMIC_ACQUIRE, "agent");
            xb_add(&bar[XB_XGEN(b.x)], 1u);
            asm volatile("s_waitcnt vmcnt(0)" ::: "memory");
        } else {
            XB_SPIN(xb_ld(&bar[XB_XGEN(b.x)]) == gen, bar);
            __builtin_amdgcn_fence(__ATOMIC_ACQUIRE, "agent");
            asm volatile("s_waitcnt vmcnt(0)" ::: "memory");
        }
    }
    __syncthreads();
}

__global__ void __launch_bounds__(NTH) k_mega(Params p) {
    __shared__ __attribute__((aligned(16))) char smem[SMEM_BYTES];
    volatile LAS unsigned* xst = (volatile LAS unsigned*)(smem + SMEM_BYTES - 16);
    if (__builtin_amdgcn_workitem_id_x() == 0) { xst[0] = 0u; xst[1] = 0u; }
    __syncthreads();
    const XcdBarrier xb = xcd_barrier_post((unsigned*)(p.ws + OFF_BAR), xst);
    const int bid = blockIdx.x, nb = gridDim.x;
#ifndef PROBE_MASK
#define PROBE_MASK 0
#endif
#define REP(bit) for (int rep_ = 0; rep_ < ((PROBE_MASK & (bit)) ? 2 : 1); ++rep_)
    REP(64) { phase_prep(p, bid, nb, smem);    xcd_barrier(xb); }
    REP(64) { phase_h(p, bid, nb);             xcd_barrier(xb); }
    REP(1)  { phase_proj(p, bid, nb, smem);    xcd_barrier(xb); }
    REP(128) { phase_hgprep(p, bid, nb);       xcd_barrier(xb); }
    REP(2)  { phase_mix(p, bid, nb, smem);     xcd_barrier(xb); }
    REP(4)  { phase_glu(p, bid, nb, smem);     xcd_barrier(xb); }
    REP(4)  { phase_a2(p, bid, nb);            xcd_barrier(xb); }
    REP(4)  { phase_outproj(p, bid, nb, smem); xcd_barrier(xb); }
    phase_ln1(p, bid, nb);           xcd_barrier(xb);
    REP(8)  { phase_q(p, bid, nb, smem);       xcd_barrier(xb); }
    REP(16) { phase_retrieve(p, bid, nb, smem); xcd_barrier(xb); }
    phase_gather(p, bid, nb, smem);
}

extern "C" void kernel_launch(void* const* d_in, const int* in_sizes, int n_in, void* d_out, int out_size, void* d_ws, size_t ws_size, hipStream_t stream) {
    if (n_in != 27 || ws_size < WS_END) { fprintf(stderr, "kernel_launch: unexpected n_in %d or ws_size %zu (< %zu)\n", n_in, ws_size, (size_t)WS_END); return; }
    static int grid_blocks = 0;
    if (!grid_blocks) {
        int dev = 0, cus = 0, per_cu = 0;
        (void)hipGetDevice(&dev);
        (void)hipDeviceGetAttribute(&cus, hipDeviceAttributeMultiprocessorCount, dev);
        (void)hipOccupancyMaxActiveBlocksPerMultiprocessor(&per_cu, k_mega, NTH, 0);
        if (cus <= 0) cus = 256;
        if (per_cu < 1) { fprintf(stderr, "kernel_launch: occupancy query says %d blocks/CU\n", per_cu); per_cu = 1; }
        grid_blocks = cus;
    }
    Params p{};
    const float** f = (const float**)&p;
    for (int i = 0; i < 27; ++i) f[i] = (const float*)d_in[i];
    p.out = (float*)d_out; p.ws = (char*)d_ws;
    hipError_t e = hipMemsetAsync((char*)d_ws + OFF_BAR, 0, (size_t)3456 * 4, stream);
    if (e == hipSuccess) { hipLaunchKernelGGL(k_mega, dim3(grid_blocks), dim3(NTH), 0, stream, p); e = hipPeekAtLastError(); }
    if (e != hipSuccess) fprintf(stderr, "launch failed: %s (grid %d)\n", hipGetErrorString(e), grid_blocks);
}
```

```cpp
#include <hip/hip_runtime.h>
#include <hip/hip_cooperative_groups.h>
#include <stdint.h>
#include <stdio.h>

namespace cg = cooperative_groups;
#define DI __device__ __forceinline__
typedef unsigned short bf16_t;
typedef short bf16x8 __attribute__((ext_vector_type(8)));
typedef float f32x16 __attribute__((ext_vector_type(16)));
typedef unsigned u32x4 __attribute__((ext_vector_type(4)));
typedef float f32x4 __attribute__((ext_vector_type(4)));
typedef float f32x2 __attribute__((ext_vector_type(2)));

constexpr int NTH = 512;
constexpr int NB = 16, SEQ = 2048, DM = 1024, NTOK = NB * SEQ;
constexpr int DHG = 512, HGH = 4, HDK = 128;
constexpr int DSS = 512, SSG = 32, SSC = 16, SSP = 64;
constexpr int INC = 2560;
constexpr int PHEADS = 8, NKEYS = 128, TOPK = 16, NEXP = 16384;
constexpr float DEEP_ALPHA = 1.189207115002721f;
constexpr float LN_EPS = 1e-5f, RMS_EPS = 1e-6f;
constexpr int SMEM_BYTES = 128 * 1024 + 256;

constexpr size_t al256(size_t x) { return (x + 255) & ~(size_t)255; }
constexpr size_t OFF_MOD = 0;
constexpr size_t OFF_LB = al256(OFF_MOD + (size_t)NB * 6144 * 4);
constexpr size_t OFF_LAM = al256(OFF_LB + 512 * 4);
constexpr size_t OFF_BB = al256(OFF_LAM + 32 * 64 * 2 * 4);
constexpr size_t OFF_WIN = al256(OFF_BB + 32 * 64 * 16 * 2 * 4);
constexpr size_t OFF_GLU = al256(OFF_WIN + (size_t)INC * DM * 2);
constexpr size_t OFF_WOUT = al256(OFF_GLU + (size_t)512 * 512 * 2);
constexpr size_t OFF_WQ = al256(OFF_WOUT + (size_t)DM * DM * 2);
constexpr size_t OFF_SUBK = al256(OFF_WQ + (size_t)2048 * DM * 2);
constexpr size_t OFF_SU = al256(OFF_SUBK + (size_t)16 * 128 * 128 * 2);
constexpr size_t OFF_SV = al256(OFF_SU + (size_t)NEXP * 4);
constexpr size_t OFF_UT = al256(OFF_SV + (size_t)NEXP * 4);
constexpr size_t OFF_VT = al256(OFF_UT + (size_t)NEXP * DM * 2);
constexpr size_t OFF_H = al256(OFF_VT + (size_t)NEXP * DM * 2);
constexpr size_t OFF_PROJ = al256(OFF_H + (size_t)NTOK * DM * 2);
constexpr size_t OFF_ORAW = al256(OFF_PROJ + (size_t)NTOK * INC * 2);
constexpr size_t OFF_YSSM = al256(OFF_ORAW + (size_t)NTOK * DHG * 4);
constexpr size_t OFF_A2 = al256(OFF_YSSM + (size_t)NTOK * DSS * 2);
constexpr size_t OFF_HG = al256(OFF_A2 + (size_t)NTOK * DM * 2);
constexpr size_t OFF_S5K = al256(OFF_HG + (size_t)4096 * 128 * 4);
constexpr size_t OFF_S5N = al256(OFF_S5K + (size_t)32 * 4096 * 2);
constexpr size_t OFF_S5M = al256(OFF_S5N + (size_t)32 * 128 * 256 * 2);
constexpr size_t OFF_S5L = al256(OFF_S5M + (size_t)32 * 256 * 128 * 2);
constexpr size_t OFF_BAR = al256(OFF_S5L + (size_t)32 * 64 * 2 * 4);
constexpr size_t WS_END = al256(OFF_BAR + (size_t)3456 * 4);
constexpr size_t OFF_HQ = OFF_H, OFF_HK = OFF_H + (size_t)NTOK * DHG * 2, OFF_HKT = OFF_A2, OFF_HVT = OFF_A2 + (size_t)NTOK * DHG * 2;
constexpr size_t OFF_TOPL = OFF_ORAW;
constexpr size_t OFF_EXPS = OFF_ORAW + (size_t)NTOK * 16 * 16 * 4;

struct Params {
    const float *x, *c, *ada_w, *ada_b, *w_in, *hg_lb, *hg_nw, *a_re, *a_im, *log_dt, *b_re, *b_im, *c_re, *c_im, *dsk,
        *glu_w, *glu_b, *ssm_nw, *w_out, *ln1w, *ln1b, *w_q, *subk, *pu, *pv, *ln2w, *ln2b;
    float* out;
    char* ws;
};

DI int my_tid() { int t = (int)__builtin_amdgcn_workitem_id_x(); asm volatile("" : "+v"(t)); return t; }
DI bf16_t f2bf(float x) { unsigned u = __float_as_uint(x); u += 0x7fffu + ((u >> 16) & 1u); return (bf16_t)(u >> 16); }
DI float bf2f(bf16_t b) { return __uint_as_float(((unsigned)b) << 16); }
DI float bflo(unsigned w) { return __uint_as_float(w << 16); }
DI float bfhi(unsigned w) { return __uint_as_float(w & 0xffff0000u); }
typedef __bf16 hwbf16x2 __attribute__((ext_vector_type(2)));
DI unsigned pack2(float a, float b) { const f32x2 v = {a, b}; return __builtin_bit_cast(unsigned, __builtin_convertvector(v, hwbf16x2)); }
DI bf16x8 pack8(const f32x16& x, const int base) {
    u32x4 o; o.x = pack2(x[base], x[base + 1]); o.y = pack2(x[base + 2], x[base + 3]); o.z = pack2(x[base + 4], x[base + 5]); o.w = pack2(x[base + 6], x[base + 7]);
    return __builtin_bit_cast(bf16x8, o);
}
DI float sigmoidf_(float x) { return 1.0f / (1.0f + __expf(-x)); }
DI float siluf_(float x) { return x * sigmoidf_(x); }
DI float geluf_(float x) { return 0.5f * x * (1.0f + erff(x * 0.70710678118654752f)); }
DI float gelu_as(float v) {
    const float t = __builtin_amdgcn_rcpf(fabsf(v) * 0.2316418882f + 1.0f);
    float q = t * 0.5307027145f + (-0.7265760135f); q = q * t + 0.7107068705f; q = q * t + (-0.142248368f); q = q * t + 0.127414796f; q = q * t;
    const float m = v * (q * __builtin_amdgcn_exp2f(v * v * (-0.72134752044f)));
    return v < 0.f ? m : v - m;
}

template <int MT, int NT_, int WM, int WN, class Epi>
DI void gemm_block(const bf16_t* __restrict__ A, int lda, const bf16_t* __restrict__ Bt, int ldb, int K, char* smem, Epi epi) {
    constexpr int BM = WM * MT * 32, BN = WN * NT_ * 32, LS = 72;
    static_assert(WM * WN == 8, "8 waves");
    bf16_t* As = (bf16_t*)smem;
    bf16_t* Bs = As + BM * LS;
    const int tid = my_tid(), lane = tid & 63, wid = tid >> 6, r = lane & 31, h = lane >> 5;
    const int wm = wid / WN, wn = wid % WN;
    constexpr int PA = BM * 8 / NTH, PB = BN * 8 / NTH;
    u32x4 ra[PA], rb[PB];
    f32x16 acc[MT][NT_];
#pragma unroll
    for (int mi = 0; mi < MT; ++mi)
#pragma unroll
        for (int ni = 0; ni < NT_; ++ni)
#pragma unroll
            for (int i = 0; i < 16; ++i) acc[mi][ni][i] = 0.f;
#define GEMM_GLOAD(kt_) { \
    _Pragma("unroll") for (int q = 0; q < PA; ++q) { const int idx = tid + q * NTH, row = idx >> 3, ch = idx & 7; ra[q] = *(const u32x4*)(A + (size_t)row * lda + (kt_) * 64 + ch * 8); } \
    _Pragma("unroll") for (int q = 0; q < PB; ++q) { const int idx = tid + q * NTH, row = idx >> 3, ch = idx & 7; rb[q] = *(const u32x4*)(Bt + (size_t)row * ldb + (kt_) * 64 + ch * 8); } }
#define GEMM_LSTORE() { \
    _Pragma("unroll") for (int q = 0; q < PA; ++q) { const int idx = tid + q * NTH, row = idx >> 3, ch = idx & 7; *(u32x4*)(As + row * LS + ch * 8) = ra[q]; } \
    _Pragma("unroll") for (int q = 0; q < PB; ++q) { const int idx = tid + q * NTH, row = idx >> 3, ch = idx & 7; *(u32x4*)(Bs + row * LS + ch * 8) = rb[q]; } }
    GEMM_GLOAD(0); GEMM_LSTORE(); __syncthreads();
    const int nk = K / 64;
    for (int kt = 0; kt < nk; ++kt) {
        if (kt + 1 < nk) GEMM_GLOAD(kt + 1);
#pragma unroll
        for (int ks = 0; ks < 4; ++ks) {
            bf16x8 a[MT], b[NT_];
#pragma unroll
            for (int mi = 0; mi < MT; ++mi) a[mi] = *(const bf16x8*)(As + (wm * MT * 32 + mi * 32 + r) * LS + ks * 16 + h * 8);
#pragma unroll
            for (int ni = 0; ni < NT_; ++ni) b[ni] = *(const bf16x8*)(Bs + (wn * NT_ * 32 + ni * 32 + r) * LS + ks * 16 + h * 8);
#pragma unroll
            for (int mi = 0; mi < MT; ++mi)
#pragma unroll
                for (int ni = 0; ni < NT_; ++ni) acc[mi][ni] = __builtin_amdgcn_mfma_f32_32x32x16_bf16(a[mi], b[ni], acc[mi][ni], 0, 0, 0);
        }
        __syncthreads();
        if (kt + 1 < nk) { GEMM_LSTORE(); __syncthreads(); }
    }
#pragma unroll
    for (int mi = 0; mi < MT; ++mi)
#pragma unroll
        for (int ni = 0; ni < NT_; ++ni)
#pragma unroll
            for (int i = 0; i < 16; ++i) epi(wm * MT * 32 + mi * 32 + (i & 3) + 8 * (i >> 2) + 4 * h, wn * NT_ * 32 + ni * 32 + r, acc[mi][ni][i]);
}

namespace pg8 {
#define PG8_LAS __attribute__((address_space(3)))
typedef unsigned short bf16_t;
typedef short bf16x8 __attribute__((ext_vector_type(8)));
typedef float f32x4 __attribute__((ext_vector_type(4)));
typedef unsigned u32x4 __attribute__((ext_vector_type(4)));
constexpr int BM = 256, BK = 64, HALF = 128, HTB = HALF * BK * 2  , STAGE_BYTES = 8 * HTB, NXCD = 8, WGM = 8;

__host__ __device__ __forceinline__ int lds_byte(int r, int c) { const int st = (r >> 4) * 2 + (c >> 5), rr = r & 15, cc = c & 31, ob = rr * 64 + cc * 2; return st * 1024 + (ob ^ (((ob >> 9) & 1) << 5)); }
__host__ __device__ __forceinline__ void stage_rc(int b, int& R, int& C) { const int st = b / 1024, sb = b % 1024, swz = sb ^ (((sb >> 9) & 1) << 5); R = (st >> 1) * 16 + swz / 64; C = (st & 1) * 32 + (swz % 64) / 2; }
__host__ __device__ __forceinline__ int perm32(int rho) { const int n = rho >> 4, i = rho & 15; return 8 * (i >> 2) + 4 * n + (i & 3); }

struct Unit { int pm, pn; };
struct Gemm { const bf16_t* A; const bf16_t* Bt; int M, N, K; };

struct StaticOrder {
    int nM, nN, nwg, G, c;
    __host__ __device__ void init(int M, int N, int G_, int c_) { nM = M / BM; nN = N / BM; nwg = nM * nN; G = G_; c = c_; }
    __host__ __device__ bool next(int i, Unit& u) const {
        const long L = (long)i * G + c; if (L >= nwg) return false;
        int wgid = (int)L; { const int q = nwg / NXCD, r = nwg % NXCD, xcd = wgid % NXCD, off = wgid / NXCD; wgid = (xcd < r ? xcd * (q + 1) : r * (q + 1) + (xcd - r) * q) + off; }
        const int nig = WGM * nN, gid = wgid / nig, fm = gid * WGM, gsz = (nM - fm) < WGM ? (nM - fm) : WGM;
        u.pm = fm + ((wgid % nig) % gsz); u.pn = (wgid % nig) / gsz; return true;
    }
    __device__ __forceinline__ void a_ready(const Unit&) const {}
    __device__ __forceinline__ void done(const Unit&) const {}
};
template <class Epi, class Sched, bool STAMP = false>
__device__ __forceinline__ void gemm_phase(PG8_LAS unsigned char* lds, const Gemm g, const Sched& S, const Epi& E, unsigned long long* stamps) {
    const int tid = (int)__builtin_amdgcn_workitem_id_x(), wid = __builtin_amdgcn_readfirstlane(tid >> 6), lane = tid & 63, wr = wid >> 2, wc = wid & 3, fr = lane & 15, fq = lane >> 4;
    const int K = g.K, nt = K / BK;
    int ts_lo = 0, ts_hi = 0, nts = 0; const unsigned long long rt_entry = STAMP ? (unsigned long long)wall_clock64() : 0ull;
#define PG8_STAMP() do { if (STAMP && wid == 0 && nts < 64) { const unsigned long long _c = (unsigned long long)clock64(); \
        ts_lo = (lane == nts) ? (int)(unsigned)_c : ts_lo; ts_hi = (lane == nts) ? (int)(unsigned)(_c >> 32) : ts_hi; ++nts; } } while (0)
    PG8_STAMP();
    unsigned voffA[2], voffB[2];
#pragma unroll
    for (int i = 0; i < 2; ++i) { int R, C; stage_rc(tid * 16 + i * 8192, R, C); const int Rb = Epi::PERM ? ((R & ~31) + perm32(R & 31)) : R;
        voffA[i] = (unsigned)(R * K + C) * 2u; voffB[i] = (unsigned)(Rb * K + C) * 2u; }
    const size_t kstep = (size_t)(BK * 2);
    const size_t hstep = (size_t)HALF * K * 2;
    const size_t tstep = 2 * hstep;
    const unsigned ldsw = (unsigned)wid * 1024u;
    const int aoff = lds_byte(wr * 64 + fr, fq * 8), boff = lds_byte(wc * 32 + fr, fq * 8);
#define PG8_SA(b, h) (((b) * 2 + (h)) * HTB)
#define PG8_SB(b, h) ((4 + (b) * 2 + (h)) * HTB)
#define PG8_STAGE(bufoff, gbase, voff) do { _Pragma("unroll") for (int _i = 0; _i < 2; ++_i) \
        __builtin_amdgcn_global_load_lds((const unsigned*)((const char*)(gbase) + (voff)[_i]), (PG8_LAS unsigned*)(lds + (bufoff) + ldsw + _i * 8192), 16, 0, 0); } while (0)
#define PG8_LDA(dst, b, h) do { _Pragma("unroll") for (int m = 0; m < 4; ++m) _Pragma("unroll") for (int k = 0; k < 2; ++k) dst[m][k] = *(const PG8_LAS bf16x8*)(lds + PG8_SA(b, h) + aoff + m * 2048 + k * 1024); } while (0)
#define PG8_LDB(dst, b, h) do { _Pragma("unroll") for (int n = 0; n < 2; ++n) _Pragma("unroll") for (int k = 0; k < 2; ++k) dst[n][k] = *(const PG8_LAS bf16x8*)(lds + PG8_SB(b, h) + boff + n * 2048 + k * 1024); } while (0)
#define PG8_MMA(ai, bj, At, Bt) do { __builtin_amdgcn_s_setprio(1); _Pragma("unroll") for (int m = 0; m < 4; ++m) _Pragma("unroll") for (int n = 0; n < 2; ++n) _Pragma("unroll") for (int k = 0; k < 2; ++k) \
        acc[ai][bj][m][n] = __builtin_amdgcn_mfma_f32_16x16x32_bf16(Bt[n][k], At[m][k], acc[ai][bj][m][n], 0, 0, 0); __builtin_amdgcn_s_setprio(0); } while (0)
#define PG8_WAIT_V(n) asm volatile("s_waitcnt vmcnt(" #n ")" ::: "memory")
#define PG8_WAIT_L(n) asm volatile("s_waitcnt lgkmcnt(" #n ")" ::: "memory")
#define PG8_BAR __builtin_amdgcn_s_barrier()
#define PG8_SCHED __builtin_amdgcn_sched_barrier(0)
    Unit cur, nxt; int ui = 0;
    if (!S.next(0, cur)) return;
    f32x4 acc[2][2][4][2];
#pragma unroll
    for (int a = 0; a < 2; ++a)
#pragma unroll
        for (int b = 0; b < 2; ++b)
#pragma unroll
            for (int m = 0; m < 4; ++m)
#pragma unroll
                for (int n = 0; n < 2; ++n) acc[a][b][m][n] = (f32x4){0.f, 0.f, 0.f, 0.f};
    bf16x8 At[4][2], B0[2][2], B1[2][2];
    const char* cA = (const char*)g.A + (size_t)cur.pm * tstep; const char* cB = (const char*)g.Bt + (size_t)cur.pn * tstep;
    S.a_ready(cur);
    PG8_STAGE(PG8_SB(0, 0), cB, voffB); PG8_STAGE(PG8_SA(0, 0), cA, voffA); PG8_STAGE(PG8_SB(0, 1), cB + hstep, voffB); PG8_STAGE(PG8_SA(0, 1), cA + hstep, voffA);
    if (wr == 1) PG8_BAR;
    PG8_WAIT_V(4); PG8_BAR;
    PG8_STAGE(PG8_SB(1, 0), cB + kstep, voffB); PG8_STAGE(PG8_SA(1, 0), cA + kstep, voffA); PG8_STAGE(PG8_SB(1, 1), cB + hstep + kstep, voffB);
    PG8_WAIT_V(6); PG8_BAR;
    PG8_STAMP();
    for (;;) {
        const bool has_next = S.next(ui + 1, nxt);
        const char* nA = has_next ? (const char*)g.A + (size_t)nxt.pm * tstep : cA; const char* nB = has_next ? (const char*)g.Bt + (size_t)nxt.pn * tstep : cB;
        for (int t = 0; t < nt; t += 2) {
            const bool last = (t == nt - 2);
            const char* a1 = cA + (size_t)(t + 1) * kstep;
            const char* a2 = last ? nA : cA + (size_t)(t + 2) * kstep; const char* b2 = last ? nB : cB + (size_t)(t + 2) * kstep;
            const char* a3 = a2 + kstep; const char* b3 = b2 + kstep;
            if (last && has_next) S.a_ready(nxt);
            PG8_LDB(B0, 0, 0); PG8_SCHED; PG8_LDA(At, 0, 0); PG8_STAGE(PG8_SA(1, 1), a1 + hstep, voffA);
            PG8_WAIT_L(8); PG8_BAR; PG8_WAIT_L(0); PG8_MMA(0, 0, At, B0); PG8_BAR; PG8_SCHED;
            PG8_LDB(B1, 0, 1); PG8_STAGE(PG8_SB(0, 0), b2, voffB);
            PG8_BAR; PG8_WAIT_L(0); PG8_MMA(0, 1, At, B1); PG8_BAR;
            PG8_LDA(At, 0, 1); PG8_STAGE(PG8_SA(0, 0), a2, voffA);
            PG8_BAR; PG8_WAIT_L(0); PG8_MMA(1, 0, At, B0); PG8_BAR; PG8_SCHED;
            PG8_STAGE(PG8_SB(0, 1), b2 + hstep, voffB);
            PG8_WAIT_V(6); PG8_BAR; PG8_MMA(1, 1, At, B1); PG8_BAR;
            PG8_LDB(B0, 1, 0); PG8_SCHED; PG8_LDA(At, 1, 0); PG8_STAGE(PG8_SA(0, 1), a2 + hstep, voffA);
            PG8_WAIT_L(8); PG8_BAR; PG8_WAIT_L(0); PG8_MMA(0, 0, At, B0); PG8_BAR; PG8_SCHED;
            PG8_LDB(B1, 1, 1); PG8_STAGE(PG8_SB(1, 0), b3, voffB);
            PG8_BAR; PG8_WAIT_L(0); PG8_MMA(0, 1, At, B1); PG8_BAR;
            PG8_LDA(At, 1, 1); PG8_STAGE(PG8_SA(1, 0), a3, voffA);
            PG8_BAR; PG8_WAIT_L(0); PG8_MMA(1, 0, At, B0); PG8_BAR; PG8_SCHED;
            PG8_STAGE(PG8_SB(1, 1), b3 + hstep, voffB);
            PG8_WAIT_V(6); PG8_BAR; PG8_MMA(1, 1, At, B1); PG8_BAR;
        }
        PG8_STAMP();
        if constexpr (!Epi::AFTER_DRAIN) { E(acc, cur, wr, wc, fr, fq); S.done(cur); }
        PG8_STAMP();
        if (!has_next) break;
#pragma unroll
        for (int a = 0; a < 2; ++a)
#pragma unroll
            for (int b = 0; b < 2; ++b)
#pragma unroll
                for (int m = 0; m < 4; ++m)
#pragma unroll
                    for (int n = 0; n < 2; ++n) acc[a][b][m][n] = (f32x4){0.f, 0.f, 0.f, 0.f};
        cur = nxt; cA = nA; cB = nB; ++ui;
    }
    PG8_WAIT_V(0);
    if (wr == 0) PG8_BAR;
    PG8_BAR;
    if constexpr (Epi::AFTER_DRAIN) { E.fused(acc, cur, wr, wc, fr, fq, lds, wid, lane); S.done(cur); }
    PG8_STAMP();
    if (STAMP && wid == 0) { stamps[lane] = lane < nts ? (((unsigned long long)(unsigned)ts_hi << 32) | (unsigned)ts_lo) : 0ull;
        if (lane == 62) stamps[62] = rt_entry; if (lane == 63) stamps[63] = (unsigned long long)wall_clock64(); }
#undef PG8_STAMP
#undef PG8_SA
#undef PG8_SB
#undef PG8_STAGE
#undef PG8_LDA
#undef PG8_LDB
#undef PG8_MMA
#undef PG8_WAIT_V
#undef PG8_WAIT_L
#undef PG8_BAR
#undef PG8_SCHED
}

__device__ __forceinline__ unsigned pk_bf16(float lo, float hi) { typedef float v2f __attribute__((ext_vector_type(2))); typedef __bf16 v2b __attribute__((ext_vector_type(2))); const v2f v = {lo, hi}; return __builtin_bit_cast(unsigned, __builtin_convertvector(v, v2b)); }
__device__ __forceinline__ float silu1(float x) { return x * __builtin_amdgcn_rcpf(1.0f + __expf(-x)); }
struct EpiBf16Act {
    static constexpr bool PERM = true, AFTER_DRAIN = false;
    bf16_t* O; int ldc; unsigned silu_mask;
    __device__ __forceinline__ void operator()(const f32x4 (&acc)[2][2][4][2], const Unit& u, int wr, int wc, int fr, int fq) const {
        const int row0 = u.pm * BM + wr * 64 + fr, col0 = u.pn * BM + wc * 32 + 8 * fq;
        const bool act = (silu_mask >> u.pn) & 1u;
#pragma unroll
        for (int ai = 0; ai < 2; ++ai)
#pragma unroll
            for (int m = 0; m < 4; ++m) { bf16_t* rowp = O + (size_t)(row0 + ai * HALF + m * 16) * ldc + col0;
#pragma unroll
                for (int bj = 0; bj < 2; ++bj) { f32x4 v0 = acc[ai][bj][m][0], v1 = acc[ai][bj][m][1];
                    if (act) {
#pragma unroll
                        for (int j = 0; j < 4; ++j) { v0[j] = silu1(v0[j]); v1[j] = silu1(v1[j]); } }
                    u32x4 w; w.x = pk_bf16(v0[0], v0[1]); w.y = pk_bf16(v0[2], v0[3]); w.z = pk_bf16(v1[0], v1[1]); w.w = pk_bf16(v1[2], v1[3]);
                    *(u32x4*)(rowp + bj * HALF) = w; } }
    }
};
struct EpiResid {
    static constexpr bool PERM = false, AFTER_DRAIN = false;
    float* C; const float* X; const float* mod_g;
    float alpha;
    __device__ __forceinline__ void operator()(const f32x4 (&acc)[2][2][4][2], const Unit& u, int wr, int wc, int fr, int fq) const {
        const int row0 = u.pm * BM + wr * 64 + fr, col0 = u.pn * BM + wc * 32 + 4 * fq;
        const float* gb = mod_g + (size_t)((u.pm * BM) / 2048) * 6144 + col0;
        f32x4 gv[2][2];
#pragma unroll
        for (int bj = 0; bj < 2; ++bj)
#pragma unroll
            for (int n = 0; n < 2; ++n) gv[bj][n] = *(const f32x4*)(gb + bj * HALF + n * 16) + 1.0f;
#pragma unroll
        for (int ai = 0; ai < 2; ++ai)
#pragma unroll
            for (int m = 0; m < 4; ++m) { const size_t ro = (size_t)(row0 + ai * HALF + m * 16) * 1024 + col0;
#pragma unroll
                for (int bj = 0; bj < 2; ++bj)
#pragma unroll
                    for (int n = 0; n < 2; ++n) { const f32x4 xv = *(const f32x4*)(X + ro + bj * HALF + n * 16); *(f32x4*)(C + ro + bj * HALF + n * 16) = alpha * xv + gv[bj][n] * acc[ai][bj][m][n]; } }
    }
};
struct EpiGlu {
    static constexpr bool PERM = false, AFTER_DRAIN = false;
    float* C; const bf16_t* Y; const float* bias;
    __device__ __forceinline__ void operator()(const f32x4 (&acc)[2][2][4][2], const Unit& u, int wr, int wc, int fr, int fq) const {
        const int row0 = u.pm * BM + wr * 64 + fr, col0 = u.pn * BM + wc * 32 + 4 * fq;
        f32x4 bv[2][2];
#pragma unroll
        for (int bj = 0; bj < 2; ++bj)
#pragma unroll
            for (int n = 0; n < 2; ++n) bv[bj][n] = *(const f32x4*)(bias + col0 + bj * HALF + n * 16);
#pragma unroll
        for (int ai = 0; ai < 2; ++ai)
#pragma unroll
            for (int m = 0; m < 4; ++m) { const size_t ro = (size_t)(row0 + ai * HALF + m * 16) * 512 + col0;
#pragma unroll
                for (int bj = 0; bj < 2; ++bj)
#pragma unroll
                    for (int n = 0; n < 2; ++n) {
                        const uint2 yw = *(const uint2*)(Y + ro + bj * HALF + n * 16);
                        const f32x4 z = acc[ai][bj][m][n] + bv[bj][n];
                        f32x4 o;
                        o[0] = __uint_as_float(yw.x << 16) * __builtin_amdgcn_rcpf(1.0f + __expf(-z[0])); o[1] = __uint_as_float(yw.x & 0xffff0000u) * __builtin_amdgcn_rcpf(1.0f + __expf(-z[1]));
                        o[2] = __uint_as_float(yw.y << 16) * __builtin_amdgcn_rcpf(1.0f + __expf(-z[2])); o[3] = __uint_as_float(yw.y & 0xffff0000u) * __builtin_amdgcn_rcpf(1.0f + __expf(-z[3]));
                        *(f32x4*)(C + ro + bj * HALF + n * 16) = o; } }
    }
};
}

DI void prep_mod_item(const Params& p, int item, char* smem) {
    float* cond = (float*)smem;
    const int tid = my_tid();
    for (int i = tid; i < NB * DM; i += NTH) cond[i] = siluf_(p.c[i]);
    __syncthreads();
    const int b = tid >> 5, col = item * 32 + (tid & 31);
    float acc = 0.f;
    const float* w = p.ada_w + col;
    const float* cb = cond + b * DM;
#pragma unroll 8
    for (int k = 0; k < DM; ++k) acc += cb[k] * w[(size_t)k * 6144];
    ((float*)(p.ws + OFF_MOD))[b * 6144 + col] = acc + p.ada_b[col];
    __syncthreads();
}
DI void prep_s5_gemm_item(const Params& p, int g, char* smem) {
    f32x2* pw = (f32x2*)smem;
    f32x2* bbL = pw + 17 * 64;
    f32x2* cL = bbL + 64 * 16;
    const int tid = my_tid();
    const float dt = expf(p.log_dt[g]);
#pragma unroll 1
    for (int idx = tid; idx < 17 * 64; idx += NTH) {
        const int j = idx >> 6, pp = idx & 63;
        const float ar = p.a_re[g * 64 + pp], ai = p.a_im[g * 64 + pp];
        const float mag = expf(ar * dt * (float)j), ang = ai * dt * (float)j;
        pw[idx] = (f32x2){mag * cosf(ang), mag * sinf(ang)};
    }
    for (int idx = tid; idx < 16 * 64; idx += NTH) { const int i = idx >> 6, pp = idx & 63; cL[idx] = (f32x2){p.c_re[(g * 16 + i) * 64 + pp], p.c_im[(g * 16 + i) * 64 + pp]}; }
    __syncthreads();
    for (int idx = tid; idx < 64 * 16; idx += NTH) {
        const int pp = idx >> 4, i = idx & 15;
        const float ar = p.a_re[g * 64 + pp], ai = p.a_im[g * 64 + pp];
        const f32x2 lam = pw[64 + pp];
        const float den = ar * ar + ai * ai, nr = lam.x - 1.0f, ni = lam.y;
        const float zr = (nr * ar + ni * ai) / den, zi = (ni * ar - nr * ai) / den;
        const float br = p.b_re[(g * 64 + pp) * 16 + i], bi = p.b_im[(g * 64 + pp) * 16 + i];
        bbL[idx] = (f32x2){zr * br - zi * bi, zr * bi + zi * br};
    }
    __syncthreads();
    bf16_t* NBg = (bf16_t*)(p.ws + OFF_S5N) + (size_t)g * 128 * 256;
#pragma unroll 1
    for (int ch = tid; ch < 128 * 256 / 8; ch += NTH) {
        const int pq = ch >> 5, t = (ch >> 1) & 15, i0 = (ch & 1) * 8, pp = pq & 63;
        const f32x2 w = pw[(15 - t) * 64 + pp];
        float v[8];
#pragma unroll
        for (int e = 0; e < 8; ++e) { const f32x2 bb = bbL[pp * 16 + i0 + e]; v[e] = pq < 64 ? (w.x * bb.x - w.y * bb.y) : (w.x * bb.y + w.y * bb.x); }
        u32x4 o; o.x = pack2(v[0], v[1]); o.y = pack2(v[2], v[3]); o.z = pack2(v[4], v[5]); o.w = pack2(v[6], v[7]);
        *(u32x4*)(NBg + (size_t)((((pq >> 5) * 16 + t) * 64) + (i0 >> 3) * 32 + (pq & 31)) * 8) = o;
    }
    bf16_t* MBg = (bf16_t*)(p.ws + OFF_S5M) + (size_t)g * 256 * 128;
#pragma unroll 1
    for (int ch = tid; ch < 256 * 128 / 8; ch += NTH) {
        const int ti = ch >> 4, p0 = (ch & 15) * 8, tq = ti >> 4, iq = ti & 15;
        float v[8];
#pragma unroll
        for (int e = 0; e < 8; ++e) {
            const int pq = p0 + e, pp = pq & 63;
            const f32x2 c = cL[iq * 64 + pp], w = pw[(tq + 1) * 64 + pp];
            v[e] = pq < 64 ? (c.x * w.x - c.y * w.y) : -(c.x * w.y + c.y * w.x);
        }
        u32x4 o; o.x = pack2(v[0], v[1]); o.y = pack2(v[2], v[3]); o.z = pack2(v[4], v[5]); o.w = pack2(v[6], v[7]);
        *(u32x4*)(MBg + (size_t)((((ti >> 5) * 8 + (p0 >> 4)) * 64) + ((p0 >> 3) & 1) * 32 + (ti & 31)) * 8) = o;
    }
    bf16_t* KTg = (bf16_t*)(p.ws + OFF_S5K) + (size_t)g * 4096;
#pragma unroll 1
    for (int idx = tid; idx < 4096; idx += NTH) {
        const int lag = idx >> 8, iq = (idx >> 4) & 15, i = idx & 15;
        float acc = (lag == 0 && iq == i) ? p.dsk[g * 16 + iq] : 0.f;
#pragma unroll 4
        for (int pp = 0; pp < 64; ++pp) {
            const f32x2 c = cL[iq * 64 + pp], w = pw[lag * 64 + pp], bb = bbL[pp * 16 + i];
            const float mr = c.x * w.x - c.y * w.y, mi_ = c.x * w.y + c.y * w.x;
            acc += mr * bb.x - mi_ * bb.y;
        }
        KTg[idx] = f2bf(acc);
    }
    if (tid < 64) { float* L = (float*)(p.ws + OFF_S5L) + (g * 64 + tid) * 2; const f32x2 w = pw[16 * 64 + tid]; L[0] = w.x; L[1] = w.y; }
    __syncthreads();
}
DI void prep_s5_item(const Params& p, int g) {
    const int tid = my_tid();
    if (tid < SSP) {
        const int pi = g * SSP + tid;
        const float dt = expf(p.log_dt[g]);
        const float ar = p.a_re[pi], ai = p.a_im[pi];
        const float mag = expf(ar * dt);
        const float lr = mag * cosf(ai * dt), li = mag * sinf(ai * dt);
        const float den = ar * ar + ai * ai, nr = lr - 1.0f, ni = li;
        const float zr = (nr * ar + ni * ai) / den, zi = (ni * ar - nr * ai) / den;
        float* lam = (float*)(p.ws + OFF_LAM) + pi * 2;
        lam[0] = lr; lam[1] = li;
        float* bb = (float*)(p.ws + OFF_BB) + (size_t)pi * 32;
        for (int i = 0; i < SSC; ++i) {
            const float br = p.b_re[pi * SSC + i], bi = p.b_im[pi * SSC + i];
            bb[i * 2] = zr * br - zi * bi; bb[i * 2 + 1] = zr * bi + zi * br;
        }
    }
}
DI void prep_transpose_tile(const float* __restrict__ W, bf16_t* __restrict__ Wt, int K, int N, int kt, int nt, char* smem) {
    float* tile = (float*)smem;
    const int tid = my_tid();
#pragma unroll
    for (int q = 0; q < 2; ++q) {
        const int kk = (tid >> 4) + q * 32, c4 = (tid & 15) * 4;
        const float4 v = *(const float4*)(W + (size_t)(kt * 64 + kk) * N + nt * 64 + c4);
        tile[kk * 65 + c4] = v.x; tile[kk * 65 + c4 + 1] = v.y; tile[kk * 65 + c4 + 2] = v.z; tile[kk * 65 + c4 + 3] = v.w;
    }
    __syncthreads();
    const int n = tid >> 3, kc = tid & 7;
    uint4 o;
    o.x = pack2(tile[(kc * 8 + 0) * 65 + n], tile[(kc * 8 + 1) * 65 + n]);
    o.y = pack2(tile[(kc * 8 + 2) * 65 + n], tile[(kc * 8 + 3) * 65 + n]);
    o.z = pack2(tile[(kc * 8 + 4) * 65 + n], tile[(kc * 8 + 5) * 65 + n]);
    o.w = pack2(tile[(kc * 8 + 6) * 65 + n], tile[(kc * 8 + 7) * 65 + n]);
    *(uint4*)(Wt + (size_t)(nt * 64 + n) * K + kt * 64 + kc * 8) = o;
    __syncthreads();
}
DI void cvt_bf16_stream(const float* __restrict__ src, bf16_t* __restrict__ dst, size_t n8, int bid, int nb) {
    for (size_t i = (size_t)bid * NTH + my_tid(); i < n8; i += (size_t)nb * NTH) {
        const float4 a = *(const float4*)(src + i * 8), b = *(const float4*)(src + i * 8 + 4);
        uint4 o; o.x = pack2(a.x, a.y); o.y = pack2(a.z, a.w); o.z = pack2(b.x, b.y); o.w = pack2(b.z, b.w);
        *(uint4*)(dst + i * 8) = o;
    }
}
DI void cvt_fp8_rows(const float* __restrict__ src, unsigned char* __restrict__ dst, float* __restrict__ inv, int bid, int nb) {
    const int lane = my_tid() & 63, wid = my_tid() >> 6;
    for (int row = bid * 8 + wid; row < NEXP; row += nb * 8) {
        const float* sp = src + (size_t)row * DM + lane * 16;
        const f32x4 a = *(const f32x4*)sp, b = *(const f32x4*)(sp + 4), c = *(const f32x4*)(sp + 8), d = *(const f32x4*)(sp + 12);
        float m = fmaxf(fmaxf(fmaxf(fabsf(a.x), fabsf(a.y)), fmaxf(fabsf(a.z), fabsf(a.w))), fmaxf(fmaxf(fabsf(b.x), fabsf(b.y)), fmaxf(fabsf(b.z), fabsf(b.w))));
        m = fmaxf(m, fmaxf(fmaxf(fmaxf(fabsf(c.x), fabsf(c.y)), fmaxf(fabsf(c.z), fabsf(c.w))), fmaxf(fmaxf(fabsf(d.x), fabsf(d.y)), fmaxf(fabsf(d.z), fabsf(d.w)))));
#pragma unroll
        for (int s = 1; s < 64; s <<= 1) m = fmaxf(m, __shfl_xor(m, s));
        float sc = 1.f, isc = 1.f;
        if (m > 1e-30f) {
            int k = (int)floorf(log2f(448.0f / m));
            k = k < -60 ? -60 : (k > 60 ? 60 : k);
            sc = ldexpf(1.0f, k); isc = ldexpf(1.0f, -k);
            if (m * sc > 448.0f) { sc *= 0.5f; isc *= 2.0f; }
        }
        u32x4 o;
        int w;
        w = __builtin_amdgcn_cvt_pk_fp8_f32(a.x * sc, a.y * sc, 0, false); w = __builtin_amdgcn_cvt_pk_fp8_f32(a.z * sc, a.w * sc, w, true); o.x = (unsigned)w;
        w = __builtin_amdgcn_cvt_pk_fp8_f32(b.x * sc, b.y * sc, 0, false); w = __builtin_amdgcn_cvt_pk_fp8_f32(b.z * sc, b.w * sc, w, true); o.y = (unsigned)w;
        w = __builtin_amdgcn_cvt_pk_fp8_f32(c.x * sc, c.y * sc, 0, false); w = __builtin_amdgcn_cvt_pk_fp8_f32(c.z * sc, c.w * sc, w, true); o.z = (unsigned)w;
        w = __builtin_amdgcn_cvt_pk_fp8_f32(d.x * sc, d.y * sc, 0, false); w = __builtin_amdgcn_cvt_pk_fp8_f32(d.z * sc, d.w * sc, w, true); o.w = (unsigned)w;
        *(u32x4*)(dst + (size_t)row * DM + lane * 16) = o;
        if (lane == 0) inv[row] = isc;
    }
}
DI void cvt_fp4_rows(const float* __restrict__ src, unsigned char* __restrict__ dst, float* __restrict__ inv, int bid, int nb) {
    const int lane = my_tid() & 63, wid = my_tid() >> 6;
    for (int row = bid * 8 + wid; row < NEXP; row += nb * 8) {
        const float* sp = src + (size_t)row * DM + lane * 16;
        const f32x4 a = *(const f32x4*)sp, b = *(const f32x4*)(sp + 4), c = *(const f32x4*)(sp + 8), d = *(const f32x4*)(sp + 12);
        float m = fmaxf(fmaxf(fmaxf(fabsf(a.x), fabsf(a.y)), fmaxf(fabsf(a.z), fabsf(a.w))), fmaxf(fmaxf(fabsf(b.x), fabsf(b.y)), fmaxf(fabsf(b.z), fabsf(b.w))));
        m = fmaxf(m, fmaxf(fmaxf(fmaxf(fabsf(c.x), fabsf(c.y)), fmaxf(fabsf(c.z), fabsf(c.w))), fmaxf(fmaxf(fabsf(d.x), fabsf(d.y)), fmaxf(fabsf(d.z), fabsf(d.w)))));
#pragma unroll
        for (int s = 1; s < 64; s <<= 1) m = fmaxf(m, __shfl_xor(m, s));
        const float sc = m > 1e-30f ? 6.0f / m : 1.0f, isc = m > 1e-30f ? m * (1.0f / 6.0f) : 1.0f;
        unsigned w0 = 0u, w1 = 0u;
        w0 = __builtin_amdgcn_cvt_scalef32_pk_fp4_f32(w0, a.x * sc, a.y * sc, 1.0f, 0); w0 = __builtin_amdgcn_cvt_scalef32_pk_fp4_f32(w0, a.z * sc, a.w * sc, 1.0f, 1);
        w0 = __builtin_amdgcn_cvt_scalef32_pk_fp4_f32(w0, b.x * sc, b.y * sc, 1.0f, 2); w0 = __builtin_amdgcn_cvt_scalef32_pk_fp4_f32(w0, b.z * sc, b.w * sc, 1.0f, 3);
        w1 = __builtin_amdgcn_cvt_scalef32_pk_fp4_f32(w1, c.x * sc, c.y * sc, 1.0f, 0); w1 = __builtin_amdgcn_cvt_scalef32_pk_fp4_f32(w1, c.z * sc, c.w * sc, 1.0f, 1);
        w1 = __builtin_amdgcn_cvt_scalef32_pk_fp4_f32(w1, d.x * sc, d.y * sc, 1.0f, 2); w1 = __builtin_amdgcn_cvt_scalef32_pk_fp4_f32(w1, d.z * sc, d.w * sc, 1.0f, 3);
        *(uint2*)(dst + (size_t)row * (DM / 2) + lane * 8) = make_uint2(w0, w1);
        if (lane == 0) inv[row] = isc;
    }
}
template <int OFFS>
DI void cvt_i8_rows(const float* __restrict__ src, unsigned char* __restrict__ dst, float* __restrict__ inv, int bid, int nb) {
    const int lane = my_tid() & 63, wid = my_tid() >> 6;
    for (int row = bid * 8 + wid; row < NEXP; row += nb * 8) {
        const float* sp = src + (size_t)row * DM + lane * 16;
        const f32x4 a = *(const f32x4*)sp, b = *(const f32x4*)(sp + 4), c = *(const f32x4*)(sp + 8), d = *(const f32x4*)(sp + 12);
        float m = fmaxf(fmaxf(fmaxf(fabsf(a.x), fabsf(a.y)), fmaxf(fabsf(a.z), fabsf(a.w))), fmaxf(fmaxf(fabsf(b.x), fabsf(b.y)), fmaxf(fabsf(b.z), fabsf(b.w))));
        m = fmaxf(m, fmaxf(fmaxf(fmaxf(fabsf(c.x), fabsf(c.y)), fmaxf(fabsf(c.z), fabsf(c.w))), fmaxf(fmaxf(fabsf(d.x), fabsf(d.y)), fmaxf(fabsf(d.z), fabsf(d.w)))));
#pragma unroll
        for (int s = 1; s < 64; s <<= 1) m = fmaxf(m, __shfl_xor(m, s));
        const float sc = m > 1e-30f ? 127.0f / m : 1.0f, isc = m > 1e-30f ? m * (1.0f / 127.0f) : 1.0f;
        const float v[16] = {a.x, a.y, a.z, a.w, b.x, b.y, b.z, b.w, c.x, c.y, c.z, c.w, d.x, d.y, d.z, d.w};
        unsigned w[4];
#pragma unroll
        for (int q = 0; q < 4; ++q) {
            unsigned pk = 0u;
#pragma unroll
            for (int e = 0; e < 4; ++e) { const int qi = (int)rintf(v[q * 4 + e] * sc) + OFFS; pk |= ((unsigned)qi & 0xffu) << (8 * e); }
            w[q] = pk;
        }
        *(u32x4*)(dst + (size_t)row * DM + lane * 16) = (u32x4){w[0], w[1], w[2], w[3]};
        if (lane == 0) inv[row] = isc;
    }
}
DI void phase_prep(const Params& p, int bid, int nb, char* smem) {
    constexpr int N_MOD = 192, N_LB = 1, N_S5 = 32, T_WIN = 16 * 40, T_GLU = 8 * 8, T_WOUT = 16 * 16, T_WQ = 16 * 32;
    constexpr int I_LB = N_MOD, I_S5 = I_LB + N_LB, I_WIN = I_S5 + N_S5, I_GLU = I_WIN + T_WIN, I_WOUT = I_GLU + T_GLU, I_WQ = I_WOUT + T_WOUT, I_END = I_WQ + T_WQ;
    for (int it = bid; it < I_END; it += nb) {
        if (it < N_MOD) prep_mod_item(p, it, smem);
        else if (it < I_S5) {
            const int j = my_tid();
            const float a0 = p.hg_lb[j], a1 = p.hg_lb[512 + j], m = fmaxf(a0, a1);
            const float e0 = expf(a0 - m), e1 = expf(a1 - m);
            ((float*)(p.ws + OFF_LB))[j] = e0 / (e0 + e1);
        } else if (it < I_WIN) { prep_s5_item(p, it - I_S5); prep_s5_gemm_item(p, it - I_S5, smem); }
        else if (it < I_GLU) { const int t = it - I_WIN; prep_transpose_tile(p.w_in, (bf16_t*)(p.ws + OFF_WIN), DM, INC, t / 40, t % 40, smem); }
        else if (it < I_WOUT) { const int t = it - I_GLU; prep_transpose_tile(p.glu_w, (bf16_t*)(p.ws + OFF_GLU), 512, 512, t / 8, t % 8, smem); }
        else if (it < I_WQ) { const int t = it - I_WOUT; prep_transpose_tile(p.w_out, (bf16_t*)(p.ws + OFF_WOUT), DM, DM, t / 16, t % 16, smem); }
        else { const int t = it - I_WQ; prep_transpose_tile(p.w_q, (bf16_t*)(p.ws + OFF_WQ), DM, 2048, t / 32, t % 32, smem); }
    }
    cvt_bf16_stream(p.subk, (bf16_t*)(p.ws + OFF_SUBK), (size_t)16 * 128 * 128 / 8, bid, nb);
    cvt_i8_rows<0>(p.pu, (unsigned char*)(p.ws + OFF_UT), (float*)(p.ws + OFF_SU), bid, nb);
    cvt_i8_rows<128>(p.pv, (unsigned char*)(p.ws + OFF_VT), (float*)(p.ws + OFF_SV), bid, nb);
}

DI void phase_h(const Params& p, int bid, int nb) {
    const float* mod = (const float*)(p.ws + OFF_MOD);
    bf16_t* H = (bf16_t*)(p.ws + OFF_H);
    const size_t n8 = (size_t)NTOK * DM / 8;
    for (size_t i = (size_t)bid * NTH + my_tid(); i < n8; i += (size_t)nb * NTH) {
        const int row = (int)(i >> 7), c0 = (int)(i & 127) * 8, b = row / SEQ;
        const float* sh = mod + b * 6144 + c0;
        const float* sc = sh + 1024;
        const float4 a = *(const float4*)(p.x + i * 8), bq = *(const float4*)(p.x + i * 8 + 4);
        const float4 s0 = *(const float4*)sc, s1 = *(const float4*)(sc + 4), h0 = *(const float4*)sh, h1 = *(const float4*)(sh + 4);
        uint4 o;
        o.x = pack2(a.x * (1.f + s0.x) + h0.x, a.y * (1.f + s0.y) + h0.y);
        o.y = pack2(a.z * (1.f + s0.z) + h0.z, a.w * (1.f + s0.w) + h0.w);
        o.z = pack2(bq.x * (1.f + s1.x) + h1.x, bq.y * (1.f + s1.y) + h1.y);
        o.w = pack2(bq.z * (1.f + s1.z) + h1.z, bq.w * (1.f + s1.w) + h1.w);
        *(uint4*)(H + i * 8) = o;
    }
}

DI void phase_proj(const Params& p, int bid, int nb, char* smem) {
    pg8::Gemm g{(const bf16_t*)(p.ws + OFF_H), (const bf16_t*)(p.ws + OFF_WIN), NTOK, INC, DM};
    pg8::StaticOrder S; S.init(NTOK, INC, nb, bid);
    pg8::EpiBf16Act E{(bf16_t*)(p.ws + OFF_PROJ), INC, 0xC3u};
    pg8::gemm_phase<pg8::EpiBf16Act, pg8::StaticOrder, false>((PG8_LAS unsigned char*)smem, g, S, E, nullptr);
}

DI void hgrn_item(const Params& p, int item, char* smem) {
    const int vs = item & 7, hd = (item >> 3) & 3, b = item >> 5;
    const bf16_t* P = (const bf16_t*)(p.ws + OFF_PROJ);
    const float* lb = (const float*)(p.ws + OFF_LB) + hd * HDK;
    float* ORAW = (float*)(p.ws + OFF_ORAW);
    float* sq = (float*)smem;
    float* sf = sq + 32 * 128;
    float* sv = sf + 32 * 128;
    float* sp = sv + 32 * 16;
    const int tid = my_tid(), lane = tid & 63, wid = tid >> 6, kq = tid >> 4, v = tid & 15;
    float S0 = 0.f, S1 = 0.f, S2 = 0.f, S3 = 0.f;
    for (int t0 = 0; t0 < SEQ; t0 += 32) {
        for (int i = tid; i < 32 * 128; i += NTH) {
            const int t = i >> 7, k = i & 127;
            const bf16_t* row = P + (size_t)(b * SEQ + t0 + t) * INC + hd * HDK + k;
            sq[i] = bf2f(row[0]);
            const float l = lb[k];
            sf[i] = l + (1.0f - l) * sigmoidf_(bf2f(row[512]));
        }
        { const int t = tid >> 4; sv[tid] = bf2f(P[(size_t)(b * SEQ + t0 + t) * INC + 1024 + hd * HDK + vs * 16 + v]); }
        __syncthreads();
        for (int t = 0; t < 32; ++t) {
            const float4 f4 = *(const float4*)(sf + t * 128 + kq * 4), q4 = *(const float4*)(sq + t * 128 + kq * 4);
            const float vv = sv[t * 16 + v];
            S0 = f4.x * S0 + (1.0f - f4.x) * vv; S1 = f4.y * S1 + (1.0f - f4.y) * vv;
            S2 = f4.z * S2 + (1.0f - f4.z) * vv; S3 = f4.w * S3 + (1.0f - f4.w) * vv;
            float part = q4.x * S0 + q4.y * S1 + q4.z * S2 + q4.w * S3;
            part += __shfl_xor(part, 16); part += __shfl_xor(part, 32);
            if (lane < 16) sp[(t * 8 + wid) * 16 + v] = part;
        }
        __syncthreads();
        {
            const int t = tid >> 4;
            float o = 0.f;
#pragma unroll
            for (int w = 0; w < 8; ++w) o += sp[(t * 8 + w) * 16 + v];
            ORAW[(size_t)(b * SEQ + t0 + t) * DHG + hd * HDK + vs * 16 + v] = o;
        }
        __syncthreads();
    }
}
DI void s5_item(const Params& p, int item, char* smem) {
    const int oct = item & 3, b = item >> 2;
    const int tid = my_tid(), lane = tid & 63, wid = tid >> 6, g = oct * 8 + wid;
    const bf16_t* P = (const bf16_t*)(p.ws + OFF_PROJ);
    bf16_t* Y = (bf16_t*)(p.ws + OFF_YSSM);
    float* su = (float*)smem + wid * 64 * 16;
    const float* lam = (const float*)(p.ws + OFF_LAM) + (g * SSP + lane) * 2;
    const float lr = lam[0], li = lam[1];
    const float* bb = (const float*)(p.ws + OFF_BB) + (size_t)(g * SSP + lane) * 32;
    float bbr[16], bbi[16], cr[16], ci[16];
#pragma unroll
    for (int i = 0; i < 16; ++i) { bbr[i] = bb[2 * i]; bbi[i] = bb[2 * i + 1]; cr[i] = p.c_re[(g * SSC + i) * SSP + lane]; ci[i] = p.c_im[(g * SSC + i) * SSP + lane]; }
    const int ch = (lane >> 2) & 15;
    const float dch = p.dsk[g * SSC + ch];
    float xr = 0.f, xi = 0.f;
    for (int t0 = 0; t0 < SEQ; t0 += 64) {
        {
            const uint4* src = (const uint4*)(P + (size_t)(b * SEQ + t0 + lane) * INC + 2048 + g * SSC);
            const uint4 a = src[0], c = src[1];
            float* d = su + lane * 16;
            d[0] = bflo(a.x); d[1] = bfhi(a.x); d[2] = bflo(a.y); d[3] = bfhi(a.y); d[4] = bflo(a.z); d[5] = bfhi(a.z); d[6] = bflo(a.w); d[7] = bfhi(a.w);
            d[8] = bflo(c.x); d[9] = bfhi(c.x); d[10] = bflo(c.y); d[11] = bfhi(c.y); d[12] = bflo(c.z); d[13] = bfhi(c.z); d[14] = bflo(c.w); d[15] = bfhi(c.w);
        }
        __syncthreads();
        for (int t = 0; t < 64; ++t) {
            float u[16];
            const float4* us = (const float4*)(su + t * 16);
            const float4 u0 = us[0], u1 = us[1], u2 = us[2], u3 = us[3];
            u[0] = u0.x; u[1] = u0.y; u[2] = u0.z; u[3] = u0.w; u[4] = u1.x; u[5] = u1.y; u[6] = u1.z; u[7] = u1.w;
            u[8] = u2.x; u[9] = u2.y; u[10] = u2.z; u[11] = u2.w; u[12] = u3.x; u[13] = u3.y; u[14] = u3.z; u[15] = u3.w;
            float bur = 0.f, bui = 0.f;
#pragma unroll
            for (int i = 0; i < 16; ++i) { bur += bbr[i] * u[i]; bui += bbi[i] * u[i]; }
            const float nxr = lr * xr - li * xi + bur, nxi = lr * xi + li * xr + bui;
            xr = nxr; xi = nxi;
            float y[16];
#pragma unroll
            for (int i = 0; i < 16; ++i) y[i] = cr[i] * xr - ci[i] * xi;
            const bool b5 = lane & 32, b4 = lane & 16, b3 = lane & 8, b2 = lane & 4;
            float y8[8], y4[4], y2[2];
#pragma unroll
            for (int j = 0; j < 8; ++j) { const float keep = b5 ? y[8 + j] : y[j], send = b5 ? y[j] : y[8 + j]; y8[j] = keep + __shfl_xor(send, 32); }
#pragma unroll
            for (int j = 0; j < 4; ++j) { const float keep = b4 ? y8[4 + j] : y8[j], send = b4 ? y8[j] : y8[4 + j]; y4[j] = keep + __shfl_xor(send, 16); }
#pragma unroll
            for (int j = 0; j < 2; ++j) { const float keep = b3 ? y4[2 + j] : y4[j], send = b3 ? y4[j] : y4[2 + j]; y2[j] = keep + __shfl_xor(send, 8); }
            float y1;
            { const float keep = b2 ? y2[1] : y2[0], send = b2 ? y2[0] : y2[1]; y1 = keep + __shfl_xor(send, 4); }
            y1 += __shfl_xor(y1, 1); y1 += __shfl_xor(y1, 2);
            if ((lane & 3) == 0) {
                const float uu = su[t * 16 + ch];
                Y[(size_t)(b * SEQ + t0 + t) * DSS + g * SSC + ch] = f2bf(geluf_(y1 + dch * uu));
            }
        }
        __syncthreads();
    }
}
DI int crow(int i, int h) { return (i & 3) + 8 * (i >> 2) + 4 * h; }
DI void phase_hgprep(const Params& p, int bid, int nb) {
    const bf16_t* P = (const bf16_t*)(p.ws + OFF_PROJ);
    const float* lbp = (const float*)(p.ws + OFF_LB);
    const int tid = my_tid(), lane = tid & 63, wid = tid >> 6, tq = lane >> 4, cg = lane & 15;
#pragma unroll 1
    for (int it = bid * 8 + wid; it < 8192; it += nb * 8) {
        const int tile = it >> 1, c = tile & 63, hd = (tile >> 6) & 3, b = tile >> 8, k0 = (it & 1) * 64 + cg * 4;
        const bf16_t* base = P + (size_t)(b * SEQ + c * 32 + tq * 8) * INC + hd * HDK + k0;
        uint2 qw[8], fw[8];
#pragma unroll
        for (int tt = 0; tt < 8; ++tt) { qw[tt] = *(const uint2*)(base + (size_t)tt * INC); fw[tt] = *(const uint2*)(base + (size_t)tt * INC + 512); }
        const f32x4 l4 = *(const f32x4*)(lbp + hd * HDK + k0);
        const float lb4[4] = {l4.x, l4.y, l4.z, l4.w};
        float bl[8][4], kk[8][4], run[4];
#pragma unroll
        for (int e = 0; e < 4; ++e) run[e] = 0.f;
#pragma unroll
        for (int tt = 0; tt < 8; ++tt) {
            const float fl[4] = {bflo(fw[tt].x), bfhi(fw[tt].x), bflo(fw[tt].y), bfhi(fw[tt].y)};
#pragma unroll
            for (int e = 0; e < 4; ++e) {
                const float f = lb4[e] + (1.0f - lb4[e]) * sigmoidf_(fl[e]);
                run[e] += __logf(f); bl[tt][e] = run[e]; kk[tt][e] = 1.0f - f;
            }
        }
        float off[4], tot[4];
#pragma unroll
        for (int e = 0; e < 4; ++e) {
            const float t0 = __shfl(run[e], cg), t1 = __shfl(run[e], cg + 16), t2 = __shfl(run[e], cg + 32), t3 = __shfl(run[e], cg + 48);
            off[e] = (tq > 0 ? t0 : 0.f) + (tq > 1 ? t1 : 0.f) + (tq > 2 ? t2 : 0.f);
            tot[e] = (t0 + t1) + (t2 + t3);
        }
        bf16_t* HQ = (bf16_t*)(p.ws + OFF_HQ) + (size_t)tile * 4096 + (tq * 8) * 128 + k0;
        bf16_t* HK = (bf16_t*)(p.ws + OFF_HK) + (size_t)tile * 4096 + (tq * 8) * 128 + k0;
#pragma unroll
        for (int tt = 0; tt < 8; ++tt) {
            const float qv[4] = {bflo(qw[tt].x), bfhi(qw[tt].x), bflo(qw[tt].y), bfhi(qw[tt].y)};
            float qo[4], ko[4];
#pragma unroll
            for (int e = 0; e < 4; ++e) { const float bb = off[e] + bl[tt][e]; qo[e] = qv[e] * __expf(bb); ko[e] = kk[tt][e] * __expf(fminf(-bb, 80.0f)); }
            *(uint2*)(HQ + tt * 128) = make_uint2(pack2(qo[0], qo[1]), pack2(qo[2], qo[3]));
            *(uint2*)(HK + tt * 128) = make_uint2(pack2(ko[0], ko[1]), pack2(ko[2], ko[3]));
        }
        if (tq == 0) *(f32x4*)((float*)(p.ws + OFF_HG) + (size_t)tile * 128 + k0) = (f32x4){__expf(tot[0]), __expf(tot[1]), __expf(tot[2]), __expf(tot[3])};
    }
}
typedef short s16x4 __attribute__((ext_vector_type(4)));
DI bf16x8 cat8(const s16x4 lo, const s16x4 hi) { return (bf16x8){lo.x, lo.y, lo.z, lo.w, hi.x, hi.y, hi.z, hi.w}; }
DI s16x4 lds_tr(const char* a) { return __builtin_amdgcn_ds_read_tr16_b64_v4i16((__attribute__((address_space(3))) s16x4*)a); }
DI void hgrn_mfma_item(const Params& p, int item, char* smem) {
    constexpr int QP_OFF = 0, KP_OFF = 8704, V_OFF = 17408, G_OFF = 26112, BUF = 26624;
    const int tid = my_tid(), lane = tid & 63, wid = tid >> 6, r = lane & 31, h = lane >> 5;
    const int b = item >> 2, hd = item & 3;
    const size_t tile0 = (size_t)item * 64;
    const bf16_t* HQ = (const bf16_t*)(p.ws + OFF_HQ) + tile0 * 4096;
    const bf16_t* HK = (const bf16_t*)(p.ws + OFF_HK) + tile0 * 4096;
    const bf16_t* PV = (const bf16_t*)(p.ws + OFF_PROJ) + (size_t)b * SEQ * INC + 1024 + hd * HDK;
    const float* HG = (const float*)(p.ws + OFF_HG) + tile0 * 128;
    float* ORAW = (float*)(p.ws + OFF_ORAW) + (size_t)b * SEQ * DHG + hd * HDK;
    const bool helper = wid >= 4;
    const int ht = tid - 256;
    const int i0 = ht, i1 = ht + 256;
    const int lo0 = (i0 >> 4) * 272 + (i0 & 15) * 16, lo1 = (i1 >> 4) * 272 + (i1 & 15) * 16;
    u32x4 A0, A1, A2, A3, A4, A5, A6, B0, B1, B2, B3, B4, B5, B6;
    A0 = A1 = A2 = A3 = A4 = A5 = A6 = B0 = B1 = B2 = B3 = B4 = B5 = B6 = (u32x4){0, 0, 0, 0};
    f32x16 S[4];
#pragma unroll
    for (int kb = 0; kb < 4; ++kb)
#pragma unroll
        for (int i = 0; i < 16; ++i) S[kb][i] = 0.f;
#define HG_LOAD(X, c_) { const size_t o_ = (size_t)(c_) * 4096; \
        X##0 = *(const u32x4*)(HQ + o_ + i0 * 8); X##1 = *(const u32x4*)(HQ + o_ + i1 * 8); \
        X##2 = *(const u32x4*)(HK + o_ + i0 * 8); X##3 = *(const u32x4*)(HK + o_ + i1 * 8); \
        X##4 = *(const u32x4*)(PV + (size_t)((c_) * 32 + (i0 >> 4)) * INC + (i0 & 15) * 8); X##5 = *(const u32x4*)(PV + (size_t)((c_) * 32 + (i1 >> 4)) * INC + (i1 & 15) * 8); \
        if (ht < 32) X##6 = *(const u32x4*)(HG + (size_t)(c_) * 128 + ht * 4); }
#define HG_STORE(X, buf_) { char* B_ = smem + (buf_) * BUF; \
        *(u32x4*)(B_ + QP_OFF + lo0) = X##0; *(u32x4*)(B_ + QP_OFF + lo1) = X##1; \
        *(u32x4*)(B_ + KP_OFF + lo0) = X##2; *(u32x4*)(B_ + KP_OFF + lo1) = X##3; \
        *(u32x4*)(B_ + V_OFF + lo0) = X##4; *(u32x4*)(B_ + V_OFF + lo1) = X##5; \
        if (ht < 32) *(u32x4*)(B_ + G_OFF + ht * 16) = X##6; }
    const int tq = (lane >> 2) & 3, tp = lane & 3, tg = lane >> 4;
    const int tr_nat = (8 * (tg >> 1) + tq) * 272 + (16 * (tg & 1) + 4 * tp) * 2;
    const int tr_krw = (4 * (tg >> 1) + tq) * 272 + (16 * (tg & 1) + 4 * tp) * 2;
    if (helper) { HG_LOAD(A, 0); HG_STORE(A, 0); HG_LOAD(A, 1); HG_STORE(A, 1); HG_LOAD(A, 2); HG_LOAD(B, 3); }
    __syncthreads();
#define HG_COMPUTE(c_) { \
        const char* B = smem + ((c_) % 3) * BUF; const int w = wid; \
        f32x16 pt; _Pragma("unroll") for (int i = 0; i < 16; ++i) pt[i] = 0.f; \
        _Pragma("unroll") for (int ks = 0; ks < 8; ++ks) { \
            const bf16x8 a = *(const bf16x8*)(B + KP_OFF + r * 272 + ks * 32 + h * 16); \
            const bf16x8 bq = *(const bf16x8*)(B + QP_OFF + r * 272 + ks * 32 + h * 16); \
            pt = __builtin_amdgcn_mfma_f32_32x32x16_bf16(a, bq, pt, 0, 0, 0); } \
        _Pragma("unroll") for (int i = 0; i < 16; ++i) if (crow(i, h) > r) pt[i] = 0.f; \
        f32x16 o; _Pragma("unroll") for (int i = 0; i < 16; ++i) o[i] = 0.f; \
        _Pragma("unroll") for (int sp = 0; sp < 2; ++sp) { \
            const char* vb = B + V_OFF + (16 * sp) * 272 + (32 * w) * 2 + tr_krw; \
            const bf16x8 bv = cat8(lds_tr(vb), lds_tr(vb + 8 * 272)); \
            o = __builtin_amdgcn_mfma_f32_32x32x16_bf16(pack8(pt, 8 * sp), bv, o, 0, 0, 0); } \
        _Pragma("unroll") for (int kb = 0; kb < 4; ++kb) _Pragma("unroll") for (int sp = 0; sp < 2; ++sp) { \
            const char* qb = B + QP_OFF + r * 272 + kb * 64 + sp * 32 + h * 8; \
            const bf16x8 aq = cat8(*(const s16x4*)qb, *(const s16x4*)(qb + 16)); \
            o = __builtin_amdgcn_mfma_f32_32x32x16_bf16(aq, pack8(S[kb], 8 * sp), o, 0, 0, 0); } \
        _Pragma("unroll") for (int i = 0; i < 16; ++i) ORAW[(size_t)((c_) * 32 + crow(i, h)) * DHG + 32 * w + r] = o[i]; \
        bf16x8 bvn[2]; \
        _Pragma("unroll") for (int ks = 0; ks < 2; ++ks) { const char* vb = B + V_OFF + (16 * ks) * 272 + (32 * w) * 2 + tr_nat; bvn[ks] = cat8(lds_tr(vb), lds_tr(vb + 4 * 272)); } \
        _Pragma("unroll") for (int kb = 0; kb < 4; ++kb) { \
            _Pragma("unroll") for (int ks = 0; ks < 2; ++ks) { \
                const char* kp = B + KP_OFF + (16 * ks) * 272 + (32 * kb) * 2 + tr_nat; \
                const bf16x8 a = cat8(lds_tr(kp), lds_tr(kp + 4 * 272)); \
                S[kb] = __builtin_amdgcn_mfma_f32_32x32x16_bf16(a, bvn[ks], S[kb], 0, 0, 0); } \
            _Pragma("unroll") for (int j = 0; j < 4; ++j) { \
                const f32x4 g4 = *(const f32x4*)(B + G_OFF + (kb * 32 + 8 * j + 4 * h) * 4); \
                S[kb][4 * j] *= g4.x; S[kb][4 * j + 1] *= g4.y; S[kb][4 * j + 2] *= g4.z; S[kb][4 * j + 3] *= g4.w; } } }
    for (int c = 0; c < 64; c += 2) {
        if (helper) { if (c + 2 < 64) HG_STORE(A, (c + 2) % 3); if (c + 4 < 64) HG_LOAD(A, c + 4); } else HG_COMPUTE(c);
        __syncthreads();
        if (helper) { if (c + 3 < 64) HG_STORE(B, (c + 3) % 3); if (c + 5 < 64) HG_LOAD(B, c + 5); } else HG_COMPUTE(c + 1);
        __syncthreads();
    }
#undef HG_LOAD
#undef HG_STORE
#undef HG_COMPUTE
}
template <int NJ>
DI void s5_gemm2_tile(const bf16x8 (&af)[16], const bf16_t* KTl, const bf16_t* Xin, const bf16_t* MBg, bf16_t* Yout, bf16_t* stg, const int mi, const int r, const int h) {
    f32x16 y;
#pragma unroll
    for (int i = 0; i < 16; ++i) y[i] = 0.f;
    const int tsel = r >> 4, iq = r & 15;
    bf16x8 bm[8];
#pragma unroll
    for (int ks = 0; ks < 8; ++ks) bm[ks] = *(const bf16x8*)(MBg + (size_t)((NJ * 8 + ks) * 64 + h * 32 + r) * 8);
#pragma unroll
    for (int ks = 0; ks <= 2 * NJ; ++ks) {
        const bf16x8 bk = *(const bf16x8*)(KTl + ((2 * NJ + tsel - ks) * 16 + iq) * 16 + 8 * h);
        y = __builtin_amdgcn_mfma_f32_32x32x16_bf16(af[ks], bk, y, 0, 0, 0);
    }
    {
        bf16x8 bk = *(const bf16x8*)(KTl + iq * 16 + 8 * h);
        if (tsel == 0) bk = (bf16x8){0, 0, 0, 0, 0, 0, 0, 0};
        y = __builtin_amdgcn_mfma_f32_32x32x16_bf16(af[2 * NJ + 1], bk, y, 0, 0, 0);
    }
#pragma unroll
    for (int ks = 0; ks < 8; ++ks) {
        const bf16x8 a = *(const bf16x8*)(Xin + (mi * 32 + r) * 136 + ks * 16 + 8 * h);
        y = __builtin_amdgcn_mfma_f32_32x32x16_bf16(a, bm[ks], y, 0, 0, 0);
    }
#pragma unroll
    for (int i = 0; i < 16; ++i) stg[((crow(i, h) * 2 + tsel) * 16) + iq] = f2bf(gelu_as(y[i]));
    {
        const int lane = h * 32 + r, cl = lane >> 1, ts = lane & 1;
        const u32x4 lo = *(const u32x4*)(stg + lane * 16), hi = *(const u32x4*)(stg + lane * 16 + 8);
        bf16_t* dst = Yout + (size_t)((mi * 32 + cl) * 16 + 2 * NJ + ts) * DSS;
        *(u32x4*)dst = lo; *(u32x4*)(dst + 8) = hi;
    }
}
DI void s5_gemm_item(const Params& p, int b, int g, char* smem) {
    float* E = (float*)smem;
    bf16_t* Xin = (bf16_t*)(smem + 128 * 132 * 4);
    bf16_t* KTl = Xin + 128 * 136;
    const int tid = my_tid(), lane = tid & 63, wid = tid >> 6, r = lane & 31, h = lane >> 5;
    const int mi = wid >> 1, wh = wid & 1;
    const bf16_t* P = (const bf16_t*)(p.ws + OFF_PROJ);
    *(u32x4*)(KTl + tid * 8) = *(const u32x4*)((const bf16_t*)(p.ws + OFF_S5K) + (size_t)g * 4096 + tid * 8);
    bf16x8 af[16];
    {
        const bf16_t* ub = P + (size_t)(b * SEQ + (mi * 32 + r) * 16) * INC + 2048 + g * 16 + 8 * h;
#pragma unroll
        for (int ks = 0; ks < 16; ++ks) af[ks] = *(const bf16x8*)(ub + (size_t)ks * INC);
    }
#ifndef S5_REP_G1
#define S5_REP_G1 1
#define S5_REP_SC 1
#define S5_REP_G2 1
#endif
    for (int rp1 = 0; rp1 < S5_REP_G1; ++rp1)
    {
        f32x16 e0, e1;
#pragma unroll
        for (int i = 0; i < 16; ++i) { e0[i] = 0.f; e1[i] = 0.f; }
        const bf16_t* nb0 = (const bf16_t*)(p.ws + OFF_S5N) + (size_t)g * 128 * 256 + (size_t)(wh * 2) * 16 * 512 + lane * 8;
#pragma unroll
        for (int ks = 0; ks < 16; ++ks) {
            const bf16x8 b0 = *(const bf16x8*)(nb0 + ks * 512), b1 = *(const bf16x8*)(nb0 + 16 * 512 + ks * 512);
            e0 = __builtin_amdgcn_mfma_f32_32x32x16_bf16(af[ks], b0, e0, 0, 0, 0);
            e1 = __builtin_amdgcn_mfma_f32_32x32x16_bf16(af[ks], b1, e1, 0, 0, 0);
        }
#pragma unroll
        for (int i = 0; i < 16; ++i) { float* er = E + (mi * 32 + crow(i, h)) * 132 + wh * 64 + r; er[0] = e0[i]; er[32] = e1[i]; }
    }
    __syncthreads();
    for (int rp2 = 0; rp2 < S5_REP_SC; ++rp2)
    if (wid == 0) {
        const float* L = (const float*)(p.ws + OFF_S5L) + (g * 64 + lane) * 2;
        const float lr = L[0], li = L[1];
        float xr = 0.f, xi = 0.f;
#pragma unroll 8
        for (int c = 0; c < 128; ++c) {
            const float er = E[c * 132 + lane], ei = E[c * 132 + 64 + lane];
            Xin[c * 136 + lane] = f2bf(xr); Xin[c * 136 + 64 + lane] = f2bf(xi);
            const float nr = lr * xr - li * xi + er, ni = lr * xi + li * xr + ei;
            xr = nr; xi = ni;
        }
    }
    __syncthreads();
    const bf16_t* MBg = (const bf16_t*)(p.ws + OFF_S5M) + (size_t)g * 256 * 128;
    bf16_t* Yout = (bf16_t*)(p.ws + OFF_YSSM) + (size_t)b * SEQ * DSS + g * 16;
    bf16_t* stg = (bf16_t*)smem + wid * 1024;
    for (int rp3 = 0; rp3 < S5_REP_G2; ++rp3)
    if (wh) {
        s5_gemm2_tile<1>(af, KTl, Xin, MBg, Yout, stg, mi, r, h); s5_gemm2_tile<6>(af, KTl, Xin, MBg, Yout, stg, mi, r, h);
        s5_gemm2_tile<3>(af, KTl, Xin, MBg, Yout, stg, mi, r, h); s5_gemm2_tile<4>(af, KTl, Xin, MBg, Yout, stg, mi, r, h);
    } else {
        s5_gemm2_tile<0>(af, KTl, Xin, MBg, Yout, stg, mi, r, h); s5_gemm2_tile<7>(af, KTl, Xin, MBg, Yout, stg, mi, r, h);
        s5_gemm2_tile<2>(af, KTl, Xin, MBg, Yout, stg, mi, r, h); s5_gemm2_tile<5>(af, KTl, Xin, MBg, Yout, stg, mi, r, h);
    }
    __syncthreads();
}
DI void phase_mix(const Params& p, int bid, int nb, char* smem) {
    if (nb == 256) {
#ifndef PROBE_HGX
#define PROBE_HGX 1
#endif
        if (bid < 64) { for (int rep = 0; rep < PROBE_HGX; ++rep) hgrn_mfma_item(p, bid, smem); return; }
        const int j = bid - 64, x = j & 7, lb = j >> 3;
#ifndef PROBE_S5X
#define PROBE_S5X 1
#endif
        for (int rep = 0; rep < PROBE_S5X; ++rep)
        for (int q = lb; q < 64; q += 24) s5_gemm_item(p, q & 15, x * 4 + (q >> 4), smem);
    } else {
        for (int it = bid; it < 64; it += nb) hgrn_mfma_item(p, it, smem);
        for (int q = bid; q < 512; q += nb) s5_gemm_item(p, q & 15, q >> 4, smem);
    }
}

DI void phase_glu(const Params& p, int bid, int nb, char* smem) {
    pg8::Gemm g{(const bf16_t*)(p.ws + OFF_YSSM), (const bf16_t*)(p.ws + OFF_GLU), NTOK, 512, 512};
    pg8::StaticOrder S; S.init(NTOK, 512, nb, bid);
    pg8::EpiGlu E{(float*)(p.ws + OFF_H), (const bf16_t*)(p.ws + OFF_YSSM), p.glu_b};
    pg8::gemm_phase<pg8::EpiGlu, pg8::StaticOrder, false>((PG8_LAS unsigned char*)smem, g, S, E, nullptr);
}
DI void phase_a2(const Params& p, int bid, int nb) {
    const float* ORAW = (const float*)(p.ws + OFF_ORAW);
    const float* Y2 = (const float*)(p.ws + OFF_H);
    const bf16_t* P = (const bf16_t*)(p.ws + OFF_PROJ);
    bf16_t* A2 = (bf16_t*)(p.ws + OFF_A2);
    const int lane = my_tid() & 63, wid = my_tid() >> 6;
    for (int tok = bid * 8 + wid; tok < NTOK; tok += nb * 8) {
        const int c0 = lane * 8;
        {
            const float4 a = *(const float4*)(ORAW + (size_t)tok * DHG + c0), b = *(const float4*)(ORAW + (size_t)tok * DHG + c0 + 4);
            float ss = a.x * a.x + a.y * a.y + a.z * a.z + a.w * a.w + b.x * b.x + b.y * b.y + b.z * b.z + b.w * b.w;
            ss += __shfl_xor(ss, 1); ss += __shfl_xor(ss, 2); ss += __shfl_xor(ss, 4); ss += __shfl_xor(ss, 8);
            const float rs = rsqrtf(ss * (1.0f / 128.0f) + RMS_EPS);
            const uint4 gq = *(const uint4*)(P + (size_t)tok * INC + 1536 + c0);
            const float4 w0 = *(const float4*)(p.hg_nw + c0), w1 = *(const float4*)(p.hg_nw + c0 + 4);
            uint4 o;
            o.x = pack2(a.x * rs * w0.x * bflo(gq.x), a.y * rs * w0.y * bfhi(gq.x));
            o.y = pack2(a.z * rs * w0.z * bflo(gq.y), a.w * rs * w0.w * bfhi(gq.y));
            o.z = pack2(b.x * rs * w1.x * bflo(gq.z), b.y * rs * w1.y * bfhi(gq.z));
            o.w = pack2(b.z * rs * w1.z * bflo(gq.w), b.w * rs * w1.w * bfhi(gq.w));
            *(uint4*)(A2 + (size_t)tok * DM + c0) = o;
        }
        {
            const float4 a = *(const float4*)(Y2 + (size_t)tok * DSS + c0), b = *(const float4*)(Y2 + (size_t)tok * DSS + c0 + 4);
            float ss = a.x * a.x + a.y * a.y + a.z * a.z + a.w * a.w + b.x * b.x + b.y * b.y + b.z * b.z + b.w * b.w;
#pragma unroll
            for (int m = 1; m < 64; m <<= 1) ss += __shfl_xor(ss, m);
            const float rs = rsqrtf(ss * (1.0f / 512.0f) + RMS_EPS);
            const float4 w0 = *(const float4*)(p.ssm_nw + c0), w1 = *(const float4*)(p.ssm_nw + c0 + 4);
            uint4 o;
            o.x = pack2(a.x * rs * w0.x, a.y * rs * w0.y); o.y = pack2(a.z * rs * w0.z, a.w * rs * w0.w);
            o.z = pack2(b.x * rs * w1.x, b.y * rs * w1.y); o.w = pack2(b.z * rs * w1.z, b.w * rs * w1.w);
            *(uint4*)(A2 + (size_t)tok * DM + 512 + c0) = o;
        }
    }
}

DI void phase_outproj(const Params& p, int bid, int nb, char* smem) {
    pg8::Gemm g{(const bf16_t*)(p.ws + OFF_A2), (const bf16_t*)(p.ws + OFF_WOUT), NTOK, DM, DM};
    pg8::StaticOrder S; S.init(NTOK, DM, nb, bid);
    pg8::EpiResid E{p.out, p.x, (const float*)(p.ws + OFF_MOD) + 2048, DEEP_ALPHA};
    pg8::gemm_phase<pg8::EpiResid, pg8::StaticOrder, false>((PG8_LAS unsigned char*)smem, g, S, E, nullptr);
}
DI void phase_ln1(const Params& p, int bid, int nb) {
    const float* mod = (const float*)(p.ws + OFF_MOD);
    bf16_t* H2 = (bf16_t*)(p.ws + OFF_H);
    const int lane = my_tid() & 63, wid = my_tid() >> 6;
    for (int tok = bid * 8 + wid; tok < NTOK; tok += nb * 8) {
        const int b = tok / SEQ;
        float* row = p.out + (size_t)tok * DM;
        float4 v[4];
        float s = 0.f;
#pragma unroll
        for (int j = 0; j < 4; ++j) { v[j] = *(const float4*)(row + j * 256 + lane * 4); s += v[j].x + v[j].y + v[j].z + v[j].w; }
#pragma unroll
        for (int m = 1; m < 64; m <<= 1) s += __shfl_xor(s, m);
        const float mu = s * (1.0f / 1024.0f);
        float q = 0.f;
#pragma unroll
        for (int j = 0; j < 4; ++j) { const float a = v[j].x - mu, bb = v[j].y - mu, cc = v[j].z - mu, d = v[j].w - mu; q += a * a + bb * bb + cc * cc + d * d; }
#pragma unroll
        for (int m = 1; m < 64; m <<= 1) q += __shfl_xor(q, m);
        const float rstd = rsqrtf(q * (1.0f / 1024.0f) + LN_EPS);
        const float* sh2 = mod + b * 6144 + 3072;
        const float* sc2 = mod + b * 6144 + 4096;
#pragma unroll
        for (int j = 0; j < 4; ++j) {
            const int c = j * 256 + lane * 4;
            const float4 w = *(const float4*)(p.ln1w + c), bi = *(const float4*)(p.ln1b + c), sc = *(const float4*)(sc2 + c), sh = *(const float4*)(sh2 + c);
            float4 o;
            o.x = (v[j].x - mu) * rstd * w.x + bi.x; o.y = (v[j].y - mu) * rstd * w.y + bi.y; o.z = (v[j].z - mu) * rstd * w.z + bi.z; o.w = (v[j].w - mu) * rstd * w.w + bi.w;
            *(float4*)(row + c) = o;
            uint2 hh; hh.x = pack2(o.x * (1.f + sc.x) + sh.x, o.y * (1.f + sc.y) + sh.y); hh.y = pack2(o.z * (1.f + sc.z) + sh.z, o.w * (1.f + sc.w) + sh.w);
            *(uint2*)(H2 + (size_t)tok * DM + c) = hh;
        }
    }
}

DI void phase_q(const Params& p, int bid, int nb, char* smem) {
    pg8::Gemm g{(const bf16_t*)(p.ws + OFF_H), (const bf16_t*)(p.ws + OFF_WQ), NTOK, 2048, DM};
    pg8::StaticOrder S; S.init(NTOK, 2048, nb, bid);
    pg8::EpiBf16Act E{(bf16_t*)(p.ws + OFF_PROJ), 2048, 0u};
    pg8::gemm_phase<pg8::EpiBf16Act, pg8::StaticOrder, false>((PG8_LAS unsigned char*)smem, g, S, E, nullptr);
}
DI void phase_topk(const Params& p, int bid, int nb, char* smem) {
    const bf16_t* Q = (const bf16_t*)(p.ws + OFF_PROJ);
    const bf16_t* SK = (const bf16_t*)(p.ws + OFF_SUBK);
    unsigned* TOPL = (unsigned*)(p.ws + OFF_TOPL);
    float* sc = (float*)(smem + 36864);
    constexpr int NTM = NTOK / 128;
    for (int t = bid; t < NTM * 16; t += nb) {
        const int mt = t >> 4, hp = t & 15;
        gemm_block<2, 1, 2, 4>(Q + (size_t)mt * 128 * 2048 + hp * 128, 2048, SK + (size_t)hp * 128 * 128, 128, 128, smem,
                               [&](int r, int c, float v) { sc[r * 129 + c] = v; });
        __syncthreads();
        if (my_tid() < 128) {
            const int r = my_tid();
            float tk[16];
#pragma unroll
            for (int j = 0; j < 16; ++j) tk[j] = -3.0e38f;
            for (int n = 0; n < 128; ++n) {
                float xv = __uint_as_float((__float_as_uint(sc[r * 129 + n]) & ~0x7fu) | (unsigned)n);
#pragma unroll
                for (int j = 0; j < 16; ++j) { const float hi = fmaxf(tk[j], xv), lo = fminf(tk[j], xv); tk[j] = hi; xv = lo; }
            }
            uint4* dst = (uint4*)(TOPL + ((size_t)(mt * 128 + r) * 16 + hp) * 16);
            dst[0] = make_uint4(__float_as_uint(tk[0]), __float_as_uint(tk[1]), __float_as_uint(tk[2]), __float_as_uint(tk[3]));
            dst[1] = make_uint4(__float_as_uint(tk[4]), __float_as_uint(tk[5]), __float_as_uint(tk[6]), __float_as_uint(tk[7]));
            dst[2] = make_uint4(__float_as_uint(tk[8]), __float_as_uint(tk[9]), __float_as_uint(tk[10]), __float_as_uint(tk[11]));
            dst[3] = make_uint4(__float_as_uint(tk[12]), __float_as_uint(tk[13]), __float_as_uint(tk[14]), __float_as_uint(tk[15]));
        }
        __syncthreads();
    }
}
DI void phase_combine(const Params& p, int bid, int nb) {
    const unsigned* TOPL = (const unsigned*)(p.ws + OFF_TOPL);
    uint2* EX = (uint2*)(p.ws + OFF_EXPS);
    const float* SU = (const float*)(p.ws + OFF_SU);
    const float* SV = (const float*)(p.ws + OFF_SV);
    for (int i = bid * NTH + my_tid(); i < NTOK * PHEADS; i += nb * NTH) {
        const unsigned* l1 = TOPL + (size_t)i * 32;
        const unsigned* l2 = l1 + 16;
        float s2[16];
        {
            const uint4 a = ((const uint4*)l2)[0], b = ((const uint4*)l2)[1], c = ((const uint4*)l2)[2], d = ((const uint4*)l2)[3];
            const unsigned w[16] = {a.x, a.y, a.z, a.w, b.x, b.y, b.z, b.w, c.x, c.y, c.z, c.w, d.x, d.y, d.z, d.w};
#pragma unroll
            for (int j = 0; j < 16; ++j) s2[j] = __uint_as_float(w[j] & ~0x7fu);
        }
        float tk[16];
#pragma unroll
        for (int j = 0; j < 16; ++j) tk[j] = -3.0e38f;
        for (int a = 0; a < 16; ++a) {
            const float s1 = __uint_as_float(l1[a] & ~0x7fu);
#pragma unroll
            for (int b = 0; b < 16; ++b) {
                float xv = __uint_as_float((__float_as_uint(s1 + s2[b]) & ~0xffu) | (unsigned)(a * 16 + b));
#pragma unroll
                for (int j = 0; j < 16; ++j) { const float hi = fmaxf(tk[j], xv), lo = fminf(tk[j], xv); tk[j] = hi; xv = lo; }
            }
        }
        float e[16], sum = 0.f;
        const float mx = __uint_as_float(__float_as_uint(tk[0]) & ~0xffu);
#pragma unroll
        for (int j = 0; j < 16; ++j) { e[j] = __expf(__uint_as_float(__float_as_uint(tk[j]) & ~0xffu) - mx); sum += e[j]; }
        const float inv = 1.0f / sum;
#pragma unroll
        for (int j = 0; j < 16; ++j) {
            const unsigned ab = __float_as_uint(tk[j]) & 0xffu;
            const unsigned i1 = l1[ab >> 4] & 0x7fu, i2 = l2[ab & 15] & 0x7fu;
            const unsigned eid = i1 * 128u + i2;
            EX[(size_t)i * 16 + j] = make_uint2(eid | (((__float_as_uint(SU[eid]) >> 23) & 0xffu) << 16), __float_as_uint(e[j] * inv * SV[eid]));
        }
    }
}

DI void ce_desc(float& a, float& b) { const float hi = fmaxf(a, b), lo = fminf(a, b); a = hi; b = lo; }
template <int N> DI void bitonic_sort_desc(float (&v)[N]) {
#pragma unroll
    for (int k = 2; k <= N; k <<= 1)
#pragma unroll
        for (int j = k >> 1; j > 0; j >>= 1)
#pragma unroll
            for (int i = 0; i < N; ++i) { const int l = i ^ j; if (l > i) { if ((i & k) == 0 || k == N) ce_desc(v[i], v[l]); else ce_desc(v[l], v[i]); } }
}
DI void merge_top16(float (&a)[16], const float (&b)[16]) {
#pragma unroll
    for (int i = 0; i < 16; ++i) a[i] = fmaxf(a[i], b[15 - i]);
#pragma unroll
    for (int j = 8; j > 0; j >>= 1)
#pragma unroll
        for (int i = 0; i < 16; ++i) { const int l = i ^ j; if (l > i) ce_desc(a[i], a[l]); }
}
DI void xlane_merge16(float (&a)[16]) {
    float o[16];
#pragma unroll
    for (int i = 0; i < 16; ++i) o[i] = __shfl_xor(a[i], 32);
    merge_top16(a, o);
}
DI void retrieve_topk_hp(const bf16_t* Q, const char* skl, const int tok, const int hp, const int r, const int h, unsigned char* lutp, float (&out)[16]) {
                f32x16 acc[4];
#pragma unroll
                for (int mi = 0; mi < 4; ++mi)
#pragma unroll
                    for (int i = 0; i < 16; ++i) acc[mi][i] = 0.f;
                const bf16_t* qb = Q + (size_t)tok * 2048 + hp * 128 + 8 * h;
                const char* kb = skl + r * 272 + h * 16;
#pragma unroll
                for (int ks = 0; ks < 8; ++ks) {
                    const bf16x8 bq = *(const bf16x8*)(qb + ks * 16);
#pragma unroll
                    for (int mi = 0; mi < 4; ++mi) {
                        const bf16x8 a = *(const bf16x8*)(kb + mi * 32 * 272 + ks * 32);
                        acc[mi] = __builtin_amdgcn_mfma_f32_32x32x16_bf16(a, bq, acc[mi], 0, 0, 0);
                    }
                }
                float v0[16], v1[16], v2[16], v3[16];
#pragma unroll
                for (int i = 0; i < 16; ++i) {
                    const unsigned n = (unsigned)crow(i, h);
                    v0[i] = __uint_as_float((__float_as_uint(acc[0][i]) & ~0x7fu) | n);
                    v1[i] = __uint_as_float((__float_as_uint(acc[1][i]) & ~0x7fu) | (n + 32u));
                    v2[i] = __uint_as_float((__float_as_uint(acc[2][i]) & ~0x7fu) | (n + 64u));
                    v3[i] = __uint_as_float((__float_as_uint(acc[3][i]) & ~0x7fu) | (n + 96u));
                }
                bitonic_sort_desc<16>(v0); bitonic_sort_desc<16>(v1); bitonic_sort_desc<16>(v2); bitonic_sort_desc<16>(v3);
                merge_top16(v0, v1); merge_top16(v2, v3); merge_top16(v0, v2);
                xlane_merge16(v0);
#pragma unroll
                for (int i = 0; i < 16; ++i) out[i] = v0[i];
                u32x4 ix;
                ix.x = (__float_as_uint(v0[0]) & 0x7fu) | ((__float_as_uint(v0[1]) & 0x7fu) << 8) | ((__float_as_uint(v0[2]) & 0x7fu) << 16) | ((__float_as_uint(v0[3]) & 0x7fu) << 24);
                ix.y = (__float_as_uint(v0[4]) & 0x7fu) | ((__float_as_uint(v0[5]) & 0x7fu) << 8) | ((__float_as_uint(v0[6]) & 0x7fu) << 16) | ((__float_as_uint(v0[7]) & 0x7fu) << 24);
                ix.z = (__float_as_uint(v0[8]) & 0x7fu) | ((__float_as_uint(v0[9]) & 0x7fu) << 8) | ((__float_as_uint(v0[10]) & 0x7fu) << 16) | ((__float_as_uint(v0[11]) & 0x7fu) << 24);
                ix.w = (__float_as_uint(v0[12]) & 0x7fu) | ((__float_as_uint(v0[13]) & 0x7fu) << 8) | ((__float_as_uint(v0[14]) & 0x7fu) << 16) | ((__float_as_uint(v0[15]) & 0x7fu) << 24);
                *(u32x4*)lutp = ix;
}
DI void phase_retrieve(const Params& p, int bid, int nb, char* smem) {
    const bf16_t* Q = (const bf16_t*)(p.ws + OFF_PROJ);
    const bf16_t* SK = (const bf16_t*)(p.ws + OFF_SUBK);
    const float* SU = (const float*)(p.ws + OFF_SU);
    const float* SV = (const float*)(p.ws + OFF_SV);
    uint2* EX = (uint2*)(p.ws + OFF_EXPS);
    const int tid = my_tid(), lane = tid & 63, wid = tid >> 6, r = lane & 31, h = lane >> 5;
    unsigned char* lut = (unsigned char*)smem + wid * 2048 + lane * 32;
    char* skb0 = smem + 16384;
    char* skb1 = skb0 + 128 * 272;
    u32x4 sr0, sr1, sr2, sr3;
#define SK_LOAD(hp_) { const bf16_t* g_ = SK + (size_t)(hp_) * 16384 + tid * 8; sr0 = *(const u32x4*)g_; sr1 = *(const u32x4*)(g_ + 4096); sr2 = *(const u32x4*)(g_ + 8192); sr3 = *(const u32x4*)(g_ + 12288); }
#define SK_STORE(buf_) { char* d_ = (buf_) + (tid >> 4) * 272 + (tid & 15) * 16; *(u32x4*)d_ = sr0; *(u32x4*)(d_ + 32 * 272) = sr1; *(u32x4*)(d_ + 64 * 272) = sr2; *(u32x4*)(d_ + 96 * 272) = sr3; }
    for (int it = bid; it < (NTOK / 256) * 2; it += nb) {
        const int hq = it & 1, tok = (it >> 1) * 256 + wid * 32 + r;
        __syncthreads();
        SK_LOAD(hq * 8); SK_STORE(skb0);
        __syncthreads();
#pragma unroll 1
        for (int hd = hq * 4; hd < hq * 4 + 4; ++hd) {
            float L0[16], L1[16];
            SK_LOAD(hd * 2 + 1);
            retrieve_topk_hp(Q, skb0, tok, hd * 2, r, h, lut, L0);
            SK_STORE(skb1);
            __syncthreads();
            if (hd + 1 < hq * 4 + 4) SK_LOAD(hd * 2 + 2);
            retrieve_topk_hp(Q, skb1, tok, hd * 2 + 1, r, h, lut + 16, L1);
            if (hd + 1 < hq * 4 + 4) SK_STORE(skb0);
            __syncthreads();
            float c[32];
            {
                constexpr int PA[50] = {0, 0, 0, 0, 0, 0, 0, 0, 0, 0, 0, 0, 0, 0, 0, 0, 1, 1, 1, 1, 1, 1, 1, 1, 2, 2, 2, 2, 2, 3, 3, 3, 3, 4, 4, 4, 5, 5, 6, 6, 7, 7, 8, 9, 10, 11, 12, 13, 14, 15};
                constexpr int PB[50] = {0, 1, 2, 3, 4, 5, 6, 7, 8, 9, 10, 11, 12, 13, 14, 15, 0, 1, 2, 3, 4, 5, 6, 7, 0, 1, 2, 3, 4, 0, 1, 2, 3, 0, 1, 2, 0, 1, 0, 1, 0, 1, 0, 0, 0, 0, 0, 0, 0, 0};
#pragma unroll
                for (int q = 0; q < 25; ++q) {
                    const float s0 = __uint_as_float(__float_as_uint(L0[PA[2 * q]]) & ~0x7fu) + __uint_as_float(__float_as_uint(L1[PB[2 * q]]) & ~0x7fu);
                    const float s1 = __uint_as_float(__float_as_uint(L0[PA[2 * q + 1]]) & ~0x7fu) + __uint_as_float(__float_as_uint(L1[PB[2 * q + 1]]) & ~0x7fu);
                    const float p0 = __uint_as_float((__float_as_uint(s0) & ~0xffu) | (unsigned)(PA[2 * q] * 16 + PB[2 * q]));
                    const float p1 = __uint_as_float((__float_as_uint(s1) & ~0xffu) | (unsigned)(PA[2 * q + 1] * 16 + PB[2 * q + 1]));
                    c[q] = h ? p1 : p0;
                }
#pragma unroll
                for (int i = 25; i < 32; ++i) c[i] = -3.0e38f;
            }
            bitonic_sort_desc<32>(c);
            float t16[16];
#pragma unroll
            for (int i = 0; i < 16; ++i) t16[i] = c[i];
            xlane_merge16(t16);
            const float mx = __uint_as_float(__float_as_uint(t16[0]) & ~0xffu);
            float e[16], sum = 0.f;
#pragma unroll
            for (int j = 0; j < 16; ++j) { e[j] = __expf(__uint_as_float(__float_as_uint(t16[j]) & ~0xffu) - mx); sum += e[j]; }
            const float inv = 1.0f / sum;
            uint2* dst = EX + ((size_t)tok * 8 + hd) * 16 + 8 * h;
#pragma unroll
            for (int j = 0; j < 8; ++j) {
                float tlo = t16[j], thi = t16[8 + j], elo = e[j], ehi = e[8 + j];
                asm volatile("" : "+v"(tlo), "+v"(thi), "+v"(elo), "+v"(ehi));
                const float tv = h ? thi : tlo, ev = h ? ehi : elo;
                const unsigned ab = __float_as_uint(tv) & 0xffu;
                const unsigned eid = (unsigned)lut[ab >> 4] * 128u + (unsigned)lut[16 + (ab & 15u)];
                dst[j] = make_uint2(eid | (pack2(0.f, SU[eid]) & 0xffff0000u), __float_as_uint(ev * inv * SV[eid]));
            }
        }
    }
#undef SK_LOAD
#undef SK_STORE
}

DI float dot16_fp8(const u32x4 w, const f32x2 (&h)[8]) {
    f32x2 acc = __builtin_amdgcn_cvt_pk_f32_fp8((int)w.x, false) * h[0];
    acc += __builtin_amdgcn_cvt_pk_f32_fp8((int)w.x, true) * h[1];
    acc += __builtin_amdgcn_cvt_pk_f32_fp8((int)w.y, false) * h[2];
    acc += __builtin_amdgcn_cvt_pk_f32_fp8((int)w.y, true) * h[3];
    acc += __builtin_amdgcn_cvt_pk_f32_fp8((int)w.z, false) * h[4];
    acc += __builtin_amdgcn_cvt_pk_f32_fp8((int)w.z, true) * h[5];
    acc += __builtin_amdgcn_cvt_pk_f32_fp8((int)w.w, false) * h[6];
    acc += __builtin_amdgcn_cvt_pk_f32_fp8((int)w.w, true) * h[7];
    return acc.x + acc.y;
}
DI void axpy16_fp8(const float a, const u32x4 w, f32x2 (&o)[8]) {
    const f32x2 aa = {a, a};
    o[0] += aa * __builtin_amdgcn_cvt_pk_f32_fp8((int)w.x, false); o[1] += aa * __builtin_amdgcn_cvt_pk_f32_fp8((int)w.x, true);
    o[2] += aa * __builtin_amdgcn_cvt_pk_f32_fp8((int)w.y, false); o[3] += aa * __builtin_amdgcn_cvt_pk_f32_fp8((int)w.y, true);
    o[4] += aa * __builtin_amdgcn_cvt_pk_f32_fp8((int)w.z, false); o[5] += aa * __builtin_amdgcn_cvt_pk_f32_fp8((int)w.z, true);
    o[6] += aa * __builtin_amdgcn_cvt_pk_f32_fp8((int)w.w, false); o[7] += aa * __builtin_amdgcn_cvt_pk_f32_fp8((int)w.w, true);
}
DI float butterfly64(float (&pz)[64], const int lane) {
    const bool b5 = lane & 32, b4 = lane & 16, b3 = lane & 8, b2 = lane & 4, b1 = lane & 2, b0 = lane & 1;
    float q32[32], q16[16], q8[8], q4[4], q2[2];
#pragma unroll
    for (int j = 0; j < 32; ++j) q32[j] = (b5 ? pz[32 + j] : pz[j]) + __shfl_xor(b5 ? pz[j] : pz[32 + j], 32);
#pragma unroll
    for (int j = 0; j < 16; ++j) q16[j] = (b4 ? q32[16 + j] : q32[j]) + __shfl_xor(b4 ? q32[j] : q32[16 + j], 16);
#pragma unroll
    for (int j = 0; j < 8; ++j) q8[j] = (b3 ? q16[8 + j] : q16[j]) + __shfl_xor(b3 ? q16[j] : q16[8 + j], 8);
#pragma unroll
    for (int j = 0; j < 4; ++j) q4[j] = (b2 ? q8[4 + j] : q8[j]) + __shfl_xor(b2 ? q8[j] : q8[4 + j], 4);
#pragma unroll
    for (int j = 0; j < 2; ++j) q2[j] = (b1 ? q4[2 + j] : q4[j]) + __shfl_xor(b1 ? q4[j] : q4[2 + j], 2);
    return (b0 ? q2[1] : q2[0]) + __shfl_xor(b0 ? q2[0] : q2[1], 1);
}
DI float bfly8(float (&pz)[8], const int lane) {
    const bool b2 = lane & 4, b1 = lane & 2, b0 = lane & 1;
    float q4[4], q2[2];
#pragma unroll
    for (int i = 0; i < 4; ++i) q4[i] = (b2 ? pz[4 + i] : pz[i]) + __shfl_xor(b2 ? pz[i] : pz[4 + i], 4);
#pragma unroll
    for (int i = 0; i < 2; ++i) q2[i] = (b1 ? q4[2 + i] : q4[i]) + __shfl_xor(b1 ? q4[i] : q4[2 + i], 2);
    float q = (b0 ? q2[1] : q2[0]) + __shfl_xor(b0 ? q2[0] : q2[1], 1);
    q += __shfl_xor(q, 8); q += __shfl_xor(q, 16); q += __shfl_xor(q, 32);
    return q;
}
DI void gs_issue(const __amdgpu_buffer_rsrc_t T, const uint2* ent, const unsigned d, const int lane, u32x4 (&w)[8], unsigned& ca) {
    const int cnt = (int)((d >> 16) & 0xfu), k = lane & 7;
    const uint2 e = ent[(d & 0xffffu) + (unsigned)(k < cnt ? k : cnt - 1)];
    ca = (k < cnt && !(d >> 31)) ? e.y : 0u;
#pragma unroll
    for (int q = 0; q < 8; ++q) {
        const int eid = __builtin_amdgcn_readlane((int)e.x, q) & 0x3fff;
        w[q] = __builtin_amdgcn_raw_buffer_load_b128(T, lane * 16, eid * DM, 0);
    }
}
DI float dot16_i8(const u32x4 w, const u32x4 h) {
    int acc = __builtin_amdgcn_sdot4((int)w.x, (int)h.x, 0, false);
    acc = __builtin_amdgcn_sdot4((int)w.y, (int)h.y, acc, false);
    acc = __builtin_amdgcn_sdot4((int)w.z, (int)h.z, acc, false);
    acc = __builtin_amdgcn_sdot4((int)w.w, (int)h.w, acc, false);
    return (float)acc;
}
DI void gs_ucompute(const u32x4 (&w)[8], const u32x4 h2q, float* zb, const unsigned d, const int lane) {
    float pz[8];
#pragma unroll
    for (int k = 0; k < 8; ++k) pz[k] = dot16_i8(w[k], h2q);
    const float z = bfly8(pz, lane);
    if (lane < (int)((d >> 16) & 0xfu) && !(d >> 31)) zb[(d & 0xffffu) + lane] = z;
}
DI void axpy16_u8(const float a, const u32x4 w, float (&o)[16]) {
    o[0] += a * (float)(w.x & 0xffu); o[1] += a * (float)((w.x >> 8) & 0xffu); o[2] += a * (float)((w.x >> 16) & 0xffu); o[3] += a * (float)(w.x >> 24);
    o[4] += a * (float)(w.y & 0xffu); o[5] += a * (float)((w.y >> 8) & 0xffu); o[6] += a * (float)((w.y >> 16) & 0xffu); o[7] += a * (float)(w.y >> 24);
    o[8] += a * (float)(w.z & 0xffu); o[9] += a * (float)((w.z >> 8) & 0xffu); o[10] += a * (float)((w.z >> 16) & 0xffu); o[11] += a * (float)(w.z >> 24);
    o[12] += a * (float)(w.w & 0xffu); o[13] += a * (float)((w.w >> 8) & 0xffu); o[14] += a * (float)((w.w >> 16) & 0xffu); o[15] += a * (float)(w.w >> 24);
}
DI void gs_vcompute(const u32x4 (&w)[8], const unsigned ca, float (&acc)[16]) {
#pragma unroll
    for (int k = 0; k < 8; ++k) { axpy16_u8(__uint_as_float((unsigned)__builtin_amdgcn_readlane((int)ca, k)), w[k], acc); __builtin_amdgcn_sched_barrier(0); }
}
constexpr int GT = 4;
DI void phase_gather(const Params& p, int bid, int nb, char* smem) {
    const float* mod = (const float*)(p.ws + OFF_MOD);
    const uint2* EX = (const uint2*)(p.ws + OFF_EXPS);
    const __amdgpu_buffer_rsrc_t UT = __builtin_amdgcn_make_buffer_rsrc((void*)(p.ws + OFF_UT), 0, NEXP * DM, 0x00020000);
    const __amdgpu_buffer_rsrc_t VT = __builtin_amdgcn_make_buffer_rsrc((void*)(p.ws + OFF_VT), 0, NEXP * DM, 0x00020000);
    const int lane = my_tid() & 63, wid = my_tid() >> 6, c0 = lane * 16;
    char* wl = smem + wid * 7168;
    uint2* ent = (uint2*)wl; float* zb = (float*)(wl + 4096); int* offs = (int*)(wl + 6144); unsigned* sched = (unsigned*)(wl + 6144 + 256);
#pragma unroll 1
    for (int t0 = (bid * 8 + wid) * GT; t0 < NTOK; t0 += nb * 8 * GT) {
        u32x4 h2q[GT]; float hsc[GT]; float acc[GT][16];
        f32x4 scv[4], shv[4];
        {
            const int b = t0 / SEQ;
#pragma unroll
            for (int q = 0; q < 4; ++q) { scv[q] = *(const f32x4*)(mod + b * 6144 + 4096 + c0 + q * 4) + 1.0f; shv[q] = *(const f32x4*)(mod + b * 6144 + 3072 + c0 + q * 4); }
        }
#pragma unroll
        for (int j = 0; j < GT; ++j) {
            const int tok = t0 + j;
            const float* row = p.out + (size_t)tok * DM + c0;
            __builtin_amdgcn_sched_barrier(0);
            {
                f32x4 hv[4];
                float m = 0.f;
#pragma unroll
                for (int q = 0; q < 4; ++q) { hv[q] = *(const f32x4*)(row + q * 4) * scv[q] + shv[q]; m = fmaxf(m, fmaxf(fmaxf(fabsf(hv[q].x), fabsf(hv[q].y)), fmaxf(fabsf(hv[q].z), fabsf(hv[q].w)))); }
#pragma unroll
                for (int sft = 1; sft < 64; sft <<= 1) m = fmaxf(m, __shfl_xor(m, sft));
                const float qs = m > 1e-30f ? 127.0f / m : 1.0f;
                hsc[j] = m > 1e-30f ? m * (1.0f / 127.0f) : 1.0f;
                unsigned hw[4];
#pragma unroll
                for (int q = 0; q < 4; ++q)
                    hw[q] = ((unsigned)(int)rintf(hv[q].x * qs) & 0xffu) | (((unsigned)(int)rintf(hv[q].y * qs) & 0xffu) << 8) | (((unsigned)(int)rintf(hv[q].z * qs) & 0xffu) << 16) | (((unsigned)(int)rintf(hv[q].w * qs) & 0xffu) << 24);
                h2q[j] = (u32x4){hw[0], hw[1], hw[2], hw[3]};
            }
            const uint2 e0 = EX[(size_t)tok * 128 + lane], e1 = EX[(size_t)tok * 128 + 64 + lane];
            const int s0 = (int)((e0.x & 0x3fffu) >> 11), s1 = (int)((e1.x & 0x3fffu) >> 11);
            int run = 0, pos0 = 0, pos1 = 0;
#pragma unroll
            for (int s = 0; s < 8; ++s) {
                const unsigned long long m0 = __ballot(s0 == s), m1 = __ballot(s1 == s);
                const int c0n = __popcll(m0), c1n = __popcll(m1);
                const int below0 = (int)__builtin_amdgcn_mbcnt_hi((unsigned)(m0 >> 32), __builtin_amdgcn_mbcnt_lo((unsigned)m0, 0u));
                const int below1 = (int)__builtin_amdgcn_mbcnt_hi((unsigned)(m1 >> 32), __builtin_amdgcn_mbcnt_lo((unsigned)m1, 0u));
                if (lane == 0) offs[j * 9 + s] = run;
                pos0 = (s0 == s) ? run + below0 : pos0;
                pos1 = (s1 == s) ? run + c0n + below1 : pos1;
                run += c0n + c1n;
            }
            if (lane == 0) offs[j * 9 + 8] = 128;
            ent[j * 128 + pos0] = e0; ent[j * 128 + pos1] = e1;
        }
        int nbat;
        {
            const int gs = (lane / GT) & 7, gj = lane % GT;
            const int gb = offs[gj * 9 + gs], ge = offs[gj * 9 + gs + 1], cnt = lane < 8 * GT ? ge - gb : 0, nbt = (cnt + 7) >> 3;
            int incl = nbt;
#pragma unroll
            for (int m = 1; m < 32; m <<= 1) { const int o = __shfl_up(incl, m); if ((lane & 31) >= m) incl += o; }
            nbat = __builtin_amdgcn_readlane(incl, 8 * GT - 1);
            const int st = incl - nbt;
            for (int q = 0; q < nbt; ++q) { const int rem = cnt - 8 * q; sched[st + q] = (unsigned)(gj * 128 + gb + 8 * q) | ((unsigned)(rem < 8 ? rem : 8) << 16); }
            if (lane < 3) sched[nbat + lane] = 0x80010000u;
        }
#ifndef PROBE_UX
#define PROBE_UX 1
#endif
        for (int rep = 0; rep < PROBE_UX; ++rep)
        {
            u32x4 wa[8], wb[8]; unsigned ca, cb;
#define GS_UC(W_, D_) { const unsigned j_ = ((D_) & 0xffffu) >> 7; \
                if (j_ == 0) gs_ucompute(W_, h2q[0], zb, D_, lane); else if (j_ == 1) gs_ucompute(W_, h2q[1], zb, D_, lane); \
                else if (j_ == 2) gs_ucompute(W_, h2q[2], zb, D_, lane); else gs_ucompute(W_, h2q[3], zb, D_, lane); }
            unsigned da = (unsigned)__builtin_amdgcn_readfirstlane((int)sched[0]);
            gs_issue(UT, ent, da, lane, wa, ca);
#pragma unroll 1
            for (int i = 0; i < nbat; i += 2) {
                const unsigned db = (unsigned)__builtin_amdgcn_readfirstlane((int)sched[i + 1]);
                gs_issue(UT, ent, db, lane, wb, cb);
                __builtin_amdgcn_sched_barrier(0);
                GS_UC(wa, da);
                da = (unsigned)__builtin_amdgcn_readfirstlane((int)sched[i + 2]);
                gs_issue(UT, ent, da, lane, wa, ca);
                __builtin_amdgcn_sched_barrier(0);
                GS_UC(wb, db);
            }
#undef GS_UC
        }
        float asum[GT];
#pragma unroll
        for (int j = 0; j < GT; ++j) {
            float as = 0.f;
#pragma unroll
            for (int q = 0; q < 2; ++q) {
                const int pos = j * 128 + q * 64 + lane;
                const uint2 e = ent[pos];
                const float z = zb[pos] * __uint_as_float(e.x & 0xffff0000u) * hsc[j];
                const float a = gelu_as(z) * __uint_as_float(e.y);
                ent[pos].y = __float_as_uint(a);
                as += a;
            }
#pragma unroll
            for (int sft = 1; sft < 64; sft <<= 1) as += __shfl_xor(as, sft);
            asum[j] = as;
        }
#pragma unroll
        for (int j = 0; j < GT; ++j)
#pragma unroll
            for (int q = 0; q < 16; ++q) acc[j][q] = 0.f;
        {
            u32x4 wa[8]; unsigned ca;
#pragma unroll 1
            for (int i = 0; i < nbat; ++i) {
                const unsigned da = (unsigned)__builtin_amdgcn_readfirstlane((int)sched[i]);
                gs_issue(VT, ent, da, lane, wa, ca);
                __builtin_amdgcn_sched_barrier(0);
                const unsigned j_ = (da & 0xffffu) >> 7;
                if (j_ == 0) gs_vcompute(wa, ca, acc[0]); else if (j_ == 1) gs_vcompute(wa, ca, acc[1]);
                else if (j_ == 2) gs_vcompute(wa, ca, acc[2]); else gs_vcompute(wa, ca, acc[3]);
            }
        }
#pragma unroll
        for (int j = 0; j < GT; ++j) {
            asm volatile("" ::: "memory");
            __builtin_amdgcn_sched_barrier(0);
            const int tok = t0 + j, b = tok / SEQ;
            float* row = p.out + (size_t)tok * DM + c0;
            const float* g2 = mod + b * 6144 + 5120 + c0;
            f32x2 r[8];
            float sm = 0.f;
#pragma unroll
            for (int q = 0; q < 4; ++q) {
                const f32x4 xv = *(const f32x4*)(row + q * 4), gg = *(const f32x4*)(g2 + q * 4);
                const float off = 128.0f * asum[j];
                r[2 * q] = DEEP_ALPHA * (f32x2){xv.x, xv.y} + (f32x2){1.f + gg.x, 1.f + gg.y} * (f32x2){acc[j][4 * q] - off, acc[j][4 * q + 1] - off};
                r[2 * q + 1] = DEEP_ALPHA * (f32x2){xv.z, xv.w} + (f32x2){1.f + gg.z, 1.f + gg.w} * (f32x2){acc[j][4 * q + 2] - off, acc[j][4 * q + 3] - off};
                sm += r[2 * q].x + r[2 * q].y + r[2 * q + 1].x + r[2 * q + 1].y;
            }
#pragma unroll
            for (int m = 1; m < 64; m <<= 1) sm += __shfl_xor(sm, m);
            const float mu = sm * (1.0f / 1024.0f);
            float qq = 0.f;
#pragma unroll
            for (int i = 0; i < 8; ++i) { const f32x2 dd = r[i] - mu; qq += dd.x * dd.x + dd.y * dd.y; }
#pragma unroll
            for (int m = 1; m < 64; m <<= 1) qq += __shfl_xor(qq, m);
            const float rstd = rsqrtf(qq * (1.0f / 1024.0f) + LN_EPS);
#pragma unroll
            for (int q = 0; q < 4; ++q) {
                const f32x4 w4 = *(const f32x4*)(p.ln2w + c0 + q * 4), bi = *(const f32x4*)(p.ln2b + c0 + q * 4);
                f32x4 ov;
                ov.x = (r[2 * q].x - mu) * rstd * w4.x + bi.x; ov.y = (r[2 * q].y - mu) * rstd * w4.y + bi.y;
                ov.z = (r[2 * q + 1].x - mu) * rstd * w4.z + bi.z; ov.w = (r[2 * q + 1].y - mu) * rstd * w4.w + bi.w;
                *(f32x4*)(row + q * 4) = ov;
            }
        }
    }
}

#define XB_TMO      128
#define XB_XCNT(j)  (256  + 64 * (j))
#define XB_XSUB(j)  (1280 + 64 * (j))
#define XB_XGEN(j)  (2304 + 64 * (j))
#define XB_TOP      3328
#define XB_TOPGEN   3392
#define XCD_BAR_WORDS 3456
#define XB_SPIN_CAP (1u << 22)
#define LAS __attribute__((address_space(3)))
DI unsigned xb_ld(unsigned* p) { return __hip_atomic_load(p, __ATOMIC_RELAXED, __HIP_MEMORY_SCOPE_AGENT); }
DI unsigned xb_add(unsigned* p, unsigned v) { return __hip_atomic_fetch_add(p, v, __ATOMIC_RELAXED, __HIP_MEMORY_SCOPE_AGENT); }
DI unsigned xb_xcc_id() { return (unsigned)__builtin_amdgcn_s_getreg((3 << 11) | 20) & 0xFu; }
#define XB_SPIN(cond, bar) do { unsigned _sp = 0; while (cond) { __builtin_amdgcn_s_sleep(1); \
    if ((++_sp & 255u) == 0u) { if (xb_ld(&(bar)[XB_TMO])) break; if (_sp > XB_SPIN_CAP) { atomicAdd(&(bar)[XB_TMO], 1u); break; } } } } while (0)
struct XcdBarrier { unsigned* bar; unsigned x; volatile LAS unsigned* st; };
DI XcdBarrier xcd_barrier_post(unsigned* bar, volatile LAS unsigned* st) {
    XcdBarrier b; b.bar = bar; b.x = xb_xcc_id(); b.st = st;
    if (__builtin_amdgcn_workitem_id_x() == 0) (void)xb_add(&bar[XB_XCNT(b.x)], 1u);
    return b;
}
DI void xcd_barrier_complete(unsigned* bar, unsigned x, unsigned& nloc, unsigned& nx) {
    const unsigned G = gridDim.x * gridDim.y * gridDim.z;
    unsigned sum, cnt, mine, sp = 0u;
    for (;;) {
        sum = 0u; cnt = 0u; mine = 0u;
#pragma unroll
        for (unsigned j = 0; j < 16; ++j) { const unsigned c = xb_ld(&bar[XB_XCNT(j)]); sum += c; cnt += (c > 0u) ? 1u : 0u; mine = (j == x) ? c : mine; }
        if (sum == G) break;
        __builtin_amdgcn_s_sleep(1);
        if ((++sp & 255u) == 0u) { if (xb_ld(&bar[XB_TMO])) break; if (sp > XB_SPIN_CAP) { atomicAdd(&bar[XB_TMO], 1u); break; } }
    }
    nloc = mine > 0u ? mine : 1u; nx = cnt > 0u ? cnt : 1u;
}
DI void xcd_barrier(const XcdBarrier& b) {
    asm volatile("s_waitcnt vmcnt(0)" ::: "memory");
    __syncthreads();
    if (__builtin_amdgcn_workitem_id_x() == 0) {
        unsigned* bar = b.bar;
        __builtin_amdgcn_s_waitcnt(0);
        unsigned nloc = b.st[0], nx = b.st[1];
        if (nloc == 0u) { xcd_barrier_complete(bar, b.x, nloc, nx); b.st[0] = nloc; b.st[1] = nx; }
        const unsigned old = xb_add(&bar[XB_XSUB(b.x)], 1u);
        const unsigned gen = old / nloc;
        if (old + 1u == (gen + 1u) * nloc) {
            __builtin_amdgcn_fence(__ATOMIC_RELEASE, "agent");
            asm volatile("s_waitcnt vmcnt(0)" ::: "memory");
            const unsigned og = xb_add(&bar[XB_TOP], 1u);
            const unsigned tg = og / nx;
            if (og + 1u == (tg + 1u) * nx) xb_add(&bar[XB_TOPGEN], 1u);
            else XB_SPIN(xb_ld(&bar[XB_TOPGEN]) == tg, bar);
            __builtin_amdgcn_fence(__ATOMIC_ACQUIRE, "agent");
            xb_add(&bar[XB_XGEN(b.x)], 1u);
            asm volatile("s_waitcnt vmcnt(0)" ::: "memory");
        } else {
            XB_SPIN(xb_ld(&bar[XB_XGEN(b.x)]) == gen, bar);
            __builtin_amdgcn_fence(__ATOMIC_ACQUIRE, "agent");
            asm volatile("s_waitcnt vmcnt(0)" ::: "memory");
        }
    }
    __syncthreads();
}

__global__ void __launch_bounds__(NTH) k_mega(Params p) {
    __shared__ __attribute__((aligned(16))) char smem[SMEM_BYTES];
    volatile LAS unsigned* xst = (volatile LAS unsigned*)(smem + SMEM_BYTES - 16);
    if (__builtin_amdgcn_workitem_id_x() == 0) { xst[0] = 0u; xst[1] = 0u; }
    __syncthreads();
    const XcdBarrier xb = xcd_barrier_post((unsigned*)(p.ws + OFF_BAR), xst);
    const int bid = blockIdx.x, nb = gridDim.x;
#ifndef PROBE_MASK
#define PROBE_MASK 0
#endif
#define REP(bit) for (int rep_ = 0; rep_ < ((PROBE_MASK & (bit)) ? 2 : 1); ++rep_)
    REP(64) { phase_prep(p, bid, nb, smem);    xcd_barrier(xb); }
    REP(64) { phase_h(p, bid, nb);             xcd_barrier(xb); }
    REP(1)  { phase_proj(p, bid, nb, smem);    xcd_barrier(xb); }
    REP(128) { phase_hgprep(p, bid, nb);       xcd_barrier(xb); }
    REP(2)  { phase_mix(p, bid, nb, smem);     xcd_barrier(xb); }
    REP(4)  { phase_glu(p, bid, nb, smem);     xcd_barrier(xb); }
    REP(4)  { phase_a2(p, bid, nb);            xcd_barrier(xb); }
    REP(4)  { phase_outproj(p, bid, nb, smem); xcd_barrier(xb); }
    phase_ln1(p, bid, nb);           xcd_barrier(xb);
    REP(8)  { phase_q(p, bid, nb, smem);       xcd_barrier(xb); }
    REP(16) { phase_retrieve(p, bid, nb, smem); xcd_barrier(xb); }
    phase_gather(p, bid, nb, smem);
}

extern "C" void kernel_launch(void* const* d_in, const int* in_sizes, int n_in, void* d_out, int out_size, void* d_ws, size_t ws_size, hipStream_t stream) {
    if (n_in != 27 || ws_size < WS_END) { fprintf(stderr, "kernel_launch: unexpected n_in %d or ws_size %zu (< %zu)\n", n_in, ws_size, (size_t)WS_END); return; }
    static int grid_blocks = 0;
    if (!grid_blocks) {
        int dev = 0, cus = 0, per_cu = 0;
        (void)hipGetDevice(&dev);
        (void)hipDeviceGetAttribute(&cus, hipDeviceAttributeMultiprocessorCount, dev);
        (void)hipOccupancyMaxActiveBlocksPerMultiprocessor(&per_cu, k_mega, NTH, 0);
        if (cus <= 0) cus = 256;
        if (per_cu < 1) { fprintf(stderr, "kernel_launch: occupancy query says %d blocks/CU\n", per_cu); per_cu = 1; }
        grid_blocks = cus;
    }
    Params p{};
    const float** f = (const float**)&p;
    for (int i = 0; i < 27; ++i) f[i] = (const float*)d_in[i];
    p.out = (float*)d_out; p.ws = (char*)d_ws;
    hipError_t e = hipMemsetAsync((char*)d_ws + OFF_BAR, 0, (size_t)3456 * 4, stream);
    if (e == hipSuccess) { hipLaunchKernelGGL(k_mega, dim3(grid_blocks), dim3(NTH), 0, stream, p); e = hipPeekAtLastError(); }
    if (e != hipSuccess) fprintf(stderr, "launch failed: %s (grid %d)\n", hipGetErrorString(e), grid_blocks);
}
```

```cpp
#include <hip/hip_runtime.h>
#include <hip/hip_cooperative_groups.h>
#include <stdint.h>
#include <stdio.h>

namespace cg = cooperative_groups;
#define DI __device__ __forceinline__
typedef unsigned short bf16_t;
typedef short bf16x8 __attribute__((ext_vector_type(8)));
typedef float f32x16 __attribute__((ext_vector_type(16)));
typedef unsigned u32x4 __attribute__((ext_vector_type(4)));
typedef float f32x4 __attribute__((ext_vector_type(4)));
typedef float f32x2 __attribute__((ext_vector_type(2)));

constexpr int NTH = 512;
constexpr int NB = 16, SEQ = 2048, DM = 1024, NTOK = NB * SEQ;
constexpr int DHG = 512, HGH = 4, HDK = 128;
constexpr int DSS = 512, SSG = 32, SSC = 16, SSP = 64;
constexpr int INC = 2560;
constexpr int PHEADS = 8, NKEYS = 128, TOPK = 16, NEXP = 16384;
constexpr float DEEP_ALPHA = 1.189207115002721f;
constexpr float LN_EPS = 1e-5f, RMS_EPS = 1e-6f;
constexpr int SMEM_BYTES = 128 * 1024 + 256;

constexpr size_t al256(size_t x) { return (x + 255) & ~(size_t)255; }
constexpr size_t OFF_MOD = 0;
constexpr size_t OFF_LB = al256(OFF_MOD + (size_t)NB * 6144 * 4);
constexpr size_t OFF_LAM = al256(OFF_LB + 512 * 4);
constexpr size_t OFF_BB = al256(OFF_LAM + 32 * 64 * 2 * 4);
constexpr size_t OFF_WIN = al256(OFF_BB + 32 * 64 * 16 * 2 * 4);
constexpr size_t OFF_GLU = al256(OFF_WIN + (size_t)INC * DM * 2);
constexpr size_t OFF_WOUT = al256(OFF_GLU + (size_t)512 * 512 * 2);
constexpr size_t OFF_WQ = al256(OFF_WOUT + (size_t)DM * DM * 2);
constexpr size_t OFF_SUBK = al256(OFF_WQ + (size_t)2048 * DM * 2);
constexpr size_t OFF_SU = al256(OFF_SUBK + (size_t)16 * 128 * 128 * 2);
constexpr size_t OFF_SV = al256(OFF_SU + (size_t)NEXP * 4);
constexpr size_t OFF_UT = al256(OFF_SV + (size_t)NEXP * 4);
constexpr size_t OFF_VT = al256(OFF_UT + (size_t)NEXP * DM * 2);
constexpr size_t OFF_H = al256(OFF_VT + (size_t)NEXP * DM * 2);
constexpr size_t OFF_PROJ = al256(OFF_H + (size_t)NTOK * DM * 2);
constexpr size_t OFF_ORAW = al256(OFF_PROJ + (size_t)NTOK * INC * 2);
constexpr size_t OFF_YSSM = al256(OFF_ORAW + (size_t)NTOK * DHG * 4);
constexpr size_t OFF_A2 = al256(OFF_YSSM + (size_t)NTOK * DSS * 2);
constexpr size_t OFF_HG = al256(OFF_A2 + (size_t)NTOK * DM * 2);
constexpr size_t OFF_S5K = al256(OFF_HG + (size_t)4096 * 128 * 4);
constexpr size_t OFF_S5N = al256(OFF_S5K + (size_t)32 * 4096 * 2);
constexpr size_t OFF_S5M = al256(OFF_S5N + (size_t)32 * 128 * 256 * 2);
constexpr size_t OFF_S5L = al256(OFF_S5M + (size_t)32 * 256 * 128 * 2);
constexpr size_t OFF_BAR = al256(OFF_S5L + (size_t)32 * 64 * 2 * 4);
constexpr size_t WS_END = al256(OFF_BAR + (size_t)3456 * 4);
constexpr size_t OFF_HQ = OFF_H, OFF_HK = OFF_H + (size_t)NTOK * DHG * 2, OFF_HKT = OFF_A2, OFF_HVT = OFF_A2 + (size_t)NTOK * DHG * 2;
constexpr size_t OFF_TOPL = OFF_ORAW;
constexpr size_t OFF_EXPS = OFF_ORAW + (size_t)NTOK * 16 * 16 * 4;

struct Params {
    const float *x, *c, *ada_w, *ada_b, *w_in, *hg_lb, *hg_nw, *a_re, *a_im, *log_dt, *b_re, *b_im, *c_re, *c_im, *dsk,
        *glu_w, *glu_b, *ssm_nw, *w_out, *ln1w, *ln1b, *w_q, *subk, *pu, *pv, *ln2w, *ln2b;
    float* out;
    char* ws;
};

DI int my_tid() { int t = (int)__builtin_amdgcn_workitem_id_x(); asm volatile("" : "+v"(t)); return t; }
DI bf16_t f2bf(float x) { unsigned u = __float_as_uint(x); u += 0x7fffu + ((u >> 16) & 1u); return (bf16_t)(u >> 16); }
DI float bf2f(bf16_t b) { return __uint_as_float(((unsigned)b) << 16); }
DI float bflo(unsigned w) { return __uint_as_float(w << 16); }
DI float bfhi(unsigned w) { return __uint_as_float(w & 0xffff0000u); }
typedef __bf16 hwbf16x2 __attribute__((ext_vector_type(2)));
DI unsigned pack2(float a, float b) { const f32x2 v = {a, b}; return __builtin_bit_cast(unsigned, __builtin_convertvector(v, hwbf16x2)); }
DI bf16x8 pack8(const f32x16& x, const int base) {
    u32x4 o; o.x = pack2(x[base], x[base + 1]); o.y = pack2(x[base + 2], x[base + 3]); o.z = pack2(x[base + 4], x[base + 5]); o.w = pack2(x[base + 6], x[base + 7]);
    return __builtin_bit_cast(bf16x8, o);
}
DI float sigmoidf_(float x) { return 1.0f / (1.0f + __expf(-x)); }
DI float siluf_(float x) { return x * sigmoidf_(x); }
DI float geluf_(float x) { return 0.5f * x * (1.0f + erff(x * 0.70710678118654752f)); }
DI float gelu_as(float v) {
    const float t = __builtin_amdgcn_rcpf(fabsf(v) * 0.2316418882f + 1.0f);
    float q = t * 0.5307027145f + (-0.7265760135f); q = q * t + 0.7107068705f; q = q * t + (-0.142248368f); q = q * t + 0.127414796f; q = q * t;
    const float m = v * (q * __builtin_amdgcn_exp2f(v * v * (-0.72134752044f)));
    return v < 0.f ? m : v - m;
}

template <int MT, int NT_, int WM, int WN, class Epi>
DI void gemm_block(const bf16_t* __restrict__ A, int lda, const bf16_t* __restrict__ Bt, int ldb, int K, char* smem, Epi epi) {
    constexpr int BM = WM * MT * 32, BN = WN * NT_ * 32, LS = 72;
    static_assert(WM * WN == 8, "8 waves");
    bf16_t* As = (bf16_t*)smem;
    bf16_t* Bs = As + BM * LS;
    const int tid = my_tid(), lane = tid & 63, wid = tid >> 6, r = lane & 31, h = lane >> 5;
    const int wm = wid / WN, wn = wid % WN;
    constexpr int PA = BM * 8 / NTH, PB = BN * 8 / NTH;
    u32x4 ra[PA], rb[PB];
    f32x16 acc[MT][NT_];
#pragma unroll
    for (int mi = 0; mi < MT; ++mi)
#pragma unroll
        for (int ni = 0; ni < NT_; ++ni)
#pragma unroll
            for (int i = 0; i < 16; ++i) acc[mi][ni][i] = 0.f;
#define GEMM_GLOAD(kt_) { \
    _Pragma("unroll") for (int q = 0; q < PA; ++q) { const int idx = tid + q * NTH, row = idx >> 3, ch = idx & 7; ra[q] = *(const u32x4*)(A + (size_t)row * lda + (kt_) * 64 + ch * 8); } \
    _Pragma("unroll") for (int q = 0; q < PB; ++q) { const int idx = tid + q * NTH, row = idx >> 3, ch = idx & 7; rb[q] = *(const u32x4*)(Bt + (size_t)row * ldb + (kt_) * 64 + ch * 8); } }
#define GEMM_LSTORE() { \
    _Pragma("unroll") for (int q = 0; q < PA; ++q) { const int idx = tid + q * NTH, row = idx >> 3, ch = idx & 7; *(u32x4*)(As + row * LS + ch * 8) = ra[q]; } \
    _Pragma("unroll") for (int q = 0; q < PB; ++q) { const int idx = tid + q * NTH, row = idx >> 3, ch = idx & 7; *(u32x4*)(Bs + row * LS + ch * 8) = rb[q]; } }
    GEMM_GLOAD(0); GEMM_LSTORE(); __syncthreads();
    const int nk = K / 64;
    for (int kt = 0; kt < nk; ++kt) {
        if (kt + 1 < nk) GEMM_GLOAD(kt + 1);
#pragma unroll
        for (int ks = 0; ks < 4; ++ks) {
            bf16x8 a[MT], b[NT_];
#pragma unroll
            for (int mi = 0; mi < MT; ++mi) a[mi] = *(const bf16x8*)(As + (wm * MT * 32 + mi * 32 + r) * LS + ks * 16 + h * 8);
#pragma unroll
            for (int ni = 0; ni < NT_; ++ni) b[ni] = *(const bf16x8*)(Bs + (wn * NT_ * 32 + ni * 32 + r) * LS + ks * 16 + h * 8);
#pragma unroll
            for (int mi = 0; mi < MT; ++mi)
#pragma unroll
                for (int ni = 0; ni < NT_; ++ni) acc[mi][ni] = __builtin_amdgcn_mfma_f32_32x32x16_bf16(a[mi], b[ni], acc[mi][ni], 0, 0, 0);
        }
        __syncthreads();
        if (kt + 1 < nk) { GEMM_LSTORE(); __syncthreads(); }
    }
#pragma unroll
    for (int mi = 0; mi < MT; ++mi)
#pragma unroll
        for (int ni = 0; ni < NT_; ++ni)
#pragma unroll
            for (int i = 0; i < 16; ++i) epi(wm * MT * 32 + mi * 32 + (i & 3) + 8 * (i >> 2) + 4 * h, wn * NT_ * 32 + ni * 32 + r, acc[mi][ni][i]);
}

namespace pg8 {
#define PG8_LAS __attribute__((address_space(3)))
typedef unsigned short bf16_t;
typedef short bf16x8 __attribute__((ext_vector_type(8)));
typedef float f32x4 __attribute__((ext_vector_type(4)));
typedef unsigned u32x4 __attribute__((ext_vector_type(4)));
constexpr int BM = 256, BK = 64, HALF = 128, HTB = HALF * BK * 2  , STAGE_BYTES = 8 * HTB, NXCD = 8, WGM = 8;

__host__ __device__ __forceinline__ int lds_byte(int r, int c) { const int st = (r >> 4) * 2 + (c >> 5), rr = r & 15, cc = c & 31, ob = rr * 64 + cc * 2; return st * 1024 + (ob ^ (((ob >> 9) & 1) << 5)); }
__host__ __device__ __forceinline__ void stage_rc(int b, int& R, int& C) { const int st = b / 1024, sb = b % 1024, swz = sb ^ (((sb >> 9) & 1) << 5); R = (st >> 1) * 16 + swz / 64; C = (st & 1) * 32 + (swz % 64) / 2; }
__host__ __device__ __forceinline__ int perm32(int rho) { const int n = rho >> 4, i = rho & 15; return 8 * (i >> 2) + 4 * n + (i & 3); }

struct Unit { int pm, pn; };
struct Gemm { const bf16_t* A; const bf16_t* Bt; int M, N, K; };

struct StaticOrder {
    int nM, nN, nwg, G, c;
    __host__ __device__ void init(int M, int N, int G_, int c_) { nM = M / BM; nN = N / BM; nwg = nM * nN; G = G_; c = c_; }
    __host__ __device__ bool next(int i, Unit& u) const {
        const long L = (long)i * G + c; if (L >= nwg) return false;
        int wgid = (int)L; { const int q = nwg / NXCD, r = nwg % NXCD, xcd = wgid % NXCD, off = wgid / NXCD; wgid = (xcd < r ? xcd * (q + 1) : r * (q + 1) + (xcd - r) * q) + off; }
        const int nig = WGM * nN, gid = wgid / nig, fm = gid * WGM, gsz = (nM - fm) < WGM ? (nM - fm) : WGM;
        u.pm = fm + ((wgid % nig) % gsz); u.pn = (wgid % nig) / gsz; return true;
    }
    __device__ __forceinline__ void a_ready(const Unit&) const {}
    __device__ __forceinline__ void done(const Unit&) const {}
};
template <class Epi, class Sched, bool STAMP = false>
__device__ __forceinline__ void gemm_phase(PG8_LAS unsigned char* lds, const Gemm g, const Sched& S, const Epi& E, unsigned long long* stamps) {
    const int tid = (int)__builtin_amdgcn_workitem_id_x(), wid = __builtin_amdgcn_readfirstlane(tid >> 6), lane = tid & 63, wr = wid >> 2, wc = wid & 3, fr = lane & 15, fq = lane >> 4;
    const int K = g.K, nt = K / BK;
    int ts_lo = 0, ts_hi = 0, nts = 0; const unsigned long long rt_entry = STAMP ? (unsigned long long)wall_clock64() : 0ull;
#define PG8_STAMP() do { if (STAMP && wid == 0 && nts < 64) { const unsigned long long _c = (unsigned long long)clock64(); \
        ts_lo = (lane == nts) ? (int)(unsigned)_c : ts_lo; ts_hi = (lane == nts) ? (int)(unsigned)(_c >> 32) : ts_hi; ++nts; } } while (0)
    PG8_STAMP();
    unsigned voffA[2], voffB[2];
#pragma unroll
    for (int i = 0; i < 2; ++i) { int R, C; stage_rc(tid * 16 + i * 8192, R, C); const int Rb = Epi::PERM ? ((R & ~31) + perm32(R & 31)) : R;
        voffA[i] = (unsigned)(R * K + C) * 2u; voffB[i] = (unsigned)(Rb * K + C) * 2u; }
    const size_t kstep = (size_t)(BK * 2);
    const size_t hstep = (size_t)HALF * K * 2;
    const size_t tstep = 2 * hstep;
    const unsigned ldsw = (unsigned)wid * 1024u;
    const int aoff = lds_byte(wr * 64 + fr, fq * 8), boff = lds_byte(wc * 32 + fr, fq * 8);
#define PG8_SA(b, h) (((b) * 2 + (h)) * HTB)
#define PG8_SB(b, h) ((4 + (b) * 2 + (h)) * HTB)
#define PG8_STAGE(bufoff, gbase, voff) do { _Pragma("unroll") for (int _i = 0; _i < 2; ++_i) \
        __builtin_amdgcn_global_load_lds((const unsigned*)((const char*)(gbase) + (voff)[_i]), (PG8_LAS unsigned*)(lds + (bufoff) + ldsw + _i * 8192), 16, 0, 0); } while (0)
#define PG8_LDA(dst, b, h) do { _Pragma("unroll") for (int m = 0; m < 4; ++m) _Pragma("unroll") for (int k = 0; k < 2; ++k) dst[m][k] = *(const PG8_LAS bf16x8*)(lds + PG8_SA(b, h) + aoff + m * 2048 + k * 1024); } while (0)
#define PG8_LDB(dst, b, h) do { _Pragma("unroll") for (int n = 0; n < 2; ++n) _Pragma("unroll") for (int k = 0; k < 2; ++k) dst[n][k] = *(const PG8_LAS bf16x8*)(lds + PG8_SB(b, h) + boff + n * 2048 + k * 1024); } while (0)
#define PG8_MMA(ai, bj, At, Bt) do { __builtin_amdgcn_s_setprio(1); _Pragma("unroll") for (int m = 0; m < 4; ++m) _Pragma("unroll") for (int n = 0; n < 2; ++n) _Pragma("unroll") for (int k = 0; k < 2; ++k) \
        acc[ai][bj][m][n] = __builtin_amdgcn_mfma_f32_16x16x32_bf16(Bt[n][k], At[m][k], acc[ai][bj][m][n], 0, 0, 0); __builtin_amdgcn_s_setprio(0); } while (0)
#define PG8_WAIT_V(n) asm volatile("s_waitcnt vmcnt(" #n ")" ::: "memory")
#define PG8_WAIT_L(n) asm volatile("s_waitcnt lgkmcnt(" #n ")" ::: "memory")
#define PG8_BAR __builtin_amdgcn_s_barrier()
#define PG8_SCHED __builtin_amdgcn_sched_barrier(0)
    Unit cur, nxt; int ui = 0;
    if (!S.next(0, cur)) return;
    f32x4 acc[2][2][4][2];
#pragma unroll
    for (int a = 0; a < 2; ++a)
#pragma unroll
        for (int b = 0; b < 2; ++b)
#pragma unroll
            for (int m = 0; m < 4; ++m)
#pragma unroll
                for (int n = 0; n < 2; ++n) acc[a][b][m][n] = (f32x4){0.f, 0.f, 0.f, 0.f};
    bf16x8 At[4][2], B0[2][2], B1[2][2];
    const char* cA = (const char*)g.A + (size_t)cur.pm * tstep; const char* cB = (const char*)g.Bt + (size_t)cur.pn * tstep;
    S.a_ready(cur);
    PG8_STAGE(PG8_SB(0, 0), cB, voffB); PG8_STAGE(PG8_SA(0, 0), cA, voffA); PG8_STAGE(PG8_SB(0, 1), cB + hstep, voffB); PG8_STAGE(PG8_SA(0, 1), cA + hstep, voffA);
    if (wr == 1) PG8_BAR;
    PG8_WAIT_V(4); PG8_BAR;
    PG8_STAGE(PG8_SB(1, 0), cB + kstep, voffB); PG8_STAGE(PG8_SA(1, 0), cA + kstep, voffA); PG8_STAGE(PG8_SB(1, 1), cB + hstep + kstep, voffB);
    PG8_WAIT_V(6); PG8_BAR;
    PG8_STAMP();
    for (;;) {
        const bool has_next = S.next(ui + 1, nxt);
        const char* nA = has_next ? (const char*)g.A + (size_t)nxt.pm * tstep : cA; const char* nB = has_next ? (const char*)g.Bt + (size_t)nxt.pn * tstep : cB;
        for (int t = 0; t < nt; t += 2) {
            const bool last = (t == nt - 2);
            const char* a1 = cA + (size_t)(t + 1) * kstep;
            const char* a2 = last ? nA : cA + (size_t)(t + 2) * kstep; const char* b2 = last ? nB : cB + (size_t)(t + 2) * kstep;
            const char* a3 = a2 + kstep; const char* b3 = b2 + kstep;
            if (last && has_next) S.a_ready(nxt);
            PG8_LDB(B0, 0, 0); PG8_SCHED; PG8_LDA(At, 0, 0); PG8_STAGE(PG8_SA(1, 1), a1 + hstep, voffA);
            PG8_WAIT_L(8); PG8_BAR; PG8_WAIT_L(0); PG8_MMA(0, 0, At, B0); PG8_BAR; PG8_SCHED;
            PG8_LDB(B1, 0, 1); PG8_STAGE(PG8_SB(0, 0), b2, voffB);
            PG8_BAR; PG8_WAIT_L(0); PG8_MMA(0, 1, At, B1); PG8_BAR;
            PG8_LDA(At, 0, 1); PG8_STAGE(PG8_SA(0, 0), a2, voffA);
            PG8_BAR; PG8_WAIT_L(0); PG8_MMA(1, 0, At, B0); PG8_BAR; PG8_SCHED;
            PG8_STAGE(PG8_SB(0, 1), b2 + hstep, voffB);
            PG8_WAIT_V(6); PG8_BAR; PG8_MMA(1, 1, At, B1); PG8_BAR;
            PG8_LDB(B0, 1, 0); PG8_SCHED; PG8_LDA(At, 1, 0); PG8_STAGE(PG8_SA(0, 1), a2 + hstep, voffA);
            PG8_WAIT_L(8); PG8_BAR; PG8_WAIT_L(0); PG8_MMA(0, 0, At, B0); PG8_BAR; PG8_SCHED;
            PG8_LDB(B1, 1, 1); PG8_STAGE(PG8_SB(1, 0), b3, voffB);
            PG8_BAR; PG8_WAIT_L(0); PG8_MMA(0, 1, At, B1); PG8_BAR;
            PG8_LDA(At, 1, 1); PG8_STAGE(PG8_SA(1, 0), a3, voffA);
            PG8_BAR; PG8_WAIT_L(0); PG8_MMA(1, 0, At, B0); PG8_BAR; PG8_SCHED;
            PG8_STAGE(PG8_SB(1, 1), b3 + hstep, voffB);
            PG8_WAIT_V(6); PG8_BAR; PG8_MMA(1, 1, At, B1); PG8_BAR;
        }
        PG8_STAMP();
        if constexpr (!Epi::AFTER_DRAIN) { E(acc, cur, wr, wc, fr, fq); S.done(cur); }
        PG8_STAMP();
        if (!has_next) break;
#pragma unroll
        for (int a = 0; a < 2; ++a)
#pragma unroll
            for (int b = 0; b < 2; ++b)
#pragma unroll
                for (int m = 0; m < 4; ++m)
#pragma unroll
                    for (int n = 0; n < 2; ++n) acc[a][b][m][n] = (f32x4){0.f, 0.f, 0.f, 0.f};
        cur = nxt; cA = nA; cB = nB; ++ui;
    }
    PG8_WAIT_V(0);
    if (wr == 0) PG8_BAR;
    PG8_BAR;
    if constexpr (Epi::AFTER_DRAIN) { E.fused(acc, cur, wr, wc, fr, fq, lds, wid, lane); S.done(cur); }
    PG8_STAMP();
    if (STAMP && wid == 0) { stamps[lane] = lane < nts ? (((unsigned long long)(unsigned)ts_hi << 32) | (unsigned)ts_lo) : 0ull;
        if (lane == 62) stamps[62] = rt_entry; if (lane == 63) stamps[63] = (unsigned long long)wall_clock64(); }
#undef PG8_STAMP
#undef PG8_SA
#undef PG8_SB
#undef PG8_STAGE
#undef PG8_LDA
#undef PG8_LDB
#undef PG8_MMA
#undef PG8_WAIT_V
#undef PG8_WAIT_L
#undef PG8_BAR
#undef PG8_SCHED
}

__device__ __forceinline__ unsigned pk_bf16(float lo, float hi) { typedef float v2f __attribute__((ext_vector_type(2))); typedef __bf16 v2b __attribute__((ext_vector_type(2))); const v2f v = {lo, hi}; return __builtin_bit_cast(unsigned, __builtin_convertvector(v, v2b)); }
__device__ __forceinline__ float silu1(float x) { return x * __builtin_amdgcn_rcpf(1.0f + __expf(-x)); }
struct EpiBf16Act {
    static constexpr bool PERM = true, AFTER_DRAIN = false;
    bf16_t* O; int ldc; unsigned silu_mask;
    __device__ __forceinline__ void operator()(const f32x4 (&acc)[2][2][4][2], const Unit& u, int wr, int wc, int fr, int fq) const {
        const int row0 = u.pm * BM + wr * 64 + fr, col0 = u.pn * BM + wc * 32 + 8 * fq;
        const bool act = (silu_mask >> u.pn) & 1u;
#pragma unroll
        for (int ai = 0; ai < 2; ++ai)
#pragma unroll
            for (int m = 0; m < 4; ++m) { bf16_t* rowp = O + (size_t)(row0 + ai * HALF + m * 16) * ldc + col0;
#pragma unroll
                for (int bj = 0; bj < 2; ++bj) { f32x4 v0 = acc[ai][bj][m][0], v1 = acc[ai][bj][m][1];
                    if (act) {
#pragma unroll
                        for (int j = 0; j < 4; ++j) { v0[j] = silu1(v0[j]); v1[j] = silu1(v1[j]); } }
                    u32x4 w; w.x = pk_bf16(v0[0], v0[1]); w.y = pk_bf16(v0[2], v0[3]); w.z = pk_bf16(v1[0], v1[1]); w.w = pk_bf16(v1[2], v1[3]);
                    *(u32x4*)(rowp + bj * HALF) = w; } }
    }
};
struct EpiResid {
    static constexpr bool PERM = false, AFTER_DRAIN = false;
    float* C; const float* X; const float* mod_g;
    float alpha;
    __device__ __forceinline__ void operator()(const f32x4 (&acc)[2][2][4][2], const Unit& u, int wr, int wc, int fr, int fq) const {
        const int row0 = u.pm * BM + wr * 64 + fr, col0 = u.pn * BM + wc * 32 + 4 * fq;
        const float* gb = mod_g + (size_t)((u.pm * BM) / 2048) * 6144 + col0;
        f32x4 gv[2][2];
#pragma unroll
        for (int bj = 0; bj < 2; ++bj)
#pragma unroll
            for (int n = 0; n < 2; ++n) gv[bj][n] = *(const f32x4*)(gb + bj * HALF + n * 16) + 1.0f;
#pragma unroll
        for (int ai = 0; ai < 2; ++ai)
#pragma unroll
            for (int m = 0; m < 4; ++m) { const size_t ro = (size_t)(row0 + ai * HALF + m * 16) * 1024 + col0;
#pragma unroll
                for (int bj = 0; bj < 2; ++bj)
#pragma unroll
                    for (int n = 0; n < 2; ++n) { const f32x4 xv = *(const f32x4*)(X + ro + bj * HALF + n * 16); *(f32x4*)(C + ro + bj * HALF + n * 16) = alpha * xv + gv[bj][n] * acc[ai][bj][m][n]; } }
    }
};
struct EpiGlu {
    static constexpr bool PERM = false, AFTER_DRAIN = false;
    float* C; const bf16_t* Y; const float* bias;
    __device__ __forceinline__ void operator()(const f32x4 (&acc)[2][2][4][2], const Unit& u, int wr, int wc, int fr, int fq) const {
        const int row0 = u.pm * BM + wr * 64 + fr, col0 = u.pn * BM + wc * 32 + 4 * fq;
        f32x4 bv[2][2];
#pragma unroll
        for (int bj = 0; bj < 2; ++bj)
#pragma unroll
            for (int n = 0; n < 2; ++n) bv[bj][n] = *(const f32x4*)(bias + col0 + bj * HALF + n * 16);
#pragma unroll
        for (int ai = 0; ai < 2; ++ai)
#pragma unroll
            for (int m = 0; m < 4; ++m) { const size_t ro = (size_t)(row0 + ai * HALF + m * 16) * 512 + col0;
#pragma unroll
                for (int bj = 0; bj < 2; ++bj)
#pragma unroll
                    for (int n = 0; n < 2; ++n) {
                        const uint2 yw = *(const uint2*)(Y + ro + bj * HALF + n * 16);
                        const f32x4 z = acc[ai][bj][m][n] + bv[bj][n];
                        f32x4 o;
                        o[0] = __uint_as_float(yw.x << 16) * __builtin_amdgcn_rcpf(1.0f + __expf(-z[0])); o[1] = __uint_as_float(yw.x & 0xffff0000u) * __builtin_amdgcn_rcpf(1.0f + __expf(-z[1]));
                        o[2] = __uint_as_float(yw.y << 16) * __builtin_amdgcn_rcpf(1.0f + __expf(-z[2])); o[3] = __uint_as_float(yw.y & 0xffff0000u) * __builtin_amdgcn_rcpf(1.0f + __expf(-z[3]));
                        *(f32x4*)(C + ro + bj * HALF + n * 16) = o; } }
    }
};
}

DI void prep_mod_item(const Params& p, int item, char* smem) {
    float* cond = (float*)smem;
    const int tid = my_tid();
    for (int i = tid; i < NB * DM; i += NTH) cond[i] = siluf_(p.c[i]);
    __syncthreads();
    const int b = tid >> 5, col = item * 32 + (tid & 31);
    float acc = 0.f;
    const float* w = p.ada_w + col;
    const float* cb = cond + b * DM;
#pragma unroll 8
    for (int k = 0; k < DM; ++k) acc += cb[k] * w[(size_t)k * 6144];
    ((float*)(p.ws + OFF_MOD))[b * 6144 + col] = acc + p.ada_b[col];
    __syncthreads();
}
DI void prep_s5_gemm_item(const Params& p, int g, char* smem) {
    f32x2* pw = (f32x2*)smem;
    f32x2* bbL = pw + 17 * 64;
    f32x2* cL = bbL + 64 * 16;
    const int tid = my_tid();
    const float dt = expf(p.log_dt[g]);
#pragma unroll 1
    for (int idx = tid; idx < 17 * 64; idx += NTH) {
        const int j = idx >> 6, pp = idx & 63;
        const float ar = p.a_re[g * 64 + pp], ai = p.a_im[g * 64 + pp];
        const float mag = expf(ar * dt * (float)j), ang = ai * dt * (float)j;
        pw[idx] = (f32x2){mag * cosf(ang), mag * sinf(ang)};
    }
    for (int idx = tid; idx < 16 * 64; idx += NTH) { const int i = idx >> 6, pp = idx & 63; cL[idx] = (f32x2){p.c_re[(g * 16 + i) * 64 + pp], p.c_im[(g * 16 + i) * 64 + pp]}; }
    __syncthreads();
    for (int idx = tid; idx < 64 * 16; idx += NTH) {
        const int pp = idx >> 4, i = idx & 15;
        const float ar = p.a_re[g * 64 + pp], ai = p.a_im[g * 64 + pp];
        const f32x2 lam = pw[64 + pp];
        const float den = ar * ar + ai * ai, nr = lam.x - 1.0f, ni = lam.y;
        const float zr = (nr * ar + ni * ai) / den, zi = (ni * ar - nr * ai) / den;
        const float br = p.b_re[(g * 64 + pp) * 16 + i], bi = p.b_im[(g * 64 + pp) * 16 + i];
        bbL[idx] = (f32x2){zr * br - zi * bi, zr * bi + zi * br};
    }
    __syncthreads();
    bf16_t* NBg = (bf16_t*)(p.ws + OFF_S5N) + (size_t)g * 128 * 256;
#pragma unroll 1
    for (int ch = tid; ch < 128 * 256 / 8; ch += NTH) {
        const int pq = ch >> 5, t = (ch >> 1) & 15, i0 = (ch & 1) * 8, pp = pq & 63;
        const f32x2 w = pw[(15 - t) * 64 + pp];
        float v[8];
#pragma unroll
        for (int e = 0; e < 8; ++e) { const f32x2 bb = bbL[pp * 16 + i0 + e]; v[e] = pq < 64 ? (w.x * bb.x - w.y * bb.y) : (w.x * bb.y + w.y * bb.x); }
        u32x4 o; o.x = pack2(v[0], v[1]); o.y = pack2(v[2], v[3]); o.z = pack2(v[4], v[5]); o.w = pack2(v[6], v[7]);
        *(u32x4*)(NBg + (size_t)((((pq >> 5) * 16 + t) * 64) + (i0 >> 3) * 32 + (pq & 31)) * 8) = o;
    }
    bf16_t* MBg = (bf16_t*)(p.ws + OFF_S5M) + (size_t)g * 256 * 128;
#pragma unroll 1
    for (int ch = tid; ch < 256 * 128 / 8; ch += NTH) {
        const int ti = ch >> 4, p0 = (ch & 15) * 8, tq = ti >> 4, iq = ti & 15;
        float v[8];
#pragma unroll
        for (int e = 0; e < 8; ++e) {
            const int pq = p0 + e, pp = pq & 63;
            const f32x2 c = cL[iq * 64 + pp], w = pw[(tq + 1) * 64 + pp];
            v[e] = pq < 64 ? (c.x * w.x - c.y * w.y) : -(c.x * w.y + c.y * w.x);
        }
        u32x4 o; o.x = pack2(v[0], v[1]); o.y = pack2(v[2], v[3]); o.z = pack2(v[4], v[5]); o.w = pack2(v[6], v[7]);
        *(u32x4*)(MBg + (size_t)((((ti >> 5) * 8 + (p0 >> 4)) * 64) + ((p0 >> 3) & 1) * 32 + (ti & 31)) * 8) = o;
    }
    bf16_t* KTg = (bf16_t*)(p.ws + OFF_S5K) + (size_t)g * 4096;
#pragma unroll 1
    for (int idx = tid; idx < 4096; idx += NTH) {
        const int lag = idx >> 8, iq = (idx >> 4) & 15, i = idx & 15;
        float acc = (lag == 0 && iq == i) ? p.dsk[g * 16 + iq] : 0.f;
#pragma unroll 4
        for (int pp = 0; pp < 64; ++pp) {
            const f32x2 c = cL[iq * 64 + pp], w = pw[lag * 64 + pp], bb = bbL[pp * 16 + i];
            const float mr = c.x * w.x - c.y * w.y, mi_ = c.x * w.y + c.y * w.x;
            acc += mr * bb.x - mi_ * bb.y;
        }
        KTg[idx] = f2bf(acc);
    }
    if (tid < 64) { float* L = (float*)(p.ws + OFF_S5L) + (g * 64 + tid) * 2; const f32x2 w = pw[16 * 64 + tid]; L[0] = w.x; L[1] = w.y; }
    __syncthreads();
}
DI void prep_s5_item(const Params& p, int g) {
    const int tid = my_tid();
    if (tid < SSP) {
        const int pi = g * SSP + tid;
        const float dt = expf(p.log_dt[g]);
        const float ar = p.a_re[pi], ai = p.a_im[pi];
        const float mag = expf(ar * dt);
        const float lr = mag * cosf(ai * dt), li = mag * sinf(ai * dt);
        const float den = ar * ar + ai * ai, nr = lr - 1.0f, ni = li;
        const float zr = (nr * ar + ni * ai) / den, zi = (ni * ar - nr * ai) / den;
        float* lam = (float*)(p.ws + OFF_LAM) + pi * 2;
        lam[0] = lr; lam[1] = li;
        float* bb = (float*)(p.ws + OFF_BB) + (size_t)pi * 32;
        for (int i = 0; i < SSC; ++i) {
            const float br = p.b_re[pi * SSC + i], bi = p.b_im[pi * SSC + i];
            bb[i * 2] = zr * br - zi * bi; bb[i * 2 + 1] = zr * bi + zi * br;
        }
    }
}
DI void prep_transpose_tile(const float* __restrict__ W, bf16_t* __restrict__ Wt, int K, int N, int kt, int nt, char* smem) {
    float* tile = (float*)smem;
    const int tid = my_tid();
#pragma unroll
    for (int q = 0; q < 2; ++q) {
        const int kk = (tid >> 4) + q * 32, c4 = (tid & 15) * 4;
        const float4 v = *(const float4*)(W + (size_t)(kt * 64 + kk) * N + nt * 64 + c4);
        tile[kk * 65 + c4] = v.x; tile[kk * 65 + c4 + 1] = v.y; tile[kk * 65 + c4 + 2] = v.z; tile[kk * 65 + c4 + 3] = v.w;
    }
    __syncthreads();
    const int n = tid >> 3, kc = tid & 7;
    uint4 o;
    o.x = pack2(tile[(kc * 8 + 0) * 65 + n], tile[(kc * 8 + 1) * 65 + n]);
    o.y = pack2(tile[(kc * 8 + 2) * 65 + n], tile[(kc * 8 + 3) * 65 + n]);
    o.z = pack2(tile[(kc * 8 + 4) * 65 + n], tile[(kc * 8 + 5) * 65 + n]);
    o.w = pack2(tile[(kc * 8 + 6) * 65 + n], tile[(kc * 8 + 7) * 65 + n]);
    *(uint4*)(Wt + (size_t)(nt * 64 + n) * K + kt * 64 + kc * 8) = o;
    __syncthreads();
}
DI void cvt_bf16_stream(const float* __restrict__ src, bf16_t* __restrict__ dst, size_t n8, int bid, int nb) {
    for (size_t i = (size_t)bid * NTH + my_tid(); i < n8; i += (size_t)nb * NTH) {
        const float4 a = *(const float4*)(src + i * 8), b = *(const float4*)(src + i * 8 + 4);
        uint4 o; o.x = pack2(a.x, a.y); o.y = pack2(a.z, a.w); o.z = pack2(b.x, b.y); o.w = pack2(b.z, b.w);
        *(uint4*)(dst + i * 8) = o;
    }
}
DI void cvt_fp8_rows(const float* __restrict__ src, unsigned char* __restrict__ dst, float* __restrict__ inv, int bid, int nb) {
    const int lane = my_tid() & 63, wid = my_tid() >> 6;
    for (int row = bid * 8 + wid; row < NEXP; row += nb * 8) {
        const float* sp = src + (size_t)row * DM + lane * 16;
        const f32x4 a = *(const f32x4*)sp, b = *(const f32x4*)(sp + 4), c = *(const f32x4*)(sp + 8), d = *(const f32x4*)(sp + 12);
        float m = fmaxf(fmaxf(fmaxf(fabsf(a.x), fabsf(a.y)), fmaxf(fabsf(a.z), fabsf(a.w))), fmaxf(fmaxf(fabsf(b.x), fabsf(b.y)), fmaxf(fabsf(b.z), fabsf(b.w))));
        m = fmaxf(m, fmaxf(fmaxf(fmaxf(fabsf(c.x), fabsf(c.y)), fmaxf(fabsf(c.z), fabsf(c.w))), fmaxf(fmaxf(fabsf(d.x), fabsf(d.y)), fmaxf(fabsf(d.z), fabsf(d.w)))));
#pragma unroll
        for (int s = 1; s < 64; s <<= 1) m = fmaxf(m, __shfl_xor(m, s));
        float sc = 1.f, isc = 1.f;
        if (m > 1e-30f) {
            int k = (int)floorf(log2f(448.0f / m));
            k = k < -60 ? -60 : (k > 60 ? 60 : k);
            sc = ldexpf(1.0f, k); isc = ldexpf(1.0f, -k);
            if (m * sc > 448.0f) { sc *= 0.5f; isc *= 2.0f; }
        }
        u32x4 o;
        int w;
        w = __builtin_amdgcn_cvt_pk_fp8_f32(a.x * sc, a.y * sc, 0, false); w = __builtin_amdgcn_cvt_pk_fp8_f32(a.z * sc, a.w * sc, w, true); o.x = (unsigned)w;
        w = __builtin_amdgcn_cvt_pk_fp8_f32(b.x * sc, b.y * sc, 0, false); w = __builtin_amdgcn_cvt_pk_fp8_f32(b.z * sc, b.w * sc, w, true); o.y = (unsigned)w;
        w = __builtin_amdgcn_cvt_pk_fp8_f32(c.x * sc, c.y * sc, 0, false); w = __builtin_amdgcn_cvt_pk_fp8_f32(c.z * sc, c.w * sc, w, true); o.z = (unsigned)w;
        w = __builtin_amdgcn_cvt_pk_fp8_f32(d.x * sc, d.y * sc, 0, false); w = __builtin_amdgcn_cvt_pk_fp8_f32(d.z * sc, d.w * sc, w, true); o.w = (unsigned)w;
        *(u32x4*)(dst + (size_t)row * DM + lane * 16) = o;
        if (lane == 0) inv[row] = isc;
    }
}
DI void cvt_fp4_rows(const float* __restrict__ src, unsigned char* __restrict__ dst, float* __restrict__ inv, int bid, int nb) {
    const int lane = my_tid() & 63, wid = my_tid() >> 6;
    for (int row = bid * 8 + wid; row < NEXP; row += nb * 8) {
        const float* sp = src + (size_t)row * DM + lane * 16;
        const f32x4 a = *(const f32x4*)sp, b = *(const f32x4*)(sp + 4), c = *(const f32x4*)(sp + 8), d = *(const f32x4*)(sp + 12);
        float m = fmaxf(fmaxf(fmaxf(fabsf(a.x), fabsf(a.y)), fmaxf(fabsf(a.z), fabsf(a.w))), fmaxf(fmaxf(fabsf(b.x), fabsf(b.y)), fmaxf(fabsf(b.z), fabsf(b.w))));
        m = fmaxf(m, fmaxf(fmaxf(fmaxf(fabsf(c.x), fabsf(c.y)), fmaxf(fabsf(c.z), fabsf(c.w))), fmaxf(fmaxf(fabsf(d.x), fabsf(d.y)), fmaxf(fabsf(d.z), fabsf(d.w)))));
#pragma unroll
        for (int s = 1; s < 64; s <<= 1) m = fmaxf(m, __shfl_xor(m, s));
        const float sc = m > 1e-30f ? 6.0f / m : 1.0f, isc = m > 1e-30f ? m * (1.0f / 6.0f) : 1.0f;
        unsigned w0 = 0u, w1 = 0u;
        w0 = __builtin_amdgcn_cvt_scalef32_pk_fp4_f32(w0, a.x * sc, a.y * sc, 1.0f, 0); w0 = __builtin_amdgcn_cvt_scalef32_pk_fp4_f32(w0, a.z * sc, a.w * sc, 1.0f, 1);
        w0 = __builtin_amdgcn_cvt_scalef32_pk_fp4_f32(w0, b.x * sc, b.y * sc, 1.0f, 2); w0 = __builtin_amdgcn_cvt_scalef32_pk_fp4_f32(w0, b.z * sc, b.w * sc, 1.0f, 3);
        w1 = __builtin_amdgcn_cvt_scalef32_pk_fp4_f32(w1, c.x * sc, c.y * sc, 1.0f, 0); w1 = __builtin_amdgcn_cvt_scalef32_pk_fp4_f32(w1, c.z * sc, c.w * sc, 1.0f, 1);
        w1 = __builtin_amdgcn_cvt_scalef32_pk_fp4_f32(w1, d.x * sc, d.y * sc, 1.0f, 2); w1 = __builtin_amdgcn_cvt_scalef32_pk_fp4_f32(w1, d.z * sc, d.w * sc, 1.0f, 3);
        *(uint2*)(dst + (size_t)row * (DM / 2) + lane * 8) = make_uint2(w0, w1);
        if (lane == 0) inv[row] = isc;
    }
}
template <int OFFS>
DI void cvt_i8_rows(const float* __restrict__ src, unsigned char* __restrict__ dst, float* __restrict__ inv, int bid, int nb) {
    const int lane = my_tid() & 63, wid = my_tid() >> 6;
    for (int row = bid * 8 + wid; row < NEXP; row += nb * 8) {
        const float* sp = src + (size_t)row * DM + lane * 16;
        const f32x4 a = *(const f32x4*)sp, b = *(const f32x4*)(sp + 4), c = *(const f32x4*)(sp + 8), d = *(const f32x4*)(sp + 12);
        float m = fmaxf(fmaxf(fmaxf(fabsf(a.x), fabsf(a.y)), fmaxf(fabsf(a.z), fabsf(a.w))), fmaxf(fmaxf(fabsf(b.x), fabsf(b.y)), fmaxf(fabsf(b.z), fabsf(b.w))));
        m = fmaxf(m, fmaxf(fmaxf(fmaxf(fabsf(c.x), fabsf(c.y)), fmaxf(fabsf(c.z), fabsf(c.w))), fmaxf(fmaxf(fabsf(d.x), fabsf(d.y)), fmaxf(fabsf(d.z), fabsf(d.w)))));
#pragma unroll
        for (int s = 1; s < 64; s <<= 1) m = fmaxf(m, __shfl_xor(m, s));
        const float sc = m > 1e-30f ? 127.0f / m : 1.0f, isc = m > 1e-30f ? m * (1.0f / 127.0f) : 1.0f;
        const float v[16] = {a.x, a.y, a.z, a.w, b.x, b.y, b.z, b.w, c.x, c.y, c.z, c.w, d.x, d.y, d.z, d.w};
        unsigned w[4];
#pragma unroll
        for (int q = 0; q < 4; ++q) {
            unsigned pk = 0u;
#pragma unroll
            for (int e = 0; e < 4; ++e) { const int qi = (int)rintf(v[q * 4 + e] * sc) + OFFS; pk |= ((unsigned)qi & 0xffu) << (8 * e); }
            w[q] = pk;
        }
        *(u32x4*)(dst + (size_t)row * DM + lane * 16) = (u32x4){w[0], w[1], w[2], w[3]};
        if (lane == 0) inv[row] = isc;
    }
}
DI void phase_prep(const Params& p, int bid, int nb, char* smem) {
    constexpr int N_MOD = 192, N_LB = 1, N_S5 = 32, T_WIN = 16 * 40, T_GLU = 8 * 8, T_WOUT = 16 * 16, T_WQ = 16 * 32;
    constexpr int I_LB = N_MOD, I_S5 = I_LB + N_LB, I_WIN = I_S5 + N_S5, I_GLU = I_WIN + T_WIN, I_WOUT = I_GLU + T_GLU, I_WQ = I_WOUT + T_WOUT, I_END = I_WQ + T_WQ;
    for (int it = bid; it < I_END; it += nb) {
        if (it < N_MOD) prep_mod_item(p, it, smem);
        else if (it < I_S5) {
            const int j = my_tid();
            const float a0 = p.hg_lb[j], a1 = p.hg_lb[512 + j], m = fmaxf(a0, a1);
            const float e0 = expf(a0 - m), e1 = expf(a1 - m);
            ((float*)(p.ws + OFF_LB))[j] = e0 / (e0 + e1);
        } else if (it < I_WIN) { prep_s5_item(p, it - I_S5); prep_s5_gemm_item(p, it - I_S5, smem); }
        else if (it < I_GLU) { const int t = it - I_WIN; prep_transpose_tile(p.w_in, (bf16_t*)(p.ws + OFF_WIN), DM, INC, t / 40, t % 40, smem); }
        else if (it < I_WOUT) { const int t = it - I_GLU; prep_transpose_tile(p.glu_w, (bf16_t*)(p.ws + OFF_GLU), 512, 512, t / 8, t % 8, smem); }
        else if (it < I_WQ) { const int t = it - I_WOUT; prep_transpose_tile(p.w_out, (bf16_t*)(p.ws + OFF_WOUT), DM, DM, t / 16, t % 16, smem); }
        else { const int t = it - I_WQ; prep_transpose_tile(p.w_q, (bf16_t*)(p.ws + OFF_WQ), DM, 2048, t / 32, t % 32, smem); }
    }
    cvt_bf16_stream(p.subk, (bf16_t*)(p.ws + OFF_SUBK), (size_t)16 * 128 * 128 / 8, bid, nb);
    cvt_i8_rows<0>(p.pu, (unsigned char*)(p.ws + OFF_UT), (float*)(p.ws + OFF_SU), bid, nb);
    cvt_i8_rows<128>(p.pv, (unsigned char*)(p.ws + OFF_VT), (float*)(p.ws + OFF_SV), bid, nb);
}

DI void phase_h(const Params& p, int bid, int nb) {
    const float* mod = (const float*)(p.ws + OFF_MOD);
    bf16_t* H = (bf16_t*)(p.ws + OFF_H);
    const size_t n8 = (size_t)NTOK * DM / 8;
    for (size_t i = (size_t)bid * NTH + my_tid(); i < n8; i += (size_t)nb * NTH) {
        const int row = (int)(i >> 7), c0 = (int)(i & 127) * 8, b = row / SEQ;
        const float* sh = mod + b * 6144 + c0;
        const float* sc = sh + 1024;
        const float4 a = *(const float4*)(p.x + i * 8), bq = *(const float4*)(p.x + i * 8 + 4);
        const float4 s0 = *(const float4*)sc, s1 = *(const float4*)(sc + 4), h0 = *(const float4*)sh, h1 = *(const float4*)(sh + 4);
        uint4 o;
        o.x = pack2(a.x * (1.f + s0.x) + h0.x, a.y * (1.f + s0.y) + h0.y);
        o.y = pack2(a.z * (1.f + s0.z) + h0.z, a.w * (1.f + s0.w) + h0.w);
        o.z = pack2(bq.x * (1.f + s1.x) + h1.x, bq.y * (1.f + s1.y) + h1.y);
        o.w = pack2(bq.z * (1.f + s1.z) + h1.z, bq.w * (1.f + s1.w) + h1.w);
        *(uint4*)(H + i * 8) = o;
    }
}

DI void phase_proj(const Params& p, int bid, int nb, char* smem) {
    pg8::Gemm g{(const bf16_t*)(p.ws + OFF_H), (const bf16_t*)(p.ws + OFF_WIN), NTOK, INC, DM};
    pg8::StaticOrder S; S.init(NTOK, INC, nb, bid);
    pg8::EpiBf16Act E{(bf16_t*)(p.ws + OFF_PROJ), INC, 0xC3u};
    pg8::gemm_phase<pg8::EpiBf16Act, pg8::StaticOrder, false>((PG8_LAS unsigned char*)smem, g, S, E, nullptr);
}

DI void hgrn_item(const Params& p, int item, char* smem) {
    const int vs = item & 7, hd = (item >> 3) & 3, b = item >> 5;
    const bf16_t* P = (const bf16_t*)(p.ws + OFF_PROJ);
    const float* lb = (const float*)(p.ws + OFF_LB) + hd * HDK;
    float* ORAW = (float*)(p.ws + OFF_ORAW);
    float* sq = (float*)smem;
    float* sf = sq + 32 * 128;
    float* sv = sf + 32 * 128;
    float* sp = sv + 32 * 16;
    const int tid = my_tid(), lane = tid & 63, wid = tid >> 6, kq = tid >> 4, v = tid & 15;
    float S0 = 0.f, S1 = 0.f, S2 = 0.f, S3 = 0.f;
    for (int t0 = 0; t0 < SEQ; t0 += 32) {
        for (int i = tid; i < 32 * 128; i += NTH) {
            const int t = i >> 7, k = i & 127;
            const bf16_t* row = P + (size_t)(b * SEQ + t0 + t) * INC + hd * HDK + k;
            sq[i] = bf2f(row[0]);
            const float l = lb[k];
            sf[i] = l + (1.0f - l) * sigmoidf_(bf2f(row[512]));
        }
        { const int t = tid >> 4; sv[tid] = bf2f(P[(size_t)(b * SEQ + t0 + t) * INC + 1024 + hd * HDK + vs * 16 + v]); }
        __syncthreads();
        for (int t = 0; t < 32; ++t) {
            const float4 f4 = *(const float4*)(sf + t * 128 + kq * 4), q4 = *(const float4*)(sq + t * 128 + kq * 4);
            const float vv = sv[t * 16 + v];
            S0 = f4.x * S0 + (1.0f - f4.x) * vv; S1 = f4.y * S1 + (1.0f - f4.y) * vv;
            S2 = f4.z * S2 + (1.0f - f4.z) * vv; S3 = f4.w * S3 + (1.0f - f4.w) * vv;
            float part = q4.x * S0 + q4.y * S1 + q4.z * S2 + q4.w * S3;
            part += __shfl_xor(part, 16); part += __shfl_xor(part, 32);
            if (lane < 16) sp[(t * 8 + wid) * 16 + v] = part;
        }
        __syncthreads();
        {
            const int t = tid >> 4;
            float o = 0.f;
#pragma unroll
            for (int w = 0; w < 8; ++w) o += sp[(t * 8 + w) * 16 + v];
            ORAW[(size_t)(b * SEQ + t0 + t) * DHG + hd * HDK + vs * 16 + v] = o;
        }
        __syncthreads();
    }
}
DI void s5_item(const Params& p, int item, char* smem) {
    const int oct = item & 3, b = item >> 2;
    const int tid = my_tid(), lane = tid & 63, wid = tid >> 6, g = oct * 8 + wid;
    const bf16_t* P = (const bf16_t*)(p.ws + OFF_PROJ);
    bf16_t* Y = (bf16_t*)(p.ws + OFF_YSSM);
    float* su = (float*)smem + wid * 64 * 16;
    const float* lam = (const float*)(p.ws + OFF_LAM) + (g * SSP + lane) * 2;
    const float lr = lam[0], li = lam[1];
    const float* bb = (const float*)(p.ws + OFF_BB) + (size_t)(g * SSP + lane) * 32;
    float bbr[16], bbi[16], cr[16], ci[16];
#pragma unroll
    for (int i = 0; i < 16; ++i) { bbr[i] = bb[2 * i]; bbi[i] = bb[2 * i + 1]; cr[i] = p.c_re[(g * SSC + i) * SSP + lane]; ci[i] = p.c_im[(g * SSC + i) * SSP + lane]; }
    const int ch = (lane >> 2) & 15;
    const float dch = p.dsk[g * SSC + ch];
    float xr = 0.f, xi = 0.f;
    for (int t0 = 0; t0 < SEQ; t0 += 64) {
        {
            const uint4* src = (const uint4*)(P + (size_t)(b * SEQ + t0 + lane) * INC + 2048 + g * SSC);
            const uint4 a = src[0], c = src[1];
            float* d = su + lane * 16;
            d[0] = bflo(a.x); d[1] = bfhi(a.x); d[2] = bflo(a.y); d[3] = bfhi(a.y); d[4] = bflo(a.z); d[5] = bfhi(a.z); d[6] = bflo(a.w); d[7] = bfhi(a.w);
            d[8] = bflo(c.x); d[9] = bfhi(c.x); d[10] = bflo(c.y); d[11] = bfhi(c.y); d[12] = bflo(c.z); d[13] = bfhi(c.z); d[14] = bflo(c.w); d[15] = bfhi(c.w);
        }
        __syncthreads();
        for (int t = 0; t < 64; ++t) {
            float u[16];
            const float4* us = (const float4*)(su + t * 16);
            const float4 u0 = us[0], u1 = us[1], u2 = us[2], u3 = us[3];
            u[0] = u0.x; u[1] = u0.y; u[2] = u0.z; u[3] = u0.w; u[4] = u1.x; u[5] = u1.y; u[6] = u1.z; u[7] = u1.w;
            u[8] = u2.x; u[9] = u2.y; u[10] = u2.z; u[11] = u2.w; u[12] = u3.x; u[13] = u3.y; u[14] = u3.z; u[15] = u3.w;
            float bur = 0.f, bui = 0.f;
#pragma unroll
            for (int i = 0; i < 16; ++i) { bur += bbr[i] * u[i]; bui += bbi[i] * u[i]; }
            const float nxr = lr * xr - li * xi + bur, nxi = lr * xi + li * xr + bui;
            xr = nxr; xi = nxi;
            float y[16];
#pragma unroll
            for (int i = 0; i < 16; ++i) y[i] = cr[i] * xr - ci[i] * xi;
            const bool b5 = lane & 32, b4 = lane & 16, b3 = lane & 8, b2 = lane & 4;
            float y8[8], y4[4], y2[2];
#pragma unroll
            for (int j = 0; j < 8; ++j) { const float keep = b5 ? y[8 + j] : y[j], send = b5 ? y[j] : y[8 + j]; y8[j] = keep + __shfl_xor(send, 32); }
#pragma unroll
            for (int j = 0; j < 4; ++j) { const float keep = b4 ? y8[4 + j] : y8[j], send = b4 ? y8[j] : y8[4 + j]; y4[j] = keep + __shfl_xor(send, 16); }
#pragma unroll
            for (int j = 0; j < 2; ++j) { const float keep = b3 ? y4[2 + j] : y4[j], send = b3 ? y4[j] : y4[2 + j]; y2[j] = keep + __shfl_xor(send, 8); }
            float y1;
            { const float keep = b2 ? y2[1] : y2[0], send = b2 ? y2[0] : y2[1]; y1 = keep + __shfl_xor(send, 4); }
            y1 += __shfl_xor(y1, 1); y1 += __shfl_xor(y1, 2);
            if ((lane & 3) == 0) {
                const float uu = su[t * 16 + ch];
                Y[(size_t)(b * SEQ + t0 + t) * DSS + g * SSC + ch] = f2bf(geluf_(y1 + dch * uu));
            }
        }
        __syncthreads();
    }
}
DI int crow(int i, int h) { return (i & 3) + 8 * (i >> 2) + 4 * h; }
DI void phase_hgprep(const Params& p, int bid, int nb) {
    const bf16_t* P = (const bf16_t*)(p.ws + OFF_PROJ);
    const float* lbp = (const float*)(p.ws + OFF_LB);
    const int tid = my_tid(), lane = tid & 63, wid = tid >> 6, tq = lane >> 4, cg = lane & 15;
#pragma unroll 1
    for (int it = bid * 8 + wid; it < 8192; it += nb * 8) {
        const int tile = it >> 1, c = tile & 63, hd = (tile >> 6) & 3, b = tile >> 8, k0 = (it & 1) * 64 + cg * 4;
        const bf16_t* base = P + (size_t)(b * SEQ + c * 32 + tq * 8) * INC + hd * HDK + k0;
        uint2 qw[8], fw[8];
#pragma unroll
        for (int tt = 0; tt < 8; ++tt) { qw[tt] = *(const uint2*)(base + (size_t)tt * INC); fw[tt] = *(const uint2*)(base + (size_t)tt * INC + 512); }
        const f32x4 l4 = *(const f32x4*)(lbp + hd * HDK + k0);
        const float lb4[4] = {l4.x, l4.y, l4.z, l4.w};
        float bl[8][4], kk[8][4], run[4];
#pragma unroll
        for (int e = 0; e < 4; ++e) run[e] = 0.f;
#pragma unroll
        for (int tt = 0; tt < 8; ++tt) {
            const float fl[4] = {bflo(fw[tt].x), bfhi(fw[tt].x), bflo(fw[tt].y), bfhi(fw[tt].y)};
#pragma unroll
            for (int e = 0; e < 4; ++e) {
                const float f = lb4[e] + (1.0f - lb4[e]) * sigmoidf_(fl[e]);
                run[e] += __logf(f); bl[tt][e] = run[e]; kk[tt][e] = 1.0f - f;
            }
        }
        float off[4], tot[4];
#pragma unroll
        for (int e = 0; e < 4; ++e) {
            const float t0 = __shfl(run[e], cg), t1 = __shfl(run[e], cg + 16), t2 = __shfl(run[e], cg + 32), t3 = __shfl(run[e], cg + 48);
            off[e] = (tq > 0 ? t0 : 0.f) + (tq > 1 ? t1 : 0.f) + (tq > 2 ? t2 : 0.f);
            tot[e] = (t0 + t1) + (t2 + t3);
        }
        bf16_t* HQ = (bf16_t*)(p.ws + OFF_HQ) + (size_t)tile * 4096 + (tq * 8) * 128 + k0;
        bf16_t* HK = (bf16_t*)(p.ws + OFF_HK) + (size_t)tile * 4096 + (tq * 8) * 128 + k0;
#pragma unroll
        for (int tt = 0; tt < 8; ++tt) {
            const float qv[4] = {bflo(qw[tt].x), bfhi(qw[tt].x), bflo(qw[tt].y), bfhi(qw[tt].y)};
            float qo[4], ko[4];
#pragma unroll
            for (int e = 0; e < 4; ++e) { const float bb = off[e] + bl[tt][e]; qo[e] = qv[e] * __expf(bb); ko[e] = kk[tt][e] * __expf(fminf(-bb, 80.0f)); }
            *(uint2*)(HQ + tt * 128) = make_uint2(pack2(qo[0], qo[1]), pack2(qo[2], qo[3]));
            *(uint2*)(HK + tt * 128) = make_uint2(pack2(ko[0], ko[1]), pack2(ko[2], ko[3]));
        }
        if (tq == 0) *(f32x4*)((float*)(p.ws + OFF_HG) + (size_t)tile * 128 + k0) = (f32x4){__expf(tot[0]), __expf(tot[1]), __expf(tot[2]), __expf(tot[3])};
    }
}
typedef short s16x4 __attribute__((ext_vector_type(4)));
DI bf16x8 cat8(const s16x4 lo, const s16x4 hi) { return (bf16x8){lo.x, lo.y, lo.z, lo.w, hi.x, hi.y, hi.z, hi.w}; }
DI s16x4 lds_tr(const char* a) { return __builtin_amdgcn_ds_read_tr16_b64_v4i16((__attribute__((address_space(3))) s16x4*)a); }
DI void hgrn_mfma_item(const Params& p, int item, char* smem) {
    constexpr int QP_OFF = 0, KP_OFF = 8704, V_OFF = 17408, G_OFF = 26112, BUF = 26624;
    const int tid = my_tid(), lane = tid & 63, wid = tid >> 6, r = lane & 31, h = lane >> 5;
    const int b = item >> 2, hd = item & 3;
    const size_t tile0 = (size_t)item * 64;
    const bf16_t* HQ = (const bf16_t*)(p.ws + OFF_HQ) + tile0 * 4096;
    const bf16_t* HK = (const bf16_t*)(p.ws + OFF_HK) + tile0 * 4096;
    const bf16_t* PV = (const bf16_t*)(p.ws + OFF_PROJ) + (size_t)b * SEQ * INC + 1024 + hd * HDK;
    const float* HG = (const float*)(p.ws + OFF_HG) + tile0 * 128;
    float* ORAW = (float*)(p.ws + OFF_ORAW) + (size_t)b * SEQ * DHG + hd * HDK;
    const bool helper = wid >= 4;
    const int ht = tid - 256;
    const int i0 = ht, i1 = ht + 256;
    const int lo0 = (i0 >> 4) * 272 + (i0 & 15) * 16, lo1 = (i1 >> 4) * 272 + (i1 & 15) * 16;
    u32x4 A0, A1, A2, A3, A4, A5, A6, B0, B1, B2, B3, B4, B5, B6;
    A0 = A1 = A2 = A3 = A4 = A5 = A6 = B0 = B1 = B2 = B3 = B4 = B5 = B6 = (u32x4){0, 0, 0, 0};
    f32x16 S[4];
#pragma unroll
    for (int kb = 0; kb < 4; ++kb)
#pragma unroll
        for (int i = 0; i < 16; ++i) S[kb][i] = 0.f;
#define HG_LOAD(X, c_) { const size_t o_ = (size_t)(c_) * 4096; \
        X##0 = *(const u32x4*)(HQ + o_ + i0 * 8); X##1 = *(const u32x4*)(HQ + o_ + i1 * 8); \
        X##2 = *(const u32x4*)(HK + o_ + i0 * 8); X##3 = *(const u32x4*)(HK + o_ + i1 * 8); \
        X##4 = *(const u32x4*)(PV + (size_t)((c_) * 32 + (i0 >> 4)) * INC + (i0 & 15) * 8); X##5 = *(const u32x4*)(PV + (size_t)((c_) * 32 + (i1 >> 4)) * INC + (i1 & 15) * 8); \
        if (ht < 32) X##6 = *(const u32x4*)(HG + (size_t)(c_) * 128 + ht * 4); }
#define HG_STORE(X, buf_) { char* B_ = smem + (buf_) * BUF; \
        *(u32x4*)(B_ + QP_OFF + lo0) = X##0; *(u32x4*)(B_ + QP_OFF + lo1) = X##1; \
        *(u32x4*)(B_ + KP_OFF + lo0) = X##2; *(u32x4*)(B_ + KP_OFF + lo1) = X##3; \
        *(u32x4*)(B_ + V_OFF + lo0) = X##4; *(u32x4*)(B_ + V_OFF + lo1) = X##5; \
        if (ht < 32) *(u32x4*)(B_ + G_OFF + ht * 16) = X##6; }
    const int tq = (lane >> 2) & 3, tp = lane & 3, tg = lane >> 4;
    const int tr_nat = (8 * (tg >> 1) + tq) * 272 + (16 * (tg & 1) + 4 * tp) * 2;
    const int tr_krw = (4 * (tg >> 1) + tq) * 272 + (16 * (tg & 1) + 4 * tp) * 2;
    if (helper) { HG_LOAD(A, 0); HG_STORE(A, 0); HG_LOAD(A, 1); HG_STORE(A, 1); HG_LOAD(A, 2); HG_LOAD(B, 3); }
    __syncthreads();
#define HG_COMPUTE(c_) { \
        const char* B = smem + ((c_) % 3) * BUF; const int w = wid; \
        f32x16 pt; _Pragma("unroll") for (int i = 0; i < 16; ++i) pt[i] = 0.f; \
        _Pragma("unroll") for (int ks = 0; ks < 8; ++ks) { \
            const bf16x8 a = *(const bf16x8*)(B + KP_OFF + r * 272 + ks * 32 + h * 16); \
            const bf16x8 bq = *(const bf16x8*)(B + QP_OFF + r * 272 + ks * 32 + h * 16); \
            pt = __builtin_amdgcn_mfma_f32_32x32x16_bf16(a, bq, pt, 0, 0, 0); } \
        _Pragma("unroll") for (int i = 0; i < 16; ++i) if (crow(i, h) > r) pt[i] = 0.f; \
        f32x16 o; _Pragma("unroll") for (int i = 0; i < 16; ++i) o[i] = 0.f; \
        _Pragma("unroll") for (int sp = 0; sp < 2; ++sp) { \
            const char* vb = B + V_OFF + (16 * sp) * 272 + (32 * w) * 2 + tr_krw; \
            const bf16x8 bv = cat8(lds_tr(vb), lds_tr(vb + 8 * 272)); \
            o = __builtin_amdgcn_mfma_f32_32x32x16_bf16(pack8(pt, 8 * sp), bv, o, 0, 0, 0); } \
        _Pragma("unroll") for (int kb = 0; kb < 4; ++kb) _Pragma("unroll") for (int sp = 0; sp < 2; ++sp) { \
            const char* qb = B + QP_OFF + r * 272 + kb * 64 + sp * 32 + h * 8; \
            const bf16x8 aq = cat8(*(const s16x4*)qb, *(const s16x4*)(qb + 16)); \
            o = __builtin_amdgcn_mfma_f32_32x32x16_bf16(aq, pack8(S[kb], 8 * sp), o, 0, 0, 0); } \
        _Pragma("unroll") for (int i = 0; i < 16; ++i) ORAW[(size_t)((c_) * 32 + crow(i, h)) * DHG + 32 * w + r] = o[i]; \
        bf16x8 bvn[2]; \
        _Pragma("unroll") for (int ks = 0; ks < 2; ++ks) { const char* vb = B + V_OFF + (16 * ks) * 272 + (32 * w) * 2 + tr_nat; bvn[ks] = cat8(lds_tr(vb), lds_tr(vb + 4 * 272)); } \
        _Pragma("unroll") for (int kb = 0; kb < 4; ++kb) { \
            _Pragma("unroll") for (int ks = 0; ks < 2; ++ks) { \
                const char* kp = B + KP_OFF + (16 * ks) * 272 + (32 * kb) * 2 + tr_nat; \
                const bf16x8 a = cat8(lds_tr(kp), lds_tr(kp + 4 * 272)); \
                S[kb] = __builtin_amdgcn_mfma_f32_32x32x16_bf16(a, bvn[ks], S[kb], 0, 0, 0); } \
            _Pragma("unroll") for (int j = 0; j < 4; ++j) { \
                const f32x4 g4 = *(const f32x4*)(B + G_OFF + (kb * 32 + 8 * j + 4 * h) * 4); \
                S[kb][4 * j] *= g4.x; S[kb][4 * j + 1] *= g4.y; S[kb][4 * j + 2] *= g4.z; S[kb][4 * j + 3] *= g4.w; } } }
    for (int c = 0; c < 64; c += 2) {
        if (helper) { if (c + 2 < 64) HG_STORE(A, (c + 2) % 3); if (c + 4 < 64) HG_LOAD(A, c + 4); } else HG_COMPUTE(c);
        __syncthreads();
        if (helper) { if (c + 3 < 64) HG_STORE(B, (c + 3) % 3); if (c + 5 < 64) HG_LOAD(B, c + 5); } else HG_COMPUTE(c + 1);
        __syncthreads();
    }
#undef HG_LOAD
#undef HG_STORE
#undef HG_COMPUTE
}
template <int NJ>
DI void s5_gemm2_tile(const bf16x8 (&af)[16], const bf16_t* KTl, const bf16_t* Xin, const bf16_t* MBg, bf16_t* Yout, bf16_t* stg, const int mi, const int r, const int h) {
    f32x16 y;
#pragma unroll
    for (int i = 0; i < 16; ++i) y[i] = 0.f;
    const int tsel = r >> 4, iq = r & 15;
    bf16x8 bm[8];
#pragma unroll
    for (int ks = 0; ks < 8; ++ks) bm[ks] = *(const bf16x8*)(MBg + (size_t)((NJ * 8 + ks) * 64 + h * 32 + r) * 8);
#pragma unroll
    for (int ks = 0; ks <= 2 * NJ; ++ks) {
        const bf16x8 bk = *(const bf16x8*)(KTl + ((2 * NJ + tsel - ks) * 16 + iq) * 16 + 8 * h);
        y = __builtin_amdgcn_mfma_f32_32x32x16_bf16(af[ks], bk, y, 0, 0, 0);
    }
    {
        bf16x8 bk = *(const bf16x8*)(KTl + iq * 16 + 8 * h);
        if (tsel == 0) bk = (bf16x8){0, 0, 0, 0, 0, 0, 0, 0};
        y = __builtin_amdgcn_mfma_f32_32x32x16_bf16(af[2 * NJ + 1], bk, y, 0, 0, 0);
    }
#pragma unroll
    for (int ks = 0; ks < 8; ++ks) {
        const bf16x8 a = *(const bf16x8*)(Xin + (mi * 32 + r) * 136 + ks * 16 + 8 * h);
        y = __builtin_amdgcn_mfma_f32_32x32x16_bf16(a, bm[ks], y, 0, 0, 0);
    }
#pragma unroll
    for (int i = 0; i < 16; ++i) stg[((crow(i, h) * 2 + tsel) * 16) + iq] = f2bf(gelu_as(y[i]));
    {
        const int lane = h * 32 + r, cl = lane >> 1, ts = lane & 1;
        const u32x4 lo = *(const u32x4*)(stg + lane * 16), hi = *(const u32x4*)(stg + lane * 16 + 8);
        bf16_t* dst = Yout + (size_t)((mi * 32 + cl) * 16 + 2 * NJ + ts) * DSS;
        *(u32x4*)dst = lo; *(u32x4*)(dst + 8) = hi;
    }
}
DI void s5_gemm_item(const Params& p, int b, int g, char* smem) {
    float* E = (float*)smem;
    bf16_t* Xin = (bf16_t*)(smem + 128 * 132 * 4);
    bf16_t* KTl = Xin + 128 * 136;
    const int tid = my_tid(), lane = tid & 63, wid = tid >> 6, r = lane & 31, h = lane >> 5;
    const int mi = wid >> 1, wh = wid & 1;
    const bf16_t* P = (const bf16_t*)(p.ws + OFF_PROJ);
    *(u32x4*)(KTl + tid * 8) = *(const u32x4*)((const bf16_t*)(p.ws + OFF_S5K) + (size_t)g * 4096 + tid * 8);
    bf16x8 af[16];
    {
        const bf16_t* ub = P + (size_t)(b * SEQ + (mi * 32 + r) * 16) * INC + 2048 + g * 16 + 8 * h;
#pragma unroll
        for (int ks = 0; ks < 16; ++ks) af[ks] = *(const bf16x8*)(ub + (size_t)ks * INC);
    }
#ifndef S5_REP_G1
#define S5_REP_G1 1
#define S5_REP_SC 1
#define S5_REP_G2 1
#endif
    for (int rp1 = 0; rp1 < S5_REP_G1; ++rp1)
    {
        f32x16 e0, e1;
#pragma unroll
        for (int i = 0; i < 16; ++i) { e0[i] = 0.f; e1[i] = 0.f; }
        const bf16_t* nb0 = (const bf16_t*)(p.ws + OFF_S5N) + (size_t)g * 128 * 256 + (size_t)(wh * 2) * 16 * 512 + lane * 8;
#pragma unroll
        for (int ks = 0; ks < 16; ++ks) {
            const bf16x8 b0 = *(const bf16x8*)(nb0 + ks * 512), b1 = *(const bf16x8*)(nb0 + 16 * 512 + ks * 512);
            e0 = __builtin_amdgcn_mfma_f32_32x32x16_bf16(af[ks], b0, e0, 0, 0, 0);
            e1 = __builtin_amdgcn_mfma_f32_32x32x16_bf16(af[ks], b1, e1, 0, 0, 0);
        }
#pragma unroll
        for (int i = 0; i < 16; ++i) { float* er = E + (mi * 32 + crow(i, h)) * 132 + wh * 64 + r; er[0] = e0[i]; er[32] = e1[i]; }
    }
    __syncthreads();
    for (int rp2 = 0; rp2 < S5_REP_SC; ++rp2)
    if (wid == 0) {
        const float* L = (const float*)(p.ws + OFF_S5L) + (g * 64 + lane) * 2;
        const float lr = L[0], li = L[1];
        float xr = 0.f, xi = 0.f;
#pragma unroll 8
        for (int c = 0; c < 128; ++c) {
            const float er = E[c * 132 + lane], ei = E[c * 132 + 64 + lane];
            Xin[c * 136 + lane] = f2bf(xr); Xin[c * 136 + 64 + lane] = f2bf(xi);
            const float nr = lr * xr - li * xi + er, ni = lr * xi + li * xr + ei;
            xr = nr; xi = ni;
        }
    }
    __syncthreads();
    const bf16_t* MBg = (const bf16_t*)(p.ws + OFF_S5M) + (size_t)g * 256 * 128;
    bf16_t* Yout = (bf16_t*)(p.ws + OFF_YSSM) + (size_t)b * SEQ * DSS + g * 16;
    bf16_t* stg = (bf16_t*)smem + wid * 1024;
    for (int rp3 = 0; rp3 < S5_REP_G2; ++rp3)
    if (wh) {
        s5_gemm2_tile<1>(af, KTl, Xin, MBg, Yout, stg, mi, r, h); s5_gemm2_tile<6>(af, KTl, Xin, MBg, Yout, stg, mi, r, h);
        s5_gemm2_tile<3>(af, KTl, Xin, MBg, Yout, stg, mi, r, h); s5_gemm2_tile<4>(af, KTl, Xin, MBg, Yout, stg, mi, r, h);
    } else {
        s5_gemm2_tile<0>(af, KTl, Xin, MBg, Yout, stg, mi, r, h); s5_gemm2_tile<7>(af, KTl, Xin, MBg, Yout, stg, mi, r, h);
        s5_gemm2_tile<2>(af, KTl, Xin, MBg, Yout, stg, mi, r, h); s5_gemm2_tile<5>(af, KTl, Xin, MBg, Yout, stg, mi, r, h);
    }
    __syncthreads();
}
DI void phase_mix(const Params& p, int bid, int nb, char* smem) {
    if (nb == 256) {
#ifndef PROBE_HGX
#define PROBE_HGX 1
#endif
        if (bid < 64) { for (int rep = 0; rep < PROBE_HGX; ++rep) hgrn_mfma_item(p, bid, smem); return; }
        const int j = bid - 64, x = j & 7, lb = j >> 3;
#ifndef PROBE_S5X
#define PROBE_S5X 1
#endif
        for (int rep = 0; rep < PROBE_S5X; ++rep)
        for (int q = lb; q < 64; q += 24) s5_gemm_item(p, q & 15, x * 4 + (q >> 4), smem);
    } else {
        for (int it = bid; it < 64; it += nb) hgrn_mfma_item(p, it, smem);
        for (int q = bid; q < 512; q += nb) s5_gemm_item(p, q & 15, q >> 4, smem);
    }
}

DI void phase_glu(const Params& p, int bid, int nb, char* smem) {
    pg8::Gemm g{(const bf16_t*)(p.ws + OFF_YSSM), (const bf16_t*)(p.ws + OFF_GLU), NTOK, 512, 512};
    pg8::StaticOrder S; S.init(NTOK, 512, nb, bid);
    pg8::EpiGlu E{(float*)(p.ws + OFF_H), (const bf16_t*)(p.ws + OFF_YSSM), p.glu_b};
    pg8::gemm_phase<pg8::EpiGlu, pg8::StaticOrder, false>((PG8_LAS unsigned char*)smem, g, S, E, nullptr);
}
DI void phase_a2(const Params& p, int bid, int nb) {
    const float* ORAW = (const float*)(p.ws + OFF_ORAW);
    const float* Y2 = (const float*)(p.ws + OFF_H);
    const bf16_t* P = (const bf16_t*)(p.ws + OFF_PROJ);
    bf16_t* A2 = (bf16_t*)(p.ws + OFF_A2);
    const int lane = my_tid() & 63, wid = my_tid() >> 6;
    for (int tok = bid * 8 + wid; tok < NTOK; tok += nb * 8) {
        const int c0 = lane * 8;
        {
            const float4 a = *(const float4*)(ORAW + (size_t)tok * DHG + c0), b = *(const float4*)(ORAW + (size_t)tok * DHG + c0 + 4);
            float ss = a.x * a.x + a.y * a.y + a.z * a.z + a.w * a.w + b.x * b.x + b.y * b.y + b.z * b.z + b.w * b.w;
            ss += __shfl_xor(ss, 1); ss += __shfl_xor(ss, 2); ss += __shfl_xor(ss, 4); ss += __shfl_xor(ss, 8);
            const float rs = rsqrtf(ss * (1.0f / 128.0f) + RMS_EPS);
            const uint4 gq = *(const uint4*)(P + (size_t)tok * INC + 1536 + c0);
            const float4 w0 = *(const float4*)(p.hg_nw + c0), w1 = *(const float4*)(p.hg_nw + c0 + 4);
            uint4 o;
            o.x = pack2(a.x * rs * w0.x * bflo(gq.x), a.y * rs * w0.y * bfhi(gq.x));
            o.y = pack2(a.z * rs * w0.z * bflo(gq.y), a.w * rs * w0.w * bfhi(gq.y));
            o.z = pack2(b.x * rs * w1.x * bflo(gq.z), b.y * rs * w1.y * bfhi(gq.z));
            o.w = pack2(b.z * rs * w1.z * bflo(gq.w), b.w * rs * w1.w * bfhi(gq.w));
            *(uint4*)(A2 + (size_t)tok * DM + c0) = o;
        }
        {
            const float4 a = *(const float4*)(Y2 + (size_t)tok * DSS + c0), b = *(const float4*)(Y2 + (size_t)tok * DSS + c0 + 4);
            float ss = a.x * a.x + a.y * a.y + a.z * a.z + a.w * a.w + b.x * b.x + b.y * b.y + b.z * b.z + b.w * b.w;
#pragma unroll
            for (int m = 1; m < 64; m <<= 1) ss += __shfl_xor(ss, m);
            const float rs = rsqrtf(ss * (1.0f / 512.0f) + RMS_EPS);
            const float4 w0 = *(const float4*)(p.ssm_nw + c0), w1 = *(const float4*)(p.ssm_nw + c0 + 4);
            uint4 o;
            o.x = pack2(a.x * rs * w0.x, a.y * rs * w0.y); o.y = pack2(a.z * rs * w0.z, a.w * rs * w0.w);
            o.z = pack2(b.x * rs * w1.x, b.y * rs * w1.y); o.w = pack2(b.z * rs * w1.z, b.w * rs * w1.w);
            *(uint4*)(A2 + (size_t)tok * DM + 512 + c0) = o;
        }
    }
}

DI void phase_outproj(const Params& p, int bid, int nb, char* smem) {
    pg8::Gemm g{(const bf16_t*)(p.ws + OFF_A2), (const bf16_t*)(p.ws + OFF_WOUT), NTOK, DM, DM};
    pg8::StaticOrder S; S.init(NTOK, DM, nb, bid);
    pg8::EpiResid E{p.out, p.x, (const float*)(p.ws + OFF_MOD) + 2048, DEEP_ALPHA};
    pg8::gemm_phase<pg8::EpiResid, pg8::StaticOrder, false>((PG8_LAS unsigned char*)smem, g, S, E, nullptr);
}
DI void phase_ln1(const Params& p, int bid, int nb) {
    const float* mod = (const float*)(p.ws + OFF_MOD);
    bf16_t* H2 = (bf16_t*)(p.ws + OFF_H);
    const int lane = my_tid() & 63, wid = my_tid() >> 6;
    for (int tok = bid * 8 + wid; tok < NTOK; tok += nb * 8) {
        const int b = tok / SEQ;
        float* row = p.out + (size_t)tok * DM;
        float4 v[4];
        float s = 0.f;
#pragma unroll
        for (int j = 0; j < 4; ++j) { v[j] = *(const float4*)(row + j * 256 + lane * 4); s += v[j].x + v[j].y + v[j].z + v[j].w; }
#pragma unroll
        for (int m = 1; m < 64; m <<= 1) s += __shfl_xor(s, m);
        const float mu = s * (1.0f / 1024.0f);
        float q = 0.f;
#pragma unroll
        for (int j = 0; j < 4; ++j) { const float a = v[j].x - mu, bb = v[j].y - mu, cc = v[j].z - mu, d = v[j].w - mu; q += a * a + bb * bb + cc * cc + d * d; }
#pragma unroll
        for (int m = 1; m < 64; m <<= 1) q += __shfl_xor(q, m);
        const float rstd = rsqrtf(q * (1.0f / 1024.0f) + LN_EPS);
        const float* sh2 = mod + b * 6144 + 3072;
        const float* sc2 = mod + b * 6144 + 4096;
#pragma unroll
        for (int j = 0; j < 4; ++j) {
            const int c = j * 256 + lane * 4;
            const float4 w = *(const float4*)(p.ln1w + c), bi = *(const float4*)(p.ln1b + c), sc = *(const float4*)(sc2 + c), sh = *(const float4*)(sh2 + c);
            float4 o;
            o.x = (v[j].x - mu) * rstd * w.x + bi.x; o.y = (v[j].y - mu) * rstd * w.y + bi.y; o.z = (v[j].z - mu) * rstd * w.z + bi.z; o.w = (v[j].w - mu) * rstd * w.w + bi.w;
            *(float4*)(row + c) = o;
            uint2 hh; hh.x = pack2(o.x * (1.f + sc.x) + sh.x, o.y * (1.f + sc.y) + sh.y); hh.y = pack2(o.z * (1.f + sc.z) + sh.z, o.w * (1.f + sc.w) + sh.w);
            *(uint2*)(H2 + (size_t)tok * DM + c) = hh;
        }
    }
}

DI void phase_q(const Params& p, int bid, int nb, char* smem) {
    pg8::Gemm g{(const bf16_t*)(p.ws + OFF_H), (const bf16_t*)(p.ws + OFF_WQ), NTOK, 2048, DM};
    pg8::StaticOrder S; S.init(NTOK, 2048, nb, bid);
    pg8::EpiBf16Act E{(bf16_t*)(p.ws + OFF_PROJ), 2048, 0u};
    pg8::gemm_phase<pg8::EpiBf16Act, pg8::StaticOrder, false>((PG8_LAS unsigned char*)smem, g, S, E, nullptr);
}
DI void phase_topk(const Params& p, int bid, int nb, char* smem) {
    const bf16_t* Q = (const bf16_t*)(p.ws + OFF_PROJ);
    const bf16_t* SK = (const bf16_t*)(p.ws + OFF_SUBK);
    unsigned* TOPL = (unsigned*)(p.ws + OFF_TOPL);
    float* sc = (float*)(smem + 36864);
    constexpr int NTM = NTOK / 128;
    for (int t = bid; t < NTM * 16; t += nb) {
        const int mt = t >> 4, hp = t & 15;
        gemm_block<2, 1, 2, 4>(Q + (size_t)mt * 128 * 2048 + hp * 128, 2048, SK + (size_t)hp * 128 * 128, 128, 128, smem,
                               [&](int r, int c, float v) { sc[r * 129 + c] = v; });
        __syncthreads();
        if (my_tid() < 128) {
            const int r = my_tid();
            float tk[16];
#pragma unroll
            for (int j = 0; j < 16; ++j) tk[j] = -3.0e38f;
            for (int n = 0; n < 128; ++n) {
                float xv = __uint_as_float((__float_as_uint(sc[r * 129 + n]) & ~0x7fu) | (unsigned)n);
#pragma unroll
                for (int j = 0; j < 16; ++j) { const float hi = fmaxf(tk[j], xv), lo = fminf(tk[j], xv); tk[j] = hi; xv = lo; }
            }
            uint4* dst = (uint4*)(TOPL + ((size_t)(mt * 128 + r) * 16 + hp) * 16);
            dst[0] = make_uint4(__float_as_uint(tk[0]), __float_as_uint(tk[1]), __float_as_uint(tk[2]), __float_as_uint(tk[3]));
            dst[1] = make_uint4(__float_as_uint(tk[4]), __float_as_uint(tk[5]), __float_as_uint(tk[6]), __float_as_uint(tk[7]));
            dst[2] = make_uint4(__float_as_uint(tk[8]), __float_as_uint(tk[9]), __float_as_uint(tk[10]), __float_as_uint(tk[11]));
            dst[3] = make_uint4(__float_as_uint(tk[12]), __float_as_uint(tk[13]), __float_as_uint(tk[14]), __float_as_uint(tk[15]));
        }
        __syncthreads();
    }
}
DI void phase_combine(const Params& p, int bid, int nb) {
    const unsigned* TOPL = (const unsigned*)(p.ws + OFF_TOPL);
    uint2* EX = (uint2*)(p.ws + OFF_EXPS);
    const float* SU = (const float*)(p.ws + OFF_SU);
    const float* SV = (const float*)(p.ws + OFF_SV);
    for (int i = bid * NTH + my_tid(); i < NTOK * PHEADS; i += nb * NTH) {
        const unsigned* l1 = TOPL + (size_t)i * 32;
        const unsigned* l2 = l1 + 16;
        float s2[16];
        {
            const uint4 a = ((const uint4*)l2)[0], b = ((const uint4*)l2)[1], c = ((const uint4*)l2)[2], d = ((const uint4*)l2)[3];
            const unsigned w[16] = {a.x, a.y, a.z, a.w, b.x, b.y, b.z, b.w, c.x, c.y, c.z, c.w, d.x, d.y, d.z, d.w};
#pragma unroll
            for (int j = 0; j < 16; ++j) s2[j] = __uint_as_float(w[j] & ~0x7fu);
        }
        float tk[16];
#pragma unroll
        for (int j = 0; j < 16; ++j) tk[j] = -3.0e38f;
        for (int a = 0; a < 16; ++a) {
            const float s1 = __uint_as_float(l1[a] & ~0x7fu);
#pragma unroll
            for (int b = 0; b < 16; ++b) {
                float xv = __uint_as_float((__float_as_uint(s1 + s2[b]) & ~0xffu) | (unsigned)(a * 16 + b));
#pragma unroll
                for (int j = 0; j < 16; ++j) { const float hi = fmaxf(tk[j], xv), lo = fminf(tk[j], xv); tk[j] = hi; xv = lo; }
            }
        }
        float e[16], sum = 0.f;
        const float mx = __uint_as_float(__float_as_uint(tk[0]) & ~0xffu);
#pragma unroll
        for (int j = 0; j < 16; ++j) { e[j] = __expf(__uint_as_float(__float_as_uint(tk[j]) & ~0xffu) - mx); sum += e[j]; }
        const float inv = 1.0f / sum;
#pragma unroll
        for (int j = 0; j < 16; ++j) {
            const unsigned ab = __float_as_uint(tk[j]) & 0xffu;
            const unsigned i1 = l1[ab >> 4] & 0x7fu, i2 = l2[ab & 15] & 0x7fu;
            const unsigned eid = i1 * 128u + i2;
            EX[(size_t)i * 16 + j] = make_uint2(eid | (((__float_as_uint(SU[eid]) >> 23) & 0xffu) << 16), __float_as_uint(e[j] * inv * SV[eid]));
        }
    }
}

DI void ce_desc(float& a, float& b) { const float hi = fmaxf(a, b), lo = fminf(a, b); a = hi; b = lo; }
template <int N> DI void bitonic_sort_desc(float (&v)[N]) {
#pragma unroll
    for (int k = 2; k <= N; k <<= 1)
#pragma unroll
        for (int j = k >> 1; j > 0; j >>= 1)
#pragma unroll
            for (int i = 0; i < N; ++i) { const int l = i ^ j; if (l > i) { if ((i & k) == 0 || k == N) ce_desc(v[i], v[l]); else ce_desc(v[l], v[i]); } }
}
DI void merge_top16(float (&a)[16], const float (&b)[16]) {
#pragma unroll
    for (int i = 0; i < 16; ++i) a[i] = fmaxf(a[i], b[15 - i]);
#pragma unroll
    for (int j = 8; j > 0; j >>= 1)
#pragma unroll
        for (int i = 0; i < 16; ++i) { const int l = i ^ j; if (l > i) ce_desc(a[i], a[l]); }
}
DI void xlane_merge16(float (&a)[16]) {
    float o[16];
#pragma unroll
    for (int i = 0; i < 16; ++i) o[i] = __shfl_xor(a[i], 32);
    merge_top16(a, o);
}
DI void retrieve_topk_hp(const bf16_t* Q, const char* skl, const int tok, const int hp, const int r, const int h, unsigned char* lutp, float (&out)[16]) {
                f32x16 acc[4];
#pragma unroll
                for (int mi = 0; mi < 4; ++mi)
#pragma unroll
                    for (int i = 0; i < 16; ++i) acc[mi][i] = 0.f;
                const bf16_t* qb = Q + (size_t)tok * 2048 + hp * 128 + 8 * h;
                const char* kb = skl + r * 272 + h * 16;
#pragma unroll
                for (int ks = 0; ks < 8; ++ks) {
                    const bf16x8 bq = *(const bf16x8*)(qb + ks * 16);
#pragma unroll
                    for (int mi = 0; mi < 4; ++mi) {
                        const bf16x8 a = *(const bf16x8*)(kb + mi * 32 * 272 + ks * 32);
                        acc[mi] = __builtin_amdgcn_mfma_f32_32x32x16_bf16(a, bq, acc[mi], 0, 0, 0);
                    }
                }
                float v0[16], v1[16], v2[16], v3[16];
#pragma unroll
                for (int i = 0; i < 16; ++i) {
                    const unsigned n = (unsigned)crow(i, h);
                    v0[i] = __uint_as_float((__float_as_uint(acc[0][i]) & ~0x7fu) | n);
                    v1[i] = __uint_as_float((__float_as_uint(acc[1][i]) & ~0x7fu) | (n + 32u));
                    v2[i] = __uint_as_float((__float_as_uint(acc[2][i]) & ~0x7fu) | (n + 64u));
                    v3[i] = __uint_as_float((__float_as_uint(acc[3][i]) & ~0x7fu) | (n + 96u));
                }
                bitonic_sort_desc<16>(v0); bitonic_sort_desc<16>(v1); bitonic_sort_desc<16>(v2); bitonic_sort_desc<16>(v3);
                merge_top16(v0, v1); merge_top16(v2, v3); merge_top16(v0, v2);
                xlane_merge16(v0);
#pragma unroll
                for (int i = 0; i < 16; ++i) out[i] = v0[i];
                u32x4 ix;
                ix.x = (__float_as_uint(v0[0]) & 0x7fu) | ((__float_as_uint(v0[1]) & 0x7fu) << 8) | ((__float_as_uint(v0[2]) & 0x7fu) << 16) | ((__float_as_uint(v0[3]) & 0x7fu) << 24);
                ix.y = (__float_as_uint(v0[4]) & 0x7fu) | ((__float_as_uint(v0[5]) & 0x7fu) << 8) | ((__float_as_uint(v0[6]) & 0x7fu) << 16) | ((__float_as_uint(v0[7]) & 0x7fu) << 24);
                ix.z = (__float_as_uint(v0[8]) & 0x7fu) | ((__float_as_uint(v0[9]) & 0x7fu) << 8) | ((__float_as_uint(v0[10]) & 0x7fu) << 16) | ((__float_as_uint(v0[11]) & 0x7fu) << 24);
                ix.w = (__float_as_uint(v0[12]) & 0x7fu) | ((__float_as_uint(v0[13]) & 0x7fu) << 8) | ((__float_as_uint(v0[14]) & 0x7fu) << 16) | ((__float_as_uint(v0[15]) & 0x7fu) << 24);
                *(u32x4*)lutp = ix;
}
DI void phase_retrieve(const Params& p, int bid, int nb, char* smem) {
    const bf16_t* Q = (const bf16_t*)(p.ws + OFF_PROJ);
    const bf16_t* SK = (const bf16_t*)(p.ws + OFF_SUBK);
    const float* SU = (const float*)(p.ws + OFF_SU);
    const float* SV = (const float*)(p.ws + OFF_SV);
    uint2* EX = (uint2*)(p.ws + OFF_EXPS);
    const int tid = my_tid(), lane = tid & 63, wid = tid >> 6, r = lane & 31, h = lane >> 5;
    unsigned char* lut = (unsigned char*)smem + wid * 2048 + lane * 32;
    char* skb0 = smem + 16384;
    char* skb1 = skb0 + 128 * 272;
    u32x4 sr0, sr1, sr2, sr3;
#define SK_LOAD(hp_) { const bf16_t* g_ = SK + (size_t)(hp_) * 16384 + tid * 8; sr0 = *(const u32x4*)g_; sr1 = *(const u32x4*)(g_ + 4096); sr2 = *(const u32x4*)(g_ + 8192); sr3 = *(const u32x4*)(g_ + 12288); }
#define SK_STORE(buf_) { char* d_ = (buf_) + (tid >> 4) * 272 + (tid & 15) * 16; *(u32x4*)d_ = sr0; *(u32x4*)(d_ + 32 * 272) = sr1; *(u32x4*)(d_ + 64 * 272) = sr2; *(u32x4*)(d_ + 96 * 272) = sr3; }
    for (int it = bid; it < (NTOK / 256) * 2; it += nb) {
        const int hq = it & 1, tok = (it >> 1) * 256 + wid * 32 + r;
        __syncthreads();
        SK_LOAD(hq * 8); SK_STORE(skb0);
        __syncthreads();
#pragma unroll 1
        for (int hd = hq * 4; hd < hq * 4 + 4; ++hd) {
            float L0[16], L1[16];
            SK_LOAD(hd * 2 + 1);
            retrieve_topk_hp(Q, skb0, tok, hd * 2, r, h, lut, L0);
            SK_STORE(skb1);
            __syncthreads();
            if (hd + 1 < hq * 4 + 4) SK_LOAD(hd * 2 + 2);
            retrieve_topk_hp(Q, skb1, tok, hd * 2 + 1, r, h, lut + 16, L1);
            if (hd + 1 < hq * 4 + 4) SK_STORE(skb0);
            __syncthreads();
            float c[32];
            {
                constexpr int PA[50] = {0, 0, 0, 0, 0, 0, 0, 0, 0, 0, 0, 0, 0, 0, 0, 0, 1, 1, 1, 1, 1, 1, 1, 1, 2, 2, 2, 2, 2, 3, 3, 3, 3, 4, 4, 4, 5, 5, 6, 6, 7, 7, 8, 9, 10, 11, 12, 13, 14, 15};
                constexpr int PB[50] = {0, 1, 2, 3, 4, 5, 6, 7, 8, 9, 10, 11, 12, 13, 14, 15, 0, 1, 2, 3, 4, 5, 6, 7, 0, 1, 2, 3, 4, 0, 1, 2, 3, 0, 1, 2, 0, 1, 0, 1, 0, 1, 0, 0, 0, 0, 0, 0, 0, 0};
#pragma unroll
                for (int q = 0; q < 25; ++q) {
                    const float s0 = __uint_as_float(__float_as_uint(L0[PA[2 * q]]) & ~0x7fu) + __uint_as_float(__float_as_uint(L1[PB[2 * q]]) & ~0x7fu);
                    const float s1 = __uint_as_float(__float_as_uint(L0[PA[2 * q + 1]]) & ~0x7fu) + __uint_as_float(__float_as_uint(L1[PB[2 * q + 1]]) & ~0x7fu);
                    const float p0 = __uint_as_float((__float_as_uint(s0) & ~0xffu) | (unsigned)(PA[2 * q] * 16 + PB[2 * q]));
                    const float p1 = __uint_as_float((__float_as_uint(s1) & ~0xffu) | (unsigned)(PA[2 * q + 1] * 16 + PB[2 * q + 1]));
                    c[q] = h ? p1 : p0;
                }
#pragma unroll
                for (int i = 25; i < 32; ++i) c[i] = -3.0e38f;
            }
            bitonic_sort_desc<32>(c);
            float t16[16];
#pragma unroll
            for (int i = 0; i < 16; ++i) t16[i] = c[i];
            xlane_merge16(t16);
            const float mx = __uint_as_float(__float_as_uint(t16[0]) & ~0xffu);
            float e[16], sum = 0.f;
#pragma unroll
            for (int j = 0; j < 16; ++j) { e[j] = __expf(__uint_as_float(__float_as_uint(t16[j]) & ~0xffu) - mx); sum += e[j]; }
            const float inv = 1.0f / sum;
            uint2* dst = EX + ((size_t)tok * 8 + hd) * 16 + 8 * h;
#pragma unroll
            for (int j = 0; j < 8; ++j) {
                float tlo = t16[j], thi = t16[8 + j], elo = e[j], ehi = e[8 + j];
                asm volatile("" : "+v"(tlo), "+v"(thi), "+v"(elo), "+v"(ehi));
                const float tv = h ? thi : tlo, ev = h ? ehi : elo;
                const unsigned ab = __float_as_uint(tv) & 0xffu;
                const unsigned eid = (unsigned)lut[ab >> 4] * 128u + (unsigned)lut[16 + (ab & 15u)];
                dst[j] = make_uint2(eid | (pack2(0.f, SU[eid]) & 0xffff0000u), __float_as_uint(ev * inv * SV[eid]));
            }
        }
    }
#undef SK_LOAD
#undef SK_STORE
}

DI float dot16_fp8(const u32x4 w, const f32x2 (&h)[8]) {
    f32x2 acc = __builtin_amdgcn_cvt_pk_f32_fp8((int)w.x, false) * h[0];
    acc += __builtin_amdgcn_cvt_pk_f32_fp8((int)w.x, true) * h[1];
    acc += __builtin_amdgcn_cvt_pk_f32_fp8((int)w.y, false) * h[2];
    acc += __builtin_amdgcn_cvt_pk_f32_fp8((int)w.y, true) * h[3];
    acc += __builtin_amdgcn_cvt_pk_f32_fp8((int)w.z, false) * h[4];
    acc += __builtin_amdgcn_cvt_pk_f32_fp8((int)w.z, true) * h[5];
    acc += __builtin_amdgcn_cvt_pk_f32_fp8((int)w.w, false) * h[6];
    acc += __builtin_amdgcn_cvt_pk_f32_fp8((int)w.w, true) * h[7];
    return acc.x + acc.y;
}
DI void axpy16_fp8(const float a, const u32x4 w, f32x2 (&o)[8]) {
    const f32x2 aa = {a, a};
    o[0] += aa * __builtin_amdgcn_cvt_pk_f32_fp8((int)w.x, false); o[1] += aa * __builtin_amdgcn_cvt_pk_f32_fp8((int)w.x, true);
    o[2] += aa * __builtin_amdgcn_cvt_pk_f32_fp8((int)w.y, false); o[3] += aa * __builtin_amdgcn_cvt_pk_f32_fp8((int)w.y, true);
    o[4] += aa * __builtin_amdgcn_cvt_pk_f32_fp8((int)w.z, false); o[5] += aa * __builtin_amdgcn_cvt_pk_f32_fp8((int)w.z, true);
    o[6] += aa * __builtin_amdgcn_cvt_pk_f32_fp8((int)w.w, false); o[7] += aa * __builtin_amdgcn_cvt_pk_f32_fp8((int)w.w, true);
}
DI float butterfly64(float (&pz)[64], const int lane) {
    const bool b5 = lane & 32, b4 = lane & 16, b3 = lane & 8, b2 = lane & 4, b1 = lane & 2, b0 = lane & 1;
    float q32[32], q16[16], q8[8], q4[4], q2[2];
#pragma unroll
    for (int j = 0; j < 32; ++j) q32[j] = (b5 ? pz[32 + j] : pz[j]) + __shfl_xor(b5 ? pz[j] : pz[32 + j], 32);
#pragma unroll
    for (int j = 0; j < 16; ++j) q16[j] = (b4 ? q32[16 + j] : q32[j]) + __shfl_xor(b4 ? q32[j] : q32[16 + j], 16);
#pragma unroll
    for (int j = 0; j < 8; ++j) q8[j] = (b3 ? q16[8 + j] : q16[j]) + __shfl_xor(b3 ? q16[j] : q16[8 + j], 8);
#pragma unroll
    for (int j = 0; j < 4; ++j) q4[j] = (b2 ? q8[4 + j] : q8[j]) + __shfl_xor(b2 ? q8[j] : q8[4 + j], 4);
#pragma unroll
    for (int j = 0; j < 2; ++j) q2[j] = (b1 ? q4[2 + j] : q4[j]) + __shfl_xor(b1 ? q4[j] : q4[2 + j], 2);
    return (b0 ? q2[1] : q2[0]) + __shfl_xor(b0 ? q2[0] : q2[1], 1);
}
DI float bfly8(float (&pz)[8], const int lane) {
    const bool b2 = lane & 4, b1 = lane & 2, b0 = lane & 1;
    float q4[4], q2[2];
#pragma unroll
    for (int i = 0; i < 4; ++i) q4[i] = (b2 ? pz[4 + i] : pz[i]) + __shfl_xor(b2 ? pz[i] : pz[4 + i], 4);
#pragma unroll
    for (int i = 0; i < 2; ++i) q2[i] = (b1 ? q4[2 + i] : q4[i]) + __shfl_xor(b1 ? q4[i] : q4[2 + i], 2);
    float q = (b0 ? q2[1] : q2[0]) + __shfl_xor(b0 ? q2[0] : q2[1], 1);
    q += __shfl_xor(q, 8); q += __shfl_xor(q, 16); q += __shfl_xor(q, 32);
    return q;
}
DI float bfly16(float (&pz)[16], const int lane) {
    const bool b3 = lane & 8, b2 = lane & 4, b1 = lane & 2, b0 = lane & 1;
    float q8[8], q4[4], q2[2];
#pragma unroll
    for (int i = 0; i < 8; ++i) q8[i] = (b3 ? pz[8 + i] : pz[i]) + __shfl_xor(b3 ? pz[i] : pz[8 + i], 8);
#pragma unroll
    for (int i = 0; i < 4; ++i) q4[i] = (b2 ? q8[4 + i] : q8[i]) + __shfl_xor(b2 ? q8[i] : q8[4 + i], 4);
#pragma unroll
    for (int i = 0; i < 2; ++i) q2[i] = (b1 ? q4[2 + i] : q4[i]) + __shfl_xor(b1 ? q4[i] : q4[2 + i], 2);
    float q = (b0 ? q2[1] : q2[0]) + __shfl_xor(b0 ? q2[0] : q2[1], 1);
    q += __shfl_xor(q, 16); q += __shfl_xor(q, 32);
    return q;
}
DI void gs_issue(const __amdgpu_buffer_rsrc_t T, const uint2* ent, const unsigned d, const int lane, u32x4 (&w)[8], unsigned& ca) {
    const int cnt = (int)((d >> 16) & 0xfu), k = lane & 7;
    const uint2 e = ent[(d & 0xffffu) + (unsigned)(k < cnt ? k : cnt - 1)];
    ca = (k < cnt && !(d >> 31)) ? e.y : 0u;
#pragma unroll
    for (int q = 0; q < 8; ++q) {
        const int eid = __builtin_amdgcn_readlane((int)e.x, q) & 0x3fff;
        w[q] = __builtin_amdgcn_raw_buffer_load_b128(T, lane * 16, eid * DM, 0);
    }
}
DI float dot16_i8(const u32x4 w, const u32x4 h) {
    int acc = __builtin_amdgcn_sdot4((int)w.x, (int)h.x, 0, false);
    acc = __builtin_amdgcn_sdot4((int)w.y, (int)h.y, acc, false);
    acc = __builtin_amdgcn_sdot4((int)w.z, (int)h.z, acc, false);
    acc = __builtin_amdgcn_sdot4((int)w.w, (int)h.w, acc, false);
    return (float)acc;
}
DI void gs_desc(const uint2* ent, const unsigned d, const int lane, unsigned& ex) {
    const int cnt = (int)((d >> 16) & 0xfu), k = lane & 7;
    ex = ent[(d & 0xffffu) + (unsigned)(k < cnt ? k : cnt - 1)].x;
}
DI void gs_loads(const __amdgpu_buffer_rsrc_t T, const unsigned ex, const int lane, u32x4 (&w)[8]) {
#pragma unroll
    for (int q = 0; q < 8; ++q) {
        const int eid = __builtin_amdgcn_readlane((int)ex, q) & 0x3fff;
        w[q] = __builtin_amdgcn_raw_buffer_load_b128(T, lane * 16, eid * DM, 0);
    }
}
DI void gs_upartial(const u32x4 (&w)[8], const u32x4 h2q, float (&pz)[16], const int base) {
#pragma unroll
    for (int k = 0; k < 8; ++k) pz[base + k] = dot16_i8(w[k], h2q);
}
DI void gs_ustore(float (&pz)[16], float* zb, const unsigned da, const unsigned db, const int lane) {
    const float z = bfly16(pz, lane);
    const unsigned d = (lane & 8) ? db : da;
    const int k = lane & 7;
    if (lane < 16 && k < (int)((d >> 16) & 0xfu) && !(d >> 31)) zb[(d & 0xffffu) + k] = z;
}
DI void axpy16_u8(const float a, const u32x4 w, float (&o)[16]) {
    o[0] += a * (float)(w.x & 0xffu); o[1] += a * (float)((w.x >> 8) & 0xffu); o[2] += a * (float)((w.x >> 16) & 0xffu); o[3] += a * (float)(w.x >> 24);
    o[4] += a * (float)(w.y & 0xffu); o[5] += a * (float)((w.y >> 8) & 0xffu); o[6] += a * (float)((w.y >> 16) & 0xffu); o[7] += a * (float)(w.y >> 24);
    o[8] += a * (float)(w.z & 0xffu); o[9] += a * (float)((w.z >> 8) & 0xffu); o[10] += a * (float)((w.z >> 16) & 0xffu); o[11] += a * (float)(w.z >> 24);
    o[12] += a * (float)(w.w & 0xffu); o[13] += a * (float)((w.w >> 8) & 0xffu); o[14] += a * (float)((w.w >> 16) & 0xffu); o[15] += a * (float)(w.w >> 24);
}
DI void gs_vcompute(const u32x4 (&w)[8], const unsigned ca, float (&acc)[16]) {
#pragma unroll
    for (int k = 0; k < 8; ++k) { axpy16_u8(__uint_as_float((unsigned)__builtin_amdgcn_readlane((int)ca, k)), w[k], acc); __builtin_amdgcn_sched_barrier(0); }
}
constexpr int GT = 4;
DI void xcd_pace(unsigned* cnt, const unsigned nloc, unsigned& step) {
    __syncthreads();
    if (__builtin_amdgcn_workitem_id_x() == 0) {
        __hip_atomic_fetch_add(cnt, 1u, __ATOMIC_RELAXED, __HIP_MEMORY_SCOPE_AGENT);
        const unsigned target = nloc * (step + 1u);
        unsigned sp = 0;
        while (__hip_atomic_load(cnt, __ATOMIC_RELAXED, __HIP_MEMORY_SCOPE_AGENT) < target) { __builtin_amdgcn_s_sleep(1); if (++sp > (1u << 22)) break; }
    }
    ++step;
    __syncthreads();
}
DI void phase_gather(const Params& p, int bid, int nb, char* smem, unsigned* pace_cnt, const unsigned pace_n) {
    unsigned pstep = 0;
    const float* mod = (const float*)(p.ws + OFF_MOD);
    const uint2* EX = (const uint2*)(p.ws + OFF_EXPS);
    const __amdgpu_buffer_rsrc_t UT = __builtin_amdgcn_make_buffer_rsrc((void*)(p.ws + OFF_UT), 0, NEXP * DM, 0x00020000);
    const __amdgpu_buffer_rsrc_t VT = __builtin_amdgcn_make_buffer_rsrc((void*)(p.ws + OFF_VT), 0, NEXP * DM, 0x00020000);
    const int lane = my_tid() & 63, wid = my_tid() >> 6, c0 = lane * 16;
    char* wl = smem + wid * 7168;
    uint2* ent = (uint2*)wl; float* zb = (float*)(wl + 4096); int* offs = (int*)(wl + 6144); unsigned* sched = (unsigned*)(wl + 6144 + 256);
#pragma unroll 1
    for (int t0 = (bid * 8 + wid) * GT; t0 < NTOK; t0 += nb * 8 * GT) {
        u32x4 h2q[GT]; float hsc[GT]; float acc[GT][16];
        f32x4 scv[4], shv[4];
        {
            const int b = t0 / SEQ;
#pragma unroll
            for (int q = 0; q < 4; ++q) { scv[q] = *(const f32x4*)(mod + b * 6144 + 4096 + c0 + q * 4) + 1.0f; shv[q] = *(const f32x4*)(mod + b * 6144 + 3072 + c0 + q * 4); }
        }
#pragma unroll
        for (int j = 0; j < GT; ++j) {
            const int tok = t0 + j;
            const float* row = p.out + (size_t)tok * DM + c0;
            __builtin_amdgcn_sched_barrier(0);
            {
                f32x4 hv[4];
                float m = 0.f;
#pragma unroll
                for (int q = 0; q < 4; ++q) { hv[q] = *(const f32x4*)(row + q * 4) * scv[q] + shv[q]; m = fmaxf(m, fmaxf(fmaxf(fabsf(hv[q].x), fabsf(hv[q].y)), fmaxf(fabsf(hv[q].z), fabsf(hv[q].w)))); }
#pragma unroll
                for (int sft = 1; sft < 64; sft <<= 1) m = fmaxf(m, __shfl_xor(m, sft));
                const float qs = m > 1e-30f ? 127.0f / m : 1.0f;
                hsc[j] = m > 1e-30f ? m * (1.0f / 127.0f) : 1.0f;
                unsigned hw[4];
#pragma unroll
                for (int q = 0; q < 4; ++q)
                    hw[q] = ((unsigned)(int)rintf(hv[q].x * qs) & 0xffu) | (((unsigned)(int)rintf(hv[q].y * qs) & 0xffu) << 8) | (((unsigned)(int)rintf(hv[q].z * qs) & 0xffu) << 16) | (((unsigned)(int)rintf(hv[q].w * qs) & 0xffu) << 24);
                h2q[j] = (u32x4){hw[0], hw[1], hw[2], hw[3]};
            }
            const uint2 e0 = EX[(size_t)tok * 128 + lane], e1 = EX[(size_t)tok * 128 + 64 + lane];
            const int s0 = (int)((e0.x & 0x3fffu) >> 11), s1 = (int)((e1.x & 0x3fffu) >> 11);
            int run = 0, pos0 = 0, pos1 = 0;
#pragma unroll
            for (int s = 0; s < 8; ++s) {
                const unsigned long long m0 = __ballot(s0 == s), m1 = __ballot(s1 == s);
                const int c0n = __popcll(m0), c1n = __popcll(m1);
                const int below0 = (int)__builtin_amdgcn_mbcnt_hi((unsigned)(m0 >> 32), __builtin_amdgcn_mbcnt_lo((unsigned)m0, 0u));
                const int below1 = (int)__builtin_amdgcn_mbcnt_hi((unsigned)(m1 >> 32), __builtin_amdgcn_mbcnt_lo((unsigned)m1, 0u));
                if (lane == 0) offs[j * 9 + s] = run;
                pos0 = (s0 == s) ? run + below0 : pos0;
                pos1 = (s1 == s) ? run + c0n + below1 : pos1;
                run += c0n + c1n;
            }
            if (lane == 0) offs[j * 9 + 8] = 128;
            ent[j * 128 + pos0] = e0; ent[j * 128 + pos1] = e1;
        }
        int nbat;
        {
            const int gs = (lane / GT) & 7, gj = lane % GT;
            const int gb = offs[gj * 9 + gs], ge = offs[gj * 9 + gs + 1], cnt = lane < 8 * GT ? ge - gb : 0, nbt = (cnt + 7) >> 3;
            int incl = nbt;
#pragma unroll
            for (int m = 1; m < 32; m <<= 1) { const int o = __shfl_up(incl, m); if ((lane & 31) >= m) incl += o; }
            nbat = __builtin_amdgcn_readlane(incl, 8 * GT - 1);
            const int st = incl - nbt;
            for (int q = 0; q < nbt; ++q) { const int rem = cnt - 8 * q; sched[st + q] = (unsigned)(gj * 128 + gb + 8 * q) | ((unsigned)(rem < 8 ? rem : 8) << 16); }
            if (lane < 3) sched[nbat + lane] = 0x80010000u;
        }
        xcd_pace(pace_cnt, pace_n, pstep);
#ifndef PROBE_UX
#define PROBE_UX 1
#endif
        for (int rep = 0; rep < PROBE_UX; ++rep)
        {
            u32x4 wa[8], wb[8];
#define GS_UP(W_, D_, B_) { const unsigned j_ = ((D_) & 0xffffu) >> 7; \
                if (j_ == 0) gs_upartial(W_, h2q[0], pz, B_); else if (j_ == 1) gs_upartial(W_, h2q[1], pz, B_); \
                else if (j_ == 2) gs_upartial(W_, h2q[2], pz, B_); else gs_upartial(W_, h2q[3], pz, B_); }
#define GS_RD(i_) ((unsigned)__builtin_amdgcn_readfirstlane((int)sched[(i_)]))
            unsigned da = GS_RD(0), db = GS_RD(1), dn = GS_RD(2), ea, eb, en;
            gs_desc(ent, da, lane, ea); gs_desc(ent, db, lane, eb); gs_desc(ent, dn, lane, en);
            gs_loads(UT, ea, lane, wa);
#pragma unroll 1
            for (int i = 0; i < nbat; i += 2) {
                float pz[16];
                gs_loads(UT, eb, lane, wb);
                __builtin_amdgcn_sched_barrier(0);
                GS_UP(wa, da, 0);
                const unsigned dcur_a = da, dcur_b = db;
                da = dn; ea = en; dn = GS_RD(i + 3); gs_desc(ent, dn, lane, en);
                gs_loads(UT, ea, lane, wa);
                __builtin_amdgcn_sched_barrier(0);
                GS_UP(wb, dcur_b, 8);
                db = dn; eb = en; dn = GS_RD(i + 4); gs_desc(ent, dn, lane, en);
                gs_ustore(pz, zb, dcur_a, dcur_b, lane);
            }
#undef GS_UP
#undef GS_RD
        }
        float asum[GT];
#pragma unroll
        for (int j = 0; j < GT; ++j) {
            float as = 0.f;
#pragma unroll
            for (int q = 0; q < 2; ++q) {
                const int pos = j * 128 + q * 64 + lane;
                const uint2 e = ent[pos];
                const float z = zb[pos] * __uint_as_float(e.x & 0xffff0000u) * hsc[j];
                const float a = gelu_as(z) * __uint_as_float(e.y);
                ent[pos].y = __float_as_uint(a);
                as += a;
            }
#pragma unroll
            for (int sft = 1; sft < 64; sft <<= 1) as += __shfl_xor(as, sft);
            asum[j] = as;
        }
        xcd_pace(pace_cnt, pace_n, pstep);
#pragma unroll
        for (int j = 0; j < GT; ++j)
#pragma unroll
            for (int q = 0; q < 16; ++q) acc[j][q] = 0.f;
        {
            u32x4 wa[8]; unsigned ca;
#pragma unroll 1
            for (int i = 0; i < nbat; ++i) {
                const unsigned da = (unsigned)__builtin_amdgcn_readfirstlane((int)sched[i]);
                gs_issue(VT, ent, da, lane, wa, ca);
                __builtin_amdgcn_sched_barrier(0);
                const unsigned j_ = (da & 0xffffu) >> 7;
                if (j_ == 0) gs_vcompute(wa, ca, acc[0]); else if (j_ == 1) gs_vcompute(wa, ca, acc[1]);
                else if (j_ == 2) gs_vcompute(wa, ca, acc[2]); else gs_vcompute(wa, ca, acc[3]);
            }
        }
#pragma unroll
        for (int j = 0; j < GT; ++j) {
            asm volatile("" ::: "memory");
            __builtin_amdgcn_sched_barrier(0);
            const int tok = t0 + j, b = tok / SEQ;
            float* row = p.out + (size_t)tok * DM + c0;
            const float* g2 = mod + b * 6144 + 5120 + c0;
            f32x2 r[8];
            float sm = 0.f;
#pragma unroll
            for (int q = 0; q < 4; ++q) {
                const f32x4 xv = *(const f32x4*)(row + q * 4), gg = *(const f32x4*)(g2 + q * 4);
                const float off = 128.0f * asum[j];
                r[2 * q] = DEEP_ALPHA * (f32x2){xv.x, xv.y} + (f32x2){1.f + gg.x, 1.f + gg.y} * (f32x2){acc[j][4 * q] - off, acc[j][4 * q + 1] - off};
                r[2 * q + 1] = DEEP_ALPHA * (f32x2){xv.z, xv.w} + (f32x2){1.f + gg.z, 1.f + gg.w} * (f32x2){acc[j][4 * q + 2] - off, acc[j][4 * q + 3] - off};
                sm += r[2 * q].x + r[2 * q].y + r[2 * q + 1].x + r[2 * q + 1].y;
            }
#pragma unroll
            for (int m = 1; m < 64; m <<= 1) sm += __shfl_xor(sm, m);
            const float mu = sm * (1.0f / 1024.0f);
            float qq = 0.f;
#pragma unroll
            for (int i = 0; i < 8; ++i) { const f32x2 dd = r[i] - mu; qq += dd.x * dd.x + dd.y * dd.y; }
#pragma unroll
            for (int m = 1; m < 64; m <<= 1) qq += __shfl_xor(qq, m);
            const float rstd = rsqrtf(qq * (1.0f / 1024.0f) + LN_EPS);
#pragma unroll
            for (int q = 0; q < 4; ++q) {
                const f32x4 w4 = *(const f32x4*)(p.ln2w + c0 + q * 4), bi = *(const f32x4*)(p.ln2b + c0 + q * 4);
                f32x4 ov;
                ov.x = (r[2 * q].x - mu) * rstd * w4.x + bi.x; ov.y = (r[2 * q].y - mu) * rstd * w4.y + bi.y;
                ov.z = (r[2 * q + 1].x - mu) * rstd * w4.z + bi.z; ov.w = (r[2 * q + 1].y - mu) * rstd * w4.w + bi.w;
                *(f32x4*)(row + q * 4) = ov;
            }
        }
    }
}

#define XB_TMO      128
#define XB_XCNT(j)  (256  + 64 * (j))
#define XB_XSUB(j)  (1280 + 64 * (j))
#define XB_XGEN(j)  (2304 + 64 * (j))
#define XB_TOP      3328
#define XB_TOPGEN   3392
#define XCD_BAR_WORDS 3456
#define XB_SPIN_CAP (1u << 22)
#define LAS __attribute__((address_space(3)))
DI unsigned xb_ld(unsigned* p) { return __hip_atomic_load(p, __ATOMIC_RELAXED, __HIP_MEMORY_SCOPE_AGENT); }
DI unsigned xb_add(unsigned* p, unsigned v) { return __hip_atomic_fetch_add(p, v, __ATOMIC_RELAXED, __HIP_MEMORY_SCOPE_AGENT); }
DI unsigned xb_xcc_id() { return (unsigned)__builtin_amdgcn_s_getreg((3 << 11) | 20) & 0xFu; }
#define XB_SPIN(cond, bar) do { unsigned _sp = 0; while (cond) { __builtin_amdgcn_s_sleep(1); \
    if ((++_sp & 255u) == 0u) { if (xb_ld(&(bar)[XB_TMO])) break; if (_sp > XB_SPIN_CAP) { atomicAdd(&(bar)[XB_TMO], 1u); break; } } } } while (0)
struct XcdBarrier { unsigned* bar; unsigned x; volatile LAS unsigned* st; };
DI XcdBarrier xcd_barrier_post(unsigned* bar, volatile LAS unsigned* st) {
    XcdBarrier b; b.bar = bar; b.x = xb_xcc_id(); b.st = st;
    if (__builtin_amdgcn_workitem_id_x() == 0) (void)xb_add(&bar[XB_XCNT(b.x)], 1u);
    return b;
}
DI void xcd_barrier_complete(unsigned* bar, unsigned x, unsigned& nloc, unsigned& nx) {
    const unsigned G = gridDim.x * gridDim.y * gridDim.z;
    unsigned sum, cnt, mine, sp = 0u;
    for (;;) {
        sum = 0u; cnt = 0u; mine = 0u;
#pragma unroll
        for (unsigned j = 0; j < 16; ++j) { const unsigned c = xb_ld(&bar[XB_XCNT(j)]); sum += c; cnt += (c > 0u) ? 1u : 0u; mine = (j == x) ? c : mine; }
        if (sum == G) break;
        __builtin_amdgcn_s_sleep(1);
        if ((++sp & 255u) == 0u) { if (xb_ld(&bar[XB_TMO])) break; if (sp > XB_SPIN_CAP) { atomicAdd(&bar[XB_TMO], 1u); break; } }
    }
    nloc = mine > 0u ? mine : 1u; nx = cnt > 0u ? cnt : 1u;
}
DI void xcd_barrier(const XcdBarrier& b) {
    asm volatile("s_waitcnt vmcnt(0)" ::: "memory");
    __syncthreads();
    if (__builtin_amdgcn_workitem_id_x() == 0) {
        unsigned* bar = b.bar;
        __builtin_amdgcn_s_waitcnt(0);
        unsigned nloc = b.st[0], nx = b.st[1];
        if (nloc == 0u) { xcd_barrier_complete(bar, b.x, nloc, nx); b.st[0] = nloc; b.st[1] = nx; }
        const unsigned old = xb_add(&bar[XB_XSUB(b.x)], 1u);
        const unsigned gen = old / nloc;
        if (old + 1u == (gen + 1u) * nloc) {
            __builtin_amdgcn_fence(__ATOMIC_RELEASE, "agent");
            asm volatile("s_waitcnt vmcnt(0)" ::: "memory");
            const unsigned og = xb_add(&bar[XB_TOP], 1u);
            const unsigned tg = og / nx;
            if (og + 1u == (tg + 1u) * nx) xb_add(&bar[XB_TOPGEN], 1u);
            else XB_SPIN(xb_ld(&bar[XB_TOPGEN]) == tg, bar);
            __builtin_amdgcn_fence(__ATOMIC_ACQUIRE, "agent");
            xb_add(&bar[XB_XGEN(b.x)], 1u);
            asm volatile("s_waitcnt vmcnt(0)" ::: "memory");
        } else {
            XB_SPIN(xb_ld(&bar[XB_XGEN(b.x)]) == gen, bar);
            __builtin_amdgcn_fence(__ATOMIC_ACQUIRE, "agent");
            asm volatile("s_waitcnt vmcnt(0)" ::: "memory");
        }
    }
    __syncthreads();
}

__global__ void __launch_bounds__(NTH) k_mega(Params p) {
    __shared__ __attribute__((aligned(16))) char smem[SMEM_BYTES];
    volatile LAS unsigned* xst = (volatile LAS unsigned*)(smem + SMEM_BYTES - 16);
    if (__builtin_amdgcn_workitem_id_x() == 0) { xst[0] = 0u; xst[1] = 0u; }
    __syncthreads();
    const XcdBarrier xb = xcd_barrier_post((unsigned*)(p.ws + OFF_BAR), xst);
    const int bid = blockIdx.x, nb = gridDim.x;
#ifndef PROBE_MASK
#define PROBE_MASK 0
#endif
#define REP(bit) for (int rep_ = 0; rep_ < ((PROBE_MASK & (bit)) ? 2 : 1); ++rep_)
    REP(64) { phase_prep(p, bid, nb, smem);    xcd_barrier(xb); }
    REP(64) { phase_h(p, bid, nb);             xcd_barrier(xb); }
    REP(1)  { phase_proj(p, bid, nb, smem);    xcd_barrier(xb); }
    REP(128) { phase_hgprep(p, bid, nb);       xcd_barrier(xb); }
    REP(2)  { phase_mix(p, bid, nb, smem);     xcd_barrier(xb); }
    REP(4)  { phase_glu(p, bid, nb, smem);     xcd_barrier(xb); }
    REP(4)  { phase_a2(p, bid, nb);            xcd_barrier(xb); }
    REP(4)  { phase_outproj(p, bid, nb, smem); xcd_barrier(xb); }
    phase_ln1(p, bid, nb);           xcd_barrier(xb);
    REP(8)  { phase_q(p, bid, nb, smem);       xcd_barrier(xb); }
    REP(16) { phase_retrieve(p, bid, nb, smem); xcd_barrier(xb); }
    phase_gather(p, bid, nb, smem, (unsigned*)(p.ws + OFF_BAR) + 16 * xb.x, xst[0]);
}

extern "C" void kernel_launch(void* const* d_in, const int* in_sizes, int n_in, void* d_out, int out_size, void* d_ws, size_t ws_size, hipStream_t stream) {
    if (n_in != 27 || ws_size < WS_END) { fprintf(stderr, "kernel_launch: unexpected n_in %d or ws_size %zu (< %zu)\n", n_in, ws_size, (size_t)WS_END); return; }
    static int grid_blocks = 0;
    if (!grid_blocks) {
        int dev = 0, cus = 0, per_cu = 0;
        (void)hipGetDevice(&dev);
        (void)hipDeviceGetAttribute(&cus, hipDeviceAttributeMultiprocessorCount, dev);
        (void)hipOccupancyMaxActiveBlocksPerMultiprocessor(&per_cu, k_mega, NTH, 0);
        if (cus <= 0) cus = 256;
        if (per_cu < 1) { fprintf(stderr, "kernel_launch: occupancy query says %d blocks/CU\n", per_cu); per_cu = 1; }
        grid_blocks = cus;
    }
    Params p{};
    const float** f = (const float**)&p;
    for (int i = 0; i < 27; ++i) f[i] = (const float*)d_in[i];
    p.out = (float*)d_out; p.ws = (char*)d_ws;
    hipError_t e = hipMemsetAsync((char*)d_ws + OFF_BAR, 0, (size_t)3456 * 4, stream);
    if (e == hipSuccess) { hipLaunchKernelGGL(k_mega, dim3(grid_blocks), dim3(NTH), 0, stream, p); e = hipPeekAtLastError(); }
    if (e != hipSuccess) fprintf(stderr, "launch failed: %s (grid %d)\n", hipGetErrorString(e), grid_blocks);
}
```

```cpp
#include <hip/hip_runtime.h>
#include <hip/hip_cooperative_groups.h>
#include <stdint.h>
#include <stdio.h>

namespace cg = cooperative_groups;
#define DI __device__ __forceinline__
typedef unsigned short bf16_t;
typedef short bf16x8 __attribute__((ext_vector_type(8)));
typedef float f32x16 __attribute__((ext_vector_type(16)));
typedef unsigned u32x4 __attribute__((ext_vector_type(4)));
typedef float f32x4 __attribute__((ext_vector_type(4)));
typedef float f32x2 __attribute__((ext_vector_type(2)));

constexpr int NTH = 512;
constexpr int NB = 16, SEQ = 2048, DM = 1024, NTOK = NB * SEQ;
constexpr int DHG = 512, HGH = 4, HDK = 128;
constexpr int DSS = 512, SSG = 32, SSC = 16, SSP = 64;
constexpr int INC = 2560;
constexpr int PHEADS = 8, NKEYS = 128, TOPK = 16, NEXP = 16384;
constexpr float DEEP_ALPHA = 1.189207115002721f;
constexpr float LN_EPS = 1e-5f, RMS_EPS = 1e-6f;
constexpr int SMEM_BYTES = 128 * 1024 + 256;

constexpr size_t al256(size_t x) { return (x + 255) & ~(size_t)255; }
constexpr size_t OFF_MOD = 0;
constexpr size_t OFF_LB = al256(OFF_MOD + (size_t)NB * 6144 * 4);
constexpr size_t OFF_LAM = al256(OFF_LB + 512 * 4);
constexpr size_t OFF_BB = al256(OFF_LAM + 32 * 64 * 2 * 4);
constexpr size_t OFF_WIN = al256(OFF_BB + 32 * 64 * 16 * 2 * 4);
constexpr size_t OFF_GLU = al256(OFF_WIN + (size_t)INC * DM * 2);
constexpr size_t OFF_WOUT = al256(OFF_GLU + (size_t)512 * 512 * 2);
constexpr size_t OFF_WQ = al256(OFF_WOUT + (size_t)DM * DM * 2);
constexpr size_t OFF_SUBK = al256(OFF_WQ + (size_t)2048 * DM * 2);
constexpr size_t OFF_SU = al256(OFF_SUBK + (size_t)16 * 128 * 128 * 2);
constexpr size_t OFF_SV = al256(OFF_SU + (size_t)NEXP * 4);
constexpr size_t OFF_UT = al256(OFF_SV + (size_t)NEXP * 4);
constexpr size_t OFF_VT = al256(OFF_UT + (size_t)NEXP * DM * 2);
constexpr size_t OFF_H = al256(OFF_VT + (size_t)NEXP * DM * 2);
constexpr size_t OFF_PROJ = al256(OFF_H + (size_t)NTOK * DM * 2);
constexpr size_t OFF_ORAW = al256(OFF_PROJ + (size_t)NTOK * INC * 2);
constexpr size_t OFF_YSSM = al256(OFF_ORAW + (size_t)NTOK * DHG * 4);
constexpr size_t OFF_A2 = al256(OFF_YSSM + (size_t)NTOK * DSS * 2);
constexpr size_t OFF_HG = al256(OFF_A2 + (size_t)NTOK * DM * 2);
constexpr size_t OFF_S5K = al256(OFF_HG + (size_t)4096 * 128 * 4);
constexpr size_t OFF_S5N = al256(OFF_S5K + (size_t)32 * 4096 * 2);
constexpr size_t OFF_S5M = al256(OFF_S5N + (size_t)32 * 128 * 256 * 2);
constexpr size_t OFF_S5L = al256(OFF_S5M + (size_t)32 * 256 * 128 * 2);
constexpr size_t OFF_BAR = al256(OFF_S5L + (size_t)32 * 64 * 2 * 4);
constexpr size_t WS_END = al256(OFF_BAR + (size_t)3456 * 4);
constexpr size_t OFF_HQ = OFF_H, OFF_HK = OFF_H + (size_t)NTOK * DHG * 2, OFF_HKT = OFF_A2, OFF_HVT = OFF_A2 + (size_t)NTOK * DHG * 2;
constexpr size_t OFF_TOPL = OFF_ORAW;
constexpr size_t OFF_EXPS = OFF_ORAW + (size_t)NTOK * 16 * 16 * 4;

struct Params {
    const float *x, *c, *ada_w, *ada_b, *w_in, *hg_lb, *hg_nw, *a_re, *a_im, *log_dt, *b_re, *b_im, *c_re, *c_im, *dsk,
        *glu_w, *glu_b, *ssm_nw, *w_out, *ln1w, *ln1b, *w_q, *subk, *pu, *pv, *ln2w, *ln2b;
    float* out;
    char* ws;
};

DI int my_tid() { int t = (int)__builtin_amdgcn_workitem_id_x(); asm volatile("" : "+v"(t)); return t; }
DI bf16_t f2bf(float x) { unsigned u = __float_as_uint(x); u += 0x7fffu + ((u >> 16) & 1u); return (bf16_t)(u >> 16); }
DI float bf2f(bf16_t b) { return __uint_as_float(((unsigned)b) << 16); }
DI float bflo(unsigned w) { return __uint_as_float(w << 16); }
DI float bfhi(unsigned w) { return __uint_as_float(w & 0xffff0000u); }
typedef __bf16 hwbf16x2 __attribute__((ext_vector_type(2)));
DI unsigned pack2(float a, float b) { const f32x2 v = {a, b}; return __builtin_bit_cast(unsigned, __builtin_convertvector(v, hwbf16x2)); }
DI bf16x8 pack8(const f32x16& x, const int base) {
    u32x4 o; o.x = pack2(x[base], x[base + 1]); o.y = pack2(x[base + 2], x[base + 3]); o.z = pack2(x[base + 4], x[base + 5]); o.w = pack2(x[base + 6], x[base + 7]);
    return __builtin_bit_cast(bf16x8, o);
}
DI float sigmoidf_(float x) { return 1.0f / (1.0f + __expf(-x)); }
DI float siluf_(float x) { return x * sigmoidf_(x); }
DI float geluf_(float x) { return 0.5f * x * (1.0f + erff(x * 0.70710678118654752f)); }
DI float gelu_as(float v) {
    const float t = __builtin_amdgcn_rcpf(fabsf(v) * 0.2316418882f + 1.0f);
    float q = t * 0.5307027145f + (-0.7265760135f); q = q * t + 0.7107068705f; q = q * t + (-0.142248368f); q = q * t + 0.127414796f; q = q * t;
    const float m = v * (q * __builtin_amdgcn_exp2f(v * v * (-0.72134752044f)));
    return v < 0.f ? m : v - m;
}

template <int MT, int NT_, int WM, int WN, class Epi>
DI void gemm_block(const bf16_t* __restrict__ A, int lda, const bf16_t* __restrict__ Bt, int ldb, int K, char* smem, Epi epi) {
    constexpr int BM = WM * MT * 32, BN = WN * NT_ * 32, LS = 72;
    static_assert(WM * WN == 8, "8 waves");
    bf16_t* As = (bf16_t*)smem;
    bf16_t* Bs = As + BM * LS;
    const int tid = my_tid(), lane = tid & 63, wid = tid >> 6, r = lane & 31, h = lane >> 5;
    const int wm = wid / WN, wn = wid % WN;
    constexpr int PA = BM * 8 / NTH, PB = BN * 8 / NTH;
    u32x4 ra[PA], rb[PB];
    f32x16 acc[MT][NT_];
#pragma unroll
    for (int mi = 0; mi < MT; ++mi)
#pragma unroll
        for (int ni = 0; ni < NT_; ++ni)
#pragma unroll
            for (int i = 0; i < 16; ++i) acc[mi][ni][i] = 0.f;
#define GEMM_GLOAD(kt_) { \
    _Pragma("unroll") for (int q = 0; q < PA; ++q) { const int idx = tid + q * NTH, row = idx >> 3, ch = idx & 7; ra[q] = *(const u32x4*)(A + (size_t)row * lda + (kt_) * 64 + ch * 8); } \
    _Pragma("unroll") for (int q = 0; q < PB; ++q) { const int idx = tid + q * NTH, row = idx >> 3, ch = idx & 7; rb[q] = *(const u32x4*)(Bt + (size_t)row * ldb + (kt_) * 64 + ch * 8); } }
#define GEMM_LSTORE() { \
    _Pragma("unroll") for (int q = 0; q < PA; ++q) { const int idx = tid + q * NTH, row = idx >> 3, ch = idx & 7; *(u32x4*)(As + row * LS + ch * 8) = ra[q]; } \
    _Pragma("unroll") for (int q = 0; q < PB; ++q) { const int idx = tid + q * NTH, row = idx >> 3, ch = idx & 7; *(u32x4*)(Bs + row * LS + ch * 8) = rb[q]; } }
    GEMM_GLOAD(0); GEMM_LSTORE(); __syncthreads();
    const int nk = K / 64;
    for (int kt = 0; kt < nk; ++kt) {
        if (kt + 1 < nk) GEMM_GLOAD(kt + 1);
#pragma unroll
        for (int ks = 0; ks < 4; ++ks) {
            bf16x8 a[MT], b[NT_];
#pragma unroll
            for (int mi = 0; mi < MT; ++mi) a[mi] = *(const bf16x8*)(As + (wm * MT * 32 + mi * 32 + r) * LS + ks * 16 + h * 8);
#pragma unroll
            for (int ni = 0; ni < NT_; ++ni) b[ni] = *(const bf16x8*)(Bs + (wn * NT_ * 32 + ni * 32 + r) * LS + ks * 16 + h * 8);
#pragma unroll
            for (int mi = 0; mi < MT; ++mi)
#pragma unroll
                for (int ni = 0; ni < NT_; ++ni) acc[mi][ni] = __builtin_amdgcn_mfma_f32_32x32x16_bf16(a[mi], b[ni], acc[mi][ni], 0, 0, 0);
        }
        __syncthreads();
        if (kt + 1 < nk) { GEMM_LSTORE(); __syncthreads(); }
    }
#pragma unroll
    for (int mi = 0; mi < MT; ++mi)
#pragma unroll
        for (int ni = 0; ni < NT_; ++ni)
#pragma unroll
            for (int i = 0; i < 16; ++i) epi(wm * MT * 32 + mi * 32 + (i & 3) + 8 * (i >> 2) + 4 * h, wn * NT_ * 32 + ni * 32 + r, acc[mi][ni][i]);
}

namespace pg8 {
#define PG8_LAS __attribute__((address_space(3)))
typedef unsigned short bf16_t;
typedef short bf16x8 __attribute__((ext_vector_type(8)));
typedef float f32x4 __attribute__((ext_vector_type(4)));
typedef unsigned u32x4 __attribute__((ext_vector_type(4)));
constexpr int BM = 256, BK = 64, HALF = 128, HTB = HALF * BK * 2  , STAGE_BYTES = 8 * HTB, NXCD = 8, WGM = 8;

__host__ __device__ __forceinline__ int lds_byte(int r, int c) { const int st = (r >> 4) * 2 + (c >> 5), rr = r & 15, cc = c & 31, ob = rr * 64 + cc * 2; return st * 1024 + (ob ^ (((ob >> 9) & 1) << 5)); }
__host__ __device__ __forceinline__ void stage_rc(int b, int& R, int& C) { const int st = b / 1024, sb = b % 1024, swz = sb ^ (((sb >> 9) & 1) << 5); R = (st >> 1) * 16 + swz / 64; C = (st & 1) * 32 + (swz % 64) / 2; }
__host__ __device__ __forceinline__ int perm32(int rho) { const int n = rho >> 4, i = rho & 15; return 8 * (i >> 2) + 4 * n + (i & 3); }

struct Unit { int pm, pn; };
struct Gemm { const bf16_t* A; const bf16_t* Bt; int M, N, K; };

struct StaticOrder {
    int nM, nN, nwg, G, c;
    __host__ __device__ void init(int M, int N, int G_, int c_) { nM = M / BM; nN = N / BM; nwg = nM * nN; G = G_; c = c_; }
    __host__ __device__ bool next(int i, Unit& u) const {
        const long L = (long)i * G + c; if (L >= nwg) return false;
        int wgid = (int)L; { const int q = nwg / NXCD, r = nwg % NXCD, xcd = wgid % NXCD, off = wgid / NXCD; wgid = (xcd < r ? xcd * (q + 1) : r * (q + 1) + (xcd - r) * q) + off; }
        const int nig = WGM * nN, gid = wgid / nig, fm = gid * WGM, gsz = (nM - fm) < WGM ? (nM - fm) : WGM;
        u.pm = fm + ((wgid % nig) % gsz); u.pn = (wgid % nig) / gsz; return true;
    }
    __device__ __forceinline__ void a_ready(const Unit&) const {}
    __device__ __forceinline__ void done(const Unit&) const {}
};
template <class Epi, class Sched, bool STAMP = false>
__device__ __forceinline__ void gemm_phase(PG8_LAS unsigned char* lds, const Gemm g, const Sched& S, const Epi& E, unsigned long long* stamps) {
    const int tid = (int)__builtin_amdgcn_workitem_id_x(), wid = __builtin_amdgcn_readfirstlane(tid >> 6), lane = tid & 63, wr = wid >> 2, wc = wid & 3, fr = lane & 15, fq = lane >> 4;
    const int K = g.K, nt = K / BK;
    int ts_lo = 0, ts_hi = 0, nts = 0; const unsigned long long rt_entry = STAMP ? (unsigned long long)wall_clock64() : 0ull;
#define PG8_STAMP() do { if (STAMP && wid == 0 && nts < 64) { const unsigned long long _c = (unsigned long long)clock64(); \
        ts_lo = (lane == nts) ? (int)(unsigned)_c : ts_lo; ts_hi = (lane == nts) ? (int)(unsigned)(_c >> 32) : ts_hi; ++nts; } } while (0)
    PG8_STAMP();
    unsigned voffA[2], voffB[2];
#pragma unroll
    for (int i = 0; i < 2; ++i) { int R, C; stage_rc(tid * 16 + i * 8192, R, C); const int Rb = Epi::PERM ? ((R & ~31) + perm32(R & 31)) : R;
        voffA[i] = (unsigned)(R * K + C) * 2u; voffB[i] = (unsigned)(Rb * K + C) * 2u; }
    const size_t kstep = (size_t)(BK * 2);
    const size_t hstep = (size_t)HALF * K * 2;
    const size_t tstep = 2 * hstep;
    const unsigned ldsw = (unsigned)wid * 1024u;
    const int aoff = lds_byte(wr * 64 + fr, fq * 8), boff = lds_byte(wc * 32 + fr, fq * 8);
#define PG8_SA(b, h) (((b) * 2 + (h)) * HTB)
#define PG8_SB(b, h) ((4 + (b) * 2 + (h)) * HTB)
#define PG8_STAGE(bufoff, gbase, voff) do { _Pragma("unroll") for (int _i = 0; _i < 2; ++_i) \
        __builtin_amdgcn_global_load_lds((const unsigned*)((const char*)(gbase) + (voff)[_i]), (PG8_LAS unsigned*)(lds + (bufoff) + ldsw + _i * 8192), 16, 0, 0); } while (0)
#define PG8_LDA(dst, b, h) do { _Pragma("unroll") for (int m = 0; m < 4; ++m) _Pragma("unroll") for (int k = 0; k < 2; ++k) dst[m][k] = *(const PG8_LAS bf16x8*)(lds + PG8_SA(b, h) + aoff + m * 2048 + k * 1024); } while (0)
#define PG8_LDB(dst, b, h) do { _Pragma("unroll") for (int n = 0; n < 2; ++n) _Pragma("unroll") for (int k = 0; k < 2; ++k) dst[n][k] = *(const PG8_LAS bf16x8*)(lds + PG8_SB(b, h) + boff + n * 2048 + k * 1024); } while (0)
#define PG8_MMA(ai, bj, At, Bt) do { __builtin_amdgcn_s_setprio(1); _Pragma("unroll") for (int m = 0; m < 4; ++m) _Pragma("unroll") for (int n = 0; n < 2; ++n) _Pragma("unroll") for (int k = 0; k < 2; ++k) \
        acc[ai][bj][m][n] = __builtin_amdgcn_mfma_f32_16x16x32_bf16(Bt[n][k], At[m][k], acc[ai][bj][m][n], 0, 0, 0); __builtin_amdgcn_s_setprio(0); } while (0)
#define PG8_WAIT_V(n) asm volatile("s_waitcnt vmcnt(" #n ")" ::: "memory")
#define PG8_WAIT_L(n) asm volatile("s_waitcnt lgkmcnt(" #n ")" ::: "memory")
#define PG8_BAR __builtin_amdgcn_s_barrier()
#define PG8_SCHED __builtin_amdgcn_sched_barrier(0)
    Unit cur, nxt; int ui = 0;
    if (!S.next(0, cur)) return;
    f32x4 acc[2][2][4][2];
#pragma unroll
    for (int a = 0; a < 2; ++a)
#pragma unroll
        for (int b = 0; b < 2; ++b)
#pragma unroll
            for (int m = 0; m < 4; ++m)
#pragma unroll
                for (int n = 0; n < 2; ++n) acc[a][b][m][n] = (f32x4){0.f, 0.f, 0.f, 0.f};
    bf16x8 At[4][2], B0[2][2], B1[2][2];
    const char* cA = (const char*)g.A + (size_t)cur.pm * tstep; const char* cB = (const char*)g.Bt + (size_t)cur.pn * tstep;
    S.a_ready(cur);
    PG8_STAGE(PG8_SB(0, 0), cB, voffB); PG8_STAGE(PG8_SA(0, 0), cA, voffA); PG8_STAGE(PG8_SB(0, 1), cB + hstep, voffB); PG8_STAGE(PG8_SA(0, 1), cA + hstep, voffA);
    if (wr == 1) PG8_BAR;
    PG8_WAIT_V(4); PG8_BAR;
    PG8_STAGE(PG8_SB(1, 0), cB + kstep, voffB); PG8_STAGE(PG8_SA(1, 0), cA + kstep, voffA); PG8_STAGE(PG8_SB(1, 1), cB + hstep + kstep, voffB);
    PG8_WAIT_V(6); PG8_BAR;
    PG8_STAMP();
    for (;;) {
        const bool has_next = S.next(ui + 1, nxt);
        const char* nA = has_next ? (const char*)g.A + (size_t)nxt.pm * tstep : cA; const char* nB = has_next ? (const char*)g.Bt + (size_t)nxt.pn * tstep : cB;
        for (int t = 0; t < nt; t += 2) {
            const bool last = (t == nt - 2);
            const char* a1 = cA + (size_t)(t + 1) * kstep;
            const char* a2 = last ? nA : cA + (size_t)(t + 2) * kstep; const char* b2 = last ? nB : cB + (size_t)(t + 2) * kstep;
            const char* a3 = a2 + kstep; const char* b3 = b2 + kstep;
            if (last && has_next) S.a_ready(nxt);
            PG8_LDB(B0, 0, 0); PG8_SCHED; PG8_LDA(At, 0, 0); PG8_STAGE(PG8_SA(1, 1), a1 + hstep, voffA);
            PG8_WAIT_L(8); PG8_BAR; PG8_WAIT_L(0); PG8_MMA(0, 0, At, B0); PG8_BAR; PG8_SCHED;
            PG8_LDB(B1, 0, 1); PG8_STAGE(PG8_SB(0, 0), b2, voffB);
            PG8_BAR; PG8_WAIT_L(0); PG8_MMA(0, 1, At, B1); PG8_BAR;
            PG8_LDA(At, 0, 1); PG8_STAGE(PG8_SA(0, 0), a2, voffA);
            PG8_BAR; PG8_WAIT_L(0); PG8_MMA(1, 0, At, B0); PG8_BAR; PG8_SCHED;
            PG8_STAGE(PG8_SB(0, 1), b2 + hstep, voffB);
            PG8_WAIT_V(6); PG8_BAR; PG8_MMA(1, 1, At, B1); PG8_BAR;
            PG8_LDB(B0, 1, 0); PG8_SCHED; PG8_LDA(At, 1, 0); PG8_STAGE(PG8_SA(0, 1), a2 + hstep, voffA);
            PG8_WAIT_L(8); PG8_BAR; PG8_WAIT_L(0); PG8_MMA(0, 0, At, B0); PG8_BAR; PG8_SCHED;
            PG8_LDB(B1, 1, 1); PG8_STAGE(PG8_SB(1, 0), b3, voffB);
            PG8_BAR; PG8_WAIT_L(0); PG8_MMA(0, 1, At, B1); PG8_BAR;
            PG8_LDA(At, 1, 1); PG8_STAGE(PG8_SA(1, 0), a3, voffA);
            PG8_BAR; PG8_WAIT_L(0); PG8_MMA(1, 0, At, B0); PG8_BAR; PG8_SCHED;
            PG8_STAGE(PG8_SB(1, 1), b3 + hstep, voffB);
            PG8_WAIT_V(6); PG8_BAR; PG8_MMA(1, 1, At, B1); PG8_BAR;
        }
        PG8_STAMP();
        if constexpr (!Epi::AFTER_DRAIN) { E(acc, cur, wr, wc, fr, fq); S.done(cur); }
        PG8_STAMP();
        if (!has_next) break;
#pragma unroll
        for (int a = 0; a < 2; ++a)
#pragma unroll
            for (int b = 0; b < 2; ++b)
#pragma unroll
                for (int m = 0; m < 4; ++m)
#pragma unroll
                    for (int n = 0; n < 2; ++n) acc[a][b][m][n] = (f32x4){0.f, 0.f, 0.f, 0.f};
        cur = nxt; cA = nA; cB = nB; ++ui;
    }
    PG8_WAIT_V(0);
    if (wr == 0) PG8_BAR;
    PG8_BAR;
    if constexpr (Epi::AFTER_DRAIN) { E.fused(acc, cur, wr, wc, fr, fq, lds, wid, lane); S.done(cur); }
    PG8_STAMP();
    if (STAMP && wid == 0) { stamps[lane] = lane < nts ? (((unsigned long long)(unsigned)ts_hi << 32) | (unsigned)ts_lo) : 0ull;
        if (lane == 62) stamps[62] = rt_entry; if (lane == 63) stamps[63] = (unsigned long long)wall_clock64(); }
#undef PG8_STAMP
#undef PG8_SA
#undef PG8_SB
#undef PG8_STAGE
#undef PG8_LDA
#undef PG8_LDB
#undef PG8_MMA
#undef PG8_WAIT_V
#undef PG8_WAIT_L
#undef PG8_BAR
#undef PG8_SCHED
}

__device__ __forceinline__ unsigned pk_bf16(float lo, float hi) { typedef float v2f __attribute__((ext_vector_type(2))); typedef __bf16 v2b __attribute__((ext_vector_type(2))); const v2f v = {lo, hi}; return __builtin_bit_cast(unsigned, __builtin_convertvector(v, v2b)); }
__device__ __forceinline__ float silu1(float x) { return x * __builtin_amdgcn_rcpf(1.0f + __expf(-x)); }
struct EpiBf16Act {
    static constexpr bool PERM = true, AFTER_DRAIN = false;
    bf16_t* O; int ldc; unsigned silu_mask;
    __device__ __forceinline__ void operator()(const f32x4 (&acc)[2][2][4][2], const Unit& u, int wr, int wc, int fr, int fq) const {
        const int row0 = u.pm * BM + wr * 64 + fr, col0 = u.pn * BM + wc * 32 + 8 * fq;
        const bool act = (silu_mask >> u.pn) & 1u;
#pragma unroll
        for (int ai = 0; ai < 2; ++ai)
#pragma unroll
            for (int m = 0; m < 4; ++m) { bf16_t* rowp = O + (size_t)(row0 + ai * HALF + m * 16) * ldc + col0;
#pragma unroll
                for (int bj = 0; bj < 2; ++bj) { f32x4 v0 = acc[ai][bj][m][0], v1 = acc[ai][bj][m][1];
                    if (act) {
#pragma unroll
                        for (int j = 0; j < 4; ++j) { v0[j] = silu1(v0[j]); v1[j] = silu1(v1[j]); } }
                    u32x4 w; w.x = pk_bf16(v0[0], v0[1]); w.y = pk_bf16(v0[2], v0[3]); w.z = pk_bf16(v1[0], v1[1]); w.w = pk_bf16(v1[2], v1[3]);
                    *(u32x4*)(rowp + bj * HALF) = w; } }
    }
};
struct EpiResid {
    static constexpr bool PERM = false, AFTER_DRAIN = false;
    float* C; const float* X; const float* mod_g;
    float alpha;
    __device__ __forceinline__ void operator()(const f32x4 (&acc)[2][2][4][2], const Unit& u, int wr, int wc, int fr, int fq) const {
        const int row0 = u.pm * BM + wr * 64 + fr, col0 = u.pn * BM + wc * 32 + 4 * fq;
        const float* gb = mod_g + (size_t)((u.pm * BM) / 2048) * 6144 + col0;
        f32x4 gv[2][2];
#pragma unroll
        for (int bj = 0; bj < 2; ++bj)
#pragma unroll
            for (int n = 0; n < 2; ++n) gv[bj][n] = *(const f32x4*)(gb + bj * HALF + n * 16) + 1.0f;
#pragma unroll
        for (int ai = 0; ai < 2; ++ai)
#pragma unroll
            for (int m = 0; m < 4; ++m) { const size_t ro = (size_t)(row0 + ai * HALF + m * 16) * 1024 + col0;
#pragma unroll
                for (int bj = 0; bj < 2; ++bj)
#pragma unroll
                    for (int n = 0; n < 2; ++n) { const f32x4 xv = *(const f32x4*)(X + ro + bj * HALF + n * 16); *(f32x4*)(C + ro + bj * HALF + n * 16) = alpha * xv + gv[bj][n] * acc[ai][bj][m][n]; } }
    }
};
struct EpiGlu {
    static constexpr bool PERM = false, AFTER_DRAIN = false;
    float* C; const bf16_t* Y; const float* bias;
    __device__ __forceinline__ void operator()(const f32x4 (&acc)[2][2][4][2], const Unit& u, int wr, int wc, int fr, int fq) const {
        const int row0 = u.pm * BM + wr * 64 + fr, col0 = u.pn * BM + wc * 32 + 4 * fq;
        f32x4 bv[2][2];
#pragma unroll
        for (int bj = 0; bj < 2; ++bj)
#pragma unroll
            for (int n = 0; n < 2; ++n) bv[bj][n] = *(const f32x4*)(bias + col0 + bj * HALF + n * 16);
#pragma unroll
        for (int ai = 0; ai < 2; ++ai)
#pragma unroll
            for (int m = 0; m < 4; ++m) { const size_t ro = (size_t)(row0 + ai * HALF + m * 16) * 512 + col0;
#pragma unroll
                for (int bj = 0; bj < 2; ++bj)
#pragma unroll
                    for (int n = 0; n < 2; ++n) {
                        const uint2 yw = *(const uint2*)(Y + ro + bj * HALF + n * 16);
                        const f32x4 z = acc[ai][bj][m][n] + bv[bj][n];
                        f32x4 o;
                        o[0] = __uint_as_float(yw.x << 16) * __builtin_amdgcn_rcpf(1.0f + __expf(-z[0])); o[1] = __uint_as_float(yw.x & 0xffff0000u) * __builtin_amdgcn_rcpf(1.0f + __expf(-z[1]));
                        o[2] = __uint_as_float(yw.y << 16) * __builtin_amdgcn_rcpf(1.0f + __expf(-z[2])); o[3] = __uint_as_float(yw.y & 0xffff0000u) * __builtin_amdgcn_rcpf(1.0f + __expf(-z[3]));
                        *(f32x4*)(C + ro + bj * HALF + n * 16) = o; } }
    }
};
}

DI void prep_mod_item(const Params& p, int item, char* smem) {
    float* condT = (float*)smem;
    float* red = condT + DM * 16;
    const int tid = my_tid();
    for (int i = tid; i < NB * DM; i += NTH) { const int b = i >> 10, k = i & 1023; condT[k * 16 + b] = siluf_(p.c[i]); }
    __syncthreads();
    const int ks = tid >> 5, col = tid & 31;
    float acc[16];
#pragma unroll
    for (int b = 0; b < 16; ++b) acc[b] = 0.f;
    const float* w = p.ada_w + (size_t)(ks * 64) * 6144 + item * 32 + col;
#pragma unroll 4
    for (int k = 0; k < 64; ++k) {
        const float wv = w[(size_t)k * 6144];
        const f32x4* cb = (const f32x4*)(condT + (ks * 64 + k) * 16);
        const f32x4 c0 = cb[0], c1 = cb[1], c2 = cb[2], c3 = cb[3];
        acc[0] += c0.x * wv; acc[1] += c0.y * wv; acc[2] += c0.z * wv; acc[3] += c0.w * wv;
        acc[4] += c1.x * wv; acc[5] += c1.y * wv; acc[6] += c1.z * wv; acc[7] += c1.w * wv;
        acc[8] += c2.x * wv; acc[9] += c2.y * wv; acc[10] += c2.z * wv; acc[11] += c2.w * wv;
        acc[12] += c3.x * wv; acc[13] += c3.y * wv; acc[14] += c3.z * wv; acc[15] += c3.w * wv;
    }
#pragma unroll
    for (int b = 0; b < 16; ++b) red[(ks * 32 + col) * 16 + b] = acc[b];
    __syncthreads();
    {
        const int b = tid >> 5;
        float sum = p.ada_b[item * 32 + col];
#pragma unroll
        for (int q = 0; q < 16; ++q) sum += red[(q * 32 + col) * 16 + b];
        ((float*)(p.ws + OFF_MOD))[b * 6144 + item * 32 + col] = sum;
    }
    __syncthreads();
}
DI void prep_s5_gemm_item(const Params& p, int g, char* smem) {
    f32x2* pw = (f32x2*)smem;
    f32x2* bbL = pw + 17 * 64;
    f32x2* cL = bbL + 64 * 16;
    const int tid = my_tid();
    const float dt = expf(p.log_dt[g]);
#pragma unroll 1
    for (int idx = tid; idx < 17 * 64; idx += NTH) {
        const int j = idx >> 6, pp = idx & 63;
        const float ar = p.a_re[g * 64 + pp], ai = p.a_im[g * 64 + pp];
        const float mag = expf(ar * dt * (float)j), ang = ai * dt * (float)j;
        pw[idx] = (f32x2){mag * cosf(ang), mag * sinf(ang)};
    }
    for (int idx = tid; idx < 16 * 64; idx += NTH) { const int i = idx >> 6, pp = idx & 63; cL[idx] = (f32x2){p.c_re[(g * 16 + i) * 64 + pp], p.c_im[(g * 16 + i) * 64 + pp]}; }
    __syncthreads();
    for (int idx = tid; idx < 64 * 16; idx += NTH) {
        const int pp = idx >> 4, i = idx & 15;
        const float ar = p.a_re[g * 64 + pp], ai = p.a_im[g * 64 + pp];
        const f32x2 lam = pw[64 + pp];
        const float den = ar * ar + ai * ai, nr = lam.x - 1.0f, ni = lam.y;
        const float zr = (nr * ar + ni * ai) / den, zi = (ni * ar - nr * ai) / den;
        const float br = p.b_re[(g * 64 + pp) * 16 + i], bi = p.b_im[(g * 64 + pp) * 16 + i];
        bbL[idx] = (f32x2){zr * br - zi * bi, zr * bi + zi * br};
    }
    __syncthreads();
    bf16_t* NBg = (bf16_t*)(p.ws + OFF_S5N) + (size_t)g * 128 * 256;
#pragma unroll 1
    for (int ch = tid; ch < 128 * 256 / 8; ch += NTH) {
        const int pq = ch >> 5, t = (ch >> 1) & 15, i0 = (ch & 1) * 8, pp = pq & 63;
        const f32x2 w = pw[(15 - t) * 64 + pp];
        float v[8];
#pragma unroll
        for (int e = 0; e < 8; ++e) { const f32x2 bb = bbL[pp * 16 + i0 + e]; v[e] = pq < 64 ? (w.x * bb.x - w.y * bb.y) : (w.x * bb.y + w.y * bb.x); }
        u32x4 o; o.x = pack2(v[0], v[1]); o.y = pack2(v[2], v[3]); o.z = pack2(v[4], v[5]); o.w = pack2(v[6], v[7]);
        *(u32x4*)(NBg + (size_t)((((pq >> 5) * 16 + t) * 64) + (i0 >> 3) * 32 + (pq & 31)) * 8) = o;
    }
    bf16_t* MBg = (bf16_t*)(p.ws + OFF_S5M) + (size_t)g * 256 * 128;
#pragma unroll 1
    for (int ch = tid; ch < 256 * 128 / 8; ch += NTH) {
        const int ti = ch >> 4, p0 = (ch & 15) * 8, tq = ti >> 4, iq = ti & 15;
        float v[8];
#pragma unroll
        for (int e = 0; e < 8; ++e) {
            const int pq = p0 + e, pp = pq & 63;
            const f32x2 c = cL[iq * 64 + pp], w = pw[(tq + 1) * 64 + pp];
            v[e] = pq < 64 ? (c.x * w.x - c.y * w.y) : -(c.x * w.y + c.y * w.x);
        }
        u32x4 o; o.x = pack2(v[0], v[1]); o.y = pack2(v[2], v[3]); o.z = pack2(v[4], v[5]); o.w = pack2(v[6], v[7]);
        *(u32x4*)(MBg + (size_t)((((ti >> 5) * 8 + (p0 >> 4)) * 64) + ((p0 >> 3) & 1) * 32 + (ti & 31)) * 8) = o;
    }
    bf16_t* KTg = (bf16_t*)(p.ws + OFF_S5K) + (size_t)g * 4096;
#pragma unroll 1
    for (int idx = tid; idx < 4096; idx += NTH) {
        const int lag = idx >> 8, iq = (idx >> 4) & 15, i = idx & 15;
        float acc = (lag == 0 && iq == i) ? p.dsk[g * 16 + iq] : 0.f;
#pragma unroll 4
        for (int pp = 0; pp < 64; ++pp) {
            const f32x2 c = cL[iq * 64 + pp], w = pw[lag * 64 + pp], bb = bbL[pp * 16 + i];
            const float mr = c.x * w.x - c.y * w.y, mi_ = c.x * w.y + c.y * w.x;
            acc += mr * bb.x - mi_ * bb.y;
        }
        KTg[idx] = f2bf(acc);
    }
    if (tid < 64) { float* L = (float*)(p.ws + OFF_S5L) + (g * 64 + tid) * 2; const f32x2 w = pw[16 * 64 + tid]; L[0] = w.x; L[1] = w.y; }
    __syncthreads();
}
DI void prep_s5_item(const Params& p, int g) {
    const int tid = my_tid();
    if (tid < SSP) {
        const int pi = g * SSP + tid;
        const float dt = expf(p.log_dt[g]);
        const float ar = p.a_re[pi], ai = p.a_im[pi];
        const float mag = expf(ar * dt);
        const float lr = mag * cosf(ai * dt), li = mag * sinf(ai * dt);
        const float den = ar * ar + ai * ai, nr = lr - 1.0f, ni = li;
        const float zr = (nr * ar + ni * ai) / den, zi = (ni * ar - nr * ai) / den;
        float* lam = (float*)(p.ws + OFF_LAM) + pi * 2;
        lam[0] = lr; lam[1] = li;
        float* bb = (float*)(p.ws + OFF_BB) + (size_t)pi * 32;
        for (int i = 0; i < SSC; ++i) {
            const float br = p.b_re[pi * SSC + i], bi = p.b_im[pi * SSC + i];
            bb[i * 2] = zr * br - zi * bi; bb[i * 2 + 1] = zr * bi + zi * br;
        }
    }
}
DI void prep_transpose_tile(const float* __restrict__ W, bf16_t* __restrict__ Wt, int K, int N, int kt, int nt, char* smem) {
    float* tile = (float*)smem;
    const int tid = my_tid();
#pragma unroll
    for (int q = 0; q < 2; ++q) {
        const int kk = (tid >> 4) + q * 32, c4 = (tid & 15) * 4;
        const float4 v = *(const float4*)(W + (size_t)(kt * 64 + kk) * N + nt * 64 + c4);
        tile[kk * 65 + c4] = v.x; tile[kk * 65 + c4 + 1] = v.y; tile[kk * 65 + c4 + 2] = v.z; tile[kk * 65 + c4 + 3] = v.w;
    }
    __syncthreads();
    const int n = tid >> 3, kc = tid & 7;
    uint4 o;
    o.x = pack2(tile[(kc * 8 + 0) * 65 + n], tile[(kc * 8 + 1) * 65 + n]);
    o.y = pack2(tile[(kc * 8 + 2) * 65 + n], tile[(kc * 8 + 3) * 65 + n]);
    o.z = pack2(tile[(kc * 8 + 4) * 65 + n], tile[(kc * 8 + 5) * 65 + n]);
    o.w = pack2(tile[(kc * 8 + 6) * 65 + n], tile[(kc * 8 + 7) * 65 + n]);
    *(uint4*)(Wt + (size_t)(nt * 64 + n) * K + kt * 64 + kc * 8) = o;
    __syncthreads();
}
DI void cvt_bf16_stream(const float* __restrict__ src, bf16_t* __restrict__ dst, size_t n8, int bid, int nb) {
    for (size_t i = (size_t)bid * NTH + my_tid(); i < n8; i += (size_t)nb * NTH) {
        const float4 a = *(const float4*)(src + i * 8), b = *(const float4*)(src + i * 8 + 4);
        uint4 o; o.x = pack2(a.x, a.y); o.y = pack2(a.z, a.w); o.z = pack2(b.x, b.y); o.w = pack2(b.z, b.w);
        *(uint4*)(dst + i * 8) = o;
    }
}
DI void cvt_fp8_rows(const float* __restrict__ src, unsigned char* __restrict__ dst, float* __restrict__ inv, int bid, int nb) {
    const int lane = my_tid() & 63, wid = my_tid() >> 6;
    for (int row = bid * 8 + wid; row < NEXP; row += nb * 8) {
        const float* sp = src + (size_t)row * DM + lane * 16;
        const f32x4 a = *(const f32x4*)sp, b = *(const f32x4*)(sp + 4), c = *(const f32x4*)(sp + 8), d = *(const f32x4*)(sp + 12);
        float m = fmaxf(fmaxf(fmaxf(fabsf(a.x), fabsf(a.y)), fmaxf(fabsf(a.z), fabsf(a.w))), fmaxf(fmaxf(fabsf(b.x), fabsf(b.y)), fmaxf(fabsf(b.z), fabsf(b.w))));
        m = fmaxf(m, fmaxf(fmaxf(fmaxf(fabsf(c.x), fabsf(c.y)), fmaxf(fabsf(c.z), fabsf(c.w))), fmaxf(fmaxf(fabsf(d.x), fabsf(d.y)), fmaxf(fabsf(d.z), fabsf(d.w)))));
#pragma unroll
        for (int s = 1; s < 64; s <<= 1) m = fmaxf(m, __shfl_xor(m, s));
        float sc = 1.f, isc = 1.f;
        if (m > 1e-30f) {
            int k = (int)floorf(log2f(448.0f / m));
            k = k < -60 ? -60 : (k > 60 ? 60 : k);
            sc = ldexpf(1.0f, k); isc = ldexpf(1.0f, -k);
            if (m * sc > 448.0f) { sc *= 0.5f; isc *= 2.0f; }
        }
        u32x4 o;
        int w;
        w = __builtin_amdgcn_cvt_pk_fp8_f32(a.x * sc, a.y * sc, 0, false); w = __builtin_amdgcn_cvt_pk_fp8_f32(a.z * sc, a.w * sc, w, true); o.x = (unsigned)w;
        w = __builtin_amdgcn_cvt_pk_fp8_f32(b.x * sc, b.y * sc, 0, false); w = __builtin_amdgcn_cvt_pk_fp8_f32(b.z * sc, b.w * sc, w, true); o.y = (unsigned)w;
        w = __builtin_amdgcn_cvt_pk_fp8_f32(c.x * sc, c.y * sc, 0, false); w = __builtin_amdgcn_cvt_pk_fp8_f32(c.z * sc, c.w * sc, w, true); o.z = (unsigned)w;
        w = __builtin_amdgcn_cvt_pk_fp8_f32(d.x * sc, d.y * sc, 0, false); w = __builtin_amdgcn_cvt_pk_fp8_f32(d.z * sc, d.w * sc, w, true); o.w = (unsigned)w;
        *(u32x4*)(dst + (size_t)row * DM + lane * 16) = o;
        if (lane == 0) inv[row] = isc;
    }
}
DI void cvt_fp4_rows(const float* __restrict__ src, unsigned char* __restrict__ dst, float* __restrict__ inv, int bid, int nb) {
    const int lane = my_tid() & 63, wid = my_tid() >> 6;
    for (int row = bid * 8 + wid; row < NEXP; row += nb * 8) {
        const float* sp = src + (size_t)row * DM + lane * 16;
        const f32x4 a = *(const f32x4*)sp, b = *(const f32x4*)(sp + 4), c = *(const f32x4*)(sp + 8), d = *(const f32x4*)(sp + 12);
        float m = fmaxf(fmaxf(fmaxf(fabsf(a.x), fabsf(a.y)), fmaxf(fabsf(a.z), fabsf(a.w))), fmaxf(fmaxf(fabsf(b.x), fabsf(b.y)), fmaxf(fabsf(b.z), fabsf(b.w))));
        m = fmaxf(m, fmaxf(fmaxf(fmaxf(fabsf(c.x), fabsf(c.y)), fmaxf(fabsf(c.z), fabsf(c.w))), fmaxf(fmaxf(fabsf(d.x), fabsf(d.y)), fmaxf(fabsf(d.z), fabsf(d.w)))));
#pragma unroll
        for (int s = 1; s < 64; s <<= 1) m = fmaxf(m, __shfl_xor(m, s));
        const float sc = m > 1e-30f ? 6.0f / m : 1.0f, isc = m > 1e-30f ? m * (1.0f / 6.0f) : 1.0f;
        unsigned w0 = 0u, w1 = 0u;
        w0 = __builtin_amdgcn_cvt_scalef32_pk_fp4_f32(w0, a.x * sc, a.y * sc, 1.0f, 0); w0 = __builtin_amdgcn_cvt_scalef32_pk_fp4_f32(w0, a.z * sc, a.w * sc, 1.0f, 1);
        w0 = __builtin_amdgcn_cvt_scalef32_pk_fp4_f32(w0, b.x * sc, b.y * sc, 1.0f, 2); w0 = __builtin_amdgcn_cvt_scalef32_pk_fp4_f32(w0, b.z * sc, b.w * sc, 1.0f, 3);
        w1 = __builtin_amdgcn_cvt_scalef32_pk_fp4_f32(w1, c.x * sc, c.y * sc, 1.0f, 0); w1 = __builtin_amdgcn_cvt_scalef32_pk_fp4_f32(w1, c.z * sc, c.w * sc, 1.0f, 1);
        w1 = __builtin_amdgcn_cvt_scalef32_pk_fp4_f32(w1, d.x * sc, d.y * sc, 1.0f, 2); w1 = __builtin_amdgcn_cvt_scalef32_pk_fp4_f32(w1, d.z * sc, d.w * sc, 1.0f, 3);
        *(uint2*)(dst + (size_t)row * (DM / 2) + lane * 8) = make_uint2(w0, w1);
        if (lane == 0) inv[row] = isc;
    }
}
template <int OFFS>
DI void cvt_i8_rows(const float* __restrict__ src, unsigned char* __restrict__ dst, float* __restrict__ inv, int bid, int nb) {
    const int lane = my_tid() & 63, wid = my_tid() >> 6;
    for (int row = bid * 8 + wid; row < NEXP; row += nb * 8) {
        const float* sp = src + (size_t)row * DM + lane * 16;
        const f32x4 a = *(const f32x4*)sp, b = *(const f32x4*)(sp + 4), c = *(const f32x4*)(sp + 8), d = *(const f32x4*)(sp + 12);
        float m = fmaxf(fmaxf(fmaxf(fabsf(a.x), fabsf(a.y)), fmaxf(fabsf(a.z), fabsf(a.w))), fmaxf(fmaxf(fabsf(b.x), fabsf(b.y)), fmaxf(fabsf(b.z), fabsf(b.w))));
        m = fmaxf(m, fmaxf(fmaxf(fmaxf(fabsf(c.x), fabsf(c.y)), fmaxf(fabsf(c.z), fabsf(c.w))), fmaxf(fmaxf(fabsf(d.x), fabsf(d.y)), fmaxf(fabsf(d.z), fabsf(d.w)))));
#pragma unroll
        for (int s = 1; s < 64; s <<= 1) m = fmaxf(m, __shfl_xor(m, s));
        const float sc = m > 1e-30f ? 127.0f / m : 1.0f, isc = m > 1e-30f ? m * (1.0f / 127.0f) : 1.0f;
        const float v[16] = {a.x, a.y, a.z, a.w, b.x, b.y, b.z, b.w, c.x, c.y, c.z, c.w, d.x, d.y, d.z, d.w};
        unsigned w[4];
#pragma unroll
        for (int q = 0; q < 4; ++q) {
            unsigned pk = 0u;
#pragma unroll
            for (int e = 0; e < 4; ++e) { const int qi = (int)rintf(v[q * 4 + e] * sc) + OFFS; pk |= ((unsigned)qi & 0xffu) << (8 * e); }
            w[q] = pk;
        }
        *(u32x4*)(dst + (size_t)row * DM + lane * 16) = (u32x4){w[0], w[1], w[2], w[3]};
        if (lane == 0) inv[row] = isc;
    }
}
DI void phase_mod(const Params& p, int bid, int nb, char* smem) {
    for (int it = bid; it < 192; it += nb) prep_mod_item(p, it, smem);
}
DI void phase_prep(const Params& p, int bid, int nb, char* smem) {
    constexpr int N_LB = 1, N_S5 = 32, T_WIN = 16 * 40, T_GLU = 8 * 8, T_WOUT = 16 * 16, T_WQ = 16 * 32;
    constexpr int I_S5 = N_LB, I_WIN = I_S5 + N_S5, I_GLU = I_WIN + T_WIN, I_WOUT = I_GLU + T_GLU, I_WQ = I_WOUT + T_WOUT, I_END = I_WQ + T_WQ;
    for (int it = bid; it < I_END; it += nb) {
        if (it < I_S5) {
            const int j = my_tid();
            const float a0 = p.hg_lb[j], a1 = p.hg_lb[512 + j], m = fmaxf(a0, a1);
            const float e0 = expf(a0 - m), e1 = expf(a1 - m);
            ((float*)(p.ws + OFF_LB))[j] = e0 / (e0 + e1);
        } else if (it < I_WIN) { prep_s5_gemm_item(p, it - I_S5, smem); }
        else if (it < I_GLU) { const int t = it - I_WIN; prep_transpose_tile(p.w_in, (bf16_t*)(p.ws + OFF_WIN), DM, INC, t / 40, t % 40, smem); }
        else if (it < I_WOUT) { const int t = it - I_GLU; prep_transpose_tile(p.glu_w, (bf16_t*)(p.ws + OFF_GLU), 512, 512, t / 8, t % 8, smem); }
        else if (it < I_WQ) { const int t = it - I_WOUT; prep_transpose_tile(p.w_out, (bf16_t*)(p.ws + OFF_WOUT), DM, DM, t / 16, t % 16, smem); }
        else { const int t = it - I_WQ; prep_transpose_tile(p.w_q, (bf16_t*)(p.ws + OFF_WQ), DM, 2048, t / 32, t % 32, smem); }
    }
    cvt_bf16_stream(p.subk, (bf16_t*)(p.ws + OFF_SUBK), (size_t)16 * 128 * 128 / 8, bid, nb);
    cvt_i8_rows<0>(p.pu, (unsigned char*)(p.ws + OFF_UT), (float*)(p.ws + OFF_SU), bid, nb);
    cvt_i8_rows<128>(p.pv, (unsigned char*)(p.ws + OFF_VT), (float*)(p.ws + OFF_SV), bid, nb);
}

DI void phase_h(const Params& p, int bid, int nb) {
    const float* mod = (const float*)(p.ws + OFF_MOD);
    bf16_t* H = (bf16_t*)(p.ws + OFF_H);
    const size_t n8 = (size_t)NTOK * DM / 8;
    for (size_t i = (size_t)bid * NTH + my_tid(); i < n8; i += (size_t)nb * NTH) {
        const int row = (int)(i >> 7), c0 = (int)(i & 127) * 8, b = row / SEQ;
        const float* sh = mod + b * 6144 + c0;
        const float* sc = sh + 1024;
        const float4 a = *(const float4*)(p.x + i * 8), bq = *(const float4*)(p.x + i * 8 + 4);
        const float4 s0 = *(const float4*)sc, s1 = *(const float4*)(sc + 4), h0 = *(const float4*)sh, h1 = *(const float4*)(sh + 4);
        uint4 o;
        o.x = pack2(a.x * (1.f + s0.x) + h0.x, a.y * (1.f + s0.y) + h0.y);
        o.y = pack2(a.z * (1.f + s0.z) + h0.z, a.w * (1.f + s0.w) + h0.w);
        o.z = pack2(bq.x * (1.f + s1.x) + h1.x, bq.y * (1.f + s1.y) + h1.y);
        o.w = pack2(bq.z * (1.f + s1.z) + h1.z, bq.w * (1.f + s1.w) + h1.w);
        *(uint4*)(H + i * 8) = o;
    }
}

DI void phase_proj(const Params& p, int bid, int nb, char* smem) {
    pg8::Gemm g{(const bf16_t*)(p.ws + OFF_H), (const bf16_t*)(p.ws + OFF_WIN), NTOK, INC, DM};
    pg8::StaticOrder S; S.init(NTOK, INC, nb, bid);
    pg8::EpiBf16Act E{(bf16_t*)(p.ws + OFF_PROJ), INC, 0xC3u};
    pg8::gemm_phase<pg8::EpiBf16Act, pg8::StaticOrder, false>((PG8_LAS unsigned char*)smem, g, S, E, nullptr);
}

DI void hgrn_item(const Params& p, int item, char* smem) {
    const int vs = item & 7, hd = (item >> 3) & 3, b = item >> 5;
    const bf16_t* P = (const bf16_t*)(p.ws + OFF_PROJ);
    const float* lb = (const float*)(p.ws + OFF_LB) + hd * HDK;
    float* ORAW = (float*)(p.ws + OFF_ORAW);
    float* sq = (float*)smem;
    float* sf = sq + 32 * 128;
    float* sv = sf + 32 * 128;
    float* sp = sv + 32 * 16;
    const int tid = my_tid(), lane = tid & 63, wid = tid >> 6, kq = tid >> 4, v = tid & 15;
    float S0 = 0.f, S1 = 0.f, S2 = 0.f, S3 = 0.f;
    for (int t0 = 0; t0 < SEQ; t0 += 32) {
        for (int i = tid; i < 32 * 128; i += NTH) {
            const int t = i >> 7, k = i & 127;
            const bf16_t* row = P + (size_t)(b * SEQ + t0 + t) * INC + hd * HDK + k;
            sq[i] = bf2f(row[0]);
            const float l = lb[k];
            sf[i] = l + (1.0f - l) * sigmoidf_(bf2f(row[512]));
        }
        { const int t = tid >> 4; sv[tid] = bf2f(P[(size_t)(b * SEQ + t0 + t) * INC + 1024 + hd * HDK + vs * 16 + v]); }
        __syncthreads();
        for (int t = 0; t < 32; ++t) {
            const float4 f4 = *(const float4*)(sf + t * 128 + kq * 4), q4 = *(const float4*)(sq + t * 128 + kq * 4);
            const float vv = sv[t * 16 + v];
            S0 = f4.x * S0 + (1.0f - f4.x) * vv; S1 = f4.y * S1 + (1.0f - f4.y) * vv;
            S2 = f4.z * S2 + (1.0f - f4.z) * vv; S3 = f4.w * S3 + (1.0f - f4.w) * vv;
            float part = q4.x * S0 + q4.y * S1 + q4.z * S2 + q4.w * S3;
            part += __shfl_xor(part, 16); part += __shfl_xor(part, 32);
            if (lane < 16) sp[(t * 8 + wid) * 16 + v] = part;
        }
        __syncthreads();
        {
            const int t = tid >> 4;
            float o = 0.f;
#pragma unroll
            for (int w = 0; w < 8; ++w) o += sp[(t * 8 + w) * 16 + v];
            ORAW[(size_t)(b * SEQ + t0 + t) * DHG + hd * HDK + vs * 16 + v] = o;
        }
        __syncthreads();
    }
}
DI void s5_item(const Params& p, int item, char* smem) {
    const int oct = item & 3, b = item >> 2;
    const int tid = my_tid(), lane = tid & 63, wid = tid >> 6, g = oct * 8 + wid;
    const bf16_t* P = (const bf16_t*)(p.ws + OFF_PROJ);
    bf16_t* Y = (bf16_t*)(p.ws + OFF_YSSM);
    float* su = (float*)smem + wid * 64 * 16;
    const float* lam = (const float*)(p.ws + OFF_LAM) + (g * SSP + lane) * 2;
    const float lr = lam[0], li = lam[1];
    const float* bb = (const float*)(p.ws + OFF_BB) + (size_t)(g * SSP + lane) * 32;
    float bbr[16], bbi[16], cr[16], ci[16];
#pragma unroll
    for (int i = 0; i < 16; ++i) { bbr[i] = bb[2 * i]; bbi[i] = bb[2 * i + 1]; cr[i] = p.c_re[(g * SSC + i) * SSP + lane]; ci[i] = p.c_im[(g * SSC + i) * SSP + lane]; }
    const int ch = (lane >> 2) & 15;
    const float dch = p.dsk[g * SSC + ch];
    float xr = 0.f, xi = 0.f;
    for (int t0 = 0; t0 < SEQ; t0 += 64) {
        {
            const uint4* src = (const uint4*)(P + (size_t)(b * SEQ + t0 + lane) * INC + 2048 + g * SSC);
            const uint4 a = src[0], c = src[1];
            float* d = su + lane * 16;
            d[0] = bflo(a.x); d[1] = bfhi(a.x); d[2] = bflo(a.y); d[3] = bfhi(a.y); d[4] = bflo(a.z); d[5] = bfhi(a.z); d[6] = bflo(a.w); d[7] = bfhi(a.w);
            d[8] = bflo(c.x); d[9] = bfhi(c.x); d[10] = bflo(c.y); d[11] = bfhi(c.y); d[12] = bflo(c.z); d[13] = bfhi(c.z); d[14] = bflo(c.w); d[15] = bfhi(c.w);
        }
        __syncthreads();
        for (int t = 0; t < 64; ++t) {
            float u[16];
            const float4* us = (const float4*)(su + t * 16);
            const float4 u0 = us[0], u1 = us[1], u2 = us[2], u3 = us[3];
            u[0] = u0.x; u[1] = u0.y; u[2] = u0.z; u[3] = u0.w; u[4] = u1.x; u[5] = u1.y; u[6] = u1.z; u[7] = u1.w;
            u[8] = u2.x; u[9] = u2.y; u[10] = u2.z; u[11] = u2.w; u[12] = u3.x; u[13] = u3.y; u[14] = u3.z; u[15] = u3.w;
            float bur = 0.f, bui = 0.f;
#pragma unroll
            for (int i = 0; i < 16; ++i) { bur += bbr[i] * u[i]; bui += bbi[i] * u[i]; }
            const float nxr = lr * xr - li * xi + bur, nxi = lr * xi + li * xr + bui;
            xr = nxr; xi = nxi;
            float y[16];
#pragma unroll
            for (int i = 0; i < 16; ++i) y[i] = cr[i] * xr - ci[i] * xi;
            const bool b5 = lane & 32, b4 = lane & 16, b3 = lane & 8, b2 = lane & 4;
            float y8[8], y4[4], y2[2];
#pragma unroll
            for (int j = 0; j < 8; ++j) { const float keep = b5 ? y[8 + j] : y[j], send = b5 ? y[j] : y[8 + j]; y8[j] = keep + __shfl_xor(send, 32); }
#pragma unroll
            for (int j = 0; j < 4; ++j) { const float keep = b4 ? y8[4 + j] : y8[j], send = b4 ? y8[j] : y8[4 + j]; y4[j] = keep + __shfl_xor(send, 16); }
#pragma unroll
            for (int j = 0; j < 2; ++j) { const float keep = b3 ? y4[2 + j] : y4[j], send = b3 ? y4[j] : y4[2 + j]; y2[j] = keep + __shfl_xor(send, 8); }
            float y1;
            { const float keep = b2 ? y2[1] : y2[0], send = b2 ? y2[0] : y2[1]; y1 = keep + __shfl_xor(send, 4); }
            y1 += __shfl_xor(y1, 1); y1 += __shfl_xor(y1, 2);
            if ((lane & 3) == 0) {
                const float uu = su[t * 16 + ch];
                Y[(size_t)(b * SEQ + t0 + t) * DSS + g * SSC + ch] = f2bf(geluf_(y1 + dch * uu));
            }
        }
        __syncthreads();
    }
}
DI int crow(int i, int h) { return (i & 3) + 8 * (i >> 2) + 4 * h; }
DI void phase_hgprep(const Params& p, int bid, int nb) {
    const bf16_t* P = (const bf16_t*)(p.ws + OFF_PROJ);
    const float* lbp = (const float*)(p.ws + OFF_LB);
    const int tid = my_tid(), lane = tid & 63, wid = tid >> 6, tq = lane >> 4, cg = lane & 15;
#pragma unroll 1
    for (int it = bid * 8 + wid; it < 8192; it += nb * 8) {
        const int tile = it >> 1, c = tile & 63, hd = (tile >> 6) & 3, b = tile >> 8, k0 = (it & 1) * 64 + cg * 4;
        const bf16_t* base = P + (size_t)(b * SEQ + c * 32 + tq * 8) * INC + hd * HDK + k0;
        uint2 qw[8], fw[8];
#pragma unroll
        for (int tt = 0; tt < 8; ++tt) { qw[tt] = *(const uint2*)(base + (size_t)tt * INC); fw[tt] = *(const uint2*)(base + (size_t)tt * INC + 512); }
        const f32x4 l4 = *(const f32x4*)(lbp + hd * HDK + k0);
        const float lb4[4] = {l4.x, l4.y, l4.z, l4.w};
        float bl[8][4], kk[8][4], run[4];
#pragma unroll
        for (int e = 0; e < 4; ++e) run[e] = 0.f;
#pragma unroll
        for (int tt = 0; tt < 8; ++tt) {
            const float fl[4] = {bflo(fw[tt].x), bfhi(fw[tt].x), bflo(fw[tt].y), bfhi(fw[tt].y)};
#pragma unroll
            for (int e = 0; e < 4; ++e) {
                const float f = lb4[e] + (1.0f - lb4[e]) * sigmoidf_(fl[e]);
                run[e] += __logf(f); bl[tt][e] = run[e]; kk[tt][e] = 1.0f - f;
            }
        }
        float off[4], tot[4];
#pragma unroll
        for (int e = 0; e < 4; ++e) {
            const float t0 = __shfl(run[e], cg), t1 = __shfl(run[e], cg + 16), t2 = __shfl(run[e], cg + 32), t3 = __shfl(run[e], cg + 48);
            off[e] = (tq > 0 ? t0 : 0.f) + (tq > 1 ? t1 : 0.f) + (tq > 2 ? t2 : 0.f);
            tot[e] = (t0 + t1) + (t2 + t3);
        }
        bf16_t* HQ = (bf16_t*)(p.ws + OFF_HQ) + (size_t)tile * 4096 + (tq * 8) * 128 + k0;
        bf16_t* HK = (bf16_t*)(p.ws + OFF_HK) + (size_t)tile * 4096 + (tq * 8) * 128 + k0;
#pragma unroll
        for (int tt = 0; tt < 8; ++tt) {
            const float qv[4] = {bflo(qw[tt].x), bfhi(qw[tt].x), bflo(qw[tt].y), bfhi(qw[tt].y)};
            float qo[4], ko[4];
#pragma unroll
            for (int e = 0; e < 4; ++e) { const float bb = off[e] + bl[tt][e]; qo[e] = qv[e] * __expf(bb); ko[e] = kk[tt][e] * __expf(fminf(-bb, 80.0f)); }
            *(uint2*)(HQ + tt * 128) = make_uint2(pack2(qo[0], qo[1]), pack2(qo[2], qo[3]));
            *(uint2*)(HK + tt * 128) = make_uint2(pack2(ko[0], ko[1]), pack2(ko[2], ko[3]));
        }
        if (tq == 0) *(f32x4*)((float*)(p.ws + OFF_HG) + (size_t)tile * 128 + k0) = (f32x4){__expf(tot[0]), __expf(tot[1]), __expf(tot[2]), __expf(tot[3])};
    }
}
typedef short s16x4 __attribute__((ext_vector_type(4)));
DI bf16x8 cat8(const s16x4 lo, const s16x4 hi) { return (bf16x8){lo.x, lo.y, lo.z, lo.w, hi.x, hi.y, hi.z, hi.w}; }
DI s16x4 lds_tr(const char* a) { return __builtin_amdgcn_ds_read_tr16_b64_v4i16((__attribute__((address_space(3))) s16x4*)a); }
DI void hgrn_mfma_item(const Params& p, int item, char* smem) {
    constexpr int QP_OFF = 0, KP_OFF = 8704, V_OFF = 17408, G_OFF = 26112, BUF = 26624;
    const int tid = my_tid(), lane = tid & 63, wid = tid >> 6, r = lane & 31, h = lane >> 5;
    const int b = item >> 2, hd = item & 3;
    const size_t tile0 = (size_t)item * 64;
    const bf16_t* HQ = (const bf16_t*)(p.ws + OFF_HQ) + tile0 * 4096;
    const bf16_t* HK = (const bf16_t*)(p.ws + OFF_HK) + tile0 * 4096;
    const bf16_t* PV = (const bf16_t*)(p.ws + OFF_PROJ) + (size_t)b * SEQ * INC + 1024 + hd * HDK;
    const float* HG = (const float*)(p.ws + OFF_HG) + tile0 * 128;
    float* ORAW = (float*)(p.ws + OFF_ORAW) + (size_t)b * SEQ * DHG + hd * HDK;
    const bool helper = wid >= 4;
    const int ht = tid - 256;
    const int i0 = ht, i1 = ht + 256;
    const int lo0 = (i0 >> 4) * 272 + (i0 & 15) * 16, lo1 = (i1 >> 4) * 272 + (i1 & 15) * 16;
    u32x4 A0, A1, A2, A3, A4, A5, A6, B0, B1, B2, B3, B4, B5, B6;
    A0 = A1 = A2 = A3 = A4 = A5 = A6 = B0 = B1 = B2 = B3 = B4 = B5 = B6 = (u32x4){0, 0, 0, 0};
    f32x16 S[4];
#pragma unroll
    for (int kb = 0; kb < 4; ++kb)
#pragma unroll
        for (int i = 0; i < 16; ++i) S[kb][i] = 0.f;
#define HG_LOAD(X, c_) { const size_t o_ = (size_t)(c_) * 4096; \
        X##0 = *(const u32x4*)(HQ + o_ + i0 * 8); X##1 = *(const u32x4*)(HQ + o_ + i1 * 8); \
        X##2 = *(const u32x4*)(HK + o_ + i0 * 8); X##3 = *(const u32x4*)(HK + o_ + i1 * 8); \
        X##4 = *(const u32x4*)(PV + (size_t)((c_) * 32 + (i0 >> 4)) * INC + (i0 & 15) * 8); X##5 = *(const u32x4*)(PV + (size_t)((c_) * 32 + (i1 >> 4)) * INC + (i1 & 15) * 8); \
        if (ht < 32) X##6 = *(const u32x4*)(HG + (size_t)(c_) * 128 + ht * 4); }
#define HG_STORE(X, buf_) { char* B_ = smem + (buf_) * BUF; \
        *(u32x4*)(B_ + QP_OFF + lo0) = X##0; *(u32x4*)(B_ + QP_OFF + lo1) = X##1; \
        *(u32x4*)(B_ + KP_OFF + lo0) = X##2; *(u32x4*)(B_ + KP_OFF + lo1) = X##3; \
        *(u32x4*)(B_ + V_OFF + lo0) = X##4; *(u32x4*)(B_ + V_OFF + lo1) = X##5; \
        if (ht < 32) *(u32x4*)(B_ + G_OFF + ht * 16) = X##6; }
    const int tq = (lane >> 2) & 3, tp = lane & 3, tg = lane >> 4;
    const int tr_nat = (8 * (tg >> 1) + tq) * 272 + (16 * (tg & 1) + 4 * tp) * 2;
    const int tr_krw = (4 * (tg >> 1) + tq) * 272 + (16 * (tg & 1) + 4 * tp) * 2;
    if (helper) { HG_LOAD(A, 0); HG_STORE(A, 0); HG_LOAD(A, 1); HG_STORE(A, 1); HG_LOAD(A, 2); HG_LOAD(B, 3); }
    __syncthreads();
#define HG_COMPUTE(c_) { \
        const char* B = smem + ((c_) % 3) * BUF; const int w = wid; \
        f32x16 pt; _Pragma("unroll") for (int i = 0; i < 16; ++i) pt[i] = 0.f; \
        _Pragma("unroll") for (int ks = 0; ks < 8; ++ks) { \
            const bf16x8 a = *(const bf16x8*)(B + KP_OFF + r * 272 + ks * 32 + h * 16); \
            const bf16x8 bq = *(const bf16x8*)(B + QP_OFF + r * 272 + ks * 32 + h * 16); \
            pt = __builtin_amdgcn_mfma_f32_32x32x16_bf16(a, bq, pt, 0, 0, 0); } \
        _Pragma("unroll") for (int i = 0; i < 16; ++i) if (crow(i, h) > r) pt[i] = 0.f; \
        f32x16 o; _Pragma("unroll") for (int i = 0; i < 16; ++i) o[i] = 0.f; \
        _Pragma("unroll") for (int sp = 0; sp < 2; ++sp) { \
            const char* vb = B + V_OFF + (16 * sp) * 272 + (32 * w) * 2 + tr_krw; \
            const bf16x8 bv = cat8(lds_tr(vb), lds_tr(vb + 8 * 272)); \
            o = __builtin_amdgcn_mfma_f32_32x32x16_bf16(pack8(pt, 8 * sp), bv, o, 0, 0, 0); } \
        _Pragma("unroll") for (int kb = 0; kb < 4; ++kb) _Pragma("unroll") for (int sp = 0; sp < 2; ++sp) { \
            const char* qb = B + QP_OFF + r * 272 + kb * 64 + sp * 32 + h * 8; \
            const bf16x8 aq = cat8(*(const s16x4*)qb, *(const s16x4*)(qb + 16)); \
            o = __builtin_amdgcn_mfma_f32_32x32x16_bf16(aq, pack8(S[kb], 8 * sp), o, 0, 0, 0); } \
        _Pragma("unroll") for (int i = 0; i < 16; ++i) ORAW[(size_t)((c_) * 32 + crow(i, h)) * DHG + 32 * w + r] = o[i]; \
        bf16x8 bvn[2]; \
        _Pragma("unroll") for (int ks = 0; ks < 2; ++ks) { const char* vb = B + V_OFF + (16 * ks) * 272 + (32 * w) * 2 + tr_nat; bvn[ks] = cat8(lds_tr(vb), lds_tr(vb + 4 * 272)); } \
        _Pragma("unroll") for (int kb = 0; kb < 4; ++kb) { \
            _Pragma("unroll") for (int ks = 0; ks < 2; ++ks) { \
                const char* kp = B + KP_OFF + (16 * ks) * 272 + (32 * kb) * 2 + tr_nat; \
                const bf16x8 a = cat8(lds_tr(kp), lds_tr(kp + 4 * 272)); \
                S[kb] = __builtin_amdgcn_mfma_f32_32x32x16_bf16(a, bvn[ks], S[kb], 0, 0, 0); } \
            _Pragma("unroll") for (int j = 0; j < 4; ++j) { \
                const f32x4 g4 = *(const f32x4*)(B + G_OFF + (kb * 32 + 8 * j + 4 * h) * 4); \
                S[kb][4 * j] *= g4.x; S[kb][4 * j + 1] *= g4.y; S[kb][4 * j + 2] *= g4.z; S[kb][4 * j + 3] *= g4.w; } } }
    for (int c = 0; c < 64; c += 2) {
        if (helper) { if (c + 2 < 64) HG_STORE(A, (c + 2) % 3); if (c + 4 < 64) HG_LOAD(A, c + 4); } else HG_COMPUTE(c);
        __syncthreads();
        if (helper) { if (c + 3 < 64) HG_STORE(B, (c + 3) % 3); if (c + 5 < 64) HG_LOAD(B, c + 5); } else HG_COMPUTE(c + 1);
        __syncthreads();
    }
#undef HG_LOAD
#undef HG_STORE
#undef HG_COMPUTE
}
template <int NJ>
DI void s5_gemm2_tile(const bf16x8 (&af)[16], const bf16_t* KTl, const bf16_t* Xin, const bf16_t* MBg, bf16_t* Yout, bf16_t* stg, const int mi, const int r, const int h) {
    f32x16 y;
#pragma unroll
    for (int i = 0; i < 16; ++i) y[i] = 0.f;
    const int tsel = r >> 4, iq = r & 15;
    bf16x8 bm[8];
#pragma unroll
    for (int ks = 0; ks < 8; ++ks) bm[ks] = *(const bf16x8*)(MBg + (size_t)((NJ * 8 + ks) * 64 + h * 32 + r) * 8);
#pragma unroll
    for (int ks = 0; ks <= 2 * NJ; ++ks) {
        const bf16x8 bk = *(const bf16x8*)(KTl + ((2 * NJ + tsel - ks) * 16 + iq) * 16 + 8 * h);
        y = __builtin_amdgcn_mfma_f32_32x32x16_bf16(af[ks], bk, y, 0, 0, 0);
    }
    {
        bf16x8 bk = *(const bf16x8*)(KTl + iq * 16 + 8 * h);
        if (tsel == 0) bk = (bf16x8){0, 0, 0, 0, 0, 0, 0, 0};
        y = __builtin_amdgcn_mfma_f32_32x32x16_bf16(af[2 * NJ + 1], bk, y, 0, 0, 0);
    }
#pragma unroll
    for (int ks = 0; ks < 8; ++ks) {
        const bf16x8 a = *(const bf16x8*)(Xin + (mi * 32 + r) * 136 + ks * 16 + 8 * h);
        y = __builtin_amdgcn_mfma_f32_32x32x16_bf16(a, bm[ks], y, 0, 0, 0);
    }
#pragma unroll
    for (int i = 0; i < 16; ++i) stg[((crow(i, h) * 2 + tsel) * 16) + iq] = f2bf(gelu_as(y[i]));
    {
        const int lane = h * 32 + r, cl = lane >> 1, ts = lane & 1;
        const u32x4 lo = *(const u32x4*)(stg + lane * 16), hi = *(const u32x4*)(stg + lane * 16 + 8);
        bf16_t* dst = Yout + (size_t)((mi * 32 + cl) * 16 + 2 * NJ + ts) * DSS;
        *(u32x4*)dst = lo; *(u32x4*)(dst + 8) = hi;
    }
}
DI void s5_gemm_item(const Params& p, int b, int g, char* smem) {
    float* E = (float*)smem;
    bf16_t* Xin = (bf16_t*)(smem + 128 * 132 * 4);
    bf16_t* KTl = Xin + 128 * 136;
    const int tid = my_tid(), lane = tid & 63, wid = tid >> 6, r = lane & 31, h = lane >> 5;
    const int mi = wid >> 1, wh = wid & 1;
    const bf16_t* P = (const bf16_t*)(p.ws + OFF_PROJ);
    *(u32x4*)(KTl + tid * 8) = *(const u32x4*)((const bf16_t*)(p.ws + OFF_S5K) + (size_t)g * 4096 + tid * 8);
    bf16x8 af[16];
    {
        const bf16_t* ub = P + (size_t)(b * SEQ + (mi * 32 + r) * 16) * INC + 2048 + g * 16 + 8 * h;
#pragma unroll
        for (int ks = 0; ks < 16; ++ks) af[ks] = *(const bf16x8*)(ub + (size_t)ks * INC);
    }
#ifndef S5_REP_G1
#define S5_REP_G1 1
#define S5_REP_SC 1
#define S5_REP_G2 1
#endif
    for (int rp1 = 0; rp1 < S5_REP_G1; ++rp1)
    {
        f32x16 e0, e1;
#pragma unroll
        for (int i = 0; i < 16; ++i) { e0[i] = 0.f; e1[i] = 0.f; }
        const bf16_t* nb0 = (const bf16_t*)(p.ws + OFF_S5N) + (size_t)g * 128 * 256 + (size_t)(wh * 2) * 16 * 512 + lane * 8;
#pragma unroll
        for (int ks = 0; ks < 16; ++ks) {
            const bf16x8 b0 = *(const bf16x8*)(nb0 + ks * 512), b1 = *(const bf16x8*)(nb0 + 16 * 512 + ks * 512);
            e0 = __builtin_amdgcn_mfma_f32_32x32x16_bf16(af[ks], b0, e0, 0, 0, 0);
            e1 = __builtin_amdgcn_mfma_f32_32x32x16_bf16(af[ks], b1, e1, 0, 0, 0);
        }
#pragma unroll
        for (int i = 0; i < 16; ++i) { float* er = E + (mi * 32 + crow(i, h)) * 132 + wh * 64 + r; er[0] = e0[i]; er[32] = e1[i]; }
    }
    __syncthreads();
    for (int rp2 = 0; rp2 < S5_REP_SC; ++rp2)
    if (wid == 0) {
        const float* L = (const float*)(p.ws + OFF_S5L) + (g * 64 + lane) * 2;
        const float lr = L[0], li = L[1];
        float xr = 0.f, xi = 0.f;
#pragma unroll 8
        for (int c = 0; c < 128; ++c) {
            const float er = E[c * 132 + lane], ei = E[c * 132 + 64 + lane];
            Xin[c * 136 + lane] = f2bf(xr); Xin[c * 136 + 64 + lane] = f2bf(xi);
            const float nr = lr * xr - li * xi + er, ni = lr * xi + li * xr + ei;
            xr = nr; xi = ni;
        }
    }
    __syncthreads();
    const bf16_t* MBg = (const bf16_t*)(p.ws + OFF_S5M) + (size_t)g * 256 * 128;
    bf16_t* Yout = (bf16_t*)(p.ws + OFF_YSSM) + (size_t)b * SEQ * DSS + g * 16;
    bf16_t* stg = (bf16_t*)smem + wid * 1024;
    for (int rp3 = 0; rp3 < S5_REP_G2; ++rp3)
    if (wh) {
        s5_gemm2_tile<1>(af, KTl, Xin, MBg, Yout, stg, mi, r, h); s5_gemm2_tile<6>(af, KTl, Xin, MBg, Yout, stg, mi, r, h);
        s5_gemm2_tile<3>(af, KTl, Xin, MBg, Yout, stg, mi, r, h); s5_gemm2_tile<4>(af, KTl, Xin, MBg, Yout, stg, mi, r, h);
    } else {
        s5_gemm2_tile<0>(af, KTl, Xin, MBg, Yout, stg, mi, r, h); s5_gemm2_tile<7>(af, KTl, Xin, MBg, Yout, stg, mi, r, h);
        s5_gemm2_tile<2>(af, KTl, Xin, MBg, Yout, stg, mi, r, h); s5_gemm2_tile<5>(af, KTl, Xin, MBg, Yout, stg, mi, r, h);
    }
    __syncthreads();
}
DI void phase_mix(const Params& p, int bid, int nb, char* smem) {
    if (nb == 256) {
#ifndef PROBE_HGX
#define PROBE_HGX 1
#endif
        if (bid < 64) { for (int rep = 0; rep < PROBE_HGX; ++rep) hgrn_mfma_item(p, bid, smem); return; }
        const int j = bid - 64, x = j & 7, lb = j >> 3;
#ifndef PROBE_S5X
#define PROBE_S5X 1
#endif
        for (int rep = 0; rep < PROBE_S5X; ++rep)
        for (int q = lb; q < 64; q += 24) s5_gemm_item(p, q & 15, x * 4 + (q >> 4), smem);
    } else {
        for (int it = bid; it < 64; it += nb) hgrn_mfma_item(p, it, smem);
        for (int q = bid; q < 512; q += nb) s5_gemm_item(p, q & 15, q >> 4, smem);
    }
}

DI void phase_glu(const Params& p, int bid, int nb, char* smem) {
    pg8::Gemm g{(const bf16_t*)(p.ws + OFF_YSSM), (const bf16_t*)(p.ws + OFF_GLU), NTOK, 512, 512};
    pg8::StaticOrder S; S.init(NTOK, 512, nb, bid);
    pg8::EpiGlu E{(float*)(p.ws + OFF_H), (const bf16_t*)(p.ws + OFF_YSSM), p.glu_b};
    pg8::gemm_phase<pg8::EpiGlu, pg8::StaticOrder, false>((PG8_LAS unsigned char*)smem, g, S, E, nullptr);
}
DI void phase_a2(const Params& p, int bid, int nb) {
    const float* ORAW = (const float*)(p.ws + OFF_ORAW);
    const float* Y2 = (const float*)(p.ws + OFF_H);
    const bf16_t* P = (const bf16_t*)(p.ws + OFF_PROJ);
    bf16_t* A2 = (bf16_t*)(p.ws + OFF_A2);
    const int lane = my_tid() & 63, wid = my_tid() >> 6;
    for (int tok = bid * 8 + wid; tok < NTOK; tok += nb * 8) {
        const int c0 = lane * 8;
        {
            const float4 a = *(const float4*)(ORAW + (size_t)tok * DHG + c0), b = *(const float4*)(ORAW + (size_t)tok * DHG + c0 + 4);
            float ss = a.x * a.x + a.y * a.y + a.z * a.z + a.w * a.w + b.x * b.x + b.y * b.y + b.z * b.z + b.w * b.w;
            ss += __shfl_xor(ss, 1); ss += __shfl_xor(ss, 2); ss += __shfl_xor(ss, 4); ss += __shfl_xor(ss, 8);
            const float rs = rsqrtf(ss * (1.0f / 128.0f) + RMS_EPS);
            const uint4 gq = *(const uint4*)(P + (size_t)tok * INC + 1536 + c0);
            const float4 w0 = *(const float4*)(p.hg_nw + c0), w1 = *(const float4*)(p.hg_nw + c0 + 4);
            uint4 o;
            o.x = pack2(a.x * rs * w0.x * bflo(gq.x), a.y * rs * w0.y * bfhi(gq.x));
            o.y = pack2(a.z * rs * w0.z * bflo(gq.y), a.w * rs * w0.w * bfhi(gq.y));
            o.z = pack2(b.x * rs * w1.x * bflo(gq.z), b.y * rs * w1.y * bfhi(gq.z));
            o.w = pack2(b.z * rs * w1.z * bflo(gq.w), b.w * rs * w1.w * bfhi(gq.w));
            *(uint4*)(A2 + (size_t)tok * DM + c0) = o;
        }
        {
            const float4 a = *(const float4*)(Y2 + (size_t)tok * DSS + c0), b = *(const float4*)(Y2 + (size_t)tok * DSS + c0 + 4);
            float ss = a.x * a.x + a.y * a.y + a.z * a.z + a.w * a.w + b.x * b.x + b.y * b.y + b.z * b.z + b.w * b.w;
#pragma unroll
            for (int m = 1; m < 64; m <<= 1) ss += __shfl_xor(ss, m);
            const float rs = rsqrtf(ss * (1.0f / 512.0f) + RMS_EPS);
            const float4 w0 = *(const float4*)(p.ssm_nw + c0), w1 = *(const float4*)(p.ssm_nw + c0 + 4);
            uint4 o;
            o.x = pack2(a.x * rs * w0.x, a.y * rs * w0.y); o.y = pack2(a.z * rs * w0.z, a.w * rs * w0.w);
            o.z = pack2(b.x * rs * w1.x, b.y * rs * w1.y); o.w = pack2(b.z * rs * w1.z, b.w * rs * w1.w);
            *(uint4*)(A2 + (size_t)tok * DM + 512 + c0) = o;
        }
    }
}

DI void phase_outproj(const Params& p, int bid, int nb, char* smem) {
    pg8::Gemm g{(const bf16_t*)(p.ws + OFF_A2), (const bf16_t*)(p.ws + OFF_WOUT), NTOK, DM, DM};
    pg8::StaticOrder S; S.init(NTOK, DM, nb, bid);
    pg8::EpiResid E{p.out, p.x, (const float*)(p.ws + OFF_MOD) + 2048, DEEP_ALPHA};
    pg8::gemm_phase<pg8::EpiResid, pg8::StaticOrder, false>((PG8_LAS unsigned char*)smem, g, S, E, nullptr);
}
DI void phase_ln1(const Params& p, int bid, int nb) {
    const float* mod = (const float*)(p.ws + OFF_MOD);
    bf16_t* H2 = (bf16_t*)(p.ws + OFF_H);
    const int lane = my_tid() & 63, wid = my_tid() >> 6;
    for (int tok = bid * 8 + wid; tok < NTOK; tok += nb * 8) {
        const int b = tok / SEQ;
        float* row = p.out + (size_t)tok * DM;
        float4 v[4];
        float s = 0.f;
#pragma unroll
        for (int j = 0; j < 4; ++j) { v[j] = *(const float4*)(row + j * 256 + lane * 4); s += v[j].x + v[j].y + v[j].z + v[j].w; }
#pragma unroll
        for (int m = 1; m < 64; m <<= 1) s += __shfl_xor(s, m);
        const float mu = s * (1.0f / 1024.0f);
        float q = 0.f;
#pragma unroll
        for (int j = 0; j < 4; ++j) { const float a = v[j].x - mu, bb = v[j].y - mu, cc = v[j].z - mu, d = v[j].w - mu; q += a * a + bb * bb + cc * cc + d * d; }
#pragma unroll
        for (int m = 1; m < 64; m <<= 1) q += __shfl_xor(q, m);
        const float rstd = rsqrtf(q * (1.0f / 1024.0f) + LN_EPS);
        const float* sh2 = mod + b * 6144 + 3072;
        const float* sc2 = mod + b * 6144 + 4096;
#pragma unroll
        for (int j = 0; j < 4; ++j) {
            const int c = j * 256 + lane * 4;
            const float4 w = *(const float4*)(p.ln1w + c), bi = *(const float4*)(p.ln1b + c), sc = *(const float4*)(sc2 + c), sh = *(const float4*)(sh2 + c);
            float4 o;
            o.x = (v[j].x - mu) * rstd * w.x + bi.x; o.y = (v[j].y - mu) * rstd * w.y + bi.y; o.z = (v[j].z - mu) * rstd * w.z + bi.z; o.w = (v[j].w - mu) * rstd * w.w + bi.w;
            *(float4*)(row + c) = o;
            uint2 hh; hh.x = pack2(o.x * (1.f + sc.x) + sh.x, o.y * (1.f + sc.y) + sh.y); hh.y = pack2(o.z * (1.f + sc.z) + sh.z, o.w * (1.f + sc.w) + sh.w);
            *(uint2*)(H2 + (size_t)tok * DM + c) = hh;
        }
    }
}

DI void phase_q(const Params& p, int bid, int nb, char* smem) {
    pg8::Gemm g{(const bf16_t*)(p.ws + OFF_H), (const bf16_t*)(p.ws + OFF_WQ), NTOK, 2048, DM};
    pg8::StaticOrder S; S.init(NTOK, 2048, nb, bid);
    pg8::EpiBf16Act E{(bf16_t*)(p.ws + OFF_PROJ), 2048, 0u};
    pg8::gemm_phase<pg8::EpiBf16Act, pg8::StaticOrder, false>((PG8_LAS unsigned char*)smem, g, S, E, nullptr);
}
DI void phase_topk(const Params& p, int bid, int nb, char* smem) {
    const bf16_t* Q = (const bf16_t*)(p.ws + OFF_PROJ);
    const bf16_t* SK = (const bf16_t*)(p.ws + OFF_SUBK);
    unsigned* TOPL = (unsigned*)(p.ws + OFF_TOPL);
    float* sc = (float*)(smem + 36864);
    constexpr int NTM = NTOK / 128;
    for (int t = bid; t < NTM * 16; t += nb) {
        const int mt = t >> 4, hp = t & 15;
        gemm_block<2, 1, 2, 4>(Q + (size_t)mt * 128 * 2048 + hp * 128, 2048, SK + (size_t)hp * 128 * 128, 128, 128, smem,
                               [&](int r, int c, float v) { sc[r * 129 + c] = v; });
        __syncthreads();
        if (my_tid() < 128) {
            const int r = my_tid();
            float tk[16];
#pragma unroll
            for (int j = 0; j < 16; ++j) tk[j] = -3.0e38f;
            for (int n = 0; n < 128; ++n) {
                float xv = __uint_as_float((__float_as_uint(sc[r * 129 + n]) & ~0x7fu) | (unsigned)n);
#pragma unroll
                for (int j = 0; j < 16; ++j) { const float hi = fmaxf(tk[j], xv), lo = fminf(tk[j], xv); tk[j] = hi; xv = lo; }
            }
            uint4* dst = (uint4*)(TOPL + ((size_t)(mt * 128 + r) * 16 + hp) * 16);
            dst[0] = make_uint4(__float_as_uint(tk[0]), __float_as_uint(tk[1]), __float_as_uint(tk[2]), __float_as_uint(tk[3]));
            dst[1] = make_uint4(__float_as_uint(tk[4]), __float_as_uint(tk[5]), __float_as_uint(tk[6]), __float_as_uint(tk[7]));
            dst[2] = make_uint4(__float_as_uint(tk[8]), __float_as_uint(tk[9]), __float_as_uint(tk[10]), __float_as_uint(tk[11]));
            dst[3] = make_uint4(__float_as_uint(tk[12]), __float_as_uint(tk[13]), __float_as_uint(tk[14]), __float_as_uint(tk[15]));
        }
        __syncthreads();
    }
}
DI void phase_combine(const Params& p, int bid, int nb) {
    const unsigned* TOPL = (const unsigned*)(p.ws + OFF_TOPL);
    uint2* EX = (uint2*)(p.ws + OFF_EXPS);
    const float* SU = (const float*)(p.ws + OFF_SU);
    const float* SV = (const float*)(p.ws + OFF_SV);
    for (int i = bid * NTH + my_tid(); i < NTOK * PHEADS; i += nb * NTH) {
        const unsigned* l1 = TOPL + (size_t)i * 32;
        const unsigned* l2 = l1 + 16;
        float s2[16];
        {
            const uint4 a = ((const uint4*)l2)[0], b = ((const uint4*)l2)[1], c = ((const uint4*)l2)[2], d = ((const uint4*)l2)[3];
            const unsigned w[16] = {a.x, a.y, a.z, a.w, b.x, b.y, b.z, b.w, c.x, c.y, c.z, c.w, d.x, d.y, d.z, d.w};
#pragma unroll
            for (int j = 0; j < 16; ++j) s2[j] = __uint_as_float(w[j] & ~0x7fu);
        }
        float tk[16];
#pragma unroll
        for (int j = 0; j < 16; ++j) tk[j] = -3.0e38f;
        for (int a = 0; a < 16; ++a) {
            const float s1 = __uint_as_float(l1[a] & ~0x7fu);
#pragma unroll
            for (int b = 0; b < 16; ++b) {
                float xv = __uint_as_float((__float_as_uint(s1 + s2[b]) & ~0xffu) | (unsigned)(a * 16 + b));
#pragma unroll
                for (int j = 0; j < 16; ++j) { const float hi = fmaxf(tk[j], xv), lo = fminf(tk[j], xv); tk[j] = hi; xv = lo; }
            }
        }
        float e[16], sum = 0.f;
        const float mx = __uint_as_float(__float_as_uint(tk[0]) & ~0xffu);
#pragma unroll
        for (int j = 0; j < 16; ++j) { e[j] = __expf(__uint_as_float(__float_as_uint(tk[j]) & ~0xffu) - mx); sum += e[j]; }
        const float inv = 1.0f / sum;
#pragma unroll
        for (int j = 0; j < 16; ++j) {
            const unsigned ab = __float_as_uint(tk[j]) & 0xffu;
            const unsigned i1 = l1[ab >> 4] & 0x7fu, i2 = l2[ab & 15] & 0x7fu;
            const unsigned eid = i1 * 128u + i2;
            EX[(size_t)i * 16 + j] = make_uint2(eid | (((__float_as_uint(SU[eid]) >> 23) & 0xffu) << 16), __float_as_uint(e[j] * inv * SV[eid]));
        }
    }
}

DI void ce_desc(float& a, float& b) { const float hi = fmaxf(a, b), lo = fminf(a, b); a = hi; b = lo; }
template <int N> DI void bitonic_sort_desc(float (&v)[N]) {
#pragma unroll
    for (int k = 2; k <= N; k <<= 1)
#pragma unroll
        for (int j = k >> 1; j > 0; j >>= 1)
#pragma unroll
            for (int i = 0; i < N; ++i) { const int l = i ^ j; if (l > i) { if ((i & k) == 0 || k == N) ce_desc(v[i], v[l]); else ce_desc(v[l], v[i]); } }
}
DI void merge_top16(float (&a)[16], const float (&b)[16]) {
#pragma unroll
    for (int i = 0; i < 16; ++i) a[i] = fmaxf(a[i], b[15 - i]);
#pragma unroll
    for (int j = 8; j > 0; j >>= 1)
#pragma unroll
        for (int i = 0; i < 16; ++i) { const int l = i ^ j; if (l > i) ce_desc(a[i], a[l]); }
}
DI void xlane_merge16(float (&a)[16]) {
    float o[16];
#pragma unroll
    for (int i = 0; i < 16; ++i) o[i] = __shfl_xor(a[i], 32);
    merge_top16(a, o);
}
DI void retrieve_topk_hp(const bf16_t* Q, const char* skl, const int tok, const int hp, const int r, const int h, unsigned char* lutp, float (&out)[16]) {
                f32x16 acc[4];
#pragma unroll
                for (int mi = 0; mi < 4; ++mi)
#pragma unroll
                    for (int i = 0; i < 16; ++i) acc[mi][i] = 0.f;
                const bf16_t* qb = Q + (size_t)tok * 2048 + hp * 128 + 8 * h;
                const char* kb = skl + r * 272 + h * 16;
#pragma unroll
                for (int ks = 0; ks < 8; ++ks) {
                    const bf16x8 bq = *(const bf16x8*)(qb + ks * 16);
#pragma unroll
                    for (int mi = 0; mi < 4; ++mi) {
                        const bf16x8 a = *(const bf16x8*)(kb + mi * 32 * 272 + ks * 32);
                        acc[mi] = __builtin_amdgcn_mfma_f32_32x32x16_bf16(a, bq, acc[mi], 0, 0, 0);
                    }
                }
                float v0[16], v1[16], v2[16], v3[16];
#pragma unroll
                for (int i = 0; i < 16; ++i) {
                    const unsigned n = (unsigned)crow(i, h);
                    v0[i] = __uint_as_float((__float_as_uint(acc[0][i]) & ~0x7fu) | n);
                    v1[i] = __uint_as_float((__float_as_uint(acc[1][i]) & ~0x7fu) | (n + 32u));
                    v2[i] = __uint_as_float((__float_as_uint(acc[2][i]) & ~0x7fu) | (n + 64u));
                    v3[i] = __uint_as_float((__float_as_uint(acc[3][i]) & ~0x7fu) | (n + 96u));
                }
                bitonic_sort_desc<16>(v0); bitonic_sort_desc<16>(v1); bitonic_sort_desc<16>(v2); bitonic_sort_desc<16>(v3);
                merge_top16(v0, v1); merge_top16(v2, v3); merge_top16(v0, v2);
                xlane_merge16(v0);
#pragma unroll
                for (int i = 0; i < 16; ++i) out[i] = v0[i];
                u32x4 ix;
                ix.x = (__float_as_uint(v0[0]) & 0x7fu) | ((__float_as_uint(v0[1]) & 0x7fu) << 8) | ((__float_as_uint(v0[2]) & 0x7fu) << 16) | ((__float_as_uint(v0[3]) & 0x7fu) << 24);
                ix.y = (__float_as_uint(v0[4]) & 0x7fu) | ((__float_as_uint(v0[5]) & 0x7fu) << 8) | ((__float_as_uint(v0[6]) & 0x7fu) << 16) | ((__float_as_uint(v0[7]) & 0x7fu) << 24);
                ix.z = (__float_as_uint(v0[8]) & 0x7fu) | ((__float_as_uint(v0[9]) & 0x7fu) << 8) | ((__float_as_uint(v0[10]) & 0x7fu) << 16) | ((__float_as_uint(v0[11]) & 0x7fu) << 24);
                ix.w = (__float_as_uint(v0[12]) & 0x7fu) | ((__float_as_uint(v0[13]) & 0x7fu) << 8) | ((__float_as_uint(v0[14]) & 0x7fu) << 16) | ((__float_as_uint(v0[15]) & 0x7fu) << 24);
                *(u32x4*)lutp = ix;
}
DI void phase_retrieve(const Params& p, int bid, int nb, char* smem) {
    const bf16_t* Q = (const bf16_t*)(p.ws + OFF_PROJ);
    const bf16_t* SK = (const bf16_t*)(p.ws + OFF_SUBK);
    const float* SU = (const float*)(p.ws + OFF_SU);
    const float* SV = (const float*)(p.ws + OFF_SV);
    uint2* EX = (uint2*)(p.ws + OFF_EXPS);
    const int tid = my_tid(), lane = tid & 63, wid = tid >> 6, r = lane & 31, h = lane >> 5;
    unsigned char* lut = (unsigned char*)smem + wid * 2048 + lane * 32;
    char* skb0 = smem + 16384;
    char* skb1 = skb0 + 128 * 272;
    u32x4 sr0, sr1, sr2, sr3;
#define SK_LOAD(hp_) { const bf16_t* g_ = SK + (size_t)(hp_) * 16384 + tid * 8; sr0 = *(const u32x4*)g_; sr1 = *(const u32x4*)(g_ + 4096); sr2 = *(const u32x4*)(g_ + 8192); sr3 = *(const u32x4*)(g_ + 12288); }
#define SK_STORE(buf_) { char* d_ = (buf_) + (tid >> 4) * 272 + (tid & 15) * 16; *(u32x4*)d_ = sr0; *(u32x4*)(d_ + 32 * 272) = sr1; *(u32x4*)(d_ + 64 * 272) = sr2; *(u32x4*)(d_ + 96 * 272) = sr3; }
    for (int it = bid; it < (NTOK / 256) * 2; it += nb) {
        const int hq = it & 1, tok = (it >> 1) * 256 + wid * 32 + r;
        __syncthreads();
        SK_LOAD(hq * 8); SK_STORE(skb0);
        __syncthreads();
#pragma unroll 1
        for (int hd = hq * 4; hd < hq * 4 + 4; ++hd) {
            float L0[16], L1[16];
            SK_LOAD(hd * 2 + 1);
            retrieve_topk_hp(Q, skb0, tok, hd * 2, r, h, lut, L0);
            SK_STORE(skb1);
            __syncthreads();
            if (hd + 1 < hq * 4 + 4) SK_LOAD(hd * 2 + 2);
            retrieve_topk_hp(Q, skb1, tok, hd * 2 + 1, r, h, lut + 16, L1);
            if (hd + 1 < hq * 4 + 4) SK_STORE(skb0);
            __syncthreads();
            float c[32];
            {
                constexpr int PA[50] = {0, 0, 0, 0, 0, 0, 0, 0, 0, 0, 0, 0, 0, 0, 0, 0, 1, 1, 1, 1, 1, 1, 1, 1, 2, 2, 2, 2, 2, 3, 3, 3, 3, 4, 4, 4, 5, 5, 6, 6, 7, 7, 8, 9, 10, 11, 12, 13, 14, 15};
                constexpr int PB[50] = {0, 1, 2, 3, 4, 5, 6, 7, 8, 9, 10, 11, 12, 13, 14, 15, 0, 1, 2, 3, 4, 5, 6, 7, 0, 1, 2, 3, 4, 0, 1, 2, 3, 0, 1, 2, 0, 1, 0, 1, 0, 1, 0, 0, 0, 0, 0, 0, 0, 0};
#pragma unroll
                for (int q = 0; q < 25; ++q) {
                    const float s0 = __uint_as_float(__float_as_uint(L0[PA[2 * q]]) & ~0x7fu) + __uint_as_float(__float_as_uint(L1[PB[2 * q]]) & ~0x7fu);
                    const float s1 = __uint_as_float(__float_as_uint(L0[PA[2 * q + 1]]) & ~0x7fu) + __uint_as_float(__float_as_uint(L1[PB[2 * q + 1]]) & ~0x7fu);
                    const float p0 = __uint_as_float((__float_as_uint(s0) & ~0xffu) | (unsigned)(PA[2 * q] * 16 + PB[2 * q]));
                    const float p1 = __uint_as_float((__float_as_uint(s1) & ~0xffu) | (unsigned)(PA[2 * q + 1] * 16 + PB[2 * q + 1]));
                    c[q] = h ? p1 : p0;
                }
#pragma unroll
                for (int i = 25; i < 32; ++i) c[i] = -3.0e38f;
            }
            bitonic_sort_desc<32>(c);
            float t16[16];
#pragma unroll
            for (int i = 0; i < 16; ++i) t16[i] = c[i];
            xlane_merge16(t16);
            const float mx = __uint_as_float(__float_as_uint(t16[0]) & ~0xffu);
            float e[16], sum = 0.f;
#pragma unroll
            for (int j = 0; j < 16; ++j) { e[j] = __expf(__uint_as_float(__float_as_uint(t16[j]) & ~0xffu) - mx); sum += e[j]; }
            const float inv = 1.0f / sum;
            uint2* dst = EX + ((size_t)tok * 8 + hd) * 16 + 8 * h;
#pragma unroll
            for (int j = 0; j < 8; ++j) {
                float tlo = t16[j], thi = t16[8 + j], elo = e[j], ehi = e[8 + j];
                asm volatile("" : "+v"(tlo), "+v"(thi), "+v"(elo), "+v"(ehi));
                const float tv = h ? thi : tlo, ev = h ? ehi : elo;
                const unsigned ab = __float_as_uint(tv) & 0xffu;
                const unsigned eid = (unsigned)lut[ab >> 4] * 128u + (unsigned)lut[16 + (ab & 15u)];
                dst[j] = make_uint2(eid | (pack2(0.f, SU[eid]) & 0xffff0000u), __float_as_uint(ev * inv * SV[eid]));
            }
        }
    }
#undef SK_LOAD
#undef SK_STORE
}

DI float dot16_fp8(const u32x4 w, const f32x2 (&h)[8]) {
    f32x2 acc = __builtin_amdgcn_cvt_pk_f32_fp8((int)w.x, false) * h[0];
    acc += __builtin_amdgcn_cvt_pk_f32_fp8((int)w.x, true) * h[1];
    acc += __builtin_amdgcn_cvt_pk_f32_fp8((int)w.y, false) * h[2];
    acc += __builtin_amdgcn_cvt_pk_f32_fp8((int)w.y, true) * h[3];
    acc += __builtin_amdgcn_cvt_pk_f32_fp8((int)w.z, false) * h[4];
    acc += __builtin_amdgcn_cvt_pk_f32_fp8((int)w.z, true) * h[5];
    acc += __builtin_amdgcn_cvt_pk_f32_fp8((int)w.w, false) * h[6];
    acc += __builtin_amdgcn_cvt_pk_f32_fp8((int)w.w, true) * h[7];
    return acc.x + acc.y;
}
DI void axpy16_fp8(const float a, const u32x4 w, f32x2 (&o)[8]) {
    const f32x2 aa = {a, a};
    o[0] += aa * __builtin_amdgcn_cvt_pk_f32_fp8((int)w.x, false); o[1] += aa * __builtin_amdgcn_cvt_pk_f32_fp8((int)w.x, true);
    o[2] += aa * __builtin_amdgcn_cvt_pk_f32_fp8((int)w.y, false); o[3] += aa * __builtin_amdgcn_cvt_pk_f32_fp8((int)w.y, true);
    o[4] += aa * __builtin_amdgcn_cvt_pk_f32_fp8((int)w.z, false); o[5] += aa * __builtin_amdgcn_cvt_pk_f32_fp8((int)w.z, true);
    o[6] += aa * __builtin_amdgcn_cvt_pk_f32_fp8((int)w.w, false); o[7] += aa * __builtin_amdgcn_cvt_pk_f32_fp8((int)w.w, true);
}
DI float butterfly64(float (&pz)[64], const int lane) {
    const bool b5 = lane & 32, b4 = lane & 16, b3 = lane & 8, b2 = lane & 4, b1 = lane & 2, b0 = lane & 1;
    float q32[32], q16[16], q8[8], q4[4], q2[2];
#pragma unroll
    for (int j = 0; j < 32; ++j) q32[j] = (b5 ? pz[32 + j] : pz[j]) + __shfl_xor(b5 ? pz[j] : pz[32 + j], 32);
#pragma unroll
    for (int j = 0; j < 16; ++j) q16[j] = (b4 ? q32[16 + j] : q32[j]) + __shfl_xor(b4 ? q32[j] : q32[16 + j], 16);
#pragma unroll
    for (int j = 0; j < 8; ++j) q8[j] = (b3 ? q16[8 + j] : q16[j]) + __shfl_xor(b3 ? q16[j] : q16[8 + j], 8);
#pragma unroll
    for (int j = 0; j < 4; ++j) q4[j] = (b2 ? q8[4 + j] : q8[j]) + __shfl_xor(b2 ? q8[j] : q8[4 + j], 4);
#pragma unroll
    for (int j = 0; j < 2; ++j) q2[j] = (b1 ? q4[2 + j] : q4[j]) + __shfl_xor(b1 ? q4[j] : q4[2 + j], 2);
    return (b0 ? q2[1] : q2[0]) + __shfl_xor(b0 ? q2[0] : q2[1], 1);
}
DI float bfly8(float (&pz)[8], const int lane) {
    const bool b2 = lane & 4, b1 = lane & 2, b0 = lane & 1;
    float q4[4], q2[2];
#pragma unroll
    for (int i = 0; i < 4; ++i) q4[i] = (b2 ? pz[4 + i] : pz[i]) + __shfl_xor(b2 ? pz[i] : pz[4 + i], 4);
#pragma unroll
    for (int i = 0; i < 2; ++i) q2[i] = (b1 ? q4[2 + i] : q4[i]) + __shfl_xor(b1 ? q4[i] : q4[2 + i], 2);
    float q = (b0 ? q2[1] : q2[0]) + __shfl_xor(b0 ? q2[0] : q2[1], 1);
    q += __shfl_xor(q, 8); q += __shfl_xor(q, 16); q += __shfl_xor(q, 32);
    return q;
}
DI float bfly16(float (&pz)[16], const int lane) {
    const bool b3 = lane & 8, b2 = lane & 4, b1 = lane & 2, b0 = lane & 1;
    float q8[8], q4[4], q2[2];
#pragma unroll
    for (int i = 0; i < 8; ++i) q8[i] = (b3 ? pz[8 + i] : pz[i]) + __shfl_xor(b3 ? pz[i] : pz[8 + i], 8);
#pragma unroll
    for (int i = 0; i < 4; ++i) q4[i] = (b2 ? q8[4 + i] : q8[i]) + __shfl_xor(b2 ? q8[i] : q8[4 + i], 4);
#pragma unroll
    for (int i = 0; i < 2; ++i) q2[i] = (b1 ? q4[2 + i] : q4[i]) + __shfl_xor(b1 ? q4[i] : q4[2 + i], 2);
    float q = (b0 ? q2[1] : q2[0]) + __shfl_xor(b0 ? q2[0] : q2[1], 1);
    q += __shfl_xor(q, 16); q += __shfl_xor(q, 32);
    return q;
}
DI void gs_issue(const __amdgpu_buffer_rsrc_t T, const uint2* ent, const unsigned d, const int lane, u32x4 (&w)[8], unsigned& ca) {
    const int cnt = (int)((d >> 16) & 0xfu), k = lane & 7;
    const uint2 e = ent[(d & 0xffffu) + (unsigned)(k < cnt ? k : cnt - 1)];
    ca = (k < cnt && !(d >> 31)) ? e.y : 0u;
#pragma unroll
    for (int q = 0; q < 8; ++q) {
        const int eid = __builtin_amdgcn_readlane((int)e.x, q) & 0x3fff;
        w[q] = __builtin_amdgcn_raw_buffer_load_b128(T, lane * 16, eid * DM, 0);
    }
}
DI float dot16_i8(const u32x4 w, const u32x4 h) {
    int acc = __builtin_amdgcn_sdot4((int)w.x, (int)h.x, 0, false);
    acc = __builtin_amdgcn_sdot4((int)w.y, (int)h.y, acc, false);
    acc = __builtin_amdgcn_sdot4((int)w.z, (int)h.z, acc, false);
    acc = __builtin_amdgcn_sdot4((int)w.w, (int)h.w, acc, false);
    return (float)acc;
}
DI void gs_desc(const uint2* ent, const unsigned d, const int lane, unsigned& ex) {
    const int cnt = (int)((d >> 16) & 0xfu), k = lane & 7;
    ex = ent[(d & 0xffffu) + (unsigned)(k < cnt ? k : cnt - 1)].x;
}
DI void gs_loads(const __amdgpu_buffer_rsrc_t T, const unsigned ex, const int lane, u32x4 (&w)[8]) {
#pragma unroll
    for (int q = 0; q < 8; ++q) {
        const int eid = __builtin_amdgcn_readlane((int)ex, q) & 0x3fff;
        w[q] = __builtin_amdgcn_raw_buffer_load_b128(T, lane * 16, eid * DM, 0);
    }
}
DI void gs_upartial(const u32x4 (&w)[8], const u32x4 h2q, float (&pz)[16], const int base) {
#pragma unroll
    for (int k = 0; k < 8; ++k) pz[base + k] = dot16_i8(w[k], h2q);
}
DI void gs_ustore(float (&pz)[16], float* zb, const unsigned da, const unsigned db, const int lane) {
    const float z = bfly16(pz, lane);
    const unsigned d = (lane & 8) ? db : da;
    const int k = lane & 7;
    if (lane < 16 && k < (int)((d >> 16) & 0xfu) && !(d >> 31)) zb[(d & 0xffffu) + k] = z;
}
DI void axpy16_u8(const float a, const u32x4 w, float (&o)[16]) {
    o[0] += a * (float)(w.x & 0xffu); o[1] += a * (float)((w.x >> 8) & 0xffu); o[2] += a * (float)((w.x >> 16) & 0xffu); o[3] += a * (float)(w.x >> 24);
    o[4] += a * (float)(w.y & 0xffu); o[5] += a * (float)((w.y >> 8) & 0xffu); o[6] += a * (float)((w.y >> 16) & 0xffu); o[7] += a * (float)(w.y >> 24);
    o[8] += a * (float)(w.z & 0xffu); o[9] += a * (float)((w.z >> 8) & 0xffu); o[10] += a * (float)((w.z >> 16) & 0xffu); o[11] += a * (float)(w.z >> 24);
    o[12] += a * (float)(w.w & 0xffu); o[13] += a * (float)((w.w >> 8) & 0xffu); o[14] += a * (float)((w.w >> 16) & 0xffu); o[15] += a * (float)(w.w >> 24);
}
DI void gs_vcompute(const u32x4 (&w)[8], const unsigned ca, float (&acc)[16]) {
#pragma unroll
    for (int k = 0; k < 8; ++k) { axpy16_u8(__uint_as_float((unsigned)__builtin_amdgcn_readlane((int)ca, k)), w[k], acc); __builtin_amdgcn_sched_barrier(0); }
}
constexpr int GT = 4;
DI void xcd_pace(unsigned* cnt, const unsigned nloc, unsigned& step) {
    __syncthreads();
    if (__builtin_amdgcn_workitem_id_x() == 0) {
        __hip_atomic_fetch_add(cnt, 1u, __ATOMIC_RELAXED, __HIP_MEMORY_SCOPE_AGENT);
        const unsigned target = nloc * (step + 1u);
        unsigned sp = 0;
        while (__hip_atomic_load(cnt, __ATOMIC_RELAXED, __HIP_MEMORY_SCOPE_AGENT) < target) { __builtin_amdgcn_s_sleep(1); if (++sp > (1u << 22)) break; }
    }
    ++step;
    __syncthreads();
}
DI void phase_gather(const Params& p, int bid, int nb, char* smem, unsigned* pace_cnt, const unsigned pace_n) {
    unsigned pstep = 0;
    const float* mod = (const float*)(p.ws + OFF_MOD);
    const uint2* EX = (const uint2*)(p.ws + OFF_EXPS);
    const __amdgpu_buffer_rsrc_t UT = __builtin_amdgcn_make_buffer_rsrc((void*)(p.ws + OFF_UT), 0, NEXP * DM, 0x00020000);
    const __amdgpu_buffer_rsrc_t VT = __builtin_amdgcn_make_buffer_rsrc((void*)(p.ws + OFF_VT), 0, NEXP * DM, 0x00020000);
    const int lane = my_tid() & 63, wid = my_tid() >> 6, c0 = lane * 16;
    char* wl = smem + wid * 7168;
    uint2* ent = (uint2*)wl; float* zb = (float*)(wl + 4096); int* offs = (int*)(wl + 6144); unsigned* sched = (unsigned*)(wl + 6144 + 256);
#pragma unroll 1
    for (int t0 = (bid * 8 + wid) * GT; t0 < NTOK; t0 += nb * 8 * GT) {
        u32x4 h2q[GT]; float hsc[GT]; float acc[GT][16];
        f32x4 scv[4], shv[4];
        {
            const int b = t0 / SEQ;
#pragma unroll
            for (int q = 0; q < 4; ++q) { scv[q] = *(const f32x4*)(mod + b * 6144 + 4096 + c0 + q * 4) + 1.0f; shv[q] = *(const f32x4*)(mod + b * 6144 + 3072 + c0 + q * 4); }
        }
#pragma unroll
        for (int j = 0; j < GT; ++j) {
            const int tok = t0 + j;
            const float* row = p.out + (size_t)tok * DM + c0;
            __builtin_amdgcn_sched_barrier(0);
            {
                f32x4 hv[4];
                float m = 0.f;
#pragma unroll
                for (int q = 0; q < 4; ++q) { hv[q] = *(const f32x4*)(row + q * 4) * scv[q] + shv[q]; m = fmaxf(m, fmaxf(fmaxf(fabsf(hv[q].x), fabsf(hv[q].y)), fmaxf(fabsf(hv[q].z), fabsf(hv[q].w)))); }
#pragma unroll
                for (int sft = 1; sft < 64; sft <<= 1) m = fmaxf(m, __shfl_xor(m, sft));
                const float qs = m > 1e-30f ? 127.0f / m : 1.0f;
                hsc[j] = m > 1e-30f ? m * (1.0f / 127.0f) : 1.0f;
                unsigned hw[4];
#pragma unroll
                for (int q = 0; q < 4; ++q)
                    hw[q] = ((unsigned)(int)rintf(hv[q].x * qs) & 0xffu) | (((unsigned)(int)rintf(hv[q].y * qs) & 0xffu) << 8) | (((unsigned)(int)rintf(hv[q].z * qs) & 0xffu) << 16) | (((unsigned)(int)rintf(hv[q].w * qs) & 0xffu) << 24);
                h2q[j] = (u32x4){hw[0], hw[1], hw[2], hw[3]};
            }
            const uint2 e0 = EX[(size_t)tok * 128 + lane], e1 = EX[(size_t)tok * 128 + 64 + lane];
            const int s0 = (int)((e0.x & 0x3fffu) >> 11), s1 = (int)((e1.x & 0x3fffu) >> 11);
            int run = 0, pos0 = 0, pos1 = 0;
#pragma unroll
            for (int s = 0; s < 8; ++s) {
                const unsigned long long m0 = __ballot(s0 == s), m1 = __ballot(s1 == s);
                const int c0n = __popcll(m0), c1n = __popcll(m1);
                const int below0 = (int)__builtin_amdgcn_mbcnt_hi((unsigned)(m0 >> 32), __builtin_amdgcn_mbcnt_lo((unsigned)m0, 0u));
                const int below1 = (int)__builtin_amdgcn_mbcnt_hi((unsigned)(m1 >> 32), __builtin_amdgcn_mbcnt_lo((unsigned)m1, 0u));
                if (lane == 0) offs[j * 9 + s] = run;
                pos0 = (s0 == s) ? run + below0 : pos0;
                pos1 = (s1 == s) ? run + c0n + below1 : pos1;
                run += c0n + c1n;
            }
            if (lane == 0) offs[j * 9 + 8] = 128;
            ent[j * 128 + pos0] = e0; ent[j * 128 + pos1] = e1;
        }
        int nbat;
        {
            const int gs = (lane / GT) & 7, gj = lane % GT;
            const int gb = offs[gj * 9 + gs], ge = offs[gj * 9 + gs + 1], cnt = lane < 8 * GT ? ge - gb : 0, nbt = (cnt + 7) >> 3;
            int incl = nbt;
#pragma unroll
            for (int m = 1; m < 32; m <<= 1) { const int o = __shfl_up(incl, m); if ((lane & 31) >= m) incl += o; }
            nbat = __builtin_amdgcn_readlane(incl, 8 * GT - 1);
            const int st = incl - nbt;
            for (int q = 0; q < nbt; ++q) { const int rem = cnt - 8 * q; sched[st + q] = (unsigned)(gj * 128 + gb + 8 * q) | ((unsigned)(rem < 8 ? rem : 8) << 16); }
            if (lane < 3) sched[nbat + lane] = 0x80010000u;
        }
        xcd_pace(pace_cnt, pace_n, pstep);
#ifndef PROBE_UX
#define PROBE_UX 1
#endif
        for (int rep = 0; rep < PROBE_UX; ++rep)
        {
            u32x4 wa[8], wb[8];
#define GS_UP(W_, D_, B_) { const unsigned j_ = ((D_) & 0xffffu) >> 7; \
                if (j_ == 0) gs_upartial(W_, h2q[0], pz, B_); else if (j_ == 1) gs_upartial(W_, h2q[1], pz, B_); \
                else if (j_ == 2) gs_upartial(W_, h2q[2], pz, B_); else gs_upartial(W_, h2q[3], pz, B_); }
#define GS_RD(i_) ((unsigned)__builtin_amdgcn_readfirstlane((int)sched[(i_)]))
            unsigned da = GS_RD(0), db = GS_RD(1), dn = GS_RD(2), ea, eb, en;
            gs_desc(ent, da, lane, ea); gs_desc(ent, db, lane, eb); gs_desc(ent, dn, lane, en);
            gs_loads(UT, ea, lane, wa);
#pragma unroll 1
            for (int i = 0; i < nbat; i += 2) {
                float pz[16];
                gs_loads(UT, eb, lane, wb);
                __builtin_amdgcn_sched_barrier(0);
                GS_UP(wa, da, 0);
                const unsigned dcur_a = da, dcur_b = db;
                da = dn; ea = en; dn = GS_RD(i + 3); gs_desc(ent, dn, lane, en);
                gs_loads(UT, ea, lane, wa);
                __builtin_amdgcn_sched_barrier(0);
                GS_UP(wb, dcur_b, 8);
                db = dn; eb = en; dn = GS_RD(i + 4); gs_desc(ent, dn, lane, en);
                gs_ustore(pz, zb, dcur_a, dcur_b, lane);
            }
#undef GS_UP
#undef GS_RD
        }
        float asum[GT];
#pragma unroll
        for (int j = 0; j < GT; ++j) {
            float as = 0.f;
#pragma unroll
            for (int q = 0; q < 2; ++q) {
                const int pos = j * 128 + q * 64 + lane;
                const uint2 e = ent[pos];
                const float z = zb[pos] * __uint_as_float(e.x & 0xffff0000u) * hsc[j];
                const float a = gelu_as(z) * __uint_as_float(e.y);
                ent[pos].y = __float_as_uint(a);
                as += a;
            }
#pragma unroll
            for (int sft = 1; sft < 64; sft <<= 1) as += __shfl_xor(as, sft);
            asum[j] = as;
        }
        xcd_pace(pace_cnt, pace_n, pstep);
#pragma unroll
        for (int j = 0; j < GT; ++j)
#pragma unroll
            for (int q = 0; q < 16; ++q) acc[j][q] = 0.f;
        {
            u32x4 wa[8]; unsigned ca;
#pragma unroll 1
            for (int i = 0; i < nbat; ++i) {
                const unsigned da = (unsigned)__builtin_amdgcn_readfirstlane((int)sched[i]);
                gs_issue(VT, ent, da, lane, wa, ca);
                __builtin_amdgcn_sched_barrier(0);
                const unsigned j_ = (da & 0xffffu) >> 7;
                if (j_ == 0) gs_vcompute(wa, ca, acc[0]); else if (j_ == 1) gs_vcompute(wa, ca, acc[1]);
                else if (j_ == 2) gs_vcompute(wa, ca, acc[2]); else gs_vcompute(wa, ca, acc[3]);
            }
        }
#pragma unroll
        for (int j = 0; j < GT; ++j) {
            asm volatile("" ::: "memory");
            __builtin_amdgcn_sched_barrier(0);
            const int tok = t0 + j, b = tok / SEQ;
            float* row = p.out + (size_t)tok * DM + c0;
            const float* g2 = mod + b * 6144 + 5120 + c0;
            f32x2 r[8];
            float sm = 0.f;
#pragma unroll
            for (int q = 0; q < 4; ++q) {
                const f32x4 xv = *(const f32x4*)(row + q * 4), gg = *(const f32x4*)(g2 + q * 4);
                const float off = 128.0f * asum[j];
                r[2 * q] = DEEP_ALPHA * (f32x2){xv.x, xv.y} + (f32x2){1.f + gg.x, 1.f + gg.y} * (f32x2){acc[j][4 * q] - off, acc[j][4 * q + 1] - off};
                r[2 * q + 1] = DEEP_ALPHA * (f32x2){xv.z, xv.w} + (f32x2){1.f + gg.z, 1.f + gg.w} * (f32x2){acc[j][4 * q + 2] - off, acc[j][4 * q + 3] - off};
                sm += r[2 * q].x + r[2 * q].y + r[2 * q + 1].x + r[2 * q + 1].y;
            }
#pragma unroll
            for (int m = 1; m < 64; m <<= 1) sm += __shfl_xor(sm, m);
            const float mu = sm * (1.0f / 1024.0f);
            float qq = 0.f;
#pragma unroll
            for (int i = 0; i < 8; ++i) { const f32x2 dd = r[i] - mu; qq += dd.x * dd.x + dd.y * dd.y; }
#pragma unroll
            for (int m = 1; m < 64; m <<= 1) qq += __shfl_xor(qq, m);
            const float rstd = rsqrtf(qq * (1.0f / 1024.0f) + LN_EPS);
#pragma unroll
            for (int q = 0; q < 4; ++q) {
                const f32x4 w4 = *(const f32x4*)(p.ln2w + c0 + q * 4), bi = *(const f32x4*)(p.ln2b + c0 + q * 4);
                f32x4 ov;
                ov.x = (r[2 * q].x - mu) * rstd * w4.x + bi.x; ov.y = (r[2 * q].y - mu) * rstd * w4.y + bi.y;
                ov.z = (r[2 * q + 1].x - mu) * rstd * w4.z + bi.z; ov.w = (r[2 * q + 1].y - mu) * rstd * w4.w + bi.w;
                *(f32x4*)(row + q * 4) = ov;
            }
        }
    }
}

#define XB_TMO      128
#define XB_XCNT(j)  (256  + 64 * (j))
#define XB_XSUB(j)  (1280 + 64 * (j))
#define XB_XGEN(j)  (2304 + 64 * (j))
#define XB_TOP      3328
#define XB_TOPGEN   3392
#define XCD_BAR_WORDS 3456
#define XB_SPIN_CAP (1u << 22)
#define LAS __attribute__((address_space(3)))
DI unsigned xb_ld(unsigned* p) { return __hip_atomic_load(p, __ATOMIC_RELAXED, __HIP_MEMORY_SCOPE_AGENT); }
DI unsigned xb_add(unsigned* p, unsigned v) { return __hip_atomic_fetch_add(p, v, __ATOMIC_RELAXED, __HIP_MEMORY_SCOPE_AGENT); }
DI unsigned xb_xcc_id() { return (unsigned)__builtin_amdgcn_s_getreg((3 << 11) | 20) & 0xFu; }
#define XB_SPIN(cond, bar) do { unsigned _sp = 0; while (cond) { __builtin_amdgcn_s_sleep(1); \
    if ((++_sp & 255u) == 0u) { if (xb_ld(&(bar)[XB_TMO])) break; if (_sp > XB_SPIN_CAP) { atomicAdd(&(bar)[XB_TMO], 1u); break; } } } } while (0)
struct XcdBarrier { unsigned* bar; unsigned x; volatile LAS unsigned* st; };
DI XcdBarrier xcd_barrier_post(unsigned* bar, volatile LAS unsigned* st) {
    XcdBarrier b; b.bar = bar; b.x = xb_xcc_id(); b.st = st;
    if (__builtin_amdgcn_workitem_id_x() == 0) (void)xb_add(&bar[XB_XCNT(b.x)], 1u);
    return b;
}
DI void xcd_barrier_complete(unsigned* bar, unsigned x, unsigned& nloc, unsigned& nx) {
    const unsigned G = gridDim.x * gridDim.y * gridDim.z;
    unsigned sum, cnt, mine, sp = 0u;
    for (;;) {
        sum = 0u; cnt = 0u; mine = 0u;
#pragma unroll
        for (unsigned j = 0; j < 16; ++j) { const unsigned c = xb_ld(&bar[XB_XCNT(j)]); sum += c; cnt += (c > 0u) ? 1u : 0u; mine = (j == x) ? c : mine; }
        if (sum == G) break;
        __builtin_amdgcn_s_sleep(1);
        if ((++sp & 255u) == 0u) { if (xb_ld(&bar[XB_TMO])) break; if (sp > XB_SPIN_CAP) { atomicAdd(&bar[XB_TMO], 1u); break; } }
    }
    nloc = mine > 0u ? mine : 1u; nx = cnt > 0u ? cnt : 1u;
}
DI void xcd_barrier(const XcdBarrier& b) {
    asm volatile("s_waitcnt vmcnt(0)" ::: "memory");
    __syncthreads();
    if (__builtin_amdgcn_workitem_id_x() == 0) {
        unsigned* bar = b.bar;
        __builtin_amdgcn_s_waitcnt(0);
        unsigned nloc = b.st[0], nx = b.st[1];
        if (nloc == 0u) { xcd_barrier_complete(bar, b.x, nloc, nx); b.st[0] = nloc; b.st[1] = nx; }
        const unsigned old = xb_add(&bar[XB_XSUB(b.x)], 1u);
        const unsigned gen = old / nloc;
        if (old + 1u == (gen + 1u) * nloc) {
            __builtin_amdgcn_fence(__ATOMIC_RELEASE, "agent");
            asm volatile("s_waitcnt vmcnt(0)" ::: "memory");
            const unsigned og = xb_add(&bar[XB_TOP], 1u);
            const unsigned tg = og / nx;
            if (og + 1u == (tg + 1u) * nx) xb_add(&bar[XB_TOPGEN], 1u);
            else XB_SPIN(xb_ld(&bar[XB_TOPGEN]) == tg, bar);
            __builtin_amdgcn_fence(__ATOMIC_ACQUIRE, "agent");
            xb_add(&bar[XB_XGEN(b.x)], 1u);
            asm volatile("s_waitcnt vmcnt(0)" ::: "memory");
        } else {
            XB_SPIN(xb_ld(&bar[XB_XGEN(b.x)]) == gen, bar);
            __builtin_amdgcn_fence(__ATOMIC_ACQUIRE, "agent");
            asm volatile("s_waitcnt vmcnt(0)" ::: "memory");
        }
    }
    __syncthreads();
}

__global__ void __launch_bounds__(NTH) k_mega(Params p) {
    __shared__ __attribute__((aligned(16))) char smem[SMEM_BYTES];
    volatile LAS unsigned* xst = (volatile LAS unsigned*)(smem + SMEM_BYTES - 16);
    if (__builtin_amdgcn_workitem_id_x() == 0) { xst[0] = 0u; xst[1] = 0u; }
    __syncthreads();
    const XcdBarrier xb = xcd_barrier_post((unsigned*)(p.ws + OFF_BAR), xst);
    const int bid = blockIdx.x, nb = gridDim.x;
#ifndef PROBE_MASK
#define PROBE_MASK 0
#endif
#define REP(bit) for (int rep_ = 0; rep_ < ((PROBE_MASK & (bit)) ? 2 : 1); ++rep_)
    REP(64) { phase_mod(p, bid, nb, smem);     xcd_barrier(xb); }
    REP(64) { phase_prep(p, bid, nb, smem); phase_h(p, bid, nb); xcd_barrier(xb); }
    REP(1)  { phase_proj(p, bid, nb, smem);    xcd_barrier(xb); }
    REP(128) { phase_hgprep(p, bid, nb);       xcd_barrier(xb); }
    REP(2)  { phase_mix(p, bid, nb, smem);     xcd_barrier(xb); }
    REP(4)  { phase_glu(p, bid, nb, smem);     xcd_barrier(xb); }
    REP(4)  { phase_a2(p, bid, nb);            xcd_barrier(xb); }
    REP(4)  { phase_outproj(p, bid, nb, smem); xcd_barrier(xb); }
    phase_ln1(p, bid, nb);           xcd_barrier(xb);
    REP(8)  { phase_q(p, bid, nb, smem);       xcd_barrier(xb); }
    REP(16) { phase_retrieve(p, bid, nb, smem); xcd_barrier(xb); }
    phase_gather(p, bid, nb, smem, (unsigned*)(p.ws + OFF_BAR) + 16 * xb.x, xst[0]);
}

extern "C" void kernel_launch(void* const* d_in, const int* in_sizes, int n_in, void* d_out, int out_size, void* d_ws, size_t ws_size, hipStream_t stream) {
    if (n_in != 27 || ws_size < WS_END) { fprintf(stderr, "kernel_launch: unexpected n_in %d or ws_size %zu (< %zu)\n", n_in, ws_size, (size_t)WS_END); return; }
    static int grid_blocks = 0;
    if (!grid_blocks) {
        int dev = 0, cus = 0, per_cu = 0;
        (void)hipGetDevice(&dev);
        (void)hipDeviceGetAttribute(&cus, hipDeviceAttributeMultiprocessorCount, dev);
        (void)hipOccupancyMaxActiveBlocksPerMultiprocessor(&per_cu, k_mega, NTH, 0);
        if (cus <= 0) cus = 256;
        if (per_cu < 1) { fprintf(stderr, "kernel_launch: occupancy query says %d blocks/CU\n", per_cu); per_cu = 1; }
        grid_blocks = cus;
    }
    Params p{};
    const float** f = (const float**)&p;
    for (int i = 0; i < 27; ++i) f[i] = (const float*)d_in[i];
    p.out = (float*)d_out; p.ws = (char*)d_ws;
    hipError_t e = hipMemsetAsync((char*)d_ws + OFF_BAR, 0, (size_t)3456 * 4, stream);
    if (e == hipSuccess) { hipLaunchKernelGGL(k_mega, dim3(grid_blocks), dim3(NTH), 0, stream, p); e = hipPeekAtLastError(); }
    if (e != hipSuccess) fprintf(stderr, "launch failed: %s (grid %d)\n", hipGetErrorString(e), grid_blocks);
}
```

```cpp
#include <hip/hip_runtime.h>
#include <hip/hip_cooperative_groups.h>
#include <stdint.h>
#include <stdio.h>

namespace cg = cooperative_groups;
#define DI __device__ __forceinline__
typedef unsigned short bf16_t;
typedef short bf16x8 __attribute__((ext_vector_type(8)));
typedef float f32x16 __attribute__((ext_vector_type(16)));
typedef unsigned u32x4 __attribute__((ext_vector_type(4)));
typedef float f32x4 __attribute__((ext_vector_type(4)));
typedef float f32x2 __attribute__((ext_vector_type(2)));

constexpr int NTH = 512;
constexpr int NB = 16, SEQ = 2048, DM = 1024, NTOK = NB * SEQ;
constexpr int DHG = 512, HGH = 4, HDK = 128;
constexpr int DSS = 512, SSG = 32, SSC = 16, SSP = 64;
constexpr int INC = 2560;
constexpr int PHEADS = 8, NKEYS = 128, TOPK = 16, NEXP = 16384;
constexpr float DEEP_ALPHA = 1.189207115002721f;
constexpr float LN_EPS = 1e-5f, RMS_EPS = 1e-6f;
constexpr int SMEM_BYTES = 128 * 1024 + 256;

constexpr size_t al256(size_t x) { return (x + 255) & ~(size_t)255; }
constexpr size_t OFF_MOD = 0;
constexpr size_t OFF_LB = al256(OFF_MOD + (size_t)NB * 6144 * 4);
constexpr size_t OFF_LAM = al256(OFF_LB + 512 * 4);
constexpr size_t OFF_BB = al256(OFF_LAM + 32 * 64 * 2 * 4);
constexpr size_t OFF_WIN = al256(OFF_BB + 32 * 64 * 16 * 2 * 4);
constexpr size_t OFF_GLU = al256(OFF_WIN + (size_t)INC * DM * 2);
constexpr size_t OFF_WOUT = al256(OFF_GLU + (size_t)512 * 512 * 2);
constexpr size_t OFF_WQ = al256(OFF_WOUT + (size_t)DM * DM * 2);
constexpr size_t OFF_SUBK = al256(OFF_WQ + (size_t)2048 * DM * 2);
constexpr size_t OFF_SU = al256(OFF_SUBK + (size_t)16 * 128 * 128 * 2);
constexpr size_t OFF_SV = al256(OFF_SU + (size_t)NEXP * 4);
constexpr size_t OFF_UT = al256(OFF_SV + (size_t)NEXP * 4);
constexpr size_t OFF_VT = al256(OFF_UT + (size_t)NEXP * DM * 2);
constexpr size_t OFF_H = al256(OFF_VT + (size_t)NEXP * DM * 2);
constexpr size_t OFF_PROJ = al256(OFF_H + (size_t)NTOK * DM * 2);
constexpr size_t OFF_ORAW = al256(OFF_PROJ + (size_t)NTOK * INC * 2);
constexpr size_t OFF_YSSM = al256(OFF_ORAW + (size_t)NTOK * DHG * 4);
constexpr size_t OFF_A2 = al256(OFF_YSSM + (size_t)NTOK * DSS * 2);
constexpr size_t OFF_HG = al256(OFF_A2 + (size_t)NTOK * DM * 2);
constexpr size_t OFF_S5K = al256(OFF_HG + (size_t)4096 * 128 * 4);
constexpr size_t OFF_S5N = al256(OFF_S5K + (size_t)32 * 4096 * 2);
constexpr size_t OFF_S5M = al256(OFF_S5N + (size_t)32 * 128 * 256 * 2);
constexpr size_t OFF_S5L = al256(OFF_S5M + (size_t)32 * 256 * 128 * 2);
constexpr size_t OFF_BAR = al256(OFF_S5L + (size_t)32 * 64 * 2 * 4);
constexpr size_t WS_END = al256(OFF_BAR + (size_t)3456 * 4);
constexpr size_t OFF_HQ = OFF_H, OFF_HK = OFF_H + (size_t)NTOK * DHG * 2, OFF_HKT = OFF_A2, OFF_HVT = OFF_A2 + (size_t)NTOK * DHG * 2;
constexpr size_t OFF_TOPL = OFF_ORAW;
constexpr size_t OFF_EXPS = OFF_ORAW + (size_t)NTOK * 16 * 16 * 4;

struct Params {
    const float *x, *c, *ada_w, *ada_b, *w_in, *hg_lb, *hg_nw, *a_re, *a_im, *log_dt, *b_re, *b_im, *c_re, *c_im, *dsk,
        *glu_w, *glu_b, *ssm_nw, *w_out, *ln1w, *ln1b, *w_q, *subk, *pu, *pv, *ln2w, *ln2b;
    float* out;
    char* ws;
};

DI int my_tid() { int t = (int)__builtin_amdgcn_workitem_id_x(); asm volatile("" : "+v"(t)); return t; }
DI bf16_t f2bf(float x) { unsigned u = __float_as_uint(x); u += 0x7fffu + ((u >> 16) & 1u); return (bf16_t)(u >> 16); }
DI float bf2f(bf16_t b) { return __uint_as_float(((unsigned)b) << 16); }
DI float bflo(unsigned w) { return __uint_as_float(w << 16); }
DI float bfhi(unsigned w) { return __uint_as_float(w & 0xffff0000u); }
typedef __bf16 hwbf16x2 __attribute__((ext_vector_type(2)));
DI unsigned pack2(float a, float b) { const f32x2 v = {a, b}; return __builtin_bit_cast(unsigned, __builtin_convertvector(v, hwbf16x2)); }
DI bf16x8 pack8(const f32x16& x, const int base) {
    u32x4 o; o.x = pack2(x[base], x[base + 1]); o.y = pack2(x[base + 2], x[base + 3]); o.z = pack2(x[base + 4], x[base + 5]); o.w = pack2(x[base + 6], x[base + 7]);
    return __builtin_bit_cast(bf16x8, o);
}
DI float sigmoidf_(float x) { return 1.0f / (1.0f + __expf(-x)); }
DI float siluf_(float x) { return x * sigmoidf_(x); }
DI float geluf_(float x) { return 0.5f * x * (1.0f + erff(x * 0.70710678118654752f)); }
DI float gelu_as(float v) {
    const float t = __builtin_amdgcn_rcpf(fabsf(v) * 0.2316418882f + 1.0f);
    float q = t * 0.5307027145f + (-0.7265760135f); q = q * t + 0.7107068705f; q = q * t + (-0.142248368f); q = q * t + 0.127414796f; q = q * t;
    const float m = v * (q * __builtin_amdgcn_exp2f(v * v * (-0.72134752044f)));
    return v < 0.f ? m : v - m;
}

template <int MT, int NT_, int WM, int WN, class Epi>
DI void gemm_block(const bf16_t* __restrict__ A, int lda, const bf16_t* __restrict__ Bt, int ldb, int K, char* smem, Epi epi) {
    constexpr int BM = WM * MT * 32, BN = WN * NT_ * 32, LS = 72;
    static_assert(WM * WN == 8, "8 waves");
    bf16_t* As = (bf16_t*)smem;
    bf16_t* Bs = As + BM * LS;
    const int tid = my_tid(), lane = tid & 63, wid = tid >> 6, r = lane & 31, h = lane >> 5;
    const int wm = wid / WN, wn = wid % WN;
    constexpr int PA = BM * 8 / NTH, PB = BN * 8 / NTH;
    u32x4 ra[PA], rb[PB];
    f32x16 acc[MT][NT_];
#pragma unroll
    for (int mi = 0; mi < MT; ++mi)
#pragma unroll
        for (int ni = 0; ni < NT_; ++ni)
#pragma unroll
            for (int i = 0; i < 16; ++i) acc[mi][ni][i] = 0.f;
#define GEMM_GLOAD(kt_) { \
    _Pragma("unroll") for (int q = 0; q < PA; ++q) { const int idx = tid + q * NTH, row = idx >> 3, ch = idx & 7; ra[q] = *(const u32x4*)(A + (size_t)row * lda + (kt_) * 64 + ch * 8); } \
    _Pragma("unroll") for (int q = 0; q < PB; ++q) { const int idx = tid + q * NTH, row = idx >> 3, ch = idx & 7; rb[q] = *(const u32x4*)(Bt + (size_t)row * ldb + (kt_) * 64 + ch * 8); } }
#define GEMM_LSTORE() { \
    _Pragma("unroll") for (int q = 0; q < PA; ++q) { const int idx = tid + q * NTH, row = idx >> 3, ch = idx & 7; *(u32x4*)(As + row * LS + ch * 8) = ra[q]; } \
    _Pragma("unroll") for (int q = 0; q < PB; ++q) { const int idx = tid + q * NTH, row = idx >> 3, ch = idx & 7; *(u32x4*)(Bs + row * LS + ch * 8) = rb[q]; } }
    GEMM_GLOAD(0); GEMM_LSTORE(); __syncthreads();
    const int nk = K / 64;
    for (int kt = 0; kt < nk; ++kt) {
        if (kt + 1 < nk) GEMM_GLOAD(kt + 1);
#pragma unroll
        for (int ks = 0; ks < 4; ++ks) {
            bf16x8 a[MT], b[NT_];
#pragma unroll
            for (int mi = 0; mi < MT; ++mi) a[mi] = *(const bf16x8*)(As + (wm * MT * 32 + mi * 32 + r) * LS + ks * 16 + h * 8);
#pragma unroll
            for (int ni = 0; ni < NT_; ++ni) b[ni] = *(const bf16x8*)(Bs + (wn * NT_ * 32 + ni * 32 + r) * LS + ks * 16 + h * 8);
#pragma unroll
            for (int mi = 0; mi < MT; ++mi)
#pragma unroll
                for (int ni = 0; ni < NT_; ++ni) acc[mi][ni] = __builtin_amdgcn_mfma_f32_32x32x16_bf16(a[mi], b[ni], acc[mi][ni], 0, 0, 0);
        }
        __syncthreads();
        if (kt + 1 < nk) { GEMM_LSTORE(); __syncthreads(); }
    }
#pragma unroll
    for (int mi = 0; mi < MT; ++mi)
#pragma unroll
        for (int ni = 0; ni < NT_; ++ni)
#pragma unroll
            for (int i = 0; i < 16; ++i) epi(wm * MT * 32 + mi * 32 + (i & 3) + 8 * (i >> 2) + 4 * h, wn * NT_ * 32 + ni * 32 + r, acc[mi][ni][i]);
}

namespace pg8 {
#define PG8_LAS __attribute__((address_space(3)))
typedef unsigned short bf16_t;
typedef short bf16x8 __attribute__((ext_vector_type(8)));
typedef float f32x4 __attribute__((ext_vector_type(4)));
typedef unsigned u32x4 __attribute__((ext_vector_type(4)));
constexpr int BM = 256, BK = 64, HALF = 128, HTB = HALF * BK * 2  , STAGE_BYTES = 8 * HTB, NXCD = 8, WGM = 8;

__host__ __device__ __forceinline__ int lds_byte(int r, int c) { const int st = (r >> 4) * 2 + (c >> 5), rr = r & 15, cc = c & 31, ob = rr * 64 + cc * 2; return st * 1024 + (ob ^ (((ob >> 9) & 1) << 5)); }
__host__ __device__ __forceinline__ void stage_rc(int b, int& R, int& C) { const int st = b / 1024, sb = b % 1024, swz = sb ^ (((sb >> 9) & 1) << 5); R = (st >> 1) * 16 + swz / 64; C = (st & 1) * 32 + (swz % 64) / 2; }
__host__ __device__ __forceinline__ int perm32(int rho) { const int n = rho >> 4, i = rho & 15; return 8 * (i >> 2) + 4 * n + (i & 3); }

struct Unit { int pm, pn; };
struct Gemm { const bf16_t* A; const bf16_t* Bt; int M, N, K; };

struct StaticOrder {
    int nM, nN, nwg, G, c;
    __host__ __device__ void init(int M, int N, int G_, int c_) { nM = M / BM; nN = N / BM; nwg = nM * nN; G = G_; c = c_; }
    __host__ __device__ bool next(int i, Unit& u) const {
        const long L = (long)i * G + c; if (L >= nwg) return false;
        int wgid = (int)L; { const int q = nwg / NXCD, r = nwg % NXCD, xcd = wgid % NXCD, off = wgid / NXCD; wgid = (xcd < r ? xcd * (q + 1) : r * (q + 1) + (xcd - r) * q) + off; }
        const int nig = WGM * nN, gid = wgid / nig, fm = gid * WGM, gsz = (nM - fm) < WGM ? (nM - fm) : WGM;
        u.pm = fm + ((wgid % nig) % gsz); u.pn = (wgid % nig) / gsz; return true;
    }
    __device__ __forceinline__ void a_ready(const Unit&) const {}
    __device__ __forceinline__ void done(const Unit&) const {}
};
template <class Epi, class Sched, bool STAMP = false>
__device__ __forceinline__ void gemm_phase(PG8_LAS unsigned char* lds, const Gemm g, const Sched& S, const Epi& E, unsigned long long* stamps) {
    const int tid = (int)__builtin_amdgcn_workitem_id_x(), wid = __builtin_amdgcn_readfirstlane(tid >> 6), lane = tid & 63, wr = wid >> 2, wc = wid & 3, fr = lane & 15, fq = lane >> 4;
    const int K = g.K, nt = K / BK;
    int ts_lo = 0, ts_hi = 0, nts = 0; const unsigned long long rt_entry = STAMP ? (unsigned long long)wall_clock64() : 0ull;
#define PG8_STAMP() do { if (STAMP && wid == 0 && nts < 64) { const unsigned long long _c = (unsigned long long)clock64(); \
        ts_lo = (lane == nts) ? (int)(unsigned)_c : ts_lo; ts_hi = (lane == nts) ? (int)(unsigned)(_c >> 32) : ts_hi; ++nts; } } while (0)
    PG8_STAMP();
    unsigned voffA[2], voffB[2];
#pragma unroll
    for (int i = 0; i < 2; ++i) { int R, C; stage_rc(tid * 16 + i * 8192, R, C); const int Rb = Epi::PERM ? ((R & ~31) + perm32(R & 31)) : R;
        voffA[i] = (unsigned)(R * K + C) * 2u; voffB[i] = (unsigned)(Rb * K + C) * 2u; }
    const size_t kstep = (size_t)(BK * 2);
    const size_t hstep = (size_t)HALF * K * 2;
    const size_t tstep = 2 * hstep;
    const unsigned ldsw = (unsigned)wid * 1024u;
    const int aoff = lds_byte(wr * 64 + fr, fq * 8), boff = lds_byte(wc * 32 + fr, fq * 8);
#define PG8_SA(b, h) (((b) * 2 + (h)) * HTB)
#define PG8_SB(b, h) ((4 + (b) * 2 + (h)) * HTB)
#define PG8_STAGE(bufoff, gbase, voff) do { _Pragma("unroll") for (int _i = 0; _i < 2; ++_i) \
        __builtin_amdgcn_global_load_lds((const unsigned*)((const char*)(gbase) + (voff)[_i]), (PG8_LAS unsigned*)(lds + (bufoff) + ldsw + _i * 8192), 16, 0, 0); } while (0)
#define PG8_LDA(dst, b, h) do { _Pragma("unroll") for (int m = 0; m < 4; ++m) _Pragma("unroll") for (int k = 0; k < 2; ++k) dst[m][k] = *(const PG8_LAS bf16x8*)(lds + PG8_SA(b, h) + aoff + m * 2048 + k * 1024); } while (0)
#define PG8_LDB(dst, b, h) do { _Pragma("unroll") for (int n = 0; n < 2; ++n) _Pragma("unroll") for (int k = 0; k < 2; ++k) dst[n][k] = *(const PG8_LAS bf16x8*)(lds + PG8_SB(b, h) + boff + n * 2048 + k * 1024); } while (0)
#define PG8_MMA(ai, bj, At, Bt) do { __builtin_amdgcn_s_setprio(1); _Pragma("unroll") for (int m = 0; m < 4; ++m) _Pragma("unroll") for (int n = 0; n < 2; ++n) _Pragma("unroll") for (int k = 0; k < 2; ++k) \
        acc[ai][bj][m][n] = __builtin_amdgcn_mfma_f32_16x16x32_bf16(Bt[n][k], At[m][k], acc[ai][bj][m][n], 0, 0, 0); __builtin_amdgcn_s_setprio(0); } while (0)
#define PG8_WAIT_V(n) asm volatile("s_waitcnt vmcnt(" #n ")" ::: "memory")
#define PG8_WAIT_L(n) asm volatile("s_waitcnt lgkmcnt(" #n ")" ::: "memory")
#define PG8_BAR __builtin_amdgcn_s_barrier()
#define PG8_SCHED __builtin_amdgcn_sched_barrier(0)
    Unit cur, nxt; int ui = 0;
    if (!S.next(0, cur)) return;
    f32x4 acc[2][2][4][2];
#pragma unroll
    for (int a = 0; a < 2; ++a)
#pragma unroll
        for (int b = 0; b < 2; ++b)
#pragma unroll
            for (int m = 0; m < 4; ++m)
#pragma unroll
                for (int n = 0; n < 2; ++n) acc[a][b][m][n] = (f32x4){0.f, 0.f, 0.f, 0.f};
    bf16x8 At[4][2], B0[2][2], B1[2][2];
    const char* cA = (const char*)g.A + (size_t)cur.pm * tstep; const char* cB = (const char*)g.Bt + (size_t)cur.pn * tstep;
    S.a_ready(cur);
    PG8_STAGE(PG8_SB(0, 0), cB, voffB); PG8_STAGE(PG8_SA(0, 0), cA, voffA); PG8_STAGE(PG8_SB(0, 1), cB + hstep, voffB); PG8_STAGE(PG8_SA(0, 1), cA + hstep, voffA);
    if (wr == 1) PG8_BAR;
    PG8_WAIT_V(4); PG8_BAR;
    PG8_STAGE(PG8_SB(1, 0), cB + kstep, voffB); PG8_STAGE(PG8_SA(1, 0), cA + kstep, voffA); PG8_STAGE(PG8_SB(1, 1), cB + hstep + kstep, voffB);
    PG8_WAIT_V(6); PG8_BAR;
    PG8_STAMP();
    for (;;) {
        const bool has_next = S.next(ui + 1, nxt);
        const char* nA = has_next ? (const char*)g.A + (size_t)nxt.pm * tstep : cA; const char* nB = has_next ? (const char*)g.Bt + (size_t)nxt.pn * tstep : cB;
        for (int t = 0; t < nt; t += 2) {
            const bool last = (t == nt - 2);
            const char* a1 = cA + (size_t)(t + 1) * kstep;
            const char* a2 = last ? nA : cA + (size_t)(t + 2) * kstep; const char* b2 = last ? nB : cB + (size_t)(t + 2) * kstep;
            const char* a3 = a2 + kstep; const char* b3 = b2 + kstep;
            if (last && has_next) S.a_ready(nxt);
            PG8_LDB(B0, 0, 0); PG8_SCHED; PG8_LDA(At, 0, 0); PG8_STAGE(PG8_SA(1, 1), a1 + hstep, voffA);
            PG8_WAIT_L(8); PG8_BAR; PG8_WAIT_L(0); PG8_MMA(0, 0, At, B0); PG8_BAR; PG8_SCHED;
            PG8_LDB(B1, 0, 1); PG8_STAGE(PG8_SB(0, 0), b2, voffB);
            PG8_BAR; PG8_WAIT_L(0); PG8_MMA(0, 1, At, B1); PG8_BAR;
            PG8_LDA(At, 0, 1); PG8_STAGE(PG8_SA(0, 0), a2, voffA);
            PG8_BAR; PG8_WAIT_L(0); PG8_MMA(1, 0, At, B0); PG8_BAR; PG8_SCHED;
            PG8_STAGE(PG8_SB(0, 1), b2 + hstep, voffB);
            PG8_WAIT_V(6); PG8_BAR; PG8_MMA(1, 1, At, B1); PG8_BAR;
            PG8_LDB(B0, 1, 0); PG8_SCHED; PG8_LDA(At, 1, 0); PG8_STAGE(PG8_SA(0, 1), a2 + hstep, voffA);
            PG8_WAIT_L(8); PG8_BAR; PG8_WAIT_L(0); PG8_MMA(0, 0, At, B0); PG8_BAR; PG8_SCHED;
            PG8_LDB(B1, 1, 1); PG8_STAGE(PG8_SB(1, 0), b3, voffB);
            PG8_BAR; PG8_WAIT_L(0); PG8_MMA(0, 1, At, B1); PG8_BAR;
            PG8_LDA(At, 1, 1); PG8_STAGE(PG8_SA(1, 0), a3, voffA);
            PG8_BAR; PG8_WAIT_L(0); PG8_MMA(1, 0, At, B0); PG8_BAR; PG8_SCHED;
            PG8_STAGE(PG8_SB(1, 1), b3 + hstep, voffB);
            PG8_WAIT_V(6); PG8_BAR; PG8_MMA(1, 1, At, B1); PG8_BAR;
        }
        PG8_STAMP();
        if constexpr (!Epi::AFTER_DRAIN) { E(acc, cur, wr, wc, fr, fq); S.done(cur); }
        PG8_STAMP();
        if (!has_next) break;
#pragma unroll
        for (int a = 0; a < 2; ++a)
#pragma unroll
            for (int b = 0; b < 2; ++b)
#pragma unroll
                for (int m = 0; m < 4; ++m)
#pragma unroll
                    for (int n = 0; n < 2; ++n) acc[a][b][m][n] = (f32x4){0.f, 0.f, 0.f, 0.f};
        cur = nxt; cA = nA; cB = nB; ++ui;
    }
    PG8_WAIT_V(0);
    if (wr == 0) PG8_BAR;
    PG8_BAR;
    if constexpr (Epi::AFTER_DRAIN) { E.fused(acc, cur, wr, wc, fr, fq, lds, wid, lane); S.done(cur); }
    PG8_STAMP();
    if (STAMP && wid == 0) { stamps[lane] = lane < nts ? (((unsigned long long)(unsigned)ts_hi << 32) | (unsigned)ts_lo) : 0ull;
        if (lane == 62) stamps[62] = rt_entry; if (lane == 63) stamps[63] = (unsigned long long)wall_clock64(); }
#undef PG8_STAMP
#undef PG8_SA
#undef PG8_SB
#undef PG8_STAGE
#undef PG8_LDA
#undef PG8_LDB
#undef PG8_MMA
#undef PG8_WAIT_V
#undef PG8_WAIT_L
#undef PG8_BAR
#undef PG8_SCHED
}

__device__ __forceinline__ unsigned pk_bf16(float lo, float hi) { typedef float v2f __attribute__((ext_vector_type(2))); typedef __bf16 v2b __attribute__((ext_vector_type(2))); const v2f v = {lo, hi}; return __builtin_bit_cast(unsigned, __builtin_convertvector(v, v2b)); }
__device__ __forceinline__ float silu1(float x) { return x * __builtin_amdgcn_rcpf(1.0f + __expf(-x)); }
struct EpiBf16Act {
    static constexpr bool PERM = true, AFTER_DRAIN = false;
    bf16_t* O; int ldc; unsigned silu_mask;
    __device__ __forceinline__ void operator()(const f32x4 (&acc)[2][2][4][2], const Unit& u, int wr, int wc, int fr, int fq) const {
        const int row0 = u.pm * BM + wr * 64 + fr, col0 = u.pn * BM + wc * 32 + 8 * fq;
        const bool act = (silu_mask >> u.pn) & 1u;
#pragma unroll
        for (int ai = 0; ai < 2; ++ai)
#pragma unroll
            for (int m = 0; m < 4; ++m) { bf16_t* rowp = O + (size_t)(row0 + ai * HALF + m * 16) * ldc + col0;
#pragma unroll
                for (int bj = 0; bj < 2; ++bj) { f32x4 v0 = acc[ai][bj][m][0], v1 = acc[ai][bj][m][1];
                    if (act) {
#pragma unroll
                        for (int j = 0; j < 4; ++j) { v0[j] = silu1(v0[j]); v1[j] = silu1(v1[j]); } }
                    u32x4 w; w.x = pk_bf16(v0[0], v0[1]); w.y = pk_bf16(v0[2], v0[3]); w.z = pk_bf16(v1[0], v1[1]); w.w = pk_bf16(v1[2], v1[3]);
                    *(u32x4*)(rowp + bj * HALF) = w; } }
    }
};
struct EpiResid {
    static constexpr bool PERM = false, AFTER_DRAIN = false;
    float* C; const float* X; const float* mod_g;
    float alpha;
    __device__ __forceinline__ void operator()(const f32x4 (&acc)[2][2][4][2], const Unit& u, int wr, int wc, int fr, int fq) const {
        const int row0 = u.pm * BM + wr * 64 + fr, col0 = u.pn * BM + wc * 32 + 4 * fq;
        const float* gb = mod_g + (size_t)((u.pm * BM) / 2048) * 6144 + col0;
        f32x4 gv[2][2];
#pragma unroll
        for (int bj = 0; bj < 2; ++bj)
#pragma unroll
            for (int n = 0; n < 2; ++n) gv[bj][n] = *(const f32x4*)(gb + bj * HALF + n * 16) + 1.0f;
#pragma unroll
        for (int ai = 0; ai < 2; ++ai)
#pragma unroll
            for (int m = 0; m < 4; ++m) { const size_t ro = (size_t)(row0 + ai * HALF + m * 16) * 1024 + col0;
#pragma unroll
                for (int bj = 0; bj < 2; ++bj)
#pragma unroll
                    for (int n = 0; n < 2; ++n) { const f32x4 xv = *(const f32x4*)(X + ro + bj * HALF + n * 16); *(f32x4*)(C + ro + bj * HALF + n * 16) = alpha * xv + gv[bj][n] * acc[ai][bj][m][n]; } }
    }
};
struct EpiGlu {
    static constexpr bool PERM = false, AFTER_DRAIN = false;
    float* C; const bf16_t* Y; const float* bias;
    __device__ __forceinline__ void operator()(const f32x4 (&acc)[2][2][4][2], const Unit& u, int wr, int wc, int fr, int fq) const {
        const int row0 = u.pm * BM + wr * 64 + fr, col0 = u.pn * BM + wc * 32 + 4 * fq;
        f32x4 bv[2][2];
#pragma unroll
        for (int bj = 0; bj < 2; ++bj)
#pragma unroll
            for (int n = 0; n < 2; ++n) bv[bj][n] = *(const f32x4*)(bias + col0 + bj * HALF + n * 16);
#pragma unroll
        for (int ai = 0; ai < 2; ++ai)
#pragma unroll
            for (int m = 0; m < 4; ++m) { const size_t ro = (size_t)(row0 + ai * HALF + m * 16) * 512 + col0;
#pragma unroll
                for (int bj = 0; bj < 2; ++bj)
#pragma unroll
                    for (int n = 0; n < 2; ++n) {
                        const uint2 yw = *(const uint2*)(Y + ro + bj * HALF + n * 16);
                        const f32x4 z = acc[ai][bj][m][n] + bv[bj][n];
                        f32x4 o;
                        o[0] = __uint_as_float(yw.x << 16) * __builtin_amdgcn_rcpf(1.0f + __expf(-z[0])); o[1] = __uint_as_float(yw.x & 0xffff0000u) * __builtin_amdgcn_rcpf(1.0f + __expf(-z[1]));
                        o[2] = __uint_as_float(yw.y << 16) * __builtin_amdgcn_rcpf(1.0f + __expf(-z[2])); o[3] = __uint_as_float(yw.y & 0xffff0000u) * __builtin_amdgcn_rcpf(1.0f + __expf(-z[3]));
                        *(f32x4*)(C + ro + bj * HALF + n * 16) = o; } }
    }
};
}

DI void prep_mod_item(const Params& p, int item, char* smem) {
    float* condT = (float*)smem;
    float* red = condT + DM * 16;
    const int tid = my_tid();
    for (int i = tid; i < NB * DM; i += NTH) { const int b = i >> 10, k = i & 1023; condT[k * 16 + b] = siluf_(p.c[i]); }
    __syncthreads();
    const int ks = tid >> 5, col = tid & 31;
    float acc[16];
#pragma unroll
    for (int b = 0; b < 16; ++b) acc[b] = 0.f;
    const float* w = p.ada_w + (size_t)(ks * 64) * 6144 + item * 32 + col;
#pragma unroll 4
    for (int k = 0; k < 64; ++k) {
        const float wv = w[(size_t)k * 6144];
        const f32x4* cb = (const f32x4*)(condT + (ks * 64 + k) * 16);
        const f32x4 c0 = cb[0], c1 = cb[1], c2 = cb[2], c3 = cb[3];
        acc[0] += c0.x * wv; acc[1] += c0.y * wv; acc[2] += c0.z * wv; acc[3] += c0.w * wv;
        acc[4] += c1.x * wv; acc[5] += c1.y * wv; acc[6] += c1.z * wv; acc[7] += c1.w * wv;
        acc[8] += c2.x * wv; acc[9] += c2.y * wv; acc[10] += c2.z * wv; acc[11] += c2.w * wv;
        acc[12] += c3.x * wv; acc[13] += c3.y * wv; acc[14] += c3.z * wv; acc[15] += c3.w * wv;
    }
#pragma unroll
    for (int b = 0; b < 16; ++b) red[(ks * 32 + col) * 16 + b] = acc[b];
    __syncthreads();
    {
        const int b = tid >> 5;
        float sum = p.ada_b[item * 32 + col];
#pragma unroll
        for (int q = 0; q < 16; ++q) sum += red[(q * 32 + col) * 16 + b];
        ((float*)(p.ws + OFF_MOD))[b * 6144 + item * 32 + col] = sum;
    }
    __syncthreads();
}
DI void prep_s5_gemm_item(const Params& p, int g, char* smem) {
    f32x2* pw = (f32x2*)smem;
    f32x2* bbL = pw + 17 * 64;
    f32x2* cL = bbL + 64 * 16;
    const int tid = my_tid();
    const float dt = expf(p.log_dt[g]);
#pragma unroll 1
    for (int idx = tid; idx < 17 * 64; idx += NTH) {
        const int j = idx >> 6, pp = idx & 63;
        const float ar = p.a_re[g * 64 + pp], ai = p.a_im[g * 64 + pp];
        const float mag = expf(ar * dt * (float)j), ang = ai * dt * (float)j;
        pw[idx] = (f32x2){mag * cosf(ang), mag * sinf(ang)};
    }
    for (int idx = tid; idx < 16 * 64; idx += NTH) { const int i = idx >> 6, pp = idx & 63; cL[idx] = (f32x2){p.c_re[(g * 16 + i) * 64 + pp], p.c_im[(g * 16 + i) * 64 + pp]}; }
    __syncthreads();
    for (int idx = tid; idx < 64 * 16; idx += NTH) {
        const int pp = idx >> 4, i = idx & 15;
        const float ar = p.a_re[g * 64 + pp], ai = p.a_im[g * 64 + pp];
        const f32x2 lam = pw[64 + pp];
        const float den = ar * ar + ai * ai, nr = lam.x - 1.0f, ni = lam.y;
        const float zr = (nr * ar + ni * ai) / den, zi = (ni * ar - nr * ai) / den;
        const float br = p.b_re[(g * 64 + pp) * 16 + i], bi = p.b_im[(g * 64 + pp) * 16 + i];
        bbL[idx] = (f32x2){zr * br - zi * bi, zr * bi + zi * br};
    }
    __syncthreads();
    bf16_t* NBg = (bf16_t*)(p.ws + OFF_S5N) + (size_t)g * 128 * 256;
#pragma unroll 1
    for (int ch = tid; ch < 128 * 256 / 8; ch += NTH) {
        const int pq = ch >> 5, t = (ch >> 1) & 15, i0 = (ch & 1) * 8, pp = pq & 63;
        const f32x2 w = pw[(15 - t) * 64 + pp];
        float v[8];
#pragma unroll
        for (int e = 0; e < 8; ++e) { const f32x2 bb = bbL[pp * 16 + i0 + e]; v[e] = pq < 64 ? (w.x * bb.x - w.y * bb.y) : (w.x * bb.y + w.y * bb.x); }
        u32x4 o; o.x = pack2(v[0], v[1]); o.y = pack2(v[2], v[3]); o.z = pack2(v[4], v[5]); o.w = pack2(v[6], v[7]);
        *(u32x4*)(NBg + (size_t)((((pq >> 5) * 16 + t) * 64) + (i0 >> 3) * 32 + (pq & 31)) * 8) = o;
    }
    bf16_t* MBg = (bf16_t*)(p.ws + OFF_S5M) + (size_t)g * 256 * 128;
#pragma unroll 1
    for (int ch = tid; ch < 256 * 128 / 8; ch += NTH) {
        const int ti = ch >> 4, p0 = (ch & 15) * 8, tq = ti >> 4, iq = ti & 15;
        float v[8];
#pragma unroll
        for (int e = 0; e < 8; ++e) {
            const int pq = p0 + e, pp = pq & 63;
            const f32x2 c = cL[iq * 64 + pp], w = pw[(tq + 1) * 64 + pp];
            v[e] = pq < 64 ? (c.x * w.x - c.y * w.y) : -(c.x * w.y + c.y * w.x);
        }
        u32x4 o; o.x = pack2(v[0], v[1]); o.y = pack2(v[2], v[3]); o.z = pack2(v[4], v[5]); o.w = pack2(v[6], v[7]);
        *(u32x4*)(MBg + (size_t)((((ti >> 5) * 8 + (p0 >> 4)) * 64) + ((p0 >> 3) & 1) * 32 + (ti & 31)) * 8) = o;
    }
    bf16_t* KTg = (bf16_t*)(p.ws + OFF_S5K) + (size_t)g * 4096;
#pragma unroll 1
    for (int idx = tid; idx < 4096; idx += NTH) {
        const int lag = idx >> 8, iq = (idx >> 4) & 15, i = idx & 15;
        float acc = (lag == 0 && iq == i) ? p.dsk[g * 16 + iq] : 0.f;
#pragma unroll 4
        for (int pp = 0; pp < 64; ++pp) {
            const f32x2 c = cL[iq * 64 + pp], w = pw[lag * 64 + pp], bb = bbL[pp * 16 + i];
            const float mr = c.x * w.x - c.y * w.y, mi_ = c.x * w.y + c.y * w.x;
            acc += mr * bb.x - mi_ * bb.y;
        }
        KTg[idx] = f2bf(acc);
    }
    if (tid < 64) { float* L = (float*)(p.ws + OFF_S5L) + (g * 64 + tid) * 2; const f32x2 w = pw[16 * 64 + tid]; L[0] = w.x; L[1] = w.y; }
    __syncthreads();
}
DI void prep_s5_item(const Params& p, int g) {
    const int tid = my_tid();
    if (tid < SSP) {
        const int pi = g * SSP + tid;
        const float dt = expf(p.log_dt[g]);
        const float ar = p.a_re[pi], ai = p.a_im[pi];
        const float mag = expf(ar * dt);
        const float lr = mag * cosf(ai * dt), li = mag * sinf(ai * dt);
        const float den = ar * ar + ai * ai, nr = lr - 1.0f, ni = li;
        const float zr = (nr * ar + ni * ai) / den, zi = (ni * ar - nr * ai) / den;
        float* lam = (float*)(p.ws + OFF_LAM) + pi * 2;
        lam[0] = lr; lam[1] = li;
        float* bb = (float*)(p.ws + OFF_BB) + (size_t)pi * 32;
        for (int i = 0; i < SSC; ++i) {
            const float br = p.b_re[pi * SSC + i], bi = p.b_im[pi * SSC + i];
            bb[i * 2] = zr * br - zi * bi; bb[i * 2 + 1] = zr * bi + zi * br;
        }
    }
}
DI void prep_transpose_tile(const float* __restrict__ W, bf16_t* __restrict__ Wt, int K, int N, int kt, int nt, char* smem) {
    float* tile = (float*)smem;
    const int tid = my_tid();
#pragma unroll
    for (int q = 0; q < 2; ++q) {
        const int kk = (tid >> 4) + q * 32, c4 = (tid & 15) * 4;
        const float4 v = *(const float4*)(W + (size_t)(kt * 64 + kk) * N + nt * 64 + c4);
        tile[kk * 65 + c4] = v.x; tile[kk * 65 + c4 + 1] = v.y; tile[kk * 65 + c4 + 2] = v.z; tile[kk * 65 + c4 + 3] = v.w;
    }
    __syncthreads();
    const int n = tid >> 3, kc = tid & 7;
    uint4 o;
    o.x = pack2(tile[(kc * 8 + 0) * 65 + n], tile[(kc * 8 + 1) * 65 + n]);
    o.y = pack2(tile[(kc * 8 + 2) * 65 + n], tile[(kc * 8 + 3) * 65 + n]);
    o.z = pack2(tile[(kc * 8 + 4) * 65 + n], tile[(kc * 8 + 5) * 65 + n]);
    o.w = pack2(tile[(kc * 8 + 6) * 65 + n], tile[(kc * 8 + 7) * 65 + n]);
    *(uint4*)(Wt + (size_t)(nt * 64 + n) * K + kt * 64 + kc * 8) = o;
    __syncthreads();
}
DI void cvt_bf16_stream(const float* __restrict__ src, bf16_t* __restrict__ dst, size_t n8, int bid, int nb) {
    for (size_t i = (size_t)bid * NTH + my_tid(); i < n8; i += (size_t)nb * NTH) {
        const float4 a = *(const float4*)(src + i * 8), b = *(const float4*)(src + i * 8 + 4);
        uint4 o; o.x = pack2(a.x, a.y); o.y = pack2(a.z, a.w); o.z = pack2(b.x, b.y); o.w = pack2(b.z, b.w);
        *(uint4*)(dst + i * 8) = o;
    }
}
DI void cvt_fp8_rows(const float* __restrict__ src, unsigned char* __restrict__ dst, float* __restrict__ inv, int bid, int nb) {
    const int lane = my_tid() & 63, wid = my_tid() >> 6;
    for (int row = bid * 8 + wid; row < NEXP; row += nb * 8) {
        const float* sp = src + (size_t)row * DM + lane * 16;
        const f32x4 a = *(const f32x4*)sp, b = *(const f32x4*)(sp + 4), c = *(const f32x4*)(sp + 8), d = *(const f32x4*)(sp + 12);
        float m = fmaxf(fmaxf(fmaxf(fabsf(a.x), fabsf(a.y)), fmaxf(fabsf(a.z), fabsf(a.w))), fmaxf(fmaxf(fabsf(b.x), fabsf(b.y)), fmaxf(fabsf(b.z), fabsf(b.w))));
        m = fmaxf(m, fmaxf(fmaxf(fmaxf(fabsf(c.x), fabsf(c.y)), fmaxf(fabsf(c.z), fabsf(c.w))), fmaxf(fmaxf(fabsf(d.x), fabsf(d.y)), fmaxf(fabsf(d.z), fabsf(d.w)))));
#pragma unroll
        for (int s = 1; s < 64; s <<= 1) m = fmaxf(m, __shfl_xor(m, s));
        float sc = 1.f, isc = 1.f;
        if (m > 1e-30f) {
            int k = (int)floorf(log2f(448.0f / m));
            k = k < -60 ? -60 : (k > 60 ? 60 : k);
            sc = ldexpf(1.0f, k); isc = ldexpf(1.0f, -k);
            if (m * sc > 448.0f) { sc *= 0.5f; isc *= 2.0f; }
        }
        u32x4 o;
        int w;
        w = __builtin_amdgcn_cvt_pk_fp8_f32(a.x * sc, a.y * sc, 0, false); w = __builtin_amdgcn_cvt_pk_fp8_f32(a.z * sc, a.w * sc, w, true); o.x = (unsigned)w;
        w = __builtin_amdgcn_cvt_pk_fp8_f32(b.x * sc, b.y * sc, 0, false); w = __builtin_amdgcn_cvt_pk_fp8_f32(b.z * sc, b.w * sc, w, true); o.y = (unsigned)w;
        w = __builtin_amdgcn_cvt_pk_fp8_f32(c.x * sc, c.y * sc, 0, false); w = __builtin_amdgcn_cvt_pk_fp8_f32(c.z * sc, c.w * sc, w, true); o.z = (unsigned)w;
        w = __builtin_amdgcn_cvt_pk_fp8_f32(d.x * sc, d.y * sc, 0, false); w = __builtin_amdgcn_cvt_pk_fp8_f32(d.z * sc, d.w * sc, w, true); o.w = (unsigned)w;
        *(u32x4*)(dst + (size_t)row * DM + lane * 16) = o;
        if (lane == 0) inv[row] = isc;
    }
}
DI void cvt_fp4_rows(const float* __restrict__ src, unsigned char* __restrict__ dst, float* __restrict__ inv, int bid, int nb) {
    const int lane = my_tid() & 63, wid = my_tid() >> 6;
    for (int row = bid * 8 + wid; row < NEXP; row += nb * 8) {
        const float* sp = src + (size_t)row * DM + lane * 16;
        const f32x4 a = *(const f32x4*)sp, b = *(const f32x4*)(sp + 4), c = *(const f32x4*)(sp + 8), d = *(const f32x4*)(sp + 12);
        float m = fmaxf(fmaxf(fmaxf(fabsf(a.x), fabsf(a.y)), fmaxf(fabsf(a.z), fabsf(a.w))), fmaxf(fmaxf(fabsf(b.x), fabsf(b.y)), fmaxf(fabsf(b.z), fabsf(b.w))));
        m = fmaxf(m, fmaxf(fmaxf(fmaxf(fabsf(c.x), fabsf(c.y)), fmaxf(fabsf(c.z), fabsf(c.w))), fmaxf(fmaxf(fabsf(d.x), fabsf(d.y)), fmaxf(fabsf(d.z), fabsf(d.w)))));
#pragma unroll
        for (int s = 1; s < 64; s <<= 1) m = fmaxf(m, __shfl_xor(m, s));
        const float sc = m > 1e-30f ? 6.0f / m : 1.0f, isc = m > 1e-30f ? m * (1.0f / 6.0f) : 1.0f;
        unsigned w0 = 0u, w1 = 0u;
        w0 = __builtin_amdgcn_cvt_scalef32_pk_fp4_f32(w0, a.x * sc, a.y * sc, 1.0f, 0); w0 = __builtin_amdgcn_cvt_scalef32_pk_fp4_f32(w0, a.z * sc, a.w * sc, 1.0f, 1);
        w0 = __builtin_amdgcn_cvt_scalef32_pk_fp4_f32(w0, b.x * sc, b.y * sc, 1.0f, 2); w0 = __builtin_amdgcn_cvt_scalef32_pk_fp4_f32(w0, b.z * sc, b.w * sc, 1.0f, 3);
        w1 = __builtin_amdgcn_cvt_scalef32_pk_fp4_f32(w1, c.x * sc, c.y * sc, 1.0f, 0); w1 = __builtin_amdgcn_cvt_scalef32_pk_fp4_f32(w1, c.z * sc, c.w * sc, 1.0f, 1);
        w1 = __builtin_amdgcn_cvt_scalef32_pk_fp4_f32(w1, d.x * sc, d.y * sc, 1.0f, 2); w1 = __builtin_amdgcn_cvt_scalef32_pk_fp4_f32(w1, d.z * sc, d.w * sc, 1.0f, 3);
        *(uint2*)(dst + (size_t)row * (DM / 2) + lane * 8) = make_uint2(w0, w1);
        if (lane == 0) inv[row] = isc;
    }
}
template <int OFFS>
DI void cvt_i8_rows(const float* __restrict__ src, unsigned char* __restrict__ dst, float* __restrict__ inv, int bid, int nb) {
    const int lane = my_tid() & 63, wid = my_tid() >> 6;
    for (int row = bid * 8 + wid; row < NEXP; row += nb * 8) {
        const float* sp = src + (size_t)row * DM + lane * 16;
        const f32x4 a = *(const f32x4*)sp, b = *(const f32x4*)(sp + 4), c = *(const f32x4*)(sp + 8), d = *(const f32x4*)(sp + 12);
        float m = fmaxf(fmaxf(fmaxf(fabsf(a.x), fabsf(a.y)), fmaxf(fabsf(a.z), fabsf(a.w))), fmaxf(fmaxf(fabsf(b.x), fabsf(b.y)), fmaxf(fabsf(b.z), fabsf(b.w))));
        m = fmaxf(m, fmaxf(fmaxf(fmaxf(fabsf(c.x), fabsf(c.y)), fmaxf(fabsf(c.z), fabsf(c.w))), fmaxf(fmaxf(fabsf(d.x), fabsf(d.y)), fmaxf(fabsf(d.z), fabsf(d.w)))));
#pragma unroll
        for (int s = 1; s < 64; s <<= 1) m = fmaxf(m, __shfl_xor(m, s));
        const float sc = m > 1e-30f ? 127.0f / m : 1.0f, isc = m > 1e-30f ? m * (1.0f / 127.0f) : 1.0f;
        const float v[16] = {a.x, a.y, a.z, a.w, b.x, b.y, b.z, b.w, c.x, c.y, c.z, c.w, d.x, d.y, d.z, d.w};
        unsigned w[4];
#pragma unroll
        for (int q = 0; q < 4; ++q) {
            unsigned pk = 0u;
#pragma unroll
            for (int e = 0; e < 4; ++e) { const int qi = (int)rintf(v[q * 4 + e] * sc) + OFFS; pk |= ((unsigned)qi & 0xffu) << (8 * e); }
            w[q] = pk;
        }
        *(u32x4*)(dst + (size_t)row * DM + lane * 16) = (u32x4){w[0], w[1], w[2], w[3]};
        if (lane == 0) inv[row] = isc;
    }
}
DI void phase_mod(const Params& p, int bid, int nb, char* smem) {
    for (int it = bid; it < 192 + 32 + 1; it += nb) {
        if (it < 192) prep_mod_item(p, it, smem);
        else if (it < 224) prep_s5_gemm_item(p, it - 192, smem);
        else {
            const int j = my_tid();
            const float a0 = p.hg_lb[j], a1 = p.hg_lb[512 + j], m = fmaxf(a0, a1);
            const float e0 = expf(a0 - m), e1 = expf(a1 - m);
            ((float*)(p.ws + OFF_LB))[j] = e0 / (e0 + e1);
        }
    }
}
DI void phase_prep(const Params& p, int bid, int nb, char* smem) {
    constexpr int T_WIN = 16 * 40, T_GLU = 8 * 8, T_WOUT = 16 * 16, T_WQ = 16 * 32;
    constexpr int I_GLU = T_WIN, I_WOUT = I_GLU + T_GLU, I_WQ = I_WOUT + T_WOUT, I_END = I_WQ + T_WQ;
    for (int it = bid; it < I_END; it += nb) {
        if (it < I_GLU) { const int t = it; prep_transpose_tile(p.w_in, (bf16_t*)(p.ws + OFF_WIN), DM, INC, t / 40, t % 40, smem); }
        else if (it < I_WOUT) { const int t = it - I_GLU; prep_transpose_tile(p.glu_w, (bf16_t*)(p.ws + OFF_GLU), 512, 512, t / 8, t % 8, smem); }
        else if (it < I_WQ) { const int t = it - I_WOUT; prep_transpose_tile(p.w_out, (bf16_t*)(p.ws + OFF_WOUT), DM, DM, t / 16, t % 16, smem); }
        else { const int t = it - I_WQ; prep_transpose_tile(p.w_q, (bf16_t*)(p.ws + OFF_WQ), DM, 2048, t / 32, t % 32, smem); }
    }
    cvt_bf16_stream(p.subk, (bf16_t*)(p.ws + OFF_SUBK), (size_t)16 * 128 * 128 / 8, bid, nb);
    cvt_i8_rows<0>(p.pu, (unsigned char*)(p.ws + OFF_UT), (float*)(p.ws + OFF_SU), bid, nb);
    cvt_i8_rows<128>(p.pv, (unsigned char*)(p.ws + OFF_VT), (float*)(p.ws + OFF_SV), bid, nb);
}

DI void phase_h(const Params& p, int bid, int nb) {
    const float* mod = (const float*)(p.ws + OFF_MOD);
    bf16_t* H = (bf16_t*)(p.ws + OFF_H);
    const size_t n8 = (size_t)NTOK * DM / 8;
    for (size_t i = (size_t)bid * NTH + my_tid(); i < n8; i += (size_t)nb * NTH) {
        const int row = (int)(i >> 7), c0 = (int)(i & 127) * 8, b = row / SEQ;
        const float* sh = mod + b * 6144 + c0;
        const float* sc = sh + 1024;
        const float4 a = *(const float4*)(p.x + i * 8), bq = *(const float4*)(p.x + i * 8 + 4);
        const float4 s0 = *(const float4*)sc, s1 = *(const float4*)(sc + 4), h0 = *(const float4*)sh, h1 = *(const float4*)(sh + 4);
        uint4 o;
        o.x = pack2(a.x * (1.f + s0.x) + h0.x, a.y * (1.f + s0.y) + h0.y);
        o.y = pack2(a.z * (1.f + s0.z) + h0.z, a.w * (1.f + s0.w) + h0.w);
        o.z = pack2(bq.x * (1.f + s1.x) + h1.x, bq.y * (1.f + s1.y) + h1.y);
        o.w = pack2(bq.z * (1.f + s1.z) + h1.z, bq.w * (1.f + s1.w) + h1.w);
        *(uint4*)(H + i * 8) = o;
    }
}

DI void phase_proj(const Params& p, int bid, int nb, char* smem) {
    pg8::Gemm g{(const bf16_t*)(p.ws + OFF_H), (const bf16_t*)(p.ws + OFF_WIN), NTOK, INC, DM};
    pg8::StaticOrder S; S.init(NTOK, INC, nb, bid);
    pg8::EpiBf16Act E{(bf16_t*)(p.ws + OFF_PROJ), INC, 0xC3u};
    pg8::gemm_phase<pg8::EpiBf16Act, pg8::StaticOrder, false>((PG8_LAS unsigned char*)smem, g, S, E, nullptr);
}

DI void hgrn_item(const Params& p, int item, char* smem) {
    const int vs = item & 7, hd = (item >> 3) & 3, b = item >> 5;
    const bf16_t* P = (const bf16_t*)(p.ws + OFF_PROJ);
    const float* lb = (const float*)(p.ws + OFF_LB) + hd * HDK;
    float* ORAW = (float*)(p.ws + OFF_ORAW);
    float* sq = (float*)smem;
    float* sf = sq + 32 * 128;
    float* sv = sf + 32 * 128;
    float* sp = sv + 32 * 16;
    const int tid = my_tid(), lane = tid & 63, wid = tid >> 6, kq = tid >> 4, v = tid & 15;
    float S0 = 0.f, S1 = 0.f, S2 = 0.f, S3 = 0.f;
    for (int t0 = 0; t0 < SEQ; t0 += 32) {
        for (int i = tid; i < 32 * 128; i += NTH) {
            const int t = i >> 7, k = i & 127;
            const bf16_t* row = P + (size_t)(b * SEQ + t0 + t) * INC + hd * HDK + k;
            sq[i] = bf2f(row[0]);
            const float l = lb[k];
            sf[i] = l + (1.0f - l) * sigmoidf_(bf2f(row[512]));
        }
        { const int t = tid >> 4; sv[tid] = bf2f(P[(size_t)(b * SEQ + t0 + t) * INC + 1024 + hd * HDK + vs * 16 + v]); }
        __syncthreads();
        for (int t = 0; t < 32; ++t) {
            const float4 f4 = *(const float4*)(sf + t * 128 + kq * 4), q4 = *(const float4*)(sq + t * 128 + kq * 4);
            const float vv = sv[t * 16 + v];
            S0 = f4.x * S0 + (1.0f - f4.x) * vv; S1 = f4.y * S1 + (1.0f - f4.y) * vv;
            S2 = f4.z * S2 + (1.0f - f4.z) * vv; S3 = f4.w * S3 + (1.0f - f4.w) * vv;
            float part = q4.x * S0 + q4.y * S1 + q4.z * S2 + q4.w * S3;
            part += __shfl_xor(part, 16); part += __shfl_xor(part, 32);
            if (lane < 16) sp[(t * 8 + wid) * 16 + v] = part;
        }
        __syncthreads();
        {
            const int t = tid >> 4;
            float o = 0.f;
#pragma unroll
            for (int w = 0; w < 8; ++w) o += sp[(t * 8 + w) * 16 + v];
            ORAW[(size_t)(b * SEQ + t0 + t) * DHG + hd * HDK + vs * 16 + v] = o;
        }
        __syncthreads();
    }
}
DI void s5_item(const Params& p, int item, char* smem) {
    const int oct = item & 3, b = item >> 2;
    const int tid = my_tid(), lane = tid & 63, wid = tid >> 6, g = oct * 8 + wid;
    const bf16_t* P = (const bf16_t*)(p.ws + OFF_PROJ);
    bf16_t* Y = (bf16_t*)(p.ws + OFF_YSSM);
    float* su = (float*)smem + wid * 64 * 16;
    const float* lam = (const float*)(p.ws + OFF_LAM) + (g * SSP + lane) * 2;
    const float lr = lam[0], li = lam[1];
    const float* bb = (const float*)(p.ws + OFF_BB) + (size_t)(g * SSP + lane) * 32;
    float bbr[16], bbi[16], cr[16], ci[16];
#pragma unroll
    for (int i = 0; i < 16; ++i) { bbr[i] = bb[2 * i]; bbi[i] = bb[2 * i + 1]; cr[i] = p.c_re[(g * SSC + i) * SSP + lane]; ci[i] = p.c_im[(g * SSC + i) * SSP + lane]; }
    const int ch = (lane >> 2) & 15;
    const float dch = p.dsk[g * SSC + ch];
    float xr = 0.f, xi = 0.f;
    for (int t0 = 0; t0 < SEQ; t0 += 64) {
        {
            const uint4* src = (const uint4*)(P + (size_t)(b * SEQ + t0 + lane) * INC + 2048 + g * SSC);
            const uint4 a = src[0], c = src[1];
            float* d = su + lane * 16;
            d[0] = bflo(a.x); d[1] = bfhi(a.x); d[2] = bflo(a.y); d[3] = bfhi(a.y); d[4] = bflo(a.z); d[5] = bfhi(a.z); d[6] = bflo(a.w); d[7] = bfhi(a.w);
            d[8] = bflo(c.x); d[9] = bfhi(c.x); d[10] = bflo(c.y); d[11] = bfhi(c.y); d[12] = bflo(c.z); d[13] = bfhi(c.z); d[14] = bflo(c.w); d[15] = bfhi(c.w);
        }
        __syncthreads();
        for (int t = 0; t < 64; ++t) {
            float u[16];
            const float4* us = (const float4*)(su + t * 16);
            const float4 u0 = us[0], u1 = us[1], u2 = us[2], u3 = us[3];
            u[0] = u0.x; u[1] = u0.y; u[2] = u0.z; u[3] = u0.w; u[4] = u1.x; u[5] = u1.y; u[6] = u1.z; u[7] = u1.w;
            u[8] = u2.x; u[9] = u2.y; u[10] = u2.z; u[11] = u2.w; u[12] = u3.x; u[13] = u3.y; u[14] = u3.z; u[15] = u3.w;
            float bur = 0.f, bui = 0.f;
#pragma unroll
            for (int i = 0; i < 16; ++i) { bur += bbr[i] * u[i]; bui += bbi[i] * u[i]; }
            const float nxr = lr * xr - li * xi + bur, nxi = lr * xi + li * xr + bui;
            xr = nxr; xi = nxi;
            float y[16];
#pragma unroll
            for (int i = 0; i < 16; ++i) y[i] = cr[i] * xr - ci[i] * xi;
            const bool b5 = lane & 32, b4 = lane & 16, b3 = lane & 8, b2 = lane & 4;
            float y8[8], y4[4], y2[2];
#pragma unroll
            for (int j = 0; j < 8; ++j) { const float keep = b5 ? y[8 + j] : y[j], send = b5 ? y[j] : y[8 + j]; y8[j] = keep + __shfl_xor(send, 32); }
#pragma unroll
            for (int j = 0; j < 4; ++j) { const float keep = b4 ? y8[4 + j] : y8[j], send = b4 ? y8[j] : y8[4 + j]; y4[j] = keep + __shfl_xor(send, 16); }
#pragma unroll
            for (int j = 0; j < 2; ++j) { const float keep = b3 ? y4[2 + j] : y4[j], send = b3 ? y4[j] : y4[2 + j]; y2[j] = keep + __shfl_xor(send, 8); }
            float y1;
            { const float keep = b2 ? y2[1] : y2[0], send = b2 ? y2[0] : y2[1]; y1 = keep + __shfl_xor(send, 4); }
            y1 += __shfl_xor(y1, 1); y1 += __shfl_xor(y1, 2);
            if ((lane & 3) == 0) {
                const float uu = su[t * 16 + ch];
                Y[(size_t)(b * SEQ + t0 + t) * DSS + g * SSC + ch] = f2bf(geluf_(y1 + dch * uu));
            }
        }
        __syncthreads();
    }
}
DI int crow(int i, int h) { return (i & 3) + 8 * (i >> 2) + 4 * h; }
DI void phase_hgprep(const Params& p, int bid, int nb) {
    const bf16_t* P = (const bf16_t*)(p.ws + OFF_PROJ);
    const float* lbp = (const float*)(p.ws + OFF_LB);
    const int tid = my_tid(), lane = tid & 63, wid = tid >> 6, tq = lane >> 4, cg = lane & 15;
#pragma unroll 1
    for (int it = bid * 8 + wid; it < 8192; it += nb * 8) {
        const int tile = it >> 1, c = tile & 63, hd = (tile >> 6) & 3, b = tile >> 8, k0 = (it & 1) * 64 + cg * 4;
        const bf16_t* base = P + (size_t)(b * SEQ + c * 32 + tq * 8) * INC + hd * HDK + k0;
        uint2 qw[8], fw[8];
#pragma unroll
        for (int tt = 0; tt < 8; ++tt) { qw[tt] = *(const uint2*)(base + (size_t)tt * INC); fw[tt] = *(const uint2*)(base + (size_t)tt * INC + 512); }
        const f32x4 l4 = *(const f32x4*)(lbp + hd * HDK + k0);
        const float lb4[4] = {l4.x, l4.y, l4.z, l4.w};
        float bl[8][4], kk[8][4], run[4];
#pragma unroll
        for (int e = 0; e < 4; ++e) run[e] = 0.f;
#pragma unroll
        for (int tt = 0; tt < 8; ++tt) {
            const float fl[4] = {bflo(fw[tt].x), bfhi(fw[tt].x), bflo(fw[tt].y), bfhi(fw[tt].y)};
#pragma unroll
            for (int e = 0; e < 4; ++e) {
                const float f = lb4[e] + (1.0f - lb4[e]) * sigmoidf_(fl[e]);
                run[e] += __logf(f); bl[tt][e] = run[e]; kk[tt][e] = 1.0f - f;
            }
        }
        float off[4], tot[4];
#pragma unroll
        for (int e = 0; e < 4; ++e) {
            const float t0 = __shfl(run[e], cg), t1 = __shfl(run[e], cg + 16), t2 = __shfl(run[e], cg + 32), t3 = __shfl(run[e], cg + 48);
            off[e] = (tq > 0 ? t0 : 0.f) + (tq > 1 ? t1 : 0.f) + (tq > 2 ? t2 : 0.f);
            tot[e] = (t0 + t1) + (t2 + t3);
        }
        bf16_t* HQ = (bf16_t*)(p.ws + OFF_HQ) + (size_t)tile * 4096 + (tq * 8) * 128 + k0;
        bf16_t* HK = (bf16_t*)(p.ws + OFF_HK) + (size_t)tile * 4096 + (tq * 8) * 128 + k0;
#pragma unroll
        for (int tt = 0; tt < 8; ++tt) {
            const float qv[4] = {bflo(qw[tt].x), bfhi(qw[tt].x), bflo(qw[tt].y), bfhi(qw[tt].y)};
            float qo[4], ko[4];
#pragma unroll
            for (int e = 0; e < 4; ++e) { const float bb = off[e] + bl[tt][e]; qo[e] = qv[e] * __expf(bb); ko[e] = kk[tt][e] * __expf(fminf(-bb, 80.0f)); }
            *(uint2*)(HQ + tt * 128) = make_uint2(pack2(qo[0], qo[1]), pack2(qo[2], qo[3]));
            *(uint2*)(HK + tt * 128) = make_uint2(pack2(ko[0], ko[1]), pack2(ko[2], ko[3]));
        }
        if (tq == 0) *(f32x4*)((float*)(p.ws + OFF_HG) + (size_t)tile * 128 + k0) = (f32x4){__expf(tot[0]), __expf(tot[1]), __expf(tot[2]), __expf(tot[3])};
    }
}
typedef short s16x4 __attribute__((ext_vector_type(4)));
DI bf16x8 cat8(const s16x4 lo, const s16x4 hi) { return (bf16x8){lo.x, lo.y, lo.z, lo.w, hi.x, hi.y, hi.z, hi.w}; }
DI s16x4 lds_tr(const char* a) { return __builtin_amdgcn_ds_read_tr16_b64_v4i16((__attribute__((address_space(3))) s16x4*)a); }
DI void hgrn_mfma_item(const Params& p, int item, char* smem) {
    constexpr int QP_OFF = 0, KP_OFF = 8704, V_OFF = 17408, G_OFF = 26112, BUF = 26624;
    const int tid = my_tid(), lane = tid & 63, wid = tid >> 6, r = lane & 31, h = lane >> 5;
    const int b = item >> 2, hd = item & 3;
    const size_t tile0 = (size_t)item * 64;
    const bf16_t* HQ = (const bf16_t*)(p.ws + OFF_HQ) + tile0 * 4096;
    const bf16_t* HK = (const bf16_t*)(p.ws + OFF_HK) + tile0 * 4096;
    const bf16_t* PV = (const bf16_t*)(p.ws + OFF_PROJ) + (size_t)b * SEQ * INC + 1024 + hd * HDK;
    const float* HG = (const float*)(p.ws + OFF_HG) + tile0 * 128;
    float* ORAW = (float*)(p.ws + OFF_ORAW) + (size_t)b * SEQ * DHG + hd * HDK;
    const bool helper = wid >= 4;
    const int ht = tid - 256;
    const int i0 = ht, i1 = ht + 256;
    const int lo0 = (i0 >> 4) * 272 + (i0 & 15) * 16, lo1 = (i1 >> 4) * 272 + (i1 & 15) * 16;
    u32x4 A0, A1, A2, A3, A4, A5, A6, B0, B1, B2, B3, B4, B5, B6;
    A0 = A1 = A2 = A3 = A4 = A5 = A6 = B0 = B1 = B2 = B3 = B4 = B5 = B6 = (u32x4){0, 0, 0, 0};
    f32x16 S[4];
#pragma unroll
    for (int kb = 0; kb < 4; ++kb)
#pragma unroll
        for (int i = 0; i < 16; ++i) S[kb][i] = 0.f;
#define HG_LOAD(X, c_) { const size_t o_ = (size_t)(c_) * 4096; \
        X##0 = *(const u32x4*)(HQ + o_ + i0 * 8); X##1 = *(const u32x4*)(HQ + o_ + i1 * 8); \
        X##2 = *(const u32x4*)(HK + o_ + i0 * 8); X##3 = *(const u32x4*)(HK + o_ + i1 * 8); \
        X##4 = *(const u32x4*)(PV + (size_t)((c_) * 32 + (i0 >> 4)) * INC + (i0 & 15) * 8); X##5 = *(const u32x4*)(PV + (size_t)((c_) * 32 + (i1 >> 4)) * INC + (i1 & 15) * 8); \
        if (ht < 32) X##6 = *(const u32x4*)(HG + (size_t)(c_) * 128 + ht * 4); }
#define HG_STORE(X, buf_) { char* B_ = smem + (buf_) * BUF; \
        *(u32x4*)(B_ + QP_OFF + lo0) = X##0; *(u32x4*)(B_ + QP_OFF + lo1) = X##1; \
        *(u32x4*)(B_ + KP_OFF + lo0) = X##2; *(u32x4*)(B_ + KP_OFF + lo1) = X##3; \
        *(u32x4*)(B_ + V_OFF + lo0) = X##4; *(u32x4*)(B_ + V_OFF + lo1) = X##5; \
        if (ht < 32) *(u32x4*)(B_ + G_OFF + ht * 16) = X##6; }
    const int tq = (lane >> 2) & 3, tp = lane & 3, tg = lane >> 4;
    const int tr_nat = (8 * (tg >> 1) + tq) * 272 + (16 * (tg & 1) + 4 * tp) * 2;
    const int tr_krw = (4 * (tg >> 1) + tq) * 272 + (16 * (tg & 1) + 4 * tp) * 2;
    if (helper) { HG_LOAD(A, 0); HG_STORE(A, 0); HG_LOAD(A, 1); HG_STORE(A, 1); HG_LOAD(A, 2); HG_LOAD(B, 3); }
    __syncthreads();
#define HG_COMPUTE(c_) { \
        const char* B = smem + ((c_) % 3) * BUF; const int w = wid; \
        f32x16 pt; _Pragma("unroll") for (int i = 0; i < 16; ++i) pt[i] = 0.f; \
        _Pragma("unroll") for (int ks = 0; ks < 8; ++ks) { \
            const bf16x8 a = *(const bf16x8*)(B + KP_OFF + r * 272 + ks * 32 + h * 16); \
            const bf16x8 bq = *(const bf16x8*)(B + QP_OFF + r * 272 + ks * 32 + h * 16); \
            pt = __builtin_amdgcn_mfma_f32_32x32x16_bf16(a, bq, pt, 0, 0, 0); } \
        _Pragma("unroll") for (int i = 0; i < 16; ++i) if (crow(i, h) > r) pt[i] = 0.f; \
        f32x16 o; _Pragma("unroll") for (int i = 0; i < 16; ++i) o[i] = 0.f; \
        _Pragma("unroll") for (int sp = 0; sp < 2; ++sp) { \
            const char* vb = B + V_OFF + (16 * sp) * 272 + (32 * w) * 2 + tr_krw; \
            const bf16x8 bv = cat8(lds_tr(vb), lds_tr(vb + 8 * 272)); \
            o = __builtin_amdgcn_mfma_f32_32x32x16_bf16(pack8(pt, 8 * sp), bv, o, 0, 0, 0); } \
        _Pragma("unroll") for (int kb = 0; kb < 4; ++kb) _Pragma("unroll") for (int sp = 0; sp < 2; ++sp) { \
            const char* qb = B + QP_OFF + r * 272 + kb * 64 + sp * 32 + h * 8; \
            const bf16x8 aq = cat8(*(const s16x4*)qb, *(const s16x4*)(qb + 16)); \
            o = __builtin_amdgcn_mfma_f32_32x32x16_bf16(aq, pack8(S[kb], 8 * sp), o, 0, 0, 0); } \
        _Pragma("unroll") for (int i = 0; i < 16; ++i) ORAW[(size_t)((c_) * 32 + crow(i, h)) * DHG + 32 * w + r] = o[i]; \
        bf16x8 bvn[2]; \
        _Pragma("unroll") for (int ks = 0; ks < 2; ++ks) { const char* vb = B + V_OFF + (16 * ks) * 272 + (32 * w) * 2 + tr_nat; bvn[ks] = cat8(lds_tr(vb), lds_tr(vb + 4 * 272)); } \
        _Pragma("unroll") for (int kb = 0; kb < 4; ++kb) { \
            _Pragma("unroll") for (int ks = 0; ks < 2; ++ks) { \
                const char* kp = B + KP_OFF + (16 * ks) * 272 + (32 * kb) * 2 + tr_nat; \
                const bf16x8 a = cat8(lds_tr(kp), lds_tr(kp + 4 * 272)); \
                S[kb] = __builtin_amdgcn_mfma_f32_32x32x16_bf16(a, bvn[ks], S[kb], 0, 0, 0); } \
            _Pragma("unroll") for (int j = 0; j < 4; ++j) { \
                const f32x4 g4 = *(const f32x4*)(B + G_OFF + (kb * 32 + 8 * j + 4 * h) * 4); \
                S[kb][4 * j] *= g4.x; S[kb][4 * j + 1] *= g4.y; S[kb][4 * j + 2] *= g4.z; S[kb][4 * j + 3] *= g4.w; } } }
    for (int c = 0; c < 64; c += 2) {
        if (helper) { if (c + 2 < 64) HG_STORE(A, (c + 2) % 3); if (c + 4 < 64) HG_LOAD(A, c + 4); } else HG_COMPUTE(c);
        __syncthreads();
        if (helper) { if (c + 3 < 64) HG_STORE(B, (c + 3) % 3); if (c + 5 < 64) HG_LOAD(B, c + 5); } else HG_COMPUTE(c + 1);
        __syncthreads();
    }
#undef HG_LOAD
#undef HG_STORE
#undef HG_COMPUTE
}
template <int NJ>
DI void s5_gemm2_tile(const bf16x8 (&af)[16], const bf16_t* KTl, const bf16_t* Xin, const bf16_t* MBg, bf16_t* Yout, bf16_t* stg, const int mi, const int r, const int h) {
    f32x16 y;
#pragma unroll
    for (int i = 0; i < 16; ++i) y[i] = 0.f;
    const int tsel = r >> 4, iq = r & 15;
    bf16x8 bm[8];
#pragma unroll
    for (int ks = 0; ks < 8; ++ks) bm[ks] = *(const bf16x8*)(MBg + (size_t)((NJ * 8 + ks) * 64 + h * 32 + r) * 8);
#pragma unroll
    for (int ks = 0; ks <= 2 * NJ; ++ks) {
        const bf16x8 bk = *(const bf16x8*)(KTl + ((2 * NJ + tsel - ks) * 16 + iq) * 16 + 8 * h);
        y = __builtin_amdgcn_mfma_f32_32x32x16_bf16(af[ks], bk, y, 0, 0, 0);
    }
    {
        bf16x8 bk = *(const bf16x8*)(KTl + iq * 16 + 8 * h);
        if (tsel == 0) bk = (bf16x8){0, 0, 0, 0, 0, 0, 0, 0};
        y = __builtin_amdgcn_mfma_f32_32x32x16_bf16(af[2 * NJ + 1], bk, y, 0, 0, 0);
    }
#pragma unroll
    for (int ks = 0; ks < 8; ++ks) {
        const bf16x8 a = *(const bf16x8*)(Xin + (mi * 32 + r) * 136 + ks * 16 + 8 * h);
        y = __builtin_amdgcn_mfma_f32_32x32x16_bf16(a, bm[ks], y, 0, 0, 0);
    }
#pragma unroll
    for (int i = 0; i < 16; ++i) stg[((crow(i, h) * 2 + tsel) * 16) + iq] = f2bf(gelu_as(y[i]));
    {
        const int lane = h * 32 + r, cl = lane >> 1, ts = lane & 1;
        const u32x4 lo = *(const u32x4*)(stg + lane * 16), hi = *(const u32x4*)(stg + lane * 16 + 8);
        bf16_t* dst = Yout + (size_t)((mi * 32 + cl) * 16 + 2 * NJ + ts) * DSS;
        *(u32x4*)dst = lo; *(u32x4*)(dst + 8) = hi;
    }
}
DI void s5_gemm_item(const Params& p, int b, int g, char* smem) {
    float* E = (float*)smem;
    bf16_t* Xin = (bf16_t*)(smem + 128 * 132 * 4);
    bf16_t* KTl = Xin + 128 * 136;
    const int tid = my_tid(), lane = tid & 63, wid = tid >> 6, r = lane & 31, h = lane >> 5;
    const int mi = wid >> 1, wh = wid & 1;
    const bf16_t* P = (const bf16_t*)(p.ws + OFF_PROJ);
    *(u32x4*)(KTl + tid * 8) = *(const u32x4*)((const bf16_t*)(p.ws + OFF_S5K) + (size_t)g * 4096 + tid * 8);
    bf16x8 af[16];
    {
        const bf16_t* ub = P + (size_t)(b * SEQ + (mi * 32 + r) * 16) * INC + 2048 + g * 16 + 8 * h;
#pragma unroll
        for (int ks = 0; ks < 16; ++ks) af[ks] = *(const bf16x8*)(ub + (size_t)ks * INC);
    }
#ifndef S5_REP_G1
#define S5_REP_G1 1
#define S5_REP_SC 1
#define S5_REP_G2 1
#endif
    for (int rp1 = 0; rp1 < S5_REP_G1; ++rp1)
    {
        f32x16 e0, e1;
#pragma unroll
        for (int i = 0; i < 16; ++i) { e0[i] = 0.f; e1[i] = 0.f; }
        const bf16_t* nb0 = (const bf16_t*)(p.ws + OFF_S5N) + (size_t)g * 128 * 256 + (size_t)(wh * 2) * 16 * 512 + lane * 8;
#pragma unroll
        for (int ks = 0; ks < 16; ++ks) {
            const bf16x8 b0 = *(const bf16x8*)(nb0 + ks * 512), b1 = *(const bf16x8*)(nb0 + 16 * 512 + ks * 512);
            e0 = __builtin_amdgcn_mfma_f32_32x32x16_bf16(af[ks], b0, e0, 0, 0, 0);
            e1 = __builtin_amdgcn_mfma_f32_32x32x16_bf16(af[ks], b1, e1, 0, 0, 0);
        }
#pragma unroll
        for (int i = 0; i < 16; ++i) { float* er = E + (mi * 32 + crow(i, h)) * 132 + wh * 64 + r; er[0] = e0[i]; er[32] = e1[i]; }
    }
    __syncthreads();
    for (int rp2 = 0; rp2 < S5_REP_SC; ++rp2)
    if (wid == 0) {
        const float* L = (const float*)(p.ws + OFF_S5L) + (g * 64 + lane) * 2;
        const float lr = L[0], li = L[1];
        float xr = 0.f, xi = 0.f;
#pragma unroll 8
        for (int c = 0; c < 128; ++c) {
            const float er = E[c * 132 + lane], ei = E[c * 132 + 64 + lane];
            Xin[c * 136 + lane] = f2bf(xr); Xin[c * 136 + 64 + lane] = f2bf(xi);
            const float nr = lr * xr - li * xi + er, ni = lr * xi + li * xr + ei;
            xr = nr; xi = ni;
        }
    }
    __syncthreads();
    const bf16_t* MBg = (const bf16_t*)(p.ws + OFF_S5M) + (size_t)g * 256 * 128;
    bf16_t* Yout = (bf16_t*)(p.ws + OFF_YSSM) + (size_t)b * SEQ * DSS + g * 16;
    bf16_t* stg = (bf16_t*)smem + wid * 1024;
    for (int rp3 = 0; rp3 < S5_REP_G2; ++rp3)
    if (wh) {
        s5_gemm2_tile<1>(af, KTl, Xin, MBg, Yout, stg, mi, r, h); s5_gemm2_tile<6>(af, KTl, Xin, MBg, Yout, stg, mi, r, h);
        s5_gemm2_tile<3>(af, KTl, Xin, MBg, Yout, stg, mi, r, h); s5_gemm2_tile<4>(af, KTl, Xin, MBg, Yout, stg, mi, r, h);
    } else {
        s5_gemm2_tile<0>(af, KTl, Xin, MBg, Yout, stg, mi, r, h); s5_gemm2_tile<7>(af, KTl, Xin, MBg, Yout, stg, mi, r, h);
        s5_gemm2_tile<2>(af, KTl, Xin, MBg, Yout, stg, mi, r, h); s5_gemm2_tile<5>(af, KTl, Xin, MBg, Yout, stg, mi, r, h);
    }
    __syncthreads();
}
DI void phase_mix(const Params& p, int bid, int nb, char* smem) {
    if (nb == 256) {
#ifndef PROBE_HGX
#define PROBE_HGX 1
#endif
        if (bid < 64) { for (int rep = 0; rep < PROBE_HGX; ++rep) hgrn_mfma_item(p, bid, smem); return; }
        const int j = bid - 64, x = j & 7, lb = j >> 3;
#ifndef PROBE_S5X
#define PROBE_S5X 1
#endif
        for (int rep = 0; rep < PROBE_S5X; ++rep)
        for (int q = lb; q < 64; q += 24) s5_gemm_item(p, q & 15, x * 4 + (q >> 4), smem);
    } else {
        for (int it = bid; it < 64; it += nb) hgrn_mfma_item(p, it, smem);
        for (int q = bid; q < 512; q += nb) s5_gemm_item(p, q & 15, q >> 4, smem);
    }
}

DI void phase_glu(const Params& p, int bid, int nb, char* smem) {
    pg8::Gemm g{(const bf16_t*)(p.ws + OFF_YSSM), (const bf16_t*)(p.ws + OFF_GLU), NTOK, 512, 512};
    pg8::StaticOrder S; S.init(NTOK, 512, nb, bid);
    pg8::EpiGlu E{(float*)(p.ws + OFF_H), (const bf16_t*)(p.ws + OFF_YSSM), p.glu_b};
    pg8::gemm_phase<pg8::EpiGlu, pg8::StaticOrder, false>((PG8_LAS unsigned char*)smem, g, S, E, nullptr);
}
DI void phase_a2(const Params& p, int bid, int nb) {
    const float* ORAW = (const float*)(p.ws + OFF_ORAW);
    const float* Y2 = (const float*)(p.ws + OFF_H);
    const bf16_t* P = (const bf16_t*)(p.ws + OFF_PROJ);
    bf16_t* A2 = (bf16_t*)(p.ws + OFF_A2);
    const int lane = my_tid() & 63, wid = my_tid() >> 6;
    for (int tok = bid * 8 + wid; tok < NTOK; tok += nb * 8) {
        const int c0 = lane * 8;
        {
            const float4 a = *(const float4*)(ORAW + (size_t)tok * DHG + c0), b = *(const float4*)(ORAW + (size_t)tok * DHG + c0 + 4);
            float ss = a.x * a.x + a.y * a.y + a.z * a.z + a.w * a.w + b.x * b.x + b.y * b.y + b.z * b.z + b.w * b.w;
            ss += __shfl_xor(ss, 1); ss += __shfl_xor(ss, 2); ss += __shfl_xor(ss, 4); ss += __shfl_xor(ss, 8);
            const float rs = rsqrtf(ss * (1.0f / 128.0f) + RMS_EPS);
            const uint4 gq = *(const uint4*)(P + (size_t)tok * INC + 1536 + c0);
            const float4 w0 = *(const float4*)(p.hg_nw + c0), w1 = *(const float4*)(p.hg_nw + c0 + 4);
            uint4 o;
            o.x = pack2(a.x * rs * w0.x * bflo(gq.x), a.y * rs * w0.y * bfhi(gq.x));
            o.y = pack2(a.z * rs * w0.z * bflo(gq.y), a.w * rs * w0.w * bfhi(gq.y));
            o.z = pack2(b.x * rs * w1.x * bflo(gq.z), b.y * rs * w1.y * bfhi(gq.z));
            o.w = pack2(b.z * rs * w1.z * bflo(gq.w), b.w * rs * w1.w * bfhi(gq.w));
            *(uint4*)(A2 + (size_t)tok * DM + c0) = o;
        }
        {
            const float4 a = *(const float4*)(Y2 + (size_t)tok * DSS + c0), b = *(const float4*)(Y2 + (size_t)tok * DSS + c0 + 4);
            float ss = a.x * a.x + a.y * a.y + a.z * a.z + a.w * a.w + b.x * b.x + b.y * b.y + b.z * b.z + b.w * b.w;
#pragma unroll
            for (int m = 1; m < 64; m <<= 1) ss += __shfl_xor(ss, m);
            const float rs = rsqrtf(ss * (1.0f / 512.0f) + RMS_EPS);
            const float4 w0 = *(const float4*)(p.ssm_nw + c0), w1 = *(const float4*)(p.ssm_nw + c0 + 4);
            uint4 o;
            o.x = pack2(a.x * rs * w0.x, a.y * rs * w0.y); o.y = pack2(a.z * rs * w0.z, a.w * rs * w0.w);
            o.z = pack2(b.x * rs * w1.x, b.y * rs * w1.y); o.w = pack2(b.z * rs * w1.z, b.w * rs * w1.w);
            *(uint4*)(A2 + (size_t)tok * DM + 512 + c0) = o;
        }
    }
}

DI void phase_outproj(const Params& p, int bid, int nb, char* smem) {
    pg8::Gemm g{(const bf16_t*)(p.ws + OFF_A2), (const bf16_t*)(p.ws + OFF_WOUT), NTOK, DM, DM};
    pg8::StaticOrder S; S.init(NTOK, DM, nb, bid);
    pg8::EpiResid E{p.out, p.x, (const float*)(p.ws + OFF_MOD) + 2048, DEEP_ALPHA};
    pg8::gemm_phase<pg8::EpiResid, pg8::StaticOrder, false>((PG8_LAS unsigned char*)smem, g, S, E, nullptr);
}
DI void phase_ln1(const Params& p, int bid, int nb) {
    const float* mod = (const float*)(p.ws + OFF_MOD);
    bf16_t* H2 = (bf16_t*)(p.ws + OFF_H);
    const int lane = my_tid() & 63, wid = my_tid() >> 6;
    for (int tok = bid * 8 + wid; tok < NTOK; tok += nb * 8) {
        const int b = tok / SEQ;
        float* row = p.out + (size_t)tok * DM;
        float4 v[4];
        float s = 0.f;
#pragma unroll
        for (int j = 0; j < 4; ++j) { v[j] = *(const float4*)(row + j * 256 + lane * 4); s += v[j].x + v[j].y + v[j].z + v[j].w; }
#pragma unroll
        for (int m = 1; m < 64; m <<= 1) s += __shfl_xor(s, m);
        const float mu = s * (1.0f / 1024.0f);
        float q = 0.f;
#pragma unroll
        for (int j = 0; j < 4; ++j) { const float a = v[j].x - mu, bb = v[j].y - mu, cc = v[j].z - mu, d = v[j].w - mu; q += a * a + bb * bb + cc * cc + d * d; }
#pragma unroll
        for (int m = 1; m < 64; m <<= 1) q += __shfl_xor(q, m);
        const float rstd = rsqrtf(q * (1.0f / 1024.0f) + LN_EPS);
        const float* sh2 = mod + b * 6144 + 3072;
        const float* sc2 = mod + b * 6144 + 4096;
#pragma unroll
        for (int j = 0; j < 4; ++j) {
            const int c = j * 256 + lane * 4;
            const float4 w = *(const float4*)(p.ln1w + c), bi = *(const float4*)(p.ln1b + c), sc = *(const float4*)(sc2 + c), sh = *(const float4*)(sh2 + c);
            float4 o;
            o.x = (v[j].x - mu) * rstd * w.x + bi.x; o.y = (v[j].y - mu) * rstd * w.y + bi.y; o.z = (v[j].z - mu) * rstd * w.z + bi.z; o.w = (v[j].w - mu) * rstd * w.w + bi.w;
            *(float4*)(row + c) = o;
            uint2 hh; hh.x = pack2(o.x * (1.f + sc.x) + sh.x, o.y * (1.f + sc.y) + sh.y); hh.y = pack2(o.z * (1.f + sc.z) + sh.z, o.w * (1.f + sc.w) + sh.w);
            *(uint2*)(H2 + (size_t)tok * DM + c) = hh;
        }
    }
}

DI void phase_q(const Params& p, int bid, int nb, char* smem) {
    pg8::Gemm g{(const bf16_t*)(p.ws + OFF_H), (const bf16_t*)(p.ws + OFF_WQ), NTOK, 2048, DM};
    pg8::StaticOrder S; S.init(NTOK, 2048, nb, bid);
    pg8::EpiBf16Act E{(bf16_t*)(p.ws + OFF_PROJ), 2048, 0u};
    pg8::gemm_phase<pg8::EpiBf16Act, pg8::StaticOrder, false>((PG8_LAS unsigned char*)smem, g, S, E, nullptr);
}
DI void phase_topk(const Params& p, int bid, int nb, char* smem) {
    const bf16_t* Q = (const bf16_t*)(p.ws + OFF_PROJ);
    const bf16_t* SK = (const bf16_t*)(p.ws + OFF_SUBK);
    unsigned* TOPL = (unsigned*)(p.ws + OFF_TOPL);
    float* sc = (float*)(smem + 36864);
    constexpr int NTM = NTOK / 128;
    for (int t = bid; t < NTM * 16; t += nb) {
        const int mt = t >> 4, hp = t & 15;
        gemm_block<2, 1, 2, 4>(Q + (size_t)mt * 128 * 2048 + hp * 128, 2048, SK + (size_t)hp * 128 * 128, 128, 128, smem,
                               [&](int r, int c, float v) { sc[r * 129 + c] = v; });
        __syncthreads();
        if (my_tid() < 128) {
            const int r = my_tid();
            float tk[16];
#pragma unroll
            for (int j = 0; j < 16; ++j) tk[j] = -3.0e38f;
            for (int n = 0; n < 128; ++n) {
                float xv = __uint_as_float((__float_as_uint(sc[r * 129 + n]) & ~0x7fu) | (unsigned)n);
#pragma unroll
                for (int j = 0; j < 16; ++j) { const float hi = fmaxf(tk[j], xv), lo = fminf(tk[j], xv); tk[j] = hi; xv = lo; }
            }
            uint4* dst = (uint4*)(TOPL + ((size_t)(mt * 128 + r) * 16 + hp) * 16);
            dst[0] = make_uint4(__float_as_uint(tk[0]), __float_as_uint(tk[1]), __float_as_uint(tk[2]), __float_as_uint(tk[3]));
            dst[1] = make_uint4(__float_as_uint(tk[4]), __float_as_uint(tk[5]), __float_as_uint(tk[6]), __float_as_uint(tk[7]));
            dst[2] = make_uint4(__float_as_uint(tk[8]), __float_as_uint(tk[9]), __float_as_uint(tk[10]), __float_as_uint(tk[11]));
            dst[3] = make_uint4(__float_as_uint(tk[12]), __float_as_uint(tk[13]), __float_as_uint(tk[14]), __float_as_uint(tk[15]));
        }
        __syncthreads();
    }
}
DI void phase_combine(const Params& p, int bid, int nb) {
    const unsigned* TOPL = (const unsigned*)(p.ws + OFF_TOPL);
    uint2* EX = (uint2*)(p.ws + OFF_EXPS);
    const float* SU = (const float*)(p.ws + OFF_SU);
    const float* SV = (const float*)(p.ws + OFF_SV);
    for (int i = bid * NTH + my_tid(); i < NTOK * PHEADS; i += nb * NTH) {
        const unsigned* l1 = TOPL + (size_t)i * 32;
        const unsigned* l2 = l1 + 16;
        float s2[16];
        {
            const uint4 a = ((const uint4*)l2)[0], b = ((const uint4*)l2)[1], c = ((const uint4*)l2)[2], d = ((const uint4*)l2)[3];
            const unsigned w[16] = {a.x, a.y, a.z, a.w, b.x, b.y, b.z, b.w, c.x, c.y, c.z, c.w, d.x, d.y, d.z, d.w};
#pragma unroll
            for (int j = 0; j < 16; ++j) s2[j] = __uint_as_float(w[j] & ~0x7fu);
        }
        float tk[16];
#pragma unroll
        for (int j = 0; j < 16; ++j) tk[j] = -3.0e38f;
        for (int a = 0; a < 16; ++a) {
            const float s1 = __uint_as_float(l1[a] & ~0x7fu);
#pragma unroll
            for (int b = 0; b < 16; ++b) {
                float xv = __uint_as_float((__float_as_uint(s1 + s2[b]) & ~0xffu) | (unsigned)(a * 16 + b));
#pragma unroll
                for (int j = 0; j < 16; ++j) { const float hi = fmaxf(tk[j], xv), lo = fminf(tk[j], xv); tk[j] = hi; xv = lo; }
            }
        }
        float e[16], sum = 0.f;
        const float mx = __uint_as_float(__float_as_uint(tk[0]) & ~0xffu);
#pragma unroll
        for (int j = 0; j < 16; ++j) { e[j] = __expf(__uint_as_float(__float_as_uint(tk[j]) & ~0xffu) - mx); sum += e[j]; }
        const float inv = 1.0f / sum;
#pragma unroll
        for (int j = 0; j < 16; ++j) {
            const unsigned ab = __float_as_uint(tk[j]) & 0xffu;
            const unsigned i1 = l1[ab >> 4] & 0x7fu, i2 = l2[ab & 15] & 0x7fu;
            const unsigned eid = i1 * 128u + i2;
            EX[(size_t)i * 16 + j] = make_uint2(eid | (((__float_as_uint(SU[eid]) >> 23) & 0xffu) << 16), __float_as_uint(e[j] * inv * SV[eid]));
        }
    }
}

DI void ce_desc(float& a, float& b) { const float hi = fmaxf(a, b), lo = fminf(a, b); a = hi; b = lo; }
template <int N> DI void bitonic_sort_desc(float (&v)[N]) {
#pragma unroll
    for (int k = 2; k <= N; k <<= 1)
#pragma unroll
        for (int j = k >> 1; j > 0; j >>= 1)
#pragma unroll
            for (int i = 0; i < N; ++i) { const int l = i ^ j; if (l > i) { if ((i & k) == 0 || k == N) ce_desc(v[i], v[l]); else ce_desc(v[l], v[i]); } }
}
DI void merge_top16(float (&a)[16], const float (&b)[16]) {
#pragma unroll
    for (int i = 0; i < 16; ++i) a[i] = fmaxf(a[i], b[15 - i]);
#pragma unroll
    for (int j = 8; j > 0; j >>= 1)
#pragma unroll
        for (int i = 0; i < 16; ++i) { const int l = i ^ j; if (l > i) ce_desc(a[i], a[l]); }
}
DI void xlane_merge16(float (&a)[16]) {
    float o[16];
#pragma unroll
    for (int i = 0; i < 16; ++i) o[i] = __shfl_xor(a[i], 32);
    merge_top16(a, o);
}
DI void retrieve_topk_hp(const bf16_t* Q, const char* skl, const int tok, const int hp_next, const int r, const int h, unsigned char* lutp, float (&out)[16], bf16x8 (&bq)[8]) {
                f32x16 acc[4];
#pragma unroll
                for (int mi = 0; mi < 4; ++mi)
#pragma unroll
                    for (int i = 0; i < 16; ++i) acc[mi][i] = 0.f;
                const char* kb = skl + r * 272 + h * 16;
#pragma unroll
                for (int ks = 0; ks < 8; ++ks) {
#pragma unroll
                    for (int mi = 0; mi < 4; ++mi) {
                        const bf16x8 a = *(const bf16x8*)(kb + mi * 32 * 272 + ks * 32);
                        acc[mi] = __builtin_amdgcn_mfma_f32_32x32x16_bf16(a, bq[ks], acc[mi], 0, 0, 0);
                    }
                }
                {
                    const bf16_t* qb = Q + (size_t)tok * 2048 + hp_next * 128 + 8 * h;
#pragma unroll
                    for (int ks = 0; ks < 8; ++ks) bq[ks] = *(const bf16x8*)(qb + ks * 16);
                }
                float v0[16], v1[16], v2[16], v3[16];
#pragma unroll
                for (int i = 0; i < 16; ++i) {
                    const unsigned n = (unsigned)crow(i, h);
                    v0[i] = __uint_as_float((__float_as_uint(acc[0][i]) & ~0x7fu) | n);
                    v1[i] = __uint_as_float((__float_as_uint(acc[1][i]) & ~0x7fu) | (n + 32u));
                    v2[i] = __uint_as_float((__float_as_uint(acc[2][i]) & ~0x7fu) | (n + 64u));
                    v3[i] = __uint_as_float((__float_as_uint(acc[3][i]) & ~0x7fu) | (n + 96u));
                }
                bitonic_sort_desc<16>(v0); bitonic_sort_desc<16>(v1); bitonic_sort_desc<16>(v2); bitonic_sort_desc<16>(v3);
                merge_top16(v0, v1); merge_top16(v2, v3); merge_top16(v0, v2);
                xlane_merge16(v0);
#pragma unroll
                for (int i = 0; i < 16; ++i) out[i] = v0[i];
                u32x4 ix;
                ix.x = (__float_as_uint(v0[0]) & 0x7fu) | ((__float_as_uint(v0[1]) & 0x7fu) << 8) | ((__float_as_uint(v0[2]) & 0x7fu) << 16) | ((__float_as_uint(v0[3]) & 0x7fu) << 24);
                ix.y = (__float_as_uint(v0[4]) & 0x7fu) | ((__float_as_uint(v0[5]) & 0x7fu) << 8) | ((__float_as_uint(v0[6]) & 0x7fu) << 16) | ((__float_as_uint(v0[7]) & 0x7fu) << 24);
                ix.z = (__float_as_uint(v0[8]) & 0x7fu) | ((__float_as_uint(v0[9]) & 0x7fu) << 8) | ((__float_as_uint(v0[10]) & 0x7fu) << 16) | ((__float_as_uint(v0[11]) & 0x7fu) << 24);
                ix.w = (__float_as_uint(v0[12]) & 0x7fu) | ((__float_as_uint(v0[13]) & 0x7fu) << 8) | ((__float_as_uint(v0[14]) & 0x7fu) << 16) | ((__float_as_uint(v0[15]) & 0x7fu) << 24);
                *(u32x4*)lutp = ix;
}
DI void phase_retrieve(const Params& p, int bid, int nb, char* smem) {
    const bf16_t* Q = (const bf16_t*)(p.ws + OFF_PROJ);
    const bf16_t* SK = (const bf16_t*)(p.ws + OFF_SUBK);
    const float* SU = (const float*)(p.ws + OFF_SU);
    const float* SV = (const float*)(p.ws + OFF_SV);
    uint2* EX = (uint2*)(p.ws + OFF_EXPS);
    const int tid = my_tid(), lane = tid & 63, wid = tid >> 6, r = lane & 31, h = lane >> 5;
    unsigned char* lut = (unsigned char*)smem + wid * 2048 + lane * 32;
    char* skb0 = smem + 16384;
    char* skb1 = skb0 + 128 * 272;
    u32x4 sr0, sr1, sr2, sr3;
#define SK_LOAD(hp_) { const bf16_t* g_ = SK + (size_t)(hp_) * 16384 + tid * 8; sr0 = *(const u32x4*)g_; sr1 = *(const u32x4*)(g_ + 4096); sr2 = *(const u32x4*)(g_ + 8192); sr3 = *(const u32x4*)(g_ + 12288); }
#define SK_STORE(buf_) { char* d_ = (buf_) + (tid >> 4) * 272 + (tid & 15) * 16; *(u32x4*)d_ = sr0; *(u32x4*)(d_ + 32 * 272) = sr1; *(u32x4*)(d_ + 64 * 272) = sr2; *(u32x4*)(d_ + 96 * 272) = sr3; }
    for (int it = bid; it < (NTOK / 256) * 2; it += nb) {
        const int hq = it & 1, tok = (it >> 1) * 256 + wid * 32 + r;
        __syncthreads();
        SK_LOAD(hq * 8); SK_STORE(skb0);
        bf16x8 bq[8];
        {
            const bf16_t* qb = Q + (size_t)tok * 2048 + (hq * 8) * 128 + 8 * h;
#pragma unroll
            for (int ks = 0; ks < 8; ++ks) bq[ks] = *(const bf16x8*)(qb + ks * 16);
        }
        __syncthreads();
#pragma unroll 1
        for (int hd = hq * 4; hd < hq * 4 + 4; ++hd) {
            float L0[16], L1[16];
            SK_LOAD(hd * 2 + 1);
            retrieve_topk_hp(Q, skb0, tok, hd * 2 + 1, r, h, lut, L0, bq);
            SK_STORE(skb1);
            __syncthreads();
            if (hd + 1 < hq * 4 + 4) SK_LOAD(hd * 2 + 2);
            retrieve_topk_hp(Q, skb1, tok, (hd + 1 < hq * 4 + 4) ? hd * 2 + 2 : hd * 2 + 1, r, h, lut + 16, L1, bq);
            if (hd + 1 < hq * 4 + 4) SK_STORE(skb0);
            __syncthreads();
            float c[32];
            {
                constexpr int PA[50] = {0, 0, 0, 0, 0, 0, 0, 0, 0, 0, 0, 0, 0, 0, 0, 0, 1, 1, 1, 1, 1, 1, 1, 1, 2, 2, 2, 2, 2, 3, 3, 3, 3, 4, 4, 4, 5, 5, 6, 6, 7, 7, 8, 9, 10, 11, 12, 13, 14, 15};
                constexpr int PB[50] = {0, 1, 2, 3, 4, 5, 6, 7, 8, 9, 10, 11, 12, 13, 14, 15, 0, 1, 2, 3, 4, 5, 6, 7, 0, 1, 2, 3, 4, 0, 1, 2, 3, 0, 1, 2, 0, 1, 0, 1, 0, 1, 0, 0, 0, 0, 0, 0, 0, 0};
#pragma unroll
                for (int q = 0; q < 25; ++q) {
                    const float s0 = __uint_as_float(__float_as_uint(L0[PA[2 * q]]) & ~0x7fu) + __uint_as_float(__float_as_uint(L1[PB[2 * q]]) & ~0x7fu);
                    const float s1 = __uint_as_float(__float_as_uint(L0[PA[2 * q + 1]]) & ~0x7fu) + __uint_as_float(__float_as_uint(L1[PB[2 * q + 1]]) & ~0x7fu);
                    const float p0 = __uint_as_float((__float_as_uint(s0) & ~0xffu) | (unsigned)(PA[2 * q] * 16 + PB[2 * q]));
                    const float p1 = __uint_as_float((__float_as_uint(s1) & ~0xffu) | (unsigned)(PA[2 * q + 1] * 16 + PB[2 * q + 1]));
                    c[q] = h ? p1 : p0;
                }
#pragma unroll
                for (int i = 25; i < 32; ++i) c[i] = -3.0e38f;
            }
            bitonic_sort_desc<32>(c);
            float t16[16];
#pragma unroll
            for (int i = 0; i < 16; ++i) t16[i] = c[i];
            xlane_merge16(t16);
            const float mx = __uint_as_float(__float_as_uint(t16[0]) & ~0xffu);
            float e[16], sum = 0.f;
#pragma unroll
            for (int j = 0; j < 16; ++j) { e[j] = __expf(__uint_as_float(__float_as_uint(t16[j]) & ~0xffu) - mx); sum += e[j]; }
            const float inv = 1.0f / sum;
            uint2* dst = EX + ((size_t)tok * 8 + hd) * 16 + 8 * h;
#pragma unroll
            for (int j = 0; j < 8; ++j) {
                float tlo = t16[j], thi = t16[8 + j], elo = e[j], ehi = e[8 + j];
                asm volatile("" : "+v"(tlo), "+v"(thi), "+v"(elo), "+v"(ehi));
                const float tv = h ? thi : tlo, ev = h ? ehi : elo;
                const unsigned ab = __float_as_uint(tv) & 0xffu;
                const unsigned eid = (unsigned)lut[ab >> 4] * 128u + (unsigned)lut[16 + (ab & 15u)];
                dst[j] = make_uint2(eid | (pack2(0.f, SU[eid]) & 0xffff0000u), __float_as_uint(ev * inv * SV[eid]));
            }
        }
    }
#undef SK_LOAD
#undef SK_STORE
}

DI float dot16_fp8(const u32x4 w, const f32x2 (&h)[8]) {
    f32x2 acc = __builtin_amdgcn_cvt_pk_f32_fp8((int)w.x, false) * h[0];
    acc += __builtin_amdgcn_cvt_pk_f32_fp8((int)w.x, true) * h[1];
    acc += __builtin_amdgcn_cvt_pk_f32_fp8((int)w.y, false) * h[2];
    acc += __builtin_amdgcn_cvt_pk_f32_fp8((int)w.y, true) * h[3];
    acc += __builtin_amdgcn_cvt_pk_f32_fp8((int)w.z, false) * h[4];
    acc += __builtin_amdgcn_cvt_pk_f32_fp8((int)w.z, true) * h[5];
    acc += __builtin_amdgcn_cvt_pk_f32_fp8((int)w.w, false) * h[6];
    acc += __builtin_amdgcn_cvt_pk_f32_fp8((int)w.w, true) * h[7];
    return acc.x + acc.y;
}
DI void axpy16_fp8(const float a, const u32x4 w, f32x2 (&o)[8]) {
    const f32x2 aa = {a, a};
    o[0] += aa * __builtin_amdgcn_cvt_pk_f32_fp8((int)w.x, false); o[1] += aa * __builtin_amdgcn_cvt_pk_f32_fp8((int)w.x, true);
    o[2] += aa * __builtin_amdgcn_cvt_pk_f32_fp8((int)w.y, false); o[3] += aa * __builtin_amdgcn_cvt_pk_f32_fp8((int)w.y, true);
    o[4] += aa * __builtin_amdgcn_cvt_pk_f32_fp8((int)w.z, false); o[5] += aa * __builtin_amdgcn_cvt_pk_f32_fp8((int)w.z, true);
    o[6] += aa * __builtin_amdgcn_cvt_pk_f32_fp8((int)w.w, false); o[7] += aa * __builtin_amdgcn_cvt_pk_f32_fp8((int)w.w, true);
}
DI float butterfly64(float (&pz)[64], const int lane) {
    const bool b5 = lane & 32, b4 = lane & 16, b3 = lane & 8, b2 = lane & 4, b1 = lane & 2, b0 = lane & 1;
    float q32[32], q16[16], q8[8], q4[4], q2[2];
#pragma unroll
    for (int j = 0; j < 32; ++j) q32[j] = (b5 ? pz[32 + j] : pz[j]) + __shfl_xor(b5 ? pz[j] : pz[32 + j], 32);
#pragma unroll
    for (int j = 0; j < 16; ++j) q16[j] = (b4 ? q32[16 + j] : q32[j]) + __shfl_xor(b4 ? q32[j] : q32[16 + j], 16);
#pragma unroll
    for (int j = 0; j < 8; ++j) q8[j] = (b3 ? q16[8 + j] : q16[j]) + __shfl_xor(b3 ? q16[j] : q16[8 + j], 8);
#pragma unroll
    for (int j = 0; j < 4; ++j) q4[j] = (b2 ? q8[4 + j] : q8[j]) + __shfl_xor(b2 ? q8[j] : q8[4 + j], 4);
#pragma unroll
    for (int j = 0; j < 2; ++j) q2[j] = (b1 ? q4[2 + j] : q4[j]) + __shfl_xor(b1 ? q4[j] : q4[2 + j], 2);
    return (b0 ? q2[1] : q2[0]) + __shfl_xor(b0 ? q2[0] : q2[1], 1);
}
DI float bfly8(float (&pz)[8], const int lane) {
    const bool b2 = lane & 4, b1 = lane & 2, b0 = lane & 1;
    float q4[4], q2[2];
#pragma unroll
    for (int i = 0; i < 4; ++i) q4[i] = (b2 ? pz[4 + i] : pz[i]) + __shfl_xor(b2 ? pz[i] : pz[4 + i], 4);
#pragma unroll
    for (int i = 0; i < 2; ++i) q2[i] = (b1 ? q4[2 + i] : q4[i]) + __shfl_xor(b1 ? q4[i] : q4[2 + i], 2);
    float q = (b0 ? q2[1] : q2[0]) + __shfl_xor(b0 ? q2[0] : q2[1], 1);
    q += __shfl_xor(q, 8); q += __shfl_xor(q, 16); q += __shfl_xor(q, 32);
    return q;
}
DI float bfly16(float (&pz)[16], const int lane) {
    const bool b3 = lane & 8, b2 = lane & 4, b1 = lane & 2, b0 = lane & 1;
    float q8[8], q4[4], q2[2];
#pragma unroll
    for (int i = 0; i < 8; ++i) q8[i] = (b3 ? pz[8 + i] : pz[i]) + __shfl_xor(b3 ? pz[i] : pz[8 + i], 8);
#pragma unroll
    for (int i = 0; i < 4; ++i) q4[i] = (b2 ? q8[4 + i] : q8[i]) + __shfl_xor(b2 ? q8[i] : q8[4 + i], 4);
#pragma unroll
    for (int i = 0; i < 2; ++i) q2[i] = (b1 ? q4[2 + i] : q4[i]) + __shfl_xor(b1 ? q4[i] : q4[2 + i], 2);
    float q = (b0 ? q2[1] : q2[0]) + __shfl_xor(b0 ? q2[0] : q2[1], 1);
    q += __shfl_xor(q, 16); q += __shfl_xor(q, 32);
    return q;
}
DI void gs_issue(const __amdgpu_buffer_rsrc_t T, const uint2* ent, const unsigned d, const int lane, u32x4 (&w)[8], unsigned& ca) {
    const int cnt = (int)((d >> 16) & 0xfu), k = lane & 7;
    const uint2 e = ent[(d & 0xffffu) + (unsigned)(k < cnt ? k : cnt - 1)];
    ca = (k < cnt && !(d >> 31)) ? e.y : 0u;
#pragma unroll
    for (int q = 0; q < 8; ++q) {
        const int eid = __builtin_amdgcn_readlane((int)e.x, q) & 0x3fff;
        w[q] = __builtin_amdgcn_raw_buffer_load_b128(T, lane * 16, eid * DM, 0);
    }
}
DI float dot16_i8(const u32x4 w, const u32x4 h) {
    int acc = __builtin_amdgcn_sdot4((int)w.x, (int)h.x, 0, false);
    acc = __builtin_amdgcn_sdot4((int)w.y, (int)h.y, acc, false);
    acc = __builtin_amdgcn_sdot4((int)w.z, (int)h.z, acc, false);
    acc = __builtin_amdgcn_sdot4((int)w.w, (int)h.w, acc, false);
    return (float)acc;
}
DI void gs_desc(const uint2* ent, const unsigned d, const int lane, unsigned& ex) {
    const int cnt = (int)((d >> 16) & 0xfu), k = lane & 7;
    ex = ent[(d & 0xffffu) + (unsigned)(k < cnt ? k : cnt - 1)].x;
}
DI void gs_loads(const __amdgpu_buffer_rsrc_t T, const unsigned ex, const int lane, u32x4 (&w)[8]) {
#pragma unroll
    for (int q = 0; q < 8; ++q) {
        const int eid = __builtin_amdgcn_readlane((int)ex, q) & 0x3fff;
        w[q] = __builtin_amdgcn_raw_buffer_load_b128(T, lane * 16, eid * DM, 0);
    }
}
DI void gs_upartial(const u32x4 (&w)[8], const u32x4 h2q, float (&pz)[16], const int base) {
#pragma unroll
    for (int k = 0; k < 8; ++k) pz[base + k] = dot16_i8(w[k], h2q);
}
DI void gs_ustore(float (&pz)[16], float* zb, const unsigned da, const unsigned db, const int lane) {
    const float z = bfly16(pz, lane);
    const unsigned d = (lane & 8) ? db : da;
    const int k = lane & 7;
    if (lane < 16 && k < (int)((d >> 16) & 0xfu) && !(d >> 31)) zb[(d & 0xffffu) + k] = z;
}
DI void axpy16_u8(const float a, const u32x4 w, float (&o)[16]) {
    o[0] += a * (float)(w.x & 0xffu); o[1] += a * (float)((w.x >> 8) & 0xffu); o[2] += a * (float)((w.x >> 16) & 0xffu); o[3] += a * (float)(w.x >> 24);
    o[4] += a * (float)(w.y & 0xffu); o[5] += a * (float)((w.y >> 8) & 0xffu); o[6] += a * (float)((w.y >> 16) & 0xffu); o[7] += a * (float)(w.y >> 24);
    o[8] += a * (float)(w.z & 0xffu); o[9] += a * (float)((w.z >> 8) & 0xffu); o[10] += a * (float)((w.z >> 16) & 0xffu); o[11] += a * (float)(w.z >> 24);
    o[12] += a * (float)(w.w & 0xffu); o[13] += a * (float)((w.w >> 8) & 0xffu); o[14] += a * (float)((w.w >> 16) & 0xffu); o[15] += a * (float)(w.w >> 24);
}
DI void gs_vcompute(const u32x4 (&w)[8], const unsigned ca, float (&acc)[16]) {
#pragma unroll
    for (int k = 0; k < 8; ++k) { axpy16_u8(__uint_as_float((unsigned)__builtin_amdgcn_readlane((int)ca, k)), w[k], acc); __builtin_amdgcn_sched_barrier(0); }
}
constexpr int GT = 4;
DI void xcd_pace(unsigned* cnt, const unsigned nloc, unsigned& step) {
    __syncthreads();
    if (__builtin_amdgcn_workitem_id_x() == 0) {
        __hip_atomic_fetch_add(cnt, 1u, __ATOMIC_RELAXED, __HIP_MEMORY_SCOPE_AGENT);
        const unsigned target = nloc * (step + 1u);
        unsigned sp = 0;
        while (__hip_atomic_load(cnt, __ATOMIC_RELAXED, __HIP_MEMORY_SCOPE_AGENT) < target) { __builtin_amdgcn_s_sleep(1); if (++sp > (1u << 22)) break; }
    }
    ++step;
    __syncthreads();
}
DI void phase_gather(const Params& p, int bid, int nb, char* smem, unsigned* pace_cnt, const unsigned pace_n) {
    unsigned pstep = 0;
    const float* mod = (const float*)(p.ws + OFF_MOD);
    const uint2* EX = (const uint2*)(p.ws + OFF_EXPS);
    const __amdgpu_buffer_rsrc_t UT = __builtin_amdgcn_make_buffer_rsrc((void*)(p.ws + OFF_UT), 0, NEXP * DM, 0x00020000);
    const __amdgpu_buffer_rsrc_t VT = __builtin_amdgcn_make_buffer_rsrc((void*)(p.ws + OFF_VT), 0, NEXP * DM, 0x00020000);
    const int lane = my_tid() & 63, wid = my_tid() >> 6, c0 = lane * 16;
    char* wl = smem + wid * 7168;
    uint2* ent = (uint2*)wl; float* zb = (float*)(wl + 4096); int* offs = (int*)(wl + 6144); unsigned* sched = (unsigned*)(wl + 6144 + 256);
#pragma unroll 1
    for (int t0 = (bid * 8 + wid) * GT; t0 < NTOK; t0 += nb * 8 * GT) {
        u32x4 h2q[GT]; float hsc[GT]; float acc[GT][16];
        f32x4 scv[4], shv[4];
        {
            const int b = t0 / SEQ;
#pragma unroll
            for (int q = 0; q < 4; ++q) { scv[q] = *(const f32x4*)(mod + b * 6144 + 4096 + c0 + q * 4) + 1.0f; shv[q] = *(const f32x4*)(mod + b * 6144 + 3072 + c0 + q * 4); }
        }
#pragma unroll
        for (int j = 0; j < GT; ++j) {
            const int tok = t0 + j;
            const float* row = p.out + (size_t)tok * DM + c0;
            __builtin_amdgcn_sched_barrier(0);
            {
                f32x4 hv[4];
                float m = 0.f;
#pragma unroll
                for (int q = 0; q < 4; ++q) { hv[q] = *(const f32x4*)(row + q * 4) * scv[q] + shv[q]; m = fmaxf(m, fmaxf(fmaxf(fabsf(hv[q].x), fabsf(hv[q].y)), fmaxf(fabsf(hv[q].z), fabsf(hv[q].w)))); }
#pragma unroll
                for (int sft = 1; sft < 64; sft <<= 1) m = fmaxf(m, __shfl_xor(m, sft));
                const float qs = m > 1e-30f ? 127.0f / m : 1.0f;
                hsc[j] = m > 1e-30f ? m * (1.0f / 127.0f) : 1.0f;
                unsigned hw[4];
#pragma unroll
                for (int q = 0; q < 4; ++q)
                    hw[q] = ((unsigned)(int)rintf(hv[q].x * qs) & 0xffu) | (((unsigned)(int)rintf(hv[q].y * qs) & 0xffu) << 8) | (((unsigned)(int)rintf(hv[q].z * qs) & 0xffu) << 16) | (((unsigned)(int)rintf(hv[q].w * qs) & 0xffu) << 24);
                h2q[j] = (u32x4){hw[0], hw[1], hw[2], hw[3]};
            }
            const uint2 e0 = EX[(size_t)tok * 128 + lane], e1 = EX[(size_t)tok * 128 + 64 + lane];
            const int s0 = (int)((e0.x & 0x3fffu) >> 11), s1 = (int)((e1.x & 0x3fffu) >> 11);
            int run = 0, pos0 = 0, pos1 = 0;
#pragma unroll
            for (int s = 0; s < 8; ++s) {
                const unsigned long long m0 = __ballot(s0 == s), m1 = __ballot(s1 == s);
                const int c0n = __popcll(m0), c1n = __popcll(m1);
                const int below0 = (int)__builtin_amdgcn_mbcnt_hi((unsigned)(m0 >> 32), __builtin_amdgcn_mbcnt_lo((unsigned)m0, 0u));
                const int below1 = (int)__builtin_amdgcn_mbcnt_hi((unsigned)(m1 >> 32), __builtin_amdgcn_mbcnt_lo((unsigned)m1, 0u));
                if (lane == 0) offs[j * 9 + s] = run;
                pos0 = (s0 == s) ? run + below0 : pos0;
                pos1 = (s1 == s) ? run + c0n + below1 : pos1;
                run += c0n + c1n;
            }
            if (lane == 0) offs[j * 9 + 8] = 128;
            ent[j * 128 + pos0] = e0; ent[j * 128 + pos1] = e1;
        }
        int nbat;
        {
            const int gs = (lane / GT) & 7, gj = lane % GT;
            const int gb = offs[gj * 9 + gs], ge = offs[gj * 9 + gs + 1], cnt = lane < 8 * GT ? ge - gb : 0, nbt = (cnt + 7) >> 3;
            int incl = nbt;
#pragma unroll
            for (int m = 1; m < 32; m <<= 1) { const int o = __shfl_up(incl, m); if ((lane & 31) >= m) incl += o; }
            nbat = __builtin_amdgcn_readlane(incl, 8 * GT - 1);
            const int st = incl - nbt;
            for (int q = 0; q < nbt; ++q) { const int rem = cnt - 8 * q; sched[st + q] = (unsigned)(gj * 128 + gb + 8 * q) | ((unsigned)(rem < 8 ? rem : 8) << 16); }
            if (lane < 3) sched[nbat + lane] = 0x80010000u;
        }
        xcd_pace(pace_cnt, pace_n, pstep);
#ifndef PROBE_UX
#define PROBE_UX 1
#endif
        for (int rep = 0; rep < PROBE_UX; ++rep)
        {
            u32x4 wa[8], wb[8];
#define GS_UP(W_, D_, B_) { const unsigned j_ = ((D_) & 0xffffu) >> 7; \
                if (j_ == 0) gs_upartial(W_, h2q[0], pz, B_); else if (j_ == 1) gs_upartial(W_, h2q[1], pz, B_); \
                else if (j_ == 2) gs_upartial(W_, h2q[2], pz, B_); else gs_upartial(W_, h2q[3], pz, B_); }
#define GS_RD(i_) ((unsigned)__builtin_amdgcn_readfirstlane((int)sched[(i_)]))
            unsigned da = GS_RD(0), db = GS_RD(1), dn = GS_RD(2), ea, eb, en;
            gs_desc(ent, da, lane, ea); gs_desc(ent, db, lane, eb); gs_desc(ent, dn, lane, en);
            gs_loads(UT, ea, lane, wa);
#pragma unroll 1
            for (int i = 0; i < nbat; i += 2) {
                float pz[16];
                gs_loads(UT, eb, lane, wb);
                __builtin_amdgcn_sched_barrier(0);
                GS_UP(wa, da, 0);
                const unsigned dcur_a = da, dcur_b = db;
                da = dn; ea = en; dn = GS_RD(i + 3); gs_desc(ent, dn, lane, en);
                gs_loads(UT, ea, lane, wa);
                __builtin_amdgcn_sched_barrier(0);
                GS_UP(wb, dcur_b, 8);
                db = dn; eb = en; dn = GS_RD(i + 4); gs_desc(ent, dn, lane, en);
                gs_ustore(pz, zb, dcur_a, dcur_b, lane);
            }
#undef GS_UP
#undef GS_RD
        }
        float asum[GT];
#pragma unroll
        for (int j = 0; j < GT; ++j) {
            float as = 0.f;
#pragma unroll
            for (int q = 0; q < 2; ++q) {
                const int pos = j * 128 + q * 64 + lane;
                const uint2 e = ent[pos];
                const float z = zb[pos] * __uint_as_float(e.x & 0xffff0000u) * hsc[j];
                const float a = gelu_as(z) * __uint_as_float(e.y);
                ent[pos].y = __float_as_uint(a);
                as += a;
            }
#pragma unroll
            for (int sft = 1; sft < 64; sft <<= 1) as += __shfl_xor(as, sft);
            asum[j] = as;
        }
        xcd_pace(pace_cnt, pace_n, pstep);
#pragma unroll
        for (int j = 0; j < GT; ++j)
#pragma unroll
            for (int q = 0; q < 16; ++q) acc[j][q] = 0.f;
        {
            u32x4 wa[8]; unsigned ca;
#pragma unroll 1
            for (int i = 0; i < nbat; ++i) {
                const unsigned da = (unsigned)__builtin_amdgcn_readfirstlane((int)sched[i]);
                gs_issue(VT, ent, da, lane, wa, ca);
                __builtin_amdgcn_sched_barrier(0);
                const unsigned j_ = (da & 0xffffu) >> 7;
                if (j_ == 0) gs_vcompute(wa, ca, acc[0]); else if (j_ == 1) gs_vcompute(wa, ca, acc[1]);
                else if (j_ == 2) gs_vcompute(wa, ca, acc[2]); else gs_vcompute(wa, ca, acc[3]);
            }
        }
#pragma unroll
        for (int j = 0; j < GT; ++j) {
            asm volatile("" ::: "memory");
            __builtin_amdgcn_sched_barrier(0);
            const int tok = t0 + j, b = tok / SEQ;
            float* row = p.out + (size_t)tok * DM + c0;
            const float* g2 = mod + b * 6144 + 5120 + c0;
            f32x2 r[8];
            float sm = 0.f;
#pragma unroll
            for (int q = 0; q < 4; ++q) {
                const f32x4 xv = *(const f32x4*)(row + q * 4), gg = *(const f32x4*)(g2 + q * 4);
                const float off = 128.0f * asum[j];
                r[2 * q] = DEEP_ALPHA * (f32x2){xv.x, xv.y} + (f32x2){1.f + gg.x, 1.f + gg.y} * (f32x2){acc[j][4 * q] - off, acc[j][4 * q + 1] - off};
                r[2 * q + 1] = DEEP_ALPHA * (f32x2){xv.z, xv.w} + (f32x2){1.f + gg.z, 1.f + gg.w} * (f32x2){acc[j][4 * q + 2] - off, acc[j][4 * q + 3] - off};
                sm += r[2 * q].x + r[2 * q].y + r[2 * q + 1].x + r[2 * q + 1].y;
            }
#pragma unroll
            for (int m = 1; m < 64; m <<= 1) sm += __shfl_xor(sm, m);
            const float mu = sm * (1.0f / 1024.0f);
            float qq = 0.f;
#pragma unroll
            for (int i = 0; i < 8; ++i) { const f32x2 dd = r[i] - mu; qq += dd.x * dd.x + dd.y * dd.y; }
#pragma unroll
            for (int m = 1; m < 64; m <<= 1) qq += __shfl_xor(qq, m);
            const float rstd = rsqrtf(qq * (1.0f / 1024.0f) + LN_EPS);
#pragma unroll
            for (int q = 0; q < 4; ++q) {
                const f32x4 w4 = *(const f32x4*)(p.ln2w + c0 + q * 4), bi = *(const f32x4*)(p.ln2b + c0 + q * 4);
                f32x4 ov;
                ov.x = (r[2 * q].x - mu) * rstd * w4.x + bi.x; ov.y = (r[2 * q].y - mu) * rstd * w4.y + bi.y;
                ov.z = (r[2 * q + 1].x - mu) * rstd * w4.z + bi.z; ov.w = (r[2 * q + 1].y - mu) * rstd * w4.w + bi.w;
                *(f32x4*)(row + q * 4) = ov;
            }
        }
    }
}

#define XB_TMO      128
#define XB_XCNT(j)  (256  + 64 * (j))
#define XB_XSUB(j)  (1280 + 64 * (j))
#define XB_XGEN(j)  (2304 + 64 * (j))
#define XB_TOP      3328
#define XB_TOPGEN   3392
#define XCD_BAR_WORDS 3456
#define XB_SPIN_CAP (1u << 22)
#define LAS __attribute__((address_space(3)))
DI unsigned xb_ld(unsigned* p) { return __hip_atomic_load(p, __ATOMIC_RELAXED, __HIP_MEMORY_SCOPE_AGENT); }
DI unsigned xb_add(unsigned* p, unsigned v) { return __hip_atomic_fetch_add(p, v, __ATOMIC_RELAXED, __HIP_MEMORY_SCOPE_AGENT); }
DI unsigned xb_xcc_id() { return (unsigned)__builtin_amdgcn_s_getreg((3 << 11) | 20) & 0xFu; }
#define XB_SPIN(cond, bar) do { unsigned _sp = 0; while (cond) { __builtin_amdgcn_s_sleep(1); \
    if ((++_sp & 255u) == 0u) { if (xb_ld(&(bar)[XB_TMO])) break; if (_sp > XB_SPIN_CAP) { atomicAdd(&(bar)[XB_TMO], 1u); break; } } } } while (0)
struct XcdBarrier { unsigned* bar; unsigned x; volatile LAS unsigned* st; };
DI XcdBarrier xcd_barrier_post(unsigned* bar, volatile LAS unsigned* st) {
    XcdBarrier b; b.bar = bar; b.x = xb_xcc_id(); b.st = st;
    if (__builtin_amdgcn_workitem_id_x() == 0) (void)xb_add(&bar[XB_XCNT(b.x)], 1u);
    return b;
}
DI void xcd_barrier_complete(unsigned* bar, unsigned x, unsigned& nloc, unsigned& nx) {
    const unsigned G = gridDim.x * gridDim.y * gridDim.z;
    unsigned sum, cnt, mine, sp = 0u;
    for (;;) {
        sum = 0u; cnt = 0u; mine = 0u;
#pragma unroll
        for (unsigned j = 0; j < 16; ++j) { const unsigned c = xb_ld(&bar[XB_XCNT(j)]); sum += c; cnt += (c > 0u) ? 1u : 0u; mine = (j == x) ? c : mine; }
        if (sum == G) break;
        __builtin_amdgcn_s_sleep(1);
        if ((++sp & 255u) == 0u) { if (xb_ld(&bar[XB_TMO])) break; if (sp > XB_SPIN_CAP) { atomicAdd(&bar[XB_TMO], 1u); break; } }
    }
    nloc = mine > 0u ? mine : 1u; nx = cnt > 0u ? cnt : 1u;
}
DI void xcd_barrier(const XcdBarrier& b) {
    asm volatile("s_waitcnt vmcnt(0)" ::: "memory");
    __syncthreads();
    if (__builtin_amdgcn_workitem_id_x() == 0) {
        unsigned* bar = b.bar;
        __builtin_amdgcn_s_waitcnt(0);
        unsigned nloc = b.st[0], nx = b.st[1];
        if (nloc == 0u) { xcd_barrier_complete(bar, b.x, nloc, nx); b.st[0] = nloc; b.st[1] = nx; }
        const unsigned old = xb_add(&bar[XB_XSUB(b.x)], 1u);
        const unsigned gen = old / nloc;
        if (old + 1u == (gen + 1u) * nloc) {
            __builtin_amdgcn_fence(__ATOMIC_RELEASE, "agent");
            asm volatile("s_waitcnt vmcnt(0)" ::: "memory");
            const unsigned og = xb_add(&bar[XB_TOP], 1u);
            const unsigned tg = og / nx;
            if (og + 1u == (tg + 1u) * nx) xb_add(&bar[XB_TOPGEN], 1u);
            else XB_SPIN(xb_ld(&bar[XB_TOPGEN]) == tg, bar);
            __builtin_amdgcn_fence(__ATOMIC_ACQUIRE, "agent");
            xb_add(&bar[XB_XGEN(b.x)], 1u);
            asm volatile("s_waitcnt vmcnt(0)" ::: "memory");
        } else {
            XB_SPIN(xb_ld(&bar[XB_XGEN(b.x)]) == gen, bar);
            __builtin_amdgcn_fence(__ATOMIC_ACQUIRE, "agent");
            asm volatile("s_waitcnt vmcnt(0)" ::: "memory");
        }
    }
    __syncthreads();
}

__global__ void __launch_bounds__(NTH) k_mega(Params p) {
    __shared__ __attribute__((aligned(16))) char smem[SMEM_BYTES];
    volatile LAS unsigned* xst = (volatile LAS unsigned*)(smem + SMEM_BYTES - 16);
    if (__builtin_amdgcn_workitem_id_x() == 0) { xst[0] = 0u; xst[1] = 0u; }
    __syncthreads();
    const XcdBarrier xb = xcd_barrier_post((unsigned*)(p.ws + OFF_BAR), xst);
    const int bid = blockIdx.x, nb = gridDim.x;
#ifndef PROBE_MASK
#define PROBE_MASK 0
#endif
#define REP(bit) for (int rep_ = 0; rep_ < ((PROBE_MASK & (bit)) ? 2 : 1); ++rep_)
    REP(64) { phase_mod(p, bid, nb, smem);     xcd_barrier(xb); }
    REP(64) { phase_prep(p, bid, nb, smem); phase_h(p, bid, nb); xcd_barrier(xb); }
    REP(1)  { phase_proj(p, bid, nb, smem);    xcd_barrier(xb); }
    REP(128) { phase_hgprep(p, bid, nb);       xcd_barrier(xb); }
    REP(2)  { phase_mix(p, bid, nb, smem);     xcd_barrier(xb); }
    REP(4)  { phase_glu(p, bid, nb, smem);     xcd_barrier(xb); }
    REP(4)  { phase_a2(p, bid, nb);            xcd_barrier(xb); }
    REP(4)  { phase_outproj(p, bid, nb, smem); xcd_barrier(xb); }
    phase_ln1(p, bid, nb);           xcd_barrier(xb);
    REP(8)  { phase_q(p, bid, nb, smem);       xcd_barrier(xb); }
    REP(16) { phase_retrieve(p, bid, nb, smem); xcd_barrier(xb); }
    phase_gather(p, bid, nb, smem, (unsigned*)(p.ws + OFF_BAR) + 16 * xb.x, xst[0]);
}

extern "C" void kernel_launch(void* const* d_in, const int* in_sizes, int n_in, void* d_out, int out_size, void* d_ws, size_t ws_size, hipStream_t stream) {
    if (n_in != 27 || ws_size < WS_END) { fprintf(stderr, "kernel_launch: unexpected n_in %d or ws_size %zu (< %zu)\n", n_in, ws_size, (size_t)WS_END); return; }
    static int grid_blocks = 0;
    if (!grid_blocks) {
        int dev = 0, cus = 0, per_cu = 0;
        (void)hipGetDevice(&dev);
        (void)hipDeviceGetAttribute(&cus, hipDeviceAttributeMultiprocessorCount, dev);
        (void)hipOccupancyMaxActiveBlocksPerMultiprocessor(&per_cu, k_mega, NTH, 0);
        if (cus <= 0) cus = 256;
        if (per_cu < 1) { fprintf(stderr, "kernel_launch: occupancy query says %d blocks/CU\n", per_cu); per_cu = 1; }
        grid_blocks = cus;
    }
    Params p{};
    const float** f = (const float**)&p;
    for (int i = 0; i < 27; ++i) f[i] = (const float*)d_in[i];
    p.out = (float*)d_out; p.ws = (char*)d_ws;
    hipError_t e = hipMemsetAsync((char*)d_ws + OFF_BAR, 0, (size_t)3456 * 4, stream);
    if (e == hipSuccess) { hipLaunchKernelGGL(k_mega, dim3(grid_blocks), dim3(NTH), 0, stream, p); e = hipPeekAtLastError(); }
    if (e != hipSuccess) fprintf(stderr, "launch failed: %s (grid %d)\n", hipGetErrorString(e), grid_blocks);
}
```

```cpp
#include <hip/hip_runtime.h>
#include <hip/hip_cooperative_groups.h>
#include <stdint.h>
#include <stdio.h>

namespace cg = cooperative_groups;
#define DI __device__ __forceinline__
typedef unsigned short bf16_t;
typedef short bf16x8 __attribute__((ext_vector_type(8)));
typedef float f32x16 __attribute__((ext_vector_type(16)));
typedef unsigned u32x4 __attribute__((ext_vector_type(4)));
typedef float f32x4 __attribute__((ext_vector_type(4)));
typedef float f32x2 __attribute__((ext_vector_type(2)));

constexpr int NTH = 512;
constexpr int NB = 16, SEQ = 2048, DM = 1024, NTOK = NB * SEQ;
constexpr int DHG = 512, HGH = 4, HDK = 128;
constexpr int DSS = 512, SSG = 32, SSC = 16, SSP = 64;
constexpr int INC = 2560;
constexpr int PHEADS = 8, NKEYS = 128, TOPK = 16, NEXP = 16384;
constexpr float DEEP_ALPHA = 1.189207115002721f;
constexpr float LN_EPS = 1e-5f, RMS_EPS = 1e-6f;
constexpr int SMEM_BYTES = 128 * 1024 + 256;

constexpr size_t al256(size_t x) { return (x + 255) & ~(size_t)255; }
constexpr size_t OFF_MOD = 0;
constexpr size_t OFF_LB = al256(OFF_MOD + (size_t)NB * 6144 * 4);
constexpr size_t OFF_LAM = al256(OFF_LB + 512 * 4);
constexpr size_t OFF_BB = al256(OFF_LAM + 32 * 64 * 2 * 4);
constexpr size_t OFF_WIN = al256(OFF_BB + 32 * 64 * 16 * 2 * 4);
constexpr size_t OFF_GLU = al256(OFF_WIN + (size_t)INC * DM * 2);
constexpr size_t OFF_WOUT = al256(OFF_GLU + (size_t)512 * 512 * 2);
constexpr size_t OFF_WQ = al256(OFF_WOUT + (size_t)DM * DM * 2);
constexpr size_t OFF_SUBK = al256(OFF_WQ + (size_t)2048 * DM * 2);
constexpr size_t OFF_SU = al256(OFF_SUBK + (size_t)16 * 128 * 128 * 2);
constexpr size_t OFF_SV = al256(OFF_SU + (size_t)NEXP * 4);
constexpr size_t OFF_UT = al256(OFF_SV + (size_t)NEXP * 4);
constexpr size_t OFF_VT = al256(OFF_UT + (size_t)NEXP * DM * 2);
constexpr size_t OFF_H = al256(OFF_VT + (size_t)NEXP * DM * 2);
constexpr size_t OFF_PROJ = al256(OFF_H + (size_t)NTOK * DM * 2);
constexpr size_t OFF_ORAW = al256(OFF_PROJ + (size_t)NTOK * INC * 2);
constexpr size_t OFF_YSSM = al256(OFF_ORAW + (size_t)NTOK * DHG * 4);
constexpr size_t OFF_A2 = al256(OFF_YSSM + (size_t)NTOK * DSS * 2);
constexpr size_t OFF_HG = al256(OFF_A2 + (size_t)NTOK * DM * 2);
constexpr size_t OFF_S5K = al256(OFF_HG + (size_t)4096 * 128 * 4);
constexpr size_t OFF_S5N = al256(OFF_S5K + (size_t)32 * 4096 * 2);
constexpr size_t OFF_S5M = al256(OFF_S5N + (size_t)32 * 128 * 256 * 2);
constexpr size_t OFF_S5L = al256(OFF_S5M + (size_t)32 * 256 * 128 * 2);
constexpr size_t OFF_STAT = al256(OFF_S5L + (size_t)32 * 64 * 2 * 4);
constexpr size_t OFF_AB = al256(OFF_STAT + (size_t)NTOK * 2 * 4);
constexpr size_t OFF_CAB = al256(OFF_AB + (size_t)2 * NB * DM * 4);
constexpr size_t OFF_BAR = al256(OFF_CAB + (size_t)2 * NB * 2048 * 4);
constexpr size_t WS_END = al256(OFF_BAR + (size_t)3456 * 4);
constexpr size_t OFF_HQ = OFF_H, OFF_HK = OFF_H + (size_t)NTOK * DHG * 2, OFF_HKT = OFF_A2, OFF_HVT = OFF_A2 + (size_t)NTOK * DHG * 2;
constexpr size_t OFF_TOPL = OFF_ORAW;
constexpr size_t OFF_EXPS = OFF_ORAW + (size_t)NTOK * 16 * 16 * 4;

struct Params {
    const float *x, *c, *ada_w, *ada_b, *w_in, *hg_lb, *hg_nw, *a_re, *a_im, *log_dt, *b_re, *b_im, *c_re, *c_im, *dsk,
        *glu_w, *glu_b, *ssm_nw, *w_out, *ln1w, *ln1b, *w_q, *subk, *pu, *pv, *ln2w, *ln2b;
    float* out;
    char* ws;
};

DI int my_tid() { int t = (int)__builtin_amdgcn_workitem_id_x(); asm volatile("" : "+v"(t)); return t; }
DI bf16_t f2bf(float x) { unsigned u = __float_as_uint(x); u += 0x7fffu + ((u >> 16) & 1u); return (bf16_t)(u >> 16); }
DI float bf2f(bf16_t b) { return __uint_as_float(((unsigned)b) << 16); }
DI float bflo(unsigned w) { return __uint_as_float(w << 16); }
DI float bfhi(unsigned w) { return __uint_as_float(w & 0xffff0000u); }
typedef __bf16 hwbf16x2 __attribute__((ext_vector_type(2)));
DI unsigned pack2(float a, float b) { const f32x2 v = {a, b}; return __builtin_bit_cast(unsigned, __builtin_convertvector(v, hwbf16x2)); }
DI bf16x8 pack8(const f32x16& x, const int base) {
    u32x4 o; o.x = pack2(x[base], x[base + 1]); o.y = pack2(x[base + 2], x[base + 3]); o.z = pack2(x[base + 4], x[base + 5]); o.w = pack2(x[base + 6], x[base + 7]);
    return __builtin_bit_cast(bf16x8, o);
}
DI float sigmoidf_(float x) { return 1.0f / (1.0f + __expf(-x)); }
DI float siluf_(float x) { return x * sigmoidf_(x); }
DI float geluf_(float x) { return 0.5f * x * (1.0f + erff(x * 0.70710678118654752f)); }
DI float gelu_as(float v) {
    const float t = __builtin_amdgcn_rcpf(fabsf(v) * 0.2316418882f + 1.0f);
    float q = t * 0.5307027145f + (-0.7265760135f); q = q * t + 0.7107068705f; q = q * t + (-0.142248368f); q = q * t + 0.127414796f; q = q * t;
    const float m = v * (q * __builtin_amdgcn_exp2f(v * v * (-0.72134752044f)));
    return v < 0.f ? m : v - m;
}

template <int MT, int NT_, int WM, int WN, class Epi>
DI void gemm_block(const bf16_t* __restrict__ A, int lda, const bf16_t* __restrict__ Bt, int ldb, int K, char* smem, Epi epi) {
    constexpr int BM = WM * MT * 32, BN = WN * NT_ * 32, LS = 72;
    static_assert(WM * WN == 8, "8 waves");
    bf16_t* As = (bf16_t*)smem;
    bf16_t* Bs = As + BM * LS;
    const int tid = my_tid(), lane = tid & 63, wid = tid >> 6, r = lane & 31, h = lane >> 5;
    const int wm = wid / WN, wn = wid % WN;
    constexpr int PA = BM * 8 / NTH, PB = BN * 8 / NTH;
    u32x4 ra[PA], rb[PB];
    f32x16 acc[MT][NT_];
#pragma unroll
    for (int mi = 0; mi < MT; ++mi)
#pragma unroll
        for (int ni = 0; ni < NT_; ++ni)
#pragma unroll
            for (int i = 0; i < 16; ++i) acc[mi][ni][i] = 0.f;
#define GEMM_GLOAD(kt_) { \
    _Pragma("unroll") for (int q = 0; q < PA; ++q) { const int idx = tid + q * NTH, row = idx >> 3, ch = idx & 7; ra[q] = *(const u32x4*)(A + (size_t)row * lda + (kt_) * 64 + ch * 8); } \
    _Pragma("unroll") for (int q = 0; q < PB; ++q) { const int idx = tid + q * NTH, row = idx >> 3, ch = idx & 7; rb[q] = *(const u32x4*)(Bt + (size_t)row * ldb + (kt_) * 64 + ch * 8); } }
#define GEMM_LSTORE() { \
    _Pragma("unroll") for (int q = 0; q < PA; ++q) { const int idx = tid + q * NTH, row = idx >> 3, ch = idx & 7; *(u32x4*)(As + row * LS + ch * 8) = ra[q]; } \
    _Pragma("unroll") for (int q = 0; q < PB; ++q) { const int idx = tid + q * NTH, row = idx >> 3, ch = idx & 7; *(u32x4*)(Bs + row * LS + ch * 8) = rb[q]; } }
    GEMM_GLOAD(0); GEMM_LSTORE(); __syncthreads();
    const int nk = K / 64;
    for (int kt = 0; kt < nk; ++kt) {
        if (kt + 1 < nk) GEMM_GLOAD(kt + 1);
#pragma unroll
        for (int ks = 0; ks < 4; ++ks) {
            bf16x8 a[MT], b[NT_];
#pragma unroll
            for (int mi = 0; mi < MT; ++mi) a[mi] = *(const bf16x8*)(As + (wm * MT * 32 + mi * 32 + r) * LS + ks * 16 + h * 8);
#pragma unroll
            for (int ni = 0; ni < NT_; ++ni) b[ni] = *(const bf16x8*)(Bs + (wn * NT_ * 32 + ni * 32 + r) * LS + ks * 16 + h * 8);
#pragma unroll
            for (int mi = 0; mi < MT; ++mi)
#pragma unroll
                for (int ni = 0; ni < NT_; ++ni) acc[mi][ni] = __builtin_amdgcn_mfma_f32_32x32x16_bf16(a[mi], b[ni], acc[mi][ni], 0, 0, 0);
        }
        __syncthreads();
        if (kt + 1 < nk) { GEMM_LSTORE(); __syncthreads(); }
    }
#pragma unroll
    for (int mi = 0; mi < MT; ++mi)
#pragma unroll
        for (int ni = 0; ni < NT_; ++ni)
#pragma unroll
            for (int i = 0; i < 16; ++i) epi(wm * MT * 32 + mi * 32 + (i & 3) + 8 * (i >> 2) + 4 * h, wn * NT_ * 32 + ni * 32 + r, acc[mi][ni][i]);
}

namespace pg8 {
#define PG8_LAS __attribute__((address_space(3)))
typedef unsigned short bf16_t;
typedef short bf16x8 __attribute__((ext_vector_type(8)));
typedef float f32x4 __attribute__((ext_vector_type(4)));
typedef unsigned u32x4 __attribute__((ext_vector_type(4)));
constexpr int BM = 256, BK = 64, HALF = 128, HTB = HALF * BK * 2  , STAGE_BYTES = 8 * HTB, NXCD = 8, WGM = 8;

__host__ __device__ __forceinline__ int lds_byte(int r, int c) { const int st = (r >> 4) * 2 + (c >> 5), rr = r & 15, cc = c & 31, ob = rr * 64 + cc * 2; return st * 1024 + (ob ^ (((ob >> 9) & 1) << 5)); }
__host__ __device__ __forceinline__ void stage_rc(int b, int& R, int& C) { const int st = b / 1024, sb = b % 1024, swz = sb ^ (((sb >> 9) & 1) << 5); R = (st >> 1) * 16 + swz / 64; C = (st & 1) * 32 + (swz % 64) / 2; }
__host__ __device__ __forceinline__ int perm32(int rho) { const int n = rho >> 4, i = rho & 15; return 8 * (i >> 2) + 4 * n + (i & 3); }

struct Unit { int pm, pn; };
struct Gemm { const bf16_t* A; const bf16_t* Bt; int M, N, K; };

struct StaticOrder {
    int nM, nN, nwg, G, c;
    __host__ __device__ void init(int M, int N, int G_, int c_) { nM = M / BM; nN = N / BM; nwg = nM * nN; G = G_; c = c_; }
    __host__ __device__ bool next(int i, Unit& u) const {
        const long L = (long)i * G + c; if (L >= nwg) return false;
        int wgid = (int)L; { const int q = nwg / NXCD, r = nwg % NXCD, xcd = wgid % NXCD, off = wgid / NXCD; wgid = (xcd < r ? xcd * (q + 1) : r * (q + 1) + (xcd - r) * q) + off; }
        const int nig = WGM * nN, gid = wgid / nig, fm = gid * WGM, gsz = (nM - fm) < WGM ? (nM - fm) : WGM;
        u.pm = fm + ((wgid % nig) % gsz); u.pn = (wgid % nig) / gsz; return true;
    }
    __device__ __forceinline__ void a_ready(const Unit&) const {}
    __device__ __forceinline__ void done(const Unit&) const {}
};
template <class Epi, class Sched, bool STAMP = false>
__device__ __forceinline__ void gemm_phase(PG8_LAS unsigned char* lds, const Gemm g, const Sched& S, const Epi& E, unsigned long long* stamps) {
    const int tid = (int)__builtin_amdgcn_workitem_id_x(), wid = __builtin_amdgcn_readfirstlane(tid >> 6), lane = tid & 63, wr = wid >> 2, wc = wid & 3, fr = lane & 15, fq = lane >> 4;
    const int K = g.K, nt = K / BK;
    int ts_lo = 0, ts_hi = 0, nts = 0; const unsigned long long rt_entry = STAMP ? (unsigned long long)wall_clock64() : 0ull;
#define PG8_STAMP() do { if (STAMP && wid == 0 && nts < 64) { const unsigned long long _c = (unsigned long long)clock64(); \
        ts_lo = (lane == nts) ? (int)(unsigned)_c : ts_lo; ts_hi = (lane == nts) ? (int)(unsigned)(_c >> 32) : ts_hi; ++nts; } } while (0)
    PG8_STAMP();
    unsigned voffA[2], voffB[2];
#pragma unroll
    for (int i = 0; i < 2; ++i) { int R, C; stage_rc(tid * 16 + i * 8192, R, C); const int Rb = Epi::PERM ? ((R & ~31) + perm32(R & 31)) : R;
        voffA[i] = (unsigned)(R * K + C) * 2u; voffB[i] = (unsigned)(Rb * K + C) * 2u; }
    const size_t kstep = (size_t)(BK * 2);
    const size_t hstep = (size_t)HALF * K * 2;
    const size_t tstep = 2 * hstep;
    const unsigned ldsw = (unsigned)wid * 1024u;
    const int aoff = lds_byte(wr * 64 + fr, fq * 8), boff = lds_byte(wc * 32 + fr, fq * 8);
#define PG8_SA(b, h) (((b) * 2 + (h)) * HTB)
#define PG8_SB(b, h) ((4 + (b) * 2 + (h)) * HTB)
#define PG8_STAGE(bufoff, gbase, voff) do { _Pragma("unroll") for (int _i = 0; _i < 2; ++_i) \
        __builtin_amdgcn_global_load_lds((const unsigned*)((const char*)(gbase) + (voff)[_i]), (PG8_LAS unsigned*)(lds + (bufoff) + ldsw + _i * 8192), 16, 0, 0); } while (0)
#define PG8_LDA(dst, b, h) do { _Pragma("unroll") for (int m = 0; m < 4; ++m) _Pragma("unroll") for (int k = 0; k < 2; ++k) dst[m][k] = *(const PG8_LAS bf16x8*)(lds + PG8_SA(b, h) + aoff + m * 2048 + k * 1024); } while (0)
#define PG8_LDB(dst, b, h) do { _Pragma("unroll") for (int n = 0; n < 2; ++n) _Pragma("unroll") for (int k = 0; k < 2; ++k) dst[n][k] = *(const PG8_LAS bf16x8*)(lds + PG8_SB(b, h) + boff + n * 2048 + k * 1024); } while (0)
#define PG8_MMA(ai, bj, At, Bt) do { __builtin_amdgcn_s_setprio(1); _Pragma("unroll") for (int m = 0; m < 4; ++m) _Pragma("unroll") for (int n = 0; n < 2; ++n) _Pragma("unroll") for (int k = 0; k < 2; ++k) \
        acc[ai][bj][m][n] = __builtin_amdgcn_mfma_f32_16x16x32_bf16(Bt[n][k], At[m][k], acc[ai][bj][m][n], 0, 0, 0); __builtin_amdgcn_s_setprio(0); } while (0)
#define PG8_WAIT_V(n) asm volatile("s_waitcnt vmcnt(" #n ")" ::: "memory")
#define PG8_WAIT_L(n) asm volatile("s_waitcnt lgkmcnt(" #n ")" ::: "memory")
#define PG8_BAR __builtin_amdgcn_s_barrier()
#define PG8_SCHED __builtin_amdgcn_sched_barrier(0)
    Unit cur, nxt; int ui = 0;
    if (!S.next(0, cur)) return;
    f32x4 acc[2][2][4][2];
#pragma unroll
    for (int a = 0; a < 2; ++a)
#pragma unroll
        for (int b = 0; b < 2; ++b)
#pragma unroll
            for (int m = 0; m < 4; ++m)
#pragma unroll
                for (int n = 0; n < 2; ++n) acc[a][b][m][n] = (f32x4){0.f, 0.f, 0.f, 0.f};
    bf16x8 At[4][2], B0[2][2], B1[2][2];
    const char* cA = (const char*)g.A + (size_t)cur.pm * tstep; const char* cB = (const char*)g.Bt + (size_t)cur.pn * tstep;
    S.a_ready(cur);
    PG8_STAGE(PG8_SB(0, 0), cB, voffB); PG8_STAGE(PG8_SA(0, 0), cA, voffA); PG8_STAGE(PG8_SB(0, 1), cB + hstep, voffB); PG8_STAGE(PG8_SA(0, 1), cA + hstep, voffA);
    if (wr == 1) PG8_BAR;
    PG8_WAIT_V(4); PG8_BAR;
    PG8_STAGE(PG8_SB(1, 0), cB + kstep, voffB); PG8_STAGE(PG8_SA(1, 0), cA + kstep, voffA); PG8_STAGE(PG8_SB(1, 1), cB + hstep + kstep, voffB);
    PG8_WAIT_V(6); PG8_BAR;
    PG8_STAMP();
    for (;;) {
        const bool has_next = S.next(ui + 1, nxt);
        const char* nA = has_next ? (const char*)g.A + (size_t)nxt.pm * tstep : cA; const char* nB = has_next ? (const char*)g.Bt + (size_t)nxt.pn * tstep : cB;
        for (int t = 0; t < nt; t += 2) {
            const bool last = (t == nt - 2);
            const char* a1 = cA + (size_t)(t + 1) * kstep;
            const char* a2 = last ? nA : cA + (size_t)(t + 2) * kstep; const char* b2 = last ? nB : cB + (size_t)(t + 2) * kstep;
            const char* a3 = a2 + kstep; const char* b3 = b2 + kstep;
            if (last && has_next) S.a_ready(nxt);
            PG8_LDB(B0, 0, 0); PG8_SCHED; PG8_LDA(At, 0, 0); PG8_STAGE(PG8_SA(1, 1), a1 + hstep, voffA);
            PG8_WAIT_L(8); PG8_BAR; PG8_WAIT_L(0); PG8_MMA(0, 0, At, B0); PG8_BAR; PG8_SCHED;
            PG8_LDB(B1, 0, 1); PG8_STAGE(PG8_SB(0, 0), b2, voffB);
            PG8_BAR; PG8_WAIT_L(0); PG8_MMA(0, 1, At, B1); PG8_BAR;
            PG8_LDA(At, 0, 1); PG8_STAGE(PG8_SA(0, 0), a2, voffA);
            PG8_BAR; PG8_WAIT_L(0); PG8_MMA(1, 0, At, B0); PG8_BAR; PG8_SCHED;
            PG8_STAGE(PG8_SB(0, 1), b2 + hstep, voffB);
            PG8_WAIT_V(6); PG8_BAR; PG8_MMA(1, 1, At, B1); PG8_BAR;
            PG8_LDB(B0, 1, 0); PG8_SCHED; PG8_LDA(At, 1, 0); PG8_STAGE(PG8_SA(0, 1), a2 + hstep, voffA);
            PG8_WAIT_L(8); PG8_BAR; PG8_WAIT_L(0); PG8_MMA(0, 0, At, B0); PG8_BAR; PG8_SCHED;
            PG8_LDB(B1, 1, 1); PG8_STAGE(PG8_SB(1, 0), b3, voffB);
            PG8_BAR; PG8_WAIT_L(0); PG8_MMA(0, 1, At, B1); PG8_BAR;
            PG8_LDA(At, 1, 1); PG8_STAGE(PG8_SA(1, 0), a3, voffA);
            PG8_BAR; PG8_WAIT_L(0); PG8_MMA(1, 0, At, B0); PG8_BAR; PG8_SCHED;
            PG8_STAGE(PG8_SB(1, 1), b3 + hstep, voffB);
            PG8_WAIT_V(6); PG8_BAR; PG8_MMA(1, 1, At, B1); PG8_BAR;
        }
        PG8_STAMP();
        if constexpr (!Epi::AFTER_DRAIN) { E(acc, cur, wr, wc, fr, fq); S.done(cur); }
        PG8_STAMP();
        if (!has_next) break;
#pragma unroll
        for (int a = 0; a < 2; ++a)
#pragma unroll
            for (int b = 0; b < 2; ++b)
#pragma unroll
                for (int m = 0; m < 4; ++m)
#pragma unroll
                    for (int n = 0; n < 2; ++n) acc[a][b][m][n] = (f32x4){0.f, 0.f, 0.f, 0.f};
        cur = nxt; cA = nA; cB = nB; ++ui;
    }
    PG8_WAIT_V(0);
    if (wr == 0) PG8_BAR;
    PG8_BAR;
    if constexpr (Epi::AFTER_DRAIN) { E.fused(acc, cur, wr, wc, fr, fq, lds, wid, lane); S.done(cur); }
    PG8_STAMP();
    if (STAMP && wid == 0) { stamps[lane] = lane < nts ? (((unsigned long long)(unsigned)ts_hi << 32) | (unsigned)ts_lo) : 0ull;
        if (lane == 62) stamps[62] = rt_entry; if (lane == 63) stamps[63] = (unsigned long long)wall_clock64(); }
#undef PG8_STAMP
#undef PG8_SA
#undef PG8_SB
#undef PG8_STAGE
#undef PG8_LDA
#undef PG8_LDB
#undef PG8_MMA
#undef PG8_WAIT_V
#undef PG8_WAIT_L
#undef PG8_BAR
#undef PG8_SCHED
}

__device__ __forceinline__ unsigned pk_bf16(float lo, float hi) { typedef float v2f __attribute__((ext_vector_type(2))); typedef __bf16 v2b __attribute__((ext_vector_type(2))); const v2f v = {lo, hi}; return __builtin_bit_cast(unsigned, __builtin_convertvector(v, v2b)); }
__device__ __forceinline__ float silu1(float x) { return x * __builtin_amdgcn_rcpf(1.0f + __expf(-x)); }
struct EpiBf16Act {
    static constexpr bool PERM = true, AFTER_DRAIN = false;
    bf16_t* O; int ldc; unsigned silu_mask;
    __device__ __forceinline__ void operator()(const f32x4 (&acc)[2][2][4][2], const Unit& u, int wr, int wc, int fr, int fq) const {
        const int row0 = u.pm * BM + wr * 64 + fr, col0 = u.pn * BM + wc * 32 + 8 * fq;
        const bool act = (silu_mask >> u.pn) & 1u;
#pragma unroll
        for (int ai = 0; ai < 2; ++ai)
#pragma unroll
            for (int m = 0; m < 4; ++m) { bf16_t* rowp = O + (size_t)(row0 + ai * HALF + m * 16) * ldc + col0;
#pragma unroll
                for (int bj = 0; bj < 2; ++bj) { f32x4 v0 = acc[ai][bj][m][0], v1 = acc[ai][bj][m][1];
                    if (act) {
#pragma unroll
                        for (int j = 0; j < 4; ++j) { v0[j] = silu1(v0[j]); v1[j] = silu1(v1[j]); } }
                    u32x4 w; w.x = pk_bf16(v0[0], v0[1]); w.y = pk_bf16(v0[2], v0[3]); w.z = pk_bf16(v1[0], v1[1]); w.w = pk_bf16(v1[2], v1[3]);
                    *(u32x4*)(rowp + bj * HALF) = w; } }
    }
};
struct EpiResid {
    static constexpr bool PERM = false, AFTER_DRAIN = false;
    float* C; const float* X; const float* mod_g;
    static constexpr int NTOK_ = 32768;
    float alpha; bf16_t* AP; const float* avec; float* stat;
    __device__ __forceinline__ void operator()(const f32x4 (&acc)[2][2][4][2], const Unit& u, int wr, int wc, int fr, int fq) const {
        const int row0 = u.pm * BM + wr * 64 + fr, col0 = u.pn * BM + wc * 32 + 4 * fq, bat = (u.pm * BM) / 2048;
        const float* gb = mod_g + (size_t)bat * 6144 + col0;
        const float* ab = avec + (size_t)bat * 1024 + col0;
        f32x4 gv[2][2], av[2][2];
#pragma unroll
        for (int bj = 0; bj < 2; ++bj)
#pragma unroll
            for (int n = 0; n < 2; ++n) { gv[bj][n] = *(const f32x4*)(gb + bj * HALF + n * 16) + 1.0f; av[bj][n] = *(const f32x4*)(ab + bj * HALF + n * 16); }
#pragma unroll
        for (int ai = 0; ai < 2; ++ai) {
            float s1[4], s2[4];
#pragma unroll
            for (int m = 0; m < 4; ++m) { const int row = row0 + ai * HALF + m * 16; const size_t ro = (size_t)row * 1024 + col0;
                s1[m] = 0.f; s2[m] = 0.f;
#pragma unroll
                for (int bj = 0; bj < 2; ++bj)
#pragma unroll
                    for (int n = 0; n < 2; ++n) {
                        const f32x4 xv = *(const f32x4*)(X + ro + bj * HALF + n * 16);
                        const f32x4 r1 = alpha * xv + gv[bj][n] * acc[ai][bj][m][n];
                        *(f32x4*)(C + ro + bj * HALF + n * 16) = r1;
                        const f32x4 ap = r1 * av[bj][n];
                        *(uint2*)(AP + ro + bj * HALF + n * 16) = make_uint2(pk_bf16(ap[0], ap[1]), pk_bf16(ap[2], ap[3]));
                        s1[m] += (r1[0] + r1[1]) + (r1[2] + r1[3]); s2[m] += (r1[0] * r1[0] + r1[1] * r1[1]) + (r1[2] * r1[2] + r1[3] * r1[3]);
                    }
            }
            const bool hi5 = fq & 2, hi4 = fq & 1;
            const float a1 = (hi5 ? s1[2] : s1[0]) + __shfl_xor(hi5 ? s1[0] : s1[2], 32), b1 = (hi5 ? s1[3] : s1[1]) + __shfl_xor(hi5 ? s1[1] : s1[3], 32);
            const float a2 = (hi5 ? s2[2] : s2[0]) + __shfl_xor(hi5 ? s2[0] : s2[2], 32), b2 = (hi5 ? s2[3] : s2[1]) + __shfl_xor(hi5 ? s2[1] : s2[3], 32);
            const float t1 = (hi4 ? b1 : a1) + __shfl_xor(hi4 ? a1 : b1, 16), t2 = (hi4 ? b2 : a2) + __shfl_xor(hi4 ? a2 : b2, 16);
            const int srow = u.pm * BM + wr * 64 + ai * HALF + fq * 16 + fr;
            atomicAdd(stat + srow, t1); atomicAdd(stat + NTOK_ + srow, t2);
        }
    }
};
struct EpiQLN {
    static constexpr bool PERM = true, AFTER_DRAIN = false;
    bf16_t* O; const float* stat; const float* ca; const float* cb; float eps;
    __device__ __forceinline__ void operator()(const f32x4 (&acc)[2][2][4][2], const Unit& u, int wr, int wc, int fr, int fq) const {
        const int row0 = u.pm * BM + wr * 64 + fr, col0 = u.pn * BM + wc * 32 + 8 * fq, bat = (u.pm * BM) / 2048;
        const float* cap = ca + (size_t)bat * 2048 + col0;
        const float* cbp = cb + (size_t)bat * 2048 + col0;
#pragma unroll
        for (int bj = 0; bj < 2; ++bj) {
            const f32x4 a0 = *(const f32x4*)(cap + bj * HALF), a1 = *(const f32x4*)(cap + bj * HALF + 4), b0 = *(const f32x4*)(cbp + bj * HALF), b1 = *(const f32x4*)(cbp + bj * HALF + 4);
#pragma unroll
            for (int ai = 0; ai < 2; ++ai)
#pragma unroll
                for (int m = 0; m < 4; ++m) {
                    const int row = row0 + ai * HALF + m * 16;
                    const float mu = stat[row] * (1.0f / 1024.0f), rstd = rsqrtf(fmaxf(stat[32768 + row] * (1.0f / 1024.0f) - mu * mu, 0.f) + eps);
                    const f32x4 v0 = rstd * (acc[ai][bj][m][0] - mu * a0) + b0, v1 = rstd * (acc[ai][bj][m][1] - mu * a1) + b1;
                    u32x4 w; w.x = pk_bf16(v0[0], v0[1]); w.y = pk_bf16(v0[2], v0[3]); w.z = pk_bf16(v1[0], v1[1]); w.w = pk_bf16(v1[2], v1[3]);
                    *(u32x4*)(O + (size_t)row * 2048 + col0 + bj * HALF) = w;
                }
        }
    }
};
struct EpiGlu {
    static constexpr bool PERM = false, AFTER_DRAIN = false;
    float* C; const bf16_t* Y; const float* bias;
    __device__ __forceinline__ void operator()(const f32x4 (&acc)[2][2][4][2], const Unit& u, int wr, int wc, int fr, int fq) const {
        const int row0 = u.pm * BM + wr * 64 + fr, col0 = u.pn * BM + wc * 32 + 4 * fq;
        f32x4 bv[2][2];
#pragma unroll
        for (int bj = 0; bj < 2; ++bj)
#pragma unroll
            for (int n = 0; n < 2; ++n) bv[bj][n] = *(const f32x4*)(bias + col0 + bj * HALF + n * 16);
#pragma unroll
        for (int ai = 0; ai < 2; ++ai)
#pragma unroll
            for (int m = 0; m < 4; ++m) { const size_t ro = (size_t)(row0 + ai * HALF + m * 16) * 512 + col0;
#pragma unroll
                for (int bj = 0; bj < 2; ++bj)
#pragma unroll
                    for (int n = 0; n < 2; ++n) {
                        const uint2 yw = *(const uint2*)(Y + ro + bj * HALF + n * 16);
                        const f32x4 z = acc[ai][bj][m][n] + bv[bj][n];
                        f32x4 o;
                        o[0] = __uint_as_float(yw.x << 16) * __builtin_amdgcn_rcpf(1.0f + __expf(-z[0])); o[1] = __uint_as_float(yw.x & 0xffff0000u) * __builtin_amdgcn_rcpf(1.0f + __expf(-z[1]));
                        o[2] = __uint_as_float(yw.y << 16) * __builtin_amdgcn_rcpf(1.0f + __expf(-z[2])); o[3] = __uint_as_float(yw.y & 0xffff0000u) * __builtin_amdgcn_rcpf(1.0f + __expf(-z[3]));
                        *(f32x4*)(C + ro + bj * HALF + n * 16) = o; } }
    }
};
}

DI void prep_mod_item(const Params& p, int item, char* smem) {
    float* condT = (float*)smem;
    float* red = condT + DM * 16;
    const int tid = my_tid();
    for (int i = tid; i < NB * DM; i += NTH) { const int b = i >> 10, k = i & 1023; condT[k * 16 + b] = siluf_(p.c[i]); }
    __syncthreads();
    const int ks = tid >> 5, col = tid & 31;
    float acc[16];
#pragma unroll
    for (int b = 0; b < 16; ++b) acc[b] = 0.f;
    const float* w = p.ada_w + (size_t)(ks * 64) * 6144 + item * 32 + col;
#pragma unroll 1
    for (int seg = 0; seg < 4; ++seg) {
        float wreg[16];
#pragma unroll
        for (int k = 0; k < 16; ++k) wreg[k] = w[(size_t)(seg * 16 + k) * 6144];
#pragma unroll
        for (int k = 0; k < 16; ++k) {
            const float wv = wreg[k];
            const f32x4* cb = (const f32x4*)(condT + (ks * 64 + seg * 16 + k) * 16);
            const f32x4 c0 = cb[0], c1 = cb[1], c2 = cb[2], c3 = cb[3];
            acc[0] += c0.x * wv; acc[1] += c0.y * wv; acc[2] += c0.z * wv; acc[3] += c0.w * wv;
            acc[4] += c1.x * wv; acc[5] += c1.y * wv; acc[6] += c1.z * wv; acc[7] += c1.w * wv;
            acc[8] += c2.x * wv; acc[9] += c2.y * wv; acc[10] += c2.z * wv; acc[11] += c2.w * wv;
            acc[12] += c3.x * wv; acc[13] += c3.y * wv; acc[14] += c3.z * wv; acc[15] += c3.w * wv;
        }
    }
#pragma unroll
    for (int b = 0; b < 16; ++b) red[(ks * 32 + col) * 16 + b] = acc[b];
    __syncthreads();
    {
        const int b = tid >> 5;
        float sum = p.ada_b[item * 32 + col];
#pragma unroll
        for (int q = 0; q < 16; ++q) sum += red[(q * 32 + col) * 16 + b];
        ((float*)(p.ws + OFF_MOD))[b * 6144 + item * 32 + col] = sum;
    }
    __syncthreads();
}
DI void prep_s5_gemm_item(const Params& p, int g, int part, char* smem) {
    f32x2* pw = (f32x2*)smem;
    f32x2* bbL = pw + 17 * 64;
    f32x2* cL = bbL + 64 * 16;
    const int tid = my_tid();
    const float dt = expf(p.log_dt[g]);
#pragma unroll 1
    for (int idx = tid; idx < 17 * 64; idx += NTH) {
        const int j = idx >> 6, pp = idx & 63;
        const float ar = p.a_re[g * 64 + pp], ai = p.a_im[g * 64 + pp];
        const float mag = expf(ar * dt * (float)j), ang = ai * dt * (float)j;
        pw[idx] = (f32x2){mag * cosf(ang), mag * sinf(ang)};
    }
    for (int idx = tid; idx < 16 * 64; idx += NTH) { const int i = idx >> 6, pp = idx & 63; cL[idx] = (f32x2){p.c_re[(g * 16 + i) * 64 + pp], p.c_im[(g * 16 + i) * 64 + pp]}; }
    __syncthreads();
    for (int idx = tid; idx < 64 * 16; idx += NTH) {
        const int pp = idx >> 4, i = idx & 15;
        const float ar = p.a_re[g * 64 + pp], ai = p.a_im[g * 64 + pp];
        const f32x2 lam = pw[64 + pp];
        const float den = ar * ar + ai * ai, nr = lam.x - 1.0f, ni = lam.y;
        const float zr = (nr * ar + ni * ai) / den, zi = (ni * ar - nr * ai) / den;
        const float br = p.b_re[(g * 64 + pp) * 16 + i], bi = p.b_im[(g * 64 + pp) * 16 + i];
        bbL[idx] = (f32x2){zr * br - zi * bi, zr * bi + zi * br};
    }
    __syncthreads();
    bf16_t* NBg = (bf16_t*)(p.ws + OFF_S5N) + (size_t)g * 128 * 256;
    if (part == 0)
#pragma unroll 1
    for (int ch = tid; ch < 128 * 256 / 8; ch += NTH) {
        const int pq = ch >> 5, t = (ch >> 1) & 15, i0 = (ch & 1) * 8, pp = pq & 63;
        const f32x2 w = pw[(15 - t) * 64 + pp];
        float v[8];
#pragma unroll
        for (int e = 0; e < 8; ++e) { const f32x2 bb = bbL[pp * 16 + i0 + e]; v[e] = pq < 64 ? (w.x * bb.x - w.y * bb.y) : (w.x * bb.y + w.y * bb.x); }
        u32x4 o; o.x = pack2(v[0], v[1]); o.y = pack2(v[2], v[3]); o.z = pack2(v[4], v[5]); o.w = pack2(v[6], v[7]);
        *(u32x4*)(NBg + (size_t)((((pq >> 5) * 16 + t) * 64) + (i0 >> 3) * 32 + (pq & 31)) * 8) = o;
    }
    bf16_t* MBg = (bf16_t*)(p.ws + OFF_S5M) + (size_t)g * 256 * 128;
    if (part == 1)
#pragma unroll 1
    for (int ch = tid; ch < 256 * 128 / 8; ch += NTH) {
        const int ti = ch >> 4, p0 = (ch & 15) * 8, tq = ti >> 4, iq = ti & 15;
        float v[8];
#pragma unroll
        for (int e = 0; e < 8; ++e) {
            const int pq = p0 + e, pp = pq & 63;
            const f32x2 c = cL[iq * 64 + pp], w = pw[(tq + 1) * 64 + pp];
            v[e] = pq < 64 ? (c.x * w.x - c.y * w.y) : -(c.x * w.y + c.y * w.x);
        }
        u32x4 o; o.x = pack2(v[0], v[1]); o.y = pack2(v[2], v[3]); o.z = pack2(v[4], v[5]); o.w = pack2(v[6], v[7]);
        *(u32x4*)(MBg + (size_t)((((ti >> 5) * 8 + (p0 >> 4)) * 64) + ((p0 >> 3) & 1) * 32 + (ti & 31)) * 8) = o;
    }
    bf16_t* KTg = (bf16_t*)(p.ws + OFF_S5K) + (size_t)g * 4096;
    if (part >= 2)
#pragma unroll 1
    for (int idx = (part - 2) * 2048 + tid; idx < (part - 1) * 2048; idx += NTH) {
        const int lag = idx >> 8, iq = (idx >> 4) & 15, i = idx & 15;
        float acc = (lag == 0 && iq == i) ? p.dsk[g * 16 + iq] : 0.f;
#pragma unroll 4
        for (int pp = 0; pp < 64; ++pp) {
            const f32x2 c = cL[iq * 64 + pp], w = pw[lag * 64 + pp], bb = bbL[pp * 16 + i];
            const float mr = c.x * w.x - c.y * w.y, mi_ = c.x * w.y + c.y * w.x;
            acc += mr * bb.x - mi_ * bb.y;
        }
        KTg[idx] = f2bf(acc);
    }
    if (part == 3 && tid < 64) { float* L = (float*)(p.ws + OFF_S5L) + (g * 64 + tid) * 2; const f32x2 w = pw[16 * 64 + tid]; L[0] = w.x; L[1] = w.y; }
    __syncthreads();
}
DI void prep_s5_item(const Params& p, int g) {
    const int tid = my_tid();
    if (tid < SSP) {
        const int pi = g * SSP + tid;
        const float dt = expf(p.log_dt[g]);
        const float ar = p.a_re[pi], ai = p.a_im[pi];
        const float mag = expf(ar * dt);
        const float lr = mag * cosf(ai * dt), li = mag * sinf(ai * dt);
        const float den = ar * ar + ai * ai, nr = lr - 1.0f, ni = li;
        const float zr = (nr * ar + ni * ai) / den, zi = (ni * ar - nr * ai) / den;
        float* lam = (float*)(p.ws + OFF_LAM) + pi * 2;
        lam[0] = lr; lam[1] = li;
        float* bb = (float*)(p.ws + OFF_BB) + (size_t)pi * 32;
        for (int i = 0; i < SSC; ++i) {
            const float br = p.b_re[pi * SSC + i], bi = p.b_im[pi * SSC + i];
            bb[i * 2] = zr * br - zi * bi; bb[i * 2 + 1] = zr * bi + zi * br;
        }
    }
}
DI void prep_transpose_tile(const float* __restrict__ W, bf16_t* __restrict__ Wt, int K, int N, int kt, int nt, char* smem) {
    float* tile = (float*)smem;
    const int tid = my_tid();
#pragma unroll
    for (int q = 0; q < 2; ++q) {
        const int kk = (tid >> 4) + q * 32, c4 = (tid & 15) * 4;
        const float4 v = *(const float4*)(W + (size_t)(kt * 64 + kk) * N + nt * 64 + c4);
        tile[kk * 65 + c4] = v.x; tile[kk * 65 + c4 + 1] = v.y; tile[kk * 65 + c4 + 2] = v.z; tile[kk * 65 + c4 + 3] = v.w;
    }
    __syncthreads();
    const int n = tid >> 3, kc = tid & 7;
    uint4 o;
    o.x = pack2(tile[(kc * 8 + 0) * 65 + n], tile[(kc * 8 + 1) * 65 + n]);
    o.y = pack2(tile[(kc * 8 + 2) * 65 + n], tile[(kc * 8 + 3) * 65 + n]);
    o.z = pack2(tile[(kc * 8 + 4) * 65 + n], tile[(kc * 8 + 5) * 65 + n]);
    o.w = pack2(tile[(kc * 8 + 6) * 65 + n], tile[(kc * 8 + 7) * 65 + n]);
    *(uint4*)(Wt + (size_t)(nt * 64 + n) * K + kt * 64 + kc * 8) = o;
    __syncthreads();
}
DI void cvt_bf16_stream(const float* __restrict__ src, bf16_t* __restrict__ dst, size_t n8, int bid, int nb) {
    for (size_t i = (size_t)bid * NTH + my_tid(); i < n8; i += (size_t)nb * NTH) {
        const float4 a = *(const float4*)(src + i * 8), b = *(const float4*)(src + i * 8 + 4);
        uint4 o; o.x = pack2(a.x, a.y); o.y = pack2(a.z, a.w); o.z = pack2(b.x, b.y); o.w = pack2(b.z, b.w);
        *(uint4*)(dst + i * 8) = o;
    }
}
DI void cvt_fp8_rows(const float* __restrict__ src, unsigned char* __restrict__ dst, float* __restrict__ inv, int bid, int nb) {
    const int lane = my_tid() & 63, wid = my_tid() >> 6;
    for (int row = bid * 8 + wid; row < NEXP; row += nb * 8) {
        const float* sp = src + (size_t)row * DM + lane * 16;
        const f32x4 a = *(const f32x4*)sp, b = *(const f32x4*)(sp + 4), c = *(const f32x4*)(sp + 8), d = *(const f32x4*)(sp + 12);
        float m = fmaxf(fmaxf(fmaxf(fabsf(a.x), fabsf(a.y)), fmaxf(fabsf(a.z), fabsf(a.w))), fmaxf(fmaxf(fabsf(b.x), fabsf(b.y)), fmaxf(fabsf(b.z), fabsf(b.w))));
        m = fmaxf(m, fmaxf(fmaxf(fmaxf(fabsf(c.x), fabsf(c.y)), fmaxf(fabsf(c.z), fabsf(c.w))), fmaxf(fmaxf(fabsf(d.x), fabsf(d.y)), fmaxf(fabsf(d.z), fabsf(d.w)))));
#pragma unroll
        for (int s = 1; s < 64; s <<= 1) m = fmaxf(m, __shfl_xor(m, s));
        float sc = 1.f, isc = 1.f;
        if (m > 1e-30f) {
            int k = (int)floorf(log2f(448.0f / m));
            k = k < -60 ? -60 : (k > 60 ? 60 : k);
            sc = ldexpf(1.0f, k); isc = ldexpf(1.0f, -k);
            if (m * sc > 448.0f) { sc *= 0.5f; isc *= 2.0f; }
        }
        u32x4 o;
        int w;
        w = __builtin_amdgcn_cvt_pk_fp8_f32(a.x * sc, a.y * sc, 0, false); w = __builtin_amdgcn_cvt_pk_fp8_f32(a.z * sc, a.w * sc, w, true); o.x = (unsigned)w;
        w = __builtin_amdgcn_cvt_pk_fp8_f32(b.x * sc, b.y * sc, 0, false); w = __builtin_amdgcn_cvt_pk_fp8_f32(b.z * sc, b.w * sc, w, true); o.y = (unsigned)w;
        w = __builtin_amdgcn_cvt_pk_fp8_f32(c.x * sc, c.y * sc, 0, false); w = __builtin_amdgcn_cvt_pk_fp8_f32(c.z * sc, c.w * sc, w, true); o.z = (unsigned)w;
        w = __builtin_amdgcn_cvt_pk_fp8_f32(d.x * sc, d.y * sc, 0, false); w = __builtin_amdgcn_cvt_pk_fp8_f32(d.z * sc, d.w * sc, w, true); o.w = (unsigned)w;
        *(u32x4*)(dst + (size_t)row * DM + lane * 16) = o;
        if (lane == 0) inv[row] = isc;
    }
}
DI void cvt_fp4_rows(const float* __restrict__ src, unsigned char* __restrict__ dst, float* __restrict__ inv, int bid, int nb) {
    const int lane = my_tid() & 63, wid = my_tid() >> 6;
    for (int row = bid * 8 + wid; row < NEXP; row += nb * 8) {
        const float* sp = src + (size_t)row * DM + lane * 16;
        const f32x4 a = *(const f32x4*)sp, b = *(const f32x4*)(sp + 4), c = *(const f32x4*)(sp + 8), d = *(const f32x4*)(sp + 12);
        float m = fmaxf(fmaxf(fmaxf(fabsf(a.x), fabsf(a.y)), fmaxf(fabsf(a.z), fabsf(a.w))), fmaxf(fmaxf(fabsf(b.x), fabsf(b.y)), fmaxf(fabsf(b.z), fabsf(b.w))));
        m = fmaxf(m, fmaxf(fmaxf(fmaxf(fabsf(c.x), fabsf(c.y)), fmaxf(fabsf(c.z), fabsf(c.w))), fmaxf(fmaxf(fabsf(d.x), fabsf(d.y)), fmaxf(fabsf(d.z), fabsf(d.w)))));
#pragma unroll
        for (int s = 1; s < 64; s <<= 1) m = fmaxf(m, __shfl_xor(m, s));
        const float sc = m > 1e-30f ? 6.0f / m : 1.0f, isc = m > 1e-30f ? m * (1.0f / 6.0f) : 1.0f;
        unsigned w0 = 0u, w1 = 0u;
        w0 = __builtin_amdgcn_cvt_scalef32_pk_fp4_f32(w0, a.x * sc, a.y * sc, 1.0f, 0); w0 = __builtin_amdgcn_cvt_scalef32_pk_fp4_f32(w0, a.z * sc, a.w * sc, 1.0f, 1);
        w0 = __builtin_amdgcn_cvt_scalef32_pk_fp4_f32(w0, b.x * sc, b.y * sc, 1.0f, 2); w0 = __builtin_amdgcn_cvt_scalef32_pk_fp4_f32(w0, b.z * sc, b.w * sc, 1.0f, 3);
        w1 = __builtin_amdgcn_cvt_scalef32_pk_fp4_f32(w1, c.x * sc, c.y * sc, 1.0f, 0); w1 = __builtin_amdgcn_cvt_scalef32_pk_fp4_f32(w1, c.z * sc, c.w * sc, 1.0f, 1);
        w1 = __builtin_amdgcn_cvt_scalef32_pk_fp4_f32(w1, d.x * sc, d.y * sc, 1.0f, 2); w1 = __builtin_amdgcn_cvt_scalef32_pk_fp4_f32(w1, d.z * sc, d.w * sc, 1.0f, 3);
        *(uint2*)(dst + (size_t)row * (DM / 2) + lane * 8) = make_uint2(w0, w1);
        if (lane == 0) inv[row] = isc;
    }
}
template <int OFFS>
DI void cvt_i8_rows(const float* __restrict__ src, unsigned char* __restrict__ dst, float* __restrict__ inv, int bid, int nb) {
    const int lane = my_tid() & 63, wid = my_tid() >> 6;
    for (int row = bid * 8 + wid; row < NEXP; row += nb * 8) {
        const float* sp = src + (size_t)row * DM + lane * 16;
        const f32x4 a = *(const f32x4*)sp, b = *(const f32x4*)(sp + 4), c = *(const f32x4*)(sp + 8), d = *(const f32x4*)(sp + 12);
        float m = fmaxf(fmaxf(fmaxf(fabsf(a.x), fabsf(a.y)), fmaxf(fabsf(a.z), fabsf(a.w))), fmaxf(fmaxf(fabsf(b.x), fabsf(b.y)), fmaxf(fabsf(b.z), fabsf(b.w))));
        m = fmaxf(m, fmaxf(fmaxf(fmaxf(fabsf(c.x), fabsf(c.y)), fmaxf(fabsf(c.z), fabsf(c.w))), fmaxf(fmaxf(fabsf(d.x), fabsf(d.y)), fmaxf(fabsf(d.z), fabsf(d.w)))));
#pragma unroll
        for (int s = 1; s < 64; s <<= 1) m = fmaxf(m, __shfl_xor(m, s));
        const float sc = m > 1e-30f ? 127.0f / m : 1.0f, isc = m > 1e-30f ? m * (1.0f / 127.0f) : 1.0f;
        const float v[16] = {a.x, a.y, a.z, a.w, b.x, b.y, b.z, b.w, c.x, c.y, c.z, c.w, d.x, d.y, d.z, d.w};
        unsigned w[4];
#pragma unroll
        for (int q = 0; q < 4; ++q) {
            unsigned pk = 0u;
#pragma unroll
            for (int e = 0; e < 4; ++e) { const int qi = (int)rintf(v[q * 4 + e] * sc) + OFFS; pk |= ((unsigned)qi & 0xffu) << (8 * e); }
            w[q] = pk;
        }
        *(u32x4*)(dst + (size_t)row * DM + lane * 16) = (u32x4){w[0], w[1], w[2], w[3]};
        if (lane == 0) inv[row] = isc;
    }
}
DI void prep_cab_item(const Params& p, int item, char* smem) {
    float* vT = (float*)smem;
    float* red = vT + DM * 16;
    const float* mod = (const float*)(p.ws + OFF_MOD);
    const int tid = my_tid(), ks = tid >> 5, col = tid & 31;
    const float* w = p.w_q + (size_t)(ks * 64) * 2048 + item * 32 + col;
#pragma unroll 1
    for (int which = 0; which < 2; ++which) {
        for (int i = tid; i < NB * DM; i += NTH) {
            const int b = i >> 10, k = i & 1023;
            const float sc = 1.0f + mod[b * 6144 + 4096 + k];
            const float v = which == 0 ? p.ln1w[k] * sc : p.ln1b[k] * sc + mod[b * 6144 + 3072 + k];
            vT[k * 16 + b] = v;
            if (item == 0) ((float*)(p.ws + OFF_AB))[(size_t)which * NB * DM + i] = v;
        }
        __syncthreads();
        float acc[16];
#pragma unroll
        for (int b = 0; b < 16; ++b) acc[b] = 0.f;
#pragma unroll 1
        for (int seg = 0; seg < 4; ++seg) {
            float wreg[16];
#pragma unroll
            for (int k = 0; k < 16; ++k) wreg[k] = w[(size_t)(seg * 16 + k) * 2048];
#pragma unroll
            for (int k = 0; k < 16; ++k) {
                const float wv = wreg[k];
                const f32x4* cb = (const f32x4*)(vT + (ks * 64 + seg * 16 + k) * 16);
                const f32x4 c0 = cb[0], c1 = cb[1], c2 = cb[2], c3 = cb[3];
                acc[0] += c0.x * wv; acc[1] += c0.y * wv; acc[2] += c0.z * wv; acc[3] += c0.w * wv;
                acc[4] += c1.x * wv; acc[5] += c1.y * wv; acc[6] += c1.z * wv; acc[7] += c1.w * wv;
                acc[8] += c2.x * wv; acc[9] += c2.y * wv; acc[10] += c2.z * wv; acc[11] += c2.w * wv;
                acc[12] += c3.x * wv; acc[13] += c3.y * wv; acc[14] += c3.z * wv; acc[15] += c3.w * wv;
            }
        }
#pragma unroll
        for (int b = 0; b < 16; ++b) red[(ks * 32 + col) * 16 + b] = acc[b];
        __syncthreads();
        {
            const int b = tid >> 5;
            float sum = 0.f;
#pragma unroll
            for (int q = 0; q < 16; ++q) sum += red[(q * 32 + col) * 16 + b];
            ((float*)(p.ws + OFF_CAB))[(size_t)which * NB * 2048 + b * 2048 + item * 32 + col] = sum;
        }
        __syncthreads();
    }
}
DI void phase_h(const Params& p, int bid, int nb) {
    const float* mod = (const float*)(p.ws + OFF_MOD);
    bf16_t* H = (bf16_t*)(p.ws + OFF_H);
    const size_t n8 = (size_t)NTOK * DM / 8;
    for (size_t i = (size_t)bid * NTH + my_tid(); i < n8; i += (size_t)nb * NTH) {
        const int row = (int)(i >> 7), c0 = (int)(i & 127) * 8, b = row / SEQ;
        const float* sh = mod + b * 6144 + c0;
        const float* sc = sh + 1024;
        const float4 a = *(const float4*)(p.x + i * 8), bq = *(const float4*)(p.x + i * 8 + 4);
        const float4 s0 = *(const float4*)sc, s1 = *(const float4*)(sc + 4), h0 = *(const float4*)sh, h1 = *(const float4*)(sh + 4);
        uint4 o;
        o.x = pack2(a.x * (1.f + s0.x) + h0.x, a.y * (1.f + s0.y) + h0.y);
        o.y = pack2(a.z * (1.f + s0.z) + h0.z, a.w * (1.f + s0.w) + h0.w);
        o.z = pack2(bq.x * (1.f + s1.x) + h1.x, bq.y * (1.f + s1.y) + h1.y);
        o.w = pack2(bq.z * (1.f + s1.z) + h1.z, bq.w * (1.f + s1.w) + h1.w);
        *(uint4*)(H + i * 8) = o;
    }
}

DI int wq_next(unsigned* ctr, char* smem) {
    volatile unsigned* slot = (volatile unsigned*)(smem + SMEM_BYTES - 8);
    __syncthreads();
    if (__builtin_amdgcn_workitem_id_x() == 0) *slot = __hip_atomic_fetch_add(ctr, 1u, __ATOMIC_RELAXED, __HIP_MEMORY_SCOPE_AGENT);
    __syncthreads();
    return (int)*slot;
}
DI void phase_prep_a(const Params& p, char* smem) {
    unsigned* ctr = (unsigned*)(p.ws + OFF_BAR) + 120;
    constexpr int U_S5 = 192, U_LB = 320, U_TR = 321, U_UT = U_TR + 368, U_VT = U_UT + 128, U_MISC = U_VT + 128, U_END = U_MISC + 8;
    for (int u = wq_next(ctr, smem); u < U_END; u = wq_next(ctr, smem)) {
        if (u < U_S5) prep_mod_item(p, u, smem);
        else if (u < U_LB) prep_s5_gemm_item(p, (u - U_S5) >> 2, (u - U_S5) & 3, smem);
        else if (u < U_TR) {
            const int j = my_tid();
            const float a0 = p.hg_lb[j], a1 = p.hg_lb[512 + j], m = fmaxf(a0, a1);
            const float e0 = expf(a0 - m), e1 = expf(a1 - m);
            ((float*)(p.ws + OFF_LB))[j] = e0 / (e0 + e1);
        } else if (u < U_UT) {
            for (int it = (u - U_TR) * 4; it < (u - U_TR) * 4 + 4; ++it) {
                constexpr int T_WIN = 16 * 40, T_GLU = 8 * 8, T_WOUT = 16 * 16;
                constexpr int I_GLU = T_WIN, I_WOUT = I_GLU + T_GLU, I_WQ = I_WOUT + T_WOUT;
                if (it < I_GLU) { const int t = it; prep_transpose_tile(p.w_in, (bf16_t*)(p.ws + OFF_WIN), DM, INC, t / 40, t % 40, smem); }
                else if (it < I_WOUT) { const int t = it - I_GLU; prep_transpose_tile(p.glu_w, (bf16_t*)(p.ws + OFF_GLU), 512, 512, t / 8, t % 8, smem); }
                else if (it < I_WQ) { const int t = it - I_WOUT; prep_transpose_tile(p.w_out, (bf16_t*)(p.ws + OFF_WOUT), DM, DM, t / 16, t % 16, smem); }
                else { const int t = it - I_WQ; prep_transpose_tile(p.w_q, (bf16_t*)(p.ws + OFF_WQ), DM, 2048, t / 32, t % 32, smem); }
            }
        } else if (u < U_VT) cvt_i8_rows<0>(p.pu, (unsigned char*)(p.ws + OFF_UT), (float*)(p.ws + OFF_SU), u - U_UT, 128);
        else if (u < U_MISC) cvt_i8_rows<128>(p.pv, (unsigned char*)(p.ws + OFF_VT), (float*)(p.ws + OFF_SV), u - U_VT, 128);
        else {
            const int q = u - U_MISC;
            cvt_bf16_stream(p.subk, (bf16_t*)(p.ws + OFF_SUBK), (size_t)16 * 128 * 128 / 8, q, 8);
            for (size_t i = (size_t)q * NTH + my_tid(); i < (size_t)NTOK * 2 / 4; i += (size_t)8 * NTH) ((f32x4*)(p.ws + OFF_STAT))[i] = (f32x4){0.f, 0.f, 0.f, 0.f};
        }
    }
}
DI void phase_prep_b(const Params& p, char* smem) {
    unsigned* ctr = (unsigned*)(p.ws + OFF_BAR) + 121;
    for (int u = wq_next(ctr, smem); u < 64 + 256; u = wq_next(ctr, smem)) {
        if (u < 64) prep_cab_item(p, u, smem); else phase_h(p, u - 64, 256);
    }
}

DI void phase_proj(const Params& p, int bid, int nb, char* smem) {
    pg8::Gemm g{(const bf16_t*)(p.ws + OFF_H), (const bf16_t*)(p.ws + OFF_WIN), NTOK, INC, DM};
    pg8::StaticOrder S; S.init(NTOK, INC, nb, bid);
    pg8::EpiBf16Act E{(bf16_t*)(p.ws + OFF_PROJ), INC, 0xC3u};
    pg8::gemm_phase<pg8::EpiBf16Act, pg8::StaticOrder, false>((PG8_LAS unsigned char*)smem, g, S, E, nullptr);
}

DI void hgrn_item(const Params& p, int item, char* smem) {
    const int vs = item & 7, hd = (item >> 3) & 3, b = item >> 5;
    const bf16_t* P = (const bf16_t*)(p.ws + OFF_PROJ);
    const float* lb = (const float*)(p.ws + OFF_LB) + hd * HDK;
    float* ORAW = (float*)(p.ws + OFF_ORAW);
    float* sq = (float*)smem;
    float* sf = sq + 32 * 128;
    float* sv = sf + 32 * 128;
    float* sp = sv + 32 * 16;
    const int tid = my_tid(), lane = tid & 63, wid = tid >> 6, kq = tid >> 4, v = tid & 15;
    float S0 = 0.f, S1 = 0.f, S2 = 0.f, S3 = 0.f;
    for (int t0 = 0; t0 < SEQ; t0 += 32) {
        for (int i = tid; i < 32 * 128; i += NTH) {
            const int t = i >> 7, k = i & 127;
            const bf16_t* row = P + (size_t)(b * SEQ + t0 + t) * INC + hd * HDK + k;
            sq[i] = bf2f(row[0]);
            const float l = lb[k];
            sf[i] = l + (1.0f - l) * sigmoidf_(bf2f(row[512]));
        }
        { const int t = tid >> 4; sv[tid] = bf2f(P[(size_t)(b * SEQ + t0 + t) * INC + 1024 + hd * HDK + vs * 16 + v]); }
        __syncthreads();
        for (int t = 0; t < 32; ++t) {
            const float4 f4 = *(const float4*)(sf + t * 128 + kq * 4), q4 = *(const float4*)(sq + t * 128 + kq * 4);
            const float vv = sv[t * 16 + v];
            S0 = f4.x * S0 + (1.0f - f4.x) * vv; S1 = f4.y * S1 + (1.0f - f4.y) * vv;
            S2 = f4.z * S2 + (1.0f - f4.z) * vv; S3 = f4.w * S3 + (1.0f - f4.w) * vv;
            float part = q4.x * S0 + q4.y * S1 + q4.z * S2 + q4.w * S3;
            part += __shfl_xor(part, 16); part += __shfl_xor(part, 32);
            if (lane < 16) sp[(t * 8 + wid) * 16 + v] = part;
        }
        __syncthreads();
        {
            const int t = tid >> 4;
            float o = 0.f;
#pragma unroll
            for (int w = 0; w < 8; ++w) o += sp[(t * 8 + w) * 16 + v];
            ORAW[(size_t)(b * SEQ + t0 + t) * DHG + hd * HDK + vs * 16 + v] = o;
        }
        __syncthreads();
    }
}
DI void s5_item(const Params& p, int item, char* smem) {
    const int oct = item & 3, b = item >> 2;
    const int tid = my_tid(), lane = tid & 63, wid = tid >> 6, g = oct * 8 + wid;
    const bf16_t* P = (const bf16_t*)(p.ws + OFF_PROJ);
    bf16_t* Y = (bf16_t*)(p.ws + OFF_YSSM);
    float* su = (float*)smem + wid * 64 * 16;
    const float* lam = (const float*)(p.ws + OFF_LAM) + (g * SSP + lane) * 2;
    const float lr = lam[0], li = lam[1];
    const float* bb = (const float*)(p.ws + OFF_BB) + (size_t)(g * SSP + lane) * 32;
    float bbr[16], bbi[16], cr[16], ci[16];
#pragma unroll
    for (int i = 0; i < 16; ++i) { bbr[i] = bb[2 * i]; bbi[i] = bb[2 * i + 1]; cr[i] = p.c_re[(g * SSC + i) * SSP + lane]; ci[i] = p.c_im[(g * SSC + i) * SSP + lane]; }
    const int ch = (lane >> 2) & 15;
    const float dch = p.dsk[g * SSC + ch];
    float xr = 0.f, xi = 0.f;
    for (int t0 = 0; t0 < SEQ; t0 += 64) {
        {
            const uint4* src = (const uint4*)(P + (size_t)(b * SEQ + t0 + lane) * INC + 2048 + g * SSC);
            const uint4 a = src[0], c = src[1];
            float* d = su + lane * 16;
            d[0] = bflo(a.x); d[1] = bfhi(a.x); d[2] = bflo(a.y); d[3] = bfhi(a.y); d[4] = bflo(a.z); d[5] = bfhi(a.z); d[6] = bflo(a.w); d[7] = bfhi(a.w);
            d[8] = bflo(c.x); d[9] = bfhi(c.x); d[10] = bflo(c.y); d[11] = bfhi(c.y); d[12] = bflo(c.z); d[13] = bfhi(c.z); d[14] = bflo(c.w); d[15] = bfhi(c.w);
        }
        __syncthreads();
        for (int t = 0; t < 64; ++t) {
            float u[16];
            const float4* us = (const float4*)(su + t * 16);
            const float4 u0 = us[0], u1 = us[1], u2 = us[2], u3 = us[3];
            u[0] = u0.x; u[1] = u0.y; u[2] = u0.z; u[3] = u0.w; u[4] = u1.x; u[5] = u1.y; u[6] = u1.z; u[7] = u1.w;
            u[8] = u2.x; u[9] = u2.y; u[10] = u2.z; u[11] = u2.w; u[12] = u3.x; u[13] = u3.y; u[14] = u3.z; u[15] = u3.w;
            float bur = 0.f, bui = 0.f;
#pragma unroll
            for (int i = 0; i < 16; ++i) { bur += bbr[i] * u[i]; bui += bbi[i] * u[i]; }
            const float nxr = lr * xr - li * xi + bur, nxi = lr * xi + li * xr + bui;
            xr = nxr; xi = nxi;
            float y[16];
#pragma unroll
            for (int i = 0; i < 16; ++i) y[i] = cr[i] * xr - ci[i] * xi;
            const bool b5 = lane & 32, b4 = lane & 16, b3 = lane & 8, b2 = lane & 4;
            float y8[8], y4[4], y2[2];
#pragma unroll
            for (int j = 0; j < 8; ++j) { const float keep = b5 ? y[8 + j] : y[j], send = b5 ? y[j] : y[8 + j]; y8[j] = keep + __shfl_xor(send, 32); }
#pragma unroll
            for (int j = 0; j < 4; ++j) { const float keep = b4 ? y8[4 + j] : y8[j], send = b4 ? y8[j] : y8[4 + j]; y4[j] = keep + __shfl_xor(send, 16); }
#pragma unroll
            for (int j = 0; j < 2; ++j) { const float keep = b3 ? y4[2 + j] : y4[j], send = b3 ? y4[j] : y4[2 + j]; y2[j] = keep + __shfl_xor(send, 8); }
            float y1;
            { const float keep = b2 ? y2[1] : y2[0], send = b2 ? y2[0] : y2[1]; y1 = keep + __shfl_xor(send, 4); }
            y1 += __shfl_xor(y1, 1); y1 += __shfl_xor(y1, 2);
            if ((lane & 3) == 0) {
                const float uu = su[t * 16 + ch];
                Y[(size_t)(b * SEQ + t0 + t) * DSS + g * SSC + ch] = f2bf(geluf_(y1 + dch * uu));
            }
        }
        __syncthreads();
    }
}
DI int crow(int i, int h) { return (i & 3) + 8 * (i >> 2) + 4 * h; }
DI void phase_hgprep(const Params& p, int bid, int nb) {
    const bf16_t* P = (const bf16_t*)(p.ws + OFF_PROJ);
    const float* lbp = (const float*)(p.ws + OFF_LB);
    const int tid = my_tid(), lane = tid & 63, wid = tid >> 6, tq = lane >> 4, cg = lane & 15;
#pragma unroll 1
    for (int it = bid * 8 + wid; it < 8192; it += nb * 8) {
        const int tile = it >> 1, c = tile & 63, hd = (tile >> 6) & 3, b = tile >> 8, k0 = (it & 1) * 64 + cg * 4;
        const bf16_t* base = P + (size_t)(b * SEQ + c * 32 + tq * 8) * INC + hd * HDK + k0;
        uint2 qw[8], fw[8];
#pragma unroll
        for (int tt = 0; tt < 8; ++tt) { qw[tt] = *(const uint2*)(base + (size_t)tt * INC); fw[tt] = *(const uint2*)(base + (size_t)tt * INC + 512); }
        const f32x4 l4 = *(const f32x4*)(lbp + hd * HDK + k0);
        const float lb4[4] = {l4.x, l4.y, l4.z, l4.w};
        float bl[8][4], kk[8][4], run[4];
#pragma unroll
        for (int e = 0; e < 4; ++e) run[e] = 0.f;
#pragma unroll
        for (int tt = 0; tt < 8; ++tt) {
            const float fl[4] = {bflo(fw[tt].x), bfhi(fw[tt].x), bflo(fw[tt].y), bfhi(fw[tt].y)};
#pragma unroll
            for (int e = 0; e < 4; ++e) {
                const float f = lb4[e] + (1.0f - lb4[e]) * sigmoidf_(fl[e]);
                run[e] += __logf(f); bl[tt][e] = run[e]; kk[tt][e] = 1.0f - f;
            }
        }
        float off[4], tot[4];
#pragma unroll
        for (int e = 0; e < 4; ++e) {
            const float t0 = __shfl(run[e], cg), t1 = __shfl(run[e], cg + 16), t2 = __shfl(run[e], cg + 32), t3 = __shfl(run[e], cg + 48);
            off[e] = (tq > 0 ? t0 : 0.f) + (tq > 1 ? t1 : 0.f) + (tq > 2 ? t2 : 0.f);
            tot[e] = (t0 + t1) + (t2 + t3);
        }
        bf16_t* HQ = (bf16_t*)(p.ws + OFF_HQ) + (size_t)tile * 4096 + (tq * 8) * 128 + k0;
        bf16_t* HK = (bf16_t*)(p.ws + OFF_HK) + (size_t)tile * 4096 + (tq * 8) * 128 + k0;
#pragma unroll
        for (int tt = 0; tt < 8; ++tt) {
            const float qv[4] = {bflo(qw[tt].x), bfhi(qw[tt].x), bflo(qw[tt].y), bfhi(qw[tt].y)};
            float qo[4], ko[4];
#pragma unroll
            for (int e = 0; e < 4; ++e) { const float bb = off[e] + bl[tt][e]; qo[e] = qv[e] * __expf(bb); ko[e] = kk[tt][e] * __expf(fminf(-bb, 80.0f)); }
            *(uint2*)(HQ + tt * 128) = make_uint2(pack2(qo[0], qo[1]), pack2(qo[2], qo[3]));
            *(uint2*)(HK + tt * 128) = make_uint2(pack2(ko[0], ko[1]), pack2(ko[2], ko[3]));
        }
        if (tq == 0) *(f32x4*)((float*)(p.ws + OFF_HG) + (size_t)tile * 128 + k0) = (f32x4){__expf(tot[0]), __expf(tot[1]), __expf(tot[2]), __expf(tot[3])};
    }
}
typedef short s16x4 __attribute__((ext_vector_type(4)));
DI bf16x8 cat8(const s16x4 lo, const s16x4 hi) { return (bf16x8){lo.x, lo.y, lo.z, lo.w, hi.x, hi.y, hi.z, hi.w}; }
DI s16x4 lds_tr(const char* a) { return __builtin_amdgcn_ds_read_tr16_b64_v4i16((__attribute__((address_space(3))) s16x4*)a); }
DI void hgrn_mfma_item(const Params& p, int item, char* smem) {
    constexpr int QP_OFF = 0, KP_OFF = 8704, V_OFF = 17408, G_OFF = 26112, BUF = 26624;
    const int tid = my_tid(), lane = tid & 63, wid = tid >> 6, r = lane & 31, h = lane >> 5;
    const int b = item >> 2, hd = item & 3;
    const size_t tile0 = (size_t)item * 64;
    const bf16_t* HQ = (const bf16_t*)(p.ws + OFF_HQ) + tile0 * 4096;
    const bf16_t* HK = (const bf16_t*)(p.ws + OFF_HK) + tile0 * 4096;
    const bf16_t* PV = (const bf16_t*)(p.ws + OFF_PROJ) + (size_t)b * SEQ * INC + 1024 + hd * HDK;
    const float* HG = (const float*)(p.ws + OFF_HG) + tile0 * 128;
    float* ORAW = (float*)(p.ws + OFF_ORAW) + (size_t)b * SEQ * DHG + hd * HDK;
    const bool helper = wid >= 4;
    const int ht = tid - 256;
    const int i0 = ht, i1 = ht + 256;
    const int lo0 = (i0 >> 4) * 272 + (i0 & 15) * 16, lo1 = (i1 >> 4) * 272 + (i1 & 15) * 16;
    u32x4 A0, A1, A2, A3, A4, A5, A6, B0, B1, B2, B3, B4, B5, B6;
    A0 = A1 = A2 = A3 = A4 = A5 = A6 = B0 = B1 = B2 = B3 = B4 = B5 = B6 = (u32x4){0, 0, 0, 0};
    f32x16 S[4];
#pragma unroll
    for (int kb = 0; kb < 4; ++kb)
#pragma unroll
        for (int i = 0; i < 16; ++i) S[kb][i] = 0.f;
#define HG_LOAD(X, c_) { const size_t o_ = (size_t)(c_) * 4096; \
        X##0 = *(const u32x4*)(HQ + o_ + i0 * 8); X##1 = *(const u32x4*)(HQ + o_ + i1 * 8); \
        X##2 = *(const u32x4*)(HK + o_ + i0 * 8); X##3 = *(const u32x4*)(HK + o_ + i1 * 8); \
        X##4 = *(const u32x4*)(PV + (size_t)((c_) * 32 + (i0 >> 4)) * INC + (i0 & 15) * 8); X##5 = *(const u32x4*)(PV + (size_t)((c_) * 32 + (i1 >> 4)) * INC + (i1 & 15) * 8); \
        if (ht < 32) X##6 = *(const u32x4*)(HG + (size_t)(c_) * 128 + ht * 4); }
#define HG_STORE(X, buf_) { char* B_ = smem + (buf_) * BUF; \
        *(u32x4*)(B_ + QP_OFF + lo0) = X##0; *(u32x4*)(B_ + QP_OFF + lo1) = X##1; \
        *(u32x4*)(B_ + KP_OFF + lo0) = X##2; *(u32x4*)(B_ + KP_OFF + lo1) = X##3; \
        *(u32x4*)(B_ + V_OFF + lo0) = X##4; *(u32x4*)(B_ + V_OFF + lo1) = X##5; \
        if (ht < 32) *(u32x4*)(B_ + G_OFF + ht * 16) = X##6; }
    const int tq = (lane >> 2) & 3, tp = lane & 3, tg = lane >> 4;
    const int tr_nat = (8 * (tg >> 1) + tq) * 272 + (16 * (tg & 1) + 4 * tp) * 2;
    const int tr_krw = (4 * (tg >> 1) + tq) * 272 + (16 * (tg & 1) + 4 * tp) * 2;
    if (helper) { HG_LOAD(A, 0); HG_STORE(A, 0); HG_LOAD(A, 1); HG_STORE(A, 1); HG_LOAD(A, 2); HG_LOAD(B, 3); }
    __syncthreads();
#define HG_COMPUTE(c_) { \
        const char* B = smem + ((c_) % 3) * BUF; const int w = wid; \
        f32x16 pt; _Pragma("unroll") for (int i = 0; i < 16; ++i) pt[i] = 0.f; \
        _Pragma("unroll") for (int ks = 0; ks < 8; ++ks) { \
            const bf16x8 a = *(const bf16x8*)(B + KP_OFF + r * 272 + ks * 32 + h * 16); \
            const bf16x8 bq = *(const bf16x8*)(B + QP_OFF + r * 272 + ks * 32 + h * 16); \
            pt = __builtin_amdgcn_mfma_f32_32x32x16_bf16(a, bq, pt, 0, 0, 0); } \
        _Pragma("unroll") for (int i = 0; i < 16; ++i) if (crow(i, h) > r) pt[i] = 0.f; \
        f32x16 o; _Pragma("unroll") for (int i = 0; i < 16; ++i) o[i] = 0.f; \
        _Pragma("unroll") for (int sp = 0; sp < 2; ++sp) { \
            const char* vb = B + V_OFF + (16 * sp) * 272 + (32 * w) * 2 + tr_krw; \
            const bf16x8 bv = cat8(lds_tr(vb), lds_tr(vb + 8 * 272)); \
            o = __builtin_amdgcn_mfma_f32_32x32x16_bf16(pack8(pt, 8 * sp), bv, o, 0, 0, 0); } \
        _Pragma("unroll") for (int kb = 0; kb < 4; ++kb) _Pragma("unroll") for (int sp = 0; sp < 2; ++sp) { \
            const char* qb = B + QP_OFF + r * 272 + kb * 64 + sp * 32 + h * 8; \
            const bf16x8 aq = cat8(*(const s16x4*)qb, *(const s16x4*)(qb + 16)); \
            o = __builtin_amdgcn_mfma_f32_32x32x16_bf16(aq, pack8(S[kb], 8 * sp), o, 0, 0, 0); } \
        _Pragma("unroll") for (int i = 0; i < 16; ++i) ORAW[(size_t)((c_) * 32 + crow(i, h)) * DHG + 32 * w + r] = o[i]; \
        bf16x8 bvn[2]; \
        _Pragma("unroll") for (int ks = 0; ks < 2; ++ks) { const char* vb = B + V_OFF + (16 * ks) * 272 + (32 * w) * 2 + tr_nat; bvn[ks] = cat8(lds_tr(vb), lds_tr(vb + 4 * 272)); } \
        _Pragma("unroll") for (int kb = 0; kb < 4; ++kb) { \
            _Pragma("unroll") for (int ks = 0; ks < 2; ++ks) { \
                const char* kp = B + KP_OFF + (16 * ks) * 272 + (32 * kb) * 2 + tr_nat; \
                const bf16x8 a = cat8(lds_tr(kp), lds_tr(kp + 4 * 272)); \
                S[kb] = __builtin_amdgcn_mfma_f32_32x32x16_bf16(a, bvn[ks], S[kb], 0, 0, 0); } \
            _Pragma("unroll") for (int j = 0; j < 4; ++j) { \
                const f32x4 g4 = *(const f32x4*)(B + G_OFF + (kb * 32 + 8 * j + 4 * h) * 4); \
                S[kb][4 * j] *= g4.x; S[kb][4 * j + 1] *= g4.y; S[kb][4 * j + 2] *= g4.z; S[kb][4 * j + 3] *= g4.w; } } }
    for (int c = 0; c < 64; c += 2) {
        if (helper) { if (c + 2 < 64) HG_STORE(A, (c + 2) % 3); if (c + 4 < 64) HG_LOAD(A, c + 4); } else HG_COMPUTE(c);
        __syncthreads();
        if (helper) { if (c + 3 < 64) HG_STORE(B, (c + 3) % 3); if (c + 5 < 64) HG_LOAD(B, c + 5); } else HG_COMPUTE(c + 1);
        __syncthreads();
    }
#undef HG_LOAD
#undef HG_STORE
#undef HG_COMPUTE
}
template <int NJ>
DI void s5_gemm2_tile(const bf16x8 (&af)[16], const bf16_t* KTl, const bf16_t* Xin, const bf16_t* MBg, bf16_t* Yout, bf16_t* stg, const int mi, const int r, const int h) {
    f32x16 y;
#pragma unroll
    for (int i = 0; i < 16; ++i) y[i] = 0.f;
    const int tsel = r >> 4, iq = r & 15;
    bf16x8 bm[8];
#pragma unroll
    for (int ks = 0; ks < 8; ++ks) bm[ks] = *(const bf16x8*)(MBg + (size_t)((NJ * 8 + ks) * 64 + h * 32 + r) * 8);
#pragma unroll
    for (int ks = 0; ks <= 2 * NJ; ++ks) {
        const bf16x8 bk = *(const bf16x8*)(KTl + ((2 * NJ + tsel - ks) * 16 + iq) * 16 + 8 * h);
        y = __builtin_amdgcn_mfma_f32_32x32x16_bf16(af[ks], bk, y, 0, 0, 0);
    }
    {
        bf16x8 bk = *(const bf16x8*)(KTl + iq * 16 + 8 * h);
        if (tsel == 0) bk = (bf16x8){0, 0, 0, 0, 0, 0, 0, 0};
        y = __builtin_amdgcn_mfma_f32_32x32x16_bf16(af[2 * NJ + 1], bk, y, 0, 0, 0);
    }
#pragma unroll
    for (int ks = 0; ks < 8; ++ks) {
        const bf16x8 a = *(const bf16x8*)(Xin + (mi * 32 + r) * 136 + ks * 16 + 8 * h);
        y = __builtin_amdgcn_mfma_f32_32x32x16_bf16(a, bm[ks], y, 0, 0, 0);
    }
#pragma unroll
    for (int i = 0; i < 16; ++i) stg[((crow(i, h) * 2 + tsel) * 16) + iq] = f2bf(gelu_as(y[i]));
    {
        const int lane = h * 32 + r, cl = lane >> 1, ts = lane & 1;
        const u32x4 lo = *(const u32x4*)(stg + lane * 16), hi = *(const u32x4*)(stg + lane * 16 + 8);
        bf16_t* dst = Yout + (size_t)((mi * 32 + cl) * 16 + 2 * NJ + ts) * DSS;
        *(u32x4*)dst = lo; *(u32x4*)(dst + 8) = hi;
    }
}
DI void s5_gemm_item(const Params& p, int b, int g, char* smem) {
    float* E = (float*)smem;
    bf16_t* Xin = (bf16_t*)(smem + 128 * 132 * 4);
    bf16_t* KTl = Xin + 128 * 136;
    const int tid = my_tid(), lane = tid & 63, wid = tid >> 6, r = lane & 31, h = lane >> 5;
    const int mi = wid >> 1, wh = wid & 1;
    const bf16_t* P = (const bf16_t*)(p.ws + OFF_PROJ);
    *(u32x4*)(KTl + tid * 8) = *(const u32x4*)((const bf16_t*)(p.ws + OFF_S5K) + (size_t)g * 4096 + tid * 8);
    bf16x8 af[16];
    {
        const bf16_t* ub = P + (size_t)(b * SEQ + (mi * 32 + r) * 16) * INC + 2048 + g * 16 + 8 * h;
#pragma unroll
        for (int ks = 0; ks < 16; ++ks) af[ks] = *(const bf16x8*)(ub + (size_t)ks * INC);
    }
#ifndef S5_REP_G1
#define S5_REP_G1 1
#define S5_REP_SC 1
#define S5_REP_G2 1
#endif
    for (int rp1 = 0; rp1 < S5_REP_G1; ++rp1)
    {
        f32x16 e0, e1;
#pragma unroll
        for (int i = 0; i < 16; ++i) { e0[i] = 0.f; e1[i] = 0.f; }
        const bf16_t* nb0 = (const bf16_t*)(p.ws + OFF_S5N) + (size_t)g * 128 * 256 + (size_t)(wh * 2) * 16 * 512 + lane * 8;
#pragma unroll
        for (int ks = 0; ks < 16; ++ks) {
            const bf16x8 b0 = *(const bf16x8*)(nb0 + ks * 512), b1 = *(const bf16x8*)(nb0 + 16 * 512 + ks * 512);
            e0 = __builtin_amdgcn_mfma_f32_32x32x16_bf16(af[ks], b0, e0, 0, 0, 0);
            e1 = __builtin_amdgcn_mfma_f32_32x32x16_bf16(af[ks], b1, e1, 0, 0, 0);
        }
#pragma unroll
        for (int i = 0; i < 16; ++i) { float* er = E + (mi * 32 + crow(i, h)) * 132 + wh * 64 + r; er[0] = e0[i]; er[32] = e1[i]; }
    }
    __syncthreads();
    for (int rp2 = 0; rp2 < S5_REP_SC; ++rp2)
    if (wid == 0) {
        const float* L = (const float*)(p.ws + OFF_S5L) + (g * 64 + lane) * 2;
        const float lr = L[0], li = L[1];
        float xr = 0.f, xi = 0.f;
#pragma unroll 8
        for (int c = 0; c < 128; ++c) {
            const float er = E[c * 132 + lane], ei = E[c * 132 + 64 + lane];
            Xin[c * 136 + lane] = f2bf(xr); Xin[c * 136 + 64 + lane] = f2bf(xi);
            const float nr = lr * xr - li * xi + er, ni = lr * xi + li * xr + ei;
            xr = nr; xi = ni;
        }
    }
    __syncthreads();
    const bf16_t* MBg = (const bf16_t*)(p.ws + OFF_S5M) + (size_t)g * 256 * 128;
    bf16_t* Yout = (bf16_t*)(p.ws + OFF_YSSM) + (size_t)b * SEQ * DSS + g * 16;
    bf16_t* stg = (bf16_t*)smem + wid * 1024;
    for (int rp3 = 0; rp3 < S5_REP_G2; ++rp3)
    if (wh) {
        s5_gemm2_tile<1>(af, KTl, Xin, MBg, Yout, stg, mi, r, h); s5_gemm2_tile<6>(af, KTl, Xin, MBg, Yout, stg, mi, r, h);
        s5_gemm2_tile<3>(af, KTl, Xin, MBg, Yout, stg, mi, r, h); s5_gemm2_tile<4>(af, KTl, Xin, MBg, Yout, stg, mi, r, h);
    } else {
        s5_gemm2_tile<0>(af, KTl, Xin, MBg, Yout, stg, mi, r, h); s5_gemm2_tile<7>(af, KTl, Xin, MBg, Yout, stg, mi, r, h);
        s5_gemm2_tile<2>(af, KTl, Xin, MBg, Yout, stg, mi, r, h); s5_gemm2_tile<5>(af, KTl, Xin, MBg, Yout, stg, mi, r, h);
    }
    __syncthreads();
}
DI void phase_mix(const Params& p, int bid, int nb, char* smem) {
    if (nb == 256) {
#ifndef PROBE_HGX
#define PROBE_HGX 1
#endif
        if (bid < 64) { for (int rep = 0; rep < PROBE_HGX; ++rep) hgrn_mfma_item(p, bid, smem); return; }
        const int j = bid - 64, x = j & 7, lb = j >> 3;
#ifndef PROBE_S5X
#define PROBE_S5X 1
#endif
        for (int rep = 0; rep < PROBE_S5X; ++rep)
        for (int q = lb; q < 64; q += 24) s5_gemm_item(p, q & 15, x * 4 + (q >> 4), smem);
    } else {
        for (int it = bid; it < 64; it += nb) hgrn_mfma_item(p, it, smem);
        for (int q = bid; q < 512; q += nb) s5_gemm_item(p, q & 15, q >> 4, smem);
    }
}

DI void phase_glu(const Params& p, int bid, int nb, char* smem) {
    pg8::Gemm g{(const bf16_t*)(p.ws + OFF_YSSM), (const bf16_t*)(p.ws + OFF_GLU), NTOK, 512, 512};
    pg8::StaticOrder S; S.init(NTOK, 512, nb, bid);
    pg8::EpiGlu E{(float*)(p.ws + OFF_H), (const bf16_t*)(p.ws + OFF_YSSM), p.glu_b};
    pg8::gemm_phase<pg8::EpiGlu, pg8::StaticOrder, false>((PG8_LAS unsigned char*)smem, g, S, E, nullptr);
}
DI void phase_a2(const Params& p, int bid, int nb) {
    const float* ORAW = (const float*)(p.ws + OFF_ORAW);
    const float* Y2 = (const float*)(p.ws + OFF_H);
    const bf16_t* P = (const bf16_t*)(p.ws + OFF_PROJ);
    bf16_t* A2 = (bf16_t*)(p.ws + OFF_A2);
    const int lane = my_tid() & 63, wid = my_tid() >> 6;
    for (int tok = bid * 8 + wid; tok < NTOK; tok += nb * 8) {
        const int c0 = lane * 8;
        {
            const float4 a = *(const float4*)(ORAW + (size_t)tok * DHG + c0), b = *(const float4*)(ORAW + (size_t)tok * DHG + c0 + 4);
            float ss = a.x * a.x + a.y * a.y + a.z * a.z + a.w * a.w + b.x * b.x + b.y * b.y + b.z * b.z + b.w * b.w;
            ss += __shfl_xor(ss, 1); ss += __shfl_xor(ss, 2); ss += __shfl_xor(ss, 4); ss += __shfl_xor(ss, 8);
            const float rs = rsqrtf(ss * (1.0f / 128.0f) + RMS_EPS);
            const uint4 gq = *(const uint4*)(P + (size_t)tok * INC + 1536 + c0);
            const float4 w0 = *(const float4*)(p.hg_nw + c0), w1 = *(const float4*)(p.hg_nw + c0 + 4);
            uint4 o;
            o.x = pack2(a.x * rs * w0.x * bflo(gq.x), a.y * rs * w0.y * bfhi(gq.x));
            o.y = pack2(a.z * rs * w0.z * bflo(gq.y), a.w * rs * w0.w * bfhi(gq.y));
            o.z = pack2(b.x * rs * w1.x * bflo(gq.z), b.y * rs * w1.y * bfhi(gq.z));
            o.w = pack2(b.z * rs * w1.z * bflo(gq.w), b.w * rs * w1.w * bfhi(gq.w));
            *(uint4*)(A2 + (size_t)tok * DM + c0) = o;
        }
        {
            const float4 a = *(const float4*)(Y2 + (size_t)tok * DSS + c0), b = *(const float4*)(Y2 + (size_t)tok * DSS + c0 + 4);
            float ss = a.x * a.x + a.y * a.y + a.z * a.z + a.w * a.w + b.x * b.x + b.y * b.y + b.z * b.z + b.w * b.w;
#pragma unroll
            for (int m = 1; m < 64; m <<= 1) ss += __shfl_xor(ss, m);
            const float rs = rsqrtf(ss * (1.0f / 512.0f) + RMS_EPS);
            const float4 w0 = *(const float4*)(p.ssm_nw + c0), w1 = *(const float4*)(p.ssm_nw + c0 + 4);
            uint4 o;
            o.x = pack2(a.x * rs * w0.x, a.y * rs * w0.y); o.y = pack2(a.z * rs * w0.z, a.w * rs * w0.w);
            o.z = pack2(b.x * rs * w1.x, b.y * rs * w1.y); o.w = pack2(b.z * rs * w1.z, b.w * rs * w1.w);
            *(uint4*)(A2 + (size_t)tok * DM + 512 + c0) = o;
        }
    }
}

DI void phase_outproj(const Params& p, int bid, int nb, char* smem) {
    pg8::Gemm g{(const bf16_t*)(p.ws + OFF_A2), (const bf16_t*)(p.ws + OFF_WOUT), NTOK, DM, DM};
    pg8::StaticOrder S; S.init(NTOK, DM, nb, bid);
    pg8::EpiResid E{p.out, p.x, (const float*)(p.ws + OFF_MOD) + 2048, DEEP_ALPHA, (bf16_t*)(p.ws + OFF_H), (const float*)(p.ws + OFF_AB), (float*)(p.ws + OFF_STAT)};
    pg8::gemm_phase<pg8::EpiResid, pg8::StaticOrder, false>((PG8_LAS unsigned char*)smem, g, S, E, nullptr);
}
DI void phase_ln1(const Params& p, int bid, int nb) {
    const float* mod = (const float*)(p.ws + OFF_MOD);
    bf16_t* H2 = (bf16_t*)(p.ws + OFF_H);
    const int lane = my_tid() & 63, wid = my_tid() >> 6;
    for (int tok = bid * 8 + wid; tok < NTOK; tok += nb * 8) {
        const int b = tok / SEQ;
        float* row = p.out + (size_t)tok * DM;
        float4 v[4];
        float s = 0.f;
#pragma unroll
        for (int j = 0; j < 4; ++j) { v[j] = *(const float4*)(row + j * 256 + lane * 4); s += v[j].x + v[j].y + v[j].z + v[j].w; }
#pragma unroll
        for (int m = 1; m < 64; m <<= 1) s += __shfl_xor(s, m);
        const float mu = s * (1.0f / 1024.0f);
        float q = 0.f;
#pragma unroll
        for (int j = 0; j < 4; ++j) { const float a = v[j].x - mu, bb = v[j].y - mu, cc = v[j].z - mu, d = v[j].w - mu; q += a * a + bb * bb + cc * cc + d * d; }
#pragma unroll
        for (int m = 1; m < 64; m <<= 1) q += __shfl_xor(q, m);
        const float rstd = rsqrtf(q * (1.0f / 1024.0f) + LN_EPS);
        const float* sh2 = mod + b * 6144 + 3072;
        const float* sc2 = mod + b * 6144 + 4096;
#pragma unroll
        for (int j = 0; j < 4; ++j) {
            const int c = j * 256 + lane * 4;
            const float4 w = *(const float4*)(p.ln1w + c), bi = *(const float4*)(p.ln1b + c), sc = *(const float4*)(sc2 + c), sh = *(const float4*)(sh2 + c);
            float4 o;
            o.x = (v[j].x - mu) * rstd * w.x + bi.x; o.y = (v[j].y - mu) * rstd * w.y + bi.y; o.z = (v[j].z - mu) * rstd * w.z + bi.z; o.w = (v[j].w - mu) * rstd * w.w + bi.w;
            *(float4*)(row + c) = o;
            uint2 hh; hh.x = pack2(o.x * (1.f + sc.x) + sh.x, o.y * (1.f + sc.y) + sh.y); hh.y = pack2(o.z * (1.f + sc.z) + sh.z, o.w * (1.f + sc.w) + sh.w);
            *(uint2*)(H2 + (size_t)tok * DM + c) = hh;
        }
    }
}

DI void phase_q(const Params& p, int bid, int nb, char* smem) {
    pg8::Gemm g{(const bf16_t*)(p.ws + OFF_H), (const bf16_t*)(p.ws + OFF_WQ), NTOK, 2048, DM};
    pg8::StaticOrder S; S.init(NTOK, 2048, nb, bid);
    pg8::EpiQLN E{(bf16_t*)(p.ws + OFF_PROJ), (const float*)(p.ws + OFF_STAT), (const float*)(p.ws + OFF_CAB), (const float*)(p.ws + OFF_CAB) + NB * 2048, LN_EPS};
    pg8::gemm_phase<pg8::EpiQLN, pg8::StaticOrder, false>((PG8_LAS unsigned char*)smem, g, S, E, nullptr);
}
DI void phase_topk(const Params& p, int bid, int nb, char* smem) {
    const bf16_t* Q = (const bf16_t*)(p.ws + OFF_PROJ);
    const bf16_t* SK = (const bf16_t*)(p.ws + OFF_SUBK);
    unsigned* TOPL = (unsigned*)(p.ws + OFF_TOPL);
    float* sc = (float*)(smem + 36864);
    constexpr int NTM = NTOK / 128;
    for (int t = bid; t < NTM * 16; t += nb) {
        const int mt = t >> 4, hp = t & 15;
        gemm_block<2, 1, 2, 4>(Q + (size_t)mt * 128 * 2048 + hp * 128, 2048, SK + (size_t)hp * 128 * 128, 128, 128, smem,
                               [&](int r, int c, float v) { sc[r * 129 + c] = v; });
        __syncthreads();
        if (my_tid() < 128) {
            const int r = my_tid();
            float tk[16];
#pragma unroll
            for (int j = 0; j < 16; ++j) tk[j] = -3.0e38f;
            for (int n = 0; n < 128; ++n) {
                float xv = __uint_as_float((__float_as_uint(sc[r * 129 + n]) & ~0x7fu) | (unsigned)n);
#pragma unroll
                for (int j = 0; j < 16; ++j) { const float hi = fmaxf(tk[j], xv), lo = fminf(tk[j], xv); tk[j] = hi; xv = lo; }
            }
            uint4* dst = (uint4*)(TOPL + ((size_t)(mt * 128 + r) * 16 + hp) * 16);
            dst[0] = make_uint4(__float_as_uint(tk[0]), __float_as_uint(tk[1]), __float_as_uint(tk[2]), __float_as_uint(tk[3]));
            dst[1] = make_uint4(__float_as_uint(tk[4]), __float_as_uint(tk[5]), __float_as_uint(tk[6]), __float_as_uint(tk[7]));
            dst[2] = make_uint4(__float_as_uint(tk[8]), __float_as_uint(tk[9]), __float_as_uint(tk[10]), __float_as_uint(tk[11]));
            dst[3] = make_uint4(__float_as_uint(tk[12]), __float_as_uint(tk[13]), __float_as_uint(tk[14]), __float_as_uint(tk[15]));
        }
        __syncthreads();
    }
}
DI void phase_combine(const Params& p, int bid, int nb) {
    const unsigned* TOPL = (const unsigned*)(p.ws + OFF_TOPL);
    uint2* EX = (uint2*)(p.ws + OFF_EXPS);
    const float* SU = (const float*)(p.ws + OFF_SU);
    const float* SV = (const float*)(p.ws + OFF_SV);
    for (int i = bid * NTH + my_tid(); i < NTOK * PHEADS; i += nb * NTH) {
        const unsigned* l1 = TOPL + (size_t)i * 32;
        const unsigned* l2 = l1 + 16;
        float s2[16];
        {
            const uint4 a = ((const uint4*)l2)[0], b = ((const uint4*)l2)[1], c = ((const uint4*)l2)[2], d = ((const uint4*)l2)[3];
            const unsigned w[16] = {a.x, a.y, a.z, a.w, b.x, b.y, b.z, b.w, c.x, c.y, c.z, c.w, d.x, d.y, d.z, d.w};
#pragma unroll
            for (int j = 0; j < 16; ++j) s2[j] = __uint_as_float(w[j] & ~0x7fu);
        }
        float tk[16];
#pragma unroll
        for (int j = 0; j < 16; ++j) tk[j] = -3.0e38f;
        for (int a = 0; a < 16; ++a) {
            const float s1 = __uint_as_float(l1[a] & ~0x7fu);
#pragma unroll
            for (int b = 0; b < 16; ++b) {
                float xv = __uint_as_float((__float_as_uint(s1 + s2[b]) & ~0xffu) | (unsigned)(a * 16 + b));
#pragma unroll
                for (int j = 0; j < 16; ++j) { const float hi = fmaxf(tk[j], xv), lo = fminf(tk[j], xv); tk[j] = hi; xv = lo; }
            }
        }
        float e[16], sum = 0.f;
        const float mx = __uint_as_float(__float_as_uint(tk[0]) & ~0xffu);
#pragma unroll
        for (int j = 0; j < 16; ++j) { e[j] = __expf(__uint_as_float(__float_as_uint(tk[j]) & ~0xffu) - mx); sum += e[j]; }
        const float inv = 1.0f / sum;
#pragma unroll
        for (int j = 0; j < 16; ++j) {
            const unsigned ab = __float_as_uint(tk[j]) & 0xffu;
            const unsigned i1 = l1[ab >> 4] & 0x7fu, i2 = l2[ab & 15] & 0x7fu;
            const unsigned eid = i1 * 128u + i2;
            EX[(size_t)i * 16 + j] = make_uint2(eid | (((__float_as_uint(SU[eid]) >> 23) & 0xffu) << 16), __float_as_uint(e[j] * inv * SV[eid]));
        }
    }
}

DI void ce_desc(float& a, float& b) { const float hi = fmaxf(a, b), lo = fminf(a, b); a = hi; b = lo; }
template <int N> DI void bitonic_sort_desc(float (&v)[N]) {
#pragma unroll
    for (int k = 2; k <= N; k <<= 1)
#pragma unroll
        for (int j = k >> 1; j > 0; j >>= 1)
#pragma unroll
            for (int i = 0; i < N; ++i) { const int l = i ^ j; if (l > i) { if ((i & k) == 0 || k == N) ce_desc(v[i], v[l]); else ce_desc(v[l], v[i]); } }
}
DI void merge_top16(float (&a)[16], const float (&b)[16]) {
#pragma unroll
    for (int i = 0; i < 16; ++i) a[i] = fmaxf(a[i], b[15 - i]);
#pragma unroll
    for (int j = 8; j > 0; j >>= 1)
#pragma unroll
        for (int i = 0; i < 16; ++i) { const int l = i ^ j; if (l > i) ce_desc(a[i], a[l]); }
}
DI void xlane_merge16(float (&a)[16]) {
    float o[16];
#pragma unroll
    for (int i = 0; i < 16; ++i) o[i] = __shfl_xor(a[i], 32);
    merge_top16(a, o);
}
DI void retrieve_topk_hp(const bf16_t* Q, const char* skl, const int tok, const int hp_next, const int r, const int h, unsigned char* lutp, float (&out)[16], bf16x8 (&bq)[8]) {
                f32x16 acc[4];
#pragma unroll
                for (int mi = 0; mi < 4; ++mi)
#pragma unroll
                    for (int i = 0; i < 16; ++i) acc[mi][i] = 0.f;
                const char* kb = skl + r * 272 + h * 16;
#pragma unroll
                for (int ks = 0; ks < 8; ++ks) {
#pragma unroll
                    for (int mi = 0; mi < 4; ++mi) {
                        const bf16x8 a = *(const bf16x8*)(kb + mi * 32 * 272 + ks * 32);
                        acc[mi] = __builtin_amdgcn_mfma_f32_32x32x16_bf16(a, bq[ks], acc[mi], 0, 0, 0);
                    }
                }
                {
                    const bf16_t* qb = Q + (size_t)tok * 2048 + hp_next * 128 + 8 * h;
#pragma unroll
                    for (int ks = 0; ks < 8; ++ks) bq[ks] = *(const bf16x8*)(qb + ks * 16);
                }
                float v0[16], v1[16], v2[16], v3[16];
#pragma unroll
                for (int i = 0; i < 16; ++i) {
                    const unsigned n = (unsigned)crow(i, h);
                    v0[i] = __uint_as_float((__float_as_uint(acc[0][i]) & ~0x7fu) | n);
                    v1[i] = __uint_as_float((__float_as_uint(acc[1][i]) & ~0x7fu) | (n + 32u));
                    v2[i] = __uint_as_float((__float_as_uint(acc[2][i]) & ~0x7fu) | (n + 64u));
                    v3[i] = __uint_as_float((__float_as_uint(acc[3][i]) & ~0x7fu) | (n + 96u));
                }
                bitonic_sort_desc<16>(v0); bitonic_sort_desc<16>(v1); bitonic_sort_desc<16>(v2); bitonic_sort_desc<16>(v3);
                merge_top16(v0, v1); merge_top16(v2, v3); merge_top16(v0, v2);
                xlane_merge16(v0);
#pragma unroll
                for (int i = 0; i < 16; ++i) out[i] = v0[i];
                u32x4 ix;
                ix.x = (__float_as_uint(v0[0]) & 0x7fu) | ((__float_as_uint(v0[1]) & 0x7fu) << 8) | ((__float_as_uint(v0[2]) & 0x7fu) << 16) | ((__float_as_uint(v0[3]) & 0x7fu) << 24);
                ix.y = (__float_as_uint(v0[4]) & 0x7fu) | ((__float_as_uint(v0[5]) & 0x7fu) << 8) | ((__float_as_uint(v0[6]) & 0x7fu) << 16) | ((__float_as_uint(v0[7]) & 0x7fu) << 24);
                ix.z = (__float_as_uint(v0[8]) & 0x7fu) | ((__float_as_uint(v0[9]) & 0x7fu) << 8) | ((__float_as_uint(v0[10]) & 0x7fu) << 16) | ((__float_as_uint(v0[11]) & 0x7fu) << 24);
                ix.w = (__float_as_uint(v0[12]) & 0x7fu) | ((__float_as_uint(v0[13]) & 0x7fu) << 8) | ((__float_as_uint(v0[14]) & 0x7fu) << 16) | ((__float_as_uint(v0[15]) & 0x7fu) << 24);
                *(u32x4*)lutp = ix;
}
DI void phase_retrieve(const Params& p, int bid, int nb, char* smem) {
    const bf16_t* Q = (const bf16_t*)(p.ws + OFF_PROJ);
    const bf16_t* SK = (const bf16_t*)(p.ws + OFF_SUBK);
    const float* SU = (const float*)(p.ws + OFF_SU);
    const float* SV = (const float*)(p.ws + OFF_SV);
    uint2* EX = (uint2*)(p.ws + OFF_EXPS);
    const int tid = my_tid(), lane = tid & 63, wid = tid >> 6, r = lane & 31, h = lane >> 5;
    unsigned char* lut = (unsigned char*)smem + wid * 2048 + lane * 32;
    char* skb0 = smem + 16384;
    char* skb1 = skb0 + 128 * 272;
    u32x4 sr0, sr1, sr2, sr3;
#define SK_LOAD(hp_) { const bf16_t* g_ = SK + (size_t)(hp_) * 16384 + tid * 8; sr0 = *(const u32x4*)g_; sr1 = *(const u32x4*)(g_ + 4096); sr2 = *(const u32x4*)(g_ + 8192); sr3 = *(const u32x4*)(g_ + 12288); }
#define SK_STORE(buf_) { char* d_ = (buf_) + (tid >> 4) * 272 + (tid & 15) * 16; *(u32x4*)d_ = sr0; *(u32x4*)(d_ + 32 * 272) = sr1; *(u32x4*)(d_ + 64 * 272) = sr2; *(u32x4*)(d_ + 96 * 272) = sr3; }
    for (int it = bid; it < (NTOK / 256) * 2; it += nb) {
        const int hq = it & 1, tok = (it >> 1) * 256 + wid * 32 + r;
        __syncthreads();
        SK_LOAD(hq * 8); SK_STORE(skb0);
        bf16x8 bq[8];
        {
            const bf16_t* qb = Q + (size_t)tok * 2048 + (hq * 8) * 128 + 8 * h;
#pragma unroll
            for (int ks = 0; ks < 8; ++ks) bq[ks] = *(const bf16x8*)(qb + ks * 16);
        }
        __syncthreads();
#pragma unroll 1
        for (int hd = hq * 4; hd < hq * 4 + 4; ++hd) {
            float L0[16], L1[16];
            SK_LOAD(hd * 2 + 1);
            retrieve_topk_hp(Q, skb0, tok, hd * 2 + 1, r, h, lut, L0, bq);
            SK_STORE(skb1);
            __syncthreads();
            if (hd + 1 < hq * 4 + 4) SK_LOAD(hd * 2 + 2);
            retrieve_topk_hp(Q, skb1, tok, (hd + 1 < hq * 4 + 4) ? hd * 2 + 2 : hd * 2 + 1, r, h, lut + 16, L1, bq);
            if (hd + 1 < hq * 4 + 4) SK_STORE(skb0);
            __syncthreads();
            float c[32];
            {
                constexpr int PA[50] = {0, 0, 0, 0, 0, 0, 0, 0, 0, 0, 0, 0, 0, 0, 0, 0, 1, 1, 1, 1, 1, 1, 1, 1, 2, 2, 2, 2, 2, 3, 3, 3, 3, 4, 4, 4, 5, 5, 6, 6, 7, 7, 8, 9, 10, 11, 12, 13, 14, 15};
                constexpr int PB[50] = {0, 1, 2, 3, 4, 5, 6, 7, 8, 9, 10, 11, 12, 13, 14, 15, 0, 1, 2, 3, 4, 5, 6, 7, 0, 1, 2, 3, 4, 0, 1, 2, 3, 0, 1, 2, 0, 1, 0, 1, 0, 1, 0, 0, 0, 0, 0, 0, 0, 0};
#pragma unroll
                for (int q = 0; q < 25; ++q) {
                    const float s0 = __uint_as_float(__float_as_uint(L0[PA[2 * q]]) & ~0x7fu) + __uint_as_float(__float_as_uint(L1[PB[2 * q]]) & ~0x7fu);
                    const float s1 = __uint_as_float(__float_as_uint(L0[PA[2 * q + 1]]) & ~0x7fu) + __uint_as_float(__float_as_uint(L1[PB[2 * q + 1]]) & ~0x7fu);
                    const float p0 = __uint_as_float((__float_as_uint(s0) & ~0xffu) | (unsigned)(PA[2 * q] * 16 + PB[2 * q]));
                    const float p1 = __uint_as_float((__float_as_uint(s1) & ~0xffu) | (unsigned)(PA[2 * q + 1] * 16 + PB[2 * q + 1]));
                    c[q] = h ? p1 : p0;
                }
#pragma unroll
                for (int i = 25; i < 32; ++i) c[i] = -3.0e38f;
            }
            bitonic_sort_desc<32>(c);
            float t16[16];
#pragma unroll
            for (int i = 0; i < 16; ++i) t16[i] = c[i];
            xlane_merge16(t16);
            const float mx = __uint_as_float(__float_as_uint(t16[0]) & ~0xffu);
            float e[16], sum = 0.f;
#pragma unroll
            for (int j = 0; j < 16; ++j) { e[j] = __expf(__uint_as_float(__float_as_uint(t16[j]) & ~0xffu) - mx); sum += e[j]; }
            const float inv = 1.0f / sum;
            uint2* dst = EX + ((size_t)tok * 8 + hd) * 16 + 8 * h;
#pragma unroll
            for (int j = 0; j < 8; ++j) {
                float tlo = t16[j], thi = t16[8 + j], elo = e[j], ehi = e[8 + j];
                asm volatile("" : "+v"(tlo), "+v"(thi), "+v"(elo), "+v"(ehi));
                const float tv = h ? thi : tlo, ev = h ? ehi : elo;
                const unsigned ab = __float_as_uint(tv) & 0xffu;
                const unsigned eid = (unsigned)lut[ab >> 4] * 128u + (unsigned)lut[16 + (ab & 15u)];
                dst[j] = make_uint2(eid | (pack2(0.f, SU[eid]) & 0xffff0000u), __float_as_uint(ev * inv * SV[eid]));
            }
        }
    }
#undef SK_LOAD
#undef SK_STORE
}

DI float dot16_fp8(const u32x4 w, const f32x2 (&h)[8]) {
    f32x2 acc = __builtin_amdgcn_cvt_pk_f32_fp8((int)w.x, false) * h[0];
    acc += __builtin_amdgcn_cvt_pk_f32_fp8((int)w.x, true) * h[1];
    acc += __builtin_amdgcn_cvt_pk_f32_fp8((int)w.y, false) * h[2];
    acc += __builtin_amdgcn_cvt_pk_f32_fp8((int)w.y, true) * h[3];
    acc += __builtin_amdgcn_cvt_pk_f32_fp8((int)w.z, false) * h[4];
    acc += __builtin_amdgcn_cvt_pk_f32_fp8((int)w.z, true) * h[5];
    acc += __builtin_amdgcn_cvt_pk_f32_fp8((int)w.w, false) * h[6];
    acc += __builtin_amdgcn_cvt_pk_f32_fp8((int)w.w, true) * h[7];
    return acc.x + acc.y;
}
DI void axpy16_fp8(const float a, const u32x4 w, f32x2 (&o)[8]) {
    const f32x2 aa = {a, a};
    o[0] += aa * __builtin_amdgcn_cvt_pk_f32_fp8((int)w.x, false); o[1] += aa * __builtin_amdgcn_cvt_pk_f32_fp8((int)w.x, true);
    o[2] += aa * __builtin_amdgcn_cvt_pk_f32_fp8((int)w.y, false); o[3] += aa * __builtin_amdgcn_cvt_pk_f32_fp8((int)w.y, true);
    o[4] += aa * __builtin_amdgcn_cvt_pk_f32_fp8((int)w.z, false); o[5] += aa * __builtin_amdgcn_cvt_pk_f32_fp8((int)w.z, true);
    o[6] += aa * __builtin_amdgcn_cvt_pk_f32_fp8((int)w.w, false); o[7] += aa * __builtin_amdgcn_cvt_pk_f32_fp8((int)w.w, true);
}
DI float butterfly64(float (&pz)[64], const int lane) {
    const bool b5 = lane & 32, b4 = lane & 16, b3 = lane & 8, b2 = lane & 4, b1 = lane & 2, b0 = lane & 1;
    float q32[32], q16[16], q8[8], q4[4], q2[2];
#pragma unroll
    for (int j = 0; j < 32; ++j) q32[j] = (b5 ? pz[32 + j] : pz[j]) + __shfl_xor(b5 ? pz[j] : pz[32 + j], 32);
#pragma unroll
    for (int j = 0; j < 16; ++j) q16[j] = (b4 ? q32[16 + j] : q32[j]) + __shfl_xor(b4 ? q32[j] : q32[16 + j], 16);
#pragma unroll
    for (int j = 0; j < 8; ++j) q8[j] = (b3 ? q16[8 + j] : q16[j]) + __shfl_xor(b3 ? q16[j] : q16[8 + j], 8);
#pragma unroll
    for (int j = 0; j < 4; ++j) q4[j] = (b2 ? q8[4 + j] : q8[j]) + __shfl_xor(b2 ? q8[j] : q8[4 + j], 4);
#pragma unroll
    for (int j = 0; j < 2; ++j) q2[j] = (b1 ? q4[2 + j] : q4[j]) + __shfl_xor(b1 ? q4[j] : q4[2 + j], 2);
    return (b0 ? q2[1] : q2[0]) + __shfl_xor(b0 ? q2[0] : q2[1], 1);
}
DI float bfly8(float (&pz)[8], const int lane) {
    const bool b2 = lane & 4, b1 = lane & 2, b0 = lane & 1;
    float q4[4], q2[2];
#pragma unroll
    for (int i = 0; i < 4; ++i) q4[i] = (b2 ? pz[4 + i] : pz[i]) + __shfl_xor(b2 ? pz[i] : pz[4 + i], 4);
#pragma unroll
    for (int i = 0; i < 2; ++i) q2[i] = (b1 ? q4[2 + i] : q4[i]) + __shfl_xor(b1 ? q4[i] : q4[2 + i], 2);
    float q = (b0 ? q2[1] : q2[0]) + __shfl_xor(b0 ? q2[0] : q2[1], 1);
    q += __shfl_xor(q, 8); q += __shfl_xor(q, 16); q += __shfl_xor(q, 32);
    return q;
}
DI float bfly16(float (&pz)[16], const int lane) {
    const bool b3 = lane & 8, b2 = lane & 4, b1 = lane & 2, b0 = lane & 1;
    float q8[8], q4[4], q2[2];
#pragma unroll
    for (int i = 0; i < 8; ++i) q8[i] = (b3 ? pz[8 + i] : pz[i]) + __shfl_xor(b3 ? pz[i] : pz[8 + i], 8);
#pragma unroll
    for (int i = 0; i < 4; ++i) q4[i] = (b2 ? q8[4 + i] : q8[i]) + __shfl_xor(b2 ? q8[i] : q8[4 + i], 4);
#pragma unroll
    for (int i = 0; i < 2; ++i) q2[i] = (b1 ? q4[2 + i] : q4[i]) + __shfl_xor(b1 ? q4[i] : q4[2 + i], 2);
    float q = (b0 ? q2[1] : q2[0]) + __shfl_xor(b0 ? q2[0] : q2[1], 1);
    q += __shfl_xor(q, 16); q += __shfl_xor(q, 32);
    return q;
}
DI void gs_issue(const __amdgpu_buffer_rsrc_t T, const uint2* ent, const unsigned d, const int lane, u32x4 (&w)[8], unsigned& ca) {
    const int cnt = (int)((d >> 16) & 0xfu), k = lane & 7;
    const uint2 e = ent[(d & 0xffffu) + (unsigned)(k < cnt ? k : cnt - 1)];
    ca = (k < cnt && !(d >> 31)) ? e.y : 0u;
#pragma unroll
    for (int q = 0; q < 8; ++q) {
        const int eid = __builtin_amdgcn_readlane((int)e.x, q) & 0x3fff;
        w[q] = __builtin_amdgcn_raw_buffer_load_b128(T, lane * 16, eid * DM, 0);
    }
}
DI float dot16_i8(const u32x4 w, const u32x4 h) {
    int acc = __builtin_amdgcn_sdot4((int)w.x, (int)h.x, 0, false);
    acc = __builtin_amdgcn_sdot4((int)w.y, (int)h.y, acc, false);
    acc = __builtin_amdgcn_sdot4((int)w.z, (int)h.z, acc, false);
    acc = __builtin_amdgcn_sdot4((int)w.w, (int)h.w, acc, false);
    return (float)acc;
}
DI void gs_desc(const uint2* ent, const unsigned d, const int lane, unsigned& ex) {
    const int cnt = (int)((d >> 16) & 0xfu), k = lane & 7;
    ex = ent[(d & 0xffffu) + (unsigned)(k < cnt ? k : cnt - 1)].x;
}
DI void gs_loads(const __amdgpu_buffer_rsrc_t T, const unsigned ex, const int lane, u32x4 (&w)[8]) {
#pragma unroll
    for (int q = 0; q < 8; ++q) {
        const int eid = __builtin_amdgcn_readlane((int)ex, q) & 0x3fff;
        w[q] = __builtin_amdgcn_raw_buffer_load_b128(T, lane * 16, eid * DM, 0);
    }
}
DI void gs_upartial(const u32x4 (&w)[8], const u32x4 h2q, float (&pz)[16], const int base) {
#pragma unroll
    for (int k = 0; k < 8; ++k) pz[base + k] = dot16_i8(w[k], h2q);
}
DI void gs_ustore(float (&pz)[16], float* zb, const unsigned da, const unsigned db, const int lane) {
    const float z = bfly16(pz, lane);
    const unsigned d = (lane & 8) ? db : da;
    const int k = lane & 7;
    if (lane < 16 && k < (int)((d >> 16) & 0xfu) && !(d >> 31)) zb[(d & 0xffffu) + k] = z;
}
DI void axpy16_u8(const float a, const u32x4 w, float (&o)[16]) {
    o[0] += a * (float)(w.x & 0xffu); o[1] += a * (float)((w.x >> 8) & 0xffu); o[2] += a * (float)((w.x >> 16) & 0xffu); o[3] += a * (float)(w.x >> 24);
    o[4] += a * (float)(w.y & 0xffu); o[5] += a * (float)((w.y >> 8) & 0xffu); o[6] += a * (float)((w.y >> 16) & 0xffu); o[7] += a * (float)(w.y >> 24);
    o[8] += a * (float)(w.z & 0xffu); o[9] += a * (float)((w.z >> 8) & 0xffu); o[10] += a * (float)((w.z >> 16) & 0xffu); o[11] += a * (float)(w.z >> 24);
    o[12] += a * (float)(w.w & 0xffu); o[13] += a * (float)((w.w >> 8) & 0xffu); o[14] += a * (float)((w.w >> 16) & 0xffu); o[15] += a * (float)(w.w >> 24);
}
DI void gs_vcompute(const u32x4 (&w)[8], const unsigned ca, float (&acc)[16]) {
#pragma unroll
    for (int k = 0; k < 8; ++k) { axpy16_u8(__uint_as_float((unsigned)__builtin_amdgcn_readlane((int)ca, k)), w[k], acc); __builtin_amdgcn_sched_barrier(0); }
}
constexpr int GT = 4;
DI void xcd_pace(unsigned* cnt, const unsigned nloc, unsigned& step) {
    __syncthreads();
    if (__builtin_amdgcn_workitem_id_x() == 0) {
        __hip_atomic_fetch_add(cnt, 1u, __ATOMIC_RELAXED, __HIP_MEMORY_SCOPE_AGENT);
        const unsigned target = nloc * (step + 1u);
        unsigned sp = 0;
        while (__hip_atomic_load(cnt, __ATOMIC_RELAXED, __HIP_MEMORY_SCOPE_AGENT) < target) { __builtin_amdgcn_s_sleep(1); if (++sp > (1u << 22)) break; }
    }
    ++step;
    __syncthreads();
}
DI void phase_gather(const Params& p, int bid, int nb, char* smem, unsigned* pace_cnt, const unsigned pace_n) {
    unsigned pstep = 0;
    const float* mod = (const float*)(p.ws + OFF_MOD);
    const float* AB = (const float*)(p.ws + OFF_AB);
    const float* STAT = (const float*)(p.ws + OFF_STAT);
    const uint2* EX = (const uint2*)(p.ws + OFF_EXPS);
    const __amdgpu_buffer_rsrc_t UT = __builtin_amdgcn_make_buffer_rsrc((void*)(p.ws + OFF_UT), 0, NEXP * DM, 0x00020000);
    const __amdgpu_buffer_rsrc_t VT = __builtin_amdgcn_make_buffer_rsrc((void*)(p.ws + OFF_VT), 0, NEXP * DM, 0x00020000);
    const int lane = my_tid() & 63, wid = my_tid() >> 6, c0 = lane * 16;
    char* wl = smem + wid * 7168;
    uint2* ent = (uint2*)wl; float* zb = (float*)(wl + 4096); int* offs = (int*)(wl + 6144); unsigned* sched = (unsigned*)(wl + 6144 + 256);
#pragma unroll 1
    for (int t0 = (bid * 8 + wid) * GT; t0 < NTOK; t0 += nb * 8 * GT) {
        u32x4 h2q[GT]; float hsc[GT], mu[GT], rs[GT]; float acc[GT][16];
        f32x4 scv[4], shv[4];
        {
            const int b = t0 / SEQ;
#pragma unroll
            for (int q = 0; q < 4; ++q) { scv[q] = *(const f32x4*)(AB + (size_t)b * DM + c0 + q * 4); shv[q] = *(const f32x4*)(AB + (size_t)(NB + b) * DM + c0 + q * 4); }
        }
#pragma unroll
        for (int j = 0; j < GT; ++j) {
            const int tok = t0 + j;
            const float* row = p.out + (size_t)tok * DM + c0;
            __builtin_amdgcn_sched_barrier(0);
            { mu[j] = STAT[tok] * (1.0f / 1024.0f); rs[j] = rsqrtf(fmaxf(STAT[NTOK + tok] * (1.0f / 1024.0f) - mu[j] * mu[j], 0.f) + LN_EPS); }
            {
                f32x4 hv[4];
                float m = 0.f;
#pragma unroll
                for (int q = 0; q < 4; ++q) { hv[q] = (*(const f32x4*)(row + q * 4) - mu[j]) * rs[j] * scv[q] + shv[q]; m = fmaxf(m, fmaxf(fmaxf(fabsf(hv[q].x), fabsf(hv[q].y)), fmaxf(fabsf(hv[q].z), fabsf(hv[q].w)))); }
#pragma unroll
                for (int sft = 1; sft < 64; sft <<= 1) m = fmaxf(m, __shfl_xor(m, sft));
                const float qs = m > 1e-30f ? 127.0f / m : 1.0f;
                hsc[j] = m > 1e-30f ? m * (1.0f / 127.0f) : 1.0f;
                unsigned hw[4];
#pragma unroll
                for (int q = 0; q < 4; ++q)
                    hw[q] = ((unsigned)(int)rintf(hv[q].x * qs) & 0xffu) | (((unsigned)(int)rintf(hv[q].y * qs) & 0xffu) << 8) | (((unsigned)(int)rintf(hv[q].z * qs) & 0xffu) << 16) | (((unsigned)(int)rintf(hv[q].w * qs) & 0xffu) << 24);
                h2q[j] = (u32x4){hw[0], hw[1], hw[2], hw[3]};
            }
            const uint2 e0 = EX[(size_t)tok * 128 + lane], e1 = EX[(size_t)tok * 128 + 64 + lane];
            const int s0 = (int)((e0.x & 0x3fffu) >> 11), s1 = (int)((e1.x & 0x3fffu) >> 11);
            int run = 0, pos0 = 0, pos1 = 0;
#pragma unroll
            for (int s = 0; s < 8; ++s) {
                const unsigned long long m0 = __ballot(s0 == s), m1 = __ballot(s1 == s);
                const int c0n = __popcll(m0), c1n = __popcll(m1);
                const int below0 = (int)__builtin_amdgcn_mbcnt_hi((unsigned)(m0 >> 32), __builtin_amdgcn_mbcnt_lo((unsigned)m0, 0u));
                const int below1 = (int)__builtin_amdgcn_mbcnt_hi((unsigned)(m1 >> 32), __builtin_amdgcn_mbcnt_lo((unsigned)m1, 0u));
                if (lane == 0) offs[j * 9 + s] = run;
                pos0 = (s0 == s) ? run + below0 : pos0;
                pos1 = (s1 == s) ? run + c0n + below1 : pos1;
                run += c0n + c1n;
            }
            if (lane == 0) offs[j * 9 + 8] = 128;
            ent[j * 128 + pos0] = e0; ent[j * 128 + pos1] = e1;
        }
        int nbat;
        {
            const int gs = (lane / GT) & 7, gj = lane % GT;
            const int gb = offs[gj * 9 + gs], ge = offs[gj * 9 + gs + 1], cnt = lane < 8 * GT ? ge - gb : 0, nbt = (cnt + 7) >> 3;
            int incl = nbt;
#pragma unroll
            for (int m = 1; m < 32; m <<= 1) { const int o = __shfl_up(incl, m); if ((lane & 31) >= m) incl += o; }
            nbat = __builtin_amdgcn_readlane(incl, 8 * GT - 1);
            const int st = incl - nbt;
            for (int q = 0; q < nbt; ++q) { const int rem = cnt - 8 * q; sched[st + q] = (unsigned)(gj * 128 + gb + 8 * q) | ((unsigned)(rem < 8 ? rem : 8) << 16); }
            if (lane < 3) sched[nbat + lane] = 0x80010000u;
        }
        xcd_pace(pace_cnt, pace_n, pstep);
#ifndef PROBE_UX
#define PROBE_UX 1
#endif
        for (int rep = 0; rep < PROBE_UX; ++rep)
        {
            u32x4 wa[8], wb[8];
#define GS_UP(W_, D_, B_) { const unsigned j_ = ((D_) & 0xffffu) >> 7; \
                if (j_ == 0) gs_upartial(W_, h2q[0], pz, B_); else if (j_ == 1) gs_upartial(W_, h2q[1], pz, B_); \
                else if (j_ == 2) gs_upartial(W_, h2q[2], pz, B_); else gs_upartial(W_, h2q[3], pz, B_); }
#define GS_RD(i_) ((unsigned)__builtin_amdgcn_readfirstlane((int)sched[(i_)]))
            unsigned da = GS_RD(0), db = GS_RD(1), dn = GS_RD(2), ea, eb, en;
            gs_desc(ent, da, lane, ea); gs_desc(ent, db, lane, eb); gs_desc(ent, dn, lane, en);
            gs_loads(UT, ea, lane, wa);
#pragma unroll 1
            for (int i = 0; i < nbat; i += 2) {
                float pz[16];
                gs_loads(UT, eb, lane, wb);
                __builtin_amdgcn_sched_barrier(0);
                GS_UP(wa, da, 0);
                const unsigned dcur_a = da, dcur_b = db;
                da = dn; ea = en; dn = GS_RD(i + 3); gs_desc(ent, dn, lane, en);
                gs_loads(UT, ea, lane, wa);
                __builtin_amdgcn_sched_barrier(0);
                GS_UP(wb, dcur_b, 8);
                db = dn; eb = en; dn = GS_RD(i + 4); gs_desc(ent, dn, lane, en);
                gs_ustore(pz, zb, dcur_a, dcur_b, lane);
            }
#undef GS_UP
#undef GS_RD
        }
        float asum[GT];
#pragma unroll
        for (int j = 0; j < GT; ++j) {
            float as = 0.f;
#pragma unroll
            for (int q = 0; q < 2; ++q) {
                const int pos = j * 128 + q * 64 + lane;
                const uint2 e = ent[pos];
                const float z = zb[pos] * __uint_as_float(e.x & 0xffff0000u) * hsc[j];
                const float a = gelu_as(z) * __uint_as_float(e.y);
                ent[pos].y = __float_as_uint(a);
                as += a;
            }
#pragma unroll
            for (int sft = 1; sft < 64; sft <<= 1) as += __shfl_xor(as, sft);
            asum[j] = as;
        }
        xcd_pace(pace_cnt, pace_n, pstep);
#pragma unroll
        for (int j = 0; j < GT; ++j)
#pragma unroll
            for (int q = 0; q < 16; ++q) acc[j][q] = 0.f;
        {
            u32x4 wa[8]; unsigned ca;
#pragma unroll 1
            for (int i = 0; i < nbat; ++i) {
                const unsigned da = (unsigned)__builtin_amdgcn_readfirstlane((int)sched[i]);
                gs_issue(VT, ent, da, lane, wa, ca);
                __builtin_amdgcn_sched_barrier(0);
                const unsigned j_ = (da & 0xffffu) >> 7;
                if (j_ == 0) gs_vcompute(wa, ca, acc[0]); else if (j_ == 1) gs_vcompute(wa, ca, acc[1]);
                else if (j_ == 2) gs_vcompute(wa, ca, acc[2]); else gs_vcompute(wa, ca, acc[3]);
            }
        }
#pragma unroll
        for (int j = 0; j < GT; ++j) {
            asm volatile("" ::: "memory");
            __builtin_amdgcn_sched_barrier(0);
            const int tok = t0 + j, b = tok / SEQ;
            float* row = p.out + (size_t)tok * DM + c0;
            const float* g2 = mod + b * 6144 + 5120 + c0;
            f32x2 r[8];
            float sm = 0.f;
#pragma unroll
            for (int q = 0; q < 4; ++q) {
                const f32x4 xv = (*(const f32x4*)(row + q * 4) - mu[j]) * rs[j] * *(const f32x4*)(p.ln1w + c0 + q * 4) + *(const f32x4*)(p.ln1b + c0 + q * 4), gg = *(const f32x4*)(g2 + q * 4);
                const float off = 128.0f * asum[j];
                r[2 * q] = DEEP_ALPHA * (f32x2){xv.x, xv.y} + (f32x2){1.f + gg.x, 1.f + gg.y} * (f32x2){acc[j][4 * q] - off, acc[j][4 * q + 1] - off};
                r[2 * q + 1] = DEEP_ALPHA * (f32x2){xv.z, xv.w} + (f32x2){1.f + gg.z, 1.f + gg.w} * (f32x2){acc[j][4 * q + 2] - off, acc[j][4 * q + 3] - off};
                sm += r[2 * q].x + r[2 * q].y + r[2 * q + 1].x + r[2 * q + 1].y;
            }
#pragma unroll
            for (int m = 1; m < 64; m <<= 1) sm += __shfl_xor(sm, m);
            const float mu = sm * (1.0f / 1024.0f);
            float qq = 0.f;
#pragma unroll
            for (int i = 0; i < 8; ++i) { const f32x2 dd = r[i] - mu; qq += dd.x * dd.x + dd.y * dd.y; }
#pragma unroll
            for (int m = 1; m < 64; m <<= 1) qq += __shfl_xor(qq, m);
            const float rstd = rsqrtf(qq * (1.0f / 1024.0f) + LN_EPS);
#pragma unroll
            for (int q = 0; q < 4; ++q) {
                const f32x4 w4 = *(const f32x4*)(p.ln2w + c0 + q * 4), bi = *(const f32x4*)(p.ln2b + c0 + q * 4);
                f32x4 ov;
                ov.x = (r[2 * q].x - mu) * rstd * w4.x + bi.x; ov.y = (r[2 * q].y - mu) * rstd * w4.y + bi.y;
                ov.z = (r[2 * q + 1].x - mu) * rstd * w4.z + bi.z; ov.w = (r[2 * q + 1].y - mu) * rstd * w4.w + bi.w;
                *(f32x4*)(row + q * 4) = ov;
            }
        }
    }
}

#define XB_TMO      128
#define XB_XCNT(j)  (256  + 64 * (j))
#define XB_XSUB(j)  (1280 + 64 * (j))
#define XB_XGEN(j)  (2304 + 64 * (j))
#define XB_TOP      3328
#define XB_TOPGEN   3392
#define XCD_BAR_WORDS 3456
#define XB_SPIN_CAP (1u << 22)
#define LAS __attribute__((address_space(3)))
DI unsigned xb_ld(unsigned* p) { return __hip_atomic_load(p, __ATOMIC_RELAXED, __HIP_MEMORY_SCOPE_AGENT); }
DI unsigned xb_add(unsigned* p, unsigned v) { return __hip_atomic_fetch_add(p, v, __ATOMIC_RELAXED, __HIP_MEMORY_SCOPE_AGENT); }
DI unsigned xb_xcc_id() { return (unsigned)__builtin_amdgcn_s_getreg((3 << 11) | 20) & 0xFu; }
#define XB_SPIN(cond, bar) do { unsigned _sp = 0; while (cond) { __builtin_amdgcn_s_sleep(1); \
    if ((++_sp & 255u) == 0u) { if (xb_ld(&(bar)[XB_TMO])) break; if (_sp > XB_SPIN_CAP) { atomicAdd(&(bar)[XB_TMO], 1u); break; } } } } while (0)
struct XcdBarrier { unsigned* bar; unsigned x; volatile LAS unsigned* st; };
DI XcdBarrier xcd_barrier_post(unsigned* bar, volatile LAS unsigned* st) {
    XcdBarrier b; b.bar = bar; b.x = xb_xcc_id(); b.st = st;
    if (__builtin_amdgcn_workitem_id_x() == 0) (void)xb_add(&bar[XB_XCNT(b.x)], 1u);
    return b;
}
DI void xcd_barrier_complete(unsigned* bar, unsigned x, unsigned& nloc, unsigned& nx) {
    const unsigned G = gridDim.x * gridDim.y * gridDim.z;
    unsigned sum, cnt, mine, sp = 0u;
    for (;;) {
        sum = 0u; cnt = 0u; mine = 0u;
#pragma unroll
        for (unsigned j = 0; j < 16; ++j) { const unsigned c = xb_ld(&bar[XB_XCNT(j)]); sum += c; cnt += (c > 0u) ? 1u : 0u; mine = (j == x) ? c : mine; }
        if (sum == G) break;
        __builtin_amdgcn_s_sleep(1);
        if ((++sp & 255u) == 0u) { if (xb_ld(&bar[XB_TMO])) break; if (sp > XB_SPIN_CAP) { atomicAdd(&bar[XB_TMO], 1u); break; } }
    }
    nloc = mine > 0u ? mine : 1u; nx = cnt > 0u ? cnt : 1u;
}
DI void xcd_barrier(const XcdBarrier& b) {
    asm volatile("s_waitcnt vmcnt(0)" ::: "memory");
    __syncthreads();
    if (__builtin_amdgcn_workitem_id_x() == 0) {
        unsigned* bar = b.bar;
        __builtin_amdgcn_s_waitcnt(0);
        unsigned nloc = b.st[0], nx = b.st[1];
        if (nloc == 0u) { xcd_barrier_complete(bar, b.x, nloc, nx); b.st[0] = nloc; b.st[1] = nx; }
        const unsigned old = xb_add(&bar[XB_XSUB(b.x)], 1u);
        const unsigned gen = old / nloc;
        if (old + 1u == (gen + 1u) * nloc) {
            __builtin_amdgcn_fence(__ATOMIC_RELEASE, "agent");
            asm volatile("s_waitcnt vmcnt(0)" ::: "memory");
            const unsigned og = xb_add(&bar[XB_TOP], 1u);
            const unsigned tg = og / nx;
            if (og + 1u == (tg + 1u) * nx) xb_add(&bar[XB_TOPGEN], 1u);
            else XB_SPIN(xb_ld(&bar[XB_TOPGEN]) == tg, bar);
            __builtin_amdgcn_fence(__ATOMIC_ACQUIRE, "agent");
            xb_add(&bar[XB_XGEN(b.x)], 1u);
            asm volatile("s_waitcnt vmcnt(0)" ::: "memory");
        } else {
            XB_SPIN(xb_ld(&bar[XB_XGEN(b.x)]) == gen, bar);
            __builtin_amdgcn_fence(__ATOMIC_ACQUIRE, "agent");
            asm volatile("s_waitcnt vmcnt(0)" ::: "memory");
        }
    }
    __syncthreads();
}

__global__ void __launch_bounds__(NTH) k_mega(Params p) {
    __shared__ __attribute__((aligned(16))) char smem[SMEM_BYTES];
    volatile LAS unsigned* xst = (volatile LAS unsigned*)(smem + SMEM_BYTES - 16);
    if (__builtin_amdgcn_workitem_id_x() == 0) { xst[0] = 0u; xst[1] = 0u; }
    __syncthreads();
    const XcdBarrier xb = xcd_barrier_post((unsigned*)(p.ws + OFF_BAR), xst);
    const int bid = blockIdx.x, nb = gridDim.x;
#ifndef PROBE_MASK
#define PROBE_MASK 0
#endif
#define REP(bit) for (int rep_ = 0; rep_ < ((PROBE_MASK & (bit)) ? 2 : 1); ++rep_)
    phase_prep_a(p, smem);           xcd_barrier(xb);
    phase_prep_b(p, smem);           xcd_barrier(xb);
    REP(1)  { phase_proj(p, bid, nb, smem);    xcd_barrier(xb); }
    REP(128) { phase_hgprep(p, bid, nb);       xcd_barrier(xb); }
    REP(2)  { phase_mix(p, bid, nb, smem);     xcd_barrier(xb); }
    REP(4)  { phase_glu(p, bid, nb, smem);     xcd_barrier(xb); }
    REP(4)  { phase_a2(p, bid, nb);            xcd_barrier(xb); }
    REP(4)  { phase_outproj(p, bid, nb, smem); xcd_barrier(xb); }
    REP(8)  { phase_q(p, bid, nb, smem);       xcd_barrier(xb); }
    REP(16) { phase_retrieve(p, bid, nb, smem); xcd_barrier(xb); }
    phase_gather(p, bid, nb, smem, (unsigned*)(p.ws + OFF_BAR) + 16 * xb.x, xst[0]);
}

extern "C" void kernel_launch(void* const* d_in, const int* in_sizes, int n_in, void* d_out, int out_size, void* d_ws, size_t ws_size, hipStream_t stream) {
    if (n_in != 27 || ws_size < WS_END) { fprintf(stderr, "kernel_launch: unexpected n_in %d or ws_size %zu (< %zu)\n", n_in, ws_size, (size_t)WS_END); return; }
    static int grid_blocks = 0;
    if (!grid_blocks) {
        int dev = 0, cus = 0, per_cu = 0;
        (void)hipGetDevice(&dev);
        (void)hipDeviceGetAttribute(&cus, hipDeviceAttributeMultiprocessorCount, dev);
        (void)hipOccupancyMaxActiveBlocksPerMultiprocessor(&per_cu, k_mega, NTH, 0);
        if (cus <= 0) cus = 256;
        if (per_cu < 1) { fprintf(stderr, "kernel_launch: occupancy query says %d blocks/CU\n", per_cu); per_cu = 1; }
        grid_blocks = cus;
    }
    Params p{};
    const float** f = (const float**)&p;
    for (int i = 0; i < 27; ++i) f[i] = (const float*)d_in[i];
    p.out = (float*)d_out; p.ws = (char*)d_ws;
    hipError_t e = hipMemsetAsync((char*)d_ws + OFF_BAR, 0, (size_t)3456 * 4, stream);
    if (e == hipSuccess) { hipLaunchKernelGGL(k_mega, dim3(grid_blocks), dim3(NTH), 0, stream, p); e = hipPeekAtLastError(); }
    if (e != hipSuccess) fprintf(stderr, "launch failed: %s (grid %d)\n", hipGetErrorString(e), grid_blocks);
}
```

```cpp
#include <hip/hip_runtime.h>
#include <hip/hip_cooperative_groups.h>
#include <stdint.h>
#include <stdio.h>

namespace cg = cooperative_groups;
#define DI __device__ __forceinline__
typedef unsigned short bf16_t;
typedef short bf16x8 __attribute__((ext_vector_type(8)));
typedef float f32x16 __attribute__((ext_vector_type(16)));
typedef unsigned u32x4 __attribute__((ext_vector_type(4)));
typedef float f32x4 __attribute__((ext_vector_type(4)));
typedef float f32x2 __attribute__((ext_vector_type(2)));

constexpr int NTH = 512;
constexpr int NB = 16, SEQ = 2048, DM = 1024, NTOK = NB * SEQ;
constexpr int DHG = 512, HGH = 4, HDK = 128;
constexpr int DSS = 512, SSG = 32, SSC = 16, SSP = 64;
constexpr int INC = 2560;
constexpr int PHEADS = 8, NKEYS = 128, TOPK = 16, NEXP = 16384;
constexpr float DEEP_ALPHA = 1.189207115002721f;
constexpr float LN_EPS = 1e-5f, RMS_EPS = 1e-6f;
constexpr int SMEM_BYTES = 128 * 1024 + 256;

constexpr size_t al256(size_t x) { return (x + 255) & ~(size_t)255; }
constexpr size_t OFF_MOD = 0;
constexpr size_t OFF_LB = al256(OFF_MOD + (size_t)NB * 6144 * 4);
constexpr size_t OFF_LAM = al256(OFF_LB + 512 * 4);
constexpr size_t OFF_BB = al256(OFF_LAM + 32 * 64 * 2 * 4);
constexpr size_t OFF_WIN = al256(OFF_BB + 32 * 64 * 16 * 2 * 4);
constexpr size_t OFF_GLU = al256(OFF_WIN + (size_t)INC * DM * 2);
constexpr size_t OFF_WOUT = al256(OFF_GLU + (size_t)512 * 512 * 2);
constexpr size_t OFF_WQ = al256(OFF_WOUT + (size_t)DM * DM * 2);
constexpr size_t OFF_SUBK = al256(OFF_WQ + (size_t)2048 * DM * 2);
constexpr size_t OFF_SU = al256(OFF_SUBK + (size_t)16 * 128 * 128 * 2);
constexpr size_t OFF_SV = al256(OFF_SU + (size_t)NEXP * 4);
constexpr size_t OFF_UT = al256(OFF_SV + (size_t)NEXP * 4);
constexpr size_t OFF_VT = al256(OFF_UT + (size_t)NEXP * DM * 2);
constexpr size_t OFF_H = al256(OFF_VT + (size_t)NEXP * DM * 2);
constexpr size_t OFF_PROJ = al256(OFF_H + (size_t)NTOK * DM * 2);
constexpr size_t OFF_ORAW = al256(OFF_PROJ + (size_t)NTOK * INC * 2);
constexpr size_t OFF_YSSM = al256(OFF_ORAW + (size_t)NTOK * DHG * 4);
constexpr size_t OFF_A2 = al256(OFF_YSSM + (size_t)NTOK * DSS * 2);
constexpr size_t OFF_HG = al256(OFF_A2 + (size_t)NTOK * DM * 2);
constexpr size_t OFF_S5K = al256(OFF_HG + (size_t)4096 * 128 * 4);
constexpr size_t OFF_S5N = al256(OFF_S5K + (size_t)32 * 4096 * 2);
constexpr size_t OFF_S5M = al256(OFF_S5N + (size_t)32 * 128 * 256 * 2);
constexpr size_t OFF_S5L = al256(OFF_S5M + (size_t)32 * 256 * 128 * 2);
constexpr size_t OFF_STAT = al256(OFF_S5L + (size_t)32 * 64 * 2 * 4);
constexpr size_t OFF_AB = al256(OFF_STAT + (size_t)NTOK * 2 * 4);
constexpr size_t OFF_CAB = al256(OFF_AB + (size_t)2 * NB * DM * 4);
constexpr size_t OFF_BAR = al256(OFF_CAB + (size_t)2 * NB * 2048 * 4);
constexpr size_t WS_END = al256(OFF_BAR + (size_t)3456 * 4);
constexpr size_t OFF_HQ = OFF_H, OFF_HK = OFF_H + (size_t)NTOK * DHG * 2, OFF_HKT = OFF_A2, OFF_HVT = OFF_A2 + (size_t)NTOK * DHG * 2;
constexpr size_t OFF_TOPL = OFF_ORAW;
constexpr size_t OFF_EXPS = OFF_ORAW + (size_t)NTOK * 16 * 16 * 4;

struct Params {
    const float *x, *c, *ada_w, *ada_b, *w_in, *hg_lb, *hg_nw, *a_re, *a_im, *log_dt, *b_re, *b_im, *c_re, *c_im, *dsk,
        *glu_w, *glu_b, *ssm_nw, *w_out, *ln1w, *ln1b, *w_q, *subk, *pu, *pv, *ln2w, *ln2b;
    float* out;
    char* ws;
};

DI int my_tid() { int t = (int)__builtin_amdgcn_workitem_id_x(); asm volatile("" : "+v"(t)); return t; }
DI bf16_t f2bf(float x) { unsigned u = __float_as_uint(x); u += 0x7fffu + ((u >> 16) & 1u); return (bf16_t)(u >> 16); }
DI float bf2f(bf16_t b) { return __uint_as_float(((unsigned)b) << 16); }
DI float bflo(unsigned w) { return __uint_as_float(w << 16); }
DI float bfhi(unsigned w) { return __uint_as_float(w & 0xffff0000u); }
typedef __bf16 hwbf16x2 __attribute__((ext_vector_type(2)));
DI unsigned pack2(float a, float b) { const f32x2 v = {a, b}; return __builtin_bit_cast(unsigned, __builtin_convertvector(v, hwbf16x2)); }
DI bf16x8 pack8(const f32x16& x, const int base) {
    u32x4 o; o.x = pack2(x[base], x[base + 1]); o.y = pack2(x[base + 2], x[base + 3]); o.z = pack2(x[base + 4], x[base + 5]); o.w = pack2(x[base + 6], x[base + 7]);
    return __builtin_bit_cast(bf16x8, o);
}
DI float sigmoidf_(float x) { return 1.0f / (1.0f + __expf(-x)); }
DI float siluf_(float x) { return x * sigmoidf_(x); }
DI float geluf_(float x) { return 0.5f * x * (1.0f + erff(x * 0.70710678118654752f)); }
DI float gelu_as(float v) {
    const float t = __builtin_amdgcn_rcpf(fabsf(v) * 0.2316418882f + 1.0f);
    float q = t * 0.5307027145f + (-0.7265760135f); q = q * t + 0.7107068705f; q = q * t + (-0.142248368f); q = q * t + 0.127414796f; q = q * t;
    const float m = v * (q * __builtin_amdgcn_exp2f(v * v * (-0.72134752044f)));
    return v < 0.f ? m : v - m;
}

template <int MT, int NT_, int WM, int WN, class Epi>
DI void gemm_block(const bf16_t* __restrict__ A, int lda, const bf16_t* __restrict__ Bt, int ldb, int K, char* smem, Epi epi) {
    constexpr int BM = WM * MT * 32, BN = WN * NT_ * 32, LS = 72;
    static_assert(WM * WN == 8, "8 waves");
    bf16_t* As = (bf16_t*)smem;
    bf16_t* Bs = As + BM * LS;
    const int tid = my_tid(), lane = tid & 63, wid = tid >> 6, r = lane & 31, h = lane >> 5;
    const int wm = wid / WN, wn = wid % WN;
    constexpr int PA = BM * 8 / NTH, PB = BN * 8 / NTH;
    u32x4 ra[PA], rb[PB];
    f32x16 acc[MT][NT_];
#pragma unroll
    for (int mi = 0; mi < MT; ++mi)
#pragma unroll
        for (int ni = 0; ni < NT_; ++ni)
#pragma unroll
            for (int i = 0; i < 16; ++i) acc[mi][ni][i] = 0.f;
#define GEMM_GLOAD(kt_) { \
    _Pragma("unroll") for (int q = 0; q < PA; ++q) { const int idx = tid + q * NTH, row = idx >> 3, ch = idx & 7; ra[q] = *(const u32x4*)(A + (size_t)row * lda + (kt_) * 64 + ch * 8); } \
    _Pragma("unroll") for (int q = 0; q < PB; ++q) { const int idx = tid + q * NTH, row = idx >> 3, ch = idx & 7; rb[q] = *(const u32x4*)(Bt + (size_t)row * ldb + (kt_) * 64 + ch * 8); } }
#define GEMM_LSTORE() { \
    _Pragma("unroll") for (int q = 0; q < PA; ++q) { const int idx = tid + q * NTH, row = idx >> 3, ch = idx & 7; *(u32x4*)(As + row * LS + ch * 8) = ra[q]; } \
    _Pragma("unroll") for (int q = 0; q < PB; ++q) { const int idx = tid + q * NTH, row = idx >> 3, ch = idx & 7; *(u32x4*)(Bs + row * LS + ch * 8) = rb[q]; } }
    GEMM_GLOAD(0); GEMM_LSTORE(); __syncthreads();
    const int nk = K / 64;
    for (int kt = 0; kt < nk; ++kt) {
        if (kt + 1 < nk) GEMM_GLOAD(kt + 1);
#pragma unroll
        for (int ks = 0; ks < 4; ++ks) {
            bf16x8 a[MT], b[NT_];
#pragma unroll
            for (int mi = 0; mi < MT; ++mi) a[mi] = *(const bf16x8*)(As + (wm * MT * 32 + mi * 32 + r) * LS + ks * 16 + h * 8);
#pragma unroll
            for (int ni = 0; ni < NT_; ++ni) b[ni] = *(const bf16x8*)(Bs + (wn * NT_ * 32 + ni * 32 + r) * LS + ks * 16 + h * 8);
#pragma unroll
            for (int mi = 0; mi < MT; ++mi)
#pragma unroll
                for (int ni = 0; ni < NT_; ++ni) acc[mi][ni] = __builtin_amdgcn_mfma_f32_32x32x16_bf16(a[mi], b[ni], acc[mi][ni], 0, 0, 0);
        }
        __syncthreads();
        if (kt + 1 < nk) { GEMM_LSTORE(); __syncthreads(); }
    }
#pragma unroll
    for (int mi = 0; mi < MT; ++mi)
#pragma unroll
        for (int ni = 0; ni < NT_; ++ni)
#pragma unroll
            for (int i = 0; i < 16; ++i) epi(wm * MT * 32 + mi * 32 + (i & 3) + 8 * (i >> 2) + 4 * h, wn * NT_ * 32 + ni * 32 + r, acc[mi][ni][i]);
}

namespace pg8 {
#define PG8_LAS __attribute__((address_space(3)))
typedef unsigned short bf16_t;
typedef short bf16x8 __attribute__((ext_vector_type(8)));
typedef float f32x4 __attribute__((ext_vector_type(4)));
typedef unsigned u32x4 __attribute__((ext_vector_type(4)));
constexpr int BM = 256, BK = 64, HALF = 128, HTB = HALF * BK * 2  , STAGE_BYTES = 8 * HTB, NXCD = 8, WGM = 8;

__host__ __device__ __forceinline__ int lds_byte(int r, int c) { const int st = (r >> 4) * 2 + (c >> 5), rr = r & 15, cc = c & 31, ob = rr * 64 + cc * 2; return st * 1024 + (ob ^ (((ob >> 9) & 1) << 5)); }
__host__ __device__ __forceinline__ void stage_rc(int b, int& R, int& C) { const int st = b / 1024, sb = b % 1024, swz = sb ^ (((sb >> 9) & 1) << 5); R = (st >> 1) * 16 + swz / 64; C = (st & 1) * 32 + (swz % 64) / 2; }
__host__ __device__ __forceinline__ int perm32(int rho) { const int n = rho >> 4, i = rho & 15; return 8 * (i >> 2) + 4 * n + (i & 3); }

struct Unit { int pm, pn; };
struct Gemm { const bf16_t* A; const bf16_t* Bt; int M, N, K; };

struct StaticOrder {
    int nM, nN, nwg, G, c;
    __host__ __device__ void init(int M, int N, int G_, int c_) { nM = M / BM; nN = N / BM; nwg = nM * nN; G = G_; c = c_; }
    __host__ __device__ bool next(int i, Unit& u) const {
        const long L = (long)i * G + c; if (L >= nwg) return false;
        int wgid = (int)L; { const int q = nwg / NXCD, r = nwg % NXCD, xcd = wgid % NXCD, off = wgid / NXCD; wgid = (xcd < r ? xcd * (q + 1) : r * (q + 1) + (xcd - r) * q) + off; }
        const int nig = WGM * nN, gid = wgid / nig, fm = gid * WGM, gsz = (nM - fm) < WGM ? (nM - fm) : WGM;
        u.pm = fm + ((wgid % nig) % gsz); u.pn = (wgid % nig) / gsz; return true;
    }
    __device__ __forceinline__ void a_ready(const Unit&) const {}
    __device__ __forceinline__ void done(const Unit&) const {}
};
template <class Epi, class Sched, bool STAMP = false>
__device__ __forceinline__ void gemm_phase(PG8_LAS unsigned char* lds, const Gemm g, const Sched& S, const Epi& E, unsigned long long* stamps) {
    const int tid = (int)__builtin_amdgcn_workitem_id_x(), wid = __builtin_amdgcn_readfirstlane(tid >> 6), lane = tid & 63, wr = wid >> 2, wc = wid & 3, fr = lane & 15, fq = lane >> 4;
    const int K = g.K, nt = K / BK;
    int ts_lo = 0, ts_hi = 0, nts = 0; const unsigned long long rt_entry = STAMP ? (unsigned long long)wall_clock64() : 0ull;
#define PG8_STAMP() do { if (STAMP && wid == 0 && nts < 64) { const unsigned long long _c = (unsigned long long)clock64(); \
        ts_lo = (lane == nts) ? (int)(unsigned)_c : ts_lo; ts_hi = (lane == nts) ? (int)(unsigned)(_c >> 32) : ts_hi; ++nts; } } while (0)
    PG8_STAMP();
    unsigned voffA[2], voffB[2];
#pragma unroll
    for (int i = 0; i < 2; ++i) { int R, C; stage_rc(tid * 16 + i * 8192, R, C); const int Rb = Epi::PERM ? ((R & ~31) + perm32(R & 31)) : R;
        voffA[i] = (unsigned)(R * K + C) * 2u; voffB[i] = (unsigned)(Rb * K + C) * 2u; }
    const size_t kstep = (size_t)(BK * 2);
    const size_t hstep = (size_t)HALF * K * 2;
    const size_t tstep = 2 * hstep;
    const unsigned ldsw = (unsigned)wid * 1024u;
    const int aoff = lds_byte(wr * 64 + fr, fq * 8), boff = lds_byte(wc * 32 + fr, fq * 8);
#define PG8_SA(b, h) (((b) * 2 + (h)) * HTB)
#define PG8_SB(b, h) ((4 + (b) * 2 + (h)) * HTB)
#define PG8_STAGE(bufoff, gbase, voff) do { _Pragma("unroll") for (int _i = 0; _i < 2; ++_i) \
        __builtin_amdgcn_global_load_lds((const unsigned*)((const char*)(gbase) + (voff)[_i]), (PG8_LAS unsigned*)(lds + (bufoff) + ldsw + _i * 8192), 16, 0, 0); } while (0)
#define PG8_LDA(dst, b, h) do { _Pragma("unroll") for (int m = 0; m < 4; ++m) _Pragma("unroll") for (int k = 0; k < 2; ++k) dst[m][k] = *(const PG8_LAS bf16x8*)(lds + PG8_SA(b, h) + aoff + m * 2048 + k * 1024); } while (0)
#define PG8_LDB(dst, b, h) do { _Pragma("unroll") for (int n = 0; n < 2; ++n) _Pragma("unroll") for (int k = 0; k < 2; ++k) dst[n][k] = *(const PG8_LAS bf16x8*)(lds + PG8_SB(b, h) + boff + n * 2048 + k * 1024); } while (0)
#define PG8_MMA(ai, bj, At, Bt) do { __builtin_amdgcn_s_setprio(1); _Pragma("unroll") for (int m = 0; m < 4; ++m) _Pragma("unroll") for (int n = 0; n < 2; ++n) _Pragma("unroll") for (int k = 0; k < 2; ++k) \
        acc[ai][bj][m][n] = __builtin_amdgcn_mfma_f32_16x16x32_bf16(Bt[n][k], At[m][k], acc[ai][bj][m][n], 0, 0, 0); __builtin_amdgcn_s_setprio(0); } while (0)
#define PG8_WAIT_V(n) asm volatile("s_waitcnt vmcnt(" #n ")" ::: "memory")
#define PG8_WAIT_L(n) asm volatile("s_waitcnt lgkmcnt(" #n ")" ::: "memory")
#define PG8_BAR __builtin_amdgcn_s_barrier()
#define PG8_SCHED __builtin_amdgcn_sched_barrier(0)
    Unit cur, nxt; int ui = 0;
    if (!S.next(0, cur)) return;
    f32x4 acc[2][2][4][2];
#pragma unroll
    for (int a = 0; a < 2; ++a)
#pragma unroll
        for (int b = 0; b < 2; ++b)
#pragma unroll
            for (int m = 0; m < 4; ++m)
#pragma unroll
                for (int n = 0; n < 2; ++n) acc[a][b][m][n] = (f32x4){0.f, 0.f, 0.f, 0.f};
    bf16x8 At[4][2], B0[2][2], B1[2][2];
    const char* cA = (const char*)g.A + (size_t)cur.pm * tstep; const char* cB = (const char*)g.Bt + (size_t)cur.pn * tstep;
    S.a_ready(cur);
    PG8_STAGE(PG8_SB(0, 0), cB, voffB); PG8_STAGE(PG8_SA(0, 0), cA, voffA); PG8_STAGE(PG8_SB(0, 1), cB + hstep, voffB); PG8_STAGE(PG8_SA(0, 1), cA + hstep, voffA);
    if (wr == 1) PG8_BAR;
    PG8_WAIT_V(4); PG8_BAR;
    PG8_STAGE(PG8_SB(1, 0), cB + kstep, voffB); PG8_STAGE(PG8_SA(1, 0), cA + kstep, voffA); PG8_STAGE(PG8_SB(1, 1), cB + hstep + kstep, voffB);
    PG8_WAIT_V(6); PG8_BAR;
    PG8_STAMP();
    for (;;) {
        const bool has_next = S.next(ui + 1, nxt);
        const char* nA = has_next ? (const char*)g.A + (size_t)nxt.pm * tstep : cA; const char* nB = has_next ? (const char*)g.Bt + (size_t)nxt.pn * tstep : cB;
        for (int t = 0; t < nt; t += 2) {
            const bool last = (t == nt - 2);
            const char* a1 = cA + (size_t)(t + 1) * kstep;
            const char* a2 = last ? nA : cA + (size_t)(t + 2) * kstep; const char* b2 = last ? nB : cB + (size_t)(t + 2) * kstep;
            const char* a3 = a2 + kstep; const char* b3 = b2 + kstep;
            if (last && has_next) S.a_ready(nxt);
            PG8_LDB(B0, 0, 0); PG8_SCHED; PG8_LDA(At, 0, 0); PG8_STAGE(PG8_SA(1, 1), a1 + hstep, voffA);
            PG8_WAIT_L(8); PG8_BAR; PG8_WAIT_L(0); PG8_MMA(0, 0, At, B0); PG8_BAR; PG8_SCHED;
            PG8_LDB(B1, 0, 1); PG8_STAGE(PG8_SB(0, 0), b2, voffB);
            PG8_BAR; PG8_WAIT_L(0); PG8_MMA(0, 1, At, B1); PG8_BAR;
            PG8_LDA(At, 0, 1); PG8_STAGE(PG8_SA(0, 0), a2, voffA);
            PG8_BAR; PG8_WAIT_L(0); PG8_MMA(1, 0, At, B0); PG8_BAR; PG8_SCHED;
            PG8_STAGE(PG8_SB(0, 1), b2 + hstep, voffB);
            PG8_WAIT_V(6); PG8_BAR; PG8_MMA(1, 1, At, B1); PG8_BAR;
            PG8_LDB(B0, 1, 0); PG8_SCHED; PG8_LDA(At, 1, 0); PG8_STAGE(PG8_SA(0, 1), a2 + hstep, voffA);
            PG8_WAIT_L(8); PG8_BAR; PG8_WAIT_L(0); PG8_MMA(0, 0, At, B0); PG8_BAR; PG8_SCHED;
            PG8_LDB(B1, 1, 1); PG8_STAGE(PG8_SB(1, 0), b3, voffB);
            PG8_BAR; PG8_WAIT_L(0); PG8_MMA(0, 1, At, B1); PG8_BAR;
            PG8_LDA(At, 1, 1); PG8_STAGE(PG8_SA(1, 0), a3, voffA);
            PG8_BAR; PG8_WAIT_L(0); PG8_MMA(1, 0, At, B0); PG8_BAR; PG8_SCHED;
            PG8_STAGE(PG8_SB(1, 1), b3 + hstep, voffB);
            PG8_WAIT_V(6); PG8_BAR; PG8_MMA(1, 1, At, B1); PG8_BAR;
        }
        PG8_STAMP();
        if constexpr (!Epi::AFTER_DRAIN) { E(acc, cur, wr, wc, fr, fq); S.done(cur); }
        PG8_STAMP();
        if (!has_next) break;
#pragma unroll
        for (int a = 0; a < 2; ++a)
#pragma unroll
            for (int b = 0; b < 2; ++b)
#pragma unroll
                for (int m = 0; m < 4; ++m)
#pragma unroll
                    for (int n = 0; n < 2; ++n) acc[a][b][m][n] = (f32x4){0.f, 0.f, 0.f, 0.f};
        cur = nxt; cA = nA; cB = nB; ++ui;
    }
    PG8_WAIT_V(0);
    if (wr == 0) PG8_BAR;
    PG8_BAR;
    if constexpr (Epi::AFTER_DRAIN) { E.fused(acc, cur, wr, wc, fr, fq, lds, wid, lane); S.done(cur); }
    PG8_STAMP();
    if (STAMP && wid == 0) { stamps[lane] = lane < nts ? (((unsigned long long)(unsigned)ts_hi << 32) | (unsigned)ts_lo) : 0ull;
        if (lane == 62) stamps[62] = rt_entry; if (lane == 63) stamps[63] = (unsigned long long)wall_clock64(); }
#undef PG8_STAMP
#undef PG8_SA
#undef PG8_SB
#undef PG8_STAGE
#undef PG8_LDA
#undef PG8_LDB
#undef PG8_MMA
#undef PG8_WAIT_V
#undef PG8_WAIT_L
#undef PG8_BAR
#undef PG8_SCHED
}

__device__ __forceinline__ unsigned pk_bf16(float lo, float hi) { typedef float v2f __attribute__((ext_vector_type(2))); typedef __bf16 v2b __attribute__((ext_vector_type(2))); const v2f v = {lo, hi}; return __builtin_bit_cast(unsigned, __builtin_convertvector(v, v2b)); }
__device__ __forceinline__ float silu1(float x) { return x * __builtin_amdgcn_rcpf(1.0f + __expf(-x)); }
struct EpiBf16Act {
    static constexpr bool PERM = true, AFTER_DRAIN = false;
    bf16_t* O; int ldc; unsigned silu_mask;
    __device__ __forceinline__ void operator()(const f32x4 (&acc)[2][2][4][2], const Unit& u, int wr, int wc, int fr, int fq) const {
        const int row0 = u.pm * BM + wr * 64 + fr, col0 = u.pn * BM + wc * 32 + 8 * fq;
        const bool act = (silu_mask >> u.pn) & 1u;
#pragma unroll
        for (int ai = 0; ai < 2; ++ai)
#pragma unroll
            for (int m = 0; m < 4; ++m) { bf16_t* rowp = O + (size_t)(row0 + ai * HALF + m * 16) * ldc + col0;
#pragma unroll
                for (int bj = 0; bj < 2; ++bj) { f32x4 v0 = acc[ai][bj][m][0], v1 = acc[ai][bj][m][1];
                    if (act) {
#pragma unroll
                        for (int j = 0; j < 4; ++j) { v0[j] = silu1(v0[j]); v1[j] = silu1(v1[j]); } }
                    u32x4 w; w.x = pk_bf16(v0[0], v0[1]); w.y = pk_bf16(v0[2], v0[3]); w.z = pk_bf16(v1[0], v1[1]); w.w = pk_bf16(v1[2], v1[3]);
                    *(u32x4*)(rowp + bj * HALF) = w; } }
    }
};
struct EpiResid {
    static constexpr bool PERM = false, AFTER_DRAIN = false;
    float* C; const float* X; const float* mod_g;
    static constexpr int NTOK_ = 32768;
    float alpha; bf16_t* AP; const float* avec; float* stat;
    __device__ __forceinline__ void operator()(const f32x4 (&acc)[2][2][4][2], const Unit& u, int wr, int wc, int fr, int fq) const {
        const int row0 = u.pm * BM + wr * 64 + fr, col0 = u.pn * BM + wc * 32 + 4 * fq, bat = (u.pm * BM) / 2048;
        const float* gb = mod_g + (size_t)bat * 6144 + col0;
        const float* ab = avec + (size_t)bat * 1024 + col0;
        f32x4 gv[2][2], av[2][2];
#pragma unroll
        for (int bj = 0; bj < 2; ++bj)
#pragma unroll
            for (int n = 0; n < 2; ++n) { gv[bj][n] = *(const f32x4*)(gb + bj * HALF + n * 16) + 1.0f; av[bj][n] = *(const f32x4*)(ab + bj * HALF + n * 16); }
#pragma unroll
        for (int ai = 0; ai < 2; ++ai) {
            float s1[4], s2[4];
#pragma unroll
            for (int m = 0; m < 4; ++m) { const int row = row0 + ai * HALF + m * 16; const size_t ro = (size_t)row * 1024 + col0;
                s1[m] = 0.f; s2[m] = 0.f;
#pragma unroll
                for (int bj = 0; bj < 2; ++bj)
#pragma unroll
                    for (int n = 0; n < 2; ++n) {
                        const f32x4 xv = *(const f32x4*)(X + ro + bj * HALF + n * 16);
                        const f32x4 r1 = alpha * xv + gv[bj][n] * acc[ai][bj][m][n];
                        *(f32x4*)(C + ro + bj * HALF + n * 16) = r1;
                        const f32x4 ap = r1 * av[bj][n];
                        *(uint2*)(AP + ro + bj * HALF + n * 16) = make_uint2(pk_bf16(ap[0], ap[1]), pk_bf16(ap[2], ap[3]));
                        s1[m] += (r1[0] + r1[1]) + (r1[2] + r1[3]); s2[m] += (r1[0] * r1[0] + r1[1] * r1[1]) + (r1[2] * r1[2] + r1[3] * r1[3]);
                    }
            }
            const bool hi5 = fq & 2, hi4 = fq & 1;
            const float a1 = (hi5 ? s1[2] : s1[0]) + __shfl_xor(hi5 ? s1[0] : s1[2], 32), b1 = (hi5 ? s1[3] : s1[1]) + __shfl_xor(hi5 ? s1[1] : s1[3], 32);
            const float a2 = (hi5 ? s2[2] : s2[0]) + __shfl_xor(hi5 ? s2[0] : s2[2], 32), b2 = (hi5 ? s2[3] : s2[1]) + __shfl_xor(hi5 ? s2[1] : s2[3], 32);
            const float t1 = (hi4 ? b1 : a1) + __shfl_xor(hi4 ? a1 : b1, 16), t2 = (hi4 ? b2 : a2) + __shfl_xor(hi4 ? a2 : b2, 16);
            const int srow = u.pm * BM + wr * 64 + ai * HALF + fq * 16 + fr;
            atomicAdd(stat + srow, t1); atomicAdd(stat + NTOK_ + srow, t2);
        }
    }
};
struct EpiQLN {
    static constexpr bool PERM = true, AFTER_DRAIN = false;
    bf16_t* O; const float* stat; const float* ca; const float* cb; float eps;
    __device__ __forceinline__ void operator()(const f32x4 (&acc)[2][2][4][2], const Unit& u, int wr, int wc, int fr, int fq) const {
        const int row0 = u.pm * BM + wr * 64 + fr, col0 = u.pn * BM + wc * 32 + 8 * fq, bat = (u.pm * BM) / 2048;
        const float* cap = ca + (size_t)bat * 2048 + col0;
        const float* cbp = cb + (size_t)bat * 2048 + col0;
#pragma unroll
        for (int bj = 0; bj < 2; ++bj) {
            const f32x4 a0 = *(const f32x4*)(cap + bj * HALF), a1 = *(const f32x4*)(cap + bj * HALF + 4), b0 = *(const f32x4*)(cbp + bj * HALF), b1 = *(const f32x4*)(cbp + bj * HALF + 4);
#pragma unroll
            for (int ai = 0; ai < 2; ++ai)
#pragma unroll
                for (int m = 0; m < 4; ++m) {
                    const int row = row0 + ai * HALF + m * 16;
                    const float mu = stat[row] * (1.0f / 1024.0f), rstd = rsqrtf(fmaxf(stat[32768 + row] * (1.0f / 1024.0f) - mu * mu, 0.f) + eps);
                    const f32x4 v0 = rstd * (acc[ai][bj][m][0] - mu * a0) + b0, v1 = rstd * (acc[ai][bj][m][1] - mu * a1) + b1;
                    u32x4 w; w.x = pk_bf16(v0[0], v0[1]); w.y = pk_bf16(v0[2], v0[3]); w.z = pk_bf16(v1[0], v1[1]); w.w = pk_bf16(v1[2], v1[3]);
                    *(u32x4*)(O + (size_t)row * 2048 + col0 + bj * HALF) = w;
                }
        }
    }
};
struct EpiGlu {
    static constexpr bool PERM = false, AFTER_DRAIN = false;
    float* C; const bf16_t* Y; const float* bias;
    __device__ __forceinline__ void operator()(const f32x4 (&acc)[2][2][4][2], const Unit& u, int wr, int wc, int fr, int fq) const {
        const int row0 = u.pm * BM + wr * 64 + fr, col0 = u.pn * BM + wc * 32 + 4 * fq;
        f32x4 bv[2][2];
#pragma unroll
        for (int bj = 0; bj < 2; ++bj)
#pragma unroll
            for (int n = 0; n < 2; ++n) bv[bj][n] = *(const f32x4*)(bias + col0 + bj * HALF + n * 16);
#pragma unroll
        for (int ai = 0; ai < 2; ++ai)
#pragma unroll
            for (int m = 0; m < 4; ++m) { const size_t ro = (size_t)(row0 + ai * HALF + m * 16) * 512 + col0;
#pragma unroll
                for (int bj = 0; bj < 2; ++bj)
#pragma unroll
                    for (int n = 0; n < 2; ++n) {
                        const uint2 yw = *(const uint2*)(Y + ro + bj * HALF + n * 16);
                        const f32x4 z = acc[ai][bj][m][n] + bv[bj][n];
                        f32x4 o;
                        o[0] = __uint_as_float(yw.x << 16) * __builtin_amdgcn_rcpf(1.0f + __expf(-z[0])); o[1] = __uint_as_float(yw.x & 0xffff0000u) * __builtin_amdgcn_rcpf(1.0f + __expf(-z[1]));
                        o[2] = __uint_as_float(yw.y << 16) * __builtin_amdgcn_rcpf(1.0f + __expf(-z[2])); o[3] = __uint_as_float(yw.y & 0xffff0000u) * __builtin_amdgcn_rcpf(1.0f + __expf(-z[3]));
                        *(f32x4*)(C + ro + bj * HALF + n * 16) = o; } }
    }
};
}

DI void prep_mod_item(const Params& p, int item, char* smem) {
    float* condT = (float*)smem;
    float* red = condT + DM * 16;
    const int tid = my_tid();
    for (int i = tid; i < NB * DM; i += NTH) { const int b = i >> 10, k = i & 1023; condT[k * 16 + b] = siluf_(p.c[i]); }
    __syncthreads();
    const int ks = tid >> 5, col = tid & 31;
    float acc[16];
#pragma unroll
    for (int b = 0; b < 16; ++b) acc[b] = 0.f;
    const float* w = p.ada_w + (size_t)(ks * 64) * 6144 + item * 32 + col;
#pragma unroll 1
    for (int seg = 0; seg < 4; ++seg) {
        float wreg[16];
#pragma unroll
        for (int k = 0; k < 16; ++k) wreg[k] = w[(size_t)(seg * 16 + k) * 6144];
#pragma unroll
        for (int k = 0; k < 16; ++k) {
            const float wv = wreg[k];
            const f32x4* cb = (const f32x4*)(condT + (ks * 64 + seg * 16 + k) * 16);
            const f32x4 c0 = cb[0], c1 = cb[1], c2 = cb[2], c3 = cb[3];
            acc[0] += c0.x * wv; acc[1] += c0.y * wv; acc[2] += c0.z * wv; acc[3] += c0.w * wv;
            acc[4] += c1.x * wv; acc[5] += c1.y * wv; acc[6] += c1.z * wv; acc[7] += c1.w * wv;
            acc[8] += c2.x * wv; acc[9] += c2.y * wv; acc[10] += c2.z * wv; acc[11] += c2.w * wv;
            acc[12] += c3.x * wv; acc[13] += c3.y * wv; acc[14] += c3.z * wv; acc[15] += c3.w * wv;
        }
    }
#pragma unroll
    for (int b = 0; b < 16; ++b) red[(ks * 32 + col) * 16 + b] = acc[b];
    __syncthreads();
    {
        const int b = tid >> 5;
        float sum = p.ada_b[item * 32 + col];
#pragma unroll
        for (int q = 0; q < 16; ++q) sum += red[(q * 32 + col) * 16 + b];
        ((float*)(p.ws + OFF_MOD))[b * 6144 + item * 32 + col] = sum;
    }
    __syncthreads();
}
DI void prep_s5_gemm_item(const Params& p, int g, int part, char* smem) {
    f32x2* pw = (f32x2*)smem;
    f32x2* bbL = pw + 17 * 64;
    f32x2* cL = bbL + 64 * 16;
    const int tid = my_tid();
    const float dt = expf(p.log_dt[g]);
#pragma unroll 1
    for (int idx = tid; idx < 17 * 64; idx += NTH) {
        const int j = idx >> 6, pp = idx & 63;
        const float ar = p.a_re[g * 64 + pp], ai = p.a_im[g * 64 + pp];
        const float mag = expf(ar * dt * (float)j), ang = ai * dt * (float)j;
        pw[idx] = (f32x2){mag * cosf(ang), mag * sinf(ang)};
    }
    for (int idx = tid; idx < 16 * 64; idx += NTH) { const int i = idx >> 6, pp = idx & 63; cL[idx] = (f32x2){p.c_re[(g * 16 + i) * 64 + pp], p.c_im[(g * 16 + i) * 64 + pp]}; }
    __syncthreads();
    for (int idx = tid; idx < 64 * 16; idx += NTH) {
        const int pp = idx >> 4, i = idx & 15;
        const float ar = p.a_re[g * 64 + pp], ai = p.a_im[g * 64 + pp];
        const f32x2 lam = pw[64 + pp];
        const float den = ar * ar + ai * ai, nr = lam.x - 1.0f, ni = lam.y;
        const float zr = (nr * ar + ni * ai) / den, zi = (ni * ar - nr * ai) / den;
        const float br = p.b_re[(g * 64 + pp) * 16 + i], bi = p.b_im[(g * 64 + pp) * 16 + i];
        bbL[idx] = (f32x2){zr * br - zi * bi, zr * bi + zi * br};
    }
    __syncthreads();
    bf16_t* NBg = (bf16_t*)(p.ws + OFF_S5N) + (size_t)g * 128 * 256;
    if (part == 0)
#pragma unroll 1
    for (int ch = tid; ch < 128 * 256 / 8; ch += NTH) {
        const int pq = ch >> 5, t = (ch >> 1) & 15, i0 = (ch & 1) * 8, pp = pq & 63;
        const f32x2 w = pw[(15 - t) * 64 + pp];
        float v[8];
#pragma unroll
        for (int e = 0; e < 8; ++e) { const f32x2 bb = bbL[pp * 16 + i0 + e]; v[e] = pq < 64 ? (w.x * bb.x - w.y * bb.y) : (w.x * bb.y + w.y * bb.x); }
        u32x4 o; o.x = pack2(v[0], v[1]); o.y = pack2(v[2], v[3]); o.z = pack2(v[4], v[5]); o.w = pack2(v[6], v[7]);
        *(u32x4*)(NBg + (size_t)((((pq >> 5) * 16 + t) * 64) + (i0 >> 3) * 32 + (pq & 31)) * 8) = o;
    }
    bf16_t* MBg = (bf16_t*)(p.ws + OFF_S5M) + (size_t)g * 256 * 128;
    if (part == 1)
#pragma unroll 1
    for (int ch = tid; ch < 256 * 128 / 8; ch += NTH) {
        const int ti = ch >> 4, p0 = (ch & 15) * 8, tq = ti >> 4, iq = ti & 15;
        float v[8];
#pragma unroll
        for (int e = 0; e < 8; ++e) {
            const int pq = p0 + e, pp = pq & 63;
            const f32x2 c = cL[iq * 64 + pp], w = pw[(tq + 1) * 64 + pp];
            v[e] = pq < 64 ? (c.x * w.x - c.y * w.y) : -(c.x * w.y + c.y * w.x);
        }
        u32x4 o; o.x = pack2(v[0], v[1]); o.y = pack2(v[2], v[3]); o.z = pack2(v[4], v[5]); o.w = pack2(v[6], v[7]);
        *(u32x4*)(MBg + (size_t)((((ti >> 5) * 8 + (p0 >> 4)) * 64) + ((p0 >> 3) & 1) * 32 + (ti & 31)) * 8) = o;
    }
    bf16_t* KTg = (bf16_t*)(p.ws + OFF_S5K) + (size_t)g * 4096;
    if (part >= 2)
#pragma unroll 1
    for (int idx = (part - 2) * 2048 + tid; idx < (part - 1) * 2048; idx += NTH) {
        const int lag = idx >> 8, iq = (idx >> 4) & 15, i = idx & 15;
        float acc = (lag == 0 && iq == i) ? p.dsk[g * 16 + iq] : 0.f;
#pragma unroll 4
        for (int pp = 0; pp < 64; ++pp) {
            const f32x2 c = cL[iq * 64 + pp], w = pw[lag * 64 + pp], bb = bbL[pp * 16 + i];
            const float mr = c.x * w.x - c.y * w.y, mi_ = c.x * w.y + c.y * w.x;
            acc += mr * bb.x - mi_ * bb.y;
        }
        KTg[idx] = f2bf(acc);
    }
    if (part == 3 && tid < 64) { float* L = (float*)(p.ws + OFF_S5L) + (g * 64 + tid) * 2; const f32x2 w = pw[16 * 64 + tid]; L[0] = w.x; L[1] = w.y; }
    __syncthreads();
}
DI void prep_s5_item(const Params& p, int g) {
    const int tid = my_tid();
    if (tid < SSP) {
        const int pi = g * SSP + tid;
        const float dt = expf(p.log_dt[g]);
        const float ar = p.a_re[pi], ai = p.a_im[pi];
        const float mag = expf(ar * dt);
        const float lr = mag * cosf(ai * dt), li = mag * sinf(ai * dt);
        const float den = ar * ar + ai * ai, nr = lr - 1.0f, ni = li;
        const float zr = (nr * ar + ni * ai) / den, zi = (ni * ar - nr * ai) / den;
        float* lam = (float*)(p.ws + OFF_LAM) + pi * 2;
        lam[0] = lr; lam[1] = li;
        float* bb = (float*)(p.ws + OFF_BB) + (size_t)pi * 32;
        for (int i = 0; i < SSC; ++i) {
            const float br = p.b_re[pi * SSC + i], bi = p.b_im[pi * SSC + i];
            bb[i * 2] = zr * br - zi * bi; bb[i * 2 + 1] = zr * bi + zi * br;
        }
    }
}
DI void prep_transpose_tile(const float* __restrict__ W, bf16_t* __restrict__ Wt, int K, int N, int kt, int nt, char* smem) {
    float* tile = (float*)smem;
    const int tid = my_tid();
#pragma unroll
    for (int q = 0; q < 2; ++q) {
        const int kk = (tid >> 4) + q * 32, c4 = (tid & 15) * 4;
        const float4 v = *(const float4*)(W + (size_t)(kt * 64 + kk) * N + nt * 64 + c4);
        tile[kk * 65 + c4] = v.x; tile[kk * 65 + c4 + 1] = v.y; tile[kk * 65 + c4 + 2] = v.z; tile[kk * 65 + c4 + 3] = v.w;
    }
    __syncthreads();
    const int n = tid >> 3, kc = tid & 7;
    uint4 o;
    o.x = pack2(tile[(kc * 8 + 0) * 65 + n], tile[(kc * 8 + 1) * 65 + n]);
    o.y = pack2(tile[(kc * 8 + 2) * 65 + n], tile[(kc * 8 + 3) * 65 + n]);
    o.z = pack2(tile[(kc * 8 + 4) * 65 + n], tile[(kc * 8 + 5) * 65 + n]);
    o.w = pack2(tile[(kc * 8 + 6) * 65 + n], tile[(kc * 8 + 7) * 65 + n]);
    *(uint4*)(Wt + (size_t)(nt * 64 + n) * K + kt * 64 + kc * 8) = o;
    __syncthreads();
}
DI void cvt_bf16_stream(const float* __restrict__ src, bf16_t* __restrict__ dst, size_t n8, int bid, int nb) {
    for (size_t i = (size_t)bid * NTH + my_tid(); i < n8; i += (size_t)nb * NTH) {
        const float4 a = *(const float4*)(src + i * 8), b = *(const float4*)(src + i * 8 + 4);
        uint4 o; o.x = pack2(a.x, a.y); o.y = pack2(a.z, a.w); o.z = pack2(b.x, b.y); o.w = pack2(b.z, b.w);
        *(uint4*)(dst + i * 8) = o;
    }
}
DI void cvt_fp8_rows(const float* __restrict__ src, unsigned char* __restrict__ dst, float* __restrict__ inv, int bid, int nb) {
    const int lane = my_tid() & 63, wid = my_tid() >> 6;
    for (int row = bid * 8 + wid; row < NEXP; row += nb * 8) {
        const float* sp = src + (size_t)row * DM + lane * 16;
        const f32x4 a = *(const f32x4*)sp, b = *(const f32x4*)(sp + 4), c = *(const f32x4*)(sp + 8), d = *(const f32x4*)(sp + 12);
        float m = fmaxf(fmaxf(fmaxf(fabsf(a.x), fabsf(a.y)), fmaxf(fabsf(a.z), fabsf(a.w))), fmaxf(fmaxf(fabsf(b.x), fabsf(b.y)), fmaxf(fabsf(b.z), fabsf(b.w))));
        m = fmaxf(m, fmaxf(fmaxf(fmaxf(fabsf(c.x), fabsf(c.y)), fmaxf(fabsf(c.z), fabsf(c.w))), fmaxf(fmaxf(fabsf(d.x), fabsf(d.y)), fmaxf(fabsf(d.z), fabsf(d.w)))));
#pragma unroll
        for (int s = 1; s < 64; s <<= 1) m = fmaxf(m, __shfl_xor(m, s));
        float sc = 1.f, isc = 1.f;
        if (m > 1e-30f) {
            int k = (int)floorf(log2f(448.0f / m));
            k = k < -60 ? -60 : (k > 60 ? 60 : k);
            sc = ldexpf(1.0f, k); isc = ldexpf(1.0f, -k);
            if (m * sc > 448.0f) { sc *= 0.5f; isc *= 2.0f; }
        }
        u32x4 o;
        int w;
        w = __builtin_amdgcn_cvt_pk_fp8_f32(a.x * sc, a.y * sc, 0, false); w = __builtin_amdgcn_cvt_pk_fp8_f32(a.z * sc, a.w * sc, w, true); o.x = (unsigned)w;
        w = __builtin_amdgcn_cvt_pk_fp8_f32(b.x * sc, b.y * sc, 0, false); w = __builtin_amdgcn_cvt_pk_fp8_f32(b.z * sc, b.w * sc, w, true); o.y = (unsigned)w;
        w = __builtin_amdgcn_cvt_pk_fp8_f32(c.x * sc, c.y * sc, 0, false); w = __builtin_amdgcn_cvt_pk_fp8_f32(c.z * sc, c.w * sc, w, true); o.z = (unsigned)w;
        w = __builtin_amdgcn_cvt_pk_fp8_f32(d.x * sc, d.y * sc, 0, false); w = __builtin_amdgcn_cvt_pk_fp8_f32(d.z * sc, d.w * sc, w, true); o.w = (unsigned)w;
        *(u32x4*)(dst + (size_t)row * DM + lane * 16) = o;
        if (lane == 0) inv[row] = isc;
    }
}
DI void cvt_fp4_rows(const float* __restrict__ src, unsigned char* __restrict__ dst, float* __restrict__ inv, int bid, int nb) {
    const int lane = my_tid() & 63, wid = my_tid() >> 6;
    for (int row = bid * 8 + wid; row < NEXP; row += nb * 8) {
        const float* sp = src + (size_t)row * DM + lane * 16;
        const f32x4 a = *(const f32x4*)sp, b = *(const f32x4*)(sp + 4), c = *(const f32x4*)(sp + 8), d = *(const f32x4*)(sp + 12);
        float m = fmaxf(fmaxf(fmaxf(fabsf(a.x), fabsf(a.y)), fmaxf(fabsf(a.z), fabsf(a.w))), fmaxf(fmaxf(fabsf(b.x), fabsf(b.y)), fmaxf(fabsf(b.z), fabsf(b.w))));
        m = fmaxf(m, fmaxf(fmaxf(fmaxf(fabsf(c.x), fabsf(c.y)), fmaxf(fabsf(c.z), fabsf(c.w))), fmaxf(fmaxf(fabsf(d.x), fabsf(d.y)), fmaxf(fabsf(d.z), fabsf(d.w)))));
#pragma unroll
        for (int s = 1; s < 64; s <<= 1) m = fmaxf(m, __shfl_xor(m, s));
        const float sc = m > 1e-30f ? 6.0f / m : 1.0f, isc = m > 1e-30f ? m * (1.0f / 6.0f) : 1.0f;
        unsigned w0 = 0u, w1 = 0u;
        w0 = __builtin_amdgcn_cvt_scalef32_pk_fp4_f32(w0, a.x * sc, a.y * sc, 1.0f, 0); w0 = __builtin_amdgcn_cvt_scalef32_pk_fp4_f32(w0, a.z * sc, a.w * sc, 1.0f, 1);
        w0 = __builtin_amdgcn_cvt_scalef32_pk_fp4_f32(w0, b.x * sc, b.y * sc, 1.0f, 2); w0 = __builtin_amdgcn_cvt_scalef32_pk_fp4_f32(w0, b.z * sc, b.w * sc, 1.0f, 3);
        w1 = __builtin_amdgcn_cvt_scalef32_pk_fp4_f32(w1, c.x * sc, c.y * sc, 1.0f, 0); w1 = __builtin_amdgcn_cvt_scalef32_pk_fp4_f32(w1, c.z * sc, c.w * sc, 1.0f, 1);
        w1 = __builtin_amdgcn_cvt_scalef32_pk_fp4_f32(w1, d.x * sc, d.y * sc, 1.0f, 2); w1 = __builtin_amdgcn_cvt_scalef32_pk_fp4_f32(w1, d.z * sc, d.w * sc, 1.0f, 3);
        *(uint2*)(dst + (size_t)row * (DM / 2) + lane * 8) = make_uint2(w0, w1);
        if (lane == 0) inv[row] = isc;
    }
}
template <int OFFS>
DI void cvt_i8_rows(const float* __restrict__ src, unsigned char* __restrict__ dst, float* __restrict__ inv, int bid, int nb) {
    const int lane = my_tid() & 63, wid = my_tid() >> 6;
    for (int row = bid * 8 + wid; row < NEXP; row += nb * 8) {
        const float* sp = src + (size_t)row * DM + lane * 16;
        const f32x4 a = *(const f32x4*)sp, b = *(const f32x4*)(sp + 4), c = *(const f32x4*)(sp + 8), d = *(const f32x4*)(sp + 12);
        float m = fmaxf(fmaxf(fmaxf(fabsf(a.x), fabsf(a.y)), fmaxf(fabsf(a.z), fabsf(a.w))), fmaxf(fmaxf(fabsf(b.x), fabsf(b.y)), fmaxf(fabsf(b.z), fabsf(b.w))));
        m = fmaxf(m, fmaxf(fmaxf(fmaxf(fabsf(c.x), fabsf(c.y)), fmaxf(fabsf(c.z), fabsf(c.w))), fmaxf(fmaxf(fabsf(d.x), fabsf(d.y)), fmaxf(fabsf(d.z), fabsf(d.w)))));
#pragma unroll
        for (int s = 1; s < 64; s <<= 1) m = fmaxf(m, __shfl_xor(m, s));
        const float sc = m > 1e-30f ? 127.0f / m : 1.0f, isc = m > 1e-30f ? m * (1.0f / 127.0f) : 1.0f;
        const float v[16] = {a.x, a.y, a.z, a.w, b.x, b.y, b.z, b.w, c.x, c.y, c.z, c.w, d.x, d.y, d.z, d.w};
        unsigned w[4];
#pragma unroll
        for (int q = 0; q < 4; ++q) {
            unsigned pk = 0u;
#pragma unroll
            for (int e = 0; e < 4; ++e) { const int qi = (int)rintf(v[q * 4 + e] * sc) + OFFS; pk |= ((unsigned)qi & 0xffu) << (8 * e); }
            w[q] = pk;
        }
        *(u32x4*)(dst + (size_t)row * DM + lane * 16) = (u32x4){w[0], w[1], w[2], w[3]};
        if (lane == 0) inv[row] = isc;
    }
}
DI void prep_cab_item(const Params& p, int item, char* smem) {
    float* vT = (float*)smem;
    float* red = vT + DM * 16;
    const float* mod = (const float*)(p.ws + OFF_MOD);
    const int tid = my_tid(), ks = tid >> 5, col = tid & 31;
    const float* w = p.w_q + (size_t)(ks * 64) * 2048 + item * 32 + col;
#pragma unroll 1
    for (int which = 0; which < 2; ++which) {
        for (int i = tid; i < NB * DM; i += NTH) {
            const int b = i >> 10, k = i & 1023;
            const float sc = 1.0f + mod[b * 6144 + 4096 + k];
            const float v = which == 0 ? p.ln1w[k] * sc : p.ln1b[k] * sc + mod[b * 6144 + 3072 + k];
            vT[k * 16 + b] = v;
            if (item == 0) ((float*)(p.ws + OFF_AB))[(size_t)which * NB * DM + i] = v;
        }
        __syncthreads();
        float acc[16];
#pragma unroll
        for (int b = 0; b < 16; ++b) acc[b] = 0.f;
#pragma unroll 1
        for (int seg = 0; seg < 4; ++seg) {
            float wreg[16];
#pragma unroll
            for (int k = 0; k < 16; ++k) wreg[k] = w[(size_t)(seg * 16 + k) * 2048];
#pragma unroll
            for (int k = 0; k < 16; ++k) {
                const float wv = wreg[k];
                const f32x4* cb = (const f32x4*)(vT + (ks * 64 + seg * 16 + k) * 16);
                const f32x4 c0 = cb[0], c1 = cb[1], c2 = cb[2], c3 = cb[3];
                acc[0] += c0.x * wv; acc[1] += c0.y * wv; acc[2] += c0.z * wv; acc[3] += c0.w * wv;
                acc[4] += c1.x * wv; acc[5] += c1.y * wv; acc[6] += c1.z * wv; acc[7] += c1.w * wv;
                acc[8] += c2.x * wv; acc[9] += c2.y * wv; acc[10] += c2.z * wv; acc[11] += c2.w * wv;
                acc[12] += c3.x * wv; acc[13] += c3.y * wv; acc[14] += c3.z * wv; acc[15] += c3.w * wv;
            }
        }
#pragma unroll
        for (int b = 0; b < 16; ++b) red[(ks * 32 + col) * 16 + b] = acc[b];
        __syncthreads();
        {
            const int b = tid >> 5;
            float sum = 0.f;
#pragma unroll
            for (int q = 0; q < 16; ++q) sum += red[(q * 32 + col) * 16 + b];
            ((float*)(p.ws + OFF_CAB))[(size_t)which * NB * 2048 + b * 2048 + item * 32 + col] = sum;
        }
        __syncthreads();
    }
}
DI void phase_h(const Params& p, int bid, int nb) {
    const float* mod = (const float*)(p.ws + OFF_MOD);
    bf16_t* H = (bf16_t*)(p.ws + OFF_H);
    const size_t n8 = (size_t)NTOK * DM / 8;
    for (size_t i = (size_t)bid * NTH + my_tid(); i < n8; i += (size_t)nb * NTH) {
        const int row = (int)(i >> 7), c0 = (int)(i & 127) * 8, b = row / SEQ;
        const float* sh = mod + b * 6144 + c0;
        const float* sc = sh + 1024;
        const float4 a = *(const float4*)(p.x + i * 8), bq = *(const float4*)(p.x + i * 8 + 4);
        const float4 s0 = *(const float4*)sc, s1 = *(const float4*)(sc + 4), h0 = *(const float4*)sh, h1 = *(const float4*)(sh + 4);
        uint4 o;
        o.x = pack2(a.x * (1.f + s0.x) + h0.x, a.y * (1.f + s0.y) + h0.y);
        o.y = pack2(a.z * (1.f + s0.z) + h0.z, a.w * (1.f + s0.w) + h0.w);
        o.z = pack2(bq.x * (1.f + s1.x) + h1.x, bq.y * (1.f + s1.y) + h1.y);
        o.w = pack2(bq.z * (1.f + s1.z) + h1.z, bq.w * (1.f + s1.w) + h1.w);
        *(uint4*)(H + i * 8) = o;
    }
}

DI int wq_next(unsigned* ctr, char* smem) {
    volatile unsigned* slot = (volatile unsigned*)(smem + SMEM_BYTES - 8);
    __syncthreads();
    if (__builtin_amdgcn_workitem_id_x() == 0) *slot = __hip_atomic_fetch_add(ctr, 1u, __ATOMIC_RELAXED, __HIP_MEMORY_SCOPE_AGENT);
    __syncthreads();
    return (int)*slot;
}
DI void phase_prep_a(const Params& p, char* smem) {
    unsigned* ctr = (unsigned*)(p.ws + OFF_BAR) + 120;
    constexpr int U_S5 = 192, U_LB = 320, U_TR = 321, U_UT = U_TR + 368, U_VT = U_UT + 128, U_MISC = U_VT + 128, U_END = U_MISC + 8;
    for (int u = wq_next(ctr, smem); u < U_END; u = wq_next(ctr, smem)) {
        if (u < U_S5) prep_mod_item(p, u, smem);
        else if (u < U_LB) prep_s5_gemm_item(p, (u - U_S5) >> 2, (u - U_S5) & 3, smem);
        else if (u < U_TR) {
            const int j = my_tid();
            const float a0 = p.hg_lb[j], a1 = p.hg_lb[512 + j], m = fmaxf(a0, a1);
            const float e0 = expf(a0 - m), e1 = expf(a1 - m);
            ((float*)(p.ws + OFF_LB))[j] = e0 / (e0 + e1);
        } else if (u < U_UT) {
            for (int it = (u - U_TR) * 4; it < (u - U_TR) * 4 + 4; ++it) {
                constexpr int T_WIN = 16 * 40, T_GLU = 8 * 8, T_WOUT = 16 * 16;
                constexpr int I_GLU = T_WIN, I_WOUT = I_GLU + T_GLU, I_WQ = I_WOUT + T_WOUT;
                if (it < I_GLU) { const int t = it; prep_transpose_tile(p.w_in, (bf16_t*)(p.ws + OFF_WIN), DM, INC, t / 40, t % 40, smem); }
                else if (it < I_WOUT) { const int t = it - I_GLU; prep_transpose_tile(p.glu_w, (bf16_t*)(p.ws + OFF_GLU), 512, 512, t / 8, t % 8, smem); }
                else if (it < I_WQ) { const int t = it - I_WOUT; prep_transpose_tile(p.w_out, (bf16_t*)(p.ws + OFF_WOUT), DM, DM, t / 16, t % 16, smem); }
                else { const int t = it - I_WQ; prep_transpose_tile(p.w_q, (bf16_t*)(p.ws + OFF_WQ), DM, 2048, t / 32, t % 32, smem); }
            }
        } else if (u < U_VT) cvt_i8_rows<0>(p.pu, (unsigned char*)(p.ws + OFF_UT), (float*)(p.ws + OFF_SU), u - U_UT, 128);
        else if (u < U_MISC) cvt_i8_rows<128>(p.pv, (unsigned char*)(p.ws + OFF_VT), (float*)(p.ws + OFF_SV), u - U_VT, 128);
        else {
            const int q = u - U_MISC;
            cvt_bf16_stream(p.subk, (bf16_t*)(p.ws + OFF_SUBK), (size_t)16 * 128 * 128 / 8, q, 8);
            for (size_t i = (size_t)q * NTH + my_tid(); i < (size_t)NTOK * 2 / 4; i += (size_t)8 * NTH) ((f32x4*)(p.ws + OFF_STAT))[i] = (f32x4){0.f, 0.f, 0.f, 0.f};
        }
    }
}
DI void phase_prep_b(const Params& p, char* smem) {
    unsigned* ctr = (unsigned*)(p.ws + OFF_BAR) + 121;
    for (int u = wq_next(ctr, smem); u < 64 + 256; u = wq_next(ctr, smem)) {
        if (u < 64) prep_cab_item(p, u, smem); else phase_h(p, u - 64, 256);
    }
}

DI void phase_proj(const Params& p, int bid, int nb, char* smem) {
    pg8::Gemm g{(const bf16_t*)(p.ws + OFF_H), (const bf16_t*)(p.ws + OFF_WIN), NTOK, INC, DM};
    pg8::StaticOrder S; S.init(NTOK, INC, nb, bid);
    pg8::EpiBf16Act E{(bf16_t*)(p.ws + OFF_PROJ), INC, 0xC3u};
    pg8::gemm_phase<pg8::EpiBf16Act, pg8::StaticOrder, false>((PG8_LAS unsigned char*)smem, g, S, E, nullptr);
}

DI void hgrn_item(const Params& p, int item, char* smem) {
    const int vs = item & 7, hd = (item >> 3) & 3, b = item >> 5;
    const bf16_t* P = (const bf16_t*)(p.ws + OFF_PROJ);
    const float* lb = (const float*)(p.ws + OFF_LB) + hd * HDK;
    float* ORAW = (float*)(p.ws + OFF_ORAW);
    float* sq = (float*)smem;
    float* sf = sq + 32 * 128;
    float* sv = sf + 32 * 128;
    float* sp = sv + 32 * 16;
    const int tid = my_tid(), lane = tid & 63, wid = tid >> 6, kq = tid >> 4, v = tid & 15;
    float S0 = 0.f, S1 = 0.f, S2 = 0.f, S3 = 0.f;
    for (int t0 = 0; t0 < SEQ; t0 += 32) {
        for (int i = tid; i < 32 * 128; i += NTH) {
            const int t = i >> 7, k = i & 127;
            const bf16_t* row = P + (size_t)(b * SEQ + t0 + t) * INC + hd * HDK + k;
            sq[i] = bf2f(row[0]);
            const float l = lb[k];
            sf[i] = l + (1.0f - l) * sigmoidf_(bf2f(row[512]));
        }
        { const int t = tid >> 4; sv[tid] = bf2f(P[(size_t)(b * SEQ + t0 + t) * INC + 1024 + hd * HDK + vs * 16 + v]); }
        __syncthreads();
        for (int t = 0; t < 32; ++t) {
            const float4 f4 = *(const float4*)(sf + t * 128 + kq * 4), q4 = *(const float4*)(sq + t * 128 + kq * 4);
            const float vv = sv[t * 16 + v];
            S0 = f4.x * S0 + (1.0f - f4.x) * vv; S1 = f4.y * S1 + (1.0f - f4.y) * vv;
            S2 = f4.z * S2 + (1.0f - f4.z) * vv; S3 = f4.w * S3 + (1.0f - f4.w) * vv;
            float part = q4.x * S0 + q4.y * S1 + q4.z * S2 + q4.w * S3;
            part += __shfl_xor(part, 16); part += __shfl_xor(part, 32);
            if (lane < 16) sp[(t * 8 + wid) * 16 + v] = part;
        }
        __syncthreads();
        {
            const int t = tid >> 4;
            float o = 0.f;
#pragma unroll
            for (int w = 0; w < 8; ++w) o += sp[(t * 8 + w) * 16 + v];
            ORAW[(size_t)(b * SEQ + t0 + t) * DHG + hd * HDK + vs * 16 + v] = o;
        }
        __syncthreads();
    }
}
DI void s5_item(const Params& p, int item, char* smem) {
    const int oct = item & 3, b = item >> 2;
    const int tid = my_tid(), lane = tid & 63, wid = tid >> 6, g = oct * 8 + wid;
    const bf16_t* P = (const bf16_t*)(p.ws + OFF_PROJ);
    bf16_t* Y = (bf16_t*)(p.ws + OFF_YSSM);
    float* su = (float*)smem + wid * 64 * 16;
    const float* lam = (const float*)(p.ws + OFF_LAM) + (g * SSP + lane) * 2;
    const float lr = lam[0], li = lam[1];
    const float* bb = (const float*)(p.ws + OFF_BB) + (size_t)(g * SSP + lane) * 32;
    float bbr[16], bbi[16], cr[16], ci[16];
#pragma unroll
    for (int i = 0; i < 16; ++i) { bbr[i] = bb[2 * i]; bbi[i] = bb[2 * i + 1]; cr[i] = p.c_re[(g * SSC + i) * SSP + lane]; ci[i] = p.c_im[(g * SSC + i) * SSP + lane]; }
    const int ch = (lane >> 2) & 15;
    const float dch = p.dsk[g * SSC + ch];
    float xr = 0.f, xi = 0.f;
    for (int t0 = 0; t0 < SEQ; t0 += 64) {
        {
            const uint4* src = (const uint4*)(P + (size_t)(b * SEQ + t0 + lane) * INC + 2048 + g * SSC);
            const uint4 a = src[0], c = src[1];
            float* d = su + lane * 16;
            d[0] = bflo(a.x); d[1] = bfhi(a.x); d[2] = bflo(a.y); d[3] = bfhi(a.y); d[4] = bflo(a.z); d[5] = bfhi(a.z); d[6] = bflo(a.w); d[7] = bfhi(a.w);
            d[8] = bflo(c.x); d[9] = bfhi(c.x); d[10] = bflo(c.y); d[11] = bfhi(c.y); d[12] = bflo(c.z); d[13] = bfhi(c.z); d[14] = bflo(c.w); d[15] = bfhi(c.w);
        }
        __syncthreads();
        for (int t = 0; t < 64; ++t) {
            float u[16];
            const float4* us = (const float4*)(su + t * 16);
            const float4 u0 = us[0], u1 = us[1], u2 = us[2], u3 = us[3];
            u[0] = u0.x; u[1] = u0.y; u[2] = u0.z; u[3] = u0.w; u[4] = u1.x; u[5] = u1.y; u[6] = u1.z; u[7] = u1.w;
            u[8] = u2.x; u[9] = u2.y; u[10] = u2.z; u[11] = u2.w; u[12] = u3.x; u[13] = u3.y; u[14] = u3.z; u[15] = u3.w;
            float bur = 0.f, bui = 0.f;
#pragma unroll
            for (int i = 0; i < 16; ++i) { bur += bbr[i] * u[i]; bui += bbi[i] * u[i]; }
            const float nxr = lr * xr - li * xi + bur, nxi = lr * xi + li * xr + bui;
            xr = nxr; xi = nxi;
            float y[16];
#pragma unroll
            for (int i = 0; i < 16; ++i) y[i] = cr[i] * xr - ci[i] * xi;
            const bool b5 = lane & 32, b4 = lane & 16, b3 = lane & 8, b2 = lane & 4;
            float y8[8], y4[4], y2[2];
#pragma unroll
            for (int j = 0; j < 8; ++j) { const float keep = b5 ? y[8 + j] : y[j], send = b5 ? y[j] : y[8 + j]; y8[j] = keep + __shfl_xor(send, 32); }
#pragma unroll
            for (int j = 0; j < 4; ++j) { const float keep = b4 ? y8[4 + j] : y8[j], send = b4 ? y8[j] : y8[4 + j]; y4[j] = keep + __shfl_xor(send, 16); }
#pragma unroll
            for (int j = 0; j < 2; ++j) { const float keep = b3 ? y4[2 + j] : y4[j], send = b3 ? y4[j] : y4[2 + j]; y2[j] = keep + __shfl_xor(send, 8); }
            float y1;
            { const float keep = b2 ? y2[1] : y2[0], send = b2 ? y2[0] : y2[1]; y1 = keep + __shfl_xor(send, 4); }
            y1 += __shfl_xor(y1, 1); y1 += __shfl_xor(y1, 2);
            if ((lane & 3) == 0) {
                const float uu = su[t * 16 + ch];
                Y[(size_t)(b * SEQ + t0 + t) * DSS + g * SSC + ch] = f2bf(geluf_(y1 + dch * uu));
            }
        }
        __syncthreads();
    }
}
DI int crow(int i, int h) { return (i & 3) + 8 * (i >> 2) + 4 * h; }
DI void phase_hgprep(const Params& p, int bid, int nb) {
    const bf16_t* P = (const bf16_t*)(p.ws + OFF_PROJ);
    const float* lbp = (const float*)(p.ws + OFF_LB);
    const int tid = my_tid(), lane = tid & 63, wid = tid >> 6, tq = lane >> 4, cg = lane & 15;
#pragma unroll 1
    for (int it = bid * 8 + wid; it < 8192; it += nb * 8) {
        const int tile = it >> 1, c = tile & 63, hd = (tile >> 6) & 3, b = tile >> 8, k0 = (it & 1) * 64 + cg * 4;
        const bf16_t* base = P + (size_t)(b * SEQ + c * 32 + tq * 8) * INC + hd * HDK + k0;
        uint2 qw[8], fw[8];
#pragma unroll
        for (int tt = 0; tt < 8; ++tt) { qw[tt] = *(const uint2*)(base + (size_t)tt * INC); fw[tt] = *(const uint2*)(base + (size_t)tt * INC + 512); }
        const f32x4 l4 = *(const f32x4*)(lbp + hd * HDK + k0);
        const float lb4[4] = {l4.x, l4.y, l4.z, l4.w};
        float bl[8][4], kk[8][4], run[4];
#pragma unroll
        for (int e = 0; e < 4; ++e) run[e] = 0.f;
#pragma unroll
        for (int tt = 0; tt < 8; ++tt) {
            const float fl[4] = {bflo(fw[tt].x), bfhi(fw[tt].x), bflo(fw[tt].y), bfhi(fw[tt].y)};
#pragma unroll
            for (int e = 0; e < 4; ++e) {
                const float f = lb4[e] + (1.0f - lb4[e]) * sigmoidf_(fl[e]);
                run[e] += __logf(f); bl[tt][e] = run[e]; kk[tt][e] = 1.0f - f;
            }
        }
        float off[4], tot[4];
#pragma unroll
        for (int e = 0; e < 4; ++e) {
            const float t0 = __shfl(run[e], cg), t1 = __shfl(run[e], cg + 16), t2 = __shfl(run[e], cg + 32), t3 = __shfl(run[e], cg + 48);
            off[e] = (tq > 0 ? t0 : 0.f) + (tq > 1 ? t1 : 0.f) + (tq > 2 ? t2 : 0.f);
            tot[e] = (t0 + t1) + (t2 + t3);
        }
        bf16_t* HQ = (bf16_t*)(p.ws + OFF_HQ) + (size_t)tile * 4096 + (tq * 8) * 128 + k0;
        bf16_t* HK = (bf16_t*)(p.ws + OFF_HK) + (size_t)tile * 4096 + (tq * 8) * 128 + k0;
#pragma unroll
        for (int tt = 0; tt < 8; ++tt) {
            const float qv[4] = {bflo(qw[tt].x), bfhi(qw[tt].x), bflo(qw[tt].y), bfhi(qw[tt].y)};
            float qo[4], ko[4];
#pragma unroll
            for (int e = 0; e < 4; ++e) { const float bb = off[e] + bl[tt][e]; qo[e] = qv[e] * __expf(bb); ko[e] = kk[tt][e] * __expf(fminf(-bb, 80.0f)); }
            *(uint2*)(HQ + tt * 128) = make_uint2(pack2(qo[0], qo[1]), pack2(qo[2], qo[3]));
            *(uint2*)(HK + tt * 128) = make_uint2(pack2(ko[0], ko[1]), pack2(ko[2], ko[3]));
        }
        if (tq == 0) *(f32x4*)((float*)(p.ws + OFF_HG) + (size_t)tile * 128 + k0) = (f32x4){__expf(tot[0]), __expf(tot[1]), __expf(tot[2]), __expf(tot[3])};
    }
}
typedef short s16x4 __attribute__((ext_vector_type(4)));
DI bf16x8 cat8(const s16x4 lo, const s16x4 hi) { return (bf16x8){lo.x, lo.y, lo.z, lo.w, hi.x, hi.y, hi.z, hi.w}; }
DI s16x4 lds_tr(const char* a) { return __builtin_amdgcn_ds_read_tr16_b64_v4i16((__attribute__((address_space(3))) s16x4*)a); }
DI void hgrn_mfma_item(const Params& p, int item, char* smem) {
    constexpr int QP_OFF = 0, KP_OFF = 8704, V_OFF = 17408, G_OFF = 26112, BUF = 26624, OB_OFF = 3 * BUF, OB_STRIDE = 132, OB_BYTES = 32 * OB_STRIDE * 4;
    const int tid = my_tid(), lane = tid & 63, wid = tid >> 6, r = lane & 31, h = lane >> 5;
    const int b = item >> 2, hd = item & 3;
    const size_t tile0 = (size_t)item * 64;
    const bf16_t* HQ = (const bf16_t*)(p.ws + OFF_HQ) + tile0 * 4096;
    const bf16_t* HK = (const bf16_t*)(p.ws + OFF_HK) + tile0 * 4096;
    const bf16_t* PV = (const bf16_t*)(p.ws + OFF_PROJ) + (size_t)b * SEQ * INC + 1024 + hd * HDK;
    const float* HG = (const float*)(p.ws + OFF_HG) + tile0 * 128;
    bf16_t* A2out = (bf16_t*)(p.ws + OFF_A2) + (size_t)b * SEQ * DM + hd * HDK;
    const bf16_t* PG = (const bf16_t*)(p.ws + OFF_PROJ) + (size_t)b * SEQ * INC + 1536 + hd * HDK;
    const bool helper = wid >= 4;
    const int ht = tid - 256;
    const int i0 = ht, i1 = ht + 256;
    const int lo0 = (i0 >> 4) * 272 + (i0 & 15) * 16, lo1 = (i1 >> 4) * 272 + (i1 & 15) * 16;
    u32x4 A0, A1, A2, A3, A4, A5, A6, B0, B1, B2, B3, B4, B5, B6;
    A0 = A1 = A2 = A3 = A4 = A5 = A6 = B0 = B1 = B2 = B3 = B4 = B5 = B6 = (u32x4){0, 0, 0, 0};
    f32x16 S[4];
#pragma unroll
    for (int kb = 0; kb < 4; ++kb)
#pragma unroll
        for (int i = 0; i < 16; ++i) S[kb][i] = 0.f;
#define HG_LOAD(X, c_) { const size_t o_ = (size_t)(c_) * 4096; \
        X##0 = *(const u32x4*)(HQ + o_ + i0 * 8); X##1 = *(const u32x4*)(HQ + o_ + i1 * 8); \
        X##2 = *(const u32x4*)(HK + o_ + i0 * 8); X##3 = *(const u32x4*)(HK + o_ + i1 * 8); \
        X##4 = *(const u32x4*)(PV + (size_t)((c_) * 32 + (i0 >> 4)) * INC + (i0 & 15) * 8); X##5 = *(const u32x4*)(PV + (size_t)((c_) * 32 + (i1 >> 4)) * INC + (i1 & 15) * 8); \
        if (ht < 32) X##6 = *(const u32x4*)(HG + (size_t)(c_) * 128 + ht * 4); }
#define HG_STORE(X, buf_) { char* B_ = smem + (buf_) * BUF; \
        *(u32x4*)(B_ + QP_OFF + lo0) = X##0; *(u32x4*)(B_ + QP_OFF + lo1) = X##1; \
        *(u32x4*)(B_ + KP_OFF + lo0) = X##2; *(u32x4*)(B_ + KP_OFF + lo1) = X##3; \
        *(u32x4*)(B_ + V_OFF + lo0) = X##4; *(u32x4*)(B_ + V_OFF + lo1) = X##5; \
        if (ht < 32) *(u32x4*)(B_ + G_OFF + ht * 16) = X##6; }
    const int tq = (lane >> 2) & 3, tp = lane & 3, tg = lane >> 4;
    const int tr_nat = (8 * (tg >> 1) + tq) * 272 + (16 * (tg & 1) + 4 * tp) * 2;
    const int tr_krw = (4 * (tg >> 1) + tq) * 272 + (16 * (tg & 1) + 4 * tp) * 2;
    if (helper) { HG_LOAD(A, 0); HG_STORE(A, 0); HG_LOAD(A, 1); HG_STORE(A, 1); HG_LOAD(A, 2); HG_LOAD(B, 3); }
    __syncthreads();
#define HG_COMPUTE(c_) { \
        const char* B = smem + ((c_) % 3) * BUF; const int w = wid; \
        f32x16 pt; _Pragma("unroll") for (int i = 0; i < 16; ++i) pt[i] = 0.f; \
        _Pragma("unroll") for (int ks = 0; ks < 8; ++ks) { \
            const bf16x8 a = *(const bf16x8*)(B + KP_OFF + r * 272 + ks * 32 + h * 16); \
            const bf16x8 bq = *(const bf16x8*)(B + QP_OFF + r * 272 + ks * 32 + h * 16); \
            pt = __builtin_amdgcn_mfma_f32_32x32x16_bf16(a, bq, pt, 0, 0, 0); } \
        _Pragma("unroll") for (int i = 0; i < 16; ++i) if (crow(i, h) > r) pt[i] = 0.f; \
        f32x16 o; _Pragma("unroll") for (int i = 0; i < 16; ++i) o[i] = 0.f; \
        _Pragma("unroll") for (int sp = 0; sp < 2; ++sp) { \
            const char* vb = B + V_OFF + (16 * sp) * 272 + (32 * w) * 2 + tr_krw; \
            const bf16x8 bv = cat8(lds_tr(vb), lds_tr(vb + 8 * 272)); \
            o = __builtin_amdgcn_mfma_f32_32x32x16_bf16(pack8(pt, 8 * sp), bv, o, 0, 0, 0); } \
        _Pragma("unroll") for (int kb = 0; kb < 4; ++kb) _Pragma("unroll") for (int sp = 0; sp < 2; ++sp) { \
            const char* qb = B + QP_OFF + r * 272 + kb * 64 + sp * 32 + h * 8; \
            const bf16x8 aq = cat8(*(const s16x4*)qb, *(const s16x4*)(qb + 16)); \
            o = __builtin_amdgcn_mfma_f32_32x32x16_bf16(aq, pack8(S[kb], 8 * sp), o, 0, 0, 0); } \
        { float* ob_ = (float*)(smem + OB_OFF + ((c_) & 1) * OB_BYTES); _Pragma("unroll") for (int i = 0; i < 16; ++i) ob_[crow(i, h) * OB_STRIDE + 32 * w + r] = o[i]; } \
        bf16x8 bvn[2]; \
        _Pragma("unroll") for (int ks = 0; ks < 2; ++ks) { const char* vb = B + V_OFF + (16 * ks) * 272 + (32 * w) * 2 + tr_nat; bvn[ks] = cat8(lds_tr(vb), lds_tr(vb + 4 * 272)); } \
        _Pragma("unroll") for (int kb = 0; kb < 4; ++kb) { \
            _Pragma("unroll") for (int ks = 0; ks < 2; ++ks) { \
                const char* kp = B + KP_OFF + (16 * ks) * 272 + (32 * kb) * 2 + tr_nat; \
                const bf16x8 a = cat8(lds_tr(kp), lds_tr(kp + 4 * 272)); \
                S[kb] = __builtin_amdgcn_mfma_f32_32x32x16_bf16(a, bvn[ks], S[kb], 0, 0, 0); } \
            _Pragma("unroll") for (int j = 0; j < 4; ++j) { \
                const f32x4 g4 = *(const f32x4*)(B + G_OFF + (kb * 32 + 8 * j + 4 * h) * 4); \
                S[kb][4 * j] *= g4.x; S[kb][4 * j + 1] *= g4.y; S[kb][4 * j + 2] *= g4.z; S[kb][4 * j + 3] *= g4.w; } } }
    f32x4 nw0, nw1, nw2, nw3;
    nw0 = nw1 = nw2 = nw3 = (f32x4){0.f, 0.f, 0.f, 0.f};
    if (helper) { const float* nwp = p.hg_nw + hd * HDK + (ht & 7) * 16; nw0 = *(const f32x4*)nwp; nw1 = *(const f32x4*)(nwp + 4); nw2 = *(const f32x4*)(nwp + 8); nw3 = *(const f32x4*)(nwp + 12); }
#define HG_NORM(cc_) { const int t_ = ht >> 3, sg_ = ht & 7; \
        const float* ob_ = (const float*)(smem + OB_OFF + ((cc_) & 1) * OB_BYTES) + t_ * OB_STRIDE + sg_ * 16; \
        const f32x4 o0 = *(const f32x4*)ob_, o1 = *(const f32x4*)(ob_ + 4), o2 = *(const f32x4*)(ob_ + 8), o3 = *(const f32x4*)(ob_ + 12); \
        const u32x4 g0 = *(const u32x4*)(PG + (size_t)((cc_) * 32 + t_) * INC + sg_ * 16), g1 = *(const u32x4*)(PG + (size_t)((cc_) * 32 + t_) * INC + sg_ * 16 + 8); \
        float ss = (o0.x * o0.x + o0.y * o0.y + o0.z * o0.z + o0.w * o0.w) + (o1.x * o1.x + o1.y * o1.y + o1.z * o1.z + o1.w * o1.w) + (o2.x * o2.x + o2.y * o2.y + o2.z * o2.z + o2.w * o2.w) + (o3.x * o3.x + o3.y * o3.y + o3.z * o3.z + o3.w * o3.w); \
        ss += __shfl_xor(ss, 1); ss += __shfl_xor(ss, 2); ss += __shfl_xor(ss, 4); \
        const float rs_ = rsqrtf(ss * (1.0f / 128.0f) + RMS_EPS); \
        const f32x4 v0 = o0 * rs_ * nw0, v1 = o1 * rs_ * nw1, v2 = o2 * rs_ * nw2, v3 = o3 * rs_ * nw3; \
        u32x4 w0, w1; \
        w0.x = pack2(v0.x * bflo(g0.x), v0.y * bfhi(g0.x)); w0.y = pack2(v0.z * bflo(g0.y), v0.w * bfhi(g0.y)); w0.z = pack2(v1.x * bflo(g0.z), v1.y * bfhi(g0.z)); w0.w = pack2(v1.z * bflo(g0.w), v1.w * bfhi(g0.w)); \
        w1.x = pack2(v2.x * bflo(g1.x), v2.y * bfhi(g1.x)); w1.y = pack2(v2.z * bflo(g1.y), v2.w * bfhi(g1.y)); w1.z = pack2(v3.x * bflo(g1.z), v3.y * bfhi(g1.z)); w1.w = pack2(v3.z * bflo(g1.w), v3.w * bfhi(g1.w)); \
        bf16_t* dst_ = A2out + (size_t)((cc_) * 32 + t_) * DM + sg_ * 16; \
        *(u32x4*)dst_ = w0; *(u32x4*)(dst_ + 8) = w1; }
    for (int c = 0; c < 64; c += 2) {
        if (helper) { if (c + 2 < 64) HG_STORE(A, (c + 2) % 3); if (c + 4 < 64) HG_LOAD(A, c + 4); if (c > 0) HG_NORM(c - 1); } else HG_COMPUTE(c);
        __syncthreads();
        if (helper) { if (c + 3 < 64) HG_STORE(B, (c + 3) % 3); if (c + 5 < 64) HG_LOAD(B, c + 5); HG_NORM(c); } else HG_COMPUTE(c + 1);
        __syncthreads();
    }
    if (helper) HG_NORM(63);
    __syncthreads();
#undef HG_LOAD
#undef HG_STORE
#undef HG_COMPUTE
#undef HG_NORM
}
template <int NJ>
DI void s5_gemm2_tile(const bf16x8 (&af)[16], const bf16_t* KTl, const bf16_t* Xin, const bf16_t* MBg, bf16_t* Yout, bf16_t* stg, const int mi, const int r, const int h) {
    f32x16 y;
#pragma unroll
    for (int i = 0; i < 16; ++i) y[i] = 0.f;
    const int tsel = r >> 4, iq = r & 15;
    bf16x8 bm[8];
#pragma unroll
    for (int ks = 0; ks < 8; ++ks) bm[ks] = *(const bf16x8*)(MBg + (size_t)((NJ * 8 + ks) * 64 + h * 32 + r) * 8);
#pragma unroll
    for (int ks = 0; ks <= 2 * NJ; ++ks) {
        const bf16x8 bk = *(const bf16x8*)(KTl + ((2 * NJ + tsel - ks) * 16 + iq) * 16 + 8 * h);
        y = __builtin_amdgcn_mfma_f32_32x32x16_bf16(af[ks], bk, y, 0, 0, 0);
    }
    {
        bf16x8 bk = *(const bf16x8*)(KTl + iq * 16 + 8 * h);
        if (tsel == 0) bk = (bf16x8){0, 0, 0, 0, 0, 0, 0, 0};
        y = __builtin_amdgcn_mfma_f32_32x32x16_bf16(af[2 * NJ + 1], bk, y, 0, 0, 0);
    }
#pragma unroll
    for (int ks = 0; ks < 8; ++ks) {
        const bf16x8 a = *(const bf16x8*)(Xin + (mi * 32 + r) * 136 + ks * 16 + 8 * h);
        y = __builtin_amdgcn_mfma_f32_32x32x16_bf16(a, bm[ks], y, 0, 0, 0);
    }
#pragma unroll
    for (int i = 0; i < 16; ++i) stg[((crow(i, h) * 2 + tsel) * 16) + iq] = f2bf(gelu_as(y[i]));
    {
        const int lane = h * 32 + r, cl = lane >> 1, ts = lane & 1;
        const u32x4 lo = *(const u32x4*)(stg + lane * 16), hi = *(const u32x4*)(stg + lane * 16 + 8);
        bf16_t* dst = Yout + (size_t)((mi * 32 + cl) * 16 + 2 * NJ + ts) * DSS;
        *(u32x4*)dst = lo; *(u32x4*)(dst + 8) = hi;
    }
}
DI void s5_gemm_item(const Params& p, int b, int g, char* smem) {
    float* E = (float*)smem;
    bf16_t* Xin = (bf16_t*)(smem + 128 * 132 * 4);
    bf16_t* KTl = Xin + 128 * 136;
    const int tid = my_tid(), lane = tid & 63, wid = tid >> 6, r = lane & 31, h = lane >> 5;
    const int mi = wid >> 1, wh = wid & 1;
    const bf16_t* P = (const bf16_t*)(p.ws + OFF_PROJ);
    *(u32x4*)(KTl + tid * 8) = *(const u32x4*)((const bf16_t*)(p.ws + OFF_S5K) + (size_t)g * 4096 + tid * 8);
    bf16x8 af[16];
    {
        const bf16_t* ub = P + (size_t)(b * SEQ + (mi * 32 + r) * 16) * INC + 2048 + g * 16 + 8 * h;
#pragma unroll
        for (int ks = 0; ks < 16; ++ks) af[ks] = *(const bf16x8*)(ub + (size_t)ks * INC);
    }
#ifndef S5_REP_G1
#define S5_REP_G1 1
#define S5_REP_SC 1
#define S5_REP_G2 1
#endif
    for (int rp1 = 0; rp1 < S5_REP_G1; ++rp1)
    {
        f32x16 e0, e1;
#pragma unroll
        for (int i = 0; i < 16; ++i) { e0[i] = 0.f; e1[i] = 0.f; }
        const bf16_t* nb0 = (const bf16_t*)(p.ws + OFF_S5N) + (size_t)g * 128 * 256 + (size_t)(wh * 2) * 16 * 512 + lane * 8;
#pragma unroll
        for (int ks = 0; ks < 16; ++ks) {
            const bf16x8 b0 = *(const bf16x8*)(nb0 + ks * 512), b1 = *(const bf16x8*)(nb0 + 16 * 512 + ks * 512);
            e0 = __builtin_amdgcn_mfma_f32_32x32x16_bf16(af[ks], b0, e0, 0, 0, 0);
            e1 = __builtin_amdgcn_mfma_f32_32x32x16_bf16(af[ks], b1, e1, 0, 0, 0);
        }
#pragma unroll
        for (int i = 0; i < 16; ++i) { float* er = E + (mi * 32 + crow(i, h)) * 132 + wh * 64 + r; er[0] = e0[i]; er[32] = e1[i]; }
    }
    __syncthreads();
    for (int rp2 = 0; rp2 < S5_REP_SC; ++rp2)
    if (wid == 0) {
        const float* L = (const float*)(p.ws + OFF_S5L) + (g * 64 + lane) * 2;
        const float lr = L[0], li = L[1];
        float xr = 0.f, xi = 0.f;
#pragma unroll 8
        for (int c = 0; c < 128; ++c) {
            const float er = E[c * 132 + lane], ei = E[c * 132 + 64 + lane];
            Xin[c * 136 + lane] = f2bf(xr); Xin[c * 136 + 64 + lane] = f2bf(xi);
            const float nr = lr * xr - li * xi + er, ni = lr * xi + li * xr + ei;
            xr = nr; xi = ni;
        }
    }
    __syncthreads();
    const bf16_t* MBg = (const bf16_t*)(p.ws + OFF_S5M) + (size_t)g * 256 * 128;
    bf16_t* Yout = (bf16_t*)(p.ws + OFF_YSSM) + (size_t)b * SEQ * DSS + g * 16;
    bf16_t* stg = (bf16_t*)smem + wid * 1024;
    for (int rp3 = 0; rp3 < S5_REP_G2; ++rp3)
    if (wh) {
        s5_gemm2_tile<1>(af, KTl, Xin, MBg, Yout, stg, mi, r, h); s5_gemm2_tile<6>(af, KTl, Xin, MBg, Yout, stg, mi, r, h);
        s5_gemm2_tile<3>(af, KTl, Xin, MBg, Yout, stg, mi, r, h); s5_gemm2_tile<4>(af, KTl, Xin, MBg, Yout, stg, mi, r, h);
    } else {
        s5_gemm2_tile<0>(af, KTl, Xin, MBg, Yout, stg, mi, r, h); s5_gemm2_tile<7>(af, KTl, Xin, MBg, Yout, stg, mi, r, h);
        s5_gemm2_tile<2>(af, KTl, Xin, MBg, Yout, stg, mi, r, h); s5_gemm2_tile<5>(af, KTl, Xin, MBg, Yout, stg, mi, r, h);
    }
    __syncthreads();
}
DI void phase_mix(const Params& p, int bid, int nb, char* smem) {
    if (nb == 256) {
#ifndef PROBE_HGX
#define PROBE_HGX 1
#endif
        if (bid < 64) { for (int rep = 0; rep < PROBE_HGX; ++rep) hgrn_mfma_item(p, bid, smem); return; }
        const int j = bid - 64, x = j & 7, lb = j >> 3;
#ifndef PROBE_S5X
#define PROBE_S5X 1
#endif
        for (int rep = 0; rep < PROBE_S5X; ++rep)
        for (int q = lb; q < 64; q += 24) s5_gemm_item(p, q & 15, x * 4 + (q >> 4), smem);
    } else {
        for (int it = bid; it < 64; it += nb) hgrn_mfma_item(p, it, smem);
        for (int q = bid; q < 512; q += nb) s5_gemm_item(p, q & 15, q >> 4, smem);
    }
}

DI void phase_glu(const Params& p, int bid, int nb, char* smem) {
    pg8::Gemm g{(const bf16_t*)(p.ws + OFF_YSSM), (const bf16_t*)(p.ws + OFF_GLU), NTOK, 512, 512};
    pg8::StaticOrder S; S.init(NTOK, 512, nb, bid);
    pg8::EpiGlu E{(float*)(p.ws + OFF_H), (const bf16_t*)(p.ws + OFF_YSSM), p.glu_b};
    pg8::gemm_phase<pg8::EpiGlu, pg8::StaticOrder, false>((PG8_LAS unsigned char*)smem, g, S, E, nullptr);
}
DI void phase_a2(const Params& p, int bid, int nb) {
    const float* Y2 = (const float*)(p.ws + OFF_H);
    const bf16_t* P = (const bf16_t*)(p.ws + OFF_PROJ);
    bf16_t* A2 = (bf16_t*)(p.ws + OFF_A2);
    const int lane = my_tid() & 63, wid = my_tid() >> 6;
    for (int tok = bid * 8 + wid; tok < NTOK; tok += nb * 8) {
        const int c0 = lane * 8;
        {
            const float4 a = *(const float4*)(Y2 + (size_t)tok * DSS + c0), b = *(const float4*)(Y2 + (size_t)tok * DSS + c0 + 4);
            float ss = a.x * a.x + a.y * a.y + a.z * a.z + a.w * a.w + b.x * b.x + b.y * b.y + b.z * b.z + b.w * b.w;
#pragma unroll
            for (int m = 1; m < 64; m <<= 1) ss += __shfl_xor(ss, m);
            const float rs = rsqrtf(ss * (1.0f / 512.0f) + RMS_EPS);
            const float4 w0 = *(const float4*)(p.ssm_nw + c0), w1 = *(const float4*)(p.ssm_nw + c0 + 4);
            uint4 o;
            o.x = pack2(a.x * rs * w0.x, a.y * rs * w0.y); o.y = pack2(a.z * rs * w0.z, a.w * rs * w0.w);
            o.z = pack2(b.x * rs * w1.x, b.y * rs * w1.y); o.w = pack2(b.z * rs * w1.z, b.w * rs * w1.w);
            *(uint4*)(A2 + (size_t)tok * DM + 512 + c0) = o;
        }
    }
}

DI void phase_outproj(const Params& p, int bid, int nb, char* smem) {
    pg8::Gemm g{(const bf16_t*)(p.ws + OFF_A2), (const bf16_t*)(p.ws + OFF_WOUT), NTOK, DM, DM};
    pg8::StaticOrder S; S.init(NTOK, DM, nb, bid);
    pg8::EpiResid E{p.out, p.x, (const float*)(p.ws + OFF_MOD) + 2048, DEEP_ALPHA, (bf16_t*)(p.ws + OFF_H), (const float*)(p.ws + OFF_AB), (float*)(p.ws + OFF_STAT)};
    pg8::gemm_phase<pg8::EpiResid, pg8::StaticOrder, false>((PG8_LAS unsigned char*)smem, g, S, E, nullptr);
}
DI void phase_ln1(const Params& p, int bid, int nb) {
    const float* mod = (const float*)(p.ws + OFF_MOD);
    bf16_t* H2 = (bf16_t*)(p.ws + OFF_H);
    const int lane = my_tid() & 63, wid = my_tid() >> 6;
    for (int tok = bid * 8 + wid; tok < NTOK; tok += nb * 8) {
        const int b = tok / SEQ;
        float* row = p.out + (size_t)tok * DM;
        float4 v[4];
        float s = 0.f;
#pragma unroll
        for (int j = 0; j < 4; ++j) { v[j] = *(const float4*)(row + j * 256 + lane * 4); s += v[j].x + v[j].y + v[j].z + v[j].w; }
#pragma unroll
        for (int m = 1; m < 64; m <<= 1) s += __shfl_xor(s, m);
        const float mu = s * (1.0f / 1024.0f);
        float q = 0.f;
#pragma unroll
        for (int j = 0; j < 4; ++j) { const float a = v[j].x - mu, bb = v[j].y - mu, cc = v[j].z - mu, d = v[j].w - mu; q += a * a + bb * bb + cc * cc + d * d; }
#pragma unroll
        for (int m = 1; m < 64; m <<= 1) q += __shfl_xor(q, m);
        const float rstd = rsqrtf(q * (1.0f / 1024.0f) + LN_EPS);
        const float* sh2 = mod + b * 6144 + 3072;
        const float* sc2 = mod + b * 6144 + 4096;
#pragma unroll
        for (int j = 0; j < 4; ++j) {
            const int c = j * 256 + lane * 4;
            const float4 w = *(const float4*)(p.ln1w + c), bi = *(const float4*)(p.ln1b + c), sc = *(const float4*)(sc2 + c), sh = *(const float4*)(sh2 + c);
            float4 o;
            o.x = (v[j].x - mu) * rstd * w.x + bi.x; o.y = (v[j].y - mu) * rstd * w.y + bi.y; o.z = (v[j].z - mu) * rstd * w.z + bi.z; o.w = (v[j].w - mu) * rstd * w.w + bi.w;
            *(float4*)(row + c) = o;
            uint2 hh; hh.x = pack2(o.x * (1.f + sc.x) + sh.x, o.y * (1.f + sc.y) + sh.y); hh.y = pack2(o.z * (1.f + sc.z) + sh.z, o.w * (1.f + sc.w) + sh.w);
            *(uint2*)(H2 + (size_t)tok * DM + c) = hh;
        }
    }
}

DI void phase_q(const Params& p, int bid, int nb, char* smem) {
    pg8::Gemm g{(const bf16_t*)(p.ws + OFF_H), (const bf16_t*)(p.ws + OFF_WQ), NTOK, 2048, DM};
    pg8::StaticOrder S; S.init(NTOK, 2048, nb, bid);
    pg8::EpiQLN E{(bf16_t*)(p.ws + OFF_PROJ), (const float*)(p.ws + OFF_STAT), (const float*)(p.ws + OFF_CAB), (const float*)(p.ws + OFF_CAB) + NB * 2048, LN_EPS};
    pg8::gemm_phase<pg8::EpiQLN, pg8::StaticOrder, false>((PG8_LAS unsigned char*)smem, g, S, E, nullptr);
}
DI void phase_topk(const Params& p, int bid, int nb, char* smem) {
    const bf16_t* Q = (const bf16_t*)(p.ws + OFF_PROJ);
    const bf16_t* SK = (const bf16_t*)(p.ws + OFF_SUBK);
    unsigned* TOPL = (unsigned*)(p.ws + OFF_TOPL);
    float* sc = (float*)(smem + 36864);
    constexpr int NTM = NTOK / 128;
    for (int t = bid; t < NTM * 16; t += nb) {
        const int mt = t >> 4, hp = t & 15;
        gemm_block<2, 1, 2, 4>(Q + (size_t)mt * 128 * 2048 + hp * 128, 2048, SK + (size_t)hp * 128 * 128, 128, 128, smem,
                               [&](int r, int c, float v) { sc[r * 129 + c] = v; });
        __syncthreads();
        if (my_tid() < 128) {
            const int r = my_tid();
            float tk[16];
#pragma unroll
            for (int j = 0; j < 16; ++j) tk[j] = -3.0e38f;
            for (int n = 0; n < 128; ++n) {
                float xv = __uint_as_float((__float_as_uint(sc[r * 129 + n]) & ~0x7fu) | (unsigned)n);
#pragma unroll
                for (int j = 0; j < 16; ++j) { const float hi = fmaxf(tk[j], xv), lo = fminf(tk[j], xv); tk[j] = hi; xv = lo; }
            }
            uint4* dst = (uint4*)(TOPL + ((size_t)(mt * 128 + r) * 16 + hp) * 16);
            dst[0] = make_uint4(__float_as_uint(tk[0]), __float_as_uint(tk[1]), __float_as_uint(tk[2]), __float_as_uint(tk[3]));
            dst[1] = make_uint4(__float_as_uint(tk[4]), __float_as_uint(tk[5]), __float_as_uint(tk[6]), __float_as_uint(tk[7]));
            dst[2] = make_uint4(__float_as_uint(tk[8]), __float_as_uint(tk[9]), __float_as_uint(tk[10]), __float_as_uint(tk[11]));
            dst[3] = make_uint4(__float_as_uint(tk[12]), __float_as_uint(tk[13]), __float_as_uint(tk[14]), __float_as_uint(tk[15]));
        }
        __syncthreads();
    }
}
DI void phase_combine(const Params& p, int bid, int nb) {
    const unsigned* TOPL = (const unsigned*)(p.ws + OFF_TOPL);
    uint2* EX = (uint2*)(p.ws + OFF_EXPS);
    const float* SU = (const float*)(p.ws + OFF_SU);
    const float* SV = (const float*)(p.ws + OFF_SV);
    for (int i = bid * NTH + my_tid(); i < NTOK * PHEADS; i += nb * NTH) {
        const unsigned* l1 = TOPL + (size_t)i * 32;
        const unsigned* l2 = l1 + 16;
        float s2[16];
        {
            const uint4 a = ((const uint4*)l2)[0], b = ((const uint4*)l2)[1], c = ((const uint4*)l2)[2], d = ((const uint4*)l2)[3];
            const unsigned w[16] = {a.x, a.y, a.z, a.w, b.x, b.y, b.z, b.w, c.x, c.y, c.z, c.w, d.x, d.y, d.z, d.w};
#pragma unroll
            for (int j = 0; j < 16; ++j) s2[j] = __uint_as_float(w[j] & ~0x7fu);
        }
        float tk[16];
#pragma unroll
        for (int j = 0; j < 16; ++j) tk[j] = -3.0e38f;
        for (int a = 0; a < 16; ++a) {
            const float s1 = __uint_as_float(l1[a] & ~0x7fu);
#pragma unroll
            for (int b = 0; b < 16; ++b) {
                float xv = __uint_as_float((__float_as_uint(s1 + s2[b]) & ~0xffu) | (unsigned)(a * 16 + b));
#pragma unroll
                for (int j = 0; j < 16; ++j) { const float hi = fmaxf(tk[j], xv), lo = fminf(tk[j], xv); tk[j] = hi; xv = lo; }
            }
        }
        float e[16], sum = 0.f;
        const float mx = __uint_as_float(__float_as_uint(tk[0]) & ~0xffu);
#pragma unroll
        for (int j = 0; j < 16; ++j) { e[j] = __expf(__uint_as_float(__float_as_uint(tk[j]) & ~0xffu) - mx); sum += e[j]; }
        const float inv = 1.0f / sum;
#pragma unroll
        for (int j = 0; j < 16; ++j) {
            const unsigned ab = __float_as_uint(tk[j]) & 0xffu;
            const unsigned i1 = l1[ab >> 4] & 0x7fu, i2 = l2[ab & 15] & 0x7fu;
            const unsigned eid = i1 * 128u + i2;
            EX[(size_t)i * 16 + j] = make_uint2(eid | (((__float_as_uint(SU[eid]) >> 23) & 0xffu) << 16), __float_as_uint(e[j] * inv * SV[eid]));
        }
    }
}

DI void ce_desc(float& a, float& b) { const float hi = fmaxf(a, b), lo = fminf(a, b); a = hi; b = lo; }
template <int N> DI void bitonic_sort_desc(float (&v)[N]) {
#pragma unroll
    for (int k = 2; k <= N; k <<= 1)
#pragma unroll
        for (int j = k >> 1; j > 0; j >>= 1)
#pragma unroll
            for (int i = 0; i < N; ++i) { const int l = i ^ j; if (l > i) { if ((i & k) == 0 || k == N) ce_desc(v[i], v[l]); else ce_desc(v[l], v[i]); } }
}
DI void merge_top16(float (&a)[16], const float (&b)[16]) {
#pragma unroll
    for (int i = 0; i < 16; ++i) a[i] = fmaxf(a[i], b[15 - i]);
#pragma unroll
    for (int j = 8; j > 0; j >>= 1)
#pragma unroll
        for (int i = 0; i < 16; ++i) { const int l = i ^ j; if (l > i) ce_desc(a[i], a[l]); }
}
DI void xlane_merge16(float (&a)[16]) {
    float o[16];
#pragma unroll
    for (int i = 0; i < 16; ++i) o[i] = __shfl_xor(a[i], 32);
    merge_top16(a, o);
}
DI void retrieve_topk_hp(const bf16_t* Q, const char* skl, const int tok, const int hp_next, const int r, const int h, unsigned char* lutp, float (&out)[16], bf16x8 (&bq)[8]) {
                f32x16 acc[4];
#pragma unroll
                for (int mi = 0; mi < 4; ++mi)
#pragma unroll
                    for (int i = 0; i < 16; ++i) acc[mi][i] = 0.f;
                const char* kb = skl + r * 272 + h * 16;
#pragma unroll
                for (int ks = 0; ks < 8; ++ks) {
#pragma unroll
                    for (int mi = 0; mi < 4; ++mi) {
                        const bf16x8 a = *(const bf16x8*)(kb + mi * 32 * 272 + ks * 32);
                        acc[mi] = __builtin_amdgcn_mfma_f32_32x32x16_bf16(a, bq[ks], acc[mi], 0, 0, 0);
                    }
                }
                {
                    const bf16_t* qb = Q + (size_t)tok * 2048 + hp_next * 128 + 8 * h;
#pragma unroll
                    for (int ks = 0; ks < 8; ++ks) bq[ks] = *(const bf16x8*)(qb + ks * 16);
                }
                float v0[16], v1[16], v2[16], v3[16];
#pragma unroll
                for (int i = 0; i < 16; ++i) {
                    const unsigned n = (unsigned)crow(i, h);
                    v0[i] = __uint_as_float((__float_as_uint(acc[0][i]) & ~0x7fu) | n);
                    v1[i] = __uint_as_float((__float_as_uint(acc[1][i]) & ~0x7fu) | (n + 32u));
                    v2[i] = __uint_as_float((__float_as_uint(acc[2][i]) & ~0x7fu) | (n + 64u));
                    v3[i] = __uint_as_float((__float_as_uint(acc[3][i]) & ~0x7fu) | (n + 96u));
                }
                bitonic_sort_desc<16>(v0); bitonic_sort_desc<16>(v1); bitonic_sort_desc<16>(v2); bitonic_sort_desc<16>(v3);
                merge_top16(v0, v1); merge_top16(v2, v3); merge_top16(v0, v2);
                xlane_merge16(v0);
#pragma unroll
                for (int i = 0; i < 16; ++i) out[i] = v0[i];
                u32x4 ix;
                ix.x = (__float_as_uint(v0[0]) & 0x7fu) | ((__float_as_uint(v0[1]) & 0x7fu) << 8) | ((__float_as_uint(v0[2]) & 0x7fu) << 16) | ((__float_as_uint(v0[3]) & 0x7fu) << 24);
                ix.y = (__float_as_uint(v0[4]) & 0x7fu) | ((__float_as_uint(v0[5]) & 0x7fu) << 8) | ((__float_as_uint(v0[6]) & 0x7fu) << 16) | ((__float_as_uint(v0[7]) & 0x7fu) << 24);
                ix.z = (__float_as_uint(v0[8]) & 0x7fu) | ((__float_as_uint(v0[9]) & 0x7fu) << 8) | ((__float_as_uint(v0[10]) & 0x7fu) << 16) | ((__float_as_uint(v0[11]) & 0x7fu) << 24);
                ix.w = (__float_as_uint(v0[12]) & 0x7fu) | ((__float_as_uint(v0[13]) & 0x7fu) << 8) | ((__float_as_uint(v0[14]) & 0x7fu) << 16) | ((__float_as_uint(v0[15]) & 0x7fu) << 24);
                *(u32x4*)lutp = ix;
}
DI void phase_retrieve(const Params& p, int bid, int nb, char* smem) {
    const bf16_t* Q = (const bf16_t*)(p.ws + OFF_PROJ);
    const bf16_t* SK = (const bf16_t*)(p.ws + OFF_SUBK);
    const float* SU = (const float*)(p.ws + OFF_SU);
    const float* SV = (const float*)(p.ws + OFF_SV);
    uint2* EX = (uint2*)(p.ws + OFF_EXPS);
    const int tid = my_tid(), lane = tid & 63, wid = tid >> 6, r = lane & 31, h = lane >> 5;
    unsigned char* lut = (unsigned char*)smem + wid * 2048 + lane * 32;
    char* skb0 = smem + 16384;
    char* skb1 = skb0 + 128 * 272;
    u32x4 sr0, sr1, sr2, sr3;
#define SK_LOAD(hp_) { const bf16_t* g_ = SK + (size_t)(hp_) * 16384 + tid * 8; sr0 = *(const u32x4*)g_; sr1 = *(const u32x4*)(g_ + 4096); sr2 = *(const u32x4*)(g_ + 8192); sr3 = *(const u32x4*)(g_ + 12288); }
#define SK_STORE(buf_) { char* d_ = (buf_) + (tid >> 4) * 272 + (tid & 15) * 16; *(u32x4*)d_ = sr0; *(u32x4*)(d_ + 32 * 272) = sr1; *(u32x4*)(d_ + 64 * 272) = sr2; *(u32x4*)(d_ + 96 * 272) = sr3; }
    for (int it = bid; it < (NTOK / 256) * 2; it += nb) {
        const int hq = it & 1, tok = (it >> 1) * 256 + wid * 32 + r;
        __syncthreads();
        SK_LOAD(hq * 8); SK_STORE(skb0);
        bf16x8 bq[8];
        {
            const bf16_t* qb = Q + (size_t)tok * 2048 + (hq * 8) * 128 + 8 * h;
#pragma unroll
            for (int ks = 0; ks < 8; ++ks) bq[ks] = *(const bf16x8*)(qb + ks * 16);
        }
        __syncthreads();
#pragma unroll 1
        for (int hd = hq * 4; hd < hq * 4 + 4; ++hd) {
            float L0[16], L1[16];
            SK_LOAD(hd * 2 + 1);
            retrieve_topk_hp(Q, skb0, tok, hd * 2 + 1, r, h, lut, L0, bq);
            SK_STORE(skb1);
            __syncthreads();
            if (hd + 1 < hq * 4 + 4) SK_LOAD(hd * 2 + 2);
            retrieve_topk_hp(Q, skb1, tok, (hd + 1 < hq * 4 + 4) ? hd * 2 + 2 : hd * 2 + 1, r, h, lut + 16, L1, bq);
            if (hd + 1 < hq * 4 + 4) SK_STORE(skb0);
            __syncthreads();
            float c[32];
            {
                constexpr int PA[50] = {0, 0, 0, 0, 0, 0, 0, 0, 0, 0, 0, 0, 0, 0, 0, 0, 1, 1, 1, 1, 1, 1, 1, 1, 2, 2, 2, 2, 2, 3, 3, 3, 3, 4, 4, 4, 5, 5, 6, 6, 7, 7, 8, 9, 10, 11, 12, 13, 14, 15};
                constexpr int PB[50] = {0, 1, 2, 3, 4, 5, 6, 7, 8, 9, 10, 11, 12, 13, 14, 15, 0, 1, 2, 3, 4, 5, 6, 7, 0, 1, 2, 3, 4, 0, 1, 2, 3, 0, 1, 2, 0, 1, 0, 1, 0, 1, 0, 0, 0, 0, 0, 0, 0, 0};
#pragma unroll
                for (int q = 0; q < 25; ++q) {
                    const float s0 = __uint_as_float(__float_as_uint(L0[PA[2 * q]]) & ~0x7fu) + __uint_as_float(__float_as_uint(L1[PB[2 * q]]) & ~0x7fu);
                    const float s1 = __uint_as_float(__float_as_uint(L0[PA[2 * q + 1]]) & ~0x7fu) + __uint_as_float(__float_as_uint(L1[PB[2 * q + 1]]) & ~0x7fu);
                    const float p0 = __uint_as_float((__float_as_uint(s0) & ~0xffu) | (unsigned)(PA[2 * q] * 16 + PB[2 * q]));
                    const float p1 = __uint_as_float((__float_as_uint(s1) & ~0xffu) | (unsigned)(PA[2 * q + 1] * 16 + PB[2 * q + 1]));
                    c[q] = h ? p1 : p0;
                }
#pragma unroll
                for (int i = 25; i < 32; ++i) c[i] = -3.0e38f;
            }
            bitonic_sort_desc<32>(c);
            float t16[16];
#pragma unroll
            for (int i = 0; i < 16; ++i) t16[i] = c[i];
            xlane_merge16(t16);
            const float mx = __uint_as_float(__float_as_uint(t16[0]) & ~0xffu);
            float e[16], sum = 0.f;
#pragma unroll
            for (int j = 0; j < 16; ++j) { e[j] = __expf(__uint_as_float(__float_as_uint(t16[j]) & ~0xffu) - mx); sum += e[j]; }
            const float inv = 1.0f / sum;
            uint2* dst = EX + ((size_t)tok * 8 + hd) * 16 + 8 * h;
#pragma unroll
            for (int j = 0; j < 8; ++j) {
                float tlo = t16[j], thi = t16[8 + j], elo = e[j], ehi = e[8 + j];
                asm volatile("" : "+v"(tlo), "+v"(thi), "+v"(elo), "+v"(ehi));
                const float tv = h ? thi : tlo, ev = h ? ehi : elo;
                const unsigned ab = __float_as_uint(tv) & 0xffu;
                const unsigned eid = (unsigned)lut[ab >> 4] * 128u + (unsigned)lut[16 + (ab & 15u)];
                dst[j] = make_uint2(eid | (pack2(0.f, SU[eid]) & 0xffff0000u), __float_as_uint(ev * inv * SV[eid]));
            }
        }
    }
#undef SK_LOAD
#undef SK_STORE
}

DI float dot16_fp8(const u32x4 w, const f32x2 (&h)[8]) {
    f32x2 acc = __builtin_amdgcn_cvt_pk_f32_fp8((int)w.x, false) * h[0];
    acc += __builtin_amdgcn_cvt_pk_f32_fp8((int)w.x, true) * h[1];
    acc += __builtin_amdgcn_cvt_pk_f32_fp8((int)w.y, false) * h[2];
    acc += __builtin_amdgcn_cvt_pk_f32_fp8((int)w.y, true) * h[3];
    acc += __builtin_amdgcn_cvt_pk_f32_fp8((int)w.z, false) * h[4];
    acc += __builtin_amdgcn_cvt_pk_f32_fp8((int)w.z, true) * h[5];
    acc += __builtin_amdgcn_cvt_pk_f32_fp8((int)w.w, false) * h[6];
    acc += __builtin_amdgcn_cvt_pk_f32_fp8((int)w.w, true) * h[7];
    return acc.x + acc.y;
}
DI void axpy16_fp8(const float a, const u32x4 w, f32x2 (&o)[8]) {
    const f32x2 aa = {a, a};
    o[0] += aa * __builtin_amdgcn_cvt_pk_f32_fp8((int)w.x, false); o[1] += aa * __builtin_amdgcn_cvt_pk_f32_fp8((int)w.x, true);
    o[2] += aa * __builtin_amdgcn_cvt_pk_f32_fp8((int)w.y, false); o[3] += aa * __builtin_amdgcn_cvt_pk_f32_fp8((int)w.y, true);
    o[4] += aa * __builtin_amdgcn_cvt_pk_f32_fp8((int)w.z, false); o[5] += aa * __builtin_amdgcn_cvt_pk_f32_fp8((int)w.z, true);
    o[6] += aa * __builtin_amdgcn_cvt_pk_f32_fp8((int)w.w, false); o[7] += aa * __builtin_amdgcn_cvt_pk_f32_fp8((int)w.w, true);
}
DI float butterfly64(float (&pz)[64], const int lane) {
    const bool b5 = lane & 32, b4 = lane & 16, b3 = lane & 8, b2 = lane & 4, b1 = lane & 2, b0 = lane & 1;
    float q32[32], q16[16], q8[8], q4[4], q2[2];
#pragma unroll
    for (int j = 0; j < 32; ++j) q32[j] = (b5 ? pz[32 + j] : pz[j]) + __shfl_xor(b5 ? pz[j] : pz[32 + j], 32);
#pragma unroll
    for (int j = 0; j < 16; ++j) q16[j] = (b4 ? q32[16 + j] : q32[j]) + __shfl_xor(b4 ? q32[j] : q32[16 + j], 16);
#pragma unroll
    for (int j = 0; j < 8; ++j) q8[j] = (b3 ? q16[8 + j] : q16[j]) + __shfl_xor(b3 ? q16[j] : q16[8 + j], 8);
#pragma unroll
    for (int j = 0; j < 4; ++j) q4[j] = (b2 ? q8[4 + j] : q8[j]) + __shfl_xor(b2 ? q8[j] : q8[4 + j], 4);
#pragma unroll
    for (int j = 0; j < 2; ++j) q2[j] = (b1 ? q4[2 + j] : q4[j]) + __shfl_xor(b1 ? q4[j] : q4[2 + j], 2);
    return (b0 ? q2[1] : q2[0]) + __shfl_xor(b0 ? q2[0] : q2[1], 1);
}
DI float bfly8(float (&pz)[8], const int lane) {
    const bool b2 = lane & 4, b1 = lane & 2, b0 = lane & 1;
    float q4[4], q2[2];
#pragma unroll
    for (int i = 0; i < 4; ++i) q4[i] = (b2 ? pz[4 + i] : pz[i]) + __shfl_xor(b2 ? pz[i] : pz[4 + i], 4);
#pragma unroll
    for (int i = 0; i < 2; ++i) q2[i] = (b1 ? q4[2 + i] : q4[i]) + __shfl_xor(b1 ? q4[i] : q4[2 + i], 2);
    float q = (b0 ? q2[1] : q2[0]) + __shfl_xor(b0 ? q2[0] : q2[1], 1);
    q += __shfl_xor(q, 8); q += __shfl_xor(q, 16); q += __shfl_xor(q, 32);
    return q;
}
DI float bfly16(float (&pz)[16], const int lane) {
    const bool b3 = lane & 8, b2 = lane & 4, b1 = lane & 2, b0 = lane & 1;
    float q8[8], q4[4], q2[2];
#pragma unroll
    for (int i = 0; i < 8; ++i) q8[i] = (b3 ? pz[8 + i] : pz[i]) + __shfl_xor(b3 ? pz[i] : pz[8 + i], 8);
#pragma unroll
    for (int i = 0; i < 4; ++i) q4[i] = (b2 ? q8[4 + i] : q8[i]) + __shfl_xor(b2 ? q8[i] : q8[4 + i], 4);
#pragma unroll
    for (int i = 0; i < 2; ++i) q2[i] = (b1 ? q4[2 + i] : q4[i]) + __shfl_xor(b1 ? q4[i] : q4[2 + i], 2);
    float q = (b0 ? q2[1] : q2[0]) + __shfl_xor(b0 ? q2[0] : q2[1], 1);
    q += __shfl_xor(q, 16); q += __shfl_xor(q, 32);
    return q;
}
DI void gs_issue(const __amdgpu_buffer_rsrc_t T, const uint2* ent, const unsigned d, const int lane, u32x4 (&w)[8], unsigned& ca) {
    const int cnt = (int)((d >> 16) & 0xfu), k = lane & 7;
    const uint2 e = ent[(d & 0xffffu) + (unsigned)(k < cnt ? k : cnt - 1)];
    ca = (k < cnt && !(d >> 31)) ? e.y : 0u;
#pragma unroll
    for (int q = 0; q < 8; ++q) {
        const int eid = __builtin_amdgcn_readlane((int)e.x, q) & 0x3fff;
        w[q] = __builtin_amdgcn_raw_buffer_load_b128(T, lane * 16, eid * DM, 0);
    }
}
DI float dot16_i8(const u32x4 w, const u32x4 h) {
    int acc = __builtin_amdgcn_sdot4((int)w.x, (int)h.x, 0, false);
    acc = __builtin_amdgcn_sdot4((int)w.y, (int)h.y, acc, false);
    acc = __builtin_amdgcn_sdot4((int)w.z, (int)h.z, acc, false);
    acc = __builtin_amdgcn_sdot4((int)w.w, (int)h.w, acc, false);
    return (float)acc;
}
DI void gs_desc(const uint2* ent, const unsigned d, const int lane, unsigned& ex) {
    const int cnt = (int)((d >> 16) & 0xfu), k = lane & 7;
    ex = ent[(d & 0xffffu) + (unsigned)(k < cnt ? k : cnt - 1)].x;
}
DI void gs_loads(const __amdgpu_buffer_rsrc_t T, const unsigned ex, const int lane, u32x4 (&w)[8]) {
#pragma unroll
    for (int q = 0; q < 8; ++q) {
        const int eid = __builtin_amdgcn_readlane((int)ex, q) & 0x3fff;
        w[q] = __builtin_amdgcn_raw_buffer_load_b128(T, lane * 16, eid * DM, 0);
    }
}
DI void gs_upartial(const u32x4 (&w)[8], const u32x4 h2q, float (&pz)[16], const int base) {
#pragma unroll
    for (int k = 0; k < 8; ++k) pz[base + k] = dot16_i8(w[k], h2q);
}
DI void gs_ustore(float (&pz)[16], float* zb, const unsigned da, const unsigned db, const int lane) {
    const float z = bfly16(pz, lane);
    const unsigned d = (lane & 8) ? db : da;
    const int k = lane & 7;
    if (lane < 16 && k < (int)((d >> 16) & 0xfu) && !(d >> 31)) zb[(d & 0xffffu) + k] = z;
}
DI void axpy16_u8(const float a, const u32x4 w, float (&o)[16]) {
    o[0] += a * (float)(w.x & 0xffu); o[1] += a * (float)((w.x >> 8) & 0xffu); o[2] += a * (float)((w.x >> 16) & 0xffu); o[3] += a * (float)(w.x >> 24);
    o[4] += a * (float)(w.y & 0xffu); o[5] += a * (float)((w.y >> 8) & 0xffu); o[6] += a * (float)((w.y >> 16) & 0xffu); o[7] += a * (float)(w.y >> 24);
    o[8] += a * (float)(w.z & 0xffu); o[9] += a * (float)((w.z >> 8) & 0xffu); o[10] += a * (float)((w.z >> 16) & 0xffu); o[11] += a * (float)(w.z >> 24);
    o[12] += a * (float)(w.w & 0xffu); o[13] += a * (float)((w.w >> 8) & 0xffu); o[14] += a * (float)((w.w >> 16) & 0xffu); o[15] += a * (float)(w.w >> 24);
}
DI void gs_vcompute(const u32x4 (&w)[8], const unsigned ca, float (&acc)[16]) {
#pragma unroll
    for (int k = 0; k < 8; ++k) { axpy16_u8(__uint_as_float((unsigned)__builtin_amdgcn_readlane((int)ca, k)), w[k], acc); __builtin_amdgcn_sched_barrier(0); }
}
constexpr int GT = 4;
DI void xcd_pace(unsigned* cnt, const unsigned nloc, unsigned& step) {
    __syncthreads();
    if (__builtin_amdgcn_workitem_id_x() == 0) {
        __hip_atomic_fetch_add(cnt, 1u, __ATOMIC_RELAXED, __HIP_MEMORY_SCOPE_AGENT);
        const unsigned target = nloc * (step + 1u);
        unsigned sp = 0;
        while (__hip_atomic_load(cnt, __ATOMIC_RELAXED, __HIP_MEMORY_SCOPE_AGENT) < target) { __builtin_amdgcn_s_sleep(1); if (++sp > (1u << 22)) break; }
    }
    ++step;
    __syncthreads();
}
DI void phase_gather(const Params& p, int bid, int nb, char* smem, unsigned* pace_cnt, const unsigned pace_n) {
    unsigned pstep = 0;
    const float* mod = (const float*)(p.ws + OFF_MOD);
    const float* AB = (const float*)(p.ws + OFF_AB);
    const float* STAT = (const float*)(p.ws + OFF_STAT);
    const uint2* EX = (const uint2*)(p.ws + OFF_EXPS);
    const __amdgpu_buffer_rsrc_t UT = __builtin_amdgcn_make_buffer_rsrc((void*)(p.ws + OFF_UT), 0, NEXP * DM, 0x00020000);
    const __amdgpu_buffer_rsrc_t VT = __builtin_amdgcn_make_buffer_rsrc((void*)(p.ws + OFF_VT), 0, NEXP * DM, 0x00020000);
    const int lane = my_tid() & 63, wid = my_tid() >> 6, c0 = lane * 16;
    char* wl = smem + wid * 7168;
    uint2* ent = (uint2*)wl; float* zb = (float*)(wl + 4096); int* offs = (int*)(wl + 6144); unsigned* sched = (unsigned*)(wl + 6144 + 256);
#pragma unroll 1
    for (int t0 = (bid * 8 + wid) * GT; t0 < NTOK; t0 += nb * 8 * GT) {
        u32x4 h2q[GT]; float hsc[GT], mu[GT], rs[GT]; float acc[GT][16];
        f32x4 scv[4], shv[4];
        {
            const int b = t0 / SEQ;
#pragma unroll
            for (int q = 0; q < 4; ++q) { scv[q] = *(const f32x4*)(AB + (size_t)b * DM + c0 + q * 4); shv[q] = *(const f32x4*)(AB + (size_t)(NB + b) * DM + c0 + q * 4); }
        }
#pragma unroll
        for (int j = 0; j < GT; ++j) {
            const int tok = t0 + j;
            const float* row = p.out + (size_t)tok * DM + c0;
            __builtin_amdgcn_sched_barrier(0);
            { mu[j] = STAT[tok] * (1.0f / 1024.0f); rs[j] = rsqrtf(fmaxf(STAT[NTOK + tok] * (1.0f / 1024.0f) - mu[j] * mu[j], 0.f) + LN_EPS); }
            {
                f32x4 hv[4];
                float m = 0.f;
#pragma unroll
                for (int q = 0; q < 4; ++q) { hv[q] = (*(const f32x4*)(row + q * 4) - mu[j]) * rs[j] * scv[q] + shv[q]; m = fmaxf(m, fmaxf(fmaxf(fabsf(hv[q].x), fabsf(hv[q].y)), fmaxf(fabsf(hv[q].z), fabsf(hv[q].w)))); }
#pragma unroll
                for (int sft = 1; sft < 64; sft <<= 1) m = fmaxf(m, __shfl_xor(m, sft));
                const float qs = m > 1e-30f ? 127.0f / m : 1.0f;
                hsc[j] = m > 1e-30f ? m * (1.0f / 127.0f) : 1.0f;
                unsigned hw[4];
#pragma unroll
                for (int q = 0; q < 4; ++q)
                    hw[q] = ((unsigned)(int)rintf(hv[q].x * qs) & 0xffu) | (((unsigned)(int)rintf(hv[q].y * qs) & 0xffu) << 8) | (((unsigned)(int)rintf(hv[q].z * qs) & 0xffu) << 16) | (((unsigned)(int)rintf(hv[q].w * qs) & 0xffu) << 24);
                h2q[j] = (u32x4){hw[0], hw[1], hw[2], hw[3]};
            }
            const uint2 e0 = EX[(size_t)tok * 128 + lane], e1 = EX[(size_t)tok * 128 + 64 + lane];
            const int s0 = (int)((e0.x & 0x3fffu) >> 11), s1 = (int)((e1.x & 0x3fffu) >> 11);
            int run = 0, pos0 = 0, pos1 = 0;
#pragma unroll
            for (int s = 0; s < 8; ++s) {
                const unsigned long long m0 = __ballot(s0 == s), m1 = __ballot(s1 == s);
                const int c0n = __popcll(m0), c1n = __popcll(m1);
                const int below0 = (int)__builtin_amdgcn_mbcnt_hi((unsigned)(m0 >> 32), __builtin_amdgcn_mbcnt_lo((unsigned)m0, 0u));
                const int below1 = (int)__builtin_amdgcn_mbcnt_hi((unsigned)(m1 >> 32), __builtin_amdgcn_mbcnt_lo((unsigned)m1, 0u));
                if (lane == 0) offs[j * 9 + s] = run;
                pos0 = (s0 == s) ? run + below0 : pos0;
                pos1 = (s1 == s) ? run + c0n + below1 : pos1;
                run += c0n + c1n;
            }
            if (lane == 0) offs[j * 9 + 8] = 128;
            ent[j * 128 + pos0] = e0; ent[j * 128 + pos1] = e1;
        }
        int nbat;
        {
            const int gs = (lane / GT) & 7, gj = lane % GT;
            const int gb = offs[gj * 9 + gs], ge = offs[gj * 9 + gs + 1], cnt = lane < 8 * GT ? ge - gb : 0, nbt = (cnt + 7) >> 3;
            int incl = nbt;
#pragma unroll
            for (int m = 1; m < 32; m <<= 1) { const int o = __shfl_up(incl, m); if ((lane & 31) >= m) incl += o; }
            nbat = __builtin_amdgcn_readlane(incl, 8 * GT - 1);
            const int st = incl - nbt;
            for (int q = 0; q < nbt; ++q) { const int rem = cnt - 8 * q; sched[st + q] = (unsigned)(gj * 128 + gb + 8 * q) | ((unsigned)(rem < 8 ? rem : 8) << 16); }
            if (lane < 3) sched[nbat + lane] = 0x80010000u;
        }
        xcd_pace(pace_cnt, pace_n, pstep);
#ifndef PROBE_UX
#define PROBE_UX 1
#endif
        for (int rep = 0; rep < PROBE_UX; ++rep)
        {
            u32x4 wa[8], wb[8];
#define GS_UP(W_, D_, B_) { const unsigned j_ = ((D_) & 0xffffu) >> 7; \
                if (j_ == 0) gs_upartial(W_, h2q[0], pz, B_); else if (j_ == 1) gs_upartial(W_, h2q[1], pz, B_); \
                else if (j_ == 2) gs_upartial(W_, h2q[2], pz, B_); else gs_upartial(W_, h2q[3], pz, B_); }
#define GS_RD(i_) ((unsigned)__builtin_amdgcn_readfirstlane((int)sched[(i_)]))
            unsigned da = GS_RD(0), db = GS_RD(1), dn = GS_RD(2), ea, eb, en;
            gs_desc(ent, da, lane, ea); gs_desc(ent, db, lane, eb); gs_desc(ent, dn, lane, en);
            gs_loads(UT, ea, lane, wa);
#pragma unroll 1
            for (int i = 0; i < nbat; i += 2) {
                float pz[16];
                gs_loads(UT, eb, lane, wb);
                __builtin_amdgcn_sched_barrier(0);
                GS_UP(wa, da, 0);
                const unsigned dcur_a = da, dcur_b = db;
                da = dn; ea = en; dn = GS_RD(i + 3); gs_desc(ent, dn, lane, en);
                gs_loads(UT, ea, lane, wa);
                __builtin_amdgcn_sched_barrier(0);
                GS_UP(wb, dcur_b, 8);
                db = dn; eb = en; dn = GS_RD(i + 4); gs_desc(ent, dn, lane, en);
                gs_ustore(pz, zb, dcur_a, dcur_b, lane);
            }
#undef GS_UP
#undef GS_RD
        }
        float asum[GT];
#pragma unroll
        for (int j = 0; j < GT; ++j) {
            float as = 0.f;
#pragma unroll
            for (int q = 0; q < 2; ++q) {
                const int pos = j * 128 + q * 64 + lane;
                const uint2 e = ent[pos];
                const float z = zb[pos] * __uint_as_float(e.x & 0xffff0000u) * hsc[j];
                const float a = gelu_as(z) * __uint_as_float(e.y);
                ent[pos].y = __float_as_uint(a);
                as += a;
            }
#pragma unroll
            for (int sft = 1; sft < 64; sft <<= 1) as += __shfl_xor(as, sft);
            asum[j] = as;
        }
        xcd_pace(pace_cnt, pace_n, pstep);
#pragma unroll
        for (int j = 0; j < GT; ++j)
#pragma unroll
            for (int q = 0; q < 16; ++q) acc[j][q] = 0.f;
        {
            u32x4 wa[8]; unsigned ca;
#pragma unroll 1
            for (int i = 0; i < nbat; ++i) {
                const unsigned da = (unsigned)__builtin_amdgcn_readfirstlane((int)sched[i]);
                gs_issue(VT, ent, da, lane, wa, ca);
                __builtin_amdgcn_sched_barrier(0);
                const unsigned j_ = (da & 0xffffu) >> 7;
                if (j_ == 0) gs_vcompute(wa, ca, acc[0]); else if (j_ == 1) gs_vcompute(wa, ca, acc[1]);
                else if (j_ == 2) gs_vcompute(wa, ca, acc[2]); else gs_vcompute(wa, ca, acc[3]);
            }
        }
#pragma unroll
        for (int j = 0; j < GT; ++j) {
            asm volatile("" ::: "memory");
            __builtin_amdgcn_sched_barrier(0);
            const int tok = t0 + j, b = tok / SEQ;
            float* row = p.out + (size_t)tok * DM + c0;
            const float* g2 = mod + b * 6144 + 5120 + c0;
            f32x2 r[8];
            float sm = 0.f;
#pragma unroll
            for (int q = 0; q < 4; ++q) {
                const f32x4 xv = (*(const f32x4*)(row + q * 4) - mu[j]) * rs[j] * *(const f32x4*)(p.ln1w + c0 + q * 4) + *(const f32x4*)(p.ln1b + c0 + q * 4), gg = *(const f32x4*)(g2 + q * 4);
                const float off = 128.0f * asum[j];
                r[2 * q] = DEEP_ALPHA * (f32x2){xv.x, xv.y} + (f32x2){1.f + gg.x, 1.f + gg.y} * (f32x2){acc[j][4 * q] - off, acc[j][4 * q + 1] - off};
                r[2 * q + 1] = DEEP_ALPHA * (f32x2){xv.z, xv.w} + (f32x2){1.f + gg.z, 1.f + gg.w} * (f32x2){acc[j][4 * q + 2] - off, acc[j][4 * q + 3] - off};
                sm += r[2 * q].x + r[2 * q].y + r[2 * q + 1].x + r[2 * q + 1].y;
            }
#pragma unroll
            for (int m = 1; m < 64; m <<= 1) sm += __shfl_xor(sm, m);
            const float mu = sm * (1.0f / 1024.0f);
            float qq = 0.f;
#pragma unroll
            for (int i = 0; i < 8; ++i) { const f32x2 dd = r[i] - mu; qq += dd.x * dd.x + dd.y * dd.y; }
#pragma unroll
            for (int m = 1; m < 64; m <<= 1) qq += __shfl_xor(qq, m);
            const float rstd = rsqrtf(qq * (1.0f / 1024.0f) + LN_EPS);
#pragma unroll
            for (int q = 0; q < 4; ++q) {
                const f32x4 w4 = *(const f32x4*)(p.ln2w + c0 + q * 4), bi = *(const f32x4*)(p.ln2b + c0 + q * 4);
                f32x4 ov;
                ov.x = (r[2 * q].x - mu) * rstd * w4.x + bi.x; ov.y = (r[2 * q].y - mu) * rstd * w4.y + bi.y;
                ov.z = (r[2 * q + 1].x - mu) * rstd * w4.z + bi.z; ov.w = (r[2 * q + 1].y - mu) * rstd * w4.w + bi.w;
                *(f32x4*)(row + q * 4) = ov;
            }
        }
    }
}

#define XB_TMO      128
#define XB_XCNT(j)  (256  + 64 * (j))
#define XB_XSUB(j)  (1280 + 64 * (j))
#define XB_XGEN(j)  (2304 + 64 * (j))
#define XB_TOP      3328
#define XB_TOPGEN   3392
#define XCD_BAR_WORDS 3456
#define XB_SPIN_CAP (1u << 22)
#define LAS __attribute__((address_space(3)))
DI unsigned xb_ld(unsigned* p) { return __hip_atomic_load(p, __ATOMIC_RELAXED, __HIP_MEMORY_SCOPE_AGENT); }
DI unsigned xb_add(unsigned* p, unsigned v) { return __hip_atomic_fetch_add(p, v, __ATOMIC_RELAXED, __HIP_MEMORY_SCOPE_AGENT); }
DI unsigned xb_xcc_id() { return (unsigned)__builtin_amdgcn_s_getreg((3 << 11) | 20) & 0xFu; }
#define XB_SPIN(cond, bar) do { unsigned _sp = 0; while (cond) { __builtin_amdgcn_s_sleep(1); \
    if ((++_sp & 255u) == 0u) { if (xb_ld(&(bar)[XB_TMO])) break; if (_sp > XB_SPIN_CAP) { atomicAdd(&(bar)[XB_TMO], 1u); break; } } } } while (0)
struct XcdBarrier { unsigned* bar; unsigned x; volatile LAS unsigned* st; };
DI XcdBarrier xcd_barrier_post(unsigned* bar, volatile LAS unsigned* st) {
    XcdBarrier b; b.bar = bar; b.x = xb_xcc_id(); b.st = st;
    if (__builtin_amdgcn_workitem_id_x() == 0) (void)xb_add(&bar[XB_XCNT(b.x)], 1u);
    return b;
}
DI void xcd_barrier_complete(unsigned* bar, unsigned x, unsigned& nloc, unsigned& nx) {
    const unsigned G = gridDim.x * gridDim.y * gridDim.z;
    unsigned sum, cnt, mine, sp = 0u;
    for (;;) {
        sum = 0u; cnt = 0u; mine = 0u;
#pragma unroll
        for (unsigned j = 0; j < 16; ++j) { const unsigned c = xb_ld(&bar[XB_XCNT(j)]); sum += c; cnt += (c > 0u) ? 1u : 0u; mine = (j == x) ? c : mine; }
        if (sum == G) break;
        __builtin_amdgcn_s_sleep(1);
        if ((++sp & 255u) == 0u) { if (xb_ld(&bar[XB_TMO])) break; if (sp > XB_SPIN_CAP) { atomicAdd(&bar[XB_TMO], 1u); break; } }
    }
    nloc = mine > 0u ? mine : 1u; nx = cnt > 0u ? cnt : 1u;
}
DI void xcd_barrier(const XcdBarrier& b) {
    asm volatile("s_waitcnt vmcnt(0)" ::: "memory");
    __syncthreads();
    if (__builtin_amdgcn_workitem_id_x() == 0) {
        unsigned* bar = b.bar;
        __builtin_amdgcn_s_waitcnt(0);
        unsigned nloc = b.st[0], nx = b.st[1];
        if (nloc == 0u) { xcd_barrier_complete(bar, b.x, nloc, nx); b.st[0] = nloc; b.st[1] = nx; }
        const unsigned old = xb_add(&bar[XB_XSUB(b.x)], 1u);
        const unsigned gen = old / nloc;
        if (old + 1u == (gen + 1u) * nloc) {
            __builtin_amdgcn_fence(__ATOMIC_RELEASE, "agent");
            asm volatile("s_waitcnt vmcnt(0)" ::: "memory");
            const unsigned og = xb_add(&bar[XB_TOP], 1u);
            const unsigned tg = og / nx;
            if (og + 1u == (tg + 1u) * nx) xb_add(&bar[XB_TOPGEN], 1u);
            else XB_SPIN(xb_ld(&bar[XB_TOPGEN]) == tg, bar);
            __builtin_amdgcn_fence(__ATOMIC_ACQUIRE, "agent");
            xb_add(&bar[XB_XGEN(b.x)], 1u);
            asm volatile("s_waitcnt vmcnt(0)" ::: "memory");
        } else {
            XB_SPIN(xb_ld(&bar[XB_XGEN(b.x)]) == gen, bar);
            __builtin_amdgcn_fence(__ATOMIC_ACQUIRE, "agent");
            asm volatile("s_waitcnt vmcnt(0)" ::: "memory");
        }
    }
    __syncthreads();
}

__global__ void __launch_bounds__(NTH) k_mega(Params p) {
    __shared__ __attribute__((aligned(16))) char smem[SMEM_BYTES];
    volatile LAS unsigned* xst = (volatile LAS unsigned*)(smem + SMEM_BYTES - 16);
    if (__builtin_amdgcn_workitem_id_x() == 0) { xst[0] = 0u; xst[1] = 0u; }
    __syncthreads();
    const XcdBarrier xb = xcd_barrier_post((unsigned*)(p.ws + OFF_BAR), xst);
    const int bid = blockIdx.x, nb = gridDim.x;
#ifndef PROBE_MASK
#define PROBE_MASK 0
#endif
#define REP(bit) for (int rep_ = 0; rep_ < ((PROBE_MASK & (bit)) ? 2 : 1); ++rep_)
    phase_prep_a(p, smem);           xcd_barrier(xb);
    phase_prep_b(p, smem);           xcd_barrier(xb);
    REP(1)  { phase_proj(p, bid, nb, smem);    xcd_barrier(xb); }
    REP(128) { phase_hgprep(p, bid, nb);       xcd_barrier(xb); }
    REP(2)  { phase_mix(p, bid, nb, smem);     xcd_barrier(xb); }
    REP(4)  { phase_glu(p, bid, nb, smem);     xcd_barrier(xb); }
    REP(4)  { phase_a2(p, bid, nb);            xcd_barrier(xb); }
    REP(4)  { phase_outproj(p, bid, nb, smem); xcd_barrier(xb); }
    REP(8)  { phase_q(p, bid, nb, smem);       xcd_barrier(xb); }
    REP(16) { phase_retrieve(p, bid, nb, smem); xcd_barrier(xb); }
    phase_gather(p, bid, nb, smem, (unsigned*)(p.ws + OFF_BAR) + 16 * xb.x, xst[0]);
}

extern "C" void kernel_launch(void* const* d_in, const int* in_sizes, int n_in, void* d_out, int out_size, void* d_ws, size_t ws_size, hipStream_t stream) {
    if (n_in != 27 || ws_size < WS_END) { fprintf(stderr, "kernel_launch: unexpected n_in %d or ws_size %zu (< %zu)\n", n_in, ws_size, (size_t)WS_END); return; }
    static int grid_blocks = 0;
    if (!grid_blocks) {
        int dev = 0, cus = 0, per_cu = 0;
        (void)hipGetDevice(&dev);
        (void)hipDeviceGetAttribute(&cus, hipDeviceAttributeMultiprocessorCount, dev);
        (void)hipOccupancyMaxActiveBlocksPerMultiprocessor(&per_cu, k_mega, NTH, 0);
        if (cus <= 0) cus = 256;
        if (per_cu < 1) { fprintf(stderr, "kernel_launch: occupancy query says %d blocks/CU\n", per_cu); per_cu = 1; }
        grid_blocks = cus;
    }
    Params p{};
    const float** f = (const float**)&p;
    for (int i = 0; i < 27; ++i) f[i] = (const float*)d_in[i];
    p.out = (float*)d_out; p.ws = (char*)d_ws;
    hipError_t e = hipMemsetAsync((char*)d_ws + OFF_BAR, 0, (size_t)3456 * 4, stream);
    if (e == hipSuccess) { hipLaunchKernelGGL(k_mega, dim3(grid_blocks), dim3(NTH), 0, stream, p); e = hipPeekAtLastError(); }
    if (e != hipSuccess) fprintf(stderr, "launch failed: %s (grid %d)\n", hipGetErrorString(e), grid_blocks);
}
```

```cpp
#include <hip/hip_runtime.h>
#include <hip/hip_cooperative_groups.h>
#include <stdint.h>
#include <stdio.h>

namespace cg = cooperative_groups;
#define DI __device__ __forceinline__
typedef unsigned short bf16_t;
typedef short bf16x8 __attribute__((ext_vector_type(8)));
typedef float f32x16 __attribute__((ext_vector_type(16)));
typedef unsigned u32x4 __attribute__((ext_vector_type(4)));
typedef float f32x4 __attribute__((ext_vector_type(4)));
typedef float f32x2 __attribute__((ext_vector_type(2)));

constexpr int NTH = 512;
constexpr int NB = 16, SEQ = 2048, DM = 1024, NTOK = NB * SEQ;
constexpr int DHG = 512, HGH = 4, HDK = 128;
constexpr int DSS = 512, SSG = 32, SSC = 16, SSP = 64;
constexpr int INC = 2560;
constexpr int PHEADS = 8, NKEYS = 128, TOPK = 16, NEXP = 16384;
constexpr float DEEP_ALPHA = 1.189207115002721f;
constexpr float LN_EPS = 1e-5f, RMS_EPS = 1e-6f;
constexpr int SMEM_BYTES = 128 * 1024 + 256;

constexpr size_t al256(size_t x) { return (x + 255) & ~(size_t)255; }
constexpr size_t OFF_MOD = 0;
constexpr size_t OFF_LB = al256(OFF_MOD + (size_t)NB * 6144 * 4);
constexpr size_t OFF_LAM = al256(OFF_LB + 512 * 4);
constexpr size_t OFF_BB = al256(OFF_LAM + 32 * 64 * 2 * 4);
constexpr size_t OFF_WIN = al256(OFF_BB + 32 * 64 * 16 * 2 * 4);
constexpr size_t OFF_GLU = al256(OFF_WIN + (size_t)INC * DM * 2);
constexpr size_t OFF_WOUT = al256(OFF_GLU + (size_t)512 * 512 * 2);
constexpr size_t OFF_WQ = al256(OFF_WOUT + (size_t)DM * DM * 2);
constexpr size_t OFF_SUBK = al256(OFF_WQ + (size_t)2048 * DM * 2);
constexpr size_t OFF_SU = al256(OFF_SUBK + (size_t)16 * 128 * 128 * 2);
constexpr size_t OFF_SV = al256(OFF_SU + (size_t)NEXP * 4);
constexpr size_t OFF_UT = al256(OFF_SV + (size_t)NEXP * 4);
constexpr size_t OFF_VT = al256(OFF_UT + (size_t)NEXP * DM * 2);
constexpr size_t OFF_H = al256(OFF_VT + (size_t)NEXP * DM * 2);
constexpr size_t OFF_PROJ = al256(OFF_H + (size_t)NTOK * DM * 2);
constexpr size_t OFF_ORAW = al256(OFF_PROJ + (size_t)NTOK * INC * 2);
constexpr size_t OFF_YSSM = al256(OFF_ORAW + (size_t)NTOK * DHG * 4);
constexpr size_t OFF_A2 = al256(OFF_YSSM + (size_t)NTOK * DSS * 2);
constexpr size_t OFF_HG = al256(OFF_A2 + (size_t)NTOK * DM * 2);
constexpr size_t OFF_S5K = al256(OFF_HG + (size_t)4096 * 128 * 4);
constexpr size_t OFF_S5N = al256(OFF_S5K + (size_t)32 * 4096 * 2);
constexpr size_t OFF_S5M = al256(OFF_S5N + (size_t)32 * 128 * 256 * 2);
constexpr size_t OFF_S5L = al256(OFF_S5M + (size_t)32 * 256 * 128 * 2);
constexpr size_t OFF_STAT = al256(OFF_S5L + (size_t)32 * 64 * 2 * 4);
constexpr size_t OFF_AB = al256(OFF_STAT + (size_t)NTOK * 2 * 4);
constexpr size_t OFF_CAB = al256(OFF_AB + (size_t)2 * NB * DM * 4);
constexpr size_t OFF_BAR = al256(OFF_CAB + (size_t)2 * NB * 2048 * 4);
constexpr size_t WS_END = al256(OFF_BAR + (size_t)3456 * 4);
constexpr size_t OFF_HQ = OFF_H, OFF_HK = OFF_H + (size_t)NTOK * DHG * 2, OFF_HKT = OFF_A2, OFF_HVT = OFF_A2 + (size_t)NTOK * DHG * 2;
constexpr size_t OFF_TOPL = OFF_ORAW;
constexpr size_t OFF_EXPS = OFF_ORAW + (size_t)NTOK * 16 * 16 * 4;

struct Params {
    const float *x, *c, *ada_w, *ada_b, *w_in, *hg_lb, *hg_nw, *a_re, *a_im, *log_dt, *b_re, *b_im, *c_re, *c_im, *dsk,
        *glu_w, *glu_b, *ssm_nw, *w_out, *ln1w, *ln1b, *w_q, *subk, *pu, *pv, *ln2w, *ln2b;
    float* out;
    char* ws;
};

DI int my_tid() { int t = (int)__builtin_amdgcn_workitem_id_x(); asm volatile("" : "+v"(t)); return t; }
DI bf16_t f2bf(float x) { unsigned u = __float_as_uint(x); u += 0x7fffu + ((u >> 16) & 1u); return (bf16_t)(u >> 16); }
DI float bf2f(bf16_t b) { return __uint_as_float(((unsigned)b) << 16); }
DI float bflo(unsigned w) { return __uint_as_float(w << 16); }
DI float bfhi(unsigned w) { return __uint_as_float(w & 0xffff0000u); }
typedef __bf16 hwbf16x2 __attribute__((ext_vector_type(2)));
DI unsigned pack2(float a, float b) { const f32x2 v = {a, b}; return __builtin_bit_cast(unsigned, __builtin_convertvector(v, hwbf16x2)); }
DI bf16x8 pack8(const f32x16& x, const int base) {
    u32x4 o; o.x = pack2(x[base], x[base + 1]); o.y = pack2(x[base + 2], x[base + 3]); o.z = pack2(x[base + 4], x[base + 5]); o.w = pack2(x[base + 6], x[base + 7]);
    return __builtin_bit_cast(bf16x8, o);
}
DI float sigmoidf_(float x) { return 1.0f / (1.0f + __expf(-x)); }
DI float siluf_(float x) { return x * sigmoidf_(x); }
DI float geluf_(float x) { return 0.5f * x * (1.0f + erff(x * 0.70710678118654752f)); }
DI float gelu_as(float v) {
    const float t = __builtin_amdgcn_rcpf(fabsf(v) * 0.2316418882f + 1.0f);
    float q = t * 0.5307027145f + (-0.7265760135f); q = q * t + 0.7107068705f; q = q * t + (-0.142248368f); q = q * t + 0.127414796f; q = q * t;
    const float m = v * (q * __builtin_amdgcn_exp2f(v * v * (-0.72134752044f)));
    return v < 0.f ? m : v - m;
}

template <int MT, int NT_, int WM, int WN, class Epi>
DI void gemm_block(const bf16_t* __restrict__ A, int lda, const bf16_t* __restrict__ Bt, int ldb, int K, char* smem, Epi epi) {
    constexpr int BM = WM * MT * 32, BN = WN * NT_ * 32, LS = 72;
    static_assert(WM * WN == 8, "8 waves");
    bf16_t* As = (bf16_t*)smem;
    bf16_t* Bs = As + BM * LS;
    const int tid = my_tid(), lane = tid & 63, wid = tid >> 6, r = lane & 31, h = lane >> 5;
    const int wm = wid / WN, wn = wid % WN;
    constexpr int PA = BM * 8 / NTH, PB = BN * 8 / NTH;
    u32x4 ra[PA], rb[PB];
    f32x16 acc[MT][NT_];
#pragma unroll
    for (int mi = 0; mi < MT; ++mi)
#pragma unroll
        for (int ni = 0; ni < NT_; ++ni)
#pragma unroll
            for (int i = 0; i < 16; ++i) acc[mi][ni][i] = 0.f;
#define GEMM_GLOAD(kt_) { \
    _Pragma("unroll") for (int q = 0; q < PA; ++q) { const int idx = tid + q * NTH, row = idx >> 3, ch = idx & 7; ra[q] = *(const u32x4*)(A + (size_t)row * lda + (kt_) * 64 + ch * 8); } \
    _Pragma("unroll") for (int q = 0; q < PB; ++q) { const int idx = tid + q * NTH, row = idx >> 3, ch = idx & 7; rb[q] = *(const u32x4*)(Bt + (size_t)row * ldb + (kt_) * 64 + ch * 8); } }
#define GEMM_LSTORE() { \
    _Pragma("unroll") for (int q = 0; q < PA; ++q) { const int idx = tid + q * NTH, row = idx >> 3, ch = idx & 7; *(u32x4*)(As + row * LS + ch * 8) = ra[q]; } \
    _Pragma("unroll") for (int q = 0; q < PB; ++q) { const int idx = tid + q * NTH, row = idx >> 3, ch = idx & 7; *(u32x4*)(Bs + row * LS + ch * 8) = rb[q]; } }
    GEMM_GLOAD(0); GEMM_LSTORE(); __syncthreads();
    const int nk = K / 64;
    for (int kt = 0; kt < nk; ++kt) {
        if (kt + 1 < nk) GEMM_GLOAD(kt + 1);
#pragma unroll
        for (int ks = 0; ks < 4; ++ks) {
            bf16x8 a[MT], b[NT_];
#pragma unroll
            for (int mi = 0; mi < MT; ++mi) a[mi] = *(const bf16x8*)(As + (wm * MT * 32 + mi * 32 + r) * LS + ks * 16 + h * 8);
#pragma unroll
            for (int ni = 0; ni < NT_; ++ni) b[ni] = *(const bf16x8*)(Bs + (wn * NT_ * 32 + ni * 32 + r) * LS + ks * 16 + h * 8);
#pragma unroll
            for (int mi = 0; mi < MT; ++mi)
#pragma unroll
                for (int ni = 0; ni < NT_; ++ni) acc[mi][ni] = __builtin_amdgcn_mfma_f32_32x32x16_bf16(a[mi], b[ni], acc[mi][ni], 0, 0, 0);
        }
        __syncthreads();
        if (kt + 1 < nk) { GEMM_LSTORE(); __syncthreads(); }
    }
#pragma unroll
    for (int mi = 0; mi < MT; ++mi)
#pragma unroll
        for (int ni = 0; ni < NT_; ++ni)
#pragma unroll
            for (int i = 0; i < 16; ++i) epi(wm * MT * 32 + mi * 32 + (i & 3) + 8 * (i >> 2) + 4 * h, wn * NT_ * 32 + ni * 32 + r, acc[mi][ni][i]);
}

namespace pg8 {
#define PG8_LAS __attribute__((address_space(3)))
typedef unsigned short bf16_t;
typedef short bf16x8 __attribute__((ext_vector_type(8)));
typedef float f32x4 __attribute__((ext_vector_type(4)));
typedef unsigned u32x4 __attribute__((ext_vector_type(4)));
constexpr int BM = 256, BK = 64, HALF = 128, HTB = HALF * BK * 2  , STAGE_BYTES = 8 * HTB, NXCD = 8, WGM = 8;

__host__ __device__ __forceinline__ int lds_byte(int r, int c) { const int st = (r >> 4) * 2 + (c >> 5), rr = r & 15, cc = c & 31, ob = rr * 64 + cc * 2; return st * 1024 + (ob ^ (((ob >> 9) & 1) << 5)); }
__host__ __device__ __forceinline__ void stage_rc(int b, int& R, int& C) { const int st = b / 1024, sb = b % 1024, swz = sb ^ (((sb >> 9) & 1) << 5); R = (st >> 1) * 16 + swz / 64; C = (st & 1) * 32 + (swz % 64) / 2; }
__host__ __device__ __forceinline__ int perm32(int rho) { const int n = rho >> 4, i = rho & 15; return 8 * (i >> 2) + 4 * n + (i & 3); }

struct Unit { int pm, pn; };
struct Gemm { const bf16_t* A; const bf16_t* Bt; int M, N, K; };

struct StaticOrder {
    int nM, nN, nwg, G, c;
    __host__ __device__ void init(int M, int N, int G_, int c_) { nM = M / BM; nN = N / BM; nwg = nM * nN; G = G_; c = c_; }
    __host__ __device__ bool next(int i, Unit& u) const {
        const long L = (long)i * G + c; if (L >= nwg) return false;
        int wgid = (int)L; { const int q = nwg / NXCD, r = nwg % NXCD, xcd = wgid % NXCD, off = wgid / NXCD; wgid = (xcd < r ? xcd * (q + 1) : r * (q + 1) + (xcd - r) * q) + off; }
        const int nig = WGM * nN, gid = wgid / nig, fm = gid * WGM, gsz = (nM - fm) < WGM ? (nM - fm) : WGM;
        u.pm = fm + ((wgid % nig) % gsz); u.pn = (wgid % nig) / gsz; return true;
    }
    __device__ __forceinline__ void a_ready(const Unit&) const {}
    __device__ __forceinline__ void done(const Unit&) const {}
};
template <class Epi, class Sched, bool STAMP = false>
__device__ __forceinline__ void gemm_phase(PG8_LAS unsigned char* lds, const Gemm g, const Sched& S, const Epi& E, unsigned long long* stamps) {
    const int tid = (int)__builtin_amdgcn_workitem_id_x(), wid = __builtin_amdgcn_readfirstlane(tid >> 6), lane = tid & 63, wr = wid >> 2, wc = wid & 3, fr = lane & 15, fq = lane >> 4;
    const int K = g.K, nt = K / BK;
    int ts_lo = 0, ts_hi = 0, nts = 0; const unsigned long long rt_entry = STAMP ? (unsigned long long)wall_clock64() : 0ull;
#define PG8_STAMP() do { if (STAMP && wid == 0 && nts < 64) { const unsigned long long _c = (unsigned long long)clock64(); \
        ts_lo = (lane == nts) ? (int)(unsigned)_c : ts_lo; ts_hi = (lane == nts) ? (int)(unsigned)(_c >> 32) : ts_hi; ++nts; } } while (0)
    PG8_STAMP();
    unsigned voffA[2], voffB[2];
#pragma unroll
    for (int i = 0; i < 2; ++i) { int R, C; stage_rc(tid * 16 + i * 8192, R, C); const int Rb = Epi::PERM ? ((R & ~31) + perm32(R & 31)) : R;
        voffA[i] = (unsigned)(R * K + C) * 2u; voffB[i] = (unsigned)(Rb * K + C) * 2u; }
    const size_t kstep = (size_t)(BK * 2);
    const size_t hstep = (size_t)HALF * K * 2;
    const size_t tstep = 2 * hstep;
    const unsigned ldsw = (unsigned)wid * 1024u;
    const int aoff = lds_byte(wr * 64 + fr, fq * 8), boff = lds_byte(wc * 32 + fr, fq * 8);
#define PG8_SA(b, h) (((b) * 2 + (h)) * HTB)
#define PG8_SB(b, h) ((4 + (b) * 2 + (h)) * HTB)
#define PG8_STAGE(bufoff, gbase, voff) do { _Pragma("unroll") for (int _i = 0; _i < 2; ++_i) \
        __builtin_amdgcn_global_load_lds((const unsigned*)((const char*)(gbase) + (voff)[_i]), (PG8_LAS unsigned*)(lds + (bufoff) + ldsw + _i * 8192), 16, 0, 0); } while (0)
#define PG8_LDA(dst, b, h) do { _Pragma("unroll") for (int m = 0; m < 4; ++m) _Pragma("unroll") for (int k = 0; k < 2; ++k) dst[m][k] = *(const PG8_LAS bf16x8*)(lds + PG8_SA(b, h) + aoff + m * 2048 + k * 1024); } while (0)
#define PG8_LDB(dst, b, h) do { _Pragma("unroll") for (int n = 0; n < 2; ++n) _Pragma("unroll") for (int k = 0; k < 2; ++k) dst[n][k] = *(const PG8_LAS bf16x8*)(lds + PG8_SB(b, h) + boff + n * 2048 + k * 1024); } while (0)
#define PG8_MMA(ai, bj, At, Bt) do { __builtin_amdgcn_s_setprio(1); _Pragma("unroll") for (int m = 0; m < 4; ++m) _Pragma("unroll") for (int n = 0; n < 2; ++n) _Pragma("unroll") for (int k = 0; k < 2; ++k) \
        acc[ai][bj][m][n] = __builtin_amdgcn_mfma_f32_16x16x32_bf16(Bt[n][k], At[m][k], acc[ai][bj][m][n], 0, 0, 0); __builtin_amdgcn_s_setprio(0); } while (0)
#define PG8_WAIT_V(n) asm volatile("s_waitcnt vmcnt(" #n ")" ::: "memory")
#define PG8_WAIT_L(n) asm volatile("s_waitcnt lgkmcnt(" #n ")" ::: "memory")
#define PG8_BAR __builtin_amdgcn_s_barrier()
#define PG8_SCHED __builtin_amdgcn_sched_barrier(0)
    Unit cur, nxt; int ui = 0;
    if (!S.next(0, cur)) return;
    f32x4 acc[2][2][4][2];
#pragma unroll
    for (int a = 0; a < 2; ++a)
#pragma unroll
        for (int b = 0; b < 2; ++b)
#pragma unroll
            for (int m = 0; m < 4; ++m)
#pragma unroll
                for (int n = 0; n < 2; ++n) acc[a][b][m][n] = (f32x4){0.f, 0.f, 0.f, 0.f};
    bf16x8 At[4][2], B0[2][2], B1[2][2];
    const char* cA = (const char*)g.A + (size_t)cur.pm * tstep; const char* cB = (const char*)g.Bt + (size_t)cur.pn * tstep;
    S.a_ready(cur);
    PG8_STAGE(PG8_SB(0, 0), cB, voffB); PG8_STAGE(PG8_SA(0, 0), cA, voffA); PG8_STAGE(PG8_SB(0, 1), cB + hstep, voffB); PG8_STAGE(PG8_SA(0, 1), cA + hstep, voffA);
    if (wr == 1) PG8_BAR;
    PG8_WAIT_V(4); PG8_BAR;
    PG8_STAGE(PG8_SB(1, 0), cB + kstep, voffB); PG8_STAGE(PG8_SA(1, 0), cA + kstep, voffA); PG8_STAGE(PG8_SB(1, 1), cB + hstep + kstep, voffB);
    PG8_WAIT_V(6); PG8_BAR;
    PG8_STAMP();
    for (;;) {
        const bool has_next = S.next(ui + 1, nxt);
        const char* nA = has_next ? (const char*)g.A + (size_t)nxt.pm * tstep : cA; const char* nB = has_next ? (const char*)g.Bt + (size_t)nxt.pn * tstep : cB;
        for (int t = 0; t < nt; t += 2) {
            const bool last = (t == nt - 2);
            const char* a1 = cA + (size_t)(t + 1) * kstep;
            const char* a2 = last ? nA : cA + (size_t)(t + 2) * kstep; const char* b2 = last ? nB : cB + (size_t)(t + 2) * kstep;
            const char* a3 = a2 + kstep; const char* b3 = b2 + kstep;
            if (last && has_next) S.a_ready(nxt);
            PG8_LDB(B0, 0, 0); PG8_SCHED; PG8_LDA(At, 0, 0); PG8_STAGE(PG8_SA(1, 1), a1 + hstep, voffA);
            PG8_WAIT_L(8); PG8_BAR; PG8_WAIT_L(0); PG8_MMA(0, 0, At, B0); PG8_BAR; PG8_SCHED;
            PG8_LDB(B1, 0, 1); PG8_STAGE(PG8_SB(0, 0), b2, voffB);
            PG8_BAR; PG8_WAIT_L(0); PG8_MMA(0, 1, At, B1); PG8_BAR;
            PG8_LDA(At, 0, 1); PG8_STAGE(PG8_SA(0, 0), a2, voffA);
            PG8_BAR; PG8_WAIT_L(0); PG8_MMA(1, 0, At, B0); PG8_BAR; PG8_SCHED;
            PG8_STAGE(PG8_SB(0, 1), b2 + hstep, voffB);
            PG8_WAIT_V(6); PG8_BAR; PG8_MMA(1, 1, At, B1); PG8_BAR;
            PG8_LDB(B0, 1, 0); PG8_SCHED; PG8_LDA(At, 1, 0); PG8_STAGE(PG8_SA(0, 1), a2 + hstep, voffA);
            PG8_WAIT_L(8); PG8_BAR; PG8_WAIT_L(0); PG8_MMA(0, 0, At, B0); PG8_BAR; PG8_SCHED;
            PG8_LDB(B1, 1, 1); PG8_STAGE(PG8_SB(1, 0), b3, voffB);
            PG8_BAR; PG8_WAIT_L(0); PG8_MMA(0, 1, At, B1); PG8_BAR;
            PG8_LDA(At, 1, 1); PG8_STAGE(PG8_SA(1, 0), a3, voffA);
            PG8_BAR; PG8_WAIT_L(0); PG8_MMA(1, 0, At, B0); PG8_BAR; PG8_SCHED;
            PG8_STAGE(PG8_SB(1, 1), b3 + hstep, voffB);
            PG8_WAIT_V(6); PG8_BAR; PG8_MMA(1, 1, At, B1); PG8_BAR;
        }
        PG8_STAMP();
        if constexpr (!Epi::AFTER_DRAIN) { E(acc, cur, wr, wc, fr, fq); S.done(cur); }
        PG8_STAMP();
        if (!has_next) break;
#pragma unroll
        for (int a = 0; a < 2; ++a)
#pragma unroll
            for (int b = 0; b < 2; ++b)
#pragma unroll
                for (int m = 0; m < 4; ++m)
#pragma unroll
                    for (int n = 0; n < 2; ++n) acc[a][b][m][n] = (f32x4){0.f, 0.f, 0.f, 0.f};
        cur = nxt; cA = nA; cB = nB; ++ui;
    }
    PG8_WAIT_V(0);
    if (wr == 0) PG8_BAR;
    PG8_BAR;
    if constexpr (Epi::AFTER_DRAIN) { E.fused(acc, cur, wr, wc, fr, fq, lds, wid, lane); S.done(cur); }
    PG8_STAMP();
    if (STAMP && wid == 0) { stamps[lane] = lane < nts ? (((unsigned long long)(unsigned)ts_hi << 32) | (unsigned)ts_lo) : 0ull;
        if (lane == 62) stamps[62] = rt_entry; if (lane == 63) stamps[63] = (unsigned long long)wall_clock64(); }
#undef PG8_STAMP
#undef PG8_SA
#undef PG8_SB
#undef PG8_STAGE
#undef PG8_LDA
#undef PG8_LDB
#undef PG8_MMA
#undef PG8_WAIT_V
#undef PG8_WAIT_L
#undef PG8_BAR
#undef PG8_SCHED
}

__device__ __forceinline__ unsigned pk_bf16(float lo, float hi) { typedef float v2f __attribute__((ext_vector_type(2))); typedef __bf16 v2b __attribute__((ext_vector_type(2))); const v2f v = {lo, hi}; return __builtin_bit_cast(unsigned, __builtin_convertvector(v, v2b)); }
__device__ __forceinline__ float silu1(float x) { return x * __builtin_amdgcn_rcpf(1.0f + __expf(-x)); }
struct EpiBf16Act {
    static constexpr bool PERM = true, AFTER_DRAIN = false;
    bf16_t* O; int ldc; unsigned silu_mask;
    __device__ __forceinline__ void operator()(const f32x4 (&acc)[2][2][4][2], const Unit& u, int wr, int wc, int fr, int fq) const {
        const int row0 = u.pm * BM + wr * 64 + fr, col0 = u.pn * BM + wc * 32 + 8 * fq;
        const bool act = (silu_mask >> u.pn) & 1u;
#pragma unroll
        for (int ai = 0; ai < 2; ++ai)
#pragma unroll
            for (int m = 0; m < 4; ++m) { bf16_t* rowp = O + (size_t)(row0 + ai * HALF + m * 16) * ldc + col0;
#pragma unroll
                for (int bj = 0; bj < 2; ++bj) { f32x4 v0 = acc[ai][bj][m][0], v1 = acc[ai][bj][m][1];
                    if (act) {
#pragma unroll
                        for (int j = 0; j < 4; ++j) { v0[j] = silu1(v0[j]); v1[j] = silu1(v1[j]); } }
                    u32x4 w; w.x = pk_bf16(v0[0], v0[1]); w.y = pk_bf16(v0[2], v0[3]); w.z = pk_bf16(v1[0], v1[1]); w.w = pk_bf16(v1[2], v1[3]);
                    *(u32x4*)(rowp + bj * HALF) = w; } }
    }
};
struct EpiResid {
    static constexpr bool PERM = false, AFTER_DRAIN = false;
    float* C; const float* X; const float* mod_g;
    static constexpr int NTOK_ = 32768;
    float alpha; bf16_t* AP; const float* avec; float* stat;
    __device__ __forceinline__ void operator()(const f32x4 (&acc)[2][2][4][2], const Unit& u, int wr, int wc, int fr, int fq) const {
        const int row0 = u.pm * BM + wr * 64 + fr, col0 = u.pn * BM + wc * 32 + 4 * fq, bat = (u.pm * BM) / 2048;
        const float* gb = mod_g + (size_t)bat * 6144 + col0;
        const float* ab = avec + (size_t)bat * 1024 + col0;
        f32x4 gv[2][2], av[2][2];
#pragma unroll
        for (int bj = 0; bj < 2; ++bj)
#pragma unroll
            for (int n = 0; n < 2; ++n) { gv[bj][n] = *(const f32x4*)(gb + bj * HALF + n * 16) + 1.0f; av[bj][n] = *(const f32x4*)(ab + bj * HALF + n * 16); }
#pragma unroll
        for (int ai = 0; ai < 2; ++ai) {
            float s1[4], s2[4];
#pragma unroll
            for (int m = 0; m < 4; ++m) { const int row = row0 + ai * HALF + m * 16; const size_t ro = (size_t)row * 1024 + col0;
                s1[m] = 0.f; s2[m] = 0.f;
#pragma unroll
                for (int bj = 0; bj < 2; ++bj)
#pragma unroll
                    for (int n = 0; n < 2; ++n) {
                        const f32x4 xv = *(const f32x4*)(X + ro + bj * HALF + n * 16);
                        const f32x4 r1 = alpha * xv + gv[bj][n] * acc[ai][bj][m][n];
                        *(f32x4*)(C + ro + bj * HALF + n * 16) = r1;
                        const f32x4 ap = r1 * av[bj][n];
                        *(uint2*)(AP + ro + bj * HALF + n * 16) = make_uint2(pk_bf16(ap[0], ap[1]), pk_bf16(ap[2], ap[3]));
                        s1[m] += (r1[0] + r1[1]) + (r1[2] + r1[3]); s2[m] += (r1[0] * r1[0] + r1[1] * r1[1]) + (r1[2] * r1[2] + r1[3] * r1[3]);
                    }
            }
            const bool hi5 = fq & 2, hi4 = fq & 1;
            const float a1 = (hi5 ? s1[2] : s1[0]) + __shfl_xor(hi5 ? s1[0] : s1[2], 32), b1 = (hi5 ? s1[3] : s1[1]) + __shfl_xor(hi5 ? s1[1] : s1[3], 32);
            const float a2 = (hi5 ? s2[2] : s2[0]) + __shfl_xor(hi5 ? s2[0] : s2[2], 32), b2 = (hi5 ? s2[3] : s2[1]) + __shfl_xor(hi5 ? s2[1] : s2[3], 32);
            const float t1 = (hi4 ? b1 : a1) + __shfl_xor(hi4 ? a1 : b1, 16), t2 = (hi4 ? b2 : a2) + __shfl_xor(hi4 ? a2 : b2, 16);
            const int srow = u.pm * BM + wr * 64 + ai * HALF + fq * 16 + fr;
            atomicAdd(stat + srow, t1); atomicAdd(stat + NTOK_ + srow, t2);
        }
    }
};
struct EpiQLN {
    static constexpr bool PERM = true, AFTER_DRAIN = false;
    bf16_t* O; const float* stat; const float* ca; const float* cb; float eps;
    __device__ __forceinline__ void operator()(const f32x4 (&acc)[2][2][4][2], const Unit& u, int wr, int wc, int fr, int fq) const {
        const int row0 = u.pm * BM + wr * 64 + fr, col0 = u.pn * BM + wc * 32 + 8 * fq, bat = (u.pm * BM) / 2048;
        const float* cap = ca + (size_t)bat * 2048 + col0;
        const float* cbp = cb + (size_t)bat * 2048 + col0;
#pragma unroll
        for (int bj = 0; bj < 2; ++bj) {
            const f32x4 a0 = *(const f32x4*)(cap + bj * HALF), a1 = *(const f32x4*)(cap + bj * HALF + 4), b0 = *(const f32x4*)(cbp + bj * HALF), b1 = *(const f32x4*)(cbp + bj * HALF + 4);
#pragma unroll
            for (int ai = 0; ai < 2; ++ai)
#pragma unroll
                for (int m = 0; m < 4; ++m) {
                    const int row = row0 + ai * HALF + m * 16;
                    const float mu = stat[row] * (1.0f / 1024.0f), rstd = rsqrtf(fmaxf(stat[32768 + row] * (1.0f / 1024.0f) - mu * mu, 0.f) + eps);
                    const f32x4 v0 = rstd * (acc[ai][bj][m][0] - mu * a0) + b0, v1 = rstd * (acc[ai][bj][m][1] - mu * a1) + b1;
                    u32x4 w; w.x = pk_bf16(v0[0], v0[1]); w.y = pk_bf16(v0[2], v0[3]); w.z = pk_bf16(v1[0], v1[1]); w.w = pk_bf16(v1[2], v1[3]);
                    *(u32x4*)(O + (size_t)row * 2048 + col0 + bj * HALF) = w;
                }
        }
    }
};
struct EpiGlu {
    static constexpr bool PERM = false, AFTER_DRAIN = false;
    float* C; const bf16_t* Y; const float* bias;
    __device__ __forceinline__ void operator()(const f32x4 (&acc)[2][2][4][2], const Unit& u, int wr, int wc, int fr, int fq) const {
        const int row0 = u.pm * BM + wr * 64 + fr, col0 = u.pn * BM + wc * 32 + 4 * fq;
        f32x4 bv[2][2];
#pragma unroll
        for (int bj = 0; bj < 2; ++bj)
#pragma unroll
            for (int n = 0; n < 2; ++n) bv[bj][n] = *(const f32x4*)(bias + col0 + bj * HALF + n * 16);
#pragma unroll
        for (int ai = 0; ai < 2; ++ai)
#pragma unroll
            for (int m = 0; m < 4; ++m) { const size_t ro = (size_t)(row0 + ai * HALF + m * 16) * 512 + col0;
#pragma unroll
                for (int bj = 0; bj < 2; ++bj)
#pragma unroll
                    for (int n = 0; n < 2; ++n) {
                        const uint2 yw = *(const uint2*)(Y + ro + bj * HALF + n * 16);
                        const f32x4 z = acc[ai][bj][m][n] + bv[bj][n];
                        f32x4 o;
                        o[0] = __uint_as_float(yw.x << 16) * __builtin_amdgcn_rcpf(1.0f + __expf(-z[0])); o[1] = __uint_as_float(yw.x & 0xffff0000u) * __builtin_amdgcn_rcpf(1.0f + __expf(-z[1]));
                        o[2] = __uint_as_float(yw.y << 16) * __builtin_amdgcn_rcpf(1.0f + __expf(-z[2])); o[3] = __uint_as_float(yw.y & 0xffff0000u) * __builtin_amdgcn_rcpf(1.0f + __expf(-z[3]));
                        *(f32x4*)(C + ro + bj * HALF + n * 16) = o; } }
    }
};
}

DI void prep_mod_item(const Params& p, int item, char* smem) {
    float* condT = (float*)smem;
    float* red = condT + DM * 16;
    const int tid = my_tid();
    for (int i = tid; i < NB * DM; i += NTH) { const int b = i >> 10, k = i & 1023; condT[k * 16 + b] = siluf_(p.c[i]); }
    __syncthreads();
    const int ks = tid >> 5, col = tid & 31;
    float acc[16];
#pragma unroll
    for (int b = 0; b < 16; ++b) acc[b] = 0.f;
    const float* w = p.ada_w + (size_t)(ks * 64) * 6144 + item * 32 + col;
#pragma unroll 1
    for (int seg = 0; seg < 4; ++seg) {
        float wreg[16];
#pragma unroll
        for (int k = 0; k < 16; ++k) wreg[k] = w[(size_t)(seg * 16 + k) * 6144];
#pragma unroll
        for (int k = 0; k < 16; ++k) {
            const float wv = wreg[k];
            const f32x4* cb = (const f32x4*)(condT + (ks * 64 + seg * 16 + k) * 16);
            const f32x4 c0 = cb[0], c1 = cb[1], c2 = cb[2], c3 = cb[3];
            acc[0] += c0.x * wv; acc[1] += c0.y * wv; acc[2] += c0.z * wv; acc[3] += c0.w * wv;
            acc[4] += c1.x * wv; acc[5] += c1.y * wv; acc[6] += c1.z * wv; acc[7] += c1.w * wv;
            acc[8] += c2.x * wv; acc[9] += c2.y * wv; acc[10] += c2.z * wv; acc[11] += c2.w * wv;
            acc[12] += c3.x * wv; acc[13] += c3.y * wv; acc[14] += c3.z * wv; acc[15] += c3.w * wv;
        }
    }
#pragma unroll
    for (int b = 0; b < 16; ++b) red[(ks * 32 + col) * 16 + b] = acc[b];
    __syncthreads();
    {
        const int b = tid >> 5;
        float sum = p.ada_b[item * 32 + col];
#pragma unroll
        for (int q = 0; q < 16; ++q) sum += red[(q * 32 + col) * 16 + b];
        ((float*)(p.ws + OFF_MOD))[b * 6144 + item * 32 + col] = sum;
    }
    __syncthreads();
}
DI void prep_s5_gemm_item(const Params& p, int g, int part, char* smem) {
    f32x2* pw = (f32x2*)smem;
    f32x2* bbL = pw + 17 * 64;
    f32x2* cL = bbL + 64 * 16;
    const int tid = my_tid();
    const float dt = expf(p.log_dt[g]);
#pragma unroll 1
    for (int idx = tid; idx < 17 * 64; idx += NTH) {
        const int j = idx >> 6, pp = idx & 63;
        const float ar = p.a_re[g * 64 + pp], ai = p.a_im[g * 64 + pp];
        const float mag = expf(ar * dt * (float)j), ang = ai * dt * (float)j;
        pw[idx] = (f32x2){mag * cosf(ang), mag * sinf(ang)};
    }
    for (int idx = tid; idx < 16 * 64; idx += NTH) { const int i = idx >> 6, pp = idx & 63; cL[idx] = (f32x2){p.c_re[(g * 16 + i) * 64 + pp], p.c_im[(g * 16 + i) * 64 + pp]}; }
    __syncthreads();
    for (int idx = tid; idx < 64 * 16; idx += NTH) {
        const int pp = idx >> 4, i = idx & 15;
        const float ar = p.a_re[g * 64 + pp], ai = p.a_im[g * 64 + pp];
        const f32x2 lam = pw[64 + pp];
        const float den = ar * ar + ai * ai, nr = lam.x - 1.0f, ni = lam.y;
        const float zr = (nr * ar + ni * ai) / den, zi = (ni * ar - nr * ai) / den;
        const float br = p.b_re[(g * 64 + pp) * 16 + i], bi = p.b_im[(g * 64 + pp) * 16 + i];
        bbL[idx] = (f32x2){zr * br - zi * bi, zr * bi + zi * br};
    }
    __syncthreads();
    bf16_t* NBg = (bf16_t*)(p.ws + OFF_S5N) + (size_t)g * 128 * 256;
    if (part == 0)
#pragma unroll 1
    for (int ch = tid; ch < 128 * 256 / 8; ch += NTH) {
        const int pq = ch >> 5, t = (ch >> 1) & 15, i0 = (ch & 1) * 8, pp = pq & 63;
        const f32x2 w = pw[(15 - t) * 64 + pp];
        float v[8];
#pragma unroll
        for (int e = 0; e < 8; ++e) { const f32x2 bb = bbL[pp * 16 + i0 + e]; v[e] = pq < 64 ? (w.x * bb.x - w.y * bb.y) : (w.x * bb.y + w.y * bb.x); }
        u32x4 o; o.x = pack2(v[0], v[1]); o.y = pack2(v[2], v[3]); o.z = pack2(v[4], v[5]); o.w = pack2(v[6], v[7]);
        *(u32x4*)(NBg + (size_t)((((pq >> 5) * 16 + t) * 64) + (i0 >> 3) * 32 + (pq & 31)) * 8) = o;
    }
    bf16_t* MBg = (bf16_t*)(p.ws + OFF_S5M) + (size_t)g * 256 * 128;
    if (part == 1)
#pragma unroll 1
    for (int ch = tid; ch < 256 * 128 / 8; ch += NTH) {
        const int ti = ch >> 4, p0 = (ch & 15) * 8, tq = ti >> 4, iq = ti & 15;
        float v[8];
#pragma unroll
        for (int e = 0; e < 8; ++e) {
            const int pq = p0 + e, pp = pq & 63;
            const f32x2 c = cL[iq * 64 + pp], w = pw[(tq + 1) * 64 + pp];
            v[e] = pq < 64 ? (c.x * w.x - c.y * w.y) : -(c.x * w.y + c.y * w.x);
        }
        u32x4 o; o.x = pack2(v[0], v[1]); o.y = pack2(v[2], v[3]); o.z = pack2(v[4], v[5]); o.w = pack2(v[6], v[7]);
        *(u32x4*)(MBg + (size_t)((((ti >> 5) * 8 + (p0 >> 4)) * 64) + ((p0 >> 3) & 1) * 32 + (ti & 31)) * 8) = o;
    }
    bf16_t* KTg = (bf16_t*)(p.ws + OFF_S5K) + (size_t)g * 4096;
    if (part >= 2)
#pragma unroll 1
    for (int idx = (part - 2) * 2048 + tid; idx < (part - 1) * 2048; idx += NTH) {
        const int lag = idx >> 8, iq = (idx >> 4) & 15, i = idx & 15;
        float acc = (lag == 0 && iq == i) ? p.dsk[g * 16 + iq] : 0.f;
#pragma unroll 4
        for (int pp = 0; pp < 64; ++pp) {
            const f32x2 c = cL[iq * 64 + pp], w = pw[lag * 64 + pp], bb = bbL[pp * 16 + i];
            const float mr = c.x * w.x - c.y * w.y, mi_ = c.x * w.y + c.y * w.x;
            acc += mr * bb.x - mi_ * bb.y;
        }
        KTg[idx] = f2bf(acc);
    }
    if (part == 3 && tid < 64) { float* L = (float*)(p.ws + OFF_S5L) + (g * 64 + tid) * 2; const f32x2 w = pw[16 * 64 + tid]; L[0] = w.x; L[1] = w.y; }
    __syncthreads();
}
DI void prep_s5_item(const Params& p, int g) {
    const int tid = my_tid();
    if (tid < SSP) {
        const int pi = g * SSP + tid;
        const float dt = expf(p.log_dt[g]);
        const float ar = p.a_re[pi], ai = p.a_im[pi];
        const float mag = expf(ar * dt);
        const float lr = mag * cosf(ai * dt), li = mag * sinf(ai * dt);
        const float den = ar * ar + ai * ai, nr = lr - 1.0f, ni = li;
        const float zr = (nr * ar + ni * ai) / den, zi = (ni * ar - nr * ai) / den;
        float* lam = (float*)(p.ws + OFF_LAM) + pi * 2;
        lam[0] = lr; lam[1] = li;
        float* bb = (float*)(p.ws + OFF_BB) + (size_t)pi * 32;
        for (int i = 0; i < SSC; ++i) {
            const float br = p.b_re[pi * SSC + i], bi = p.b_im[pi * SSC + i];
            bb[i * 2] = zr * br - zi * bi; bb[i * 2 + 1] = zr * bi + zi * br;
        }
    }
}
DI void prep_transpose_tile(const float* __restrict__ W, bf16_t* __restrict__ Wt, int K, int N, int kt, int nt, char* smem) {
    float* tile = (float*)smem;
    const int tid = my_tid();
#pragma unroll
    for (int q = 0; q < 2; ++q) {
        const int kk = (tid >> 4) + q * 32, c4 = (tid & 15) * 4;
        const float4 v = *(const float4*)(W + (size_t)(kt * 64 + kk) * N + nt * 64 + c4);
        tile[kk * 65 + c4] = v.x; tile[kk * 65 + c4 + 1] = v.y; tile[kk * 65 + c4 + 2] = v.z; tile[kk * 65 + c4 + 3] = v.w;
    }
    __syncthreads();
    const int n = tid >> 3, kc = tid & 7;
    uint4 o;
    o.x = pack2(tile[(kc * 8 + 0) * 65 + n], tile[(kc * 8 + 1) * 65 + n]);
    o.y = pack2(tile[(kc * 8 + 2) * 65 + n], tile[(kc * 8 + 3) * 65 + n]);
    o.z = pack2(tile[(kc * 8 + 4) * 65 + n], tile[(kc * 8 + 5) * 65 + n]);
    o.w = pack2(tile[(kc * 8 + 6) * 65 + n], tile[(kc * 8 + 7) * 65 + n]);
    *(uint4*)(Wt + (size_t)(nt * 64 + n) * K + kt * 64 + kc * 8) = o;
    __syncthreads();
}
DI void cvt_bf16_stream(const float* __restrict__ src, bf16_t* __restrict__ dst, size_t n8, int bid, int nb) {
    for (size_t i = (size_t)bid * NTH + my_tid(); i < n8; i += (size_t)nb * NTH) {
        const float4 a = *(const float4*)(src + i * 8), b = *(const float4*)(src + i * 8 + 4);
        uint4 o; o.x = pack2(a.x, a.y); o.y = pack2(a.z, a.w); o.z = pack2(b.x, b.y); o.w = pack2(b.z, b.w);
        *(uint4*)(dst + i * 8) = o;
    }
}
DI void cvt_fp8_rows(const float* __restrict__ src, unsigned char* __restrict__ dst, float* __restrict__ inv, int bid, int nb) {
    const int lane = my_tid() & 63, wid = my_tid() >> 6;
    for (int row = bid * 8 + wid; row < NEXP; row += nb * 8) {
        const float* sp = src + (size_t)row * DM + lane * 16;
        const f32x4 a = *(const f32x4*)sp, b = *(const f32x4*)(sp + 4), c = *(const f32x4*)(sp + 8), d = *(const f32x4*)(sp + 12);
        float m = fmaxf(fmaxf(fmaxf(fabsf(a.x), fabsf(a.y)), fmaxf(fabsf(a.z), fabsf(a.w))), fmaxf(fmaxf(fabsf(b.x), fabsf(b.y)), fmaxf(fabsf(b.z), fabsf(b.w))));
        m = fmaxf(m, fmaxf(fmaxf(fmaxf(fabsf(c.x), fabsf(c.y)), fmaxf(fabsf(c.z), fabsf(c.w))), fmaxf(fmaxf(fabsf(d.x), fabsf(d.y)), fmaxf(fabsf(d.z), fabsf(d.w)))));
#pragma unroll
        for (int s = 1; s < 64; s <<= 1) m = fmaxf(m, __shfl_xor(m, s));
        float sc = 1.f, isc = 1.f;
        if (m > 1e-30f) {
            int k = (int)floorf(log2f(448.0f / m));
            k = k < -60 ? -60 : (k > 60 ? 60 : k);
            sc = ldexpf(1.0f, k); isc = ldexpf(1.0f, -k);
            if (m * sc > 448.0f) { sc *= 0.5f; isc *= 2.0f; }
        }
        u32x4 o;
        int w;
        w = __builtin_amdgcn_cvt_pk_fp8_f32(a.x * sc, a.y * sc, 0, false); w = __builtin_amdgcn_cvt_pk_fp8_f32(a.z * sc, a.w * sc, w, true); o.x = (unsigned)w;
        w = __builtin_amdgcn_cvt_pk_fp8_f32(b.x * sc, b.y * sc, 0, false); w = __builtin_amdgcn_cvt_pk_fp8_f32(b.z * sc, b.w * sc, w, true); o.y = (unsigned)w;
        w = __builtin_amdgcn_cvt_pk_fp8_f32(c.x * sc, c.y * sc, 0, false); w = __builtin_amdgcn_cvt_pk_fp8_f32(c.z * sc, c.w * sc, w, true); o.z = (unsigned)w;
        w = __builtin_amdgcn_cvt_pk_fp8_f32(d.x * sc, d.y * sc, 0, false); w = __builtin_amdgcn_cvt_pk_fp8_f32(d.z * sc, d.w * sc, w, true); o.w = (unsigned)w;
        *(u32x4*)(dst + (size_t)row * DM + lane * 16) = o;
        if (lane == 0) inv[row] = isc;
    }
}
DI void cvt_fp4_rows(const float* __restrict__ src, unsigned char* __restrict__ dst, float* __restrict__ inv, int bid, int nb) {
    const int lane = my_tid() & 63, wid = my_tid() >> 6;
    for (int row = bid * 8 + wid; row < NEXP; row += nb * 8) {
        const float* sp = src + (size_t)row * DM + lane * 16;
        const f32x4 a = *(const f32x4*)sp, b = *(const f32x4*)(sp + 4), c = *(const f32x4*)(sp + 8), d = *(const f32x4*)(sp + 12);
        float m = fmaxf(fmaxf(fmaxf(fabsf(a.x), fabsf(a.y)), fmaxf(fabsf(a.z), fabsf(a.w))), fmaxf(fmaxf(fabsf(b.x), fabsf(b.y)), fmaxf(fabsf(b.z), fabsf(b.w))));
        m = fmaxf(m, fmaxf(fmaxf(fmaxf(fabsf(c.x), fabsf(c.y)), fmaxf(fabsf(c.z), fabsf(c.w))), fmaxf(fmaxf(fabsf(d.x), fabsf(d.y)), fmaxf(fabsf(d.z), fabsf(d.w)))));
#pragma unroll
        for (int s = 1; s < 64; s <<= 1) m = fmaxf(m, __shfl_xor(m, s));
        const float sc = m > 1e-30f ? 6.0f / m : 1.0f, isc = m > 1e-30f ? m * (1.0f / 6.0f) : 1.0f;
        unsigned w0 = 0u, w1 = 0u;
        w0 = __builtin_amdgcn_cvt_scalef32_pk_fp4_f32(w0, a.x * sc, a.y * sc, 1.0f, 0); w0 = __builtin_amdgcn_cvt_scalef32_pk_fp4_f32(w0, a.z * sc, a.w * sc, 1.0f, 1);
        w0 = __builtin_amdgcn_cvt_scalef32_pk_fp4_f32(w0, b.x * sc, b.y * sc, 1.0f, 2); w0 = __builtin_amdgcn_cvt_scalef32_pk_fp4_f32(w0, b.z * sc, b.w * sc, 1.0f, 3);
        w1 = __builtin_amdgcn_cvt_scalef32_pk_fp4_f32(w1, c.x * sc, c.y * sc, 1.0f, 0); w1 = __builtin_amdgcn_cvt_scalef32_pk_fp4_f32(w1, c.z * sc, c.w * sc, 1.0f, 1);
        w1 = __builtin_amdgcn_cvt_scalef32_pk_fp4_f32(w1, d.x * sc, d.y * sc, 1.0f, 2); w1 = __builtin_amdgcn_cvt_scalef32_pk_fp4_f32(w1, d.z * sc, d.w * sc, 1.0f, 3);
        *(uint2*)(dst + (size_t)row * (DM / 2) + lane * 8) = make_uint2(w0, w1);
        if (lane == 0) inv[row] = isc;
    }
}
template <int OFFS>
DI void cvt_i8_rows(const float* __restrict__ src, unsigned char* __restrict__ dst, float* __restrict__ inv, int bid, int nb) {
    const int lane = my_tid() & 63, wid = my_tid() >> 6;
    for (int row = bid * 8 + wid; row < NEXP; row += nb * 8) {
        const float* sp = src + (size_t)row * DM + lane * 16;
        const f32x4 a = *(const f32x4*)sp, b = *(const f32x4*)(sp + 4), c = *(const f32x4*)(sp + 8), d = *(const f32x4*)(sp + 12);
        float m = fmaxf(fmaxf(fmaxf(fabsf(a.x), fabsf(a.y)), fmaxf(fabsf(a.z), fabsf(a.w))), fmaxf(fmaxf(fabsf(b.x), fabsf(b.y)), fmaxf(fabsf(b.z), fabsf(b.w))));
        m = fmaxf(m, fmaxf(fmaxf(fmaxf(fabsf(c.x), fabsf(c.y)), fmaxf(fabsf(c.z), fabsf(c.w))), fmaxf(fmaxf(fabsf(d.x), fabsf(d.y)), fmaxf(fabsf(d.z), fabsf(d.w)))));
#pragma unroll
        for (int s = 1; s < 64; s <<= 1) m = fmaxf(m, __shfl_xor(m, s));
        const float sc = m > 1e-30f ? 127.0f / m : 1.0f, isc = m > 1e-30f ? m * (1.0f / 127.0f) : 1.0f;
        const float v[16] = {a.x, a.y, a.z, a.w, b.x, b.y, b.z, b.w, c.x, c.y, c.z, c.w, d.x, d.y, d.z, d.w};
        unsigned w[4];
#pragma unroll
        for (int q = 0; q < 4; ++q) {
            unsigned pk = 0u;
#pragma unroll
            for (int e = 0; e < 4; ++e) { const int qi = (int)rintf(v[q * 4 + e] * sc) + OFFS; pk |= ((unsigned)qi & 0xffu) << (8 * e); }
            w[q] = pk;
        }
        *(u32x4*)(dst + (size_t)row * DM + lane * 16) = (u32x4){w[0], w[1], w[2], w[3]};
        if (lane == 0) inv[row] = isc;
    }
}
DI void prep_cab_item(const Params& p, int item, char* smem) {
    float* vT = (float*)smem;
    float* red = vT + DM * 16;
    const float* mod = (const float*)(p.ws + OFF_MOD);
    const int tid = my_tid(), ks = tid >> 5, col = tid & 31;
    const float* w = p.w_q + (size_t)(ks * 64) * 2048 + item * 32 + col;
#pragma unroll 1
    for (int which = 0; which < 2; ++which) {
        for (int i = tid; i < NB * DM; i += NTH) {
            const int b = i >> 10, k = i & 1023;
            const float sc = 1.0f + mod[b * 6144 + 4096 + k];
            const float v = which == 0 ? p.ln1w[k] * sc : p.ln1b[k] * sc + mod[b * 6144 + 3072 + k];
            vT[k * 16 + b] = v;
            if (item == 0) ((float*)(p.ws + OFF_AB))[(size_t)which * NB * DM + i] = v;
        }
        __syncthreads();
        float acc[16];
#pragma unroll
        for (int b = 0; b < 16; ++b) acc[b] = 0.f;
#pragma unroll 1
        for (int seg = 0; seg < 4; ++seg) {
            float wreg[16];
#pragma unroll
            for (int k = 0; k < 16; ++k) wreg[k] = w[(size_t)(seg * 16 + k) * 2048];
#pragma unroll
            for (int k = 0; k < 16; ++k) {
                const float wv = wreg[k];
                const f32x4* cb = (const f32x4*)(vT + (ks * 64 + seg * 16 + k) * 16);
                const f32x4 c0 = cb[0], c1 = cb[1], c2 = cb[2], c3 = cb[3];
                acc[0] += c0.x * wv; acc[1] += c0.y * wv; acc[2] += c0.z * wv; acc[3] += c0.w * wv;
                acc[4] += c1.x * wv; acc[5] += c1.y * wv; acc[6] += c1.z * wv; acc[7] += c1.w * wv;
                acc[8] += c2.x * wv; acc[9] += c2.y * wv; acc[10] += c2.z * wv; acc[11] += c2.w * wv;
                acc[12] += c3.x * wv; acc[13] += c3.y * wv; acc[14] += c3.z * wv; acc[15] += c3.w * wv;
            }
        }
#pragma unroll
        for (int b = 0; b < 16; ++b) red[(ks * 32 + col) * 16 + b] = acc[b];
        __syncthreads();
        {
            const int b = tid >> 5;
            float sum = 0.f;
#pragma unroll
            for (int q = 0; q < 16; ++q) sum += red[(q * 32 + col) * 16 + b];
            ((float*)(p.ws + OFF_CAB))[(size_t)which * NB * 2048 + b * 2048 + item * 32 + col] = sum;
        }
        __syncthreads();
    }
}
DI void phase_h(const Params& p, int bid, int nb) {
    const float* mod = (const float*)(p.ws + OFF_MOD);
    bf16_t* H = (bf16_t*)(p.ws + OFF_H);
    const size_t n8 = (size_t)NTOK * DM / 8;
    for (size_t i = (size_t)bid * NTH + my_tid(); i < n8; i += (size_t)nb * NTH) {
        const int row = (int)(i >> 7), c0 = (int)(i & 127) * 8, b = row / SEQ;
        const float* sh = mod + b * 6144 + c0;
        const float* sc = sh + 1024;
        const float4 a = *(const float4*)(p.x + i * 8), bq = *(const float4*)(p.x + i * 8 + 4);
        const float4 s0 = *(const float4*)sc, s1 = *(const float4*)(sc + 4), h0 = *(const float4*)sh, h1 = *(const float4*)(sh + 4);
        uint4 o;
        o.x = pack2(a.x * (1.f + s0.x) + h0.x, a.y * (1.f + s0.y) + h0.y);
        o.y = pack2(a.z * (1.f + s0.z) + h0.z, a.w * (1.f + s0.w) + h0.w);
        o.z = pack2(bq.x * (1.f + s1.x) + h1.x, bq.y * (1.f + s1.y) + h1.y);
        o.w = pack2(bq.z * (1.f + s1.z) + h1.z, bq.w * (1.f + s1.w) + h1.w);
        *(uint4*)(H + i * 8) = o;
    }
}

DI int wq_next(unsigned* ctr, char* smem) {
    volatile unsigned* slot = (volatile unsigned*)(smem + SMEM_BYTES - 8);
    __syncthreads();
    if (__builtin_amdgcn_workitem_id_x() == 0) *slot = __hip_atomic_fetch_add(ctr, 1u, __ATOMIC_RELAXED, __HIP_MEMORY_SCOPE_AGENT);
    __syncthreads();
    return (int)*slot;
}
DI void phase_prep_a(const Params& p, char* smem) {
    unsigned* ctr = (unsigned*)(p.ws + OFF_BAR) + 120;
    constexpr int U_S5 = 192, U_LB = 320, U_TR = 321, U_UT = U_TR + 368, U_VT = U_UT + 128, U_MISC = U_VT + 128, U_END = U_MISC + 8;
    for (int u = wq_next(ctr, smem); u < U_END; u = wq_next(ctr, smem)) {
        if (u < U_S5) prep_mod_item(p, u, smem);
        else if (u < U_LB) prep_s5_gemm_item(p, (u - U_S5) >> 2, (u - U_S5) & 3, smem);
        else if (u < U_TR) {
            const int j = my_tid();
            const float a0 = p.hg_lb[j], a1 = p.hg_lb[512 + j], m = fmaxf(a0, a1);
            const float e0 = expf(a0 - m), e1 = expf(a1 - m);
            ((float*)(p.ws + OFF_LB))[j] = e0 / (e0 + e1);
        } else if (u < U_UT) {
            for (int it = (u - U_TR) * 4; it < (u - U_TR) * 4 + 4; ++it) {
                constexpr int T_WIN = 16 * 40, T_GLU = 8 * 8, T_WOUT = 16 * 16;
                constexpr int I_GLU = T_WIN, I_WOUT = I_GLU + T_GLU, I_WQ = I_WOUT + T_WOUT;
                if (it < I_GLU) { const int t = it; prep_transpose_tile(p.w_in, (bf16_t*)(p.ws + OFF_WIN), DM, INC, t / 40, t % 40, smem); }
                else if (it < I_WOUT) { const int t = it - I_GLU; prep_transpose_tile(p.glu_w, (bf16_t*)(p.ws + OFF_GLU), 512, 512, t / 8, t % 8, smem); }
                else if (it < I_WQ) { const int t = it - I_WOUT; prep_transpose_tile(p.w_out, (bf16_t*)(p.ws + OFF_WOUT), DM, DM, t / 16, t % 16, smem); }
                else { const int t = it - I_WQ; prep_transpose_tile(p.w_q, (bf16_t*)(p.ws + OFF_WQ), DM, 2048, t / 32, t % 32, smem); }
            }
        } else if (u < U_VT) cvt_i8_rows<0>(p.pu, (unsigned char*)(p.ws + OFF_UT), (float*)(p.ws + OFF_SU), u - U_UT, 128);
        else if (u < U_MISC) cvt_i8_rows<128>(p.pv, (unsigned char*)(p.ws + OFF_VT), (float*)(p.ws + OFF_SV), u - U_VT, 128);
        else {
            const int q = u - U_MISC;
            cvt_bf16_stream(p.subk, (bf16_t*)(p.ws + OFF_SUBK), (size_t)16 * 128 * 128 / 8, q, 8);
            for (size_t i = (size_t)q * NTH + my_tid(); i < (size_t)NTOK * 2 / 4; i += (size_t)8 * NTH) ((f32x4*)(p.ws + OFF_STAT))[i] = (f32x4){0.f, 0.f, 0.f, 0.f};
        }
    }
}
DI void phase_prep_b(const Params& p, char* smem) {
    unsigned* ctr = (unsigned*)(p.ws + OFF_BAR) + 121;
    for (int u = wq_next(ctr, smem); u < 64 + 256; u = wq_next(ctr, smem)) {
        if (u < 64) prep_cab_item(p, u, smem); else phase_h(p, u - 64, 256);
    }
}

DI void phase_proj(const Params& p, int bid, int nb, char* smem) {
    pg8::Gemm g{(const bf16_t*)(p.ws + OFF_H), (const bf16_t*)(p.ws + OFF_WIN), NTOK, INC, DM};
    pg8::StaticOrder S; S.init(NTOK, INC, nb, bid);
    pg8::EpiBf16Act E{(bf16_t*)(p.ws + OFF_PROJ), INC, 0xC3u};
    pg8::gemm_phase<pg8::EpiBf16Act, pg8::StaticOrder, false>((PG8_LAS unsigned char*)smem, g, S, E, nullptr);
}

DI void hgrn_item(const Params& p, int item, char* smem) {
    const int vs = item & 7, hd = (item >> 3) & 3, b = item >> 5;
    const bf16_t* P = (const bf16_t*)(p.ws + OFF_PROJ);
    const float* lb = (const float*)(p.ws + OFF_LB) + hd * HDK;
    float* ORAW = (float*)(p.ws + OFF_ORAW);
    float* sq = (float*)smem;
    float* sf = sq + 32 * 128;
    float* sv = sf + 32 * 128;
    float* sp = sv + 32 * 16;
    const int tid = my_tid(), lane = tid & 63, wid = tid >> 6, kq = tid >> 4, v = tid & 15;
    float S0 = 0.f, S1 = 0.f, S2 = 0.f, S3 = 0.f;
    for (int t0 = 0; t0 < SEQ; t0 += 32) {
        for (int i = tid; i < 32 * 128; i += NTH) {
            const int t = i >> 7, k = i & 127;
            const bf16_t* row = P + (size_t)(b * SEQ + t0 + t) * INC + hd * HDK + k;
            sq[i] = bf2f(row[0]);
            const float l = lb[k];
            sf[i] = l + (1.0f - l) * sigmoidf_(bf2f(row[512]));
        }
        { const int t = tid >> 4; sv[tid] = bf2f(P[(size_t)(b * SEQ + t0 + t) * INC + 1024 + hd * HDK + vs * 16 + v]); }
        __syncthreads();
        for (int t = 0; t < 32; ++t) {
            const float4 f4 = *(const float4*)(sf + t * 128 + kq * 4), q4 = *(const float4*)(sq + t * 128 + kq * 4);
            const float vv = sv[t * 16 + v];
            S0 = f4.x * S0 + (1.0f - f4.x) * vv; S1 = f4.y * S1 + (1.0f - f4.y) * vv;
            S2 = f4.z * S2 + (1.0f - f4.z) * vv; S3 = f4.w * S3 + (1.0f - f4.w) * vv;
            float part = q4.x * S0 + q4.y * S1 + q4.z * S2 + q4.w * S3;
            part += __shfl_xor(part, 16); part += __shfl_xor(part, 32);
            if (lane < 16) sp[(t * 8 + wid) * 16 + v] = part;
        }
        __syncthreads();
        {
            const int t = tid >> 4;
            float o = 0.f;
#pragma unroll
            for (int w = 0; w < 8; ++w) o += sp[(t * 8 + w) * 16 + v];
            ORAW[(size_t)(b * SEQ + t0 + t) * DHG + hd * HDK + vs * 16 + v] = o;
        }
        __syncthreads();
    }
}
DI void s5_item(const Params& p, int item, char* smem) {
    const int oct = item & 3, b = item >> 2;
    const int tid = my_tid(), lane = tid & 63, wid = tid >> 6, g = oct * 8 + wid;
    const bf16_t* P = (const bf16_t*)(p.ws + OFF_PROJ);
    bf16_t* Y = (bf16_t*)(p.ws + OFF_YSSM);
    float* su = (float*)smem + wid * 64 * 16;
    const float* lam = (const float*)(p.ws + OFF_LAM) + (g * SSP + lane) * 2;
    const float lr = lam[0], li = lam[1];
    const float* bb = (const float*)(p.ws + OFF_BB) + (size_t)(g * SSP + lane) * 32;
    float bbr[16], bbi[16], cr[16], ci[16];
#pragma unroll
    for (int i = 0; i < 16; ++i) { bbr[i] = bb[2 * i]; bbi[i] = bb[2 * i + 1]; cr[i] = p.c_re[(g * SSC + i) * SSP + lane]; ci[i] = p.c_im[(g * SSC + i) * SSP + lane]; }
    const int ch = (lane >> 2) & 15;
    const float dch = p.dsk[g * SSC + ch];
    float xr = 0.f, xi = 0.f;
    for (int t0 = 0; t0 < SEQ; t0 += 64) {
        {
            const uint4* src = (const uint4*)(P + (size_t)(b * SEQ + t0 + lane) * INC + 2048 + g * SSC);
            const uint4 a = src[0], c = src[1];
            float* d = su + lane * 16;
            d[0] = bflo(a.x); d[1] = bfhi(a.x); d[2] = bflo(a.y); d[3] = bfhi(a.y); d[4] = bflo(a.z); d[5] = bfhi(a.z); d[6] = bflo(a.w); d[7] = bfhi(a.w);
            d[8] = bflo(c.x); d[9] = bfhi(c.x); d[10] = bflo(c.y); d[11] = bfhi(c.y); d[12] = bflo(c.z); d[13] = bfhi(c.z); d[14] = bflo(c.w); d[15] = bfhi(c.w);
        }
        __syncthreads();
        for (int t = 0; t < 64; ++t) {
            float u[16];
            const float4* us = (const float4*)(su + t * 16);
            const float4 u0 = us[0], u1 = us[1], u2 = us[2], u3 = us[3];
            u[0] = u0.x; u[1] = u0.y; u[2] = u0.z; u[3] = u0.w; u[4] = u1.x; u[5] = u1.y; u[6] = u1.z; u[7] = u1.w;
            u[8] = u2.x; u[9] = u2.y; u[10] = u2.z; u[11] = u2.w; u[12] = u3.x; u[13] = u3.y; u[14] = u3.z; u[15] = u3.w;
            float bur = 0.f, bui = 0.f;
#pragma unroll
            for (int i = 0; i < 16; ++i) { bur += bbr[i] * u[i]; bui += bbi[i] * u[i]; }
            const float nxr = lr * xr - li * xi + bur, nxi = lr * xi + li * xr + bui;
            xr = nxr; xi = nxi;
            float y[16];
#pragma unroll
            for (int i = 0; i < 16; ++i) y[i] = cr[i] * xr - ci[i] * xi;
            const bool b5 = lane & 32, b4 = lane & 16, b3 = lane & 8, b2 = lane & 4;
            float y8[8], y4[4], y2[2];
#pragma unroll
            for (int j = 0; j < 8; ++j) { const float keep = b5 ? y[8 + j] : y[j], send = b5 ? y[j] : y[8 + j]; y8[j] = keep + __shfl_xor(send, 32); }
#pragma unroll
            for (int j = 0; j < 4; ++j) { const float keep = b4 ? y8[4 + j] : y8[j], send = b4 ? y8[j] : y8[4 + j]; y4[j] = keep + __shfl_xor(send, 16); }
#pragma unroll
            for (int j = 0; j < 2; ++j) { const float keep = b3 ? y4[2 + j] : y4[j], send = b3 ? y4[j] : y4[2 + j]; y2[j] = keep + __shfl_xor(send, 8); }
            float y1;
            { const float keep = b2 ? y2[1] : y2[0], send = b2 ? y2[0] : y2[1]; y1 = keep + __shfl_xor(send, 4); }
            y1 += __shfl_xor(y1, 1); y1 += __shfl_xor(y1, 2);
            if ((lane & 3) == 0) {
                const float uu = su[t * 16 + ch];
                Y[(size_t)(b * SEQ + t0 + t) * DSS + g * SSC + ch] = f2bf(geluf_(y1 + dch * uu));
            }
        }
        __syncthreads();
    }
}
DI int crow(int i, int h) { return (i & 3) + 8 * (i >> 2) + 4 * h; }
DI void phase_hgprep(const Params& p, int bid, int nb) {
    const bf16_t* P = (const bf16_t*)(p.ws + OFF_PROJ);
    const float* lbp = (const float*)(p.ws + OFF_LB);
    const int tid = my_tid(), lane = tid & 63, wid = tid >> 6, tq = lane >> 4, cg = lane & 15;
#pragma unroll 1
    for (int it = bid * 8 + wid; it < 8192; it += nb * 8) {
        const int tile = it >> 1, c = tile & 63, hd = (tile >> 6) & 3, b = tile >> 8, k0 = (it & 1) * 64 + cg * 4;
        const bf16_t* base = P + (size_t)(b * SEQ + c * 32 + tq * 8) * INC + hd * HDK + k0;
        uint2 qw[8], fw[8];
#pragma unroll
        for (int tt = 0; tt < 8; ++tt) { qw[tt] = *(const uint2*)(base + (size_t)tt * INC); fw[tt] = *(const uint2*)(base + (size_t)tt * INC + 512); }
        const f32x4 l4 = *(const f32x4*)(lbp + hd * HDK + k0);
        const float lb4[4] = {l4.x, l4.y, l4.z, l4.w};
        float bl[8][4], kk[8][4], run[4];
#pragma unroll
        for (int e = 0; e < 4; ++e) run[e] = 0.f;
#pragma unroll
        for (int tt = 0; tt < 8; ++tt) {
            const float fl[4] = {bflo(fw[tt].x), bfhi(fw[tt].x), bflo(fw[tt].y), bfhi(fw[tt].y)};
#pragma unroll
            for (int e = 0; e < 4; ++e) {
                const float f = lb4[e] + (1.0f - lb4[e]) * sigmoidf_(fl[e]);
                run[e] += __logf(f); bl[tt][e] = run[e]; kk[tt][e] = 1.0f - f;
            }
        }
        float off[4], tot[4];
#pragma unroll
        for (int e = 0; e < 4; ++e) {
            const float t0 = __shfl(run[e], cg), t1 = __shfl(run[e], cg + 16), t2 = __shfl(run[e], cg + 32), t3 = __shfl(run[e], cg + 48);
            off[e] = (tq > 0 ? t0 : 0.f) + (tq > 1 ? t1 : 0.f) + (tq > 2 ? t2 : 0.f);
            tot[e] = (t0 + t1) + (t2 + t3);
        }
        bf16_t* HQ = (bf16_t*)(p.ws + OFF_HQ) + (size_t)tile * 4096 + (tq * 8) * 128 + k0;
        bf16_t* HK = (bf16_t*)(p.ws + OFF_HK) + (size_t)tile * 4096 + (tq * 8) * 128 + k0;
#pragma unroll
        for (int tt = 0; tt < 8; ++tt) {
            const float qv[4] = {bflo(qw[tt].x), bfhi(qw[tt].x), bflo(qw[tt].y), bfhi(qw[tt].y)};
            float qo[4], ko[4];
#pragma unroll
            for (int e = 0; e < 4; ++e) { const float bb = off[e] + bl[tt][e]; qo[e] = qv[e] * __expf(bb); ko[e] = kk[tt][e] * __expf(fminf(-bb, 80.0f)); }
            *(uint2*)(HQ + tt * 128) = make_uint2(pack2(qo[0], qo[1]), pack2(qo[2], qo[3]));
            *(uint2*)(HK + tt * 128) = make_uint2(pack2(ko[0], ko[1]), pack2(ko[2], ko[3]));
        }
        if (tq == 0) *(f32x4*)((float*)(p.ws + OFF_HG) + (size_t)tile * 128 + k0) = (f32x4){__expf(tot[0]), __expf(tot[1]), __expf(tot[2]), __expf(tot[3])};
    }
}
typedef short s16x4 __attribute__((ext_vector_type(4)));
DI bf16x8 cat8(const s16x4 lo, const s16x4 hi) { return (bf16x8){lo.x, lo.y, lo.z, lo.w, hi.x, hi.y, hi.z, hi.w}; }
DI s16x4 lds_tr(const char* a) { return __builtin_amdgcn_ds_read_tr16_b64_v4i16((__attribute__((address_space(3))) s16x4*)a); }
DI void hgrn_mfma_item(const Params& p, int item, char* smem) {
    constexpr int QP_OFF = 0, KP_OFF = 8704, V_OFF = 17408, G_OFF = 26112, BUF = 26624, OB_OFF = 3 * BUF, OB_STRIDE = 132, OB_BYTES = 32 * OB_STRIDE * 4;
    const int tid = my_tid(), lane = tid & 63, wid = tid >> 6, r = lane & 31, h = lane >> 5;
    const int b = item >> 2, hd = item & 3;
    const size_t tile0 = (size_t)item * 64;
    const bf16_t* HQ = (const bf16_t*)(p.ws + OFF_HQ) + tile0 * 4096;
    const bf16_t* HK = (const bf16_t*)(p.ws + OFF_HK) + tile0 * 4096;
    const bf16_t* PV = (const bf16_t*)(p.ws + OFF_PROJ) + (size_t)b * SEQ * INC + 1024 + hd * HDK;
    const float* HG = (const float*)(p.ws + OFF_HG) + tile0 * 128;
    bf16_t* A2out = (bf16_t*)(p.ws + OFF_A2) + (size_t)b * SEQ * DM + hd * HDK;
    const bf16_t* PG = (const bf16_t*)(p.ws + OFF_PROJ) + (size_t)b * SEQ * INC + 1536 + hd * HDK;
    const bool helper = wid >= 4;
    const int ht = tid - 256;
    const int i0 = ht, i1 = ht + 256;
    const int lo0 = (i0 >> 4) * 272 + (i0 & 15) * 16, lo1 = (i1 >> 4) * 272 + (i1 & 15) * 16;
    u32x4 A0, A1, A2, A3, A4, A5, A6, B0, B1, B2, B3, B4, B5, B6;
    A0 = A1 = A2 = A3 = A4 = A5 = A6 = B0 = B1 = B2 = B3 = B4 = B5 = B6 = (u32x4){0, 0, 0, 0};
    f32x16 S[4];
#pragma unroll
    for (int kb = 0; kb < 4; ++kb)
#pragma unroll
        for (int i = 0; i < 16; ++i) S[kb][i] = 0.f;
#define HG_LOAD(X, c_) { const size_t o_ = (size_t)(c_) * 4096; \
        X##0 = *(const u32x4*)(HQ + o_ + i0 * 8); X##1 = *(const u32x4*)(HQ + o_ + i1 * 8); \
        X##2 = *(const u32x4*)(HK + o_ + i0 * 8); X##3 = *(const u32x4*)(HK + o_ + i1 * 8); \
        X##4 = *(const u32x4*)(PV + (size_t)((c_) * 32 + (i0 >> 4)) * INC + (i0 & 15) * 8); X##5 = *(const u32x4*)(PV + (size_t)((c_) * 32 + (i1 >> 4)) * INC + (i1 & 15) * 8); \
        if (ht < 32) X##6 = *(const u32x4*)(HG + (size_t)(c_) * 128 + ht * 4); }
#define HG_STORE(X, buf_) { char* B_ = smem + (buf_) * BUF; \
        *(u32x4*)(B_ + QP_OFF + lo0) = X##0; *(u32x4*)(B_ + QP_OFF + lo1) = X##1; \
        *(u32x4*)(B_ + KP_OFF + lo0) = X##2; *(u32x4*)(B_ + KP_OFF + lo1) = X##3; \
        *(u32x4*)(B_ + V_OFF + lo0) = X##4; *(u32x4*)(B_ + V_OFF + lo1) = X##5; \
        if (ht < 32) *(u32x4*)(B_ + G_OFF + ht * 16) = X##6; }
    const int tq = (lane >> 2) & 3, tp = lane & 3, tg = lane >> 4;
    const int tr_nat = (8 * (tg >> 1) + tq) * 272 + (16 * (tg & 1) + 4 * tp) * 2;
    const int tr_krw = (4 * (tg >> 1) + tq) * 272 + (16 * (tg & 1) + 4 * tp) * 2;
    if (helper) { HG_LOAD(A, 0); HG_STORE(A, 0); HG_LOAD(A, 1); HG_STORE(A, 1); HG_LOAD(A, 2); HG_LOAD(B, 3); }
    __syncthreads();
#define HG_COMPUTE(c_) { \
        const char* B = smem + ((c_) % 3) * BUF; const int w = wid; \
        f32x16 pt; _Pragma("unroll") for (int i = 0; i < 16; ++i) pt[i] = 0.f; \
        _Pragma("unroll") for (int ks = 0; ks < 8; ++ks) { \
            const bf16x8 a = *(const bf16x8*)(B + KP_OFF + r * 272 + ks * 32 + h * 16); \
            const bf16x8 bq = *(const bf16x8*)(B + QP_OFF + r * 272 + ks * 32 + h * 16); \
            pt = __builtin_amdgcn_mfma_f32_32x32x16_bf16(a, bq, pt, 0, 0, 0); } \
        _Pragma("unroll") for (int i = 0; i < 16; ++i) if (crow(i, h) > r) pt[i] = 0.f; \
        f32x16 o; _Pragma("unroll") for (int i = 0; i < 16; ++i) o[i] = 0.f; \
        _Pragma("unroll") for (int sp = 0; sp < 2; ++sp) { \
            const char* vb = B + V_OFF + (16 * sp) * 272 + (32 * w) * 2 + tr_krw; \
            const bf16x8 bv = cat8(lds_tr(vb), lds_tr(vb + 8 * 272)); \
            o = __builtin_amdgcn_mfma_f32_32x32x16_bf16(pack8(pt, 8 * sp), bv, o, 0, 0, 0); } \
        _Pragma("unroll") for (int kb = 0; kb < 4; ++kb) _Pragma("unroll") for (int sp = 0; sp < 2; ++sp) { \
            const char* qb = B + QP_OFF + r * 272 + kb * 64 + sp * 32 + h * 8; \
            const bf16x8 aq = cat8(*(const s16x4*)qb, *(const s16x4*)(qb + 16)); \
            o = __builtin_amdgcn_mfma_f32_32x32x16_bf16(aq, pack8(S[kb], 8 * sp), o, 0, 0, 0); } \
        { float* ob_ = (float*)(smem + OB_OFF + ((c_) & 1) * OB_BYTES); _Pragma("unroll") for (int i = 0; i < 16; ++i) ob_[crow(i, h) * OB_STRIDE + 32 * w + r] = o[i]; } \
        bf16x8 bvn[2]; \
        _Pragma("unroll") for (int ks = 0; ks < 2; ++ks) { const char* vb = B + V_OFF + (16 * ks) * 272 + (32 * w) * 2 + tr_nat; bvn[ks] = cat8(lds_tr(vb), lds_tr(vb + 4 * 272)); } \
        _Pragma("unroll") for (int kb = 0; kb < 4; ++kb) { \
            _Pragma("unroll") for (int ks = 0; ks < 2; ++ks) { \
                const char* kp = B + KP_OFF + (16 * ks) * 272 + (32 * kb) * 2 + tr_nat; \
                const bf16x8 a = cat8(lds_tr(kp), lds_tr(kp + 4 * 272)); \
                S[kb] = __builtin_amdgcn_mfma_f32_32x32x16_bf16(a, bvn[ks], S[kb], 0, 0, 0); } \
            _Pragma("unroll") for (int j = 0; j < 4; ++j) { \
                const f32x4 g4 = *(const f32x4*)(B + G_OFF + (kb * 32 + 8 * j + 4 * h) * 4); \
                S[kb][4 * j] *= g4.x; S[kb][4 * j + 1] *= g4.y; S[kb][4 * j + 2] *= g4.z; S[kb][4 * j + 3] *= g4.w; } } }
    f32x4 nw0, nw1, nw2, nw3;
    nw0 = nw1 = nw2 = nw3 = (f32x4){0.f, 0.f, 0.f, 0.f};
    if (helper) { const float* nwp = p.hg_nw + hd * HDK + (ht & 7) * 16; nw0 = *(const f32x4*)nwp; nw1 = *(const f32x4*)(nwp + 4); nw2 = *(const f32x4*)(nwp + 8); nw3 = *(const f32x4*)(nwp + 12); }
#define HG_NORM(cc_) { const int t_ = ht >> 3, sg_ = ht & 7; \
        const float* ob_ = (const float*)(smem + OB_OFF + ((cc_) & 1) * OB_BYTES) + t_ * OB_STRIDE + sg_ * 16; \
        const f32x4 o0 = *(const f32x4*)ob_, o1 = *(const f32x4*)(ob_ + 4), o2 = *(const f32x4*)(ob_ + 8), o3 = *(const f32x4*)(ob_ + 12); \
        const u32x4 g0 = *(const u32x4*)(PG + (size_t)((cc_) * 32 + t_) * INC + sg_ * 16), g1 = *(const u32x4*)(PG + (size_t)((cc_) * 32 + t_) * INC + sg_ * 16 + 8); \
        float ss = (o0.x * o0.x + o0.y * o0.y + o0.z * o0.z + o0.w * o0.w) + (o1.x * o1.x + o1.y * o1.y + o1.z * o1.z + o1.w * o1.w) + (o2.x * o2.x + o2.y * o2.y + o2.z * o2.z + o2.w * o2.w) + (o3.x * o3.x + o3.y * o3.y + o3.z * o3.z + o3.w * o3.w); \
        ss += __shfl_xor(ss, 1); ss += __shfl_xor(ss, 2); ss += __shfl_xor(ss, 4); \
        const float rs_ = rsqrtf(ss * (1.0f / 128.0f) + RMS_EPS); \
        const f32x4 v0 = o0 * rs_ * nw0, v1 = o1 * rs_ * nw1, v2 = o2 * rs_ * nw2, v3 = o3 * rs_ * nw3; \
        u32x4 w0, w1; \
        w0.x = pack2(v0.x * bflo(g0.x), v0.y * bfhi(g0.x)); w0.y = pack2(v0.z * bflo(g0.y), v0.w * bfhi(g0.y)); w0.z = pack2(v1.x * bflo(g0.z), v1.y * bfhi(g0.z)); w0.w = pack2(v1.z * bflo(g0.w), v1.w * bfhi(g0.w)); \
        w1.x = pack2(v2.x * bflo(g1.x), v2.y * bfhi(g1.x)); w1.y = pack2(v2.z * bflo(g1.y), v2.w * bfhi(g1.y)); w1.z = pack2(v3.x * bflo(g1.z), v3.y * bfhi(g1.z)); w1.w = pack2(v3.z * bflo(g1.w), v3.w * bfhi(g1.w)); \
        bf16_t* dst_ = A2out + (size_t)((cc_) * 32 + t_) * DM + sg_ * 16; \
        *(u32x4*)dst_ = w0; *(u32x4*)(dst_ + 8) = w1; }
    for (int c = 0; c < 64; c += 2) {
        if (helper) { if (c + 2 < 64) HG_STORE(A, (c + 2) % 3); if (c + 4 < 64) HG_LOAD(A, c + 4); if (c > 0) HG_NORM(c - 1); } else HG_COMPUTE(c);
        __syncthreads();
        if (helper) { if (c + 3 < 64) HG_STORE(B, (c + 3) % 3); if (c + 5 < 64) HG_LOAD(B, c + 5); HG_NORM(c); } else HG_COMPUTE(c + 1);
        __syncthreads();
    }
    if (helper) HG_NORM(63);
    __syncthreads();
#undef HG_LOAD
#undef HG_STORE
#undef HG_COMPUTE
#undef HG_NORM
}
template <int NJ>
DI void s5_gemm2_tile(const bf16x8 (&af)[16], const bf16_t* KTl, const bf16_t* Xin, const bf16_t* MBg, bf16_t* Yout, bf16_t* stg, const int mi, const int r, const int h) {
    f32x16 y;
#pragma unroll
    for (int i = 0; i < 16; ++i) y[i] = 0.f;
    const int tsel = r >> 4, iq = r & 15;
    bf16x8 bm[8];
#pragma unroll
    for (int ks = 0; ks < 8; ++ks) bm[ks] = *(const bf16x8*)(MBg + (size_t)((NJ * 8 + ks) * 64 + h * 32 + r) * 8);
#pragma unroll
    for (int ks = 0; ks <= 2 * NJ; ++ks) {
        const bf16x8 bk = *(const bf16x8*)(KTl + ((2 * NJ + tsel - ks) * 16 + iq) * 16 + 8 * h);
        y = __builtin_amdgcn_mfma_f32_32x32x16_bf16(af[ks], bk, y, 0, 0, 0);
    }
    {
        bf16x8 bk = *(const bf16x8*)(KTl + iq * 16 + 8 * h);
        if (tsel == 0) bk = (bf16x8){0, 0, 0, 0, 0, 0, 0, 0};
        y = __builtin_amdgcn_mfma_f32_32x32x16_bf16(af[2 * NJ + 1], bk, y, 0, 0, 0);
    }
#pragma unroll
    for (int ks = 0; ks < 8; ++ks) {
        const bf16x8 a = *(const bf16x8*)(Xin + (mi * 32 + r) * 136 + ks * 16 + 8 * h);
        y = __builtin_amdgcn_mfma_f32_32x32x16_bf16(a, bm[ks], y, 0, 0, 0);
    }
#pragma unroll
    for (int i = 0; i < 16; ++i) stg[((crow(i, h) * 2 + tsel) * 16) + iq] = f2bf(gelu_as(y[i]));
    {
        const int lane = h * 32 + r, cl = lane >> 1, ts = lane & 1;
        const u32x4 lo = *(const u32x4*)(stg + lane * 16), hi = *(const u32x4*)(stg + lane * 16 + 8);
        bf16_t* dst = Yout + (size_t)((mi * 32 + cl) * 16 + 2 * NJ + ts) * DSS;
        *(u32x4*)dst = lo; *(u32x4*)(dst + 8) = hi;
    }
}
DI void s5_gemm_item(const Params& p, int b, int g, char* smem) {
    float* E = (float*)smem;
    bf16_t* Xin = (bf16_t*)(smem + 128 * 132 * 4);
    bf16_t* KTl = Xin + 128 * 136;
    const int tid = my_tid(), lane = tid & 63, wid = tid >> 6, r = lane & 31, h = lane >> 5;
    const int mi = wid >> 1, wh = wid & 1;
    const bf16_t* P = (const bf16_t*)(p.ws + OFF_PROJ);
    *(u32x4*)(KTl + tid * 8) = *(const u32x4*)((const bf16_t*)(p.ws + OFF_S5K) + (size_t)g * 4096 + tid * 8);
    bf16x8 af[16];
    {
        const bf16_t* ub = P + (size_t)(b * SEQ + (mi * 32 + r) * 16) * INC + 2048 + g * 16 + 8 * h;
#pragma unroll
        for (int ks = 0; ks < 16; ++ks) af[ks] = *(const bf16x8*)(ub + (size_t)ks * INC);
    }
#ifndef S5_REP_G1
#define S5_REP_G1 1
#define S5_REP_SC 1
#define S5_REP_G2 1
#endif
    for (int rp1 = 0; rp1 < S5_REP_G1; ++rp1)
    {
        f32x16 e0, e1;
#pragma unroll
        for (int i = 0; i < 16; ++i) { e0[i] = 0.f; e1[i] = 0.f; }
        const bf16_t* nb0 = (const bf16_t*)(p.ws + OFF_S5N) + (size_t)g * 128 * 256 + (size_t)(wh * 2) * 16 * 512 + lane * 8;
#pragma unroll
        for (int ks = 0; ks < 16; ++ks) {
            const bf16x8 b0 = *(const bf16x8*)(nb0 + ks * 512), b1 = *(const bf16x8*)(nb0 + 16 * 512 + ks * 512);
            e0 = __builtin_amdgcn_mfma_f32_32x32x16_bf16(af[ks], b0, e0, 0, 0, 0);
            e1 = __builtin_amdgcn_mfma_f32_32x32x16_bf16(af[ks], b1, e1, 0, 0, 0);
        }
#pragma unroll
        for (int i = 0; i < 16; ++i) { float* er = E + (mi * 32 + crow(i, h)) * 132 + wh * 64 + r; er[0] = e0[i]; er[32] = e1[i]; }
    }
    __syncthreads();
    for (int rp2 = 0; rp2 < S5_REP_SC; ++rp2)
    if (wid == 0) {
        const float* L = (const float*)(p.ws + OFF_S5L) + (g * 64 + lane) * 2;
        const float lr = L[0], li = L[1];
        float xr = 0.f, xi = 0.f;
#pragma unroll 8
        for (int c = 0; c < 128; ++c) {
            const float er = E[c * 132 + lane], ei = E[c * 132 + 64 + lane];
            Xin[c * 136 + lane] = f2bf(xr); Xin[c * 136 + 64 + lane] = f2bf(xi);
            const float nr = lr * xr - li * xi + er, ni = lr * xi + li * xr + ei;
            xr = nr; xi = ni;
        }
    }
    __syncthreads();
    const bf16_t* MBg = (const bf16_t*)(p.ws + OFF_S5M) + (size_t)g * 256 * 128;
    bf16_t* Yout = (bf16_t*)(p.ws + OFF_YSSM) + (size_t)b * SEQ * DSS + g * 16;
    bf16_t* stg = (bf16_t*)smem + wid * 1024;
    for (int rp3 = 0; rp3 < S5_REP_G2; ++rp3)
    if (wh) {
        s5_gemm2_tile<1>(af, KTl, Xin, MBg, Yout, stg, mi, r, h); s5_gemm2_tile<6>(af, KTl, Xin, MBg, Yout, stg, mi, r, h);
        s5_gemm2_tile<3>(af, KTl, Xin, MBg, Yout, stg, mi, r, h); s5_gemm2_tile<4>(af, KTl, Xin, MBg, Yout, stg, mi, r, h);
    } else {
        s5_gemm2_tile<0>(af, KTl, Xin, MBg, Yout, stg, mi, r, h); s5_gemm2_tile<7>(af, KTl, Xin, MBg, Yout, stg, mi, r, h);
        s5_gemm2_tile<2>(af, KTl, Xin, MBg, Yout, stg, mi, r, h); s5_gemm2_tile<5>(af, KTl, Xin, MBg, Yout, stg, mi, r, h);
    }
    __syncthreads();
}
DI void phase_mix(const Params& p, int bid, int nb, char* smem) {
    if (nb == 256) {
#ifndef PROBE_HGX
#define PROBE_HGX 1
#endif
        if (bid < 64) { for (int rep = 0; rep < PROBE_HGX; ++rep) hgrn_mfma_item(p, bid, smem); return; }
        const int j = bid - 64, x = j & 7, lb = j >> 3;
#ifndef PROBE_S5X
#define PROBE_S5X 1
#endif
        for (int rep = 0; rep < PROBE_S5X; ++rep)
        for (int q = lb; q < 64; q += 24) s5_gemm_item(p, q & 15, x * 4 + (q >> 4), smem);
    } else {
        for (int it = bid; it < 64; it += nb) hgrn_mfma_item(p, it, smem);
        for (int q = bid; q < 512; q += nb) s5_gemm_item(p, q & 15, q >> 4, smem);
    }
}

DI void phase_glu(const Params& p, int bid, int nb, char* smem) {
    pg8::Gemm g{(const bf16_t*)(p.ws + OFF_YSSM), (const bf16_t*)(p.ws + OFF_GLU), NTOK, 512, 512};
    pg8::StaticOrder S; S.init(NTOK, 512, nb, bid);
    pg8::EpiGlu E{(float*)(p.ws + OFF_H), (const bf16_t*)(p.ws + OFF_YSSM), p.glu_b};
    pg8::gemm_phase<pg8::EpiGlu, pg8::StaticOrder, false>((PG8_LAS unsigned char*)smem, g, S, E, nullptr);
}
DI void phase_a2(const Params& p, int bid, int nb) {
    const float* Y2 = (const float*)(p.ws + OFF_H);
    const bf16_t* P = (const bf16_t*)(p.ws + OFF_PROJ);
    bf16_t* A2 = (bf16_t*)(p.ws + OFF_A2);
    const int lane = my_tid() & 63, wid = my_tid() >> 6;
    for (int tok = bid * 8 + wid; tok < NTOK; tok += nb * 8) {
        const int c0 = lane * 8;
        {
            const float4 a = *(const float4*)(Y2 + (size_t)tok * DSS + c0), b = *(const float4*)(Y2 + (size_t)tok * DSS + c0 + 4);
            float ss = a.x * a.x + a.y * a.y + a.z * a.z + a.w * a.w + b.x * b.x + b.y * b.y + b.z * b.z + b.w * b.w;
#pragma unroll
            for (int m = 1; m < 64; m <<= 1) ss += __shfl_xor(ss, m);
            const float rs = rsqrtf(ss * (1.0f / 512.0f) + RMS_EPS);
            const float4 w0 = *(const float4*)(p.ssm_nw + c0), w1 = *(const float4*)(p.ssm_nw + c0 + 4);
            uint4 o;
            o.x = pack2(a.x * rs * w0.x, a.y * rs * w0.y); o.y = pack2(a.z * rs * w0.z, a.w * rs * w0.w);
            o.z = pack2(b.x * rs * w1.x, b.y * rs * w1.y); o.w = pack2(b.z * rs * w1.z, b.w * rs * w1.w);
            *(uint4*)(A2 + (size_t)tok * DM + 512 + c0) = o;
        }
    }
}

DI void phase_outproj(const Params& p, int bid, int nb, char* smem) {
    pg8::Gemm g{(const bf16_t*)(p.ws + OFF_A2), (const bf16_t*)(p.ws + OFF_WOUT), NTOK, DM, DM};
    pg8::StaticOrder S; S.init(NTOK, DM, nb, bid);
    pg8::EpiResid E{p.out, p.x, (const float*)(p.ws + OFF_MOD) + 2048, DEEP_ALPHA, (bf16_t*)(p.ws + OFF_H), (const float*)(p.ws + OFF_AB), (float*)(p.ws + OFF_STAT)};
    pg8::gemm_phase<pg8::EpiResid, pg8::StaticOrder, false>((PG8_LAS unsigned char*)smem, g, S, E, nullptr);
}
DI void phase_ln1(const Params& p, int bid, int nb) {
    const float* mod = (const float*)(p.ws + OFF_MOD);
    bf16_t* H2 = (bf16_t*)(p.ws + OFF_H);
    const int lane = my_tid() & 63, wid = my_tid() >> 6;
    for (int tok = bid * 8 + wid; tok < NTOK; tok += nb * 8) {
        const int b = tok / SEQ;
        float* row = p.out + (size_t)tok * DM;
        float4 v[4];
        float s = 0.f;
#pragma unroll
        for (int j = 0; j < 4; ++j) { v[j] = *(const float4*)(row + j * 256 + lane * 4); s += v[j].x + v[j].y + v[j].z + v[j].w; }
#pragma unroll
        for (int m = 1; m < 64; m <<= 1) s += __shfl_xor(s, m);
        const float mu = s * (1.0f / 1024.0f);
        float q = 0.f;
#pragma unroll
        for (int j = 0; j < 4; ++j) { const float a = v[j].x - mu, bb = v[j].y - mu, cc = v[j].z - mu, d = v[j].w - mu; q += a * a + bb * bb + cc * cc + d * d; }
#pragma unroll
        for (int m = 1; m < 64; m <<= 1) q += __shfl_xor(q, m);
        const float rstd = rsqrtf(q * (1.0f / 1024.0f) + LN_EPS);
        const float* sh2 = mod + b * 6144 + 3072;
        const float* sc2 = mod + b * 6144 + 4096;
#pragma unroll
        for (int j = 0; j < 4; ++j) {
            const int c = j * 256 + lane * 4;
            const float4 w = *(const float4*)(p.ln1w + c), bi = *(const float4*)(p.ln1b + c), sc = *(const float4*)(sc2 + c), sh = *(const float4*)(sh2 + c);
            float4 o;
            o.x = (v[j].x - mu) * rstd * w.x + bi.x; o.y = (v[j].y - mu) * rstd * w.y + bi.y; o.z = (v[j].z - mu) * rstd * w.z + bi.z; o.w = (v[j].w - mu) * rstd * w.w + bi.w;
            *(float4*)(row + c) = o;
            uint2 hh; hh.x = pack2(o.x * (1.f + sc.x) + sh.x, o.y * (1.f + sc.y) + sh.y); hh.y = pack2(o.z * (1.f + sc.z) + sh.z, o.w * (1.f + sc.w) + sh.w);
            *(uint2*)(H2 + (size_t)tok * DM + c) = hh;
        }
    }
}

DI void phase_q(const Params& p, int bid, int nb, char* smem) {
    pg8::Gemm g{(const bf16_t*)(p.ws + OFF_H), (const bf16_t*)(p.ws + OFF_WQ), NTOK, 2048, DM};
    pg8::StaticOrder S; S.init(NTOK, 2048, nb, bid);
    pg8::EpiQLN E{(bf16_t*)(p.ws + OFF_PROJ), (const float*)(p.ws + OFF_STAT), (const float*)(p.ws + OFF_CAB), (const float*)(p.ws + OFF_CAB) + NB * 2048, LN_EPS};
    pg8::gemm_phase<pg8::EpiQLN, pg8::StaticOrder, false>((PG8_LAS unsigned char*)smem, g, S, E, nullptr);
}
DI void phase_topk(const Params& p, int bid, int nb, char* smem) {
    const bf16_t* Q = (const bf16_t*)(p.ws + OFF_PROJ);
    const bf16_t* SK = (const bf16_t*)(p.ws + OFF_SUBK);
    unsigned* TOPL = (unsigned*)(p.ws + OFF_TOPL);
    float* sc = (float*)(smem + 36864);
    constexpr int NTM = NTOK / 128;
    for (int t = bid; t < NTM * 16; t += nb) {
        const int mt = t >> 4, hp = t & 15;
        gemm_block<2, 1, 2, 4>(Q + (size_t)mt * 128 * 2048 + hp * 128, 2048, SK + (size_t)hp * 128 * 128, 128, 128, smem,
                               [&](int r, int c, float v) { sc[r * 129 + c] = v; });
        __syncthreads();
        if (my_tid() < 128) {
            const int r = my_tid();
            float tk[16];
#pragma unroll
            for (int j = 0; j < 16; ++j) tk[j] = -3.0e38f;
            for (int n = 0; n < 128; ++n) {
                float xv = __uint_as_float((__float_as_uint(sc[r * 129 + n]) & ~0x7fu) | (unsigned)n);
#pragma unroll
                for (int j = 0; j < 16; ++j) { const float hi = fmaxf(tk[j], xv), lo = fminf(tk[j], xv); tk[j] = hi; xv = lo; }
            }
            uint4* dst = (uint4*)(TOPL + ((size_t)(mt * 128 + r) * 16 + hp) * 16);
            dst[0] = make_uint4(__float_as_uint(tk[0]), __float_as_uint(tk[1]), __float_as_uint(tk[2]), __float_as_uint(tk[3]));
            dst[1] = make_uint4(__float_as_uint(tk[4]), __float_as_uint(tk[5]), __float_as_uint(tk[6]), __float_as_uint(tk[7]));
            dst[2] = make_uint4(__float_as_uint(tk[8]), __float_as_uint(tk[9]), __float_as_uint(tk[10]), __float_as_uint(tk[11]));
            dst[3] = make_uint4(__float_as_uint(tk[12]), __float_as_uint(tk[13]), __float_as_uint(tk[14]), __float_as_uint(tk[15]));
        }
        __syncthreads();
    }
}
DI void phase_combine(const Params& p, int bid, int nb) {
    const unsigned* TOPL = (const unsigned*)(p.ws + OFF_TOPL);
    uint2* EX = (uint2*)(p.ws + OFF_EXPS);
    const float* SU = (const float*)(p.ws + OFF_SU);
    const float* SV = (const float*)(p.ws + OFF_SV);
    for (int i = bid * NTH + my_tid(); i < NTOK * PHEADS; i += nb * NTH) {
        const unsigned* l1 = TOPL + (size_t)i * 32;
        const unsigned* l2 = l1 + 16;
        float s2[16];
        {
            const uint4 a = ((const uint4*)l2)[0], b = ((const uint4*)l2)[1], c = ((const uint4*)l2)[2], d = ((const uint4*)l2)[3];
            const unsigned w[16] = {a.x, a.y, a.z, a.w, b.x, b.y, b.z, b.w, c.x, c.y, c.z, c.w, d.x, d.y, d.z, d.w};
#pragma unroll
            for (int j = 0; j < 16; ++j) s2[j] = __uint_as_float(w[j] & ~0x7fu);
        }
        float tk[16];
#pragma unroll
        for (int j = 0; j < 16; ++j) tk[j] = -3.0e38f;
        for (int a = 0; a < 16; ++a) {
            const float s1 = __uint_as_float(l1[a] & ~0x7fu);
#pragma unroll
            for (int b = 0; b < 16; ++b) {
                float xv = __uint_as_float((__float_as_uint(s1 + s2[b]) & ~0xffu) | (unsigned)(a * 16 + b));
#pragma unroll
                for (int j = 0; j < 16; ++j) { const float hi = fmaxf(tk[j], xv), lo = fminf(tk[j], xv); tk[j] = hi; xv = lo; }
            }
        }
        float e[16], sum = 0.f;
        const float mx = __uint_as_float(__float_as_uint(tk[0]) & ~0xffu);
#pragma unroll
        for (int j = 0; j < 16; ++j) { e[j] = __expf(__uint_as_float(__float_as_uint(tk[j]) & ~0xffu) - mx); sum += e[j]; }
        const float inv = 1.0f / sum;
#pragma unroll
        for (int j = 0; j < 16; ++j) {
            const unsigned ab = __float_as_uint(tk[j]) & 0xffu;
            const unsigned i1 = l1[ab >> 4] & 0x7fu, i2 = l2[ab & 15] & 0x7fu;
            const unsigned eid = i1 * 128u + i2;
            EX[(size_t)i * 16 + j] = make_uint2(eid | (((__float_as_uint(SU[eid]) >> 23) & 0xffu) << 16), __float_as_uint(e[j] * inv * SV[eid]));
        }
    }
}

DI void ce_desc(float& a, float& b) { const float hi = fmaxf(a, b), lo = fminf(a, b); a = hi; b = lo; }
template <int N> DI void bitonic_sort_desc(float (&v)[N]) {
#pragma unroll
    for (int k = 2; k <= N; k <<= 1)
#pragma unroll
        for (int j = k >> 1; j > 0; j >>= 1)
#pragma unroll
            for (int i = 0; i < N; ++i) { const int l = i ^ j; if (l > i) { if ((i & k) == 0 || k == N) ce_desc(v[i], v[l]); else ce_desc(v[l], v[i]); } }
}
DI void merge_top16(float (&a)[16], const float (&b)[16]) {
#pragma unroll
    for (int i = 0; i < 16; ++i) a[i] = fmaxf(a[i], b[15 - i]);
#pragma unroll
    for (int j = 8; j > 0; j >>= 1)
#pragma unroll
        for (int i = 0; i < 16; ++i) { const int l = i ^ j; if (l > i) ce_desc(a[i], a[l]); }
}
DI void xlane_merge16(float (&a)[16]) {
    float o[16];
#pragma unroll
    for (int i = 0; i < 16; ++i) o[i] = __shfl_xor(a[i], 32);
    merge_top16(a, o);
}
DI void retrieve_topk_hp(const bf16_t* Q, const char* skl, const int tok, const int hp_next, const int r, const int h, unsigned char* lutp, float (&out)[16], bf16x8 (&bq)[8]) {
                f32x16 acc[4];
#pragma unroll
                for (int mi = 0; mi < 4; ++mi)
#pragma unroll
                    for (int i = 0; i < 16; ++i) acc[mi][i] = 0.f;
                const char* kb = skl + r * 272 + h * 16;
#pragma unroll
                for (int ks = 0; ks < 8; ++ks) {
#pragma unroll
                    for (int mi = 0; mi < 4; ++mi) {
                        const bf16x8 a = *(const bf16x8*)(kb + mi * 32 * 272 + ks * 32);
                        acc[mi] = __builtin_amdgcn_mfma_f32_32x32x16_bf16(a, bq[ks], acc[mi], 0, 0, 0);
                    }
                }
                {
                    const bf16_t* qb = Q + (size_t)tok * 2048 + hp_next * 128 + 8 * h;
#pragma unroll
                    for (int ks = 0; ks < 8; ++ks) bq[ks] = *(const bf16x8*)(qb + ks * 16);
                }
                float v0[16], v1[16], v2[16], v3[16];
#pragma unroll
                for (int i = 0; i < 16; ++i) {
                    const unsigned n = (unsigned)crow(i, h);
                    v0[i] = __uint_as_float((__float_as_uint(acc[0][i]) & ~0x7fu) | n);
                    v1[i] = __uint_as_float((__float_as_uint(acc[1][i]) & ~0x7fu) | (n + 32u));
                    v2[i] = __uint_as_float((__float_as_uint(acc[2][i]) & ~0x7fu) | (n + 64u));
                    v3[i] = __uint_as_float((__float_as_uint(acc[3][i]) & ~0x7fu) | (n + 96u));
                }
                bitonic_sort_desc<16>(v0); bitonic_sort_desc<16>(v1); bitonic_sort_desc<16>(v2); bitonic_sort_desc<16>(v3);
                merge_top16(v0, v1); merge_top16(v2, v3); merge_top16(v0, v2);
                xlane_merge16(v0);
#pragma unroll
                for (int i = 0; i < 16; ++i) out[i] = v0[i];
                u32x4 ix;
                ix.x = (__float_as_uint(v0[0]) & 0x7fu) | ((__float_as_uint(v0[1]) & 0x7fu) << 8) | ((__float_as_uint(v0[2]) & 0x7fu) << 16) | ((__float_as_uint(v0[3]) & 0x7fu) << 24);
                ix.y = (__float_as_uint(v0[4]) & 0x7fu) | ((__float_as_uint(v0[5]) & 0x7fu) << 8) | ((__float_as_uint(v0[6]) & 0x7fu) << 16) | ((__float_as_uint(v0[7]) & 0x7fu) << 24);
                ix.z = (__float_as_uint(v0[8]) & 0x7fu) | ((__float_as_uint(v0[9]) & 0x7fu) << 8) | ((__float_as_uint(v0[10]) & 0x7fu) << 16) | ((__float_as_uint(v0[11]) & 0x7fu) << 24);
                ix.w = (__float_as_uint(v0[12]) & 0x7fu) | ((__float_as_uint(v0[13]) & 0x7fu) << 8) | ((__float_as_uint(v0[14]) & 0x7fu) << 16) | ((__float_as_uint(v0[15]) & 0x7fu) << 24);
                *(u32x4*)lutp = ix;
}
DI void phase_retrieve(const Params& p, int bid, int nb, char* smem) {
    const bf16_t* Q = (const bf16_t*)(p.ws + OFF_PROJ);
    const bf16_t* SK = (const bf16_t*)(p.ws + OFF_SUBK);
    const float* SU = (const float*)(p.ws + OFF_SU);
    const float* SV = (const float*)(p.ws + OFF_SV);
    uint2* EX = (uint2*)(p.ws + OFF_EXPS);
    const int tid = my_tid(), lane = tid & 63, wid = tid >> 6, r = lane & 31, h = lane >> 5;
    unsigned char* lut = (unsigned char*)smem + wid * 2048 + lane * 32;
    char* skb0 = smem + 16384;
    char* skb1 = skb0 + 128 * 272;
    u32x4 sr0, sr1, sr2, sr3;
#define SK_LOAD(hp_) { const bf16_t* g_ = SK + (size_t)(hp_) * 16384 + tid * 8; sr0 = *(const u32x4*)g_; sr1 = *(const u32x4*)(g_ + 4096); sr2 = *(const u32x4*)(g_ + 8192); sr3 = *(const u32x4*)(g_ + 12288); }
#define SK_STORE(buf_) { char* d_ = (buf_) + (tid >> 4) * 272 + (tid & 15) * 16; *(u32x4*)d_ = sr0; *(u32x4*)(d_ + 32 * 272) = sr1; *(u32x4*)(d_ + 64 * 272) = sr2; *(u32x4*)(d_ + 96 * 272) = sr3; }
    for (int it = bid; it < (NTOK / 256) * 2; it += nb) {
        const int hq = it & 1, tok = (it >> 1) * 256 + wid * 32 + r;
        __syncthreads();
        SK_LOAD(hq * 8); SK_STORE(skb0);
        bf16x8 bq[8];
        {
            const bf16_t* qb = Q + (size_t)tok * 2048 + (hq * 8) * 128 + 8 * h;
#pragma unroll
            for (int ks = 0; ks < 8; ++ks) bq[ks] = *(const bf16x8*)(qb + ks * 16);
        }
        __syncthreads();
#pragma unroll 1
        for (int hd = hq * 4; hd < hq * 4 + 4; ++hd) {
            float L0[16], L1[16];
            SK_LOAD(hd * 2 + 1);
            retrieve_topk_hp(Q, skb0, tok, hd * 2 + 1, r, h, lut, L0, bq);
            SK_STORE(skb1);
            __syncthreads();
            if (hd + 1 < hq * 4 + 4) SK_LOAD(hd * 2 + 2);
            retrieve_topk_hp(Q, skb1, tok, (hd + 1 < hq * 4 + 4) ? hd * 2 + 2 : hd * 2 + 1, r, h, lut + 16, L1, bq);
            if (hd + 1 < hq * 4 + 4) SK_STORE(skb0);
            __syncthreads();
            float c[32];
            {
                constexpr int PA[50] = {0, 0, 0, 0, 0, 0, 0, 0, 0, 0, 0, 0, 0, 0, 0, 0, 1, 1, 1, 1, 1, 1, 1, 1, 2, 2, 2, 2, 2, 3, 3, 3, 3, 4, 4, 4, 5, 5, 6, 6, 7, 7, 8, 9, 10, 11, 12, 13, 14, 15};
                constexpr int PB[50] = {0, 1, 2, 3, 4, 5, 6, 7, 8, 9, 10, 11, 12, 13, 14, 15, 0, 1, 2, 3, 4, 5, 6, 7, 0, 1, 2, 3, 4, 0, 1, 2, 3, 0, 1, 2, 0, 1, 0, 1, 0, 1, 0, 0, 0, 0, 0, 0, 0, 0};
#pragma unroll
                for (int q = 0; q < 25; ++q) {
                    const float s0 = __uint_as_float(__float_as_uint(L0[PA[2 * q]]) & ~0x7fu) + __uint_as_float(__float_as_uint(L1[PB[2 * q]]) & ~0x7fu);
                    const float s1 = __uint_as_float(__float_as_uint(L0[PA[2 * q + 1]]) & ~0x7fu) + __uint_as_float(__float_as_uint(L1[PB[2 * q + 1]]) & ~0x7fu);
                    const float p0 = __uint_as_float((__float_as_uint(s0) & ~0xffu) | (unsigned)(PA[2 * q] * 16 + PB[2 * q]));
                    const float p1 = __uint_as_float((__float_as_uint(s1) & ~0xffu) | (unsigned)(PA[2 * q + 1] * 16 + PB[2 * q + 1]));
                    c[q] = h ? p1 : p0;
                }
#pragma unroll
                for (int i = 25; i < 32; ++i) c[i] = -3.0e38f;
            }
            bitonic_sort_desc<32>(c);
            float t16[16];
#pragma unroll
            for (int i = 0; i < 16; ++i) t16[i] = c[i];
            xlane_merge16(t16);
            const float mx = __uint_as_float(__float_as_uint(t16[0]) & ~0xffu);
            float e[16], sum = 0.f;
#pragma unroll
            for (int j = 0; j < 16; ++j) { e[j] = __expf(__uint_as_float(__float_as_uint(t16[j]) & ~0xffu) - mx); sum += e[j]; }
            const float inv = 1.0f / sum;
            uint2* dst = EX + ((size_t)tok * 8 + hd) * 16 + 8 * h;
#pragma unroll
            for (int j = 0; j < 8; ++j) {
                float tlo = t16[j], thi = t16[8 + j], elo = e[j], ehi = e[8 + j];
                asm volatile("" : "+v"(tlo), "+v"(thi), "+v"(elo), "+v"(ehi));
                const float tv = h ? thi : tlo, ev = h ? ehi : elo;
                const unsigned ab = __float_as_uint(tv) & 0xffu;
                const unsigned eid = (unsigned)lut[ab >> 4] * 128u + (unsigned)lut[16 + (ab & 15u)];
                dst[j] = make_uint2(eid | (pack2(0.f, SU[eid]) & 0xffff0000u), __float_as_uint(ev * inv * SV[eid]));
            }
        }
    }
#undef SK_LOAD
#undef SK_STORE
}

DI float dot16_fp8(const u32x4 w, const f32x2 (&h)[8]) {
    f32x2 acc = __builtin_amdgcn_cvt_pk_f32_fp8((int)w.x, false) * h[0];
    acc += __builtin_amdgcn_cvt_pk_f32_fp8((int)w.x, true) * h[1];
    acc += __builtin_amdgcn_cvt_pk_f32_fp8((int)w.y, false) * h[2];
    acc += __builtin_amdgcn_cvt_pk_f32_fp8((int)w.y, true) * h[3];
    acc += __builtin_amdgcn_cvt_pk_f32_fp8((int)w.z, false) * h[4];
    acc += __builtin_amdgcn_cvt_pk_f32_fp8((int)w.z, true) * h[5];
    acc += __builtin_amdgcn_cvt_pk_f32_fp8((int)w.w, false) * h[6];
    acc += __builtin_amdgcn_cvt_pk_f32_fp8((int)w.w, true) * h[7];
    return acc.x + acc.y;
}
DI void axpy16_fp8(const float a, const u32x4 w, f32x2 (&o)[8]) {
    const f32x2 aa = {a, a};
    o[0] += aa * __builtin_amdgcn_cvt_pk_f32_fp8((int)w.x, false); o[1] += aa * __builtin_amdgcn_cvt_pk_f32_fp8((int)w.x, true);
    o[2] += aa * __builtin_amdgcn_cvt_pk_f32_fp8((int)w.y, false); o[3] += aa * __builtin_amdgcn_cvt_pk_f32_fp8((int)w.y, true);
    o[4] += aa * __builtin_amdgcn_cvt_pk_f32_fp8((int)w.z, false); o[5] += aa * __builtin_amdgcn_cvt_pk_f32_fp8((int)w.z, true);
    o[6] += aa * __builtin_amdgcn_cvt_pk_f32_fp8((int)w.w, false); o[7] += aa * __builtin_amdgcn_cvt_pk_f32_fp8((int)w.w, true);
}
DI float butterfly64(float (&pz)[64], const int lane) {
    const bool b5 = lane & 32, b4 = lane & 16, b3 = lane & 8, b2 = lane & 4, b1 = lane & 2, b0 = lane & 1;
    float q32[32], q16[16], q8[8], q4[4], q2[2];
#pragma unroll
    for (int j = 0; j < 32; ++j) q32[j] = (b5 ? pz[32 + j] : pz[j]) + __shfl_xor(b5 ? pz[j] : pz[32 + j], 32);
#pragma unroll
    for (int j = 0; j < 16; ++j) q16[j] = (b4 ? q32[16 + j] : q32[j]) + __shfl_xor(b4 ? q32[j] : q32[16 + j], 16);
#pragma unroll
    for (int j = 0; j < 8; ++j) q8[j] = (b3 ? q16[8 + j] : q16[j]) + __shfl_xor(b3 ? q16[j] : q16[8 + j], 8);
#pragma unroll
    for (int j = 0; j < 4; ++j) q4[j] = (b2 ? q8[4 + j] : q8[j]) + __shfl_xor(b2 ? q8[j] : q8[4 + j], 4);
#pragma unroll
    for (int j = 0; j < 2; ++j) q2[j] = (b1 ? q4[2 + j] : q4[j]) + __shfl_xor(b1 ? q4[j] : q4[2 + j], 2);
    return (b0 ? q2[1] : q2[0]) + __shfl_xor(b0 ? q2[0] : q2[1], 1);
}
DI float bfly8(float (&pz)[8], const int lane) {
    const bool b2 = lane & 4, b1 = lane & 2, b0 = lane & 1;
    float q4[4], q2[2];
#pragma unroll
    for (int i = 0; i < 4; ++i) q4[i] = (b2 ? pz[4 + i] : pz[i]) + __shfl_xor(b2 ? pz[i] : pz[4 + i], 4);
#pragma unroll
    for (int i = 0; i < 2; ++i) q2[i] = (b1 ? q4[2 + i] : q4[i]) + __shfl_xor(b1 ? q4[i] : q4[2 + i], 2);
    float q = (b0 ? q2[1] : q2[0]) + __shfl_xor(b0 ? q2[0] : q2[1], 1);
    q += __shfl_xor(q, 8); q += __shfl_xor(q, 16); q += __shfl_xor(q, 32);
    return q;
}
DI float bfly16(float (&pz)[16], const int lane) {
    const bool b3 = lane & 8, b2 = lane & 4, b1 = lane & 2, b0 = lane & 1;
    float q8[8], q4[4], q2[2];
#pragma unroll
    for (int i = 0; i < 8; ++i) q8[i] = (b3 ? pz[8 + i] : pz[i]) + __shfl_xor(b3 ? pz[i] : pz[8 + i], 8);
#pragma unroll
    for (int i = 0; i < 4; ++i) q4[i] = (b2 ? q8[4 + i] : q8[i]) + __shfl_xor(b2 ? q8[i] : q8[4 + i], 4);
#pragma unroll
    for (int i = 0; i < 2; ++i) q2[i] = (b1 ? q4[2 + i] : q4[i]) + __shfl_xor(b1 ? q4[i] : q4[2 + i], 2);
    float q = (b0 ? q2[1] : q2[0]) + __shfl_xor(b0 ? q2[0] : q2[1], 1);
    q += __shfl_xor(q, 16); q += __shfl_xor(q, 32);
    return q;
}
DI void gs_issue(const __amdgpu_buffer_rsrc_t T, const uint2* ent, const unsigned d, const int lane, u32x4 (&w)[8], unsigned& ca) {
    const int cnt = (int)((d >> 16) & 0xfu), k = lane & 7;
    const uint2 e = ent[(d & 0xffffu) + (unsigned)(k < cnt ? k : cnt - 1)];
    ca = (k < cnt && !(d >> 31)) ? e.y : 0u;
#pragma unroll
    for (int q = 0; q < 8; ++q) {
        const int eid = __builtin_amdgcn_readlane((int)e.x, q) & 0x3fff;
        w[q] = __builtin_amdgcn_raw_buffer_load_b128(T, lane * 16, eid * DM, 0);
    }
}
DI float dot16_i8(const u32x4 w, const u32x4 h) {
    int acc = __builtin_amdgcn_sdot4((int)w.x, (int)h.x, 0, false);
    acc = __builtin_amdgcn_sdot4((int)w.y, (int)h.y, acc, false);
    acc = __builtin_amdgcn_sdot4((int)w.z, (int)h.z, acc, false);
    acc = __builtin_amdgcn_sdot4((int)w.w, (int)h.w, acc, false);
    return (float)acc;
}
DI void gs_desc(const uint2* ent, const unsigned d, const int lane, unsigned& ex) {
    const int cnt = (int)((d >> 16) & 0xfu), k = lane & 7;
    ex = ent[(d & 0xffffu) + (unsigned)(k < cnt ? k : cnt - 1)].x;
}
DI void gs_loads(const __amdgpu_buffer_rsrc_t T, const unsigned ex, const int lane, u32x4 (&w)[8]) {
#pragma unroll
    for (int q = 0; q < 8; ++q) {
        const int eid = __builtin_amdgcn_readlane((int)ex, q) & 0x3fff;
        w[q] = __builtin_amdgcn_raw_buffer_load_b128(T, lane * 16, eid * DM, 0);
    }
}
DI void gs_upartial(const u32x4 (&w)[8], const u32x4 h2q, float (&pz)[16], const int base) {
#pragma unroll
    for (int k = 0; k < 8; ++k) pz[base + k] = dot16_i8(w[k], h2q);
}
DI void gs_ustore(float (&pz)[16], float* zb, const unsigned da, const unsigned db, const int lane) {
    const float z = bfly16(pz, lane);
    const unsigned d = (lane & 8) ? db : da;
    const int k = lane & 7;
    if (lane < 16 && k < (int)((d >> 16) & 0xfu) && !(d >> 31)) zb[(d & 0xffffu) + k] = z;
}
DI void axpy16_u8(const float a, const u32x4 w, float (&o)[16]) {
    o[0] += a * (float)(w.x & 0xffu); o[1] += a * (float)((w.x >> 8) & 0xffu); o[2] += a * (float)((w.x >> 16) & 0xffu); o[3] += a * (float)(w.x >> 24);
    o[4] += a * (float)(w.y & 0xffu); o[5] += a * (float)((w.y >> 8) & 0xffu); o[6] += a * (float)((w.y >> 16) & 0xffu); o[7] += a * (float)(w.y >> 24);
    o[8] += a * (float)(w.z & 0xffu); o[9] += a * (float)((w.z >> 8) & 0xffu); o[10] += a * (float)((w.z >> 16) & 0xffu); o[11] += a * (float)(w.z >> 24);
    o[12] += a * (float)(w.w & 0xffu); o[13] += a * (float)((w.w >> 8) & 0xffu); o[14] += a * (float)((w.w >> 16) & 0xffu); o[15] += a * (float)(w.w >> 24);
}
DI void gs_vcompute(const u32x4 (&w)[8], const unsigned ca, float (&acc)[16]) {
#pragma unroll
    for (int k = 0; k < 8; ++k) { axpy16_u8(__uint_as_float((unsigned)__builtin_amdgcn_readlane((int)ca, k)), w[k], acc); __builtin_amdgcn_sched_barrier(0); }
}
constexpr int GT = 4;
constexpr int NSL = 4, SLSH = 12;
DI void xcd_pace(unsigned* cnt, const unsigned nloc, unsigned& step) {
    __syncthreads();
    if (__builtin_amdgcn_workitem_id_x() == 0) {
        __hip_atomic_fetch_add(cnt, 1u, __ATOMIC_RELAXED, __HIP_MEMORY_SCOPE_AGENT);
        const unsigned target = nloc * (step + 1u);
        unsigned sp = 0;
        while (__hip_atomic_load(cnt, __ATOMIC_RELAXED, __HIP_MEMORY_SCOPE_AGENT) < target) { __builtin_amdgcn_s_sleep(1); if (++sp > (1u << 22)) break; }
    }
    ++step;
    __syncthreads();
}
DI void phase_gather(const Params& p, int bid, int nb, char* smem, unsigned* pace_cnt, const unsigned pace_n) {
    unsigned pstep = 0;
    const float* mod = (const float*)(p.ws + OFF_MOD);
    const float* AB = (const float*)(p.ws + OFF_AB);
    const float* STAT = (const float*)(p.ws + OFF_STAT);
    const uint2* EX = (const uint2*)(p.ws + OFF_EXPS);
    const __amdgpu_buffer_rsrc_t UT = __builtin_amdgcn_make_buffer_rsrc((void*)(p.ws + OFF_UT), 0, NEXP * DM, 0x00020000);
    const __amdgpu_buffer_rsrc_t VT = __builtin_amdgcn_make_buffer_rsrc((void*)(p.ws + OFF_VT), 0, NEXP * DM, 0x00020000);
    const int lane = my_tid() & 63, wid = my_tid() >> 6, c0 = lane * 16;
    char* wl = smem + wid * 7168;
    uint2* ent = (uint2*)wl; float* zb = (float*)(wl + 4096); int* offs = (int*)(wl + 6144); unsigned* sched = (unsigned*)(wl + 6144 + 256);
#pragma unroll 1
    for (int t0 = (bid * 8 + wid) * GT; t0 < NTOK; t0 += nb * 8 * GT) {
        u32x4 h2q[GT]; float hsc[GT], mu[GT], rs[GT]; float acc[GT][16];
        f32x4 scv[4], shv[4];
        {
            const int b = t0 / SEQ;
#pragma unroll
            for (int q = 0; q < 4; ++q) { scv[q] = *(const f32x4*)(AB + (size_t)b * DM + c0 + q * 4); shv[q] = *(const f32x4*)(AB + (size_t)(NB + b) * DM + c0 + q * 4); }
        }
#pragma unroll
        for (int j = 0; j < GT; ++j) {
            const int tok = t0 + j;
            const float* row = p.out + (size_t)tok * DM + c0;
            __builtin_amdgcn_sched_barrier(0);
            { mu[j] = STAT[tok] * (1.0f / 1024.0f); rs[j] = rsqrtf(fmaxf(STAT[NTOK + tok] * (1.0f / 1024.0f) - mu[j] * mu[j], 0.f) + LN_EPS); }
            {
                f32x4 hv[4];
                float m = 0.f;
#pragma unroll
                for (int q = 0; q < 4; ++q) { hv[q] = (*(const f32x4*)(row + q * 4) - mu[j]) * rs[j] * scv[q] + shv[q]; m = fmaxf(m, fmaxf(fmaxf(fabsf(hv[q].x), fabsf(hv[q].y)), fmaxf(fabsf(hv[q].z), fabsf(hv[q].w)))); }
#pragma unroll
                for (int sft = 1; sft < 64; sft <<= 1) m = fmaxf(m, __shfl_xor(m, sft));
                const float qs = m > 1e-30f ? 127.0f / m : 1.0f;
                hsc[j] = m > 1e-30f ? m * (1.0f / 127.0f) : 1.0f;
                unsigned hw[4];
#pragma unroll
                for (int q = 0; q < 4; ++q)
                    hw[q] = ((unsigned)(int)rintf(hv[q].x * qs) & 0xffu) | (((unsigned)(int)rintf(hv[q].y * qs) & 0xffu) << 8) | (((unsigned)(int)rintf(hv[q].z * qs) & 0xffu) << 16) | (((unsigned)(int)rintf(hv[q].w * qs) & 0xffu) << 24);
                h2q[j] = (u32x4){hw[0], hw[1], hw[2], hw[3]};
            }
            const uint2 e0 = EX[(size_t)tok * 128 + lane], e1 = EX[(size_t)tok * 128 + 64 + lane];
            const int s0 = (int)((e0.x & 0x3fffu) >> SLSH), s1 = (int)((e1.x & 0x3fffu) >> SLSH);
            int run = 0, pos0 = 0, pos1 = 0;
#pragma unroll
            for (int s = 0; s < NSL; ++s) {
                const unsigned long long m0 = __ballot(s0 == s), m1 = __ballot(s1 == s);
                const int c0n = __popcll(m0), c1n = __popcll(m1);
                const int below0 = (int)__builtin_amdgcn_mbcnt_hi((unsigned)(m0 >> 32), __builtin_amdgcn_mbcnt_lo((unsigned)m0, 0u));
                const int below1 = (int)__builtin_amdgcn_mbcnt_hi((unsigned)(m1 >> 32), __builtin_amdgcn_mbcnt_lo((unsigned)m1, 0u));
                if (lane == 0) offs[j * 9 + s] = run;
                pos0 = (s0 == s) ? run + below0 : pos0;
                pos1 = (s1 == s) ? run + c0n + below1 : pos1;
                run += c0n + c1n;
            }
            if (lane == 0) offs[j * 9 + NSL] = 128;
            ent[j * 128 + pos0] = e0; ent[j * 128 + pos1] = e1;
        }
        int nbat;
        {
            const int gs = (lane / GT) % NSL, gj = lane % GT;
            const int gb = offs[gj * 9 + gs], ge = offs[gj * 9 + gs + 1], cnt = lane < NSL * GT ? ge - gb : 0, nbt = (cnt + 7) >> 3;
            int incl = nbt;
#pragma unroll
            for (int m = 1; m < 32; m <<= 1) { const int o = __shfl_up(incl, m); if ((lane & 31) >= m) incl += o; }
            nbat = __builtin_amdgcn_readlane(incl, NSL * GT - 1);
            const int st = incl - nbt;
            for (int q = 0; q < nbt; ++q) { const int rem = cnt - 8 * q; sched[st + q] = (unsigned)(gj * 128 + gb + 8 * q) | ((unsigned)(rem < 8 ? rem : 8) << 16); }
            if (lane < 3) sched[nbat + lane] = 0x80010000u;
        }
        xcd_pace(pace_cnt, pace_n, pstep);
#ifndef PROBE_UX
#define PROBE_UX 1
#endif
        for (int rep = 0; rep < PROBE_UX; ++rep)
        {
            u32x4 wa[8], wb[8];
#define GS_UP(W_, D_, B_) { const unsigned j_ = ((D_) & 0xffffu) >> 7; \
                if (j_ == 0) gs_upartial(W_, h2q[0], pz, B_); else if (j_ == 1) gs_upartial(W_, h2q[1], pz, B_); \
                else if (j_ == 2) gs_upartial(W_, h2q[2], pz, B_); else gs_upartial(W_, h2q[3], pz, B_); }
#define GS_RD(i_) ((unsigned)__builtin_amdgcn_readfirstlane((int)sched[(i_)]))
            unsigned da = GS_RD(0), db = GS_RD(1), dn = GS_RD(2), ea, eb, en;
            gs_desc(ent, da, lane, ea); gs_desc(ent, db, lane, eb); gs_desc(ent, dn, lane, en);
            gs_loads(UT, ea, lane, wa);
#pragma unroll 1
            for (int i = 0; i < nbat; i += 2) {
                float pz[16];
                gs_loads(UT, eb, lane, wb);
                __builtin_amdgcn_sched_barrier(0);
                GS_UP(wa, da, 0);
                const unsigned dcur_a = da, dcur_b = db;
                da = dn; ea = en; dn = GS_RD(i + 3); gs_desc(ent, dn, lane, en);
                gs_loads(UT, ea, lane, wa);
                __builtin_amdgcn_sched_barrier(0);
                GS_UP(wb, dcur_b, 8);
                db = dn; eb = en; dn = GS_RD(i + 4); gs_desc(ent, dn, lane, en);
                gs_ustore(pz, zb, dcur_a, dcur_b, lane);
            }
#undef GS_UP
#undef GS_RD
        }
        float asum[GT];
#pragma unroll
        for (int j = 0; j < GT; ++j) {
            float as = 0.f;
#pragma unroll
            for (int q = 0; q < 2; ++q) {
                const int pos = j * 128 + q * 64 + lane;
                const uint2 e = ent[pos];
                const float z = zb[pos] * __uint_as_float(e.x & 0xffff0000u) * hsc[j];
                const float a = gelu_as(z) * __uint_as_float(e.y);
                ent[pos].y = __float_as_uint(a);
                as += a;
            }
#pragma unroll
            for (int sft = 1; sft < 64; sft <<= 1) as += __shfl_xor(as, sft);
            asum[j] = as;
        }
        xcd_pace(pace_cnt, pace_n, pstep);
#pragma unroll
        for (int j = 0; j < GT; ++j)
#pragma unroll
            for (int q = 0; q < 16; ++q) acc[j][q] = 0.f;
        {
            u32x4 wa[8]; unsigned ca;
#pragma unroll 1
            for (int i = 0; i < nbat; ++i) {
                const unsigned da = (unsigned)__builtin_amdgcn_readfirstlane((int)sched[i]);
                gs_issue(VT, ent, da, lane, wa, ca);
                __builtin_amdgcn_sched_barrier(0);
                const unsigned j_ = (da & 0xffffu) >> 7;
                if (j_ == 0) gs_vcompute(wa, ca, acc[0]); else if (j_ == 1) gs_vcompute(wa, ca, acc[1]);
                else if (j_ == 2) gs_vcompute(wa, ca, acc[2]); else gs_vcompute(wa, ca, acc[3]);
            }
        }
#pragma unroll
        for (int j = 0; j < GT; ++j) {
            asm volatile("" ::: "memory");
            __builtin_amdgcn_sched_barrier(0);
            const int tok = t0 + j, b = tok / SEQ;
            float* row = p.out + (size_t)tok * DM + c0;
            const float* g2 = mod + b * 6144 + 5120 + c0;
            f32x2 r[8];
            float sm = 0.f;
#pragma unroll
            for (int q = 0; q < 4; ++q) {
                const f32x4 xv = (*(const f32x4*)(row + q * 4) - mu[j]) * rs[j] * *(const f32x4*)(p.ln1w + c0 + q * 4) + *(const f32x4*)(p.ln1b + c0 + q * 4), gg = *(const f32x4*)(g2 + q * 4);
                const float off = 128.0f * asum[j];
                r[2 * q] = DEEP_ALPHA * (f32x2){xv.x, xv.y} + (f32x2){1.f + gg.x, 1.f + gg.y} * (f32x2){acc[j][4 * q] - off, acc[j][4 * q + 1] - off};
                r[2 * q + 1] = DEEP_ALPHA * (f32x2){xv.z, xv.w} + (f32x2){1.f + gg.z, 1.f + gg.w} * (f32x2){acc[j][4 * q + 2] - off, acc[j][4 * q + 3] - off};
                sm += r[2 * q].x + r[2 * q].y + r[2 * q + 1].x + r[2 * q + 1].y;
            }
#pragma unroll
            for (int m = 1; m < 64; m <<= 1) sm += __shfl_xor(sm, m);
            const float mu = sm * (1.0f / 1024.0f);
            float qq = 0.f;
#pragma unroll
            for (int i = 0; i < 8; ++i) { const f32x2 dd = r[i] - mu; qq += dd.x * dd.x + dd.y * dd.y; }
#pragma unroll
            for (int m = 1; m < 64; m <<= 1) qq += __shfl_xor(qq, m);
            const float rstd = rsqrtf(qq * (1.0f / 1024.0f) + LN_EPS);
#pragma unroll
            for (int q = 0; q < 4; ++q) {
                const f32x4 w4 = *(const f32x4*)(p.ln2w + c0 + q * 4), bi = *(const f32x4*)(p.ln2b + c0 + q * 4);
                f32x4 ov;
                ov.x = (r[2 * q].x - mu) * rstd * w4.x + bi.x; ov.y = (r[2 * q].y - mu) * rstd * w4.y + bi.y;
                ov.z = (r[2 * q + 1].x - mu) * rstd * w4.z + bi.z; ov.w = (r[2 * q + 1].y - mu) * rstd * w4.w + bi.w;
                *(f32x4*)(row + q * 4) = ov;
            }
        }
    }
}

#define XB_TMO      128
#define XB_XCNT(j)  (256  + 64 * (j))
#define XB_XSUB(j)  (1280 + 64 * (j))
#define XB_XGEN(j)  (2304 + 64 * (j))
#define XB_TOP      3328
#define XB_TOPGEN   3392
#define XCD_BAR_WORDS 3456
#define XB_SPIN_CAP (1u << 22)
#define LAS __attribute__((address_space(3)))
DI unsigned xb_ld(unsigned* p) { return __hip_atomic_load(p, __ATOMIC_RELAXED, __HIP_MEMORY_SCOPE_AGENT); }
DI unsigned xb_add(unsigned* p, unsigned v) { return __hip_atomic_fetch_add(p, v, __ATOMIC_RELAXED, __HIP_MEMORY_SCOPE_AGENT); }
DI unsigned xb_xcc_id() { return (unsigned)__builtin_amdgcn_s_getreg((3 << 11) | 20) & 0xFu; }
#define XB_SPIN(cond, bar) do { unsigned _sp = 0; while (cond) { __builtin_amdgcn_s_sleep(1); \
    if ((++_sp & 255u) == 0u) { if (xb_ld(&(bar)[XB_TMO])) break; if (_sp > XB_SPIN_CAP) { atomicAdd(&(bar)[XB_TMO], 1u); break; } } } } while (0)
struct XcdBarrier { unsigned* bar; unsigned x; volatile LAS unsigned* st; };
DI XcdBarrier xcd_barrier_post(unsigned* bar, volatile LAS unsigned* st) {
    XcdBarrier b; b.bar = bar; b.x = xb_xcc_id(); b.st = st;
    if (__builtin_amdgcn_workitem_id_x() == 0) (void)xb_add(&bar[XB_XCNT(b.x)], 1u);
    return b;
}
DI void xcd_barrier_complete(unsigned* bar, unsigned x, unsigned& nloc, unsigned& nx) {
    const unsigned G = gridDim.x * gridDim.y * gridDim.z;
    unsigned sum, cnt, mine, sp = 0u;
    for (;;) {
        sum = 0u; cnt = 0u; mine = 0u;
#pragma unroll
        for (unsigned j = 0; j < 16; ++j) { const unsigned c = xb_ld(&bar[XB_XCNT(j)]); sum += c; cnt += (c > 0u) ? 1u : 0u; mine = (j == x) ? c : mine; }
        if (sum == G) break;
        __builtin_amdgcn_s_sleep(1);
        if ((++sp & 255u) == 0u) { if (xb_ld(&bar[XB_TMO])) break; if (sp > XB_SPIN_CAP) { atomicAdd(&bar[XB_TMO], 1u); break; } }
    }
    nloc = mine > 0u ? mine : 1u; nx = cnt > 0u ? cnt : 1u;
}
DI void xcd_barrier(const XcdBarrier& b) {
    asm volatile("s_waitcnt vmcnt(0)" ::: "memory");
    __syncthreads();
    if (__builtin_amdgcn_workitem_id_x() == 0) {
        unsigned* bar = b.bar;
        __builtin_amdgcn_s_waitcnt(0);
        unsigned nloc = b.st[0], nx = b.st[1];
        if (nloc == 0u) { xcd_barrier_complete(bar, b.x, nloc, nx); b.st[0] = nloc; b.st[1] = nx; }
        const unsigned old = xb_add(&bar[XB_XSUB(b.x)], 1u);
        const unsigned gen = old / nloc;
        if (old + 1u == (gen + 1u) * nloc) {
            __builtin_amdgcn_fence(__ATOMIC_RELEASE, "agent");
            asm volatile("s_waitcnt vmcnt(0)" ::: "memory");
            const unsigned og = xb_add(&bar[XB_TOP], 1u);
            const unsigned tg = og / nx;
            if (og + 1u == (tg + 1u) * nx) xb_add(&bar[XB_TOPGEN], 1u);
            else XB_SPIN(xb_ld(&bar[XB_TOPGEN]) == tg, bar);
            __builtin_amdgcn_fence(__ATOMIC_ACQUIRE, "agent");
            xb_add(&bar[XB_XGEN(b.x)], 1u);
            asm volatile("s_waitcnt vmcnt(0)" ::: "memory");
        } else {
            XB_SPIN(xb_ld(&bar[XB_XGEN(b.x)]) == gen, bar);
            __builtin_amdgcn_fence(__ATOMIC_ACQUIRE, "agent");
            asm volatile("s_waitcnt vmcnt(0)" ::: "memory");
        }
    }
    __syncthreads();
}

__global__ void __launch_bounds__(NTH) k_mega(Params p) {
    __shared__ __attribute__((aligned(16))) char smem[SMEM_BYTES];
    volatile LAS unsigned* xst = (volatile LAS unsigned*)(smem + SMEM_BYTES - 16);
    if (__builtin_amdgcn_workitem_id_x() == 0) { xst[0] = 0u; xst[1] = 0u; }
    __syncthreads();
    const XcdBarrier xb = xcd_barrier_post((unsigned*)(p.ws + OFF_BAR), xst);
    const int bid = blockIdx.x, nb = gridDim.x;
#ifndef PROBE_MASK
#define PROBE_MASK 0
#endif
#define REP(bit) for (int rep_ = 0; rep_ < ((PROBE_MASK & (bit)) ? 2 : 1); ++rep_)
    phase_prep_a(p, smem);           xcd_barrier(xb);
    phase_prep_b(p, smem);           xcd_barrier(xb);
    REP(1)  { phase_proj(p, bid, nb, smem);    xcd_barrier(xb); }
    REP(128) { phase_hgprep(p, bid, nb);       xcd_barrier(xb); }
    REP(2)  { phase_mix(p, bid, nb, smem);     xcd_barrier(xb); }
    REP(4)  { phase_glu(p, bid, nb, smem);     xcd_barrier(xb); }
    REP(4)  { phase_a2(p, bid, nb);            xcd_barrier(xb); }
    REP(4)  { phase_outproj(p, bid, nb, smem); xcd_barrier(xb); }
    REP(8)  { phase_q(p, bid, nb, smem);       xcd_barrier(xb); }
    REP(16) { phase_retrieve(p, bid, nb, smem); xcd_barrier(xb); }
    phase_gather(p, bid, nb, smem, (unsigned*)(p.ws + OFF_BAR) + 16 * xb.x, xst[0]);
}

extern "C" void kernel_launch(void* const* d_in, const int* in_sizes, int n_in, void* d_out, int out_size, void* d_ws, size_t ws_size, hipStream_t stream) {
    if (n_in != 27 || ws_size < WS_END) { fprintf(stderr, "kernel_launch: unexpected n_in %d or ws_size %zu (< %zu)\n", n_in, ws_size, (size_t)WS_END); return; }
    static int grid_blocks = 0;
    if (!grid_blocks) {
        int dev = 0, cus = 0, per_cu = 0;
        (void)hipGetDevice(&dev);
        (void)hipDeviceGetAttribute(&cus, hipDeviceAttributeMultiprocessorCount, dev);
        (void)hipOccupancyMaxActiveBlocksPerMultiprocessor(&per_cu, k_mega, NTH, 0);
        if (cus <= 0) cus = 256;
        if (per_cu < 1) { fprintf(stderr, "kernel_launch: occupancy query says %d blocks/CU\n", per_cu); per_cu = 1; }
        grid_blocks = cus;
    }
    Params p{};
    const float** f = (const float**)&p;
    for (int i = 0; i < 27; ++i) f[i] = (const float*)d_in[i];
    p.out = (float*)d_out; p.ws = (char*)d_ws;
    hipError_t e = hipMemsetAsync((char*)d_ws + OFF_BAR, 0, (size_t)3456 * 4, stream);
    if (e == hipSuccess) { hipLaunchKernelGGL(k_mega, dim3(grid_blocks), dim3(NTH), 0, stream, p); e = hipPeekAtLastError(); }
    if (e != hipSuccess) fprintf(stderr, "launch failed: %s (grid %d)\n", hipGetErrorString(e), grid_blocks);
}
```

```cpp
#include <hip/hip_runtime.h>
#include <hip/hip_cooperative_groups.h>
#include <stdint.h>
#include <stdio.h>

namespace cg = cooperative_groups;
#define DI __device__ __forceinline__
typedef unsigned short bf16_t;
typedef short bf16x8 __attribute__((ext_vector_type(8)));
typedef float f32x16 __attribute__((ext_vector_type(16)));
typedef unsigned u32x4 __attribute__((ext_vector_type(4)));
typedef float f32x4 __attribute__((ext_vector_type(4)));
typedef float f32x2 __attribute__((ext_vector_type(2)));

constexpr int NTH = 512;
constexpr int NB = 16, SEQ = 2048, DM = 1024, NTOK = NB * SEQ;
constexpr int DHG = 512, HGH = 4, HDK = 128;
constexpr int DSS = 512, SSG = 32, SSC = 16, SSP = 64;
constexpr int INC = 2560;
constexpr int PHEADS = 8, NKEYS = 128, TOPK = 16, NEXP = 16384;
constexpr float DEEP_ALPHA = 1.189207115002721f;
constexpr float LN_EPS = 1e-5f, RMS_EPS = 1e-6f;
constexpr int SMEM_BYTES = 128 * 1024 + 256;

constexpr size_t al256(size_t x) { return (x + 255) & ~(size_t)255; }
constexpr size_t OFF_MOD = 0;
constexpr size_t OFF_LB = al256(OFF_MOD + (size_t)NB * 6144 * 4);
constexpr size_t OFF_LAM = al256(OFF_LB + 512 * 4);
constexpr size_t OFF_BB = al256(OFF_LAM + 32 * 64 * 2 * 4);
constexpr size_t OFF_WIN = al256(OFF_BB + 32 * 64 * 16 * 2 * 4);
constexpr size_t OFF_GLU = al256(OFF_WIN + (size_t)INC * DM * 2);
constexpr size_t OFF_WOUT = al256(OFF_GLU + (size_t)512 * 512 * 2);
constexpr size_t OFF_WQ = al256(OFF_WOUT + (size_t)DM * DM * 2);
constexpr size_t OFF_SUBK = al256(OFF_WQ + (size_t)2048 * DM * 2);
constexpr size_t OFF_SU = al256(OFF_SUBK + (size_t)16 * 128 * 128 * 2);
constexpr size_t OFF_SV = al256(OFF_SU + (size_t)NEXP * 4);
constexpr size_t OFF_UT = al256(OFF_SV + (size_t)NEXP * 4);
constexpr size_t OFF_VT = al256(OFF_UT + (size_t)NEXP * DM * 2);
constexpr size_t OFF_H = al256(OFF_VT + (size_t)NEXP * DM * 2);
constexpr size_t OFF_PROJ = al256(OFF_H + (size_t)NTOK * DM * 2);
constexpr size_t OFF_ORAW = al256(OFF_PROJ + (size_t)NTOK * INC * 2);
constexpr size_t OFF_YSSM = al256(OFF_ORAW + (size_t)NTOK * DHG * 4);
constexpr size_t OFF_A2 = al256(OFF_YSSM + (size_t)NTOK * DSS * 2);
constexpr size_t OFF_HG = al256(OFF_A2 + (size_t)NTOK * DM * 2);
constexpr size_t OFF_S5K = al256(OFF_HG + (size_t)4096 * 128 * 4);
constexpr size_t OFF_S5N = al256(OFF_S5K + (size_t)32 * 4096 * 2);
constexpr size_t OFF_S5M = al256(OFF_S5N + (size_t)32 * 128 * 256 * 2);
constexpr size_t OFF_S5L = al256(OFF_S5M + (size_t)32 * 256 * 128 * 2);
constexpr size_t OFF_STAT = al256(OFF_S5L + (size_t)32 * 64 * 2 * 4);
constexpr size_t OFF_AB = al256(OFF_STAT + (size_t)NTOK * 2 * 4);
constexpr size_t OFF_CAB = al256(OFF_AB + (size_t)2 * NB * DM * 4);
constexpr size_t OFF_BAR = al256(OFF_CAB + (size_t)2 * NB * 2048 * 4);
constexpr size_t WS_END = al256(OFF_BAR + (size_t)3456 * 4);
constexpr size_t OFF_HQ = OFF_H, OFF_HK = OFF_H + (size_t)NTOK * DHG * 2, OFF_HKT = OFF_A2, OFF_HVT = OFF_A2 + (size_t)NTOK * DHG * 2;
constexpr size_t OFF_TOPL = OFF_ORAW;
constexpr size_t OFF_EXPS = OFF_ORAW + (size_t)NTOK * 16 * 16 * 4;

struct Params {
    const float *x, *c, *ada_w, *ada_b, *w_in, *hg_lb, *hg_nw, *a_re, *a_im, *log_dt, *b_re, *b_im, *c_re, *c_im, *dsk,
        *glu_w, *glu_b, *ssm_nw, *w_out, *ln1w, *ln1b, *w_q, *subk, *pu, *pv, *ln2w, *ln2b;
    float* out;
    char* ws;
};

DI int my_tid() { int t = (int)__builtin_amdgcn_workitem_id_x(); asm volatile("" : "+v"(t)); return t; }
DI bf16_t f2bf(float x) { unsigned u = __float_as_uint(x); u += 0x7fffu + ((u >> 16) & 1u); return (bf16_t)(u >> 16); }
DI float bf2f(bf16_t b) { return __uint_as_float(((unsigned)b) << 16); }
DI float bflo(unsigned w) { return __uint_as_float(w << 16); }
DI float bfhi(unsigned w) { return __uint_as_float(w & 0xffff0000u); }
typedef __bf16 hwbf16x2 __attribute__((ext_vector_type(2)));
DI unsigned pack2(float a, float b) { const f32x2 v = {a, b}; return __builtin_bit_cast(unsigned, __builtin_convertvector(v, hwbf16x2)); }
DI bf16x8 pack8(const f32x16& x, const int base) {
    u32x4 o; o.x = pack2(x[base], x[base + 1]); o.y = pack2(x[base + 2], x[base + 3]); o.z = pack2(x[base + 4], x[base + 5]); o.w = pack2(x[base + 6], x[base + 7]);
    return __builtin_bit_cast(bf16x8, o);
}
DI float sigmoidf_(float x) { return 1.0f / (1.0f + __expf(-x)); }
DI float siluf_(float x) { return x * sigmoidf_(x); }
DI float geluf_(float x) { return 0.5f * x * (1.0f + erff(x * 0.70710678118654752f)); }
DI float gelu_as(float v) {
    const float t = __builtin_amdgcn_rcpf(fabsf(v) * 0.2316418882f + 1.0f);
    float q = t * 0.5307027145f + (-0.7265760135f); q = q * t + 0.7107068705f; q = q * t + (-0.142248368f); q = q * t + 0.127414796f; q = q * t;
    const float m = v * (q * __builtin_amdgcn_exp2f(v * v * (-0.72134752044f)));
    return v < 0.f ? m : v - m;
}

template <int MT, int NT_, int WM, int WN, class Epi>
DI void gemm_block(const bf16_t* __restrict__ A, int lda, const bf16_t* __restrict__ Bt, int ldb, int K, char* smem, Epi epi) {
    constexpr int BM = WM * MT * 32, BN = WN * NT_ * 32, LS = 72;
    static_assert(WM * WN == 8, "8 waves");
    bf16_t* As = (bf16_t*)smem;
    bf16_t* Bs = As + BM * LS;
    const int tid = my_tid(), lane = tid & 63, wid = tid >> 6, r = lane & 31, h = lane >> 5;
    const int wm = wid / WN, wn = wid % WN;
    constexpr int PA = BM * 8 / NTH, PB = BN * 8 / NTH;
    u32x4 ra[PA], rb[PB];
    f32x16 acc[MT][NT_];
#pragma unroll
    for (int mi = 0; mi < MT; ++mi)
#pragma unroll
        for (int ni = 0; ni < NT_; ++ni)
#pragma unroll
            for (int i = 0; i < 16; ++i) acc[mi][ni][i] = 0.f;
#define GEMM_GLOAD(kt_) { \
    _Pragma("unroll") for (int q = 0; q < PA; ++q) { const int idx = tid + q * NTH, row = idx >> 3, ch = idx & 7; ra[q] = *(const u32x4*)(A + (size_t)row * lda + (kt_) * 64 + ch * 8); } \
    _Pragma("unroll") for (int q = 0; q < PB; ++q) { const int idx = tid + q * NTH, row = idx >> 3, ch = idx & 7; rb[q] = *(const u32x4*)(Bt + (size_t)row * ldb + (kt_) * 64 + ch * 8); } }
#define GEMM_LSTORE() { \
    _Pragma("unroll") for (int q = 0; q < PA; ++q) { const int idx = tid + q * NTH, row = idx >> 3, ch = idx & 7; *(u32x4*)(As + row * LS + ch * 8) = ra[q]; } \
    _Pragma("unroll") for (int q = 0; q < PB; ++q) { const int idx = tid + q * NTH, row = idx >> 3, ch = idx & 7; *(u32x4*)(Bs + row * LS + ch * 8) = rb[q]; } }
    GEMM_GLOAD(0); GEMM_LSTORE(); __syncthreads();
    const int nk = K / 64;
    for (int kt = 0; kt < nk; ++kt) {
        if (kt + 1 < nk) GEMM_GLOAD(kt + 1);
#pragma unroll
        for (int ks = 0; ks < 4; ++ks) {
            bf16x8 a[MT], b[NT_];
#pragma unroll
            for (int mi = 0; mi < MT; ++mi) a[mi] = *(const bf16x8*)(As + (wm * MT * 32 + mi * 32 + r) * LS + ks * 16 + h * 8);
#pragma unroll
            for (int ni = 0; ni < NT_; ++ni) b[ni] = *(const bf16x8*)(Bs + (wn * NT_ * 32 + ni * 32 + r) * LS + ks * 16 + h * 8);
#pragma unroll
            for (int mi = 0; mi < MT; ++mi)
#pragma unroll
                for (int ni = 0; ni < NT_; ++ni) acc[mi][ni] = __builtin_amdgcn_mfma_f32_32x32x16_bf16(a[mi], b[ni], acc[mi][ni], 0, 0, 0);
        }
        __syncthreads();
        if (kt + 1 < nk) { GEMM_LSTORE(); __syncthreads(); }
    }
#pragma unroll
    for (int mi = 0; mi < MT; ++mi)
#pragma unroll
        for (int ni = 0; ni < NT_; ++ni)
#pragma unroll
            for (int i = 0; i < 16; ++i) epi(wm * MT * 32 + mi * 32 + (i & 3) + 8 * (i >> 2) + 4 * h, wn * NT_ * 32 + ni * 32 + r, acc[mi][ni][i]);
}

namespace pg8 {
#define PG8_LAS __attribute__((address_space(3)))
typedef unsigned short bf16_t;
typedef short bf16x8 __attribute__((ext_vector_type(8)));
typedef float f32x4 __attribute__((ext_vector_type(4)));
typedef unsigned u32x4 __attribute__((ext_vector_type(4)));
constexpr int BM = 256, BK = 64, HALF = 128, HTB = HALF * BK * 2  , STAGE_BYTES = 8 * HTB, NXCD = 8, WGM = 8;

__host__ __device__ __forceinline__ int lds_byte(int r, int c) { const int st = (r >> 4) * 2 + (c >> 5), rr = r & 15, cc = c & 31, ob = rr * 64 + cc * 2; return st * 1024 + (ob ^ (((ob >> 9) & 1) << 5)); }
__host__ __device__ __forceinline__ void stage_rc(int b, int& R, int& C) { const int st = b / 1024, sb = b % 1024, swz = sb ^ (((sb >> 9) & 1) << 5); R = (st >> 1) * 16 + swz / 64; C = (st & 1) * 32 + (swz % 64) / 2; }
__host__ __device__ __forceinline__ int perm32(int rho) { const int n = rho >> 4, i = rho & 15; return 8 * (i >> 2) + 4 * n + (i & 3); }

struct Unit { int pm, pn; };
struct Gemm { const bf16_t* A; const bf16_t* Bt; int M, N, K; };

struct StaticOrder {
    int nM, nN, nwg, G, c;
    __host__ __device__ void init(int M, int N, int G_, int c_) { nM = M / BM; nN = N / BM; nwg = nM * nN; G = G_; c = c_; }
    __host__ __device__ bool next(int i, Unit& u) const {
        const long L = (long)i * G + c; if (L >= nwg) return false;
        int wgid = (int)L; { const int q = nwg / NXCD, r = nwg % NXCD, xcd = wgid % NXCD, off = wgid / NXCD; wgid = (xcd < r ? xcd * (q + 1) : r * (q + 1) + (xcd - r) * q) + off; }
        const int nig = WGM * nN, gid = wgid / nig, fm = gid * WGM, gsz = (nM - fm) < WGM ? (nM - fm) : WGM;
        u.pm = fm + ((wgid % nig) % gsz); u.pn = (wgid % nig) / gsz; return true;
    }
    __device__ __forceinline__ void a_ready(const Unit&) const {}
    __device__ __forceinline__ void done(const Unit&) const {}
};
template <class Epi, class Sched, bool STAMP = false>
__device__ __forceinline__ void gemm_phase(PG8_LAS unsigned char* lds, const Gemm g, const Sched& S, const Epi& E, unsigned long long* stamps) {
    const int tid = (int)__builtin_amdgcn_workitem_id_x(), wid = __builtin_amdgcn_readfirstlane(tid >> 6), lane = tid & 63, wr = wid >> 2, wc = wid & 3, fr = lane & 15, fq = lane >> 4;
    const int K = g.K, nt = K / BK;
    int ts_lo = 0, ts_hi = 0, nts = 0; const unsigned long long rt_entry = STAMP ? (unsigned long long)wall_clock64() : 0ull;
#define PG8_STAMP() do { if (STAMP && wid == 0 && nts < 64) { const unsigned long long _c = (unsigned long long)clock64(); \
        ts_lo = (lane == nts) ? (int)(unsigned)_c : ts_lo; ts_hi = (lane == nts) ? (int)(unsigned)(_c >> 32) : ts_hi; ++nts; } } while (0)
    PG8_STAMP();
    unsigned voffA[2], voffB[2];
#pragma unroll
    for (int i = 0; i < 2; ++i) { int R, C; stage_rc(tid * 16 + i * 8192, R, C); const int Rb = Epi::PERM ? ((R & ~31) + perm32(R & 31)) : R;
        voffA[i] = (unsigned)(R * K + C) * 2u; voffB[i] = (unsigned)(Rb * K + C) * 2u; }
    const size_t kstep = (size_t)(BK * 2);
    const size_t hstep = (size_t)HALF * K * 2;
    const size_t tstep = 2 * hstep;
    const unsigned ldsw = (unsigned)wid * 1024u;
    const int aoff = lds_byte(wr * 64 + fr, fq * 8), boff = lds_byte(wc * 32 + fr, fq * 8);
#define PG8_SA(b, h) (((b) * 2 + (h)) * HTB)
#define PG8_SB(b, h) ((4 + (b) * 2 + (h)) * HTB)
#define PG8_STAGE(bufoff, gbase, voff) do { _Pragma("unroll") for (int _i = 0; _i < 2; ++_i) \
        __builtin_amdgcn_global_load_lds((const unsigned*)((const char*)(gbase) + (voff)[_i]), (PG8_LAS unsigned*)(lds + (bufoff) + ldsw + _i * 8192), 16, 0, 0); } while (0)
#define PG8_LDA(dst, b, h) do { _Pragma("unroll") for (int m = 0; m < 4; ++m) _Pragma("unroll") for (int k = 0; k < 2; ++k) dst[m][k] = *(const PG8_LAS bf16x8*)(lds + PG8_SA(b, h) + aoff + m * 2048 + k * 1024); } while (0)
#define PG8_LDB(dst, b, h) do { _Pragma("unroll") for (int n = 0; n < 2; ++n) _Pragma("unroll") for (int k = 0; k < 2; ++k) dst[n][k] = *(const PG8_LAS bf16x8*)(lds + PG8_SB(b, h) + boff + n * 2048 + k * 1024); } while (0)
#define PG8_MMA(ai, bj, At, Bt) do { __builtin_amdgcn_s_setprio(1); _Pragma("unroll") for (int m = 0; m < 4; ++m) _Pragma("unroll") for (int n = 0; n < 2; ++n) _Pragma("unroll") for (int k = 0; k < 2; ++k) \
        acc[ai][bj][m][n] = __builtin_amdgcn_mfma_f32_16x16x32_bf16(Bt[n][k], At[m][k], acc[ai][bj][m][n], 0, 0, 0); __builtin_amdgcn_s_setprio(0); } while (0)
#define PG8_WAIT_V(n) asm volatile("s_waitcnt vmcnt(" #n ")" ::: "memory")
#define PG8_WAIT_L(n) asm volatile("s_waitcnt lgkmcnt(" #n ")" ::: "memory")
#define PG8_BAR __builtin_amdgcn_s_barrier()
#define PG8_SCHED __builtin_amdgcn_sched_barrier(0)
    Unit cur, nxt; int ui = 0;
    if (!S.next(0, cur)) return;
    f32x4 acc[2][2][4][2];
#pragma unroll
    for (int a = 0; a < 2; ++a)
#pragma unroll
        for (int b = 0; b < 2; ++b)
#pragma unroll
            for (int m = 0; m < 4; ++m)
#pragma unroll
                for (int n = 0; n < 2; ++n) acc[a][b][m][n] = (f32x4){0.f, 0.f, 0.f, 0.f};
    bf16x8 At[4][2], B0[2][2], B1[2][2];
    const char* cA = (const char*)g.A + (size_t)cur.pm * tstep; const char* cB = (const char*)g.Bt + (size_t)cur.pn * tstep;
    S.a_ready(cur);
    PG8_STAGE(PG8_SB(0, 0), cB, voffB); PG8_STAGE(PG8_SA(0, 0), cA, voffA); PG8_STAGE(PG8_SB(0, 1), cB + hstep, voffB); PG8_STAGE(PG8_SA(0, 1), cA + hstep, voffA);
    if (wr == 1) PG8_BAR;
    PG8_WAIT_V(4); PG8_BAR;
    PG8_STAGE(PG8_SB(1, 0), cB + kstep, voffB); PG8_STAGE(PG8_SA(1, 0), cA + kstep, voffA); PG8_STAGE(PG8_SB(1, 1), cB + hstep + kstep, voffB);
    PG8_WAIT_V(6); PG8_BAR;
    PG8_STAMP();
    for (;;) {
        const bool has_next = S.next(ui + 1, nxt);
        const char* nA = has_next ? (const char*)g.A + (size_t)nxt.pm * tstep : cA; const char* nB = has_next ? (const char*)g.Bt + (size_t)nxt.pn * tstep : cB;
        for (int t = 0; t < nt; t += 2) {
            const bool last = (t == nt - 2);
            const char* a1 = cA + (size_t)(t + 1) * kstep;
            const char* a2 = last ? nA : cA + (size_t)(t + 2) * kstep; const char* b2 = last ? nB : cB + (size_t)(t + 2) * kstep;
            const char* a3 = a2 + kstep; const char* b3 = b2 + kstep;
            if (last && has_next) S.a_ready(nxt);
            PG8_LDB(B0, 0, 0); PG8_SCHED; PG8_LDA(At, 0, 0); PG8_STAGE(PG8_SA(1, 1), a1 + hstep, voffA);
            PG8_WAIT_L(8); PG8_BAR; PG8_WAIT_L(0); PG8_MMA(0, 0, At, B0); PG8_BAR; PG8_SCHED;
            PG8_LDB(B1, 0, 1); PG8_STAGE(PG8_SB(0, 0), b2, voffB);
            PG8_BAR; PG8_WAIT_L(0); PG8_MMA(0, 1, At, B1); PG8_BAR;
            PG8_LDA(At, 0, 1); PG8_STAGE(PG8_SA(0, 0), a2, voffA);
            PG8_BAR; PG8_WAIT_L(0); PG8_MMA(1, 0, At, B0); PG8_BAR; PG8_SCHED;
            PG8_STAGE(PG8_SB(0, 1), b2 + hstep, voffB);
            PG8_WAIT_V(6); PG8_BAR; PG8_MMA(1, 1, At, B1); PG8_BAR;
            PG8_LDB(B0, 1, 0); PG8_SCHED; PG8_LDA(At, 1, 0); PG8_STAGE(PG8_SA(0, 1), a2 + hstep, voffA);
            PG8_WAIT_L(8); PG8_BAR; PG8_WAIT_L(0); PG8_MMA(0, 0, At, B0); PG8_BAR; PG8_SCHED;
            PG8_LDB(B1, 1, 1); PG8_STAGE(PG8_SB(1, 0), b3, voffB);
            PG8_BAR; PG8_WAIT_L(0); PG8_MMA(0, 1, At, B1); PG8_BAR;
            PG8_LDA(At, 1, 1); PG8_STAGE(PG8_SA(1, 0), a3, voffA);
            PG8_BAR; PG8_WAIT_L(0); PG8_MMA(1, 0, At, B0); PG8_BAR; PG8_SCHED;
            PG8_STAGE(PG8_SB(1, 1), b3 + hstep, voffB);
            PG8_WAIT_V(6); PG8_BAR; PG8_MMA(1, 1, At, B1); PG8_BAR;
        }
        PG8_STAMP();
        if constexpr (!Epi::AFTER_DRAIN) { E(acc, cur, wr, wc, fr, fq); S.done(cur); }
        PG8_STAMP();
        if (!has_next) break;
#pragma unroll
        for (int a = 0; a < 2; ++a)
#pragma unroll
            for (int b = 0; b < 2; ++b)
#pragma unroll
                for (int m = 0; m < 4; ++m)
#pragma unroll
                    for (int n = 0; n < 2; ++n) acc[a][b][m][n] = (f32x4){0.f, 0.f, 0.f, 0.f};
        cur = nxt; cA = nA; cB = nB; ++ui;
    }
    PG8_WAIT_V(0);
    if (wr == 0) PG8_BAR;
    PG8_BAR;
    if constexpr (Epi::AFTER_DRAIN) { E.fused(acc, cur, wr, wc, fr, fq, lds, wid, lane); S.done(cur); }
    PG8_STAMP();
    if (STAMP && wid == 0) { stamps[lane] = lane < nts ? (((unsigned long long)(unsigned)ts_hi << 32) | (unsigned)ts_lo) : 0ull;
        if (lane == 62) stamps[62] = rt_entry; if (lane == 63) stamps[63] = (unsigned long long)wall_clock64(); }
#undef PG8_STAMP
#undef PG8_SA
#undef PG8_SB
#undef PG8_STAGE
#undef PG8_LDA
#undef PG8_LDB
#undef PG8_MMA
#undef PG8_WAIT_V
#undef PG8_WAIT_L
#undef PG8_BAR
#undef PG8_SCHED
}

__device__ __forceinline__ unsigned pk_bf16(float lo, float hi) { typedef float v2f __attribute__((ext_vector_type(2))); typedef __bf16 v2b __attribute__((ext_vector_type(2))); const v2f v = {lo, hi}; return __builtin_bit_cast(unsigned, __builtin_convertvector(v, v2b)); }
__device__ __forceinline__ float silu1(float x) { return x * __builtin_amdgcn_rcpf(1.0f + __expf(-x)); }
struct EpiBf16Act {
    static constexpr bool PERM = true, AFTER_DRAIN = false;
    bf16_t* O; int ldc; unsigned silu_mask;
    __device__ __forceinline__ void operator()(const f32x4 (&acc)[2][2][4][2], const Unit& u, int wr, int wc, int fr, int fq) const {
        const int row0 = u.pm * BM + wr * 64 + fr, col0 = u.pn * BM + wc * 32 + 8 * fq;
        const bool act = (silu_mask >> u.pn) & 1u;
#pragma unroll
        for (int ai = 0; ai < 2; ++ai)
#pragma unroll
            for (int m = 0; m < 4; ++m) { bf16_t* rowp = O + (size_t)(row0 + ai * HALF + m * 16) * ldc + col0;
#pragma unroll
                for (int bj = 0; bj < 2; ++bj) { f32x4 v0 = acc[ai][bj][m][0], v1 = acc[ai][bj][m][1];
                    if (act) {
#pragma unroll
                        for (int j = 0; j < 4; ++j) { v0[j] = silu1(v0[j]); v1[j] = silu1(v1[j]); } }
                    u32x4 w; w.x = pk_bf16(v0[0], v0[1]); w.y = pk_bf16(v0[2], v0[3]); w.z = pk_bf16(v1[0], v1[1]); w.w = pk_bf16(v1[2], v1[3]);
                    *(u32x4*)(rowp + bj * HALF) = w; } }
    }
};
struct EpiResid {
    static constexpr bool PERM = false, AFTER_DRAIN = false;
    float* C; const float* X; const float* mod_g;
    static constexpr int NTOK_ = 32768;
    float alpha; bf16_t* AP; const float* avec; float* stat;
    __device__ __forceinline__ void operator()(const f32x4 (&acc)[2][2][4][2], const Unit& u, int wr, int wc, int fr, int fq) const {
        const int row0 = u.pm * BM + wr * 64 + fr, col0 = u.pn * BM + wc * 32 + 4 * fq, bat = (u.pm * BM) / 2048;
        const float* gb = mod_g + (size_t)bat * 6144 + col0;
        const float* ab = avec + (size_t)bat * 1024 + col0;
        f32x4 gv[2][2], av[2][2];
#pragma unroll
        for (int bj = 0; bj < 2; ++bj)
#pragma unroll
            for (int n = 0; n < 2; ++n) { gv[bj][n] = *(const f32x4*)(gb + bj * HALF + n * 16) + 1.0f; av[bj][n] = *(const f32x4*)(ab + bj * HALF + n * 16); }
#pragma unroll
        for (int ai = 0; ai < 2; ++ai) {
            float s1[4], s2[4];
#pragma unroll
            for (int m = 0; m < 4; ++m) { const int row = row0 + ai * HALF + m * 16; const size_t ro = (size_t)row * 1024 + col0;
                s1[m] = 0.f; s2[m] = 0.f;
#pragma unroll
                for (int bj = 0; bj < 2; ++bj)
#pragma unroll
                    for (int n = 0; n < 2; ++n) {
                        const f32x4 xv = *(const f32x4*)(X + ro + bj * HALF + n * 16);
                        const f32x4 r1 = alpha * xv + gv[bj][n] * acc[ai][bj][m][n];
                        *(f32x4*)(C + ro + bj * HALF + n * 16) = r1;
                        const f32x4 ap = r1 * av[bj][n];
                        *(uint2*)(AP + ro + bj * HALF + n * 16) = make_uint2(pk_bf16(ap[0], ap[1]), pk_bf16(ap[2], ap[3]));
                        s1[m] += (r1[0] + r1[1]) + (r1[2] + r1[3]); s2[m] += (r1[0] * r1[0] + r1[1] * r1[1]) + (r1[2] * r1[2] + r1[3] * r1[3]);
                    }
            }
            const bool hi5 = fq & 2, hi4 = fq & 1;
            const float a1 = (hi5 ? s1[2] : s1[0]) + __shfl_xor(hi5 ? s1[0] : s1[2], 32), b1 = (hi5 ? s1[3] : s1[1]) + __shfl_xor(hi5 ? s1[1] : s1[3], 32);
            const float a2 = (hi5 ? s2[2] : s2[0]) + __shfl_xor(hi5 ? s2[0] : s2[2], 32), b2 = (hi5 ? s2[3] : s2[1]) + __shfl_xor(hi5 ? s2[1] : s2[3], 32);
            const float t1 = (hi4 ? b1 : a1) + __shfl_xor(hi4 ? a1 : b1, 16), t2 = (hi4 ? b2 : a2) + __shfl_xor(hi4 ? a2 : b2, 16);
            const int srow = u.pm * BM + wr * 64 + ai * HALF + fq * 16 + fr;
            atomicAdd(stat + srow, t1); atomicAdd(stat + NTOK_ + srow, t2);
        }
    }
};
struct EpiQLN {
    static constexpr bool PERM = true, AFTER_DRAIN = false;
    bf16_t* O; const float* stat; const float* ca; const float* cb; float eps;
    __device__ __forceinline__ void operator()(const f32x4 (&acc)[2][2][4][2], const Unit& u, int wr, int wc, int fr, int fq) const {
        const int row0 = u.pm * BM + wr * 64 + fr, col0 = u.pn * BM + wc * 32 + 8 * fq, bat = (u.pm * BM) / 2048;
        const float* cap = ca + (size_t)bat * 2048 + col0;
        const float* cbp = cb + (size_t)bat * 2048 + col0;
#pragma unroll
        for (int bj = 0; bj < 2; ++bj) {
            const f32x4 a0 = *(const f32x4*)(cap + bj * HALF), a1 = *(const f32x4*)(cap + bj * HALF + 4), b0 = *(const f32x4*)(cbp + bj * HALF), b1 = *(const f32x4*)(cbp + bj * HALF + 4);
#pragma unroll
            for (int ai = 0; ai < 2; ++ai)
#pragma unroll
                for (int m = 0; m < 4; ++m) {
                    const int row = row0 + ai * HALF + m * 16;
                    const float mu = stat[row] * (1.0f / 1024.0f), rstd = rsqrtf(fmaxf(stat[32768 + row] * (1.0f / 1024.0f) - mu * mu, 0.f) + eps);
                    const f32x4 v0 = rstd * (acc[ai][bj][m][0] - mu * a0) + b0, v1 = rstd * (acc[ai][bj][m][1] - mu * a1) + b1;
                    u32x4 w; w.x = pk_bf16(v0[0], v0[1]); w.y = pk_bf16(v0[2], v0[3]); w.z = pk_bf16(v1[0], v1[1]); w.w = pk_bf16(v1[2], v1[3]);
                    *(u32x4*)(O + (size_t)row * 2048 + col0 + bj * HALF) = w;
                }
        }
    }
};
struct EpiGlu {
    static constexpr bool PERM = false, AFTER_DRAIN = false;
    float* C; const bf16_t* Y; const float* bias;
    __device__ __forceinline__ void operator()(const f32x4 (&acc)[2][2][4][2], const Unit& u, int wr, int wc, int fr, int fq) const {
        const int row0 = u.pm * BM + wr * 64 + fr, col0 = u.pn * BM + wc * 32 + 4 * fq;
        f32x4 bv[2][2];
#pragma unroll
        for (int bj = 0; bj < 2; ++bj)
#pragma unroll
            for (int n = 0; n < 2; ++n) bv[bj][n] = *(const f32x4*)(bias + col0 + bj * HALF + n * 16);
#pragma unroll
        for (int ai = 0; ai < 2; ++ai)
#pragma unroll
            for (int m = 0; m < 4; ++m) { const size_t ro = (size_t)(row0 + ai * HALF + m * 16) * 512 + col0;
#pragma unroll
                for (int bj = 0; bj < 2; ++bj)
#pragma unroll
                    for (int n = 0; n < 2; ++n) {
                        const uint2 yw = *(const uint2*)(Y + ro + bj * HALF + n * 16);
                        const f32x4 z = acc[ai][bj][m][n] + bv[bj][n];
                        f32x4 o;
                        o[0] = __uint_as_float(yw.x << 16) * __builtin_amdgcn_rcpf(1.0f + __expf(-z[0])); o[1] = __uint_as_float(yw.x & 0xffff0000u) * __builtin_amdgcn_rcpf(1.0f + __expf(-z[1]));
                        o[2] = __uint_as_float(yw.y << 16) * __builtin_amdgcn_rcpf(1.0f + __expf(-z[2])); o[3] = __uint_as_float(yw.y & 0xffff0000u) * __builtin_amdgcn_rcpf(1.0f + __expf(-z[3]));
                        *(f32x4*)(C + ro + bj * HALF + n * 16) = o; } }
    }
};
}

DI void prep_mod_item(const Params& p, int item, char* smem) {
    float* condT = (float*)smem;
    float* red = condT + DM * 16;
    const int tid = my_tid();
    for (int i = tid; i < NB * DM; i += NTH) { const int b = i >> 10, k = i & 1023; condT[k * 16 + b] = siluf_(p.c[i]); }
    __syncthreads();
    const int ks = tid >> 5, col = tid & 31;
    float acc[16];
#pragma unroll
    for (int b = 0; b < 16; ++b) acc[b] = 0.f;
    const float* w = p.ada_w + (size_t)(ks * 64) * 6144 + item * 32 + col;
#pragma unroll 1
    for (int seg = 0; seg < 4; ++seg) {
        float wreg[16];
#pragma unroll
        for (int k = 0; k < 16; ++k) wreg[k] = w[(size_t)(seg * 16 + k) * 6144];
#pragma unroll
        for (int k = 0; k < 16; ++k) {
            const float wv = wreg[k];
            const f32x4* cb = (const f32x4*)(condT + (ks * 64 + seg * 16 + k) * 16);
            const f32x4 c0 = cb[0], c1 = cb[1], c2 = cb[2], c3 = cb[3];
            acc[0] += c0.x * wv; acc[1] += c0.y * wv; acc[2] += c0.z * wv; acc[3] += c0.w * wv;
            acc[4] += c1.x * wv; acc[5] += c1.y * wv; acc[6] += c1.z * wv; acc[7] += c1.w * wv;
            acc[8] += c2.x * wv; acc[9] += c2.y * wv; acc[10] += c2.z * wv; acc[11] += c2.w * wv;
            acc[12] += c3.x * wv; acc[13] += c3.y * wv; acc[14] += c3.z * wv; acc[15] += c3.w * wv;
        }
    }
#pragma unroll
    for (int b = 0; b < 16; ++b) red[(ks * 32 + col) * 16 + b] = acc[b];
    __syncthreads();
    {
        const int b = tid >> 5;
        float sum = p.ada_b[item * 32 + col];
#pragma unroll
        for (int q = 0; q < 16; ++q) sum += red[(q * 32 + col) * 16 + b];
        ((float*)(p.ws + OFF_MOD))[b * 6144 + item * 32 + col] = sum;
    }
    __syncthreads();
}
DI void prep_s5_gemm_item(const Params& p, int g, int part, char* smem) {
    f32x2* pw = (f32x2*)smem;
    f32x2* bbL = pw + 17 * 64;
    f32x2* cL = bbL + 64 * 16;
    const int tid = my_tid();
    const float dt = expf(p.log_dt[g]);
#pragma unroll 1
    for (int idx = tid; idx < 17 * 64; idx += NTH) {
        const int j = idx >> 6, pp = idx & 63;
        const float ar = p.a_re[g * 64 + pp], ai = p.a_im[g * 64 + pp];
        const float mag = expf(ar * dt * (float)j), ang = ai * dt * (float)j;
        pw[idx] = (f32x2){mag * cosf(ang), mag * sinf(ang)};
    }
    for (int idx = tid; idx < 16 * 64; idx += NTH) { const int i = idx >> 6, pp = idx & 63; cL[idx] = (f32x2){p.c_re[(g * 16 + i) * 64 + pp], p.c_im[(g * 16 + i) * 64 + pp]}; }
    __syncthreads();
    for (int idx = tid; idx < 64 * 16; idx += NTH) {
        const int pp = idx >> 4, i = idx & 15;
        const float ar = p.a_re[g * 64 + pp], ai = p.a_im[g * 64 + pp];
        const f32x2 lam = pw[64 + pp];
        const float den = ar * ar + ai * ai, nr = lam.x - 1.0f, ni = lam.y;
        const float zr = (nr * ar + ni * ai) / den, zi = (ni * ar - nr * ai) / den;
        const float br = p.b_re[(g * 64 + pp) * 16 + i], bi = p.b_im[(g * 64 + pp) * 16 + i];
        bbL[idx] = (f32x2){zr * br - zi * bi, zr * bi + zi * br};
    }
    __syncthreads();
    bf16_t* NBg = (bf16_t*)(p.ws + OFF_S5N) + (size_t)g * 128 * 256;
    if (part == 0)
#pragma unroll 1
    for (int ch = tid; ch < 128 * 256 / 8; ch += NTH) {
        const int pq = ch >> 5, t = (ch >> 1) & 15, i0 = (ch & 1) * 8, pp = pq & 63;
        const f32x2 w = pw[(15 - t) * 64 + pp];
        float v[8];
#pragma unroll
        for (int e = 0; e < 8; ++e) { const f32x2 bb = bbL[pp * 16 + i0 + e]; v[e] = pq < 64 ? (w.x * bb.x - w.y * bb.y) : (w.x * bb.y + w.y * bb.x); }
        u32x4 o; o.x = pack2(v[0], v[1]); o.y = pack2(v[2], v[3]); o.z = pack2(v[4], v[5]); o.w = pack2(v[6], v[7]);
        *(u32x4*)(NBg + (size_t)((((pq >> 5) * 16 + t) * 64) + (i0 >> 3) * 32 + (pq & 31)) * 8) = o;
    }
    bf16_t* MBg = (bf16_t*)(p.ws + OFF_S5M) + (size_t)g * 256 * 128;
    if (part == 1)
#pragma unroll 1
    for (int ch = tid; ch < 256 * 128 / 8; ch += NTH) {
        const int ti = ch >> 4, p0 = (ch & 15) * 8, tq = ti >> 4, iq = ti & 15;
        float v[8];
#pragma unroll
        for (int e = 0; e < 8; ++e) {
            const int pq = p0 + e, pp = pq & 63;
            const f32x2 c = cL[iq * 64 + pp], w = pw[(tq + 1) * 64 + pp];
            v[e] = pq < 64 ? (c.x * w.x - c.y * w.y) : -(c.x * w.y + c.y * w.x);
        }
        u32x4 o; o.x = pack2(v[0], v[1]); o.y = pack2(v[2], v[3]); o.z = pack2(v[4], v[5]); o.w = pack2(v[6], v[7]);
        *(u32x4*)(MBg + (size_t)((((ti >> 5) * 8 + (p0 >> 4)) * 64) + ((p0 >> 3) & 1) * 32 + (ti & 31)) * 8) = o;
    }
    bf16_t* KTg = (bf16_t*)(p.ws + OFF_S5K) + (size_t)g * 4096;
    if (part >= 2)
#pragma unroll 1
    for (int idx = (part - 2) * 2048 + tid; idx < (part - 1) * 2048; idx += NTH) {
        const int lag = idx >> 8, iq = (idx >> 4) & 15, i = idx & 15;
        float acc = (lag == 0 && iq == i) ? p.dsk[g * 16 + iq] : 0.f;
#pragma unroll 4
        for (int pp = 0; pp < 64; ++pp) {
            const f32x2 c = cL[iq * 64 + pp], w = pw[lag * 64 + pp], bb = bbL[pp * 16 + i];
            const float mr = c.x * w.x - c.y * w.y, mi_ = c.x * w.y + c.y * w.x;
            acc += mr * bb.x - mi_ * bb.y;
        }
        KTg[idx] = f2bf(acc);
    }
    if (part == 3 && tid < 64) { float* L = (float*)(p.ws + OFF_S5L) + (g * 64 + tid) * 2; const f32x2 w = pw[16 * 64 + tid]; L[0] = w.x; L[1] = w.y; }
    __syncthreads();
}
DI void prep_s5_item(const Params& p, int g) {
    const int tid = my_tid();
    if (tid < SSP) {
        const int pi = g * SSP + tid;
        const float dt = expf(p.log_dt[g]);
        const float ar = p.a_re[pi], ai = p.a_im[pi];
        const float mag = expf(ar * dt);
        const float lr = mag * cosf(ai * dt), li = mag * sinf(ai * dt);
        const float den = ar * ar + ai * ai, nr = lr - 1.0f, ni = li;
        const float zr = (nr * ar + ni * ai) / den, zi = (ni * ar - nr * ai) / den;
        float* lam = (float*)(p.ws + OFF_LAM) + pi * 2;
        lam[0] = lr; lam[1] = li;
        float* bb = (float*)(p.ws + OFF_BB) + (size_t)pi * 32;
        for (int i = 0; i < SSC; ++i) {
            const float br = p.b_re[pi * SSC + i], bi = p.b_im[pi * SSC + i];
            bb[i * 2] = zr * br - zi * bi; bb[i * 2 + 1] = zr * bi + zi * br;
        }
    }
}
DI void prep_transpose_tile(const float* __restrict__ W, bf16_t* __restrict__ Wt, int K, int N, int kt, int nt, char* smem) {
    float* tile = (float*)smem;
    const int tid = my_tid();
#pragma unroll
    for (int q = 0; q < 2; ++q) {
        const int kk = (tid >> 4) + q * 32, c4 = (tid & 15) * 4;
        const float4 v = *(const float4*)(W + (size_t)(kt * 64 + kk) * N + nt * 64 + c4);
        tile[kk * 65 + c4] = v.x; tile[kk * 65 + c4 + 1] = v.y; tile[kk * 65 + c4 + 2] = v.z; tile[kk * 65 + c4 + 3] = v.w;
    }
    __syncthreads();
    const int n = tid >> 3, kc = tid & 7;
    uint4 o;
    o.x = pack2(tile[(kc * 8 + 0) * 65 + n], tile[(kc * 8 + 1) * 65 + n]);
    o.y = pack2(tile[(kc * 8 + 2) * 65 + n], tile[(kc * 8 + 3) * 65 + n]);
    o.z = pack2(tile[(kc * 8 + 4) * 65 + n], tile[(kc * 8 + 5) * 65 + n]);
    o.w = pack2(tile[(kc * 8 + 6) * 65 + n], tile[(kc * 8 + 7) * 65 + n]);
    *(uint4*)(Wt + (size_t)(nt * 64 + n) * K + kt * 64 + kc * 8) = o;
    __syncthreads();
}
DI void cvt_bf16_stream(const float* __restrict__ src, bf16_t* __restrict__ dst, size_t n8, int bid, int nb) {
    for (size_t i = (size_t)bid * NTH + my_tid(); i < n8; i += (size_t)nb * NTH) {
        const float4 a = *(const float4*)(src + i * 8), b = *(const float4*)(src + i * 8 + 4);
        uint4 o; o.x = pack2(a.x, a.y); o.y = pack2(a.z, a.w); o.z = pack2(b.x, b.y); o.w = pack2(b.z, b.w);
        *(uint4*)(dst + i * 8) = o;
    }
}
DI void cvt_fp8_rows(const float* __restrict__ src, unsigned char* __restrict__ dst, float* __restrict__ inv, int bid, int nb) {
    const int lane = my_tid() & 63, wid = my_tid() >> 6;
    for (int row = bid * 8 + wid; row < NEXP; row += nb * 8) {
        const float* sp = src + (size_t)row * DM + lane * 16;
        const f32x4 a = *(const f32x4*)sp, b = *(const f32x4*)(sp + 4), c = *(const f32x4*)(sp + 8), d = *(const f32x4*)(sp + 12);
        float m = fmaxf(fmaxf(fmaxf(fabsf(a.x), fabsf(a.y)), fmaxf(fabsf(a.z), fabsf(a.w))), fmaxf(fmaxf(fabsf(b.x), fabsf(b.y)), fmaxf(fabsf(b.z), fabsf(b.w))));
        m = fmaxf(m, fmaxf(fmaxf(fmaxf(fabsf(c.x), fabsf(c.y)), fmaxf(fabsf(c.z), fabsf(c.w))), fmaxf(fmaxf(fabsf(d.x), fabsf(d.y)), fmaxf(fabsf(d.z), fabsf(d.w)))));
#pragma unroll
        for (int s = 1; s < 64; s <<= 1) m = fmaxf(m, __shfl_xor(m, s));
        float sc = 1.f, isc = 1.f;
        if (m > 1e-30f) {
            int k = (int)floorf(log2f(448.0f / m));
            k = k < -60 ? -60 : (k > 60 ? 60 : k);
            sc = ldexpf(1.0f, k); isc = ldexpf(1.0f, -k);
            if (m * sc > 448.0f) { sc *= 0.5f; isc *= 2.0f; }
        }
        u32x4 o;
        int w;
        w = __builtin_amdgcn_cvt_pk_fp8_f32(a.x * sc, a.y * sc, 0, false); w = __builtin_amdgcn_cvt_pk_fp8_f32(a.z * sc, a.w * sc, w, true); o.x = (unsigned)w;
        w = __builtin_amdgcn_cvt_pk_fp8_f32(b.x * sc, b.y * sc, 0, false); w = __builtin_amdgcn_cvt_pk_fp8_f32(b.z * sc, b.w * sc, w, true); o.y = (unsigned)w;
        w = __builtin_amdgcn_cvt_pk_fp8_f32(c.x * sc, c.y * sc, 0, false); w = __builtin_amdgcn_cvt_pk_fp8_f32(c.z * sc, c.w * sc, w, true); o.z = (unsigned)w;
        w = __builtin_amdgcn_cvt_pk_fp8_f32(d.x * sc, d.y * sc, 0, false); w = __builtin_amdgcn_cvt_pk_fp8_f32(d.z * sc, d.w * sc, w, true); o.w = (unsigned)w;
        *(u32x4*)(dst + (size_t)row * DM + lane * 16) = o;
        if (lane == 0) inv[row] = isc;
    }
}
DI void cvt_fp4_rows(const float* __restrict__ src, unsigned char* __restrict__ dst, float* __restrict__ inv, int bid, int nb) {
    const int lane = my_tid() & 63, wid = my_tid() >> 6;
    for (int row = bid * 8 + wid; row < NEXP; row += nb * 8) {
        const float* sp = src + (size_t)row * DM + lane * 16;
        const f32x4 a = *(const f32x4*)sp, b = *(const f32x4*)(sp + 4), c = *(const f32x4*)(sp + 8), d = *(const f32x4*)(sp + 12);
        float m = fmaxf(fmaxf(fmaxf(fabsf(a.x), fabsf(a.y)), fmaxf(fabsf(a.z), fabsf(a.w))), fmaxf(fmaxf(fabsf(b.x), fabsf(b.y)), fmaxf(fabsf(b.z), fabsf(b.w))));
        m = fmaxf(m, fmaxf(fmaxf(fmaxf(fabsf(c.x), fabsf(c.y)), fmaxf(fabsf(c.z), fabsf(c.w))), fmaxf(fmaxf(fabsf(d.x), fabsf(d.y)), fmaxf(fabsf(d.z), fabsf(d.w)))));
#pragma unroll
        for (int s = 1; s < 64; s <<= 1) m = fmaxf(m, __shfl_xor(m, s));
        const float sc = m > 1e-30f ? 6.0f / m : 1.0f, isc = m > 1e-30f ? m * (1.0f / 6.0f) : 1.0f;
        unsigned w0 = 0u, w1 = 0u;
        w0 = __builtin_amdgcn_cvt_scalef32_pk_fp4_f32(w0, a.x * sc, a.y * sc, 1.0f, 0); w0 = __builtin_amdgcn_cvt_scalef32_pk_fp4_f32(w0, a.z * sc, a.w * sc, 1.0f, 1);
        w0 = __builtin_amdgcn_cvt_scalef32_pk_fp4_f32(w0, b.x * sc, b.y * sc, 1.0f, 2); w0 = __builtin_amdgcn_cvt_scalef32_pk_fp4_f32(w0, b.z * sc, b.w * sc, 1.0f, 3);
        w1 = __builtin_amdgcn_cvt_scalef32_pk_fp4_f32(w1, c.x * sc, c.y * sc, 1.0f, 0); w1 = __builtin_amdgcn_cvt_scalef32_pk_fp4_f32(w1, c.z * sc, c.w * sc, 1.0f, 1);
        w1 = __builtin_amdgcn_cvt_scalef32_pk_fp4_f32(w1, d.x * sc, d.y * sc, 1.0f, 2); w1 = __builtin_amdgcn_cvt_scalef32_pk_fp4_f32(w1, d.z * sc, d.w * sc, 1.0f, 3);
        *(uint2*)(dst + (size_t)row * (DM / 2) + lane * 8) = make_uint2(w0, w1);
        if (lane == 0) inv[row] = isc;
    }
}
template <int OFFS>
DI void cvt_i8_rows(const float* __restrict__ src, unsigned char* __restrict__ dst, float* __restrict__ inv, int bid, int nb) {
    const int lane = my_tid() & 63, wid = my_tid() >> 6;
    for (int row0 = bid * 8 + wid; row0 < NEXP; row0 += nb * 8 * 4) {
        f32x4 x[4][4];
#pragma unroll
        for (int rr = 0; rr < 4; ++rr) {
            const int row = row0 + rr * nb * 8;
            const float* sp = src + (size_t)(row < NEXP ? row : row0) * DM + lane * 16;
#pragma unroll
            for (int q = 0; q < 4; ++q) x[rr][q] = *(const f32x4*)(sp + q * 4);
        }
#pragma unroll
        for (int rr = 0; rr < 4; ++rr) {
            const int row = row0 + rr * nb * 8;
            float m = 0.f;
#pragma unroll
            for (int q = 0; q < 4; ++q) m = fmaxf(m, fmaxf(fmaxf(fabsf(x[rr][q].x), fabsf(x[rr][q].y)), fmaxf(fabsf(x[rr][q].z), fabsf(x[rr][q].w))));
#pragma unroll
            for (int s = 1; s < 64; s <<= 1) m = fmaxf(m, __shfl_xor(m, s));
            const float sc = m > 1e-30f ? 127.0f / m : 1.0f, isc = m > 1e-30f ? m * (1.0f / 127.0f) : 1.0f;
            unsigned w[4];
#pragma unroll
            for (int q = 0; q < 4; ++q)
                w[q] = (((unsigned)((int)rintf(x[rr][q].x * sc) + OFFS)) & 0xffu) | ((((unsigned)((int)rintf(x[rr][q].y * sc) + OFFS)) & 0xffu) << 8)
                     | ((((unsigned)((int)rintf(x[rr][q].z * sc) + OFFS)) & 0xffu) << 16) | ((((unsigned)((int)rintf(x[rr][q].w * sc) + OFFS)) & 0xffu) << 24);
            if (row < NEXP) {
                *(u32x4*)(dst + (size_t)row * DM + lane * 16) = (u32x4){w[0], w[1], w[2], w[3]};
                if (lane == 0) inv[row] = isc;
            }
        }
    }
}
DI void prep_cab_item(const Params& p, int item, char* smem) {
    float* vT = (float*)smem;
    float* red = vT + DM * 16;
    const float* mod = (const float*)(p.ws + OFF_MOD);
    const int tid = my_tid(), ks = tid >> 5, col = tid & 31;
    const float* w = p.w_q + (size_t)(ks * 64) * 2048 + item * 32 + col;
#pragma unroll 1
    for (int which = 0; which < 2; ++which) {
        for (int i = tid; i < NB * DM; i += NTH) {
            const int b = i >> 10, k = i & 1023;
            const float sc = 1.0f + mod[b * 6144 + 4096 + k];
            const float v = which == 0 ? p.ln1w[k] * sc : p.ln1b[k] * sc + mod[b * 6144 + 3072 + k];
            vT[k * 16 + b] = v;
            if (item == 0) ((float*)(p.ws + OFF_AB))[(size_t)which * NB * DM + i] = v;
        }
        __syncthreads();
        float acc[16];
#pragma unroll
        for (int b = 0; b < 16; ++b) acc[b] = 0.f;
#pragma unroll 1
        for (int seg = 0; seg < 4; ++seg) {
            float wreg[16];
#pragma unroll
            for (int k = 0; k < 16; ++k) wreg[k] = w[(size_t)(seg * 16 + k) * 2048];
#pragma unroll
            for (int k = 0; k < 16; ++k) {
                const float wv = wreg[k];
                const f32x4* cb = (const f32x4*)(vT + (ks * 64 + seg * 16 + k) * 16);
                const f32x4 c0 = cb[0], c1 = cb[1], c2 = cb[2], c3 = cb[3];
                acc[0] += c0.x * wv; acc[1] += c0.y * wv; acc[2] += c0.z * wv; acc[3] += c0.w * wv;
                acc[4] += c1.x * wv; acc[5] += c1.y * wv; acc[6] += c1.z * wv; acc[7] += c1.w * wv;
                acc[8] += c2.x * wv; acc[9] += c2.y * wv; acc[10] += c2.z * wv; acc[11] += c2.w * wv;
                acc[12] += c3.x * wv; acc[13] += c3.y * wv; acc[14] += c3.z * wv; acc[15] += c3.w * wv;
            }
        }
#pragma unroll
        for (int b = 0; b < 16; ++b) red[(ks * 32 + col) * 16 + b] = acc[b];
        __syncthreads();
        {
            const int b = tid >> 5;
            float sum = 0.f;
#pragma unroll
            for (int q = 0; q < 16; ++q) sum += red[(q * 32 + col) * 16 + b];
            ((float*)(p.ws + OFF_CAB))[(size_t)which * NB * 2048 + b * 2048 + item * 32 + col] = sum;
        }
        __syncthreads();
    }
}
DI void phase_h(const Params& p, int bid, int nb) {
    const float* mod = (const float*)(p.ws + OFF_MOD);
    bf16_t* H = (bf16_t*)(p.ws + OFF_H);
    const size_t n8 = (size_t)NTOK * DM / 8;
#pragma unroll 4
    for (size_t i = (size_t)bid * NTH + my_tid(); i < n8; i += (size_t)nb * NTH) {
        const int row = (int)(i >> 7), c0 = (int)(i & 127) * 8, b = row / SEQ;
        const float* sh = mod + b * 6144 + c0;
        const float* sc = sh + 1024;
        const float4 a = *(const float4*)(p.x + i * 8), bq = *(const float4*)(p.x + i * 8 + 4);
        const float4 s0 = *(const float4*)sc, s1 = *(const float4*)(sc + 4), h0 = *(const float4*)sh, h1 = *(const float4*)(sh + 4);
        uint4 o;
        o.x = pack2(a.x * (1.f + s0.x) + h0.x, a.y * (1.f + s0.y) + h0.y);
        o.y = pack2(a.z * (1.f + s0.z) + h0.z, a.w * (1.f + s0.w) + h0.w);
        o.z = pack2(bq.x * (1.f + s1.x) + h1.x, bq.y * (1.f + s1.y) + h1.y);
        o.w = pack2(bq.z * (1.f + s1.z) + h1.z, bq.w * (1.f + s1.w) + h1.w);
        *(uint4*)(H + i * 8) = o;
    }
}

DI int wq_next(unsigned* ctr, char* smem) {
    volatile unsigned* slot = (volatile unsigned*)(smem + SMEM_BYTES - 8);
    __syncthreads();
    if (__builtin_amdgcn_workitem_id_x() == 0) *slot = __hip_atomic_fetch_add(ctr, 1u, __ATOMIC_RELAXED, __HIP_MEMORY_SCOPE_AGENT);
    __syncthreads();
    return (int)*slot;
}
DI void phase_prep_a(const Params& p, char* smem, int rep = 0) {
    unsigned* ctr = (unsigned*)(p.ws + OFF_BAR) + 120 + 2 * rep;
    constexpr int U_S5 = 192, U_LB = 320, U_TR = 321, U_UT = U_TR + 368, U_VT = U_UT + 128, U_MISC = U_VT + 128, U_END = U_MISC + 8;
    for (int u = wq_next(ctr, smem); u < U_END; u = wq_next(ctr, smem)) {
        if (u < U_S5) prep_mod_item(p, u, smem);
        else if (u < U_LB) prep_s5_gemm_item(p, (u - U_S5) >> 2, (u - U_S5) & 3, smem);
        else if (u < U_TR) {
            const int j = my_tid();
            const float a0 = p.hg_lb[j], a1 = p.hg_lb[512 + j], m = fmaxf(a0, a1);
            const float e0 = expf(a0 - m), e1 = expf(a1 - m);
            ((float*)(p.ws + OFF_LB))[j] = e0 / (e0 + e1);
        } else if (u < U_UT) {
            for (int it = (u - U_TR) * 4; it < (u - U_TR) * 4 + 4; ++it) {
                constexpr int T_WIN = 16 * 40, T_GLU = 8 * 8, T_WOUT = 16 * 16;
                constexpr int I_GLU = T_WIN, I_WOUT = I_GLU + T_GLU, I_WQ = I_WOUT + T_WOUT;
                if (it < I_GLU) { const int t = it; prep_transpose_tile(p.w_in, (bf16_t*)(p.ws + OFF_WIN), DM, INC, t / 40, t % 40, smem); }
                else if (it < I_WOUT) { const int t = it - I_GLU; prep_transpose_tile(p.glu_w, (bf16_t*)(p.ws + OFF_GLU), 512, 512, t / 8, t % 8, smem); }
                else if (it < I_WQ) { const int t = it - I_WOUT; prep_transpose_tile(p.w_out, (bf16_t*)(p.ws + OFF_WOUT), DM, DM, t / 16, t % 16, smem); }
                else { const int t = it - I_WQ; prep_transpose_tile(p.w_q, (bf16_t*)(p.ws + OFF_WQ), DM, 2048, t / 32, t % 32, smem); }
            }
        } else if (u < U_VT) cvt_i8_rows<0>(p.pu, (unsigned char*)(p.ws + OFF_UT), (float*)(p.ws + OFF_SU), u - U_UT, 128);
        else if (u < U_MISC) cvt_i8_rows<128>(p.pv, (unsigned char*)(p.ws + OFF_VT), (float*)(p.ws + OFF_SV), u - U_VT, 128);
        else {
            const int q = u - U_MISC;
            cvt_bf16_stream(p.subk, (bf16_t*)(p.ws + OFF_SUBK), (size_t)16 * 128 * 128 / 8, q, 8);
            for (size_t i = (size_t)q * NTH + my_tid(); i < (size_t)NTOK * 2 / 4; i += (size_t)8 * NTH) ((f32x4*)(p.ws + OFF_STAT))[i] = (f32x4){0.f, 0.f, 0.f, 0.f};
        }
    }
}
DI void phase_prep_b(const Params& p, char* smem, int rep = 0) {
    unsigned* ctr = (unsigned*)(p.ws + OFF_BAR) + 121 + 2 * rep;
    for (int u = wq_next(ctr, smem); u < 64 + 256; u = wq_next(ctr, smem)) {
        if (u < 64) prep_cab_item(p, u, smem); else phase_h(p, u - 64, 256);
    }
}

DI void phase_proj(const Params& p, int bid, int nb, char* smem) {
    pg8::Gemm g{(const bf16_t*)(p.ws + OFF_H), (const bf16_t*)(p.ws + OFF_WIN), NTOK, INC, DM};
    pg8::StaticOrder S; S.init(NTOK, INC, nb, bid);
    pg8::EpiBf16Act E{(bf16_t*)(p.ws + OFF_PROJ), INC, 0xC3u};
    pg8::gemm_phase<pg8::EpiBf16Act, pg8::StaticOrder, false>((PG8_LAS unsigned char*)smem, g, S, E, nullptr);
}

DI void hgrn_item(const Params& p, int item, char* smem) {
    const int vs = item & 7, hd = (item >> 3) & 3, b = item >> 5;
    const bf16_t* P = (const bf16_t*)(p.ws + OFF_PROJ);
    const float* lb = (const float*)(p.ws + OFF_LB) + hd * HDK;
    float* ORAW = (float*)(p.ws + OFF_ORAW);
    float* sq = (float*)smem;
    float* sf = sq + 32 * 128;
    float* sv = sf + 32 * 128;
    float* sp = sv + 32 * 16;
    const int tid = my_tid(), lane = tid & 63, wid = tid >> 6, kq = tid >> 4, v = tid & 15;
    float S0 = 0.f, S1 = 0.f, S2 = 0.f, S3 = 0.f;
    for (int t0 = 0; t0 < SEQ; t0 += 32) {
        for (int i = tid; i < 32 * 128; i += NTH) {
            const int t = i >> 7, k = i & 127;
            const bf16_t* row = P + (size_t)(b * SEQ + t0 + t) * INC + hd * HDK + k;
            sq[i] = bf2f(row[0]);
            const float l = lb[k];
            sf[i] = l + (1.0f - l) * sigmoidf_(bf2f(row[512]));
        }
        { const int t = tid >> 4; sv[tid] = bf2f(P[(size_t)(b * SEQ + t0 + t) * INC + 1024 + hd * HDK + vs * 16 + v]); }
        __syncthreads();
        for (int t = 0; t < 32; ++t) {
            const float4 f4 = *(const float4*)(sf + t * 128 + kq * 4), q4 = *(const float4*)(sq + t * 128 + kq * 4);
            const float vv = sv[t * 16 + v];
            S0 = f4.x * S0 + (1.0f - f4.x) * vv; S1 = f4.y * S1 + (1.0f - f4.y) * vv;
            S2 = f4.z * S2 + (1.0f - f4.z) * vv; S3 = f4.w * S3 + (1.0f - f4.w) * vv;
            float part = q4.x * S0 + q4.y * S1 + q4.z * S2 + q4.w * S3;
            part += __shfl_xor(part, 16); part += __shfl_xor(part, 32);
            if (lane < 16) sp[(t * 8 + wid) * 16 + v] = part;
        }
        __syncthreads();
        {
            const int t = tid >> 4;
            float o = 0.f;
#pragma unroll
            for (int w = 0; w < 8; ++w) o += sp[(t * 8 + w) * 16 + v];
            ORAW[(size_t)(b * SEQ + t0 + t) * DHG + hd * HDK + vs * 16 + v] = o;
        }
        __syncthreads();
    }
}
DI void s5_item(const Params& p, int item, char* smem) {
    const int oct = item & 3, b = item >> 2;
    const int tid = my_tid(), lane = tid & 63, wid = tid >> 6, g = oct * 8 + wid;
    const bf16_t* P = (const bf16_t*)(p.ws + OFF_PROJ);
    bf16_t* Y = (bf16_t*)(p.ws + OFF_YSSM);
    float* su = (float*)smem + wid * 64 * 16;
    const float* lam = (const float*)(p.ws + OFF_LAM) + (g * SSP + lane) * 2;
    const float lr = lam[0], li = lam[1];
    const float* bb = (const float*)(p.ws + OFF_BB) + (size_t)(g * SSP + lane) * 32;
    float bbr[16], bbi[16], cr[16], ci[16];
#pragma unroll
    for (int i = 0; i < 16; ++i) { bbr[i] = bb[2 * i]; bbi[i] = bb[2 * i + 1]; cr[i] = p.c_re[(g * SSC + i) * SSP + lane]; ci[i] = p.c_im[(g * SSC + i) * SSP + lane]; }
    const int ch = (lane >> 2) & 15;
    const float dch = p.dsk[g * SSC + ch];
    float xr = 0.f, xi = 0.f;
    for (int t0 = 0; t0 < SEQ; t0 += 64) {
        {
            const uint4* src = (const uint4*)(P + (size_t)(b * SEQ + t0 + lane) * INC + 2048 + g * SSC);
            const uint4 a = src[0], c = src[1];
            float* d = su + lane * 16;
            d[0] = bflo(a.x); d[1] = bfhi(a.x); d[2] = bflo(a.y); d[3] = bfhi(a.y); d[4] = bflo(a.z); d[5] = bfhi(a.z); d[6] = bflo(a.w); d[7] = bfhi(a.w);
            d[8] = bflo(c.x); d[9] = bfhi(c.x); d[10] = bflo(c.y); d[11] = bfhi(c.y); d[12] = bflo(c.z); d[13] = bfhi(c.z); d[14] = bflo(c.w); d[15] = bfhi(c.w);
        }
        __syncthreads();
        for (int t = 0; t < 64; ++t) {
            float u[16];
            const float4* us = (const float4*)(su + t * 16);
            const float4 u0 = us[0], u1 = us[1], u2 = us[2], u3 = us[3];
            u[0] = u0.x; u[1] = u0.y; u[2] = u0.z; u[3] = u0.w; u[4] = u1.x; u[5] = u1.y; u[6] = u1.z; u[7] = u1.w;
            u[8] = u2.x; u[9] = u2.y; u[10] = u2.z; u[11] = u2.w; u[12] = u3.x; u[13] = u3.y; u[14] = u3.z; u[15] = u3.w;
            float bur = 0.f, bui = 0.f;
#pragma unroll
            for (int i = 0; i < 16; ++i) { bur += bbr[i] * u[i]; bui += bbi[i] * u[i]; }
            const float nxr = lr * xr - li * xi + bur, nxi = lr * xi + li * xr + bui;
            xr = nxr; xi = nxi;
            float y[16];
#pragma unroll
            for (int i = 0; i < 16; ++i) y[i] = cr[i] * xr - ci[i] * xi;
            const bool b5 = lane & 32, b4 = lane & 16, b3 = lane & 8, b2 = lane & 4;
            float y8[8], y4[4], y2[2];
#pragma unroll
            for (int j = 0; j < 8; ++j) { const float keep = b5 ? y[8 + j] : y[j], send = b5 ? y[j] : y[8 + j]; y8[j] = keep + __shfl_xor(send, 32); }
#pragma unroll
            for (int j = 0; j < 4; ++j) { const float keep = b4 ? y8[4 + j] : y8[j], send = b4 ? y8[j] : y8[4 + j]; y4[j] = keep + __shfl_xor(send, 16); }
#pragma unroll
            for (int j = 0; j < 2; ++j) { const float keep = b3 ? y4[2 + j] : y4[j], send = b3 ? y4[j] : y4[2 + j]; y2[j] = keep + __shfl_xor(send, 8); }
            float y1;
            { const float keep = b2 ? y2[1] : y2[0], send = b2 ? y2[0] : y2[1]; y1 = keep + __shfl_xor(send, 4); }
            y1 += __shfl_xor(y1, 1); y1 += __shfl_xor(y1, 2);
            if ((lane & 3) == 0) {
                const float uu = su[t * 16 + ch];
                Y[(size_t)(b * SEQ + t0 + t) * DSS + g * SSC + ch] = f2bf(geluf_(y1 + dch * uu));
            }
        }
        __syncthreads();
    }
}
DI int crow(int i, int h) { return (i & 3) + 8 * (i >> 2) + 4 * h; }
DI void phase_hgprep(const Params& p, int bid, int nb) {
    const bf16_t* P = (const bf16_t*)(p.ws + OFF_PROJ);
    const float* lbp = (const float*)(p.ws + OFF_LB);
    const int tid = my_tid(), lane = tid & 63, wid = tid >> 6, tq = lane >> 4, cg = lane & 15;
#pragma unroll 1
    for (int it = bid * 8 + wid; it < 8192; it += nb * 8) {
        const int tile = it >> 1, c = tile & 63, hd = (tile >> 6) & 3, b = tile >> 8, k0 = (it & 1) * 64 + cg * 4;
        const bf16_t* base = P + (size_t)(b * SEQ + c * 32 + tq * 8) * INC + hd * HDK + k0;
        uint2 qw[8], fw[8];
#pragma unroll
        for (int tt = 0; tt < 8; ++tt) { qw[tt] = *(const uint2*)(base + (size_t)tt * INC); fw[tt] = *(const uint2*)(base + (size_t)tt * INC + 512); }
        const f32x4 l4 = *(const f32x4*)(lbp + hd * HDK + k0);
        const float lb4[4] = {l4.x, l4.y, l4.z, l4.w};
        float bl[8][4], kk[8][4], run[4];
#pragma unroll
        for (int e = 0; e < 4; ++e) run[e] = 0.f;
#pragma unroll
        for (int tt = 0; tt < 8; ++tt) {
            const float fl[4] = {bflo(fw[tt].x), bfhi(fw[tt].x), bflo(fw[tt].y), bfhi(fw[tt].y)};
#pragma unroll
            for (int e = 0; e < 4; ++e) {
                const float f = lb4[e] + (1.0f - lb4[e]) * sigmoidf_(fl[e]);
                run[e] += __logf(f); bl[tt][e] = run[e]; kk[tt][e] = 1.0f - f;
            }
        }
        float off[4], tot[4];
#pragma unroll
        for (int e = 0; e < 4; ++e) {
            const float t0 = __shfl(run[e], cg), t1 = __shfl(run[e], cg + 16), t2 = __shfl(run[e], cg + 32), t3 = __shfl(run[e], cg + 48);
            off[e] = (tq > 0 ? t0 : 0.f) + (tq > 1 ? t1 : 0.f) + (tq > 2 ? t2 : 0.f);
            tot[e] = (t0 + t1) + (t2 + t3);
        }
        bf16_t* HQ = (bf16_t*)(p.ws + OFF_HQ) + (size_t)tile * 4096 + (tq * 8) * 128 + k0;
        bf16_t* HK = (bf16_t*)(p.ws + OFF_HK) + (size_t)tile * 4096 + (tq * 8) * 128 + k0;
#pragma unroll
        for (int tt = 0; tt < 8; ++tt) {
            const float qv[4] = {bflo(qw[tt].x), bfhi(qw[tt].x), bflo(qw[tt].y), bfhi(qw[tt].y)};
            float qo[4], ko[4];
#pragma unroll
            for (int e = 0; e < 4; ++e) { const float bb = off[e] + bl[tt][e]; qo[e] = qv[e] * __expf(bb); ko[e] = kk[tt][e] * __expf(fminf(-bb, 80.0f)); }
            *(uint2*)(HQ + tt * 128) = make_uint2(pack2(qo[0], qo[1]), pack2(qo[2], qo[3]));
            *(uint2*)(HK + tt * 128) = make_uint2(pack2(ko[0], ko[1]), pack2(ko[2], ko[3]));
        }
        if (tq == 0) *(f32x4*)((float*)(p.ws + OFF_HG) + (size_t)tile * 128 + k0) = (f32x4){__expf(tot[0]), __expf(tot[1]), __expf(tot[2]), __expf(tot[3])};
    }
}
typedef short s16x4 __attribute__((ext_vector_type(4)));
DI bf16x8 cat8(const s16x4 lo, const s16x4 hi) { return (bf16x8){lo.x, lo.y, lo.z, lo.w, hi.x, hi.y, hi.z, hi.w}; }
DI s16x4 lds_tr(const char* a) { return __builtin_amdgcn_ds_read_tr16_b64_v4i16((__attribute__((address_space(3))) s16x4*)a); }
DI void hgrn_mfma_item(const Params& p, int item, char* smem) {
    constexpr int QP_OFF = 0, KP_OFF = 8704, V_OFF = 17408, G_OFF = 26112, BUF = 26624, OB_OFF = 3 * BUF, OB_STRIDE = 132, OB_BYTES = 32 * OB_STRIDE * 4;
    const int tid = my_tid(), lane = tid & 63, wid = tid >> 6, r = lane & 31, h = lane >> 5;
    const int b = item >> 2, hd = item & 3;
    const size_t tile0 = (size_t)item * 64;
    const bf16_t* HQ = (const bf16_t*)(p.ws + OFF_HQ) + tile0 * 4096;
    const bf16_t* HK = (const bf16_t*)(p.ws + OFF_HK) + tile0 * 4096;
    const bf16_t* PV = (const bf16_t*)(p.ws + OFF_PROJ) + (size_t)b * SEQ * INC + 1024 + hd * HDK;
    const float* HG = (const float*)(p.ws + OFF_HG) + tile0 * 128;
    bf16_t* A2out = (bf16_t*)(p.ws + OFF_A2) + (size_t)b * SEQ * DM + hd * HDK;
    const bf16_t* PG = (const bf16_t*)(p.ws + OFF_PROJ) + (size_t)b * SEQ * INC + 1536 + hd * HDK;
    const bool helper = wid >= 4;
    const int ht = tid - 256;
    const int i0 = ht, i1 = ht + 256;
    const int lo0 = (i0 >> 4) * 272 + (i0 & 15) * 16, lo1 = (i1 >> 4) * 272 + (i1 & 15) * 16;
    u32x4 A0, A1, A2, A3, A4, A5, A6, B0, B1, B2, B3, B4, B5, B6;
    A0 = A1 = A2 = A3 = A4 = A5 = A6 = B0 = B1 = B2 = B3 = B4 = B5 = B6 = (u32x4){0, 0, 0, 0};
    f32x16 S[4];
#pragma unroll
    for (int kb = 0; kb < 4; ++kb)
#pragma unroll
        for (int i = 0; i < 16; ++i) S[kb][i] = 0.f;
#define HG_LOAD(X, c_) { const size_t o_ = (size_t)(c_) * 4096; \
        X##0 = *(const u32x4*)(HQ + o_ + i0 * 8); X##1 = *(const u32x4*)(HQ + o_ + i1 * 8); \
        X##2 = *(const u32x4*)(HK + o_ + i0 * 8); X##3 = *(const u32x4*)(HK + o_ + i1 * 8); \
        X##4 = *(const u32x4*)(PV + (size_t)((c_) * 32 + (i0 >> 4)) * INC + (i0 & 15) * 8); X##5 = *(const u32x4*)(PV + (size_t)((c_) * 32 + (i1 >> 4)) * INC + (i1 & 15) * 8); \
        if (ht < 32) X##6 = *(const u32x4*)(HG + (size_t)(c_) * 128 + ht * 4); }
#define HG_STORE(X, buf_) { char* B_ = smem + (buf_) * BUF; \
        *(u32x4*)(B_ + QP_OFF + lo0) = X##0; *(u32x4*)(B_ + QP_OFF + lo1) = X##1; \
        *(u32x4*)(B_ + KP_OFF + lo0) = X##2; *(u32x4*)(B_ + KP_OFF + lo1) = X##3; \
        *(u32x4*)(B_ + V_OFF + lo0) = X##4; *(u32x4*)(B_ + V_OFF + lo1) = X##5; \
        if (ht < 32) *(u32x4*)(B_ + G_OFF + ht * 16) = X##6; }
    const int tq = (lane >> 2) & 3, tp = lane & 3, tg = lane >> 4;
    const int tr_nat = (8 * (tg >> 1) + tq) * 272 + (16 * (tg & 1) + 4 * tp) * 2;
    const int tr_krw = (4 * (tg >> 1) + tq) * 272 + (16 * (tg & 1) + 4 * tp) * 2;
    if (helper) { HG_LOAD(A, 0); HG_STORE(A, 0); HG_LOAD(A, 1); HG_STORE(A, 1); HG_LOAD(A, 2); HG_LOAD(B, 3); }
    __syncthreads();
#define HG_COMPUTE(c_) { \
        const char* B = smem + ((c_) % 3) * BUF; const int w = wid; \
        f32x16 pt; _Pragma("unroll") for (int i = 0; i < 16; ++i) pt[i] = 0.f; \
        _Pragma("unroll") for (int ks = 0; ks < 8; ++ks) { \
            const bf16x8 a = *(const bf16x8*)(B + KP_OFF + r * 272 + ks * 32 + h * 16); \
            const bf16x8 bq = *(const bf16x8*)(B + QP_OFF + r * 272 + ks * 32 + h * 16); \
            pt = __builtin_amdgcn_mfma_f32_32x32x16_bf16(a, bq, pt, 0, 0, 0); } \
        _Pragma("unroll") for (int i = 0; i < 16; ++i) if (crow(i, h) > r) pt[i] = 0.f; \
        f32x16 o; _Pragma("unroll") for (int i = 0; i < 16; ++i) o[i] = 0.f; \
        _Pragma("unroll") for (int sp = 0; sp < 2; ++sp) { \
            const char* vb = B + V_OFF + (16 * sp) * 272 + (32 * w) * 2 + tr_krw; \
            const bf16x8 bv = cat8(lds_tr(vb), lds_tr(vb + 8 * 272)); \
            o = __builtin_amdgcn_mfma_f32_32x32x16_bf16(pack8(pt, 8 * sp), bv, o, 0, 0, 0); } \
        _Pragma("unroll") for (int kb = 0; kb < 4; ++kb) _Pragma("unroll") for (int sp = 0; sp < 2; ++sp) { \
            const char* qb = B + QP_OFF + r * 272 + kb * 64 + sp * 32 + h * 8; \
            const bf16x8 aq = cat8(*(const s16x4*)qb, *(const s16x4*)(qb + 16)); \
            o = __builtin_amdgcn_mfma_f32_32x32x16_bf16(aq, pack8(S[kb], 8 * sp), o, 0, 0, 0); } \
        { float* ob_ = (float*)(smem + OB_OFF + ((c_) & 1) * OB_BYTES); _Pragma("unroll") for (int i = 0; i < 16; ++i) ob_[crow(i, h) * OB_STRIDE + 32 * w + r] = o[i]; } \
        bf16x8 bvn[2]; \
        _Pragma("unroll") for (int ks = 0; ks < 2; ++ks) { const char* vb = B + V_OFF + (16 * ks) * 272 + (32 * w) * 2 + tr_nat; bvn[ks] = cat8(lds_tr(vb), lds_tr(vb + 4 * 272)); } \
        _Pragma("unroll") for (int kb = 0; kb < 4; ++kb) { \
            _Pragma("unroll") for (int ks = 0; ks < 2; ++ks) { \
                const char* kp = B + KP_OFF + (16 * ks) * 272 + (32 * kb) * 2 + tr_nat; \
                const bf16x8 a = cat8(lds_tr(kp), lds_tr(kp + 4 * 272)); \
                S[kb] = __builtin_amdgcn_mfma_f32_32x32x16_bf16(a, bvn[ks], S[kb], 0, 0, 0); } \
            _Pragma("unroll") for (int j = 0; j < 4; ++j) { \
                const f32x4 g4 = *(const f32x4*)(B + G_OFF + (kb * 32 + 8 * j + 4 * h) * 4); \
                S[kb][4 * j] *= g4.x; S[kb][4 * j + 1] *= g4.y; S[kb][4 * j + 2] *= g4.z; S[kb][4 * j + 3] *= g4.w; } } }
    f32x4 nw0, nw1, nw2, nw3;
    nw0 = nw1 = nw2 = nw3 = (f32x4){0.f, 0.f, 0.f, 0.f};
    if (helper) { const float* nwp = p.hg_nw + hd * HDK + (ht & 7) * 16; nw0 = *(const f32x4*)nwp; nw1 = *(const f32x4*)(nwp + 4); nw2 = *(const f32x4*)(nwp + 8); nw3 = *(const f32x4*)(nwp + 12); }
#define HG_NORM(cc_) { const int t_ = ht >> 3, sg_ = ht & 7; \
        const float* ob_ = (const float*)(smem + OB_OFF + ((cc_) & 1) * OB_BYTES) + t_ * OB_STRIDE + sg_ * 16; \
        const f32x4 o0 = *(const f32x4*)ob_, o1 = *(const f32x4*)(ob_ + 4), o2 = *(const f32x4*)(ob_ + 8), o3 = *(const f32x4*)(ob_ + 12); \
        const u32x4 g0 = *(const u32x4*)(PG + (size_t)((cc_) * 32 + t_) * INC + sg_ * 16), g1 = *(const u32x4*)(PG + (size_t)((cc_) * 32 + t_) * INC + sg_ * 16 + 8); \
        float ss = (o0.x * o0.x + o0.y * o0.y + o0.z * o0.z + o0.w * o0.w) + (o1.x * o1.x + o1.y * o1.y + o1.z * o1.z + o1.w * o1.w) + (o2.x * o2.x + o2.y * o2.y + o2.z * o2.z + o2.w * o2.w) + (o3.x * o3.x + o3.y * o3.y + o3.z * o3.z + o3.w * o3.w); \
        ss += __shfl_xor(ss, 1); ss += __shfl_xor(ss, 2); ss += __shfl_xor(ss, 4); \
        const float rs_ = rsqrtf(ss * (1.0f / 128.0f) + RMS_EPS); \
        const f32x4 v0 = o0 * rs_ * nw0, v1 = o1 * rs_ * nw1, v2 = o2 * rs_ * nw2, v3 = o3 * rs_ * nw3; \
        u32x4 w0, w1; \
        w0.x = pack2(v0.x * bflo(g0.x), v0.y * bfhi(g0.x)); w0.y = pack2(v0.z * bflo(g0.y), v0.w * bfhi(g0.y)); w0.z = pack2(v1.x * bflo(g0.z), v1.y * bfhi(g0.z)); w0.w = pack2(v1.z * bflo(g0.w), v1.w * bfhi(g0.w)); \
        w1.x = pack2(v2.x * bflo(g1.x), v2.y * bfhi(g1.x)); w1.y = pack2(v2.z * bflo(g1.y), v2.w * bfhi(g1.y)); w1.z = pack2(v3.x * bflo(g1.z), v3.y * bfhi(g1.z)); w1.w = pack2(v3.z * bflo(g1.w), v3.w * bfhi(g1.w)); \
        bf16_t* dst_ = A2out + (size_t)((cc_) * 32 + t_) * DM + sg_ * 16; \
        *(u32x4*)dst_ = w0; *(u32x4*)(dst_ + 8) = w1; }
    for (int c = 0; c < 64; c += 2) {
        if (helper) { if (c + 2 < 64) HG_STORE(A, (c + 2) % 3); if (c + 4 < 64) HG_LOAD(A, c + 4); if (c > 0) HG_NORM(c - 1); } else HG_COMPUTE(c);
        __syncthreads();
        if (helper) { if (c + 3 < 64) HG_STORE(B, (c + 3) % 3); if (c + 5 < 64) HG_LOAD(B, c + 5); HG_NORM(c); } else HG_COMPUTE(c + 1);
        __syncthreads();
    }
    if (helper) HG_NORM(63);
    __syncthreads();
#undef HG_LOAD
#undef HG_STORE
#undef HG_COMPUTE
#undef HG_NORM
}
template <int NJ>
DI void s5_gemm2_tile(const bf16x8 (&af)[16], const bf16_t* KTl, const bf16_t* Xin, const bf16_t* MBg, bf16_t* Yout, bf16_t* stg, const int mi, const int r, const int h) {
    f32x16 y;
#pragma unroll
    for (int i = 0; i < 16; ++i) y[i] = 0.f;
    const int tsel = r >> 4, iq = r & 15;
    bf16x8 bm[8];
#pragma unroll
    for (int ks = 0; ks < 8; ++ks) bm[ks] = *(const bf16x8*)(MBg + (size_t)((NJ * 8 + ks) * 64 + h * 32 + r) * 8);
#pragma unroll
    for (int ks = 0; ks <= 2 * NJ; ++ks) {
        const bf16x8 bk = *(const bf16x8*)(KTl + ((2 * NJ + tsel - ks) * 16 + iq) * 16 + 8 * h);
        y = __builtin_amdgcn_mfma_f32_32x32x16_bf16(af[ks], bk, y, 0, 0, 0);
    }
    {
        bf16x8 bk = *(const bf16x8*)(KTl + iq * 16 + 8 * h);
        if (tsel == 0) bk = (bf16x8){0, 0, 0, 0, 0, 0, 0, 0};
        y = __builtin_amdgcn_mfma_f32_32x32x16_bf16(af[2 * NJ + 1], bk, y, 0, 0, 0);
    }
#pragma unroll
    for (int ks = 0; ks < 8; ++ks) {
        const bf16x8 a = *(const bf16x8*)(Xin + (mi * 32 + r) * 136 + ks * 16 + 8 * h);
        y = __builtin_amdgcn_mfma_f32_32x32x16_bf16(a, bm[ks], y, 0, 0, 0);
    }
#pragma unroll
    for (int i = 0; i < 16; ++i) stg[((crow(i, h) * 2 + tsel) * 16) + iq] = f2bf(gelu_as(y[i]));
    {
        const int lane = h * 32 + r, cl = lane >> 1, ts = lane & 1;
        const u32x4 lo = *(const u32x4*)(stg + lane * 16), hi = *(const u32x4*)(stg + lane * 16 + 8);
        bf16_t* dst = Yout + (size_t)((mi * 32 + cl) * 16 + 2 * NJ + ts) * DSS;
        *(u32x4*)dst = lo; *(u32x4*)(dst + 8) = hi;
    }
}
DI void s5_gemm_item(const Params& p, int b, int g, char* smem) {
    float* E = (float*)smem;
    bf16_t* Xin = (bf16_t*)(smem + 128 * 132 * 4);
    bf16_t* KTl = Xin + 128 * 136;
    const int tid = my_tid(), lane = tid & 63, wid = tid >> 6, r = lane & 31, h = lane >> 5;
    const int mi = wid >> 1, wh = wid & 1;
    const bf16_t* P = (const bf16_t*)(p.ws + OFF_PROJ);
    *(u32x4*)(KTl + tid * 8) = *(const u32x4*)((const bf16_t*)(p.ws + OFF_S5K) + (size_t)g * 4096 + tid * 8);
    bf16x8 af[16];
    {
        const bf16_t* ub = P + (size_t)(b * SEQ + (mi * 32 + r) * 16) * INC + 2048 + g * 16 + 8 * h;
#pragma unroll
        for (int ks = 0; ks < 16; ++ks) af[ks] = *(const bf16x8*)(ub + (size_t)ks * INC);
    }
#ifndef S5_REP_G1
#define S5_REP_G1 1
#define S5_REP_SC 1
#define S5_REP_G2 1
#endif
    for (int rp1 = 0; rp1 < S5_REP_G1; ++rp1)
    {
        f32x16 e0, e1;
#pragma unroll
        for (int i = 0; i < 16; ++i) { e0[i] = 0.f; e1[i] = 0.f; }
        const bf16_t* nb0 = (const bf16_t*)(p.ws + OFF_S5N) + (size_t)g * 128 * 256 + (size_t)(wh * 2) * 16 * 512 + lane * 8;
#pragma unroll
        for (int ks = 0; ks < 16; ++ks) {
            const bf16x8 b0 = *(const bf16x8*)(nb0 + ks * 512), b1 = *(const bf16x8*)(nb0 + 16 * 512 + ks * 512);
            e0 = __builtin_amdgcn_mfma_f32_32x32x16_bf16(af[ks], b0, e0, 0, 0, 0);
            e1 = __builtin_amdgcn_mfma_f32_32x32x16_bf16(af[ks], b1, e1, 0, 0, 0);
        }
#pragma unroll
        for (int i = 0; i < 16; ++i) { float* er = E + (mi * 32 + crow(i, h)) * 132 + wh * 64 + r; er[0] = e0[i]; er[32] = e1[i]; }
    }
    __syncthreads();
    for (int rp2 = 0; rp2 < S5_REP_SC; ++rp2)
    if (wid == 0) {
        const float* L = (const float*)(p.ws + OFF_S5L) + (g * 64 + lane) * 2;
        const float lr = L[0], li = L[1];
        float xr = 0.f, xi = 0.f;
#pragma unroll 8
        for (int c = 0; c < 128; ++c) {
            const float er = E[c * 132 + lane], ei = E[c * 132 + 64 + lane];
            Xin[c * 136 + lane] = f2bf(xr); Xin[c * 136 + 64 + lane] = f2bf(xi);
            const float nr = lr * xr - li * xi + er, ni = lr * xi + li * xr + ei;
            xr = nr; xi = ni;
        }
    }
    __syncthreads();
    const bf16_t* MBg = (const bf16_t*)(p.ws + OFF_S5M) + (size_t)g * 256 * 128;
    bf16_t* Yout = (bf16_t*)(p.ws + OFF_YSSM) + (size_t)b * SEQ * DSS + g * 16;
    bf16_t* stg = (bf16_t*)smem + wid * 1024;
    for (int rp3 = 0; rp3 < S5_REP_G2; ++rp3)
    if (wh) {
        s5_gemm2_tile<1>(af, KTl, Xin, MBg, Yout, stg, mi, r, h); s5_gemm2_tile<6>(af, KTl, Xin, MBg, Yout, stg, mi, r, h);
        s5_gemm2_tile<3>(af, KTl, Xin, MBg, Yout, stg, mi, r, h); s5_gemm2_tile<4>(af, KTl, Xin, MBg, Yout, stg, mi, r, h);
    } else {
        s5_gemm2_tile<0>(af, KTl, Xin, MBg, Yout, stg, mi, r, h); s5_gemm2_tile<7>(af, KTl, Xin, MBg, Yout, stg, mi, r, h);
        s5_gemm2_tile<2>(af, KTl, Xin, MBg, Yout, stg, mi, r, h); s5_gemm2_tile<5>(af, KTl, Xin, MBg, Yout, stg, mi, r, h);
    }
    __syncthreads();
}
DI void phase_mix(const Params& p, int bid, int nb, char* smem) {
    if (nb == 256) {
#ifndef PROBE_HGX
#define PROBE_HGX 1
#endif
        if (bid < 64) { for (int rep = 0; rep < PROBE_HGX; ++rep) hgrn_mfma_item(p, bid, smem); return; }
        const int j = bid - 64, x = j & 7, lb = j >> 3;
#ifndef PROBE_S5X
#define PROBE_S5X 1
#endif
        for (int rep = 0; rep < PROBE_S5X; ++rep)
        for (int q = lb; q < 64; q += 24) s5_gemm_item(p, q & 15, x * 4 + (q >> 4), smem);
    } else {
        for (int it = bid; it < 64; it += nb) hgrn_mfma_item(p, it, smem);
        for (int q = bid; q < 512; q += nb) s5_gemm_item(p, q & 15, q >> 4, smem);
    }
}

DI void phase_glu(const Params& p, int bid, int nb, char* smem) {
    pg8::Gemm g{(const bf16_t*)(p.ws + OFF_YSSM), (const bf16_t*)(p.ws + OFF_GLU), NTOK, 512, 512};
    pg8::StaticOrder S; S.init(NTOK, 512, nb, bid);
    pg8::EpiGlu E{(float*)(p.ws + OFF_H), (const bf16_t*)(p.ws + OFF_YSSM), p.glu_b};
    pg8::gemm_phase<pg8::EpiGlu, pg8::StaticOrder, false>((PG8_LAS unsigned char*)smem, g, S, E, nullptr);
}
DI void phase_a2(const Params& p, int bid, int nb) {
    const float* Y2 = (const float*)(p.ws + OFF_H);
    const bf16_t* P = (const bf16_t*)(p.ws + OFF_PROJ);
    bf16_t* A2 = (bf16_t*)(p.ws + OFF_A2);
    const int lane = my_tid() & 63, wid = my_tid() >> 6;
    for (int tok = bid * 8 + wid; tok < NTOK; tok += nb * 8) {
        const int c0 = lane * 8;
        {
            const float4 a = *(const float4*)(Y2 + (size_t)tok * DSS + c0), b = *(const float4*)(Y2 + (size_t)tok * DSS + c0 + 4);
            float ss = a.x * a.x + a.y * a.y + a.z * a.z + a.w * a.w + b.x * b.x + b.y * b.y + b.z * b.z + b.w * b.w;
#pragma unroll
            for (int m = 1; m < 64; m <<= 1) ss += __shfl_xor(ss, m);
            const float rs = rsqrtf(ss * (1.0f / 512.0f) + RMS_EPS);
            const float4 w0 = *(const float4*)(p.ssm_nw + c0), w1 = *(const float4*)(p.ssm_nw + c0 + 4);
            uint4 o;
            o.x = pack2(a.x * rs * w0.x, a.y * rs * w0.y); o.y = pack2(a.z * rs * w0.z, a.w * rs * w0.w);
            o.z = pack2(b.x * rs * w1.x, b.y * rs * w1.y); o.w = pack2(b.z * rs * w1.z, b.w * rs * w1.w);
            *(uint4*)(A2 + (size_t)tok * DM + 512 + c0) = o;
        }
    }
}

DI void phase_outproj(const Params& p, int bid, int nb, char* smem) {
    pg8::Gemm g{(const bf16_t*)(p.ws + OFF_A2), (const bf16_t*)(p.ws + OFF_WOUT), NTOK, DM, DM};
    pg8::StaticOrder S; S.init(NTOK, DM, nb, bid);
    pg8::EpiResid E{p.out, p.x, (const float*)(p.ws + OFF_MOD) + 2048, DEEP_ALPHA, (bf16_t*)(p.ws + OFF_H), (const float*)(p.ws + OFF_AB), (float*)(p.ws + OFF_STAT)};
    pg8::gemm_phase<pg8::EpiResid, pg8::StaticOrder, false>((PG8_LAS unsigned char*)smem, g, S, E, nullptr);
}
DI void phase_ln1(const Params& p, int bid, int nb) {
    const float* mod = (const float*)(p.ws + OFF_MOD);
    bf16_t* H2 = (bf16_t*)(p.ws + OFF_H);
    const int lane = my_tid() & 63, wid = my_tid() >> 6;
    for (int tok = bid * 8 + wid; tok < NTOK; tok += nb * 8) {
        const int b = tok / SEQ;
        float* row = p.out + (size_t)tok * DM;
        float4 v[4];
        float s = 0.f;
#pragma unroll
        for (int j = 0; j < 4; ++j) { v[j] = *(const float4*)(row + j * 256 + lane * 4); s += v[j].x + v[j].y + v[j].z + v[j].w; }
#pragma unroll
        for (int m = 1; m < 64; m <<= 1) s += __shfl_xor(s, m);
        const float mu = s * (1.0f / 1024.0f);
        float q = 0.f;
#pragma unroll
        for (int j = 0; j < 4; ++j) { const float a = v[j].x - mu, bb = v[j].y - mu, cc = v[j].z - mu, d = v[j].w - mu; q += a * a + bb * bb + cc * cc + d * d; }
#pragma unroll
        for (int m = 1; m < 64; m <<= 1) q += __shfl_xor(q, m);
        const float rstd = rsqrtf(q * (1.0f / 1024.0f) + LN_EPS);
        const float* sh2 = mod + b * 6144 + 3072;
        const float* sc2 = mod + b * 6144 + 4096;
#pragma unroll
        for (int j = 0; j < 4; ++j) {
            const int c = j * 256 + lane * 4;
            const float4 w = *(const float4*)(p.ln1w + c), bi = *(const float4*)(p.ln1b + c), sc = *(const float4*)(sc2 + c), sh = *(const float4*)(sh2 + c);
            float4 o;
            o.x = (v[j].x - mu) * rstd * w.x + bi.x; o.y = (v[j].y - mu) * rstd * w.y + bi.y; o.z = (v[j].z - mu) * rstd * w.z + bi.z; o.w = (v[j].w - mu) * rstd * w.w + bi.w;
            *(float4*)(row + c) = o;
            uint2 hh; hh.x = pack2(o.x * (1.f + sc.x) + sh.x, o.y * (1.f + sc.y) + sh.y); hh.y = pack2(o.z * (1.f + sc.z) + sh.z, o.w * (1.f + sc.w) + sh.w);
            *(uint2*)(H2 + (size_t)tok * DM + c) = hh;
        }
    }
}

DI void phase_q(const Params& p, int bid, int nb, char* smem) {
    pg8::Gemm g{(const bf16_t*)(p.ws + OFF_H), (const bf16_t*)(p.ws + OFF_WQ), NTOK, 2048, DM};
    pg8::StaticOrder S; S.init(NTOK, 2048, nb, bid);
    pg8::EpiQLN E{(bf16_t*)(p.ws + OFF_PROJ), (const float*)(p.ws + OFF_STAT), (const float*)(p.ws + OFF_CAB), (const float*)(p.ws + OFF_CAB) + NB * 2048, LN_EPS};
    pg8::gemm_phase<pg8::EpiQLN, pg8::StaticOrder, false>((PG8_LAS unsigned char*)smem, g, S, E, nullptr);
}
DI void phase_topk(const Params& p, int bid, int nb, char* smem) {
    const bf16_t* Q = (const bf16_t*)(p.ws + OFF_PROJ);
    const bf16_t* SK = (const bf16_t*)(p.ws + OFF_SUBK);
    unsigned* TOPL = (unsigned*)(p.ws + OFF_TOPL);
    float* sc = (float*)(smem + 36864);
    constexpr int NTM = NTOK / 128;
    for (int t = bid; t < NTM * 16; t += nb) {
        const int mt = t >> 4, hp = t & 15;
        gemm_block<2, 1, 2, 4>(Q + (size_t)mt * 128 * 2048 + hp * 128, 2048, SK + (size_t)hp * 128 * 128, 128, 128, smem,
                               [&](int r, int c, float v) { sc[r * 129 + c] = v; });
        __syncthreads();
        if (my_tid() < 128) {
            const int r = my_tid();
            float tk[16];
#pragma unroll
            for (int j = 0; j < 16; ++j) tk[j] = -3.0e38f;
            for (int n = 0; n < 128; ++n) {
                float xv = __uint_as_float((__float_as_uint(sc[r * 129 + n]) & ~0x7fu) | (unsigned)n);
#pragma unroll
                for (int j = 0; j < 16; ++j) { const float hi = fmaxf(tk[j], xv), lo = fminf(tk[j], xv); tk[j] = hi; xv = lo; }
            }
            uint4* dst = (uint4*)(TOPL + ((size_t)(mt * 128 + r) * 16 + hp) * 16);
            dst[0] = make_uint4(__float_as_uint(tk[0]), __float_as_uint(tk[1]), __float_as_uint(tk[2]), __float_as_uint(tk[3]));
            dst[1] = make_uint4(__float_as_uint(tk[4]), __float_as_uint(tk[5]), __float_as_uint(tk[6]), __float_as_uint(tk[7]));
            dst[2] = make_uint4(__float_as_uint(tk[8]), __float_as_uint(tk[9]), __float_as_uint(tk[10]), __float_as_uint(tk[11]));
            dst[3] = make_uint4(__float_as_uint(tk[12]), __float_as_uint(tk[13]), __float_as_uint(tk[14]), __float_as_uint(tk[15]));
        }
        __syncthreads();
    }
}
DI void phase_combine(const Params& p, int bid, int nb) {
    const unsigned* TOPL = (const unsigned*)(p.ws + OFF_TOPL);
    uint2* EX = (uint2*)(p.ws + OFF_EXPS);
    const float* SU = (const float*)(p.ws + OFF_SU);
    const float* SV = (const float*)(p.ws + OFF_SV);
    for (int i = bid * NTH + my_tid(); i < NTOK * PHEADS; i += nb * NTH) {
        const unsigned* l1 = TOPL + (size_t)i * 32;
        const unsigned* l2 = l1 + 16;
        float s2[16];
        {
            const uint4 a = ((const uint4*)l2)[0], b = ((const uint4*)l2)[1], c = ((const uint4*)l2)[2], d = ((const uint4*)l2)[3];
            const unsigned w[16] = {a.x, a.y, a.z, a.w, b.x, b.y, b.z, b.w, c.x, c.y, c.z, c.w, d.x, d.y, d.z, d.w};
#pragma unroll
            for (int j = 0; j < 16; ++j) s2[j] = __uint_as_float(w[j] & ~0x7fu);
        }
        float tk[16];
#pragma unroll
        for (int j = 0; j < 16; ++j) tk[j] = -3.0e38f;
        for (int a = 0; a < 16; ++a) {
            const float s1 = __uint_as_float(l1[a] & ~0x7fu);
#pragma unroll
            for (int b = 0; b < 16; ++b) {
                float xv = __uint_as_float((__float_as_uint(s1 + s2[b]) & ~0xffu) | (unsigned)(a * 16 + b));
#pragma unroll
                for (int j = 0; j < 16; ++j) { const float hi = fmaxf(tk[j], xv), lo = fminf(tk[j], xv); tk[j] = hi; xv = lo; }
            }
        }
        float e[16], sum = 0.f;
        const float mx = __uint_as_float(__float_as_uint(tk[0]) & ~0xffu);
#pragma unroll
        for (int j = 0; j < 16; ++j) { e[j] = __expf(__uint_as_float(__float_as_uint(tk[j]) & ~0xffu) - mx); sum += e[j]; }
        const float inv = 1.0f / sum;
#pragma unroll
        for (int j = 0; j < 16; ++j) {
            const unsigned ab = __float_as_uint(tk[j]) & 0xffu;
            const unsigned i1 = l1[ab >> 4] & 0x7fu, i2 = l2[ab & 15] & 0x7fu;
            const unsigned eid = i1 * 128u + i2;
            EX[(size_t)i * 16 + j] = make_uint2(eid | (((__float_as_uint(SU[eid]) >> 23) & 0xffu) << 16), __float_as_uint(e[j] * inv * SV[eid]));
        }
    }
}

DI void ce_desc(float& a, float& b) { const float hi = fmaxf(a, b), lo = fminf(a, b); a = hi; b = lo; }
template <int N> DI void bitonic_sort_desc(float (&v)[N]) {
#pragma unroll
    for (int k = 2; k <= N; k <<= 1)
#pragma unroll
        for (int j = k >> 1; j > 0; j >>= 1)
#pragma unroll
            for (int i = 0; i < N; ++i) { const int l = i ^ j; if (l > i) { if ((i & k) == 0 || k == N) ce_desc(v[i], v[l]); else ce_desc(v[l], v[i]); } }
}
DI void merge_top16(float (&a)[16], const float (&b)[16]) {
#pragma unroll
    for (int i = 0; i < 16; ++i) a[i] = fmaxf(a[i], b[15 - i]);
#pragma unroll
    for (int j = 8; j > 0; j >>= 1)
#pragma unroll
        for (int i = 0; i < 16; ++i) { const int l = i ^ j; if (l > i) ce_desc(a[i], a[l]); }
}
DI void xlane_merge16(float (&a)[16]) {
    float o[16];
#pragma unroll
    for (int i = 0; i < 16; ++i) o[i] = __shfl_xor(a[i], 32);
    merge_top16(a, o);
}
DI void retrieve_topk_hp(const bf16_t* Q, const char* skl, const int tok, const int hp_next, const int r, const int h, unsigned char* lutp, float (&out)[16], bf16x8 (&bq)[8]) {
                f32x16 acc[4];
#pragma unroll
                for (int mi = 0; mi < 4; ++mi)
#pragma unroll
                    for (int i = 0; i < 16; ++i) acc[mi][i] = 0.f;
                const char* kb = skl + r * 272 + h * 16;
#pragma unroll
                for (int ks = 0; ks < 8; ++ks) {
#pragma unroll
                    for (int mi = 0; mi < 4; ++mi) {
                        const bf16x8 a = *(const bf16x8*)(kb + mi * 32 * 272 + ks * 32);
                        acc[mi] = __builtin_amdgcn_mfma_f32_32x32x16_bf16(a, bq[ks], acc[mi], 0, 0, 0);
                    }
                }
                {
                    const bf16_t* qb = Q + (size_t)tok * 2048 + hp_next * 128 + 8 * h;
#pragma unroll
                    for (int ks = 0; ks < 8; ++ks) bq[ks] = *(const bf16x8*)(qb + ks * 16);
                }
                float v0[16], v1[16], v2[16], v3[16];
#pragma unroll
                for (int i = 0; i < 16; ++i) {
                    const unsigned n = (unsigned)crow(i, h);
                    v0[i] = __uint_as_float((__float_as_uint(acc[0][i]) & ~0x7fu) | n);
                    v1[i] = __uint_as_float((__float_as_uint(acc[1][i]) & ~0x7fu) | (n + 32u));
                    v2[i] = __uint_as_float((__float_as_uint(acc[2][i]) & ~0x7fu) | (n + 64u));
                    v3[i] = __uint_as_float((__float_as_uint(acc[3][i]) & ~0x7fu) | (n + 96u));
                }
                bitonic_sort_desc<16>(v0); bitonic_sort_desc<16>(v1); bitonic_sort_desc<16>(v2); bitonic_sort_desc<16>(v3);
                merge_top16(v0, v1); merge_top16(v2, v3); merge_top16(v0, v2);
                xlane_merge16(v0);
#pragma unroll
                for (int i = 0; i < 16; ++i) out[i] = v0[i];
                u32x4 ix;
                ix.x = (__float_as_uint(v0[0]) & 0x7fu) | ((__float_as_uint(v0[1]) & 0x7fu) << 8) | ((__float_as_uint(v0[2]) & 0x7fu) << 16) | ((__float_as_uint(v0[3]) & 0x7fu) << 24);
                ix.y = (__float_as_uint(v0[4]) & 0x7fu) | ((__float_as_uint(v0[5]) & 0x7fu) << 8) | ((__float_as_uint(v0[6]) & 0x7fu) << 16) | ((__float_as_uint(v0[7]) & 0x7fu) << 24);
                ix.z = (__float_as_uint(v0[8]) & 0x7fu) | ((__float_as_uint(v0[9]) & 0x7fu) << 8) | ((__float_as_uint(v0[10]) & 0x7fu) << 16) | ((__float_as_uint(v0[11]) & 0x7fu) << 24);
                ix.w = (__float_as_uint(v0[12]) & 0x7fu) | ((__float_as_uint(v0[13]) & 0x7fu) << 8) | ((__float_as_uint(v0[14]) & 0x7fu) << 16) | ((__float_as_uint(v0[15]) & 0x7fu) << 24);
                *(u32x4*)lutp = ix;
}
DI void phase_retrieve(const Params& p, int bid, int nb, char* smem) {
    const bf16_t* Q = (const bf16_t*)(p.ws + OFF_PROJ);
    const bf16_t* SK = (const bf16_t*)(p.ws + OFF_SUBK);
    const float* SU = (const float*)(p.ws + OFF_SU);
    const float* SV = (const float*)(p.ws + OFF_SV);
    uint2* EX = (uint2*)(p.ws + OFF_EXPS);
    const int tid = my_tid(), lane = tid & 63, wid = tid >> 6, r = lane & 31, h = lane >> 5;
    unsigned char* lut = (unsigned char*)smem + wid * 2048 + lane * 32;
    char* skb0 = smem + 16384;
    char* skb1 = skb0 + 128 * 272;
    u32x4 sr0, sr1, sr2, sr3;
#define SK_LOAD(hp_) { const bf16_t* g_ = SK + (size_t)(hp_) * 16384 + tid * 8; sr0 = *(const u32x4*)g_; sr1 = *(const u32x4*)(g_ + 4096); sr2 = *(const u32x4*)(g_ + 8192); sr3 = *(const u32x4*)(g_ + 12288); }
#define SK_STORE(buf_) { char* d_ = (buf_) + (tid >> 4) * 272 + (tid & 15) * 16; *(u32x4*)d_ = sr0; *(u32x4*)(d_ + 32 * 272) = sr1; *(u32x4*)(d_ + 64 * 272) = sr2; *(u32x4*)(d_ + 96 * 272) = sr3; }
    for (int it = bid; it < (NTOK / 256) * 2; it += nb) {
        const int hq = it & 1, tok = (it >> 1) * 256 + wid * 32 + r;
        __syncthreads();
        SK_LOAD(hq * 8); SK_STORE(skb0);
        bf16x8 bq[8];
        {
            const bf16_t* qb = Q + (size_t)tok * 2048 + (hq * 8) * 128 + 8 * h;
#pragma unroll
            for (int ks = 0; ks < 8; ++ks) bq[ks] = *(const bf16x8*)(qb + ks * 16);
        }
        __syncthreads();
#pragma unroll 1
        for (int hd = hq * 4; hd < hq * 4 + 4; ++hd) {
            float L0[16], L1[16];
            SK_LOAD(hd * 2 + 1);
            retrieve_topk_hp(Q, skb0, tok, hd * 2 + 1, r, h, lut, L0, bq);
            SK_STORE(skb1);
            __syncthreads();
            if (hd + 1 < hq * 4 + 4) SK_LOAD(hd * 2 + 2);
            retrieve_topk_hp(Q, skb1, tok, (hd + 1 < hq * 4 + 4) ? hd * 2 + 2 : hd * 2 + 1, r, h, lut + 16, L1, bq);
            if (hd + 1 < hq * 4 + 4) SK_STORE(skb0);
            __syncthreads();
            float c[32];
            {
                constexpr int PA[50] = {0, 0, 0, 0, 0, 0, 0, 0, 0, 0, 0, 0, 0, 0, 0, 0, 1, 1, 1, 1, 1, 1, 1, 1, 2, 2, 2, 2, 2, 3, 3, 3, 3, 4, 4, 4, 5, 5, 6, 6, 7, 7, 8, 9, 10, 11, 12, 13, 14, 15};
                constexpr int PB[50] = {0, 1, 2, 3, 4, 5, 6, 7, 8, 9, 10, 11, 12, 13, 14, 15, 0, 1, 2, 3, 4, 5, 6, 7, 0, 1, 2, 3, 4, 0, 1, 2, 3, 0, 1, 2, 0, 1, 0, 1, 0, 1, 0, 0, 0, 0, 0, 0, 0, 0};
#pragma unroll
                for (int q = 0; q < 25; ++q) {
                    const float s0 = __uint_as_float(__float_as_uint(L0[PA[2 * q]]) & ~0x7fu) + __uint_as_float(__float_as_uint(L1[PB[2 * q]]) & ~0x7fu);
                    const float s1 = __uint_as_float(__float_as_uint(L0[PA[2 * q + 1]]) & ~0x7fu) + __uint_as_float(__float_as_uint(L1[PB[2 * q + 1]]) & ~0x7fu);
                    const float p0 = __uint_as_float((__float_as_uint(s0) & ~0xffu) | (unsigned)(PA[2 * q] * 16 + PB[2 * q]));
                    const float p1 = __uint_as_float((__float_as_uint(s1) & ~0xffu) | (unsigned)(PA[2 * q + 1] * 16 + PB[2 * q + 1]));
                    c[q] = h ? p1 : p0;
                }
#pragma unroll
                for (int i = 25; i < 32; ++i) c[i] = -3.0e38f;
            }
            bitonic_sort_desc<32>(c);
            float t16[16];
#pragma unroll
            for (int i = 0; i < 16; ++i) t16[i] = c[i];
            xlane_merge16(t16);
            const float mx = __uint_as_float(__float_as_uint(t16[0]) & ~0xffu);
            float e[16], sum = 0.f;
#pragma unroll
            for (int j = 0; j < 16; ++j) { e[j] = __expf(__uint_as_float(__float_as_uint(t16[j]) & ~0xffu) - mx); sum += e[j]; }
            const float inv = 1.0f / sum;
            uint2* dst = EX + ((size_t)tok * 8 + hd) * 16 + 8 * h;
#pragma unroll
            for (int j = 0; j < 8; ++j) {
                float tlo = t16[j], thi = t16[8 + j], elo = e[j], ehi = e[8 + j];
                asm volatile("" : "+v"(tlo), "+v"(thi), "+v"(elo), "+v"(ehi));
                const float tv = h ? thi : tlo, ev = h ? ehi : elo;
                const unsigned ab = __float_as_uint(tv) & 0xffu;
                const unsigned eid = (unsigned)lut[ab >> 4] * 128u + (unsigned)lut[16 + (ab & 15u)];
                dst[j] = make_uint2(eid | (pack2(0.f, SU[eid]) & 0xffff0000u), __float_as_uint(ev * inv * SV[eid]));
            }
        }
    }
#undef SK_LOAD
#undef SK_STORE
}

DI float dot16_fp8(const u32x4 w, const f32x2 (&h)[8]) {
    f32x2 acc = __builtin_amdgcn_cvt_pk_f32_fp8((int)w.x, false) * h[0];
    acc += __builtin_amdgcn_cvt_pk_f32_fp8((int)w.x, true) * h[1];
    acc += __builtin_amdgcn_cvt_pk_f32_fp8((int)w.y, false) * h[2];
    acc += __builtin_amdgcn_cvt_pk_f32_fp8((int)w.y, true) * h[3];
    acc += __builtin_amdgcn_cvt_pk_f32_fp8((int)w.z, false) * h[4];
    acc += __builtin_amdgcn_cvt_pk_f32_fp8((int)w.z, true) * h[5];
    acc += __builtin_amdgcn_cvt_pk_f32_fp8((int)w.w, false) * h[6];
    acc += __builtin_amdgcn_cvt_pk_f32_fp8((int)w.w, true) * h[7];
    return acc.x + acc.y;
}
DI void axpy16_fp8(const float a, const u32x4 w, f32x2 (&o)[8]) {
    const f32x2 aa = {a, a};
    o[0] += aa * __builtin_amdgcn_cvt_pk_f32_fp8((int)w.x, false); o[1] += aa * __builtin_amdgcn_cvt_pk_f32_fp8((int)w.x, true);
    o[2] += aa * __builtin_amdgcn_cvt_pk_f32_fp8((int)w.y, false); o[3] += aa * __builtin_amdgcn_cvt_pk_f32_fp8((int)w.y, true);
    o[4] += aa * __builtin_amdgcn_cvt_pk_f32_fp8((int)w.z, false); o[5] += aa * __builtin_amdgcn_cvt_pk_f32_fp8((int)w.z, true);
    o[6] += aa * __builtin_amdgcn_cvt_pk_f32_fp8((int)w.w, false); o[7] += aa * __builtin_amdgcn_cvt_pk_f32_fp8((int)w.w, true);
}
DI float butterfly64(float (&pz)[64], const int lane) {
    const bool b5 = lane & 32, b4 = lane & 16, b3 = lane & 8, b2 = lane & 4, b1 = lane & 2, b0 = lane & 1;
    float q32[32], q16[16], q8[8], q4[4], q2[2];
#pragma unroll
    for (int j = 0; j < 32; ++j) q32[j] = (b5 ? pz[32 + j] : pz[j]) + __shfl_xor(b5 ? pz[j] : pz[32 + j], 32);
#pragma unroll
    for (int j = 0; j < 16; ++j) q16[j] = (b4 ? q32[16 + j] : q32[j]) + __shfl_xor(b4 ? q32[j] : q32[16 + j], 16);
#pragma unroll
    for (int j = 0; j < 8; ++j) q8[j] = (b3 ? q16[8 + j] : q16[j]) + __shfl_xor(b3 ? q16[j] : q16[8 + j], 8);
#pragma unroll
    for (int j = 0; j < 4; ++j) q4[j] = (b2 ? q8[4 + j] : q8[j]) + __shfl_xor(b2 ? q8[j] : q8[4 + j], 4);
#pragma unroll
    for (int j = 0; j < 2; ++j) q2[j] = (b1 ? q4[2 + j] : q4[j]) + __shfl_xor(b1 ? q4[j] : q4[2 + j], 2);
    return (b0 ? q2[1] : q2[0]) + __shfl_xor(b0 ? q2[0] : q2[1], 1);
}
DI float bfly8(float (&pz)[8], const int lane) {
    const bool b2 = lane & 4, b1 = lane & 2, b0 = lane & 1;
    float q4[4], q2[2];
#pragma unroll
    for (int i = 0; i < 4; ++i) q4[i] = (b2 ? pz[4 + i] : pz[i]) + __shfl_xor(b2 ? pz[i] : pz[4 + i], 4);
#pragma unroll
    for (int i = 0; i < 2; ++i) q2[i] = (b1 ? q4[2 + i] : q4[i]) + __shfl_xor(b1 ? q4[i] : q4[2 + i], 2);
    float q = (b0 ? q2[1] : q2[0]) + __shfl_xor(b0 ? q2[0] : q2[1], 1);
    q += __shfl_xor(q, 8); q += __shfl_xor(q, 16); q += __shfl_xor(q, 32);
    return q;
}
DI float bfly16(float (&pz)[16], const int lane) {
    const bool b3 = lane & 8, b2 = lane & 4, b1 = lane & 2, b0 = lane & 1;
    float q8[8], q4[4], q2[2];
#pragma unroll
    for (int i = 0; i < 8; ++i) q8[i] = (b3 ? pz[8 + i] : pz[i]) + __shfl_xor(b3 ? pz[i] : pz[8 + i], 8);
#pragma unroll
    for (int i = 0; i < 4; ++i) q4[i] = (b2 ? q8[4 + i] : q8[i]) + __shfl_xor(b2 ? q8[i] : q8[4 + i], 4);
#pragma unroll
    for (int i = 0; i < 2; ++i) q2[i] = (b1 ? q4[2 + i] : q4[i]) + __shfl_xor(b1 ? q4[i] : q4[2 + i], 2);
    float q = (b0 ? q2[1] : q2[0]) + __shfl_xor(b0 ? q2[0] : q2[1], 1);
    q += __shfl_xor(q, 16); q += __shfl_xor(q, 32);
    return q;
}
DI void gs_issue(const __amdgpu_buffer_rsrc_t T, const uint2* ent, const unsigned d, const int lane, u32x4 (&w)[8], unsigned& ca) {
    const int cnt = (int)((d >> 16) & 0xfu), k = lane & 7;
    const uint2 e = ent[(d & 0xffffu) + (unsigned)(k < cnt ? k : cnt - 1)];
    ca = (k < cnt && !(d >> 31)) ? e.y : 0u;
#pragma unroll
    for (int q = 0; q < 8; ++q) {
        const int eid = __builtin_amdgcn_readlane((int)e.x, q) & 0x3fff;
        w[q] = __builtin_amdgcn_raw_buffer_load_b128(T, lane * 16, eid * DM, 0);
    }
}
DI float dot16_i8(const u32x4 w, const u32x4 h) {
    int acc = __builtin_amdgcn_sdot4((int)w.x, (int)h.x, 0, false);
    acc = __builtin_amdgcn_sdot4((int)w.y, (int)h.y, acc, false);
    acc = __builtin_amdgcn_sdot4((int)w.z, (int)h.z, acc, false);
    acc = __builtin_amdgcn_sdot4((int)w.w, (int)h.w, acc, false);
    return (float)acc;
}
DI void gs_desc(const uint2* ent, const unsigned d, const int lane, unsigned& ex) {
    const int cnt = (int)((d >> 16) & 0xfu), k = lane & 7;
    ex = ent[(d & 0xffffu) + (unsigned)(k < cnt ? k : cnt - 1)].x;
}
DI void gs_loads(const __amdgpu_buffer_rsrc_t T, const unsigned ex, const int lane, u32x4 (&w)[8]) {
#pragma unroll
    for (int q = 0; q < 8; ++q) {
        const int eid = __builtin_amdgcn_readlane((int)ex, q) & 0x3fff;
        w[q] = __builtin_amdgcn_raw_buffer_load_b128(T, lane * 16, eid * DM, 0);
    }
}
DI void gs_upartial(const u32x4 (&w)[8], const u32x4 h2q, float (&pz)[16], const int base) {
#pragma unroll
    for (int k = 0; k < 8; ++k) pz[base + k] = dot16_i8(w[k], h2q);
}
DI void gs_ustore(float (&pz)[16], float* zb, const unsigned da, const unsigned db, const int lane) {
    const float z = bfly16(pz, lane);
    const unsigned d = (lane & 8) ? db : da;
    const int k = lane & 7;
    if (lane < 16 && k < (int)((d >> 16) & 0xfu) && !(d >> 31)) zb[(d & 0xffffu) + k] = z;
}
DI void axpy16_u8(const float a, const u32x4 w, float (&o)[16]) {
    o[0] += a * (float)(w.x & 0xffu); o[1] += a * (float)((w.x >> 8) & 0xffu); o[2] += a * (float)((w.x >> 16) & 0xffu); o[3] += a * (float)(w.x >> 24);
    o[4] += a * (float)(w.y & 0xffu); o[5] += a * (float)((w.y >> 8) & 0xffu); o[6] += a * (float)((w.y >> 16) & 0xffu); o[7] += a * (float)(w.y >> 24);
    o[8] += a * (float)(w.z & 0xffu); o[9] += a * (float)((w.z >> 8) & 0xffu); o[10] += a * (float)((w.z >> 16) & 0xffu); o[11] += a * (float)(w.z >> 24);
    o[12] += a * (float)(w.w & 0xffu); o[13] += a * (float)((w.w >> 8) & 0xffu); o[14] += a * (float)((w.w >> 16) & 0xffu); o[15] += a * (float)(w.w >> 24);
}
DI void gs_vcompute(const u32x4 (&w)[8], const unsigned ca, float (&acc)[16]) {
#pragma unroll
    for (int k = 0; k < 8; ++k) { axpy16_u8(__uint_as_float((unsigned)__builtin_amdgcn_readlane((int)ca, k)), w[k], acc); __builtin_amdgcn_sched_barrier(0); }
}
constexpr int GT = 4;
constexpr int NSL = 4, SLSH = 12;
DI void xcd_pace(unsigned* cnt, const unsigned nloc, unsigned& step) {
    __syncthreads();
    if (__builtin_amdgcn_workitem_id_x() == 0) {
        __hip_atomic_fetch_add(cnt, 1u, __ATOMIC_RELAXED, __HIP_MEMORY_SCOPE_AGENT);
        const unsigned target = nloc * (step + 1u);
        unsigned sp = 0;
        while (__hip_atomic_load(cnt, __ATOMIC_RELAXED, __HIP_MEMORY_SCOPE_AGENT) < target) { __builtin_amdgcn_s_sleep(1); if (++sp > (1u << 22)) break; }
    }
    ++step;
    __syncthreads();
}
DI void phase_gather(const Params& p, int bid, int nb, char* smem, unsigned* pace_cnt, const unsigned pace_n) {
    unsigned pstep = 0;
    const float* mod = (const float*)(p.ws + OFF_MOD);
    const float* AB = (const float*)(p.ws + OFF_AB);
    const float* STAT = (const float*)(p.ws + OFF_STAT);
    const uint2* EX = (const uint2*)(p.ws + OFF_EXPS);
    const __amdgpu_buffer_rsrc_t UT = __builtin_amdgcn_make_buffer_rsrc((void*)(p.ws + OFF_UT), 0, NEXP * DM, 0x00020000);
    const __amdgpu_buffer_rsrc_t VT = __builtin_amdgcn_make_buffer_rsrc((void*)(p.ws + OFF_VT), 0, NEXP * DM, 0x00020000);
    const int lane = my_tid() & 63, wid = my_tid() >> 6, c0 = lane * 16;
    char* wl = smem + wid * 7168;
    uint2* ent = (uint2*)wl; float* zb = (float*)(wl + 4096); int* offs = (int*)(wl + 6144); unsigned* sched = (unsigned*)(wl + 6144 + 256);
#pragma unroll 1
    for (int t0 = (bid * 8 + wid) * GT; t0 < NTOK; t0 += nb * 8 * GT) {
        u32x4 h2q[GT]; float hsc[GT], mu[GT], rs[GT]; float acc[GT][16];
        f32x4 scv[4], shv[4];
        {
            const int b = t0 / SEQ;
#pragma unroll
            for (int q = 0; q < 4; ++q) { scv[q] = *(const f32x4*)(AB + (size_t)b * DM + c0 + q * 4); shv[q] = *(const f32x4*)(AB + (size_t)(NB + b) * DM + c0 + q * 4); }
        }
#pragma unroll
        for (int j = 0; j < GT; ++j) {
            const int tok = t0 + j;
            const float* row = p.out + (size_t)tok * DM + c0;
            __builtin_amdgcn_sched_barrier(0);
            { mu[j] = STAT[tok] * (1.0f / 1024.0f); rs[j] = rsqrtf(fmaxf(STAT[NTOK + tok] * (1.0f / 1024.0f) - mu[j] * mu[j], 0.f) + LN_EPS); }
            {
                f32x4 hv[4];
                float m = 0.f;
#pragma unroll
                for (int q = 0; q < 4; ++q) { hv[q] = (*(const f32x4*)(row + q * 4) - mu[j]) * rs[j] * scv[q] + shv[q]; m = fmaxf(m, fmaxf(fmaxf(fabsf(hv[q].x), fabsf(hv[q].y)), fmaxf(fabsf(hv[q].z), fabsf(hv[q].w)))); }
#pragma unroll
                for (int sft = 1; sft < 64; sft <<= 1) m = fmaxf(m, __shfl_xor(m, sft));
                const float qs = m > 1e-30f ? 127.0f / m : 1.0f;
                hsc[j] = m > 1e-30f ? m * (1.0f / 127.0f) : 1.0f;
                unsigned hw[4];
#pragma unroll
                for (int q = 0; q < 4; ++q)
                    hw[q] = ((unsigned)(int)rintf(hv[q].x * qs) & 0xffu) | (((unsigned)(int)rintf(hv[q].y * qs) & 0xffu) << 8) | (((unsigned)(int)rintf(hv[q].z * qs) & 0xffu) << 16) | (((unsigned)(int)rintf(hv[q].w * qs) & 0xffu) << 24);
                h2q[j] = (u32x4){hw[0], hw[1], hw[2], hw[3]};
            }
            const uint2 e0 = EX[(size_t)tok * 128 + lane], e1 = EX[(size_t)tok * 128 + 64 + lane];
            const int s0 = (int)((e0.x & 0x3fffu) >> SLSH), s1 = (int)((e1.x & 0x3fffu) >> SLSH);
            int run = 0, pos0 = 0, pos1 = 0;
#pragma unroll
            for (int s = 0; s < NSL; ++s) {
                const unsigned long long m0 = __ballot(s0 == s), m1 = __ballot(s1 == s);
                const int c0n = __popcll(m0), c1n = __popcll(m1);
                const int below0 = (int)__builtin_amdgcn_mbcnt_hi((unsigned)(m0 >> 32), __builtin_amdgcn_mbcnt_lo((unsigned)m0, 0u));
                const int below1 = (int)__builtin_amdgcn_mbcnt_hi((unsigned)(m1 >> 32), __builtin_amdgcn_mbcnt_lo((unsigned)m1, 0u));
                if (lane == 0) offs[j * 9 + s] = run;
                pos0 = (s0 == s) ? run + below0 : pos0;
                pos1 = (s1 == s) ? run + c0n + below1 : pos1;
                run += c0n + c1n;
            }
            if (lane == 0) offs[j * 9 + NSL] = 128;
            ent[j * 128 + pos0] = e0; ent[j * 128 + pos1] = e1;
        }
        int nbat;
        {
            const int gs = (lane / GT) % NSL, gj = lane % GT;
            const int gb = offs[gj * 9 + gs], ge = offs[gj * 9 + gs + 1], cnt = lane < NSL * GT ? ge - gb : 0, nbt = (cnt + 7) >> 3;
            int incl = nbt;
#pragma unroll
            for (int m = 1; m < 32; m <<= 1) { const int o = __shfl_up(incl, m); if ((lane & 31) >= m) incl += o; }
            nbat = __builtin_amdgcn_readlane(incl, NSL * GT - 1);
            const int st = incl - nbt;
            for (int q = 0; q < nbt; ++q) { const int rem = cnt - 8 * q; sched[st + q] = (unsigned)(gj * 128 + gb + 8 * q) | ((unsigned)(rem < 8 ? rem : 8) << 16); }
            if (lane < 3) sched[nbat + lane] = 0x80010000u;
        }
        xcd_pace(pace_cnt, pace_n, pstep);
#ifndef PROBE_UX
#define PROBE_UX 1
#endif
        for (int rep = 0; rep < PROBE_UX; ++rep)
        {
            u32x4 wa[8], wb[8];
#define GS_UP(W_, D_, B_) { const unsigned j_ = ((D_) & 0xffffu) >> 7; \
                if (j_ == 0) gs_upartial(W_, h2q[0], pz, B_); else if (j_ == 1) gs_upartial(W_, h2q[1], pz, B_); \
                else if (j_ == 2) gs_upartial(W_, h2q[2], pz, B_); else gs_upartial(W_, h2q[3], pz, B_); }
#define GS_RD(i_) ((unsigned)__builtin_amdgcn_readfirstlane((int)sched[(i_)]))
            unsigned da = GS_RD(0), db = GS_RD(1), dn = GS_RD(2), ea, eb, en;
            gs_desc(ent, da, lane, ea); gs_desc(ent, db, lane, eb); gs_desc(ent, dn, lane, en);
            gs_loads(UT, ea, lane, wa);
#pragma unroll 1
            for (int i = 0; i < nbat; i += 2) {
                float pz[16];
                gs_loads(UT, eb, lane, wb);
                __builtin_amdgcn_sched_barrier(0);
                GS_UP(wa, da, 0);
                const unsigned dcur_a = da, dcur_b = db;
                da = dn; ea = en; dn = GS_RD(i + 3); gs_desc(ent, dn, lane, en);
                gs_loads(UT, ea, lane, wa);
                __builtin_amdgcn_sched_barrier(0);
                GS_UP(wb, dcur_b, 8);
                db = dn; eb = en; dn = GS_RD(i + 4); gs_desc(ent, dn, lane, en);
                gs_ustore(pz, zb, dcur_a, dcur_b, lane);
            }
#undef GS_UP
#undef GS_RD
        }
        float asum[GT];
#pragma unroll
        for (int j = 0; j < GT; ++j) {
            float as = 0.f;
#pragma unroll
            for (int q = 0; q < 2; ++q) {
                const int pos = j * 128 + q * 64 + lane;
                const uint2 e = ent[pos];
                const float z = zb[pos] * __uint_as_float(e.x & 0xffff0000u) * hsc[j];
                const float a = gelu_as(z) * __uint_as_float(e.y);
                ent[pos].y = __float_as_uint(a);
                as += a;
            }
#pragma unroll
            for (int sft = 1; sft < 64; sft <<= 1) as += __shfl_xor(as, sft);
            asum[j] = as;
        }
        xcd_pace(pace_cnt, pace_n, pstep);
#pragma unroll
        for (int j = 0; j < GT; ++j)
#pragma unroll
            for (int q = 0; q < 16; ++q) acc[j][q] = 0.f;
        {
            u32x4 wa[8]; unsigned ca;
#pragma unroll 1
            for (int i = 0; i < nbat; ++i) {
                const unsigned da = (unsigned)__builtin_amdgcn_readfirstlane((int)sched[i]);
                gs_issue(VT, ent, da, lane, wa, ca);
                __builtin_amdgcn_sched_barrier(0);
                const unsigned j_ = (da & 0xffffu) >> 7;
                if (j_ == 0) gs_vcompute(wa, ca, acc[0]); else if (j_ == 1) gs_vcompute(wa, ca, acc[1]);
                else if (j_ == 2) gs_vcompute(wa, ca, acc[2]); else gs_vcompute(wa, ca, acc[3]);
            }
        }
#pragma unroll
        for (int j = 0; j < GT; ++j) {
            asm volatile("" ::: "memory");
            __builtin_amdgcn_sched_barrier(0);
            const int tok = t0 + j, b = tok / SEQ;
            float* row = p.out + (size_t)tok * DM + c0;
            const float* g2 = mod + b * 6144 + 5120 + c0;
            f32x2 r[8];
            float sm = 0.f;
#pragma unroll
            for (int q = 0; q < 4; ++q) {
                const f32x4 xv = (*(const f32x4*)(row + q * 4) - mu[j]) * rs[j] * *(const f32x4*)(p.ln1w + c0 + q * 4) + *(const f32x4*)(p.ln1b + c0 + q * 4), gg = *(const f32x4*)(g2 + q * 4);
                const float off = 128.0f * asum[j];
                r[2 * q] = DEEP_ALPHA * (f32x2){xv.x, xv.y} + (f32x2){1.f + gg.x, 1.f + gg.y} * (f32x2){acc[j][4 * q] - off, acc[j][4 * q + 1] - off};
                r[2 * q + 1] = DEEP_ALPHA * (f32x2){xv.z, xv.w} + (f32x2){1.f + gg.z, 1.f + gg.w} * (f32x2){acc[j][4 * q + 2] - off, acc[j][4 * q + 3] - off};
                sm += r[2 * q].x + r[2 * q].y + r[2 * q + 1].x + r[2 * q + 1].y;
            }
#pragma unroll
            for (int m = 1; m < 64; m <<= 1) sm += __shfl_xor(sm, m);
            const float mu = sm * (1.0f / 1024.0f);
            float qq = 0.f;
#pragma unroll
            for (int i = 0; i < 8; ++i) { const f32x2 dd = r[i] - mu; qq += dd.x * dd.x + dd.y * dd.y; }
#pragma unroll
            for (int m = 1; m < 64; m <<= 1) qq += __shfl_xor(qq, m);
            const float rstd = rsqrtf(qq * (1.0f / 1024.0f) + LN_EPS);
#pragma unroll
            for (int q = 0; q < 4; ++q) {
                const f32x4 w4 = *(const f32x4*)(p.ln2w + c0 + q * 4), bi = *(const f32x4*)(p.ln2b + c0 + q * 4);
                f32x4 ov;
                ov.x = (r[2 * q].x - mu) * rstd * w4.x + bi.x; ov.y = (r[2 * q].y - mu) * rstd * w4.y + bi.y;
                ov.z = (r[2 * q + 1].x - mu) * rstd * w4.z + bi.z; ov.w = (r[2 * q + 1].y - mu) * rstd * w4.w + bi.w;
                *(f32x4*)(row + q * 4) = ov;
            }
        }
    }
}

#define XB_TMO      128
#define XB_XCNT(j)  (256  + 64 * (j))
#define XB_XSUB(j)  (1280 + 64 * (j))
#define XB_XGEN(j)  (2304 + 64 * (j))
#define XB_TOP      3328
#define XB_TOPGEN   3392
#define XCD_BAR_WORDS 3456
#define XB_SPIN_CAP (1u << 22)
#define LAS __attribute__((address_space(3)))
DI unsigned xb_ld(unsigned* p) { return __hip_atomic_load(p, __ATOMIC_RELAXED, __HIP_MEMORY_SCOPE_AGENT); }
DI unsigned xb_add(unsigned* p, unsigned v) { return __hip_atomic_fetch_add(p, v, __ATOMIC_RELAXED, __HIP_MEMORY_SCOPE_AGENT); }
DI unsigned xb_xcc_id() { return (unsigned)__builtin_amdgcn_s_getreg((3 << 11) | 20) & 0xFu; }
#define XB_SPIN(cond, bar) do { unsigned _sp = 0; while (cond) { __builtin_amdgcn_s_sleep(1); \
    if ((++_sp & 255u) == 0u) { if (xb_ld(&(bar)[XB_TMO])) break; if (_sp > XB_SPIN_CAP) { atomicAdd(&(bar)[XB_TMO], 1u); break; } } } } while (0)
struct XcdBarrier { unsigned* bar; unsigned x; volatile LAS unsigned* st; };
DI XcdBarrier xcd_barrier_post(unsigned* bar, volatile LAS unsigned* st) {
    XcdBarrier b; b.bar = bar; b.x = xb_xcc_id(); b.st = st;
    if (__builtin_amdgcn_workitem_id_x() == 0) (void)xb_add(&bar[XB_XCNT(b.x)], 1u);
    return b;
}
DI void xcd_barrier_complete(unsigned* bar, unsigned x, unsigned& nloc, unsigned& nx) {
    const unsigned G = gridDim.x * gridDim.y * gridDim.z;
    unsigned sum, cnt, mine, sp = 0u;
    for (;;) {
        sum = 0u; cnt = 0u; mine = 0u;
#pragma unroll
        for (unsigned j = 0; j < 16; ++j) { const unsigned c = xb_ld(&bar[XB_XCNT(j)]); sum += c; cnt += (c > 0u) ? 1u : 0u; mine = (j == x) ? c : mine; }
        if (sum == G) break;
        __builtin_amdgcn_s_sleep(1);
        if ((++sp & 255u) == 0u) { if (xb_ld(&bar[XB_TMO])) break; if (sp > XB_SPIN_CAP) { atomicAdd(&bar[XB_TMO], 1u); break; } }
    }
    nloc = mine > 0u ? mine : 1u; nx = cnt > 0u ? cnt : 1u;
}
DI void xcd_barrier(const XcdBarrier& b) {
    asm volatile("s_waitcnt vmcnt(0)" ::: "memory");
    __syncthreads();
    if (__builtin_amdgcn_workitem_id_x() == 0) {
        unsigned* bar = b.bar;
        __builtin_amdgcn_s_waitcnt(0);
        unsigned nloc = b.st[0], nx = b.st[1];
        if (nloc == 0u) { xcd_barrier_complete(bar, b.x, nloc, nx); b.st[0] = nloc; b.st[1] = nx; }
        const unsigned old = xb_add(&bar[XB_XSUB(b.x)], 1u);
        const unsigned gen = old / nloc;
        if (old + 1u == (gen + 1u) * nloc) {
            __builtin_amdgcn_fence(__ATOMIC_RELEASE, "agent");
            asm volatile("s_waitcnt vmcnt(0)" ::: "memory");
            const unsigned og = xb_add(&bar[XB_TOP], 1u);
            const unsigned tg = og / nx;
            if (og + 1u == (tg + 1u) * nx) xb_add(&bar[XB_TOPGEN], 1u);
            else XB_SPIN(xb_ld(&bar[XB_TOPGEN]) == tg, bar);
            __builtin_amdgcn_fence(__ATOMIC_ACQUIRE, "agent");
            xb_add(&bar[XB_XGEN(b.x)], 1u);
            asm volatile("s_waitcnt vmcnt(0)" ::: "memory");
        } else {
            XB_SPIN(xb_ld(&bar[XB_XGEN(b.x)]) == gen, bar);
            __builtin_amdgcn_fence(__ATOMIC_ACQUIRE, "agent");
            asm volatile("s_waitcnt vmcnt(0)" ::: "memory");
        }
    }
    __syncthreads();
}

__global__ void __launch_bounds__(NTH) k_mega(Params p) {
    __shared__ __attribute__((aligned(16))) char smem[SMEM_BYTES];
    volatile LAS unsigned* xst = (volatile LAS unsigned*)(smem + SMEM_BYTES - 16);
    if (__builtin_amdgcn_workitem_id_x() == 0) { xst[0] = 0u; xst[1] = 0u; }
    __syncthreads();
    const XcdBarrier xb = xcd_barrier_post((unsigned*)(p.ws + OFF_BAR), xst);
    const int bid = blockIdx.x, nb = gridDim.x;
#ifndef PROBE_MASK
#define PROBE_MASK 0
#endif
#define REP(bit) for (int rep_ = 0; rep_ < ((PROBE_MASK & (bit)) ? 2 : 1); ++rep_)
    REP(64)  { phase_prep_a(p, smem, rep_);     xcd_barrier(xb); }
    REP(256) { phase_prep_b(p, smem, rep_);     xcd_barrier(xb); }
    REP(1)  { phase_proj(p, bid, nb, smem);    xcd_barrier(xb); }
    REP(128) { phase_hgprep(p, bid, nb);       xcd_barrier(xb); }
    REP(2)  { phase_mix(p, bid, nb, smem);     xcd_barrier(xb); }
    REP(4)  { phase_glu(p, bid, nb, smem);     xcd_barrier(xb); }
    REP(4)  { phase_a2(p, bid, nb);            xcd_barrier(xb); }
    REP(4)  { phase_outproj(p, bid, nb, smem); xcd_barrier(xb); }
    REP(8)  { phase_q(p, bid, nb, smem);       xcd_barrier(xb); }
    REP(16) { phase_retrieve(p, bid, nb, smem); xcd_barrier(xb); }
    phase_gather(p, bid, nb, smem, (unsigned*)(p.ws + OFF_BAR) + 16 * xb.x, xst[0]);
}

extern "C" void kernel_launch(void* const* d_in, const int* in_sizes, int n_in, void* d_out, int out_size, void* d_ws, size_t ws_size, hipStream_t stream) {
    if (n_in != 27 || ws_size < WS_END) { fprintf(stderr, "kernel_launch: unexpected n_in %d or ws_size %zu (< %zu)\n", n_in, ws_size, (size_t)WS_END); return; }
    static int grid_blocks = 0;
    if (!grid_blocks) {
        int dev = 0, cus = 0, per_cu = 0;
        (void)hipGetDevice(&dev);
        (void)hipDeviceGetAttribute(&cus, hipDeviceAttributeMultiprocessorCount, dev);
        (void)hipOccupancyMaxActiveBlocksPerMultiprocessor(&per_cu, k_mega, NTH, 0);
        if (cus <= 0) cus = 256;
        if (per_cu < 1) { fprintf(stderr, "kernel_launch: occupancy query says %d blocks/CU\n", per_cu); per_cu = 1; }
        grid_blocks = cus;
    }
    Params p{};
    const float** f = (const float**)&p;
    for (int i = 0; i < 27; ++i) f[i] = (const float*)d_in[i];
    p.out = (float*)d_out; p.ws = (char*)d_ws;
    hipError_t e = hipMemsetAsync((char*)d_ws + OFF_BAR, 0, (size_t)3456 * 4, stream);
    if (e == hipSuccess) { hipLaunchKernelGGL(k_mega, dim3(grid_blocks), dim3(NTH), 0, stream, p); e = hipPeekAtLastError(); }
    if (e != hipSuccess) fprintf(stderr, "launch failed: %s (grid %d)\n", hipGetErrorString(e), grid_blocks);
}
```

```cpp
#include <hip/hip_runtime.h>
#include <hip/hip_cooperative_groups.h>
#include <stdint.h>
#include <stdio.h>

namespace cg = cooperative_groups;
#define DI __device__ __forceinline__
typedef unsigned short bf16_t;
typedef short bf16x8 __attribute__((ext_vector_type(8)));
typedef float f32x16 __attribute__((ext_vector_type(16)));
typedef unsigned u32x4 __attribute__((ext_vector_type(4)));
typedef float f32x4 __attribute__((ext_vector_type(4)));
typedef float f32x2 __attribute__((ext_vector_type(2)));

constexpr int NTH = 512;
constexpr int NB = 16, SEQ = 2048, DM = 1024, NTOK = NB * SEQ;
constexpr int DHG = 512, HGH = 4, HDK = 128;
constexpr int DSS = 512, SSG = 32, SSC = 16, SSP = 64;
constexpr int INC = 2560;
constexpr int PHEADS = 8, NKEYS = 128, TOPK = 16, NEXP = 16384;
constexpr float DEEP_ALPHA = 1.189207115002721f;
constexpr float LN_EPS = 1e-5f, RMS_EPS = 1e-6f;
constexpr int SMEM_BYTES = 128 * 1024 + 256;

constexpr size_t al256(size_t x) { return (x + 255) & ~(size_t)255; }
constexpr size_t OFF_MOD = 0;
constexpr size_t OFF_LB = al256(OFF_MOD + (size_t)NB * 6144 * 4);
constexpr size_t OFF_LAM = al256(OFF_LB + 512 * 4);
constexpr size_t OFF_BB = al256(OFF_LAM + 32 * 64 * 2 * 4);
constexpr size_t OFF_WIN = al256(OFF_BB + 32 * 64 * 16 * 2 * 4);
constexpr size_t OFF_GLU = al256(OFF_WIN + (size_t)INC * DM * 2);
constexpr size_t OFF_WOUT = al256(OFF_GLU + (size_t)512 * 512 * 2);
constexpr size_t OFF_WQ = al256(OFF_WOUT + (size_t)DM * DM * 2);
constexpr size_t OFF_SUBK = al256(OFF_WQ + (size_t)2048 * DM * 2);
constexpr size_t OFF_SU = al256(OFF_SUBK + (size_t)16 * 128 * 128 * 2);
constexpr size_t OFF_SV = al256(OFF_SU + (size_t)NEXP * 4);
constexpr size_t OFF_UT = al256(OFF_SV + (size_t)NEXP * 4);
constexpr size_t OFF_VT = al256(OFF_UT + (size_t)NEXP * DM * 2);
constexpr size_t OFF_H = al256(OFF_VT + (size_t)NEXP * DM * 2);
constexpr size_t OFF_PROJ = al256(OFF_H + (size_t)NTOK * DM * 2);
constexpr size_t OFF_ORAW = al256(OFF_PROJ + (size_t)NTOK * INC * 2);
constexpr size_t OFF_YSSM = al256(OFF_ORAW + (size_t)NTOK * DHG * 4);
constexpr size_t OFF_A2 = al256(OFF_YSSM + (size_t)NTOK * DSS * 2);
constexpr size_t OFF_HG = al256(OFF_A2 + (size_t)NTOK * DM * 2);
constexpr size_t OFF_S5K = al256(OFF_HG + (size_t)4096 * 128 * 4);
constexpr size_t OFF_S5N = al256(OFF_S5K + (size_t)32 * 4096 * 2);
constexpr size_t OFF_S5M = al256(OFF_S5N + (size_t)32 * 128 * 256 * 2);
constexpr size_t OFF_S5L = al256(OFF_S5M + (size_t)32 * 256 * 128 * 2);
constexpr size_t OFF_STAT = al256(OFF_S5L + (size_t)32 * 64 * 2 * 4);
constexpr size_t OFF_AB = al256(OFF_STAT + (size_t)NTOK * 2 * 4);
constexpr size_t OFF_CAB = al256(OFF_AB + (size_t)2 * NB * DM * 4);
constexpr size_t OFF_BAR = al256(OFF_CAB + (size_t)2 * NB * 2048 * 4);
constexpr size_t WS_END = al256(OFF_BAR + (size_t)3456 * 4);
constexpr size_t OFF_HQ = OFF_H, OFF_HK = OFF_H + (size_t)NTOK * DHG * 2, OFF_HKT = OFF_A2, OFF_HVT = OFF_A2 + (size_t)NTOK * DHG * 2;
constexpr size_t OFF_TOPL = OFF_ORAW;
constexpr size_t OFF_EXPS = OFF_ORAW + (size_t)NTOK * 16 * 16 * 4;

struct Params {
    const float *x, *c, *ada_w, *ada_b, *w_in, *hg_lb, *hg_nw, *a_re, *a_im, *log_dt, *b_re, *b_im, *c_re, *c_im, *dsk,
        *glu_w, *glu_b, *ssm_nw, *w_out, *ln1w, *ln1b, *w_q, *subk, *pu, *pv, *ln2w, *ln2b;
    float* out;
    char* ws;
};

DI int my_tid() { int t = (int)__builtin_amdgcn_workitem_id_x(); asm volatile("" : "+v"(t)); return t; }
DI bf16_t f2bf(float x) { unsigned u = __float_as_uint(x); u += 0x7fffu + ((u >> 16) & 1u); return (bf16_t)(u >> 16); }
DI float bf2f(bf16_t b) { return __uint_as_float(((unsigned)b) << 16); }
DI float bflo(unsigned w) { return __uint_as_float(w << 16); }
DI float bfhi(unsigned w) { return __uint_as_float(w & 0xffff0000u); }
typedef __bf16 hwbf16x2 __attribute__((ext_vector_type(2)));
DI unsigned pack2(float a, float b) { const f32x2 v = {a, b}; return __builtin_bit_cast(unsigned, __builtin_convertvector(v, hwbf16x2)); }
DI bf16x8 pack8(const f32x16& x, const int base) {
    u32x4 o; o.x = pack2(x[base], x[base + 1]); o.y = pack2(x[base + 2], x[base + 3]); o.z = pack2(x[base + 4], x[base + 5]); o.w = pack2(x[base + 6], x[base + 7]);
    return __builtin_bit_cast(bf16x8, o);
}
DI float sigmoidf_(float x) { return 1.0f / (1.0f + __expf(-x)); }
DI float siluf_(float x) { return x * sigmoidf_(x); }
DI float geluf_(float x) { return 0.5f * x * (1.0f + erff(x * 0.70710678118654752f)); }
DI float gelu_as(float v) {
    const float t = __builtin_amdgcn_rcpf(fabsf(v) * 0.2316418882f + 1.0f);
    float q = t * 0.5307027145f + (-0.7265760135f); q = q * t + 0.7107068705f; q = q * t + (-0.142248368f); q = q * t + 0.127414796f; q = q * t;
    const float m = v * (q * __builtin_amdgcn_exp2f(v * v * (-0.72134752044f)));
    return v < 0.f ? m : v - m;
}

template <int MT, int NT_, int WM, int WN, class Epi>
DI void gemm_block(const bf16_t* __restrict__ A, int lda, const bf16_t* __restrict__ Bt, int ldb, int K, char* smem, Epi epi) {
    constexpr int BM = WM * MT * 32, BN = WN * NT_ * 32, LS = 72;
    static_assert(WM * WN == 8, "8 waves");
    bf16_t* As = (bf16_t*)smem;
    bf16_t* Bs = As + BM * LS;
    const int tid = my_tid(), lane = tid & 63, wid = tid >> 6, r = lane & 31, h = lane >> 5;
    const int wm = wid / WN, wn = wid % WN;
    constexpr int PA = BM * 8 / NTH, PB = BN * 8 / NTH;
    u32x4 ra[PA], rb[PB];
    f32x16 acc[MT][NT_];
#pragma unroll
    for (int mi = 0; mi < MT; ++mi)
#pragma unroll
        for (int ni = 0; ni < NT_; ++ni)
#pragma unroll
            for (int i = 0; i < 16; ++i) acc[mi][ni][i] = 0.f;
#define GEMM_GLOAD(kt_) { \
    _Pragma("unroll") for (int q = 0; q < PA; ++q) { const int idx = tid + q * NTH, row = idx >> 3, ch = idx & 7; ra[q] = *(const u32x4*)(A + (size_t)row * lda + (kt_) * 64 + ch * 8); } \
    _Pragma("unroll") for (int q = 0; q < PB; ++q) { const int idx = tid + q * NTH, row = idx >> 3, ch = idx & 7; rb[q] = *(const u32x4*)(Bt + (size_t)row * ldb + (kt_) * 64 + ch * 8); } }
#define GEMM_LSTORE() { \
    _Pragma("unroll") for (int q = 0; q < PA; ++q) { const int idx = tid + q * NTH, row = idx >> 3, ch = idx & 7; *(u32x4*)(As + row * LS + ch * 8) = ra[q]; } \
    _Pragma("unroll") for (int q = 0; q < PB; ++q) { const int idx = tid + q * NTH, row = idx >> 3, ch = idx & 7; *(u32x4*)(Bs + row * LS + ch * 8) = rb[q]; } }
    GEMM_GLOAD(0); GEMM_LSTORE(); __syncthreads();
    const int nk = K / 64;
    for (int kt = 0; kt < nk; ++kt) {
        if (kt + 1 < nk) GEMM_GLOAD(kt + 1);
#pragma unroll
        for (int ks = 0; ks < 4; ++ks) {
            bf16x8 a[MT], b[NT_];
#pragma unroll
            for (int mi = 0; mi < MT; ++mi) a[mi] = *(const bf16x8*)(As + (wm * MT * 32 + mi * 32 + r) * LS + ks * 16 + h * 8);
#pragma unroll
            for (int ni = 0; ni < NT_; ++ni) b[ni] = *(const bf16x8*)(Bs + (wn * NT_ * 32 + ni * 32 + r) * LS + ks * 16 + h * 8);
#pragma unroll
            for (int mi = 0; mi < MT; ++mi)
#pragma unroll
                for (int ni = 0; ni < NT_; ++ni) acc[mi][ni] = __builtin_amdgcn_mfma_f32_32x32x16_bf16(a[mi], b[ni], acc[mi][ni], 0, 0, 0);
        }
        __syncthreads();
        if (kt + 1 < nk) { GEMM_LSTORE(); __syncthreads(); }
    }
#pragma unroll
    for (int mi = 0; mi < MT; ++mi)
#pragma unroll
        for (int ni = 0; ni < NT_; ++ni)
#pragma unroll
            for (int i = 0; i < 16; ++i) epi(wm * MT * 32 + mi * 32 + (i & 3) + 8 * (i >> 2) + 4 * h, wn * NT_ * 32 + ni * 32 + r, acc[mi][ni][i]);
}

namespace pg8 {
#define PG8_LAS __attribute__((address_space(3)))
typedef unsigned short bf16_t;
typedef short bf16x8 __attribute__((ext_vector_type(8)));
typedef float f32x4 __attribute__((ext_vector_type(4)));
typedef unsigned u32x4 __attribute__((ext_vector_type(4)));
constexpr int BM = 256, BK = 64, HALF = 128, HTB = HALF * BK * 2  , STAGE_BYTES = 8 * HTB, NXCD = 8, WGM = 8;

__host__ __device__ __forceinline__ int lds_byte(int r, int c) { const int st = (r >> 4) * 2 + (c >> 5), rr = r & 15, cc = c & 31, ob = rr * 64 + cc * 2; return st * 1024 + (ob ^ (((ob >> 9) & 1) << 5)); }
__host__ __device__ __forceinline__ void stage_rc(int b, int& R, int& C) { const int st = b / 1024, sb = b % 1024, swz = sb ^ (((sb >> 9) & 1) << 5); R = (st >> 1) * 16 + swz / 64; C = (st & 1) * 32 + (swz % 64) / 2; }
__host__ __device__ __forceinline__ int perm32(int rho) { const int n = rho >> 4, i = rho & 15; return 8 * (i >> 2) + 4 * n + (i & 3); }

struct Unit { int pm, pn; };
struct Gemm { const bf16_t* A; const bf16_t* Bt; int M, N, K; };

struct StaticOrder {
    int nM, nN, nwg, G, c;
    __host__ __device__ void init(int M, int N, int G_, int c_) { nM = M / BM; nN = N / BM; nwg = nM * nN; G = G_; c = c_; }
    __host__ __device__ bool next(int i, Unit& u) const {
        const long L = (long)i * G + c; if (L >= nwg) return false;
        int wgid = (int)L; { const int q = nwg / NXCD, r = nwg % NXCD, xcd = wgid % NXCD, off = wgid / NXCD; wgid = (xcd < r ? xcd * (q + 1) : r * (q + 1) + (xcd - r) * q) + off; }
        const int nig = WGM * nN, gid = wgid / nig, fm = gid * WGM, gsz = (nM - fm) < WGM ? (nM - fm) : WGM;
        u.pm = fm + ((wgid % nig) % gsz); u.pn = (wgid % nig) / gsz; return true;
    }
    __device__ __forceinline__ void a_ready(const Unit&) const {}
    __device__ __forceinline__ void done(const Unit&) const {}
};
template <class Epi, class Sched, bool STAMP = false>
__device__ __forceinline__ void gemm_phase(PG8_LAS unsigned char* lds, const Gemm g, const Sched& S, const Epi& E, unsigned long long* stamps) {
    const int tid = (int)__builtin_amdgcn_workitem_id_x(), wid = __builtin_amdgcn_readfirstlane(tid >> 6), lane = tid & 63, wr = wid >> 2, wc = wid & 3, fr = lane & 15, fq = lane >> 4;
    const int K = g.K, nt = K / BK;
    int ts_lo = 0, ts_hi = 0, nts = 0; const unsigned long long rt_entry = STAMP ? (unsigned long long)wall_clock64() : 0ull;
#define PG8_STAMP() do { if (STAMP && wid == 0 && nts < 64) { const unsigned long long _c = (unsigned long long)clock64(); \
        ts_lo = (lane == nts) ? (int)(unsigned)_c : ts_lo; ts_hi = (lane == nts) ? (int)(unsigned)(_c >> 32) : ts_hi; ++nts; } } while (0)
    PG8_STAMP();
    unsigned voffA[2], voffB[2];
#pragma unroll
    for (int i = 0; i < 2; ++i) { int R, C; stage_rc(tid * 16 + i * 8192, R, C); const int Rb = Epi::PERM ? ((R & ~31) + perm32(R & 31)) : R;
        voffA[i] = (unsigned)(R * K + C) * 2u; voffB[i] = (unsigned)(Rb * K + C) * 2u; }
    const size_t kstep = (size_t)(BK * 2);
    const size_t hstep = (size_t)HALF * K * 2;
    const size_t tstep = 2 * hstep;
    const unsigned ldsw = (unsigned)wid * 1024u;
    const int aoff = lds_byte(wr * 64 + fr, fq * 8), boff = lds_byte(wc * 32 + fr, fq * 8);
#define PG8_SA(b, h) (((b) * 2 + (h)) * HTB)
#define PG8_SB(b, h) ((4 + (b) * 2 + (h)) * HTB)
#define PG8_STAGE(bufoff, gbase, voff) do { _Pragma("unroll") for (int _i = 0; _i < 2; ++_i) \
        __builtin_amdgcn_global_load_lds((const unsigned*)((const char*)(gbase) + (voff)[_i]), (PG8_LAS unsigned*)(lds + (bufoff) + ldsw + _i * 8192), 16, 0, 0); } while (0)
#define PG8_LDA(dst, b, h) do { _Pragma("unroll") for (int m = 0; m < 4; ++m) _Pragma("unroll") for (int k = 0; k < 2; ++k) dst[m][k] = *(const PG8_LAS bf16x8*)(lds + PG8_SA(b, h) + aoff + m * 2048 + k * 1024); } while (0)
#define PG8_LDB(dst, b, h) do { _Pragma("unroll") for (int n = 0; n < 2; ++n) _Pragma("unroll") for (int k = 0; k < 2; ++k) dst[n][k] = *(const PG8_LAS bf16x8*)(lds + PG8_SB(b, h) + boff + n * 2048 + k * 1024); } while (0)
#define PG8_MMA(ai, bj, At, Bt) do { __builtin_amdgcn_s_setprio(1); _Pragma("unroll") for (int m = 0; m < 4; ++m) _Pragma("unroll") for (int n = 0; n < 2; ++n) _Pragma("unroll") for (int k = 0; k < 2; ++k) \
        acc[ai][bj][m][n] = __builtin_amdgcn_mfma_f32_16x16x32_bf16(Bt[n][k], At[m][k], acc[ai][bj][m][n], 0, 0, 0); __builtin_amdgcn_s_setprio(0); } while (0)
#define PG8_WAIT_V(n) asm volatile("s_waitcnt vmcnt(" #n ")" ::: "memory")
#define PG8_WAIT_L(n) asm volatile("s_waitcnt lgkmcnt(" #n ")" ::: "memory")
#define PG8_BAR __builtin_amdgcn_s_barrier()
#define PG8_SCHED __builtin_amdgcn_sched_barrier(0)
    Unit cur, nxt; int ui = 0;
    if (!S.next(0, cur)) return;
    f32x4 acc[2][2][4][2];
#pragma unroll
    for (int a = 0; a < 2; ++a)
#pragma unroll
        for (int b = 0; b < 2; ++b)
#pragma unroll
            for (int m = 0; m < 4; ++m)
#pragma unroll
                for (int n = 0; n < 2; ++n) acc[a][b][m][n] = (f32x4){0.f, 0.f, 0.f, 0.f};
    bf16x8 At[4][2], B0[2][2], B1[2][2];
    const char* cA = (const char*)g.A + (size_t)cur.pm * tstep; const char* cB = (const char*)g.Bt + (size_t)cur.pn * tstep;
    S.a_ready(cur);
    PG8_STAGE(PG8_SB(0, 0), cB, voffB); PG8_STAGE(PG8_SA(0, 0), cA, voffA); PG8_STAGE(PG8_SB(0, 1), cB + hstep, voffB); PG8_STAGE(PG8_SA(0, 1), cA + hstep, voffA);
    if (wr == 1) PG8_BAR;
    PG8_WAIT_V(4); PG8_BAR;
    PG8_STAGE(PG8_SB(1, 0), cB + kstep, voffB); PG8_STAGE(PG8_SA(1, 0), cA + kstep, voffA); PG8_STAGE(PG8_SB(1, 1), cB + hstep + kstep, voffB);
    PG8_WAIT_V(6); PG8_BAR;
    PG8_STAMP();
    for (;;) {
        const bool has_next = S.next(ui + 1, nxt);
        const char* nA = has_next ? (const char*)g.A + (size_t)nxt.pm * tstep : cA; const char* nB = has_next ? (const char*)g.Bt + (size_t)nxt.pn * tstep : cB;
        for (int t = 0; t < nt; t += 2) {
            const bool last = (t == nt - 2);
            const char* a1 = cA + (size_t)(t + 1) * kstep;
            const char* a2 = last ? nA : cA + (size_t)(t + 2) * kstep; const char* b2 = last ? nB : cB + (size_t)(t + 2) * kstep;
            const char* a3 = a2 + kstep; const char* b3 = b2 + kstep;
            if (last && has_next) S.a_ready(nxt);
            PG8_LDB(B0, 0, 0); PG8_SCHED; PG8_LDA(At, 0, 0); PG8_STAGE(PG8_SA(1, 1), a1 + hstep, voffA);
            PG8_WAIT_L(8); PG8_BAR; PG8_WAIT_L(0); PG8_MMA(0, 0, At, B0); PG8_BAR; PG8_SCHED;
            PG8_LDB(B1, 0, 1); PG8_STAGE(PG8_SB(0, 0), b2, voffB);
            PG8_BAR; PG8_WAIT_L(0); PG8_MMA(0, 1, At, B1); PG8_BAR;
            PG8_LDA(At, 0, 1); PG8_STAGE(PG8_SA(0, 0), a2, voffA);
            PG8_BAR; PG8_WAIT_L(0); PG8_MMA(1, 0, At, B0); PG8_BAR; PG8_SCHED;
            PG8_STAGE(PG8_SB(0, 1), b2 + hstep, voffB);
            PG8_WAIT_V(6); PG8_BAR; PG8_MMA(1, 1, At, B1); PG8_BAR;
            PG8_LDB(B0, 1, 0); PG8_SCHED; PG8_LDA(At, 1, 0); PG8_STAGE(PG8_SA(0, 1), a2 + hstep, voffA);
            PG8_WAIT_L(8); PG8_BAR; PG8_WAIT_L(0); PG8_MMA(0, 0, At, B0); PG8_BAR; PG8_SCHED;
            PG8_LDB(B1, 1, 1); PG8_STAGE(PG8_SB(1, 0), b3, voffB);
            PG8_BAR; PG8_WAIT_L(0); PG8_MMA(0, 1, At, B1); PG8_BAR;
            PG8_LDA(At, 1, 1); PG8_STAGE(PG8_SA(1, 0), a3, voffA);
            PG8_BAR; PG8_WAIT_L(0); PG8_MMA(1, 0, At, B0); PG8_BAR; PG8_SCHED;
            PG8_STAGE(PG8_SB(1, 1), b3 + hstep, voffB);
            PG8_WAIT_V(6); PG8_BAR; PG8_MMA(1, 1, At, B1); PG8_BAR;
        }
        PG8_STAMP();
        if constexpr (!Epi::AFTER_DRAIN) { E(acc, cur, wr, wc, fr, fq); S.done(cur); }
        PG8_STAMP();
        if (!has_next) break;
#pragma unroll
        for (int a = 0; a < 2; ++a)
#pragma unroll
            for (int b = 0; b < 2; ++b)
#pragma unroll
                for (int m = 0; m < 4; ++m)
#pragma unroll
                    for (int n = 0; n < 2; ++n) acc[a][b][m][n] = (f32x4){0.f, 0.f, 0.f, 0.f};
        cur = nxt; cA = nA; cB = nB; ++ui;
    }
    PG8_WAIT_V(0);
    if (wr == 0) PG8_BAR;
    PG8_BAR;
    if constexpr (Epi::AFTER_DRAIN) { E.fused(acc, cur, wr, wc, fr, fq, lds, wid, lane); S.done(cur); }
    PG8_STAMP();
    if (STAMP && wid == 0) { stamps[lane] = lane < nts ? (((unsigned long long)(unsigned)ts_hi << 32) | (unsigned)ts_lo) : 0ull;
        if (lane == 62) stamps[62] = rt_entry; if (lane == 63) stamps[63] = (unsigned long long)wall_clock64(); }
#undef PG8_STAMP
#undef PG8_SA
#undef PG8_SB
#undef PG8_STAGE
#undef PG8_LDA
#undef PG8_LDB
#undef PG8_MMA
#undef PG8_WAIT_V
#undef PG8_WAIT_L
#undef PG8_BAR
#undef PG8_SCHED
}

__device__ __forceinline__ unsigned pk_bf16(float lo, float hi) { typedef float v2f __attribute__((ext_vector_type(2))); typedef __bf16 v2b __attribute__((ext_vector_type(2))); const v2f v = {lo, hi}; return __builtin_bit_cast(unsigned, __builtin_convertvector(v, v2b)); }
__device__ __forceinline__ float silu1(float x) { return x * __builtin_amdgcn_rcpf(1.0f + __expf(-x)); }
struct EpiBf16Act {
    static constexpr bool PERM = true, AFTER_DRAIN = false;
    bf16_t* O; int ldc; unsigned silu_mask;
    __device__ __forceinline__ void operator()(const f32x4 (&acc)[2][2][4][2], const Unit& u, int wr, int wc, int fr, int fq) const {
        const int row0 = u.pm * BM + wr * 64 + fr, col0 = u.pn * BM + wc * 32 + 8 * fq;
        const bool act = (silu_mask >> u.pn) & 1u;
#pragma unroll
        for (int ai = 0; ai < 2; ++ai)
#pragma unroll
            for (int m = 0; m < 4; ++m) { bf16_t* rowp = O + (size_t)(row0 + ai * HALF + m * 16) * ldc + col0;
#pragma unroll
                for (int bj = 0; bj < 2; ++bj) { f32x4 v0 = acc[ai][bj][m][0], v1 = acc[ai][bj][m][1];
                    if (act) {
#pragma unroll
                        for (int j = 0; j < 4; ++j) { v0[j] = silu1(v0[j]); v1[j] = silu1(v1[j]); } }
                    u32x4 w; w.x = pk_bf16(v0[0], v0[1]); w.y = pk_bf16(v0[2], v0[3]); w.z = pk_bf16(v1[0], v1[1]); w.w = pk_bf16(v1[2], v1[3]);
                    *(u32x4*)(rowp + bj * HALF) = w; } }
    }
};
struct EpiResid {
    static constexpr bool PERM = false, AFTER_DRAIN = false;
    float* C; const float* X; const float* mod_g;
    static constexpr int NTOK_ = 32768;
    float alpha; bf16_t* AP; const float* avec; float* stat;
    __device__ __forceinline__ void operator()(const f32x4 (&acc)[2][2][4][2], const Unit& u, int wr, int wc, int fr, int fq) const {
        const int row0 = u.pm * BM + wr * 64 + fr, col0 = u.pn * BM + wc * 32 + 4 * fq, bat = (u.pm * BM) / 2048;
        const float* gb = mod_g + (size_t)bat * 6144 + col0;
        const float* ab = avec + (size_t)bat * 1024 + col0;
        f32x4 gv[2][2], av[2][2];
#pragma unroll
        for (int bj = 0; bj < 2; ++bj)
#pragma unroll
            for (int n = 0; n < 2; ++n) { gv[bj][n] = *(const f32x4*)(gb + bj * HALF + n * 16) + 1.0f; av[bj][n] = *(const f32x4*)(ab + bj * HALF + n * 16); }
#pragma unroll
        for (int ai = 0; ai < 2; ++ai) {
            float s1[4], s2[4];
#pragma unroll
            for (int m = 0; m < 4; ++m) { const int row = row0 + ai * HALF + m * 16; const size_t ro = (size_t)row * 1024 + col0;
                s1[m] = 0.f; s2[m] = 0.f;
#pragma unroll
                for (int bj = 0; bj < 2; ++bj)
#pragma unroll
                    for (int n = 0; n < 2; ++n) {
                        const f32x4 xv = *(const f32x4*)(X + ro + bj * HALF + n * 16);
                        const f32x4 r1 = alpha * xv + gv[bj][n] * acc[ai][bj][m][n];
                        *(f32x4*)(C + ro + bj * HALF + n * 16) = r1;
                        const f32x4 ap = r1 * av[bj][n];
                        *(uint2*)(AP + ro + bj * HALF + n * 16) = make_uint2(pk_bf16(ap[0], ap[1]), pk_bf16(ap[2], ap[3]));
                        s1[m] += (r1[0] + r1[1]) + (r1[2] + r1[3]); s2[m] += (r1[0] * r1[0] + r1[1] * r1[1]) + (r1[2] * r1[2] + r1[3] * r1[3]);
                    }
            }
            const bool hi5 = fq & 2, hi4 = fq & 1;
            const float a1 = (hi5 ? s1[2] : s1[0]) + __shfl_xor(hi5 ? s1[0] : s1[2], 32), b1 = (hi5 ? s1[3] : s1[1]) + __shfl_xor(hi5 ? s1[1] : s1[3], 32);
            const float a2 = (hi5 ? s2[2] : s2[0]) + __shfl_xor(hi5 ? s2[0] : s2[2], 32), b2 = (hi5 ? s2[3] : s2[1]) + __shfl_xor(hi5 ? s2[1] : s2[3], 32);
            const float t1 = (hi4 ? b1 : a1) + __shfl_xor(hi4 ? a1 : b1, 16), t2 = (hi4 ? b2 : a2) + __shfl_xor(hi4 ? a2 : b2, 16);
            const int srow = u.pm * BM + wr * 64 + ai * HALF + fq * 16 + fr;
            atomicAdd(stat + srow, t1); atomicAdd(stat + NTOK_ + srow, t2);
        }
    }
};
struct EpiQLN {
    static constexpr bool PERM = true, AFTER_DRAIN = false;
    bf16_t* O; const float* stat; const float* ca; const float* cb; float eps;
    __device__ __forceinline__ void operator()(const f32x4 (&acc)[2][2][4][2], const Unit& u, int wr, int wc, int fr, int fq) const {
        const int row0 = u.pm * BM + wr * 64 + fr, col0 = u.pn * BM + wc * 32 + 8 * fq, bat = (u.pm * BM) / 2048;
        const float* cap = ca + (size_t)bat * 2048 + col0;
        const float* cbp = cb + (size_t)bat * 2048 + col0;
#pragma unroll
        for (int bj = 0; bj < 2; ++bj) {
            const f32x4 a0 = *(const f32x4*)(cap + bj * HALF), a1 = *(const f32x4*)(cap + bj * HALF + 4), b0 = *(const f32x4*)(cbp + bj * HALF), b1 = *(const f32x4*)(cbp + bj * HALF + 4);
#pragma unroll
            for (int ai = 0; ai < 2; ++ai)
#pragma unroll
                for (int m = 0; m < 4; ++m) {
                    const int row = row0 + ai * HALF + m * 16;
                    const float mu = stat[row] * (1.0f / 1024.0f), rstd = rsqrtf(fmaxf(stat[32768 + row] * (1.0f / 1024.0f) - mu * mu, 0.f) + eps);
                    const f32x4 v0 = rstd * (acc[ai][bj][m][0] - mu * a0) + b0, v1 = rstd * (acc[ai][bj][m][1] - mu * a1) + b1;
                    u32x4 w; w.x = pk_bf16(v0[0], v0[1]); w.y = pk_bf16(v0[2], v0[3]); w.z = pk_bf16(v1[0], v1[1]); w.w = pk_bf16(v1[2], v1[3]);
                    *(u32x4*)(O + (size_t)row * 2048 + col0 + bj * HALF) = w;
                }
        }
    }
};
struct EpiGlu {
    static constexpr bool PERM = false, AFTER_DRAIN = false;
    float* C; const bf16_t* Y; const float* bias;
    __device__ __forceinline__ void operator()(const f32x4 (&acc)[2][2][4][2], const Unit& u, int wr, int wc, int fr, int fq) const {
        const int row0 = u.pm * BM + wr * 64 + fr, col0 = u.pn * BM + wc * 32 + 4 * fq;
        f32x4 bv[2][2];
#pragma unroll
        for (int bj = 0; bj < 2; ++bj)
#pragma unroll
            for (int n = 0; n < 2; ++n) bv[bj][n] = *(const f32x4*)(bias + col0 + bj * HALF + n * 16);
#pragma unroll
        for (int ai = 0; ai < 2; ++ai)
#pragma unroll
            for (int m = 0; m < 4; ++m) { const size_t ro = (size_t)(row0 + ai * HALF + m * 16) * 512 + col0;
#pragma unroll
                for (int bj = 0; bj < 2; ++bj)
#pragma unroll
                    for (int n = 0; n < 2; ++n) {
                        const uint2 yw = *(const uint2*)(Y + ro + bj * HALF + n * 16);
                        const f32x4 z = acc[ai][bj][m][n] + bv[bj][n];
                        f32x4 o;
                        o[0] = __uint_as_float(yw.x << 16) * __builtin_amdgcn_rcpf(1.0f + __expf(-z[0])); o[1] = __uint_as_float(yw.x & 0xffff0000u) * __builtin_amdgcn_rcpf(1.0f + __expf(-z[1]));
                        o[2] = __uint_as_float(yw.y << 16) * __builtin_amdgcn_rcpf(1.0f + __expf(-z[2])); o[3] = __uint_as_float(yw.y & 0xffff0000u) * __builtin_amdgcn_rcpf(1.0f + __expf(-z[3]));
                        *(f32x4*)(C + ro + bj * HALF + n * 16) = o; } }
    }
};
}

DI void prep_mod_item(const Params& p, int item, char* smem) {
    float* condT = (float*)smem;
    float* red = condT + DM * 16;
    const int tid = my_tid();
    for (int i = tid; i < NB * DM; i += NTH) { const int b = i >> 10, k = i & 1023; condT[k * 16 + b] = siluf_(p.c[i]); }
    __syncthreads();
    const int ks = tid >> 5, col = tid & 31;
    float acc[16];
#pragma unroll
    for (int b = 0; b < 16; ++b) acc[b] = 0.f;
    const float* w = p.ada_w + (size_t)(ks * 64) * 6144 + item * 32 + col;
#pragma unroll 1
    for (int seg = 0; seg < 4; ++seg) {
        float wreg[16];
#pragma unroll
        for (int k = 0; k < 16; ++k) wreg[k] = w[(size_t)(seg * 16 + k) * 6144];
#pragma unroll
        for (int k = 0; k < 16; ++k) {
            const float wv = wreg[k];
            const f32x4* cb = (const f32x4*)(condT + (ks * 64 + seg * 16 + k) * 16);
            const f32x4 c0 = cb[0], c1 = cb[1], c2 = cb[2], c3 = cb[3];
            acc[0] += c0.x * wv; acc[1] += c0.y * wv; acc[2] += c0.z * wv; acc[3] += c0.w * wv;
            acc[4] += c1.x * wv; acc[5] += c1.y * wv; acc[6] += c1.z * wv; acc[7] += c1.w * wv;
            acc[8] += c2.x * wv; acc[9] += c2.y * wv; acc[10] += c2.z * wv; acc[11] += c2.w * wv;
            acc[12] += c3.x * wv; acc[13] += c3.y * wv; acc[14] += c3.z * wv; acc[15] += c3.w * wv;
        }
    }
#pragma unroll
    for (int b = 0; b < 16; ++b) red[(ks * 32 + col) * 16 + b] = acc[b];
    __syncthreads();
    {
        const int b = tid >> 5;
        float sum = p.ada_b[item * 32 + col];
#pragma unroll
        for (int q = 0; q < 16; ++q) sum += red[(q * 32 + col) * 16 + b];
        ((float*)(p.ws + OFF_MOD))[b * 6144 + item * 32 + col] = sum;
    }
    __syncthreads();
}
DI void prep_s5_gemm_item(const Params& p, int g, int part, char* smem) {
    f32x2* pw = (f32x2*)smem;
    f32x2* bbL = pw + 17 * 64;
    f32x2* cL = bbL + 64 * 16;
    const int tid = my_tid();
    const float dt = expf(p.log_dt[g]);
#pragma unroll 1
    for (int idx = tid; idx < 17 * 64; idx += NTH) {
        const int j = idx >> 6, pp = idx & 63;
        const float ar = p.a_re[g * 64 + pp], ai = p.a_im[g * 64 + pp];
        const float mag = expf(ar * dt * (float)j), ang = ai * dt * (float)j;
        pw[idx] = (f32x2){mag * cosf(ang), mag * sinf(ang)};
    }
    for (int idx = tid; idx < 16 * 64; idx += NTH) { const int i = idx >> 6, pp = idx & 63; cL[idx] = (f32x2){p.c_re[(g * 16 + i) * 64 + pp], p.c_im[(g * 16 + i) * 64 + pp]}; }
    __syncthreads();
    for (int idx = tid; idx < 64 * 16; idx += NTH) {
        const int pp = idx >> 4, i = idx & 15;
        const float ar = p.a_re[g * 64 + pp], ai = p.a_im[g * 64 + pp];
        const f32x2 lam = pw[64 + pp];
        const float den = ar * ar + ai * ai, nr = lam.x - 1.0f, ni = lam.y;
        const float zr = (nr * ar + ni * ai) / den, zi = (ni * ar - nr * ai) / den;
        const float br = p.b_re[(g * 64 + pp) * 16 + i], bi = p.b_im[(g * 64 + pp) * 16 + i];
        bbL[idx] = (f32x2){zr * br - zi * bi, zr * bi + zi * br};
    }
    __syncthreads();
    bf16_t* NBg = (bf16_t*)(p.ws + OFF_S5N) + (size_t)g * 128 * 256;
    if (part == 0)
#pragma unroll 1
    for (int ch = tid; ch < 128 * 256 / 8; ch += NTH) {
        const int pq = ch >> 5, t = (ch >> 1) & 15, i0 = (ch & 1) * 8, pp = pq & 63;
        const f32x2 w = pw[(15 - t) * 64 + pp];
        float v[8];
#pragma unroll
        for (int e = 0; e < 8; ++e) { const f32x2 bb = bbL[pp * 16 + i0 + e]; v[e] = pq < 64 ? (w.x * bb.x - w.y * bb.y) : (w.x * bb.y + w.y * bb.x); }
        u32x4 o; o.x = pack2(v[0], v[1]); o.y = pack2(v[2], v[3]); o.z = pack2(v[4], v[5]); o.w = pack2(v[6], v[7]);
        *(u32x4*)(NBg + (size_t)((((pq >> 5) * 16 + t) * 64) + (i0 >> 3) * 32 + (pq & 31)) * 8) = o;
    }
    bf16_t* MBg = (bf16_t*)(p.ws + OFF_S5M) + (size_t)g * 256 * 128;
    if (part == 1)
#pragma unroll 1
    for (int ch = tid; ch < 256 * 128 / 8; ch += NTH) {
        const int ti = ch >> 4, p0 = (ch & 15) * 8, tq = ti >> 4, iq = ti & 15;
        float v[8];
#pragma unroll
        for (int e = 0; e < 8; ++e) {
            const int pq = p0 + e, pp = pq & 63;
            const f32x2 c = cL[iq * 64 + pp], w = pw[(tq + 1) * 64 + pp];
            v[e] = pq < 64 ? (c.x * w.x - c.y * w.y) : -(c.x * w.y + c.y * w.x);
        }
        u32x4 o; o.x = pack2(v[0], v[1]); o.y = pack2(v[2], v[3]); o.z = pack2(v[4], v[5]); o.w = pack2(v[6], v[7]);
        *(u32x4*)(MBg + (size_t)((((ti >> 5) * 8 + (p0 >> 4)) * 64) + ((p0 >> 3) & 1) * 32 + (ti & 31)) * 8) = o;
    }
    bf16_t* KTg = (bf16_t*)(p.ws + OFF_S5K) + (size_t)g * 4096;
    if (part >= 2)
#pragma unroll 1
    for (int idx = (part - 2) * 2048 + tid; idx < (part - 1) * 2048; idx += NTH) {
        const int lag = idx >> 8, iq = (idx >> 4) & 15, i = idx & 15;
        float acc = (lag == 0 && iq == i) ? p.dsk[g * 16 + iq] : 0.f;
#pragma unroll 4
        for (int pp = 0; pp < 64; ++pp) {
            const f32x2 c = cL[iq * 64 + pp], w = pw[lag * 64 + pp], bb = bbL[pp * 16 + i];
            const float mr = c.x * w.x - c.y * w.y, mi_ = c.x * w.y + c.y * w.x;
            acc += mr * bb.x - mi_ * bb.y;
        }
        KTg[idx] = f2bf(acc);
    }
    if (part == 3 && tid < 64) { float* L = (float*)(p.ws + OFF_S5L) + (g * 64 + tid) * 2; const f32x2 w = pw[16 * 64 + tid]; L[0] = w.x; L[1] = w.y; }
    __syncthreads();
}
DI void prep_s5_item(const Params& p, int g) {
    const int tid = my_tid();
    if (tid < SSP) {
        const int pi = g * SSP + tid;
        const float dt = expf(p.log_dt[g]);
        const float ar = p.a_re[pi], ai = p.a_im[pi];
        const float mag = expf(ar * dt);
        const float lr = mag * cosf(ai * dt), li = mag * sinf(ai * dt);
        const float den = ar * ar + ai * ai, nr = lr - 1.0f, ni = li;
        const float zr = (nr * ar + ni * ai) / den, zi = (ni * ar - nr * ai) / den;
        float* lam = (float*)(p.ws + OFF_LAM) + pi * 2;
        lam[0] = lr; lam[1] = li;
        float* bb = (float*)(p.ws + OFF_BB) + (size_t)pi * 32;
        for (int i = 0; i < SSC; ++i) {
            const float br = p.b_re[pi * SSC + i], bi = p.b_im[pi * SSC + i];
            bb[i * 2] = zr * br - zi * bi; bb[i * 2 + 1] = zr * bi + zi * br;
        }
    }
}
DI void prep_transpose_tile(const float* __restrict__ W, bf16_t* __restrict__ Wt, int K, int N, int kt, int nt, char* smem) {
    float* tile = (float*)smem;
    const int tid = my_tid();
#pragma unroll
    for (int q = 0; q < 2; ++q) {
        const int kk = (tid >> 4) + q * 32, c4 = (tid & 15) * 4;
        const float4 v = *(const float4*)(W + (size_t)(kt * 64 + kk) * N + nt * 64 + c4);
        tile[kk * 65 + c4] = v.x; tile[kk * 65 + c4 + 1] = v.y; tile[kk * 65 + c4 + 2] = v.z; tile[kk * 65 + c4 + 3] = v.w;
    }
    __syncthreads();
    const int n = tid >> 3, kc = tid & 7;
    uint4 o;
    o.x = pack2(tile[(kc * 8 + 0) * 65 + n], tile[(kc * 8 + 1) * 65 + n]);
    o.y = pack2(tile[(kc * 8 + 2) * 65 + n], tile[(kc * 8 + 3) * 65 + n]);
    o.z = pack2(tile[(kc * 8 + 4) * 65 + n], tile[(kc * 8 + 5) * 65 + n]);
    o.w = pack2(tile[(kc * 8 + 6) * 65 + n], tile[(kc * 8 + 7) * 65 + n]);
    *(uint4*)(Wt + (size_t)(nt * 64 + n) * K + kt * 64 + kc * 8) = o;
    __syncthreads();
}
DI void cvt_bf16_stream(const float* __restrict__ src, bf16_t* __restrict__ dst, size_t n8, int bid, int nb) {
    for (size_t i = (size_t)bid * NTH + my_tid(); i < n8; i += (size_t)nb * NTH) {
        const float4 a = *(const float4*)(src + i * 8), b = *(const float4*)(src + i * 8 + 4);
        uint4 o; o.x = pack2(a.x, a.y); o.y = pack2(a.z, a.w); o.z = pack2(b.x, b.y); o.w = pack2(b.z, b.w);
        *(uint4*)(dst + i * 8) = o;
    }
}
DI void cvt_fp8_rows(const float* __restrict__ src, unsigned char* __restrict__ dst, float* __restrict__ inv, int bid, int nb) {
    const int lane = my_tid() & 63, wid = my_tid() >> 6;
    for (int row = bid * 8 + wid; row < NEXP; row += nb * 8) {
        const float* sp = src + (size_t)row * DM + lane * 16;
        const f32x4 a = *(const f32x4*)sp, b = *(const f32x4*)(sp + 4), c = *(const f32x4*)(sp + 8), d = *(const f32x4*)(sp + 12);
        float m = fmaxf(fmaxf(fmaxf(fabsf(a.x), fabsf(a.y)), fmaxf(fabsf(a.z), fabsf(a.w))), fmaxf(fmaxf(fabsf(b.x), fabsf(b.y)), fmaxf(fabsf(b.z), fabsf(b.w))));
        m = fmaxf(m, fmaxf(fmaxf(fmaxf(fabsf(c.x), fabsf(c.y)), fmaxf(fabsf(c.z), fabsf(c.w))), fmaxf(fmaxf(fabsf(d.x), fabsf(d.y)), fmaxf(fabsf(d.z), fabsf(d.w)))));
#pragma unroll
        for (int s = 1; s < 64; s <<= 1) m = fmaxf(m, __shfl_xor(m, s));
        float sc = 1.f, isc = 1.f;
        if (m > 1e-30f) {
            int k = (int)floorf(log2f(448.0f / m));
            k = k < -60 ? -60 : (k > 60 ? 60 : k);
            sc = ldexpf(1.0f, k); isc = ldexpf(1.0f, -k);
            if (m * sc > 448.0f) { sc *= 0.5f; isc *= 2.0f; }
        }
        u32x4 o;
        int w;
        w = __builtin_amdgcn_cvt_pk_fp8_f32(a.x * sc, a.y * sc, 0, false); w = __builtin_amdgcn_cvt_pk_fp8_f32(a.z * sc, a.w * sc, w, true); o.x = (unsigned)w;
        w = __builtin_amdgcn_cvt_pk_fp8_f32(b.x * sc, b.y * sc, 0, false); w = __builtin_amdgcn_cvt_pk_fp8_f32(b.z * sc, b.w * sc, w, true); o.y = (unsigned)w;
        w = __builtin_amdgcn_cvt_pk_fp8_f32(c.x * sc, c.y * sc, 0, false); w = __builtin_amdgcn_cvt_pk_fp8_f32(c.z * sc, c.w * sc, w, true); o.z = (unsigned)w;
        w = __builtin_amdgcn_cvt_pk_fp8_f32(d.x * sc, d.y * sc, 0, false); w = __builtin_amdgcn_cvt_pk_fp8_f32(d.z * sc, d.w * sc, w, true); o.w = (unsigned)w;
        *(u32x4*)(dst + (size_t)row * DM + lane * 16) = o;
        if (lane == 0) inv[row] = isc;
    }
}
DI void cvt_fp4_rows(const float* __restrict__ src, unsigned char* __restrict__ dst, float* __restrict__ inv, int bid, int nb) {
    const int lane = my_tid() & 63, wid = my_tid() >> 6;
    for (int row = bid * 8 + wid; row < NEXP; row += nb * 8) {
        const float* sp = src + (size_t)row * DM + lane * 16;
        const f32x4 a = *(const f32x4*)sp, b = *(const f32x4*)(sp + 4), c = *(const f32x4*)(sp + 8), d = *(const f32x4*)(sp + 12);
        float m = fmaxf(fmaxf(fmaxf(fabsf(a.x), fabsf(a.y)), fmaxf(fabsf(a.z), fabsf(a.w))), fmaxf(fmaxf(fabsf(b.x), fabsf(b.y)), fmaxf(fabsf(b.z), fabsf(b.w))));
        m = fmaxf(m, fmaxf(fmaxf(fmaxf(fabsf(c.x), fabsf(c.y)), fmaxf(fabsf(c.z), fabsf(c.w))), fmaxf(fmaxf(fabsf(d.x), fabsf(d.y)), fmaxf(fabsf(d.z), fabsf(d.w)))));
#pragma unroll
        for (int s = 1; s < 64; s <<= 1) m = fmaxf(m, __shfl_xor(m, s));
        const float sc = m > 1e-30f ? 6.0f / m : 1.0f, isc = m > 1e-30f ? m * (1.0f / 6.0f) : 1.0f;
        unsigned w0 = 0u, w1 = 0u;
        w0 = __builtin_amdgcn_cvt_scalef32_pk_fp4_f32(w0, a.x * sc, a.y * sc, 1.0f, 0); w0 = __builtin_amdgcn_cvt_scalef32_pk_fp4_f32(w0, a.z * sc, a.w * sc, 1.0f, 1);
        w0 = __builtin_amdgcn_cvt_scalef32_pk_fp4_f32(w0, b.x * sc, b.y * sc, 1.0f, 2); w0 = __builtin_amdgcn_cvt_scalef32_pk_fp4_f32(w0, b.z * sc, b.w * sc, 1.0f, 3);
        w1 = __builtin_amdgcn_cvt_scalef32_pk_fp4_f32(w1, c.x * sc, c.y * sc, 1.0f, 0); w1 = __builtin_amdgcn_cvt_scalef32_pk_fp4_f32(w1, c.z * sc, c.w * sc, 1.0f, 1);
        w1 = __builtin_amdgcn_cvt_scalef32_pk_fp4_f32(w1, d.x * sc, d.y * sc, 1.0f, 2); w1 = __builtin_amdgcn_cvt_scalef32_pk_fp4_f32(w1, d.z * sc, d.w * sc, 1.0f, 3);
        *(uint2*)(dst + (size_t)row * (DM / 2) + lane * 8) = make_uint2(w0, w1);
        if (lane == 0) inv[row] = isc;
    }
}
template <int OFFS>
DI void cvt_i8_rows(const float* __restrict__ src, unsigned char* __restrict__ dst, float* __restrict__ inv, int bid, int nb) {
    const int lane = my_tid() & 63, wid = my_tid() >> 6;
    for (int row = bid * 8 + wid; row < NEXP; row += nb * 8) {
        const float* sp = src + (size_t)row * DM + lane * 16;
        const f32x4 a = *(const f32x4*)sp, b = *(const f32x4*)(sp + 4), c = *(const f32x4*)(sp + 8), d = *(const f32x4*)(sp + 12);
        float m = fmaxf(fmaxf(fmaxf(fabsf(a.x), fabsf(a.y)), fmaxf(fabsf(a.z), fabsf(a.w))), fmaxf(fmaxf(fabsf(b.x), fabsf(b.y)), fmaxf(fabsf(b.z), fabsf(b.w))));
        m = fmaxf(m, fmaxf(fmaxf(fmaxf(fabsf(c.x), fabsf(c.y)), fmaxf(fabsf(c.z), fabsf(c.w))), fmaxf(fmaxf(fabsf(d.x), fabsf(d.y)), fmaxf(fabsf(d.z), fabsf(d.w)))));
#pragma unroll
        for (int s = 1; s < 64; s <<= 1) m = fmaxf(m, __shfl_xor(m, s));
        const float sc = m > 1e-30f ? 127.0f / m : 1.0f, isc = m > 1e-30f ? m * (1.0f / 127.0f) : 1.0f;
        const float v[16] = {a.x, a.y, a.z, a.w, b.x, b.y, b.z, b.w, c.x, c.y, c.z, c.w, d.x, d.y, d.z, d.w};
        unsigned w[4];
#pragma unroll
        for (int q = 0; q < 4; ++q) {
            unsigned pk = 0u;
#pragma unroll
            for (int e = 0; e < 4; ++e) { const int qi = (int)rintf(v[q * 4 + e] * sc) + OFFS; pk |= ((unsigned)qi & 0xffu) << (8 * e); }
            w[q] = pk;
        }
        *(u32x4*)(dst + (size_t)row * DM + lane * 16) = (u32x4){w[0], w[1], w[2], w[3]};
        if (lane == 0) inv[row] = isc;
    }
}
DI void prep_cab_item(const Params& p, int item, char* smem) {
    float* vT = (float*)smem;
    float* red = vT + DM * 16;
    const float* mod = (const float*)(p.ws + OFF_MOD);
    const int tid = my_tid(), ks = tid >> 5, col = tid & 31;
    const float* w = p.w_q + (size_t)(ks * 64) * 2048 + item * 32 + col;
#pragma unroll 1
    for (int which = 0; which < 2; ++which) {
        for (int i = tid; i < NB * DM; i += NTH) {
            const int b = i >> 10, k = i & 1023;
            const float sc = 1.0f + mod[b * 6144 + 4096 + k];
            const float v = which == 0 ? p.ln1w[k] * sc : p.ln1b[k] * sc + mod[b * 6144 + 3072 + k];
            vT[k * 16 + b] = v;
            if (item == 0) ((float*)(p.ws + OFF_AB))[(size_t)which * NB * DM + i] = v;
        }
        __syncthreads();
        float acc[16];
#pragma unroll
        for (int b = 0; b < 16; ++b) acc[b] = 0.f;
#pragma unroll 1
        for (int seg = 0; seg < 4; ++seg) {
            float wreg[16];
#pragma unroll
            for (int k = 0; k < 16; ++k) wreg[k] = w[(size_t)(seg * 16 + k) * 2048];
#pragma unroll
            for (int k = 0; k < 16; ++k) {
                const float wv = wreg[k];
                const f32x4* cb = (const f32x4*)(vT + (ks * 64 + seg * 16 + k) * 16);
                const f32x4 c0 = cb[0], c1 = cb[1], c2 = cb[2], c3 = cb[3];
                acc[0] += c0.x * wv; acc[1] += c0.y * wv; acc[2] += c0.z * wv; acc[3] += c0.w * wv;
                acc[4] += c1.x * wv; acc[5] += c1.y * wv; acc[6] += c1.z * wv; acc[7] += c1.w * wv;
                acc[8] += c2.x * wv; acc[9] += c2.y * wv; acc[10] += c2.z * wv; acc[11] += c2.w * wv;
                acc[12] += c3.x * wv; acc[13] += c3.y * wv; acc[14] += c3.z * wv; acc[15] += c3.w * wv;
            }
        }
#pragma unroll
        for (int b = 0; b < 16; ++b) red[(ks * 32 + col) * 16 + b] = acc[b];
        __syncthreads();
        {
            const int b = tid >> 5;
            float sum = 0.f;
#pragma unroll
            for (int q = 0; q < 16; ++q) sum += red[(q * 32 + col) * 16 + b];
            ((float*)(p.ws + OFF_CAB))[(size_t)which * NB * 2048 + b * 2048 + item * 32 + col] = sum;
        }
        __syncthreads();
    }
}
DI void phase_h(const Params& p, int bid, int nb) {
    const float* mod = (const float*)(p.ws + OFF_MOD);
    bf16_t* H = (bf16_t*)(p.ws + OFF_H);
    const size_t n8 = (size_t)NTOK * DM / 8;
    for (size_t i = (size_t)bid * NTH + my_tid(); i < n8; i += (size_t)nb * NTH) {
        const int row = (int)(i >> 7), c0 = (int)(i & 127) * 8, b = row / SEQ;
        const float* sh = mod + b * 6144 + c0;
        const float* sc = sh + 1024;
        const float4 a = *(const float4*)(p.x + i * 8), bq = *(const float4*)(p.x + i * 8 + 4);
        const float4 s0 = *(const float4*)sc, s1 = *(const float4*)(sc + 4), h0 = *(const float4*)sh, h1 = *(const float4*)(sh + 4);
        uint4 o;
        o.x = pack2(a.x * (1.f + s0.x) + h0.x, a.y * (1.f + s0.y) + h0.y);
        o.y = pack2(a.z * (1.f + s0.z) + h0.z, a.w * (1.f + s0.w) + h0.w);
        o.z = pack2(bq.x * (1.f + s1.x) + h1.x, bq.y * (1.f + s1.y) + h1.y);
        o.w = pack2(bq.z * (1.f + s1.z) + h1.z, bq.w * (1.f + s1.w) + h1.w);
        *(uint4*)(H + i * 8) = o;
    }
}

DI int wq_next(unsigned* ctr, char* smem) {
    volatile unsigned* slot = (volatile unsigned*)(smem + SMEM_BYTES - 8);
    __syncthreads();
    if (__builtin_amdgcn_workitem_id_x() == 0) *slot = __hip_atomic_fetch_add(ctr, 1u, __ATOMIC_RELAXED, __HIP_MEMORY_SCOPE_AGENT);
    __syncthreads();
    return (int)*slot;
}
DI void phase_prep_a(const Params& p, char* smem) {
    unsigned* ctr = (unsigned*)(p.ws + OFF_BAR) + 120;
    constexpr int U_S5 = 192, U_LB = 320, U_TR = 321, U_UT = U_TR + 368, U_VT = U_UT + 128, U_MISC = U_VT + 128, U_END = U_MISC + 8;
    for (int u = wq_next(ctr, smem); u < U_END; u = wq_next(ctr, smem)) {
        if (u < U_S5) prep_mod_item(p, u, smem);
        else if (u < U_LB) prep_s5_gemm_item(p, (u - U_S5) >> 2, (u - U_S5) & 3, smem);
        else if (u < U_TR) {
            const int j = my_tid();
            const float a0 = p.hg_lb[j], a1 = p.hg_lb[512 + j], m = fmaxf(a0, a1);
            const float e0 = expf(a0 - m), e1 = expf(a1 - m);
            ((float*)(p.ws + OFF_LB))[j] = e0 / (e0 + e1);
        } else if (u < U_UT) {
            for (int it = (u - U_TR) * 4; it < (u - U_TR) * 4 + 4; ++it) {
                constexpr int T_WIN = 16 * 40, T_GLU = 8 * 8, T_WOUT = 16 * 16;
                constexpr int I_GLU = T_WIN, I_WOUT = I_GLU + T_GLU, I_WQ = I_WOUT + T_WOUT;
                if (it < I_GLU) { const int t = it; prep_transpose_tile(p.w_in, (bf16_t*)(p.ws + OFF_WIN), DM, INC, t / 40, t % 40, smem); }
                else if (it < I_WOUT) { const int t = it - I_GLU; prep_transpose_tile(p.glu_w, (bf16_t*)(p.ws + OFF_GLU), 512, 512, t / 8, t % 8, smem); }
                else if (it < I_WQ) { const int t = it - I_WOUT; prep_transpose_tile(p.w_out, (bf16_t*)(p.ws + OFF_WOUT), DM, DM, t / 16, t % 16, smem); }
                else { const int t = it - I_WQ; prep_transpose_tile(p.w_q, (bf16_t*)(p.ws + OFF_WQ), DM, 2048, t / 32, t % 32, smem); }
            }
        } else if (u < U_VT) cvt_i8_rows<0>(p.pu, (unsigned char*)(p.ws + OFF_UT), (float*)(p.ws + OFF_SU), u - U_UT, 128);
        else if (u < U_MISC) cvt_i8_rows<128>(p.pv, (unsigned char*)(p.ws + OFF_VT), (float*)(p.ws + OFF_SV), u - U_VT, 128);
        else {
            const int q = u - U_MISC;
            cvt_bf16_stream(p.subk, (bf16_t*)(p.ws + OFF_SUBK), (size_t)16 * 128 * 128 / 8, q, 8);
            for (size_t i = (size_t)q * NTH + my_tid(); i < (size_t)NTOK * 2 / 4; i += (size_t)8 * NTH) ((f32x4*)(p.ws + OFF_STAT))[i] = (f32x4){0.f, 0.f, 0.f, 0.f};
        }
    }
}
DI void phase_prep_b(const Params& p, char* smem) {
    unsigned* ctr = (unsigned*)(p.ws + OFF_BAR) + 121;
    for (int u = wq_next(ctr, smem); u < 64 + 256; u = wq_next(ctr, smem)) {
        if (u < 64) prep_cab_item(p, u, smem); else phase_h(p, u - 64, 256);
    }
}

DI void phase_proj(const Params& p, int bid, int nb, char* smem) {
    pg8::Gemm g{(const bf16_t*)(p.ws + OFF_H), (const bf16_t*)(p.ws + OFF_WIN), NTOK, INC, DM};
    pg8::StaticOrder S; S.init(NTOK, INC, nb, bid);
    pg8::EpiBf16Act E{(bf16_t*)(p.ws + OFF_PROJ), INC, 0xC3u};
    pg8::gemm_phase<pg8::EpiBf16Act, pg8::StaticOrder, false>((PG8_LAS unsigned char*)smem, g, S, E, nullptr);
}

DI void hgrn_item(const Params& p, int item, char* smem) {
    const int vs = item & 7, hd = (item >> 3) & 3, b = item >> 5;
    const bf16_t* P = (const bf16_t*)(p.ws + OFF_PROJ);
    const float* lb = (const float*)(p.ws + OFF_LB) + hd * HDK;
    float* ORAW = (float*)(p.ws + OFF_ORAW);
    float* sq = (float*)smem;
    float* sf = sq + 32 * 128;
    float* sv = sf + 32 * 128;
    float* sp = sv + 32 * 16;
    const int tid = my_tid(), lane = tid & 63, wid = tid >> 6, kq = tid >> 4, v = tid & 15;
    float S0 = 0.f, S1 = 0.f, S2 = 0.f, S3 = 0.f;
    for (int t0 = 0; t0 < SEQ; t0 += 32) {
        for (int i = tid; i < 32 * 128; i += NTH) {
            const int t = i >> 7, k = i & 127;
            const bf16_t* row = P + (size_t)(b * SEQ + t0 + t) * INC + hd * HDK + k;
            sq[i] = bf2f(row[0]);
            const float l = lb[k];
            sf[i] = l + (1.0f - l) * sigmoidf_(bf2f(row[512]));
        }
        { const int t = tid >> 4; sv[tid] = bf2f(P[(size_t)(b * SEQ + t0 + t) * INC + 1024 + hd * HDK + vs * 16 + v]); }
        __syncthreads();
        for (int t = 0; t < 32; ++t) {
            const float4 f4 = *(const float4*)(sf + t * 128 + kq * 4), q4 = *(const float4*)(sq + t * 128 + kq * 4);
            const float vv = sv[t * 16 + v];
            S0 = f4.x * S0 + (1.0f - f4.x) * vv; S1 = f4.y * S1 + (1.0f - f4.y) * vv;
            S2 = f4.z * S2 + (1.0f - f4.z) * vv; S3 = f4.w * S3 + (1.0f - f4.w) * vv;
            float part = q4.x * S0 + q4.y * S1 + q4.z * S2 + q4.w * S3;
            part += __shfl_xor(part, 16); part += __shfl_xor(part, 32);
            if (lane < 16) sp[(t * 8 + wid) * 16 + v] = part;
        }
        __syncthreads();
        {
            const int t = tid >> 4;
            float o = 0.f;
#pragma unroll
            for (int w = 0; w < 8; ++w) o += sp[(t * 8 + w) * 16 + v];
            ORAW[(size_t)(b * SEQ + t0 + t) * DHG + hd * HDK + vs * 16 + v] = o;
        }
        __syncthreads();
    }
}
DI void s5_item(const Params& p, int item, char* smem) {
    const int oct = item & 3, b = item >> 2;
    const int tid = my_tid(), lane = tid & 63, wid = tid >> 6, g = oct * 8 + wid;
    const bf16_t* P = (const bf16_t*)(p.ws + OFF_PROJ);
    bf16_t* Y = (bf16_t*)(p.ws + OFF_YSSM);
    float* su = (float*)smem + wid * 64 * 16;
    const float* lam = (const float*)(p.ws + OFF_LAM) + (g * SSP + lane) * 2;
    const float lr = lam[0], li = lam[1];
    const float* bb = (const float*)(p.ws + OFF_BB) + (size_t)(g * SSP + lane) * 32;
    float bbr[16], bbi[16], cr[16], ci[16];
#pragma unroll
    for (int i = 0; i < 16; ++i) { bbr[i] = bb[2 * i]; bbi[i] = bb[2 * i + 1]; cr[i] = p.c_re[(g * SSC + i) * SSP + lane]; ci[i] = p.c_im[(g * SSC + i) * SSP + lane]; }
    const int ch = (lane >> 2) & 15;
    const float dch = p.dsk[g * SSC + ch];
    float xr = 0.f, xi = 0.f;
    for (int t0 = 0; t0 < SEQ; t0 += 64) {
        {
            const uint4* src = (const uint4*)(P + (size_t)(b * SEQ + t0 + lane) * INC + 2048 + g * SSC);
            const uint4 a = src[0], c = src[1];
            float* d = su + lane * 16;
            d[0] = bflo(a.x); d[1] = bfhi(a.x); d[2] = bflo(a.y); d[3] = bfhi(a.y); d[4] = bflo(a.z); d[5] = bfhi(a.z); d[6] = bflo(a.w); d[7] = bfhi(a.w);
            d[8] = bflo(c.x); d[9] = bfhi(c.x); d[10] = bflo(c.y); d[11] = bfhi(c.y); d[12] = bflo(c.z); d[13] = bfhi(c.z); d[14] = bflo(c.w); d[15] = bfhi(c.w);
        }
        __syncthreads();
        for (int t = 0; t < 64; ++t) {
            float u[16];
            const float4* us = (const float4*)(su + t * 16);
            const float4 u0 = us[0], u1 = us[1], u2 = us[2], u3 = us[3];
            u[0] = u0.x; u[1] = u0.y; u[2] = u0.z; u[3] = u0.w; u[4] = u1.x; u[5] = u1.y; u[6] = u1.z; u[7] = u1.w;
            u[8] = u2.x; u[9] = u2.y; u[10] = u2.z; u[11] = u2.w; u[12] = u3.x; u[13] = u3.y; u[14] = u3.z; u[15] = u3.w;
            float bur = 0.f, bui = 0.f;
#pragma unroll
            for (int i = 0; i < 16; ++i) { bur += bbr[i] * u[i]; bui += bbi[i] * u[i]; }
            const float nxr = lr * xr - li * xi + bur, nxi = lr * xi + li * xr + bui;
            xr = nxr; xi = nxi;
            float y[16];
#pragma unroll
            for (int i = 0; i < 16; ++i) y[i] = cr[i] * xr - ci[i] * xi;
            const bool b5 = lane & 32, b4 = lane & 16, b3 = lane & 8, b2 = lane & 4;
            float y8[8], y4[4], y2[2];
#pragma unroll
            for (int j = 0; j < 8; ++j) { const float keep = b5 ? y[8 + j] : y[j], send = b5 ? y[j] : y[8 + j]; y8[j] = keep + __shfl_xor(send, 32); }
#pragma unroll
            for (int j = 0; j < 4; ++j) { const float keep = b4 ? y8[4 + j] : y8[j], send = b4 ? y8[j] : y8[4 + j]; y4[j] = keep + __shfl_xor(send, 16); }
#pragma unroll
            for (int j = 0; j < 2; ++j) { const float keep = b3 ? y4[2 + j] : y4[j], send = b3 ? y4[j] : y4[2 + j]; y2[j] = keep + __shfl_xor(send, 8); }
            float y1;
            { const float keep = b2 ? y2[1] : y2[0], send = b2 ? y2[0] : y2[1]; y1 = keep + __shfl_xor(send, 4); }
            y1 += __shfl_xor(y1, 1); y1 += __shfl_xor(y1, 2);
            if ((lane & 3) == 0) {
                const float uu = su[t * 16 + ch];
                Y[(size_t)(b * SEQ + t0 + t) * DSS + g * SSC + ch] = f2bf(geluf_(y1 + dch * uu));
            }
        }
        __syncthreads();
    }
}
DI int crow(int i, int h) { return (i & 3) + 8 * (i >> 2) + 4 * h; }
DI void phase_hgprep(const Params& p, int bid, int nb) {
    const bf16_t* P = (const bf16_t*)(p.ws + OFF_PROJ);
    const float* lbp = (const float*)(p.ws + OFF_LB);
    const int tid = my_tid(), lane = tid & 63, wid = tid >> 6, tq = lane >> 4, cg = lane & 15;
#pragma unroll 1
    for (int it = bid * 8 + wid; it < 8192; it += nb * 8) {
        const int tile = it >> 1, c = tile & 63, hd = (tile >> 6) & 3, b = tile >> 8, k0 = (it & 1) * 64 + cg * 4;
        const bf16_t* base = P + (size_t)(b * SEQ + c * 32 + tq * 8) * INC + hd * HDK + k0;
        uint2 qw[8], fw[8];
#pragma unroll
        for (int tt = 0; tt < 8; ++tt) { qw[tt] = *(const uint2*)(base + (size_t)tt * INC); fw[tt] = *(const uint2*)(base + (size_t)tt * INC + 512); }
        const f32x4 l4 = *(const f32x4*)(lbp + hd * HDK + k0);
        const float lb4[4] = {l4.x, l4.y, l4.z, l4.w};
        float bl[8][4], kk[8][4], run[4];
#pragma unroll
        for (int e = 0; e < 4; ++e) run[e] = 0.f;
#pragma unroll
        for (int tt = 0; tt < 8; ++tt) {
            const float fl[4] = {bflo(fw[tt].x), bfhi(fw[tt].x), bflo(fw[tt].y), bfhi(fw[tt].y)};
#pragma unroll
            for (int e = 0; e < 4; ++e) {
                const float f = lb4[e] + (1.0f - lb4[e]) * sigmoidf_(fl[e]);
                run[e] += __logf(f); bl[tt][e] = run[e]; kk[tt][e] = 1.0f - f;
            }
        }
        float off[4], tot[4];
#pragma unroll
        for (int e = 0; e < 4; ++e) {
            const float t0 = __shfl(run[e], cg), t1 = __shfl(run[e], cg + 16), t2 = __shfl(run[e], cg + 32), t3 = __shfl(run[e], cg + 48);
            off[e] = (tq > 0 ? t0 : 0.f) + (tq > 1 ? t1 : 0.f) + (tq > 2 ? t2 : 0.f);
            tot[e] = (t0 + t1) + (t2 + t3);
        }
        bf16_t* HQ = (bf16_t*)(p.ws + OFF_HQ) + (size_t)tile * 4096 + (tq * 8) * 128 + k0;
        bf16_t* HK = (bf16_t*)(p.ws + OFF_HK) + (size_t)tile * 4096 + (tq * 8) * 128 + k0;
#pragma unroll
        for (int tt = 0; tt < 8; ++tt) {
            const float qv[4] = {bflo(qw[tt].x), bfhi(qw[tt].x), bflo(qw[tt].y), bfhi(qw[tt].y)};
            float qo[4], ko[4];
#pragma unroll
            for (int e = 0; e < 4; ++e) { const float bb = off[e] + bl[tt][e]; qo[e] = qv[e] * __expf(bb); ko[e] = kk[tt][e] * __expf(fminf(-bb, 80.0f)); }
            *(uint2*)(HQ + tt * 128) = make_uint2(pack2(qo[0], qo[1]), pack2(qo[2], qo[3]));
            *(uint2*)(HK + tt * 128) = make_uint2(pack2(ko[0], ko[1]), pack2(ko[2], ko[3]));
        }
        if (tq == 0) *(f32x4*)((float*)(p.ws + OFF_HG) + (size_t)tile * 128 + k0) = (f32x4){__expf(tot[0]), __expf(tot[1]), __expf(tot[2]), __expf(tot[3])};
    }
}
typedef short s16x4 __attribute__((ext_vector_type(4)));
DI bf16x8 cat8(const s16x4 lo, const s16x4 hi) { return (bf16x8){lo.x, lo.y, lo.z, lo.w, hi.x, hi.y, hi.z, hi.w}; }
DI s16x4 lds_tr(const char* a) { return __builtin_amdgcn_ds_read_tr16_b64_v4i16((__attribute__((address_space(3))) s16x4*)a); }
DI void hgrn_mfma_item(const Params& p, int item, char* smem) {
    constexpr int QP_OFF = 0, KP_OFF = 8704, V_OFF = 17408, G_OFF = 26112, BUF = 26624, OB_OFF = 3 * BUF, OB_STRIDE = 132, OB_BYTES = 32 * OB_STRIDE * 4;
    const int tid = my_tid(), lane = tid & 63, wid = tid >> 6, r = lane & 31, h = lane >> 5;
    const int b = item >> 2, hd = item & 3;
    const size_t tile0 = (size_t)item * 64;
    const bf16_t* HQ = (const bf16_t*)(p.ws + OFF_HQ) + tile0 * 4096;
    const bf16_t* HK = (const bf16_t*)(p.ws + OFF_HK) + tile0 * 4096;
    const bf16_t* PV = (const bf16_t*)(p.ws + OFF_PROJ) + (size_t)b * SEQ * INC + 1024 + hd * HDK;
    const float* HG = (const float*)(p.ws + OFF_HG) + tile0 * 128;
    bf16_t* A2out = (bf16_t*)(p.ws + OFF_A2) + (size_t)b * SEQ * DM + hd * HDK;
    const bf16_t* PG = (const bf16_t*)(p.ws + OFF_PROJ) + (size_t)b * SEQ * INC + 1536 + hd * HDK;
    const bool helper = wid >= 4;
    const int ht = tid - 256;
    const int i0 = ht, i1 = ht + 256;
    const int lo0 = (i0 >> 4) * 272 + (i0 & 15) * 16, lo1 = (i1 >> 4) * 272 + (i1 & 15) * 16;
    u32x4 A0, A1, A2, A3, A4, A5, A6, B0, B1, B2, B3, B4, B5, B6;
    A0 = A1 = A2 = A3 = A4 = A5 = A6 = B0 = B1 = B2 = B3 = B4 = B5 = B6 = (u32x4){0, 0, 0, 0};
    f32x16 S[4];
#pragma unroll
    for (int kb = 0; kb < 4; ++kb)
#pragma unroll
        for (int i = 0; i < 16; ++i) S[kb][i] = 0.f;
#define HG_LOAD(X, c_) { const size_t o_ = (size_t)(c_) * 4096; \
        X##0 = *(const u32x4*)(HQ + o_ + i0 * 8); X##1 = *(const u32x4*)(HQ + o_ + i1 * 8); \
        X##2 = *(const u32x4*)(HK + o_ + i0 * 8); X##3 = *(const u32x4*)(HK + o_ + i1 * 8); \
        X##4 = *(const u32x4*)(PV + (size_t)((c_) * 32 + (i0 >> 4)) * INC + (i0 & 15) * 8); X##5 = *(const u32x4*)(PV + (size_t)((c_) * 32 + (i1 >> 4)) * INC + (i1 & 15) * 8); \
        if (ht < 32) X##6 = *(const u32x4*)(HG + (size_t)(c_) * 128 + ht * 4); }
#define HG_STORE(X, buf_) { char* B_ = smem + (buf_) * BUF; \
        *(u32x4*)(B_ + QP_OFF + lo0) = X##0; *(u32x4*)(B_ + QP_OFF + lo1) = X##1; \
        *(u32x4*)(B_ + KP_OFF + lo0) = X##2; *(u32x4*)(B_ + KP_OFF + lo1) = X##3; \
        *(u32x4*)(B_ + V_OFF + lo0) = X##4; *(u32x4*)(B_ + V_OFF + lo1) = X##5; \
        if (ht < 32) *(u32x4*)(B_ + G_OFF + ht * 16) = X##6; }
    const int tq = (lane >> 2) & 3, tp = lane & 3, tg = lane >> 4;
    const int tr_nat = (8 * (tg >> 1) + tq) * 272 + (16 * (tg & 1) + 4 * tp) * 2;
    const int tr_krw = (4 * (tg >> 1) + tq) * 272 + (16 * (tg & 1) + 4 * tp) * 2;
    if (helper) { HG_LOAD(A, 0); HG_STORE(A, 0); HG_LOAD(A, 1); HG_STORE(A, 1); HG_LOAD(A, 2); HG_LOAD(B, 3); }
    __syncthreads();
#define HG_COMPUTE(c_) { \
        const char* B = smem + ((c_) % 3) * BUF; const int w = wid; \
        f32x16 pt; _Pragma("unroll") for (int i = 0; i < 16; ++i) pt[i] = 0.f; \
        _Pragma("unroll") for (int ks = 0; ks < 8; ++ks) { \
            const bf16x8 a = *(const bf16x8*)(B + KP_OFF + r * 272 + ks * 32 + h * 16); \
            const bf16x8 bq = *(const bf16x8*)(B + QP_OFF + r * 272 + ks * 32 + h * 16); \
            pt = __builtin_amdgcn_mfma_f32_32x32x16_bf16(a, bq, pt, 0, 0, 0); } \
        _Pragma("unroll") for (int i = 0; i < 16; ++i) if (crow(i, h) > r) pt[i] = 0.f; \
        f32x16 o; _Pragma("unroll") for (int i = 0; i < 16; ++i) o[i] = 0.f; \
        _Pragma("unroll") for (int sp = 0; sp < 2; ++sp) { \
            const char* vb = B + V_OFF + (16 * sp) * 272 + (32 * w) * 2 + tr_krw; \
            const bf16x8 bv = cat8(lds_tr(vb), lds_tr(vb + 8 * 272)); \
            o = __builtin_amdgcn_mfma_f32_32x32x16_bf16(pack8(pt, 8 * sp), bv, o, 0, 0, 0); } \
        _Pragma("unroll") for (int kb = 0; kb < 4; ++kb) _Pragma("unroll") for (int sp = 0; sp < 2; ++sp) { \
            const char* qb = B + QP_OFF + r * 272 + kb * 64 + sp * 32 + h * 8; \
            const bf16x8 aq = cat8(*(const s16x4*)qb, *(const s16x4*)(qb + 16)); \
            o = __builtin_amdgcn_mfma_f32_32x32x16_bf16(aq, pack8(S[kb], 8 * sp), o, 0, 0, 0); } \
        { float* ob_ = (float*)(smem + OB_OFF + ((c_) & 1) * OB_BYTES); _Pragma("unroll") for (int i = 0; i < 16; ++i) ob_[crow(i, h) * OB_STRIDE + 32 * w + r] = o[i]; } \
        bf16x8 bvn[2]; \
        _Pragma("unroll") for (int ks = 0; ks < 2; ++ks) { const char* vb = B + V_OFF + (16 * ks) * 272 + (32 * w) * 2 + tr_nat; bvn[ks] = cat8(lds_tr(vb), lds_tr(vb + 4 * 272)); } \
        _Pragma("unroll") for (int kb = 0; kb < 4; ++kb) { \
            _Pragma("unroll") for (int ks = 0; ks < 2; ++ks) { \
                const char* kp = B + KP_OFF + (16 * ks) * 272 + (32 * kb) * 2 + tr_nat; \
                const bf16x8 a = cat8(lds_tr(kp), lds_tr(kp + 4 * 272)); \
                S[kb] = __builtin_amdgcn_mfma_f32_32x32x16_bf16(a, bvn[ks], S[kb], 0, 0, 0); } \
            _Pragma("unroll") for (int j = 0; j < 4; ++j) { \
                const f32x4 g4 = *(const f32x4*)(B + G_OFF + (kb * 32 + 8 * j + 4 * h) * 4); \
                S[kb][4 * j] *= g4.x; S[kb][4 * j + 1] *= g4.y; S[kb][4 * j + 2] *= g4.z; S[kb][4 * j + 3] *= g4.w; } } }
    f32x4 nw0, nw1, nw2, nw3;
    nw0 = nw1 = nw2 = nw3 = (f32x4){0.f, 0.f, 0.f, 0.f};
    if (helper) { const float* nwp = p.hg_nw + hd * HDK + (ht & 7) * 16; nw0 = *(const f32x4*)nwp; nw1 = *(const f32x4*)(nwp + 4); nw2 = *(const f32x4*)(nwp + 8); nw3 = *(const f32x4*)(nwp + 12); }
#define HG_NORM(cc_) { const int t_ = ht >> 3, sg_ = ht & 7; \
        const float* ob_ = (const float*)(smem + OB_OFF + ((cc_) & 1) * OB_BYTES) + t_ * OB_STRIDE + sg_ * 16; \
        const f32x4 o0 = *(const f32x4*)ob_, o1 = *(const f32x4*)(ob_ + 4), o2 = *(const f32x4*)(ob_ + 8), o3 = *(const f32x4*)(ob_ + 12); \
        const u32x4 g0 = *(const u32x4*)(PG + (size_t)((cc_) * 32 + t_) * INC + sg_ * 16), g1 = *(const u32x4*)(PG + (size_t)((cc_) * 32 + t_) * INC + sg_ * 16 + 8); \
        float ss = (o0.x * o0.x + o0.y * o0.y + o0.z * o0.z + o0.w * o0.w) + (o1.x * o1.x + o1.y * o1.y + o1.z * o1.z + o1.w * o1.w) + (o2.x * o2.x + o2.y * o2.y + o2.z * o2.z + o2.w * o2.w) + (o3.x * o3.x + o3.y * o3.y + o3.z * o3.z + o3.w * o3.w); \
        ss += __shfl_xor(ss, 1); ss += __shfl_xor(ss, 2); ss += __shfl_xor(ss, 4); \
        const float rs_ = rsqrtf(ss * (1.0f / 128.0f) + RMS_EPS); \
        const f32x4 v0 = o0 * rs_ * nw0, v1 = o1 * rs_ * nw1, v2 = o2 * rs_ * nw2, v3 = o3 * rs_ * nw3; \
        u32x4 w0, w1; \
        w0.x = pack2(v0.x * bflo(g0.x), v0.y * bfhi(g0.x)); w0.y = pack2(v0.z * bflo(g0.y), v0.w * bfhi(g0.y)); w0.z = pack2(v1.x * bflo(g0.z), v1.y * bfhi(g0.z)); w0.w = pack2(v1.z * bflo(g0.w), v1.w * bfhi(g0.w)); \
        w1.x = pack2(v2.x * bflo(g1.x), v2.y * bfhi(g1.x)); w1.y = pack2(v2.z * bflo(g1.y), v2.w * bfhi(g1.y)); w1.z = pack2(v3.x * bflo(g1.z), v3.y * bfhi(g1.z)); w1.w = pack2(v3.z * bflo(g1.w), v3.w * bfhi(g1.w)); \
        bf16_t* dst_ = A2out + (size_t)((cc_) * 32 + t_) * DM + sg_ * 16; \
        *(u32x4*)dst_ = w0; *(u32x4*)(dst_ + 8) = w1; }
    for (int c = 0; c < 64; c += 2) {
        if (helper) { if (c + 2 < 64) HG_STORE(A, (c + 2) % 3); if (c + 4 < 64) HG_LOAD(A, c + 4); if (c > 0) HG_NORM(c - 1); } else HG_COMPUTE(c);
        __syncthreads();
        if (helper) { if (c + 3 < 64) HG_STORE(B, (c + 3) % 3); if (c + 5 < 64) HG_LOAD(B, c + 5); HG_NORM(c); } else HG_COMPUTE(c + 1);
        __syncthreads();
    }
    if (helper) HG_NORM(63);
    __syncthreads();
#undef HG_LOAD
#undef HG_STORE
#undef HG_COMPUTE
#undef HG_NORM
}
template <int NJ>
DI void s5_gemm2_tile(const bf16x8 (&af)[16], const bf16_t* KTl, const bf16_t* Xin, const bf16_t* MBg, bf16_t* Yout, bf16_t* stg, const int mi, const int r, const int h) {
    f32x16 y;
#pragma unroll
    for (int i = 0; i < 16; ++i) y[i] = 0.f;
    const int tsel = r >> 4, iq = r & 15;
    bf16x8 bm[8];
#pragma unroll
    for (int ks = 0; ks < 8; ++ks) bm[ks] = *(const bf16x8*)(MBg + (size_t)((NJ * 8 + ks) * 64 + h * 32 + r) * 8);
#pragma unroll
    for (int ks = 0; ks <= 2 * NJ; ++ks) {
        const bf16x8 bk = *(const bf16x8*)(KTl + ((2 * NJ + tsel - ks) * 16 + iq) * 16 + 8 * h);
        y = __builtin_amdgcn_mfma_f32_32x32x16_bf16(af[ks], bk, y, 0, 0, 0);
    }
    {
        bf16x8 bk = *(const bf16x8*)(KTl + iq * 16 + 8 * h);
        if (tsel == 0) bk = (bf16x8){0, 0, 0, 0, 0, 0, 0, 0};
        y = __builtin_amdgcn_mfma_f32_32x32x16_bf16(af[2 * NJ + 1], bk, y, 0, 0, 0);
    }
#pragma unroll
    for (int ks = 0; ks < 8; ++ks) {
        const bf16x8 a = *(const bf16x8*)(Xin + (mi * 32 + r) * 136 + ks * 16 + 8 * h);
        y = __builtin_amdgcn_mfma_f32_32x32x16_bf16(a, bm[ks], y, 0, 0, 0);
    }
#pragma unroll
    for (int i = 0; i < 16; ++i) stg[((crow(i, h) * 2 + tsel) * 16) + iq] = f2bf(gelu_as(y[i]));
    {
        const int lane = h * 32 + r, cl = lane >> 1, ts = lane & 1;
        const u32x4 lo = *(const u32x4*)(stg + lane * 16), hi = *(const u32x4*)(stg + lane * 16 + 8);
        bf16_t* dst = Yout + (size_t)((mi * 32 + cl) * 16 + 2 * NJ + ts) * DSS;
        *(u32x4*)dst = lo; *(u32x4*)(dst + 8) = hi;
    }
}
DI void s5_gemm_item(const Params& p, int b, int g, char* smem) {
    float* E = (float*)smem;
    bf16_t* Xin = (bf16_t*)(smem + 128 * 132 * 4);
    bf16_t* KTl = Xin + 128 * 136;
    const int tid = my_tid(), lane = tid & 63, wid = tid >> 6, r = lane & 31, h = lane >> 5;
    const int mi = wid >> 1, wh = wid & 1;
    const bf16_t* P = (const bf16_t*)(p.ws + OFF_PROJ);
    *(u32x4*)(KTl + tid * 8) = *(const u32x4*)((const bf16_t*)(p.ws + OFF_S5K) + (size_t)g * 4096 + tid * 8);
    bf16x8 af[16];
    {
        const bf16_t* ub = P + (size_t)(b * SEQ + (mi * 32 + r) * 16) * INC + 2048 + g * 16 + 8 * h;
#pragma unroll
        for (int ks = 0; ks < 16; ++ks) af[ks] = *(const bf16x8*)(ub + (size_t)ks * INC);
    }
#ifndef S5_REP_G1
#define S5_REP_G1 1
#define S5_REP_SC 1
#define S5_REP_G2 1
#endif
    for (int rp1 = 0; rp1 < S5_REP_G1; ++rp1)
    {
        f32x16 e0, e1;
#pragma unroll
        for (int i = 0; i < 16; ++i) { e0[i] = 0.f; e1[i] = 0.f; }
        const bf16_t* nb0 = (const bf16_t*)(p.ws + OFF_S5N) + (size_t)g * 128 * 256 + (size_t)(wh * 2) * 16 * 512 + lane * 8;
#pragma unroll
        for (int ks = 0; ks < 16; ++ks) {
            const bf16x8 b0 = *(const bf16x8*)(nb0 + ks * 512), b1 = *(const bf16x8*)(nb0 + 16 * 512 + ks * 512);
            e0 = __builtin_amdgcn_mfma_f32_32x32x16_bf16(af[ks], b0, e0, 0, 0, 0);
            e1 = __builtin_amdgcn_mfma_f32_32x32x16_bf16(af[ks], b1, e1, 0, 0, 0);
        }
#pragma unroll
        for (int i = 0; i < 16; ++i) { float* er = E + (mi * 32 + crow(i, h)) * 132 + wh * 64 + r; er[0] = e0[i]; er[32] = e1[i]; }
    }
    __syncthreads();
    for (int rp2 = 0; rp2 < S5_REP_SC; ++rp2)
    if (wid == 0) {
        const float* L = (const float*)(p.ws + OFF_S5L) + (g * 64 + lane) * 2;
        const float lr = L[0], li = L[1];
        float xr = 0.f, xi = 0.f;
#pragma unroll 8
        for (int c = 0; c < 128; ++c) {
            const float er = E[c * 132 + lane], ei = E[c * 132 + 64 + lane];
            Xin[c * 136 + lane] = f2bf(xr); Xin[c * 136 + 64 + lane] = f2bf(xi);
            const float nr = lr * xr - li * xi + er, ni = lr * xi + li * xr + ei;
            xr = nr; xi = ni;
        }
    }
    __syncthreads();
    const bf16_t* MBg = (const bf16_t*)(p.ws + OFF_S5M) + (size_t)g * 256 * 128;
    bf16_t* Yout = (bf16_t*)(p.ws + OFF_YSSM) + (size_t)b * SEQ * DSS + g * 16;
    bf16_t* stg = (bf16_t*)smem + wid * 1024;
    for (int rp3 = 0; rp3 < S5_REP_G2; ++rp3)
    if (wh) {
        s5_gemm2_tile<1>(af, KTl, Xin, MBg, Yout, stg, mi, r, h); s5_gemm2_tile<6>(af, KTl, Xin, MBg, Yout, stg, mi, r, h);
        s5_gemm2_tile<3>(af, KTl, Xin, MBg, Yout, stg, mi, r, h); s5_gemm2_tile<4>(af, KTl, Xin, MBg, Yout, stg, mi, r, h);
    } else {
        s5_gemm2_tile<0>(af, KTl, Xin, MBg, Yout, stg, mi, r, h); s5_gemm2_tile<7>(af, KTl, Xin, MBg, Yout, stg, mi, r, h);
        s5_gemm2_tile<2>(af, KTl, Xin, MBg, Yout, stg, mi, r, h); s5_gemm2_tile<5>(af, KTl, Xin, MBg, Yout, stg, mi, r, h);
    }
    __syncthreads();
}
DI void phase_mix(const Params& p, int bid, int nb, char* smem) {
    if (nb == 256) {
#ifndef PROBE_HGX
#define PROBE_HGX 1
#endif
        if (bid < 64) { for (int rep = 0; rep < PROBE_HGX; ++rep) hgrn_mfma_item(p, bid, smem); return; }
        const int j = bid - 64, x = j & 7, lb = j >> 3;
#ifndef PROBE_S5X
#define PROBE_S5X 1
#endif
        for (int rep = 0; rep < PROBE_S5X; ++rep)
        for (int q = lb; q < 64; q += 24) s5_gemm_item(p, q & 15, x * 4 + (q >> 4), smem);
    } else {
        for (int it = bid; it < 64; it += nb) hgrn_mfma_item(p, it, smem);
        for (int q = bid; q < 512; q += nb) s5_gemm_item(p, q & 15, q >> 4, smem);
    }
}

DI void phase_glu(const Params& p, int bid, int nb, char* smem) {
    pg8::Gemm g{(const bf16_t*)(p.ws + OFF_YSSM), (const bf16_t*)(p.ws + OFF_GLU), NTOK, 512, 512};
    pg8::StaticOrder S; S.init(NTOK, 512, nb, bid);
    pg8::EpiGlu E{(float*)(p.ws + OFF_H), (const bf16_t*)(p.ws + OFF_YSSM), p.glu_b};
    pg8::gemm_phase<pg8::EpiGlu, pg8::StaticOrder, false>((PG8_LAS unsigned char*)smem, g, S, E, nullptr);
}
DI void phase_a2(const Params& p, int bid, int nb) {
    const float* Y2 = (const float*)(p.ws + OFF_H);
    const bf16_t* P = (const bf16_t*)(p.ws + OFF_PROJ);
    bf16_t* A2 = (bf16_t*)(p.ws + OFF_A2);
    const int lane = my_tid() & 63, wid = my_tid() >> 6;
    for (int tok = bid * 8 + wid; tok < NTOK; tok += nb * 8) {
        const int c0 = lane * 8;
        {
            const float4 a = *(const float4*)(Y2 + (size_t)tok * DSS + c0), b = *(const float4*)(Y2 + (size_t)tok * DSS + c0 + 4);
            float ss = a.x * a.x + a.y * a.y + a.z * a.z + a.w * a.w + b.x * b.x + b.y * b.y + b.z * b.z + b.w * b.w;
#pragma unroll
            for (int m = 1; m < 64; m <<= 1) ss += __shfl_xor(ss, m);
            const float rs = rsqrtf(ss * (1.0f / 512.0f) + RMS_EPS);
            const float4 w0 = *(const float4*)(p.ssm_nw + c0), w1 = *(const float4*)(p.ssm_nw + c0 + 4);
            uint4 o;
            o.x = pack2(a.x * rs * w0.x, a.y * rs * w0.y); o.y = pack2(a.z * rs * w0.z, a.w * rs * w0.w);
            o.z = pack2(b.x * rs * w1.x, b.y * rs * w1.y); o.w = pack2(b.z * rs * w1.z, b.w * rs * w1.w);
            *(uint4*)(A2 + (size_t)tok * DM + 512 + c0) = o;
        }
    }
}

DI void phase_outproj(const Params& p, int bid, int nb, char* smem) {
    pg8::Gemm g{(const bf16_t*)(p.ws + OFF_A2), (const bf16_t*)(p.ws + OFF_WOUT), NTOK, DM, DM};
    pg8::StaticOrder S; S.init(NTOK, DM, nb, bid);
    pg8::EpiResid E{p.out, p.x, (const float*)(p.ws + OFF_MOD) + 2048, DEEP_ALPHA, (bf16_t*)(p.ws + OFF_H), (const float*)(p.ws + OFF_AB), (float*)(p.ws + OFF_STAT)};
    pg8::gemm_phase<pg8::EpiResid, pg8::StaticOrder, false>((PG8_LAS unsigned char*)smem, g, S, E, nullptr);
}
DI void phase_ln1(const Params& p, int bid, int nb) {
    const float* mod = (const float*)(p.ws + OFF_MOD);
    bf16_t* H2 = (bf16_t*)(p.ws + OFF_H);
    const int lane = my_tid() & 63, wid = my_tid() >> 6;
    for (int tok = bid * 8 + wid; tok < NTOK; tok += nb * 8) {
        const int b = tok / SEQ;
        float* row = p.out + (size_t)tok * DM;
        float4 v[4];
        float s = 0.f;
#pragma unroll
        for (int j = 0; j < 4; ++j) { v[j] = *(const float4*)(row + j * 256 + lane * 4); s += v[j].x + v[j].y + v[j].z + v[j].w; }
#pragma unroll
        for (int m = 1; m < 64; m <<= 1) s += __shfl_xor(s, m);
        const float mu = s * (1.0f / 1024.0f);
        float q = 0.f;
#pragma unroll
        for (int j = 0; j < 4; ++j) { const float a = v[j].x - mu, bb = v[j].y - mu, cc = v[j].z - mu, d = v[j].w - mu; q += a * a + bb * bb + cc * cc + d * d; }
#pragma unroll
        for (int m = 1; m < 64; m <<= 1) q += __shfl_xor(q, m);
        const float rstd = rsqrtf(q * (1.0f / 1024.0f) + LN_EPS);
        const float* sh2 = mod + b * 6144 + 3072;
        const float* sc2 = mod + b * 6144 + 4096;
#pragma unroll
        for (int j = 0; j < 4; ++j) {
            const int c = j * 256 + lane * 4;
            const float4 w = *(const float4*)(p.ln1w + c), bi = *(const float4*)(p.ln1b + c), sc = *(const float4*)(sc2 + c), sh = *(const float4*)(sh2 + c);
            float4 o;
            o.x = (v[j].x - mu) * rstd * w.x + bi.x; o.y = (v[j].y - mu) * rstd * w.y + bi.y; o.z = (v[j].z - mu) * rstd * w.z + bi.z; o.w = (v[j].w - mu) * rstd * w.w + bi.w;
            *(float4*)(row + c) = o;
            uint2 hh; hh.x = pack2(o.x * (1.f + sc.x) + sh.x, o.y * (1.f + sc.y) + sh.y); hh.y = pack2(o.z * (1.f + sc.z) + sh.z, o.w * (1.f + sc.w) + sh.w);
            *(uint2*)(H2 + (size_t)tok * DM + c) = hh;
        }
    }
}

DI void phase_q(const Params& p, int bid, int nb, char* smem) {
    pg8::Gemm g{(const bf16_t*)(p.ws + OFF_H), (const bf16_t*)(p.ws + OFF_WQ), NTOK, 2048, DM};
    pg8::StaticOrder S; S.init(NTOK, 2048, nb, bid);
    pg8::EpiQLN E{(bf16_t*)(p.ws + OFF_PROJ), (const float*)(p.ws + OFF_STAT), (const float*)(p.ws + OFF_CAB), (const float*)(p.ws + OFF_CAB) + NB * 2048, LN_EPS};
    pg8::gemm_phase<pg8::EpiQLN, pg8::StaticOrder, false>((PG8_LAS unsigned char*)smem, g, S, E, nullptr);
}
DI void phase_topk(const Params& p, int bid, int nb, char* smem) {
    const bf16_t* Q = (const bf16_t*)(p.ws + OFF_PROJ);
    const bf16_t* SK = (const bf16_t*)(p.ws + OFF_SUBK);
    unsigned* TOPL = (unsigned*)(p.ws + OFF_TOPL);
    float* sc = (float*)(smem + 36864);
    constexpr int NTM = NTOK / 128;
    for (int t = bid; t < NTM * 16; t += nb) {
        const int mt = t >> 4, hp = t & 15;
        gemm_block<2, 1, 2, 4>(Q + (size_t)mt * 128 * 2048 + hp * 128, 2048, SK + (size_t)hp * 128 * 128, 128, 128, smem,
                               [&](int r, int c, float v) { sc[r * 129 + c] = v; });
        __syncthreads();
        if (my_tid() < 128) {
            const int r = my_tid();
            float tk[16];
#pragma unroll
            for (int j = 0; j < 16; ++j) tk[j] = -3.0e38f;
            for (int n = 0; n < 128; ++n) {
                float xv = __uint_as_float((__float_as_uint(sc[r * 129 + n]) & ~0x7fu) | (unsigned)n);
#pragma unroll
                for (int j = 0; j < 16; ++j) { const float hi = fmaxf(tk[j], xv), lo = fminf(tk[j], xv); tk[j] = hi; xv = lo; }
            }
            uint4* dst = (uint4*)(TOPL + ((size_t)(mt * 128 + r) * 16 + hp) * 16);
            dst[0] = make_uint4(__float_as_uint(tk[0]), __float_as_uint(tk[1]), __float_as_uint(tk[2]), __float_as_uint(tk[3]));
            dst[1] = make_uint4(__float_as_uint(tk[4]), __float_as_uint(tk[5]), __float_as_uint(tk[6]), __float_as_uint(tk[7]));
            dst[2] = make_uint4(__float_as_uint(tk[8]), __float_as_uint(tk[9]), __float_as_uint(tk[10]), __float_as_uint(tk[11]));
            dst[3] = make_uint4(__float_as_uint(tk[12]), __float_as_uint(tk[13]), __float_as_uint(tk[14]), __float_as_uint(tk[15]));
        }
        __syncthreads();
    }
}
DI void phase_combine(const Params& p, int bid, int nb) {
    const unsigned* TOPL = (const unsigned*)(p.ws + OFF_TOPL);
    uint2* EX = (uint2*)(p.ws + OFF_EXPS);
    const float* SU = (const float*)(p.ws + OFF_SU);
    const float* SV = (const float*)(p.ws + OFF_SV);
    for (int i = bid * NTH + my_tid(); i < NTOK * PHEADS; i += nb * NTH) {
        const unsigned* l1 = TOPL + (size_t)i * 32;
        const unsigned* l2 = l1 + 16;
        float s2[16];
        {
            const uint4 a = ((const uint4*)l2)[0], b = ((const uint4*)l2)[1], c = ((const uint4*)l2)[2], d = ((const uint4*)l2)[3];
            const unsigned w[16] = {a.x, a.y, a.z, a.w, b.x, b.y, b.z, b.w, c.x, c.y, c.z, c.w, d.x, d.y, d.z, d.w};
#pragma unroll
            for (int j = 0; j < 16; ++j) s2[j] = __uint_as_float(w[j] & ~0x7fu);
        }
        float tk[16];
#pragma unroll
        for (int j = 0; j < 16; ++j) tk[j] = -3.0e38f;
        for (int a = 0; a < 16; ++a) {
            const float s1 = __uint_as_float(l1[a] & ~0x7fu);
#pragma unroll
            for (int b = 0; b < 16; ++b) {
                float xv = __uint_as_float((__float_as_uint(s1 + s2[b]) & ~0xffu) | (unsigned)(a * 16 + b));
#pragma unroll
                for (int j = 0; j < 16; ++j) { const float hi = fmaxf(tk[j], xv), lo = fminf(tk[j], xv); tk[j] = hi; xv = lo; }
            }
        }
        float e[16], sum = 0.f;
        const float mx = __uint_as_float(__float_as_uint(tk[0]) & ~0xffu);
#pragma unroll
        for (int j = 0; j < 16; ++j) { e[j] = __expf(__uint_as_float(__float_as_uint(tk[j]) & ~0xffu) - mx); sum += e[j]; }
        const float inv = 1.0f / sum;
#pragma unroll
        for (int j = 0; j < 16; ++j) {
            const unsigned ab = __float_as_uint(tk[j]) & 0xffu;
            const unsigned i1 = l1[ab >> 4] & 0x7fu, i2 = l2[ab & 15] & 0x7fu;
            const unsigned eid = i1 * 128u + i2;
            EX[(size_t)i * 16 + j] = make_uint2(eid | (((__float_as_uint(SU[eid]) >> 23) & 0xffu) << 16), __float_as_uint(e[j] * inv * SV[eid]));
        }
    }
}

DI void ce_desc(float& a, float& b) { const float hi = fmaxf(a, b), lo = fminf(a, b); a = hi; b = lo; }
template <int N> DI void bitonic_sort_desc(float (&v)[N]) {
#pragma unroll
    for (int k = 2; k <= N; k <<= 1)
#pragma unroll
        for (int j = k >> 1; j > 0; j >>= 1)
#pragma unroll
            for (int i = 0; i < N; ++i) { const int l = i ^ j; if (l > i) { if ((i & k) == 0 || k == N) ce_desc(v[i], v[l]); else ce_desc(v[l], v[i]); } }
}
DI void merge_top16(float (&a)[16], const float (&b)[16]) {
#pragma unroll
    for (int i = 0; i < 16; ++i) a[i] = fmaxf(a[i], b[15 - i]);
#pragma unroll
    for (int j = 8; j > 0; j >>= 1)
#pragma unroll
        for (int i = 0; i < 16; ++i) { const int l = i ^ j; if (l > i) ce_desc(a[i], a[l]); }
}
DI void xlane_merge16(float (&a)[16]) {
    float o[16];
#pragma unroll
    for (int i = 0; i < 16; ++i) o[i] = __shfl_xor(a[i], 32);
    merge_top16(a, o);
}
DI void retrieve_topk_hp(const bf16_t* Q, const char* skl, const int tok, const int hp_next, const int r, const int h, unsigned char* lutp, float (&out)[16], bf16x8 (&bq)[8]) {
                f32x16 acc[4];
#pragma unroll
                for (int mi = 0; mi < 4; ++mi)
#pragma unroll
                    for (int i = 0; i < 16; ++i) acc[mi][i] = 0.f;
                const char* kb = skl + r * 272 + h * 16;
#pragma unroll
                for (int ks = 0; ks < 8; ++ks) {
#pragma unroll
                    for (int mi = 0; mi < 4; ++mi) {
                        const bf16x8 a = *(const bf16x8*)(kb + mi * 32 * 272 + ks * 32);
                        acc[mi] = __builtin_amdgcn_mfma_f32_32x32x16_bf16(a, bq[ks], acc[mi], 0, 0, 0);
                    }
                }
                {
                    const bf16_t* qb = Q + (size_t)tok * 2048 + hp_next * 128 + 8 * h;
#pragma unroll
                    for (int ks = 0; ks < 8; ++ks) bq[ks] = *(const bf16x8*)(qb + ks * 16);
                }
                float v0[16], v1[16], v2[16], v3[16];
#pragma unroll
                for (int i = 0; i < 16; ++i) {
                    const unsigned n = (unsigned)crow(i, h);
                    v0[i] = __uint_as_float((__float_as_uint(acc[0][i]) & ~0x7fu) | n);
                    v1[i] = __uint_as_float((__float_as_uint(acc[1][i]) & ~0x7fu) | (n + 32u));
                    v2[i] = __uint_as_float((__float_as_uint(acc[2][i]) & ~0x7fu) | (n + 64u));
                    v3[i] = __uint_as_float((__float_as_uint(acc[3][i]) & ~0x7fu) | (n + 96u));
                }
                bitonic_sort_desc<16>(v0); bitonic_sort_desc<16>(v1); bitonic_sort_desc<16>(v2); bitonic_sort_desc<16>(v3);
                merge_top16(v0, v1); merge_top16(v2, v3); merge_top16(v0, v2);
                xlane_merge16(v0);
#pragma unroll
                for (int i = 0; i < 16; ++i) out[i] = v0[i];
                u32x4 ix;
                ix.x = (__float_as_uint(v0[0]) & 0x7fu) | ((__float_as_uint(v0[1]) & 0x7fu) << 8) | ((__float_as_uint(v0[2]) & 0x7fu) << 16) | ((__float_as_uint(v0[3]) & 0x7fu) << 24);
                ix.y = (__float_as_uint(v0[4]) & 0x7fu) | ((__float_as_uint(v0[5]) & 0x7fu) << 8) | ((__float_as_uint(v0[6]) & 0x7fu) << 16) | ((__float_as_uint(v0[7]) & 0x7fu) << 24);
                ix.z = (__float_as_uint(v0[8]) & 0x7fu) | ((__float_as_uint(v0[9]) & 0x7fu) << 8) | ((__float_as_uint(v0[10]) & 0x7fu) << 16) | ((__float_as_uint(v0[11]) & 0x7fu) << 24);
                ix.w = (__float_as_uint(v0[12]) & 0x7fu) | ((__float_as_uint(v0[13]) & 0x7fu) << 8) | ((__float_as_uint(v0[14]) & 0x7fu) << 16) | ((__float_as_uint(v0[15]) & 0x7fu) << 24);
                *(u32x4*)lutp = ix;
}
DI void phase_retrieve(const Params& p, int bid, int nb, char* smem) {
    const bf16_t* Q = (const bf16_t*)(p.ws + OFF_PROJ);
    const bf16_t* SK = (const bf16_t*)(p.ws + OFF_SUBK);
    const float* SU = (const float*)(p.ws + OFF_SU);
    const float* SV = (const float*)(p.ws + OFF_SV);
    uint2* EX = (uint2*)(p.ws + OFF_EXPS);
    const int tid = my_tid(), lane = tid & 63, wid = tid >> 6, r = lane & 31, h = lane >> 5;
    unsigned char* lut = (unsigned char*)smem + wid * 2048 + lane * 32;
    char* skb0 = smem + 16384;
    char* skb1 = skb0 + 128 * 272;
    u32x4 sr0, sr1, sr2, sr3;
#define SK_LOAD(hp_) { const bf16_t* g_ = SK + (size_t)(hp_) * 16384 + tid * 8; sr0 = *(const u32x4*)g_; sr1 = *(const u32x4*)(g_ + 4096); sr2 = *(const u32x4*)(g_ + 8192); sr3 = *(const u32x4*)(g_ + 12288); }
#define SK_STORE(buf_) { char* d_ = (buf_) + (tid >> 4) * 272 + (tid & 15) * 16; *(u32x4*)d_ = sr0; *(u32x4*)(d_ + 32 * 272) = sr1; *(u32x4*)(d_ + 64 * 272) = sr2; *(u32x4*)(d_ + 96 * 272) = sr3; }
    for (int it = bid; it < (NTOK / 256) * 2; it += nb) {
        const int hq = it & 1, tok = (it >> 1) * 256 + wid * 32 + r;
        __syncthreads();
        SK_LOAD(hq * 8); SK_STORE(skb0);
        bf16x8 bq[8];
        {
            const bf16_t* qb = Q + (size_t)tok * 2048 + (hq * 8) * 128 + 8 * h;
#pragma unroll
            for (int ks = 0; ks < 8; ++ks) bq[ks] = *(const bf16x8*)(qb + ks * 16);
        }
        __syncthreads();
#pragma unroll 1
        for (int hd = hq * 4; hd < hq * 4 + 4; ++hd) {
            float L0[16], L1[16];
            SK_LOAD(hd * 2 + 1);
            retrieve_topk_hp(Q, skb0, tok, hd * 2 + 1, r, h, lut, L0, bq);
            SK_STORE(skb1);
            __syncthreads();
            if (hd + 1 < hq * 4 + 4) SK_LOAD(hd * 2 + 2);
            retrieve_topk_hp(Q, skb1, tok, (hd + 1 < hq * 4 + 4) ? hd * 2 + 2 : hd * 2 + 1, r, h, lut + 16, L1, bq);
            if (hd + 1 < hq * 4 + 4) SK_STORE(skb0);
            __syncthreads();
            float c[32];
            {
                constexpr int PA[50] = {0, 0, 0, 0, 0, 0, 0, 0, 0, 0, 0, 0, 0, 0, 0, 0, 1, 1, 1, 1, 1, 1, 1, 1, 2, 2, 2, 2, 2, 3, 3, 3, 3, 4, 4, 4, 5, 5, 6, 6, 7, 7, 8, 9, 10, 11, 12, 13, 14, 15};
                constexpr int PB[50] = {0, 1, 2, 3, 4, 5, 6, 7, 8, 9, 10, 11, 12, 13, 14, 15, 0, 1, 2, 3, 4, 5, 6, 7, 0, 1, 2, 3, 4, 0, 1, 2, 3, 0, 1, 2, 0, 1, 0, 1, 0, 1, 0, 0, 0, 0, 0, 0, 0, 0};
#pragma unroll
                for (int q = 0; q < 25; ++q) {
                    const float s0 = __uint_as_float(__float_as_uint(L0[PA[2 * q]]) & ~0x7fu) + __uint_as_float(__float_as_uint(L1[PB[2 * q]]) & ~0x7fu);
                    const float s1 = __uint_as_float(__float_as_uint(L0[PA[2 * q + 1]]) & ~0x7fu) + __uint_as_float(__float_as_uint(L1[PB[2 * q + 1]]) & ~0x7fu);
                    const float p0 = __uint_as_float((__float_as_uint(s0) & ~0xffu) | (unsigned)(PA[2 * q] * 16 + PB[2 * q]));
                    const float p1 = __uint_as_float((__float_as_uint(s1) & ~0xffu) | (unsigned)(PA[2 * q + 1] * 16 + PB[2 * q + 1]));
                    c[q] = h ? p1 : p0;
                }
#pragma unroll
                for (int i = 25; i < 32; ++i) c[i] = -3.0e38f;
            }
            bitonic_sort_desc<32>(c);
            float t16[16];
#pragma unroll
            for (int i = 0; i < 16; ++i) t16[i] = c[i];
            xlane_merge16(t16);
            const float mx = __uint_as_float(__float_as_uint(t16[0]) & ~0xffu);
            float e[16], sum = 0.f;
#pragma unroll
            for (int j = 0; j < 16; ++j) { e[j] = __expf(__uint_as_float(__float_as_uint(t16[j]) & ~0xffu) - mx); sum += e[j]; }
            const float inv = 1.0f / sum;
            uint2* dst = EX + ((size_t)tok * 8 + hd) * 16 + 8 * h;
#pragma unroll
            for (int j = 0; j < 8; ++j) {
                float tlo = t16[j], thi = t16[8 + j], elo = e[j], ehi = e[8 + j];
                asm volatile("" : "+v"(tlo), "+v"(thi), "+v"(elo), "+v"(ehi));
                const float tv = h ? thi : tlo, ev = h ? ehi : elo;
                const unsigned ab = __float_as_uint(tv) & 0xffu;
                const unsigned eid = (unsigned)lut[ab >> 4] * 128u + (unsigned)lut[16 + (ab & 15u)];
                dst[j] = make_uint2(eid | (pack2(0.f, SU[eid]) & 0xffff0000u), __float_as_uint(ev * inv * SV[eid]));
            }
        }
    }
#undef SK_LOAD
#undef SK_STORE
}

DI float dot16_fp8(const u32x4 w, const f32x2 (&h)[8]) {
    f32x2 acc = __builtin_amdgcn_cvt_pk_f32_fp8((int)w.x, false) * h[0];
    acc += __builtin_amdgcn_cvt_pk_f32_fp8((int)w.x, true) * h[1];
    acc += __builtin_amdgcn_cvt_pk_f32_fp8((int)w.y, false) * h[2];
    acc += __builtin_amdgcn_cvt_pk_f32_fp8((int)w.y, true) * h[3];
    acc += __builtin_amdgcn_cvt_pk_f32_fp8((int)w.z, false) * h[4];
    acc += __builtin_amdgcn_cvt_pk_f32_fp8((int)w.z, true) * h[5];
    acc += __builtin_amdgcn_cvt_pk_f32_fp8((int)w.w, false) * h[6];
    acc += __builtin_amdgcn_cvt_pk_f32_fp8((int)w.w, true) * h[7];
    return acc.x + acc.y;
}
DI void axpy16_fp8(const float a, const u32x4 w, f32x2 (&o)[8]) {
    const f32x2 aa = {a, a};
    o[0] += aa * __builtin_amdgcn_cvt_pk_f32_fp8((int)w.x, false); o[1] += aa * __builtin_amdgcn_cvt_pk_f32_fp8((int)w.x, true);
    o[2] += aa * __builtin_amdgcn_cvt_pk_f32_fp8((int)w.y, false); o[3] += aa * __builtin_amdgcn_cvt_pk_f32_fp8((int)w.y, true);
    o[4] += aa * __builtin_amdgcn_cvt_pk_f32_fp8((int)w.z, false); o[5] += aa * __builtin_amdgcn_cvt_pk_f32_fp8((int)w.z, true);
    o[6] += aa * __builtin_amdgcn_cvt_pk_f32_fp8((int)w.w, false); o[7] += aa * __builtin_amdgcn_cvt_pk_f32_fp8((int)w.w, true);
}
DI float butterfly64(float (&pz)[64], const int lane) {
    const bool b5 = lane & 32, b4 = lane & 16, b3 = lane & 8, b2 = lane & 4, b1 = lane & 2, b0 = lane & 1;
    float q32[32], q16[16], q8[8], q4[4], q2[2];
#pragma unroll
    for (int j = 0; j < 32; ++j) q32[j] = (b5 ? pz[32 + j] : pz[j]) + __shfl_xor(b5 ? pz[j] : pz[32 + j], 32);
#pragma unroll
    for (int j = 0; j < 16; ++j) q16[j] = (b4 ? q32[16 + j] : q32[j]) + __shfl_xor(b4 ? q32[j] : q32[16 + j], 16);
#pragma unroll
    for (int j = 0; j < 8; ++j) q8[j] = (b3 ? q16[8 + j] : q16[j]) + __shfl_xor(b3 ? q16[j] : q16[8 + j], 8);
#pragma unroll
    for (int j = 0; j < 4; ++j) q4[j] = (b2 ? q8[4 + j] : q8[j]) + __shfl_xor(b2 ? q8[j] : q8[4 + j], 4);
#pragma unroll
    for (int j = 0; j < 2; ++j) q2[j] = (b1 ? q4[2 + j] : q4[j]) + __shfl_xor(b1 ? q4[j] : q4[2 + j], 2);
    return (b0 ? q2[1] : q2[0]) + __shfl_xor(b0 ? q2[0] : q2[1], 1);
}
DI float bfly8(float (&pz)[8], const int lane) {
    const bool b2 = lane & 4, b1 = lane & 2, b0 = lane & 1;
    float q4[4], q2[2];
#pragma unroll
    for (int i = 0; i < 4; ++i) q4[i] = (b2 ? pz[4 + i] : pz[i]) + __shfl_xor(b2 ? pz[i] : pz[4 + i], 4);
#pragma unroll
    for (int i = 0; i < 2; ++i) q2[i] = (b1 ? q4[2 + i] : q4[i]) + __shfl_xor(b1 ? q4[i] : q4[2 + i], 2);
    float q = (b0 ? q2[1] : q2[0]) + __shfl_xor(b0 ? q2[0] : q2[1], 1);
    q += __shfl_xor(q, 8); q += __shfl_xor(q, 16); q += __shfl_xor(q, 32);
    return q;
}
DI float bfly16(float (&pz)[16], const int lane) {
    const bool b3 = lane & 8, b2 = lane & 4, b1 = lane & 2, b0 = lane & 1;
    float q8[8], q4[4], q2[2];
#pragma unroll
    for (int i = 0; i < 8; ++i) q8[i] = (b3 ? pz[8 + i] : pz[i]) + __shfl_xor(b3 ? pz[i] : pz[8 + i], 8);
#pragma unroll
    for (int i = 0; i < 4; ++i) q4[i] = (b2 ? q8[4 + i] : q8[i]) + __shfl_xor(b2 ? q8[i] : q8[4 + i], 4);
#pragma unroll
    for (int i = 0; i < 2; ++i) q2[i] = (b1 ? q4[2 + i] : q4[i]) + __shfl_xor(b1 ? q4[i] : q4[2 + i], 2);
    float q = (b0 ? q2[1] : q2[0]) + __shfl_xor(b0 ? q2[0] : q2[1], 1);
    q += __shfl_xor(q, 16); q += __shfl_xor(q, 32);
    return q;
}
DI void gs_issue(const __amdgpu_buffer_rsrc_t T, const uint2* ent, const unsigned d, const int lane, u32x4 (&w)[8], unsigned& ca) {
    const int cnt = (int)((d >> 16) & 0xfu), k = lane & 7;
    const uint2 e = ent[(d & 0xffffu) + (unsigned)(k < cnt ? k : cnt - 1)];
    ca = (k < cnt && !(d >> 31)) ? e.y : 0u;
#pragma unroll
    for (int q = 0; q < 8; ++q) {
        const int eid = __builtin_amdgcn_readlane((int)e.x, q) & 0x3fff;
        w[q] = __builtin_amdgcn_raw_buffer_load_b128(T, lane * 16, eid * DM, 0);
    }
}
DI float dot16_i8(const u32x4 w, const u32x4 h) {
    int acc = __builtin_amdgcn_sdot4((int)w.x, (int)h.x, 0, false);
    acc = __builtin_amdgcn_sdot4((int)w.y, (int)h.y, acc, false);
    acc = __builtin_amdgcn_sdot4((int)w.z, (int)h.z, acc, false);
    acc = __builtin_amdgcn_sdot4((int)w.w, (int)h.w, acc, false);
    return (float)acc;
}
DI void gs_desc(const uint2* ent, const unsigned d, const int lane, unsigned& ex) {
    const int cnt = (int)((d >> 16) & 0xfu), k = lane & 7;
    ex = ent[(d & 0xffffu) + (unsigned)(k < cnt ? k : cnt - 1)].x;
}
DI void gs_loads(const __amdgpu_buffer_rsrc_t T, const unsigned ex, const int lane, u32x4 (&w)[8]) {
#pragma unroll
    for (int q = 0; q < 8; ++q) {
        const int eid = __builtin_amdgcn_readlane((int)ex, q) & 0x3fff;
        w[q] = __builtin_amdgcn_raw_buffer_load_b128(T, lane * 16, eid * DM, 0);
    }
}
DI void gs_upartial(const u32x4 (&w)[8], const u32x4 h2q, float (&pz)[16], const int base) {
#pragma unroll
    for (int k = 0; k < 8; ++k) pz[base + k] = dot16_i8(w[k], h2q);
}
DI void gs_ustore(float (&pz)[16], float* zb, const unsigned da, const unsigned db, const int lane) {
    const float z = bfly16(pz, lane);
    const unsigned d = (lane & 8) ? db : da;
    const int k = lane & 7;
    if (lane < 16 && k < (int)((d >> 16) & 0xfu) && !(d >> 31)) zb[(d & 0xffffu) + k] = z;
}
DI void axpy16_u8(const float a, const u32x4 w, float (&o)[16]) {
    o[0] += a * (float)(w.x & 0xffu); o[1] += a * (float)((w.x >> 8) & 0xffu); o[2] += a * (float)((w.x >> 16) & 0xffu); o[3] += a * (float)(w.x >> 24);
    o[4] += a * (float)(w.y & 0xffu); o[5] += a * (float)((w.y >> 8) & 0xffu); o[6] += a * (float)((w.y >> 16) & 0xffu); o[7] += a * (float)(w.y >> 24);
    o[8] += a * (float)(w.z & 0xffu); o[9] += a * (float)((w.z >> 8) & 0xffu); o[10] += a * (float)((w.z >> 16) & 0xffu); o[11] += a * (float)(w.z >> 24);
    o[12] += a * (float)(w.w & 0xffu); o[13] += a * (float)((w.w >> 8) & 0xffu); o[14] += a * (float)((w.w >> 16) & 0xffu); o[15] += a * (float)(w.w >> 24);
}
DI void gs_vcompute(const u32x4 (&w)[8], const unsigned ca, float (&acc)[16]) {
#pragma unroll
    for (int k = 0; k < 8; ++k) { axpy16_u8(__uint_as_float((unsigned)__builtin_amdgcn_readlane((int)ca, k)), w[k], acc); __builtin_amdgcn_sched_barrier(0); }
}
constexpr int GT = 4;
constexpr int NSL = 4, SLSH = 12;
DI void xcd_pace(unsigned* cnt, const unsigned nloc, unsigned& step) {
    __syncthreads();
    if (__builtin_amdgcn_workitem_id_x() == 0) {
        __hip_atomic_fetch_add(cnt, 1u, __ATOMIC_RELAXED, __HIP_MEMORY_SCOPE_AGENT);
        const unsigned target = nloc * (step + 1u);
        unsigned sp = 0;
        while (__hip_atomic_load(cnt, __ATOMIC_RELAXED, __HIP_MEMORY_SCOPE_AGENT) < target) { __builtin_amdgcn_s_sleep(1); if (++sp > (1u << 22)) break; }
    }
    ++step;
    __syncthreads();
}
DI void phase_gather(const Params& p, int bid, int nb, char* smem, unsigned* pace_cnt, const unsigned pace_n) {
    unsigned pstep = 0;
    const float* mod = (const float*)(p.ws + OFF_MOD);
    const float* AB = (const float*)(p.ws + OFF_AB);
    const float* STAT = (const float*)(p.ws + OFF_STAT);
    const uint2* EX = (const uint2*)(p.ws + OFF_EXPS);
    const __amdgpu_buffer_rsrc_t UT = __builtin_amdgcn_make_buffer_rsrc((void*)(p.ws + OFF_UT), 0, NEXP * DM, 0x00020000);
    const __amdgpu_buffer_rsrc_t VT = __builtin_amdgcn_make_buffer_rsrc((void*)(p.ws + OFF_VT), 0, NEXP * DM, 0x00020000);
    const int lane = my_tid() & 63, wid = my_tid() >> 6, c0 = lane * 16;
    char* wl = smem + wid * 7168;
    uint2* ent = (uint2*)wl; float* zb = (float*)(wl + 4096); int* offs = (int*)(wl + 6144); unsigned* sched = (unsigned*)(wl + 6144 + 256);
#pragma unroll 1
    for (int t0 = (bid * 8 + wid) * GT; t0 < NTOK; t0 += nb * 8 * GT) {
        u32x4 h2q[GT]; float hsc[GT], mu[GT], rs[GT]; float acc[GT][16];
        f32x4 scv[4], shv[4];
        {
            const int b = t0 / SEQ;
#pragma unroll
            for (int q = 0; q < 4; ++q) { scv[q] = *(const f32x4*)(AB + (size_t)b * DM + c0 + q * 4); shv[q] = *(const f32x4*)(AB + (size_t)(NB + b) * DM + c0 + q * 4); }
        }
#pragma unroll
        for (int j = 0; j < GT; ++j) {
            const int tok = t0 + j;
            const float* row = p.out + (size_t)tok * DM + c0;
            __builtin_amdgcn_sched_barrier(0);
            { mu[j] = STAT[tok] * (1.0f / 1024.0f); rs[j] = rsqrtf(fmaxf(STAT[NTOK + tok] * (1.0f / 1024.0f) - mu[j] * mu[j], 0.f) + LN_EPS); }
            {
                f32x4 hv[4];
                float m = 0.f;
#pragma unroll
                for (int q = 0; q < 4; ++q) { hv[q] = (*(const f32x4*)(row + q * 4) - mu[j]) * rs[j] * scv[q] + shv[q]; m = fmaxf(m, fmaxf(fmaxf(fabsf(hv[q].x), fabsf(hv[q].y)), fmaxf(fabsf(hv[q].z), fabsf(hv[q].w)))); }
#pragma unroll
                for (int sft = 1; sft < 64; sft <<= 1) m = fmaxf(m, __shfl_xor(m, sft));
                const float qs = m > 1e-30f ? 127.0f / m : 1.0f;
                hsc[j] = m > 1e-30f ? m * (1.0f / 127.0f) : 1.0f;
                unsigned hw[4];
#pragma unroll
                for (int q = 0; q < 4; ++q)
                    hw[q] = ((unsigned)(int)rintf(hv[q].x * qs) & 0xffu) | (((unsigned)(int)rintf(hv[q].y * qs) & 0xffu) << 8) | (((unsigned)(int)rintf(hv[q].z * qs) & 0xffu) << 16) | (((unsigned)(int)rintf(hv[q].w * qs) & 0xffu) << 24);
                h2q[j] = (u32x4){hw[0], hw[1], hw[2], hw[3]};
            }
            const uint2 e0 = EX[(size_t)tok * 128 + lane], e1 = EX[(size_t)tok * 128 + 64 + lane];
            const int s0 = (int)((e0.x & 0x3fffu) >> SLSH), s1 = (int)((e1.x & 0x3fffu) >> SLSH);
            int run = 0, pos0 = 0, pos1 = 0;
#pragma unroll
            for (int s = 0; s < NSL; ++s) {
                const unsigned long long m0 = __ballot(s0 == s), m1 = __ballot(s1 == s);
                const int c0n = __popcll(m0), c1n = __popcll(m1);
                const int below0 = (int)__builtin_amdgcn_mbcnt_hi((unsigned)(m0 >> 32), __builtin_amdgcn_mbcnt_lo((unsigned)m0, 0u));
                const int below1 = (int)__builtin_amdgcn_mbcnt_hi((unsigned)(m1 >> 32), __builtin_amdgcn_mbcnt_lo((unsigned)m1, 0u));
                if (lane == 0) offs[j * 9 + s] = run;
                pos0 = (s0 == s) ? run + below0 : pos0;
                pos1 = (s1 == s) ? run + c0n + below1 : pos1;
                run += c0n + c1n;
            }
            if (lane == 0) offs[j * 9 + NSL] = 128;
            ent[j * 128 + pos0] = e0; ent[j * 128 + pos1] = e1;
        }
        int nbat;
        {
            const int gs = (lane / GT) % NSL, gj = lane % GT;
            const int gb = offs[gj * 9 + gs], ge = offs[gj * 9 + gs + 1], cnt = lane < NSL * GT ? ge - gb : 0, nbt = (cnt + 7) >> 3;
            int incl = nbt;
#pragma unroll
            for (int m = 1; m < 32; m <<= 1) { const int o = __shfl_up(incl, m); if ((lane & 31) >= m) incl += o; }
            nbat = __builtin_amdgcn_readlane(incl, NSL * GT - 1);
            const int st = incl - nbt;
            for (int q = 0; q < nbt; ++q) { const int rem = cnt - 8 * q; sched[st + q] = (unsigned)(gj * 128 + gb + 8 * q) | ((unsigned)(rem < 8 ? rem : 8) << 16); }
            if (lane < 3) sched[nbat + lane] = 0x80010000u;
        }
        xcd_pace(pace_cnt, pace_n, pstep);
#ifndef PROBE_UX
#define PROBE_UX 1
#endif
        for (int rep = 0; rep < PROBE_UX; ++rep)
        {
            u32x4 wa[8], wb[8];
#define GS_UP(W_, D_, B_) { const unsigned j_ = ((D_) & 0xffffu) >> 7; \
                if (j_ == 0) gs_upartial(W_, h2q[0], pz, B_); else if (j_ == 1) gs_upartial(W_, h2q[1], pz, B_); \
                else if (j_ == 2) gs_upartial(W_, h2q[2], pz, B_); else gs_upartial(W_, h2q[3], pz, B_); }
#define GS_RD(i_) ((unsigned)__builtin_amdgcn_readfirstlane((int)sched[(i_)]))
            unsigned da = GS_RD(0), db = GS_RD(1), dn = GS_RD(2), ea, eb, en;
            gs_desc(ent, da, lane, ea); gs_desc(ent, db, lane, eb); gs_desc(ent, dn, lane, en);
            gs_loads(UT, ea, lane, wa);
#pragma unroll 1
            for (int i = 0; i < nbat; i += 2) {
                float pz[16];
                gs_loads(UT, eb, lane, wb);
                __builtin_amdgcn_sched_barrier(0);
                GS_UP(wa, da, 0);
                const unsigned dcur_a = da, dcur_b = db;
                da = dn; ea = en; dn = GS_RD(i + 3); gs_desc(ent, dn, lane, en);
                gs_loads(UT, ea, lane, wa);
                __builtin_amdgcn_sched_barrier(0);
                GS_UP(wb, dcur_b, 8);
                db = dn; eb = en; dn = GS_RD(i + 4); gs_desc(ent, dn, lane, en);
                gs_ustore(pz, zb, dcur_a, dcur_b, lane);
            }
#undef GS_UP
#undef GS_RD
        }
        float asum[GT];
#pragma unroll
        for (int j = 0; j < GT; ++j) {
            float as = 0.f;
#pragma unroll
            for (int q = 0; q < 2; ++q) {
                const int pos = j * 128 + q * 64 + lane;
                const uint2 e = ent[pos];
                const float z = zb[pos] * __uint_as_float(e.x & 0xffff0000u) * hsc[j];
                const float a = gelu_as(z) * __uint_as_float(e.y);
                ent[pos].y = __float_as_uint(a);
                as += a;
            }
#pragma unroll
            for (int sft = 1; sft < 64; sft <<= 1) as += __shfl_xor(as, sft);
            asum[j] = as;
        }
#pragma unroll
        for (int j = 0; j < GT; ++j)
#pragma unroll
            for (int q = 0; q < 16; ++q) acc[j][q] = 0.f;
        {
            u32x4 wa[8]; unsigned ca;
#pragma unroll 1
            for (int i = 0; i < nbat; ++i) {
                const unsigned da = (unsigned)__builtin_amdgcn_readfirstlane((int)sched[i]);
                gs_issue(VT, ent, da, lane, wa, ca);
                __builtin_amdgcn_sched_barrier(0);
                const unsigned j_ = (da & 0xffffu) >> 7;
                if (j_ == 0) gs_vcompute(wa, ca, acc[0]); else if (j_ == 1) gs_vcompute(wa, ca, acc[1]);
                else if (j_ == 2) gs_vcompute(wa, ca, acc[2]); else gs_vcompute(wa, ca, acc[3]);
            }
        }
#pragma unroll
        for (int j = 0; j < GT; ++j) {
            asm volatile("" ::: "memory");
            __builtin_amdgcn_sched_barrier(0);
            const int tok = t0 + j, b = tok / SEQ;
            float* row = p.out + (size_t)tok * DM + c0;
            const float* g2 = mod + b * 6144 + 5120 + c0;
            f32x2 r[8];
            float sm = 0.f;
#pragma unroll
            for (int q = 0; q < 4; ++q) {
                const f32x4 xv = (*(const f32x4*)(row + q * 4) - mu[j]) * rs[j] * *(const f32x4*)(p.ln1w + c0 + q * 4) + *(const f32x4*)(p.ln1b + c0 + q * 4), gg = *(const f32x4*)(g2 + q * 4);
                const float off = 128.0f * asum[j];
                r[2 * q] = DEEP_ALPHA * (f32x2){xv.x, xv.y} + (f32x2){1.f + gg.x, 1.f + gg.y} * (f32x2){acc[j][4 * q] - off, acc[j][4 * q + 1] - off};
                r[2 * q + 1] = DEEP_ALPHA * (f32x2){xv.z, xv.w} + (f32x2){1.f + gg.z, 1.f + gg.w} * (f32x2){acc[j][4 * q + 2] - off, acc[j][4 * q + 3] - off};
                sm += r[2 * q].x + r[2 * q].y + r[2 * q + 1].x + r[2 * q + 1].y;
            }
#pragma unroll
            for (int m = 1; m < 64; m <<= 1) sm += __shfl_xor(sm, m);
            const float mu = sm * (1.0f / 1024.0f);
            float qq = 0.f;
#pragma unroll
            for (int i = 0; i < 8; ++i) { const f32x2 dd = r[i] - mu; qq += dd.x * dd.x + dd.y * dd.y; }
#pragma unroll
            for (int m = 1; m < 64; m <<= 1) qq += __shfl_xor(qq, m);
            const float rstd = rsqrtf(qq * (1.0f / 1024.0f) + LN_EPS);
#pragma unroll
            for (int q = 0; q < 4; ++q) {
                const f32x4 w4 = *(const f32x4*)(p.ln2w + c0 + q * 4), bi = *(const f32x4*)(p.ln2b + c0 + q * 4);
                f32x4 ov;
                ov.x = (r[2 * q].x - mu) * rstd * w4.x + bi.x; ov.y = (r[2 * q].y - mu) * rstd * w4.y + bi.y;
                ov.z = (r[2 * q + 1].x - mu) * rstd * w4.z + bi.z; ov.w = (r[2 * q + 1].y - mu) * rstd * w4.w + bi.w;
                *(f32x4*)(row + q * 4) = ov;
            }
        }
    }
}

#define XB_TMO      128
#define XB_XCNT(j)  (256  + 64 * (j))
#define XB_XSUB(j)  (1280 + 64 * (j))
#define XB_XGEN(j)  (2304 + 64 * (j))
#define XB_TOP      3328
#define XB_TOPGEN   3392
#define XCD_BAR_WORDS 3456
#define XB_SPIN_CAP (1u << 22)
#define LAS __attribute__((address_space(3)))
DI unsigned xb_ld(unsigned* p) { return __hip_atomic_load(p, __ATOMIC_RELAXED, __HIP_MEMORY_SCOPE_AGENT); }
DI unsigned xb_add(unsigned* p, unsigned v) { return __hip_atomic_fetch_add(p, v, __ATOMIC_RELAXED, __HIP_MEMORY_SCOPE_AGENT); }
DI unsigned xb_xcc_id() { return (unsigned)__builtin_amdgcn_s_getreg((3 << 11) | 20) & 0xFu; }
#define XB_SPIN(cond, bar) do { unsigned _sp = 0; while (cond) { __builtin_amdgcn_s_sleep(1); \
    if ((++_sp & 255u) == 0u) { if (xb_ld(&(bar)[XB_TMO])) break; if (_sp > XB_SPIN_CAP) { atomicAdd(&(bar)[XB_TMO], 1u); break; } } } } while (0)
struct XcdBarrier { unsigned* bar; unsigned x; volatile LAS unsigned* st; };
DI XcdBarrier xcd_barrier_post(unsigned* bar, volatile LAS unsigned* st) {
    XcdBarrier b; b.bar = bar; b.x = xb_xcc_id(); b.st = st;
    if (__builtin_amdgcn_workitem_id_x() == 0) (void)xb_add(&bar[XB_XCNT(b.x)], 1u);
    return b;
}
DI void xcd_barrier_complete(unsigned* bar, unsigned x, unsigned& nloc, unsigned& nx) {
    const unsigned G = gridDim.x * gridDim.y * gridDim.z;
    unsigned sum, cnt, mine, sp = 0u;
    for (;;) {
        sum = 0u; cnt = 0u; mine = 0u;
#pragma unroll
        for (unsigned j = 0; j < 16; ++j) { const unsigned c = xb_ld(&bar[XB_XCNT(j)]); sum += c; cnt += (c > 0u) ? 1u : 0u; mine = (j == x) ? c : mine; }
        if (sum == G) break;
        __builtin_amdgcn_s_sleep(1);
        if ((++sp & 255u) == 0u) { if (xb_ld(&bar[XB_TMO])) break; if (sp > XB_SPIN_CAP) { atomicAdd(&bar[XB_TMO], 1u); break; } }
    }
    nloc = mine > 0u ? mine : 1u; nx = cnt > 0u ? cnt : 1u;
}
DI void xcd_barrier(const XcdBarrier& b) {
    asm volatile("s_waitcnt vmcnt(0)" ::: "memory");
    __syncthreads();
    if (__builtin_amdgcn_workitem_id_x() == 0) {
        unsigned* bar = b.bar;
        __builtin_amdgcn_s_waitcnt(0);
        unsigned nloc = b.st[0], nx = b.st[1];
        if (nloc == 0u) { xcd_barrier_complete(bar, b.x, nloc, nx); b.st[0] = nloc; b.st[1] = nx; }
        const unsigned old = xb_add(&bar[XB_XSUB(b.x)], 1u);
        const unsigned gen = old / nloc;
        if (old + 1u == (gen + 1u) * nloc) {
            __builtin_amdgcn_fence(__ATOMIC_RELEASE, "agent");
            asm volatile("s_waitcnt vmcnt(0)" ::: "memory");
            const unsigned og = xb_add(&bar[XB_TOP], 1u);
            const unsigned tg = og / nx;
            if (og + 1u == (tg + 1u) * nx) xb_add(&bar[XB_TOPGEN], 1u);
            else XB_SPIN(xb_ld(&bar[XB_TOPGEN]) == tg, bar);
            __builtin_amdgcn_fence(__ATOMIC_ACQUIRE, "agent");
            xb_add(&bar[XB_XGEN(b.x)], 1u);
            asm volatile("s_waitcnt vmcnt(0)" ::: "memory");
        } else {
            XB_SPIN(xb_ld(&bar[XB_XGEN(b.x)]) == gen, bar);
            __builtin_amdgcn_fence(__ATOMIC_ACQUIRE, "agent");
            asm volatile("s_waitcnt vmcnt(0)" ::: "memory");
        }
    }
    __syncthreads();
}

__global__ void __launch_bounds__(NTH) k_mega(Params p) {
    __shared__ __attribute__((aligned(16))) char smem[SMEM_BYTES];
    volatile LAS unsigned* xst = (volatile LAS unsigned*)(smem + SMEM_BYTES - 16);
    if (__builtin_amdgcn_workitem_id_x() == 0) { xst[0] = 0u; xst[1] = 0u; }
    __syncthreads();
    const XcdBarrier xb = xcd_barrier_post((unsigned*)(p.ws + OFF_BAR), xst);
    const int bid = blockIdx.x, nb = gridDim.x;
#ifndef PROBE_MASK
#define PROBE_MASK 0
#endif
#define REP(bit) for (int rep_ = 0; rep_ < ((PROBE_MASK & (bit)) ? 2 : 1); ++rep_)
    phase_prep_a(p, smem);           xcd_barrier(xb);
    phase_prep_b(p, smem);           xcd_barrier(xb);
    REP(1)  { phase_proj(p, bid, nb, smem);    xcd_barrier(xb); }
    REP(128) { phase_hgprep(p, bid, nb);       xcd_barrier(xb); }
    REP(2)  { phase_mix(p, bid, nb, smem);     xcd_barrier(xb); }
    REP(4)  { phase_glu(p, bid, nb, smem);     xcd_barrier(xb); }
    REP(4)  { phase_a2(p, bid, nb);            xcd_barrier(xb); }
    REP(4)  { phase_outproj(p, bid, nb, smem); xcd_barrier(xb); }
    REP(8)  { phase_q(p, bid, nb, smem);       xcd_barrier(xb); }
    REP(16) { phase_retrieve(p, bid, nb, smem); xcd_barrier(xb); }
    phase_gather(p, bid, nb, smem, (unsigned*)(p.ws + OFF_BAR) + 16 * xb.x, xst[0]);
}

extern "C" void kernel_launch(void* const* d_in, const int* in_sizes, int n_in, void* d_out, int out_size, void* d_ws, size_t ws_size, hipStream_t stream) {
    if (n_in != 27 || ws_size < WS_END) { fprintf(stderr, "kernel_launch: unexpected n_in %d or ws_size %zu (< %zu)\n", n_in, ws_size, (size_t)WS_END); return; }
    static int grid_blocks = 0;
    if (!grid_blocks) {
        int dev = 0, cus = 0, per_cu = 0;
        (void)hipGetDevice(&dev);
        (void)hipDeviceGetAttribute(&cus, hipDeviceAttributeMultiprocessorCount, dev);
        (void)hipOccupancyMaxActiveBlocksPerMultiprocessor(&per_cu, k_mega, NTH, 0);
        if (cus <= 0) cus = 256;
        if (per_cu < 1) { fprintf(stderr, "kernel_launch: occupancy query says %d blocks/CU\n", per_cu); per_cu = 1; }
        grid_blocks = cus;
    }
    Params p{};
    const float** f = (const float**)&p;
    for (int i = 0; i < 27; ++i) f[i] = (const float*)d_in[i];
    p.out = (float*)d_out; p.ws = (char*)d_ws;
    hipError_t e = hipMemsetAsync((char*)d_ws + OFF_BAR, 0, (size_t)3456 * 4, stream);
    if (e == hipSuccess) { hipLaunchKernelGGL(k_mega, dim3(grid_blocks), dim3(NTH), 0, stream, p); e = hipPeekAtLastError(); }
    if (e != hipSuccess) fprintf(stderr, "launch failed: %s (grid %d)\n", hipGetErrorString(e), grid_blocks);
}
```

```cpp
#include <hip/hip_runtime.h>
#include <hip/hip_cooperative_groups.h>
#include <stdint.h>
#include <stdio.h>

namespace cg = cooperative_groups;
#define DI __device__ __forceinline__
typedef unsigned short bf16_t;
typedef short bf16x8 __attribute__((ext_vector_type(8)));
typedef float f32x16 __attribute__((ext_vector_type(16)));
typedef unsigned u32x4 __attribute__((ext_vector_type(4)));
typedef float f32x4 __attribute__((ext_vector_type(4)));
typedef float f32x2 __attribute__((ext_vector_type(2)));

constexpr int NTH = 512;
constexpr int NB = 16, SEQ = 2048, DM = 1024, NTOK = NB * SEQ;
constexpr int DHG = 512, HGH = 4, HDK = 128;
constexpr int DSS = 512, SSG = 32, SSC = 16, SSP = 64;
constexpr int INC = 2560;
constexpr int PHEADS = 8, NKEYS = 128, TOPK = 16, NEXP = 16384;
constexpr float DEEP_ALPHA = 1.189207115002721f;
constexpr float LN_EPS = 1e-5f, RMS_EPS = 1e-6f;
constexpr int SMEM_BYTES = 128 * 1024 + 256;

constexpr size_t al256(size_t x) { return (x + 255) & ~(size_t)255; }
constexpr size_t OFF_MOD = 0;
constexpr size_t OFF_LB = al256(OFF_MOD + (size_t)NB * 6144 * 4);
constexpr size_t OFF_LAM = al256(OFF_LB + 512 * 4);
constexpr size_t OFF_BB = al256(OFF_LAM + 32 * 64 * 2 * 4);
constexpr size_t OFF_WIN = al256(OFF_BB + 32 * 64 * 16 * 2 * 4);
constexpr size_t OFF_GLU = al256(OFF_WIN + (size_t)INC * DM * 2);
constexpr size_t OFF_WOUT = al256(OFF_GLU + (size_t)512 * 512 * 2);
constexpr size_t OFF_WQ = al256(OFF_WOUT + (size_t)DM * DM * 2);
constexpr size_t OFF_SUBK = al256(OFF_WQ + (size_t)2048 * DM * 2);
constexpr size_t OFF_SU = al256(OFF_SUBK + (size_t)16 * 128 * 128 * 2);
constexpr size_t OFF_SV = al256(OFF_SU + (size_t)NEXP * 4);
constexpr size_t OFF_UT = al256(OFF_SV + (size_t)NEXP * 4);
constexpr size_t OFF_VT = al256(OFF_UT + (size_t)NEXP * DM * 2);
constexpr size_t OFF_H = al256(OFF_VT + (size_t)NEXP * DM * 2);
constexpr size_t OFF_PROJ = al256(OFF_H + (size_t)NTOK * DM * 2);
constexpr size_t OFF_ORAW = al256(OFF_PROJ + (size_t)NTOK * INC * 2);
constexpr size_t OFF_YSSM = al256(OFF_ORAW + (size_t)NTOK * DHG * 4);
constexpr size_t OFF_A2 = al256(OFF_YSSM + (size_t)NTOK * DSS * 2);
constexpr size_t OFF_HG = al256(OFF_A2 + (size_t)NTOK * DM * 2);
constexpr size_t OFF_S5K = al256(OFF_HG + (size_t)4096 * 128 * 4);
constexpr size_t OFF_S5N = al256(OFF_S5K + (size_t)32 * 4096 * 2);
constexpr size_t OFF_S5M = al256(OFF_S5N + (size_t)32 * 128 * 256 * 2);
constexpr size_t OFF_S5L = al256(OFF_S5M + (size_t)32 * 256 * 128 * 2);
constexpr size_t OFF_STAT = al256(OFF_S5L + (size_t)32 * 64 * 2 * 4);
constexpr size_t OFF_AB = al256(OFF_STAT + (size_t)NTOK * 2 * 4);
constexpr size_t OFF_CAB = al256(OFF_AB + (size_t)2 * NB * DM * 4);
constexpr size_t OFF_BAR = al256(OFF_CAB + (size_t)2 * NB * 2048 * 4);
constexpr size_t WS_END = al256(OFF_BAR + (size_t)3456 * 4);
constexpr size_t OFF_HQ = OFF_ORAW, OFF_HK = OFF_ORAW + (size_t)NTOK * DHG * 2;
constexpr size_t OFF_TOPL = OFF_ORAW;
constexpr size_t OFF_EXPS = OFF_ORAW + (size_t)NTOK * 16 * 16 * 4;

struct Params {
    const float *x, *c, *ada_w, *ada_b, *w_in, *hg_lb, *hg_nw, *a_re, *a_im, *log_dt, *b_re, *b_im, *c_re, *c_im, *dsk,
        *glu_w, *glu_b, *ssm_nw, *w_out, *ln1w, *ln1b, *w_q, *subk, *pu, *pv, *ln2w, *ln2b;
    float* out;
    char* ws;
};

DI int my_tid() { int t = (int)__builtin_amdgcn_workitem_id_x(); asm volatile("" : "+v"(t)); return t; }
DI bf16_t f2bf(float x) { unsigned u = __float_as_uint(x); u += 0x7fffu + ((u >> 16) & 1u); return (bf16_t)(u >> 16); }
DI float bf2f(bf16_t b) { return __uint_as_float(((unsigned)b) << 16); }
DI float bflo(unsigned w) { return __uint_as_float(w << 16); }
DI float bfhi(unsigned w) { return __uint_as_float(w & 0xffff0000u); }
typedef __bf16 hwbf16x2 __attribute__((ext_vector_type(2)));
DI unsigned pack2(float a, float b) { const f32x2 v = {a, b}; return __builtin_bit_cast(unsigned, __builtin_convertvector(v, hwbf16x2)); }
DI bf16x8 pack8(const f32x16& x, const int base) {
    u32x4 o; o.x = pack2(x[base], x[base + 1]); o.y = pack2(x[base + 2], x[base + 3]); o.z = pack2(x[base + 4], x[base + 5]); o.w = pack2(x[base + 6], x[base + 7]);
    return __builtin_bit_cast(bf16x8, o);
}
DI float sigmoidf_(float x) { return 1.0f / (1.0f + __expf(-x)); }
DI float siluf_(float x) { return x * sigmoidf_(x); }
DI float geluf_(float x) { return 0.5f * x * (1.0f + erff(x * 0.70710678118654752f)); }
DI float gelu_as(float v) {
    const float t = __builtin_amdgcn_rcpf(fabsf(v) * 0.2316418882f + 1.0f);
    float q = t * 0.5307027145f + (-0.7265760135f); q = q * t + 0.7107068705f; q = q * t + (-0.142248368f); q = q * t + 0.127414796f; q = q * t;
    const float m = v * (q * __builtin_amdgcn_exp2f(v * v * (-0.72134752044f)));
    return v < 0.f ? m : v - m;
}

template <int MT, int NT_, int WM, int WN, class Epi>
DI void gemm_block(const bf16_t* __restrict__ A, int lda, const bf16_t* __restrict__ Bt, int ldb, int K, char* smem, Epi epi) {
    constexpr int BM = WM * MT * 32, BN = WN * NT_ * 32, LS = 72;
    static_assert(WM * WN == 8, "8 waves");
    bf16_t* As = (bf16_t*)smem;
    bf16_t* Bs = As + BM * LS;
    const int tid = my_tid(), lane = tid & 63, wid = tid >> 6, r = lane & 31, h = lane >> 5;
    const int wm = wid / WN, wn = wid % WN;
    constexpr int PA = BM * 8 / NTH, PB = BN * 8 / NTH;
    u32x4 ra[PA], rb[PB];
    f32x16 acc[MT][NT_];
#pragma unroll
    for (int mi = 0; mi < MT; ++mi)
#pragma unroll
        for (int ni = 0; ni < NT_; ++ni)
#pragma unroll
            for (int i = 0; i < 16; ++i) acc[mi][ni][i] = 0.f;
#define GEMM_GLOAD(kt_) { \
    _Pragma("unroll") for (int q = 0; q < PA; ++q) { const int idx = tid + q * NTH, row = idx >> 3, ch = idx & 7; ra[q] = *(const u32x4*)(A + (size_t)row * lda + (kt_) * 64 + ch * 8); } \
    _Pragma("unroll") for (int q = 0; q < PB; ++q) { const int idx = tid + q * NTH, row = idx >> 3, ch = idx & 7; rb[q] = *(const u32x4*)(Bt + (size_t)row * ldb + (kt_) * 64 + ch * 8); } }
#define GEMM_LSTORE() { \
    _Pragma("unroll") for (int q = 0; q < PA; ++q) { const int idx = tid + q * NTH, row = idx >> 3, ch = idx & 7; *(u32x4*)(As + row * LS + ch * 8) = ra[q]; } \
    _Pragma("unroll") for (int q = 0; q < PB; ++q) { const int idx = tid + q * NTH, row = idx >> 3, ch = idx & 7; *(u32x4*)(Bs + row * LS + ch * 8) = rb[q]; } }
    GEMM_GLOAD(0); GEMM_LSTORE(); __syncthreads();
    const int nk = K / 64;
    for (int kt = 0; kt < nk; ++kt) {
        if (kt + 1 < nk) GEMM_GLOAD(kt + 1);
#pragma unroll
        for (int ks = 0; ks < 4; ++ks) {
            bf16x8 a[MT], b[NT_];
#pragma unroll
            for (int mi = 0; mi < MT; ++mi) a[mi] = *(const bf16x8*)(As + (wm * MT * 32 + mi * 32 + r) * LS + ks * 16 + h * 8);
#pragma unroll
            for (int ni = 0; ni < NT_; ++ni) b[ni] = *(const bf16x8*)(Bs + (wn * NT_ * 32 + ni * 32 + r) * LS + ks * 16 + h * 8);
#pragma unroll
            for (int mi = 0; mi < MT; ++mi)
#pragma unroll
                for (int ni = 0; ni < NT_; ++ni) acc[mi][ni] = __builtin_amdgcn_mfma_f32_32x32x16_bf16(a[mi], b[ni], acc[mi][ni], 0, 0, 0);
        }
        __syncthreads();
        if (kt + 1 < nk) { GEMM_LSTORE(); __syncthreads(); }
    }
#pragma unroll
    for (int mi = 0; mi < MT; ++mi)
#pragma unroll
        for (int ni = 0; ni < NT_; ++ni)
#pragma unroll
            for (int i = 0; i < 16; ++i) epi(wm * MT * 32 + mi * 32 + (i & 3) + 8 * (i >> 2) + 4 * h, wn * NT_ * 32 + ni * 32 + r, acc[mi][ni][i]);
}

namespace pg8 {
#define PG8_LAS __attribute__((address_space(3)))
typedef unsigned short bf16_t;
typedef short bf16x8 __attribute__((ext_vector_type(8)));
typedef float f32x4 __attribute__((ext_vector_type(4)));
typedef unsigned u32x4 __attribute__((ext_vector_type(4)));
constexpr int BM = 256, BK = 64, HALF = 128, HTB = HALF * BK * 2  , STAGE_BYTES = 8 * HTB, NXCD = 8, WGM = 8;

__host__ __device__ __forceinline__ int lds_byte(int r, int c) { const int st = (r >> 4) * 2 + (c >> 5), rr = r & 15, cc = c & 31, ob = rr * 64 + cc * 2; return st * 1024 + (ob ^ (((ob >> 9) & 1) << 5)); }
__host__ __device__ __forceinline__ void stage_rc(int b, int& R, int& C) { const int st = b / 1024, sb = b % 1024, swz = sb ^ (((sb >> 9) & 1) << 5); R = (st >> 1) * 16 + swz / 64; C = (st & 1) * 32 + (swz % 64) / 2; }
__host__ __device__ __forceinline__ int perm32(int rho) { const int n = rho >> 4, i = rho & 15; return 8 * (i >> 2) + 4 * n + (i & 3); }

struct Unit { int pm, pn; };
struct Gemm { const bf16_t* A; const bf16_t* Bt; int M, N, K; };

struct StaticOrder {
    int nM, nN, nwg, G, c;
    __host__ __device__ void init(int M, int N, int G_, int c_) { nM = M / BM; nN = N / BM; nwg = nM * nN; G = G_; c = c_; }
    __host__ __device__ bool next(int i, Unit& u) const {
        const long L = (long)i * G + c; if (L >= nwg) return false;
        int wgid = (int)L; { const int q = nwg / NXCD, r = nwg % NXCD, xcd = wgid % NXCD, off = wgid / NXCD; wgid = (xcd < r ? xcd * (q + 1) : r * (q + 1) + (xcd - r) * q) + off; }
        const int nig = WGM * nN, gid = wgid / nig, fm = gid * WGM, gsz = (nM - fm) < WGM ? (nM - fm) : WGM;
        u.pm = fm + ((wgid % nig) % gsz); u.pn = (wgid % nig) / gsz; return true;
    }
    __device__ __forceinline__ void a_ready(const Unit&) const {}
    __device__ __forceinline__ void done(const Unit&) const {}
};
template <class Epi, class Sched, bool STAMP = false>
__device__ __forceinline__ void gemm_phase(PG8_LAS unsigned char* lds, const Gemm g, const Sched& S, const Epi& E, unsigned long long* stamps) {
    int tid_ = (int)__builtin_amdgcn_workitem_id_x(); asm volatile("" : "+v"(tid_));
    const int tid = tid_, wid = __builtin_amdgcn_readfirstlane(tid >> 6), lane = tid & 63, wr = wid >> 2, wc = wid & 3, fr = lane & 15, fq = lane >> 4;
    const int K = g.K, nt = K / BK;
    int ts_lo = 0, ts_hi = 0, nts = 0; const unsigned long long rt_entry = STAMP ? (unsigned long long)wall_clock64() : 0ull;
#define PG8_STAMP() do { if (STAMP && wid == 0 && nts < 64) { const unsigned long long _c = (unsigned long long)clock64(); \
        ts_lo = (lane == nts) ? (int)(unsigned)_c : ts_lo; ts_hi = (lane == nts) ? (int)(unsigned)(_c >> 32) : ts_hi; ++nts; } } while (0)
    PG8_STAMP();
    unsigned voffA[2], voffB[2];
#pragma unroll
    for (int i = 0; i < 2; ++i) { int R, C; stage_rc(tid * 16 + i * 8192, R, C); const int Rb = Epi::PERM ? ((R & ~31) + perm32(R & 31)) : R;
        voffA[i] = (unsigned)(R * K + C) * 2u; voffB[i] = (unsigned)(Rb * K + C) * 2u; }
    const size_t kstep = (size_t)(BK * 2);
    const size_t hstep = (size_t)HALF * K * 2;
    const size_t tstep = 2 * hstep;
    const unsigned ldsw = (unsigned)wid * 1024u;
    const int aoff = lds_byte(wr * 64 + fr, fq * 8), boff = lds_byte(wc * 32 + fr, fq * 8);
#define PG8_SA(b, h) (((b) * 2 + (h)) * HTB)
#define PG8_SB(b, h) ((4 + (b) * 2 + (h)) * HTB)
#define PG8_STAGE(bufoff, gbase, voff) do { _Pragma("unroll") for (int _i = 0; _i < 2; ++_i) \
        __builtin_amdgcn_global_load_lds((const unsigned*)((const char*)(gbase) + (voff)[_i]), (PG8_LAS unsigned*)(lds + (bufoff) + ldsw + _i * 8192), 16, 0, 0); } while (0)
#define PG8_LDA(dst, b, h) do { _Pragma("unroll") for (int m = 0; m < 4; ++m) _Pragma("unroll") for (int k = 0; k < 2; ++k) dst[m][k] = *(const PG8_LAS bf16x8*)(lds + PG8_SA(b, h) + aoff + m * 2048 + k * 1024); } while (0)
#define PG8_LDB(dst, b, h) do { _Pragma("unroll") for (int n = 0; n < 2; ++n) _Pragma("unroll") for (int k = 0; k < 2; ++k) dst[n][k] = *(const PG8_LAS bf16x8*)(lds + PG8_SB(b, h) + boff + n * 2048 + k * 1024); } while (0)
#define PG8_MMA(ai, bj, At, Bt) do { __builtin_amdgcn_s_setprio(1); _Pragma("unroll") for (int m = 0; m < 4; ++m) _Pragma("unroll") for (int n = 0; n < 2; ++n) _Pragma("unroll") for (int k = 0; k < 2; ++k) \
        acc[ai][bj][m][n] = __builtin_amdgcn_mfma_f32_16x16x32_bf16(Bt[n][k], At[m][k], acc[ai][bj][m][n], 0, 0, 0); __builtin_amdgcn_s_setprio(0); } while (0)
#define PG8_WAIT_V(n) asm volatile("s_waitcnt vmcnt(" #n ")" ::: "memory")
#define PG8_WAIT_L(n) asm volatile("s_waitcnt lgkmcnt(" #n ")" ::: "memory")
#define PG8_BAR __builtin_amdgcn_s_barrier()
#define PG8_SCHED __builtin_amdgcn_sched_barrier(0)
    Unit cur, nxt; int ui = 0;
    if (!S.next(0, cur)) return;
    f32x4 acc[2][2][4][2];
#pragma unroll
    for (int a = 0; a < 2; ++a)
#pragma unroll
        for (int b = 0; b < 2; ++b)
#pragma unroll
            for (int m = 0; m < 4; ++m)
#pragma unroll
                for (int n = 0; n < 2; ++n) acc[a][b][m][n] = (f32x4){0.f, 0.f, 0.f, 0.f};
    bf16x8 At[4][2], B0[2][2], B1[2][2];
    const char* cA = (const char*)g.A + (size_t)cur.pm * tstep; const char* cB = (const char*)g.Bt + (size_t)cur.pn * tstep;
    S.a_ready(cur);
    PG8_STAGE(PG8_SB(0, 0), cB, voffB); PG8_STAGE(PG8_SA(0, 0), cA, voffA); PG8_STAGE(PG8_SB(0, 1), cB + hstep, voffB); PG8_STAGE(PG8_SA(0, 1), cA + hstep, voffA);
    if (wr == 1) PG8_BAR;
    PG8_WAIT_V(4); PG8_BAR;
    PG8_STAGE(PG8_SB(1, 0), cB + kstep, voffB); PG8_STAGE(PG8_SA(1, 0), cA + kstep, voffA); PG8_STAGE(PG8_SB(1, 1), cB + hstep + kstep, voffB);
    PG8_WAIT_V(6); PG8_BAR;
    PG8_STAMP();
    for (;;) {
        const bool has_next = S.next(ui + 1, nxt);
        const char* nA = has_next ? (const char*)g.A + (size_t)nxt.pm * tstep : cA; const char* nB = has_next ? (const char*)g.Bt + (size_t)nxt.pn * tstep : cB;
        for (int t = 0; t < nt; t += 2) {
            const bool last = (t == nt - 2);
            const char* a1 = cA + (size_t)(t + 1) * kstep;
            const char* a2 = last ? nA : cA + (size_t)(t + 2) * kstep; const char* b2 = last ? nB : cB + (size_t)(t + 2) * kstep;
            const char* a3 = a2 + kstep; const char* b3 = b2 + kstep;
            if (last && has_next) S.a_ready(nxt);
            PG8_LDB(B0, 0, 0); PG8_SCHED; PG8_LDA(At, 0, 0); PG8_STAGE(PG8_SA(1, 1), a1 + hstep, voffA);
            PG8_WAIT_L(8); PG8_BAR; PG8_WAIT_L(0); PG8_MMA(0, 0, At, B0); PG8_BAR; PG8_SCHED;
            PG8_LDB(B1, 0, 1); PG8_STAGE(PG8_SB(0, 0), b2, voffB);
            PG8_BAR; PG8_WAIT_L(0); PG8_MMA(0, 1, At, B1); PG8_BAR;
            PG8_LDA(At, 0, 1); PG8_STAGE(PG8_SA(0, 0), a2, voffA);
            PG8_BAR; PG8_WAIT_L(0); PG8_MMA(1, 0, At, B0); PG8_BAR; PG8_SCHED;
            PG8_STAGE(PG8_SB(0, 1), b2 + hstep, voffB);
            PG8_WAIT_V(6); PG8_BAR; PG8_MMA(1, 1, At, B1); PG8_BAR;
            PG8_LDB(B0, 1, 0); PG8_SCHED; PG8_LDA(At, 1, 0); PG8_STAGE(PG8_SA(0, 1), a2 + hstep, voffA);
            PG8_WAIT_L(8); PG8_BAR; PG8_WAIT_L(0); PG8_MMA(0, 0, At, B0); PG8_BAR; PG8_SCHED;
            PG8_LDB(B1, 1, 1); PG8_STAGE(PG8_SB(1, 0), b3, voffB);
            PG8_BAR; PG8_WAIT_L(0); PG8_MMA(0, 1, At, B1); PG8_BAR;
            PG8_LDA(At, 1, 1); PG8_STAGE(PG8_SA(1, 0), a3, voffA);
            PG8_BAR; PG8_WAIT_L(0); PG8_MMA(1, 0, At, B0); PG8_BAR; PG8_SCHED;
            PG8_STAGE(PG8_SB(1, 1), b3 + hstep, voffB);
            PG8_WAIT_V(6); PG8_BAR; PG8_MMA(1, 1, At, B1); PG8_BAR;
        }
        PG8_STAMP();
        if constexpr (!Epi::AFTER_DRAIN) { E(acc, cur, wr, wc, fr, fq); S.done(cur); }
        PG8_STAMP();
        if (!has_next) break;
#pragma unroll
        for (int a = 0; a < 2; ++a)
#pragma unroll
            for (int b = 0; b < 2; ++b)
#pragma unroll
                for (int m = 0; m < 4; ++m)
#pragma unroll
                    for (int n = 0; n < 2; ++n) acc[a][b][m][n] = (f32x4){0.f, 0.f, 0.f, 0.f};
        cur = nxt; cA = nA; cB = nB; ++ui;
    }
    PG8_WAIT_V(0);
    if (wr == 0) PG8_BAR;
    PG8_BAR;
    if constexpr (Epi::AFTER_DRAIN) { E.fused(acc, cur, wr, wc, fr, fq, lds, wid, lane); S.done(cur); }
    PG8_STAMP();
    if (STAMP && wid == 0) { stamps[lane] = lane < nts ? (((unsigned long long)(unsigned)ts_hi << 32) | (unsigned)ts_lo) : 0ull;
        if (lane == 62) stamps[62] = rt_entry; if (lane == 63) stamps[63] = (unsigned long long)wall_clock64(); }
#undef PG8_STAMP
#undef PG8_SA
#undef PG8_SB
#undef PG8_STAGE
#undef PG8_LDA
#undef PG8_LDB
#undef PG8_MMA
#undef PG8_WAIT_V
#undef PG8_WAIT_L
#undef PG8_BAR
#undef PG8_SCHED
}

__device__ __forceinline__ unsigned pk_bf16(float lo, float hi) { typedef float v2f __attribute__((ext_vector_type(2))); typedef __bf16 v2b __attribute__((ext_vector_type(2))); const v2f v = {lo, hi}; return __builtin_bit_cast(unsigned, __builtin_convertvector(v, v2b)); }
__device__ __forceinline__ float silu1(float x) { return x * __builtin_amdgcn_rcpf(1.0f + __expf(-x)); }
struct EpiBf16Act {
    static constexpr bool PERM = true, AFTER_DRAIN = false;
    bf16_t* O; int ldc; unsigned silu_mask;
    __device__ __forceinline__ void operator()(const f32x4 (&acc)[2][2][4][2], const Unit& u, int wr, int wc, int fr, int fq) const {
        const int row0 = u.pm * BM + wr * 64 + fr, col0 = u.pn * BM + wc * 32 + 8 * fq;
        const bool act = (silu_mask >> u.pn) & 1u;
#pragma unroll
        for (int ai = 0; ai < 2; ++ai)
#pragma unroll
            for (int m = 0; m < 4; ++m) { bf16_t* rowp = O + (size_t)(row0 + ai * HALF + m * 16) * ldc + col0;
#pragma unroll
                for (int bj = 0; bj < 2; ++bj) { f32x4 v0 = acc[ai][bj][m][0], v1 = acc[ai][bj][m][1];
                    if (act) {
#pragma unroll
                        for (int j = 0; j < 4; ++j) { v0[j] = silu1(v0[j]); v1[j] = silu1(v1[j]); } }
                    u32x4 w; w.x = pk_bf16(v0[0], v0[1]); w.y = pk_bf16(v0[2], v0[3]); w.z = pk_bf16(v1[0], v1[1]); w.w = pk_bf16(v1[2], v1[3]);
                    *(u32x4*)(rowp + bj * HALF) = w; } }
    }
};
struct EpiProj {
    static constexpr bool PERM = true, AFTER_DRAIN = false;
    bf16_t* O; bf16_t* HQ; bf16_t* HK; float* HG; const float* LB;
    __device__ __forceinline__ void operator()(const f32x4 (&acc)[2][2][4][2], const Unit& u, int wr, int wc, int fr, int fq) const {
        if (u.pn >= 4) {
            const int row0 = u.pm * BM + wr * 64 + fr, col0 = u.pn * BM + wc * 32 + 8 * fq;
            const bool act = (u.pn == 6) || (u.pn == 7);
#pragma unroll
            for (int ai = 0; ai < 2; ++ai)
#pragma unroll
                for (int m = 0; m < 4; ++m) { bf16_t* rowp = O + (size_t)(row0 + ai * HALF + m * 16) * 2560 + col0;
#pragma unroll
                    for (int bj = 0; bj < 2; ++bj) { f32x4 v0 = acc[ai][bj][m][0], v1 = acc[ai][bj][m][1];
                        if (act) {
#pragma unroll
                            for (int j = 0; j < 4; ++j) { v0[j] = silu1(v0[j]); v1[j] = silu1(v1[j]); } }
                        u32x4 w; w.x = pk_bf16(v0[0], v0[1]); w.y = pk_bf16(v0[2], v0[3]); w.z = pk_bf16(v1[0], v1[1]); w.w = pk_bf16(v1[2], v1[3]);
                        *(u32x4*)(rowp + bj * HALF) = w; } }
            return;
        }
        const int hd = u.pn, bat = (u.pm * BM) / 2048, cb = (u.pm & 7) * 8, k0 = wc * 32 + 8 * fq, lane = fq * 16 + fr;
        float lb[8];
        { const f32x4 l0 = *(const f32x4*)(LB + hd * 128 + k0), l1 = *(const f32x4*)(LB + hd * 128 + k0 + 4);
          lb[0] = l0[0]; lb[1] = l0[1]; lb[2] = l0[2]; lb[3] = l0[3]; lb[4] = l1[0]; lb[5] = l1[1]; lb[6] = l1[2]; lb[7] = l1[3]; }
#pragma unroll
        for (int ac = 0; ac < 4; ++ac) {
            const int ai = ac >> 1, cp = ac & 1;
            __builtin_amdgcn_sched_barrier(0);
            const size_t tile = ((size_t)(bat * 4 + hd) * 64 + cb + 4 * ai + 2 * wr + cp);
#pragma unroll
            for (int eh = 0; eh < 2; ++eh) {
                __builtin_amdgcn_sched_barrier(0);
                float tot0[4];
                bf16_t* hq = HQ + tile * 4096 + k0 + 4 * eh;
                bf16_t* hk = HK + tile * 4096 + k0 + 4 * eh;
#pragma unroll
                for (int mm = 0; mm < 2; ++mm) {
                    const f32x4 q4 = acc[ai][0][2 * cp + mm][eh], f4 = acc[ai][1][2 * cp + mm][eh];
                    float qo[4], ko[4], bl[4];
#pragma unroll
                    for (int e = 0; e < 4; ++e) {
                        const float lbe = lb[4 * eh + e];
                        const float f = lbe + (1.0f - lbe) * __builtin_amdgcn_rcpf(1.0f + __expf(-f4[e]));
                        float sc = __logf(f);
                        sc += __builtin_bit_cast(float, __builtin_amdgcn_update_dpp(0, __builtin_bit_cast(int, sc), 0x111, 0xf, 0xf, true));
                        sc += __builtin_bit_cast(float, __builtin_amdgcn_update_dpp(0, __builtin_bit_cast(int, sc), 0x112, 0xf, 0xf, true));
                        sc += __builtin_bit_cast(float, __builtin_amdgcn_update_dpp(0, __builtin_bit_cast(int, sc), 0x114, 0xf, 0xf, true));
                        sc += __builtin_bit_cast(float, __builtin_amdgcn_update_dpp(0, __builtin_bit_cast(int, sc), 0x118, 0xf, 0xf, true));
                        if (mm == 1) sc += tot0[e];
                        bl[e] = sc;
                        qo[e] = silu1(q4[e]) * __expf(sc); ko[e] = (1.0f - f) * __expf(fminf(-sc, 80.0f));
                    }
                    *(uint2*)(hq + (size_t)(mm * 16 + fr) * 128) = make_uint2(pk_bf16(qo[0], qo[1]), pk_bf16(qo[2], qo[3]));
                    *(uint2*)(hk + (size_t)(mm * 16 + fr) * 128) = make_uint2(pk_bf16(ko[0], ko[1]), pk_bf16(ko[2], ko[3]));
                    if (mm == 0) {
#pragma unroll
                        for (int e = 0; e < 4; ++e) tot0[e] = __shfl(bl[e], (lane & 48) | 15);
                    } else if (fr == 15) *(f32x4*)(HG + tile * 128 + k0 + 4 * eh) = (f32x4){__expf(bl[0]), __expf(bl[1]), __expf(bl[2]), __expf(bl[3])};
                    __builtin_amdgcn_sched_barrier(0);
                }
            }
        }
    }
};
struct EpiResid {
    static constexpr bool PERM = false, AFTER_DRAIN = false;
    float* C; const float* X; const float* mod_g;
    static constexpr int NTOK_ = 32768;
    float alpha; bf16_t* AP; const float* avec; float* stat;
    __device__ __forceinline__ void operator()(const f32x4 (&acc)[2][2][4][2], const Unit& u, int wr, int wc, int fr, int fq) const {
        const int row0 = u.pm * BM + wr * 64 + fr, col0 = u.pn * BM + wc * 32 + 4 * fq, bat = (u.pm * BM) / 2048;
        const float* gb = mod_g + (size_t)bat * 6144 + col0;
        const float* ab = avec + (size_t)bat * 1024 + col0;
        f32x4 gv[2][2], av[2][2];
#pragma unroll
        for (int bj = 0; bj < 2; ++bj)
#pragma unroll
            for (int n = 0; n < 2; ++n) { gv[bj][n] = *(const f32x4*)(gb + bj * HALF + n * 16) + 1.0f; av[bj][n] = *(const f32x4*)(ab + bj * HALF + n * 16); }
#pragma unroll
        for (int ai = 0; ai < 2; ++ai) {
            float s1[4], s2[4];
#pragma unroll
            for (int m = 0; m < 4; ++m) { const int row = row0 + ai * HALF + m * 16; const size_t ro = (size_t)row * 1024 + col0;
                s1[m] = 0.f; s2[m] = 0.f;
#pragma unroll
                for (int bj = 0; bj < 2; ++bj)
#pragma unroll
                    for (int n = 0; n < 2; ++n) {
                        const f32x4 xv = *(const f32x4*)(X + ro + bj * HALF + n * 16);
                        const f32x4 r1 = alpha * xv + gv[bj][n] * acc[ai][bj][m][n];
                        *(f32x4*)(C + ro + bj * HALF + n * 16) = r1;
                        const f32x4 ap = r1 * av[bj][n];
                        *(uint2*)(AP + ro + bj * HALF + n * 16) = make_uint2(pk_bf16(ap[0], ap[1]), pk_bf16(ap[2], ap[3]));
                        s1[m] += (r1[0] + r1[1]) + (r1[2] + r1[3]); s2[m] += (r1[0] * r1[0] + r1[1] * r1[1]) + (r1[2] * r1[2] + r1[3] * r1[3]);
                    }
            }
            const bool hi5 = fq & 2, hi4 = fq & 1;
            const float a1 = (hi5 ? s1[2] : s1[0]) + __shfl_xor(hi5 ? s1[0] : s1[2], 32), b1 = (hi5 ? s1[3] : s1[1]) + __shfl_xor(hi5 ? s1[1] : s1[3], 32);
            const float a2 = (hi5 ? s2[2] : s2[0]) + __shfl_xor(hi5 ? s2[0] : s2[2], 32), b2 = (hi5 ? s2[3] : s2[1]) + __shfl_xor(hi5 ? s2[1] : s2[3], 32);
            const float t1 = (hi4 ? b1 : a1) + __shfl_xor(hi4 ? a1 : b1, 16), t2 = (hi4 ? b2 : a2) + __shfl_xor(hi4 ? a2 : b2, 16);
            const int srow = u.pm * BM + wr * 64 + ai * HALF + fq * 16 + fr;
            atomicAdd(stat + srow, t1); atomicAdd(stat + NTOK_ + srow, t2);
        }
    }
};
struct EpiQLN {
    static constexpr bool PERM = true, AFTER_DRAIN = false;
    bf16_t* O; const float* stat; const float* ca; const float* cb; float eps;
    __device__ __forceinline__ void operator()(const f32x4 (&acc)[2][2][4][2], const Unit& u, int wr, int wc, int fr, int fq) const {
        const int row0 = u.pm * BM + wr * 64 + fr, col0 = u.pn * BM + wc * 32 + 8 * fq, bat = (u.pm * BM) / 2048;
        const float* cap = ca + (size_t)bat * 2048 + col0;
        const float* cbp = cb + (size_t)bat * 2048 + col0;
#pragma unroll
        for (int bj = 0; bj < 2; ++bj) {
            const f32x4 a0 = *(const f32x4*)(cap + bj * HALF), a1 = *(const f32x4*)(cap + bj * HALF + 4), b0 = *(const f32x4*)(cbp + bj * HALF), b1 = *(const f32x4*)(cbp + bj * HALF + 4);
#pragma unroll
            for (int ai = 0; ai < 2; ++ai)
#pragma unroll
                for (int m = 0; m < 4; ++m) {
                    const int row = row0 + ai * HALF + m * 16;
                    const float mu = stat[row] * (1.0f / 1024.0f), rstd = rsqrtf(fmaxf(stat[32768 + row] * (1.0f / 1024.0f) - mu * mu, 0.f) + eps);
                    const f32x4 v0 = rstd * (acc[ai][bj][m][0] - mu * a0) + b0, v1 = rstd * (acc[ai][bj][m][1] - mu * a1) + b1;
                    u32x4 w; w.x = pk_bf16(v0[0], v0[1]); w.y = pk_bf16(v0[2], v0[3]); w.z = pk_bf16(v1[0], v1[1]); w.w = pk_bf16(v1[2], v1[3]);
                    *(u32x4*)(O + (size_t)row * 2048 + col0 + bj * HALF) = w;
                }
        }
    }
};
struct EpiGlu {
    static constexpr bool PERM = false, AFTER_DRAIN = false;
    float* C; const bf16_t* Y; const float* bias;
    __device__ __forceinline__ void operator()(const f32x4 (&acc)[2][2][4][2], const Unit& u, int wr, int wc, int fr, int fq) const {
        const int row0 = u.pm * BM + wr * 64 + fr, col0 = u.pn * BM + wc * 32 + 4 * fq;
        f32x4 bv[2][2];
#pragma unroll
        for (int bj = 0; bj < 2; ++bj)
#pragma unroll
            for (int n = 0; n < 2; ++n) bv[bj][n] = *(const f32x4*)(bias + col0 + bj * HALF + n * 16);
#pragma unroll
        for (int ai = 0; ai < 2; ++ai)
#pragma unroll
            for (int m = 0; m < 4; ++m) { const size_t ro = (size_t)(row0 + ai * HALF + m * 16) * 512 + col0;
#pragma unroll
                for (int bj = 0; bj < 2; ++bj)
#pragma unroll
                    for (int n = 0; n < 2; ++n) {
                        const uint2 yw = *(const uint2*)(Y + ro + bj * HALF + n * 16);
                        const f32x4 z = acc[ai][bj][m][n] + bv[bj][n];
                        f32x4 o;
                        o[0] = __uint_as_float(yw.x << 16) * __builtin_amdgcn_rcpf(1.0f + __expf(-z[0])); o[1] = __uint_as_float(yw.x & 0xffff0000u) * __builtin_amdgcn_rcpf(1.0f + __expf(-z[1]));
                        o[2] = __uint_as_float(yw.y << 16) * __builtin_amdgcn_rcpf(1.0f + __expf(-z[2])); o[3] = __uint_as_float(yw.y & 0xffff0000u) * __builtin_amdgcn_rcpf(1.0f + __expf(-z[3]));
                        *(f32x4*)(C + ro + bj * HALF + n * 16) = o; } }
    }
};
}

DI void prep_mod_item(const Params& p, int item, char* smem) {
    float* condT = (float*)smem;
    float* red = condT + DM * 16;
    const int tid = my_tid();
    for (int i = tid; i < NB * DM; i += NTH) { const int b = i >> 10, k = i & 1023; condT[k * 16 + b] = siluf_(p.c[i]); }
    __syncthreads();
    const int ks = tid >> 5, col = tid & 31;
    float acc[16];
#pragma unroll
    for (int b = 0; b < 16; ++b) acc[b] = 0.f;
    const float* w = p.ada_w + (size_t)(ks * 64) * 6144 + item * 32 + col;
#pragma unroll 1
    for (int seg = 0; seg < 4; ++seg) {
        float wreg[16];
#pragma unroll
        for (int k = 0; k < 16; ++k) wreg[k] = w[(size_t)(seg * 16 + k) * 6144];
#pragma unroll
        for (int k = 0; k < 16; ++k) {
            const float wv = wreg[k];
            const f32x4* cb = (const f32x4*)(condT + (ks * 64 + seg * 16 + k) * 16);
            const f32x4 c0 = cb[0], c1 = cb[1], c2 = cb[2], c3 = cb[3];
            acc[0] += c0.x * wv; acc[1] += c0.y * wv; acc[2] += c0.z * wv; acc[3] += c0.w * wv;
            acc[4] += c1.x * wv; acc[5] += c1.y * wv; acc[6] += c1.z * wv; acc[7] += c1.w * wv;
            acc[8] += c2.x * wv; acc[9] += c2.y * wv; acc[10] += c2.z * wv; acc[11] += c2.w * wv;
            acc[12] += c3.x * wv; acc[13] += c3.y * wv; acc[14] += c3.z * wv; acc[15] += c3.w * wv;
        }
    }
#pragma unroll
    for (int b = 0; b < 16; ++b) red[(ks * 32 + col) * 16 + b] = acc[b];
    __syncthreads();
    {
        const int b = tid >> 5;
        float sum = p.ada_b[item * 32 + col];
#pragma unroll
        for (int q = 0; q < 16; ++q) sum += red[(q * 32 + col) * 16 + b];
        ((float*)(p.ws + OFF_MOD))[b * 6144 + item * 32 + col] = sum;
    }
    __syncthreads();
}
DI void prep_s5_gemm_item(const Params& p, int g, int part, char* smem) {
    f32x2* pw = (f32x2*)smem;
    f32x2* bbL = pw + 17 * 64;
    f32x2* cL = bbL + 64 * 16;
    const int tid = my_tid();
    const float dt = expf(p.log_dt[g]);
#pragma unroll 1
    for (int idx = tid; idx < 17 * 64; idx += NTH) {
        const int j = idx >> 6, pp = idx & 63;
        const float ar = p.a_re[g * 64 + pp], ai = p.a_im[g * 64 + pp];
        const float mag = expf(ar * dt * (float)j), ang = ai * dt * (float)j;
        pw[idx] = (f32x2){mag * cosf(ang), mag * sinf(ang)};
    }
    for (int idx = tid; idx < 16 * 64; idx += NTH) { const int i = idx >> 6, pp = idx & 63; cL[idx] = (f32x2){p.c_re[(g * 16 + i) * 64 + pp], p.c_im[(g * 16 + i) * 64 + pp]}; }
    __syncthreads();
    for (int idx = tid; idx < 64 * 16; idx += NTH) {
        const int pp = idx >> 4, i = idx & 15;
        const float ar = p.a_re[g * 64 + pp], ai = p.a_im[g * 64 + pp];
        const f32x2 lam = pw[64 + pp];
        const float den = ar * ar + ai * ai, nr = lam.x - 1.0f, ni = lam.y;
        const float zr = (nr * ar + ni * ai) / den, zi = (ni * ar - nr * ai) / den;
        const float br = p.b_re[(g * 64 + pp) * 16 + i], bi = p.b_im[(g * 64 + pp) * 16 + i];
        bbL[idx] = (f32x2){zr * br - zi * bi, zr * bi + zi * br};
    }
    __syncthreads();
    bf16_t* NBg = (bf16_t*)(p.ws + OFF_S5N) + (size_t)g * 128 * 256;
    if (part == 0)
#pragma unroll 1
    for (int ch = tid; ch < 128 * 256 / 8; ch += NTH) {
        const int pq = ch >> 5, t = (ch >> 1) & 15, i0 = (ch & 1) * 8, pp = pq & 63;
        const f32x2 w = pw[(15 - t) * 64 + pp];
        float v[8];
#pragma unroll
        for (int e = 0; e < 8; ++e) { const f32x2 bb = bbL[pp * 16 + i0 + e]; v[e] = pq < 64 ? (w.x * bb.x - w.y * bb.y) : (w.x * bb.y + w.y * bb.x); }
        u32x4 o; o.x = pack2(v[0], v[1]); o.y = pack2(v[2], v[3]); o.z = pack2(v[4], v[5]); o.w = pack2(v[6], v[7]);
        *(u32x4*)(NBg + (size_t)((((pq >> 5) * 16 + t) * 64) + (i0 >> 3) * 32 + (pq & 31)) * 8) = o;
    }
    bf16_t* MBg = (bf16_t*)(p.ws + OFF_S5M) + (size_t)g * 256 * 128;
    if (part == 1)
#pragma unroll 1
    for (int ch = tid; ch < 256 * 128 / 8; ch += NTH) {
        const int ti = ch >> 4, p0 = (ch & 15) * 8, tq = ti >> 4, iq = ti & 15;
        float v[8];
#pragma unroll
        for (int e = 0; e < 8; ++e) {
            const int pq = p0 + e, pp = pq & 63;
            const f32x2 c = cL[iq * 64 + pp], w = pw[(tq + 1) * 64 + pp];
            v[e] = pq < 64 ? (c.x * w.x - c.y * w.y) : -(c.x * w.y + c.y * w.x);
        }
        u32x4 o; o.x = pack2(v[0], v[1]); o.y = pack2(v[2], v[3]); o.z = pack2(v[4], v[5]); o.w = pack2(v[6], v[7]);
        *(u32x4*)(MBg + (size_t)((((ti >> 5) * 8 + (p0 >> 4)) * 64) + ((p0 >> 3) & 1) * 32 + (ti & 31)) * 8) = o;
    }
    bf16_t* KTg = (bf16_t*)(p.ws + OFF_S5K) + (size_t)g * 4096;
    if (part >= 2)
#pragma unroll 1
    for (int idx = (part - 2) * 2048 + tid; idx < (part - 1) * 2048; idx += NTH) {
        const int lag = idx >> 8, iq = (idx >> 4) & 15, i = idx & 15;
        float acc = (lag == 0 && iq == i) ? p.dsk[g * 16 + iq] : 0.f;
#pragma unroll 4
        for (int pp = 0; pp < 64; ++pp) {
            const f32x2 c = cL[iq * 64 + pp], w = pw[lag * 64 + pp], bb = bbL[pp * 16 + i];
            const float mr = c.x * w.x - c.y * w.y, mi_ = c.x * w.y + c.y * w.x;
            acc += mr * bb.x - mi_ * bb.y;
        }
        KTg[idx] = f2bf(acc);
    }
    if (part == 3 && tid < 64) { float* L = (float*)(p.ws + OFF_S5L) + (g * 64 + tid) * 2; const f32x2 w = pw[16 * 64 + tid]; L[0] = w.x; L[1] = w.y; }
    __syncthreads();
}
DI void prep_s5_item(const Params& p, int g) {
    const int tid = my_tid();
    if (tid < SSP) {
        const int pi = g * SSP + tid;
        const float dt = expf(p.log_dt[g]);
        const float ar = p.a_re[pi], ai = p.a_im[pi];
        const float mag = expf(ar * dt);
        const float lr = mag * cosf(ai * dt), li = mag * sinf(ai * dt);
        const float den = ar * ar + ai * ai, nr = lr - 1.0f, ni = li;
        const float zr = (nr * ar + ni * ai) / den, zi = (ni * ar - nr * ai) / den;
        float* lam = (float*)(p.ws + OFF_LAM) + pi * 2;
        lam[0] = lr; lam[1] = li;
        float* bb = (float*)(p.ws + OFF_BB) + (size_t)pi * 32;
        for (int i = 0; i < SSC; ++i) {
            const float br = p.b_re[pi * SSC + i], bi = p.b_im[pi * SSC + i];
            bb[i * 2] = zr * br - zi * bi; bb[i * 2 + 1] = zr * bi + zi * br;
        }
    }
}
DI void prep_transpose_tile(const float* __restrict__ W, bf16_t* __restrict__ Wt, int K, int N, int kt, int nt, char* smem, int dst_row0 = -1) {
    float* tile = (float*)smem;
    const int tid = my_tid();
#pragma unroll
    for (int q = 0; q < 2; ++q) {
        const int kk = (tid >> 4) + q * 32, c4 = (tid & 15) * 4;
        const float4 v = *(const float4*)(W + (size_t)(kt * 64 + kk) * N + nt * 64 + c4);
        tile[kk * 65 + c4] = v.x; tile[kk * 65 + c4 + 1] = v.y; tile[kk * 65 + c4 + 2] = v.z; tile[kk * 65 + c4 + 3] = v.w;
    }
    __syncthreads();
    const int n = tid >> 3, kc = tid & 7;
    uint4 o;
    o.x = pack2(tile[(kc * 8 + 0) * 65 + n], tile[(kc * 8 + 1) * 65 + n]);
    o.y = pack2(tile[(kc * 8 + 2) * 65 + n], tile[(kc * 8 + 3) * 65 + n]);
    o.z = pack2(tile[(kc * 8 + 4) * 65 + n], tile[(kc * 8 + 5) * 65 + n]);
    o.w = pack2(tile[(kc * 8 + 6) * 65 + n], tile[(kc * 8 + 7) * 65 + n]);
    *(uint4*)(Wt + (size_t)((dst_row0 < 0 ? nt * 64 : dst_row0) + n) * K + kt * 64 + kc * 8) = o;
    __syncthreads();
}
DI void cvt_bf16_stream(const float* __restrict__ src, bf16_t* __restrict__ dst, size_t n8, int bid, int nb) {
    for (size_t i = (size_t)bid * NTH + my_tid(); i < n8; i += (size_t)nb * NTH) {
        const float4 a = *(const float4*)(src + i * 8), b = *(const float4*)(src + i * 8 + 4);
        uint4 o; o.x = pack2(a.x, a.y); o.y = pack2(a.z, a.w); o.z = pack2(b.x, b.y); o.w = pack2(b.z, b.w);
        *(uint4*)(dst + i * 8) = o;
    }
}
DI void cvt_fp8_rows(const float* __restrict__ src, unsigned char* __restrict__ dst, float* __restrict__ inv, int bid, int nb) {
    const int lane = my_tid() & 63, wid = my_tid() >> 6;
    for (int row = bid * 8 + wid; row < NEXP; row += nb * 8) {
        const float* sp = src + (size_t)row * DM + lane * 16;
        const f32x4 a = *(const f32x4*)sp, b = *(const f32x4*)(sp + 4), c = *(const f32x4*)(sp + 8), d = *(const f32x4*)(sp + 12);
        float m = fmaxf(fmaxf(fmaxf(fabsf(a.x), fabsf(a.y)), fmaxf(fabsf(a.z), fabsf(a.w))), fmaxf(fmaxf(fabsf(b.x), fabsf(b.y)), fmaxf(fabsf(b.z), fabsf(b.w))));
        m = fmaxf(m, fmaxf(fmaxf(fmaxf(fabsf(c.x), fabsf(c.y)), fmaxf(fabsf(c.z), fabsf(c.w))), fmaxf(fmaxf(fabsf(d.x), fabsf(d.y)), fmaxf(fabsf(d.z), fabsf(d.w)))));
#pragma unroll
        for (int s = 1; s < 64; s <<= 1) m = fmaxf(m, __shfl_xor(m, s));
        float sc = 1.f, isc = 1.f;
        if (m > 1e-30f) {
            int k = (int)floorf(log2f(448.0f / m));
            k = k < -60 ? -60 : (k > 60 ? 60 : k);
            sc = ldexpf(1.0f, k); isc = ldexpf(1.0f, -k);
            if (m * sc > 448.0f) { sc *= 0.5f; isc *= 2.0f; }
        }
        u32x4 o;
        int w;
        w = __builtin_amdgcn_cvt_pk_fp8_f32(a.x * sc, a.y * sc, 0, false); w = __builtin_amdgcn_cvt_pk_fp8_f32(a.z * sc, a.w * sc, w, true); o.x = (unsigned)w;
        w = __builtin_amdgcn_cvt_pk_fp8_f32(b.x * sc, b.y * sc, 0, false); w = __builtin_amdgcn_cvt_pk_fp8_f32(b.z * sc, b.w * sc, w, true); o.y = (unsigned)w;
        w = __builtin_amdgcn_cvt_pk_fp8_f32(c.x * sc, c.y * sc, 0, false); w = __builtin_amdgcn_cvt_pk_fp8_f32(c.z * sc, c.w * sc, w, true); o.z = (unsigned)w;
        w = __builtin_amdgcn_cvt_pk_fp8_f32(d.x * sc, d.y * sc, 0, false); w = __builtin_amdgcn_cvt_pk_fp8_f32(d.z * sc, d.w * sc, w, true); o.w = (unsigned)w;
        *(u32x4*)(dst + (size_t)row * DM + lane * 16) = o;
        if (lane == 0) inv[row] = isc;
    }
}
DI void cvt_fp4_rows(const float* __restrict__ src, unsigned char* __restrict__ dst, float* __restrict__ inv, int bid, int nb) {
    const int lane = my_tid() & 63, wid = my_tid() >> 6;
    for (int row = bid * 8 + wid; row < NEXP; row += nb * 8) {
        const float* sp = src + (size_t)row * DM + lane * 16;
        const f32x4 a = *(const f32x4*)sp, b = *(const f32x4*)(sp + 4), c = *(const f32x4*)(sp + 8), d = *(const f32x4*)(sp + 12);
        float m = fmaxf(fmaxf(fmaxf(fabsf(a.x), fabsf(a.y)), fmaxf(fabsf(a.z), fabsf(a.w))), fmaxf(fmaxf(fabsf(b.x), fabsf(b.y)), fmaxf(fabsf(b.z), fabsf(b.w))));
        m = fmaxf(m, fmaxf(fmaxf(fmaxf(fabsf(c.x), fabsf(c.y)), fmaxf(fabsf(c.z), fabsf(c.w))), fmaxf(fmaxf(fabsf(d.x), fabsf(d.y)), fmaxf(fabsf(d.z), fabsf(d.w)))));
#pragma unroll
        for (int s = 1; s < 64; s <<= 1) m = fmaxf(m, __shfl_xor(m, s));
        const float sc = m > 1e-30f ? 6.0f / m : 1.0f, isc = m > 1e-30f ? m * (1.0f / 6.0f) : 1.0f;
        unsigned w0 = 0u, w1 = 0u;
        w0 = __builtin_amdgcn_cvt_scalef32_pk_fp4_f32(w0, a.x * sc, a.y * sc, 1.0f, 0); w0 = __builtin_amdgcn_cvt_scalef32_pk_fp4_f32(w0, a.z * sc, a.w * sc, 1.0f, 1);
        w0 = __builtin_amdgcn_cvt_scalef32_pk_fp4_f32(w0, b.x * sc, b.y * sc, 1.0f, 2); w0 = __builtin_amdgcn_cvt_scalef32_pk_fp4_f32(w0, b.z * sc, b.w * sc, 1.0f, 3);
        w1 = __builtin_amdgcn_cvt_scalef32_pk_fp4_f32(w1, c.x * sc, c.y * sc, 1.0f, 0); w1 = __builtin_amdgcn_cvt_scalef32_pk_fp4_f32(w1, c.z * sc, c.w * sc, 1.0f, 1);
        w1 = __builtin_amdgcn_cvt_scalef32_pk_fp4_f32(w1, d.x * sc, d.y * sc, 1.0f, 2); w1 = __builtin_amdgcn_cvt_scalef32_pk_fp4_f32(w1, d.z * sc, d.w * sc, 1.0f, 3);
        *(uint2*)(dst + (size_t)row * (DM / 2) + lane * 8) = make_uint2(w0, w1);
        if (lane == 0) inv[row] = isc;
    }
}
template <int OFFS>
DI void cvt_i8_rows(const float* __restrict__ src, unsigned char* __restrict__ dst, float* __restrict__ inv, int bid, int nb) {
    const int lane = my_tid() & 63, wid = my_tid() >> 6;
    for (int row = bid * 8 + wid; row < NEXP; row += nb * 8) {
        const float* sp = src + (size_t)row * DM + lane * 16;
        const f32x4 a = *(const f32x4*)sp, b = *(const f32x4*)(sp + 4), c = *(const f32x4*)(sp + 8), d = *(const f32x4*)(sp + 12);
        float m = fmaxf(fmaxf(fmaxf(fabsf(a.x), fabsf(a.y)), fmaxf(fabsf(a.z), fabsf(a.w))), fmaxf(fmaxf(fabsf(b.x), fabsf(b.y)), fmaxf(fabsf(b.z), fabsf(b.w))));
        m = fmaxf(m, fmaxf(fmaxf(fmaxf(fabsf(c.x), fabsf(c.y)), fmaxf(fabsf(c.z), fabsf(c.w))), fmaxf(fmaxf(fabsf(d.x), fabsf(d.y)), fmaxf(fabsf(d.z), fabsf(d.w)))));
#pragma unroll
        for (int s = 1; s < 64; s <<= 1) m = fmaxf(m, __shfl_xor(m, s));
        const float sc = m > 1e-30f ? 127.0f / m : 1.0f, isc = m > 1e-30f ? m * (1.0f / 127.0f) : 1.0f;
        const float v[16] = {a.x, a.y, a.z, a.w, b.x, b.y, b.z, b.w, c.x, c.y, c.z, c.w, d.x, d.y, d.z, d.w};
        unsigned w[4];
#pragma unroll
        for (int q = 0; q < 4; ++q) {
            unsigned pk = 0u;
#pragma unroll
            for (int e = 0; e < 4; ++e) { const int qi = (int)rintf(v[q * 4 + e] * sc) + OFFS; pk |= ((unsigned)qi & 0xffu) << (8 * e); }
            w[q] = pk;
        }
        *(u32x4*)(dst + (size_t)row * DM + lane * 16) = (u32x4){w[0], w[1], w[2], w[3]};
        if (lane == 0) inv[row] = isc;
    }
}
DI void prep_cab_item(const Params& p, int item, char* smem) {
    float* vT = (float*)smem;
    float* red = vT + DM * 16;
    const float* mod = (const float*)(p.ws + OFF_MOD);
    const int tid = my_tid(), ks = tid >> 5, col = tid & 31;
    const float* w = p.w_q + (size_t)(ks * 64) * 2048 + item * 32 + col;
#pragma unroll 1
    for (int which = 0; which < 2; ++which) {
        for (int i = tid; i < NB * DM; i += NTH) {
            const int b = i >> 10, k = i & 1023;
            const float sc = 1.0f + mod[b * 6144 + 4096 + k];
            const float v = which == 0 ? p.ln1w[k] * sc : p.ln1b[k] * sc + mod[b * 6144 + 3072 + k];
            vT[k * 16 + b] = v;
            if (item == 0) ((float*)(p.ws + OFF_AB))[(size_t)which * NB * DM + i] = v;
        }
        __syncthreads();
        float acc[16];
#pragma unroll
        for (int b = 0; b < 16; ++b) acc[b] = 0.f;
#pragma unroll 1
        for (int seg = 0; seg < 4; ++seg) {
            float wreg[16];
#pragma unroll
            for (int k = 0; k < 16; ++k) wreg[k] = w[(size_t)(seg * 16 + k) * 2048];
#pragma unroll
            for (int k = 0; k < 16; ++k) {
                const float wv = wreg[k];
                const f32x4* cb = (const f32x4*)(vT + (ks * 64 + seg * 16 + k) * 16);
                const f32x4 c0 = cb[0], c1 = cb[1], c2 = cb[2], c3 = cb[3];
                acc[0] += c0.x * wv; acc[1] += c0.y * wv; acc[2] += c0.z * wv; acc[3] += c0.w * wv;
                acc[4] += c1.x * wv; acc[5] += c1.y * wv; acc[6] += c1.z * wv; acc[7] += c1.w * wv;
                acc[8] += c2.x * wv; acc[9] += c2.y * wv; acc[10] += c2.z * wv; acc[11] += c2.w * wv;
                acc[12] += c3.x * wv; acc[13] += c3.y * wv; acc[14] += c3.z * wv; acc[15] += c3.w * wv;
            }
        }
#pragma unroll
        for (int b = 0; b < 16; ++b) red[(ks * 32 + col) * 16 + b] = acc[b];
        __syncthreads();
        {
            const int b = tid >> 5;
            float sum = 0.f;
#pragma unroll
            for (int q = 0; q < 16; ++q) sum += red[(q * 32 + col) * 16 + b];
            ((float*)(p.ws + OFF_CAB))[(size_t)which * NB * 2048 + b * 2048 + item * 32 + col] = sum;
        }
        __syncthreads();
    }
}
DI void phase_h(const Params& p, int bid, int nb) {
    const float* mod = (const float*)(p.ws + OFF_MOD);
    bf16_t* H = (bf16_t*)(p.ws + OFF_H);
    const size_t n8 = (size_t)NTOK * DM / 8;
    for (size_t i = (size_t)bid * NTH + my_tid(); i < n8; i += (size_t)nb * NTH) {
        const int row = (int)(i >> 7), c0 = (int)(i & 127) * 8, b = row / SEQ;
        const float* sh = mod + b * 6144 + c0;
        const float* sc = sh + 1024;
        const float4 a = *(const float4*)(p.x + i * 8), bq = *(const float4*)(p.x + i * 8 + 4);
        const float4 s0 = *(const float4*)sc, s1 = *(const float4*)(sc + 4), h0 = *(const float4*)sh, h1 = *(const float4*)(sh + 4);
        uint4 o;
        o.x = pack2(a.x * (1.f + s0.x) + h0.x, a.y * (1.f + s0.y) + h0.y);
        o.y = pack2(a.z * (1.f + s0.z) + h0.z, a.w * (1.f + s0.w) + h0.w);
        o.z = pack2(bq.x * (1.f + s1.x) + h1.x, bq.y * (1.f + s1.y) + h1.y);
        o.w = pack2(bq.z * (1.f + s1.z) + h1.z, bq.w * (1.f + s1.w) + h1.w);
        *(uint4*)(H + i * 8) = o;
    }
}

DI int wq_next(unsigned* ctr, char* smem) {
    volatile unsigned* slot = (volatile unsigned*)(smem + SMEM_BYTES - 8);
    __syncthreads();
    if (__builtin_amdgcn_workitem_id_x() == 0) *slot = __hip_atomic_fetch_add(ctr, 1u, __ATOMIC_RELAXED, __HIP_MEMORY_SCOPE_AGENT);
    __syncthreads();
    return (int)*slot;
}
DI void phase_prep_a(const Params& p, char* smem) {
    unsigned* ctr = (unsigned*)(p.ws + OFF_BAR) + 120;
    constexpr int U_S5 = 192, U_LB = 320, U_TR = 321, U_UT = U_TR + 368, U_VT = U_UT + 128, U_MISC = U_VT + 128, U_END = U_MISC + 8;
    for (int u = wq_next(ctr, smem); u < U_END; u = wq_next(ctr, smem)) {
        if (u < U_S5) prep_mod_item(p, u, smem);
        else if (u < U_LB) prep_s5_gemm_item(p, (u - U_S5) >> 2, (u - U_S5) & 3, smem);
        else if (u < U_TR) {
            const int j = my_tid();
            const float a0 = p.hg_lb[j], a1 = p.hg_lb[512 + j], m = fmaxf(a0, a1);
            const float e0 = expf(a0 - m), e1 = expf(a1 - m);
            ((float*)(p.ws + OFF_LB))[j] = e0 / (e0 + e1);
        } else if (u < U_UT) {
            for (int it = (u - U_TR) * 4; it < (u - U_TR) * 4 + 4; ++it) {
                constexpr int T_WIN = 16 * 40, T_GLU = 8 * 8, T_WOUT = 16 * 16;
                constexpr int I_GLU = T_WIN, I_WOUT = I_GLU + T_GLU, I_WQ = I_WOUT + T_WOUT;
                if (it < I_GLU) { const int t = it, n0 = (t % 40) * 64;
                    const int d0 = n0 < 512 ? (n0 >> 7) * 256 + (n0 & 127) : (n0 < 1024 ? ((n0 - 512) >> 7) * 256 + 128 + (n0 & 127) : n0);
                    prep_transpose_tile(p.w_in, (bf16_t*)(p.ws + OFF_WIN), DM, INC, t / 40, t % 40, smem, d0); }
                else if (it < I_WOUT) { const int t = it - I_GLU; prep_transpose_tile(p.glu_w, (bf16_t*)(p.ws + OFF_GLU), 512, 512, t / 8, t % 8, smem); }
                else if (it < I_WQ) { const int t = it - I_WOUT; prep_transpose_tile(p.w_out, (bf16_t*)(p.ws + OFF_WOUT), DM, DM, t / 16, t % 16, smem); }
                else { const int t = it - I_WQ; prep_transpose_tile(p.w_q, (bf16_t*)(p.ws + OFF_WQ), DM, 2048, t / 32, t % 32, smem); }
            }
        } else if (u < U_VT) cvt_i8_rows<0>(p.pu, (unsigned char*)(p.ws + OFF_UT), (float*)(p.ws + OFF_SU), u - U_UT, 128);
        else if (u < U_MISC) cvt_i8_rows<128>(p.pv, (unsigned char*)(p.ws + OFF_VT), (float*)(p.ws + OFF_SV), u - U_VT, 128);
        else {
            const int q = u - U_MISC;
            cvt_bf16_stream(p.subk, (bf16_t*)(p.ws + OFF_SUBK), (size_t)16 * 128 * 128 / 8, q, 8);
            for (size_t i = (size_t)q * NTH + my_tid(); i < (size_t)NTOK * 2 / 4; i += (size_t)8 * NTH) ((f32x4*)(p.ws + OFF_STAT))[i] = (f32x4){0.f, 0.f, 0.f, 0.f};
        }
    }
}
DI void phase_prep_b(const Params& p, char* smem) {
    unsigned* ctr = (unsigned*)(p.ws + OFF_BAR) + 121;
    for (int u = wq_next(ctr, smem); u < 64 + 256; u = wq_next(ctr, smem)) {
        if (u < 64) prep_cab_item(p, u, smem); else phase_h(p, u - 64, 256);
    }
}

DI void phase_proj(const Params& p, int bid, int nb, char* smem) {
    pg8::Gemm g{(const bf16_t*)(p.ws + OFF_H), (const bf16_t*)(p.ws + OFF_WIN), NTOK, INC, DM};
    pg8::StaticOrder S; S.init(NTOK, INC, nb, bid);
    pg8::EpiProj E{(bf16_t*)(p.ws + OFF_PROJ), (bf16_t*)(p.ws + OFF_HQ), (bf16_t*)(p.ws + OFF_HK), (float*)(p.ws + OFF_HG), (const float*)(p.ws + OFF_LB)};
    pg8::gemm_phase<pg8::EpiProj, pg8::StaticOrder, false>((PG8_LAS unsigned char*)smem, g, S, E, nullptr);
}

DI void hgrn_item(const Params& p, int item, char* smem) {
    const int vs = item & 7, hd = (item >> 3) & 3, b = item >> 5;
    const bf16_t* P = (const bf16_t*)(p.ws + OFF_PROJ);
    const float* lb = (const float*)(p.ws + OFF_LB) + hd * HDK;
    float* ORAW = (float*)(p.ws + OFF_ORAW);
    float* sq = (float*)smem;
    float* sf = sq + 32 * 128;
    float* sv = sf + 32 * 128;
    float* sp = sv + 32 * 16;
    const int tid = my_tid(), lane = tid & 63, wid = tid >> 6, kq = tid >> 4, v = tid & 15;
    float S0 = 0.f, S1 = 0.f, S2 = 0.f, S3 = 0.f;
    for (int t0 = 0; t0 < SEQ; t0 += 32) {
        for (int i = tid; i < 32 * 128; i += NTH) {
            const int t = i >> 7, k = i & 127;
            const bf16_t* row = P + (size_t)(b * SEQ + t0 + t) * INC + hd * HDK + k;
            sq[i] = bf2f(row[0]);
            const float l = lb[k];
            sf[i] = l + (1.0f - l) * sigmoidf_(bf2f(row[512]));
        }
        { const int t = tid >> 4; sv[tid] = bf2f(P[(size_t)(b * SEQ + t0 + t) * INC + 1024 + hd * HDK + vs * 16 + v]); }
        __syncthreads();
        for (int t = 0; t < 32; ++t) {
            const float4 f4 = *(const float4*)(sf + t * 128 + kq * 4), q4 = *(const float4*)(sq + t * 128 + kq * 4);
            const float vv = sv[t * 16 + v];
            S0 = f4.x * S0 + (1.0f - f4.x) * vv; S1 = f4.y * S1 + (1.0f - f4.y) * vv;
            S2 = f4.z * S2 + (1.0f - f4.z) * vv; S3 = f4.w * S3 + (1.0f - f4.w) * vv;
            float part = q4.x * S0 + q4.y * S1 + q4.z * S2 + q4.w * S3;
            part += __shfl_xor(part, 16); part += __shfl_xor(part, 32);
            if (lane < 16) sp[(t * 8 + wid) * 16 + v] = part;
        }
        __syncthreads();
        {
            const int t = tid >> 4;
            float o = 0.f;
#pragma unroll
            for (int w = 0; w < 8; ++w) o += sp[(t * 8 + w) * 16 + v];
            ORAW[(size_t)(b * SEQ + t0 + t) * DHG + hd * HDK + vs * 16 + v] = o;
        }
        __syncthreads();
    }
}
DI void s5_item(const Params& p, int item, char* smem) {
    const int oct = item & 3, b = item >> 2;
    const int tid = my_tid(), lane = tid & 63, wid = tid >> 6, g = oct * 8 + wid;
    const bf16_t* P = (const bf16_t*)(p.ws + OFF_PROJ);
    bf16_t* Y = (bf16_t*)(p.ws + OFF_YSSM);
    float* su = (float*)smem + wid * 64 * 16;
    const float* lam = (const float*)(p.ws + OFF_LAM) + (g * SSP + lane) * 2;
    const float lr = lam[0], li = lam[1];
    const float* bb = (const float*)(p.ws + OFF_BB) + (size_t)(g * SSP + lane) * 32;
    float bbr[16], bbi[16], cr[16], ci[16];
#pragma unroll
    for (int i = 0; i < 16; ++i) { bbr[i] = bb[2 * i]; bbi[i] = bb[2 * i + 1]; cr[i] = p.c_re[(g * SSC + i) * SSP + lane]; ci[i] = p.c_im[(g * SSC + i) * SSP + lane]; }
    const int ch = (lane >> 2) & 15;
    const float dch = p.dsk[g * SSC + ch];
    float xr = 0.f, xi = 0.f;
    for (int t0 = 0; t0 < SEQ; t0 += 64) {
        {
            const uint4* src = (const uint4*)(P + (size_t)(b * SEQ + t0 + lane) * INC + 2048 + g * SSC);
            const uint4 a = src[0], c = src[1];
            float* d = su + lane * 16;
            d[0] = bflo(a.x); d[1] = bfhi(a.x); d[2] = bflo(a.y); d[3] = bfhi(a.y); d[4] = bflo(a.z); d[5] = bfhi(a.z); d[6] = bflo(a.w); d[7] = bfhi(a.w);
            d[8] = bflo(c.x); d[9] = bfhi(c.x); d[10] = bflo(c.y); d[11] = bfhi(c.y); d[12] = bflo(c.z); d[13] = bfhi(c.z); d[14] = bflo(c.w); d[15] = bfhi(c.w);
        }
        __syncthreads();
        for (int t = 0; t < 64; ++t) {
            float u[16];
            const float4* us = (const float4*)(su + t * 16);
            const float4 u0 = us[0], u1 = us[1], u2 = us[2], u3 = us[3];
            u[0] = u0.x; u[1] = u0.y; u[2] = u0.z; u[3] = u0.w; u[4] = u1.x; u[5] = u1.y; u[6] = u1.z; u[7] = u1.w;
            u[8] = u2.x; u[9] = u2.y; u[10] = u2.z; u[11] = u2.w; u[12] = u3.x; u[13] = u3.y; u[14] = u3.z; u[15] = u3.w;
            float bur = 0.f, bui = 0.f;
#pragma unroll
            for (int i = 0; i < 16; ++i) { bur += bbr[i] * u[i]; bui += bbi[i] * u[i]; }
            const float nxr = lr * xr - li * xi + bur, nxi = lr * xi + li * xr + bui;
            xr = nxr; xi = nxi;
            float y[16];
#pragma unroll
            for (int i = 0; i < 16; ++i) y[i] = cr[i] * xr - ci[i] * xi;
            const bool b5 = lane & 32, b4 = lane & 16, b3 = lane & 8, b2 = lane & 4;
            float y8[8], y4[4], y2[2];
#pragma unroll
            for (int j = 0; j < 8; ++j) { const float keep = b5 ? y[8 + j] : y[j], send = b5 ? y[j] : y[8 + j]; y8[j] = keep + __shfl_xor(send, 32); }
#pragma unroll
            for (int j = 0; j < 4; ++j) { const float keep = b4 ? y8[4 + j] : y8[j], send = b4 ? y8[j] : y8[4 + j]; y4[j] = keep + __shfl_xor(send, 16); }
#pragma unroll
            for (int j = 0; j < 2; ++j) { const float keep = b3 ? y4[2 + j] : y4[j], send = b3 ? y4[j] : y4[2 + j]; y2[j] = keep + __shfl_xor(send, 8); }
            float y1;
            { const float keep = b2 ? y2[1] : y2[0], send = b2 ? y2[0] : y2[1]; y1 = keep + __shfl_xor(send, 4); }
            y1 += __shfl_xor(y1, 1); y1 += __shfl_xor(y1, 2);
            if ((lane & 3) == 0) {
                const float uu = su[t * 16 + ch];
                Y[(size_t)(b * SEQ + t0 + t) * DSS + g * SSC + ch] = f2bf(geluf_(y1 + dch * uu));
            }
        }
        __syncthreads();
    }
}
DI int crow(int i, int h) { return (i & 3) + 8 * (i >> 2) + 4 * h; }
DI void phase_hgprep(const Params& p, int bid, int nb) {
    const bf16_t* P = (const bf16_t*)(p.ws + OFF_PROJ);
    const float* lbp = (const float*)(p.ws + OFF_LB);
    const int tid = my_tid(), lane = tid & 63, wid = tid >> 6, tq = lane >> 4, cg = lane & 15;
#pragma unroll 1
    for (int it = bid * 8 + wid; it < 8192; it += nb * 8) {
        const int tile = it >> 1, c = tile & 63, hd = (tile >> 6) & 3, b = tile >> 8, k0 = (it & 1) * 64 + cg * 4;
        const bf16_t* base = P + (size_t)(b * SEQ + c * 32 + tq * 8) * INC + hd * HDK + k0;
        uint2 qw[8], fw[8];
#pragma unroll
        for (int tt = 0; tt < 8; ++tt) { qw[tt] = *(const uint2*)(base + (size_t)tt * INC); fw[tt] = *(const uint2*)(base + (size_t)tt * INC + 512); }
        const f32x4 l4 = *(const f32x4*)(lbp + hd * HDK + k0);
        const float lb4[4] = {l4.x, l4.y, l4.z, l4.w};
        float bl[8][4], kk[8][4], run[4];
#pragma unroll
        for (int e = 0; e < 4; ++e) run[e] = 0.f;
#pragma unroll
        for (int tt = 0; tt < 8; ++tt) {
            const float fl[4] = {bflo(fw[tt].x), bfhi(fw[tt].x), bflo(fw[tt].y), bfhi(fw[tt].y)};
#pragma unroll
            for (int e = 0; e < 4; ++e) {
                const float f = lb4[e] + (1.0f - lb4[e]) * sigmoidf_(fl[e]);
                run[e] += __logf(f); bl[tt][e] = run[e]; kk[tt][e] = 1.0f - f;
            }
        }
        float off[4], tot[4];
#pragma unroll
        for (int e = 0; e < 4; ++e) {
            const float t0 = __shfl(run[e], cg), t1 = __shfl(run[e], cg + 16), t2 = __shfl(run[e], cg + 32), t3 = __shfl(run[e], cg + 48);
            off[e] = (tq > 0 ? t0 : 0.f) + (tq > 1 ? t1 : 0.f) + (tq > 2 ? t2 : 0.f);
            tot[e] = (t0 + t1) + (t2 + t3);
        }
        bf16_t* HQ = (bf16_t*)(p.ws + OFF_HQ) + (size_t)tile * 4096 + (tq * 8) * 128 + k0;
        bf16_t* HK = (bf16_t*)(p.ws + OFF_HK) + (size_t)tile * 4096 + (tq * 8) * 128 + k0;
#pragma unroll
        for (int tt = 0; tt < 8; ++tt) {
            const float qv[4] = {bflo(qw[tt].x), bfhi(qw[tt].x), bflo(qw[tt].y), bfhi(qw[tt].y)};
            float qo[4], ko[4];
#pragma unroll
            for (int e = 0; e < 4; ++e) { const float bb = off[e] + bl[tt][e]; qo[e] = qv[e] * __expf(bb); ko[e] = kk[tt][e] * __expf(fminf(-bb, 80.0f)); }
            *(uint2*)(HQ + tt * 128) = make_uint2(pack2(qo[0], qo[1]), pack2(qo[2], qo[3]));
            *(uint2*)(HK + tt * 128) = make_uint2(pack2(ko[0], ko[1]), pack2(ko[2], ko[3]));
        }
        if (tq == 0) *(f32x4*)((float*)(p.ws + OFF_HG) + (size_t)tile * 128 + k0) = (f32x4){__expf(tot[0]), __expf(tot[1]), __expf(tot[2]), __expf(tot[3])};
    }
}
typedef short s16x4 __attribute__((ext_vector_type(4)));
DI bf16x8 cat8(const s16x4 lo, const s16x4 hi) { return (bf16x8){lo.x, lo.y, lo.z, lo.w, hi.x, hi.y, hi.z, hi.w}; }
DI s16x4 lds_tr(const char* a) { return __builtin_amdgcn_ds_read_tr16_b64_v4i16((__attribute__((address_space(3))) s16x4*)a); }
DI void hgrn_mfma_item(const Params& p, int item, char* smem) {
    constexpr int QP_OFF = 0, KP_OFF = 8704, V_OFF = 17408, G_OFF = 26112, BUF = 26624, OB_OFF = 3 * BUF, OB_STRIDE = 132, OB_BYTES = 32 * OB_STRIDE * 4;
    const int tid = my_tid(), lane = tid & 63, wid = tid >> 6, r = lane & 31, h = lane >> 5;
    const int b = item >> 2, hd = item & 3;
    const size_t tile0 = (size_t)item * 64;
    const bf16_t* HQ = (const bf16_t*)(p.ws + OFF_HQ) + tile0 * 4096;
    const bf16_t* HK = (const bf16_t*)(p.ws + OFF_HK) + tile0 * 4096;
    const bf16_t* PV = (const bf16_t*)(p.ws + OFF_PROJ) + (size_t)b * SEQ * INC + 1024 + hd * HDK;
    const float* HG = (const float*)(p.ws + OFF_HG) + tile0 * 128;
    bf16_t* A2out = (bf16_t*)(p.ws + OFF_A2) + (size_t)b * SEQ * DM + hd * HDK;
    const bf16_t* PG = (const bf16_t*)(p.ws + OFF_PROJ) + (size_t)b * SEQ * INC + 1536 + hd * HDK;
    const bool helper = wid >= 4;
    const int ht = tid - 256;
    const int i0 = ht, i1 = ht + 256;
    const int lo0 = (i0 >> 4) * 272 + (i0 & 15) * 16, lo1 = (i1 >> 4) * 272 + (i1 & 15) * 16;
    u32x4 A0, A1, A2, A3, A4, A5, A6, B0, B1, B2, B3, B4, B5, B6;
    A0 = A1 = A2 = A3 = A4 = A5 = A6 = B0 = B1 = B2 = B3 = B4 = B5 = B6 = (u32x4){0, 0, 0, 0};
    f32x16 S[4];
#pragma unroll
    for (int kb = 0; kb < 4; ++kb)
#pragma unroll
        for (int i = 0; i < 16; ++i) S[kb][i] = 0.f;
#define HG_LOAD(X, c_) { const size_t o_ = (size_t)(c_) * 4096; \
        X##0 = *(const u32x4*)(HQ + o_ + i0 * 8); X##1 = *(const u32x4*)(HQ + o_ + i1 * 8); \
        X##2 = *(const u32x4*)(HK + o_ + i0 * 8); X##3 = *(const u32x4*)(HK + o_ + i1 * 8); \
        X##4 = *(const u32x4*)(PV + (size_t)((c_) * 32 + (i0 >> 4)) * INC + (i0 & 15) * 8); X##5 = *(const u32x4*)(PV + (size_t)((c_) * 32 + (i1 >> 4)) * INC + (i1 & 15) * 8); \
        if (ht < 32) X##6 = *(const u32x4*)(HG + (size_t)(c_) * 128 + ht * 4); }
#define HG_STORE(X, buf_) { char* B_ = smem + (buf_) * BUF; \
        *(u32x4*)(B_ + QP_OFF + lo0) = X##0; *(u32x4*)(B_ + QP_OFF + lo1) = X##1; \
        *(u32x4*)(B_ + KP_OFF + lo0) = X##2; *(u32x4*)(B_ + KP_OFF + lo1) = X##3; \
        *(u32x4*)(B_ + V_OFF + lo0) = X##4; *(u32x4*)(B_ + V_OFF + lo1) = X##5; \
        if (ht < 32) *(u32x4*)(B_ + G_OFF + ht * 16) = X##6; }
    const int tq = (lane >> 2) & 3, tp = lane & 3, tg = lane >> 4;
    const int tr_nat = (8 * (tg >> 1) + tq) * 272 + (16 * (tg & 1) + 4 * tp) * 2;
    const int tr_krw = (4 * (tg >> 1) + tq) * 272 + (16 * (tg & 1) + 4 * tp) * 2;
    if (helper) { HG_LOAD(A, 0); HG_STORE(A, 0); HG_LOAD(A, 1); HG_STORE(A, 1); HG_LOAD(A, 2); HG_LOAD(B, 3); }
    __syncthreads();
#define HG_COMPUTE(c_) { \
        const char* B = smem + ((c_) % 3) * BUF; const int w = wid; \
        f32x16 pt; _Pragma("unroll") for (int i = 0; i < 16; ++i) pt[i] = 0.f; \
        _Pragma("unroll") for (int ks = 0; ks < 8; ++ks) { \
            const bf16x8 a = *(const bf16x8*)(B + KP_OFF + r * 272 + ks * 32 + h * 16); \
            const bf16x8 bq = *(const bf16x8*)(B + QP_OFF + r * 272 + ks * 32 + h * 16); \
            pt = __builtin_amdgcn_mfma_f32_32x32x16_bf16(a, bq, pt, 0, 0, 0); } \
        _Pragma("unroll") for (int i = 0; i < 16; ++i) if (crow(i, h) > r) pt[i] = 0.f; \
        f32x16 o; _Pragma("unroll") for (int i = 0; i < 16; ++i) o[i] = 0.f; \
        _Pragma("unroll") for (int sp = 0; sp < 2; ++sp) { \
            const char* vb = B + V_OFF + (16 * sp) * 272 + (32 * w) * 2 + tr_krw; \
            const bf16x8 bv = cat8(lds_tr(vb), lds_tr(vb + 8 * 272)); \
            o = __builtin_amdgcn_mfma_f32_32x32x16_bf16(pack8(pt, 8 * sp), bv, o, 0, 0, 0); } \
        _Pragma("unroll") for (int kb = 0; kb < 4; ++kb) _Pragma("unroll") for (int sp = 0; sp < 2; ++sp) { \
            const char* qb = B + QP_OFF + r * 272 + kb * 64 + sp * 32 + h * 8; \
            const bf16x8 aq = cat8(*(const s16x4*)qb, *(const s16x4*)(qb + 16)); \
            o = __builtin_amdgcn_mfma_f32_32x32x16_bf16(aq, pack8(S[kb], 8 * sp), o, 0, 0, 0); } \
        { float* ob_ = (float*)(smem + OB_OFF + ((c_) & 1) * OB_BYTES); _Pragma("unroll") for (int i = 0; i < 16; ++i) ob_[crow(i, h) * OB_STRIDE + 32 * w + r] = o[i]; } \
        bf16x8 bvn[2]; \
        _Pragma("unroll") for (int ks = 0; ks < 2; ++ks) { const char* vb = B + V_OFF + (16 * ks) * 272 + (32 * w) * 2 + tr_nat; bvn[ks] = cat8(lds_tr(vb), lds_tr(vb + 4 * 272)); } \
        _Pragma("unroll") for (int kb = 0; kb < 4; ++kb) { \
            _Pragma("unroll") for (int ks = 0; ks < 2; ++ks) { \
                const char* kp = B + KP_OFF + (16 * ks) * 272 + (32 * kb) * 2 + tr_nat; \
                const bf16x8 a = cat8(lds_tr(kp), lds_tr(kp + 4 * 272)); \
                S[kb] = __builtin_amdgcn_mfma_f32_32x32x16_bf16(a, bvn[ks], S[kb], 0, 0, 0); } \
            _Pragma("unroll") for (int j = 0; j < 4; ++j) { \
                const f32x4 g4 = *(const f32x4*)(B + G_OFF + (kb * 32 + 8 * j + 4 * h) * 4); \
                S[kb][4 * j] *= g4.x; S[kb][4 * j + 1] *= g4.y; S[kb][4 * j + 2] *= g4.z; S[kb][4 * j + 3] *= g4.w; } } }
    f32x4 nw0, nw1, nw2, nw3;
    nw0 = nw1 = nw2 = nw3 = (f32x4){0.f, 0.f, 0.f, 0.f};
    if (helper) { const float* nwp = p.hg_nw + hd * HDK + (ht & 7) * 16; nw0 = *(const f32x4*)nwp; nw1 = *(const f32x4*)(nwp + 4); nw2 = *(const f32x4*)(nwp + 8); nw3 = *(const f32x4*)(nwp + 12); }
#define HG_NORM(cc_) { const int t_ = ht >> 3, sg_ = ht & 7; \
        const float* ob_ = (const float*)(smem + OB_OFF + ((cc_) & 1) * OB_BYTES) + t_ * OB_STRIDE + sg_ * 16; \
        const f32x4 o0 = *(const f32x4*)ob_, o1 = *(const f32x4*)(ob_ + 4), o2 = *(const f32x4*)(ob_ + 8), o3 = *(const f32x4*)(ob_ + 12); \
        const u32x4 g0 = *(const u32x4*)(PG + (size_t)((cc_) * 32 + t_) * INC + sg_ * 16), g1 = *(const u32x4*)(PG + (size_t)((cc_) * 32 + t_) * INC + sg_ * 16 + 8); \
        float ss = (o0.x * o0.x + o0.y * o0.y + o0.z * o0.z + o0.w * o0.w) + (o1.x * o1.x + o1.y * o1.y + o1.z * o1.z + o1.w * o1.w) + (o2.x * o2.x + o2.y * o2.y + o2.z * o2.z + o2.w * o2.w) + (o3.x * o3.x + o3.y * o3.y + o3.z * o3.z + o3.w * o3.w); \
        ss += __shfl_xor(ss, 1); ss += __shfl_xor(ss, 2); ss += __shfl_xor(ss, 4); \
        const float rs_ = rsqrtf(ss * (1.0f / 128.0f) + RMS_EPS); \
        const f32x4 v0 = o0 * rs_ * nw0, v1 = o1 * rs_ * nw1, v2 = o2 * rs_ * nw2, v3 = o3 * rs_ * nw3; \
        u32x4 w0, w1; \
        w0.x = pack2(v0.x * bflo(g0.x), v0.y * bfhi(g0.x)); w0.y = pack2(v0.z * bflo(g0.y), v0.w * bfhi(g0.y)); w0.z = pack2(v1.x * bflo(g0.z), v1.y * bfhi(g0.z)); w0.w = pack2(v1.z * bflo(g0.w), v1.w * bfhi(g0.w)); \
        w1.x = pack2(v2.x * bflo(g1.x), v2.y * bfhi(g1.x)); w1.y = pack2(v2.z * bflo(g1.y), v2.w * bfhi(g1.y)); w1.z = pack2(v3.x * bflo(g1.z), v3.y * bfhi(g1.z)); w1.w = pack2(v3.z * bflo(g1.w), v3.w * bfhi(g1.w)); \
        bf16_t* dst_ = A2out + (size_t)((cc_) * 32 + t_) * DM + sg_ * 16; \
        *(u32x4*)dst_ = w0; *(u32x4*)(dst_ + 8) = w1; }
    for (int c = 0; c < 64; c += 2) {
        if (helper) { if (c + 2 < 64) HG_STORE(A, (c + 2) % 3); if (c + 4 < 64) HG_LOAD(A, c + 4); if (c > 0) HG_NORM(c - 1); } else HG_COMPUTE(c);
        __syncthreads();
        if (helper) { if (c + 3 < 64) HG_STORE(B, (c + 3) % 3); if (c + 5 < 64) HG_LOAD(B, c + 5); HG_NORM(c); } else HG_COMPUTE(c + 1);
        __syncthreads();
    }
    if (helper) HG_NORM(63);
    __syncthreads();
#undef HG_LOAD
#undef HG_STORE
#undef HG_COMPUTE
#undef HG_NORM
}
template <int NJ>
DI void s5_gemm2_tile(const bf16x8 (&af)[16], const bf16_t* KTl, const bf16_t* Xin, const bf16_t* MBg, bf16_t* Yout, bf16_t* stg, const int mi, const int r, const int h) {
    f32x16 y;
#pragma unroll
    for (int i = 0; i < 16; ++i) y[i] = 0.f;
    const int tsel = r >> 4, iq = r & 15;
    bf16x8 bm[8];
#pragma unroll
    for (int ks = 0; ks < 8; ++ks) bm[ks] = *(const bf16x8*)(MBg + (size_t)((NJ * 8 + ks) * 64 + h * 32 + r) * 8);
#pragma unroll
    for (int ks = 0; ks <= 2 * NJ; ++ks) {
        const bf16x8 bk = *(const bf16x8*)(KTl + ((2 * NJ + tsel - ks) * 16 + iq) * 16 + 8 * h);
        y = __builtin_amdgcn_mfma_f32_32x32x16_bf16(af[ks], bk, y, 0, 0, 0);
    }
    {
        bf16x8 bk = *(const bf16x8*)(KTl + iq * 16 + 8 * h);
        if (tsel == 0) bk = (bf16x8){0, 0, 0, 0, 0, 0, 0, 0};
        y = __builtin_amdgcn_mfma_f32_32x32x16_bf16(af[2 * NJ + 1], bk, y, 0, 0, 0);
    }
#pragma unroll
    for (int ks = 0; ks < 8; ++ks) {
        const bf16x8 a = *(const bf16x8*)(Xin + (mi * 32 + r) * 136 + ks * 16 + 8 * h);
        y = __builtin_amdgcn_mfma_f32_32x32x16_bf16(a, bm[ks], y, 0, 0, 0);
    }
#pragma unroll
    for (int i = 0; i < 16; ++i) stg[((crow(i, h) * 2 + tsel) * 16) + iq] = f2bf(gelu_as(y[i]));
    {
        const int lane = h * 32 + r, cl = lane >> 1, ts = lane & 1;
        const u32x4 lo = *(const u32x4*)(stg + lane * 16), hi = *(const u32x4*)(stg + lane * 16 + 8);
        bf16_t* dst = Yout + (size_t)((mi * 32 + cl) * 16 + 2 * NJ + ts) * DSS;
        *(u32x4*)dst = lo; *(u32x4*)(dst + 8) = hi;
    }
}
DI void s5_gemm_item(const Params& p, int b, int g, char* smem) {
    float* E = (float*)smem;
    bf16_t* Xin = (bf16_t*)(smem + 128 * 132 * 4);
    bf16_t* KTl = Xin + 128 * 136;
    const int tid = my_tid(), lane = tid & 63, wid = tid >> 6, r = lane & 31, h = lane >> 5;
    const int mi = wid >> 1, wh = wid & 1;
    const bf16_t* P = (const bf16_t*)(p.ws + OFF_PROJ);
    *(u32x4*)(KTl + tid * 8) = *(const u32x4*)((const bf16_t*)(p.ws + OFF_S5K) + (size_t)g * 4096 + tid * 8);
    bf16x8 af[16];
    {
        const bf16_t* ub = P + (size_t)(b * SEQ + (mi * 32 + r) * 16) * INC + 2048 + g * 16 + 8 * h;
#pragma unroll
        for (int ks = 0; ks < 16; ++ks) af[ks] = *(const bf16x8*)(ub + (size_t)ks * INC);
    }
#ifndef S5_REP_G1
#define S5_REP_G1 1
#define S5_REP_SC 1
#define S5_REP_G2 1
#endif
    for (int rp1 = 0; rp1 < S5_REP_G1; ++rp1)
    {
        f32x16 e0, e1;
#pragma unroll
        for (int i = 0; i < 16; ++i) { e0[i] = 0.f; e1[i] = 0.f; }
        const bf16_t* nb0 = (const bf16_t*)(p.ws + OFF_S5N) + (size_t)g * 128 * 256 + (size_t)(wh * 2) * 16 * 512 + lane * 8;
#pragma unroll
        for (int ks = 0; ks < 16; ++ks) {
            const bf16x8 b0 = *(const bf16x8*)(nb0 + ks * 512), b1 = *(const bf16x8*)(nb0 + 16 * 512 + ks * 512);
            e0 = __builtin_amdgcn_mfma_f32_32x32x16_bf16(af[ks], b0, e0, 0, 0, 0);
            e1 = __builtin_amdgcn_mfma_f32_32x32x16_bf16(af[ks], b1, e1, 0, 0, 0);
        }
#pragma unroll
        for (int i = 0; i < 16; ++i) { float* er = E + (mi * 32 + crow(i, h)) * 132 + wh * 64 + r; er[0] = e0[i]; er[32] = e1[i]; }
    }
    __syncthreads();
    for (int rp2 = 0; rp2 < S5_REP_SC; ++rp2)
    if (wid == 0) {
        const float* L = (const float*)(p.ws + OFF_S5L) + (g * 64 + lane) * 2;
        const float lr = L[0], li = L[1];
        float xr = 0.f, xi = 0.f;
#pragma unroll 8
        for (int c = 0; c < 128; ++c) {
            const float er = E[c * 132 + lane], ei = E[c * 132 + 64 + lane];
            Xin[c * 136 + lane] = f2bf(xr); Xin[c * 136 + 64 + lane] = f2bf(xi);
            const float nr = lr * xr - li * xi + er, ni = lr * xi + li * xr + ei;
            xr = nr; xi = ni;
        }
    }
    __syncthreads();
    const bf16_t* MBg = (const bf16_t*)(p.ws + OFF_S5M) + (size_t)g * 256 * 128;
    bf16_t* Yout = (bf16_t*)(p.ws + OFF_YSSM) + (size_t)b * SEQ * DSS + g * 16;
    bf16_t* stg = (bf16_t*)smem + wid * 1024;
    for (int rp3 = 0; rp3 < S5_REP_G2; ++rp3)
    if (wh) {
        s5_gemm2_tile<1>(af, KTl, Xin, MBg, Yout, stg, mi, r, h); s5_gemm2_tile<6>(af, KTl, Xin, MBg, Yout, stg, mi, r, h);
        s5_gemm2_tile<3>(af, KTl, Xin, MBg, Yout, stg, mi, r, h); s5_gemm2_tile<4>(af, KTl, Xin, MBg, Yout, stg, mi, r, h);
    } else {
        s5_gemm2_tile<0>(af, KTl, Xin, MBg, Yout, stg, mi, r, h); s5_gemm2_tile<7>(af, KTl, Xin, MBg, Yout, stg, mi, r, h);
        s5_gemm2_tile<2>(af, KTl, Xin, MBg, Yout, stg, mi, r, h); s5_gemm2_tile<5>(af, KTl, Xin, MBg, Yout, stg, mi, r, h);
    }
    __syncthreads();
}
DI void phase_mix(const Params& p, int bid, int nb, char* smem) {
    if (nb == 256) {
#ifndef PROBE_HGX
#define PROBE_HGX 1
#endif
        if (bid < 64) { for (int rep = 0; rep < PROBE_HGX; ++rep) hgrn_mfma_item(p, bid, smem); return; }
        const int j = bid - 64, x = j & 7, lb = j >> 3;
#ifndef PROBE_S5X
#define PROBE_S5X 1
#endif
        for (int rep = 0; rep < PROBE_S5X; ++rep)
        for (int q = lb; q < 64; q += 24) s5_gemm_item(p, q & 15, x * 4 + (q >> 4), smem);
    } else {
        for (int it = bid; it < 64; it += nb) hgrn_mfma_item(p, it, smem);
        for (int q = bid; q < 512; q += nb) s5_gemm_item(p, q & 15, q >> 4, smem);
    }
}

DI void phase_glu(const Params& p, int bid, int nb, char* smem) {
    pg8::Gemm g{(const bf16_t*)(p.ws + OFF_YSSM), (const bf16_t*)(p.ws + OFF_GLU), NTOK, 512, 512};
    pg8::StaticOrder S; S.init(NTOK, 512, nb, bid);
    pg8::EpiGlu E{(float*)(p.ws + OFF_H), (const bf16_t*)(p.ws + OFF_YSSM), p.glu_b};
    pg8::gemm_phase<pg8::EpiGlu, pg8::StaticOrder, false>((PG8_LAS unsigned char*)smem, g, S, E, nullptr);
}
DI void phase_a2(const Params& p, int bid, int nb) {
    const float* Y2 = (const float*)(p.ws + OFF_H);
    const bf16_t* P = (const bf16_t*)(p.ws + OFF_PROJ);
    bf16_t* A2 = (bf16_t*)(p.ws + OFF_A2);
    const int lane = my_tid() & 63, wid = my_tid() >> 6;
    for (int tok = bid * 8 + wid; tok < NTOK; tok += nb * 8) {
        const int c0 = lane * 8;
        {
            const float4 a = *(const float4*)(Y2 + (size_t)tok * DSS + c0), b = *(const float4*)(Y2 + (size_t)tok * DSS + c0 + 4);
            float ss = a.x * a.x + a.y * a.y + a.z * a.z + a.w * a.w + b.x * b.x + b.y * b.y + b.z * b.z + b.w * b.w;
#pragma unroll
            for (int m = 1; m < 64; m <<= 1) ss += __shfl_xor(ss, m);
            const float rs = rsqrtf(ss * (1.0f / 512.0f) + RMS_EPS);
            const float4 w0 = *(const float4*)(p.ssm_nw + c0), w1 = *(const float4*)(p.ssm_nw + c0 + 4);
            uint4 o;
            o.x = pack2(a.x * rs * w0.x, a.y * rs * w0.y); o.y = pack2(a.z * rs * w0.z, a.w * rs * w0.w);
            o.z = pack2(b.x * rs * w1.x, b.y * rs * w1.y); o.w = pack2(b.z * rs * w1.z, b.w * rs * w1.w);
            *(uint4*)(A2 + (size_t)tok * DM + 512 + c0) = o;
        }
    }
}

DI void phase_outproj(const Params& p, int bid, int nb, char* smem) {
    pg8::Gemm g{(const bf16_t*)(p.ws + OFF_A2), (const bf16_t*)(p.ws + OFF_WOUT), NTOK, DM, DM};
    pg8::StaticOrder S; S.init(NTOK, DM, nb, bid);
    pg8::EpiResid E{p.out, p.x, (const float*)(p.ws + OFF_MOD) + 2048, DEEP_ALPHA, (bf16_t*)(p.ws + OFF_H), (const float*)(p.ws + OFF_AB), (float*)(p.ws + OFF_STAT)};
    pg8::gemm_phase<pg8::EpiResid, pg8::StaticOrder, false>((PG8_LAS unsigned char*)smem, g, S, E, nullptr);
}
DI void phase_ln1(const Params& p, int bid, int nb) {
    const float* mod = (const float*)(p.ws + OFF_MOD);
    bf16_t* H2 = (bf16_t*)(p.ws + OFF_H);
    const int lane = my_tid() & 63, wid = my_tid() >> 6;
    for (int tok = bid * 8 + wid; tok < NTOK; tok += nb * 8) {
        const int b = tok / SEQ;
        float* row = p.out + (size_t)tok * DM;
        float4 v[4];
        float s = 0.f;
#pragma unroll
        for (int j = 0; j < 4; ++j) { v[j] = *(const float4*)(row + j * 256 + lane * 4); s += v[j].x + v[j].y + v[j].z + v[j].w; }
#pragma unroll
        for (int m = 1; m < 64; m <<= 1) s += __shfl_xor(s, m);
        const float mu = s * (1.0f / 1024.0f);
        float q = 0.f;
#pragma unroll
        for (int j = 0; j < 4; ++j) { const float a = v[j].x - mu, bb = v[j].y - mu, cc = v[j].z - mu, d = v[j].w - mu; q += a * a + bb * bb + cc * cc + d * d; }
#pragma unroll
        for (int m = 1; m < 64; m <<= 1) q += __shfl_xor(q, m);
        const float rstd = rsqrtf(q * (1.0f / 1024.0f) + LN_EPS);
        const float* sh2 = mod + b * 6144 + 3072;
        const float* sc2 = mod + b * 6144 + 4096;
#pragma unroll
        for (int j = 0; j < 4; ++j) {
            const int c = j * 256 + lane * 4;
            const float4 w = *(const float4*)(p.ln1w + c), bi = *(const float4*)(p.ln1b + c), sc = *(const float4*)(sc2 + c), sh = *(const float4*)(sh2 + c);
            float4 o;
            o.x = (v[j].x - mu) * rstd * w.x + bi.x; o.y = (v[j].y - mu) * rstd * w.y + bi.y; o.z = (v[j].z - mu) * rstd * w.z + bi.z; o.w = (v[j].w - mu) * rstd * w.w + bi.w;
            *(float4*)(row + c) = o;
            uint2 hh; hh.x = pack2(o.x * (1.f + sc.x) + sh.x, o.y * (1.f + sc.y) + sh.y); hh.y = pack2(o.z * (1.f + sc.z) + sh.z, o.w * (1.f + sc.w) + sh.w);
            *(uint2*)(H2 + (size_t)tok * DM + c) = hh;
        }
    }
}

DI void phase_q(const Params& p, int bid, int nb, char* smem) {
    pg8::Gemm g{(const bf16_t*)(p.ws + OFF_H), (const bf16_t*)(p.ws + OFF_WQ), NTOK, 2048, DM};
    pg8::StaticOrder S; S.init(NTOK, 2048, nb, bid);
    pg8::EpiQLN E{(bf16_t*)(p.ws + OFF_PROJ), (const float*)(p.ws + OFF_STAT), (const float*)(p.ws + OFF_CAB), (const float*)(p.ws + OFF_CAB) + NB * 2048, LN_EPS};
    pg8::gemm_phase<pg8::EpiQLN, pg8::StaticOrder, false>((PG8_LAS unsigned char*)smem, g, S, E, nullptr);
}
DI void phase_topk(const Params& p, int bid, int nb, char* smem) {
    const bf16_t* Q = (const bf16_t*)(p.ws + OFF_PROJ);
    const bf16_t* SK = (const bf16_t*)(p.ws + OFF_SUBK);
    unsigned* TOPL = (unsigned*)(p.ws + OFF_TOPL);
    float* sc = (float*)(smem + 36864);
    constexpr int NTM = NTOK / 128;
    for (int t = bid; t < NTM * 16; t += nb) {
        const int mt = t >> 4, hp = t & 15;
        gemm_block<2, 1, 2, 4>(Q + (size_t)mt * 128 * 2048 + hp * 128, 2048, SK + (size_t)hp * 128 * 128, 128, 128, smem,
                               [&](int r, int c, float v) { sc[r * 129 + c] = v; });
        __syncthreads();
        if (my_tid() < 128) {
            const int r = my_tid();
            float tk[16];
#pragma unroll
            for (int j = 0; j < 16; ++j) tk[j] = -3.0e38f;
            for (int n = 0; n < 128; ++n) {
                float xv = __uint_as_float((__float_as_uint(sc[r * 129 + n]) & ~0x7fu) | (unsigned)n);
#pragma unroll
                for (int j = 0; j < 16; ++j) { const float hi = fmaxf(tk[j], xv), lo = fminf(tk[j], xv); tk[j] = hi; xv = lo; }
            }
            uint4* dst = (uint4*)(TOPL + ((size_t)(mt * 128 + r) * 16 + hp) * 16);
            dst[0] = make_uint4(__float_as_uint(tk[0]), __float_as_uint(tk[1]), __float_as_uint(tk[2]), __float_as_uint(tk[3]));
            dst[1] = make_uint4(__float_as_uint(tk[4]), __float_as_uint(tk[5]), __float_as_uint(tk[6]), __float_as_uint(tk[7]));
            dst[2] = make_uint4(__float_as_uint(tk[8]), __float_as_uint(tk[9]), __float_as_uint(tk[10]), __float_as_uint(tk[11]));
            dst[3] = make_uint4(__float_as_uint(tk[12]), __float_as_uint(tk[13]), __float_as_uint(tk[14]), __float_as_uint(tk[15]));
        }
        __syncthreads();
    }
}
DI void phase_combine(const Params& p, int bid, int nb) {
    const unsigned* TOPL = (const unsigned*)(p.ws + OFF_TOPL);
    uint2* EX = (uint2*)(p.ws + OFF_EXPS);
    const float* SU = (const float*)(p.ws + OFF_SU);
    const float* SV = (const float*)(p.ws + OFF_SV);
    for (int i = bid * NTH + my_tid(); i < NTOK * PHEADS; i += nb * NTH) {
        const unsigned* l1 = TOPL + (size_t)i * 32;
        const unsigned* l2 = l1 + 16;
        float s2[16];
        {
            const uint4 a = ((const uint4*)l2)[0], b = ((const uint4*)l2)[1], c = ((const uint4*)l2)[2], d = ((const uint4*)l2)[3];
            const unsigned w[16] = {a.x, a.y, a.z, a.w, b.x, b.y, b.z, b.w, c.x, c.y, c.z, c.w, d.x, d.y, d.z, d.w};
#pragma unroll
            for (int j = 0; j < 16; ++j) s2[j] = __uint_as_float(w[j] & ~0x7fu);
        }
        float tk[16];
#pragma unroll
        for (int j = 0; j < 16; ++j) tk[j] = -3.0e38f;
        for (int a = 0; a < 16; ++a) {
            const float s1 = __uint_as_float(l1[a] & ~0x7fu);
#pragma unroll
            for (int b = 0; b < 16; ++b) {
                float xv = __uint_as_float((__float_as_uint(s1 + s2[b]) & ~0xffu) | (unsigned)(a * 16 + b));
#pragma unroll
                for (int j = 0; j < 16; ++j) { const float hi = fmaxf(tk[j], xv), lo = fminf(tk[j], xv); tk[j] = hi; xv = lo; }
            }
        }
        float e[16], sum = 0.f;
        const float mx = __uint_as_float(__float_as_uint(tk[0]) & ~0xffu);
#pragma unroll
        for (int j = 0; j < 16; ++j) { e[j] = __expf(__uint_as_float(__float_as_uint(tk[j]) & ~0xffu) - mx); sum += e[j]; }
        const float inv = 1.0f / sum;
#pragma unroll
        for (int j = 0; j < 16; ++j) {
            const unsigned ab = __float_as_uint(tk[j]) & 0xffu;
            const unsigned i1 = l1[ab >> 4] & 0x7fu, i2 = l2[ab & 15] & 0x7fu;
            const unsigned eid = i1 * 128u + i2;
            EX[(size_t)i * 16 + j] = make_uint2(eid | (((__float_as_uint(SU[eid]) >> 23) & 0xffu) << 16), __float_as_uint(e[j] * inv * SV[eid]));
        }
    }
}

DI void ce_desc(float& a, float& b) { const float hi = fmaxf(a, b), lo = fminf(a, b); a = hi; b = lo; }
template <int N> DI void bitonic_sort_desc(float (&v)[N]) {
#pragma unroll
    for (int k = 2; k <= N; k <<= 1)
#pragma unroll
        for (int j = k >> 1; j > 0; j >>= 1)
#pragma unroll
            for (int i = 0; i < N; ++i) { const int l = i ^ j; if (l > i) { if ((i & k) == 0 || k == N) ce_desc(v[i], v[l]); else ce_desc(v[l], v[i]); } }
}
DI void merge_top16(float (&a)[16], const float (&b)[16]) {
#pragma unroll
    for (int i = 0; i < 16; ++i) a[i] = fmaxf(a[i], b[15 - i]);
#pragma unroll
    for (int j = 8; j > 0; j >>= 1)
#pragma unroll
        for (int i = 0; i < 16; ++i) { const int l = i ^ j; if (l > i) ce_desc(a[i], a[l]); }
}
DI void xlane_merge16(float (&a)[16]) {
    float o[16];
#pragma unroll
    for (int i = 0; i < 16; ++i) o[i] = __shfl_xor(a[i], 32);
    merge_top16(a, o);
}
DI void retrieve_topk_hp(const bf16_t* Q, const char* skl, const int tok, const int hp_next, const int r, const int h, unsigned char* lutp, float (&out)[16], bf16x8 (&bq)[8]) {
                f32x16 acc[4];
#pragma unroll
                for (int mi = 0; mi < 4; ++mi)
#pragma unroll
                    for (int i = 0; i < 16; ++i) acc[mi][i] = 0.f;
                const char* kb = skl + r * 272 + h * 16;
#pragma unroll
                for (int ks = 0; ks < 8; ++ks) {
#pragma unroll
                    for (int mi = 0; mi < 4; ++mi) {
                        const bf16x8 a = *(const bf16x8*)(kb + mi * 32 * 272 + ks * 32);
                        acc[mi] = __builtin_amdgcn_mfma_f32_32x32x16_bf16(a, bq[ks], acc[mi], 0, 0, 0);
                    }
                }
                {
                    const bf16_t* qb = Q + (size_t)tok * 2048 + hp_next * 128 + 8 * h;
#pragma unroll
                    for (int ks = 0; ks < 8; ++ks) bq[ks] = *(const bf16x8*)(qb + ks * 16);
                }
                float v0[16], v1[16], v2[16], v3[16];
#pragma unroll
                for (int i = 0; i < 16; ++i) {
                    const unsigned n = (unsigned)crow(i, h);
                    v0[i] = __uint_as_float((__float_as_uint(acc[0][i]) & ~0x7fu) | n);
                    v1[i] = __uint_as_float((__float_as_uint(acc[1][i]) & ~0x7fu) | (n + 32u));
                    v2[i] = __uint_as_float((__float_as_uint(acc[2][i]) & ~0x7fu) | (n + 64u));
                    v3[i] = __uint_as_float((__float_as_uint(acc[3][i]) & ~0x7fu) | (n + 96u));
                }
                bitonic_sort_desc<16>(v0); bitonic_sort_desc<16>(v1); bitonic_sort_desc<16>(v2); bitonic_sort_desc<16>(v3);
                merge_top16(v0, v1); merge_top16(v2, v3); merge_top16(v0, v2);
                xlane_merge16(v0);
#pragma unroll
                for (int i = 0; i < 16; ++i) out[i] = v0[i];
                u32x4 ix;
                ix.x = (__float_as_uint(v0[0]) & 0x7fu) | ((__float_as_uint(v0[1]) & 0x7fu) << 8) | ((__float_as_uint(v0[2]) & 0x7fu) << 16) | ((__float_as_uint(v0[3]) & 0x7fu) << 24);
                ix.y = (__float_as_uint(v0[4]) & 0x7fu) | ((__float_as_uint(v0[5]) & 0x7fu) << 8) | ((__float_as_uint(v0[6]) & 0x7fu) << 16) | ((__float_as_uint(v0[7]) & 0x7fu) << 24);
                ix.z = (__float_as_uint(v0[8]) & 0x7fu) | ((__float_as_uint(v0[9]) & 0x7fu) << 8) | ((__float_as_uint(v0[10]) & 0x7fu) << 16) | ((__float_as_uint(v0[11]) & 0x7fu) << 24);
                ix.w = (__float_as_uint(v0[12]) & 0x7fu) | ((__float_as_uint(v0[13]) & 0x7fu) << 8) | ((__float_as_uint(v0[14]) & 0x7fu) << 16) | ((__float_as_uint(v0[15]) & 0x7fu) << 24);
                *(u32x4*)lutp = ix;
}
DI void phase_retrieve(const Params& p, int bid, int nb, char* smem) {
    const bf16_t* Q = (const bf16_t*)(p.ws + OFF_PROJ);
    const bf16_t* SK = (const bf16_t*)(p.ws + OFF_SUBK);
    const float* SU = (const float*)(p.ws + OFF_SU);
    const float* SV = (const float*)(p.ws + OFF_SV);
    uint2* EX = (uint2*)(p.ws + OFF_EXPS);
    const int tid = my_tid(), lane = tid & 63, wid = tid >> 6, r = lane & 31, h = lane >> 5;
    unsigned char* lut = (unsigned char*)smem + wid * 2048 + lane * 32;
    char* skb0 = smem + 16384;
    char* skb1 = skb0 + 128 * 272;
    u32x4 sr0, sr1, sr2, sr3;
#define SK_LOAD(hp_) { const bf16_t* g_ = SK + (size_t)(hp_) * 16384 + tid * 8; sr0 = *(const u32x4*)g_; sr1 = *(const u32x4*)(g_ + 4096); sr2 = *(const u32x4*)(g_ + 8192); sr3 = *(const u32x4*)(g_ + 12288); }
#define SK_STORE(buf_) { char* d_ = (buf_) + (tid >> 4) * 272 + (tid & 15) * 16; *(u32x4*)d_ = sr0; *(u32x4*)(d_ + 32 * 272) = sr1; *(u32x4*)(d_ + 64 * 272) = sr2; *(u32x4*)(d_ + 96 * 272) = sr3; }
    for (int it = bid; it < (NTOK / 256) * 2; it += nb) {
        const int hq = it & 1, tok = (it >> 1) * 256 + wid * 32 + r;
        __syncthreads();
        SK_LOAD(hq * 8); SK_STORE(skb0);
        bf16x8 bq[8];
        {
            const bf16_t* qb = Q + (size_t)tok * 2048 + (hq * 8) * 128 + 8 * h;
#pragma unroll
            for (int ks = 0; ks < 8; ++ks) bq[ks] = *(const bf16x8*)(qb + ks * 16);
        }
        __syncthreads();
#pragma unroll 1
        for (int hd = hq * 4; hd < hq * 4 + 4; ++hd) {
            float L0[16], L1[16];
            SK_LOAD(hd * 2 + 1);
            retrieve_topk_hp(Q, skb0, tok, hd * 2 + 1, r, h, lut, L0, bq);
            SK_STORE(skb1);
            __syncthreads();
            if (hd + 1 < hq * 4 + 4) SK_LOAD(hd * 2 + 2);
            retrieve_topk_hp(Q, skb1, tok, (hd + 1 < hq * 4 + 4) ? hd * 2 + 2 : hd * 2 + 1, r, h, lut + 16, L1, bq);
            if (hd + 1 < hq * 4 + 4) SK_STORE(skb0);
            __syncthreads();
            float c[32];
            {
                constexpr int PA[50] = {0, 0, 0, 0, 0, 0, 0, 0, 0, 0, 0, 0, 0, 0, 0, 0, 1, 1, 1, 1, 1, 1, 1, 1, 2, 2, 2, 2, 2, 3, 3, 3, 3, 4, 4, 4, 5, 5, 6, 6, 7, 7, 8, 9, 10, 11, 12, 13, 14, 15};
                constexpr int PB[50] = {0, 1, 2, 3, 4, 5, 6, 7, 8, 9, 10, 11, 12, 13, 14, 15, 0, 1, 2, 3, 4, 5, 6, 7, 0, 1, 2, 3, 4, 0, 1, 2, 3, 0, 1, 2, 0, 1, 0, 1, 0, 1, 0, 0, 0, 0, 0, 0, 0, 0};
#pragma unroll
                for (int q = 0; q < 25; ++q) {
                    const float s0 = __uint_as_float(__float_as_uint(L0[PA[2 * q]]) & ~0x7fu) + __uint_as_float(__float_as_uint(L1[PB[2 * q]]) & ~0x7fu);
                    const float s1 = __uint_as_float(__float_as_uint(L0[PA[2 * q + 1]]) & ~0x7fu) + __uint_as_float(__float_as_uint(L1[PB[2 * q + 1]]) & ~0x7fu);
                    const float p0 = __uint_as_float((__float_as_uint(s0) & ~0xffu) | (unsigned)(PA[2 * q] * 16 + PB[2 * q]));
                    const float p1 = __uint_as_float((__float_as_uint(s1) & ~0xffu) | (unsigned)(PA[2 * q + 1] * 16 + PB[2 * q + 1]));
                    c[q] = h ? p1 : p0;
                }
#pragma unroll
                for (int i = 25; i < 32; ++i) c[i] = -3.0e38f;
            }
            bitonic_sort_desc<32>(c);
            float t16[16];
#pragma unroll
            for (int i = 0; i < 16; ++i) t16[i] = c[i];
            xlane_merge16(t16);
            const float mx = __uint_as_float(__float_as_uint(t16[0]) & ~0xffu);
            float e[16], sum = 0.f;
#pragma unroll
            for (int j = 0; j < 16; ++j) { e[j] = __expf(__uint_as_float(__float_as_uint(t16[j]) & ~0xffu) - mx); sum += e[j]; }
            const float inv = 1.0f / sum;
            uint2* dst = EX + ((size_t)tok * 8 + hd) * 16 + 8 * h;
#pragma unroll
            for (int j = 0; j < 8; ++j) {
                float tlo = t16[j], thi = t16[8 + j], elo = e[j], ehi = e[8 + j];
                asm volatile("" : "+v"(tlo), "+v"(thi), "+v"(elo), "+v"(ehi));
                const float tv = h ? thi : tlo, ev = h ? ehi : elo;
                const unsigned ab = __float_as_uint(tv) & 0xffu;
                const unsigned eid = (unsigned)lut[ab >> 4] * 128u + (unsigned)lut[16 + (ab & 15u)];
                dst[j] = make_uint2(eid | (pack2(0.f, SU[eid]) & 0xffff0000u), __float_as_uint(ev * inv * SV[eid]));
            }
        }
    }
#undef SK_LOAD
#undef SK_STORE
}

DI float dot16_fp8(const u32x4 w, const f32x2 (&h)[8]) {
    f32x2 acc = __builtin_amdgcn_cvt_pk_f32_fp8((int)w.x, false) * h[0];
    acc += __builtin_amdgcn_cvt_pk_f32_fp8((int)w.x, true) * h[1];
    acc += __builtin_amdgcn_cvt_pk_f32_fp8((int)w.y, false) * h[2];
    acc += __builtin_amdgcn_cvt_pk_f32_fp8((int)w.y, true) * h[3];
    acc += __builtin_amdgcn_cvt_pk_f32_fp8((int)w.z, false) * h[4];
    acc += __builtin_amdgcn_cvt_pk_f32_fp8((int)w.z, true) * h[5];
    acc += __builtin_amdgcn_cvt_pk_f32_fp8((int)w.w, false) * h[6];
    acc += __builtin_amdgcn_cvt_pk_f32_fp8((int)w.w, true) * h[7];
    return acc.x + acc.y;
}
DI void axpy16_fp8(const float a, const u32x4 w, f32x2 (&o)[8]) {
    const f32x2 aa = {a, a};
    o[0] += aa * __builtin_amdgcn_cvt_pk_f32_fp8((int)w.x, false); o[1] += aa * __builtin_amdgcn_cvt_pk_f32_fp8((int)w.x, true);
    o[2] += aa * __builtin_amdgcn_cvt_pk_f32_fp8((int)w.y, false); o[3] += aa * __builtin_amdgcn_cvt_pk_f32_fp8((int)w.y, true);
    o[4] += aa * __builtin_amdgcn_cvt_pk_f32_fp8((int)w.z, false); o[5] += aa * __builtin_amdgcn_cvt_pk_f32_fp8((int)w.z, true);
    o[6] += aa * __builtin_amdgcn_cvt_pk_f32_fp8((int)w.w, false); o[7] += aa * __builtin_amdgcn_cvt_pk_f32_fp8((int)w.w, true);
}
DI float butterfly64(float (&pz)[64], const int lane) {
    const bool b5 = lane & 32, b4 = lane & 16, b3 = lane & 8, b2 = lane & 4, b1 = lane & 2, b0 = lane & 1;
    float q32[32], q16[16], q8[8], q4[4], q2[2];
#pragma unroll
    for (int j = 0; j < 32; ++j) q32[j] = (b5 ? pz[32 + j] : pz[j]) + __shfl_xor(b5 ? pz[j] : pz[32 + j], 32);
#pragma unroll
    for (int j = 0; j < 16; ++j) q16[j] = (b4 ? q32[16 + j] : q32[j]) + __shfl_xor(b4 ? q32[j] : q32[16 + j], 16);
#pragma unroll
    for (int j = 0; j < 8; ++j) q8[j] = (b3 ? q16[8 + j] : q16[j]) + __shfl_xor(b3 ? q16[j] : q16[8 + j], 8);
#pragma unroll
    for (int j = 0; j < 4; ++j) q4[j] = (b2 ? q8[4 + j] : q8[j]) + __shfl_xor(b2 ? q8[j] : q8[4 + j], 4);
#pragma unroll
    for (int j = 0; j < 2; ++j) q2[j] = (b1 ? q4[2 + j] : q4[j]) + __shfl_xor(b1 ? q4[j] : q4[2 + j], 2);
    return (b0 ? q2[1] : q2[0]) + __shfl_xor(b0 ? q2[0] : q2[1], 1);
}
DI float bfly8(float (&pz)[8], const int lane) {
    const bool b2 = lane & 4, b1 = lane & 2, b0 = lane & 1;
    float q4[4], q2[2];
#pragma unroll
    for (int i = 0; i < 4; ++i) q4[i] = (b2 ? pz[4 + i] : pz[i]) + __shfl_xor(b2 ? pz[i] : pz[4 + i], 4);
#pragma unroll
    for (int i = 0; i < 2; ++i) q2[i] = (b1 ? q4[2 + i] : q4[i]) + __shfl_xor(b1 ? q4[i] : q4[2 + i], 2);
    float q = (b0 ? q2[1] : q2[0]) + __shfl_xor(b0 ? q2[0] : q2[1], 1);
    q += __shfl_xor(q, 8); q += __shfl_xor(q, 16); q += __shfl_xor(q, 32);
    return q;
}
DI float bfly16(float (&pz)[16], const int lane) {
    const bool b3 = lane & 8, b2 = lane & 4, b1 = lane & 2, b0 = lane & 1;
    float q8[8], q4[4], q2[2];
#pragma unroll
    for (int i = 0; i < 8; ++i) q8[i] = (b3 ? pz[8 + i] : pz[i]) + __shfl_xor(b3 ? pz[i] : pz[8 + i], 8);
#pragma unroll
    for (int i = 0; i < 4; ++i) q4[i] = (b2 ? q8[4 + i] : q8[i]) + __shfl_xor(b2 ? q8[i] : q8[4 + i], 4);
#pragma unroll
    for (int i = 0; i < 2; ++i) q2[i] = (b1 ? q4[2 + i] : q4[i]) + __shfl_xor(b1 ? q4[i] : q4[2 + i], 2);
    float q = (b0 ? q2[1] : q2[0]) + __shfl_xor(b0 ? q2[0] : q2[1], 1);
    q += __shfl_xor(q, 16); q += __shfl_xor(q, 32);
    return q;
}
DI void gs_issue(const __amdgpu_buffer_rsrc_t T, const uint2* ent, const unsigned d, const int lane, u32x4 (&w)[8], unsigned& ca) {
    const int cnt = (int)((d >> 16) & 0xfu), k = lane & 7;
    const uint2 e = ent[(d & 0xffffu) + (unsigned)(k < cnt ? k : cnt - 1)];
    ca = (k < cnt && !(d >> 31)) ? e.y : 0u;
#pragma unroll
    for (int q = 0; q < 8; ++q) {
        const int eid = __builtin_amdgcn_readlane((int)e.x, q) & 0x3fff;
        w[q] = __builtin_amdgcn_raw_buffer_load_b128(T, lane * 16, eid * DM, 0);
    }
}
DI float dot16_i8(const u32x4 w, const u32x4 h) {
    int acc = __builtin_amdgcn_sdot4((int)w.x, (int)h.x, 0, false);
    acc = __builtin_amdgcn_sdot4((int)w.y, (int)h.y, acc, false);
    acc = __builtin_amdgcn_sdot4((int)w.z, (int)h.z, acc, false);
    acc = __builtin_amdgcn_sdot4((int)w.w, (int)h.w, acc, false);
    return (float)acc;
}
DI void gs_desc(const uint2* ent, const unsigned d, const int lane, unsigned& ex) {
    const int cnt = (int)((d >> 16) & 0xfu), k = lane & 7;
    ex = ent[(d & 0xffffu) + (unsigned)(k < cnt ? k : cnt - 1)].x;
}
DI void gs_loads(const __amdgpu_buffer_rsrc_t T, const unsigned ex, const int lane, u32x4 (&w)[8]) {
#pragma unroll
    for (int q = 0; q < 8; ++q) {
        const int eid = __builtin_amdgcn_readlane((int)ex, q) & 0x3fff;
        w[q] = __builtin_amdgcn_raw_buffer_load_b128(T, lane * 16, eid * DM, 0);
    }
}
DI void gs_upartial(const u32x4 (&w)[8], const u32x4 h2q, float (&pz)[16], const int base) {
#pragma unroll
    for (int k = 0; k < 8; ++k) pz[base + k] = dot16_i8(w[k], h2q);
}
DI void gs_ustore(float (&pz)[16], float* zb, const unsigned da, const unsigned db, const int lane) {
    const float z = bfly16(pz, lane);
    const unsigned d = (lane & 8) ? db : da;
    const int k = lane & 7;
    if (lane < 16 && k < (int)((d >> 16) & 0xfu) && !(d >> 31)) zb[(d & 0xffffu) + k] = z;
}
DI void axpy16_u8(const float a, const u32x4 w, float (&o)[16]) {
    o[0] += a * (float)(w.x & 0xffu); o[1] += a * (float)((w.x >> 8) & 0xffu); o[2] += a * (float)((w.x >> 16) & 0xffu); o[3] += a * (float)(w.x >> 24);
    o[4] += a * (float)(w.y & 0xffu); o[5] += a * (float)((w.y >> 8) & 0xffu); o[6] += a * (float)((w.y >> 16) & 0xffu); o[7] += a * (float)(w.y >> 24);
    o[8] += a * (float)(w.z & 0xffu); o[9] += a * (float)((w.z >> 8) & 0xffu); o[10] += a * (float)((w.z >> 16) & 0xffu); o[11] += a * (float)(w.z >> 24);
    o[12] += a * (float)(w.w & 0xffu); o[13] += a * (float)((w.w >> 8) & 0xffu); o[14] += a * (float)((w.w >> 16) & 0xffu); o[15] += a * (float)(w.w >> 24);
}
DI void gs_vcompute(const u32x4 (&w)[8], const unsigned ca, float (&acc)[16]) {
#pragma unroll
    for (int k = 0; k < 8; ++k) { axpy16_u8(__uint_as_float((unsigned)__builtin_amdgcn_readlane((int)ca, k)), w[k], acc); __builtin_amdgcn_sched_barrier(0); }
}
constexpr int GT = 4;
constexpr int NSL = 4, SLSH = 12;
DI void xcd_pace(unsigned* cnt, const unsigned nloc, unsigned& step) {
    __syncthreads();
    if (__builtin_amdgcn_workitem_id_x() == 0) {
        __hip_atomic_fetch_add(cnt, 1u, __ATOMIC_RELAXED, __HIP_MEMORY_SCOPE_AGENT);
        const unsigned target = nloc * (step + 1u);
        unsigned sp = 0;
        while (__hip_atomic_load(cnt, __ATOMIC_RELAXED, __HIP_MEMORY_SCOPE_AGENT) < target) { __builtin_amdgcn_s_sleep(1); if (++sp > (1u << 22)) break; }
    }
    ++step;
    __syncthreads();
}
DI void phase_gather(const Params& p, int bid, int nb, char* smem, unsigned* pace_cnt, const unsigned pace_n) {
    unsigned pstep = 0;
    const float* mod = (const float*)(p.ws + OFF_MOD);
    const float* AB = (const float*)(p.ws + OFF_AB);
    const float* STAT = (const float*)(p.ws + OFF_STAT);
    const uint2* EX = (const uint2*)(p.ws + OFF_EXPS);
    const __amdgpu_buffer_rsrc_t UT = __builtin_amdgcn_make_buffer_rsrc((void*)(p.ws + OFF_UT), 0, NEXP * DM, 0x00020000);
    const __amdgpu_buffer_rsrc_t VT = __builtin_amdgcn_make_buffer_rsrc((void*)(p.ws + OFF_VT), 0, NEXP * DM, 0x00020000);
    const int lane = my_tid() & 63, wid = my_tid() >> 6, c0 = lane * 16;
    char* wl = smem + wid * 7168;
    uint2* ent = (uint2*)wl; float* zb = (float*)(wl + 4096); int* offs = (int*)(wl + 6144); unsigned* sched = (unsigned*)(wl + 6144 + 256);
#pragma unroll 1
    for (int t0 = (bid * 8 + wid) * GT; t0 < NTOK; t0 += nb * 8 * GT) {
        u32x4 h2q[GT]; float hsc[GT], mu[GT], rs[GT]; float acc[GT][16];
        f32x4 scv[4], shv[4];
        {
            const int b = t0 / SEQ;
#pragma unroll
            for (int q = 0; q < 4; ++q) { scv[q] = *(const f32x4*)(AB + (size_t)b * DM + c0 + q * 4); shv[q] = *(const f32x4*)(AB + (size_t)(NB + b) * DM + c0 + q * 4); }
        }
#pragma unroll
        for (int j = 0; j < GT; ++j) {
            const int tok = t0 + j;
            const float* row = p.out + (size_t)tok * DM + c0;
            __builtin_amdgcn_sched_barrier(0);
            { mu[j] = STAT[tok] * (1.0f / 1024.0f); rs[j] = rsqrtf(fmaxf(STAT[NTOK + tok] * (1.0f / 1024.0f) - mu[j] * mu[j], 0.f) + LN_EPS); }
            {
                f32x4 hv[4];
                float m = 0.f;
#pragma unroll
                for (int q = 0; q < 4; ++q) { hv[q] = (*(const f32x4*)(row + q * 4) - mu[j]) * rs[j] * scv[q] + shv[q]; m = fmaxf(m, fmaxf(fmaxf(fabsf(hv[q].x), fabsf(hv[q].y)), fmaxf(fabsf(hv[q].z), fabsf(hv[q].w)))); }
#pragma unroll
                for (int sft = 1; sft < 64; sft <<= 1) m = fmaxf(m, __shfl_xor(m, sft));
                const float qs = m > 1e-30f ? 127.0f / m : 1.0f;
                hsc[j] = m > 1e-30f ? m * (1.0f / 127.0f) : 1.0f;
                unsigned hw[4];
#pragma unroll
                for (int q = 0; q < 4; ++q)
                    hw[q] = ((unsigned)(int)rintf(hv[q].x * qs) & 0xffu) | (((unsigned)(int)rintf(hv[q].y * qs) & 0xffu) << 8) | (((unsigned)(int)rintf(hv[q].z * qs) & 0xffu) << 16) | (((unsigned)(int)rintf(hv[q].w * qs) & 0xffu) << 24);
                h2q[j] = (u32x4){hw[0], hw[1], hw[2], hw[3]};
            }
            const uint2 e0 = EX[(size_t)tok * 128 + lane], e1 = EX[(size_t)tok * 128 + 64 + lane];
            const int s0 = (int)((e0.x & 0x3fffu) >> SLSH), s1 = (int)((e1.x & 0x3fffu) >> SLSH);
            int run = 0, pos0 = 0, pos1 = 0;
#pragma unroll
            for (int s = 0; s < NSL; ++s) {
                const unsigned long long m0 = __ballot(s0 == s), m1 = __ballot(s1 == s);
                const int c0n = __popcll(m0), c1n = __popcll(m1);
                const int below0 = (int)__builtin_amdgcn_mbcnt_hi((unsigned)(m0 >> 32), __builtin_amdgcn_mbcnt_lo((unsigned)m0, 0u));
                const int below1 = (int)__builtin_amdgcn_mbcnt_hi((unsigned)(m1 >> 32), __builtin_amdgcn_mbcnt_lo((unsigned)m1, 0u));
                if (lane == 0) offs[j * 9 + s] = run;
                pos0 = (s0 == s) ? run + below0 : pos0;
                pos1 = (s1 == s) ? run + c0n + below1 : pos1;
                run += c0n + c1n;
            }
            if (lane == 0) offs[j * 9 + NSL] = 128;
            ent[j * 128 + pos0] = e0; ent[j * 128 + pos1] = e1;
        }
        int nbat;
        {
            const int gs = (lane / GT) % NSL, gj = lane % GT;
            const int gb = offs[gj * 9 + gs], ge = offs[gj * 9 + gs + 1], cnt = lane < NSL * GT ? ge - gb : 0, nbt = (cnt + 7) >> 3;
            int incl = nbt;
#pragma unroll
            for (int m = 1; m < 32; m <<= 1) { const int o = __shfl_up(incl, m); if ((lane & 31) >= m) incl += o; }
            nbat = __builtin_amdgcn_readlane(incl, NSL * GT - 1);
            const int st = incl - nbt;
            for (int q = 0; q < nbt; ++q) { const int rem = cnt - 8 * q; sched[st + q] = (unsigned)(gj * 128 + gb + 8 * q) | ((unsigned)(rem < 8 ? rem : 8) << 16); }
            if (lane < 3) sched[nbat + lane] = 0x80010000u;
        }
        xcd_pace(pace_cnt, pace_n, pstep);
#ifndef PROBE_UX
#define PROBE_UX 1
#endif
        for (int rep = 0; rep < PROBE_UX; ++rep)
        {
            u32x4 wa[8], wb[8];
#define GS_UP(W_, D_, B_) { const unsigned j_ = ((D_) & 0xffffu) >> 7; \
                if (j_ == 0) gs_upartial(W_, h2q[0], pz, B_); else if (j_ == 1) gs_upartial(W_, h2q[1], pz, B_); \
                else if (j_ == 2) gs_upartial(W_, h2q[2], pz, B_); else gs_upartial(W_, h2q[3], pz, B_); }
#define GS_RD(i_) ((unsigned)__builtin_amdgcn_readfirstlane((int)sched[(i_)]))
            unsigned da = GS_RD(0), db = GS_RD(1), dn = GS_RD(2), ea, eb, en;
            gs_desc(ent, da, lane, ea); gs_desc(ent, db, lane, eb); gs_desc(ent, dn, lane, en);
            gs_loads(UT, ea, lane, wa);
#pragma unroll 1
            for (int i = 0; i < nbat; i += 2) {
                float pz[16];
                gs_loads(UT, eb, lane, wb);
                __builtin_amdgcn_sched_barrier(0);
                GS_UP(wa, da, 0);
                const unsigned dcur_a = da, dcur_b = db;
                da = dn; ea = en; dn = GS_RD(i + 3); gs_desc(ent, dn, lane, en);
                gs_loads(UT, ea, lane, wa);
                __builtin_amdgcn_sched_barrier(0);
                GS_UP(wb, dcur_b, 8);
                db = dn; eb = en; dn = GS_RD(i + 4); gs_desc(ent, dn, lane, en);
                gs_ustore(pz, zb, dcur_a, dcur_b, lane);
            }
#undef GS_UP
#undef GS_RD
        }
        float asum[GT];
#pragma unroll
        for (int j = 0; j < GT; ++j) {
            float as = 0.f;
#pragma unroll
            for (int q = 0; q < 2; ++q) {
                const int pos = j * 128 + q * 64 + lane;
                const uint2 e = ent[pos];
                const float z = zb[pos] * __uint_as_float(e.x & 0xffff0000u) * hsc[j];
                const float a = gelu_as(z) * __uint_as_float(e.y);
                ent[pos].y = __float_as_uint(a);
                as += a;
            }
#pragma unroll
            for (int sft = 1; sft < 64; sft <<= 1) as += __shfl_xor(as, sft);
            asum[j] = as;
        }
#pragma unroll
        for (int j = 0; j < GT; ++j)
#pragma unroll
            for (int q = 0; q < 16; ++q) acc[j][q] = 0.f;
        {
            u32x4 wa[8]; unsigned ca;
#pragma unroll 1
            for (int i = 0; i < nbat; ++i) {
                const unsigned da = (unsigned)__builtin_amdgcn_readfirstlane((int)sched[i]);
                gs_issue(VT, ent, da, lane, wa, ca);
                __builtin_amdgcn_sched_barrier(0);
                const unsigned j_ = (da & 0xffffu) >> 7;
                if (j_ == 0) gs_vcompute(wa, ca, acc[0]); else if (j_ == 1) gs_vcompute(wa, ca, acc[1]);
                else if (j_ == 2) gs_vcompute(wa, ca, acc[2]); else gs_vcompute(wa, ca, acc[3]);
            }
        }
#pragma unroll
        for (int j = 0; j < GT; ++j) {
            asm volatile("" ::: "memory");
            __builtin_amdgcn_sched_barrier(0);
            const int tok = t0 + j, b = tok / SEQ;
            float* row = p.out + (size_t)tok * DM + c0;
            const float* g2 = mod + b * 6144 + 5120 + c0;
            f32x2 r[8];
            float sm = 0.f;
#pragma unroll
            for (int q = 0; q < 4; ++q) {
                const f32x4 xv = (*(const f32x4*)(row + q * 4) - mu[j]) * rs[j] * *(const f32x4*)(p.ln1w + c0 + q * 4) + *(const f32x4*)(p.ln1b + c0 + q * 4), gg = *(const f32x4*)(g2 + q * 4);
                const float off = 128.0f * asum[j];
                r[2 * q] = DEEP_ALPHA * (f32x2){xv.x, xv.y} + (f32x2){1.f + gg.x, 1.f + gg.y} * (f32x2){acc[j][4 * q] - off, acc[j][4 * q + 1] - off};
                r[2 * q + 1] = DEEP_ALPHA * (f32x2){xv.z, xv.w} + (f32x2){1.f + gg.z, 1.f + gg.w} * (f32x2){acc[j][4 * q + 2] - off, acc[j][4 * q + 3] - off};
                sm += r[2 * q].x + r[2 * q].y + r[2 * q + 1].x + r[2 * q + 1].y;
            }
#pragma unroll
            for (int m = 1; m < 64; m <<= 1) sm += __shfl_xor(sm, m);
            const float mu = sm * (1.0f / 1024.0f);
            float qq = 0.f;
#pragma unroll
            for (int i = 0; i < 8; ++i) { const f32x2 dd = r[i] - mu; qq += dd.x * dd.x + dd.y * dd.y; }
#pragma unroll
            for (int m = 1; m < 64; m <<= 1) qq += __shfl_xor(qq, m);
            const float rstd = rsqrtf(qq * (1.0f / 1024.0f) + LN_EPS);
#pragma unroll
            for (int q = 0; q < 4; ++q) {
                const f32x4 w4 = *(const f32x4*)(p.ln2w + c0 + q * 4), bi = *(const f32x4*)(p.ln2b + c0 + q * 4);
                f32x4 ov;
                ov.x = (r[2 * q].x - mu) * rstd * w4.x + bi.x; ov.y = (r[2 * q].y - mu) * rstd * w4.y + bi.y;
                ov.z = (r[2 * q + 1].x - mu) * rstd * w4.z + bi.z; ov.w = (r[2 * q + 1].y - mu) * rstd * w4.w + bi.w;
                *(f32x4*)(row + q * 4) = ov;
            }
        }
    }
}

#define XB_TMO      128
#define XB_XCNT(j)  (256  + 64 * (j))
#define XB_XSUB(j)  (1280 + 64 * (j))
#define XB_XGEN(j)  (2304 + 64 * (j))
#define XB_TOP      3328
#define XB_TOPGEN   3392
#define XCD_BAR_WORDS 3456
#define XB_SPIN_CAP (1u << 22)
#define LAS __attribute__((address_space(3)))
DI unsigned xb_ld(unsigned* p) { return __hip_atomic_load(p, __ATOMIC_RELAXED, __HIP_MEMORY_SCOPE_AGENT); }
DI unsigned xb_add(unsigned* p, unsigned v) { return __hip_atomic_fetch_add(p, v, __ATOMIC_RELAXED, __HIP_MEMORY_SCOPE_AGENT); }
DI unsigned xb_xcc_id() { return (unsigned)__builtin_amdgcn_s_getreg((3 << 11) | 20) & 0xFu; }
#define XB_SPIN(cond, bar) do { unsigned _sp = 0; while (cond) { __builtin_amdgcn_s_sleep(1); \
    if ((++_sp & 255u) == 0u) { if (xb_ld(&(bar)[XB_TMO])) break; if (_sp > XB_SPIN_CAP) { atomicAdd(&(bar)[XB_TMO], 1u); break; } } } } while (0)
struct XcdBarrier { unsigned* bar; unsigned x; volatile LAS unsigned* st; };
DI XcdBarrier xcd_barrier_post(unsigned* bar, volatile LAS unsigned* st) {
    XcdBarrier b; b.bar = bar; b.x = xb_xcc_id(); b.st = st;
    if (__builtin_amdgcn_workitem_id_x() == 0) (void)xb_add(&bar[XB_XCNT(b.x)], 1u);
    return b;
}
DI void xcd_barrier_complete(unsigned* bar, unsigned x, unsigned& nloc, unsigned& nx) {
    const unsigned G = gridDim.x * gridDim.y * gridDim.z;
    unsigned sum, cnt, mine, sp = 0u;
    for (;;) {
        sum = 0u; cnt = 0u; mine = 0u;
#pragma unroll
        for (unsigned j = 0; j < 16; ++j) { const unsigned c = xb_ld(&bar[XB_XCNT(j)]); sum += c; cnt += (c > 0u) ? 1u : 0u; mine = (j == x) ? c : mine; }
        if (sum == G) break;
        __builtin_amdgcn_s_sleep(1);
        if ((++sp & 255u) == 0u) { if (xb_ld(&bar[XB_TMO])) break; if (sp > XB_SPIN_CAP) { atomicAdd(&bar[XB_TMO], 1u); break; } }
    }
    nloc = mine > 0u ? mine : 1u; nx = cnt > 0u ? cnt : 1u;
}
DI void xcd_barrier(const XcdBarrier& b) {
    asm volatile("s_waitcnt vmcnt(0)" ::: "memory");
    __syncthreads();
    if (__builtin_amdgcn_workitem_id_x() == 0) {
        unsigned* bar = b.bar;
        __builtin_amdgcn_s_waitcnt(0);
        unsigned nloc = b.st[0], nx = b.st[1];
        if (nloc == 0u) { xcd_barrier_complete(bar, b.x, nloc, nx); b.st[0] = nloc; b.st[1] = nx; }
        const unsigned old = xb_add(&bar[XB_XSUB(b.x)], 1u);
        const unsigned gen = old / nloc;
        if (old + 1u == (gen + 1u) * nloc) {
            __builtin_amdgcn_fence(__ATOMIC_RELEASE, "agent");
            asm volatile("s_waitcnt vmcnt(0)" ::: "memory");
            const unsigned og = xb_add(&bar[XB_TOP], 1u);
            const unsigned tg = og / nx;
            if (og + 1u == (tg + 1u) * nx) xb_add(&bar[XB_TOPGEN], 1u);
            else XB_SPIN(xb_ld(&bar[XB_TOPGEN]) == tg, bar);
            __builtin_amdgcn_fence(__ATOMIC_ACQUIRE, "agent");
            xb_add(&bar[XB_XGEN(b.x)], 1u);
            asm volatile("s_waitcnt vmcnt(0)" ::: "memory");
        } else {
            XB_SPIN(xb_ld(&bar[XB_XGEN(b.x)]) == gen, bar);
            __builtin_amdgcn_fence(__ATOMIC_ACQUIRE, "agent");
            asm volatile("s_waitcnt vmcnt(0)" ::: "memory");
        }
    }
    __syncthreads();
}

__global__ void __launch_bounds__(NTH) k_mega(Params p) {
    __shared__ __attribute__((aligned(16))) char smem[SMEM_BYTES];
    volatile LAS unsigned* xst = (volatile LAS unsigned*)(smem + SMEM_BYTES - 16);
    if (__builtin_amdgcn_workitem_id_x() == 0) { xst[0] = 0u; xst[1] = 0u; }
    __syncthreads();
    const XcdBarrier xb = xcd_barrier_post((unsigned*)(p.ws + OFF_BAR), xst);
    const int bid = blockIdx.x, nb = gridDim.x;
#ifndef PROBE_MASK
#define PROBE_MASK 0
#endif
#define REP(bit) for (int rep_ = 0; rep_ < ((PROBE_MASK & (bit)) ? 2 : 1); ++rep_)
    phase_prep_a(p, smem);           xcd_barrier(xb);
    phase_prep_b(p, smem);           xcd_barrier(xb);
    REP(1)  { phase_proj(p, bid, nb, smem);    xcd_barrier(xb); }
    REP(2)  { phase_mix(p, bid, nb, smem);     xcd_barrier(xb); }
    REP(4)  { phase_glu(p, bid, nb, smem);     xcd_barrier(xb); }
    REP(4)  { phase_a2(p, bid, nb);            xcd_barrier(xb); }
    REP(4)  { phase_outproj(p, bid, nb, smem); xcd_barrier(xb); }
    REP(8)  { phase_q(p, bid, nb, smem);       xcd_barrier(xb); }
    REP(16) { phase_retrieve(p, bid, nb, smem); xcd_barrier(xb); }
    phase_gather(p, bid, nb, smem, (unsigned*)(p.ws + OFF_BAR) + 16 * xb.x, xst[0]);
}

extern "C" void kernel_launch(void* const* d_in, const int* in_sizes, int n_in, void* d_out, int out_size, void* d_ws, size_t ws_size, hipStream_t stream) {
    if (n_in != 27 || ws_size < WS_END) { fprintf(stderr, "kernel_launch: unexpected n_in %d or ws_size %zu (< %zu)\n", n_in, ws_size, (size_t)WS_END); return; }
    static int grid_blocks = 0;
    if (!grid_blocks) {
        int dev = 0, cus = 0, per_cu = 0;
        (void)hipGetDevice(&dev);
        (void)hipDeviceGetAttribute(&cus, hipDeviceAttributeMultiprocessorCount, dev);
        (void)hipOccupancyMaxActiveBlocksPerMultiprocessor(&per_cu, k_mega, NTH, 0);
        if (cus <= 0) cus = 256;
        if (per_cu < 1) { fprintf(stderr, "kernel_launch: occupancy query says %d blocks/CU\n", per_cu); per_cu = 1; }
        grid_blocks = cus;
    }
    Params p{};
    const float** f = (const float**)&p;
    for (int i = 0; i < 27; ++i) f[i] = (const float*)d_in[i];
    p.out = (float*)d_out; p.ws = (char*)d_ws;
    hipError_t e = hipMemsetAsync((char*)d_ws + OFF_BAR, 0, (size_t)3456 * 4, stream);
    if (e == hipSuccess) { hipLaunchKernelGGL(k_mega, dim3(grid_blocks), dim3(NTH), 0, stream, p); e = hipPeekAtLastError(); }
    if (e != hipSuccess) fprintf(stderr, "launch failed: %s (grid %d)\n", hipGetErrorString(e), grid_blocks);
}
```

```cpp
#include <hip/hip_runtime.h>
#include <hip/hip_cooperative_groups.h>
#include <stdint.h>
#include <stdio.h>

namespace cg = cooperative_groups;
#define DI __device__ __forceinline__
typedef unsigned short bf16_t;
typedef short bf16x8 __attribute__((ext_vector_type(8)));
typedef float f32x16 __attribute__((ext_vector_type(16)));
typedef unsigned u32x4 __attribute__((ext_vector_type(4)));
typedef float f32x4 __attribute__((ext_vector_type(4)));
typedef float f32x2 __attribute__((ext_vector_type(2)));

constexpr int NTH = 512;
constexpr int NB = 16, SEQ = 2048, DM = 1024, NTOK = NB * SEQ;
constexpr int DHG = 512, HGH = 4, HDK = 128;
constexpr int DSS = 512, SSG = 32, SSC = 16, SSP = 64;
constexpr int INC = 2560;
constexpr int PHEADS = 8, NKEYS = 128, TOPK = 16, NEXP = 16384;
constexpr float DEEP_ALPHA = 1.189207115002721f;
constexpr float LN_EPS = 1e-5f, RMS_EPS = 1e-6f;
constexpr int SMEM_BYTES = 128 * 1024 + 256;

constexpr size_t al256(size_t x) { return (x + 255) & ~(size_t)255; }
constexpr size_t OFF_MOD = 0;
constexpr size_t OFF_LB = al256(OFF_MOD + (size_t)NB * 6144 * 4);
constexpr size_t OFF_LAM = al256(OFF_LB + 512 * 4);
constexpr size_t OFF_BB = al256(OFF_LAM + 32 * 64 * 2 * 4);
constexpr size_t OFF_WIN = al256(OFF_BB + 32 * 64 * 16 * 2 * 4);
constexpr size_t OFF_GLU = al256(OFF_WIN + (size_t)INC * DM * 2);
constexpr size_t OFF_WOUT = al256(OFF_GLU + (size_t)512 * 512 * 2);
constexpr size_t OFF_WQ = al256(OFF_WOUT + (size_t)DM * DM * 2);
constexpr size_t OFF_SUBK = al256(OFF_WQ + (size_t)2048 * DM * 2);
constexpr size_t OFF_SU = al256(OFF_SUBK + (size_t)16 * 128 * 128 * 2);
constexpr size_t OFF_SV = al256(OFF_SU + (size_t)NEXP * 4);
constexpr size_t OFF_UT = al256(OFF_SV + (size_t)NEXP * 4);
constexpr size_t OFF_VT = al256(OFF_UT + (size_t)NEXP * DM * 2);
constexpr size_t OFF_H = al256(OFF_VT + (size_t)NEXP * DM * 2);
constexpr size_t OFF_PROJ = al256(OFF_H + (size_t)NTOK * DM * 2);
constexpr size_t OFF_ORAW = al256(OFF_PROJ + (size_t)NTOK * INC * 2);
constexpr size_t OFF_YSSM = al256(OFF_ORAW + (size_t)NTOK * DHG * 4);
constexpr size_t OFF_A2 = al256(OFF_YSSM + (size_t)NTOK * DSS * 2);
constexpr size_t OFF_HG = al256(OFF_A2 + (size_t)NTOK * DM * 2);
constexpr size_t OFF_S5K = al256(OFF_HG + (size_t)4096 * 128 * 4);
constexpr size_t OFF_S5N = al256(OFF_S5K + (size_t)32 * 4096 * 2);
constexpr size_t OFF_S5M = al256(OFF_S5N + (size_t)32 * 128 * 256 * 2);
constexpr size_t OFF_S5L = al256(OFF_S5M + (size_t)32 * 256 * 128 * 2);
constexpr size_t OFF_STAT = al256(OFF_S5L + (size_t)32 * 64 * 2 * 4);
constexpr size_t OFF_AB = al256(OFF_STAT + (size_t)NTOK * 3 * 4);
constexpr size_t OFF_CAB = al256(OFF_AB + (size_t)2 * NB * DM * 4);
constexpr size_t OFF_BAR = al256(OFF_CAB + (size_t)2 * NB * 2048 * 4);
constexpr size_t WS_END = al256(OFF_BAR + (size_t)3456 * 4);
constexpr size_t OFF_HQ = OFF_ORAW, OFF_HK = OFF_ORAW + (size_t)NTOK * DHG * 2;
constexpr size_t OFF_TOPL = OFF_ORAW;
constexpr size_t OFF_EXPS = OFF_ORAW + (size_t)NTOK * 16 * 16 * 4;

struct Params {
    const float *x, *c, *ada_w, *ada_b, *w_in, *hg_lb, *hg_nw, *a_re, *a_im, *log_dt, *b_re, *b_im, *c_re, *c_im, *dsk,
        *glu_w, *glu_b, *ssm_nw, *w_out, *ln1w, *ln1b, *w_q, *subk, *pu, *pv, *ln2w, *ln2b;
    float* out;
    char* ws;
};

DI int my_tid() { int t = (int)__builtin_amdgcn_workitem_id_x(); asm volatile("" : "+v"(t)); return t; }
DI bf16_t f2bf(float x) { unsigned u = __float_as_uint(x); u += 0x7fffu + ((u >> 16) & 1u); return (bf16_t)(u >> 16); }
DI float bf2f(bf16_t b) { return __uint_as_float(((unsigned)b) << 16); }
DI float bflo(unsigned w) { return __uint_as_float(w << 16); }
DI float bfhi(unsigned w) { return __uint_as_float(w & 0xffff0000u); }
typedef __bf16 hwbf16x2 __attribute__((ext_vector_type(2)));
DI unsigned pack2(float a, float b) { const f32x2 v = {a, b}; return __builtin_bit_cast(unsigned, __builtin_convertvector(v, hwbf16x2)); }
DI bf16x8 pack8(const f32x16& x, const int base) {
    u32x4 o; o.x = pack2(x[base], x[base + 1]); o.y = pack2(x[base + 2], x[base + 3]); o.z = pack2(x[base + 4], x[base + 5]); o.w = pack2(x[base + 6], x[base + 7]);
    return __builtin_bit_cast(bf16x8, o);
}
DI float sigmoidf_(float x) { return 1.0f / (1.0f + __expf(-x)); }
DI float siluf_(float x) { return x * sigmoidf_(x); }
DI float geluf_(float x) { return 0.5f * x * (1.0f + erff(x * 0.70710678118654752f)); }
DI float gelu_as(float v) {
    const float t = __builtin_amdgcn_rcpf(fabsf(v) * 0.2316418882f + 1.0f);
    float q = t * 0.5307027145f + (-0.7265760135f); q = q * t + 0.7107068705f; q = q * t + (-0.142248368f); q = q * t + 0.127414796f; q = q * t;
    const float m = v * (q * __builtin_amdgcn_exp2f(v * v * (-0.72134752044f)));
    return v < 0.f ? m : v - m;
}

template <int MT, int NT_, int WM, int WN, class Epi>
DI void gemm_block(const bf16_t* __restrict__ A, int lda, const bf16_t* __restrict__ Bt, int ldb, int K, char* smem, Epi epi) {
    constexpr int BM = WM * MT * 32, BN = WN * NT_ * 32, LS = 72;
    static_assert(WM * WN == 8, "8 waves");
    bf16_t* As = (bf16_t*)smem;
    bf16_t* Bs = As + BM * LS;
    const int tid = my_tid(), lane = tid & 63, wid = tid >> 6, r = lane & 31, h = lane >> 5;
    const int wm = wid / WN, wn = wid % WN;
    constexpr int PA = BM * 8 / NTH, PB = BN * 8 / NTH;
    u32x4 ra[PA], rb[PB];
    f32x16 acc[MT][NT_];
#pragma unroll
    for (int mi = 0; mi < MT; ++mi)
#pragma unroll
        for (int ni = 0; ni < NT_; ++ni)
#pragma unroll
            for (int i = 0; i < 16; ++i) acc[mi][ni][i] = 0.f;
#define GEMM_GLOAD(kt_) { \
    _Pragma("unroll") for (int q = 0; q < PA; ++q) { const int idx = tid + q * NTH, row = idx >> 3, ch = idx & 7; ra[q] = *(const u32x4*)(A + (size_t)row * lda + (kt_) * 64 + ch * 8); } \
    _Pragma("unroll") for (int q = 0; q < PB; ++q) { const int idx = tid + q * NTH, row = idx >> 3, ch = idx & 7; rb[q] = *(const u32x4*)(Bt + (size_t)row * ldb + (kt_) * 64 + ch * 8); } }
#define GEMM_LSTORE() { \
    _Pragma("unroll") for (int q = 0; q < PA; ++q) { const int idx = tid + q * NTH, row = idx >> 3, ch = idx & 7; *(u32x4*)(As + row * LS + ch * 8) = ra[q]; } \
    _Pragma("unroll") for (int q = 0; q < PB; ++q) { const int idx = tid + q * NTH, row = idx >> 3, ch = idx & 7; *(u32x4*)(Bs + row * LS + ch * 8) = rb[q]; } }
    GEMM_GLOAD(0); GEMM_LSTORE(); __syncthreads();
    const int nk = K / 64;
    for (int kt = 0; kt < nk; ++kt) {
        if (kt + 1 < nk) GEMM_GLOAD(kt + 1);
#pragma unroll
        for (int ks = 0; ks < 4; ++ks) {
            bf16x8 a[MT], b[NT_];
#pragma unroll
            for (int mi = 0; mi < MT; ++mi) a[mi] = *(const bf16x8*)(As + (wm * MT * 32 + mi * 32 + r) * LS + ks * 16 + h * 8);
#pragma unroll
            for (int ni = 0; ni < NT_; ++ni) b[ni] = *(const bf16x8*)(Bs + (wn * NT_ * 32 + ni * 32 + r) * LS + ks * 16 + h * 8);
#pragma unroll
            for (int mi = 0; mi < MT; ++mi)
#pragma unroll
                for (int ni = 0; ni < NT_; ++ni) acc[mi][ni] = __builtin_amdgcn_mfma_f32_32x32x16_bf16(a[mi], b[ni], acc[mi][ni], 0, 0, 0);
        }
        __syncthreads();
        if (kt + 1 < nk) { GEMM_LSTORE(); __syncthreads(); }
    }
#pragma unroll
    for (int mi = 0; mi < MT; ++mi)
#pragma unroll
        for (int ni = 0; ni < NT_; ++ni)
#pragma unroll
            for (int i = 0; i < 16; ++i) epi(wm * MT * 32 + mi * 32 + (i & 3) + 8 * (i >> 2) + 4 * h, wn * NT_ * 32 + ni * 32 + r, acc[mi][ni][i]);
}

namespace pg8 {
#define PG8_LAS __attribute__((address_space(3)))
typedef unsigned short bf16_t;
typedef short bf16x8 __attribute__((ext_vector_type(8)));
typedef float f32x4 __attribute__((ext_vector_type(4)));
typedef unsigned u32x4 __attribute__((ext_vector_type(4)));
constexpr int BM = 256, BK = 64, HALF = 128, HTB = HALF * BK * 2  , STAGE_BYTES = 8 * HTB, NXCD = 8, WGM = 8;

__host__ __device__ __forceinline__ int lds_byte(int r, int c) { const int st = (r >> 4) * 2 + (c >> 5), rr = r & 15, cc = c & 31, ob = rr * 64 + cc * 2; return st * 1024 + (ob ^ (((ob >> 9) & 1) << 5)); }
__host__ __device__ __forceinline__ void stage_rc(int b, int& R, int& C) { const int st = b / 1024, sb = b % 1024, swz = sb ^ (((sb >> 9) & 1) << 5); R = (st >> 1) * 16 + swz / 64; C = (st & 1) * 32 + (swz % 64) / 2; }
__host__ __device__ __forceinline__ int perm32(int rho) { const int n = rho >> 4, i = rho & 15; return 8 * (i >> 2) + 4 * n + (i & 3); }

struct Unit { int pm, pn; };
struct Gemm { const bf16_t* A; const bf16_t* Bt; int M, N, K; };

struct StaticOrder {
    int nM, nN, nwg, G, c;
    __host__ __device__ void init(int M, int N, int G_, int c_) { nM = M / BM; nN = N / BM; nwg = nM * nN; G = G_; c = c_; }
    __host__ __device__ bool next(int i, Unit& u) const {
        const long L = (long)i * G + c; if (L >= nwg) return false;
        int wgid = (int)L; { const int q = nwg / NXCD, r = nwg % NXCD, xcd = wgid % NXCD, off = wgid / NXCD; wgid = (xcd < r ? xcd * (q + 1) : r * (q + 1) + (xcd - r) * q) + off; }
        const int nig = WGM * nN, gid = wgid / nig, fm = gid * WGM, gsz = (nM - fm) < WGM ? (nM - fm) : WGM;
        u.pm = fm + ((wgid % nig) % gsz); u.pn = (wgid % nig) / gsz; return true;
    }
    __device__ __forceinline__ void a_ready(const Unit&) const {}
    __device__ __forceinline__ void done(const Unit&) const {}
};
template <class Epi, class Sched, bool STAMP = false>
__device__ __forceinline__ void gemm_phase(PG8_LAS unsigned char* lds, const Gemm g, const Sched& S, const Epi& E, unsigned long long* stamps) {
    int tid_ = (int)__builtin_amdgcn_workitem_id_x(); asm volatile("" : "+v"(tid_));
    const int tid = tid_, wid = __builtin_amdgcn_readfirstlane(tid >> 6), lane = tid & 63, wr = wid >> 2, wc = wid & 3, fr = lane & 15, fq = lane >> 4;
    const int K = g.K, nt = K / BK;
    int ts_lo = 0, ts_hi = 0, nts = 0; const unsigned long long rt_entry = STAMP ? (unsigned long long)wall_clock64() : 0ull;
#define PG8_STAMP() do { if (STAMP && wid == 0 && nts < 64) { const unsigned long long _c = (unsigned long long)clock64(); \
        ts_lo = (lane == nts) ? (int)(unsigned)_c : ts_lo; ts_hi = (lane == nts) ? (int)(unsigned)(_c >> 32) : ts_hi; ++nts; } } while (0)
    PG8_STAMP();
    unsigned voffA[2], voffB[2];
#pragma unroll
    for (int i = 0; i < 2; ++i) { int R, C; stage_rc(tid * 16 + i * 8192, R, C); const int Rb = Epi::PERM ? ((R & ~31) + perm32(R & 31)) : R;
        voffA[i] = (unsigned)(R * K + C) * 2u; voffB[i] = (unsigned)(Rb * K + C) * 2u; }
    const size_t kstep = (size_t)(BK * 2);
    const size_t hstep = (size_t)HALF * K * 2;
    const size_t tstep = 2 * hstep;
    const unsigned ldsw = (unsigned)wid * 1024u;
    const int aoff = lds_byte(wr * 64 + fr, fq * 8), boff = lds_byte(wc * 32 + fr, fq * 8);
#define PG8_SA(b, h) (((b) * 2 + (h)) * HTB)
#define PG8_SB(b, h) ((4 + (b) * 2 + (h)) * HTB)
#define PG8_STAGE(bufoff, gbase, voff) do { _Pragma("unroll") for (int _i = 0; _i < 2; ++_i) \
        __builtin_amdgcn_global_load_lds((const unsigned*)((const char*)(gbase) + (voff)[_i]), (PG8_LAS unsigned*)(lds + (bufoff) + ldsw + _i * 8192), 16, 0, 0); } while (0)
#define PG8_LDA(dst, b, h) do { _Pragma("unroll") for (int m = 0; m < 4; ++m) _Pragma("unroll") for (int k = 0; k < 2; ++k) dst[m][k] = *(const PG8_LAS bf16x8*)(lds + PG8_SA(b, h) + aoff + m * 2048 + k * 1024); } while (0)
#define PG8_LDB(dst, b, h) do { _Pragma("unroll") for (int n = 0; n < 2; ++n) _Pragma("unroll") for (int k = 0; k < 2; ++k) dst[n][k] = *(const PG8_LAS bf16x8*)(lds + PG8_SB(b, h) + boff + n * 2048 + k * 1024); } while (0)
#define PG8_MMA(ai, bj, At, Bt) do { __builtin_amdgcn_s_setprio(1); _Pragma("unroll") for (int m = 0; m < 4; ++m) _Pragma("unroll") for (int n = 0; n < 2; ++n) _Pragma("unroll") for (int k = 0; k < 2; ++k) \
        acc[ai][bj][m][n] = __builtin_amdgcn_mfma_f32_16x16x32_bf16(Bt[n][k], At[m][k], acc[ai][bj][m][n], 0, 0, 0); __builtin_amdgcn_s_setprio(0); } while (0)
#define PG8_WAIT_V(n) asm volatile("s_waitcnt vmcnt(" #n ")" ::: "memory")
#define PG8_WAIT_L(n) asm volatile("s_waitcnt lgkmcnt(" #n ")" ::: "memory")
#define PG8_BAR __builtin_amdgcn_s_barrier()
#define PG8_SCHED __builtin_amdgcn_sched_barrier(0)
    Unit cur, nxt; int ui = 0;
    if (!S.next(0, cur)) return;
    f32x4 acc[2][2][4][2];
#pragma unroll
    for (int a = 0; a < 2; ++a)
#pragma unroll
        for (int b = 0; b < 2; ++b)
#pragma unroll
            for (int m = 0; m < 4; ++m)
#pragma unroll
                for (int n = 0; n < 2; ++n) acc[a][b][m][n] = (f32x4){0.f, 0.f, 0.f, 0.f};
    bf16x8 At[4][2], B0[2][2], B1[2][2];
    const char* cA = (const char*)g.A + (size_t)cur.pm * tstep; const char* cB = (const char*)g.Bt + (size_t)cur.pn * tstep;
    S.a_ready(cur);
    PG8_STAGE(PG8_SB(0, 0), cB, voffB); PG8_STAGE(PG8_SA(0, 0), cA, voffA); PG8_STAGE(PG8_SB(0, 1), cB + hstep, voffB); PG8_STAGE(PG8_SA(0, 1), cA + hstep, voffA);
    if (wr == 1) PG8_BAR;
    PG8_WAIT_V(4); PG8_BAR;
    PG8_STAGE(PG8_SB(1, 0), cB + kstep, voffB); PG8_STAGE(PG8_SA(1, 0), cA + kstep, voffA); PG8_STAGE(PG8_SB(1, 1), cB + hstep + kstep, voffB);
    PG8_WAIT_V(6); PG8_BAR;
    PG8_STAMP();
    for (;;) {
        const bool has_next = S.next(ui + 1, nxt);
        const char* nA = has_next ? (const char*)g.A + (size_t)nxt.pm * tstep : cA; const char* nB = has_next ? (const char*)g.Bt + (size_t)nxt.pn * tstep : cB;
        for (int t = 0; t < nt; t += 2) {
            const bool last = (t == nt - 2);
            const char* a1 = cA + (size_t)(t + 1) * kstep;
            const char* a2 = last ? nA : cA + (size_t)(t + 2) * kstep; const char* b2 = last ? nB : cB + (size_t)(t + 2) * kstep;
            const char* a3 = a2 + kstep; const char* b3 = b2 + kstep;
            if (last && has_next) S.a_ready(nxt);
            if constexpr (Epi::MIDSCALE) { if (t == nt / 2) E.midscale(acc, cur, wr, fr); }
            PG8_LDB(B0, 0, 0); PG8_SCHED; PG8_LDA(At, 0, 0); PG8_STAGE(PG8_SA(1, 1), a1 + hstep, voffA);
            PG8_WAIT_L(8); PG8_BAR; PG8_WAIT_L(0); PG8_MMA(0, 0, At, B0); PG8_BAR; PG8_SCHED;
            PG8_LDB(B1, 0, 1); PG8_STAGE(PG8_SB(0, 0), b2, voffB);
            PG8_BAR; PG8_WAIT_L(0); PG8_MMA(0, 1, At, B1); PG8_BAR;
            PG8_LDA(At, 0, 1); PG8_STAGE(PG8_SA(0, 0), a2, voffA);
            PG8_BAR; PG8_WAIT_L(0); PG8_MMA(1, 0, At, B0); PG8_BAR; PG8_SCHED;
            PG8_STAGE(PG8_SB(0, 1), b2 + hstep, voffB);
            PG8_WAIT_V(6); PG8_BAR; PG8_MMA(1, 1, At, B1); PG8_BAR;
            PG8_LDB(B0, 1, 0); PG8_SCHED; PG8_LDA(At, 1, 0); PG8_STAGE(PG8_SA(0, 1), a2 + hstep, voffA);
            PG8_WAIT_L(8); PG8_BAR; PG8_WAIT_L(0); PG8_MMA(0, 0, At, B0); PG8_BAR; PG8_SCHED;
            PG8_LDB(B1, 1, 1); PG8_STAGE(PG8_SB(1, 0), b3, voffB);
            PG8_BAR; PG8_WAIT_L(0); PG8_MMA(0, 1, At, B1); PG8_BAR;
            PG8_LDA(At, 1, 1); PG8_STAGE(PG8_SA(1, 0), a3, voffA);
            PG8_BAR; PG8_WAIT_L(0); PG8_MMA(1, 0, At, B0); PG8_BAR; PG8_SCHED;
            PG8_STAGE(PG8_SB(1, 1), b3 + hstep, voffB);
            PG8_WAIT_V(6); PG8_BAR; PG8_MMA(1, 1, At, B1); PG8_BAR;
        }
        PG8_STAMP();
        if constexpr (!Epi::AFTER_DRAIN) { E(acc, cur, wr, wc, fr, fq); S.done(cur); }
        PG8_STAMP();
        if (!has_next) break;
#pragma unroll
        for (int a = 0; a < 2; ++a)
#pragma unroll
            for (int b = 0; b < 2; ++b)
#pragma unroll
                for (int m = 0; m < 4; ++m)
#pragma unroll
                    for (int n = 0; n < 2; ++n) acc[a][b][m][n] = (f32x4){0.f, 0.f, 0.f, 0.f};
        cur = nxt; cA = nA; cB = nB; ++ui;
    }
    PG8_WAIT_V(0);
    if (wr == 0) PG8_BAR;
    PG8_BAR;
    if constexpr (Epi::AFTER_DRAIN) { E.fused(acc, cur, wr, wc, fr, fq, lds, wid, lane); S.done(cur); }
    PG8_STAMP();
    if (STAMP && wid == 0) { stamps[lane] = lane < nts ? (((unsigned long long)(unsigned)ts_hi << 32) | (unsigned)ts_lo) : 0ull;
        if (lane == 62) stamps[62] = rt_entry; if (lane == 63) stamps[63] = (unsigned long long)wall_clock64(); }
#undef PG8_STAMP
#undef PG8_SA
#undef PG8_SB
#undef PG8_STAGE
#undef PG8_LDA
#undef PG8_LDB
#undef PG8_MMA
#undef PG8_WAIT_V
#undef PG8_WAIT_L
#undef PG8_BAR
#undef PG8_SCHED
}

__device__ __forceinline__ unsigned pk_bf16(float lo, float hi) { typedef float v2f __attribute__((ext_vector_type(2))); typedef __bf16 v2b __attribute__((ext_vector_type(2))); const v2f v = {lo, hi}; return __builtin_bit_cast(unsigned, __builtin_convertvector(v, v2b)); }
__device__ __forceinline__ float silu1(float x) { return x * __builtin_amdgcn_rcpf(1.0f + __expf(-x)); }
struct EpiBf16Act {
    static constexpr bool PERM = true, AFTER_DRAIN = false, MIDSCALE = false;
    bf16_t* O; int ldc; unsigned silu_mask;
    __device__ __forceinline__ void operator()(const f32x4 (&acc)[2][2][4][2], const Unit& u, int wr, int wc, int fr, int fq) const {
        const int row0 = u.pm * BM + wr * 64 + fr, col0 = u.pn * BM + wc * 32 + 8 * fq;
        const bool act = (silu_mask >> u.pn) & 1u;
#pragma unroll
        for (int ai = 0; ai < 2; ++ai)
#pragma unroll
            for (int m = 0; m < 4; ++m) { bf16_t* rowp = O + (size_t)(row0 + ai * HALF + m * 16) * ldc + col0;
#pragma unroll
                for (int bj = 0; bj < 2; ++bj) { f32x4 v0 = acc[ai][bj][m][0], v1 = acc[ai][bj][m][1];
                    if (act) {
#pragma unroll
                        for (int j = 0; j < 4; ++j) { v0[j] = silu1(v0[j]); v1[j] = silu1(v1[j]); } }
                    u32x4 w; w.x = pk_bf16(v0[0], v0[1]); w.y = pk_bf16(v0[2], v0[3]); w.z = pk_bf16(v1[0], v1[1]); w.w = pk_bf16(v1[2], v1[3]);
                    *(u32x4*)(rowp + bj * HALF) = w; } }
    }
};
struct EpiProj {
    static constexpr bool PERM = true, AFTER_DRAIN = false, MIDSCALE = false;
    bf16_t* O; bf16_t* HQ; bf16_t* HK; float* HG; const float* LB;
    __device__ __forceinline__ void operator()(const f32x4 (&acc)[2][2][4][2], const Unit& u, int wr, int wc, int fr, int fq) const {
        if (u.pn >= 4) {
            const int row0 = u.pm * BM + wr * 64 + fr, col0 = u.pn * BM + wc * 32 + 8 * fq;
            const bool act = (u.pn == 6) || (u.pn == 7);
#pragma unroll
            for (int ai = 0; ai < 2; ++ai)
#pragma unroll
                for (int m = 0; m < 4; ++m) { bf16_t* rowp = O + (size_t)(row0 + ai * HALF + m * 16) * 2560 + col0;
#pragma unroll
                    for (int bj = 0; bj < 2; ++bj) { f32x4 v0 = acc[ai][bj][m][0], v1 = acc[ai][bj][m][1];
                        if (act) {
#pragma unroll
                            for (int j = 0; j < 4; ++j) { v0[j] = silu1(v0[j]); v1[j] = silu1(v1[j]); } }
                        u32x4 w; w.x = pk_bf16(v0[0], v0[1]); w.y = pk_bf16(v0[2], v0[3]); w.z = pk_bf16(v1[0], v1[1]); w.w = pk_bf16(v1[2], v1[3]);
                        *(u32x4*)(rowp + bj * HALF) = w; } }
            return;
        }
        const int hd = u.pn, bat = (u.pm * BM) / 2048, cb = (u.pm & 7) * 8, k0 = wc * 32 + 8 * fq, lane = fq * 16 + fr;
        float lb[8];
        { const f32x4 l0 = *(const f32x4*)(LB + hd * 128 + k0), l1 = *(const f32x4*)(LB + hd * 128 + k0 + 4);
          lb[0] = l0[0]; lb[1] = l0[1]; lb[2] = l0[2]; lb[3] = l0[3]; lb[4] = l1[0]; lb[5] = l1[1]; lb[6] = l1[2]; lb[7] = l1[3]; }
#pragma unroll
        for (int ac = 0; ac < 4; ++ac) {
            const int ai = ac >> 1, cp = ac & 1;
            __builtin_amdgcn_sched_barrier(0);
            const size_t tile = ((size_t)(bat * 4 + hd) * 64 + cb + 4 * ai + 2 * wr + cp);
#pragma unroll
            for (int eh = 0; eh < 2; ++eh) {
                __builtin_amdgcn_sched_barrier(0);
                float tot0[4];
                bf16_t* hq = HQ + tile * 4096 + k0 + 4 * eh;
                bf16_t* hk = HK + tile * 4096 + k0 + 4 * eh;
#pragma unroll
                for (int mm = 0; mm < 2; ++mm) {
                    const f32x4 q4 = acc[ai][0][2 * cp + mm][eh], f4 = acc[ai][1][2 * cp + mm][eh];
                    float qo[4], ko[4], bl[4];
#pragma unroll
                    for (int e = 0; e < 4; ++e) {
                        const float lbe = lb[4 * eh + e];
                        const float f = lbe + (1.0f - lbe) * __builtin_amdgcn_rcpf(1.0f + __expf(-f4[e]));
                        float sc = __logf(f);
                        sc += __builtin_bit_cast(float, __builtin_amdgcn_update_dpp(0, __builtin_bit_cast(int, sc), 0x111, 0xf, 0xf, true));
                        sc += __builtin_bit_cast(float, __builtin_amdgcn_update_dpp(0, __builtin_bit_cast(int, sc), 0x112, 0xf, 0xf, true));
                        sc += __builtin_bit_cast(float, __builtin_amdgcn_update_dpp(0, __builtin_bit_cast(int, sc), 0x114, 0xf, 0xf, true));
                        sc += __builtin_bit_cast(float, __builtin_amdgcn_update_dpp(0, __builtin_bit_cast(int, sc), 0x118, 0xf, 0xf, true));
                        if (mm == 1) sc += tot0[e];
                        bl[e] = sc;
                        qo[e] = silu1(q4[e]) * __expf(sc); ko[e] = (1.0f - f) * __expf(fminf(-sc, 80.0f));
                    }
                    *(uint2*)(hq + (size_t)(mm * 16 + fr) * 128) = make_uint2(pk_bf16(qo[0], qo[1]), pk_bf16(qo[2], qo[3]));
                    *(uint2*)(hk + (size_t)(mm * 16 + fr) * 128) = make_uint2(pk_bf16(ko[0], ko[1]), pk_bf16(ko[2], ko[3]));
                    if (mm == 0) {
#pragma unroll
                        for (int e = 0; e < 4; ++e) tot0[e] = __shfl(bl[e], (lane & 48) | 15);
                    } else if (fr == 15) *(f32x4*)(HG + tile * 128 + k0 + 4 * eh) = (f32x4){__expf(bl[0]), __expf(bl[1]), __expf(bl[2]), __expf(bl[3])};
                    __builtin_amdgcn_sched_barrier(0);
                }
            }
        }
    }
};
struct EpiResid {
    static constexpr bool PERM = false, AFTER_DRAIN = false, MIDSCALE = true;
    float* C; const float* X; const float* mod_g;
    static constexpr int NTOK_ = 32768;
    float alpha; bf16_t* AP; const float* avec; float* stat;
    const float* ssq; float rms_eps;
    __device__ __forceinline__ void midscale(f32x4 (&acc)[2][2][4][2], const Unit& u, int wr, int fr) const {
        const float* sp = ssq + u.pm * BM + wr * 64 + fr;
#pragma unroll
        for (int ai = 0; ai < 2; ++ai)
#pragma unroll
            for (int m = 0; m < 4; ++m) {
                const float rs = rsqrtf(sp[ai * HALF + m * 16] * (1.0f / 512.0f) + rms_eps);
#pragma unroll
                for (int bj = 0; bj < 2; ++bj)
#pragma unroll
                    for (int n = 0; n < 2; ++n) acc[ai][bj][m][n] *= rs;
            }
    }
    __device__ __forceinline__ void operator()(const f32x4 (&acc)[2][2][4][2], const Unit& u, int wr, int wc, int fr, int fq) const {
        const int row0 = u.pm * BM + wr * 64 + fr, col0 = u.pn * BM + wc * 32 + 4 * fq, bat = (u.pm * BM) / 2048;
        const float* gb = mod_g + (size_t)bat * 6144 + col0;
        const float* ab = avec + (size_t)bat * 1024 + col0;
        f32x4 gv[2][2], av[2][2];
#pragma unroll
        for (int bj = 0; bj < 2; ++bj)
#pragma unroll
            for (int n = 0; n < 2; ++n) { gv[bj][n] = *(const f32x4*)(gb + bj * HALF + n * 16) + 1.0f; av[bj][n] = *(const f32x4*)(ab + bj * HALF + n * 16); }
#pragma unroll
        for (int ai = 0; ai < 2; ++ai) {
            float s1[4], s2[4];
#pragma unroll
            for (int m = 0; m < 4; ++m) { const int row = row0 + ai * HALF + m * 16; const size_t ro = (size_t)row * 1024 + col0;
                s1[m] = 0.f; s2[m] = 0.f;
#pragma unroll
                for (int bj = 0; bj < 2; ++bj)
#pragma unroll
                    for (int n = 0; n < 2; ++n) {
                        const f32x4 xv = *(const f32x4*)(X + ro + bj * HALF + n * 16);
                        const f32x4 r1 = alpha * xv + gv[bj][n] * acc[ai][bj][m][n];
                        *(f32x4*)(C + ro + bj * HALF + n * 16) = r1;
                        const f32x4 ap = r1 * av[bj][n];
                        *(uint2*)(AP + ro + bj * HALF + n * 16) = make_uint2(pk_bf16(ap[0], ap[1]), pk_bf16(ap[2], ap[3]));
                        s1[m] += (r1[0] + r1[1]) + (r1[2] + r1[3]); s2[m] += (r1[0] * r1[0] + r1[1] * r1[1]) + (r1[2] * r1[2] + r1[3] * r1[3]);
                    }
            }
            const bool hi5 = fq & 2, hi4 = fq & 1;
            const float a1 = (hi5 ? s1[2] : s1[0]) + __shfl_xor(hi5 ? s1[0] : s1[2], 32), b1 = (hi5 ? s1[3] : s1[1]) + __shfl_xor(hi5 ? s1[1] : s1[3], 32);
            const float a2 = (hi5 ? s2[2] : s2[0]) + __shfl_xor(hi5 ? s2[0] : s2[2], 32), b2 = (hi5 ? s2[3] : s2[1]) + __shfl_xor(hi5 ? s2[1] : s2[3], 32);
            const float t1 = (hi4 ? b1 : a1) + __shfl_xor(hi4 ? a1 : b1, 16), t2 = (hi4 ? b2 : a2) + __shfl_xor(hi4 ? a2 : b2, 16);
            const int srow = u.pm * BM + wr * 64 + ai * HALF + fq * 16 + fr;
            atomicAdd(stat + srow, t1); atomicAdd(stat + NTOK_ + srow, t2);
        }
    }
};
struct EpiQLN {
    static constexpr bool PERM = true, AFTER_DRAIN = false, MIDSCALE = false;
    bf16_t* O; const float* stat; const float* ca; const float* cb; float eps;
    __device__ __forceinline__ void operator()(const f32x4 (&acc)[2][2][4][2], const Unit& u, int wr, int wc, int fr, int fq) const {
        const int row0 = u.pm * BM + wr * 64 + fr, col0 = u.pn * BM + wc * 32 + 8 * fq, bat = (u.pm * BM) / 2048;
        const float* cap = ca + (size_t)bat * 2048 + col0;
        const float* cbp = cb + (size_t)bat * 2048 + col0;
#pragma unroll
        for (int bj = 0; bj < 2; ++bj) {
            const f32x4 a0 = *(const f32x4*)(cap + bj * HALF), a1 = *(const f32x4*)(cap + bj * HALF + 4), b0 = *(const f32x4*)(cbp + bj * HALF), b1 = *(const f32x4*)(cbp + bj * HALF + 4);
#pragma unroll
            for (int ai = 0; ai < 2; ++ai)
#pragma unroll
                for (int m = 0; m < 4; ++m) {
                    const int row = row0 + ai * HALF + m * 16;
                    const float mu = stat[row] * (1.0f / 1024.0f), rstd = rsqrtf(fmaxf(stat[32768 + row] * (1.0f / 1024.0f) - mu * mu, 0.f) + eps);
                    const f32x4 v0 = rstd * (acc[ai][bj][m][0] - mu * a0) + b0, v1 = rstd * (acc[ai][bj][m][1] - mu * a1) + b1;
                    u32x4 w; w.x = pk_bf16(v0[0], v0[1]); w.y = pk_bf16(v0[2], v0[3]); w.z = pk_bf16(v1[0], v1[1]); w.w = pk_bf16(v1[2], v1[3]);
                    *(u32x4*)(O + (size_t)row * 2048 + col0 + bj * HALF) = w;
                }
        }
    }
};
struct EpiGluA2 {
    static constexpr bool PERM = true, AFTER_DRAIN = false, MIDSCALE = false;
    bf16_t* A2; const bf16_t* Y; const float* bias; const float* nw; float* ssq;
    __device__ __forceinline__ void operator()(const f32x4 (&acc)[2][2][4][2], const Unit& u, int wr, int wc, int fr, int fq) const {
        const int row0 = u.pm * BM + wr * 64 + fr, col0 = u.pn * BM + wc * 32 + 8 * fq;
        float s2[2][4];
#pragma unroll
        for (int ai = 0; ai < 2; ++ai)
#pragma unroll
            for (int m = 0; m < 4; ++m) s2[ai][m] = 0.f;
#pragma unroll
        for (int bj = 0; bj < 2; ++bj) {
            const f32x4 bv0 = *(const f32x4*)(bias + col0 + bj * HALF), bv1 = *(const f32x4*)(bias + col0 + bj * HALF + 4);
            const f32x4 wv0 = *(const f32x4*)(nw + col0 + bj * HALF), wv1 = *(const f32x4*)(nw + col0 + bj * HALF + 4);
#pragma unroll
            for (int ai = 0; ai < 2; ++ai)
#pragma unroll
                for (int m = 0; m < 4; ++m) { const int row = row0 + ai * HALF + m * 16;
                    const u32x4 yw = *(const u32x4*)(Y + (size_t)row * 512 + col0 + bj * HALF);
                    const f32x4 z0 = acc[ai][bj][m][0] + bv0, z1 = acc[ai][bj][m][1] + bv1;
                    f32x4 o0, o1;
                    o0[0] = __uint_as_float(yw.x << 16) * __builtin_amdgcn_rcpf(1.0f + __expf(-z0[0])); o0[1] = __uint_as_float(yw.x & 0xffff0000u) * __builtin_amdgcn_rcpf(1.0f + __expf(-z0[1]));
                    o0[2] = __uint_as_float(yw.y << 16) * __builtin_amdgcn_rcpf(1.0f + __expf(-z0[2])); o0[3] = __uint_as_float(yw.y & 0xffff0000u) * __builtin_amdgcn_rcpf(1.0f + __expf(-z0[3]));
                    o1[0] = __uint_as_float(yw.z << 16) * __builtin_amdgcn_rcpf(1.0f + __expf(-z1[0])); o1[1] = __uint_as_float(yw.z & 0xffff0000u) * __builtin_amdgcn_rcpf(1.0f + __expf(-z1[1]));
                    o1[2] = __uint_as_float(yw.w << 16) * __builtin_amdgcn_rcpf(1.0f + __expf(-z1[2])); o1[3] = __uint_as_float(yw.w & 0xffff0000u) * __builtin_amdgcn_rcpf(1.0f + __expf(-z1[3]));
                    s2[ai][m] += (o0[0] * o0[0] + o0[1] * o0[1]) + (o0[2] * o0[2] + o0[3] * o0[3]) + (o1[0] * o1[0] + o1[1] * o1[1]) + (o1[2] * o1[2] + o1[3] * o1[3]);
                    const f32x4 p0 = o0 * wv0, p1 = o1 * wv1;
                    u32x4 w; w.x = pk_bf16(p0[0], p0[1]); w.y = pk_bf16(p0[2], p0[3]); w.z = pk_bf16(p1[0], p1[1]); w.w = pk_bf16(p1[2], p1[3]);
                    *(u32x4*)(A2 + (size_t)row * 1024 + col0 + bj * HALF) = w;
                }
        }
        const bool hi5 = fq & 2, hi4 = fq & 1;
#pragma unroll
        for (int ai = 0; ai < 2; ++ai) {
            const float a2 = (hi5 ? s2[ai][2] : s2[ai][0]) + __shfl_xor(hi5 ? s2[ai][0] : s2[ai][2], 32), b2 = (hi5 ? s2[ai][3] : s2[ai][1]) + __shfl_xor(hi5 ? s2[ai][1] : s2[ai][3], 32);
            const float t2 = (hi4 ? b2 : a2) + __shfl_xor(hi4 ? a2 : b2, 16);
            atomicAdd(ssq + u.pm * BM + wr * 64 + ai * HALF + fq * 16 + fr, t2);
        }
    }
};
}

DI void prep_mod_item(const Params& p, int item, char* smem) {
    float* condT = (float*)smem;
    float* red = condT + DM * 16;
    const int tid = my_tid();
    for (int i = tid; i < NB * DM; i += NTH) { const int b = i >> 10, k = i & 1023; condT[k * 16 + b] = siluf_(p.c[i]); }
    __syncthreads();
    const int ks = tid >> 5, col = tid & 31;
    float acc[16];
#pragma unroll
    for (int b = 0; b < 16; ++b) acc[b] = 0.f;
    const float* w = p.ada_w + (size_t)(ks * 64) * 6144 + item * 32 + col;
#pragma unroll 1
    for (int seg = 0; seg < 4; ++seg) {
        float wreg[16];
#pragma unroll
        for (int k = 0; k < 16; ++k) wreg[k] = w[(size_t)(seg * 16 + k) * 6144];
#pragma unroll
        for (int k = 0; k < 16; ++k) {
            const float wv = wreg[k];
            const f32x4* cb = (const f32x4*)(condT + (ks * 64 + seg * 16 + k) * 16);
            const f32x4 c0 = cb[0], c1 = cb[1], c2 = cb[2], c3 = cb[3];
            acc[0] += c0.x * wv; acc[1] += c0.y * wv; acc[2] += c0.z * wv; acc[3] += c0.w * wv;
            acc[4] += c1.x * wv; acc[5] += c1.y * wv; acc[6] += c1.z * wv; acc[7] += c1.w * wv;
            acc[8] += c2.x * wv; acc[9] += c2.y * wv; acc[10] += c2.z * wv; acc[11] += c2.w * wv;
            acc[12] += c3.x * wv; acc[13] += c3.y * wv; acc[14] += c3.z * wv; acc[15] += c3.w * wv;
        }
    }
#pragma unroll
    for (int b = 0; b < 16; ++b) red[(ks * 32 + col) * 16 + b] = acc[b];
    __syncthreads();
    {
        const int b = tid >> 5;
        float sum = p.ada_b[item * 32 + col];
#pragma unroll
        for (int q = 0; q < 16; ++q) sum += red[(q * 32 + col) * 16 + b];
        ((float*)(p.ws + OFF_MOD))[b * 6144 + item * 32 + col] = sum;
    }
    __syncthreads();
}
DI void prep_s5_gemm_item(const Params& p, int g, int part, char* smem) {
    f32x2* pw = (f32x2*)smem;
    f32x2* bbL = pw + 17 * 64;
    f32x2* cL = bbL + 64 * 16;
    const int tid = my_tid();
    const float dt = expf(p.log_dt[g]);
#pragma unroll 1
    for (int idx = tid; idx < 17 * 64; idx += NTH) {
        const int j = idx >> 6, pp = idx & 63;
        const float ar = p.a_re[g * 64 + pp], ai = p.a_im[g * 64 + pp];
        const float mag = expf(ar * dt * (float)j), ang = ai * dt * (float)j;
        pw[idx] = (f32x2){mag * cosf(ang), mag * sinf(ang)};
    }
    for (int idx = tid; idx < 16 * 64; idx += NTH) { const int i = idx >> 6, pp = idx & 63; cL[idx] = (f32x2){p.c_re[(g * 16 + i) * 64 + pp], p.c_im[(g * 16 + i) * 64 + pp]}; }
    __syncthreads();
    for (int idx = tid; idx < 64 * 16; idx += NTH) {
        const int pp = idx >> 4, i = idx & 15;
        const float ar = p.a_re[g * 64 + pp], ai = p.a_im[g * 64 + pp];
        const f32x2 lam = pw[64 + pp];
        const float den = ar * ar + ai * ai, nr = lam.x - 1.0f, ni = lam.y;
        const float zr = (nr * ar + ni * ai) / den, zi = (ni * ar - nr * ai) / den;
        const float br = p.b_re[(g * 64 + pp) * 16 + i], bi = p.b_im[(g * 64 + pp) * 16 + i];
        bbL[idx] = (f32x2){zr * br - zi * bi, zr * bi + zi * br};
    }
    __syncthreads();
    bf16_t* NBg = (bf16_t*)(p.ws + OFF_S5N) + (size_t)g * 128 * 256;
    if (part == 0)
#pragma unroll 1
    for (int ch = tid; ch < 128 * 256 / 8; ch += NTH) {
        const int pq = ch >> 5, t = (ch >> 1) & 15, i0 = (ch & 1) * 8, pp = pq & 63;
        const f32x2 w = pw[(15 - t) * 64 + pp];
        float v[8];
#pragma unroll
        for (int e = 0; e < 8; ++e) { const f32x2 bb = bbL[pp * 16 + i0 + e]; v[e] = pq < 64 ? (w.x * bb.x - w.y * bb.y) : (w.x * bb.y + w.y * bb.x); }
        u32x4 o; o.x = pack2(v[0], v[1]); o.y = pack2(v[2], v[3]); o.z = pack2(v[4], v[5]); o.w = pack2(v[6], v[7]);
        *(u32x4*)(NBg + (size_t)((((pq >> 5) * 16 + t) * 64) + (i0 >> 3) * 32 + (pq & 31)) * 8) = o;
    }
    bf16_t* MBg = (bf16_t*)(p.ws + OFF_S5M) + (size_t)g * 256 * 128;
    if (part == 1)
#pragma unroll 1
    for (int ch = tid; ch < 256 * 128 / 8; ch += NTH) {
        const int ti = ch >> 4, p0 = (ch & 15) * 8, tq = ti >> 4, iq = ti & 15;
        float v[8];
#pragma unroll
        for (int e = 0; e < 8; ++e) {
            const int pq = p0 + e, pp = pq & 63;
            const f32x2 c = cL[iq * 64 + pp], w = pw[(tq + 1) * 64 + pp];
            v[e] = pq < 64 ? (c.x * w.x - c.y * w.y) : -(c.x * w.y + c.y * w.x);
        }
        u32x4 o; o.x = pack2(v[0], v[1]); o.y = pack2(v[2], v[3]); o.z = pack2(v[4], v[5]); o.w = pack2(v[6], v[7]);
        *(u32x4*)(MBg + (size_t)((((ti >> 5) * 8 + (p0 >> 4)) * 64) + ((p0 >> 3) & 1) * 32 + (ti & 31)) * 8) = o;
    }
    bf16_t* KTg = (bf16_t*)(p.ws + OFF_S5K) + (size_t)g * 4096;
    if (part >= 2)
#pragma unroll 1
    for (int idx = (part - 2) * 2048 + tid; idx < (part - 1) * 2048; idx += NTH) {
        const int lag = idx >> 8, iq = (idx >> 4) & 15, i = idx & 15;
        float acc = (lag == 0 && iq == i) ? p.dsk[g * 16 + iq] : 0.f;
#pragma unroll 4
        for (int pp = 0; pp < 64; ++pp) {
            const f32x2 c = cL[iq * 64 + pp], w = pw[lag * 64 + pp], bb = bbL[pp * 16 + i];
            const float mr = c.x * w.x - c.y * w.y, mi_ = c.x * w.y + c.y * w.x;
            acc += mr * bb.x - mi_ * bb.y;
        }
        KTg[idx] = f2bf(acc);
    }
    if (part == 3 && tid < 64) { float* L = (float*)(p.ws + OFF_S5L) + (g * 64 + tid) * 2; const f32x2 w = pw[16 * 64 + tid]; L[0] = w.x; L[1] = w.y; }
    __syncthreads();
}
DI void prep_s5_item(const Params& p, int g) {
    const int tid = my_tid();
    if (tid < SSP) {
        const int pi = g * SSP + tid;
        const float dt = expf(p.log_dt[g]);
        const float ar = p.a_re[pi], ai = p.a_im[pi];
        const float mag = expf(ar * dt);
        const float lr = mag * cosf(ai * dt), li = mag * sinf(ai * dt);
        const float den = ar * ar + ai * ai, nr = lr - 1.0f, ni = li;
        const float zr = (nr * ar + ni * ai) / den, zi = (ni * ar - nr * ai) / den;
        float* lam = (float*)(p.ws + OFF_LAM) + pi * 2;
        lam[0] = lr; lam[1] = li;
        float* bb = (float*)(p.ws + OFF_BB) + (size_t)pi * 32;
        for (int i = 0; i < SSC; ++i) {
            const float br = p.b_re[pi * SSC + i], bi = p.b_im[pi * SSC + i];
            bb[i * 2] = zr * br - zi * bi; bb[i * 2 + 1] = zr * bi + zi * br;
        }
    }
}
DI void prep_transpose_tile(const float* __restrict__ W, bf16_t* __restrict__ Wt, int K, int N, int kt, int nt, char* smem, int dst_row0 = -1, int kswap = 0) {
    float* tile = (float*)smem;
    const int tid = my_tid();
#pragma unroll
    for (int q = 0; q < 2; ++q) {
        const int kk = (tid >> 4) + q * 32, c4 = (tid & 15) * 4;
        const float4 v = *(const float4*)(W + (size_t)(kt * 64 + kk) * N + nt * 64 + c4);
        tile[kk * 65 + c4] = v.x; tile[kk * 65 + c4 + 1] = v.y; tile[kk * 65 + c4 + 2] = v.z; tile[kk * 65 + c4 + 3] = v.w;
    }
    __syncthreads();
    const int n = tid >> 3, kc = tid & 7;
    uint4 o;
    o.x = pack2(tile[(kc * 8 + 0) * 65 + n], tile[(kc * 8 + 1) * 65 + n]);
    o.y = pack2(tile[(kc * 8 + 2) * 65 + n], tile[(kc * 8 + 3) * 65 + n]);
    o.z = pack2(tile[(kc * 8 + 4) * 65 + n], tile[(kc * 8 + 5) * 65 + n]);
    o.w = pack2(tile[(kc * 8 + 6) * 65 + n], tile[(kc * 8 + 7) * 65 + n]);
    *(uint4*)(Wt + (size_t)((dst_row0 < 0 ? nt * 64 : dst_row0) + n) * K + ((kt * 64 + kswap) & (K - 1)) + kc * 8) = o;
    __syncthreads();
}
DI void cvt_bf16_stream(const float* __restrict__ src, bf16_t* __restrict__ dst, size_t n8, int bid, int nb) {
    for (size_t i = (size_t)bid * NTH + my_tid(); i < n8; i += (size_t)nb * NTH) {
        const float4 a = *(const float4*)(src + i * 8), b = *(const float4*)(src + i * 8 + 4);
        uint4 o; o.x = pack2(a.x, a.y); o.y = pack2(a.z, a.w); o.z = pack2(b.x, b.y); o.w = pack2(b.z, b.w);
        *(uint4*)(dst + i * 8) = o;
    }
}
DI void cvt_fp8_rows(const float* __restrict__ src, unsigned char* __restrict__ dst, float* __restrict__ inv, int bid, int nb) {
    const int lane = my_tid() & 63, wid = my_tid() >> 6;
    for (int row = bid * 8 + wid; row < NEXP; row += nb * 8) {
        const float* sp = src + (size_t)row * DM + lane * 16;
        const f32x4 a = *(const f32x4*)sp, b = *(const f32x4*)(sp + 4), c = *(const f32x4*)(sp + 8), d = *(const f32x4*)(sp + 12);
        float m = fmaxf(fmaxf(fmaxf(fabsf(a.x), fabsf(a.y)), fmaxf(fabsf(a.z), fabsf(a.w))), fmaxf(fmaxf(fabsf(b.x), fabsf(b.y)), fmaxf(fabsf(b.z), fabsf(b.w))));
        m = fmaxf(m, fmaxf(fmaxf(fmaxf(fabsf(c.x), fabsf(c.y)), fmaxf(fabsf(c.z), fabsf(c.w))), fmaxf(fmaxf(fabsf(d.x), fabsf(d.y)), fmaxf(fabsf(d.z), fabsf(d.w)))));
#pragma unroll
        for (int s = 1; s < 64; s <<= 1) m = fmaxf(m, __shfl_xor(m, s));
        float sc = 1.f, isc = 1.f;
        if (m > 1e-30f) {
            int k = (int)floorf(log2f(448.0f / m));
            k = k < -60 ? -60 : (k > 60 ? 60 : k);
            sc = ldexpf(1.0f, k); isc = ldexpf(1.0f, -k);
            if (m * sc > 448.0f) { sc *= 0.5f; isc *= 2.0f; }
        }
        u32x4 o;
        int w;
        w = __builtin_amdgcn_cvt_pk_fp8_f32(a.x * sc, a.y * sc, 0, false); w = __builtin_amdgcn_cvt_pk_fp8_f32(a.z * sc, a.w * sc, w, true); o.x = (unsigned)w;
        w = __builtin_amdgcn_cvt_pk_fp8_f32(b.x * sc, b.y * sc, 0, false); w = __builtin_amdgcn_cvt_pk_fp8_f32(b.z * sc, b.w * sc, w, true); o.y = (unsigned)w;
        w = __builtin_amdgcn_cvt_pk_fp8_f32(c.x * sc, c.y * sc, 0, false); w = __builtin_amdgcn_cvt_pk_fp8_f32(c.z * sc, c.w * sc, w, true); o.z = (unsigned)w;
        w = __builtin_amdgcn_cvt_pk_fp8_f32(d.x * sc, d.y * sc, 0, false); w = __builtin_amdgcn_cvt_pk_fp8_f32(d.z * sc, d.w * sc, w, true); o.w = (unsigned)w;
        *(u32x4*)(dst + (size_t)row * DM + lane * 16) = o;
        if (lane == 0) inv[row] = isc;
    }
}
DI void cvt_fp4_rows(const float* __restrict__ src, unsigned char* __restrict__ dst, float* __restrict__ inv, int bid, int nb) {
    const int lane = my_tid() & 63, wid = my_tid() >> 6;
    for (int row = bid * 8 + wid; row < NEXP; row += nb * 8) {
        const float* sp = src + (size_t)row * DM + lane * 16;
        const f32x4 a = *(const f32x4*)sp, b = *(const f32x4*)(sp + 4), c = *(const f32x4*)(sp + 8), d = *(const f32x4*)(sp + 12);
        float m = fmaxf(fmaxf(fmaxf(fabsf(a.x), fabsf(a.y)), fmaxf(fabsf(a.z), fabsf(a.w))), fmaxf(fmaxf(fabsf(b.x), fabsf(b.y)), fmaxf(fabsf(b.z), fabsf(b.w))));
        m = fmaxf(m, fmaxf(fmaxf(fmaxf(fabsf(c.x), fabsf(c.y)), fmaxf(fabsf(c.z), fabsf(c.w))), fmaxf(fmaxf(fabsf(d.x), fabsf(d.y)), fmaxf(fabsf(d.z), fabsf(d.w)))));
#pragma unroll
        for (int s = 1; s < 64; s <<= 1) m = fmaxf(m, __shfl_xor(m, s));
        const float sc = m > 1e-30f ? 6.0f / m : 1.0f, isc = m > 1e-30f ? m * (1.0f / 6.0f) : 1.0f;
        unsigned w0 = 0u, w1 = 0u;
        w0 = __builtin_amdgcn_cvt_scalef32_pk_fp4_f32(w0, a.x * sc, a.y * sc, 1.0f, 0); w0 = __builtin_amdgcn_cvt_scalef32_pk_fp4_f32(w0, a.z * sc, a.w * sc, 1.0f, 1);
        w0 = __builtin_amdgcn_cvt_scalef32_pk_fp4_f32(w0, b.x * sc, b.y * sc, 1.0f, 2); w0 = __builtin_amdgcn_cvt_scalef32_pk_fp4_f32(w0, b.z * sc, b.w * sc, 1.0f, 3);
        w1 = __builtin_amdgcn_cvt_scalef32_pk_fp4_f32(w1, c.x * sc, c.y * sc, 1.0f, 0); w1 = __builtin_amdgcn_cvt_scalef32_pk_fp4_f32(w1, c.z * sc, c.w * sc, 1.0f, 1);
        w1 = __builtin_amdgcn_cvt_scalef32_pk_fp4_f32(w1, d.x * sc, d.y * sc, 1.0f, 2); w1 = __builtin_amdgcn_cvt_scalef32_pk_fp4_f32(w1, d.z * sc, d.w * sc, 1.0f, 3);
        *(uint2*)(dst + (size_t)row * (DM / 2) + lane * 8) = make_uint2(w0, w1);
        if (lane == 0) inv[row] = isc;
    }
}
template <int OFFS>
DI void cvt_i8_rows(const float* __restrict__ src, unsigned char* __restrict__ dst, float* __restrict__ inv, int bid, int nb) {
    const int lane = my_tid() & 63, wid = my_tid() >> 6;
    for (int row = bid * 8 + wid; row < NEXP; row += nb * 8) {
        const float* sp = src + (size_t)row * DM + lane * 16;
        const f32x4 a = *(const f32x4*)sp, b = *(const f32x4*)(sp + 4), c = *(const f32x4*)(sp + 8), d = *(const f32x4*)(sp + 12);
        float m = fmaxf(fmaxf(fmaxf(fabsf(a.x), fabsf(a.y)), fmaxf(fabsf(a.z), fabsf(a.w))), fmaxf(fmaxf(fabsf(b.x), fabsf(b.y)), fmaxf(fabsf(b.z), fabsf(b.w))));
        m = fmaxf(m, fmaxf(fmaxf(fmaxf(fabsf(c.x), fabsf(c.y)), fmaxf(fabsf(c.z), fabsf(c.w))), fmaxf(fmaxf(fabsf(d.x), fabsf(d.y)), fmaxf(fabsf(d.z), fabsf(d.w)))));
#pragma unroll
        for (int s = 1; s < 64; s <<= 1) m = fmaxf(m, __shfl_xor(m, s));
        const float sc = m > 1e-30f ? 127.0f / m : 1.0f, isc = m > 1e-30f ? m * (1.0f / 127.0f) : 1.0f;
        const float v[16] = {a.x, a.y, a.z, a.w, b.x, b.y, b.z, b.w, c.x, c.y, c.z, c.w, d.x, d.y, d.z, d.w};
        unsigned w[4];
#pragma unroll
        for (int q = 0; q < 4; ++q) {
            unsigned pk = 0u;
#pragma unroll
            for (int e = 0; e < 4; ++e) { const int qi = (int)rintf(v[q * 4 + e] * sc) + OFFS; pk |= ((unsigned)qi & 0xffu) << (8 * e); }
            w[q] = pk;
        }
        *(u32x4*)(dst + (size_t)row * DM + lane * 16) = (u32x4){w[0], w[1], w[2], w[3]};
        if (lane == 0) inv[row] = isc;
    }
}
DI void prep_cab_item(const Params& p, int item, char* smem) {
    float* vT = (float*)smem;
    float* red = vT + DM * 16;
    const float* mod = (const float*)(p.ws + OFF_MOD);
    const int tid = my_tid(), ks = tid >> 5, col = tid & 31;
    const float* w = p.w_q + (size_t)(ks * 64) * 2048 + item * 32 + col;
#pragma unroll 1
    for (int which = 0; which < 2; ++which) {
        for (int i = tid; i < NB * DM; i += NTH) {
            const int b = i >> 10, k = i & 1023;
            const float sc = 1.0f + mod[b * 6144 + 4096 + k];
            const float v = which == 0 ? p.ln1w[k] * sc : p.ln1b[k] * sc + mod[b * 6144 + 3072 + k];
            vT[k * 16 + b] = v;
            if (item == 0) ((float*)(p.ws + OFF_AB))[(size_t)which * NB * DM + i] = v;
        }
        __syncthreads();
        float acc[16];
#pragma unroll
        for (int b = 0; b < 16; ++b) acc[b] = 0.f;
#pragma unroll 1
        for (int seg = 0; seg < 4; ++seg) {
            float wreg[16];
#pragma unroll
            for (int k = 0; k < 16; ++k) wreg[k] = w[(size_t)(seg * 16 + k) * 2048];
#pragma unroll
            for (int k = 0; k < 16; ++k) {
                const float wv = wreg[k];
                const f32x4* cb = (const f32x4*)(vT + (ks * 64 + seg * 16 + k) * 16);
                const f32x4 c0 = cb[0], c1 = cb[1], c2 = cb[2], c3 = cb[3];
                acc[0] += c0.x * wv; acc[1] += c0.y * wv; acc[2] += c0.z * wv; acc[3] += c0.w * wv;
                acc[4] += c1.x * wv; acc[5] += c1.y * wv; acc[6] += c1.z * wv; acc[7] += c1.w * wv;
                acc[8] += c2.x * wv; acc[9] += c2.y * wv; acc[10] += c2.z * wv; acc[11] += c2.w * wv;
                acc[12] += c3.x * wv; acc[13] += c3.y * wv; acc[14] += c3.z * wv; acc[15] += c3.w * wv;
            }
        }
#pragma unroll
        for (int b = 0; b < 16; ++b) red[(ks * 32 + col) * 16 + b] = acc[b];
        __syncthreads();
        {
            const int b = tid >> 5;
            float sum = 0.f;
#pragma unroll
            for (int q = 0; q < 16; ++q) sum += red[(q * 32 + col) * 16 + b];
            ((float*)(p.ws + OFF_CAB))[(size_t)which * NB * 2048 + b * 2048 + item * 32 + col] = sum;
        }
        __syncthreads();
    }
}
DI void phase_h(const Params& p, int bid, int nb) {
    const float* mod = (const float*)(p.ws + OFF_MOD);
    bf16_t* H = (bf16_t*)(p.ws + OFF_H);
    const size_t n8 = (size_t)NTOK * DM / 8;
    for (size_t i = (size_t)bid * NTH + my_tid(); i < n8; i += (size_t)nb * NTH) {
        const int row = (int)(i >> 7), c0 = (int)(i & 127) * 8, b = row / SEQ;
        const float* sh = mod + b * 6144 + c0;
        const float* sc = sh + 1024;
        const float4 a = *(const float4*)(p.x + i * 8), bq = *(const float4*)(p.x + i * 8 + 4);
        const float4 s0 = *(const float4*)sc, s1 = *(const float4*)(sc + 4), h0 = *(const float4*)sh, h1 = *(const float4*)(sh + 4);
        uint4 o;
        o.x = pack2(a.x * (1.f + s0.x) + h0.x, a.y * (1.f + s0.y) + h0.y);
        o.y = pack2(a.z * (1.f + s0.z) + h0.z, a.w * (1.f + s0.w) + h0.w);
        o.z = pack2(bq.x * (1.f + s1.x) + h1.x, bq.y * (1.f + s1.y) + h1.y);
        o.w = pack2(bq.z * (1.f + s1.z) + h1.z, bq.w * (1.f + s1.w) + h1.w);
        *(uint4*)(H + i * 8) = o;
    }
}

DI int wq_next(unsigned* ctr, char* smem) {
    volatile unsigned* slot = (volatile unsigned*)(smem + SMEM_BYTES - 8);
    __syncthreads();
    if (__builtin_amdgcn_workitem_id_x() == 0) *slot = __hip_atomic_fetch_add(ctr, 1u, __ATOMIC_RELAXED, __HIP_MEMORY_SCOPE_AGENT);
    __syncthreads();
    return (int)*slot;
}
DI void phase_prep_a(const Params& p, char* smem) {
    unsigned* ctr = (unsigned*)(p.ws + OFF_BAR) + 120;
    constexpr int U_S5 = 192, U_LB = 320, U_TR = 321, U_UT = U_TR + 368, U_VT = U_UT + 128, U_MISC = U_VT + 128, U_END = U_MISC + 8;
    for (int u = wq_next(ctr, smem); u < U_END; u = wq_next(ctr, smem)) {
        if (u < U_S5) prep_mod_item(p, u, smem);
        else if (u < U_LB) prep_s5_gemm_item(p, (u - U_S5) >> 2, (u - U_S5) & 3, smem);
        else if (u < U_TR) {
            const int j = my_tid();
            const float a0 = p.hg_lb[j], a1 = p.hg_lb[512 + j], m = fmaxf(a0, a1);
            const float e0 = expf(a0 - m), e1 = expf(a1 - m);
            ((float*)(p.ws + OFF_LB))[j] = e0 / (e0 + e1);
        } else if (u < U_UT) {
            for (int it = (u - U_TR) * 4; it < (u - U_TR) * 4 + 4; ++it) {
                constexpr int T_WIN = 16 * 40, T_GLU = 8 * 8, T_WOUT = 16 * 16;
                constexpr int I_GLU = T_WIN, I_WOUT = I_GLU + T_GLU, I_WQ = I_WOUT + T_WOUT;
                if (it < I_GLU) { const int t = it, n0 = (t % 40) * 64;
                    const int d0 = n0 < 512 ? (n0 >> 7) * 256 + (n0 & 127) : (n0 < 1024 ? ((n0 - 512) >> 7) * 256 + 128 + (n0 & 127) : n0);
                    prep_transpose_tile(p.w_in, (bf16_t*)(p.ws + OFF_WIN), DM, INC, t / 40, t % 40, smem, d0); }
                else if (it < I_WOUT) { const int t = it - I_GLU; prep_transpose_tile(p.glu_w, (bf16_t*)(p.ws + OFF_GLU), 512, 512, t / 8, t % 8, smem); }
                else if (it < I_WQ) { const int t = it - I_WOUT; prep_transpose_tile(p.w_out, (bf16_t*)(p.ws + OFF_WOUT), DM, DM, t / 16, t % 16, smem, -1, 512); }
                else { const int t = it - I_WQ; prep_transpose_tile(p.w_q, (bf16_t*)(p.ws + OFF_WQ), DM, 2048, t / 32, t % 32, smem); }
            }
        } else if (u < U_VT) cvt_i8_rows<0>(p.pu, (unsigned char*)(p.ws + OFF_UT), (float*)(p.ws + OFF_SU), u - U_UT, 128);
        else if (u < U_MISC) cvt_i8_rows<128>(p.pv, (unsigned char*)(p.ws + OFF_VT), (float*)(p.ws + OFF_SV), u - U_VT, 128);
        else {
            const int q = u - U_MISC;
            cvt_bf16_stream(p.subk, (bf16_t*)(p.ws + OFF_SUBK), (size_t)16 * 128 * 128 / 8, q, 8);
            for (size_t i = (size_t)q * NTH + my_tid(); i < (size_t)NTOK * 3 / 4; i += (size_t)8 * NTH) ((f32x4*)(p.ws + OFF_STAT))[i] = (f32x4){0.f, 0.f, 0.f, 0.f};
        }
    }
}
DI void phase_prep_b(const Params& p, char* smem) {
    unsigned* ctr = (unsigned*)(p.ws + OFF_BAR) + 121;
    for (int u = wq_next(ctr, smem); u < 64 + 256; u = wq_next(ctr, smem)) {
        if (u < 64) prep_cab_item(p, u, smem); else phase_h(p, u - 64, 256);
    }
}

DI void phase_proj(const Params& p, int bid, int nb, char* smem) {
    pg8::Gemm g{(const bf16_t*)(p.ws + OFF_H), (const bf16_t*)(p.ws + OFF_WIN), NTOK, INC, DM};
    pg8::StaticOrder S; S.init(NTOK, INC, nb, bid);
    pg8::EpiProj E{(bf16_t*)(p.ws + OFF_PROJ), (bf16_t*)(p.ws + OFF_HQ), (bf16_t*)(p.ws + OFF_HK), (float*)(p.ws + OFF_HG), (const float*)(p.ws + OFF_LB)};
    pg8::gemm_phase<pg8::EpiProj, pg8::StaticOrder, false>((PG8_LAS unsigned char*)smem, g, S, E, nullptr);
}

DI void hgrn_item(const Params& p, int item, char* smem) {
    const int vs = item & 7, hd = (item >> 3) & 3, b = item >> 5;
    const bf16_t* P = (const bf16_t*)(p.ws + OFF_PROJ);
    const float* lb = (const float*)(p.ws + OFF_LB) + hd * HDK;
    float* ORAW = (float*)(p.ws + OFF_ORAW);
    float* sq = (float*)smem;
    float* sf = sq + 32 * 128;
    float* sv = sf + 32 * 128;
    float* sp = sv + 32 * 16;
    const int tid = my_tid(), lane = tid & 63, wid = tid >> 6, kq = tid >> 4, v = tid & 15;
    float S0 = 0.f, S1 = 0.f, S2 = 0.f, S3 = 0.f;
    for (int t0 = 0; t0 < SEQ; t0 += 32) {
        for (int i = tid; i < 32 * 128; i += NTH) {
            const int t = i >> 7, k = i & 127;
            const bf16_t* row = P + (size_t)(b * SEQ + t0 + t) * INC + hd * HDK + k;
            sq[i] = bf2f(row[0]);
            const float l = lb[k];
            sf[i] = l + (1.0f - l) * sigmoidf_(bf2f(row[512]));
        }
        { const int t = tid >> 4; sv[tid] = bf2f(P[(size_t)(b * SEQ + t0 + t) * INC + 1024 + hd * HDK + vs * 16 + v]); }
        __syncthreads();
        for (int t = 0; t < 32; ++t) {
            const float4 f4 = *(const float4*)(sf + t * 128 + kq * 4), q4 = *(const float4*)(sq + t * 128 + kq * 4);
            const float vv = sv[t * 16 + v];
            S0 = f4.x * S0 + (1.0f - f4.x) * vv; S1 = f4.y * S1 + (1.0f - f4.y) * vv;
            S2 = f4.z * S2 + (1.0f - f4.z) * vv; S3 = f4.w * S3 + (1.0f - f4.w) * vv;
            float part = q4.x * S0 + q4.y * S1 + q4.z * S2 + q4.w * S3;
            part += __shfl_xor(part, 16); part += __shfl_xor(part, 32);
            if (lane < 16) sp[(t * 8 + wid) * 16 + v] = part;
        }
        __syncthreads();
        {
            const int t = tid >> 4;
            float o = 0.f;
#pragma unroll
            for (int w = 0; w < 8; ++w) o += sp[(t * 8 + w) * 16 + v];
            ORAW[(size_t)(b * SEQ + t0 + t) * DHG + hd * HDK + vs * 16 + v] = o;
        }
        __syncthreads();
    }
}
DI void s5_item(const Params& p, int item, char* smem) {
    const int oct = item & 3, b = item >> 2;
    const int tid = my_tid(), lane = tid & 63, wid = tid >> 6, g = oct * 8 + wid;
    const bf16_t* P = (const bf16_t*)(p.ws + OFF_PROJ);
    bf16_t* Y = (bf16_t*)(p.ws + OFF_YSSM);
    float* su = (float*)smem + wid * 64 * 16;
    const float* lam = (const float*)(p.ws + OFF_LAM) + (g * SSP + lane) * 2;
    const float lr = lam[0], li = lam[1];
    const float* bb = (const float*)(p.ws + OFF_BB) + (size_t)(g * SSP + lane) * 32;
    float bbr[16], bbi[16], cr[16], ci[16];
#pragma unroll
    for (int i = 0; i < 16; ++i) { bbr[i] = bb[2 * i]; bbi[i] = bb[2 * i + 1]; cr[i] = p.c_re[(g * SSC + i) * SSP + lane]; ci[i] = p.c_im[(g * SSC + i) * SSP + lane]; }
    const int ch = (lane >> 2) & 15;
    const float dch = p.dsk[g * SSC + ch];
    float xr = 0.f, xi = 0.f;
    for (int t0 = 0; t0 < SEQ; t0 += 64) {
        {
            const uint4* src = (const uint4*)(P + (size_t)(b * SEQ + t0 + lane) * INC + 2048 + g * SSC);
            const uint4 a = src[0], c = src[1];
            float* d = su + lane * 16;
            d[0] = bflo(a.x); d[1] = bfhi(a.x); d[2] = bflo(a.y); d[3] = bfhi(a.y); d[4] = bflo(a.z); d[5] = bfhi(a.z); d[6] = bflo(a.w); d[7] = bfhi(a.w);
            d[8] = bflo(c.x); d[9] = bfhi(c.x); d[10] = bflo(c.y); d[11] = bfhi(c.y); d[12] = bflo(c.z); d[13] = bfhi(c.z); d[14] = bflo(c.w); d[15] = bfhi(c.w);
        }
        __syncthreads();
        for (int t = 0; t < 64; ++t) {
            float u[16];
            const float4* us = (const float4*)(su + t * 16);
            const float4 u0 = us[0], u1 = us[1], u2 = us[2], u3 = us[3];
            u[0] = u0.x; u[1] = u0.y; u[2] = u0.z; u[3] = u0.w; u[4] = u1.x; u[5] = u1.y; u[6] = u1.z; u[7] = u1.w;
            u[8] = u2.x; u[9] = u2.y; u[10] = u2.z; u[11] = u2.w; u[12] = u3.x; u[13] = u3.y; u[14] = u3.z; u[15] = u3.w;
            float bur = 0.f, bui = 0.f;
#pragma unroll
            for (int i = 0; i < 16; ++i) { bur += bbr[i] * u[i]; bui += bbi[i] * u[i]; }
            const float nxr = lr * xr - li * xi + bur, nxi = lr * xi + li * xr + bui;
            xr = nxr; xi = nxi;
            float y[16];
#pragma unroll
            for (int i = 0; i < 16; ++i) y[i] = cr[i] * xr - ci[i] * xi;
            const bool b5 = lane & 32, b4 = lane & 16, b3 = lane & 8, b2 = lane & 4;
            float y8[8], y4[4], y2[2];
#pragma unroll
            for (int j = 0; j < 8; ++j) { const float keep = b5 ? y[8 + j] : y[j], send = b5 ? y[j] : y[8 + j]; y8[j] = keep + __shfl_xor(send, 32); }
#pragma unroll
            for (int j = 0; j < 4; ++j) { const float keep = b4 ? y8[4 + j] : y8[j], send = b4 ? y8[j] : y8[4 + j]; y4[j] = keep + __shfl_xor(send, 16); }
#pragma unroll
            for (int j = 0; j < 2; ++j) { const float keep = b3 ? y4[2 + j] : y4[j], send = b3 ? y4[j] : y4[2 + j]; y2[j] = keep + __shfl_xor(send, 8); }
            float y1;
            { const float keep = b2 ? y2[1] : y2[0], send = b2 ? y2[0] : y2[1]; y1 = keep + __shfl_xor(send, 4); }
            y1 += __shfl_xor(y1, 1); y1 += __shfl_xor(y1, 2);
            if ((lane & 3) == 0) {
                const float uu = su[t * 16 + ch];
                Y[(size_t)(b * SEQ + t0 + t) * DSS + g * SSC + ch] = f2bf(geluf_(y1 + dch * uu));
            }
        }
        __syncthreads();
    }
}
DI int crow(int i, int h) { return (i & 3) + 8 * (i >> 2) + 4 * h; }
DI void phase_hgprep(const Params& p, int bid, int nb) {
    const bf16_t* P = (const bf16_t*)(p.ws + OFF_PROJ);
    const float* lbp = (const float*)(p.ws + OFF_LB);
    const int tid = my_tid(), lane = tid & 63, wid = tid >> 6, tq = lane >> 4, cg = lane & 15;
#pragma unroll 1
    for (int it = bid * 8 + wid; it < 8192; it += nb * 8) {
        const int tile = it >> 1, c = tile & 63, hd = (tile >> 6) & 3, b = tile >> 8, k0 = (it & 1) * 64 + cg * 4;
        const bf16_t* base = P + (size_t)(b * SEQ + c * 32 + tq * 8) * INC + hd * HDK + k0;
        uint2 qw[8], fw[8];
#pragma unroll
        for (int tt = 0; tt < 8; ++tt) { qw[tt] = *(const uint2*)(base + (size_t)tt * INC); fw[tt] = *(const uint2*)(base + (size_t)tt * INC + 512); }
        const f32x4 l4 = *(const f32x4*)(lbp + hd * HDK + k0);
        const float lb4[4] = {l4.x, l4.y, l4.z, l4.w};
        float bl[8][4], kk[8][4], run[4];
#pragma unroll
        for (int e = 0; e < 4; ++e) run[e] = 0.f;
#pragma unroll
        for (int tt = 0; tt < 8; ++tt) {
            const float fl[4] = {bflo(fw[tt].x), bfhi(fw[tt].x), bflo(fw[tt].y), bfhi(fw[tt].y)};
#pragma unroll
            for (int e = 0; e < 4; ++e) {
                const float f = lb4[e] + (1.0f - lb4[e]) * sigmoidf_(fl[e]);
                run[e] += __logf(f); bl[tt][e] = run[e]; kk[tt][e] = 1.0f - f;
            }
        }
        float off[4], tot[4];
#pragma unroll
        for (int e = 0; e < 4; ++e) {
            const float t0 = __shfl(run[e], cg), t1 = __shfl(run[e], cg + 16), t2 = __shfl(run[e], cg + 32), t3 = __shfl(run[e], cg + 48);
            off[e] = (tq > 0 ? t0 : 0.f) + (tq > 1 ? t1 : 0.f) + (tq > 2 ? t2 : 0.f);
            tot[e] = (t0 + t1) + (t2 + t3);
        }
        bf16_t* HQ = (bf16_t*)(p.ws + OFF_HQ) + (size_t)tile * 4096 + (tq * 8) * 128 + k0;
        bf16_t* HK = (bf16_t*)(p.ws + OFF_HK) + (size_t)tile * 4096 + (tq * 8) * 128 + k0;
#pragma unroll
        for (int tt = 0; tt < 8; ++tt) {
            const float qv[4] = {bflo(qw[tt].x), bfhi(qw[tt].x), bflo(qw[tt].y), bfhi(qw[tt].y)};
            float qo[4], ko[4];
#pragma unroll
            for (int e = 0; e < 4; ++e) { const float bb = off[e] + bl[tt][e]; qo[e] = qv[e] * __expf(bb); ko[e] = kk[tt][e] * __expf(fminf(-bb, 80.0f)); }
            *(uint2*)(HQ + tt * 128) = make_uint2(pack2(qo[0], qo[1]), pack2(qo[2], qo[3]));
            *(uint2*)(HK + tt * 128) = make_uint2(pack2(ko[0], ko[1]), pack2(ko[2], ko[3]));
        }
        if (tq == 0) *(f32x4*)((float*)(p.ws + OFF_HG) + (size_t)tile * 128 + k0) = (f32x4){__expf(tot[0]), __expf(tot[1]), __expf(tot[2]), __expf(tot[3])};
    }
}
typedef short s16x4 __attribute__((ext_vector_type(4)));
DI bf16x8 cat8(const s16x4 lo, const s16x4 hi) { return (bf16x8){lo.x, lo.y, lo.z, lo.w, hi.x, hi.y, hi.z, hi.w}; }
DI s16x4 lds_tr(const char* a) { return __builtin_amdgcn_ds_read_tr16_b64_v4i16((__attribute__((address_space(3))) s16x4*)a); }
DI void hgrn_mfma_item(const Params& p, int item, char* smem) {
    constexpr int QP_OFF = 0, KP_OFF = 8704, V_OFF = 17408, G_OFF = 26112, BUF = 26624, OB_OFF = 3 * BUF, OB_STRIDE = 132, OB_BYTES = 32 * OB_STRIDE * 4;
    const int tid = my_tid(), lane = tid & 63, wid = tid >> 6, r = lane & 31, h = lane >> 5;
    const int b = item >> 2, hd = item & 3;
    const size_t tile0 = (size_t)item * 64;
    const bf16_t* HQ = (const bf16_t*)(p.ws + OFF_HQ) + tile0 * 4096;
    const bf16_t* HK = (const bf16_t*)(p.ws + OFF_HK) + tile0 * 4096;
    const bf16_t* PV = (const bf16_t*)(p.ws + OFF_PROJ) + (size_t)b * SEQ * INC + 1024 + hd * HDK;
    const float* HG = (const float*)(p.ws + OFF_HG) + tile0 * 128;
    bf16_t* A2out = (bf16_t*)(p.ws + OFF_A2) + (size_t)b * SEQ * DM + 512 + hd * HDK;
    const bf16_t* PG = (const bf16_t*)(p.ws + OFF_PROJ) + (size_t)b * SEQ * INC + 1536 + hd * HDK;
    const bool helper = wid >= 4;
    const int ht = tid - 256;
    const int i0 = ht, i1 = ht + 256;
    const int lo0 = (i0 >> 4) * 272 + (i0 & 15) * 16, lo1 = (i1 >> 4) * 272 + (i1 & 15) * 16;
    u32x4 A0, A1, A2, A3, A4, A5, A6, B0, B1, B2, B3, B4, B5, B6;
    A0 = A1 = A2 = A3 = A4 = A5 = A6 = B0 = B1 = B2 = B3 = B4 = B5 = B6 = (u32x4){0, 0, 0, 0};
    f32x16 S[4];
#pragma unroll
    for (int kb = 0; kb < 4; ++kb)
#pragma unroll
        for (int i = 0; i < 16; ++i) S[kb][i] = 0.f;
#define HG_LOAD(X, c_) { const size_t o_ = (size_t)(c_) * 4096; \
        X##0 = *(const u32x4*)(HQ + o_ + i0 * 8); X##1 = *(const u32x4*)(HQ + o_ + i1 * 8); \
        X##2 = *(const u32x4*)(HK + o_ + i0 * 8); X##3 = *(const u32x4*)(HK + o_ + i1 * 8); \
        X##4 = *(const u32x4*)(PV + (size_t)((c_) * 32 + (i0 >> 4)) * INC + (i0 & 15) * 8); X##5 = *(const u32x4*)(PV + (size_t)((c_) * 32 + (i1 >> 4)) * INC + (i1 & 15) * 8); \
        if (ht < 32) X##6 = *(const u32x4*)(HG + (size_t)(c_) * 128 + ht * 4); }
#define HG_STORE(X, buf_) { char* B_ = smem + (buf_) * BUF; \
        *(u32x4*)(B_ + QP_OFF + lo0) = X##0; *(u32x4*)(B_ + QP_OFF + lo1) = X##1; \
        *(u32x4*)(B_ + KP_OFF + lo0) = X##2; *(u32x4*)(B_ + KP_OFF + lo1) = X##3; \
        *(u32x4*)(B_ + V_OFF + lo0) = X##4; *(u32x4*)(B_ + V_OFF + lo1) = X##5; \
        if (ht < 32) *(u32x4*)(B_ + G_OFF + ht * 16) = X##6; }
    const int tq = (lane >> 2) & 3, tp = lane & 3, tg = lane >> 4;
    const int tr_nat = (8 * (tg >> 1) + tq) * 272 + (16 * (tg & 1) + 4 * tp) * 2;
    const int tr_krw = (4 * (tg >> 1) + tq) * 272 + (16 * (tg & 1) + 4 * tp) * 2;
    if (helper) { HG_LOAD(A, 0); HG_STORE(A, 0); HG_LOAD(A, 1); HG_STORE(A, 1); HG_LOAD(A, 2); HG_LOAD(B, 3); }
    __syncthreads();
#define HG_COMPUTE(c_) { \
        const char* B = smem + ((c_) % 3) * BUF; const int w = wid; \
        f32x16 pt; _Pragma("unroll") for (int i = 0; i < 16; ++i) pt[i] = 0.f; \
        _Pragma("unroll") for (int ks = 0; ks < 8; ++ks) { \
            const bf16x8 a = *(const bf16x8*)(B + KP_OFF + r * 272 + ks * 32 + h * 16); \
            const bf16x8 bq = *(const bf16x8*)(B + QP_OFF + r * 272 + ks * 32 + h * 16); \
            pt = __builtin_amdgcn_mfma_f32_32x32x16_bf16(a, bq, pt, 0, 0, 0); } \
        _Pragma("unroll") for (int i = 0; i < 16; ++i) if (crow(i, h) > r) pt[i] = 0.f; \
        f32x16 o; _Pragma("unroll") for (int i = 0; i < 16; ++i) o[i] = 0.f; \
        _Pragma("unroll") for (int sp = 0; sp < 2; ++sp) { \
            const char* vb = B + V_OFF + (16 * sp) * 272 + (32 * w) * 2 + tr_krw; \
            const bf16x8 bv = cat8(lds_tr(vb), lds_tr(vb + 8 * 272)); \
            o = __builtin_amdgcn_mfma_f32_32x32x16_bf16(pack8(pt, 8 * sp), bv, o, 0, 0, 0); } \
        _Pragma("unroll") for (int kb = 0; kb < 4; ++kb) _Pragma("unroll") for (int sp = 0; sp < 2; ++sp) { \
            const char* qb = B + QP_OFF + r * 272 + kb * 64 + sp * 32 + h * 8; \
            const bf16x8 aq = cat8(*(const s16x4*)qb, *(const s16x4*)(qb + 16)); \
            o = __builtin_amdgcn_mfma_f32_32x32x16_bf16(aq, pack8(S[kb], 8 * sp), o, 0, 0, 0); } \
        { float* ob_ = (float*)(smem + OB_OFF + ((c_) & 1) * OB_BYTES); _Pragma("unroll") for (int i = 0; i < 16; ++i) ob_[crow(i, h) * OB_STRIDE + 32 * w + r] = o[i]; } \
        bf16x8 bvn[2]; \
        _Pragma("unroll") for (int ks = 0; ks < 2; ++ks) { const char* vb = B + V_OFF + (16 * ks) * 272 + (32 * w) * 2 + tr_nat; bvn[ks] = cat8(lds_tr(vb), lds_tr(vb + 4 * 272)); } \
        _Pragma("unroll") for (int kb = 0; kb < 4; ++kb) { \
            _Pragma("unroll") for (int ks = 0; ks < 2; ++ks) { \
                const char* kp = B + KP_OFF + (16 * ks) * 272 + (32 * kb) * 2 + tr_nat; \
                const bf16x8 a = cat8(lds_tr(kp), lds_tr(kp + 4 * 272)); \
                S[kb] = __builtin_amdgcn_mfma_f32_32x32x16_bf16(a, bvn[ks], S[kb], 0, 0, 0); } \
            _Pragma("unroll") for (int j = 0; j < 4; ++j) { \
                const f32x4 g4 = *(const f32x4*)(B + G_OFF + (kb * 32 + 8 * j + 4 * h) * 4); \
                S[kb][4 * j] *= g4.x; S[kb][4 * j + 1] *= g4.y; S[kb][4 * j + 2] *= g4.z; S[kb][4 * j + 3] *= g4.w; } } }
    f32x4 nw0, nw1, nw2, nw3;
    nw0 = nw1 = nw2 = nw3 = (f32x4){0.f, 0.f, 0.f, 0.f};
    if (helper) { const float* nwp = p.hg_nw + hd * HDK + (ht & 7) * 16; nw0 = *(const f32x4*)nwp; nw1 = *(const f32x4*)(nwp + 4); nw2 = *(const f32x4*)(nwp + 8); nw3 = *(const f32x4*)(nwp + 12); }
#define HG_NORM(cc_) { const int t_ = ht >> 3, sg_ = ht & 7; \
        const float* ob_ = (const float*)(smem + OB_OFF + ((cc_) & 1) * OB_BYTES) + t_ * OB_STRIDE + sg_ * 16; \
        const f32x4 o0 = *(const f32x4*)ob_, o1 = *(const f32x4*)(ob_ + 4), o2 = *(const f32x4*)(ob_ + 8), o3 = *(const f32x4*)(ob_ + 12); \
        const u32x4 g0 = *(const u32x4*)(PG + (size_t)((cc_) * 32 + t_) * INC + sg_ * 16), g1 = *(const u32x4*)(PG + (size_t)((cc_) * 32 + t_) * INC + sg_ * 16 + 8); \
        float ss = (o0.x * o0.x + o0.y * o0.y + o0.z * o0.z + o0.w * o0.w) + (o1.x * o1.x + o1.y * o1.y + o1.z * o1.z + o1.w * o1.w) + (o2.x * o2.x + o2.y * o2.y + o2.z * o2.z + o2.w * o2.w) + (o3.x * o3.x + o3.y * o3.y + o3.z * o3.z + o3.w * o3.w); \
        ss += __shfl_xor(ss, 1); ss += __shfl_xor(ss, 2); ss += __shfl_xor(ss, 4); \
        const float rs_ = rsqrtf(ss * (1.0f / 128.0f) + RMS_EPS); \
        const f32x4 v0 = o0 * rs_ * nw0, v1 = o1 * rs_ * nw1, v2 = o2 * rs_ * nw2, v3 = o3 * rs_ * nw3; \
        u32x4 w0, w1; \
        w0.x = pack2(v0.x * bflo(g0.x), v0.y * bfhi(g0.x)); w0.y = pack2(v0.z * bflo(g0.y), v0.w * bfhi(g0.y)); w0.z = pack2(v1.x * bflo(g0.z), v1.y * bfhi(g0.z)); w0.w = pack2(v1.z * bflo(g0.w), v1.w * bfhi(g0.w)); \
        w1.x = pack2(v2.x * bflo(g1.x), v2.y * bfhi(g1.x)); w1.y = pack2(v2.z * bflo(g1.y), v2.w * bfhi(g1.y)); w1.z = pack2(v3.x * bflo(g1.z), v3.y * bfhi(g1.z)); w1.w = pack2(v3.z * bflo(g1.w), v3.w * bfhi(g1.w)); \
        bf16_t* dst_ = A2out + (size_t)((cc_) * 32 + t_) * DM + sg_ * 16; \
        *(u32x4*)dst_ = w0; *(u32x4*)(dst_ + 8) = w1; }
    for (int c = 0; c < 64; c += 2) {
        if (helper) { if (c + 2 < 64) HG_STORE(A, (c + 2) % 3); if (c + 4 < 64) HG_LOAD(A, c + 4); if (c > 0) HG_NORM(c - 1); } else HG_COMPUTE(c);
        __syncthreads();
        if (helper) { if (c + 3 < 64) HG_STORE(B, (c + 3) % 3); if (c + 5 < 64) HG_LOAD(B, c + 5); HG_NORM(c); } else HG_COMPUTE(c + 1);
        __syncthreads();
    }
    if (helper) HG_NORM(63);
    __syncthreads();
#undef HG_LOAD
#undef HG_STORE
#undef HG_COMPUTE
#undef HG_NORM
}
template <int NJ>
DI void s5_gemm2_tile(const bf16x8 (&af)[16], const bf16_t* KTl, const bf16_t* Xin, const bf16_t* MBg, bf16_t* Yout, bf16_t* stg, const int mi, const int r, const int h) {
    f32x16 y;
#pragma unroll
    for (int i = 0; i < 16; ++i) y[i] = 0.f;
    const int tsel = r >> 4, iq = r & 15;
    bf16x8 bm[8];
#pragma unroll
    for (int ks = 0; ks < 8; ++ks) bm[ks] = *(const bf16x8*)(MBg + (size_t)((NJ * 8 + ks) * 64 + h * 32 + r) * 8);
#pragma unroll
    for (int ks = 0; ks <= 2 * NJ; ++ks) {
        const bf16x8 bk = *(const bf16x8*)(KTl + ((2 * NJ + tsel - ks) * 16 + iq) * 16 + 8 * h);
        y = __builtin_amdgcn_mfma_f32_32x32x16_bf16(af[ks], bk, y, 0, 0, 0);
    }
    {
        bf16x8 bk = *(const bf16x8*)(KTl + iq * 16 + 8 * h);
        if (tsel == 0) bk = (bf16x8){0, 0, 0, 0, 0, 0, 0, 0};
        y = __builtin_amdgcn_mfma_f32_32x32x16_bf16(af[2 * NJ + 1], bk, y, 0, 0, 0);
    }
#pragma unroll
    for (int ks = 0; ks < 8; ++ks) {
        const bf16x8 a = *(const bf16x8*)(Xin + (mi * 32 + r) * 136 + ks * 16 + 8 * h);
        y = __builtin_amdgcn_mfma_f32_32x32x16_bf16(a, bm[ks], y, 0, 0, 0);
    }
#pragma unroll
    for (int i = 0; i < 16; ++i) stg[((crow(i, h) * 2 + tsel) * 16) + iq] = f2bf(gelu_as(y[i]));
    {
        const int lane = h * 32 + r, cl = lane >> 1, ts = lane & 1;
        const u32x4 lo = *(const u32x4*)(stg + lane * 16), hi = *(const u32x4*)(stg + lane * 16 + 8);
        bf16_t* dst = Yout + (size_t)((mi * 32 + cl) * 16 + 2 * NJ + ts) * DSS;
        *(u32x4*)dst = lo; *(u32x4*)(dst + 8) = hi;
    }
}
DI void s5_gemm_item(const Params& p, int b, int g, char* smem) {
    float* E = (float*)smem;
    bf16_t* Xin = (bf16_t*)(smem + 128 * 132 * 4);
    bf16_t* KTl = Xin + 128 * 136;
    const int tid = my_tid(), lane = tid & 63, wid = tid >> 6, r = lane & 31, h = lane >> 5;
    const int mi = wid >> 1, wh = wid & 1;
    const bf16_t* P = (const bf16_t*)(p.ws + OFF_PROJ);
    *(u32x4*)(KTl + tid * 8) = *(const u32x4*)((const bf16_t*)(p.ws + OFF_S5K) + (size_t)g * 4096 + tid * 8);
    bf16x8 af[16];
    {
        const bf16_t* ub = P + (size_t)(b * SEQ + (mi * 32 + r) * 16) * INC + 2048 + g * 16 + 8 * h;
#pragma unroll
        for (int ks = 0; ks < 16; ++ks) af[ks] = *(const bf16x8*)(ub + (size_t)ks * INC);
    }
#ifndef S5_REP_G1
#define S5_REP_G1 1
#define S5_REP_SC 1
#define S5_REP_G2 1
#endif
    for (int rp1 = 0; rp1 < S5_REP_G1; ++rp1)
    {
        f32x16 e0, e1;
#pragma unroll
        for (int i = 0; i < 16; ++i) { e0[i] = 0.f; e1[i] = 0.f; }
        const bf16_t* nb0 = (const bf16_t*)(p.ws + OFF_S5N) + (size_t)g * 128 * 256 + (size_t)(wh * 2) * 16 * 512 + lane * 8;
#pragma unroll
        for (int ks = 0; ks < 16; ++ks) {
            const bf16x8 b0 = *(const bf16x8*)(nb0 + ks * 512), b1 = *(const bf16x8*)(nb0 + 16 * 512 + ks * 512);
            e0 = __builtin_amdgcn_mfma_f32_32x32x16_bf16(af[ks], b0, e0, 0, 0, 0);
            e1 = __builtin_amdgcn_mfma_f32_32x32x16_bf16(af[ks], b1, e1, 0, 0, 0);
        }
#pragma unroll
        for (int i = 0; i < 16; ++i) { float* er = E + (mi * 32 + crow(i, h)) * 132 + wh * 64 + r; er[0] = e0[i]; er[32] = e1[i]; }
    }
    __syncthreads();
    for (int rp2 = 0; rp2 < S5_REP_SC; ++rp2)
    if (wid == 0) {
        const float* L = (const float*)(p.ws + OFF_S5L) + (g * 64 + lane) * 2;
        const float lr = L[0], li = L[1];
        float xr = 0.f, xi = 0.f;
#pragma unroll 8
        for (int c = 0; c < 128; ++c) {
            const float er = E[c * 132 + lane], ei = E[c * 132 + 64 + lane];
            Xin[c * 136 + lane] = f2bf(xr); Xin[c * 136 + 64 + lane] = f2bf(xi);
            const float nr = lr * xr - li * xi + er, ni = lr * xi + li * xr + ei;
            xr = nr; xi = ni;
        }
    }
    __syncthreads();
    const bf16_t* MBg = (const bf16_t*)(p.ws + OFF_S5M) + (size_t)g * 256 * 128;
    bf16_t* Yout = (bf16_t*)(p.ws + OFF_YSSM) + (size_t)b * SEQ * DSS + g * 16;
    bf16_t* stg = (bf16_t*)smem + wid * 1024;
    for (int rp3 = 0; rp3 < S5_REP_G2; ++rp3)
    if (wh) {
        s5_gemm2_tile<1>(af, KTl, Xin, MBg, Yout, stg, mi, r, h); s5_gemm2_tile<6>(af, KTl, Xin, MBg, Yout, stg, mi, r, h);
        s5_gemm2_tile<3>(af, KTl, Xin, MBg, Yout, stg, mi, r, h); s5_gemm2_tile<4>(af, KTl, Xin, MBg, Yout, stg, mi, r, h);
    } else {
        s5_gemm2_tile<0>(af, KTl, Xin, MBg, Yout, stg, mi, r, h); s5_gemm2_tile<7>(af, KTl, Xin, MBg, Yout, stg, mi, r, h);
        s5_gemm2_tile<2>(af, KTl, Xin, MBg, Yout, stg, mi, r, h); s5_gemm2_tile<5>(af, KTl, Xin, MBg, Yout, stg, mi, r, h);
    }
    __syncthreads();
}
DI void phase_mix(const Params& p, int bid, int nb, char* smem) {
    if (nb == 256) {
#ifndef PROBE_HGX
#define PROBE_HGX 1
#endif
        if (bid < 64) { for (int rep = 0; rep < PROBE_HGX; ++rep) hgrn_mfma_item(p, bid, smem); return; }
        const int j = bid - 64, x = j & 7, lb = j >> 3;
#ifndef PROBE_S5X
#define PROBE_S5X 1
#endif
        for (int rep = 0; rep < PROBE_S5X; ++rep)
        for (int q = lb; q < 64; q += 24) s5_gemm_item(p, q & 15, x * 4 + (q >> 4), smem);
    } else {
        for (int it = bid; it < 64; it += nb) hgrn_mfma_item(p, it, smem);
        for (int q = bid; q < 512; q += nb) s5_gemm_item(p, q & 15, q >> 4, smem);
    }
}

DI void phase_glu(const Params& p, int bid, int nb, char* smem) {
    pg8::Gemm g{(const bf16_t*)(p.ws + OFF_YSSM), (const bf16_t*)(p.ws + OFF_GLU), NTOK, 512, 512};
    pg8::StaticOrder S; S.init(NTOK, 512, nb, bid);
    pg8::EpiGluA2 E{(bf16_t*)(p.ws + OFF_A2), (const bf16_t*)(p.ws + OFF_YSSM), p.glu_b, p.ssm_nw, (float*)(p.ws + OFF_STAT) + 2 * NTOK};
    pg8::gemm_phase<pg8::EpiGluA2, pg8::StaticOrder, false>((PG8_LAS unsigned char*)smem, g, S, E, nullptr);
}
DI void phase_a2(const Params& p, int bid, int nb) {
    const float* Y2 = (const float*)(p.ws + OFF_H);
    const bf16_t* P = (const bf16_t*)(p.ws + OFF_PROJ);
    bf16_t* A2 = (bf16_t*)(p.ws + OFF_A2);
    const int lane = my_tid() & 63, wid = my_tid() >> 6;
    for (int tok = bid * 8 + wid; tok < NTOK; tok += nb * 8) {
        const int c0 = lane * 8;
        {
            const float4 a = *(const float4*)(Y2 + (size_t)tok * DSS + c0), b = *(const float4*)(Y2 + (size_t)tok * DSS + c0 + 4);
            float ss = a.x * a.x + a.y * a.y + a.z * a.z + a.w * a.w + b.x * b.x + b.y * b.y + b.z * b.z + b.w * b.w;
#pragma unroll
            for (int m = 1; m < 64; m <<= 1) ss += __shfl_xor(ss, m);
            const float rs = rsqrtf(ss * (1.0f / 512.0f) + RMS_EPS);
            const float4 w0 = *(const float4*)(p.ssm_nw + c0), w1 = *(const float4*)(p.ssm_nw + c0 + 4);
            uint4 o;
            o.x = pack2(a.x * rs * w0.x, a.y * rs * w0.y); o.y = pack2(a.z * rs * w0.z, a.w * rs * w0.w);
            o.z = pack2(b.x * rs * w1.x, b.y * rs * w1.y); o.w = pack2(b.z * rs * w1.z, b.w * rs * w1.w);
            *(uint4*)(A2 + (size_t)tok * DM + 512 + c0) = o;
        }
    }
}

DI void phase_outproj(const Params& p, int bid, int nb, char* smem) {
    pg8::Gemm g{(const bf16_t*)(p.ws + OFF_A2), (const bf16_t*)(p.ws + OFF_WOUT), NTOK, DM, DM};
    pg8::StaticOrder S; S.init(NTOK, DM, nb, bid);
    pg8::EpiResid E{p.out, p.x, (const float*)(p.ws + OFF_MOD) + 2048, DEEP_ALPHA, (bf16_t*)(p.ws + OFF_H), (const float*)(p.ws + OFF_AB), (float*)(p.ws + OFF_STAT), (const float*)(p.ws + OFF_STAT) + 2 * NTOK, RMS_EPS};
    pg8::gemm_phase<pg8::EpiResid, pg8::StaticOrder, false>((PG8_LAS unsigned char*)smem, g, S, E, nullptr);
}
DI void phase_ln1(const Params& p, int bid, int nb) {
    const float* mod = (const float*)(p.ws + OFF_MOD);
    bf16_t* H2 = (bf16_t*)(p.ws + OFF_H);
    const int lane = my_tid() & 63, wid = my_tid() >> 6;
    for (int tok = bid * 8 + wid; tok < NTOK; tok += nb * 8) {
        const int b = tok / SEQ;
        float* row = p.out + (size_t)tok * DM;
        float4 v[4];
        float s = 0.f;
#pragma unroll
        for (int j = 0; j < 4; ++j) { v[j] = *(const float4*)(row + j * 256 + lane * 4); s += v[j].x + v[j].y + v[j].z + v[j].w; }
#pragma unroll
        for (int m = 1; m < 64; m <<= 1) s += __shfl_xor(s, m);
        const float mu = s * (1.0f / 1024.0f);
        float q = 0.f;
#pragma unroll
        for (int j = 0; j < 4; ++j) { const float a = v[j].x - mu, bb = v[j].y - mu, cc = v[j].z - mu, d = v[j].w - mu; q += a * a + bb * bb + cc * cc + d * d; }
#pragma unroll
        for (int m = 1; m < 64; m <<= 1) q += __shfl_xor(q, m);
        const float rstd = rsqrtf(q * (1.0f / 1024.0f) + LN_EPS);
        const float* sh2 = mod + b * 6144 + 3072;
        const float* sc2 = mod + b * 6144 + 4096;
#pragma unroll
        for (int j = 0; j < 4; ++j) {
            const int c = j * 256 + lane * 4;
            const float4 w = *(const float4*)(p.ln1w + c), bi = *(const float4*)(p.ln1b + c), sc = *(const float4*)(sc2 + c), sh = *(const float4*)(sh2 + c);
            float4 o;
            o.x = (v[j].x - mu) * rstd * w.x + bi.x; o.y = (v[j].y - mu) * rstd * w.y + bi.y; o.z = (v[j].z - mu) * rstd * w.z + bi.z; o.w = (v[j].w - mu) * rstd * w.w + bi.w;
            *(float4*)(row + c) = o;
            uint2 hh; hh.x = pack2(o.x * (1.f + sc.x) + sh.x, o.y * (1.f + sc.y) + sh.y); hh.y = pack2(o.z * (1.f + sc.z) + sh.z, o.w * (1.f + sc.w) + sh.w);
            *(uint2*)(H2 + (size_t)tok * DM + c) = hh;
        }
    }
}

DI void phase_q(const Params& p, int bid, int nb, char* smem) {
    pg8::Gemm g{(const bf16_t*)(p.ws + OFF_H), (const bf16_t*)(p.ws + OFF_WQ), NTOK, 2048, DM};
    pg8::StaticOrder S; S.init(NTOK, 2048, nb, bid);
    pg8::EpiQLN E{(bf16_t*)(p.ws + OFF_PROJ), (const float*)(p.ws + OFF_STAT), (const float*)(p.ws + OFF_CAB), (const float*)(p.ws + OFF_CAB) + NB * 2048, LN_EPS};
    pg8::gemm_phase<pg8::EpiQLN, pg8::StaticOrder, false>((PG8_LAS unsigned char*)smem, g, S, E, nullptr);
}
DI void phase_topk(const Params& p, int bid, int nb, char* smem) {
    const bf16_t* Q = (const bf16_t*)(p.ws + OFF_PROJ);
    const bf16_t* SK = (const bf16_t*)(p.ws + OFF_SUBK);
    unsigned* TOPL = (unsigned*)(p.ws + OFF_TOPL);
    float* sc = (float*)(smem + 36864);
    constexpr int NTM = NTOK / 128;
    for (int t = bid; t < NTM * 16; t += nb) {
        const int mt = t >> 4, hp = t & 15;
        gemm_block<2, 1, 2, 4>(Q + (size_t)mt * 128 * 2048 + hp * 128, 2048, SK + (size_t)hp * 128 * 128, 128, 128, smem,
                               [&](int r, int c, float v) { sc[r * 129 + c] = v; });
        __syncthreads();
        if (my_tid() < 128) {
            const int r = my_tid();
            float tk[16];
#pragma unroll
            for (int j = 0; j < 16; ++j) tk[j] = -3.0e38f;
            for (int n = 0; n < 128; ++n) {
                float xv = __uint_as_float((__float_as_uint(sc[r * 129 + n]) & ~0x7fu) | (unsigned)n);
#pragma unroll
                for (int j = 0; j < 16; ++j) { const float hi = fmaxf(tk[j], xv), lo = fminf(tk[j], xv); tk[j] = hi; xv = lo; }
            }
            uint4* dst = (uint4*)(TOPL + ((size_t)(mt * 128 + r) * 16 + hp) * 16);
            dst[0] = make_uint4(__float_as_uint(tk[0]), __float_as_uint(tk[1]), __float_as_uint(tk[2]), __float_as_uint(tk[3]));
            dst[1] = make_uint4(__float_as_uint(tk[4]), __float_as_uint(tk[5]), __float_as_uint(tk[6]), __float_as_uint(tk[7]));
            dst[2] = make_uint4(__float_as_uint(tk[8]), __float_as_uint(tk[9]), __float_as_uint(tk[10]), __float_as_uint(tk[11]));
            dst[3] = make_uint4(__float_as_uint(tk[12]), __float_as_uint(tk[13]), __float_as_uint(tk[14]), __float_as_uint(tk[15]));
        }
        __syncthreads();
    }
}
DI void phase_combine(const Params& p, int bid, int nb) {
    const unsigned* TOPL = (const unsigned*)(p.ws + OFF_TOPL);
    uint2* EX = (uint2*)(p.ws + OFF_EXPS);
    const float* SU = (const float*)(p.ws + OFF_SU);
    const float* SV = (const float*)(p.ws + OFF_SV);
    for (int i = bid * NTH + my_tid(); i < NTOK * PHEADS; i += nb * NTH) {
        const unsigned* l1 = TOPL + (size_t)i * 32;
        const unsigned* l2 = l1 + 16;
        float s2[16];
        {
            const uint4 a = ((const uint4*)l2)[0], b = ((const uint4*)l2)[1], c = ((const uint4*)l2)[2], d = ((const uint4*)l2)[3];
            const unsigned w[16] = {a.x, a.y, a.z, a.w, b.x, b.y, b.z, b.w, c.x, c.y, c.z, c.w, d.x, d.y, d.z, d.w};
#pragma unroll
            for (int j = 0; j < 16; ++j) s2[j] = __uint_as_float(w[j] & ~0x7fu);
        }
        float tk[16];
#pragma unroll
        for (int j = 0; j < 16; ++j) tk[j] = -3.0e38f;
        for (int a = 0; a < 16; ++a) {
            const float s1 = __uint_as_float(l1[a] & ~0x7fu);
#pragma unroll
            for (int b = 0; b < 16; ++b) {
                float xv = __uint_as_float((__float_as_uint(s1 + s2[b]) & ~0xffu) | (unsigned)(a * 16 + b));
#pragma unroll
                for (int j = 0; j < 16; ++j) { const float hi = fmaxf(tk[j], xv), lo = fminf(tk[j], xv); tk[j] = hi; xv = lo; }
            }
        }
        float e[16], sum = 0.f;
        const float mx = __uint_as_float(__float_as_uint(tk[0]) & ~0xffu);
#pragma unroll
        for (int j = 0; j < 16; ++j) { e[j] = __expf(__uint_as_float(__float_as_uint(tk[j]) & ~0xffu) - mx); sum += e[j]; }
        const float inv = 1.0f / sum;
#pragma unroll
        for (int j = 0; j < 16; ++j) {
            const unsigned ab = __float_as_uint(tk[j]) & 0xffu;
            const unsigned i1 = l1[ab >> 4] & 0x7fu, i2 = l2[ab & 15] & 0x7fu;
            const unsigned eid = i1 * 128u + i2;
            EX[(size_t)i * 16 + j] = make_uint2(eid | (((__float_as_uint(SU[eid]) >> 23) & 0xffu) << 16), __float_as_uint(e[j] * inv * SV[eid]));
        }
    }
}

DI void ce_desc(float& a, float& b) { const float hi = fmaxf(a, b), lo = fminf(a, b); a = hi; b = lo; }
template <int N> DI void bitonic_sort_desc(float (&v)[N]) {
#pragma unroll
    for (int k = 2; k <= N; k <<= 1)
#pragma unroll
        for (int j = k >> 1; j > 0; j >>= 1)
#pragma unroll
            for (int i = 0; i < N; ++i) { const int l = i ^ j; if (l > i) { if ((i & k) == 0 || k == N) ce_desc(v[i], v[l]); else ce_desc(v[l], v[i]); } }
}
DI void merge_top16(float (&a)[16], const float (&b)[16]) {
#pragma unroll
    for (int i = 0; i < 16; ++i) a[i] = fmaxf(a[i], b[15 - i]);
#pragma unroll
    for (int j = 8; j > 0; j >>= 1)
#pragma unroll
        for (int i = 0; i < 16; ++i) { const int l = i ^ j; if (l > i) ce_desc(a[i], a[l]); }
}
DI void xlane_merge16(float (&a)[16]) {
    float o[16];
#pragma unroll
    for (int i = 0; i < 16; ++i) o[i] = __shfl_xor(a[i], 32);
    merge_top16(a, o);
}
DI void retrieve_topk_hp(const bf16_t* Q, const char* skl, const int tok, const int hp_next, const int r, const int h, unsigned char* lutp, float (&out)[16], bf16x8 (&bq)[8]) {
                f32x16 acc[4];
#pragma unroll
                for (int mi = 0; mi < 4; ++mi)
#pragma unroll
                    for (int i = 0; i < 16; ++i) acc[mi][i] = 0.f;
                const char* kb = skl + r * 272 + h * 16;
#pragma unroll
                for (int ks = 0; ks < 8; ++ks) {
#pragma unroll
                    for (int mi = 0; mi < 4; ++mi) {
                        const bf16x8 a = *(const bf16x8*)(kb + mi * 32 * 272 + ks * 32);
                        acc[mi] = __builtin_amdgcn_mfma_f32_32x32x16_bf16(a, bq[ks], acc[mi], 0, 0, 0);
                    }
                }
                {
                    const bf16_t* qb = Q + (size_t)tok * 2048 + hp_next * 128 + 8 * h;
#pragma unroll
                    for (int ks = 0; ks < 8; ++ks) bq[ks] = *(const bf16x8*)(qb + ks * 16);
                }
                float v0[16], v1[16], v2[16], v3[16];
#pragma unroll
                for (int i = 0; i < 16; ++i) {
                    const unsigned n = (unsigned)crow(i, h);
                    v0[i] = __uint_as_float((__float_as_uint(acc[0][i]) & ~0x7fu) | n);
                    v1[i] = __uint_as_float((__float_as_uint(acc[1][i]) & ~0x7fu) | (n + 32u));
                    v2[i] = __uint_as_float((__float_as_uint(acc[2][i]) & ~0x7fu) | (n + 64u));
                    v3[i] = __uint_as_float((__float_as_uint(acc[3][i]) & ~0x7fu) | (n + 96u));
                }
                bitonic_sort_desc<16>(v0); bitonic_sort_desc<16>(v1); bitonic_sort_desc<16>(v2); bitonic_sort_desc<16>(v3);
                merge_top16(v0, v1); merge_top16(v2, v3); merge_top16(v0, v2);
                xlane_merge16(v0);
#pragma unroll
                for (int i = 0; i < 16; ++i) out[i] = v0[i];
                u32x4 ix;
                ix.x = (__float_as_uint(v0[0]) & 0x7fu) | ((__float_as_uint(v0[1]) & 0x7fu) << 8) | ((__float_as_uint(v0[2]) & 0x7fu) << 16) | ((__float_as_uint(v0[3]) & 0x7fu) << 24);
                ix.y = (__float_as_uint(v0[4]) & 0x7fu) | ((__float_as_uint(v0[5]) & 0x7fu) << 8) | ((__float_as_uint(v0[6]) & 0x7fu) << 16) | ((__float_as_uint(v0[7]) & 0x7fu) << 24);
                ix.z = (__float_as_uint(v0[8]) & 0x7fu) | ((__float_as_uint(v0[9]) & 0x7fu) << 8) | ((__float_as_uint(v0[10]) & 0x7fu) << 16) | ((__float_as_uint(v0[11]) & 0x7fu) << 24);
                ix.w = (__float_as_uint(v0[12]) & 0x7fu) | ((__float_as_uint(v0[13]) & 0x7fu) << 8) | ((__float_as_uint(v0[14]) & 0x7fu) << 16) | ((__float_as_uint(v0[15]) & 0x7fu) << 24);
                *(u32x4*)lutp = ix;
}
DI void phase_retrieve(const Params& p, int bid, int nb, char* smem) {
    const bf16_t* Q = (const bf16_t*)(p.ws + OFF_PROJ);
    const bf16_t* SK = (const bf16_t*)(p.ws + OFF_SUBK);
    const float* SU = (const float*)(p.ws + OFF_SU);
    const float* SV = (const float*)(p.ws + OFF_SV);
    uint2* EX = (uint2*)(p.ws + OFF_EXPS);
    const int tid = my_tid(), lane = tid & 63, wid = tid >> 6, r = lane & 31, h = lane >> 5;
    unsigned char* lut = (unsigned char*)smem + wid * 2048 + lane * 32;
    char* skb0 = smem + 16384;
    char* skb1 = skb0 + 128 * 272;
    u32x4 sr0, sr1, sr2, sr3;
#define SK_LOAD(hp_) { const bf16_t* g_ = SK + (size_t)(hp_) * 16384 + tid * 8; sr0 = *(const u32x4*)g_; sr1 = *(const u32x4*)(g_ + 4096); sr2 = *(const u32x4*)(g_ + 8192); sr3 = *(const u32x4*)(g_ + 12288); }
#define SK_STORE(buf_) { char* d_ = (buf_) + (tid >> 4) * 272 + (tid & 15) * 16; *(u32x4*)d_ = sr0; *(u32x4*)(d_ + 32 * 272) = sr1; *(u32x4*)(d_ + 64 * 272) = sr2; *(u32x4*)(d_ + 96 * 272) = sr3; }
    for (int it = bid; it < (NTOK / 256) * 2; it += nb) {
        const int hq = it & 1, tok = (it >> 1) * 256 + wid * 32 + r;
        __syncthreads();
        SK_LOAD(hq * 8); SK_STORE(skb0);
        bf16x8 bq[8];
        {
            const bf16_t* qb = Q + (size_t)tok * 2048 + (hq * 8) * 128 + 8 * h;
#pragma unroll
            for (int ks = 0; ks < 8; ++ks) bq[ks] = *(const bf16x8*)(qb + ks * 16);
        }
        __syncthreads();
#pragma unroll 1
        for (int hd = hq * 4; hd < hq * 4 + 4; ++hd) {
            float L0[16], L1[16];
            SK_LOAD(hd * 2 + 1);
            retrieve_topk_hp(Q, skb0, tok, hd * 2 + 1, r, h, lut, L0, bq);
            SK_STORE(skb1);
            __syncthreads();
            if (hd + 1 < hq * 4 + 4) SK_LOAD(hd * 2 + 2);
            retrieve_topk_hp(Q, skb1, tok, (hd + 1 < hq * 4 + 4) ? hd * 2 + 2 : hd * 2 + 1, r, h, lut + 16, L1, bq);
            if (hd + 1 < hq * 4 + 4) SK_STORE(skb0);
            __syncthreads();
            float c[32];
            {
                constexpr int PA[50] = {0, 0, 0, 0, 0, 0, 0, 0, 0, 0, 0, 0, 0, 0, 0, 0, 1, 1, 1, 1, 1, 1, 1, 1, 2, 2, 2, 2, 2, 3, 3, 3, 3, 4, 4, 4, 5, 5, 6, 6, 7, 7, 8, 9, 10, 11, 12, 13, 14, 15};
                constexpr int PB[50] = {0, 1, 2, 3, 4, 5, 6, 7, 8, 9, 10, 11, 12, 13, 14, 15, 0, 1, 2, 3, 4, 5, 6, 7, 0, 1, 2, 3, 4, 0, 1, 2, 3, 0, 1, 2, 0, 1, 0, 1, 0, 1, 0, 0, 0, 0, 0, 0, 0, 0};
#pragma unroll
                for (int q = 0; q < 25; ++q) {
                    const float s0 = __uint_as_float(__float_as_uint(L0[PA[2 * q]]) & ~0x7fu) + __uint_as_float(__float_as_uint(L1[PB[2 * q]]) & ~0x7fu);
                    const float s1 = __uint_as_float(__float_as_uint(L0[PA[2 * q + 1]]) & ~0x7fu) + __uint_as_float(__float_as_uint(L1[PB[2 * q + 1]]) & ~0x7fu);
                    const float p0 = __uint_as_float((__float_as_uint(s0) & ~0xffu) | (unsigned)(PA[2 * q] * 16 + PB[2 * q]));
                    const float p1 = __uint_as_float((__float_as_uint(s1) & ~0xffu) | (unsigned)(PA[2 * q + 1] * 16 + PB[2 * q + 1]));
                    c[q] = h ? p1 : p0;
                }
#pragma unroll
                for (int i = 25; i < 32; ++i) c[i] = -3.0e38f;
            }
            bitonic_sort_desc<32>(c);
            float t16[16];
#pragma unroll
            for (int i = 0; i < 16; ++i) t16[i] = c[i];
            xlane_merge16(t16);
            const float mx = __uint_as_float(__float_as_uint(t16[0]) & ~0xffu);
            float e[16], sum = 0.f;
#pragma unroll
            for (int j = 0; j < 16; ++j) { e[j] = __expf(__uint_as_float(__float_as_uint(t16[j]) & ~0xffu) - mx); sum += e[j]; }
            const float inv = 1.0f / sum;
            uint2* dst = EX + ((size_t)tok * 8 + hd) * 16 + 8 * h;
#pragma unroll
            for (int j = 0; j < 8; ++j) {
                float tlo = t16[j], thi = t16[8 + j], elo = e[j], ehi = e[8 + j];
                asm volatile("" : "+v"(tlo), "+v"(thi), "+v"(elo), "+v"(ehi));
                const float tv = h ? thi : tlo, ev = h ? ehi : elo;
                const unsigned ab = __float_as_uint(tv) & 0xffu;
                const unsigned eid = (unsigned)lut[ab >> 4] * 128u + (unsigned)lut[16 + (ab & 15u)];
                dst[j] = make_uint2(eid | (pack2(0.f, SU[eid]) & 0xffff0000u), __float_as_uint(ev * inv * SV[eid]));
            }
        }
    }
#undef SK_LOAD
#undef SK_STORE
}

DI float dot16_fp8(const u32x4 w, const f32x2 (&h)[8]) {
    f32x2 acc = __builtin_amdgcn_cvt_pk_f32_fp8((int)w.x, false) * h[0];
    acc += __builtin_amdgcn_cvt_pk_f32_fp8((int)w.x, true) * h[1];
    acc += __builtin_amdgcn_cvt_pk_f32_fp8((int)w.y, false) * h[2];
    acc += __builtin_amdgcn_cvt_pk_f32_fp8((int)w.y, true) * h[3];
    acc += __builtin_amdgcn_cvt_pk_f32_fp8((int)w.z, false) * h[4];
    acc += __builtin_amdgcn_cvt_pk_f32_fp8((int)w.z, true) * h[5];
    acc += __builtin_amdgcn_cvt_pk_f32_fp8((int)w.w, false) * h[6];
    acc += __builtin_amdgcn_cvt_pk_f32_fp8((int)w.w, true) * h[7];
    return acc.x + acc.y;
}
DI void axpy16_fp8(const float a, const u32x4 w, f32x2 (&o)[8]) {
    const f32x2 aa = {a, a};
    o[0] += aa * __builtin_amdgcn_cvt_pk_f32_fp8((int)w.x, false); o[1] += aa * __builtin_amdgcn_cvt_pk_f32_fp8((int)w.x, true);
    o[2] += aa * __builtin_amdgcn_cvt_pk_f32_fp8((int)w.y, false); o[3] += aa * __builtin_amdgcn_cvt_pk_f32_fp8((int)w.y, true);
    o[4] += aa * __builtin_amdgcn_cvt_pk_f32_fp8((int)w.z, false); o[5] += aa * __builtin_amdgcn_cvt_pk_f32_fp8((int)w.z, true);
    o[6] += aa * __builtin_amdgcn_cvt_pk_f32_fp8((int)w.w, false); o[7] += aa * __builtin_amdgcn_cvt_pk_f32_fp8((int)w.w, true);
}
DI float butterfly64(float (&pz)[64], const int lane) {
    const bool b5 = lane & 32, b4 = lane & 16, b3 = lane & 8, b2 = lane & 4, b1 = lane & 2, b0 = lane & 1;
    float q32[32], q16[16], q8[8], q4[4], q2[2];
#pragma unroll
    for (int j = 0; j < 32; ++j) q32[j] = (b5 ? pz[32 + j] : pz[j]) + __shfl_xor(b5 ? pz[j] : pz[32 + j], 32);
#pragma unroll
    for (int j = 0; j < 16; ++j) q16[j] = (b4 ? q32[16 + j] : q32[j]) + __shfl_xor(b4 ? q32[j] : q32[16 + j], 16);
#pragma unroll
    for (int j = 0; j < 8; ++j) q8[j] = (b3 ? q16[8 + j] : q16[j]) + __shfl_xor(b3 ? q16[j] : q16[8 + j], 8);
#pragma unroll
    for (int j = 0; j < 4; ++j) q4[j] = (b2 ? q8[4 + j] : q8[j]) + __shfl_xor(b2 ? q8[j] : q8[4 + j], 4);
#pragma unroll
    for (int j = 0; j < 2; ++j) q2[j] = (b1 ? q4[2 + j] : q4[j]) + __shfl_xor(b1 ? q4[j] : q4[2 + j], 2);
    return (b0 ? q2[1] : q2[0]) + __shfl_xor(b0 ? q2[0] : q2[1], 1);
}
DI float bfly8(float (&pz)[8], const int lane) {
    const bool b2 = lane & 4, b1 = lane & 2, b0 = lane & 1;
    float q4[4], q2[2];
#pragma unroll
    for (int i = 0; i < 4; ++i) q4[i] = (b2 ? pz[4 + i] : pz[i]) + __shfl_xor(b2 ? pz[i] : pz[4 + i], 4);
#pragma unroll
    for (int i = 0; i < 2; ++i) q2[i] = (b1 ? q4[2 + i] : q4[i]) + __shfl_xor(b1 ? q4[i] : q4[2 + i], 2);
    float q = (b0 ? q2[1] : q2[0]) + __shfl_xor(b0 ? q2[0] : q2[1], 1);
    q += __shfl_xor(q, 8); q += __shfl_xor(q, 16); q += __shfl_xor(q, 32);
    return q;
}
DI float bfly16(float (&pz)[16], const int lane) {
    const bool b3 = lane & 8, b2 = lane & 4, b1 = lane & 2, b0 = lane & 1;
    float q8[8], q4[4], q2[2];
#pragma unroll
    for (int i = 0; i < 8; ++i) q8[i] = (b3 ? pz[8 + i] : pz[i]) + __shfl_xor(b3 ? pz[i] : pz[8 + i], 8);
#pragma unroll
    for (int i = 0; i < 4; ++i) q4[i] = (b2 ? q8[4 + i] : q8[i]) + __shfl_xor(b2 ? q8[i] : q8[4 + i], 4);
#pragma unroll
    for (int i = 0; i < 2; ++i) q2[i] = (b1 ? q4[2 + i] : q4[i]) + __shfl_xor(b1 ? q4[i] : q4[2 + i], 2);
    float q = (b0 ? q2[1] : q2[0]) + __shfl_xor(b0 ? q2[0] : q2[1], 1);
    q += __shfl_xor(q, 16); q += __shfl_xor(q, 32);
    return q;
}
DI void gs_issue(const __amdgpu_buffer_rsrc_t T, const uint2* ent, const unsigned d, const int lane, u32x4 (&w)[8], unsigned& ca) {
    const int cnt = (int)((d >> 16) & 0xfu), k = lane & 7;
    const uint2 e = ent[(d & 0xffffu) + (unsigned)(k < cnt ? k : cnt - 1)];
    ca = (k < cnt && !(d >> 31)) ? e.y : 0u;
#pragma unroll
    for (int q = 0; q < 8; ++q) {
        const int eid = __builtin_amdgcn_readlane((int)e.x, q) & 0x3fff;
        w[q] = __builtin_amdgcn_raw_buffer_load_b128(T, lane * 16, eid * DM, 0);
    }
}
DI float dot16_i8(const u32x4 w, const u32x4 h) {
    int acc = __builtin_amdgcn_sdot4((int)w.x, (int)h.x, 0, false);
    acc = __builtin_amdgcn_sdot4((int)w.y, (int)h.y, acc, false);
    acc = __builtin_amdgcn_sdot4((int)w.z, (int)h.z, acc, false);
    acc = __builtin_amdgcn_sdot4((int)w.w, (int)h.w, acc, false);
    return (float)acc;
}
DI void gs_desc(const uint2* ent, const unsigned d, const int lane, unsigned& ex) {
    const int cnt = (int)((d >> 16) & 0xfu), k = lane & 7;
    ex = ent[(d & 0xffffu) + (unsigned)(k < cnt ? k : cnt - 1)].x;
}
DI void gs_loads(const __amdgpu_buffer_rsrc_t T, const unsigned ex, const int lane, u32x4 (&w)[8]) {
#pragma unroll
    for (int q = 0; q < 8; ++q) {
        const int eid = __builtin_amdgcn_readlane((int)ex, q) & 0x3fff;
        w[q] = __builtin_amdgcn_raw_buffer_load_b128(T, lane * 16, eid * DM, 0);
    }
}
DI void gs_upartial(const u32x4 (&w)[8], const u32x4 h2q, float (&pz)[16], const int base) {
#pragma unroll
    for (int k = 0; k < 8; ++k) pz[base + k] = dot16_i8(w[k], h2q);
}
DI void gs_ustore(float (&pz)[16], float* zb, const unsigned da, const unsigned db, const int lane) {
    const float z = bfly16(pz, lane);
    const unsigned d = (lane & 8) ? db : da;
    const int k = lane & 7;
    if (lane < 16 && k < (int)((d >> 16) & 0xfu) && !(d >> 31)) zb[(d & 0xffffu) + k] = z;
}
DI void axpy16_u8(const float a, const u32x4 w, float (&o)[16]) {
    o[0] += a * (float)(w.x & 0xffu); o[1] += a * (float)((w.x >> 8) & 0xffu); o[2] += a * (float)((w.x >> 16) & 0xffu); o[3] += a * (float)(w.x >> 24);
    o[4] += a * (float)(w.y & 0xffu); o[5] += a * (float)((w.y >> 8) & 0xffu); o[6] += a * (float)((w.y >> 16) & 0xffu); o[7] += a * (float)(w.y >> 24);
    o[8] += a * (float)(w.z & 0xffu); o[9] += a * (float)((w.z >> 8) & 0xffu); o[10] += a * (float)((w.z >> 16) & 0xffu); o[11] += a * (float)(w.z >> 24);
    o[12] += a * (float)(w.w & 0xffu); o[13] += a * (float)((w.w >> 8) & 0xffu); o[14] += a * (float)((w.w >> 16) & 0xffu); o[15] += a * (float)(w.w >> 24);
}
DI void gs_vcompute(const u32x4 (&w)[8], const unsigned ca, float (&acc)[16]) {
#pragma unroll
    for (int k = 0; k < 8; ++k) { axpy16_u8(__uint_as_float((unsigned)__builtin_amdgcn_readlane((int)ca, k)), w[k], acc); __builtin_amdgcn_sched_barrier(0); }
}
constexpr int GT = 4;
constexpr int NSL = 4, SLSH = 12;
DI void xcd_pace(unsigned* cnt, const unsigned nloc, unsigned& step) {
    __syncthreads();
    if (__builtin_amdgcn_workitem_id_x() == 0) {
        __hip_atomic_fetch_add(cnt, 1u, __ATOMIC_RELAXED, __HIP_MEMORY_SCOPE_AGENT);
        const unsigned target = nloc * (step + 1u);
        unsigned sp = 0;
        while (__hip_atomic_load(cnt, __ATOMIC_RELAXED, __HIP_MEMORY_SCOPE_AGENT) < target) { __builtin_amdgcn_s_sleep(1); if (++sp > (1u << 22)) break; }
    }
    ++step;
    __syncthreads();
}
DI void phase_gather(const Params& p, int bid, int nb, char* smem, unsigned* pace_cnt, const unsigned pace_n) {
    unsigned pstep = 0;
    const float* mod = (const float*)(p.ws + OFF_MOD);
    const float* AB = (const float*)(p.ws + OFF_AB);
    const float* STAT = (const float*)(p.ws + OFF_STAT);
    const uint2* EX = (const uint2*)(p.ws + OFF_EXPS);
    const __amdgpu_buffer_rsrc_t UT = __builtin_amdgcn_make_buffer_rsrc((void*)(p.ws + OFF_UT), 0, NEXP * DM, 0x00020000);
    const __amdgpu_buffer_rsrc_t VT = __builtin_amdgcn_make_buffer_rsrc((void*)(p.ws + OFF_VT), 0, NEXP * DM, 0x00020000);
    const int lane = my_tid() & 63, wid = my_tid() >> 6, c0 = lane * 16;
    char* wl = smem + wid * 7168;
    uint2* ent = (uint2*)wl; float* zb = (float*)(wl + 4096); int* offs = (int*)(wl + 6144); unsigned* sched = (unsigned*)(wl + 6144 + 256);
#pragma unroll 1
    for (int t0 = (bid * 8 + wid) * GT; t0 < NTOK; t0 += nb * 8 * GT) {
        u32x4 h2q[GT]; float hsc[GT], mu[GT], rs[GT]; float acc[GT][16];
        f32x4 scv[4], shv[4];
        {
            const int b = t0 / SEQ;
#pragma unroll
            for (int q = 0; q < 4; ++q) { scv[q] = *(const f32x4*)(AB + (size_t)b * DM + c0 + q * 4); shv[q] = *(const f32x4*)(AB + (size_t)(NB + b) * DM + c0 + q * 4); }
        }
#pragma unroll
        for (int j = 0; j < GT; ++j) {
            const int tok = t0 + j;
            const float* row = p.out + (size_t)tok * DM + c0;
            __builtin_amdgcn_sched_barrier(0);
            { mu[j] = STAT[tok] * (1.0f / 1024.0f); rs[j] = rsqrtf(fmaxf(STAT[NTOK + tok] * (1.0f / 1024.0f) - mu[j] * mu[j], 0.f) + LN_EPS); }
            {
                f32x4 hv[4];
                float m = 0.f;
#pragma unroll
                for (int q = 0; q < 4; ++q) { hv[q] = (*(const f32x4*)(row + q * 4) - mu[j]) * rs[j] * scv[q] + shv[q]; m = fmaxf(m, fmaxf(fmaxf(fabsf(hv[q].x), fabsf(hv[q].y)), fmaxf(fabsf(hv[q].z), fabsf(hv[q].w)))); }
#pragma unroll
                for (int sft = 1; sft < 64; sft <<= 1) m = fmaxf(m, __shfl_xor(m, sft));
                const float qs = m > 1e-30f ? 127.0f / m : 1.0f;
                hsc[j] = m > 1e-30f ? m * (1.0f / 127.0f) : 1.0f;
                unsigned hw[4];
#pragma unroll
                for (int q = 0; q < 4; ++q)
                    hw[q] = ((unsigned)(int)rintf(hv[q].x * qs) & 0xffu) | (((unsigned)(int)rintf(hv[q].y * qs) & 0xffu) << 8) | (((unsigned)(int)rintf(hv[q].z * qs) & 0xffu) << 16) | (((unsigned)(int)rintf(hv[q].w * qs) & 0xffu) << 24);
                h2q[j] = (u32x4){hw[0], hw[1], hw[2], hw[3]};
            }
            const uint2 e0 = EX[(size_t)tok * 128 + lane], e1 = EX[(size_t)tok * 128 + 64 + lane];
            const int s0 = (int)((e0.x & 0x3fffu) >> SLSH), s1 = (int)((e1.x & 0x3fffu) >> SLSH);
            int run = 0, pos0 = 0, pos1 = 0;
#pragma unroll
            for (int s = 0; s < NSL; ++s) {
                const unsigned long long m0 = __ballot(s0 == s), m1 = __ballot(s1 == s);
                const int c0n = __popcll(m0), c1n = __popcll(m1);
                const int below0 = (int)__builtin_amdgcn_mbcnt_hi((unsigned)(m0 >> 32), __builtin_amdgcn_mbcnt_lo((unsigned)m0, 0u));
                const int below1 = (int)__builtin_amdgcn_mbcnt_hi((unsigned)(m1 >> 32), __builtin_amdgcn_mbcnt_lo((unsigned)m1, 0u));
                if (lane == 0) offs[j * 9 + s] = run;
                pos0 = (s0 == s) ? run + below0 : pos0;
                pos1 = (s1 == s) ? run + c0n + below1 : pos1;
                run += c0n + c1n;
            }
            if (lane == 0) offs[j * 9 + NSL] = 128;
            ent[j * 128 + pos0] = e0; ent[j * 128 + pos1] = e1;
        }
        int nbat;
        {
            const int gs = (lane / GT) % NSL, gj = lane % GT;
            const int gb = offs[gj * 9 + gs], ge = offs[gj * 9 + gs + 1], cnt = lane < NSL * GT ? ge - gb : 0, nbt = (cnt + 7) >> 3;
            int incl = nbt;
#pragma unroll
            for (int m = 1; m < 32; m <<= 1) { const int o = __shfl_up(incl, m); if ((lane & 31) >= m) incl += o; }
            nbat = __builtin_amdgcn_readlane(incl, NSL * GT - 1);
            const int st = incl - nbt;
            for (int q = 0; q < nbt; ++q) { const int rem = cnt - 8 * q; sched[st + q] = (unsigned)(gj * 128 + gb + 8 * q) | ((unsigned)(rem < 8 ? rem : 8) << 16); }
            if (lane < 3) sched[nbat + lane] = 0x80010000u;
        }
        xcd_pace(pace_cnt, pace_n, pstep);
#ifndef PROBE_UX
#define PROBE_UX 1
#endif
        for (int rep = 0; rep < PROBE_UX; ++rep)
        {
            u32x4 wa[8], wb[8];
#define GS_UP(W_, D_, B_) { const unsigned j_ = ((D_) & 0xffffu) >> 7; \
                if (j_ == 0) gs_upartial(W_, h2q[0], pz, B_); else if (j_ == 1) gs_upartial(W_, h2q[1], pz, B_); \
                else if (j_ == 2) gs_upartial(W_, h2q[2], pz, B_); else gs_upartial(W_, h2q[3], pz, B_); }
#define GS_RD(i_) ((unsigned)__builtin_amdgcn_readfirstlane((int)sched[(i_)]))
            unsigned da = GS_RD(0), db = GS_RD(1), dn = GS_RD(2), ea, eb, en;
            gs_desc(ent, da, lane, ea); gs_desc(ent, db, lane, eb); gs_desc(ent, dn, lane, en);
            gs_loads(UT, ea, lane, wa);
#pragma unroll 1
            for (int i = 0; i < nbat; i += 2) {
                float pz[16];
                gs_loads(UT, eb, lane, wb);
                __builtin_amdgcn_sched_barrier(0);
                GS_UP(wa, da, 0);
                const unsigned dcur_a = da, dcur_b = db;
                da = dn; ea = en; dn = GS_RD(i + 3); gs_desc(ent, dn, lane, en);
                gs_loads(UT, ea, lane, wa);
                __builtin_amdgcn_sched_barrier(0);
                GS_UP(wb, dcur_b, 8);
                db = dn; eb = en; dn = GS_RD(i + 4); gs_desc(ent, dn, lane, en);
                gs_ustore(pz, zb, dcur_a, dcur_b, lane);
            }
#undef GS_UP
#undef GS_RD
        }
        float asum[GT];
#pragma unroll
        for (int j = 0; j < GT; ++j) {
            float as = 0.f;
#pragma unroll
            for (int q = 0; q < 2; ++q) {
                const int pos = j * 128 + q * 64 + lane;
                const uint2 e = ent[pos];
                const float z = zb[pos] * __uint_as_float(e.x & 0xffff0000u) * hsc[j];
                const float a = gelu_as(z) * __uint_as_float(e.y);
                ent[pos].y = __float_as_uint(a);
                as += a;
            }
#pragma unroll
            for (int sft = 1; sft < 64; sft <<= 1) as += __shfl_xor(as, sft);
            asum[j] = as;
        }
#pragma unroll
        for (int j = 0; j < GT; ++j)
#pragma unroll
            for (int q = 0; q < 16; ++q) acc[j][q] = 0.f;
        {
            u32x4 wa[8]; unsigned ca;
#pragma unroll 1
            for (int i = 0; i < nbat; ++i) {
                const unsigned da = (unsigned)__builtin_amdgcn_readfirstlane((int)sched[i]);
                gs_issue(VT, ent, da, lane, wa, ca);
                __builtin_amdgcn_sched_barrier(0);
                const unsigned j_ = (da & 0xffffu) >> 7;
                if (j_ == 0) gs_vcompute(wa, ca, acc[0]); else if (j_ == 1) gs_vcompute(wa, ca, acc[1]);
                else if (j_ == 2) gs_vcompute(wa, ca, acc[2]); else gs_vcompute(wa, ca, acc[3]);
            }
        }
#pragma unroll
        for (int j = 0; j < GT; ++j) {
            asm volatile("" ::: "memory");
            __builtin_amdgcn_sched_barrier(0);
            const int tok = t0 + j, b = tok / SEQ;
            float* row = p.out + (size_t)tok * DM + c0;
            const float* g2 = mod + b * 6144 + 5120 + c0;
            f32x2 r[8];
            float sm = 0.f;
#pragma unroll
            for (int q = 0; q < 4; ++q) {
                const f32x4 xv = (*(const f32x4*)(row + q * 4) - mu[j]) * rs[j] * *(const f32x4*)(p.ln1w + c0 + q * 4) + *(const f32x4*)(p.ln1b + c0 + q * 4), gg = *(const f32x4*)(g2 + q * 4);
                const float off = 128.0f * asum[j];
                r[2 * q] = DEEP_ALPHA * (f32x2){xv.x, xv.y} + (f32x2){1.f + gg.x, 1.f + gg.y} * (f32x2){acc[j][4 * q] - off, acc[j][4 * q + 1] - off};
                r[2 * q + 1] = DEEP_ALPHA * (f32x2){xv.z, xv.w} + (f32x2){1.f + gg.z, 1.f + gg.w} * (f32x2){acc[j][4 * q + 2] - off, acc[j][4 * q + 3] - off};
                sm += r[2 * q].x + r[2 * q].y + r[2 * q + 1].x + r[2 * q + 1].y;
            }
#pragma unroll
            for (int m = 1; m < 64; m <<= 1) sm += __shfl_xor(sm, m);
            const float mu = sm * (1.0f / 1024.0f);
            float qq = 0.f;
#pragma unroll
            for (int i = 0; i < 8; ++i) { const f32x2 dd = r[i] - mu; qq += dd.x * dd.x + dd.y * dd.y; }
#pragma unroll
            for (int m = 1; m < 64; m <<= 1) qq += __shfl_xor(qq, m);
            const float rstd = rsqrtf(qq * (1.0f / 1024.0f) + LN_EPS);
#pragma unroll
            for (int q = 0; q < 4; ++q) {
                const f32x4 w4 = *(const f32x4*)(p.ln2w + c0 + q * 4), bi = *(const f32x4*)(p.ln2b + c0 + q * 4);
                f32x4 ov;
                ov.x = (r[2 * q].x - mu) * rstd * w4.x + bi.x; ov.y = (r[2 * q].y - mu) * rstd * w4.y + bi.y;
                ov.z = (r[2 * q + 1].x - mu) * rstd * w4.z + bi.z; ov.w = (r[2 * q + 1].y - mu) * rstd * w4.w + bi.w;
                *(f32x4*)(row + q * 4) = ov;
            }
        }
    }
}

#define XB_TMO      128
#define XB_XCNT(j)  (256  + 64 * (j))
#define XB_XSUB(j)  (1280 + 64 * (j))
#define XB_XGEN(j)  (2304 + 64 * (j))
#define XB_TOP      3328
#define XB_TOPGEN   3392
#define XCD_BAR_WORDS 3456
#define XB_SPIN_CAP (1u << 22)
#define LAS __attribute__((address_space(3)))
DI unsigned xb_ld(unsigned* p) { return __hip_atomic_load(p, __ATOMIC_RELAXED, __HIP_MEMORY_SCOPE_AGENT); }
DI unsigned xb_add(unsigned* p, unsigned v) { return __hip_atomic_fetch_add(p, v, __ATOMIC_RELAXED, __HIP_MEMORY_SCOPE_AGENT); }
DI unsigned xb_xcc_id() { return (unsigned)__builtin_amdgcn_s_getreg((3 << 11) | 20) & 0xFu; }
#define XB_SPIN(cond, bar) do { unsigned _sp = 0; while (cond) { __builtin_amdgcn_s_sleep(1); \
    if ((++_sp & 255u) == 0u) { if (xb_ld(&(bar)[XB_TMO])) break; if (_sp > XB_SPIN_CAP) { atomicAdd(&(bar)[XB_TMO], 1u); break; } } } } while (0)
struct XcdBarrier { unsigned* bar; unsigned x; volatile LAS unsigned* st; };
DI XcdBarrier xcd_barrier_post(unsigned* bar, volatile LAS unsigned* st) {
    XcdBarrier b; b.bar = bar; b.x = xb_xcc_id(); b.st = st;
    if (__builtin_amdgcn_workitem_id_x() == 0) (void)xb_add(&bar[XB_XCNT(b.x)], 1u);
    return b;
}
DI void xcd_barrier_complete(unsigned* bar, unsigned x, unsigned& nloc, unsigned& nx) {
    const unsigned G = gridDim.x * gridDim.y * gridDim.z;
    unsigned sum, cnt, mine, sp = 0u;
    for (;;) {
        sum = 0u; cnt = 0u; mine = 0u;
#pragma unroll
        for (unsigned j = 0; j < 16; ++j) { const unsigned c = xb_ld(&bar[XB_XCNT(j)]); sum += c; cnt += (c > 0u) ? 1u : 0u; mine = (j == x) ? c : mine; }
        if (sum == G) break;
        __builtin_amdgcn_s_sleep(1);
        if ((++sp & 255u) == 0u) { if (xb_ld(&bar[XB_TMO])) break; if (sp > XB_SPIN_CAP) { atomicAdd(&bar[XB_TMO], 1u); break; } }
    }
    nloc = mine > 0u ? mine : 1u; nx = cnt > 0u ? cnt : 1u;
}
DI void xcd_barrier(const XcdBarrier& b) {
    asm volatile("s_waitcnt vmcnt(0)" ::: "memory");
    __syncthreads();
    if (__builtin_amdgcn_workitem_id_x() == 0) {
        unsigned* bar = b.bar;
        unsigned bx = b.x; asm volatile("" : "+s"(bx));
        __builtin_amdgcn_s_waitcnt(0);
        unsigned nloc = b.st[0], nx = b.st[1];
        if (nloc == 0u) { xcd_barrier_complete(bar, bx, nloc, nx); b.st[0] = nloc; b.st[1] = nx; }
        const unsigned old = xb_add(&bar[XB_XSUB(bx)], 1u);
        const unsigned gen = old / nloc;
        if (old + 1u == (gen + 1u) * nloc) {
            __builtin_amdgcn_fence(__ATOMIC_RELEASE, "agent");
            asm volatile("s_waitcnt vmcnt(0)" ::: "memory");
            const unsigned og = xb_add(&bar[XB_TOP], 1u);
            const unsigned tg = og / nx;
            if (og + 1u == (tg + 1u) * nx) xb_add(&bar[XB_TOPGEN], 1u);
            else XB_SPIN(xb_ld(&bar[XB_TOPGEN]) == tg, bar);
            __builtin_amdgcn_fence(__ATOMIC_ACQUIRE, "agent");
            xb_add(&bar[XB_XGEN(bx)], 1u);
            asm volatile("s_waitcnt vmcnt(0)" ::: "memory");
        } else {
            XB_SPIN(xb_ld(&bar[XB_XGEN(bx)]) == gen, bar);
            __builtin_amdgcn_fence(__ATOMIC_ACQUIRE, "agent");
            asm volatile("s_waitcnt vmcnt(0)" ::: "memory");
        }
    }
    __syncthreads();
}

__global__ void __launch_bounds__(NTH) k_mega(Params p) {
    __shared__ __attribute__((aligned(16))) char smem[SMEM_BYTES];
    volatile LAS unsigned* xst = (volatile LAS unsigned*)(smem + SMEM_BYTES - 16);
    if (__builtin_amdgcn_workitem_id_x() == 0) { xst[0] = 0u; xst[1] = 0u; }
    __syncthreads();
    const XcdBarrier xb = xcd_barrier_post((unsigned*)(p.ws + OFF_BAR), xst);
    const int bid = blockIdx.x, nb = gridDim.x;
#ifndef PROBE_MASK
#define PROBE_MASK 0
#endif
#define REP(bit) for (int rep_ = 0; rep_ < ((PROBE_MASK & (bit)) ? 2 : 1); ++rep_)
    phase_prep_a(p, smem);           xcd_barrier(xb);
    phase_prep_b(p, smem);           xcd_barrier(xb);
    REP(1)  { phase_proj(p, bid, nb, smem);    xcd_barrier(xb); }
    REP(2)  { phase_mix(p, bid, nb, smem);     xcd_barrier(xb); }
    REP(4)  { phase_glu(p, bid, nb, smem);     xcd_barrier(xb); }
    REP(4)  { phase_outproj(p, bid, nb, smem); xcd_barrier(xb); }
    REP(8)  { phase_q(p, bid, nb, smem);       xcd_barrier(xb); }
    REP(16) { phase_retrieve(p, bid, nb, smem); xcd_barrier(xb); }
    phase_gather(p, bid, nb, smem, (unsigned*)(p.ws + OFF_BAR) + 16 * xb_xcc_id(), xst[0]);
}

extern "C" void kernel_launch(void* const* d_in, const int* in_sizes, int n_in, void* d_out, int out_size, void* d_ws, size_t ws_size, hipStream_t stream) {
    if (n_in != 27 || ws_size < WS_END) { fprintf(stderr, "kernel_launch: unexpected n_in %d or ws_size %zu (< %zu)\n", n_in, ws_size, (size_t)WS_END); return; }
    static int grid_blocks = 0;
    if (!grid_blocks) {
        int dev = 0, cus = 0, per_cu = 0;
        (void)hipGetDevice(&dev);
        (void)hipDeviceGetAttribute(&cus, hipDeviceAttributeMultiprocessorCount, dev);
        (void)hipOccupancyMaxActiveBlocksPerMultiprocessor(&per_cu, k_mega, NTH, 0);
        if (cus <= 0) cus = 256;
        if (per_cu < 1) { fprintf(stderr, "kernel_launch: occupancy query says %d blocks/CU\n", per_cu); per_cu = 1; }
        grid_blocks = cus;
    }
    Params p{};
    const float** f = (const float**)&p;
    for (int i = 0; i < 27; ++i) f[i] = (const float*)d_in[i];
    p.out = (float*)d_out; p.ws = (char*)d_ws;
    hipError_t e = hipMemsetAsync((char*)d_ws + OFF_BAR, 0, (size_t)3456 * 4, stream);
    if (e == hipSuccess) { hipLaunchKernelGGL(k_mega, dim3(grid_blocks), dim3(NTH), 0, stream, p); e = hipPeekAtLastError(); }
    if (e != hipSuccess) fprintf(stderr, "launch failed: %s (grid %d)\n", hipGetErrorString(e), grid_blocks);
}
```

```cpp
#include <hip/hip_runtime.h>
#include <hip/hip_cooperative_groups.h>
#include <stdint.h>
#include <stdio.h>

namespace cg = cooperative_groups;
#define DI __device__ __forceinline__
typedef unsigned short bf16_t;
typedef short bf16x8 __attribute__((ext_vector_type(8)));
typedef float f32x16 __attribute__((ext_vector_type(16)));
typedef unsigned u32x4 __attribute__((ext_vector_type(4)));
typedef float f32x4 __attribute__((ext_vector_type(4)));
typedef float f32x2 __attribute__((ext_vector_type(2)));

constexpr int NTH = 512;
constexpr int NB = 16, SEQ = 2048, DM = 1024, NTOK = NB * SEQ;
constexpr int DHG = 512, HGH = 4, HDK = 128;
constexpr int DSS = 512, SSG = 32, SSC = 16, SSP = 64;
constexpr int INC = 2560;
constexpr int PHEADS = 8, NKEYS = 128, TOPK = 16, NEXP = 16384;
constexpr float DEEP_ALPHA = 1.189207115002721f;
constexpr float LN_EPS = 1e-5f, RMS_EPS = 1e-6f;
constexpr int SMEM_BYTES = 128 * 1024 + 256;

constexpr size_t al256(size_t x) { return (x + 255) & ~(size_t)255; }
constexpr size_t OFF_MOD = 0;
constexpr size_t OFF_LB = al256(OFF_MOD + (size_t)NB * 6144 * 4);
constexpr size_t OFF_LAM = al256(OFF_LB + 512 * 4);
constexpr size_t OFF_BB = al256(OFF_LAM + 32 * 64 * 2 * 4);
constexpr size_t OFF_WIN = al256(OFF_BB + 32 * 64 * 16 * 2 * 4);
constexpr size_t OFF_GLU = al256(OFF_WIN + (size_t)INC * DM * 2);
constexpr size_t OFF_WOUT = al256(OFF_GLU + (size_t)512 * 512 * 2);
constexpr size_t OFF_WQ = al256(OFF_WOUT + (size_t)DM * DM * 2);
constexpr size_t OFF_SUBK = al256(OFF_WQ + (size_t)2048 * DM * 2);
constexpr size_t OFF_SU = al256(OFF_SUBK + (size_t)16 * 128 * 128 * 2);
constexpr size_t OFF_SV = al256(OFF_SU + (size_t)NEXP * 4);
constexpr size_t OFF_UT = al256(OFF_SV + (size_t)NEXP * 4);
constexpr size_t OFF_VT = al256(OFF_UT + (size_t)NEXP * DM * 2);
constexpr size_t OFF_H = al256(OFF_VT + (size_t)NEXP * DM * 2);
constexpr size_t OFF_PROJ = al256(OFF_H + (size_t)NTOK * DM * 2);
constexpr size_t OFF_ORAW = al256(OFF_PROJ + (size_t)NTOK * INC * 2);
constexpr size_t OFF_YSSM = al256(OFF_ORAW + (size_t)NTOK * DHG * 4);
constexpr size_t OFF_A2 = al256(OFF_YSSM + (size_t)NTOK * DSS * 2);
constexpr size_t OFF_HG = al256(OFF_A2 + (size_t)NTOK * DM * 2);
constexpr size_t OFF_S5K = al256(OFF_HG + (size_t)4096 * 128 * 4);
constexpr size_t OFF_S5N = al256(OFF_S5K + (size_t)32 * 4096 * 2);
constexpr size_t OFF_S5M = al256(OFF_S5N + (size_t)32 * 128 * 256 * 2);
constexpr size_t OFF_S5L = al256(OFF_S5M + (size_t)32 * 256 * 128 * 2);
constexpr size_t OFF_STAT = al256(OFF_S5L + (size_t)32 * 64 * 2 * 4);
constexpr size_t OFF_AB = al256(OFF_STAT + (size_t)NTOK * 3 * 4);
constexpr size_t OFF_CAB = al256(OFF_AB + (size_t)2 * NB * DM * 4);
constexpr size_t OFF_BAR = al256(OFF_CAB + (size_t)2 * NB * 2048 * 4);
constexpr size_t WS_END = al256(OFF_BAR + (size_t)3456 * 4);
constexpr size_t OFF_HQ = OFF_ORAW, OFF_HK = OFF_ORAW + (size_t)NTOK * DHG * 2;
constexpr size_t OFF_TOPL = OFF_ORAW;
constexpr size_t OFF_EXPS = OFF_YSSM;
constexpr size_t OFF_R1 = OFF_ORAW;

struct Params {
    const float *x, *c, *ada_w, *ada_b, *w_in, *hg_lb, *hg_nw, *a_re, *a_im, *log_dt, *b_re, *b_im, *c_re, *c_im, *dsk,
        *glu_w, *glu_b, *ssm_nw, *w_out, *ln1w, *ln1b, *w_q, *subk, *pu, *pv, *ln2w, *ln2b;
    float* out;
    char* ws;
};

DI int my_tid() { int t = (int)__builtin_amdgcn_workitem_id_x(); asm volatile("" : "+v"(t)); return t; }
DI bf16_t f2bf(float x) { unsigned u = __float_as_uint(x); u += 0x7fffu + ((u >> 16) & 1u); return (bf16_t)(u >> 16); }
DI float bf2f(bf16_t b) { return __uint_as_float(((unsigned)b) << 16); }
DI float bflo(unsigned w) { return __uint_as_float(w << 16); }
DI float bfhi(unsigned w) { return __uint_as_float(w & 0xffff0000u); }
typedef __bf16 hwbf16x2 __attribute__((ext_vector_type(2)));
DI unsigned pack2(float a, float b) { const f32x2 v = {a, b}; return __builtin_bit_cast(unsigned, __builtin_convertvector(v, hwbf16x2)); }
DI bf16x8 pack8(const f32x16& x, const int base) {
    u32x4 o; o.x = pack2(x[base], x[base + 1]); o.y = pack2(x[base + 2], x[base + 3]); o.z = pack2(x[base + 4], x[base + 5]); o.w = pack2(x[base + 6], x[base + 7]);
    return __builtin_bit_cast(bf16x8, o);
}
DI float sigmoidf_(float x) { return 1.0f / (1.0f + __expf(-x)); }
DI float siluf_(float x) { return x * sigmoidf_(x); }
DI float geluf_(float x) { return 0.5f * x * (1.0f + erff(x * 0.70710678118654752f)); }
DI float gelu_as(float v) {
    const float t = __builtin_amdgcn_rcpf(fabsf(v) * 0.2316418882f + 1.0f);
    float q = t * 0.5307027145f + (-0.7265760135f); q = q * t + 0.7107068705f; q = q * t + (-0.142248368f); q = q * t + 0.127414796f; q = q * t;
    const float m = v * (q * __builtin_amdgcn_exp2f(v * v * (-0.72134752044f)));
    return v < 0.f ? m : v - m;
}

template <int MT, int NT_, int WM, int WN, class Epi>
DI void gemm_block(const bf16_t* __restrict__ A, int lda, const bf16_t* __restrict__ Bt, int ldb, int K, char* smem, Epi epi) {
    constexpr int BM = WM * MT * 32, BN = WN * NT_ * 32, LS = 72;
    static_assert(WM * WN == 8, "8 waves");
    bf16_t* As = (bf16_t*)smem;
    bf16_t* Bs = As + BM * LS;
    const int tid = my_tid(), lane = tid & 63, wid = tid >> 6, r = lane & 31, h = lane >> 5;
    const int wm = wid / WN, wn = wid % WN;
    constexpr int PA = BM * 8 / NTH, PB = BN * 8 / NTH;
    u32x4 ra[PA], rb[PB];
    f32x16 acc[MT][NT_];
#pragma unroll
    for (int mi = 0; mi < MT; ++mi)
#pragma unroll
        for (int ni = 0; ni < NT_; ++ni)
#pragma unroll
            for (int i = 0; i < 16; ++i) acc[mi][ni][i] = 0.f;
#define GEMM_GLOAD(kt_) { \
    _Pragma("unroll") for (int q = 0; q < PA; ++q) { const int idx = tid + q * NTH, row = idx >> 3, ch = idx & 7; ra[q] = *(const u32x4*)(A + (size_t)row * lda + (kt_) * 64 + ch * 8); } \
    _Pragma("unroll") for (int q = 0; q < PB; ++q) { const int idx = tid + q * NTH, row = idx >> 3, ch = idx & 7; rb[q] = *(const u32x4*)(Bt + (size_t)row * ldb + (kt_) * 64 + ch * 8); } }
#define GEMM_LSTORE() { \
    _Pragma("unroll") for (int q = 0; q < PA; ++q) { const int idx = tid + q * NTH, row = idx >> 3, ch = idx & 7; *(u32x4*)(As + row * LS + ch * 8) = ra[q]; } \
    _Pragma("unroll") for (int q = 0; q < PB; ++q) { const int idx = tid + q * NTH, row = idx >> 3, ch = idx & 7; *(u32x4*)(Bs + row * LS + ch * 8) = rb[q]; } }
    GEMM_GLOAD(0); GEMM_LSTORE(); __syncthreads();
    const int nk = K / 64;
    for (int kt = 0; kt < nk; ++kt) {
        if (kt + 1 < nk) GEMM_GLOAD(kt + 1);
#pragma unroll
        for (int ks = 0; ks < 4; ++ks) {
            bf16x8 a[MT], b[NT_];
#pragma unroll
            for (int mi = 0; mi < MT; ++mi) a[mi] = *(const bf16x8*)(As + (wm * MT * 32 + mi * 32 + r) * LS + ks * 16 + h * 8);
#pragma unroll
            for (int ni = 0; ni < NT_; ++ni) b[ni] = *(const bf16x8*)(Bs + (wn * NT_ * 32 + ni * 32 + r) * LS + ks * 16 + h * 8);
#pragma unroll
            for (int mi = 0; mi < MT; ++mi)
#pragma unroll
                for (int ni = 0; ni < NT_; ++ni) acc[mi][ni] = __builtin_amdgcn_mfma_f32_32x32x16_bf16(a[mi], b[ni], acc[mi][ni], 0, 0, 0);
        }
        __syncthreads();
        if (kt + 1 < nk) { GEMM_LSTORE(); __syncthreads(); }
    }
#pragma unroll
    for (int mi = 0; mi < MT; ++mi)
#pragma unroll
        for (int ni = 0; ni < NT_; ++ni)
#pragma unroll
            for (int i = 0; i < 16; ++i) epi(wm * MT * 32 + mi * 32 + (i & 3) + 8 * (i >> 2) + 4 * h, wn * NT_ * 32 + ni * 32 + r, acc[mi][ni][i]);
}

namespace pg8 {
#define PG8_LAS __attribute__((address_space(3)))
typedef unsigned short bf16_t;
typedef short bf16x8 __attribute__((ext_vector_type(8)));
typedef float f32x4 __attribute__((ext_vector_type(4)));
typedef unsigned u32x4 __attribute__((ext_vector_type(4)));
constexpr int BM = 256, BK = 64, HALF = 128, HTB = HALF * BK * 2  , STAGE_BYTES = 8 * HTB, NXCD = 8, WGM = 8;

__host__ __device__ __forceinline__ int lds_byte(int r, int c) { const int st = (r >> 4) * 2 + (c >> 5), rr = r & 15, cc = c & 31, ob = rr * 64 + cc * 2; return st * 1024 + (ob ^ (((ob >> 9) & 1) << 5)); }
__host__ __device__ __forceinline__ void stage_rc(int b, int& R, int& C) { const int st = b / 1024, sb = b % 1024, swz = sb ^ (((sb >> 9) & 1) << 5); R = (st >> 1) * 16 + swz / 64; C = (st & 1) * 32 + (swz % 64) / 2; }
__host__ __device__ __forceinline__ int perm32(int rho) { const int n = rho >> 4, i = rho & 15; return 8 * (i >> 2) + 4 * n + (i & 3); }

struct Unit { int pm, pn; };
struct Gemm { const bf16_t* A; const bf16_t* Bt; int M, N, K; };

struct StaticOrder {
    int nM, nN, nwg, G, c;
    __host__ __device__ void init(int M, int N, int G_, int c_) { nM = M / BM; nN = N / BM; nwg = nM * nN; G = G_; c = c_; }
    __host__ __device__ bool next(int i, Unit& u) const {
        const long L = (long)i * G + c; if (L >= nwg) return false;
        int wgid = (int)L; { const int q = nwg / NXCD, r = nwg % NXCD, xcd = wgid % NXCD, off = wgid / NXCD; wgid = (xcd < r ? xcd * (q + 1) : r * (q + 1) + (xcd - r) * q) + off; }
        const int nig = WGM * nN, gid = wgid / nig, fm = gid * WGM, gsz = (nM - fm) < WGM ? (nM - fm) : WGM;
        u.pm = fm + ((wgid % nig) % gsz); u.pn = (wgid % nig) / gsz; return true;
    }
    __device__ __forceinline__ void a_ready(const Unit&) const {}
    __device__ __forceinline__ void done(const Unit&) const {}
};
template <class Epi, class Sched, bool STAMP = false>
__device__ __forceinline__ void gemm_phase(PG8_LAS unsigned char* lds, const Gemm g, const Sched& S, const Epi& E, unsigned long long* stamps) {
    int tid_ = (int)__builtin_amdgcn_workitem_id_x(); asm volatile("" : "+v"(tid_));
    const int tid = tid_, wid = __builtin_amdgcn_readfirstlane(tid >> 6), lane = tid & 63, wr = wid >> 2, wc = wid & 3, fr = lane & 15, fq = lane >> 4;
    const int K = g.K, nt = K / BK;
    int ts_lo = 0, ts_hi = 0, nts = 0; const unsigned long long rt_entry = STAMP ? (unsigned long long)wall_clock64() : 0ull;
#define PG8_STAMP() do { if (STAMP && wid == 0 && nts < 64) { const unsigned long long _c = (unsigned long long)clock64(); \
        ts_lo = (lane == nts) ? (int)(unsigned)_c : ts_lo; ts_hi = (lane == nts) ? (int)(unsigned)(_c >> 32) : ts_hi; ++nts; } } while (0)
    PG8_STAMP();
    unsigned voffA[2], voffB[2];
#pragma unroll
    for (int i = 0; i < 2; ++i) { int R, C; stage_rc(tid * 16 + i * 8192, R, C); const int Rb = Epi::PERM ? ((R & ~31) + perm32(R & 31)) : R;
        voffA[i] = (unsigned)(R * K + C) * 2u; voffB[i] = (unsigned)(Rb * K + C) * 2u; }
    const size_t kstep = (size_t)(BK * 2);
    const size_t hstep = (size_t)HALF * K * 2;
    const size_t tstep = 2 * hstep;
    const unsigned ldsw = (unsigned)wid * 1024u;
    const int aoff = lds_byte(wr * 64 + fr, fq * 8), boff = lds_byte(wc * 32 + fr, fq * 8);
#define PG8_SA(b, h) (((b) * 2 + (h)) * HTB)
#define PG8_SB(b, h) ((4 + (b) * 2 + (h)) * HTB)
#define PG8_STAGE(bufoff, gbase, voff) do { _Pragma("unroll") for (int _i = 0; _i < 2; ++_i) \
        __builtin_amdgcn_global_load_lds((const unsigned*)((const char*)(gbase) + (voff)[_i]), (PG8_LAS unsigned*)(lds + (bufoff) + ldsw + _i * 8192), 16, 0, 0); } while (0)
#define PG8_LDA(dst, b, h) do { _Pragma("unroll") for (int m = 0; m < 4; ++m) _Pragma("unroll") for (int k = 0; k < 2; ++k) dst[m][k] = *(const PG8_LAS bf16x8*)(lds + PG8_SA(b, h) + aoff + m * 2048 + k * 1024); } while (0)
#define PG8_LDB(dst, b, h) do { _Pragma("unroll") for (int n = 0; n < 2; ++n) _Pragma("unroll") for (int k = 0; k < 2; ++k) dst[n][k] = *(const PG8_LAS bf16x8*)(lds + PG8_SB(b, h) + boff + n * 2048 + k * 1024); } while (0)
#define PG8_MMA(ai, bj, At, Bt) do { __builtin_amdgcn_s_setprio(1); _Pragma("unroll") for (int m = 0; m < 4; ++m) _Pragma("unroll") for (int n = 0; n < 2; ++n) _Pragma("unroll") for (int k = 0; k < 2; ++k) \
        acc[ai][bj][m][n] = __builtin_amdgcn_mfma_f32_16x16x32_bf16(Bt[n][k], At[m][k], acc[ai][bj][m][n], 0, 0, 0); __builtin_amdgcn_s_setprio(0); } while (0)
#define PG8_WAIT_V(n) asm volatile("s_waitcnt vmcnt(" #n ")" ::: "memory")
#define PG8_WAIT_L(n) asm volatile("s_waitcnt lgkmcnt(" #n ")" ::: "memory")
#define PG8_BAR __builtin_amdgcn_s_barrier()
#define PG8_SCHED __builtin_amdgcn_sched_barrier(0)
    Unit cur, nxt; int ui = 0;
    if (!S.next(0, cur)) return;
    f32x4 acc[2][2][4][2];
#pragma unroll
    for (int a = 0; a < 2; ++a)
#pragma unroll
        for (int b = 0; b < 2; ++b)
#pragma unroll
            for (int m = 0; m < 4; ++m)
#pragma unroll
                for (int n = 0; n < 2; ++n) acc[a][b][m][n] = (f32x4){0.f, 0.f, 0.f, 0.f};
    bf16x8 At[4][2], B0[2][2], B1[2][2];
    const char* cA = (const char*)g.A + (size_t)cur.pm * tstep; const char* cB = (const char*)g.Bt + (size_t)cur.pn * tstep;
    S.a_ready(cur);
    PG8_STAGE(PG8_SB(0, 0), cB, voffB); PG8_STAGE(PG8_SA(0, 0), cA, voffA); PG8_STAGE(PG8_SB(0, 1), cB + hstep, voffB); PG8_STAGE(PG8_SA(0, 1), cA + hstep, voffA);
    if (wr == 1) PG8_BAR;
    PG8_WAIT_V(4); PG8_BAR;
    PG8_STAGE(PG8_SB(1, 0), cB + kstep, voffB); PG8_STAGE(PG8_SA(1, 0), cA + kstep, voffA); PG8_STAGE(PG8_SB(1, 1), cB + hstep + kstep, voffB);
    PG8_WAIT_V(6); PG8_BAR;
    PG8_STAMP();
    for (;;) {
        const bool has_next = S.next(ui + 1, nxt);
        const char* nA = has_next ? (const char*)g.A + (size_t)nxt.pm * tstep : cA; const char* nB = has_next ? (const char*)g.Bt + (size_t)nxt.pn * tstep : cB;
        for (int t = 0; t < nt; t += 2) {
            const bool last = (t == nt - 2);
            const char* a1 = cA + (size_t)(t + 1) * kstep;
            const char* a2 = last ? nA : cA + (size_t)(t + 2) * kstep; const char* b2 = last ? nB : cB + (size_t)(t + 2) * kstep;
            const char* a3 = a2 + kstep; const char* b3 = b2 + kstep;
            if (last && has_next) S.a_ready(nxt);
            if constexpr (Epi::MIDSCALE) { if (t == nt / 2) E.midscale(acc, cur, wr, fr); }
            PG8_LDB(B0, 0, 0); PG8_SCHED; PG8_LDA(At, 0, 0); PG8_STAGE(PG8_SA(1, 1), a1 + hstep, voffA);
            PG8_WAIT_L(8); PG8_BAR; PG8_WAIT_L(0); PG8_MMA(0, 0, At, B0); PG8_BAR; PG8_SCHED;
            PG8_LDB(B1, 0, 1); PG8_STAGE(PG8_SB(0, 0), b2, voffB);
            PG8_BAR; PG8_WAIT_L(0); PG8_MMA(0, 1, At, B1); PG8_BAR;
            PG8_LDA(At, 0, 1); PG8_STAGE(PG8_SA(0, 0), a2, voffA);
            PG8_BAR; PG8_WAIT_L(0); PG8_MMA(1, 0, At, B0); PG8_BAR; PG8_SCHED;
            PG8_STAGE(PG8_SB(0, 1), b2 + hstep, voffB);
            PG8_WAIT_V(6); PG8_BAR; PG8_MMA(1, 1, At, B1); PG8_BAR;
            PG8_LDB(B0, 1, 0); PG8_SCHED; PG8_LDA(At, 1, 0); PG8_STAGE(PG8_SA(0, 1), a2 + hstep, voffA);
            PG8_WAIT_L(8); PG8_BAR; PG8_WAIT_L(0); PG8_MMA(0, 0, At, B0); PG8_BAR; PG8_SCHED;
            PG8_LDB(B1, 1, 1); PG8_STAGE(PG8_SB(1, 0), b3, voffB);
            PG8_BAR; PG8_WAIT_L(0); PG8_MMA(0, 1, At, B1); PG8_BAR;
            PG8_LDA(At, 1, 1); PG8_STAGE(PG8_SA(1, 0), a3, voffA);
            PG8_BAR; PG8_WAIT_L(0); PG8_MMA(1, 0, At, B0); PG8_BAR; PG8_SCHED;
            PG8_STAGE(PG8_SB(1, 1), b3 + hstep, voffB);
            PG8_WAIT_V(6); PG8_BAR; PG8_MMA(1, 1, At, B1); PG8_BAR;
        }
        PG8_STAMP();
        if constexpr (!Epi::AFTER_DRAIN) { E(acc, cur, wr, wc, fr, fq); S.done(cur); }
        PG8_STAMP();
        if (!has_next) break;
#pragma unroll
        for (int a = 0; a < 2; ++a)
#pragma unroll
            for (int b = 0; b < 2; ++b)
#pragma unroll
                for (int m = 0; m < 4; ++m)
#pragma unroll
                    for (int n = 0; n < 2; ++n) acc[a][b][m][n] = (f32x4){0.f, 0.f, 0.f, 0.f};
        cur = nxt; cA = nA; cB = nB; ++ui;
    }
    PG8_WAIT_V(0);
    if (wr == 0) PG8_BAR;
    PG8_BAR;
    if constexpr (Epi::AFTER_DRAIN) { E.fused(acc, cur, wr, wc, fr, fq, lds, wid, lane); S.done(cur); }
    PG8_STAMP();
    if (STAMP && wid == 0) { stamps[lane] = lane < nts ? (((unsigned long long)(unsigned)ts_hi << 32) | (unsigned)ts_lo) : 0ull;
        if (lane == 62) stamps[62] = rt_entry; if (lane == 63) stamps[63] = (unsigned long long)wall_clock64(); }
#undef PG8_STAMP
#undef PG8_SA
#undef PG8_SB
#undef PG8_STAGE
#undef PG8_LDA
#undef PG8_LDB
#undef PG8_MMA
#undef PG8_WAIT_V
#undef PG8_WAIT_L
#undef PG8_BAR
#undef PG8_SCHED
}

__device__ __forceinline__ unsigned pk_bf16(float lo, float hi) { typedef float v2f __attribute__((ext_vector_type(2))); typedef __bf16 v2b __attribute__((ext_vector_type(2))); const v2f v = {lo, hi}; return __builtin_bit_cast(unsigned, __builtin_convertvector(v, v2b)); }
__device__ __forceinline__ float silu1(float x) { return x * __builtin_amdgcn_rcpf(1.0f + __expf(-x)); }
struct EpiBf16Act {
    static constexpr bool PERM = true, AFTER_DRAIN = false, MIDSCALE = false;
    bf16_t* O; int ldc; unsigned silu_mask;
    __device__ __forceinline__ void operator()(const f32x4 (&acc)[2][2][4][2], const Unit& u, int wr, int wc, int fr, int fq) const {
        const int row0 = u.pm * BM + wr * 64 + fr, col0 = u.pn * BM + wc * 32 + 8 * fq;
        const bool act = (silu_mask >> u.pn) & 1u;
#pragma unroll
        for (int ai = 0; ai < 2; ++ai)
#pragma unroll
            for (int m = 0; m < 4; ++m) { bf16_t* rowp = O + (size_t)(row0 + ai * HALF + m * 16) * ldc + col0;
#pragma unroll
                for (int bj = 0; bj < 2; ++bj) { f32x4 v0 = acc[ai][bj][m][0], v1 = acc[ai][bj][m][1];
                    if (act) {
#pragma unroll
                        for (int j = 0; j < 4; ++j) { v0[j] = silu1(v0[j]); v1[j] = silu1(v1[j]); } }
                    u32x4 w; w.x = pk_bf16(v0[0], v0[1]); w.y = pk_bf16(v0[2], v0[3]); w.z = pk_bf16(v1[0], v1[1]); w.w = pk_bf16(v1[2], v1[3]);
                    *(u32x4*)(rowp + bj * HALF) = w; } }
    }
};
struct EpiProj {
    static constexpr bool PERM = true, AFTER_DRAIN = false, MIDSCALE = false;
    bf16_t* O; bf16_t* HQ; bf16_t* HK; float* HG; const float* LB;
    __device__ __forceinline__ void operator()(const f32x4 (&acc)[2][2][4][2], const Unit& u, int wr, int wc, int fr, int fq) const {
        if (u.pn >= 4) {
            const int row0 = u.pm * BM + wr * 64 + fr, col0 = u.pn * BM + wc * 32 + 8 * fq;
            const bool act = (u.pn == 6) || (u.pn == 7);
#pragma unroll
            for (int ai = 0; ai < 2; ++ai)
#pragma unroll
                for (int m = 0; m < 4; ++m) { bf16_t* rowp = O + (size_t)(row0 + ai * HALF + m * 16) * 2560 + col0;
#pragma unroll
                    for (int bj = 0; bj < 2; ++bj) { f32x4 v0 = acc[ai][bj][m][0], v1 = acc[ai][bj][m][1];
                        if (act) {
#pragma unroll
                            for (int j = 0; j < 4; ++j) { v0[j] = silu1(v0[j]); v1[j] = silu1(v1[j]); } }
                        u32x4 w; w.x = pk_bf16(v0[0], v0[1]); w.y = pk_bf16(v0[2], v0[3]); w.z = pk_bf16(v1[0], v1[1]); w.w = pk_bf16(v1[2], v1[3]);
                        *(u32x4*)(rowp + bj * HALF) = w; } }
            return;
        }
        const int hd = u.pn, bat = (u.pm * BM) / 2048, cb = (u.pm & 7) * 8, k0 = wc * 32 + 8 * fq, lane = fq * 16 + fr;
        float lb[8];
        { const f32x4 l0 = *(const f32x4*)(LB + hd * 128 + k0), l1 = *(const f32x4*)(LB + hd * 128 + k0 + 4);
          lb[0] = l0[0]; lb[1] = l0[1]; lb[2] = l0[2]; lb[3] = l0[3]; lb[4] = l1[0]; lb[5] = l1[1]; lb[6] = l1[2]; lb[7] = l1[3]; }
#pragma unroll
        for (int ac = 0; ac < 4; ++ac) {
            const int ai = ac >> 1, cp = ac & 1;
            __builtin_amdgcn_sched_barrier(0);
            const size_t tile = ((size_t)(bat * 4 + hd) * 64 + cb + 4 * ai + 2 * wr + cp);
#pragma unroll
            for (int eh = 0; eh < 2; ++eh) {
                __builtin_amdgcn_sched_barrier(0);
                float tot0[4];
                bf16_t* hq = HQ + tile * 4096 + k0 + 4 * eh;
                bf16_t* hk = HK + tile * 4096 + k0 + 4 * eh;
#pragma unroll
                for (int mm = 0; mm < 2; ++mm) {
                    const f32x4 q4 = acc[ai][0][2 * cp + mm][eh], f4 = acc[ai][1][2 * cp + mm][eh];
                    float qo[4], ko[4], bl[4];
#pragma unroll
                    for (int e = 0; e < 4; ++e) {
                        const float lbe = lb[4 * eh + e];
                        const float f = lbe + (1.0f - lbe) * __builtin_amdgcn_rcpf(1.0f + __expf(-f4[e]));
                        float sc = __logf(f);
                        sc += __builtin_bit_cast(float, __builtin_amdgcn_update_dpp(0, __builtin_bit_cast(int, sc), 0x111, 0xf, 0xf, true));
                        sc += __builtin_bit_cast(float, __builtin_amdgcn_update_dpp(0, __builtin_bit_cast(int, sc), 0x112, 0xf, 0xf, true));
                        sc += __builtin_bit_cast(float, __builtin_amdgcn_update_dpp(0, __builtin_bit_cast(int, sc), 0x114, 0xf, 0xf, true));
                        sc += __builtin_bit_cast(float, __builtin_amdgcn_update_dpp(0, __builtin_bit_cast(int, sc), 0x118, 0xf, 0xf, true));
                        if (mm == 1) sc += tot0[e];
                        bl[e] = sc;
                        qo[e] = silu1(q4[e]) * __expf(sc); ko[e] = (1.0f - f) * __expf(fminf(-sc, 80.0f));
                    }
                    *(uint2*)(hq + (size_t)(mm * 16 + fr) * 128) = make_uint2(pk_bf16(qo[0], qo[1]), pk_bf16(qo[2], qo[3]));
                    *(uint2*)(hk + (size_t)(mm * 16 + fr) * 128) = make_uint2(pk_bf16(ko[0], ko[1]), pk_bf16(ko[2], ko[3]));
                    if (mm == 0) {
#pragma unroll
                        for (int e = 0; e < 4; ++e) tot0[e] = __shfl(bl[e], (lane & 48) | 15);
                    } else if (fr == 15) *(f32x4*)(HG + tile * 128 + k0 + 4 * eh) = (f32x4){__expf(bl[0]), __expf(bl[1]), __expf(bl[2]), __expf(bl[3])};
                    __builtin_amdgcn_sched_barrier(0);
                }
            }
        }
    }
};
struct EpiResid {
    static constexpr bool PERM = true, AFTER_DRAIN = false, MIDSCALE = true;
    bf16_t* R1; const float* X; const float* mod_g;
    static constexpr int NTOK_ = 32768;
    float alpha; bf16_t* AP; const float* avec; float* stat;
    const float* ssq; float rms_eps;
    __device__ __forceinline__ void midscale(f32x4 (&acc)[2][2][4][2], const Unit& u, int wr, int fr) const {
        const float* sp = ssq + u.pm * BM + wr * 64 + fr;
#pragma unroll
        for (int ai = 0; ai < 2; ++ai)
#pragma unroll
            for (int m = 0; m < 4; ++m) {
                const float rs = rsqrtf(sp[ai * HALF + m * 16] * (1.0f / 512.0f) + rms_eps);
#pragma unroll
                for (int bj = 0; bj < 2; ++bj)
#pragma unroll
                    for (int n = 0; n < 2; ++n) acc[ai][bj][m][n] *= rs;
            }
    }
    __device__ __forceinline__ void operator()(const f32x4 (&acc)[2][2][4][2], const Unit& u, int wr, int wc, int fr, int fq) const {
        const int row0 = u.pm * BM + wr * 64 + fr, col0 = u.pn * BM + wc * 32 + 8 * fq, bat = (u.pm * BM) / 2048;
        const float* gb = mod_g + (size_t)bat * 6144 + col0;
        const float* ab = avec + (size_t)bat * 1024 + col0;
        float s1[2][4], s2[2][4];
#pragma unroll
        for (int ai = 0; ai < 2; ++ai)
#pragma unroll
            for (int m = 0; m < 4; ++m) { s1[ai][m] = 0.f; s2[ai][m] = 0.f; }
#pragma unroll
        for (int bj = 0; bj < 2; ++bj) {
            const f32x4 g0 = *(const f32x4*)(gb + bj * HALF) + 1.0f, g1 = *(const f32x4*)(gb + bj * HALF + 4) + 1.0f;
            const f32x4 a0 = *(const f32x4*)(ab + bj * HALF), a1 = *(const f32x4*)(ab + bj * HALF + 4);
#pragma unroll
            for (int ai = 0; ai < 2; ++ai)
#pragma unroll
                for (int m = 0; m < 4; ++m) { const size_t ro = (size_t)(row0 + ai * HALF + m * 16) * 1024 + col0 + bj * HALF;
                    const f32x4 x0 = *(const f32x4*)(X + ro), x1 = *(const f32x4*)(X + ro + 4);
                    const f32x4 r0 = alpha * x0 + g0 * acc[ai][bj][m][0], r1 = alpha * x1 + g1 * acc[ai][bj][m][1];
                    u32x4 w; w.x = pk_bf16(r0[0], r0[1]); w.y = pk_bf16(r0[2], r0[3]); w.z = pk_bf16(r1[0], r1[1]); w.w = pk_bf16(r1[2], r1[3]);
                    *(u32x4*)(R1 + ro) = w;
                    const f32x4 p0 = r0 * a0, p1 = r1 * a1;
                    w.x = pk_bf16(p0[0], p0[1]); w.y = pk_bf16(p0[2], p0[3]); w.z = pk_bf16(p1[0], p1[1]); w.w = pk_bf16(p1[2], p1[3]);
                    *(u32x4*)(AP + ro) = w;
                    s1[ai][m] += ((r0[0] + r0[1]) + (r0[2] + r0[3])) + ((r1[0] + r1[1]) + (r1[2] + r1[3]));
                    s2[ai][m] += ((r0[0] * r0[0] + r0[1] * r0[1]) + (r0[2] * r0[2] + r0[3] * r0[3])) + ((r1[0] * r1[0] + r1[1] * r1[1]) + (r1[2] * r1[2] + r1[3] * r1[3]));
                }
        }
        const bool hi5 = fq & 2, hi4 = fq & 1;
#pragma unroll
        for (int ai = 0; ai < 2; ++ai) {
            const float a1 = (hi5 ? s1[ai][2] : s1[ai][0]) + __shfl_xor(hi5 ? s1[ai][0] : s1[ai][2], 32), b1 = (hi5 ? s1[ai][3] : s1[ai][1]) + __shfl_xor(hi5 ? s1[ai][1] : s1[ai][3], 32);
            const float a2 = (hi5 ? s2[ai][2] : s2[ai][0]) + __shfl_xor(hi5 ? s2[ai][0] : s2[ai][2], 32), b2 = (hi5 ? s2[ai][3] : s2[ai][1]) + __shfl_xor(hi5 ? s2[ai][1] : s2[ai][3], 32);
            const float t1 = (hi4 ? b1 : a1) + __shfl_xor(hi4 ? a1 : b1, 16), t2 = (hi4 ? b2 : a2) + __shfl_xor(hi4 ? a2 : b2, 16);
            const int srow = u.pm * BM + wr * 64 + ai * HALF + fq * 16 + fr;
            atomicAdd(stat + srow, t1); atomicAdd(stat + NTOK_ + srow, t2);
        }
    }
};
struct EpiQLN {
    static constexpr bool PERM = true, AFTER_DRAIN = false, MIDSCALE = false;
    bf16_t* O; const float* stat; const float* ca; const float* cb; float eps;
    __device__ __forceinline__ void operator()(const f32x4 (&acc)[2][2][4][2], const Unit& u, int wr, int wc, int fr, int fq) const {
        const int row0 = u.pm * BM + wr * 64 + fr, col0 = u.pn * BM + wc * 32 + 8 * fq, bat = (u.pm * BM) / 2048;
        const float* cap = ca + (size_t)bat * 2048 + col0;
        const float* cbp = cb + (size_t)bat * 2048 + col0;
#pragma unroll
        for (int bj = 0; bj < 2; ++bj) {
            const f32x4 a0 = *(const f32x4*)(cap + bj * HALF), a1 = *(const f32x4*)(cap + bj * HALF + 4), b0 = *(const f32x4*)(cbp + bj * HALF), b1 = *(const f32x4*)(cbp + bj * HALF + 4);
#pragma unroll
            for (int ai = 0; ai < 2; ++ai)
#pragma unroll
                for (int m = 0; m < 4; ++m) {
                    const int row = row0 + ai * HALF + m * 16;
                    const float mu = stat[row] * (1.0f / 1024.0f), rstd = rsqrtf(fmaxf(stat[32768 + row] * (1.0f / 1024.0f) - mu * mu, 0.f) + eps);
                    const f32x4 v0 = rstd * (acc[ai][bj][m][0] - mu * a0) + b0, v1 = rstd * (acc[ai][bj][m][1] - mu * a1) + b1;
                    u32x4 w; w.x = pk_bf16(v0[0], v0[1]); w.y = pk_bf16(v0[2], v0[3]); w.z = pk_bf16(v1[0], v1[1]); w.w = pk_bf16(v1[2], v1[3]);
                    *(u32x4*)(O + (size_t)row * 2048 + col0 + bj * HALF) = w;
                }
        }
    }
};
struct EpiGluA2 {
    static constexpr bool PERM = true, AFTER_DRAIN = false, MIDSCALE = false;
    bf16_t* A2; const bf16_t* Y; const float* bias; const float* nw; float* ssq;
    __device__ __forceinline__ void operator()(const f32x4 (&acc)[2][2][4][2], const Unit& u, int wr, int wc, int fr, int fq) const {
        const int row0 = u.pm * BM + wr * 64 + fr, col0 = u.pn * BM + wc * 32 + 8 * fq;
        float s2[2][4];
#pragma unroll
        for (int ai = 0; ai < 2; ++ai)
#pragma unroll
            for (int m = 0; m < 4; ++m) s2[ai][m] = 0.f;
#pragma unroll
        for (int bj = 0; bj < 2; ++bj) {
            const f32x4 bv0 = *(const f32x4*)(bias + col0 + bj * HALF), bv1 = *(const f32x4*)(bias + col0 + bj * HALF + 4);
            const f32x4 wv0 = *(const f32x4*)(nw + col0 + bj * HALF), wv1 = *(const f32x4*)(nw + col0 + bj * HALF + 4);
#pragma unroll
            for (int ai = 0; ai < 2; ++ai)
#pragma unroll
                for (int m = 0; m < 4; ++m) { const int row = row0 + ai * HALF + m * 16;
                    const u32x4 yw = *(const u32x4*)(Y + (size_t)row * 512 + col0 + bj * HALF);
                    const f32x4 z0 = acc[ai][bj][m][0] + bv0, z1 = acc[ai][bj][m][1] + bv1;
                    f32x4 o0, o1;
                    o0[0] = __uint_as_float(yw.x << 16) * __builtin_amdgcn_rcpf(1.0f + __expf(-z0[0])); o0[1] = __uint_as_float(yw.x & 0xffff0000u) * __builtin_amdgcn_rcpf(1.0f + __expf(-z0[1]));
                    o0[2] = __uint_as_float(yw.y << 16) * __builtin_amdgcn_rcpf(1.0f + __expf(-z0[2])); o0[3] = __uint_as_float(yw.y & 0xffff0000u) * __builtin_amdgcn_rcpf(1.0f + __expf(-z0[3]));
                    o1[0] = __uint_as_float(yw.z << 16) * __builtin_amdgcn_rcpf(1.0f + __expf(-z1[0])); o1[1] = __uint_as_float(yw.z & 0xffff0000u) * __builtin_amdgcn_rcpf(1.0f + __expf(-z1[1]));
                    o1[2] = __uint_as_float(yw.w << 16) * __builtin_amdgcn_rcpf(1.0f + __expf(-z1[2])); o1[3] = __uint_as_float(yw.w & 0xffff0000u) * __builtin_amdgcn_rcpf(1.0f + __expf(-z1[3]));
                    s2[ai][m] += (o0[0] * o0[0] + o0[1] * o0[1]) + (o0[2] * o0[2] + o0[3] * o0[3]) + (o1[0] * o1[0] + o1[1] * o1[1]) + (o1[2] * o1[2] + o1[3] * o1[3]);
                    const f32x4 p0 = o0 * wv0, p1 = o1 * wv1;
                    u32x4 w; w.x = pk_bf16(p0[0], p0[1]); w.y = pk_bf16(p0[2], p0[3]); w.z = pk_bf16(p1[0], p1[1]); w.w = pk_bf16(p1[2], p1[3]);
                    *(u32x4*)(A2 + (size_t)row * 1024 + col0 + bj * HALF) = w;
                }
        }
        const bool hi5 = fq & 2, hi4 = fq & 1;
#pragma unroll
        for (int ai = 0; ai < 2; ++ai) {
            const float a2 = (hi5 ? s2[ai][2] : s2[ai][0]) + __shfl_xor(hi5 ? s2[ai][0] : s2[ai][2], 32), b2 = (hi5 ? s2[ai][3] : s2[ai][1]) + __shfl_xor(hi5 ? s2[ai][1] : s2[ai][3], 32);
            const float t2 = (hi4 ? b2 : a2) + __shfl_xor(hi4 ? a2 : b2, 16);
            atomicAdd(ssq + u.pm * BM + wr * 64 + ai * HALF + fq * 16 + fr, t2);
        }
    }
};
}

DI void prep_mod_item(const Params& p, int item, char* smem) {
    float* condT = (float*)smem;
    float* red = condT + DM * 16;
    const int tid = my_tid();
    for (int i = tid; i < NB * DM; i += NTH) { const int b = i >> 10, k = i & 1023; condT[k * 16 + b] = siluf_(p.c[i]); }
    __syncthreads();
    const int ks = tid >> 5, col = tid & 31;
    float acc[16];
#pragma unroll
    for (int b = 0; b < 16; ++b) acc[b] = 0.f;
    const float* w = p.ada_w + (size_t)(ks * 64) * 6144 + item * 32 + col;
#pragma unroll 1
    for (int seg = 0; seg < 4; ++seg) {
        float wreg[16];
#pragma unroll
        for (int k = 0; k < 16; ++k) wreg[k] = w[(size_t)(seg * 16 + k) * 6144];
#pragma unroll
        for (int k = 0; k < 16; ++k) {
            const float wv = wreg[k];
            const f32x4* cb = (const f32x4*)(condT + (ks * 64 + seg * 16 + k) * 16);
            const f32x4 c0 = cb[0], c1 = cb[1], c2 = cb[2], c3 = cb[3];
            acc[0] += c0.x * wv; acc[1] += c0.y * wv; acc[2] += c0.z * wv; acc[3] += c0.w * wv;
            acc[4] += c1.x * wv; acc[5] += c1.y * wv; acc[6] += c1.z * wv; acc[7] += c1.w * wv;
            acc[8] += c2.x * wv; acc[9] += c2.y * wv; acc[10] += c2.z * wv; acc[11] += c2.w * wv;
            acc[12] += c3.x * wv; acc[13] += c3.y * wv; acc[14] += c3.z * wv; acc[15] += c3.w * wv;
        }
    }
#pragma unroll
    for (int b = 0; b < 16; ++b) red[(ks * 32 + col) * 16 + b] = acc[b];
    __syncthreads();
    {
        const int b = tid >> 5;
        float sum = p.ada_b[item * 32 + col];
#pragma unroll
        for (int q = 0; q < 16; ++q) sum += red[(q * 32 + col) * 16 + b];
        ((float*)(p.ws + OFF_MOD))[b * 6144 + item * 32 + col] = sum;
    }
    __syncthreads();
}
DI void prep_s5_gemm_item(const Params& p, int g, int part, char* smem) {
    f32x2* pw = (f32x2*)smem;
    f32x2* bbL = pw + 17 * 64;
    f32x2* cL = bbL + 64 * 16;
    const int tid = my_tid();
    const float dt = expf(p.log_dt[g]);
#pragma unroll 1
    for (int idx = tid; idx < 17 * 64; idx += NTH) {
        const int j = idx >> 6, pp = idx & 63;
        const float ar = p.a_re[g * 64 + pp], ai = p.a_im[g * 64 + pp];
        const float mag = expf(ar * dt * (float)j), ang = ai * dt * (float)j;
        pw[idx] = (f32x2){mag * cosf(ang), mag * sinf(ang)};
    }
    for (int idx = tid; idx < 16 * 64; idx += NTH) { const int i = idx >> 6, pp = idx & 63; cL[idx] = (f32x2){p.c_re[(g * 16 + i) * 64 + pp], p.c_im[(g * 16 + i) * 64 + pp]}; }
    __syncthreads();
    for (int idx = tid; idx < 64 * 16; idx += NTH) {
        const int pp = idx >> 4, i = idx & 15;
        const float ar = p.a_re[g * 64 + pp], ai = p.a_im[g * 64 + pp];
        const f32x2 lam = pw[64 + pp];
        const float den = ar * ar + ai * ai, nr = lam.x - 1.0f, ni = lam.y;
        const float zr = (nr * ar + ni * ai) / den, zi = (ni * ar - nr * ai) / den;
        const float br = p.b_re[(g * 64 + pp) * 16 + i], bi = p.b_im[(g * 64 + pp) * 16 + i];
        bbL[idx] = (f32x2){zr * br - zi * bi, zr * bi + zi * br};
    }
    __syncthreads();
    bf16_t* NBg = (bf16_t*)(p.ws + OFF_S5N) + (size_t)g * 128 * 256;
    if (part == 0)
#pragma unroll 1
    for (int ch = tid; ch < 128 * 256 / 8; ch += NTH) {
        const int pq = ch >> 5, t = (ch >> 1) & 15, i0 = (ch & 1) * 8, pp = pq & 63;
        const f32x2 w = pw[(15 - t) * 64 + pp];
        float v[8];
#pragma unroll
        for (int e = 0; e < 8; ++e) { const f32x2 bb = bbL[pp * 16 + i0 + e]; v[e] = pq < 64 ? (w.x * bb.x - w.y * bb.y) : (w.x * bb.y + w.y * bb.x); }
        u32x4 o; o.x = pack2(v[0], v[1]); o.y = pack2(v[2], v[3]); o.z = pack2(v[4], v[5]); o.w = pack2(v[6], v[7]);
        *(u32x4*)(NBg + (size_t)((((pq >> 5) * 16 + t) * 64) + (i0 >> 3) * 32 + (pq & 31)) * 8) = o;
    }
    bf16_t* MBg = (bf16_t*)(p.ws + OFF_S5M) + (size_t)g * 256 * 128;
    if (part == 1)
#pragma unroll 1
    for (int ch = tid; ch < 256 * 128 / 8; ch += NTH) {
        const int ti = ch >> 4, p0 = (ch & 15) * 8, tq = ti >> 4, iq = ti & 15;
        float v[8];
#pragma unroll
        for (int e = 0; e < 8; ++e) {
            const int pq = p0 + e, pp = pq & 63;
            const f32x2 c = cL[iq * 64 + pp], w = pw[(tq + 1) * 64 + pp];
            v[e] = pq < 64 ? (c.x * w.x - c.y * w.y) : -(c.x * w.y + c.y * w.x);
        }
        u32x4 o; o.x = pack2(v[0], v[1]); o.y = pack2(v[2], v[3]); o.z = pack2(v[4], v[5]); o.w = pack2(v[6], v[7]);
        *(u32x4*)(MBg + (size_t)((((ti >> 5) * 8 + (p0 >> 4)) * 64) + ((p0 >> 3) & 1) * 32 + (ti & 31)) * 8) = o;
    }
    bf16_t* KTg = (bf16_t*)(p.ws + OFF_S5K) + (size_t)g * 4096;
    if (part >= 2)
#pragma unroll 1
    for (int idx = (part - 2) * 2048 + tid; idx < (part - 1) * 2048; idx += NTH) {
        const int lag = idx >> 8, iq = (idx >> 4) & 15, i = idx & 15;
        float acc = (lag == 0 && iq == i) ? p.dsk[g * 16 + iq] : 0.f;
#pragma unroll 4
        for (int pp = 0; pp < 64; ++pp) {
            const f32x2 c = cL[iq * 64 + pp], w = pw[lag * 64 + pp], bb = bbL[pp * 16 + i];
            const float mr = c.x * w.x - c.y * w.y, mi_ = c.x * w.y + c.y * w.x;
            acc += mr * bb.x - mi_ * bb.y;
        }
        KTg[idx] = f2bf(acc);
    }
    if (part == 3 && tid < 64) { float* L = (float*)(p.ws + OFF_S5L) + (g * 64 + tid) * 2; const f32x2 w = pw[16 * 64 + tid]; L[0] = w.x; L[1] = w.y; }
    __syncthreads();
}
DI void prep_s5_item(const Params& p, int g) {
    const int tid = my_tid();
    if (tid < SSP) {
        const int pi = g * SSP + tid;
        const float dt = expf(p.log_dt[g]);
        const float ar = p.a_re[pi], ai = p.a_im[pi];
        const float mag = expf(ar * dt);
        const float lr = mag * cosf(ai * dt), li = mag * sinf(ai * dt);
        const float den = ar * ar + ai * ai, nr = lr - 1.0f, ni = li;
        const float zr = (nr * ar + ni * ai) / den, zi = (ni * ar - nr * ai) / den;
        float* lam = (float*)(p.ws + OFF_LAM) + pi * 2;
        lam[0] = lr; lam[1] = li;
        float* bb = (float*)(p.ws + OFF_BB) + (size_t)pi * 32;
        for (int i = 0; i < SSC; ++i) {
            const float br = p.b_re[pi * SSC + i], bi = p.b_im[pi * SSC + i];
            bb[i * 2] = zr * br - zi * bi; bb[i * 2 + 1] = zr * bi + zi * br;
        }
    }
}
DI void prep_transpose_tile(const float* __restrict__ W, bf16_t* __restrict__ Wt, int K, int N, int kt, int nt, char* smem, int dst_row0 = -1, int kswap = 0) {
    float* tile = (float*)smem;
    const int tid = my_tid();
#pragma unroll
    for (int q = 0; q < 2; ++q) {
        const int kk = (tid >> 4) + q * 32, c4 = (tid & 15) * 4;
        const float4 v = *(const float4*)(W + (size_t)(kt * 64 + kk) * N + nt * 64 + c4);
        tile[kk * 65 + c4] = v.x; tile[kk * 65 + c4 + 1] = v.y; tile[kk * 65 + c4 + 2] = v.z; tile[kk * 65 + c4 + 3] = v.w;
    }
    __syncthreads();
    const int n = tid >> 3, kc = tid & 7;
    uint4 o;
    o.x = pack2(tile[(kc * 8 + 0) * 65 + n], tile[(kc * 8 + 1) * 65 + n]);
    o.y = pack2(tile[(kc * 8 + 2) * 65 + n], tile[(kc * 8 + 3) * 65 + n]);
    o.z = pack2(tile[(kc * 8 + 4) * 65 + n], tile[(kc * 8 + 5) * 65 + n]);
    o.w = pack2(tile[(kc * 8 + 6) * 65 + n], tile[(kc * 8 + 7) * 65 + n]);
    *(uint4*)(Wt + (size_t)((dst_row0 < 0 ? nt * 64 : dst_row0) + n) * K + ((kt * 64 + kswap) & (K - 1)) + kc * 8) = o;
    __syncthreads();
}
DI void cvt_bf16_stream(const float* __restrict__ src, bf16_t* __restrict__ dst, size_t n8, int bid, int nb) {
    for (size_t i = (size_t)bid * NTH + my_tid(); i < n8; i += (size_t)nb * NTH) {
        const float4 a = *(const float4*)(src + i * 8), b = *(const float4*)(src + i * 8 + 4);
        uint4 o; o.x = pack2(a.x, a.y); o.y = pack2(a.z, a.w); o.z = pack2(b.x, b.y); o.w = pack2(b.z, b.w);
        *(uint4*)(dst + i * 8) = o;
    }
}
DI void cvt_fp8_rows(const float* __restrict__ src, unsigned char* __restrict__ dst, float* __restrict__ inv, int bid, int nb) {
    const int lane = my_tid() & 63, wid = my_tid() >> 6;
    for (int row = bid * 8 + wid; row < NEXP; row += nb * 8) {
        const float* sp = src + (size_t)row * DM + lane * 16;
        const f32x4 a = *(const f32x4*)sp, b = *(const f32x4*)(sp + 4), c = *(const f32x4*)(sp + 8), d = *(const f32x4*)(sp + 12);
        float m = fmaxf(fmaxf(fmaxf(fabsf(a.x), fabsf(a.y)), fmaxf(fabsf(a.z), fabsf(a.w))), fmaxf(fmaxf(fabsf(b.x), fabsf(b.y)), fmaxf(fabsf(b.z), fabsf(b.w))));
        m = fmaxf(m, fmaxf(fmaxf(fmaxf(fabsf(c.x), fabsf(c.y)), fmaxf(fabsf(c.z), fabsf(c.w))), fmaxf(fmaxf(fabsf(d.x), fabsf(d.y)), fmaxf(fabsf(d.z), fabsf(d.w)))));
#pragma unroll
        for (int s = 1; s < 64; s <<= 1) m = fmaxf(m, __shfl_xor(m, s));
        float sc = 1.f, isc = 1.f;
        if (m > 1e-30f) {
            int k = (int)floorf(log2f(448.0f / m));
            k = k < -60 ? -60 : (k > 60 ? 60 : k);
            sc = ldexpf(1.0f, k); isc = ldexpf(1.0f, -k);
            if (m * sc > 448.0f) { sc *= 0.5f; isc *= 2.0f; }
        }
        u32x4 o;
        int w;
        w = __builtin_amdgcn_cvt_pk_fp8_f32(a.x * sc, a.y * sc, 0, false); w = __builtin_amdgcn_cvt_pk_fp8_f32(a.z * sc, a.w * sc, w, true); o.x = (unsigned)w;
        w = __builtin_amdgcn_cvt_pk_fp8_f32(b.x * sc, b.y * sc, 0, false); w = __builtin_amdgcn_cvt_pk_fp8_f32(b.z * sc, b.w * sc, w, true); o.y = (unsigned)w;
        w = __builtin_amdgcn_cvt_pk_fp8_f32(c.x * sc, c.y * sc, 0, false); w = __builtin_amdgcn_cvt_pk_fp8_f32(c.z * sc, c.w * sc, w, true); o.z = (unsigned)w;
        w = __builtin_amdgcn_cvt_pk_fp8_f32(d.x * sc, d.y * sc, 0, false); w = __builtin_amdgcn_cvt_pk_fp8_f32(d.z * sc, d.w * sc, w, true); o.w = (unsigned)w;
        *(u32x4*)(dst + (size_t)row * DM + lane * 16) = o;
        if (lane == 0) inv[row] = isc;
    }
}
DI void cvt_fp4_rows(const float* __restrict__ src, unsigned char* __restrict__ dst, float* __restrict__ inv, int bid, int nb) {
    const int lane = my_tid() & 63, wid = my_tid() >> 6;
    for (int row = bid * 8 + wid; row < NEXP; row += nb * 8) {
        const float* sp = src + (size_t)row * DM + lane * 16;
        const f32x4 a = *(const f32x4*)sp, b = *(const f32x4*)(sp + 4), c = *(const f32x4*)(sp + 8), d = *(const f32x4*)(sp + 12);
        float m = fmaxf(fmaxf(fmaxf(fabsf(a.x), fabsf(a.y)), fmaxf(fabsf(a.z), fabsf(a.w))), fmaxf(fmaxf(fabsf(b.x), fabsf(b.y)), fmaxf(fabsf(b.z), fabsf(b.w))));
        m = fmaxf(m, fmaxf(fmaxf(fmaxf(fabsf(c.x), fabsf(c.y)), fmaxf(fabsf(c.z), fabsf(c.w))), fmaxf(fmaxf(fabsf(d.x), fabsf(d.y)), fmaxf(fabsf(d.z), fabsf(d.w)))));
#pragma unroll
        for (int s = 1; s < 64; s <<= 1) m = fmaxf(m, __shfl_xor(m, s));
        const float sc = m > 1e-30f ? 6.0f / m : 1.0f, isc = m > 1e-30f ? m * (1.0f / 6.0f) : 1.0f;
        unsigned w0 = 0u, w1 = 0u;
        w0 = __builtin_amdgcn_cvt_scalef32_pk_fp4_f32(w0, a.x * sc, a.y * sc, 1.0f, 0); w0 = __builtin_amdgcn_cvt_scalef32_pk_fp4_f32(w0, a.z * sc, a.w * sc, 1.0f, 1);
        w0 = __builtin_amdgcn_cvt_scalef32_pk_fp4_f32(w0, b.x * sc, b.y * sc, 1.0f, 2); w0 = __builtin_amdgcn_cvt_scalef32_pk_fp4_f32(w0, b.z * sc, b.w * sc, 1.0f, 3);
        w1 = __builtin_amdgcn_cvt_scalef32_pk_fp4_f32(w1, c.x * sc, c.y * sc, 1.0f, 0); w1 = __builtin_amdgcn_cvt_scalef32_pk_fp4_f32(w1, c.z * sc, c.w * sc, 1.0f, 1);
        w1 = __builtin_amdgcn_cvt_scalef32_pk_fp4_f32(w1, d.x * sc, d.y * sc, 1.0f, 2); w1 = __builtin_amdgcn_cvt_scalef32_pk_fp4_f32(w1, d.z * sc, d.w * sc, 1.0f, 3);
        *(uint2*)(dst + (size_t)row * (DM / 2) + lane * 8) = make_uint2(w0, w1);
        if (lane == 0) inv[row] = isc;
    }
}
template <int OFFS>
DI void cvt_i8_rows(const float* __restrict__ src, unsigned char* __restrict__ dst, float* __restrict__ inv, int bid, int nb) {
    const int lane = my_tid() & 63, wid = my_tid() >> 6;
    for (int row = bid * 8 + wid; row < NEXP; row += nb * 8) {
        const float* sp = src + (size_t)row * DM + lane * 16;
        const f32x4 a = *(const f32x4*)sp, b = *(const f32x4*)(sp + 4), c = *(const f32x4*)(sp + 8), d = *(const f32x4*)(sp + 12);
        float m = fmaxf(fmaxf(fmaxf(fabsf(a.x), fabsf(a.y)), fmaxf(fabsf(a.z), fabsf(a.w))), fmaxf(fmaxf(fabsf(b.x), fabsf(b.y)), fmaxf(fabsf(b.z), fabsf(b.w))));
        m = fmaxf(m, fmaxf(fmaxf(fmaxf(fabsf(c.x), fabsf(c.y)), fmaxf(fabsf(c.z), fabsf(c.w))), fmaxf(fmaxf(fabsf(d.x), fabsf(d.y)), fmaxf(fabsf(d.z), fabsf(d.w)))));
#pragma unroll
        for (int s = 1; s < 64; s <<= 1) m = fmaxf(m, __shfl_xor(m, s));
        const float sc = m > 1e-30f ? 127.0f / m : 1.0f, isc = m > 1e-30f ? m * (1.0f / 127.0f) : 1.0f;
        const float v[16] = {a.x, a.y, a.z, a.w, b.x, b.y, b.z, b.w, c.x, c.y, c.z, c.w, d.x, d.y, d.z, d.w};
        unsigned w[4];
#pragma unroll
        for (int q = 0; q < 4; ++q) {
            unsigned pk = 0u;
#pragma unroll
            for (int e = 0; e < 4; ++e) { const int qi = (int)rintf(v[q * 4 + e] * sc) + OFFS; pk |= ((unsigned)qi & 0xffu) << (8 * e); }
            w[q] = pk;
        }
        *(u32x4*)(dst + (size_t)row * DM + lane * 16) = (u32x4){w[0], w[1], w[2], w[3]};
        if (lane == 0) inv[row] = isc;
    }
}
DI void prep_cab_item(const Params& p, int item, char* smem) {
    float* vT = (float*)smem;
    float* red = vT + DM * 16;
    const float* mod = (const float*)(p.ws + OFF_MOD);
    const int tid = my_tid(), ks = tid >> 5, col = tid & 31;
    const float* w = p.w_q + (size_t)(ks * 64) * 2048 + item * 32 + col;
#pragma unroll 1
    for (int which = 0; which < 2; ++which) {
        for (int i = tid; i < NB * DM; i += NTH) {
            const int b = i >> 10, k = i & 1023;
            const float sc = 1.0f + mod[b * 6144 + 4096 + k];
            const float v = which == 0 ? p.ln1w[k] * sc : p.ln1b[k] * sc + mod[b * 6144 + 3072 + k];
            vT[k * 16 + b] = v;
            if (item == 0) ((float*)(p.ws + OFF_AB))[(size_t)which * NB * DM + i] = v;
        }
        __syncthreads();
        float acc[16];
#pragma unroll
        for (int b = 0; b < 16; ++b) acc[b] = 0.f;
#pragma unroll 1
        for (int seg = 0; seg < 4; ++seg) {
            float wreg[16];
#pragma unroll
            for (int k = 0; k < 16; ++k) wreg[k] = w[(size_t)(seg * 16 + k) * 2048];
#pragma unroll
            for (int k = 0; k < 16; ++k) {
                const float wv = wreg[k];
                const f32x4* cb = (const f32x4*)(vT + (ks * 64 + seg * 16 + k) * 16);
                const f32x4 c0 = cb[0], c1 = cb[1], c2 = cb[2], c3 = cb[3];
                acc[0] += c0.x * wv; acc[1] += c0.y * wv; acc[2] += c0.z * wv; acc[3] += c0.w * wv;
                acc[4] += c1.x * wv; acc[5] += c1.y * wv; acc[6] += c1.z * wv; acc[7] += c1.w * wv;
                acc[8] += c2.x * wv; acc[9] += c2.y * wv; acc[10] += c2.z * wv; acc[11] += c2.w * wv;
                acc[12] += c3.x * wv; acc[13] += c3.y * wv; acc[14] += c3.z * wv; acc[15] += c3.w * wv;
            }
        }
#pragma unroll
        for (int b = 0; b < 16; ++b) red[(ks * 32 + col) * 16 + b] = acc[b];
        __syncthreads();
        {
            const int b = tid >> 5;
            float sum = 0.f;
#pragma unroll
            for (int q = 0; q < 16; ++q) sum += red[(q * 32 + col) * 16 + b];
            ((float*)(p.ws + OFF_CAB))[(size_t)which * NB * 2048 + b * 2048 + item * 32 + col] = sum;
        }
        __syncthreads();
    }
}
DI void phase_h(const Params& p, int bid, int nb) {
    const float* mod = (const float*)(p.ws + OFF_MOD);
    bf16_t* H = (bf16_t*)(p.ws + OFF_H);
    const size_t n8 = (size_t)NTOK * DM / 8;
    for (size_t i = (size_t)bid * NTH + my_tid(); i < n8; i += (size_t)nb * NTH) {
        const int row = (int)(i >> 7), c0 = (int)(i & 127) * 8, b = row / SEQ;
        const float* sh = mod + b * 6144 + c0;
        const float* sc = sh + 1024;
        const float4 a = *(const float4*)(p.x + i * 8), bq = *(const float4*)(p.x + i * 8 + 4);
        const float4 s0 = *(const float4*)sc, s1 = *(const float4*)(sc + 4), h0 = *(const float4*)sh, h1 = *(const float4*)(sh + 4);
        uint4 o;
        o.x = pack2(a.x * (1.f + s0.x) + h0.x, a.y * (1.f + s0.y) + h0.y);
        o.y = pack2(a.z * (1.f + s0.z) + h0.z, a.w * (1.f + s0.w) + h0.w);
        o.z = pack2(bq.x * (1.f + s1.x) + h1.x, bq.y * (1.f + s1.y) + h1.y);
        o.w = pack2(bq.z * (1.f + s1.z) + h1.z, bq.w * (1.f + s1.w) + h1.w);
        *(uint4*)(H + i * 8) = o;
    }
}

DI int wq_next(unsigned* ctr, char* smem) {
    volatile unsigned* slot = (volatile unsigned*)(smem + SMEM_BYTES - 8);
    __syncthreads();
    if (__builtin_amdgcn_workitem_id_x() == 0) *slot = __hip_atomic_fetch_add(ctr, 1u, __ATOMIC_RELAXED, __HIP_MEMORY_SCOPE_AGENT);
    __syncthreads();
    return (int)*slot;
}
DI void phase_prep_a(const Params& p, char* smem) {
    unsigned* ctr = (unsigned*)(p.ws + OFF_BAR) + 120;
    constexpr int U_S5 = 192, U_LB = 320, U_TR = 321, U_UT = U_TR + 368, U_VT = U_UT + 128, U_MISC = U_VT + 128, U_END = U_MISC + 8;
    for (int u = wq_next(ctr, smem); u < U_END; u = wq_next(ctr, smem)) {
        if (u < U_S5) prep_mod_item(p, u, smem);
        else if (u < U_LB) prep_s5_gemm_item(p, (u - U_S5) >> 2, (u - U_S5) & 3, smem);
        else if (u < U_TR) {
            const int j = my_tid();
            const float a0 = p.hg_lb[j], a1 = p.hg_lb[512 + j], m = fmaxf(a0, a1);
            const float e0 = expf(a0 - m), e1 = expf(a1 - m);
            ((float*)(p.ws + OFF_LB))[j] = e0 / (e0 + e1);
        } else if (u < U_UT) {
            for (int it = (u - U_TR) * 4; it < (u - U_TR) * 4 + 4; ++it) {
                constexpr int T_WIN = 16 * 40, T_GLU = 8 * 8, T_WOUT = 16 * 16;
                constexpr int I_GLU = T_WIN, I_WOUT = I_GLU + T_GLU, I_WQ = I_WOUT + T_WOUT;
                if (it < I_GLU) { const int t = it, n0 = (t % 40) * 64;
                    const int d0 = n0 < 512 ? (n0 >> 7) * 256 + (n0 & 127) : (n0 < 1024 ? ((n0 - 512) >> 7) * 256 + 128 + (n0 & 127) : n0);
                    prep_transpose_tile(p.w_in, (bf16_t*)(p.ws + OFF_WIN), DM, INC, t / 40, t % 40, smem, d0); }
                else if (it < I_WOUT) { const int t = it - I_GLU; prep_transpose_tile(p.glu_w, (bf16_t*)(p.ws + OFF_GLU), 512, 512, t / 8, t % 8, smem); }
                else if (it < I_WQ) { const int t = it - I_WOUT; prep_transpose_tile(p.w_out, (bf16_t*)(p.ws + OFF_WOUT), DM, DM, t / 16, t % 16, smem, -1, 512); }
                else { const int t = it - I_WQ; prep_transpose_tile(p.w_q, (bf16_t*)(p.ws + OFF_WQ), DM, 2048, t / 32, t % 32, smem); }
            }
        } else if (u < U_VT) cvt_i8_rows<0>(p.pu, (unsigned char*)(p.ws + OFF_UT), (float*)(p.ws + OFF_SU), u - U_UT, 128);
        else if (u < U_MISC) cvt_i8_rows<128>(p.pv, (unsigned char*)(p.ws + OFF_VT), (float*)(p.ws + OFF_SV), u - U_VT, 128);
        else {
            const int q = u - U_MISC;
            cvt_bf16_stream(p.subk, (bf16_t*)(p.ws + OFF_SUBK), (size_t)16 * 128 * 128 / 8, q, 8);
            for (size_t i = (size_t)q * NTH + my_tid(); i < (size_t)NTOK * 3 / 4; i += (size_t)8 * NTH) ((f32x4*)(p.ws + OFF_STAT))[i] = (f32x4){0.f, 0.f, 0.f, 0.f};
        }
    }
}
DI void phase_prep_b(const Params& p, char* smem) {
    unsigned* ctr = (unsigned*)(p.ws + OFF_BAR) + 121;
    for (int u = wq_next(ctr, smem); u < 64 + 256; u = wq_next(ctr, smem)) {
        if (u < 64) prep_cab_item(p, u, smem); else phase_h(p, u - 64, 256);
    }
}

DI void phase_proj(const Params& p, int bid, int nb, char* smem) {
    pg8::Gemm g{(const bf16_t*)(p.ws + OFF_H), (const bf16_t*)(p.ws + OFF_WIN), NTOK, INC, DM};
    pg8::StaticOrder S; S.init(NTOK, INC, nb, bid);
    pg8::EpiProj E{(bf16_t*)(p.ws + OFF_PROJ), (bf16_t*)(p.ws + OFF_HQ), (bf16_t*)(p.ws + OFF_HK), (float*)(p.ws + OFF_HG), (const float*)(p.ws + OFF_LB)};
    pg8::gemm_phase<pg8::EpiProj, pg8::StaticOrder, false>((PG8_LAS unsigned char*)smem, g, S, E, nullptr);
}

DI void hgrn_item(const Params& p, int item, char* smem) {
    const int vs = item & 7, hd = (item >> 3) & 3, b = item >> 5;
    const bf16_t* P = (const bf16_t*)(p.ws + OFF_PROJ);
    const float* lb = (const float*)(p.ws + OFF_LB) + hd * HDK;
    float* ORAW = (float*)(p.ws + OFF_ORAW);
    float* sq = (float*)smem;
    float* sf = sq + 32 * 128;
    float* sv = sf + 32 * 128;
    float* sp = sv + 32 * 16;
    const int tid = my_tid(), lane = tid & 63, wid = tid >> 6, kq = tid >> 4, v = tid & 15;
    float S0 = 0.f, S1 = 0.f, S2 = 0.f, S3 = 0.f;
    for (int t0 = 0; t0 < SEQ; t0 += 32) {
        for (int i = tid; i < 32 * 128; i += NTH) {
            const int t = i >> 7, k = i & 127;
            const bf16_t* row = P + (size_t)(b * SEQ + t0 + t) * INC + hd * HDK + k;
            sq[i] = bf2f(row[0]);
            const float l = lb[k];
            sf[i] = l + (1.0f - l) * sigmoidf_(bf2f(row[512]));
        }
        { const int t = tid >> 4; sv[tid] = bf2f(P[(size_t)(b * SEQ + t0 + t) * INC + 1024 + hd * HDK + vs * 16 + v]); }
        __syncthreads();
        for (int t = 0; t < 32; ++t) {
            const float4 f4 = *(const float4*)(sf + t * 128 + kq * 4), q4 = *(const float4*)(sq + t * 128 + kq * 4);
            const float vv = sv[t * 16 + v];
            S0 = f4.x * S0 + (1.0f - f4.x) * vv; S1 = f4.y * S1 + (1.0f - f4.y) * vv;
            S2 = f4.z * S2 + (1.0f - f4.z) * vv; S3 = f4.w * S3 + (1.0f - f4.w) * vv;
            float part = q4.x * S0 + q4.y * S1 + q4.z * S2 + q4.w * S3;
            part += __shfl_xor(part, 16); part += __shfl_xor(part, 32);
            if (lane < 16) sp[(t * 8 + wid) * 16 + v] = part;
        }
        __syncthreads();
        {
            const int t = tid >> 4;
            float o = 0.f;
#pragma unroll
            for (int w = 0; w < 8; ++w) o += sp[(t * 8 + w) * 16 + v];
            ORAW[(size_t)(b * SEQ + t0 + t) * DHG + hd * HDK + vs * 16 + v] = o;
        }
        __syncthreads();
    }
}
DI void s5_item(const Params& p, int item, char* smem) {
    const int oct = item & 3, b = item >> 2;
    const int tid = my_tid(), lane = tid & 63, wid = tid >> 6, g = oct * 8 + wid;
    const bf16_t* P = (const bf16_t*)(p.ws + OFF_PROJ);
    bf16_t* Y = (bf16_t*)(p.ws + OFF_YSSM);
    float* su = (float*)smem + wid * 64 * 16;
    const float* lam = (const float*)(p.ws + OFF_LAM) + (g * SSP + lane) * 2;
    const float lr = lam[0], li = lam[1];
    const float* bb = (const float*)(p.ws + OFF_BB) + (size_t)(g * SSP + lane) * 32;
    float bbr[16], bbi[16], cr[16], ci[16];
#pragma unroll
    for (int i = 0; i < 16; ++i) { bbr[i] = bb[2 * i]; bbi[i] = bb[2 * i + 1]; cr[i] = p.c_re[(g * SSC + i) * SSP + lane]; ci[i] = p.c_im[(g * SSC + i) * SSP + lane]; }
    const int ch = (lane >> 2) & 15;
    const float dch = p.dsk[g * SSC + ch];
    float xr = 0.f, xi = 0.f;
    for (int t0 = 0; t0 < SEQ; t0 += 64) {
        {
            const uint4* src = (const uint4*)(P + (size_t)(b * SEQ + t0 + lane) * INC + 2048 + g * SSC);
            const uint4 a = src[0], c = src[1];
            float* d = su + lane * 16;
            d[0] = bflo(a.x); d[1] = bfhi(a.x); d[2] = bflo(a.y); d[3] = bfhi(a.y); d[4] = bflo(a.z); d[5] = bfhi(a.z); d[6] = bflo(a.w); d[7] = bfhi(a.w);
            d[8] = bflo(c.x); d[9] = bfhi(c.x); d[10] = bflo(c.y); d[11] = bfhi(c.y); d[12] = bflo(c.z); d[13] = bfhi(c.z); d[14] = bflo(c.w); d[15] = bfhi(c.w);
        }
        __syncthreads();
        for (int t = 0; t < 64; ++t) {
            float u[16];
            const float4* us = (const float4*)(su + t * 16);
            const float4 u0 = us[0], u1 = us[1], u2 = us[2], u3 = us[3];
            u[0] = u0.x; u[1] = u0.y; u[2] = u0.z; u[3] = u0.w; u[4] = u1.x; u[5] = u1.y; u[6] = u1.z; u[7] = u1.w;
            u[8] = u2.x; u[9] = u2.y; u[10] = u2.z; u[11] = u2.w; u[12] = u3.x; u[13] = u3.y; u[14] = u3.z; u[15] = u3.w;
            float bur = 0.f, bui = 0.f;
#pragma unroll
            for (int i = 0; i < 16; ++i) { bur += bbr[i] * u[i]; bui += bbi[i] * u[i]; }
            const float nxr = lr * xr - li * xi + bur, nxi = lr * xi + li * xr + bui;
            xr = nxr; xi = nxi;
            float y[16];
#pragma unroll
            for (int i = 0; i < 16; ++i) y[i] = cr[i] * xr - ci[i] * xi;
            const bool b5 = lane & 32, b4 = lane & 16, b3 = lane & 8, b2 = lane & 4;
            float y8[8], y4[4], y2[2];
#pragma unroll
            for (int j = 0; j < 8; ++j) { const float keep = b5 ? y[8 + j] : y[j], send = b5 ? y[j] : y[8 + j]; y8[j] = keep + __shfl_xor(send, 32); }
#pragma unroll
            for (int j = 0; j < 4; ++j) { const float keep = b4 ? y8[4 + j] : y8[j], send = b4 ? y8[j] : y8[4 + j]; y4[j] = keep + __shfl_xor(send, 16); }
#pragma unroll
            for (int j = 0; j < 2; ++j) { const float keep = b3 ? y4[2 + j] : y4[j], send = b3 ? y4[j] : y4[2 + j]; y2[j] = keep + __shfl_xor(send, 8); }
            float y1;
            { const float keep = b2 ? y2[1] : y2[0], send = b2 ? y2[0] : y2[1]; y1 = keep + __shfl_xor(send, 4); }
            y1 += __shfl_xor(y1, 1); y1 += __shfl_xor(y1, 2);
            if ((lane & 3) == 0) {
                const float uu = su[t * 16 + ch];
                Y[(size_t)(b * SEQ + t0 + t) * DSS + g * SSC + ch] = f2bf(geluf_(y1 + dch * uu));
            }
        }
        __syncthreads();
    }
}
DI int crow(int i, int h) { return (i & 3) + 8 * (i >> 2) + 4 * h; }
DI void phase_hgprep(const Params& p, int bid, int nb) {
    const bf16_t* P = (const bf16_t*)(p.ws + OFF_PROJ);
    const float* lbp = (const float*)(p.ws + OFF_LB);
    const int tid = my_tid(), lane = tid & 63, wid = tid >> 6, tq = lane >> 4, cg = lane & 15;
#pragma unroll 1
    for (int it = bid * 8 + wid; it < 8192; it += nb * 8) {
        const int tile = it >> 1, c = tile & 63, hd = (tile >> 6) & 3, b = tile >> 8, k0 = (it & 1) * 64 + cg * 4;
        const bf16_t* base = P + (size_t)(b * SEQ + c * 32 + tq * 8) * INC + hd * HDK + k0;
        uint2 qw[8], fw[8];
#pragma unroll
        for (int tt = 0; tt < 8; ++tt) { qw[tt] = *(const uint2*)(base + (size_t)tt * INC); fw[tt] = *(const uint2*)(base + (size_t)tt * INC + 512); }
        const f32x4 l4 = *(const f32x4*)(lbp + hd * HDK + k0);
        const float lb4[4] = {l4.x, l4.y, l4.z, l4.w};
        float bl[8][4], kk[8][4], run[4];
#pragma unroll
        for (int e = 0; e < 4; ++e) run[e] = 0.f;
#pragma unroll
        for (int tt = 0; tt < 8; ++tt) {
            const float fl[4] = {bflo(fw[tt].x), bfhi(fw[tt].x), bflo(fw[tt].y), bfhi(fw[tt].y)};
#pragma unroll
            for (int e = 0; e < 4; ++e) {
                const float f = lb4[e] + (1.0f - lb4[e]) * sigmoidf_(fl[e]);
                run[e] += __logf(f); bl[tt][e] = run[e]; kk[tt][e] = 1.0f - f;
            }
        }
        float off[4], tot[4];
#pragma unroll
        for (int e = 0; e < 4; ++e) {
            const float t0 = __shfl(run[e], cg), t1 = __shfl(run[e], cg + 16), t2 = __shfl(run[e], cg + 32), t3 = __shfl(run[e], cg + 48);
            off[e] = (tq > 0 ? t0 : 0.f) + (tq > 1 ? t1 : 0.f) + (tq > 2 ? t2 : 0.f);
            tot[e] = (t0 + t1) + (t2 + t3);
        }
        bf16_t* HQ = (bf16_t*)(p.ws + OFF_HQ) + (size_t)tile * 4096 + (tq * 8) * 128 + k0;
        bf16_t* HK = (bf16_t*)(p.ws + OFF_HK) + (size_t)tile * 4096 + (tq * 8) * 128 + k0;
#pragma unroll
        for (int tt = 0; tt < 8; ++tt) {
            const float qv[4] = {bflo(qw[tt].x), bfhi(qw[tt].x), bflo(qw[tt].y), bfhi(qw[tt].y)};
            float qo[4], ko[4];
#pragma unroll
            for (int e = 0; e < 4; ++e) { const float bb = off[e] + bl[tt][e]; qo[e] = qv[e] * __expf(bb); ko[e] = kk[tt][e] * __expf(fminf(-bb, 80.0f)); }
            *(uint2*)(HQ + tt * 128) = make_uint2(pack2(qo[0], qo[1]), pack2(qo[2], qo[3]));
            *(uint2*)(HK + tt * 128) = make_uint2(pack2(ko[0], ko[1]), pack2(ko[2], ko[3]));
        }
        if (tq == 0) *(f32x4*)((float*)(p.ws + OFF_HG) + (size_t)tile * 128 + k0) = (f32x4){__expf(tot[0]), __expf(tot[1]), __expf(tot[2]), __expf(tot[3])};
    }
}
typedef short s16x4 __attribute__((ext_vector_type(4)));
DI bf16x8 cat8(const s16x4 lo, const s16x4 hi) { return (bf16x8){lo.x, lo.y, lo.z, lo.w, hi.x, hi.y, hi.z, hi.w}; }
DI s16x4 lds_tr(const char* a) { return __builtin_amdgcn_ds_read_tr16_b64_v4i16((__attribute__((address_space(3))) s16x4*)a); }
DI void hgrn_mfma_item(const Params& p, int item, char* smem) {
    constexpr int QP_OFF = 0, KP_OFF = 8704, V_OFF = 17408, G_OFF = 26112, BUF = 26624, OB_OFF = 3 * BUF, OB_STRIDE = 132, OB_BYTES = 32 * OB_STRIDE * 4;
    const int tid = my_tid(), lane = tid & 63, wid = tid >> 6, r = lane & 31, h = lane >> 5;
    const int b = item >> 2, hd = item & 3;
    const size_t tile0 = (size_t)item * 64;
    const bf16_t* HQ = (const bf16_t*)(p.ws + OFF_HQ) + tile0 * 4096;
    const bf16_t* HK = (const bf16_t*)(p.ws + OFF_HK) + tile0 * 4096;
    const bf16_t* PV = (const bf16_t*)(p.ws + OFF_PROJ) + (size_t)b * SEQ * INC + 1024 + hd * HDK;
    const float* HG = (const float*)(p.ws + OFF_HG) + tile0 * 128;
    bf16_t* A2out = (bf16_t*)(p.ws + OFF_A2) + (size_t)b * SEQ * DM + 512 + hd * HDK;
    const bf16_t* PG = (const bf16_t*)(p.ws + OFF_PROJ) + (size_t)b * SEQ * INC + 1536 + hd * HDK;
    const bool helper = wid >= 4;
    const int ht = tid - 256;
    const int i0 = ht, i1 = ht + 256;
    const int lo0 = (i0 >> 4) * 272 + (i0 & 15) * 16, lo1 = (i1 >> 4) * 272 + (i1 & 15) * 16;
    u32x4 A0, A1, A2, A3, A4, A5, A6, B0, B1, B2, B3, B4, B5, B6;
    A0 = A1 = A2 = A3 = A4 = A5 = A6 = B0 = B1 = B2 = B3 = B4 = B5 = B6 = (u32x4){0, 0, 0, 0};
    f32x16 S[4];
#pragma unroll
    for (int kb = 0; kb < 4; ++kb)
#pragma unroll
        for (int i = 0; i < 16; ++i) S[kb][i] = 0.f;
#define HG_LOAD(X, c_) { const size_t o_ = (size_t)(c_) * 4096; \
        X##0 = *(const u32x4*)(HQ + o_ + i0 * 8); X##1 = *(const u32x4*)(HQ + o_ + i1 * 8); \
        X##2 = *(const u32x4*)(HK + o_ + i0 * 8); X##3 = *(const u32x4*)(HK + o_ + i1 * 8); \
        X##4 = *(const u32x4*)(PV + (size_t)((c_) * 32 + (i0 >> 4)) * INC + (i0 & 15) * 8); X##5 = *(const u32x4*)(PV + (size_t)((c_) * 32 + (i1 >> 4)) * INC + (i1 & 15) * 8); \
        if (ht < 32) X##6 = *(const u32x4*)(HG + (size_t)(c_) * 128 + ht * 4); }
#define HG_STORE(X, buf_) { char* B_ = smem + (buf_) * BUF; \
        *(u32x4*)(B_ + QP_OFF + lo0) = X##0; *(u32x4*)(B_ + QP_OFF + lo1) = X##1; \
        *(u32x4*)(B_ + KP_OFF + lo0) = X##2; *(u32x4*)(B_ + KP_OFF + lo1) = X##3; \
        *(u32x4*)(B_ + V_OFF + lo0) = X##4; *(u32x4*)(B_ + V_OFF + lo1) = X##5; \
        if (ht < 32) *(u32x4*)(B_ + G_OFF + ht * 16) = X##6; }
    const int tq = (lane >> 2) & 3, tp = lane & 3, tg = lane >> 4;
    const int tr_nat = (8 * (tg >> 1) + tq) * 272 + (16 * (tg & 1) + 4 * tp) * 2;
    const int tr_krw = (4 * (tg >> 1) + tq) * 272 + (16 * (tg & 1) + 4 * tp) * 2;
    if (helper) { HG_LOAD(A, 0); HG_STORE(A, 0); HG_LOAD(A, 1); HG_STORE(A, 1); HG_LOAD(A, 2); HG_LOAD(B, 3); }
    __syncthreads();
#define HG_COMPUTE(c_) { \
        const char* B = smem + ((c_) % 3) * BUF; const int w = wid; \
        f32x16 pt; _Pragma("unroll") for (int i = 0; i < 16; ++i) pt[i] = 0.f; \
        _Pragma("unroll") for (int ks = 0; ks < 8; ++ks) { \
            const bf16x8 a = *(const bf16x8*)(B + KP_OFF + r * 272 + ks * 32 + h * 16); \
            const bf16x8 bq = *(const bf16x8*)(B + QP_OFF + r * 272 + ks * 32 + h * 16); \
            pt = __builtin_amdgcn_mfma_f32_32x32x16_bf16(a, bq, pt, 0, 0, 0); } \
        _Pragma("unroll") for (int i = 0; i < 16; ++i) if (crow(i, h) > r) pt[i] = 0.f; \
        f32x16 o; _Pragma("unroll") for (int i = 0; i < 16; ++i) o[i] = 0.f; \
        _Pragma("unroll") for (int sp = 0; sp < 2; ++sp) { \
            const char* vb = B + V_OFF + (16 * sp) * 272 + (32 * w) * 2 + tr_krw; \
            const bf16x8 bv = cat8(lds_tr(vb), lds_tr(vb + 8 * 272)); \
            o = __builtin_amdgcn_mfma_f32_32x32x16_bf16(pack8(pt, 8 * sp), bv, o, 0, 0, 0); } \
        _Pragma("unroll") for (int kb = 0; kb < 4; ++kb) _Pragma("unroll") for (int sp = 0; sp < 2; ++sp) { \
            const char* qb = B + QP_OFF + r * 272 + kb * 64 + sp * 32 + h * 8; \
            const bf16x8 aq = cat8(*(const s16x4*)qb, *(const s16x4*)(qb + 16)); \
            o = __builtin_amdgcn_mfma_f32_32x32x16_bf16(aq, pack8(S[kb], 8 * sp), o, 0, 0, 0); } \
        { float* ob_ = (float*)(smem + OB_OFF + ((c_) & 1) * OB_BYTES); _Pragma("unroll") for (int i = 0; i < 16; ++i) ob_[crow(i, h) * OB_STRIDE + 32 * w + r] = o[i]; } \
        bf16x8 bvn[2]; \
        _Pragma("unroll") for (int ks = 0; ks < 2; ++ks) { const char* vb = B + V_OFF + (16 * ks) * 272 + (32 * w) * 2 + tr_nat; bvn[ks] = cat8(lds_tr(vb), lds_tr(vb + 4 * 272)); } \
        _Pragma("unroll") for (int kb = 0; kb < 4; ++kb) { \
            _Pragma("unroll") for (int ks = 0; ks < 2; ++ks) { \
                const char* kp = B + KP_OFF + (16 * ks) * 272 + (32 * kb) * 2 + tr_nat; \
                const bf16x8 a = cat8(lds_tr(kp), lds_tr(kp + 4 * 272)); \
                S[kb] = __builtin_amdgcn_mfma_f32_32x32x16_bf16(a, bvn[ks], S[kb], 0, 0, 0); } \
            _Pragma("unroll") for (int j = 0; j < 4; ++j) { \
                const f32x4 g4 = *(const f32x4*)(B + G_OFF + (kb * 32 + 8 * j + 4 * h) * 4); \
                S[kb][4 * j] *= g4.x; S[kb][4 * j + 1] *= g4.y; S[kb][4 * j + 2] *= g4.z; S[kb][4 * j + 3] *= g4.w; } } }
    f32x4 nw0, nw1, nw2, nw3;
    nw0 = nw1 = nw2 = nw3 = (f32x4){0.f, 0.f, 0.f, 0.f};
    if (helper) { const float* nwp = p.hg_nw + hd * HDK + (ht & 7) * 16; nw0 = *(const f32x4*)nwp; nw1 = *(const f32x4*)(nwp + 4); nw2 = *(const f32x4*)(nwp + 8); nw3 = *(const f32x4*)(nwp + 12); }
#define HG_NORM(cc_) { const int t_ = ht >> 3, sg_ = ht & 7; \
        const float* ob_ = (const float*)(smem + OB_OFF + ((cc_) & 1) * OB_BYTES) + t_ * OB_STRIDE + sg_ * 16; \
        const f32x4 o0 = *(const f32x4*)ob_, o1 = *(const f32x4*)(ob_ + 4), o2 = *(const f32x4*)(ob_ + 8), o3 = *(const f32x4*)(ob_ + 12); \
        const u32x4 g0 = *(const u32x4*)(PG + (size_t)((cc_) * 32 + t_) * INC + sg_ * 16), g1 = *(const u32x4*)(PG + (size_t)((cc_) * 32 + t_) * INC + sg_ * 16 + 8); \
        float ss = (o0.x * o0.x + o0.y * o0.y + o0.z * o0.z + o0.w * o0.w) + (o1.x * o1.x + o1.y * o1.y + o1.z * o1.z + o1.w * o1.w) + (o2.x * o2.x + o2.y * o2.y + o2.z * o2.z + o2.w * o2.w) + (o3.x * o3.x + o3.y * o3.y + o3.z * o3.z + o3.w * o3.w); \
        ss += __shfl_xor(ss, 1); ss += __shfl_xor(ss, 2); ss += __shfl_xor(ss, 4); \
        const float rs_ = rsqrtf(ss * (1.0f / 128.0f) + RMS_EPS); \
        const f32x4 v0 = o0 * rs_ * nw0, v1 = o1 * rs_ * nw1, v2 = o2 * rs_ * nw2, v3 = o3 * rs_ * nw3; \
        u32x4 w0, w1; \
        w0.x = pack2(v0.x * bflo(g0.x), v0.y * bfhi(g0.x)); w0.y = pack2(v0.z * bflo(g0.y), v0.w * bfhi(g0.y)); w0.z = pack2(v1.x * bflo(g0.z), v1.y * bfhi(g0.z)); w0.w = pack2(v1.z * bflo(g0.w), v1.w * bfhi(g0.w)); \
        w1.x = pack2(v2.x * bflo(g1.x), v2.y * bfhi(g1.x)); w1.y = pack2(v2.z * bflo(g1.y), v2.w * bfhi(g1.y)); w1.z = pack2(v3.x * bflo(g1.z), v3.y * bfhi(g1.z)); w1.w = pack2(v3.z * bflo(g1.w), v3.w * bfhi(g1.w)); \
        bf16_t* dst_ = A2out + (size_t)((cc_) * 32 + t_) * DM + sg_ * 16; \
        *(u32x4*)dst_ = w0; *(u32x4*)(dst_ + 8) = w1; }
    for (int c = 0; c < 64; c += 2) {
        if (helper) { if (c + 2 < 64) HG_STORE(A, (c + 2) % 3); if (c + 4 < 64) HG_LOAD(A, c + 4); if (c > 0) HG_NORM(c - 1); } else HG_COMPUTE(c);
        __syncthreads();
        if (helper) { if (c + 3 < 64) HG_STORE(B, (c + 3) % 3); if (c + 5 < 64) HG_LOAD(B, c + 5); HG_NORM(c); } else HG_COMPUTE(c + 1);
        __syncthreads();
    }
    if (helper) HG_NORM(63);
    __syncthreads();
#undef HG_LOAD
#undef HG_STORE
#undef HG_COMPUTE
#undef HG_NORM
}
template <int NJ>
DI void s5_gemm2_tile(const bf16x8 (&af)[16], const bf16_t* KTl, const bf16_t* Xin, const bf16_t* MBg, bf16_t* Yout, bf16_t* stg, const int mi, const int r, const int h) {
    f32x16 y;
#pragma unroll
    for (int i = 0; i < 16; ++i) y[i] = 0.f;
    const int tsel = r >> 4, iq = r & 15;
    bf16x8 bm[8];
#pragma unroll
    for (int ks = 0; ks < 8; ++ks) bm[ks] = *(const bf16x8*)(MBg + (size_t)((NJ * 8 + ks) * 64 + h * 32 + r) * 8);
#pragma unroll
    for (int ks = 0; ks <= 2 * NJ; ++ks) {
        const bf16x8 bk = *(const bf16x8*)(KTl + ((2 * NJ + tsel - ks) * 16 + iq) * 16 + 8 * h);
        y = __builtin_amdgcn_mfma_f32_32x32x16_bf16(af[ks], bk, y, 0, 0, 0);
    }
    {
        bf16x8 bk = *(const bf16x8*)(KTl + iq * 16 + 8 * h);
        if (tsel == 0) bk = (bf16x8){0, 0, 0, 0, 0, 0, 0, 0};
        y = __builtin_amdgcn_mfma_f32_32x32x16_bf16(af[2 * NJ + 1], bk, y, 0, 0, 0);
    }
#pragma unroll
    for (int ks = 0; ks < 8; ++ks) {
        const bf16x8 a = *(const bf16x8*)(Xin + (mi * 32 + r) * 136 + ks * 16 + 8 * h);
        y = __builtin_amdgcn_mfma_f32_32x32x16_bf16(a, bm[ks], y, 0, 0, 0);
    }
#pragma unroll
    for (int i = 0; i < 16; ++i) stg[((crow(i, h) * 2 + tsel) * 16) + iq] = f2bf(gelu_as(y[i]));
    {
        const int lane = h * 32 + r, cl = lane >> 1, ts = lane & 1;
        const u32x4 lo = *(const u32x4*)(stg + lane * 16), hi = *(const u32x4*)(stg + lane * 16 + 8);
        bf16_t* dst = Yout + (size_t)((mi * 32 + cl) * 16 + 2 * NJ + ts) * DSS;
        *(u32x4*)dst = lo; *(u32x4*)(dst + 8) = hi;
    }
}
DI void s5_gemm_item(const Params& p, int b, int g, char* smem) {
    float* E = (float*)smem;
    bf16_t* Xin = (bf16_t*)(smem + 128 * 132 * 4);
    bf16_t* KTl = Xin + 128 * 136;
    const int tid = my_tid(), lane = tid & 63, wid = tid >> 6, r = lane & 31, h = lane >> 5;
    const int mi = wid >> 1, wh = wid & 1;
    const bf16_t* P = (const bf16_t*)(p.ws + OFF_PROJ);
    *(u32x4*)(KTl + tid * 8) = *(const u32x4*)((const bf16_t*)(p.ws + OFF_S5K) + (size_t)g * 4096 + tid * 8);
    bf16x8 af[16];
    {
        const bf16_t* ub = P + (size_t)(b * SEQ + (mi * 32 + r) * 16) * INC + 2048 + g * 16 + 8 * h;
#pragma unroll
        for (int ks = 0; ks < 16; ++ks) af[ks] = *(const bf16x8*)(ub + (size_t)ks * INC);
    }
#ifndef S5_REP_G1
#define S5_REP_G1 1
#define S5_REP_SC 1
#define S5_REP_G2 1
#endif
    for (int rp1 = 0; rp1 < S5_REP_G1; ++rp1)
    {
        f32x16 e0, e1;
#pragma unroll
        for (int i = 0; i < 16; ++i) { e0[i] = 0.f; e1[i] = 0.f; }
        const bf16_t* nb0 = (const bf16_t*)(p.ws + OFF_S5N) + (size_t)g * 128 * 256 + (size_t)(wh * 2) * 16 * 512 + lane * 8;
#pragma unroll
        for (int ks = 0; ks < 16; ++ks) {
            const bf16x8 b0 = *(const bf16x8*)(nb0 + ks * 512), b1 = *(const bf16x8*)(nb0 + 16 * 512 + ks * 512);
            e0 = __builtin_amdgcn_mfma_f32_32x32x16_bf16(af[ks], b0, e0, 0, 0, 0);
            e1 = __builtin_amdgcn_mfma_f32_32x32x16_bf16(af[ks], b1, e1, 0, 0, 0);
        }
#pragma unroll
        for (int i = 0; i < 16; ++i) { float* er = E + (mi * 32 + crow(i, h)) * 132 + wh * 64 + r; er[0] = e0[i]; er[32] = e1[i]; }
    }
    __syncthreads();
    for (int rp2 = 0; rp2 < S5_REP_SC; ++rp2)
    if (wid == 0) {
        const float* L = (const float*)(p.ws + OFF_S5L) + (g * 64 + lane) * 2;
        const float lr = L[0], li = L[1];
        float xr = 0.f, xi = 0.f;
#pragma unroll 8
        for (int c = 0; c < 128; ++c) {
            const float er = E[c * 132 + lane], ei = E[c * 132 + 64 + lane];
            Xin[c * 136 + lane] = f2bf(xr); Xin[c * 136 + 64 + lane] = f2bf(xi);
            const float nr = lr * xr - li * xi + er, ni = lr * xi + li * xr + ei;
            xr = nr; xi = ni;
        }
    }
    __syncthreads();
    const bf16_t* MBg = (const bf16_t*)(p.ws + OFF_S5M) + (size_t)g * 256 * 128;
    bf16_t* Yout = (bf16_t*)(p.ws + OFF_YSSM) + (size_t)b * SEQ * DSS + g * 16;
    bf16_t* stg = (bf16_t*)smem + wid * 1024;
    for (int rp3 = 0; rp3 < S5_REP_G2; ++rp3)
    if (wh) {
        s5_gemm2_tile<1>(af, KTl, Xin, MBg, Yout, stg, mi, r, h); s5_gemm2_tile<6>(af, KTl, Xin, MBg, Yout, stg, mi, r, h);
        s5_gemm2_tile<3>(af, KTl, Xin, MBg, Yout, stg, mi, r, h); s5_gemm2_tile<4>(af, KTl, Xin, MBg, Yout, stg, mi, r, h);
    } else {
        s5_gemm2_tile<0>(af, KTl, Xin, MBg, Yout, stg, mi, r, h); s5_gemm2_tile<7>(af, KTl, Xin, MBg, Yout, stg, mi, r, h);
        s5_gemm2_tile<2>(af, KTl, Xin, MBg, Yout, stg, mi, r, h); s5_gemm2_tile<5>(af, KTl, Xin, MBg, Yout, stg, mi, r, h);
    }
    __syncthreads();
}
DI void phase_mix(const Params& p, int bid, int nb, char* smem) {
    if (nb == 256) {
#ifndef PROBE_HGX
#define PROBE_HGX 1
#endif
        if (bid < 64) { for (int rep = 0; rep < PROBE_HGX; ++rep) hgrn_mfma_item(p, bid, smem); return; }
        const int j = bid - 64, x = j & 7, lb = j >> 3;
#ifndef PROBE_S5X
#define PROBE_S5X 1
#endif
        for (int rep = 0; rep < PROBE_S5X; ++rep)
        for (int q = lb; q < 64; q += 24) s5_gemm_item(p, q & 15, x * 4 + (q >> 4), smem);
    } else {
        for (int it = bid; it < 64; it += nb) hgrn_mfma_item(p, it, smem);
        for (int q = bid; q < 512; q += nb) s5_gemm_item(p, q & 15, q >> 4, smem);
    }
}

DI void phase_glu(const Params& p, int bid, int nb, char* smem) {
    pg8::Gemm g{(const bf16_t*)(p.ws + OFF_YSSM), (const bf16_t*)(p.ws + OFF_GLU), NTOK, 512, 512};
    pg8::StaticOrder S; S.init(NTOK, 512, nb, bid);
    pg8::EpiGluA2 E{(bf16_t*)(p.ws + OFF_A2), (const bf16_t*)(p.ws + OFF_YSSM), p.glu_b, p.ssm_nw, (float*)(p.ws + OFF_STAT) + 2 * NTOK};
    pg8::gemm_phase<pg8::EpiGluA2, pg8::StaticOrder, false>((PG8_LAS unsigned char*)smem, g, S, E, nullptr);
}
DI void phase_a2(const Params& p, int bid, int nb) {
    const float* Y2 = (const float*)(p.ws + OFF_H);
    const bf16_t* P = (const bf16_t*)(p.ws + OFF_PROJ);
    bf16_t* A2 = (bf16_t*)(p.ws + OFF_A2);
    const int lane = my_tid() & 63, wid = my_tid() >> 6;
    for (int tok = bid * 8 + wid; tok < NTOK; tok += nb * 8) {
        const int c0 = lane * 8;
        {
            const float4 a = *(const float4*)(Y2 + (size_t)tok * DSS + c0), b = *(const float4*)(Y2 + (size_t)tok * DSS + c0 + 4);
            float ss = a.x * a.x + a.y * a.y + a.z * a.z + a.w * a.w + b.x * b.x + b.y * b.y + b.z * b.z + b.w * b.w;
#pragma unroll
            for (int m = 1; m < 64; m <<= 1) ss += __shfl_xor(ss, m);
            const float rs = rsqrtf(ss * (1.0f / 512.0f) + RMS_EPS);
            const float4 w0 = *(const float4*)(p.ssm_nw + c0), w1 = *(const float4*)(p.ssm_nw + c0 + 4);
            uint4 o;
            o.x = pack2(a.x * rs * w0.x, a.y * rs * w0.y); o.y = pack2(a.z * rs * w0.z, a.w * rs * w0.w);
            o.z = pack2(b.x * rs * w1.x, b.y * rs * w1.y); o.w = pack2(b.z * rs * w1.z, b.w * rs * w1.w);
            *(uint4*)(A2 + (size_t)tok * DM + 512 + c0) = o;
        }
    }
}

DI void phase_outproj(const Params& p, int bid, int nb, char* smem) {
    pg8::Gemm g{(const bf16_t*)(p.ws + OFF_A2), (const bf16_t*)(p.ws + OFF_WOUT), NTOK, DM, DM};
    pg8::StaticOrder S; S.init(NTOK, DM, nb, bid);
    pg8::EpiResid E{(bf16_t*)(p.ws + OFF_R1), p.x, (const float*)(p.ws + OFF_MOD) + 2048, DEEP_ALPHA, (bf16_t*)(p.ws + OFF_H), (const float*)(p.ws + OFF_AB), (float*)(p.ws + OFF_STAT), (const float*)(p.ws + OFF_STAT) + 2 * NTOK, RMS_EPS};
    pg8::gemm_phase<pg8::EpiResid, pg8::StaticOrder, false>((PG8_LAS unsigned char*)smem, g, S, E, nullptr);
}
DI void phase_ln1(const Params& p, int bid, int nb) {
    const float* mod = (const float*)(p.ws + OFF_MOD);
    bf16_t* H2 = (bf16_t*)(p.ws + OFF_H);
    const int lane = my_tid() & 63, wid = my_tid() >> 6;
    for (int tok = bid * 8 + wid; tok < NTOK; tok += nb * 8) {
        const int b = tok / SEQ;
        float* row = p.out + (size_t)tok * DM;
        float4 v[4];
        float s = 0.f;
#pragma unroll
        for (int j = 0; j < 4; ++j) { v[j] = *(const float4*)(row + j * 256 + lane * 4); s += v[j].x + v[j].y + v[j].z + v[j].w; }
#pragma unroll
        for (int m = 1; m < 64; m <<= 1) s += __shfl_xor(s, m);
        const float mu = s * (1.0f / 1024.0f);
        float q = 0.f;
#pragma unroll
        for (int j = 0; j < 4; ++j) { const float a = v[j].x - mu, bb = v[j].y - mu, cc = v[j].z - mu, d = v[j].w - mu; q += a * a + bb * bb + cc * cc + d * d; }
#pragma unroll
        for (int m = 1; m < 64; m <<= 1) q += __shfl_xor(q, m);
        const float rstd = rsqrtf(q * (1.0f / 1024.0f) + LN_EPS);
        const float* sh2 = mod + b * 6144 + 3072;
        const float* sc2 = mod + b * 6144 + 4096;
#pragma unroll
        for (int j = 0; j < 4; ++j) {
            const int c = j * 256 + lane * 4;
            const float4 w = *(const float4*)(p.ln1w + c), bi = *(const float4*)(p.ln1b + c), sc = *(const float4*)(sc2 + c), sh = *(const float4*)(sh2 + c);
            float4 o;
            o.x = (v[j].x - mu) * rstd * w.x + bi.x; o.y = (v[j].y - mu) * rstd * w.y + bi.y; o.z = (v[j].z - mu) * rstd * w.z + bi.z; o.w = (v[j].w - mu) * rstd * w.w + bi.w;
            *(float4*)(row + c) = o;
            uint2 hh; hh.x = pack2(o.x * (1.f + sc.x) + sh.x, o.y * (1.f + sc.y) + sh.y); hh.y = pack2(o.z * (1.f + sc.z) + sh.z, o.w * (1.f + sc.w) + sh.w);
            *(uint2*)(H2 + (size_t)tok * DM + c) = hh;
        }
    }
}

DI void phase_q(const Params& p, int bid, int nb, char* smem) {
    pg8::Gemm g{(const bf16_t*)(p.ws + OFF_H), (const bf16_t*)(p.ws + OFF_WQ), NTOK, 2048, DM};
    pg8::StaticOrder S; S.init(NTOK, 2048, nb, bid);
    pg8::EpiQLN E{(bf16_t*)(p.ws + OFF_PROJ), (const float*)(p.ws + OFF_STAT), (const float*)(p.ws + OFF_CAB), (const float*)(p.ws + OFF_CAB) + NB * 2048, LN_EPS};
    pg8::gemm_phase<pg8::EpiQLN, pg8::StaticOrder, false>((PG8_LAS unsigned char*)smem, g, S, E, nullptr);
}
DI void phase_topk(const Params& p, int bid, int nb, char* smem) {
    const bf16_t* Q = (const bf16_t*)(p.ws + OFF_PROJ);
    const bf16_t* SK = (const bf16_t*)(p.ws + OFF_SUBK);
    unsigned* TOPL = (unsigned*)(p.ws + OFF_TOPL);
    float* sc = (float*)(smem + 36864);
    constexpr int NTM = NTOK / 128;
    for (int t = bid; t < NTM * 16; t += nb) {
        const int mt = t >> 4, hp = t & 15;
        gemm_block<2, 1, 2, 4>(Q + (size_t)mt * 128 * 2048 + hp * 128, 2048, SK + (size_t)hp * 128 * 128, 128, 128, smem,
                               [&](int r, int c, float v) { sc[r * 129 + c] = v; });
        __syncthreads();
        if (my_tid() < 128) {
            const int r = my_tid();
            float tk[16];
#pragma unroll
            for (int j = 0; j < 16; ++j) tk[j] = -3.0e38f;
            for (int n = 0; n < 128; ++n) {
                float xv = __uint_as_float((__float_as_uint(sc[r * 129 + n]) & ~0x7fu) | (unsigned)n);
#pragma unroll
                for (int j = 0; j < 16; ++j) { const float hi = fmaxf(tk[j], xv), lo = fminf(tk[j], xv); tk[j] = hi; xv = lo; }
            }
            uint4* dst = (uint4*)(TOPL + ((size_t)(mt * 128 + r) * 16 + hp) * 16);
            dst[0] = make_uint4(__float_as_uint(tk[0]), __float_as_uint(tk[1]), __float_as_uint(tk[2]), __float_as_uint(tk[3]));
            dst[1] = make_uint4(__float_as_uint(tk[4]), __float_as_uint(tk[5]), __float_as_uint(tk[6]), __float_as_uint(tk[7]));
            dst[2] = make_uint4(__float_as_uint(tk[8]), __float_as_uint(tk[9]), __float_as_uint(tk[10]), __float_as_uint(tk[11]));
            dst[3] = make_uint4(__float_as_uint(tk[12]), __float_as_uint(tk[13]), __float_as_uint(tk[14]), __float_as_uint(tk[15]));
        }
        __syncthreads();
    }
}
DI void phase_combine(const Params& p, int bid, int nb) {
    const unsigned* TOPL = (const unsigned*)(p.ws + OFF_TOPL);
    uint2* EX = (uint2*)(p.ws + OFF_EXPS);
    const float* SU = (const float*)(p.ws + OFF_SU);
    const float* SV = (const float*)(p.ws + OFF_SV);
    for (int i = bid * NTH + my_tid(); i < NTOK * PHEADS; i += nb * NTH) {
        const unsigned* l1 = TOPL + (size_t)i * 32;
        const unsigned* l2 = l1 + 16;
        float s2[16];
        {
            const uint4 a = ((const uint4*)l2)[0], b = ((const uint4*)l2)[1], c = ((const uint4*)l2)[2], d = ((const uint4*)l2)[3];
            const unsigned w[16] = {a.x, a.y, a.z, a.w, b.x, b.y, b.z, b.w, c.x, c.y, c.z, c.w, d.x, d.y, d.z, d.w};
#pragma unroll
            for (int j = 0; j < 16; ++j) s2[j] = __uint_as_float(w[j] & ~0x7fu);
        }
        float tk[16];
#pragma unroll
        for (int j = 0; j < 16; ++j) tk[j] = -3.0e38f;
        for (int a = 0; a < 16; ++a) {
            const float s1 = __uint_as_float(l1[a] & ~0x7fu);
#pragma unroll
            for (int b = 0; b < 16; ++b) {
                float xv = __uint_as_float((__float_as_uint(s1 + s2[b]) & ~0xffu) | (unsigned)(a * 16 + b));
#pragma unroll
                for (int j = 0; j < 16; ++j) { const float hi = fmaxf(tk[j], xv), lo = fminf(tk[j], xv); tk[j] = hi; xv = lo; }
            }
        }
        float e[16], sum = 0.f;
        const float mx = __uint_as_float(__float_as_uint(tk[0]) & ~0xffu);
#pragma unroll
        for (int j = 0; j < 16; ++j) { e[j] = __expf(__uint_as_float(__float_as_uint(tk[j]) & ~0xffu) - mx); sum += e[j]; }
        const float inv = 1.0f / sum;
#pragma unroll
        for (int j = 0; j < 16; ++j) {
            const unsigned ab = __float_as_uint(tk[j]) & 0xffu;
            const unsigned i1 = l1[ab >> 4] & 0x7fu, i2 = l2[ab & 15] & 0x7fu;
            const unsigned eid = i1 * 128u + i2;
            EX[(size_t)i * 16 + j] = make_uint2(eid | (((__float_as_uint(SU[eid]) >> 23) & 0xffu) << 16), __float_as_uint(e[j] * inv * SV[eid]));
        }
    }
}

DI void ce_desc(float& a, float& b) { const float hi = fmaxf(a, b), lo = fminf(a, b); a = hi; b = lo; }
template <int N> DI void bitonic_sort_desc(float (&v)[N]) {
#pragma unroll
    for (int k = 2; k <= N; k <<= 1)
#pragma unroll
        for (int j = k >> 1; j > 0; j >>= 1)
#pragma unroll
            for (int i = 0; i < N; ++i) { const int l = i ^ j; if (l > i) { if ((i & k) == 0 || k == N) ce_desc(v[i], v[l]); else ce_desc(v[l], v[i]); } }
}
DI void merge_top16(float (&a)[16], const float (&b)[16]) {
#pragma unroll
    for (int i = 0; i < 16; ++i) a[i] = fmaxf(a[i], b[15 - i]);
#pragma unroll
    for (int j = 8; j > 0; j >>= 1)
#pragma unroll
        for (int i = 0; i < 16; ++i) { const int l = i ^ j; if (l > i) ce_desc(a[i], a[l]); }
}
DI void xlane_merge16(float (&a)[16]) {
    float o[16];
#pragma unroll
    for (int i = 0; i < 16; ++i) o[i] = __shfl_xor(a[i], 32);
    merge_top16(a, o);
}
DI void retrieve_topk_hp(const bf16_t* Q, const char* skl, const int tok, const int hp_next, const int r, const int h, unsigned char* lutp, float (&out)[16], bf16x8 (&bq)[8]) {
                f32x16 acc[4];
#pragma unroll
                for (int mi = 0; mi < 4; ++mi)
#pragma unroll
                    for (int i = 0; i < 16; ++i) acc[mi][i] = 0.f;
                const char* kb = skl + r * 272 + h * 16;
#pragma unroll
                for (int ks = 0; ks < 8; ++ks) {
#pragma unroll
                    for (int mi = 0; mi < 4; ++mi) {
                        const bf16x8 a = *(const bf16x8*)(kb + mi * 32 * 272 + ks * 32);
                        acc[mi] = __builtin_amdgcn_mfma_f32_32x32x16_bf16(a, bq[ks], acc[mi], 0, 0, 0);
                    }
                }
                {
                    const bf16_t* qb = Q + (size_t)tok * 2048 + hp_next * 128 + 8 * h;
#pragma unroll
                    for (int ks = 0; ks < 8; ++ks) bq[ks] = *(const bf16x8*)(qb + ks * 16);
                }
                float v0[16], v1[16], v2[16], v3[16];
#pragma unroll
                for (int i = 0; i < 16; ++i) {
                    const unsigned n = (unsigned)crow(i, h);
                    v0[i] = __uint_as_float((__float_as_uint(acc[0][i]) & ~0x7fu) | n);
                    v1[i] = __uint_as_float((__float_as_uint(acc[1][i]) & ~0x7fu) | (n + 32u));
                    v2[i] = __uint_as_float((__float_as_uint(acc[2][i]) & ~0x7fu) | (n + 64u));
                    v3[i] = __uint_as_float((__float_as_uint(acc[3][i]) & ~0x7fu) | (n + 96u));
                }
                bitonic_sort_desc<16>(v0); bitonic_sort_desc<16>(v1); bitonic_sort_desc<16>(v2); bitonic_sort_desc<16>(v3);
                merge_top16(v0, v1); merge_top16(v2, v3); merge_top16(v0, v2);
                xlane_merge16(v0);
#pragma unroll
                for (int i = 0; i < 16; ++i) out[i] = v0[i];
                u32x4 ix;
                ix.x = (__float_as_uint(v0[0]) & 0x7fu) | ((__float_as_uint(v0[1]) & 0x7fu) << 8) | ((__float_as_uint(v0[2]) & 0x7fu) << 16) | ((__float_as_uint(v0[3]) & 0x7fu) << 24);
                ix.y = (__float_as_uint(v0[4]) & 0x7fu) | ((__float_as_uint(v0[5]) & 0x7fu) << 8) | ((__float_as_uint(v0[6]) & 0x7fu) << 16) | ((__float_as_uint(v0[7]) & 0x7fu) << 24);
                ix.z = (__float_as_uint(v0[8]) & 0x7fu) | ((__float_as_uint(v0[9]) & 0x7fu) << 8) | ((__float_as_uint(v0[10]) & 0x7fu) << 16) | ((__float_as_uint(v0[11]) & 0x7fu) << 24);
                ix.w = (__float_as_uint(v0[12]) & 0x7fu) | ((__float_as_uint(v0[13]) & 0x7fu) << 8) | ((__float_as_uint(v0[14]) & 0x7fu) << 16) | ((__float_as_uint(v0[15]) & 0x7fu) << 24);
                *(u32x4*)lutp = ix;
}
DI void phase_retrieve(const Params& p, int bid, int nb, char* smem) {
    const bf16_t* Q = (const bf16_t*)(p.ws + OFF_PROJ);
    const bf16_t* SK = (const bf16_t*)(p.ws + OFF_SUBK);
    const float* SU = (const float*)(p.ws + OFF_SU);
    const float* SV = (const float*)(p.ws + OFF_SV);
    uint2* EX = (uint2*)(p.ws + OFF_EXPS);
    const int tid = my_tid(), lane = tid & 63, wid = tid >> 6, r = lane & 31, h = lane >> 5;
    unsigned char* lut = (unsigned char*)smem + wid * 2048 + lane * 32;
    char* skb0 = smem + 16384;
    char* skb1 = skb0 + 128 * 272;
    u32x4 sr0, sr1, sr2, sr3;
#define SK_LOAD(hp_) { const bf16_t* g_ = SK + (size_t)(hp_) * 16384 + tid * 8; sr0 = *(const u32x4*)g_; sr1 = *(const u32x4*)(g_ + 4096); sr2 = *(const u32x4*)(g_ + 8192); sr3 = *(const u32x4*)(g_ + 12288); }
#define SK_STORE(buf_) { char* d_ = (buf_) + (tid >> 4) * 272 + (tid & 15) * 16; *(u32x4*)d_ = sr0; *(u32x4*)(d_ + 32 * 272) = sr1; *(u32x4*)(d_ + 64 * 272) = sr2; *(u32x4*)(d_ + 96 * 272) = sr3; }
    for (int it = bid; it < (NTOK / 256) * 2; it += nb) {
        const int hq = it & 1, tok = (it >> 1) * 256 + wid * 32 + r;
        __syncthreads();
        SK_LOAD(hq * 8); SK_STORE(skb0);
        bf16x8 bq[8];
        {
            const bf16_t* qb = Q + (size_t)tok * 2048 + (hq * 8) * 128 + 8 * h;
#pragma unroll
            for (int ks = 0; ks < 8; ++ks) bq[ks] = *(const bf16x8*)(qb + ks * 16);
        }
        __syncthreads();
#pragma unroll 1
        for (int hd = hq * 4; hd < hq * 4 + 4; ++hd) {
            float L0[16], L1[16];
            SK_LOAD(hd * 2 + 1);
            retrieve_topk_hp(Q, skb0, tok, hd * 2 + 1, r, h, lut, L0, bq);
            SK_STORE(skb1);
            __syncthreads();
            if (hd + 1 < hq * 4 + 4) SK_LOAD(hd * 2 + 2);
            retrieve_topk_hp(Q, skb1, tok, (hd + 1 < hq * 4 + 4) ? hd * 2 + 2 : hd * 2 + 1, r, h, lut + 16, L1, bq);
            if (hd + 1 < hq * 4 + 4) SK_STORE(skb0);
            __syncthreads();
            float c[32];
            {
                constexpr int PA[50] = {0, 0, 0, 0, 0, 0, 0, 0, 0, 0, 0, 0, 0, 0, 0, 0, 1, 1, 1, 1, 1, 1, 1, 1, 2, 2, 2, 2, 2, 3, 3, 3, 3, 4, 4, 4, 5, 5, 6, 6, 7, 7, 8, 9, 10, 11, 12, 13, 14, 15};
                constexpr int PB[50] = {0, 1, 2, 3, 4, 5, 6, 7, 8, 9, 10, 11, 12, 13, 14, 15, 0, 1, 2, 3, 4, 5, 6, 7, 0, 1, 2, 3, 4, 0, 1, 2, 3, 0, 1, 2, 0, 1, 0, 1, 0, 1, 0, 0, 0, 0, 0, 0, 0, 0};
#pragma unroll
                for (int q = 0; q < 25; ++q) {
                    const float s0 = __uint_as_float(__float_as_uint(L0[PA[2 * q]]) & ~0x7fu) + __uint_as_float(__float_as_uint(L1[PB[2 * q]]) & ~0x7fu);
                    const float s1 = __uint_as_float(__float_as_uint(L0[PA[2 * q + 1]]) & ~0x7fu) + __uint_as_float(__float_as_uint(L1[PB[2 * q + 1]]) & ~0x7fu);
                    const float p0 = __uint_as_float((__float_as_uint(s0) & ~0xffu) | (unsigned)(PA[2 * q] * 16 + PB[2 * q]));
                    const float p1 = __uint_as_float((__float_as_uint(s1) & ~0xffu) | (unsigned)(PA[2 * q + 1] * 16 + PB[2 * q + 1]));
                    c[q] = h ? p1 : p0;
                }
#pragma unroll
                for (int i = 25; i < 32; ++i) c[i] = -3.0e38f;
            }
            bitonic_sort_desc<32>(c);
            float t16[16];
#pragma unroll
            for (int i = 0; i < 16; ++i) t16[i] = c[i];
            xlane_merge16(t16);
            const float mx = __uint_as_float(__float_as_uint(t16[0]) & ~0xffu);
            float e[16], sum = 0.f;
#pragma unroll
            for (int j = 0; j < 16; ++j) { e[j] = __expf(__uint_as_float(__float_as_uint(t16[j]) & ~0xffu) - mx); sum += e[j]; }
            const float inv = 1.0f / sum;
            uint2* dst = EX + ((size_t)tok * 8 + hd) * 16 + 8 * h;
#pragma unroll
            for (int j = 0; j < 8; ++j) {
                float tlo = t16[j], thi = t16[8 + j], elo = e[j], ehi = e[8 + j];
                asm volatile("" : "+v"(tlo), "+v"(thi), "+v"(elo), "+v"(ehi));
                const float tv = h ? thi : tlo, ev = h ? ehi : elo;
                const unsigned ab = __float_as_uint(tv) & 0xffu;
                const unsigned eid = (unsigned)lut[ab >> 4] * 128u + (unsigned)lut[16 + (ab & 15u)];
                dst[j] = make_uint2(eid | (pack2(0.f, SU[eid]) & 0xffff0000u), __float_as_uint(ev * inv * SV[eid]));
            }
        }
    }
#undef SK_LOAD
#undef SK_STORE
}

DI float dot16_fp8(const u32x4 w, const f32x2 (&h)[8]) {
    f32x2 acc = __builtin_amdgcn_cvt_pk_f32_fp8((int)w.x, false) * h[0];
    acc += __builtin_amdgcn_cvt_pk_f32_fp8((int)w.x, true) * h[1];
    acc += __builtin_amdgcn_cvt_pk_f32_fp8((int)w.y, false) * h[2];
    acc += __builtin_amdgcn_cvt_pk_f32_fp8((int)w.y, true) * h[3];
    acc += __builtin_amdgcn_cvt_pk_f32_fp8((int)w.z, false) * h[4];
    acc += __builtin_amdgcn_cvt_pk_f32_fp8((int)w.z, true) * h[5];
    acc += __builtin_amdgcn_cvt_pk_f32_fp8((int)w.w, false) * h[6];
    acc += __builtin_amdgcn_cvt_pk_f32_fp8((int)w.w, true) * h[7];
    return acc.x + acc.y;
}
DI void axpy16_fp8(const float a, const u32x4 w, f32x2 (&o)[8]) {
    const f32x2 aa = {a, a};
    o[0] += aa * __builtin_amdgcn_cvt_pk_f32_fp8((int)w.x, false); o[1] += aa * __builtin_amdgcn_cvt_pk_f32_fp8((int)w.x, true);
    o[2] += aa * __builtin_amdgcn_cvt_pk_f32_fp8((int)w.y, false); o[3] += aa * __builtin_amdgcn_cvt_pk_f32_fp8((int)w.y, true);
    o[4] += aa * __builtin_amdgcn_cvt_pk_f32_fp8((int)w.z, false); o[5] += aa * __builtin_amdgcn_cvt_pk_f32_fp8((int)w.z, true);
    o[6] += aa * __builtin_amdgcn_cvt_pk_f32_fp8((int)w.w, false); o[7] += aa * __builtin_amdgcn_cvt_pk_f32_fp8((int)w.w, true);
}
DI float butterfly64(float (&pz)[64], const int lane) {
    const bool b5 = lane & 32, b4 = lane & 16, b3 = lane & 8, b2 = lane & 4, b1 = lane & 2, b0 = lane & 1;
    float q32[32], q16[16], q8[8], q4[4], q2[2];
#pragma unroll
    for (int j = 0; j < 32; ++j) q32[j] = (b5 ? pz[32 + j] : pz[j]) + __shfl_xor(b5 ? pz[j] : pz[32 + j], 32);
#pragma unroll
    for (int j = 0; j < 16; ++j) q16[j] = (b4 ? q32[16 + j] : q32[j]) + __shfl_xor(b4 ? q32[j] : q32[16 + j], 16);
#pragma unroll
    for (int j = 0; j < 8; ++j) q8[j] = (b3 ? q16[8 + j] : q16[j]) + __shfl_xor(b3 ? q16[j] : q16[8 + j], 8);
#pragma unroll
    for (int j = 0; j < 4; ++j) q4[j] = (b2 ? q8[4 + j] : q8[j]) + __shfl_xor(b2 ? q8[j] : q8[4 + j], 4);
#pragma unroll
    for (int j = 0; j < 2; ++j) q2[j] = (b1 ? q4[2 + j] : q4[j]) + __shfl_xor(b1 ? q4[j] : q4[2 + j], 2);
    return (b0 ? q2[1] : q2[0]) + __shfl_xor(b0 ? q2[0] : q2[1], 1);
}
DI float bfly8(float (&pz)[8], const int lane) {
    const bool b2 = lane & 4, b1 = lane & 2, b0 = lane & 1;
    float q4[4], q2[2];
#pragma unroll
    for (int i = 0; i < 4; ++i) q4[i] = (b2 ? pz[4 + i] : pz[i]) + __shfl_xor(b2 ? pz[i] : pz[4 + i], 4);
#pragma unroll
    for (int i = 0; i < 2; ++i) q2[i] = (b1 ? q4[2 + i] : q4[i]) + __shfl_xor(b1 ? q4[i] : q4[2 + i], 2);
    float q = (b0 ? q2[1] : q2[0]) + __shfl_xor(b0 ? q2[0] : q2[1], 1);
    q += __shfl_xor(q, 8); q += __shfl_xor(q, 16); q += __shfl_xor(q, 32);
    return q;
}
DI float bfly16(float (&pz)[16], const int lane) {
    const bool b3 = lane & 8, b2 = lane & 4, b1 = lane & 2, b0 = lane & 1;
    float q8[8], q4[4], q2[2];
#pragma unroll
    for (int i = 0; i < 8; ++i) q8[i] = (b3 ? pz[8 + i] : pz[i]) + __shfl_xor(b3 ? pz[i] : pz[8 + i], 8);
#pragma unroll
    for (int i = 0; i < 4; ++i) q4[i] = (b2 ? q8[4 + i] : q8[i]) + __shfl_xor(b2 ? q8[i] : q8[4 + i], 4);
#pragma unroll
    for (int i = 0; i < 2; ++i) q2[i] = (b1 ? q4[2 + i] : q4[i]) + __shfl_xor(b1 ? q4[i] : q4[2 + i], 2);
    float q = (b0 ? q2[1] : q2[0]) + __shfl_xor(b0 ? q2[0] : q2[1], 1);
    q += __shfl_xor(q, 16); q += __shfl_xor(q, 32);
    return q;
}
DI void gs_issue(const __amdgpu_buffer_rsrc_t T, const uint2* ent, const unsigned d, const int lane, u32x4 (&w)[8], unsigned& ca) {
    const int cnt = (int)((d >> 16) & 0xfu), k = lane & 7;
    const uint2 e = ent[(d & 0xffffu) + (unsigned)(k < cnt ? k : cnt - 1)];
    ca = (k < cnt && !(d >> 31)) ? e.y : 0u;
#pragma unroll
    for (int q = 0; q < 8; ++q) {
        const int eid = __builtin_amdgcn_readlane((int)e.x, q) & 0x3fff;
        w[q] = __builtin_amdgcn_raw_buffer_load_b128(T, lane * 16, eid * DM, 0);
    }
}
DI float dot16_i8(const u32x4 w, const u32x4 h) {
    int acc = __builtin_amdgcn_sdot4((int)w.x, (int)h.x, 0, false);
    acc = __builtin_amdgcn_sdot4((int)w.y, (int)h.y, acc, false);
    acc = __builtin_amdgcn_sdot4((int)w.z, (int)h.z, acc, false);
    acc = __builtin_amdgcn_sdot4((int)w.w, (int)h.w, acc, false);
    return (float)acc;
}
DI void gs_desc(const uint2* ent, const unsigned d, const int lane, unsigned& ex) {
    const int cnt = (int)((d >> 16) & 0xfu), k = lane & 7;
    ex = ent[(d & 0xffffu) + (unsigned)(k < cnt ? k : cnt - 1)].x;
}
DI void gs_loads(const __amdgpu_buffer_rsrc_t T, const unsigned ex, const int lane, u32x4 (&w)[8]) {
#pragma unroll
    for (int q = 0; q < 8; ++q) {
        const int eid = __builtin_amdgcn_readlane((int)ex, q) & 0x3fff;
        w[q] = __builtin_amdgcn_raw_buffer_load_b128(T, lane * 16, eid * DM, 0);
    }
}
DI void gs_upartial(const u32x4 (&w)[8], const u32x4 h2q, float (&pz)[16], const int base) {
#pragma unroll
    for (int k = 0; k < 8; ++k) pz[base + k] = dot16_i8(w[k], h2q);
}
DI void gs_ustore(float (&pz)[16], float* zb, const unsigned da, const unsigned db, const int lane) {
    const float z = bfly16(pz, lane);
    const unsigned d = (lane & 8) ? db : da;
    const int k = lane & 7;
    if (lane < 16 && k < (int)((d >> 16) & 0xfu) && !(d >> 31)) zb[(d & 0xffffu) + k] = z;
}
DI void axpy16_u8(const float a, const u32x4 w, float (&o)[16]) {
    o[0] += a * (float)(w.x & 0xffu); o[1] += a * (float)((w.x >> 8) & 0xffu); o[2] += a * (float)((w.x >> 16) & 0xffu); o[3] += a * (float)(w.x >> 24);
    o[4] += a * (float)(w.y & 0xffu); o[5] += a * (float)((w.y >> 8) & 0xffu); o[6] += a * (float)((w.y >> 16) & 0xffu); o[7] += a * (float)(w.y >> 24);
    o[8] += a * (float)(w.z & 0xffu); o[9] += a * (float)((w.z >> 8) & 0xffu); o[10] += a * (float)((w.z >> 16) & 0xffu); o[11] += a * (float)(w.z >> 24);
    o[12] += a * (float)(w.w & 0xffu); o[13] += a * (float)((w.w >> 8) & 0xffu); o[14] += a * (float)((w.w >> 16) & 0xffu); o[15] += a * (float)(w.w >> 24);
}
DI void gs_vcompute(const u32x4 (&w)[8], const unsigned ca, float (&acc)[16]) {
#pragma unroll
    for (int k = 0; k < 8; ++k) { axpy16_u8(__uint_as_float((unsigned)__builtin_amdgcn_readlane((int)ca, k)), w[k], acc); __builtin_amdgcn_sched_barrier(0); }
}
constexpr int GT = 4;
constexpr int NSL = 4, SLSH = 12;
DI void xcd_pace(unsigned* cnt, const unsigned nloc, unsigned& step) {
    __syncthreads();
    if (__builtin_amdgcn_workitem_id_x() == 0) {
        __hip_atomic_fetch_add(cnt, 1u, __ATOMIC_RELAXED, __HIP_MEMORY_SCOPE_AGENT);
        const unsigned target = nloc * (step + 1u);
        unsigned sp = 0;
        while (__hip_atomic_load(cnt, __ATOMIC_RELAXED, __HIP_MEMORY_SCOPE_AGENT) < target) { __builtin_amdgcn_s_sleep(1); if (++sp > (1u << 22)) break; }
    }
    ++step;
    __syncthreads();
}
DI void phase_gather(const Params& p, int bid, int nb, char* smem, unsigned* pace_cnt, const unsigned pace_n) {
    unsigned pstep = 0;
    const float* mod = (const float*)(p.ws + OFF_MOD);
    const float* AB = (const float*)(p.ws + OFF_AB);
    const float* STAT = (const float*)(p.ws + OFF_STAT);
    const uint2* EX = (const uint2*)(p.ws + OFF_EXPS);
    const __amdgpu_buffer_rsrc_t UT = __builtin_amdgcn_make_buffer_rsrc((void*)(p.ws + OFF_UT), 0, NEXP * DM, 0x00020000);
    const __amdgpu_buffer_rsrc_t VT = __builtin_amdgcn_make_buffer_rsrc((void*)(p.ws + OFF_VT), 0, NEXP * DM, 0x00020000);
    const int lane = my_tid() & 63, wid = my_tid() >> 6, c0 = lane * 16;
    char* wl = smem + wid * 7168;
    uint2* ent = (uint2*)wl; float* zb = (float*)(wl + 4096); int* offs = (int*)(wl + 6144); unsigned* sched = (unsigned*)(wl + 6144 + 256);
#pragma unroll 1
    for (int t0 = (bid * 8 + wid) * GT; t0 < NTOK; t0 += nb * 8 * GT) {
        u32x4 h2q[GT]; float hsc[GT], mu[GT], rs[GT]; float acc[GT][16];
        f32x4 scv[4], shv[4];
        {
            const int b = t0 / SEQ;
#pragma unroll
            for (int q = 0; q < 4; ++q) { scv[q] = *(const f32x4*)(AB + (size_t)b * DM + c0 + q * 4); shv[q] = *(const f32x4*)(AB + (size_t)(NB + b) * DM + c0 + q * 4); }
        }
#pragma unroll
        for (int j = 0; j < GT; ++j) {
            const int tok = t0 + j;
            const bf16_t* row = (const bf16_t*)(p.ws + OFF_R1) + (size_t)tok * DM + c0;
            __builtin_amdgcn_sched_barrier(0);
            { mu[j] = STAT[tok] * (1.0f / 1024.0f); rs[j] = rsqrtf(fmaxf(STAT[NTOK + tok] * (1.0f / 1024.0f) - mu[j] * mu[j], 0.f) + LN_EPS); }
            {
                f32x4 hv[4];
                float m = 0.f;
                const u32x4 ra = *(const u32x4*)row, rb = *(const u32x4*)(row + 8);
                hv[0] = (f32x4){bflo(ra.x), bfhi(ra.x), bflo(ra.y), bfhi(ra.y)}; hv[1] = (f32x4){bflo(ra.z), bfhi(ra.z), bflo(ra.w), bfhi(ra.w)};
                hv[2] = (f32x4){bflo(rb.x), bfhi(rb.x), bflo(rb.y), bfhi(rb.y)}; hv[3] = (f32x4){bflo(rb.z), bfhi(rb.z), bflo(rb.w), bfhi(rb.w)};
#pragma unroll
                for (int q = 0; q < 4; ++q) { hv[q] = (hv[q] - mu[j]) * rs[j] * scv[q] + shv[q]; m = fmaxf(m, fmaxf(fmaxf(fabsf(hv[q].x), fabsf(hv[q].y)), fmaxf(fabsf(hv[q].z), fabsf(hv[q].w)))); }
#pragma unroll
                for (int sft = 1; sft < 64; sft <<= 1) m = fmaxf(m, __shfl_xor(m, sft));
                const float qs = m > 1e-30f ? 127.0f / m : 1.0f;
                hsc[j] = m > 1e-30f ? m * (1.0f / 127.0f) : 1.0f;
                unsigned hw[4];
#pragma unroll
                for (int q = 0; q < 4; ++q)
                    hw[q] = ((unsigned)(int)rintf(hv[q].x * qs) & 0xffu) | (((unsigned)(int)rintf(hv[q].y * qs) & 0xffu) << 8) | (((unsigned)(int)rintf(hv[q].z * qs) & 0xffu) << 16) | (((unsigned)(int)rintf(hv[q].w * qs) & 0xffu) << 24);
                h2q[j] = (u32x4){hw[0], hw[1], hw[2], hw[3]};
            }
            const uint2 e0 = EX[(size_t)tok * 128 + lane], e1 = EX[(size_t)tok * 128 + 64 + lane];
            const int s0 = (int)((e0.x & 0x3fffu) >> SLSH), s1 = (int)((e1.x & 0x3fffu) >> SLSH);
            int run = 0, pos0 = 0, pos1 = 0;
#pragma unroll
            for (int s = 0; s < NSL; ++s) {
                const unsigned long long m0 = __ballot(s0 == s), m1 = __ballot(s1 == s);
                const int c0n = __popcll(m0), c1n = __popcll(m1);
                const int below0 = (int)__builtin_amdgcn_mbcnt_hi((unsigned)(m0 >> 32), __builtin_amdgcn_mbcnt_lo((unsigned)m0, 0u));
                const int below1 = (int)__builtin_amdgcn_mbcnt_hi((unsigned)(m1 >> 32), __builtin_amdgcn_mbcnt_lo((unsigned)m1, 0u));
                if (lane == 0) offs[j * 9 + s] = run;
                pos0 = (s0 == s) ? run + below0 : pos0;
                pos1 = (s1 == s) ? run + c0n + below1 : pos1;
                run += c0n + c1n;
            }
            if (lane == 0) offs[j * 9 + NSL] = 128;
            ent[j * 128 + pos0] = e0; ent[j * 128 + pos1] = e1;
        }
        int nbat;
        {
            const int gs = (lane / GT) % NSL, gj = lane % GT;
            const int gb = offs[gj * 9 + gs], ge = offs[gj * 9 + gs + 1], cnt = lane < NSL * GT ? ge - gb : 0, nbt = (cnt + 7) >> 3;
            int incl = nbt;
#pragma unroll
            for (int m = 1; m < 32; m <<= 1) { const int o = __shfl_up(incl, m); if ((lane & 31) >= m) incl += o; }
            nbat = __builtin_amdgcn_readlane(incl, NSL * GT - 1);
            const int st = incl - nbt;
            for (int q = 0; q < nbt; ++q) { const int rem = cnt - 8 * q; sched[st + q] = (unsigned)(gj * 128 + gb + 8 * q) | ((unsigned)(rem < 8 ? rem : 8) << 16); }
            if (lane < 3) sched[nbat + lane] = 0x80010000u;
        }
        xcd_pace(pace_cnt, pace_n, pstep);
#ifndef PROBE_UX
#define PROBE_UX 1
#endif
        for (int rep = 0; rep < PROBE_UX; ++rep)
        {
            u32x4 wa[8], wb[8];
#define GS_UP(W_, D_, B_) { const unsigned j_ = ((D_) & 0xffffu) >> 7; \
                if (j_ == 0) gs_upartial(W_, h2q[0], pz, B_); else if (j_ == 1) gs_upartial(W_, h2q[1], pz, B_); \
                else if (j_ == 2) gs_upartial(W_, h2q[2], pz, B_); else gs_upartial(W_, h2q[3], pz, B_); }
#define GS_RD(i_) ((unsigned)__builtin_amdgcn_readfirstlane((int)sched[(i_)]))
            unsigned da = GS_RD(0), db = GS_RD(1), dn = GS_RD(2), ea, eb, en;
            gs_desc(ent, da, lane, ea); gs_desc(ent, db, lane, eb); gs_desc(ent, dn, lane, en);
            gs_loads(UT, ea, lane, wa);
#pragma unroll 1
            for (int i = 0; i < nbat; i += 2) {
                float pz[16];
                gs_loads(UT, eb, lane, wb);
                __builtin_amdgcn_sched_barrier(0);
                GS_UP(wa, da, 0);
                const unsigned dcur_a = da, dcur_b = db;
                da = dn; ea = en; dn = GS_RD(i + 3); gs_desc(ent, dn, lane, en);
                gs_loads(UT, ea, lane, wa);
                __builtin_amdgcn_sched_barrier(0);
                GS_UP(wb, dcur_b, 8);
                db = dn; eb = en; dn = GS_RD(i + 4); gs_desc(ent, dn, lane, en);
                gs_ustore(pz, zb, dcur_a, dcur_b, lane);
            }
#undef GS_UP
#undef GS_RD
        }
        float asum[GT];
#pragma unroll
        for (int j = 0; j < GT; ++j) {
            float as = 0.f;
#pragma unroll
            for (int q = 0; q < 2; ++q) {
                const int pos = j * 128 + q * 64 + lane;
                const uint2 e = ent[pos];
                const float z = zb[pos] * __uint_as_float(e.x & 0xffff0000u) * hsc[j];
                const float a = gelu_as(z) * __uint_as_float(e.y);
                ent[pos].y = __float_as_uint(a);
                as += a;
            }
#pragma unroll
            for (int sft = 1; sft < 64; sft <<= 1) as += __shfl_xor(as, sft);
            asum[j] = as;
        }
#pragma unroll
        for (int j = 0; j < GT; ++j)
#pragma unroll
            for (int q = 0; q < 16; ++q) acc[j][q] = 0.f;
        {
            u32x4 wa[8]; unsigned ca;
#pragma unroll 1
            for (int i = 0; i < nbat; ++i) {
                const unsigned da = (unsigned)__builtin_amdgcn_readfirstlane((int)sched[i]);
                gs_issue(VT, ent, da, lane, wa, ca);
                __builtin_amdgcn_sched_barrier(0);
                const unsigned j_ = (da & 0xffffu) >> 7;
                if (j_ == 0) gs_vcompute(wa, ca, acc[0]); else if (j_ == 1) gs_vcompute(wa, ca, acc[1]);
                else if (j_ == 2) gs_vcompute(wa, ca, acc[2]); else gs_vcompute(wa, ca, acc[3]);
            }
        }
#pragma unroll
        for (int j = 0; j < GT; ++j) {
            asm volatile("" ::: "memory");
            __builtin_amdgcn_sched_barrier(0);
            const int tok = t0 + j, b = tok / SEQ;
            float* row = p.out + (size_t)tok * DM + c0;
            const bf16_t* r1row = (const bf16_t*)(p.ws + OFF_R1) + (size_t)tok * DM + c0;
            const float* g2 = mod + b * 6144 + 5120 + c0;
            f32x2 r[8];
            float sm = 0.f;
            const u32x4 ra = *(const u32x4*)r1row, rb = *(const u32x4*)(r1row + 8);
            const f32x4 r1v[4] = {(f32x4){bflo(ra.x), bfhi(ra.x), bflo(ra.y), bfhi(ra.y)}, (f32x4){bflo(ra.z), bfhi(ra.z), bflo(ra.w), bfhi(ra.w)},
                                  (f32x4){bflo(rb.x), bfhi(rb.x), bflo(rb.y), bfhi(rb.y)}, (f32x4){bflo(rb.z), bfhi(rb.z), bflo(rb.w), bfhi(rb.w)}};
#pragma unroll
            for (int q = 0; q < 4; ++q) {
                const f32x4 xv = (r1v[q] - mu[j]) * rs[j] * *(const f32x4*)(p.ln1w + c0 + q * 4) + *(const f32x4*)(p.ln1b + c0 + q * 4), gg = *(const f32x4*)(g2 + q * 4);
                const float off = 128.0f * asum[j];
                r[2 * q] = DEEP_ALPHA * (f32x2){xv.x, xv.y} + (f32x2){1.f + gg.x, 1.f + gg.y} * (f32x2){acc[j][4 * q] - off, acc[j][4 * q + 1] - off};
                r[2 * q + 1] = DEEP_ALPHA * (f32x2){xv.z, xv.w} + (f32x2){1.f + gg.z, 1.f + gg.w} * (f32x2){acc[j][4 * q + 2] - off, acc[j][4 * q + 3] - off};
                sm += r[2 * q].x + r[2 * q].y + r[2 * q + 1].x + r[2 * q + 1].y;
            }
#pragma unroll
            for (int m = 1; m < 64; m <<= 1) sm += __shfl_xor(sm, m);
            const float mu = sm * (1.0f / 1024.0f);
            float qq = 0.f;
#pragma unroll
            for (int i = 0; i < 8; ++i) { const f32x2 dd = r[i] - mu; qq += dd.x * dd.x + dd.y * dd.y; }
#pragma unroll
            for (int m = 1; m < 64; m <<= 1) qq += __shfl_xor(qq, m);
            const float rstd = rsqrtf(qq * (1.0f / 1024.0f) + LN_EPS);
#pragma unroll
            for (int q = 0; q < 4; ++q) {
                const f32x4 w4 = *(const f32x4*)(p.ln2w + c0 + q * 4), bi = *(const f32x4*)(p.ln2b + c0 + q * 4);
                f32x4 ov;
                ov.x = (r[2 * q].x - mu) * rstd * w4.x + bi.x; ov.y = (r[2 * q].y - mu) * rstd * w4.y + bi.y;
                ov.z = (r[2 * q + 1].x - mu) * rstd * w4.z + bi.z; ov.w = (r[2 * q + 1].y - mu) * rstd * w4.w + bi.w;
                *(f32x4*)(row + q * 4) = ov;
            }
        }
    }
}

#define XB_TMO      128
#define XB_XCNT(j)  (256  + 64 * (j))
#define XB_XSUB(j)  (1280 + 64 * (j))
#define XB_XGEN(j)  (2304 + 64 * (j))
#define XB_TOP      3328
#define XB_TOPGEN   3392
#define XCD_BAR_WORDS 3456
#define XB_SPIN_CAP (1u << 22)
#define LAS __attribute__((address_space(3)))
DI unsigned xb_ld(unsigned* p) { return __hip_atomic_load(p, __ATOMIC_RELAXED, __HIP_MEMORY_SCOPE_AGENT); }
DI unsigned xb_add(unsigned* p, unsigned v) { return __hip_atomic_fetch_add(p, v, __ATOMIC_RELAXED, __HIP_MEMORY_SCOPE_AGENT); }
DI unsigned xb_xcc_id() { return (unsigned)__builtin_amdgcn_s_getreg((3 << 11) | 20) & 0xFu; }
#define XB_SPIN(cond, bar) do { unsigned _sp = 0; while (cond) { __builtin_amdgcn_s_sleep(1); \
    if ((++_sp & 255u) == 0u) { if (xb_ld(&(bar)[XB_TMO])) break; if (_sp > XB_SPIN_CAP) { atomicAdd(&(bar)[XB_TMO], 1u); break; } } } } while (0)
struct XcdBarrier { unsigned* bar; unsigned x; volatile LAS unsigned* st; };
DI XcdBarrier xcd_barrier_post(unsigned* bar, volatile LAS unsigned* st) {
    XcdBarrier b; b.bar = bar; b.x = xb_xcc_id(); b.st = st;
    if (__builtin_amdgcn_workitem_id_x() == 0) (void)xb_add(&bar[XB_XCNT(b.x)], 1u);
    return b;
}
DI void xcd_barrier_complete(unsigned* bar, unsigned x, unsigned& nloc, unsigned& nx) {
    const unsigned G = gridDim.x * gridDim.y * gridDim.z;
    unsigned sum, cnt, mine, sp = 0u;
    for (;;) {
        sum = 0u; cnt = 0u; mine = 0u;
#pragma unroll
        for (unsigned j = 0; j < 16; ++j) { const unsigned c = xb_ld(&bar[XB_XCNT(j)]); sum += c; cnt += (c > 0u) ? 1u : 0u; mine = (j == x) ? c : mine; }
        if (sum == G) break;
        __builtin_amdgcn_s_sleep(1);
        if ((++sp & 255u) == 0u) { if (xb_ld(&bar[XB_TMO])) break; if (sp > XB_SPIN_CAP) { atomicAdd(&bar[XB_TMO], 1u); break; } }
    }
    nloc = mine > 0u ? mine : 1u; nx = cnt > 0u ? cnt : 1u;
}
DI void xcd_barrier(const XcdBarrier& b) {
    asm volatile("s_waitcnt vmcnt(0)" ::: "memory");
    __syncthreads();
    if (__builtin_amdgcn_workitem_id_x() == 0) {
        unsigned* bar = b.bar;
        unsigned bx = b.x; asm volatile("" : "+s"(bx));
        __builtin_amdgcn_s_waitcnt(0);
        unsigned nloc = b.st[0], nx = b.st[1];
        if (nloc == 0u) { xcd_barrier_complete(bar, bx, nloc, nx); b.st[0] = nloc; b.st[1] = nx; }
        const unsigned old = xb_add(&bar[XB_XSUB(bx)], 1u);
        const unsigned gen = old / nloc;
        if (old + 1u == (gen + 1u) * nloc) {
            __builtin_amdgcn_fence(__ATOMIC_RELEASE, "agent");
            asm volatile("s_waitcnt vmcnt(0)" ::: "memory");
            const unsigned og = xb_add(&bar[XB_TOP], 1u);
            const unsigned tg = og / nx;
            if (og + 1u == (tg + 1u) * nx) xb_add(&bar[XB_TOPGEN], 1u);
            else XB_SPIN(xb_ld(&bar[XB_TOPGEN]) == tg, bar);
            __builtin_amdgcn_fence(__ATOMIC_ACQUIRE, "agent");
            xb_add(&bar[XB_XGEN(bx)], 1u);
            asm volatile("s_waitcnt vmcnt(0)" ::: "memory");
        } else {
            XB_SPIN(xb_ld(&bar[XB_XGEN(bx)]) == gen, bar);
            __builtin_amdgcn_fence(__ATOMIC_ACQUIRE, "agent");
            asm volatile("s_waitcnt vmcnt(0)" ::: "memory");
        }
    }
    __syncthreads();
}

__global__ void __launch_bounds__(NTH) k_mega(Params p) {
    __shared__ __attribute__((aligned(16))) char smem[SMEM_BYTES];
    volatile LAS unsigned* xst = (volatile LAS unsigned*)(smem + SMEM_BYTES - 16);
    if (__builtin_amdgcn_workitem_id_x() == 0) { xst[0] = 0u; xst[1] = 0u; }
    __syncthreads();
    const XcdBarrier xb = xcd_barrier_post((unsigned*)(p.ws + OFF_BAR), xst);
    const int bid = blockIdx.x, nb = gridDim.x;
#ifndef PROBE_MASK
#define PROBE_MASK 0
#endif
#define REP(bit) for (int rep_ = 0; rep_ < ((PROBE_MASK & (bit)) ? 2 : 1); ++rep_)
    phase_prep_a(p, smem);           xcd_barrier(xb);
    phase_prep_b(p, smem);           xcd_barrier(xb);
    REP(1)  { phase_proj(p, bid, nb, smem);    xcd_barrier(xb); }
    REP(2)  { phase_mix(p, bid, nb, smem);     xcd_barrier(xb); }
    REP(4)  { phase_glu(p, bid, nb, smem);     xcd_barrier(xb); }
    REP(4)  { phase_outproj(p, bid, nb, smem); xcd_barrier(xb); }
    REP(8)  { phase_q(p, bid, nb, smem);       xcd_barrier(xb); }
    REP(16) { phase_retrieve(p, bid, nb, smem); xcd_barrier(xb); }
    phase_gather(p, bid, nb, smem, (unsigned*)(p.ws + OFF_BAR) + 16 * xb_xcc_id(), xst[0]);
}

extern "C" void kernel_launch(void* const* d_in, const int* in_sizes, int n_in, void* d_out, int out_size, void* d_ws, size_t ws_size, hipStream_t stream) {
    if (n_in != 27 || ws_size < WS_END) { fprintf(stderr, "kernel_launch: unexpected n_in %d or ws_size %zu (< %zu)\n", n_in, ws_size, (size_t)WS_END); return; }
    static int grid_blocks = 0;
    if (!grid_blocks) {
        int dev = 0, cus = 0, per_cu = 0;
        (void)hipGetDevice(&dev);
        (void)hipDeviceGetAttribute(&cus, hipDeviceAttributeMultiprocessorCount, dev);
        (void)hipOccupancyMaxActiveBlocksPerMultiprocessor(&per_cu, k_mega, NTH, 0);
        if (cus <= 0) cus = 256;
        if (per_cu < 1) { fprintf(stderr, "kernel_launch: occupancy query says %d blocks/CU\n", per_cu); per_cu = 1; }
        grid_blocks = cus;
    }
    Params p{};
    const float** f = (const float**)&p;
    for (int i = 0; i < 27; ++i) f[i] = (const float*)d_in[i];
    p.out = (float*)d_out; p.ws = (char*)d_ws;
    hipError_t e = hipMemsetAsync((char*)d_ws + OFF_BAR, 0, (size_t)3456 * 4, stream);
    if (e == hipSuccess) { hipLaunchKernelGGL(k_mega, dim3(grid_blocks), dim3(NTH), 0, stream, p); e = hipPeekAtLastError(); }
    if (e != hipSuccess) fprintf(stderr, "launch failed: %s (grid %d)\n", hipGetErrorString(e), grid_blocks);
}
```

```cpp
#include <hip/hip_runtime.h>
#include <hip/hip_cooperative_groups.h>
#include <stdint.h>
#include <stdio.h>

namespace cg = cooperative_groups;
#define DI __device__ __forceinline__
typedef unsigned short bf16_t;
typedef short bf16x8 __attribute__((ext_vector_type(8)));
typedef float f32x16 __attribute__((ext_vector_type(16)));
typedef unsigned u32x4 __attribute__((ext_vector_type(4)));
typedef float f32x4 __attribute__((ext_vector_type(4)));
typedef float f32x2 __attribute__((ext_vector_type(2)));

constexpr int NTH = 512;
constexpr int NB = 16, SEQ = 2048, DM = 1024, NTOK = NB * SEQ;
constexpr int DHG = 512, HGH = 4, HDK = 128;
constexpr int DSS = 512, SSG = 32, SSC = 16, SSP = 64;
constexpr int INC = 2560;
constexpr int PHEADS = 8, NKEYS = 128, TOPK = 16, NEXP = 16384;
constexpr float DEEP_ALPHA = 1.189207115002721f;
constexpr float LN_EPS = 1e-5f, RMS_EPS = 1e-6f;
constexpr int SMEM_BYTES = 128 * 1024 + 256;

constexpr size_t al256(size_t x) { return (x + 255) & ~(size_t)255; }
constexpr size_t OFF_MOD = 0;
constexpr size_t OFF_LB = al256(OFF_MOD + (size_t)NB * 6144 * 4);
constexpr size_t OFF_LAM = al256(OFF_LB + 512 * 4);
constexpr size_t OFF_BB = al256(OFF_LAM + 32 * 64 * 2 * 4);
constexpr size_t OFF_WIN = al256(OFF_BB + 32 * 64 * 16 * 2 * 4);
constexpr size_t OFF_GLU = al256(OFF_WIN + (size_t)INC * DM * 2);
constexpr size_t OFF_WOUT = al256(OFF_GLU + (size_t)512 * 512 * 2);
constexpr size_t OFF_WQ = al256(OFF_WOUT + (size_t)DM * DM * 2);
constexpr size_t OFF_SUBK = al256(OFF_WQ + (size_t)2048 * DM * 2);
constexpr size_t OFF_SU = al256(OFF_SUBK + (size_t)16 * 128 * 128 * 2);
constexpr size_t OFF_SV = al256(OFF_SU + (size_t)NEXP * 4);
constexpr size_t OFF_UT = al256(OFF_SV + (size_t)NEXP * 4);
constexpr size_t OFF_VT = al256(OFF_UT + (size_t)NEXP * DM * 2);
constexpr size_t OFF_H = al256(OFF_VT + (size_t)NEXP * DM * 2);
constexpr size_t OFF_PROJ = al256(OFF_H + (size_t)NTOK * DM * 2);
constexpr size_t OFF_ORAW = al256(OFF_PROJ + (size_t)NTOK * INC * 2);
constexpr size_t OFF_YSSM = al256(OFF_ORAW + (size_t)NTOK * DHG * 4);
constexpr size_t OFF_A2 = al256(OFF_YSSM + (size_t)NTOK * DSS * 2);
constexpr size_t OFF_HG = al256(OFF_A2 + (size_t)NTOK * DM * 2);
constexpr size_t OFF_S5K = al256(OFF_HG + (size_t)4096 * 128 * 4);
constexpr size_t OFF_S5N = al256(OFF_S5K + (size_t)32 * 4096 * 2);
constexpr size_t OFF_S5M = al256(OFF_S5N + (size_t)32 * 128 * 256 * 2);
constexpr size_t OFF_S5L = al256(OFF_S5M + (size_t)32 * 256 * 128 * 2);
constexpr size_t OFF_STAT = al256(OFF_S5L + (size_t)32 * 64 * 2 * 4);
constexpr size_t OFF_AB = al256(OFF_STAT + (size_t)NTOK * 3 * 4);
constexpr size_t OFF_CAB = al256(OFF_AB + (size_t)2 * NB * DM * 4);
constexpr size_t OFF_BAR = al256(OFF_CAB + (size_t)2 * NB * 2048 * 4);
constexpr size_t WS_END = al256(OFF_BAR + (size_t)3456 * 4);
constexpr size_t OFF_HQ = OFF_ORAW, OFF_HK = OFF_ORAW + (size_t)NTOK * DHG * 2;
constexpr size_t OFF_TOPL = OFF_ORAW;
constexpr size_t OFF_EXPS = OFF_YSSM;
constexpr size_t OFF_R1 = OFF_ORAW;

struct Params {
    const float *x, *c, *ada_w, *ada_b, *w_in, *hg_lb, *hg_nw, *a_re, *a_im, *log_dt, *b_re, *b_im, *c_re, *c_im, *dsk,
        *glu_w, *glu_b, *ssm_nw, *w_out, *ln1w, *ln1b, *w_q, *subk, *pu, *pv, *ln2w, *ln2b;
    float* out;
    char* ws;
};

DI int my_tid() { int t = (int)__builtin_amdgcn_workitem_id_x(); asm volatile("" : "+v"(t)); return t; }
DI bf16_t f2bf(float x) { unsigned u = __float_as_uint(x); u += 0x7fffu + ((u >> 16) & 1u); return (bf16_t)(u >> 16); }
DI float bf2f(bf16_t b) { return __uint_as_float(((unsigned)b) << 16); }
DI float bflo(unsigned w) { return __uint_as_float(w << 16); }
DI float bfhi(unsigned w) { return __uint_as_float(w & 0xffff0000u); }
typedef __bf16 hwbf16x2 __attribute__((ext_vector_type(2)));
DI unsigned pack2(float a, float b) { const f32x2 v = {a, b}; return __builtin_bit_cast(unsigned, __builtin_convertvector(v, hwbf16x2)); }
DI bf16x8 pack8(const f32x16& x, const int base) {
    u32x4 o; o.x = pack2(x[base], x[base + 1]); o.y = pack2(x[base + 2], x[base + 3]); o.z = pack2(x[base + 4], x[base + 5]); o.w = pack2(x[base + 6], x[base + 7]);
    return __builtin_bit_cast(bf16x8, o);
}
DI float sigmoidf_(float x) { return 1.0f / (1.0f + __expf(-x)); }
DI float siluf_(float x) { return x * sigmoidf_(x); }
DI float geluf_(float x) { return 0.5f * x * (1.0f + erff(x * 0.70710678118654752f)); }
DI float gelu_as(float v) {
    const float t = __builtin_amdgcn_rcpf(fabsf(v) * 0.2316418882f + 1.0f);
    float q = t * 0.5307027145f + (-0.7265760135f); q = q * t + 0.7107068705f; q = q * t + (-0.142248368f); q = q * t + 0.127414796f; q = q * t;
    const float m = v * (q * __builtin_amdgcn_exp2f(v * v * (-0.72134752044f)));
    return v < 0.f ? m : v - m;
}

template <int MT, int NT_, int WM, int WN, class Epi>
DI void gemm_block(const bf16_t* __restrict__ A, int lda, const bf16_t* __restrict__ Bt, int ldb, int K, char* smem, Epi epi) {
    constexpr int BM = WM * MT * 32, BN = WN * NT_ * 32, LS = 72;
    static_assert(WM * WN == 8, "8 waves");
    bf16_t* As = (bf16_t*)smem;
    bf16_t* Bs = As + BM * LS;
    const int tid = my_tid(), lane = tid & 63, wid = tid >> 6, r = lane & 31, h = lane >> 5;
    const int wm = wid / WN, wn = wid % WN;
    constexpr int PA = BM * 8 / NTH, PB = BN * 8 / NTH;
    u32x4 ra[PA], rb[PB];
    f32x16 acc[MT][NT_];
#pragma unroll
    for (int mi = 0; mi < MT; ++mi)
#pragma unroll
        for (int ni = 0; ni < NT_; ++ni)
#pragma unroll
            for (int i = 0; i < 16; ++i) acc[mi][ni][i] = 0.f;
#define GEMM_GLOAD(kt_) { \
    _Pragma("unroll") for (int q = 0; q < PA; ++q) { const int idx = tid + q * NTH, row = idx >> 3, ch = idx & 7; ra[q] = *(const u32x4*)(A + (size_t)row * lda + (kt_) * 64 + ch * 8); } \
    _Pragma("unroll") for (int q = 0; q < PB; ++q) { const int idx = tid + q * NTH, row = idx >> 3, ch = idx & 7; rb[q] = *(const u32x4*)(Bt + (size_t)row * ldb + (kt_) * 64 + ch * 8); } }
#define GEMM_LSTORE() { \
    _Pragma("unroll") for (int q = 0; q < PA; ++q) { const int idx = tid + q * NTH, row = idx >> 3, ch = idx & 7; *(u32x4*)(As + row * LS + ch * 8) = ra[q]; } \
    _Pragma("unroll") for (int q = 0; q < PB; ++q) { const int idx = tid + q * NTH, row = idx >> 3, ch = idx & 7; *(u32x4*)(Bs + row * LS + ch * 8) = rb[q]; } }
    GEMM_GLOAD(0); GEMM_LSTORE(); __syncthreads();
    const int nk = K / 64;
    for (int kt = 0; kt < nk; ++kt) {
        if (kt + 1 < nk) GEMM_GLOAD(kt + 1);
#pragma unroll
        for (int ks = 0; ks < 4; ++ks) {
            bf16x8 a[MT], b[NT_];
#pragma unroll
            for (int mi = 0; mi < MT; ++mi) a[mi] = *(const bf16x8*)(As + (wm * MT * 32 + mi * 32 + r) * LS + ks * 16 + h * 8);
#pragma unroll
            for (int ni = 0; ni < NT_; ++ni) b[ni] = *(const bf16x8*)(Bs + (wn * NT_ * 32 + ni * 32 + r) * LS + ks * 16 + h * 8);
#pragma unroll
            for (int mi = 0; mi < MT; ++mi)
#pragma unroll
                for (int ni = 0; ni < NT_; ++ni) acc[mi][ni] = __builtin_amdgcn_mfma_f32_32x32x16_bf16(a[mi], b[ni], acc[mi][ni], 0, 0, 0);
        }
        __syncthreads();
        if (kt + 1 < nk) { GEMM_LSTORE(); __syncthreads(); }
    }
#pragma unroll
    for (int mi = 0; mi < MT; ++mi)
#pragma unroll
        for (int ni = 0; ni < NT_; ++ni)
#pragma unroll
            for (int i = 0; i < 16; ++i) epi(wm * MT * 32 + mi * 32 + (i & 3) + 8 * (i >> 2) + 4 * h, wn * NT_ * 32 + ni * 32 + r, acc[mi][ni][i]);
}

namespace pg8 {
#define PG8_LAS __attribute__((address_space(3)))
typedef unsigned short bf16_t;
typedef short bf16x8 __attribute__((ext_vector_type(8)));
typedef float f32x4 __attribute__((ext_vector_type(4)));
typedef unsigned u32x4 __attribute__((ext_vector_type(4)));
constexpr int BM = 256, BK = 64, HALF = 128, HTB = HALF * BK * 2  , STAGE_BYTES = 8 * HTB, NXCD = 8, WGM = 8;

__host__ __device__ __forceinline__ int lds_byte(int r, int c) { const int st = (r >> 4) * 2 + (c >> 5), rr = r & 15, cc = c & 31, ob = rr * 64 + cc * 2; return st * 1024 + (ob ^ (((ob >> 9) & 1) << 5)); }
__host__ __device__ __forceinline__ void stage_rc(int b, int& R, int& C) { const int st = b / 1024, sb = b % 1024, swz = sb ^ (((sb >> 9) & 1) << 5); R = (st >> 1) * 16 + swz / 64; C = (st & 1) * 32 + (swz % 64) / 2; }
__host__ __device__ __forceinline__ int perm32(int rho) { const int n = rho >> 4, i = rho & 15; return 8 * (i >> 2) + 4 * n + (i & 3); }

struct Unit { int pm, pn; };
struct Gemm { const bf16_t* A; const bf16_t* Bt; int M, N, K; };

struct StaticOrder {
    int nM, nN, nwg, G, c;
    __host__ __device__ void init(int M, int N, int G_, int c_) { nM = M / BM; nN = N / BM; nwg = nM * nN; G = G_; c = c_; }
    __host__ __device__ bool next(int i, Unit& u) const {
        const long L = (long)i * G + c; if (L >= nwg) return false;
        int wgid = (int)L; { const int q = nwg / NXCD, r = nwg % NXCD, xcd = wgid % NXCD, off = wgid / NXCD; wgid = (xcd < r ? xcd * (q + 1) : r * (q + 1) + (xcd - r) * q) + off; }
        const int nig = WGM * nN, gid = wgid / nig, fm = gid * WGM, gsz = (nM - fm) < WGM ? (nM - fm) : WGM;
        u.pm = fm + ((wgid % nig) % gsz); u.pn = (wgid % nig) / gsz; return true;
    }
    __device__ __forceinline__ void a_ready(const Unit&) const {}
    __device__ __forceinline__ void done(const Unit&) const {}
};
template <class Epi, class Sched, bool STAMP = false>
__device__ __forceinline__ void gemm_phase(PG8_LAS unsigned char* lds, const Gemm g, const Sched& S, const Epi& E, unsigned long long* stamps) {
    int tid_ = (int)__builtin_amdgcn_workitem_id_x(); asm volatile("" : "+v"(tid_));
    const int tid = tid_, wid = __builtin_amdgcn_readfirstlane(tid >> 6), lane = tid & 63, wr = wid >> 2, wc = wid & 3, fr = lane & 15, fq = lane >> 4;
    const int K = g.K, nt = K / BK;
    int ts_lo = 0, ts_hi = 0, nts = 0; const unsigned long long rt_entry = STAMP ? (unsigned long long)wall_clock64() : 0ull;
#define PG8_STAMP() do { if (STAMP && wid == 0 && nts < 64) { const unsigned long long _c = (unsigned long long)clock64(); \
        ts_lo = (lane == nts) ? (int)(unsigned)_c : ts_lo; ts_hi = (lane == nts) ? (int)(unsigned)(_c >> 32) : ts_hi; ++nts; } } while (0)
    PG8_STAMP();
    unsigned voffA[2], voffB[2];
#pragma unroll
    for (int i = 0; i < 2; ++i) { int R, C; stage_rc(tid * 16 + i * 8192, R, C); const int Rb = Epi::PERM ? ((R & ~31) + perm32(R & 31)) : R;
        voffA[i] = (unsigned)(R * K + C) * 2u; voffB[i] = (unsigned)(Rb * K + C) * 2u; }
    const size_t kstep = (size_t)(BK * 2);
    const size_t hstep = (size_t)HALF * K * 2;
    const size_t tstep = 2 * hstep;
    const unsigned ldsw = (unsigned)wid * 1024u;
    const int aoff = lds_byte(wr * 64 + fr, fq * 8), boff = lds_byte(wc * 32 + fr, fq * 8);
#define PG8_SA(b, h) (((b) * 2 + (h)) * HTB)
#define PG8_SB(b, h) ((4 + (b) * 2 + (h)) * HTB)
#define PG8_STAGE(bufoff, gbase, voff) do { _Pragma("unroll") for (int _i = 0; _i < 2; ++_i) \
        __builtin_amdgcn_global_load_lds((const unsigned*)((const char*)(gbase) + (voff)[_i]), (PG8_LAS unsigned*)(lds + (bufoff) + ldsw + _i * 8192), 16, 0, 0); } while (0)
#define PG8_LDA(dst, b, h) do { _Pragma("unroll") for (int m = 0; m < 4; ++m) _Pragma("unroll") for (int k = 0; k < 2; ++k) dst[m][k] = *(const PG8_LAS bf16x8*)(lds + PG8_SA(b, h) + aoff + m * 2048 + k * 1024); } while (0)
#define PG8_LDB(dst, b, h) do { _Pragma("unroll") for (int n = 0; n < 2; ++n) _Pragma("unroll") for (int k = 0; k < 2; ++k) dst[n][k] = *(const PG8_LAS bf16x8*)(lds + PG8_SB(b, h) + boff + n * 2048 + k * 1024); } while (0)
#define PG8_MMA(ai, bj, At, Bt) do { __builtin_amdgcn_s_setprio(1); _Pragma("unroll") for (int m = 0; m < 4; ++m) _Pragma("unroll") for (int n = 0; n < 2; ++n) _Pragma("unroll") for (int k = 0; k < 2; ++k) \
        acc[ai][bj][m][n] = __builtin_amdgcn_mfma_f32_16x16x32_bf16(Bt[n][k], At[m][k], acc[ai][bj][m][n], 0, 0, 0); __builtin_amdgcn_s_setprio(0); } while (0)
#define PG8_WAIT_V(n) asm volatile("s_waitcnt vmcnt(" #n ")" ::: "memory")
#define PG8_WAIT_L(n) asm volatile("s_waitcnt lgkmcnt(" #n ")" ::: "memory")
#define PG8_BAR __builtin_amdgcn_s_barrier()
#define PG8_SCHED __builtin_amdgcn_sched_barrier(0)
    Unit cur, nxt; int ui = 0;
    if (!S.next(0, cur)) return;
    f32x4 acc[2][2][4][2];
#pragma unroll
    for (int a = 0; a < 2; ++a)
#pragma unroll
        for (int b = 0; b < 2; ++b)
#pragma unroll
            for (int m = 0; m < 4; ++m)
#pragma unroll
                for (int n = 0; n < 2; ++n) acc[a][b][m][n] = (f32x4){0.f, 0.f, 0.f, 0.f};
    bf16x8 At[4][2], B0[2][2], B1[2][2];
    const char* cA = (const char*)g.A + (size_t)cur.pm * tstep; const char* cB = (const char*)g.Bt + (size_t)cur.pn * tstep;
    S.a_ready(cur);
    PG8_STAGE(PG8_SB(0, 0), cB, voffB); PG8_STAGE(PG8_SA(0, 0), cA, voffA); PG8_STAGE(PG8_SB(0, 1), cB + hstep, voffB); PG8_STAGE(PG8_SA(0, 1), cA + hstep, voffA);
    if (wr == 1) PG8_BAR;
    PG8_WAIT_V(4); PG8_BAR;
    PG8_STAGE(PG8_SB(1, 0), cB + kstep, voffB); PG8_STAGE(PG8_SA(1, 0), cA + kstep, voffA); PG8_STAGE(PG8_SB(1, 1), cB + hstep + kstep, voffB);
    PG8_WAIT_V(6); PG8_BAR;
    PG8_STAMP();
    for (;;) {
        const bool has_next = S.next(ui + 1, nxt);
        const char* nA = has_next ? (const char*)g.A + (size_t)nxt.pm * tstep : cA; const char* nB = has_next ? (const char*)g.Bt + (size_t)nxt.pn * tstep : cB;
        for (int t = 0; t < nt; t += 2) {
            const bool last = (t == nt - 2);
            const char* a1 = cA + (size_t)(t + 1) * kstep;
            const char* a2 = last ? nA : cA + (size_t)(t + 2) * kstep; const char* b2 = last ? nB : cB + (size_t)(t + 2) * kstep;
            const char* a3 = a2 + kstep; const char* b3 = b2 + kstep;
            if (last && has_next) S.a_ready(nxt);
            if constexpr (Epi::MIDSCALE) { if (t == nt / 2) E.midscale(acc, cur, wr, fr); }
            PG8_LDB(B0, 0, 0); PG8_SCHED; PG8_LDA(At, 0, 0); PG8_STAGE(PG8_SA(1, 1), a1 + hstep, voffA);
            PG8_WAIT_L(8); PG8_BAR; PG8_WAIT_L(0); PG8_MMA(0, 0, At, B0); PG8_BAR; PG8_SCHED;
            PG8_LDB(B1, 0, 1); PG8_STAGE(PG8_SB(0, 0), b2, voffB);
            PG8_BAR; PG8_WAIT_L(0); PG8_MMA(0, 1, At, B1); PG8_BAR;
            PG8_LDA(At, 0, 1); PG8_STAGE(PG8_SA(0, 0), a2, voffA);
            PG8_BAR; PG8_WAIT_L(0); PG8_MMA(1, 0, At, B0); PG8_BAR; PG8_SCHED;
            PG8_STAGE(PG8_SB(0, 1), b2 + hstep, voffB);
            PG8_WAIT_V(6); PG8_BAR; PG8_MMA(1, 1, At, B1); PG8_BAR;
            PG8_LDB(B0, 1, 0); PG8_SCHED; PG8_LDA(At, 1, 0); PG8_STAGE(PG8_SA(0, 1), a2 + hstep, voffA);
            PG8_WAIT_L(8); PG8_BAR; PG8_WAIT_L(0); PG8_MMA(0, 0, At, B0); PG8_BAR; PG8_SCHED;
            PG8_LDB(B1, 1, 1); PG8_STAGE(PG8_SB(1, 0), b3, voffB);
            PG8_BAR; PG8_WAIT_L(0); PG8_MMA(0, 1, At, B1); PG8_BAR;
            PG8_LDA(At, 1, 1); PG8_STAGE(PG8_SA(1, 0), a3, voffA);
            PG8_BAR; PG8_WAIT_L(0); PG8_MMA(1, 0, At, B0); PG8_BAR; PG8_SCHED;
            PG8_STAGE(PG8_SB(1, 1), b3 + hstep, voffB);
            PG8_WAIT_V(6); PG8_BAR; PG8_MMA(1, 1, At, B1); PG8_BAR;
        }
        PG8_STAMP();
        if constexpr (!Epi::AFTER_DRAIN) { E(acc, cur, wr, wc, fr, fq); S.done(cur); }
        PG8_STAMP();
        if (!has_next) break;
#pragma unroll
        for (int a = 0; a < 2; ++a)
#pragma unroll
            for (int b = 0; b < 2; ++b)
#pragma unroll
                for (int m = 0; m < 4; ++m)
#pragma unroll
                    for (int n = 0; n < 2; ++n) acc[a][b][m][n] = (f32x4){0.f, 0.f, 0.f, 0.f};
        cur = nxt; cA = nA; cB = nB; ++ui;
    }
    PG8_WAIT_V(0);
    if (wr == 0) PG8_BAR;
    PG8_BAR;
    if constexpr (Epi::AFTER_DRAIN) { E.fused(acc, cur, wr, wc, fr, fq, lds, wid, lane); S.done(cur); }
    PG8_STAMP();
    if (STAMP && wid == 0) { stamps[lane] = lane < nts ? (((unsigned long long)(unsigned)ts_hi << 32) | (unsigned)ts_lo) : 0ull;
        if (lane == 62) stamps[62] = rt_entry; if (lane == 63) stamps[63] = (unsigned long long)wall_clock64(); }
#undef PG8_STAMP
#undef PG8_SA
#undef PG8_SB
#undef PG8_STAGE
#undef PG8_LDA
#undef PG8_LDB
#undef PG8_MMA
#undef PG8_WAIT_V
#undef PG8_WAIT_L
#undef PG8_BAR
#undef PG8_SCHED
}

__device__ __forceinline__ unsigned pk_bf16(float lo, float hi) { typedef float v2f __attribute__((ext_vector_type(2))); typedef __bf16 v2b __attribute__((ext_vector_type(2))); const v2f v = {lo, hi}; return __builtin_bit_cast(unsigned, __builtin_convertvector(v, v2b)); }
__device__ __forceinline__ float silu1(float x) { return x * __builtin_amdgcn_rcpf(1.0f + __expf(-x)); }
struct EpiBf16Act {
    static constexpr bool PERM = true, AFTER_DRAIN = false, MIDSCALE = false;
    bf16_t* O; int ldc; unsigned silu_mask;
    __device__ __forceinline__ void operator()(const f32x4 (&acc)[2][2][4][2], const Unit& u, int wr, int wc, int fr, int fq) const {
        const int row0 = u.pm * BM + wr * 64 + fr, col0 = u.pn * BM + wc * 32 + 8 * fq;
        const bool act = (silu_mask >> u.pn) & 1u;
#pragma unroll
        for (int ai = 0; ai < 2; ++ai)
#pragma unroll
            for (int m = 0; m < 4; ++m) { bf16_t* rowp = O + (size_t)(row0 + ai * HALF + m * 16) * ldc + col0;
#pragma unroll
                for (int bj = 0; bj < 2; ++bj) { f32x4 v0 = acc[ai][bj][m][0], v1 = acc[ai][bj][m][1];
                    if (act) {
#pragma unroll
                        for (int j = 0; j < 4; ++j) { v0[j] = silu1(v0[j]); v1[j] = silu1(v1[j]); } }
                    u32x4 w; w.x = pk_bf16(v0[0], v0[1]); w.y = pk_bf16(v0[2], v0[3]); w.z = pk_bf16(v1[0], v1[1]); w.w = pk_bf16(v1[2], v1[3]);
                    *(u32x4*)(rowp + bj * HALF) = w; } }
    }
};
struct EpiProj {
    static constexpr bool PERM = true, AFTER_DRAIN = false, MIDSCALE = false;
    bf16_t* O; bf16_t* HQ; bf16_t* HK; float* HG; const float* LB;
    __device__ __forceinline__ void operator()(const f32x4 (&acc)[2][2][4][2], const Unit& u, int wr, int wc, int fr, int fq) const {
        if (u.pn >= 4) {
            const int row0 = u.pm * BM + wr * 64 + fr, col0 = u.pn * BM + wc * 32 + 8 * fq;
            const bool act = (u.pn == 6) || (u.pn == 7);
#pragma unroll
            for (int ai = 0; ai < 2; ++ai)
#pragma unroll
                for (int m = 0; m < 4; ++m) { bf16_t* rowp = O + (size_t)(row0 + ai * HALF + m * 16) * 2560 + col0;
#pragma unroll
                    for (int bj = 0; bj < 2; ++bj) { f32x4 v0 = acc[ai][bj][m][0], v1 = acc[ai][bj][m][1];
                        if (act) {
#pragma unroll
                            for (int j = 0; j < 4; ++j) { v0[j] = silu1(v0[j]); v1[j] = silu1(v1[j]); } }
                        u32x4 w; w.x = pk_bf16(v0[0], v0[1]); w.y = pk_bf16(v0[2], v0[3]); w.z = pk_bf16(v1[0], v1[1]); w.w = pk_bf16(v1[2], v1[3]);
                        *(u32x4*)(rowp + bj * HALF) = w; } }
            return;
        }
        const int hd = u.pn, bat = (u.pm * BM) / 2048, cb = (u.pm & 7) * 8, k0 = wc * 32 + 8 * fq, lane = fq * 16 + fr;
        float lb[8];
        { const f32x4 l0 = *(const f32x4*)(LB + hd * 128 + k0), l1 = *(const f32x4*)(LB + hd * 128 + k0 + 4);
          lb[0] = l0[0]; lb[1] = l0[1]; lb[2] = l0[2]; lb[3] = l0[3]; lb[4] = l1[0]; lb[5] = l1[1]; lb[6] = l1[2]; lb[7] = l1[3]; }
#pragma unroll
        for (int ac = 0; ac < 4; ++ac) {
            const int ai = ac >> 1, cp = ac & 1;
            __builtin_amdgcn_sched_barrier(0);
            const size_t tile = ((size_t)(bat * 4 + hd) * 64 + cb + 4 * ai + 2 * wr + cp);
#pragma unroll
            for (int eh = 0; eh < 2; ++eh) {
                __builtin_amdgcn_sched_barrier(0);
                float tot0[4];
                bf16_t* hq = HQ + tile * 4096 + k0 + 4 * eh;
                bf16_t* hk = HK + tile * 4096 + k0 + 4 * eh;
#pragma unroll
                for (int mm = 0; mm < 2; ++mm) {
                    const f32x4 q4 = acc[ai][0][2 * cp + mm][eh], f4 = acc[ai][1][2 * cp + mm][eh];
                    float qo[4], ko[4], bl[4];
#pragma unroll
                    for (int e = 0; e < 4; ++e) {
                        const float lbe = lb[4 * eh + e];
                        const float f = lbe + (1.0f - lbe) * __builtin_amdgcn_rcpf(1.0f + __expf(-f4[e]));
                        float sc = __logf(f);
                        sc += __builtin_bit_cast(float, __builtin_amdgcn_update_dpp(0, __builtin_bit_cast(int, sc), 0x111, 0xf, 0xf, true));
                        sc += __builtin_bit_cast(float, __builtin_amdgcn_update_dpp(0, __builtin_bit_cast(int, sc), 0x112, 0xf, 0xf, true));
                        sc += __builtin_bit_cast(float, __builtin_amdgcn_update_dpp(0, __builtin_bit_cast(int, sc), 0x114, 0xf, 0xf, true));
                        sc += __builtin_bit_cast(float, __builtin_amdgcn_update_dpp(0, __builtin_bit_cast(int, sc), 0x118, 0xf, 0xf, true));
                        if (mm == 1) sc += tot0[e];
                        bl[e] = sc;
                        qo[e] = silu1(q4[e]) * __expf(sc); ko[e] = (1.0f - f) * __expf(fminf(-sc, 80.0f));
                    }
                    *(uint2*)(hq + (size_t)(mm * 16 + fr) * 128) = make_uint2(pk_bf16(qo[0], qo[1]), pk_bf16(qo[2], qo[3]));
                    *(uint2*)(hk + (size_t)(mm * 16 + fr) * 128) = make_uint2(pk_bf16(ko[0], ko[1]), pk_bf16(ko[2], ko[3]));
                    if (mm == 0) {
#pragma unroll
                        for (int e = 0; e < 4; ++e) tot0[e] = __shfl(bl[e], (lane & 48) | 15);
                    } else if (fr == 15) *(f32x4*)(HG + tile * 128 + k0 + 4 * eh) = (f32x4){__expf(bl[0]), __expf(bl[1]), __expf(bl[2]), __expf(bl[3])};
                    __builtin_amdgcn_sched_barrier(0);
                }
            }
        }
    }
};
struct EpiResid {
    static constexpr bool PERM = true, AFTER_DRAIN = false, MIDSCALE = true;
    bf16_t* R1; const float* X; const float* mod_g;
    static constexpr int NTOK_ = 32768;
    float alpha; bf16_t* AP; const float* avec; float* stat;
    const float* ssq; float rms_eps;
    __device__ __forceinline__ void midscale(f32x4 (&acc)[2][2][4][2], const Unit& u, int wr, int fr) const {
        const float* sp = ssq + u.pm * BM + wr * 64 + fr;
#pragma unroll
        for (int ai = 0; ai < 2; ++ai)
#pragma unroll
            for (int m = 0; m < 4; ++m) {
                const float rs = rsqrtf(sp[ai * HALF + m * 16] * (1.0f / 512.0f) + rms_eps);
#pragma unroll
                for (int bj = 0; bj < 2; ++bj)
#pragma unroll
                    for (int n = 0; n < 2; ++n) acc[ai][bj][m][n] *= rs;
            }
    }
    __device__ __forceinline__ void operator()(const f32x4 (&acc)[2][2][4][2], const Unit& u, int wr, int wc, int fr, int fq) const {
        const int row0 = u.pm * BM + wr * 64 + fr, col0 = u.pn * BM + wc * 32 + 8 * fq, bat = (u.pm * BM) / 2048;
        const float* gb = mod_g + (size_t)bat * 6144 + col0;
        const float* ab = avec + (size_t)bat * 1024 + col0;
        float s1[2][4], s2[2][4];
#pragma unroll
        for (int ai = 0; ai < 2; ++ai)
#pragma unroll
            for (int m = 0; m < 4; ++m) { s1[ai][m] = 0.f; s2[ai][m] = 0.f; }
#pragma unroll
        for (int bj = 0; bj < 2; ++bj) {
            const f32x4 g0 = *(const f32x4*)(gb + bj * HALF) + 1.0f, g1 = *(const f32x4*)(gb + bj * HALF + 4) + 1.0f;
            const f32x4 a0 = *(const f32x4*)(ab + bj * HALF), a1 = *(const f32x4*)(ab + bj * HALF + 4);
#pragma unroll
            for (int ai = 0; ai < 2; ++ai)
#pragma unroll
                for (int m = 0; m < 4; ++m) { const size_t ro = (size_t)(row0 + ai * HALF + m * 16) * 1024 + col0 + bj * HALF;
                    const f32x4 x0 = *(const f32x4*)(X + ro), x1 = *(const f32x4*)(X + ro + 4);
                    const f32x4 r0 = alpha * x0 + g0 * acc[ai][bj][m][0], r1 = alpha * x1 + g1 * acc[ai][bj][m][1];
                    u32x4 w; w.x = pk_bf16(r0[0], r0[1]); w.y = pk_bf16(r0[2], r0[3]); w.z = pk_bf16(r1[0], r1[1]); w.w = pk_bf16(r1[2], r1[3]);
                    *(u32x4*)(R1 + ro) = w;
                    const f32x4 p0 = r0 * a0, p1 = r1 * a1;
                    w.x = pk_bf16(p0[0], p0[1]); w.y = pk_bf16(p0[2], p0[3]); w.z = pk_bf16(p1[0], p1[1]); w.w = pk_bf16(p1[2], p1[3]);
                    *(u32x4*)(AP + ro) = w;
                    s1[ai][m] += ((r0[0] + r0[1]) + (r0[2] + r0[3])) + ((r1[0] + r1[1]) + (r1[2] + r1[3]));
                    s2[ai][m] += ((r0[0] * r0[0] + r0[1] * r0[1]) + (r0[2] * r0[2] + r0[3] * r0[3])) + ((r1[0] * r1[0] + r1[1] * r1[1]) + (r1[2] * r1[2] + r1[3] * r1[3]));
                }
        }
        const bool hi5 = fq & 2, hi4 = fq & 1;
#pragma unroll
        for (int ai = 0; ai < 2; ++ai) {
            const float a1 = (hi5 ? s1[ai][2] : s1[ai][0]) + __shfl_xor(hi5 ? s1[ai][0] : s1[ai][2], 32), b1 = (hi5 ? s1[ai][3] : s1[ai][1]) + __shfl_xor(hi5 ? s1[ai][1] : s1[ai][3], 32);
            const float a2 = (hi5 ? s2[ai][2] : s2[ai][0]) + __shfl_xor(hi5 ? s2[ai][0] : s2[ai][2], 32), b2 = (hi5 ? s2[ai][3] : s2[ai][1]) + __shfl_xor(hi5 ? s2[ai][1] : s2[ai][3], 32);
            const float t1 = (hi4 ? b1 : a1) + __shfl_xor(hi4 ? a1 : b1, 16), t2 = (hi4 ? b2 : a2) + __shfl_xor(hi4 ? a2 : b2, 16);
            const int srow = u.pm * BM + wr * 64 + ai * HALF + fq * 16 + fr;
            atomicAdd(stat + srow, t1); atomicAdd(stat + NTOK_ + srow, t2);
        }
    }
};
struct EpiQLN {
    static constexpr bool PERM = true, AFTER_DRAIN = false, MIDSCALE = false;
    bf16_t* O; const float* stat; const float* ca; const float* cb; float eps;
    __device__ __forceinline__ void operator()(const f32x4 (&acc)[2][2][4][2], const Unit& u, int wr, int wc, int fr, int fq) const {
        const int row0 = u.pm * BM + wr * 64 + fr, col0 = u.pn * BM + wc * 32 + 8 * fq, bat = (u.pm * BM) / 2048;
        const float* cap = ca + (size_t)bat * 2048 + col0;
        const float* cbp = cb + (size_t)bat * 2048 + col0;
#pragma unroll
        for (int bj = 0; bj < 2; ++bj) {
            const f32x4 a0 = *(const f32x4*)(cap + bj * HALF), a1 = *(const f32x4*)(cap + bj * HALF + 4), b0 = *(const f32x4*)(cbp + bj * HALF), b1 = *(const f32x4*)(cbp + bj * HALF + 4);
#pragma unroll
            for (int ai = 0; ai < 2; ++ai)
#pragma unroll
                for (int m = 0; m < 4; ++m) {
                    const int row = row0 + ai * HALF + m * 16;
                    const float mu = stat[row] * (1.0f / 1024.0f), rstd = rsqrtf(fmaxf(stat[32768 + row] * (1.0f / 1024.0f) - mu * mu, 0.f) + eps);
                    const f32x4 v0 = rstd * (acc[ai][bj][m][0] - mu * a0) + b0, v1 = rstd * (acc[ai][bj][m][1] - mu * a1) + b1;
                    u32x4 w; w.x = pk_bf16(v0[0], v0[1]); w.y = pk_bf16(v0[2], v0[3]); w.z = pk_bf16(v1[0], v1[1]); w.w = pk_bf16(v1[2], v1[3]);
                    *(u32x4*)(O + (size_t)row * 2048 + col0 + bj * HALF) = w;
                }
        }
    }
};
struct EpiGluA2 {
    static constexpr bool PERM = true, AFTER_DRAIN = false, MIDSCALE = false;
    bf16_t* A2; const bf16_t* Y; const float* bias; const float* nw; float* ssq;
    __device__ __forceinline__ void operator()(const f32x4 (&acc)[2][2][4][2], const Unit& u, int wr, int wc, int fr, int fq) const {
        const int row0 = u.pm * BM + wr * 64 + fr, col0 = u.pn * BM + wc * 32 + 8 * fq;
        float s2[2][4];
#pragma unroll
        for (int ai = 0; ai < 2; ++ai)
#pragma unroll
            for (int m = 0; m < 4; ++m) s2[ai][m] = 0.f;
#pragma unroll
        for (int bj = 0; bj < 2; ++bj) {
            const f32x4 bv0 = *(const f32x4*)(bias + col0 + bj * HALF), bv1 = *(const f32x4*)(bias + col0 + bj * HALF + 4);
            const f32x4 wv0 = *(const f32x4*)(nw + col0 + bj * HALF), wv1 = *(const f32x4*)(nw + col0 + bj * HALF + 4);
#pragma unroll
            for (int ai = 0; ai < 2; ++ai)
#pragma unroll
                for (int m = 0; m < 4; ++m) { const int row = row0 + ai * HALF + m * 16;
                    const u32x4 yw = *(const u32x4*)(Y + (size_t)row * 512 + col0 + bj * HALF);
                    const f32x4 z0 = acc[ai][bj][m][0] + bv0, z1 = acc[ai][bj][m][1] + bv1;
                    f32x4 o0, o1;
                    o0[0] = __uint_as_float(yw.x << 16) * __builtin_amdgcn_rcpf(1.0f + __expf(-z0[0])); o0[1] = __uint_as_float(yw.x & 0xffff0000u) * __builtin_amdgcn_rcpf(1.0f + __expf(-z0[1]));
                    o0[2] = __uint_as_float(yw.y << 16) * __builtin_amdgcn_rcpf(1.0f + __expf(-z0[2])); o0[3] = __uint_as_float(yw.y & 0xffff0000u) * __builtin_amdgcn_rcpf(1.0f + __expf(-z0[3]));
                    o1[0] = __uint_as_float(yw.z << 16) * __builtin_amdgcn_rcpf(1.0f + __expf(-z1[0])); o1[1] = __uint_as_float(yw.z & 0xffff0000u) * __builtin_amdgcn_rcpf(1.0f + __expf(-z1[1]));
                    o1[2] = __uint_as_float(yw.w << 16) * __builtin_amdgcn_rcpf(1.0f + __expf(-z1[2])); o1[3] = __uint_as_float(yw.w & 0xffff0000u) * __builtin_amdgcn_rcpf(1.0f + __expf(-z1[3]));
                    s2[ai][m] += (o0[0] * o0[0] + o0[1] * o0[1]) + (o0[2] * o0[2] + o0[3] * o0[3]) + (o1[0] * o1[0] + o1[1] * o1[1]) + (o1[2] * o1[2] + o1[3] * o1[3]);
                    const f32x4 p0 = o0 * wv0, p1 = o1 * wv1;
                    u32x4 w; w.x = pk_bf16(p0[0], p0[1]); w.y = pk_bf16(p0[2], p0[3]); w.z = pk_bf16(p1[0], p1[1]); w.w = pk_bf16(p1[2], p1[3]);
                    *(u32x4*)(A2 + (size_t)row * 1024 + col0 + bj * HALF) = w;
                }
        }
        const bool hi5 = fq & 2, hi4 = fq & 1;
#pragma unroll
        for (int ai = 0; ai < 2; ++ai) {
            const float a2 = (hi5 ? s2[ai][2] : s2[ai][0]) + __shfl_xor(hi5 ? s2[ai][0] : s2[ai][2], 32), b2 = (hi5 ? s2[ai][3] : s2[ai][1]) + __shfl_xor(hi5 ? s2[ai][1] : s2[ai][3], 32);
            const float t2 = (hi4 ? b2 : a2) + __shfl_xor(hi4 ? a2 : b2, 16);
            atomicAdd(ssq + u.pm * BM + wr * 64 + ai * HALF + fq * 16 + fr, t2);
        }
    }
};
}

DI void prep_mod_item(const Params& p, int item, char* smem) {
    float* condT = (float*)smem;
    float* red = condT + DM * 16;
    const int tid = my_tid();
    for (int i = tid; i < NB * DM; i += NTH) { const int b = i >> 10, k = i & 1023; condT[k * 16 + b] = siluf_(p.c[i]); }
    __syncthreads();
    const int ks = tid >> 5, col = tid & 31;
    float acc[16];
#pragma unroll
    for (int b = 0; b < 16; ++b) acc[b] = 0.f;
    const float* w = p.ada_w + (size_t)(ks * 64) * 6144 + item * 32 + col;
#pragma unroll 1
    for (int seg = 0; seg < 4; ++seg) {
        float wreg[16];
#pragma unroll
        for (int k = 0; k < 16; ++k) wreg[k] = w[(size_t)(seg * 16 + k) * 6144];
#pragma unroll
        for (int k = 0; k < 16; ++k) {
            const float wv = wreg[k];
            const f32x4* cb = (const f32x4*)(condT + (ks * 64 + seg * 16 + k) * 16);
            const f32x4 c0 = cb[0], c1 = cb[1], c2 = cb[2], c3 = cb[3];
            acc[0] += c0.x * wv; acc[1] += c0.y * wv; acc[2] += c0.z * wv; acc[3] += c0.w * wv;
            acc[4] += c1.x * wv; acc[5] += c1.y * wv; acc[6] += c1.z * wv; acc[7] += c1.w * wv;
            acc[8] += c2.x * wv; acc[9] += c2.y * wv; acc[10] += c2.z * wv; acc[11] += c2.w * wv;
            acc[12] += c3.x * wv; acc[13] += c3.y * wv; acc[14] += c3.z * wv; acc[15] += c3.w * wv;
        }
    }
#pragma unroll
    for (int b = 0; b < 16; ++b) red[(ks * 32 + col) * 16 + b] = acc[b];
    __syncthreads();
    {
        const int b = tid >> 5;
        float sum = p.ada_b[item * 32 + col];
#pragma unroll
        for (int q = 0; q < 16; ++q) sum += red[(q * 32 + col) * 16 + b];
        ((float*)(p.ws + OFF_MOD))[b * 6144 + item * 32 + col] = sum;
    }
    __syncthreads();
}
DI void prep_s5_gemm_item(const Params& p, int g, int part, char* smem) {
    f32x2* pw = (f32x2*)smem;
    f32x2* bbL = pw + 17 * 64;
    f32x2* cL = bbL + 64 * 16;
    const int tid = my_tid();
    const float dt = expf(p.log_dt[g]);
#pragma unroll 1
    for (int idx = tid; idx < 17 * 64; idx += NTH) {
        const int j = idx >> 6, pp = idx & 63;
        const float ar = p.a_re[g * 64 + pp], ai = p.a_im[g * 64 + pp];
        const float mag = expf(ar * dt * (float)j), ang = ai * dt * (float)j;
        pw[idx] = (f32x2){mag * cosf(ang), mag * sinf(ang)};
    }
    for (int idx = tid; idx < 16 * 64; idx += NTH) { const int i = idx >> 6, pp = idx & 63; cL[idx] = (f32x2){p.c_re[(g * 16 + i) * 64 + pp], p.c_im[(g * 16 + i) * 64 + pp]}; }
    __syncthreads();
    for (int idx = tid; idx < 64 * 16; idx += NTH) {
        const int pp = idx >> 4, i = idx & 15;
        const float ar = p.a_re[g * 64 + pp], ai = p.a_im[g * 64 + pp];
        const f32x2 lam = pw[64 + pp];
        const float den = ar * ar + ai * ai, nr = lam.x - 1.0f, ni = lam.y;
        const float zr = (nr * ar + ni * ai) / den, zi = (ni * ar - nr * ai) / den;
        const float br = p.b_re[(g * 64 + pp) * 16 + i], bi = p.b_im[(g * 64 + pp) * 16 + i];
        bbL[idx] = (f32x2){zr * br - zi * bi, zr * bi + zi * br};
    }
    __syncthreads();
    bf16_t* NBg = (bf16_t*)(p.ws + OFF_S5N) + (size_t)g * 128 * 256;
    if (part == 0)
#pragma unroll 1
    for (int ch = tid; ch < 128 * 256 / 8; ch += NTH) {
        const int pq = ch >> 5, t = (ch >> 1) & 15, i0 = (ch & 1) * 8, pp = pq & 63;
        const f32x2 w = pw[(15 - t) * 64 + pp];
        float v[8];
#pragma unroll
        for (int e = 0; e < 8; ++e) { const f32x2 bb = bbL[pp * 16 + i0 + e]; v[e] = pq < 64 ? (w.x * bb.x - w.y * bb.y) : (w.x * bb.y + w.y * bb.x); }
        u32x4 o; o.x = pack2(v[0], v[1]); o.y = pack2(v[2], v[3]); o.z = pack2(v[4], v[5]); o.w = pack2(v[6], v[7]);
        *(u32x4*)(NBg + (size_t)((((pq >> 5) * 16 + t) * 64) + (i0 >> 3) * 32 + (pq & 31)) * 8) = o;
    }
    bf16_t* MBg = (bf16_t*)(p.ws + OFF_S5M) + (size_t)g * 256 * 128;
    if (part == 1)
#pragma unroll 1
    for (int ch = tid; ch < 256 * 128 / 8; ch += NTH) {
        const int ti = ch >> 4, p0 = (ch & 15) * 8, tq = ti >> 4, iq = ti & 15;
        float v[8];
#pragma unroll
        for (int e = 0; e < 8; ++e) {
            const int pq = p0 + e, pp = pq & 63;
            const f32x2 c = cL[iq * 64 + pp], w = pw[(tq + 1) * 64 + pp];
            v[e] = pq < 64 ? (c.x * w.x - c.y * w.y) : -(c.x * w.y + c.y * w.x);
        }
        u32x4 o; o.x = pack2(v[0], v[1]); o.y = pack2(v[2], v[3]); o.z = pack2(v[4], v[5]); o.w = pack2(v[6], v[7]);
        *(u32x4*)(MBg + (size_t)((((ti >> 5) * 8 + (p0 >> 4)) * 64) + ((p0 >> 3) & 1) * 32 + (ti & 31)) * 8) = o;
    }
    bf16_t* KTg = (bf16_t*)(p.ws + OFF_S5K) + (size_t)g * 4096;
    if (part >= 2)
#pragma unroll 1
    for (int idx = (part - 2) * 2048 + tid; idx < (part - 1) * 2048; idx += NTH) {
        const int lag = idx >> 8, iq = (idx >> 4) & 15, i = idx & 15;
        float acc = (lag == 0 && iq == i) ? p.dsk[g * 16 + iq] : 0.f;
#pragma unroll 4
        for (int pp = 0; pp < 64; ++pp) {
            const f32x2 c = cL[iq * 64 + pp], w = pw[lag * 64 + pp], bb = bbL[pp * 16 + i];
            const float mr = c.x * w.x - c.y * w.y, mi_ = c.x * w.y + c.y * w.x;
            acc += mr * bb.x - mi_ * bb.y;
        }
        KTg[idx] = f2bf(acc);
    }
    if (part == 3 && tid < 64) { float* L = (float*)(p.ws + OFF_S5L) + (g * 64 + tid) * 2; const f32x2 w = pw[16 * 64 + tid]; L[0] = w.x; L[1] = w.y; }
    __syncthreads();
}
DI void prep_s5_item(const Params& p, int g) {
    const int tid = my_tid();
    if (tid < SSP) {
        const int pi = g * SSP + tid;
        const float dt = expf(p.log_dt[g]);
        const float ar = p.a_re[pi], ai = p.a_im[pi];
        const float mag = expf(ar * dt);
        const float lr = mag * cosf(ai * dt), li = mag * sinf(ai * dt);
        const float den = ar * ar + ai * ai, nr = lr - 1.0f, ni = li;
        const float zr = (nr * ar + ni * ai) / den, zi = (ni * ar - nr * ai) / den;
        float* lam = (float*)(p.ws + OFF_LAM) + pi * 2;
        lam[0] = lr; lam[1] = li;
        float* bb = (float*)(p.ws + OFF_BB) + (size_t)pi * 32;
        for (int i = 0; i < SSC; ++i) {
            const float br = p.b_re[pi * SSC + i], bi = p.b_im[pi * SSC + i];
            bb[i * 2] = zr * br - zi * bi; bb[i * 2 + 1] = zr * bi + zi * br;
        }
    }
}
DI void prep_transpose_tile(const float* __restrict__ W, bf16_t* __restrict__ Wt, int K, int N, int kt, int nt, char* smem, int dst_row0 = -1, int kswap = 0) {
    float* tile = (float*)smem;
    const int tid = my_tid();
#pragma unroll
    for (int q = 0; q < 2; ++q) {
        const int kk = (tid >> 4) + q * 32, c4 = (tid & 15) * 4;
        const float4 v = *(const float4*)(W + (size_t)(kt * 64 + kk) * N + nt * 64 + c4);
        tile[kk * 65 + c4] = v.x; tile[kk * 65 + c4 + 1] = v.y; tile[kk * 65 + c4 + 2] = v.z; tile[kk * 65 + c4 + 3] = v.w;
    }
    __syncthreads();
    const int n = tid >> 3, kc = tid & 7;
    uint4 o;
    o.x = pack2(tile[(kc * 8 + 0) * 65 + n], tile[(kc * 8 + 1) * 65 + n]);
    o.y = pack2(tile[(kc * 8 + 2) * 65 + n], tile[(kc * 8 + 3) * 65 + n]);
    o.z = pack2(tile[(kc * 8 + 4) * 65 + n], tile[(kc * 8 + 5) * 65 + n]);
    o.w = pack2(tile[(kc * 8 + 6) * 65 + n], tile[(kc * 8 + 7) * 65 + n]);
    *(uint4*)(Wt + (size_t)((dst_row0 < 0 ? nt * 64 : dst_row0) + n) * K + ((kt * 64 + kswap) & (K - 1)) + kc * 8) = o;
    __syncthreads();
}
DI void cvt_bf16_stream(const float* __restrict__ src, bf16_t* __restrict__ dst, size_t n8, int bid, int nb) {
    for (size_t i = (size_t)bid * NTH + my_tid(); i < n8; i += (size_t)nb * NTH) {
        const float4 a = *(const float4*)(src + i * 8), b = *(const float4*)(src + i * 8 + 4);
        uint4 o; o.x = pack2(a.x, a.y); o.y = pack2(a.z, a.w); o.z = pack2(b.x, b.y); o.w = pack2(b.z, b.w);
        *(uint4*)(dst + i * 8) = o;
    }
}
DI void cvt_fp8_rows(const float* __restrict__ src, unsigned char* __restrict__ dst, float* __restrict__ inv, int bid, int nb) {
    const int lane = my_tid() & 63, wid = my_tid() >> 6;
    for (int row = bid * 8 + wid; row < NEXP; row += nb * 8) {
        const float* sp = src + (size_t)row * DM + lane * 16;
        const f32x4 a = *(const f32x4*)sp, b = *(const f32x4*)(sp + 4), c = *(const f32x4*)(sp + 8), d = *(const f32x4*)(sp + 12);
        float m = fmaxf(fmaxf(fmaxf(fabsf(a.x), fabsf(a.y)), fmaxf(fabsf(a.z), fabsf(a.w))), fmaxf(fmaxf(fabsf(b.x), fabsf(b.y)), fmaxf(fabsf(b.z), fabsf(b.w))));
        m = fmaxf(m, fmaxf(fmaxf(fmaxf(fabsf(c.x), fabsf(c.y)), fmaxf(fabsf(c.z), fabsf(c.w))), fmaxf(fmaxf(fabsf(d.x), fabsf(d.y)), fmaxf(fabsf(d.z), fabsf(d.w)))));
#pragma unroll
        for (int s = 1; s < 64; s <<= 1) m = fmaxf(m, __shfl_xor(m, s));
        float sc = 1.f, isc = 1.f;
        if (m > 1e-30f) {
            int k = (int)floorf(log2f(448.0f / m));
            k = k < -60 ? -60 : (k > 60 ? 60 : k);
            sc = ldexpf(1.0f, k); isc = ldexpf(1.0f, -k);
            if (m * sc > 448.0f) { sc *= 0.5f; isc *= 2.0f; }
        }
        u32x4 o;
        int w;
        w = __builtin_amdgcn_cvt_pk_fp8_f32(a.x * sc, a.y * sc, 0, false); w = __builtin_amdgcn_cvt_pk_fp8_f32(a.z * sc, a.w * sc, w, true); o.x = (unsigned)w;
        w = __builtin_amdgcn_cvt_pk_fp8_f32(b.x * sc, b.y * sc, 0, false); w = __builtin_amdgcn_cvt_pk_fp8_f32(b.z * sc, b.w * sc, w, true); o.y = (unsigned)w;
        w = __builtin_amdgcn_cvt_pk_fp8_f32(c.x * sc, c.y * sc, 0, false); w = __builtin_amdgcn_cvt_pk_fp8_f32(c.z * sc, c.w * sc, w, true); o.z = (unsigned)w;
        w = __builtin_amdgcn_cvt_pk_fp8_f32(d.x * sc, d.y * sc, 0, false); w = __builtin_amdgcn_cvt_pk_fp8_f32(d.z * sc, d.w * sc, w, true); o.w = (unsigned)w;
        *(u32x4*)(dst + (size_t)row * DM + lane * 16) = o;
        if (lane == 0) inv[row] = isc;
    }
}
DI void cvt_fp4_rows(const float* __restrict__ src, unsigned char* __restrict__ dst, float* __restrict__ inv, int bid, int nb) {
    const int lane = my_tid() & 63, wid = my_tid() >> 6;
    for (int row = bid * 8 + wid; row < NEXP; row += nb * 8) {
        const float* sp = src + (size_t)row * DM + lane * 16;
        const f32x4 a = *(const f32x4*)sp, b = *(const f32x4*)(sp + 4), c = *(const f32x4*)(sp + 8), d = *(const f32x4*)(sp + 12);
        float m = fmaxf(fmaxf(fmaxf(fabsf(a.x), fabsf(a.y)), fmaxf(fabsf(a.z), fabsf(a.w))), fmaxf(fmaxf(fabsf(b.x), fabsf(b.y)), fmaxf(fabsf(b.z), fabsf(b.w))));
        m = fmaxf(m, fmaxf(fmaxf(fmaxf(fabsf(c.x), fabsf(c.y)), fmaxf(fabsf(c.z), fabsf(c.w))), fmaxf(fmaxf(fabsf(d.x), fabsf(d.y)), fmaxf(fabsf(d.z), fabsf(d.w)))));
#pragma unroll
        for (int s = 1; s < 64; s <<= 1) m = fmaxf(m, __shfl_xor(m, s));
        const float sc = m > 1e-30f ? 6.0f / m : 1.0f, isc = m > 1e-30f ? m * (1.0f / 6.0f) : 1.0f;
        unsigned w0 = 0u, w1 = 0u;
        w0 = __builtin_amdgcn_cvt_scalef32_pk_fp4_f32(w0, a.x * sc, a.y * sc, 1.0f, 0); w0 = __builtin_amdgcn_cvt_scalef32_pk_fp4_f32(w0, a.z * sc, a.w * sc, 1.0f, 1);
        w0 = __builtin_amdgcn_cvt_scalef32_pk_fp4_f32(w0, b.x * sc, b.y * sc, 1.0f, 2); w0 = __builtin_amdgcn_cvt_scalef32_pk_fp4_f32(w0, b.z * sc, b.w * sc, 1.0f, 3);
        w1 = __builtin_amdgcn_cvt_scalef32_pk_fp4_f32(w1, c.x * sc, c.y * sc, 1.0f, 0); w1 = __builtin_amdgcn_cvt_scalef32_pk_fp4_f32(w1, c.z * sc, c.w * sc, 1.0f, 1);
        w1 = __builtin_amdgcn_cvt_scalef32_pk_fp4_f32(w1, d.x * sc, d.y * sc, 1.0f, 2); w1 = __builtin_amdgcn_cvt_scalef32_pk_fp4_f32(w1, d.z * sc, d.w * sc, 1.0f, 3);
        *(uint2*)(dst + (size_t)row * (DM / 2) + lane * 8) = make_uint2(w0, w1);
        if (lane == 0) inv[row] = isc;
    }
}
template <int OFFS>
DI void cvt_i8_rows(const float* __restrict__ src, unsigned char* __restrict__ dst, float* __restrict__ inv, int bid, int nb) {
    const int lane = my_tid() & 63, wid = my_tid() >> 6;
    for (int row = bid * 8 + wid; row < NEXP; row += nb * 8) {
        const float* sp = src + (size_t)row * DM + lane * 16;
        const f32x4 a = *(const f32x4*)sp, b = *(const f32x4*)(sp + 4), c = *(const f32x4*)(sp + 8), d = *(const f32x4*)(sp + 12);
        float m = fmaxf(fmaxf(fmaxf(fabsf(a.x), fabsf(a.y)), fmaxf(fabsf(a.z), fabsf(a.w))), fmaxf(fmaxf(fabsf(b.x), fabsf(b.y)), fmaxf(fabsf(b.z), fabsf(b.w))));
        m = fmaxf(m, fmaxf(fmaxf(fmaxf(fabsf(c.x), fabsf(c.y)), fmaxf(fabsf(c.z), fabsf(c.w))), fmaxf(fmaxf(fabsf(d.x), fabsf(d.y)), fmaxf(fabsf(d.z), fabsf(d.w)))));
#pragma unroll
        for (int s = 1; s < 64; s <<= 1) m = fmaxf(m, __shfl_xor(m, s));
        const float sc = m > 1e-30f ? 127.0f / m : 1.0f, isc = m > 1e-30f ? m * (1.0f / 127.0f) : 1.0f;
        const float v[16] = {a.x, a.y, a.z, a.w, b.x, b.y, b.z, b.w, c.x, c.y, c.z, c.w, d.x, d.y, d.z, d.w};
        unsigned w[4];
#pragma unroll
        for (int q = 0; q < 4; ++q) {
            unsigned pk = 0u;
#pragma unroll
            for (int e = 0; e < 4; ++e) { const int qi = (int)rintf(v[q * 4 + e] * sc) + OFFS; pk |= ((unsigned)qi & 0xffu) << (8 * e); }
            w[q] = pk;
        }
        *(u32x4*)(dst + (size_t)row * DM + lane * 16) = (u32x4){w[0], w[1], w[2], w[3]};
        if (lane == 0) inv[row] = isc;
    }
}
DI void prep_cab_item(const Params& p, int item, char* smem) {
    float* vT = (float*)smem;
    float* red = vT + DM * 16;
    const float* mod = (const float*)(p.ws + OFF_MOD);
    const int tid = my_tid(), ks = tid >> 5, col = tid & 31;
    const float* w = p.w_q + (size_t)(ks * 64) * 2048 + item * 32 + col;
#pragma unroll 1
    for (int which = 0; which < 2; ++which) {
        for (int i = tid; i < NB * DM; i += NTH) {
            const int b = i >> 10, k = i & 1023;
            const float sc = 1.0f + mod[b * 6144 + 4096 + k];
            const float v = which == 0 ? p.ln1w[k] * sc : p.ln1b[k] * sc + mod[b * 6144 + 3072 + k];
            vT[k * 16 + b] = v;
            if (item == 0) ((float*)(p.ws + OFF_AB))[(size_t)which * NB * DM + i] = v;
        }
        __syncthreads();
        float acc[16];
#pragma unroll
        for (int b = 0; b < 16; ++b) acc[b] = 0.f;
#pragma unroll 1
        for (int seg = 0; seg < 4; ++seg) {
            float wreg[16];
#pragma unroll
            for (int k = 0; k < 16; ++k) wreg[k] = w[(size_t)(seg * 16 + k) * 2048];
#pragma unroll
            for (int k = 0; k < 16; ++k) {
                const float wv = wreg[k];
                const f32x4* cb = (const f32x4*)(vT + (ks * 64 + seg * 16 + k) * 16);
                const f32x4 c0 = cb[0], c1 = cb[1], c2 = cb[2], c3 = cb[3];
                acc[0] += c0.x * wv; acc[1] += c0.y * wv; acc[2] += c0.z * wv; acc[3] += c0.w * wv;
                acc[4] += c1.x * wv; acc[5] += c1.y * wv; acc[6] += c1.z * wv; acc[7] += c1.w * wv;
                acc[8] += c2.x * wv; acc[9] += c2.y * wv; acc[10] += c2.z * wv; acc[11] += c2.w * wv;
                acc[12] += c3.x * wv; acc[13] += c3.y * wv; acc[14] += c3.z * wv; acc[15] += c3.w * wv;
            }
        }
#pragma unroll
        for (int b = 0; b < 16; ++b) red[(ks * 32 + col) * 16 + b] = acc[b];
        __syncthreads();
        {
            const int b = tid >> 5;
            float sum = 0.f;
#pragma unroll
            for (int q = 0; q < 16; ++q) sum += red[(q * 32 + col) * 16 + b];
            ((float*)(p.ws + OFF_CAB))[(size_t)which * NB * 2048 + b * 2048 + item * 32 + col] = sum;
        }
        __syncthreads();
    }
}
DI void phase_h(const Params& p, int bid, int nb) {
    const float* mod = (const float*)(p.ws + OFF_MOD);
    bf16_t* H = (bf16_t*)(p.ws + OFF_H);
    const size_t n8 = (size_t)NTOK * DM / 8;
    for (size_t i = (size_t)bid * NTH + my_tid(); i < n8; i += (size_t)nb * NTH) {
        const int row = (int)(i >> 7), c0 = (int)(i & 127) * 8, b = row / SEQ;
        const float* sh = mod + b * 6144 + c0;
        const float* sc = sh + 1024;
        const float4 a = *(const float4*)(p.x + i * 8), bq = *(const float4*)(p.x + i * 8 + 4);
        const float4 s0 = *(const float4*)sc, s1 = *(const float4*)(sc + 4), h0 = *(const float4*)sh, h1 = *(const float4*)(sh + 4);
        uint4 o;
        o.x = pack2(a.x * (1.f + s0.x) + h0.x, a.y * (1.f + s0.y) + h0.y);
        o.y = pack2(a.z * (1.f + s0.z) + h0.z, a.w * (1.f + s0.w) + h0.w);
        o.z = pack2(bq.x * (1.f + s1.x) + h1.x, bq.y * (1.f + s1.y) + h1.y);
        o.w = pack2(bq.z * (1.f + s1.z) + h1.z, bq.w * (1.f + s1.w) + h1.w);
        *(uint4*)(H + i * 8) = o;
    }
}

DI int wq_next(unsigned* ctr, char* smem) {
    volatile unsigned* slot = (volatile unsigned*)(smem + SMEM_BYTES - 8);
    __syncthreads();
    if (__builtin_amdgcn_workitem_id_x() == 0) *slot = __hip_atomic_fetch_add(ctr, 1u, __ATOMIC_RELAXED, __HIP_MEMORY_SCOPE_AGENT);
    __syncthreads();
    return (int)*slot;
}
DI void phase_prep_a(const Params& p, char* smem) {
    unsigned* ctr = (unsigned*)(p.ws + OFF_BAR) + 120;
    constexpr int U_S5 = 192, U_LB = 320, U_TR = 321, U_UT = U_TR + 368, U_VT = U_UT + 128, U_MISC = U_VT + 128, U_END = U_MISC + 8;
    for (int raw = wq_next(ctr, smem); raw < U_END; raw = wq_next(ctr, smem)) {
        const int u = raw < 512 ? ((raw & 1) ? (raw >> 1) : U_UT + (raw >> 1)) : (raw < U_MISC ? 256 + (raw - 512) : raw);
        if (u < U_S5) prep_mod_item(p, u, smem);
        else if (u < U_LB) prep_s5_gemm_item(p, (u - U_S5) >> 2, (u - U_S5) & 3, smem);
        else if (u < U_TR) {
            const int j = my_tid();
            const float a0 = p.hg_lb[j], a1 = p.hg_lb[512 + j], m = fmaxf(a0, a1);
            const float e0 = expf(a0 - m), e1 = expf(a1 - m);
            ((float*)(p.ws + OFF_LB))[j] = e0 / (e0 + e1);
        } else if (u < U_UT) {
            for (int it = (u - U_TR) * 4; it < (u - U_TR) * 4 + 4; ++it) {
                constexpr int T_WIN = 16 * 40, T_GLU = 8 * 8, T_WOUT = 16 * 16;
                constexpr int I_GLU = T_WIN, I_WOUT = I_GLU + T_GLU, I_WQ = I_WOUT + T_WOUT;
                if (it < I_GLU) { const int t = it, n0 = (t % 40) * 64;
                    const int d0 = n0 < 512 ? (n0 >> 7) * 256 + (n0 & 127) : (n0 < 1024 ? ((n0 - 512) >> 7) * 256 + 128 + (n0 & 127) : n0);
                    prep_transpose_tile(p.w_in, (bf16_t*)(p.ws + OFF_WIN), DM, INC, t / 40, t % 40, smem, d0); }
                else if (it < I_WOUT) { const int t = it - I_GLU; prep_transpose_tile(p.glu_w, (bf16_t*)(p.ws + OFF_GLU), 512, 512, t / 8, t % 8, smem); }
                else if (it < I_WQ) { const int t = it - I_WOUT; prep_transpose_tile(p.w_out, (bf16_t*)(p.ws + OFF_WOUT), DM, DM, t / 16, t % 16, smem, -1, 512); }
                else { const int t = it - I_WQ; prep_transpose_tile(p.w_q, (bf16_t*)(p.ws + OFF_WQ), DM, 2048, t / 32, t % 32, smem); }
            }
        } else if (u < U_VT) cvt_i8_rows<0>(p.pu, (unsigned char*)(p.ws + OFF_UT), (float*)(p.ws + OFF_SU), u - U_UT, 128);
        else if (u < U_MISC) cvt_i8_rows<128>(p.pv, (unsigned char*)(p.ws + OFF_VT), (float*)(p.ws + OFF_SV), u - U_VT, 128);
        else {
            const int q = u - U_MISC;
            cvt_bf16_stream(p.subk, (bf16_t*)(p.ws + OFF_SUBK), (size_t)16 * 128 * 128 / 8, q, 8);
            for (size_t i = (size_t)q * NTH + my_tid(); i < (size_t)NTOK * 3 / 4; i += (size_t)8 * NTH) ((f32x4*)(p.ws + OFF_STAT))[i] = (f32x4){0.f, 0.f, 0.f, 0.f};
        }
    }
}
DI void phase_prep_b(const Params& p, char* smem) {
    unsigned* ctr = (unsigned*)(p.ws + OFF_BAR) + 121;
    for (int u = wq_next(ctr, smem); u < 64 + 256; u = wq_next(ctr, smem)) {
        if (u < 64) prep_cab_item(p, u, smem); else phase_h(p, u - 64, 256);
    }
}

DI void phase_proj(const Params& p, int bid, int nb, char* smem) {
    pg8::Gemm g{(const bf16_t*)(p.ws + OFF_H), (const bf16_t*)(p.ws + OFF_WIN), NTOK, INC, DM};
    pg8::StaticOrder S; S.init(NTOK, INC, nb, bid);
    pg8::EpiProj E{(bf16_t*)(p.ws + OFF_PROJ), (bf16_t*)(p.ws + OFF_HQ), (bf16_t*)(p.ws + OFF_HK), (float*)(p.ws + OFF_HG), (const float*)(p.ws + OFF_LB)};
    pg8::gemm_phase<pg8::EpiProj, pg8::StaticOrder, false>((PG8_LAS unsigned char*)smem, g, S, E, nullptr);
}

DI void hgrn_item(const Params& p, int item, char* smem) {
    const int vs = item & 7, hd = (item >> 3) & 3, b = item >> 5;
    const bf16_t* P = (const bf16_t*)(p.ws + OFF_PROJ);
    const float* lb = (const float*)(p.ws + OFF_LB) + hd * HDK;
    float* ORAW = (float*)(p.ws + OFF_ORAW);
    float* sq = (float*)smem;
    float* sf = sq + 32 * 128;
    float* sv = sf + 32 * 128;
    float* sp = sv + 32 * 16;
    const int tid = my_tid(), lane = tid & 63, wid = tid >> 6, kq = tid >> 4, v = tid & 15;
    float S0 = 0.f, S1 = 0.f, S2 = 0.f, S3 = 0.f;
    for (int t0 = 0; t0 < SEQ; t0 += 32) {
        for (int i = tid; i < 32 * 128; i += NTH) {
            const int t = i >> 7, k = i & 127;
            const bf16_t* row = P + (size_t)(b * SEQ + t0 + t) * INC + hd * HDK + k;
            sq[i] = bf2f(row[0]);
            const float l = lb[k];
            sf[i] = l + (1.0f - l) * sigmoidf_(bf2f(row[512]));
        }
        { const int t = tid >> 4; sv[tid] = bf2f(P[(size_t)(b * SEQ + t0 + t) * INC + 1024 + hd * HDK + vs * 16 + v]); }
        __syncthreads();
        for (int t = 0; t < 32; ++t) {
            const float4 f4 = *(const float4*)(sf + t * 128 + kq * 4), q4 = *(const float4*)(sq + t * 128 + kq * 4);
            const float vv = sv[t * 16 + v];
            S0 = f4.x * S0 + (1.0f - f4.x) * vv; S1 = f4.y * S1 + (1.0f - f4.y) * vv;
            S2 = f4.z * S2 + (1.0f - f4.z) * vv; S3 = f4.w * S3 + (1.0f - f4.w) * vv;
            float part = q4.x * S0 + q4.y * S1 + q4.z * S2 + q4.w * S3;
            part += __shfl_xor(part, 16); part += __shfl_xor(part, 32);
            if (lane < 16) sp[(t * 8 + wid) * 16 + v] = part;
        }
        __syncthreads();
        {
            const int t = tid >> 4;
            float o = 0.f;
#pragma unroll
            for (int w = 0; w < 8; ++w) o += sp[(t * 8 + w) * 16 + v];
            ORAW[(size_t)(b * SEQ + t0 + t) * DHG + hd * HDK + vs * 16 + v] = o;
        }
        __syncthreads();
    }
}
DI void s5_item(const Params& p, int item, char* smem) {
    const int oct = item & 3, b = item >> 2;
    const int tid = my_tid(), lane = tid & 63, wid = tid >> 6, g = oct * 8 + wid;
    const bf16_t* P = (const bf16_t*)(p.ws + OFF_PROJ);
    bf16_t* Y = (bf16_t*)(p.ws + OFF_YSSM);
    float* su = (float*)smem + wid * 64 * 16;
    const float* lam = (const float*)(p.ws + OFF_LAM) + (g * SSP + lane) * 2;
    const float lr = lam[0], li = lam[1];
    const float* bb = (const float*)(p.ws + OFF_BB) + (size_t)(g * SSP + lane) * 32;
    float bbr[16], bbi[16], cr[16], ci[16];
#pragma unroll
    for (int i = 0; i < 16; ++i) { bbr[i] = bb[2 * i]; bbi[i] = bb[2 * i + 1]; cr[i] = p.c_re[(g * SSC + i) * SSP + lane]; ci[i] = p.c_im[(g * SSC + i) * SSP + lane]; }
    const int ch = (lane >> 2) & 15;
    const float dch = p.dsk[g * SSC + ch];
    float xr = 0.f, xi = 0.f;
    for (int t0 = 0; t0 < SEQ; t0 += 64) {
        {
            const uint4* src = (const uint4*)(P + (size_t)(b * SEQ + t0 + lane) * INC + 2048 + g * SSC);
            const uint4 a = src[0], c = src[1];
            float* d = su + lane * 16;
            d[0] = bflo(a.x); d[1] = bfhi(a.x); d[2] = bflo(a.y); d[3] = bfhi(a.y); d[4] = bflo(a.z); d[5] = bfhi(a.z); d[6] = bflo(a.w); d[7] = bfhi(a.w);
            d[8] = bflo(c.x); d[9] = bfhi(c.x); d[10] = bflo(c.y); d[11] = bfhi(c.y); d[12] = bflo(c.z); d[13] = bfhi(c.z); d[14] = bflo(c.w); d[15] = bfhi(c.w);
        }
        __syncthreads();
        for (int t = 0; t < 64; ++t) {
            float u[16];
            const float4* us = (const float4*)(su + t * 16);
            const float4 u0 = us[0], u1 = us[1], u2 = us[2], u3 = us[3];
            u[0] = u0.x; u[1] = u0.y; u[2] = u0.z; u[3] = u0.w; u[4] = u1.x; u[5] = u1.y; u[6] = u1.z; u[7] = u1.w;
            u[8] = u2.x; u[9] = u2.y; u[10] = u2.z; u[11] = u2.w; u[12] = u3.x; u[13] = u3.y; u[14] = u3.z; u[15] = u3.w;
            float bur = 0.f, bui = 0.f;
#pragma unroll
            for (int i = 0; i < 16; ++i) { bur += bbr[i] * u[i]; bui += bbi[i] * u[i]; }
            const float nxr = lr * xr - li * xi + bur, nxi = lr * xi + li * xr + bui;
            xr = nxr; xi = nxi;
            float y[16];
#pragma unroll
            for (int i = 0; i < 16; ++i) y[i] = cr[i] * xr - ci[i] * xi;
            const bool b5 = lane & 32, b4 = lane & 16, b3 = lane & 8, b2 = lane & 4;
            float y8[8], y4[4], y2[2];
#pragma unroll
            for (int j = 0; j < 8; ++j) { const float keep = b5 ? y[8 + j] : y[j], send = b5 ? y[j] : y[8 + j]; y8[j] = keep + __shfl_xor(send, 32); }
#pragma unroll
            for (int j = 0; j < 4; ++j) { const float keep = b4 ? y8[4 + j] : y8[j], send = b4 ? y8[j] : y8[4 + j]; y4[j] = keep + __shfl_xor(send, 16); }
#pragma unroll
            for (int j = 0; j < 2; ++j) { const float keep = b3 ? y4[2 + j] : y4[j], send = b3 ? y4[j] : y4[2 + j]; y2[j] = keep + __shfl_xor(send, 8); }
            float y1;
            { const float keep = b2 ? y2[1] : y2[0], send = b2 ? y2[0] : y2[1]; y1 = keep + __shfl_xor(send, 4); }
            y1 += __shfl_xor(y1, 1); y1 += __shfl_xor(y1, 2);
            if ((lane & 3) == 0) {
                const float uu = su[t * 16 + ch];
                Y[(size_t)(b * SEQ + t0 + t) * DSS + g * SSC + ch] = f2bf(geluf_(y1 + dch * uu));
            }
        }
        __syncthreads();
    }
}
DI int crow(int i, int h) { return (i & 3) + 8 * (i >> 2) + 4 * h; }
DI void phase_hgprep(const Params& p, int bid, int nb) {
    const bf16_t* P = (const bf16_t*)(p.ws + OFF_PROJ);
    const float* lbp = (const float*)(p.ws + OFF_LB);
    const int tid = my_tid(), lane = tid & 63, wid = tid >> 6, tq = lane >> 4, cg = lane & 15;
#pragma unroll 1
    for (int it = bid * 8 + wid; it < 8192; it += nb * 8) {
        const int tile = it >> 1, c = tile & 63, hd = (tile >> 6) & 3, b = tile >> 8, k0 = (it & 1) * 64 + cg * 4;
        const bf16_t* base = P + (size_t)(b * SEQ + c * 32 + tq * 8) * INC + hd * HDK + k0;
        uint2 qw[8], fw[8];
#pragma unroll
        for (int tt = 0; tt < 8; ++tt) { qw[tt] = *(const uint2*)(base + (size_t)tt * INC); fw[tt] = *(const uint2*)(base + (size_t)tt * INC + 512); }
        const f32x4 l4 = *(const f32x4*)(lbp + hd * HDK + k0);
        const float lb4[4] = {l4.x, l4.y, l4.z, l4.w};
        float bl[8][4], kk[8][4], run[4];
#pragma unroll
        for (int e = 0; e < 4; ++e) run[e] = 0.f;
#pragma unroll
        for (int tt = 0; tt < 8; ++tt) {
            const float fl[4] = {bflo(fw[tt].x), bfhi(fw[tt].x), bflo(fw[tt].y), bfhi(fw[tt].y)};
#pragma unroll
            for (int e = 0; e < 4; ++e) {
                const float f = lb4[e] + (1.0f - lb4[e]) * sigmoidf_(fl[e]);
                run[e] += __logf(f); bl[tt][e] = run[e]; kk[tt][e] = 1.0f - f;
            }
        }
        float off[4], tot[4];
#pragma unroll
        for (int e = 0; e < 4; ++e) {
            const float t0 = __shfl(run[e], cg), t1 = __shfl(run[e], cg + 16), t2 = __shfl(run[e], cg + 32), t3 = __shfl(run[e], cg + 48);
            off[e] = (tq > 0 ? t0 : 0.f) + (tq > 1 ? t1 : 0.f) + (tq > 2 ? t2 : 0.f);
            tot[e] = (t0 + t1) + (t2 + t3);
        }
        bf16_t* HQ = (bf16_t*)(p.ws + OFF_HQ) + (size_t)tile * 4096 + (tq * 8) * 128 + k0;
        bf16_t* HK = (bf16_t*)(p.ws + OFF_HK) + (size_t)tile * 4096 + (tq * 8) * 128 + k0;
#pragma unroll
        for (int tt = 0; tt < 8; ++tt) {
            const float qv[4] = {bflo(qw[tt].x), bfhi(qw[tt].x), bflo(qw[tt].y), bfhi(qw[tt].y)};
            float qo[4], ko[4];
#pragma unroll
            for (int e = 0; e < 4; ++e) { const float bb = off[e] + bl[tt][e]; qo[e] = qv[e] * __expf(bb); ko[e] = kk[tt][e] * __expf(fminf(-bb, 80.0f)); }
            *(uint2*)(HQ + tt * 128) = make_uint2(pack2(qo[0], qo[1]), pack2(qo[2], qo[3]));
            *(uint2*)(HK + tt * 128) = make_uint2(pack2(ko[0], ko[1]), pack2(ko[2], ko[3]));
        }
        if (tq == 0) *(f32x4*)((float*)(p.ws + OFF_HG) + (size_t)tile * 128 + k0) = (f32x4){__expf(tot[0]), __expf(tot[1]), __expf(tot[2]), __expf(tot[3])};
    }
}
typedef short s16x4 __attribute__((ext_vector_type(4)));
DI bf16x8 cat8(const s16x4 lo, const s16x4 hi) { return (bf16x8){lo.x, lo.y, lo.z, lo.w, hi.x, hi.y, hi.z, hi.w}; }
DI s16x4 lds_tr(const char* a) { return __builtin_amdgcn_ds_read_tr16_b64_v4i16((__attribute__((address_space(3))) s16x4*)a); }
DI void hgrn_mfma_item(const Params& p, int item, char* smem) {
    constexpr int QP_OFF = 0, KP_OFF = 8704, V_OFF = 17408, G_OFF = 26112, BUF = 26624, OB_OFF = 3 * BUF, OB_STRIDE = 132, OB_BYTES = 32 * OB_STRIDE * 4;
    const int tid = my_tid(), lane = tid & 63, wid = tid >> 6, r = lane & 31, h = lane >> 5;
    const int b = item >> 2, hd = item & 3;
    const size_t tile0 = (size_t)item * 64;
    const bf16_t* HQ = (const bf16_t*)(p.ws + OFF_HQ) + tile0 * 4096;
    const bf16_t* HK = (const bf16_t*)(p.ws + OFF_HK) + tile0 * 4096;
    const bf16_t* PV = (const bf16_t*)(p.ws + OFF_PROJ) + (size_t)b * SEQ * INC + 1024 + hd * HDK;
    const float* HG = (const float*)(p.ws + OFF_HG) + tile0 * 128;
    bf16_t* A2out = (bf16_t*)(p.ws + OFF_A2) + (size_t)b * SEQ * DM + 512 + hd * HDK;
    const bf16_t* PG = (const bf16_t*)(p.ws + OFF_PROJ) + (size_t)b * SEQ * INC + 1536 + hd * HDK;
    const bool helper = wid >= 4;
    const int ht = tid - 256;
    const int i0 = ht, i1 = ht + 256;
    const int lo0 = (i0 >> 4) * 272 + (i0 & 15) * 16, lo1 = (i1 >> 4) * 272 + (i1 & 15) * 16;
    u32x4 A0, A1, A2, A3, A4, A5, A6, B0, B1, B2, B3, B4, B5, B6;
    A0 = A1 = A2 = A3 = A4 = A5 = A6 = B0 = B1 = B2 = B3 = B4 = B5 = B6 = (u32x4){0, 0, 0, 0};
    f32x16 S[4];
#pragma unroll
    for (int kb = 0; kb < 4; ++kb)
#pragma unroll
        for (int i = 0; i < 16; ++i) S[kb][i] = 0.f;
#define HG_LOAD(X, c_) { const size_t o_ = (size_t)(c_) * 4096; \
        X##0 = *(const u32x4*)(HQ + o_ + i0 * 8); X##1 = *(const u32x4*)(HQ + o_ + i1 * 8); \
        X##2 = *(const u32x4*)(HK + o_ + i0 * 8); X##3 = *(const u32x4*)(HK + o_ + i1 * 8); \
        X##4 = *(const u32x4*)(PV + (size_t)((c_) * 32 + (i0 >> 4)) * INC + (i0 & 15) * 8); X##5 = *(const u32x4*)(PV + (size_t)((c_) * 32 + (i1 >> 4)) * INC + (i1 & 15) * 8); \
        if (ht < 32) X##6 = *(const u32x4*)(HG + (size_t)(c_) * 128 + ht * 4); }
#define HG_STORE(X, buf_) { char* B_ = smem + (buf_) * BUF; \
        *(u32x4*)(B_ + QP_OFF + lo0) = X##0; *(u32x4*)(B_ + QP_OFF + lo1) = X##1; \
        *(u32x4*)(B_ + KP_OFF + lo0) = X##2; *(u32x4*)(B_ + KP_OFF + lo1) = X##3; \
        *(u32x4*)(B_ + V_OFF + lo0) = X##4; *(u32x4*)(B_ + V_OFF + lo1) = X##5; \
        if (ht < 32) *(u32x4*)(B_ + G_OFF + ht * 16) = X##6; }
    const int tq = (lane >> 2) & 3, tp = lane & 3, tg = lane >> 4;
    const int tr_nat = (8 * (tg >> 1) + tq) * 272 + (16 * (tg & 1) + 4 * tp) * 2;
    const int tr_krw = (4 * (tg >> 1) + tq) * 272 + (16 * (tg & 1) + 4 * tp) * 2;
    if (helper) { HG_LOAD(A, 0); HG_STORE(A, 0); HG_LOAD(A, 1); HG_STORE(A, 1); HG_LOAD(A, 2); HG_LOAD(B, 3); }
    __syncthreads();
#define HG_COMPUTE(c_) { \
        const char* B = smem + ((c_) % 3) * BUF; const int w = wid; \
        f32x16 pt; _Pragma("unroll") for (int i = 0; i < 16; ++i) pt[i] = 0.f; \
        _Pragma("unroll") for (int ks = 0; ks < 8; ++ks) { \
            const bf16x8 a = *(const bf16x8*)(B + KP_OFF + r * 272 + ks * 32 + h * 16); \
            const bf16x8 bq = *(const bf16x8*)(B + QP_OFF + r * 272 + ks * 32 + h * 16); \
            pt = __builtin_amdgcn_mfma_f32_32x32x16_bf16(a, bq, pt, 0, 0, 0); } \
        _Pragma("unroll") for (int i = 0; i < 16; ++i) if (crow(i, h) > r) pt[i] = 0.f; \
        f32x16 o; _Pragma("unroll") for (int i = 0; i < 16; ++i) o[i] = 0.f; \
        _Pragma("unroll") for (int sp = 0; sp < 2; ++sp) { \
            const char* vb = B + V_OFF + (16 * sp) * 272 + (32 * w) * 2 + tr_krw; \
            const bf16x8 bv = cat8(lds_tr(vb), lds_tr(vb + 8 * 272)); \
            o = __builtin_amdgcn_mfma_f32_32x32x16_bf16(pack8(pt, 8 * sp), bv, o, 0, 0, 0); } \
        _Pragma("unroll") for (int kb = 0; kb < 4; ++kb) _Pragma("unroll") for (int sp = 0; sp < 2; ++sp) { \
            const char* qb = B + QP_OFF + r * 272 + kb * 64 + sp * 32 + h * 8; \
            const bf16x8 aq = cat8(*(const s16x4*)qb, *(const s16x4*)(qb + 16)); \
            o = __builtin_amdgcn_mfma_f32_32x32x16_bf16(aq, pack8(S[kb], 8 * sp), o, 0, 0, 0); } \
        { float* ob_ = (float*)(smem + OB_OFF + ((c_) & 1) * OB_BYTES); _Pragma("unroll") for (int i = 0; i < 16; ++i) ob_[crow(i, h) * OB_STRIDE + 32 * w + r] = o[i]; } \
        bf16x8 bvn[2]; \
        _Pragma("unroll") for (int ks = 0; ks < 2; ++ks) { const char* vb = B + V_OFF + (16 * ks) * 272 + (32 * w) * 2 + tr_nat; bvn[ks] = cat8(lds_tr(vb), lds_tr(vb + 4 * 272)); } \
        _Pragma("unroll") for (int kb = 0; kb < 4; ++kb) { \
            _Pragma("unroll") for (int ks = 0; ks < 2; ++ks) { \
                const char* kp = B + KP_OFF + (16 * ks) * 272 + (32 * kb) * 2 + tr_nat; \
                const bf16x8 a = cat8(lds_tr(kp), lds_tr(kp + 4 * 272)); \
                S[kb] = __builtin_amdgcn_mfma_f32_32x32x16_bf16(a, bvn[ks], S[kb], 0, 0, 0); } \
            _Pragma("unroll") for (int j = 0; j < 4; ++j) { \
                const f32x4 g4 = *(const f32x4*)(B + G_OFF + (kb * 32 + 8 * j + 4 * h) * 4); \
                S[kb][4 * j] *= g4.x; S[kb][4 * j + 1] *= g4.y; S[kb][4 * j + 2] *= g4.z; S[kb][4 * j + 3] *= g4.w; } } }
    f32x4 nw0, nw1, nw2, nw3;
    nw0 = nw1 = nw2 = nw3 = (f32x4){0.f, 0.f, 0.f, 0.f};
    if (helper) { const float* nwp = p.hg_nw + hd * HDK + (ht & 7) * 16; nw0 = *(const f32x4*)nwp; nw1 = *(const f32x4*)(nwp + 4); nw2 = *(const f32x4*)(nwp + 8); nw3 = *(const f32x4*)(nwp + 12); }
#define HG_NORM(cc_) { const int t_ = ht >> 3, sg_ = ht & 7; \
        const float* ob_ = (const float*)(smem + OB_OFF + ((cc_) & 1) * OB_BYTES) + t_ * OB_STRIDE + sg_ * 16; \
        const f32x4 o0 = *(const f32x4*)ob_, o1 = *(const f32x4*)(ob_ + 4), o2 = *(const f32x4*)(ob_ + 8), o3 = *(const f32x4*)(ob_ + 12); \
        const u32x4 g0 = *(const u32x4*)(PG + (size_t)((cc_) * 32 + t_) * INC + sg_ * 16), g1 = *(const u32x4*)(PG + (size_t)((cc_) * 32 + t_) * INC + sg_ * 16 + 8); \
        float ss = (o0.x * o0.x + o0.y * o0.y + o0.z * o0.z + o0.w * o0.w) + (o1.x * o1.x + o1.y * o1.y + o1.z * o1.z + o1.w * o1.w) + (o2.x * o2.x + o2.y * o2.y + o2.z * o2.z + o2.w * o2.w) + (o3.x * o3.x + o3.y * o3.y + o3.z * o3.z + o3.w * o3.w); \
        ss += __shfl_xor(ss, 1); ss += __shfl_xor(ss, 2); ss += __shfl_xor(ss, 4); \
        const float rs_ = rsqrtf(ss * (1.0f / 128.0f) + RMS_EPS); \
        const f32x4 v0 = o0 * rs_ * nw0, v1 = o1 * rs_ * nw1, v2 = o2 * rs_ * nw2, v3 = o3 * rs_ * nw3; \
        u32x4 w0, w1; \
        w0.x = pack2(v0.x * bflo(g0.x), v0.y * bfhi(g0.x)); w0.y = pack2(v0.z * bflo(g0.y), v0.w * bfhi(g0.y)); w0.z = pack2(v1.x * bflo(g0.z), v1.y * bfhi(g0.z)); w0.w = pack2(v1.z * bflo(g0.w), v1.w * bfhi(g0.w)); \
        w1.x = pack2(v2.x * bflo(g1.x), v2.y * bfhi(g1.x)); w1.y = pack2(v2.z * bflo(g1.y), v2.w * bfhi(g1.y)); w1.z = pack2(v3.x * bflo(g1.z), v3.y * bfhi(g1.z)); w1.w = pack2(v3.z * bflo(g1.w), v3.w * bfhi(g1.w)); \
        bf16_t* dst_ = A2out + (size_t)((cc_) * 32 + t_) * DM + sg_ * 16; \
        *(u32x4*)dst_ = w0; *(u32x4*)(dst_ + 8) = w1; }
    for (int c = 0; c < 64; c += 2) {
        if (helper) { if (c + 2 < 64) HG_STORE(A, (c + 2) % 3); if (c + 4 < 64) HG_LOAD(A, c + 4); if (c > 0) HG_NORM(c - 1); } else HG_COMPUTE(c);
        __syncthreads();
        if (helper) { if (c + 3 < 64) HG_STORE(B, (c + 3) % 3); if (c + 5 < 64) HG_LOAD(B, c + 5); HG_NORM(c); } else HG_COMPUTE(c + 1);
        __syncthreads();
    }
    if (helper) HG_NORM(63);
    __syncthreads();
#undef HG_LOAD
#undef HG_STORE
#undef HG_COMPUTE
#undef HG_NORM
}
template <int NJ>
DI void s5_gemm2_tile(const bf16x8 (&af)[16], const bf16_t* KTl, const bf16_t* Xin, const bf16_t* MBg, bf16_t* Yout, bf16_t* stg, const int mi, const int r, const int h) {
    f32x16 y;
#pragma unroll
    for (int i = 0; i < 16; ++i) y[i] = 0.f;
    const int tsel = r >> 4, iq = r & 15;
    bf16x8 bm[8];
#pragma unroll
    for (int ks = 0; ks < 8; ++ks) bm[ks] = *(const bf16x8*)(MBg + (size_t)((NJ * 8 + ks) * 64 + h * 32 + r) * 8);
#pragma unroll
    for (int ks = 0; ks <= 2 * NJ; ++ks) {
        const bf16x8 bk = *(const bf16x8*)(KTl + ((2 * NJ + tsel - ks) * 16 + iq) * 16 + 8 * h);
        y = __builtin_amdgcn_mfma_f32_32x32x16_bf16(af[ks], bk, y, 0, 0, 0);
    }
    {
        bf16x8 bk = *(const bf16x8*)(KTl + iq * 16 + 8 * h);
        if (tsel == 0) bk = (bf16x8){0, 0, 0, 0, 0, 0, 0, 0};
        y = __builtin_amdgcn_mfma_f32_32x32x16_bf16(af[2 * NJ + 1], bk, y, 0, 0, 0);
    }
#pragma unroll
    for (int ks = 0; ks < 8; ++ks) {
        const bf16x8 a = *(const bf16x8*)(Xin + (mi * 32 + r) * 136 + ks * 16 + 8 * h);
        y = __builtin_amdgcn_mfma_f32_32x32x16_bf16(a, bm[ks], y, 0, 0, 0);
    }
#pragma unroll
    for (int i = 0; i < 16; ++i) stg[((crow(i, h) * 2 + tsel) * 16) + iq] = f2bf(gelu_as(y[i]));
    {
        const int lane = h * 32 + r, cl = lane >> 1, ts = lane & 1;
        const u32x4 lo = *(const u32x4*)(stg + lane * 16), hi = *(const u32x4*)(stg + lane * 16 + 8);
        bf16_t* dst = Yout + (size_t)((mi * 32 + cl) * 16 + 2 * NJ + ts) * DSS;
        *(u32x4*)dst = lo; *(u32x4*)(dst + 8) = hi;
    }
}
DI void s5_gemm_item(const Params& p, int b, int g, char* smem) {
    float* E = (float*)smem;
    bf16_t* Xin = (bf16_t*)(smem + 128 * 132 * 4);
    bf16_t* KTl = Xin + 128 * 136;
    const int tid = my_tid(), lane = tid & 63, wid = tid >> 6, r = lane & 31, h = lane >> 5;
    const int mi = wid >> 1, wh = wid & 1;
    const bf16_t* P = (const bf16_t*)(p.ws + OFF_PROJ);
    *(u32x4*)(KTl + tid * 8) = *(const u32x4*)((const bf16_t*)(p.ws + OFF_S5K) + (size_t)g * 4096 + tid * 8);
    bf16x8 af[16];
    {
        const bf16_t* ub = P + (size_t)(b * SEQ + (mi * 32 + r) * 16) * INC + 2048 + g * 16 + 8 * h;
#pragma unroll
        for (int ks = 0; ks < 16; ++ks) af[ks] = *(const bf16x8*)(ub + (size_t)ks * INC);
    }
#ifndef S5_REP_G1
#define S5_REP_G1 1
#define S5_REP_SC 1
#define S5_REP_G2 1
#endif
    for (int rp1 = 0; rp1 < S5_REP_G1; ++rp1)
    {
        f32x16 e0, e1;
#pragma unroll
        for (int i = 0; i < 16; ++i) { e0[i] = 0.f; e1[i] = 0.f; }
        const bf16_t* nb0 = (const bf16_t*)(p.ws + OFF_S5N) + (size_t)g * 128 * 256 + (size_t)(wh * 2) * 16 * 512 + lane * 8;
#pragma unroll
        for (int ks = 0; ks < 16; ++ks) {
            const bf16x8 b0 = *(const bf16x8*)(nb0 + ks * 512), b1 = *(const bf16x8*)(nb0 + 16 * 512 + ks * 512);
            e0 = __builtin_amdgcn_mfma_f32_32x32x16_bf16(af[ks], b0, e0, 0, 0, 0);
            e1 = __builtin_amdgcn_mfma_f32_32x32x16_bf16(af[ks], b1, e1, 0, 0, 0);
        }
#pragma unroll
        for (int i = 0; i < 16; ++i) { float* er = E + (mi * 32 + crow(i, h)) * 132 + wh * 64 + r; er[0] = e0[i]; er[32] = e1[i]; }
    }
    __syncthreads();
    for (int rp2 = 0; rp2 < S5_REP_SC; ++rp2)
    if (wid == 0) {
        const float* L = (const float*)(p.ws + OFF_S5L) + (g * 64 + lane) * 2;
        const float lr = L[0], li = L[1];
        float xr = 0.f, xi = 0.f;
#pragma unroll 8
        for (int c = 0; c < 128; ++c) {
            const float er = E[c * 132 + lane], ei = E[c * 132 + 64 + lane];
            Xin[c * 136 + lane] = f2bf(xr); Xin[c * 136 + 64 + lane] = f2bf(xi);
            const float nr = lr * xr - li * xi + er, ni = lr * xi + li * xr + ei;
            xr = nr; xi = ni;
        }
    }
    __syncthreads();
    const bf16_t* MBg = (const bf16_t*)(p.ws + OFF_S5M) + (size_t)g * 256 * 128;
    bf16_t* Yout = (bf16_t*)(p.ws + OFF_YSSM) + (size_t)b * SEQ * DSS + g * 16;
    bf16_t* stg = (bf16_t*)smem + wid * 1024;
    for (int rp3 = 0; rp3 < S5_REP_G2; ++rp3)
    if (wh) {
        s5_gemm2_tile<1>(af, KTl, Xin, MBg, Yout, stg, mi, r, h); s5_gemm2_tile<6>(af, KTl, Xin, MBg, Yout, stg, mi, r, h);
        s5_gemm2_tile<3>(af, KTl, Xin, MBg, Yout, stg, mi, r, h); s5_gemm2_tile<4>(af, KTl, Xin, MBg, Yout, stg, mi, r, h);
    } else {
        s5_gemm2_tile<0>(af, KTl, Xin, MBg, Yout, stg, mi, r, h); s5_gemm2_tile<7>(af, KTl, Xin, MBg, Yout, stg, mi, r, h);
        s5_gemm2_tile<2>(af, KTl, Xin, MBg, Yout, stg, mi, r, h); s5_gemm2_tile<5>(af, KTl, Xin, MBg, Yout, stg, mi, r, h);
    }
    __syncthreads();
}
DI void phase_mix(const Params& p, int bid, int nb, char* smem) {
    if (nb == 256) {
#ifndef PROBE_HGX
#define PROBE_HGX 1
#endif
        if (bid < 64) { for (int rep = 0; rep < PROBE_HGX; ++rep) hgrn_mfma_item(p, bid, smem); return; }
        const int j = bid - 64, x = j & 7, lb = j >> 3;
#ifndef PROBE_S5X
#define PROBE_S5X 1
#endif
        for (int rep = 0; rep < PROBE_S5X; ++rep)
        for (int q = lb; q < 64; q += 24) s5_gemm_item(p, q & 15, x * 4 + (q >> 4), smem);
    } else {
        for (int it = bid; it < 64; it += nb) hgrn_mfma_item(p, it, smem);
        for (int q = bid; q < 512; q += nb) s5_gemm_item(p, q & 15, q >> 4, smem);
    }
}

DI void phase_glu(const Params& p, int bid, int nb, char* smem) {
    pg8::Gemm g{(const bf16_t*)(p.ws + OFF_YSSM), (const bf16_t*)(p.ws + OFF_GLU), NTOK, 512, 512};
    pg8::StaticOrder S; S.init(NTOK, 512, nb, bid);
    pg8::EpiGluA2 E{(bf16_t*)(p.ws + OFF_A2), (const bf16_t*)(p.ws + OFF_YSSM), p.glu_b, p.ssm_nw, (float*)(p.ws + OFF_STAT) + 2 * NTOK};
    pg8::gemm_phase<pg8::EpiGluA2, pg8::StaticOrder, false>((PG8_LAS unsigned char*)smem, g, S, E, nullptr);
}
DI void phase_a2(const Params& p, int bid, int nb) {
    const float* Y2 = (const float*)(p.ws + OFF_H);
    const bf16_t* P = (const bf16_t*)(p.ws + OFF_PROJ);
    bf16_t* A2 = (bf16_t*)(p.ws + OFF_A2);
    const int lane = my_tid() & 63, wid = my_tid() >> 6;
    for (int tok = bid * 8 + wid; tok < NTOK; tok += nb * 8) {
        const int c0 = lane * 8;
        {
            const float4 a = *(const float4*)(Y2 + (size_t)tok * DSS + c0), b = *(const float4*)(Y2 + (size_t)tok * DSS + c0 + 4);
            float ss = a.x * a.x + a.y * a.y + a.z * a.z + a.w * a.w + b.x * b.x + b.y * b.y + b.z * b.z + b.w * b.w;
#pragma unroll
            for (int m = 1; m < 64; m <<= 1) ss += __shfl_xor(ss, m);
            const float rs = rsqrtf(ss * (1.0f / 512.0f) + RMS_EPS);
            const float4 w0 = *(const float4*)(p.ssm_nw + c0), w1 = *(const float4*)(p.ssm_nw + c0 + 4);
            uint4 o;
            o.x = pack2(a.x * rs * w0.x, a.y * rs * w0.y); o.y = pack2(a.z * rs * w0.z, a.w * rs * w0.w);
            o.z = pack2(b.x * rs * w1.x, b.y * rs * w1.y); o.w = pack2(b.z * rs * w1.z, b.w * rs * w1.w);
            *(uint4*)(A2 + (size_t)tok * DM + 512 + c0) = o;
        }
    }
}

DI void phase_outproj(const Params& p, int bid, int nb, char* smem) {
    pg8::Gemm g{(const bf16_t*)(p.ws + OFF_A2), (const bf16_t*)(p.ws + OFF_WOUT), NTOK, DM, DM};
    pg8::StaticOrder S; S.init(NTOK, DM, nb, bid);
    pg8::EpiResid E{(bf16_t*)(p.ws + OFF_R1), p.x, (const float*)(p.ws + OFF_MOD) + 2048, DEEP_ALPHA, (bf16_t*)(p.ws + OFF_H), (const float*)(p.ws + OFF_AB), (float*)(p.ws + OFF_STAT), (const float*)(p.ws + OFF_STAT) + 2 * NTOK, RMS_EPS};
    pg8::gemm_phase<pg8::EpiResid, pg8::StaticOrder, false>((PG8_LAS unsigned char*)smem, g, S, E, nullptr);
}
DI void phase_ln1(const Params& p, int bid, int nb) {
    const float* mod = (const float*)(p.ws + OFF_MOD);
    bf16_t* H2 = (bf16_t*)(p.ws + OFF_H);
    const int lane = my_tid() & 63, wid = my_tid() >> 6;
    for (int tok = bid * 8 + wid; tok < NTOK; tok += nb * 8) {
        const int b = tok / SEQ;
        float* row = p.out + (size_t)tok * DM;
        float4 v[4];
        float s = 0.f;
#pragma unroll
        for (int j = 0; j < 4; ++j) { v[j] = *(const float4*)(row + j * 256 + lane * 4); s += v[j].x + v[j].y + v[j].z + v[j].w; }
#pragma unroll
        for (int m = 1; m < 64; m <<= 1) s += __shfl_xor(s, m);
        const float mu = s * (1.0f / 1024.0f);
        float q = 0.f;
#pragma unroll
        for (int j = 0; j < 4; ++j) { const float a = v[j].x - mu, bb = v[j].y - mu, cc = v[j].z - mu, d = v[j].w - mu; q += a * a + bb * bb + cc * cc + d * d; }
#pragma unroll
        for (int m = 1; m < 64; m <<= 1) q += __shfl_xor(q, m);
        const float rstd = rsqrtf(q * (1.0f / 1024.0f) + LN_EPS);
        const float* sh2 = mod + b * 6144 + 3072;
        const float* sc2 = mod + b * 6144 + 4096;
#pragma unroll
        for (int j = 0; j < 4; ++j) {
            const int c = j * 256 + lane * 4;
            const float4 w = *(const float4*)(p.ln1w + c), bi = *(const float4*)(p.ln1b + c), sc = *(const float4*)(sc2 + c), sh = *(const float4*)(sh2 + c);
            float4 o;
            o.x = (v[j].x - mu) * rstd * w.x + bi.x; o.y = (v[j].y - mu) * rstd * w.y + bi.y; o.z = (v[j].z - mu) * rstd * w.z + bi.z; o.w = (v[j].w - mu) * rstd * w.w + bi.w;
            *(float4*)(row + c) = o;
            uint2 hh; hh.x = pack2(o.x * (1.f + sc.x) + sh.x, o.y * (1.f + sc.y) + sh.y); hh.y = pack2(o.z * (1.f + sc.z) + sh.z, o.w * (1.f + sc.w) + sh.w);
            *(uint2*)(H2 + (size_t)tok * DM + c) = hh;
        }
    }
}

DI void phase_q(const Params& p, int bid, int nb, char* smem) {
    pg8::Gemm g{(const bf16_t*)(p.ws + OFF_H), (const bf16_t*)(p.ws + OFF_WQ), NTOK, 2048, DM};
    pg8::StaticOrder S; S.init(NTOK, 2048, nb, bid);
    pg8::EpiQLN E{(bf16_t*)(p.ws + OFF_PROJ), (const float*)(p.ws + OFF_STAT), (const float*)(p.ws + OFF_CAB), (const float*)(p.ws + OFF_CAB) + NB * 2048, LN_EPS};
    pg8::gemm_phase<pg8::EpiQLN, pg8::StaticOrder, false>((PG8_LAS unsigned char*)smem, g, S, E, nullptr);
}
DI void phase_topk(const Params& p, int bid, int nb, char* smem) {
    const bf16_t* Q = (const bf16_t*)(p.ws + OFF_PROJ);
    const bf16_t* SK = (const bf16_t*)(p.ws + OFF_SUBK);
    unsigned* TOPL = (unsigned*)(p.ws + OFF_TOPL);
    float* sc = (float*)(smem + 36864);
    constexpr int NTM = NTOK / 128;
    for (int t = bid; t < NTM * 16; t += nb) {
        const int mt = t >> 4, hp = t & 15;
        gemm_block<2, 1, 2, 4>(Q + (size_t)mt * 128 * 2048 + hp * 128, 2048, SK + (size_t)hp * 128 * 128, 128, 128, smem,
                               [&](int r, int c, float v) { sc[r * 129 + c] = v; });
        __syncthreads();
        if (my_tid() < 128) {
            const int r = my_tid();
            float tk[16];
#pragma unroll
            for (int j = 0; j < 16; ++j) tk[j] = -3.0e38f;
            for (int n = 0; n < 128; ++n) {
                float xv = __uint_as_float((__float_as_uint(sc[r * 129 + n]) & ~0x7fu) | (unsigned)n);
#pragma unroll
                for (int j = 0; j < 16; ++j) { const float hi = fmaxf(tk[j], xv), lo = fminf(tk[j], xv); tk[j] = hi; xv = lo; }
            }
            uint4* dst = (uint4*)(TOPL + ((size_t)(mt * 128 + r) * 16 + hp) * 16);
            dst[0] = make_uint4(__float_as_uint(tk[0]), __float_as_uint(tk[1]), __float_as_uint(tk[2]), __float_as_uint(tk[3]));
            dst[1] = make_uint4(__float_as_uint(tk[4]), __float_as_uint(tk[5]), __float_as_uint(tk[6]), __float_as_uint(tk[7]));
            dst[2] = make_uint4(__float_as_uint(tk[8]), __float_as_uint(tk[9]), __float_as_uint(tk[10]), __float_as_uint(tk[11]));
            dst[3] = make_uint4(__float_as_uint(tk[12]), __float_as_uint(tk[13]), __float_as_uint(tk[14]), __float_as_uint(tk[15]));
        }
        __syncthreads();
    }
}
DI void phase_combine(const Params& p, int bid, int nb) {
    const unsigned* TOPL = (const unsigned*)(p.ws + OFF_TOPL);
    uint2* EX = (uint2*)(p.ws + OFF_EXPS);
    const float* SU = (const float*)(p.ws + OFF_SU);
    const float* SV = (const float*)(p.ws + OFF_SV);
    for (int i = bid * NTH + my_tid(); i < NTOK * PHEADS; i += nb * NTH) {
        const unsigned* l1 = TOPL + (size_t)i * 32;
        const unsigned* l2 = l1 + 16;
        float s2[16];
        {
            const uint4 a = ((const uint4*)l2)[0], b = ((const uint4*)l2)[1], c = ((const uint4*)l2)[2], d = ((const uint4*)l2)[3];
            const unsigned w[16] = {a.x, a.y, a.z, a.w, b.x, b.y, b.z, b.w, c.x, c.y, c.z, c.w, d.x, d.y, d.z, d.w};
#pragma unroll
            for (int j = 0; j < 16; ++j) s2[j] = __uint_as_float(w[j] & ~0x7fu);
        }
        float tk[16];
#pragma unroll
        for (int j = 0; j < 16; ++j) tk[j] = -3.0e38f;
        for (int a = 0; a < 16; ++a) {
            const float s1 = __uint_as_float(l1[a] & ~0x7fu);
#pragma unroll
            for (int b = 0; b < 16; ++b) {
                float xv = __uint_as_float((__float_as_uint(s1 + s2[b]) & ~0xffu) | (unsigned)(a * 16 + b));
#pragma unroll
                for (int j = 0; j < 16; ++j) { const float hi = fmaxf(tk[j], xv), lo = fminf(tk[j], xv); tk[j] = hi; xv = lo; }
            }
        }
        float e[16], sum = 0.f;
        const float mx = __uint_as_float(__float_as_uint(tk[0]) & ~0xffu);
#pragma unroll
        for (int j = 0; j < 16; ++j) { e[j] = __expf(__uint_as_float(__float_as_uint(tk[j]) & ~0xffu) - mx); sum += e[j]; }
        const float inv = 1.0f / sum;
#pragma unroll
        for (int j = 0; j < 16; ++j) {
            const unsigned ab = __float_as_uint(tk[j]) & 0xffu;
            const unsigned i1 = l1[ab >> 4] & 0x7fu, i2 = l2[ab & 15] & 0x7fu;
            const unsigned eid = i1 * 128u + i2;
            EX[(size_t)i * 16 + j] = make_uint2(eid | (((__float_as_uint(SU[eid]) >> 23) & 0xffu) << 16), __float_as_uint(e[j] * inv * SV[eid]));
        }
    }
}

DI void ce_desc(float& a, float& b) { const float hi = fmaxf(a, b), lo = fminf(a, b); a = hi; b = lo; }
template <int N> DI void bitonic_sort_desc(float (&v)[N]) {
#pragma unroll
    for (int k = 2; k <= N; k <<= 1)
#pragma unroll
        for (int j = k >> 1; j > 0; j >>= 1)
#pragma unroll
            for (int i = 0; i < N; ++i) { const int l = i ^ j; if (l > i) { if ((i & k) == 0 || k == N) ce_desc(v[i], v[l]); else ce_desc(v[l], v[i]); } }
}
DI void merge_top16(float (&a)[16], const float (&b)[16]) {
#pragma unroll
    for (int i = 0; i < 16; ++i) a[i] = fmaxf(a[i], b[15 - i]);
#pragma unroll
    for (int j = 8; j > 0; j >>= 1)
#pragma unroll
        for (int i = 0; i < 16; ++i) { const int l = i ^ j; if (l > i) ce_desc(a[i], a[l]); }
}
DI void xlane_merge16(float (&a)[16]) {
    float o[16];
#pragma unroll
    for (int i = 0; i < 16; ++i) o[i] = __shfl_xor(a[i], 32);
    merge_top16(a, o);
}
DI void retrieve_topk_hp(const bf16_t* Q, const char* skl, const int tok, const int hp_next, const int r, const int h, unsigned char* lutp, float (&out)[16], bf16x8 (&bq)[8]) {
                f32x16 acc[4];
#pragma unroll
                for (int mi = 0; mi < 4; ++mi)
#pragma unroll
                    for (int i = 0; i < 16; ++i) acc[mi][i] = 0.f;
                const char* kb = skl + r * 272 + h * 16;
#pragma unroll
                for (int ks = 0; ks < 8; ++ks) {
#pragma unroll
                    for (int mi = 0; mi < 4; ++mi) {
                        const bf16x8 a = *(const bf16x8*)(kb + mi * 32 * 272 + ks * 32);
                        acc[mi] = __builtin_amdgcn_mfma_f32_32x32x16_bf16(a, bq[ks], acc[mi], 0, 0, 0);
                    }
                }
                {
                    const bf16_t* qb = Q + (size_t)tok * 2048 + hp_next * 128 + 8 * h;
#pragma unroll
                    for (int ks = 0; ks < 8; ++ks) bq[ks] = *(const bf16x8*)(qb + ks * 16);
                }
                float v0[16], v1[16], v2[16], v3[16];
#pragma unroll
                for (int i = 0; i < 16; ++i) {
                    const unsigned n = (unsigned)crow(i, h);
                    v0[i] = __uint_as_float((__float_as_uint(acc[0][i]) & ~0x7fu) | n);
                    v1[i] = __uint_as_float((__float_as_uint(acc[1][i]) & ~0x7fu) | (n + 32u));
                    v2[i] = __uint_as_float((__float_as_uint(acc[2][i]) & ~0x7fu) | (n + 64u));
                    v3[i] = __uint_as_float((__float_as_uint(acc[3][i]) & ~0x7fu) | (n + 96u));
                }
                bitonic_sort_desc<16>(v0); bitonic_sort_desc<16>(v1); bitonic_sort_desc<16>(v2); bitonic_sort_desc<16>(v3);
                merge_top16(v0, v1); merge_top16(v2, v3); merge_top16(v0, v2);
                xlane_merge16(v0);
#pragma unroll
                for (int i = 0; i < 16; ++i) out[i] = v0[i];
                u32x4 ix;
                ix.x = (__float_as_uint(v0[0]) & 0x7fu) | ((__float_as_uint(v0[1]) & 0x7fu) << 8) | ((__float_as_uint(v0[2]) & 0x7fu) << 16) | ((__float_as_uint(v0[3]) & 0x7fu) << 24);
                ix.y = (__float_as_uint(v0[4]) & 0x7fu) | ((__float_as_uint(v0[5]) & 0x7fu) << 8) | ((__float_as_uint(v0[6]) & 0x7fu) << 16) | ((__float_as_uint(v0[7]) & 0x7fu) << 24);
                ix.z = (__float_as_uint(v0[8]) & 0x7fu) | ((__float_as_uint(v0[9]) & 0x7fu) << 8) | ((__float_as_uint(v0[10]) & 0x7fu) << 16) | ((__float_as_uint(v0[11]) & 0x7fu) << 24);
                ix.w = (__float_as_uint(v0[12]) & 0x7fu) | ((__float_as_uint(v0[13]) & 0x7fu) << 8) | ((__float_as_uint(v0[14]) & 0x7fu) << 16) | ((__float_as_uint(v0[15]) & 0x7fu) << 24);
                *(u32x4*)lutp = ix;
}
DI void phase_retrieve(const Params& p, int bid, int nb, char* smem) {
    const bf16_t* Q = (const bf16_t*)(p.ws + OFF_PROJ);
    const bf16_t* SK = (const bf16_t*)(p.ws + OFF_SUBK);
    const float* SU = (const float*)(p.ws + OFF_SU);
    const float* SV = (const float*)(p.ws + OFF_SV);
    uint2* EX = (uint2*)(p.ws + OFF_EXPS);
    const int tid = my_tid(), lane = tid & 63, wid = tid >> 6, r = lane & 31, h = lane >> 5;
    unsigned char* lut = (unsigned char*)smem + wid * 2048 + lane * 32;
    char* skb0 = smem + 16384;
    char* skb1 = skb0 + 128 * 272;
    u32x4 sr0, sr1, sr2, sr3;
#define SK_LOAD(hp_) { const bf16_t* g_ = SK + (size_t)(hp_) * 16384 + tid * 8; sr0 = *(const u32x4*)g_; sr1 = *(const u32x4*)(g_ + 4096); sr2 = *(const u32x4*)(g_ + 8192); sr3 = *(const u32x4*)(g_ + 12288); }
#define SK_STORE(buf_) { char* d_ = (buf_) + (tid >> 4) * 272 + (tid & 15) * 16; *(u32x4*)d_ = sr0; *(u32x4*)(d_ + 32 * 272) = sr1; *(u32x4*)(d_ + 64 * 272) = sr2; *(u32x4*)(d_ + 96 * 272) = sr3; }
    for (int it = bid; it < (NTOK / 256) * 2; it += nb) {
        const int hq = it & 1, tok = (it >> 1) * 256 + wid * 32 + r;
        __syncthreads();
        SK_LOAD(hq * 8); SK_STORE(skb0);
        bf16x8 bq[8];
        {
            const bf16_t* qb = Q + (size_t)tok * 2048 + (hq * 8) * 128 + 8 * h;
#pragma unroll
            for (int ks = 0; ks < 8; ++ks) bq[ks] = *(const bf16x8*)(qb + ks * 16);
        }
        __syncthreads();
#pragma unroll 1
        for (int hd = hq * 4; hd < hq * 4 + 4; ++hd) {
            float L0[16], L1[16];
            SK_LOAD(hd * 2 + 1);
            retrieve_topk_hp(Q, skb0, tok, hd * 2 + 1, r, h, lut, L0, bq);
            SK_STORE(skb1);
            __syncthreads();
            if (hd + 1 < hq * 4 + 4) SK_LOAD(hd * 2 + 2);
            retrieve_topk_hp(Q, skb1, tok, (hd + 1 < hq * 4 + 4) ? hd * 2 + 2 : hd * 2 + 1, r, h, lut + 16, L1, bq);
            if (hd + 1 < hq * 4 + 4) SK_STORE(skb0);
            __syncthreads();
            float c[32];
            {
                constexpr int PA[50] = {0, 0, 0, 0, 0, 0, 0, 0, 0, 0, 0, 0, 0, 0, 0, 0, 1, 1, 1, 1, 1, 1, 1, 1, 2, 2, 2, 2, 2, 3, 3, 3, 3, 4, 4, 4, 5, 5, 6, 6, 7, 7, 8, 9, 10, 11, 12, 13, 14, 15};
                constexpr int PB[50] = {0, 1, 2, 3, 4, 5, 6, 7, 8, 9, 10, 11, 12, 13, 14, 15, 0, 1, 2, 3, 4, 5, 6, 7, 0, 1, 2, 3, 4, 0, 1, 2, 3, 0, 1, 2, 0, 1, 0, 1, 0, 1, 0, 0, 0, 0, 0, 0, 0, 0};
#pragma unroll
                for (int q = 0; q < 25; ++q) {
                    const float s0 = __uint_as_float(__float_as_uint(L0[PA[2 * q]]) & ~0x7fu) + __uint_as_float(__float_as_uint(L1[PB[2 * q]]) & ~0x7fu);
                    const float s1 = __uint_as_float(__float_as_uint(L0[PA[2 * q + 1]]) & ~0x7fu) + __uint_as_float(__float_as_uint(L1[PB[2 * q + 1]]) & ~0x7fu);
                    const float p0 = __uint_as_float((__float_as_uint(s0) & ~0xffu) | (unsigned)(PA[2 * q] * 16 + PB[2 * q]));
                    const float p1 = __uint_as_float((__float_as_uint(s1) & ~0xffu) | (unsigned)(PA[2 * q + 1] * 16 + PB[2 * q + 1]));
                    c[q] = h ? p1 : p0;
                }
#pragma unroll
                for (int i = 25; i < 32; ++i) c[i] = -3.0e38f;
            }
            bitonic_sort_desc<32>(c);
            float t16[16];
#pragma unroll
            for (int i = 0; i < 16; ++i) t16[i] = c[i];
            xlane_merge16(t16);
            const float mx = __uint_as_float(__float_as_uint(t16[0]) & ~0xffu);
            float e[16], sum = 0.f;
#pragma unroll
            for (int j = 0; j < 16; ++j) { e[j] = __expf(__uint_as_float(__float_as_uint(t16[j]) & ~0xffu) - mx); sum += e[j]; }
            const float inv = 1.0f / sum;
            uint2* dst = EX + ((size_t)tok * 8 + hd) * 16 + 8 * h;
#pragma unroll
            for (int j = 0; j < 8; ++j) {
                float tlo = t16[j], thi = t16[8 + j], elo = e[j], ehi = e[8 + j];
                asm volatile("" : "+v"(tlo), "+v"(thi), "+v"(elo), "+v"(ehi));
                const float tv = h ? thi : tlo, ev = h ? ehi : elo;
                const unsigned ab = __float_as_uint(tv) & 0xffu;
                const unsigned eid = (unsigned)lut[ab >> 4] * 128u + (unsigned)lut[16 + (ab & 15u)];
                dst[j] = make_uint2(eid | (pack2(0.f, SU[eid]) & 0xffff0000u), __float_as_uint(ev * inv * SV[eid]));
            }
        }
    }
#undef SK_LOAD
#undef SK_STORE
}

DI float dot16_fp8(const u32x4 w, const f32x2 (&h)[8]) {
    f32x2 acc = __builtin_amdgcn_cvt_pk_f32_fp8((int)w.x, false) * h[0];
    acc += __builtin_amdgcn_cvt_pk_f32_fp8((int)w.x, true) * h[1];
    acc += __builtin_amdgcn_cvt_pk_f32_fp8((int)w.y, false) * h[2];
    acc += __builtin_amdgcn_cvt_pk_f32_fp8((int)w.y, true) * h[3];
    acc += __builtin_amdgcn_cvt_pk_f32_fp8((int)w.z, false) * h[4];
    acc += __builtin_amdgcn_cvt_pk_f32_fp8((int)w.z, true) * h[5];
    acc += __builtin_amdgcn_cvt_pk_f32_fp8((int)w.w, false) * h[6];
    acc += __builtin_amdgcn_cvt_pk_f32_fp8((int)w.w, true) * h[7];
    return acc.x + acc.y;
}
DI void axpy16_fp8(const float a, const u32x4 w, f32x2 (&o)[8]) {
    const f32x2 aa = {a, a};
    o[0] += aa * __builtin_amdgcn_cvt_pk_f32_fp8((int)w.x, false); o[1] += aa * __builtin_amdgcn_cvt_pk_f32_fp8((int)w.x, true);
    o[2] += aa * __builtin_amdgcn_cvt_pk_f32_fp8((int)w.y, false); o[3] += aa * __builtin_amdgcn_cvt_pk_f32_fp8((int)w.y, true);
    o[4] += aa * __builtin_amdgcn_cvt_pk_f32_fp8((int)w.z, false); o[5] += aa * __builtin_amdgcn_cvt_pk_f32_fp8((int)w.z, true);
    o[6] += aa * __builtin_amdgcn_cvt_pk_f32_fp8((int)w.w, false); o[7] += aa * __builtin_amdgcn_cvt_pk_f32_fp8((int)w.w, true);
}
DI float butterfly64(float (&pz)[64], const int lane) {
    const bool b5 = lane & 32, b4 = lane & 16, b3 = lane & 8, b2 = lane & 4, b1 = lane & 2, b0 = lane & 1;
    float q32[32], q16[16], q8[8], q4[4], q2[2];
#pragma unroll
    for (int j = 0; j < 32; ++j) q32[j] = (b5 ? pz[32 + j] : pz[j]) + __shfl_xor(b5 ? pz[j] : pz[32 + j], 32);
#pragma unroll
    for (int j = 0; j < 16; ++j) q16[j] = (b4 ? q32[16 + j] : q32[j]) + __shfl_xor(b4 ? q32[j] : q32[16 + j], 16);
#pragma unroll
    for (int j = 0; j < 8; ++j) q8[j] = (b3 ? q16[8 + j] : q16[j]) + __shfl_xor(b3 ? q16[j] : q16[8 + j], 8);
#pragma unroll
    for (int j = 0; j < 4; ++j) q4[j] = (b2 ? q8[4 + j] : q8[j]) + __shfl_xor(b2 ? q8[j] : q8[4 + j], 4);
#pragma unroll
    for (int j = 0; j < 2; ++j) q2[j] = (b1 ? q4[2 + j] : q4[j]) + __shfl_xor(b1 ? q4[j] : q4[2 + j], 2);
    return (b0 ? q2[1] : q2[0]) + __shfl_xor(b0 ? q2[0] : q2[1], 1);
}
DI float bfly8(float (&pz)[8], const int lane) {
    const bool b2 = lane & 4, b1 = lane & 2, b0 = lane & 1;
    float q4[4], q2[2];
#pragma unroll
    for (int i = 0; i < 4; ++i) q4[i] = (b2 ? pz[4 + i] : pz[i]) + __shfl_xor(b2 ? pz[i] : pz[4 + i], 4);
#pragma unroll
    for (int i = 0; i < 2; ++i) q2[i] = (b1 ? q4[2 + i] : q4[i]) + __shfl_xor(b1 ? q4[i] : q4[2 + i], 2);
    float q = (b0 ? q2[1] : q2[0]) + __shfl_xor(b0 ? q2[0] : q2[1], 1);
    q += __shfl_xor(q, 8); q += __shfl_xor(q, 16); q += __shfl_xor(q, 32);
    return q;
}
DI float bfly16(float (&pz)[16], const int lane) {
    const bool b3 = lane & 8, b2 = lane & 4, b1 = lane & 2, b0 = lane & 1;
    float q8[8], q4[4], q2[2];
#pragma unroll
    for (int i = 0; i < 8; ++i) q8[i] = (b3 ? pz[8 + i] : pz[i]) + __shfl_xor(b3 ? pz[i] : pz[8 + i], 8);
#pragma unroll
    for (int i = 0; i < 4; ++i) q4[i] = (b2 ? q8[4 + i] : q8[i]) + __shfl_xor(b2 ? q8[i] : q8[4 + i], 4);
#pragma unroll
    for (int i = 0; i < 2; ++i) q2[i] = (b1 ? q4[2 + i] : q4[i]) + __shfl_xor(b1 ? q4[i] : q4[2 + i], 2);
    float q = (b0 ? q2[1] : q2[0]) + __shfl_xor(b0 ? q2[0] : q2[1], 1);
    q += __shfl_xor(q, 16); q += __shfl_xor(q, 32);
    return q;
}
DI void gs_issue(const __amdgpu_buffer_rsrc_t T, const uint2* ent, const unsigned d, const int lane, u32x4 (&w)[8], unsigned& ca) {
    const int cnt = (int)((d >> 16) & 0xfu), k = lane & 7;
    const uint2 e = ent[(d & 0xffffu) + (unsigned)(k < cnt ? k : cnt - 1)];
    ca = (k < cnt && !(d >> 31)) ? e.y : 0u;
#pragma unroll
    for (int q = 0; q < 8; ++q) {
        const int eid = __builtin_amdgcn_readlane((int)e.x, q) & 0x3fff;
        w[q] = __builtin_amdgcn_raw_buffer_load_b128(T, lane * 16, eid * DM, 0);
    }
}
DI float dot16_i8(const u32x4 w, const u32x4 h) {
    int acc = __builtin_amdgcn_sdot4((int)w.x, (int)h.x, 0, false);
    acc = __builtin_amdgcn_sdot4((int)w.y, (int)h.y, acc, false);
    acc = __builtin_amdgcn_sdot4((int)w.z, (int)h.z, acc, false);
    acc = __builtin_amdgcn_sdot4((int)w.w, (int)h.w, acc, false);
    return (float)acc;
}
DI void gs_desc(const uint2* ent, const unsigned d, const int lane, unsigned& ex) {
    const int cnt = (int)((d >> 16) & 0xfu), k = lane & 7;
    ex = ent[(d & 0xffffu) + (unsigned)(k < cnt ? k : cnt - 1)].x;
}
DI void gs_loads(const __amdgpu_buffer_rsrc_t T, const unsigned ex, const int lane, u32x4 (&w)[8]) {
#pragma unroll
    for (int q = 0; q < 8; ++q) {
        const int eid = __builtin_amdgcn_readlane((int)ex, q) & 0x3fff;
        w[q] = __builtin_amdgcn_raw_buffer_load_b128(T, lane * 16, eid * DM, 0);
    }
}
DI void gs_upartial(const u32x4 (&w)[8], const u32x4 h2q, float (&pz)[16], const int base) {
#pragma unroll
    for (int k = 0; k < 8; ++k) pz[base + k] = dot16_i8(w[k], h2q);
}
DI void gs_ustore(float (&pz)[16], float* zb, const unsigned da, const unsigned db, const int lane) {
    const float z = bfly16(pz, lane);
    const unsigned d = (lane & 8) ? db : da;
    const int k = lane & 7;
    if (lane < 16 && k < (int)((d >> 16) & 0xfu) && !(d >> 31)) zb[(d & 0xffffu) + k] = z;
}
DI void axpy16_u8(const float a, const u32x4 w, float (&o)[16]) {
    o[0] += a * (float)(w.x & 0xffu); o[1] += a * (float)((w.x >> 8) & 0xffu); o[2] += a * (float)((w.x >> 16) & 0xffu); o[3] += a * (float)(w.x >> 24);
    o[4] += a * (float)(w.y & 0xffu); o[5] += a * (float)((w.y >> 8) & 0xffu); o[6] += a * (float)((w.y >> 16) & 0xffu); o[7] += a * (float)(w.y >> 24);
    o[8] += a * (float)(w.z & 0xffu); o[9] += a * (float)((w.z >> 8) & 0xffu); o[10] += a * (float)((w.z >> 16) & 0xffu); o[11] += a * (float)(w.z >> 24);
    o[12] += a * (float)(w.w & 0xffu); o[13] += a * (float)((w.w >> 8) & 0xffu); o[14] += a * (float)((w.w >> 16) & 0xffu); o[15] += a * (float)(w.w >> 24);
}
DI void gs_vcompute(const u32x4 (&w)[8], const unsigned ca, float (&acc)[16]) {
#pragma unroll
    for (int k = 0; k < 8; ++k) { axpy16_u8(__uint_as_float((unsigned)__builtin_amdgcn_readlane((int)ca, k)), w[k], acc); __builtin_amdgcn_sched_barrier(0); }
}
constexpr int GT = 4;
constexpr int WL_ENT = GT * 1024, WL_Z = GT * 512, WL_OFFS = ((GT * 9 * 4 + 63) / 64) * 64, WL_SCHED = ((GT * 20 + 3) * 4 + 63) / 64 * 64, WL_BYTES = WL_ENT + WL_Z + WL_OFFS + WL_SCHED;
static_assert(8 * WL_BYTES <= 128 * 1024, "gather LDS");
template <int J> DI void gs_usel(const u32x4 (&w)[8], const u32x4 (&h2q)[GT], float (&pz)[16], const int base, const unsigned j) {
    if constexpr (J + 1 < GT) { if (j == (unsigned)J) gs_upartial(w, h2q[J], pz, base); else gs_usel<J + 1>(w, h2q, pz, base, j); } else gs_upartial(w, h2q[J], pz, base);
}
template <int J> DI void gs_vsel(const u32x4 (&w)[8], const unsigned ca, float (&acc)[GT][16], const unsigned j) {
    if constexpr (J + 1 < GT) { if (j == (unsigned)J) gs_vcompute(w, ca, acc[J]); else gs_vsel<J + 1>(w, ca, acc, j); } else gs_vcompute(w, ca, acc[J]);
}
constexpr int NSL = 4, SLSH = 12;
DI void xcd_pace(unsigned* cnt, const unsigned nloc, unsigned& step) {
    __syncthreads();
    if (__builtin_amdgcn_workitem_id_x() == 0) {
        __hip_atomic_fetch_add(cnt, 1u, __ATOMIC_RELAXED, __HIP_MEMORY_SCOPE_AGENT);
        const unsigned target = nloc * (step + 1u);
        unsigned sp = 0;
        while (__hip_atomic_load(cnt, __ATOMIC_RELAXED, __HIP_MEMORY_SCOPE_AGENT) < target) { __builtin_amdgcn_s_sleep(1); if (++sp > (1u << 22)) break; }
    }
    ++step;
    __syncthreads();
}
DI void phase_gather(const Params& p, int bid, int nb, char* smem, unsigned* pace_cnt, const unsigned pace_n) {
    unsigned pstep = 0;
    const float* mod = (const float*)(p.ws + OFF_MOD);
    const float* AB = (const float*)(p.ws + OFF_AB);
    const float* STAT = (const float*)(p.ws + OFF_STAT);
    const uint2* EX = (const uint2*)(p.ws + OFF_EXPS);
    const __amdgpu_buffer_rsrc_t UT = __builtin_amdgcn_make_buffer_rsrc((void*)(p.ws + OFF_UT), 0, NEXP * DM, 0x00020000);
    const __amdgpu_buffer_rsrc_t VT = __builtin_amdgcn_make_buffer_rsrc((void*)(p.ws + OFF_VT), 0, NEXP * DM, 0x00020000);
    const int lane = my_tid() & 63, wid = my_tid() >> 6, c0 = lane * 16;
    char* wl = smem + wid * WL_BYTES;
    uint2* ent = (uint2*)wl; float* zb = (float*)(wl + WL_ENT); int* offs = (int*)(wl + WL_ENT + WL_Z); unsigned* sched = (unsigned*)(wl + WL_ENT + WL_Z + WL_OFFS);
#pragma unroll 1
    for (int t0 = (bid * 8 + wid) * GT; t0 < NTOK; t0 += nb * 8 * GT) {
        u32x4 h2q[GT]; float hsc[GT]; float acc[GT][16];
        f32x4 scv[4], shv[4];
        {
            const int b = t0 / SEQ;
#pragma unroll
            for (int q = 0; q < 4; ++q) { scv[q] = *(const f32x4*)(AB + (size_t)b * DM + c0 + q * 4); shv[q] = *(const f32x4*)(AB + (size_t)(NB + b) * DM + c0 + q * 4); }
        }
#pragma unroll
        for (int j = 0; j < GT; ++j) {
            const int tok = t0 + j;
            const bf16_t* row = (const bf16_t*)(p.ws + OFF_R1) + (size_t)tok * DM + c0;
            __builtin_amdgcn_sched_barrier(0);
            const float mu_j = STAT[tok] * (1.0f / 1024.0f), rs_j = rsqrtf(fmaxf(STAT[NTOK + tok] * (1.0f / 1024.0f) - mu_j * mu_j, 0.f) + LN_EPS);
            {
                f32x4 hv[4];
                float m = 0.f;
                const u32x4 ra = *(const u32x4*)row, rb = *(const u32x4*)(row + 8);
                hv[0] = (f32x4){bflo(ra.x), bfhi(ra.x), bflo(ra.y), bfhi(ra.y)}; hv[1] = (f32x4){bflo(ra.z), bfhi(ra.z), bflo(ra.w), bfhi(ra.w)};
                hv[2] = (f32x4){bflo(rb.x), bfhi(rb.x), bflo(rb.y), bfhi(rb.y)}; hv[3] = (f32x4){bflo(rb.z), bfhi(rb.z), bflo(rb.w), bfhi(rb.w)};
#pragma unroll
                for (int q = 0; q < 4; ++q) { hv[q] = (hv[q] - mu_j) * rs_j * scv[q] + shv[q]; m = fmaxf(m, fmaxf(fmaxf(fabsf(hv[q].x), fabsf(hv[q].y)), fmaxf(fabsf(hv[q].z), fabsf(hv[q].w)))); }
#pragma unroll
                for (int sft = 1; sft < 64; sft <<= 1) m = fmaxf(m, __shfl_xor(m, sft));
                const float qs = m > 1e-30f ? 127.0f / m : 1.0f;
                hsc[j] = m > 1e-30f ? m * (1.0f / 127.0f) : 1.0f;
                unsigned hw[4];
#pragma unroll
                for (int q = 0; q < 4; ++q)
                    hw[q] = ((unsigned)(int)rintf(hv[q].x * qs) & 0xffu) | (((unsigned)(int)rintf(hv[q].y * qs) & 0xffu) << 8) | (((unsigned)(int)rintf(hv[q].z * qs) & 0xffu) << 16) | (((unsigned)(int)rintf(hv[q].w * qs) & 0xffu) << 24);
                h2q[j] = (u32x4){hw[0], hw[1], hw[2], hw[3]};
            }
            const uint2 e0 = EX[(size_t)tok * 128 + lane], e1 = EX[(size_t)tok * 128 + 64 + lane];
            const int s0 = (int)((e0.x & 0x3fffu) >> SLSH), s1 = (int)((e1.x & 0x3fffu) >> SLSH);
            int run = 0, pos0 = 0, pos1 = 0;
#pragma unroll
            for (int s = 0; s < NSL; ++s) {
                const unsigned long long m0 = __ballot(s0 == s), m1 = __ballot(s1 == s);
                const int c0n = __popcll(m0), c1n = __popcll(m1);
                const int below0 = (int)__builtin_amdgcn_mbcnt_hi((unsigned)(m0 >> 32), __builtin_amdgcn_mbcnt_lo((unsigned)m0, 0u));
                const int below1 = (int)__builtin_amdgcn_mbcnt_hi((unsigned)(m1 >> 32), __builtin_amdgcn_mbcnt_lo((unsigned)m1, 0u));
                if (lane == 0) offs[j * 9 + s] = run;
                pos0 = (s0 == s) ? run + below0 : pos0;
                pos1 = (s1 == s) ? run + c0n + below1 : pos1;
                run += c0n + c1n;
            }
            if (lane == 0) offs[j * 9 + NSL] = 128;
            ent[j * 128 + pos0] = e0; ent[j * 128 + pos1] = e1;
        }
        int nbat;
        {
            const int gs = (lane / GT) % NSL, gj = lane % GT;
            const int gb = offs[gj * 9 + gs], ge = offs[gj * 9 + gs + 1], cnt = lane < NSL * GT ? ge - gb : 0, nbt = (cnt + 7) >> 3;
            int incl = nbt;
#pragma unroll
            for (int m = 1; m < 32; m <<= 1) { const int o = __shfl_up(incl, m); if ((lane & 31) >= m) incl += o; }
            nbat = __builtin_amdgcn_readlane(incl, NSL * GT - 1);
            const int st = incl - nbt;
            for (int q = 0; q < nbt; ++q) { const int rem = cnt - 8 * q; sched[st + q] = (unsigned)(gj * 128 + gb + 8 * q) | ((unsigned)(rem < 8 ? rem : 8) << 16); }
            if (lane < 3) sched[nbat + lane] = 0x80010000u;
        }
        xcd_pace(pace_cnt, pace_n, pstep);
#ifndef PROBE_UX
#define PROBE_UX 1
#endif
        for (int rep = 0; rep < PROBE_UX; ++rep)
        {
            u32x4 wa[8], wb[8];
#define GS_UP(W_, D_, B_) gs_usel<0>(W_, h2q, pz, B_, ((D_) & 0xffffu) >> 7)
#define GS_RD(i_) ((unsigned)__builtin_amdgcn_readfirstlane((int)sched[(i_)]))
            unsigned da = GS_RD(0), db = GS_RD(1), dn = GS_RD(2), ea, eb, en;
            gs_desc(ent, da, lane, ea); gs_desc(ent, db, lane, eb); gs_desc(ent, dn, lane, en);
            gs_loads(UT, ea, lane, wa);
#pragma unroll 1
            for (int i = 0; i < nbat; i += 2) {
                float pz[16];
                gs_loads(UT, eb, lane, wb);
                __builtin_amdgcn_sched_barrier(0);
                GS_UP(wa, da, 0);
                const unsigned dcur_a = da, dcur_b = db;
                da = dn; ea = en; dn = GS_RD(i + 3); gs_desc(ent, dn, lane, en);
                gs_loads(UT, ea, lane, wa);
                __builtin_amdgcn_sched_barrier(0);
                GS_UP(wb, dcur_b, 8);
                db = dn; eb = en; dn = GS_RD(i + 4); gs_desc(ent, dn, lane, en);
                gs_ustore(pz, zb, dcur_a, dcur_b, lane);
            }
#undef GS_UP
#undef GS_RD
        }
        float asum[GT];
#pragma unroll
        for (int j = 0; j < GT; ++j) {
            float as = 0.f;
#pragma unroll
            for (int q = 0; q < 2; ++q) {
                const int pos = j * 128 + q * 64 + lane;
                const uint2 e = ent[pos];
                const float z = zb[pos] * __uint_as_float(e.x & 0xffff0000u) * hsc[j];
                const float a = gelu_as(z) * __uint_as_float(e.y);
                ent[pos].y = __float_as_uint(a);
                as += a;
            }
#pragma unroll
            for (int sft = 1; sft < 64; sft <<= 1) as += __shfl_xor(as, sft);
            asum[j] = as;
        }
#pragma unroll
        for (int j = 0; j < GT; ++j)
#pragma unroll
            for (int q = 0; q < 16; ++q) acc[j][q] = 0.f;
        {
            u32x4 wa[8]; unsigned ca;
#pragma unroll 1
            for (int i = 0; i < nbat; ++i) {
                const unsigned da = (unsigned)__builtin_amdgcn_readfirstlane((int)sched[i]);
                gs_issue(VT, ent, da, lane, wa, ca);
                __builtin_amdgcn_sched_barrier(0);
                gs_vsel<0>(wa, ca, acc, (da & 0xffffu) >> 7);
            }
        }
#pragma unroll
        for (int j = 0; j < GT; ++j) {
            asm volatile("" ::: "memory");
            __builtin_amdgcn_sched_barrier(0);
            const int tok = t0 + j, b = tok / SEQ;
            int c0 = lane * 16; asm volatile("" : "+v"(c0));
            const float mu_j = STAT[tok] * (1.0f / 1024.0f), rs_j = rsqrtf(fmaxf(STAT[NTOK + tok] * (1.0f / 1024.0f) - mu_j * mu_j, 0.f) + LN_EPS);
            float* row = p.out + (size_t)tok * DM + c0;
            const bf16_t* r1row = (const bf16_t*)(p.ws + OFF_R1) + (size_t)tok * DM + c0;
            const float* g2 = mod + b * 6144 + 5120 + c0;
            f32x2 r[8];
            float sm = 0.f;
            const u32x4 ra = *(const u32x4*)r1row, rb = *(const u32x4*)(r1row + 8);
            const f32x4 r1v[4] = {(f32x4){bflo(ra.x), bfhi(ra.x), bflo(ra.y), bfhi(ra.y)}, (f32x4){bflo(ra.z), bfhi(ra.z), bflo(ra.w), bfhi(ra.w)},
                                  (f32x4){bflo(rb.x), bfhi(rb.x), bflo(rb.y), bfhi(rb.y)}, (f32x4){bflo(rb.z), bfhi(rb.z), bflo(rb.w), bfhi(rb.w)}};
#pragma unroll
            for (int q = 0; q < 4; ++q) {
                const f32x4 xv = (r1v[q] - mu_j) * rs_j * *(const f32x4*)(p.ln1w + c0 + q * 4) + *(const f32x4*)(p.ln1b + c0 + q * 4), gg = *(const f32x4*)(g2 + q * 4);
                const float off = 128.0f * asum[j];
                r[2 * q] = DEEP_ALPHA * (f32x2){xv.x, xv.y} + (f32x2){1.f + gg.x, 1.f + gg.y} * (f32x2){acc[j][4 * q] - off, acc[j][4 * q + 1] - off};
                r[2 * q + 1] = DEEP_ALPHA * (f32x2){xv.z, xv.w} + (f32x2){1.f + gg.z, 1.f + gg.w} * (f32x2){acc[j][4 * q + 2] - off, acc[j][4 * q + 3] - off};
                sm += r[2 * q].x + r[2 * q].y + r[2 * q + 1].x + r[2 * q + 1].y;
            }
#pragma unroll
            for (int m = 1; m < 64; m <<= 1) sm += __shfl_xor(sm, m);
            const float mu = sm * (1.0f / 1024.0f);
            float qq = 0.f;
#pragma unroll
            for (int i = 0; i < 8; ++i) { const f32x2 dd = r[i] - mu; qq += dd.x * dd.x + dd.y * dd.y; }
#pragma unroll
            for (int m = 1; m < 64; m <<= 1) qq += __shfl_xor(qq, m);
            const float rstd = rsqrtf(qq * (1.0f / 1024.0f) + LN_EPS);
#pragma unroll
            for (int q = 0; q < 4; ++q) {
                const f32x4 w4 = *(const f32x4*)(p.ln2w + c0 + q * 4), bi = *(const f32x4*)(p.ln2b + c0 + q * 4);
                f32x4 ov;
                ov.x = (r[2 * q].x - mu) * rstd * w4.x + bi.x; ov.y = (r[2 * q].y - mu) * rstd * w4.y + bi.y;
                ov.z = (r[2 * q + 1].x - mu) * rstd * w4.z + bi.z; ov.w = (r[2 * q + 1].y - mu) * rstd * w4.w + bi.w;
                *(f32x4*)(row + q * 4) = ov;
            }
        }
    }
}

#define XB_TMO      128
#define XB_XCNT(j)  (256  + 64 * (j))
#define XB_XSUB(j)  (1280 + 64 * (j))
#define XB_XGEN(j)  (2304 + 64 * (j))
#define XB_TOP      3328
#define XB_TOPGEN   3392
#define XCD_BAR_WORDS 3456
#define XB_SPIN_CAP (1u << 22)
#define LAS __attribute__((address_space(3)))
DI unsigned xb_ld(unsigned* p) { return __hip_atomic_load(p, __ATOMIC_RELAXED, __HIP_MEMORY_SCOPE_AGENT); }
DI unsigned xb_add(unsigned* p, unsigned v) { return __hip_atomic_fetch_add(p, v, __ATOMIC_RELAXED, __HIP_MEMORY_SCOPE_AGENT); }
DI unsigned xb_xcc_id() { return (unsigned)__builtin_amdgcn_s_getreg((3 << 11) | 20) & 0xFu; }
#define XB_SPIN(cond, bar) do { unsigned _sp = 0; while (cond) { __builtin_amdgcn_s_sleep(1); \
    if ((++_sp & 255u) == 0u) { if (xb_ld(&(bar)[XB_TMO])) break; if (_sp > XB_SPIN_CAP) { atomicAdd(&(bar)[XB_TMO], 1u); break; } } } } while (0)
struct XcdBarrier { unsigned* bar; unsigned x; volatile LAS unsigned* st; };
DI XcdBarrier xcd_barrier_post(unsigned* bar, volatile LAS unsigned* st) {
    XcdBarrier b; b.bar = bar; b.x = xb_xcc_id(); b.st = st;
    if (__builtin_amdgcn_workitem_id_x() == 0) (void)xb_add(&bar[XB_XCNT(b.x)], 1u);
    return b;
}
DI void xcd_barrier_complete(unsigned* bar, unsigned x, unsigned& nloc, unsigned& nx) {
    const unsigned G = gridDim.x * gridDim.y * gridDim.z;
    unsigned sum, cnt, mine, sp = 0u;
    for (;;) {
        sum = 0u; cnt = 0u; mine = 0u;
#pragma unroll
        for (unsigned j = 0; j < 16; ++j) { const unsigned c = xb_ld(&bar[XB_XCNT(j)]); sum += c; cnt += (c > 0u) ? 1u : 0u; mine = (j == x) ? c : mine; }
        if (sum == G) break;
        __builtin_amdgcn_s_sleep(1);
        if ((++sp & 255u) == 0u) { if (xb_ld(&bar[XB_TMO])) break; if (sp > XB_SPIN_CAP) { atomicAdd(&bar[XB_TMO], 1u); break; } }
    }
    nloc = mine > 0u ? mine : 1u; nx = cnt > 0u ? cnt : 1u;
}
DI void xcd_barrier(const XcdBarrier& b) {
    asm volatile("s_waitcnt vmcnt(0)" ::: "memory");
    __syncthreads();
    if (__builtin_amdgcn_workitem_id_x() == 0) {
        unsigned* bar = b.bar;
        unsigned bx = b.x; asm volatile("" : "+s"(bx));
        __builtin_amdgcn_s_waitcnt(0);
        unsigned nloc = b.st[0], nx = b.st[1];
        if (nloc == 0u) { xcd_barrier_complete(bar, bx, nloc, nx); b.st[0] = nloc; b.st[1] = nx; }
        const unsigned old = xb_add(&bar[XB_XSUB(bx)], 1u);
        const unsigned gen = old / nloc;
        if (old + 1u == (gen + 1u) * nloc) {
            __builtin_amdgcn_fence(__ATOMIC_RELEASE, "agent");
            asm volatile("s_waitcnt vmcnt(0)" ::: "memory");
            const unsigned og = xb_add(&bar[XB_TOP], 1u);
            const unsigned tg = og / nx;
            if (og + 1u == (tg + 1u) * nx) xb_add(&bar[XB_TOPGEN], 1u);
            else XB_SPIN(xb_ld(&bar[XB_TOPGEN]) == tg, bar);
            __builtin_amdgcn_fence(__ATOMIC_ACQUIRE, "agent");
            xb_add(&bar[XB_XGEN(bx)], 1u);
            asm volatile("s_waitcnt vmcnt(0)" ::: "memory");
        } else {
            XB_SPIN(xb_ld(&bar[XB_XGEN(bx)]) == gen, bar);
            __builtin_amdgcn_fence(__ATOMIC_ACQUIRE, "agent");
            asm volatile("s_waitcnt vmcnt(0)" ::: "memory");
        }
    }
    __syncthreads();
}

__global__ void __launch_bounds__(NTH) k_mega(Params p) {
    __shared__ __attribute__((aligned(16))) char smem[SMEM_BYTES];
    volatile LAS unsigned* xst = (volatile LAS unsigned*)(smem + SMEM_BYTES - 16);
    if (__builtin_amdgcn_workitem_id_x() == 0) { xst[0] = 0u; xst[1] = 0u; }
    __syncthreads();
    const XcdBarrier xb = xcd_barrier_post((unsigned*)(p.ws + OFF_BAR), xst);
    const int bid = blockIdx.x, nb = gridDim.x;
#ifndef PROBE_MASK
#define PROBE_MASK 0
#endif
#define REP(bit) for (int rep_ = 0; rep_ < ((PROBE_MASK & (bit)) ? 2 : 1); ++rep_)
    phase_prep_a(p, smem);           xcd_barrier(xb);
    phase_prep_b(p, smem);           xcd_barrier(xb);
    REP(1)  { phase_proj(p, bid, nb, smem);    xcd_barrier(xb); }
    REP(2)  { phase_mix(p, bid, nb, smem);     xcd_barrier(xb); }
    REP(4)  { phase_glu(p, bid, nb, smem);     xcd_barrier(xb); }
    REP(4)  { phase_outproj(p, bid, nb, smem); xcd_barrier(xb); }
    REP(8)  { phase_q(p, bid, nb, smem);       xcd_barrier(xb); }
    REP(16) { phase_retrieve(p, bid, nb, smem); xcd_barrier(xb); }
    phase_gather(p, bid, nb, smem, (unsigned*)(p.ws + OFF_BAR) + 16 * xb_xcc_id(), (unsigned)__builtin_amdgcn_readfirstlane((int)xst[0]));
}

extern "C" void kernel_launch(void* const* d_in, const int* in_sizes, int n_in, void* d_out, int out_size, void* d_ws, size_t ws_size, hipStream_t stream) {
    if (n_in != 27 || ws_size < WS_END) { fprintf(stderr, "kernel_launch: unexpected n_in %d or ws_size %zu (< %zu)\n", n_in, ws_size, (size_t)WS_END); return; }
    static int grid_blocks = 0;
    if (!grid_blocks) {
        int dev = 0, cus = 0, per_cu = 0;
        (void)hipGetDevice(&dev);
        (void)hipDeviceGetAttribute(&cus, hipDeviceAttributeMultiprocessorCount, dev);
        (void)hipOccupancyMaxActiveBlocksPerMultiprocessor(&per_cu, k_mega, NTH, 0);
        if (cus <= 0) cus = 256;
        if (per_cu < 1) { fprintf(stderr, "kernel_launch: occupancy query says %d blocks/CU\n", per_cu); per_cu = 1; }
        grid_blocks = cus;
    }
    Params p{};
    const float** f = (const float**)&p;
    for (int i = 0; i < 27; ++i) f[i] = (const float*)d_in[i];
    p.out = (float*)d_out; p.ws = (char*)d_ws;
    hipError_t e = hipMemsetAsync((char*)d_ws + OFF_BAR, 0, (size_t)3456 * 4, stream);
    if (e == hipSuccess) { hipLaunchKernelGGL(k_mega, dim3(grid_blocks), dim3(NTH), 0, stream, p); e = hipPeekAtLastError(); }
    if (e != hipSuccess) fprintf(stderr, "launch failed: %s (grid %d)\n", hipGetErrorString(e), grid_blocks);
}
```

```cpp
#include <hip/hip_runtime.h>
#include <hip/hip_cooperative_groups.h>
#include <stdint.h>
#include <stdio.h>

namespace cg = cooperative_groups;
#define DI __device__ __forceinline__
typedef unsigned short bf16_t;
typedef short bf16x8 __attribute__((ext_vector_type(8)));
typedef float f32x16 __attribute__((ext_vector_type(16)));
typedef unsigned u32x4 __attribute__((ext_vector_type(4)));
typedef float f32x4 __attribute__((ext_vector_type(4)));
typedef float f32x2 __attribute__((ext_vector_type(2)));

constexpr int NTH = 512;
constexpr int NB = 16, SEQ = 2048, DM = 1024, NTOK = NB * SEQ;
constexpr int DHG = 512, HGH = 4, HDK = 128;
constexpr int DSS = 512, SSG = 32, SSC = 16, SSP = 64;
constexpr int INC = 2560;
constexpr int PHEADS = 8, NKEYS = 128, TOPK = 16, NEXP = 16384;
constexpr float DEEP_ALPHA = 1.189207115002721f;
constexpr float LN_EPS = 1e-5f, RMS_EPS = 1e-6f;
constexpr int SMEM_BYTES = 128 * 1024 + 256;

constexpr size_t al256(size_t x) { return (x + 255) & ~(size_t)255; }
constexpr size_t OFF_MOD = 0;
constexpr size_t OFF_LB = al256(OFF_MOD + (size_t)NB * 6144 * 4);
constexpr size_t OFF_LAM = al256(OFF_LB + 512 * 4);
constexpr size_t OFF_BB = al256(OFF_LAM + 32 * 64 * 2 * 4);
constexpr size_t OFF_WIN = al256(OFF_BB + 32 * 64 * 16 * 2 * 4);
constexpr size_t OFF_GLU = al256(OFF_WIN + (size_t)INC * DM * 2);
constexpr size_t OFF_WOUT = al256(OFF_GLU + (size_t)512 * 512 * 2);
constexpr size_t OFF_WQ = al256(OFF_WOUT + (size_t)DM * DM * 2);
constexpr size_t OFF_SUBK = al256(OFF_WQ + (size_t)2048 * DM * 2);
constexpr size_t OFF_SU = al256(OFF_SUBK + (size_t)16 * 128 * 128 * 2);
constexpr size_t OFF_SV = al256(OFF_SU + (size_t)NEXP * 4);
constexpr size_t OFF_UT = al256(OFF_SV + (size_t)NEXP * 4);
constexpr size_t OFF_VT = al256(OFF_UT + (size_t)NEXP * DM * 2);
constexpr size_t OFF_H = al256(OFF_VT + (size_t)NEXP * DM * 2);
constexpr size_t OFF_PROJ = al256(OFF_H + (size_t)NTOK * DM * 2);
constexpr size_t OFF_ORAW = al256(OFF_PROJ + (size_t)NTOK * INC * 2);
constexpr size_t OFF_YSSM = al256(OFF_ORAW + (size_t)NTOK * DHG * 4);
constexpr size_t OFF_A2 = al256(OFF_YSSM + (size_t)NTOK * DSS * 2);
constexpr size_t OFF_HG = al256(OFF_A2 + (size_t)NTOK * DM * 2);
constexpr size_t OFF_S5K = al256(OFF_HG + (size_t)4096 * 128 * 4);
constexpr size_t OFF_S5N = al256(OFF_S5K + (size_t)32 * 4096 * 2);
constexpr size_t OFF_S5M = al256(OFF_S5N + (size_t)32 * 128 * 256 * 2);
constexpr size_t OFF_S5L = al256(OFF_S5M + (size_t)32 * 256 * 128 * 2);
constexpr size_t OFF_STAT = al256(OFF_S5L + (size_t)32 * 64 * 2 * 4);
constexpr size_t OFF_AB = al256(OFF_STAT + (size_t)NTOK * 3 * 4);
constexpr size_t OFF_CAB = al256(OFF_AB + (size_t)2 * NB * DM * 4);
constexpr size_t OFF_BAR = al256(OFF_CAB + (size_t)2 * NB * 2048 * 4);
constexpr size_t WS_END = al256(OFF_BAR + (size_t)3456 * 4);
constexpr size_t OFF_HQ = OFF_ORAW, OFF_HK = OFF_ORAW + (size_t)NTOK * DHG * 2;
constexpr size_t OFF_TOPL = OFF_ORAW;
constexpr size_t OFF_EXPS = OFF_YSSM;
constexpr size_t OFF_R1 = OFF_ORAW;

struct Params {
    const float *x, *c, *ada_w, *ada_b, *w_in, *hg_lb, *hg_nw, *a_re, *a_im, *log_dt, *b_re, *b_im, *c_re, *c_im, *dsk,
        *glu_w, *glu_b, *ssm_nw, *w_out, *ln1w, *ln1b, *w_q, *subk, *pu, *pv, *ln2w, *ln2b;
    float* out;
    char* ws;
};

DI int my_tid() { int t = (int)__builtin_amdgcn_workitem_id_x(); asm volatile("" : "+v"(t)); return t; }
DI bf16_t f2bf(float x) { unsigned u = __float_as_uint(x); u += 0x7fffu + ((u >> 16) & 1u); return (bf16_t)(u >> 16); }
DI float bf2f(bf16_t b) { return __uint_as_float(((unsigned)b) << 16); }
DI float bflo(unsigned w) { return __uint_as_float(w << 16); }
DI float bfhi(unsigned w) { return __uint_as_float(w & 0xffff0000u); }
typedef __bf16 hwbf16x2 __attribute__((ext_vector_type(2)));
DI unsigned pack2(float a, float b) { const f32x2 v = {a, b}; return __builtin_bit_cast(unsigned, __builtin_convertvector(v, hwbf16x2)); }
DI bf16x8 pack8(const f32x16& x, const int base) {
    u32x4 o; o.x = pack2(x[base], x[base + 1]); o.y = pack2(x[base + 2], x[base + 3]); o.z = pack2(x[base + 4], x[base + 5]); o.w = pack2(x[base + 6], x[base + 7]);
    return __builtin_bit_cast(bf16x8, o);
}
DI float sigmoidf_(float x) { return 1.0f / (1.0f + __expf(-x)); }
DI float siluf_(float x) { return x * sigmoidf_(x); }
DI float geluf_(float x) { return 0.5f * x * (1.0f + erff(x * 0.70710678118654752f)); }
DI float gelu_as(float v) {
    const float t = __builtin_amdgcn_rcpf(fabsf(v) * 0.2316418882f + 1.0f);
    float q = t * 0.5307027145f + (-0.7265760135f); q = q * t + 0.7107068705f; q = q * t + (-0.142248368f); q = q * t + 0.127414796f; q = q * t;
    const float m = v * (q * __builtin_amdgcn_exp2f(v * v * (-0.72134752044f)));
    return v < 0.f ? m : v - m;
}

template <int MT, int NT_, int WM, int WN, class Epi>
DI void gemm_block(const bf16_t* __restrict__ A, int lda, const bf16_t* __restrict__ Bt, int ldb, int K, char* smem, Epi epi) {
    constexpr int BM = WM * MT * 32, BN = WN * NT_ * 32, LS = 72;
    static_assert(WM * WN == 8, "8 waves");
    bf16_t* As = (bf16_t*)smem;
    bf16_t* Bs = As + BM * LS;
    const int tid = my_tid(), lane = tid & 63, wid = tid >> 6, r = lane & 31, h = lane >> 5;
    const int wm = wid / WN, wn = wid % WN;
    constexpr int PA = BM * 8 / NTH, PB = BN * 8 / NTH;
    u32x4 ra[PA], rb[PB];
    f32x16 acc[MT][NT_];
#pragma unroll
    for (int mi = 0; mi < MT; ++mi)
#pragma unroll
        for (int ni = 0; ni < NT_; ++ni)
#pragma unroll
            for (int i = 0; i < 16; ++i) acc[mi][ni][i] = 0.f;
#define GEMM_GLOAD(kt_) { \
    _Pragma("unroll") for (int q = 0; q < PA; ++q) { const int idx = tid + q * NTH, row = idx >> 3, ch = idx & 7; ra[q] = *(const u32x4*)(A + (size_t)row * lda + (kt_) * 64 + ch * 8); } \
    _Pragma("unroll") for (int q = 0; q < PB; ++q) { const int idx = tid + q * NTH, row = idx >> 3, ch = idx & 7; rb[q] = *(const u32x4*)(Bt + (size_t)row * ldb + (kt_) * 64 + ch * 8); } }
#define GEMM_LSTORE() { \
    _Pragma("unroll") for (int q = 0; q < PA; ++q) { const int idx = tid + q * NTH, row = idx >> 3, ch = idx & 7; *(u32x4*)(As + row * LS + ch * 8) = ra[q]; } \
    _Pragma("unroll") for (int q = 0; q < PB; ++q) { const int idx = tid + q * NTH, row = idx >> 3, ch = idx & 7; *(u32x4*)(Bs + row * LS + ch * 8) = rb[q]; } }
    GEMM_GLOAD(0); GEMM_LSTORE(); __syncthreads();
    const int nk = K / 64;
    for (int kt = 0; kt < nk; ++kt) {
        if (kt + 1 < nk) GEMM_GLOAD(kt + 1);
#pragma unroll
        for (int ks = 0; ks < 4; ++ks) {
            bf16x8 a[MT], b[NT_];
#pragma unroll
            for (int mi = 0; mi < MT; ++mi) a[mi] = *(const bf16x8*)(As + (wm * MT * 32 + mi * 32 + r) * LS + ks * 16 + h * 8);
#pragma unroll
            for (int ni = 0; ni < NT_; ++ni) b[ni] = *(const bf16x8*)(Bs + (wn * NT_ * 32 + ni * 32 + r) * LS + ks * 16 + h * 8);
#pragma unroll
            for (int mi = 0; mi < MT; ++mi)
#pragma unroll
                for (int ni = 0; ni < NT_; ++ni) acc[mi][ni] = __builtin_amdgcn_mfma_f32_32x32x16_bf16(a[mi], b[ni], acc[mi][ni], 0, 0, 0);
        }
        __syncthreads();
        if (kt + 1 < nk) { GEMM_LSTORE(); __syncthreads(); }
    }
#pragma unroll
    for (int mi = 0; mi < MT; ++mi)
#pragma unroll
        for (int ni = 0; ni < NT_; ++ni)
#pragma unroll
            for (int i = 0; i < 16; ++i) epi(wm * MT * 32 + mi * 32 + (i & 3) + 8 * (i >> 2) + 4 * h, wn * NT_ * 32 + ni * 32 + r, acc[mi][ni][i]);
}

namespace pg8 {
#define PG8_LAS __attribute__((address_space(3)))
typedef unsigned short bf16_t;
typedef short bf16x8 __attribute__((ext_vector_type(8)));
typedef float f32x4 __attribute__((ext_vector_type(4)));
typedef unsigned u32x4 __attribute__((ext_vector_type(4)));
constexpr int BM = 256, BK = 64, HALF = 128, HTB = HALF * BK * 2  , STAGE_BYTES = 8 * HTB, NXCD = 8, WGM = 8;

__host__ __device__ __forceinline__ int lds_byte(int r, int c) { const int st = (r >> 4) * 2 + (c >> 5), rr = r & 15, cc = c & 31, ob = rr * 64 + cc * 2; return st * 1024 + (ob ^ (((ob >> 9) & 1) << 5)); }
__host__ __device__ __forceinline__ void stage_rc(int b, int& R, int& C) { const int st = b / 1024, sb = b % 1024, swz = sb ^ (((sb >> 9) & 1) << 5); R = (st >> 1) * 16 + swz / 64; C = (st & 1) * 32 + (swz % 64) / 2; }
__host__ __device__ __forceinline__ int perm32(int rho) { const int n = rho >> 4, i = rho & 15; return 8 * (i >> 2) + 4 * n + (i & 3); }

struct Unit { int pm, pn; };
struct Gemm { const bf16_t* A; const bf16_t* Bt; int M, N, K; };

struct StaticOrder {
    int nM, nN, nwg, G, c;
    __host__ __device__ void init(int M, int N, int G_, int c_) { nM = M / BM; nN = N / BM; nwg = nM * nN; G = G_; c = c_; }
    __host__ __device__ bool next(int i, Unit& u) const {
        const long L = (long)i * G + c; if (L >= nwg) return false;
        int wgid = (int)L; { const int q = nwg / NXCD, r = nwg % NXCD, xcd = wgid % NXCD, off = wgid / NXCD; wgid = (xcd < r ? xcd * (q + 1) : r * (q + 1) + (xcd - r) * q) + off; }
        const int nig = WGM * nN, gid = wgid / nig, fm = gid * WGM, gsz = (nM - fm) < WGM ? (nM - fm) : WGM;
        u.pm = fm + ((wgid % nig) % gsz); u.pn = (wgid % nig) / gsz; return true;
    }
    __device__ __forceinline__ void a_ready(const Unit&) const {}
    __device__ __forceinline__ void done(const Unit&) const {}
};
template <class Epi, class Sched, bool STAMP = false>
__device__ __forceinline__ void gemm_phase(PG8_LAS unsigned char* lds, const Gemm g, const Sched& S, const Epi& E, unsigned long long* stamps) {
    int tid_ = (int)__builtin_amdgcn_workitem_id_x(); asm volatile("" : "+v"(tid_));
    const int tid = tid_, wid = __builtin_amdgcn_readfirstlane(tid >> 6), lane = tid & 63, wr = wid >> 2, wc = wid & 3, fr = lane & 15, fq = lane >> 4;
    const int K = g.K, nt = K / BK;
    int ts_lo = 0, ts_hi = 0, nts = 0; const unsigned long long rt_entry = STAMP ? (unsigned long long)wall_clock64() : 0ull;
#define PG8_STAMP() do { if (STAMP && wid == 0 && nts < 64) { const unsigned long long _c = (unsigned long long)clock64(); \
        ts_lo = (lane == nts) ? (int)(unsigned)_c : ts_lo; ts_hi = (lane == nts) ? (int)(unsigned)(_c >> 32) : ts_hi; ++nts; } } while (0)
    PG8_STAMP();
    unsigned voffA[2], voffB[2];
#pragma unroll
    for (int i = 0; i < 2; ++i) { int R, C; stage_rc(tid * 16 + i * 8192, R, C); const int Rb = Epi::PERM ? ((R & ~31) + perm32(R & 31)) : R;
        voffA[i] = (unsigned)(R * K + C) * 2u; voffB[i] = (unsigned)(Rb * K + C) * 2u; }
    const size_t kstep = (size_t)(BK * 2);
    const size_t hstep = (size_t)HALF * K * 2;
    const size_t tstep = 2 * hstep;
    const unsigned ldsw = (unsigned)wid * 1024u;
    const int aoff = lds_byte(wr * 64 + fr, fq * 8), boff = lds_byte(wc * 32 + fr, fq * 8);
#define PG8_SA(b, h) (((b) * 2 + (h)) * HTB)
#define PG8_SB(b, h) ((4 + (b) * 2 + (h)) * HTB)
#define PG8_STAGE(bufoff, gbase, voff) do { _Pragma("unroll") for (int _i = 0; _i < 2; ++_i) \
        __builtin_amdgcn_global_load_lds((const unsigned*)((const char*)(gbase) + (voff)[_i]), (PG8_LAS unsigned*)(lds + (bufoff) + ldsw + _i * 8192), 16, 0, 0); } while (0)
#define PG8_LDA(dst, b, h) do { _Pragma("unroll") for (int m = 0; m < 4; ++m) _Pragma("unroll") for (int k = 0; k < 2; ++k) dst[m][k] = *(const PG8_LAS bf16x8*)(lds + PG8_SA(b, h) + aoff + m * 2048 + k * 1024); } while (0)
#define PG8_LDB(dst, b, h) do { _Pragma("unroll") for (int n = 0; n < 2; ++n) _Pragma("unroll") for (int k = 0; k < 2; ++k) dst[n][k] = *(const PG8_LAS bf16x8*)(lds + PG8_SB(b, h) + boff + n * 2048 + k * 1024); } while (0)
#define PG8_MMA(ai, bj, At, Bt) do { __builtin_amdgcn_s_setprio(1); _Pragma("unroll") for (int m = 0; m < 4; ++m) _Pragma("unroll") for (int n = 0; n < 2; ++n) _Pragma("unroll") for (int k = 0; k < 2; ++k) \
        acc[ai][bj][m][n] = __builtin_amdgcn_mfma_f32_16x16x32_bf16(Bt[n][k], At[m][k], acc[ai][bj][m][n], 0, 0, 0); __builtin_amdgcn_s_setprio(0); } while (0)
#define PG8_WAIT_V(n) asm volatile("s_waitcnt vmcnt(" #n ")" ::: "memory")
#define PG8_WAIT_L(n) asm volatile("s_waitcnt lgkmcnt(" #n ")" ::: "memory")
#define PG8_BAR __builtin_amdgcn_s_barrier()
#define PG8_SCHED __builtin_amdgcn_sched_barrier(0)
    Unit cur, nxt; int ui = 0;
    if (!S.next(0, cur)) return;
    f32x4 acc[2][2][4][2];
#pragma unroll
    for (int a = 0; a < 2; ++a)
#pragma unroll
        for (int b = 0; b < 2; ++b)
#pragma unroll
            for (int m = 0; m < 4; ++m)
#pragma unroll
                for (int n = 0; n < 2; ++n) acc[a][b][m][n] = (f32x4){0.f, 0.f, 0.f, 0.f};
    bf16x8 At[4][2], B0[2][2], B1[2][2];
    const char* cA = (const char*)g.A + (size_t)cur.pm * tstep; const char* cB = (const char*)g.Bt + (size_t)cur.pn * tstep;
    S.a_ready(cur);
    PG8_STAGE(PG8_SB(0, 0), cB, voffB); PG8_STAGE(PG8_SA(0, 0), cA, voffA); PG8_STAGE(PG8_SB(0, 1), cB + hstep, voffB); PG8_STAGE(PG8_SA(0, 1), cA + hstep, voffA);
    if (wr == 1) PG8_BAR;
    PG8_WAIT_V(4); PG8_BAR;
    PG8_STAGE(PG8_SB(1, 0), cB + kstep, voffB); PG8_STAGE(PG8_SA(1, 0), cA + kstep, voffA); PG8_STAGE(PG8_SB(1, 1), cB + hstep + kstep, voffB);
    PG8_WAIT_V(6); PG8_BAR;
    PG8_STAMP();
    for (;;) {
        const bool has_next = S.next(ui + 1, nxt);
        const char* nA = has_next ? (const char*)g.A + (size_t)nxt.pm * tstep : cA; const char* nB = has_next ? (const char*)g.Bt + (size_t)nxt.pn * tstep : cB;
        for (int t = 0; t < nt; t += 2) {
            const bool last = (t == nt - 2);
            const char* a1 = cA + (size_t)(t + 1) * kstep;
            const char* a2 = last ? nA : cA + (size_t)(t + 2) * kstep; const char* b2 = last ? nB : cB + (size_t)(t + 2) * kstep;
            const char* a3 = a2 + kstep; const char* b3 = b2 + kstep;
            if (last && has_next) S.a_ready(nxt);
            if constexpr (Epi::MIDSCALE) { if (t == nt / 2) E.midscale(acc, cur, wr, fr); }
            PG8_LDB(B0, 0, 0); PG8_SCHED; PG8_LDA(At, 0, 0); PG8_STAGE(PG8_SA(1, 1), a1 + hstep, voffA);
            PG8_WAIT_L(8); PG8_BAR; PG8_WAIT_L(0); PG8_MMA(0, 0, At, B0); PG8_BAR; PG8_SCHED;
            PG8_LDB(B1, 0, 1); PG8_STAGE(PG8_SB(0, 0), b2, voffB);
            PG8_BAR; PG8_WAIT_L(0); PG8_MMA(0, 1, At, B1); PG8_BAR;
            PG8_LDA(At, 0, 1); PG8_STAGE(PG8_SA(0, 0), a2, voffA);
            PG8_BAR; PG8_WAIT_L(0); PG8_MMA(1, 0, At, B0); PG8_BAR; PG8_SCHED;
            PG8_STAGE(PG8_SB(0, 1), b2 + hstep, voffB);
            PG8_WAIT_V(6); PG8_BAR; PG8_MMA(1, 1, At, B1); PG8_BAR;
            PG8_LDB(B0, 1, 0); PG8_SCHED; PG8_LDA(At, 1, 0); PG8_STAGE(PG8_SA(0, 1), a2 + hstep, voffA);
            PG8_WAIT_L(8); PG8_BAR; PG8_WAIT_L(0); PG8_MMA(0, 0, At, B0); PG8_BAR; PG8_SCHED;
            PG8_LDB(B1, 1, 1); PG8_STAGE(PG8_SB(1, 0), b3, voffB);
            PG8_BAR; PG8_WAIT_L(0); PG8_MMA(0, 1, At, B1); PG8_BAR;
            PG8_LDA(At, 1, 1); PG8_STAGE(PG8_SA(1, 0), a3, voffA);
            PG8_BAR; PG8_WAIT_L(0); PG8_MMA(1, 0, At, B0); PG8_BAR; PG8_SCHED;
            PG8_STAGE(PG8_SB(1, 1), b3 + hstep, voffB);
            PG8_WAIT_V(6); PG8_BAR; PG8_MMA(1, 1, At, B1); PG8_BAR;
        }
        PG8_STAMP();
        if constexpr (!Epi::AFTER_DRAIN) { E(acc, cur, wr, wc, fr, fq); S.done(cur); }
        PG8_STAMP();
        if (!has_next) break;
#pragma unroll
        for (int a = 0; a < 2; ++a)
#pragma unroll
            for (int b = 0; b < 2; ++b)
#pragma unroll
                for (int m = 0; m < 4; ++m)
#pragma unroll
                    for (int n = 0; n < 2; ++n) acc[a][b][m][n] = (f32x4){0.f, 0.f, 0.f, 0.f};
        cur = nxt; cA = nA; cB = nB; ++ui;
    }
    PG8_WAIT_V(0);
    if (wr == 0) PG8_BAR;
    PG8_BAR;
    if constexpr (Epi::AFTER_DRAIN) { E.fused(acc, cur, wr, wc, fr, fq, lds, wid, lane); S.done(cur); }
    PG8_STAMP();
    if (STAMP && wid == 0) { stamps[lane] = lane < nts ? (((unsigned long long)(unsigned)ts_hi << 32) | (unsigned)ts_lo) : 0ull;
        if (lane == 62) stamps[62] = rt_entry; if (lane == 63) stamps[63] = (unsigned long long)wall_clock64(); }
#undef PG8_STAMP
#undef PG8_SA
#undef PG8_SB
#undef PG8_STAGE
#undef PG8_LDA
#undef PG8_LDB
#undef PG8_MMA
#undef PG8_WAIT_V
#undef PG8_WAIT_L
#undef PG8_BAR
#undef PG8_SCHED
}

__device__ __forceinline__ unsigned pk_bf16(float lo, float hi) { typedef float v2f __attribute__((ext_vector_type(2))); typedef __bf16 v2b __attribute__((ext_vector_type(2))); const v2f v = {lo, hi}; return __builtin_bit_cast(unsigned, __builtin_convertvector(v, v2b)); }
__device__ __forceinline__ float silu1(float x) { return x * __builtin_amdgcn_rcpf(1.0f + __expf(-x)); }
struct EpiBf16Act {
    static constexpr bool PERM = true, AFTER_DRAIN = false, MIDSCALE = false;
    bf16_t* O; int ldc; unsigned silu_mask;
    __device__ __forceinline__ void operator()(const f32x4 (&acc)[2][2][4][2], const Unit& u, int wr, int wc, int fr, int fq) const {
        const int row0 = u.pm * BM + wr * 64 + fr, col0 = u.pn * BM + wc * 32 + 8 * fq;
        const bool act = (silu_mask >> u.pn) & 1u;
#pragma unroll
        for (int ai = 0; ai < 2; ++ai)
#pragma unroll
            for (int m = 0; m < 4; ++m) { bf16_t* rowp = O + (size_t)(row0 + ai * HALF + m * 16) * ldc + col0;
#pragma unroll
                for (int bj = 0; bj < 2; ++bj) { f32x4 v0 = acc[ai][bj][m][0], v1 = acc[ai][bj][m][1];
                    if (act) {
#pragma unroll
                        for (int j = 0; j < 4; ++j) { v0[j] = silu1(v0[j]); v1[j] = silu1(v1[j]); } }
                    u32x4 w; w.x = pk_bf16(v0[0], v0[1]); w.y = pk_bf16(v0[2], v0[3]); w.z = pk_bf16(v1[0], v1[1]); w.w = pk_bf16(v1[2], v1[3]);
                    *(u32x4*)(rowp + bj * HALF) = w; } }
    }
};
struct EpiProj {
    static constexpr bool PERM = true, AFTER_DRAIN = false, MIDSCALE = false;
    bf16_t* O; bf16_t* HQ; bf16_t* HK; float* HG; const float* LB;
    __device__ __forceinline__ void operator()(const f32x4 (&acc)[2][2][4][2], const Unit& u, int wr, int wc, int fr, int fq) const {
        if (u.pn >= 4) {
            const int row0 = u.pm * BM + wr * 64 + fr, col0 = u.pn * BM + wc * 32 + 8 * fq;
            const bool act = (u.pn == 6) || (u.pn == 7);
#pragma unroll
            for (int ai = 0; ai < 2; ++ai)
#pragma unroll
                for (int m = 0; m < 4; ++m) { bf16_t* rowp = O + (size_t)(row0 + ai * HALF + m * 16) * 2560 + col0;
#pragma unroll
                    for (int bj = 0; bj < 2; ++bj) { f32x4 v0 = acc[ai][bj][m][0], v1 = acc[ai][bj][m][1];
                        if (act) {
#pragma unroll
                            for (int j = 0; j < 4; ++j) { v0[j] = silu1(v0[j]); v1[j] = silu1(v1[j]); } }
                        u32x4 w; w.x = pk_bf16(v0[0], v0[1]); w.y = pk_bf16(v0[2], v0[3]); w.z = pk_bf16(v1[0], v1[1]); w.w = pk_bf16(v1[2], v1[3]);
                        *(u32x4*)(rowp + bj * HALF) = w; } }
            return;
        }
        const int hd = u.pn, bat = (u.pm * BM) / 2048, cb = (u.pm & 7) * 8, k0 = wc * 32 + 8 * fq, lane = fq * 16 + fr;
        float lb[8];
        { const f32x4 l0 = *(const f32x4*)(LB + hd * 128 + k0), l1 = *(const f32x4*)(LB + hd * 128 + k0 + 4);
          lb[0] = l0[0]; lb[1] = l0[1]; lb[2] = l0[2]; lb[3] = l0[3]; lb[4] = l1[0]; lb[5] = l1[1]; lb[6] = l1[2]; lb[7] = l1[3]; }
#pragma unroll
        for (int ac = 0; ac < 4; ++ac) {
            const int ai = ac >> 1, cp = ac & 1;
            __builtin_amdgcn_sched_barrier(0);
            const size_t tile = ((size_t)(bat * 4 + hd) * 64 + cb + 4 * ai + 2 * wr + cp);
#pragma unroll
            for (int eh = 0; eh < 2; ++eh) {
                __builtin_amdgcn_sched_barrier(0);
                float tot0[4];
                bf16_t* hq = HQ + tile * 4096 + k0 + 4 * eh;
                bf16_t* hk = HK + tile * 4096 + k0 + 4 * eh;
#pragma unroll
                for (int mm = 0; mm < 2; ++mm) {
                    const f32x4 q4 = acc[ai][0][2 * cp + mm][eh], f4 = acc[ai][1][2 * cp + mm][eh];
                    float qo[4], ko[4], bl[4];
#pragma unroll
                    for (int e = 0; e < 4; ++e) {
                        const float lbe = lb[4 * eh + e];
                        const float f = lbe + (1.0f - lbe) * __builtin_amdgcn_rcpf(1.0f + __expf(-f4[e]));
                        float sc = __logf(f);
                        sc += __builtin_bit_cast(float, __builtin_amdgcn_update_dpp(0, __builtin_bit_cast(int, sc), 0x111, 0xf, 0xf, true));
                        sc += __builtin_bit_cast(float, __builtin_amdgcn_update_dpp(0, __builtin_bit_cast(int, sc), 0x112, 0xf, 0xf, true));
                        sc += __builtin_bit_cast(float, __builtin_amdgcn_update_dpp(0, __builtin_bit_cast(int, sc), 0x114, 0xf, 0xf, true));
                        sc += __builtin_bit_cast(float, __builtin_amdgcn_update_dpp(0, __builtin_bit_cast(int, sc), 0x118, 0xf, 0xf, true));
                        if (mm == 1) sc += tot0[e];
                        bl[e] = sc;
                        qo[e] = silu1(q4[e]) * __expf(sc); ko[e] = (1.0f - f) * __expf(fminf(-sc, 80.0f));
                    }
                    *(uint2*)(hq + (size_t)(mm * 16 + fr) * 128) = make_uint2(pk_bf16(qo[0], qo[1]), pk_bf16(qo[2], qo[3]));
                    *(uint2*)(hk + (size_t)(mm * 16 + fr) * 128) = make_uint2(pk_bf16(ko[0], ko[1]), pk_bf16(ko[2], ko[3]));
                    if (mm == 0) {
#pragma unroll
                        for (int e = 0; e < 4; ++e) tot0[e] = __shfl(bl[e], (lane & 48) | 15);
                    } else if (fr == 15) *(f32x4*)(HG + tile * 128 + k0 + 4 * eh) = (f32x4){__expf(bl[0]), __expf(bl[1]), __expf(bl[2]), __expf(bl[3])};
                    __builtin_amdgcn_sched_barrier(0);
                }
            }
        }
    }
};
struct EpiResid {
    static constexpr bool PERM = true, AFTER_DRAIN = false, MIDSCALE = true;
    bf16_t* R1; const float* X; const float* mod_g;
    static constexpr int NTOK_ = 32768;
    float alpha; bf16_t* AP; const float* avec; float* stat;
    const float* ssq; float rms_eps;
    __device__ __forceinline__ void midscale(f32x4 (&acc)[2][2][4][2], const Unit& u, int wr, int fr) const {
        const float* sp = ssq + u.pm * BM + wr * 64 + fr;
#pragma unroll
        for (int ai = 0; ai < 2; ++ai)
#pragma unroll
            for (int m = 0; m < 4; ++m) {
                const float rs = rsqrtf(sp[ai * HALF + m * 16] * (1.0f / 512.0f) + rms_eps);
#pragma unroll
                for (int bj = 0; bj < 2; ++bj)
#pragma unroll
                    for (int n = 0; n < 2; ++n) acc[ai][bj][m][n] *= rs;
            }
    }
    __device__ __forceinline__ void operator()(const f32x4 (&acc)[2][2][4][2], const Unit& u, int wr, int wc, int fr, int fq) const {
        const int row0 = u.pm * BM + wr * 64 + fr, col0 = u.pn * BM + wc * 32 + 8 * fq, bat = (u.pm * BM) / 2048;
        const float* gb = mod_g + (size_t)bat * 6144 + col0;
        const float* ab = avec + (size_t)bat * 1024 + col0;
        float s1[2][4], s2[2][4];
#pragma unroll
        for (int ai = 0; ai < 2; ++ai)
#pragma unroll
            for (int m = 0; m < 4; ++m) { s1[ai][m] = 0.f; s2[ai][m] = 0.f; }
        f32x4 xq[2][2];
        const unsigned robase = (unsigned)row0 * 1024u + (unsigned)col0;
#define RESID_RO(G_) (robase + (unsigned)((((G_) >> 2) & 1) * HALF + ((G_) & 3) * 16) * 1024u + (unsigned)(((G_) >> 3) * HALF))
#define RESID_LOADX(G_, S_) { const unsigned bo_ = RESID_RO(G_) << 2; xq[S_][0] = *(const f32x4*)((const char*)X + bo_); xq[S_][1] = *(const f32x4*)((const char*)X + bo_ + 16); }
        RESID_LOADX(0, 0);
#pragma unroll
        for (int bj = 0; bj < 2; ++bj) {
            const f32x4 g0 = *(const f32x4*)(gb + bj * HALF) + 1.0f, g1 = *(const f32x4*)(gb + bj * HALF + 4) + 1.0f;
            const f32x4 a0 = *(const f32x4*)(ab + bj * HALF), a1 = *(const f32x4*)(ab + bj * HALF + 4);
#pragma unroll
            for (int sub = 0; sub < 8; ++sub) {
                const int grp = bj * 8 + sub, ai = sub >> 2, m = sub & 3;
                if (grp + 1 < 16) { if ((grp & 1) == 0) RESID_LOADX(grp + 1, 1) else RESID_LOADX(grp + 1, 0) }
                {
                    const unsigned bo = RESID_RO(grp) << 1;
                    const f32x4 x0 = xq[grp & 1][0], x1 = xq[grp & 1][1];
                    const f32x4 r0 = alpha * x0 + g0 * acc[ai][bj][m][0], r1 = alpha * x1 + g1 * acc[ai][bj][m][1];
                    u32x4 w; w.x = pk_bf16(r0[0], r0[1]); w.y = pk_bf16(r0[2], r0[3]); w.z = pk_bf16(r1[0], r1[1]); w.w = pk_bf16(r1[2], r1[3]);
                    *(u32x4*)((char*)R1 + bo) = w;
                    const f32x4 p0 = r0 * a0, p1 = r1 * a1;
                    w.x = pk_bf16(p0[0], p0[1]); w.y = pk_bf16(p0[2], p0[3]); w.z = pk_bf16(p1[0], p1[1]); w.w = pk_bf16(p1[2], p1[3]);
                    *(u32x4*)((char*)AP + bo) = w;
                    s1[ai][m] += ((r0[0] + r0[1]) + (r0[2] + r0[3])) + ((r1[0] + r1[1]) + (r1[2] + r1[3]));
                    s2[ai][m] += ((r0[0] * r0[0] + r0[1] * r0[1]) + (r0[2] * r0[2] + r0[3] * r0[3])) + ((r1[0] * r1[0] + r1[1] * r1[1]) + (r1[2] * r1[2] + r1[3] * r1[3]));
                }
            }
        }
#undef RESID_LOADX
#undef RESID_RO
        const bool hi5 = fq & 2, hi4 = fq & 1;
#pragma unroll
        for (int ai = 0; ai < 2; ++ai) {
            const float a1 = (hi5 ? s1[ai][2] : s1[ai][0]) + __shfl_xor(hi5 ? s1[ai][0] : s1[ai][2], 32), b1 = (hi5 ? s1[ai][3] : s1[ai][1]) + __shfl_xor(hi5 ? s1[ai][1] : s1[ai][3], 32);
            const float a2 = (hi5 ? s2[ai][2] : s2[ai][0]) + __shfl_xor(hi5 ? s2[ai][0] : s2[ai][2], 32), b2 = (hi5 ? s2[ai][3] : s2[ai][1]) + __shfl_xor(hi5 ? s2[ai][1] : s2[ai][3], 32);
            const float t1 = (hi4 ? b1 : a1) + __shfl_xor(hi4 ? a1 : b1, 16), t2 = (hi4 ? b2 : a2) + __shfl_xor(hi4 ? a2 : b2, 16);
            const int srow = u.pm * BM + wr * 64 + ai * HALF + fq * 16 + fr;
            atomicAdd(stat + srow, t1); atomicAdd(stat + NTOK_ + srow, t2);
        }
    }
};
struct EpiQLN {
    static constexpr bool PERM = true, AFTER_DRAIN = false, MIDSCALE = false;
    bf16_t* O; const float* stat; const float* ca; const float* cb; float eps;
    __device__ __forceinline__ void operator()(const f32x4 (&acc)[2][2][4][2], const Unit& u, int wr, int wc, int fr, int fq) const {
        const int row0 = u.pm * BM + wr * 64 + fr, col0 = u.pn * BM + wc * 32 + 8 * fq, bat = (u.pm * BM) / 2048;
        const float* cap = ca + (size_t)bat * 2048 + col0;
        const float* cbp = cb + (size_t)bat * 2048 + col0;
        float s1[2][4], s2[2][4];
#pragma unroll
        for (int ai = 0; ai < 2; ++ai)
#pragma unroll
            for (int m = 0; m < 4; ++m) { const int row = row0 + ai * HALF + m * 16; s1[ai][m] = stat[row]; s2[ai][m] = stat[32768 + row]; }
        f32x4 av[2][2], bv[2][2];
#pragma unroll
        for (int bj = 0; bj < 2; ++bj) { av[bj][0] = *(const f32x4*)(cap + bj * HALF); av[bj][1] = *(const f32x4*)(cap + bj * HALF + 4); bv[bj][0] = *(const f32x4*)(cbp + bj * HALF); bv[bj][1] = *(const f32x4*)(cbp + bj * HALF + 4); }
#pragma unroll
        for (int ai = 0; ai < 2; ++ai)
#pragma unroll
            for (int m = 0; m < 4; ++m) {
                const int row = row0 + ai * HALF + m * 16;
                const float mu = s1[ai][m] * (1.0f / 1024.0f), rstd = rsqrtf(fmaxf(s2[ai][m] * (1.0f / 1024.0f) - mu * mu, 0.f) + eps);
#pragma unroll
                for (int bj = 0; bj < 2; ++bj) {
                    const f32x4 v0 = rstd * (acc[ai][bj][m][0] - mu * av[bj][0]) + bv[bj][0], v1 = rstd * (acc[ai][bj][m][1] - mu * av[bj][1]) + bv[bj][1];
                    u32x4 w; w.x = pk_bf16(v0[0], v0[1]); w.y = pk_bf16(v0[2], v0[3]); w.z = pk_bf16(v1[0], v1[1]); w.w = pk_bf16(v1[2], v1[3]);
                    *(u32x4*)((char*)O + (((unsigned)row * 2048u + (unsigned)(col0 + bj * HALF)) << 1)) = w;
                }
            }
    }
};
struct EpiGluA2 {
    static constexpr bool PERM = true, AFTER_DRAIN = false, MIDSCALE = false;
    bf16_t* A2; const bf16_t* Y; const float* bias; const float* nw; float* ssq;
    __device__ __forceinline__ void operator()(const f32x4 (&acc)[2][2][4][2], const Unit& u, int wr, int wc, int fr, int fq) const {
        const int row0 = u.pm * BM + wr * 64 + fr, col0 = u.pn * BM + wc * 32 + 8 * fq;
        float s2[2][4];
#pragma unroll
        for (int ai = 0; ai < 2; ++ai)
#pragma unroll
            for (int m = 0; m < 4; ++m) s2[ai][m] = 0.f;
#pragma unroll
        for (int bj = 0; bj < 2; ++bj) {
            const f32x4 bv0 = *(const f32x4*)(bias + col0 + bj * HALF), bv1 = *(const f32x4*)(bias + col0 + bj * HALF + 4);
            const f32x4 wv0 = *(const f32x4*)(nw + col0 + bj * HALF), wv1 = *(const f32x4*)(nw + col0 + bj * HALF + 4);
#pragma unroll
            for (int ai = 0; ai < 2; ++ai) {
                u32x4 yv[4];
#pragma unroll
                for (int m = 0; m < 4; ++m) yv[m] = *(const u32x4*)((const char*)Y + (((unsigned)(row0 + ai * HALF + m * 16) * 512u + (unsigned)(col0 + bj * HALF)) << 1));
#pragma unroll
                for (int m = 0; m < 4; ++m) { const int row = row0 + ai * HALF + m * 16;
                    const u32x4 yw = yv[m];
                    const f32x4 z0 = acc[ai][bj][m][0] + bv0, z1 = acc[ai][bj][m][1] + bv1;
                    f32x4 o0, o1;
                    o0[0] = __uint_as_float(yw.x << 16) * __builtin_amdgcn_rcpf(1.0f + __expf(-z0[0])); o0[1] = __uint_as_float(yw.x & 0xffff0000u) * __builtin_amdgcn_rcpf(1.0f + __expf(-z0[1]));
                    o0[2] = __uint_as_float(yw.y << 16) * __builtin_amdgcn_rcpf(1.0f + __expf(-z0[2])); o0[3] = __uint_as_float(yw.y & 0xffff0000u) * __builtin_amdgcn_rcpf(1.0f + __expf(-z0[3]));
                    o1[0] = __uint_as_float(yw.z << 16) * __builtin_amdgcn_rcpf(1.0f + __expf(-z1[0])); o1[1] = __uint_as_float(yw.z & 0xffff0000u) * __builtin_amdgcn_rcpf(1.0f + __expf(-z1[1]));
                    o1[2] = __uint_as_float(yw.w << 16) * __builtin_amdgcn_rcpf(1.0f + __expf(-z1[2])); o1[3] = __uint_as_float(yw.w & 0xffff0000u) * __builtin_amdgcn_rcpf(1.0f + __expf(-z1[3]));
                    s2[ai][m] += (o0[0] * o0[0] + o0[1] * o0[1]) + (o0[2] * o0[2] + o0[3] * o0[3]) + (o1[0] * o1[0] + o1[1] * o1[1]) + (o1[2] * o1[2] + o1[3] * o1[3]);
                    const f32x4 p0 = o0 * wv0, p1 = o1 * wv1;
                    u32x4 w; w.x = pk_bf16(p0[0], p0[1]); w.y = pk_bf16(p0[2], p0[3]); w.z = pk_bf16(p1[0], p1[1]); w.w = pk_bf16(p1[2], p1[3]);
                    *(u32x4*)((char*)A2 + (((unsigned)row * 1024u + (unsigned)(col0 + bj * HALF)) << 1)) = w;
                }
            }
        }
        const bool hi5 = fq & 2, hi4 = fq & 1;
#pragma unroll
        for (int ai = 0; ai < 2; ++ai) {
            const float a2 = (hi5 ? s2[ai][2] : s2[ai][0]) + __shfl_xor(hi5 ? s2[ai][0] : s2[ai][2], 32), b2 = (hi5 ? s2[ai][3] : s2[ai][1]) + __shfl_xor(hi5 ? s2[ai][1] : s2[ai][3], 32);
            const float t2 = (hi4 ? b2 : a2) + __shfl_xor(hi4 ? a2 : b2, 16);
            atomicAdd(ssq + u.pm * BM + wr * 64 + ai * HALF + fq * 16 + fr, t2);
        }
    }
};
}

DI void prep_mod_item(const Params& p, int item, char* smem) {
    float* condT = (float*)smem;
    float* red = condT + DM * 16;
    const int tid = my_tid();
    for (int i = tid; i < NB * DM; i += NTH) { const int b = i >> 10, k = i & 1023; condT[k * 16 + b] = siluf_(p.c[i]); }
    __syncthreads();
    const int ks = tid >> 5, col = tid & 31;
    float acc[16];
#pragma unroll
    for (int b = 0; b < 16; ++b) acc[b] = 0.f;
    const float* w = p.ada_w + (size_t)(ks * 64) * 6144 + item * 32 + col;
#pragma unroll 1
    for (int seg = 0; seg < 4; ++seg) {
        float wreg[16];
#pragma unroll
        for (int k = 0; k < 16; ++k) wreg[k] = w[(size_t)(seg * 16 + k) * 6144];
#pragma unroll
        for (int k = 0; k < 16; ++k) {
            const float wv = wreg[k];
            const f32x4* cb = (const f32x4*)(condT + (ks * 64 + seg * 16 + k) * 16);
            const f32x4 c0 = cb[0], c1 = cb[1], c2 = cb[2], c3 = cb[3];
            acc[0] += c0.x * wv; acc[1] += c0.y * wv; acc[2] += c0.z * wv; acc[3] += c0.w * wv;
            acc[4] += c1.x * wv; acc[5] += c1.y * wv; acc[6] += c1.z * wv; acc[7] += c1.w * wv;
            acc[8] += c2.x * wv; acc[9] += c2.y * wv; acc[10] += c2.z * wv; acc[11] += c2.w * wv;
            acc[12] += c3.x * wv; acc[13] += c3.y * wv; acc[14] += c3.z * wv; acc[15] += c3.w * wv;
        }
    }
#pragma unroll
    for (int b = 0; b < 16; ++b) red[(ks * 32 + col) * 16 + b] = acc[b];
    __syncthreads();
    {
        const int b = tid >> 5;
        float sum = p.ada_b[item * 32 + col];
#pragma unroll
        for (int q = 0; q < 16; ++q) sum += red[(q * 32 + col) * 16 + b];
        ((float*)(p.ws + OFF_MOD))[b * 6144 + item * 32 + col] = sum;
    }
    __syncthreads();
}
DI void prep_s5_gemm_item(const Params& p, int g, int part, char* smem) {
    f32x2* pw = (f32x2*)smem;
    f32x2* bbL = pw + 17 * 64;
    f32x2* cL = bbL + 64 * 16;
    const int tid = my_tid();
    const float dt = expf(p.log_dt[g]);
#pragma unroll 1
    for (int idx = tid; idx < 17 * 64; idx += NTH) {
        const int j = idx >> 6, pp = idx & 63;
        const float ar = p.a_re[g * 64 + pp], ai = p.a_im[g * 64 + pp];
        const float mag = expf(ar * dt * (float)j), ang = ai * dt * (float)j;
        pw[idx] = (f32x2){mag * cosf(ang), mag * sinf(ang)};
    }
    for (int idx = tid; idx < 16 * 64; idx += NTH) { const int i = idx >> 6, pp = idx & 63; cL[idx] = (f32x2){p.c_re[(g * 16 + i) * 64 + pp], p.c_im[(g * 16 + i) * 64 + pp]}; }
    __syncthreads();
    for (int idx = tid; idx < 64 * 16; idx += NTH) {
        const int pp = idx >> 4, i = idx & 15;
        const float ar = p.a_re[g * 64 + pp], ai = p.a_im[g * 64 + pp];
        const f32x2 lam = pw[64 + pp];
        const float den = ar * ar + ai * ai, nr = lam.x - 1.0f, ni = lam.y;
        const float zr = (nr * ar + ni * ai) / den, zi = (ni * ar - nr * ai) / den;
        const float br = p.b_re[(g * 64 + pp) * 16 + i], bi = p.b_im[(g * 64 + pp) * 16 + i];
        bbL[idx] = (f32x2){zr * br - zi * bi, zr * bi + zi * br};
    }
    __syncthreads();
    bf16_t* NBg = (bf16_t*)(p.ws + OFF_S5N) + (size_t)g * 128 * 256;
    if (part == 0)
#pragma unroll 1
    for (int ch = tid; ch < 128 * 256 / 8; ch += NTH) {
        const int pq = ch >> 5, t = (ch >> 1) & 15, i0 = (ch & 1) * 8, pp = pq & 63;
        const f32x2 w = pw[(15 - t) * 64 + pp];
        float v[8];
#pragma unroll
        for (int e = 0; e < 8; ++e) { const f32x2 bb = bbL[pp * 16 + i0 + e]; v[e] = pq < 64 ? (w.x * bb.x - w.y * bb.y) : (w.x * bb.y + w.y * bb.x); }
        u32x4 o; o.x = pack2(v[0], v[1]); o.y = pack2(v[2], v[3]); o.z = pack2(v[4], v[5]); o.w = pack2(v[6], v[7]);
        *(u32x4*)(NBg + (size_t)((((pq >> 5) * 16 + t) * 64) + (i0 >> 3) * 32 + (pq & 31)) * 8) = o;
    }
    bf16_t* MBg = (bf16_t*)(p.ws + OFF_S5M) + (size_t)g * 256 * 128;
    if (part == 1)
#pragma unroll 1
    for (int ch = tid; ch < 256 * 128 / 8; ch += NTH) {
        const int ti = ch >> 4, p0 = (ch & 15) * 8, tq = ti >> 4, iq = ti & 15;
        float v[8];
#pragma unroll
        for (int e = 0; e < 8; ++e) {
            const int pq = p0 + e, pp = pq & 63;
            const f32x2 c = cL[iq * 64 + pp], w = pw[(tq + 1) * 64 + pp];
            v[e] = pq < 64 ? (c.x * w.x - c.y * w.y) : -(c.x * w.y + c.y * w.x);
        }
        u32x4 o; o.x = pack2(v[0], v[1]); o.y = pack2(v[2], v[3]); o.z = pack2(v[4], v[5]); o.w = pack2(v[6], v[7]);
        *(u32x4*)(MBg + (size_t)((((ti >> 5) * 8 + (p0 >> 4)) * 64) + ((p0 >> 3) & 1) * 32 + (ti & 31)) * 8) = o;
    }
    bf16_t* KTg = (bf16_t*)(p.ws + OFF_S5K) + (size_t)g * 4096;
    if (part >= 2)
#pragma unroll 1
    for (int idx = (part - 2) * 2048 + tid; idx < (part - 1) * 2048; idx += NTH) {
        const int lag = idx >> 8, iq = (idx >> 4) & 15, i = idx & 15;
        float acc = (lag == 0 && iq == i) ? p.dsk[g * 16 + iq] : 0.f;
#pragma unroll 4
        for (int pp = 0; pp < 64; ++pp) {
            const f32x2 c = cL[iq * 64 + pp], w = pw[lag * 64 + pp], bb = bbL[pp * 16 + i];
            const float mr = c.x * w.x - c.y * w.y, mi_ = c.x * w.y + c.y * w.x;
            acc += mr * bb.x - mi_ * bb.y;
        }
        KTg[idx] = f2bf(acc);
    }
    if (part == 3 && tid < 64) { float* L = (float*)(p.ws + OFF_S5L) + (g * 64 + tid) * 2; const f32x2 w = pw[16 * 64 + tid]; L[0] = w.x; L[1] = w.y; }
    __syncthreads();
}
DI void prep_s5_item(const Params& p, int g) {
    const int tid = my_tid();
    if (tid < SSP) {
        const int pi = g * SSP + tid;
        const float dt = expf(p.log_dt[g]);
        const float ar = p.a_re[pi], ai = p.a_im[pi];
        const float mag = expf(ar * dt);
        const float lr = mag * cosf(ai * dt), li = mag * sinf(ai * dt);
        const float den = ar * ar + ai * ai, nr = lr - 1.0f, ni = li;
        const float zr = (nr * ar + ni * ai) / den, zi = (ni * ar - nr * ai) / den;
        float* lam = (float*)(p.ws + OFF_LAM) + pi * 2;
        lam[0] = lr; lam[1] = li;
        float* bb = (float*)(p.ws + OFF_BB) + (size_t)pi * 32;
        for (int i = 0; i < SSC; ++i) {
            const float br = p.b_re[pi * SSC + i], bi = p.b_im[pi * SSC + i];
            bb[i * 2] = zr * br - zi * bi; bb[i * 2 + 1] = zr * bi + zi * br;
        }
    }
}
DI void prep_transpose_tile(const float* __restrict__ W, bf16_t* __restrict__ Wt, int K, int N, int kt, int nt, char* smem, int dst_row0 = -1, int kswap = 0) {
    float* tile = (float*)smem;
    const int tid = my_tid();
#pragma unroll
    for (int q = 0; q < 2; ++q) {
        const int kk = (tid >> 4) + q * 32, c4 = (tid & 15) * 4;
        const float4 v = *(const float4*)(W + (size_t)(kt * 64 + kk) * N + nt * 64 + c4);
        tile[kk * 65 + c4] = v.x; tile[kk * 65 + c4 + 1] = v.y; tile[kk * 65 + c4 + 2] = v.z; tile[kk * 65 + c4 + 3] = v.w;
    }
    __syncthreads();
    const int n = tid >> 3, kc = tid & 7;
    uint4 o;
    o.x = pack2(tile[(kc * 8 + 0) * 65 + n], tile[(kc * 8 + 1) * 65 + n]);
    o.y = pack2(tile[(kc * 8 + 2) * 65 + n], tile[(kc * 8 + 3) * 65 + n]);
    o.z = pack2(tile[(kc * 8 + 4) * 65 + n], tile[(kc * 8 + 5) * 65 + n]);
    o.w = pack2(tile[(kc * 8 + 6) * 65 + n], tile[(kc * 8 + 7) * 65 + n]);
    *(uint4*)(Wt + (size_t)((dst_row0 < 0 ? nt * 64 : dst_row0) + n) * K + ((kt * 64 + kswap) & (K - 1)) + kc * 8) = o;
    __syncthreads();
}
DI void cvt_bf16_stream(const float* __restrict__ src, bf16_t* __restrict__ dst, size_t n8, int bid, int nb) {
    for (size_t i = (size_t)bid * NTH + my_tid(); i < n8; i += (size_t)nb * NTH) {
        const float4 a = *(const float4*)(src + i * 8), b = *(const float4*)(src + i * 8 + 4);
        uint4 o; o.x = pack2(a.x, a.y); o.y = pack2(a.z, a.w); o.z = pack2(b.x, b.y); o.w = pack2(b.z, b.w);
        *(uint4*)(dst + i * 8) = o;
    }
}
DI void cvt_fp8_rows(const float* __restrict__ src, unsigned char* __restrict__ dst, float* __restrict__ inv, int bid, int nb) {
    const int lane = my_tid() & 63, wid = my_tid() >> 6;
    for (int row = bid * 8 + wid; row < NEXP; row += nb * 8) {
        const float* sp = src + (size_t)row * DM + lane * 16;
        const f32x4 a = *(const f32x4*)sp, b = *(const f32x4*)(sp + 4), c = *(const f32x4*)(sp + 8), d = *(const f32x4*)(sp + 12);
        float m = fmaxf(fmaxf(fmaxf(fabsf(a.x), fabsf(a.y)), fmaxf(fabsf(a.z), fabsf(a.w))), fmaxf(fmaxf(fabsf(b.x), fabsf(b.y)), fmaxf(fabsf(b.z), fabsf(b.w))));
        m = fmaxf(m, fmaxf(fmaxf(fmaxf(fabsf(c.x), fabsf(c.y)), fmaxf(fabsf(c.z), fabsf(c.w))), fmaxf(fmaxf(fabsf(d.x), fabsf(d.y)), fmaxf(fabsf(d.z), fabsf(d.w)))));
#pragma unroll
        for (int s = 1; s < 64; s <<= 1) m = fmaxf(m, __shfl_xor(m, s));
        float sc = 1.f, isc = 1.f;
        if (m > 1e-30f) {
            int k = (int)floorf(log2f(448.0f / m));
            k = k < -60 ? -60 : (k > 60 ? 60 : k);
            sc = ldexpf(1.0f, k); isc = ldexpf(1.0f, -k);
            if (m * sc > 448.0f) { sc *= 0.5f; isc *= 2.0f; }
        }
        u32x4 o;
        int w;
        w = __builtin_amdgcn_cvt_pk_fp8_f32(a.x * sc, a.y * sc, 0, false); w = __builtin_amdgcn_cvt_pk_fp8_f32(a.z * sc, a.w * sc, w, true); o.x = (unsigned)w;
        w = __builtin_amdgcn_cvt_pk_fp8_f32(b.x * sc, b.y * sc, 0, false); w = __builtin_amdgcn_cvt_pk_fp8_f32(b.z * sc, b.w * sc, w, true); o.y = (unsigned)w;
        w = __builtin_amdgcn_cvt_pk_fp8_f32(c.x * sc, c.y * sc, 0, false); w = __builtin_amdgcn_cvt_pk_fp8_f32(c.z * sc, c.w * sc, w, true); o.z = (unsigned)w;
        w = __builtin_amdgcn_cvt_pk_fp8_f32(d.x * sc, d.y * sc, 0, false); w = __builtin_amdgcn_cvt_pk_fp8_f32(d.z * sc, d.w * sc, w, true); o.w = (unsigned)w;
        *(u32x4*)(dst + (size_t)row * DM + lane * 16) = o;
        if (lane == 0) inv[row] = isc;
    }
}
DI void cvt_fp4_rows(const float* __restrict__ src, unsigned char* __restrict__ dst, float* __restrict__ inv, int bid, int nb) {
    const int lane = my_tid() & 63, wid = my_tid() >> 6;
    for (int row = bid * 8 + wid; row < NEXP; row += nb * 8) {
        const float* sp = src + (size_t)row * DM + lane * 16;
        const f32x4 a = *(const f32x4*)sp, b = *(const f32x4*)(sp + 4), c = *(const f32x4*)(sp + 8), d = *(const f32x4*)(sp + 12);
        float m = fmaxf(fmaxf(fmaxf(fabsf(a.x), fabsf(a.y)), fmaxf(fabsf(a.z), fabsf(a.w))), fmaxf(fmaxf(fabsf(b.x), fabsf(b.y)), fmaxf(fabsf(b.z), fabsf(b.w))));
        m = fmaxf(m, fmaxf(fmaxf(fmaxf(fabsf(c.x), fabsf(c.y)), fmaxf(fabsf(c.z), fabsf(c.w))), fmaxf(fmaxf(fabsf(d.x), fabsf(d.y)), fmaxf(fabsf(d.z), fabsf(d.w)))));
#pragma unroll
        for (int s = 1; s < 64; s <<= 1) m = fmaxf(m, __shfl_xor(m, s));
        const float sc = m > 1e-30f ? 6.0f / m : 1.0f, isc = m > 1e-30f ? m * (1.0f / 6.0f) : 1.0f;
        unsigned w0 = 0u, w1 = 0u;
        w0 = __builtin_amdgcn_cvt_scalef32_pk_fp4_f32(w0, a.x * sc, a.y * sc, 1.0f, 0); w0 = __builtin_amdgcn_cvt_scalef32_pk_fp4_f32(w0, a.z * sc, a.w * sc, 1.0f, 1);
        w0 = __builtin_amdgcn_cvt_scalef32_pk_fp4_f32(w0, b.x * sc, b.y * sc, 1.0f, 2); w0 = __builtin_amdgcn_cvt_scalef32_pk_fp4_f32(w0, b.z * sc, b.w * sc, 1.0f, 3);
        w1 = __builtin_amdgcn_cvt_scalef32_pk_fp4_f32(w1, c.x * sc, c.y * sc, 1.0f, 0); w1 = __builtin_amdgcn_cvt_scalef32_pk_fp4_f32(w1, c.z * sc, c.w * sc, 1.0f, 1);
        w1 = __builtin_amdgcn_cvt_scalef32_pk_fp4_f32(w1, d.x * sc, d.y * sc, 1.0f, 2); w1 = __builtin_amdgcn_cvt_scalef32_pk_fp4_f32(w1, d.z * sc, d.w * sc, 1.0f, 3);
        *(uint2*)(dst + (size_t)row * (DM / 2) + lane * 8) = make_uint2(w0, w1);
        if (lane == 0) inv[row] = isc;
    }
}
template <int OFFS>
DI void cvt_i8_rows(const float* __restrict__ src, unsigned char* __restrict__ dst, float* __restrict__ inv, int bid, int nb) {
    const int lane = my_tid() & 63, wid = my_tid() >> 6;
    for (int row = bid * 8 + wid; row < NEXP; row += nb * 8) {
        const float* sp = src + (size_t)row * DM + lane * 16;
        const f32x4 a = *(const f32x4*)sp, b = *(const f32x4*)(sp + 4), c = *(const f32x4*)(sp + 8), d = *(const f32x4*)(sp + 12);
        float m = fmaxf(fmaxf(fmaxf(fabsf(a.x), fabsf(a.y)), fmaxf(fabsf(a.z), fabsf(a.w))), fmaxf(fmaxf(fabsf(b.x), fabsf(b.y)), fmaxf(fabsf(b.z), fabsf(b.w))));
        m = fmaxf(m, fmaxf(fmaxf(fmaxf(fabsf(c.x), fabsf(c.y)), fmaxf(fabsf(c.z), fabsf(c.w))), fmaxf(fmaxf(fabsf(d.x), fabsf(d.y)), fmaxf(fabsf(d.z), fabsf(d.w)))));
#pragma unroll
        for (int s = 1; s < 64; s <<= 1) m = fmaxf(m, __shfl_xor(m, s));
        const float sc = m > 1e-30f ? 127.0f / m : 1.0f, isc = m > 1e-30f ? m * (1.0f / 127.0f) : 1.0f;
        const float v[16] = {a.x, a.y, a.z, a.w, b.x, b.y, b.z, b.w, c.x, c.y, c.z, c.w, d.x, d.y, d.z, d.w};
        unsigned w[4];
#pragma unroll
        for (int q = 0; q < 4; ++q) {
            unsigned pk = 0u;
#pragma unroll
            for (int e = 0; e < 4; ++e) { const int qi = (int)rintf(v[q * 4 + e] * sc) + OFFS; pk |= ((unsigned)qi & 0xffu) << (8 * e); }
            w[q] = pk;
        }
        *(u32x4*)(dst + (size_t)row * DM + lane * 16) = (u32x4){w[0], w[1], w[2], w[3]};
        if (lane == 0) inv[row] = isc;
    }
}
DI void prep_cab_item(const Params& p, int item, char* smem) {
    float* vT = (float*)smem;
    float* red = vT + DM * 16;
    const float* mod = (const float*)(p.ws + OFF_MOD);
    const int tid = my_tid(), ks = tid >> 5, col = tid & 31;
    const float* w = p.w_q + (size_t)(ks * 64) * 2048 + item * 32 + col;
#pragma unroll 1
    for (int which = 0; which < 2; ++which) {
        for (int i = tid; i < NB * DM; i += NTH) {
            const int b = i >> 10, k = i & 1023;
            const float sc = 1.0f + mod[b * 6144 + 4096 + k];
            const float v = which == 0 ? p.ln1w[k] * sc : p.ln1b[k] * sc + mod[b * 6144 + 3072 + k];
            vT[k * 16 + b] = v;
            if (item == 0) ((float*)(p.ws + OFF_AB))[(size_t)which * NB * DM + i] = v;
        }
        __syncthreads();
        float acc[16];
#pragma unroll
        for (int b = 0; b < 16; ++b) acc[b] = 0.f;
#pragma unroll 1
        for (int seg = 0; seg < 4; ++seg) {
            float wreg[16];
#pragma unroll
            for (int k = 0; k < 16; ++k) wreg[k] = w[(size_t)(seg * 16 + k) * 2048];
#pragma unroll
            for (int k = 0; k < 16; ++k) {
                const float wv = wreg[k];
                const f32x4* cb = (const f32x4*)(vT + (ks * 64 + seg * 16 + k) * 16);
                const f32x4 c0 = cb[0], c1 = cb[1], c2 = cb[2], c3 = cb[3];
                acc[0] += c0.x * wv; acc[1] += c0.y * wv; acc[2] += c0.z * wv; acc[3] += c0.w * wv;
                acc[4] += c1.x * wv; acc[5] += c1.y * wv; acc[6] += c1.z * wv; acc[7] += c1.w * wv;
                acc[8] += c2.x * wv; acc[9] += c2.y * wv; acc[10] += c2.z * wv; acc[11] += c2.w * wv;
                acc[12] += c3.x * wv; acc[13] += c3.y * wv; acc[14] += c3.z * wv; acc[15] += c3.w * wv;
            }
        }
#pragma unroll
        for (int b = 0; b < 16; ++b) red[(ks * 32 + col) * 16 + b] = acc[b];
        __syncthreads();
        {
            const int b = tid >> 5;
            float sum = 0.f;
#pragma unroll
            for (int q = 0; q < 16; ++q) sum += red[(q * 32 + col) * 16 + b];
            ((float*)(p.ws + OFF_CAB))[(size_t)which * NB * 2048 + b * 2048 + item * 32 + col] = sum;
        }
        __syncthreads();
    }
}
DI void phase_h(const Params& p, int bid, int nb) {
    const float* mod = (const float*)(p.ws + OFF_MOD);
    bf16_t* H = (bf16_t*)(p.ws + OFF_H);
    const size_t n8 = (size_t)NTOK * DM / 8;
    for (size_t i = (size_t)bid * NTH + my_tid(); i < n8; i += (size_t)nb * NTH) {
        const int row = (int)(i >> 7), c0 = (int)(i & 127) * 8, b = row / SEQ;
        const float* sh = mod + b * 6144 + c0;
        const float* sc = sh + 1024;
        const float4 a = *(const float4*)(p.x + i * 8), bq = *(const float4*)(p.x + i * 8 + 4);
        const float4 s0 = *(const float4*)sc, s1 = *(const float4*)(sc + 4), h0 = *(const float4*)sh, h1 = *(const float4*)(sh + 4);
        uint4 o;
        o.x = pack2(a.x * (1.f + s0.x) + h0.x, a.y * (1.f + s0.y) + h0.y);
        o.y = pack2(a.z * (1.f + s0.z) + h0.z, a.w * (1.f + s0.w) + h0.w);
        o.z = pack2(bq.x * (1.f + s1.x) + h1.x, bq.y * (1.f + s1.y) + h1.y);
        o.w = pack2(bq.z * (1.f + s1.z) + h1.z, bq.w * (1.f + s1.w) + h1.w);
        *(uint4*)(H + i * 8) = o;
    }
}

DI int wq_next(unsigned* ctr, char* smem) {
    volatile unsigned* slot = (volatile unsigned*)(smem + SMEM_BYTES - 8);
    __syncthreads();
    if (__builtin_amdgcn_workitem_id_x() == 0) *slot = __hip_atomic_fetch_add(ctr, 1u, __ATOMIC_RELAXED, __HIP_MEMORY_SCOPE_AGENT);
    __syncthreads();
    return (int)*slot;
}
DI void phase_prep_a(const Params& p, char* smem) {
    unsigned* ctr = (unsigned*)(p.ws + OFF_BAR) + 120;
    constexpr int U_S5 = 192, U_LB = 320, U_TR = 321, U_UT = U_TR + 368, U_VT = U_UT + 128, U_MISC = U_VT + 128, U_END = U_MISC + 8;
    for (int raw = wq_next(ctr, smem); raw < U_END; raw = wq_next(ctr, smem)) {
        const int u = raw < 512 ? ((raw & 1) ? (raw >> 1) : U_UT + (raw >> 1)) : (raw < U_MISC ? 256 + (raw - 512) : raw);
        if (u < U_S5) prep_mod_item(p, u, smem);
        else if (u < U_LB) prep_s5_gemm_item(p, (u - U_S5) >> 2, (u - U_S5) & 3, smem);
        else if (u < U_TR) {
            const int j = my_tid();
            const float a0 = p.hg_lb[j], a1 = p.hg_lb[512 + j], m = fmaxf(a0, a1);
            const float e0 = expf(a0 - m), e1 = expf(a1 - m);
            ((float*)(p.ws + OFF_LB))[j] = e0 / (e0 + e1);
        } else if (u < U_UT) {
            for (int it = (u - U_TR) * 4; it < (u - U_TR) * 4 + 4; ++it) {
                constexpr int T_WIN = 16 * 40, T_GLU = 8 * 8, T_WOUT = 16 * 16;
                constexpr int I_GLU = T_WIN, I_WOUT = I_GLU + T_GLU, I_WQ = I_WOUT + T_WOUT;
                if (it < I_GLU) { const int t = it, n0 = (t % 40) * 64;
                    const int d0 = n0 < 512 ? (n0 >> 7) * 256 + (n0 & 127) : (n0 < 1024 ? ((n0 - 512) >> 7) * 256 + 128 + (n0 & 127) : n0);
                    prep_transpose_tile(p.w_in, (bf16_t*)(p.ws + OFF_WIN), DM, INC, t / 40, t % 40, smem, d0); }
                else if (it < I_WOUT) { const int t = it - I_GLU; prep_transpose_tile(p.glu_w, (bf16_t*)(p.ws + OFF_GLU), 512, 512, t / 8, t % 8, smem); }
                else if (it < I_WQ) { const int t = it - I_WOUT; prep_transpose_tile(p.w_out, (bf16_t*)(p.ws + OFF_WOUT), DM, DM, t / 16, t % 16, smem, -1, 512); }
                else { const int t = it - I_WQ; prep_transpose_tile(p.w_q, (bf16_t*)(p.ws + OFF_WQ), DM, 2048, t / 32, t % 32, smem); }
            }
        } else if (u < U_VT) cvt_i8_rows<0>(p.pu, (unsigned char*)(p.ws + OFF_UT), (float*)(p.ws + OFF_SU), u - U_UT, 128);
        else if (u < U_MISC) cvt_i8_rows<128>(p.pv, (unsigned char*)(p.ws + OFF_VT), (float*)(p.ws + OFF_SV), u - U_VT, 128);
        else {
            const int q = u - U_MISC;
            cvt_bf16_stream(p.subk, (bf16_t*)(p.ws + OFF_SUBK), (size_t)16 * 128 * 128 / 8, q, 8);
            for (size_t i = (size_t)q * NTH + my_tid(); i < (size_t)NTOK * 3 / 4; i += (size_t)8 * NTH) ((f32x4*)(p.ws + OFF_STAT))[i] = (f32x4){0.f, 0.f, 0.f, 0.f};
        }
    }
}
DI void phase_prep_b(const Params& p, char* smem) {
    unsigned* ctr = (unsigned*)(p.ws + OFF_BAR) + 121;
    for (int u = wq_next(ctr, smem); u < 64 + 256; u = wq_next(ctr, smem)) {
        if (u < 64) prep_cab_item(p, u, smem); else phase_h(p, u - 64, 256);
    }
}

DI void phase_proj(const Params& p, int bid, int nb, char* smem) {
    pg8::Gemm g{(const bf16_t*)(p.ws + OFF_H), (const bf16_t*)(p.ws + OFF_WIN), NTOK, INC, DM};
    pg8::StaticOrder S; S.init(NTOK, INC, nb, bid);
    pg8::EpiProj E{(bf16_t*)(p.ws + OFF_PROJ), (bf16_t*)(p.ws + OFF_HQ), (bf16_t*)(p.ws + OFF_HK), (float*)(p.ws + OFF_HG), (const float*)(p.ws + OFF_LB)};
    pg8::gemm_phase<pg8::EpiProj, pg8::StaticOrder, false>((PG8_LAS unsigned char*)smem, g, S, E, nullptr);
}

DI void hgrn_item(const Params& p, int item, char* smem) {
    const int vs = item & 7, hd = (item >> 3) & 3, b = item >> 5;
    const bf16_t* P = (const bf16_t*)(p.ws + OFF_PROJ);
    const float* lb = (const float*)(p.ws + OFF_LB) + hd * HDK;
    float* ORAW = (float*)(p.ws + OFF_ORAW);
    float* sq = (float*)smem;
    float* sf = sq + 32 * 128;
    float* sv = sf + 32 * 128;
    float* sp = sv + 32 * 16;
    const int tid = my_tid(), lane = tid & 63, wid = tid >> 6, kq = tid >> 4, v = tid & 15;
    float S0 = 0.f, S1 = 0.f, S2 = 0.f, S3 = 0.f;
    for (int t0 = 0; t0 < SEQ; t0 += 32) {
        for (int i = tid; i < 32 * 128; i += NTH) {
            const int t = i >> 7, k = i & 127;
            const bf16_t* row = P + (size_t)(b * SEQ + t0 + t) * INC + hd * HDK + k;
            sq[i] = bf2f(row[0]);
            const float l = lb[k];
            sf[i] = l + (1.0f - l) * sigmoidf_(bf2f(row[512]));
        }
        { const int t = tid >> 4; sv[tid] = bf2f(P[(size_t)(b * SEQ + t0 + t) * INC + 1024 + hd * HDK + vs * 16 + v]); }
        __syncthreads();
        for (int t = 0; t < 32; ++t) {
            const float4 f4 = *(const float4*)(sf + t * 128 + kq * 4), q4 = *(const float4*)(sq + t * 128 + kq * 4);
            const float vv = sv[t * 16 + v];
            S0 = f4.x * S0 + (1.0f - f4.x) * vv; S1 = f4.y * S1 + (1.0f - f4.y) * vv;
            S2 = f4.z * S2 + (1.0f - f4.z) * vv; S3 = f4.w * S3 + (1.0f - f4.w) * vv;
            float part = q4.x * S0 + q4.y * S1 + q4.z * S2 + q4.w * S3;
            part += __shfl_xor(part, 16); part += __shfl_xor(part, 32);
            if (lane < 16) sp[(t * 8 + wid) * 16 + v] = part;
        }
        __syncthreads();
        {
            const int t = tid >> 4;
            float o = 0.f;
#pragma unroll
            for (int w = 0; w < 8; ++w) o += sp[(t * 8 + w) * 16 + v];
            ORAW[(size_t)(b * SEQ + t0 + t) * DHG + hd * HDK + vs * 16 + v] = o;
        }
        __syncthreads();
    }
}
DI void s5_item(const Params& p, int item, char* smem) {
    const int oct = item & 3, b = item >> 2;
    const int tid = my_tid(), lane = tid & 63, wid = tid >> 6, g = oct * 8 + wid;
    const bf16_t* P = (const bf16_t*)(p.ws + OFF_PROJ);
    bf16_t* Y = (bf16_t*)(p.ws + OFF_YSSM);
    float* su = (float*)smem + wid * 64 * 16;
    const float* lam = (const float*)(p.ws + OFF_LAM) + (g * SSP + lane) * 2;
    const float lr = lam[0], li = lam[1];
    const float* bb = (const float*)(p.ws + OFF_BB) + (size_t)(g * SSP + lane) * 32;
    float bbr[16], bbi[16], cr[16], ci[16];
#pragma unroll
    for (int i = 0; i < 16; ++i) { bbr[i] = bb[2 * i]; bbi[i] = bb[2 * i + 1]; cr[i] = p.c_re[(g * SSC + i) * SSP + lane]; ci[i] = p.c_im[(g * SSC + i) * SSP + lane]; }
    const int ch = (lane >> 2) & 15;
    const float dch = p.dsk[g * SSC + ch];
    float xr = 0.f, xi = 0.f;
    for (int t0 = 0; t0 < SEQ; t0 += 64) {
        {
            const uint4* src = (const uint4*)(P + (size_t)(b * SEQ + t0 + lane) * INC + 2048 + g * SSC);
            const uint4 a = src[0], c = src[1];
            float* d = su + lane * 16;
            d[0] = bflo(a.x); d[1] = bfhi(a.x); d[2] = bflo(a.y); d[3] = bfhi(a.y); d[4] = bflo(a.z); d[5] = bfhi(a.z); d[6] = bflo(a.w); d[7] = bfhi(a.w);
            d[8] = bflo(c.x); d[9] = bfhi(c.x); d[10] = bflo(c.y); d[11] = bfhi(c.y); d[12] = bflo(c.z); d[13] = bfhi(c.z); d[14] = bflo(c.w); d[15] = bfhi(c.w);
        }
        __syncthreads();
        for (int t = 0; t < 64; ++t) {
            float u[16];
            const float4* us = (const float4*)(su + t * 16);
            const float4 u0 = us[0], u1 = us[1], u2 = us[2], u3 = us[3];
            u[0] = u0.x; u[1] = u0.y; u[2] = u0.z; u[3] = u0.w; u[4] = u1.x; u[5] = u1.y; u[6] = u1.z; u[7] = u1.w;
            u[8] = u2.x; u[9] = u2.y; u[10] = u2.z; u[11] = u2.w; u[12] = u3.x; u[13] = u3.y; u[14] = u3.z; u[15] = u3.w;
            float bur = 0.f, bui = 0.f;
#pragma unroll
            for (int i = 0; i < 16; ++i) { bur += bbr[i] * u[i]; bui += bbi[i] * u[i]; }
            const float nxr = lr * xr - li * xi + bur, nxi = lr * xi + li * xr + bui;
            xr = nxr; xi = nxi;
            float y[16];
#pragma unroll
            for (int i = 0; i < 16; ++i) y[i] = cr[i] * xr - ci[i] * xi;
            const bool b5 = lane & 32, b4 = lane & 16, b3 = lane & 8, b2 = lane & 4;
            float y8[8], y4[4], y2[2];
#pragma unroll
            for (int j = 0; j < 8; ++j) { const float keep = b5 ? y[8 + j] : y[j], send = b5 ? y[j] : y[8 + j]; y8[j] = keep + __shfl_xor(send, 32); }
#pragma unroll
            for (int j = 0; j < 4; ++j) { const float keep = b4 ? y8[4 + j] : y8[j], send = b4 ? y8[j] : y8[4 + j]; y4[j] = keep + __shfl_xor(send, 16); }
#pragma unroll
            for (int j = 0; j < 2; ++j) { const float keep = b3 ? y4[2 + j] : y4[j], send = b3 ? y4[j] : y4[2 + j]; y2[j] = keep + __shfl_xor(send, 8); }
            float y1;
            { const float keep = b2 ? y2[1] : y2[0], send = b2 ? y2[0] : y2[1]; y1 = keep + __shfl_xor(send, 4); }
            y1 += __shfl_xor(y1, 1); y1 += __shfl_xor(y1, 2);
            if ((lane & 3) == 0) {
                const float uu = su[t * 16 + ch];
                Y[(size_t)(b * SEQ + t0 + t) * DSS + g * SSC + ch] = f2bf(geluf_(y1 + dch * uu));
            }
        }
        __syncthreads();
    }
}
DI int crow(int i, int h) { return (i & 3) + 8 * (i >> 2) + 4 * h; }
DI void phase_hgprep(const Params& p, int bid, int nb) {
    const bf16_t* P = (const bf16_t*)(p.ws + OFF_PROJ);
    const float* lbp = (const float*)(p.ws + OFF_LB);
    const int tid = my_tid(), lane = tid & 63, wid = tid >> 6, tq = lane >> 4, cg = lane & 15;
#pragma unroll 1
    for (int it = bid * 8 + wid; it < 8192; it += nb * 8) {
        const int tile = it >> 1, c = tile & 63, hd = (tile >> 6) & 3, b = tile >> 8, k0 = (it & 1) * 64 + cg * 4;
        const bf16_t* base = P + (size_t)(b * SEQ + c * 32 + tq * 8) * INC + hd * HDK + k0;
        uint2 qw[8], fw[8];
#pragma unroll
        for (int tt = 0; tt < 8; ++tt) { qw[tt] = *(const uint2*)(base + (size_t)tt * INC); fw[tt] = *(const uint2*)(base + (size_t)tt * INC + 512); }
        const f32x4 l4 = *(const f32x4*)(lbp + hd * HDK + k0);
        const float lb4[4] = {l4.x, l4.y, l4.z, l4.w};
        float bl[8][4], kk[8][4], run[4];
#pragma unroll
        for (int e = 0; e < 4; ++e) run[e] = 0.f;
#pragma unroll
        for (int tt = 0; tt < 8; ++tt) {
            const float fl[4] = {bflo(fw[tt].x), bfhi(fw[tt].x), bflo(fw[tt].y), bfhi(fw[tt].y)};
#pragma unroll
            for (int e = 0; e < 4; ++e) {
                const float f = lb4[e] + (1.0f - lb4[e]) * sigmoidf_(fl[e]);
                run[e] += __logf(f); bl[tt][e] = run[e]; kk[tt][e] = 1.0f - f;
            }
        }
        float off[4], tot[4];
#pragma unroll
        for (int e = 0; e < 4; ++e) {
            const float t0 = __shfl(run[e], cg), t1 = __shfl(run[e], cg + 16), t2 = __shfl(run[e], cg + 32), t3 = __shfl(run[e], cg + 48);
            off[e] = (tq > 0 ? t0 : 0.f) + (tq > 1 ? t1 : 0.f) + (tq > 2 ? t2 : 0.f);
            tot[e] = (t0 + t1) + (t2 + t3);
        }
        bf16_t* HQ = (bf16_t*)(p.ws + OFF_HQ) + (size_t)tile * 4096 + (tq * 8) * 128 + k0;
        bf16_t* HK = (bf16_t*)(p.ws + OFF_HK) + (size_t)tile * 4096 + (tq * 8) * 128 + k0;
#pragma unroll
        for (int tt = 0; tt < 8; ++tt) {
            const float qv[4] = {bflo(qw[tt].x), bfhi(qw[tt].x), bflo(qw[tt].y), bfhi(qw[tt].y)};
            float qo[4], ko[4];
#pragma unroll
            for (int e = 0; e < 4; ++e) { const float bb = off[e] + bl[tt][e]; qo[e] = qv[e] * __expf(bb); ko[e] = kk[tt][e] * __expf(fminf(-bb, 80.0f)); }
            *(uint2*)(HQ + tt * 128) = make_uint2(pack2(qo[0], qo[1]), pack2(qo[2], qo[3]));
            *(uint2*)(HK + tt * 128) = make_uint2(pack2(ko[0], ko[1]), pack2(ko[2], ko[3]));
        }
        if (tq == 0) *(f32x4*)((float*)(p.ws + OFF_HG) + (size_t)tile * 128 + k0) = (f32x4){__expf(tot[0]), __expf(tot[1]), __expf(tot[2]), __expf(tot[3])};
    }
}
typedef short s16x4 __attribute__((ext_vector_type(4)));
DI bf16x8 cat8(const s16x4 lo, const s16x4 hi) { return (bf16x8){lo.x, lo.y, lo.z, lo.w, hi.x, hi.y, hi.z, hi.w}; }
DI s16x4 lds_tr(const char* a) { return __builtin_amdgcn_ds_read_tr16_b64_v4i16((__attribute__((address_space(3))) s16x4*)a); }
DI void hgrn_mfma_item(const Params& p, int item, char* smem) {
    constexpr int QP_OFF = 0, KP_OFF = 8704, V_OFF = 17408, G_OFF = 26112, BUF = 26624, OB_OFF = 3 * BUF, OB_STRIDE = 132, OB_BYTES = 32 * OB_STRIDE * 4;
    const int tid = my_tid(), lane = tid & 63, wid = tid >> 6, r = lane & 31, h = lane >> 5;
    const int b = item >> 2, hd = item & 3;
    const size_t tile0 = (size_t)item * 64;
    const bf16_t* HQ = (const bf16_t*)(p.ws + OFF_HQ) + tile0 * 4096;
    const bf16_t* HK = (const bf16_t*)(p.ws + OFF_HK) + tile0 * 4096;
    const bf16_t* PV = (const bf16_t*)(p.ws + OFF_PROJ) + (size_t)b * SEQ * INC + 1024 + hd * HDK;
    const float* HG = (const float*)(p.ws + OFF_HG) + tile0 * 128;
    bf16_t* A2out = (bf16_t*)(p.ws + OFF_A2) + (size_t)b * SEQ * DM + 512 + hd * HDK;
    const bf16_t* PG = (const bf16_t*)(p.ws + OFF_PROJ) + (size_t)b * SEQ * INC + 1536 + hd * HDK;
    const bool helper = wid >= 4;
    const int ht = tid - 256;
    const int i0 = ht, i1 = ht + 256;
    const int lo0 = (i0 >> 4) * 272 + (i0 & 15) * 16, lo1 = (i1 >> 4) * 272 + (i1 & 15) * 16;
    u32x4 A0, A1, A2, A3, A4, A5, A6, B0, B1, B2, B3, B4, B5, B6;
    A0 = A1 = A2 = A3 = A4 = A5 = A6 = B0 = B1 = B2 = B3 = B4 = B5 = B6 = (u32x4){0, 0, 0, 0};
    f32x16 S[4];
#pragma unroll
    for (int kb = 0; kb < 4; ++kb)
#pragma unroll
        for (int i = 0; i < 16; ++i) S[kb][i] = 0.f;
#define HG_LOAD(X, c_) { const size_t o_ = (size_t)(c_) * 4096; \
        X##0 = *(const u32x4*)(HQ + o_ + i0 * 8); X##1 = *(const u32x4*)(HQ + o_ + i1 * 8); \
        X##2 = *(const u32x4*)(HK + o_ + i0 * 8); X##3 = *(const u32x4*)(HK + o_ + i1 * 8); \
        X##4 = *(const u32x4*)(PV + (size_t)((c_) * 32 + (i0 >> 4)) * INC + (i0 & 15) * 8); X##5 = *(const u32x4*)(PV + (size_t)((c_) * 32 + (i1 >> 4)) * INC + (i1 & 15) * 8); \
        if (ht < 32) X##6 = *(const u32x4*)(HG + (size_t)(c_) * 128 + ht * 4); }
#define HG_STORE(X, buf_) { char* B_ = smem + (buf_) * BUF; \
        *(u32x4*)(B_ + QP_OFF + lo0) = X##0; *(u32x4*)(B_ + QP_OFF + lo1) = X##1; \
        *(u32x4*)(B_ + KP_OFF + lo0) = X##2; *(u32x4*)(B_ + KP_OFF + lo1) = X##3; \
        *(u32x4*)(B_ + V_OFF + lo0) = X##4; *(u32x4*)(B_ + V_OFF + lo1) = X##5; \
        if (ht < 32) *(u32x4*)(B_ + G_OFF + ht * 16) = X##6; }
    const int tq = (lane >> 2) & 3, tp = lane & 3, tg = lane >> 4;
    const int tr_nat = (8 * (tg >> 1) + tq) * 272 + (16 * (tg & 1) + 4 * tp) * 2;
    const int tr_krw = (4 * (tg >> 1) + tq) * 272 + (16 * (tg & 1) + 4 * tp) * 2;
    if (helper) { HG_LOAD(A, 0); HG_STORE(A, 0); HG_LOAD(A, 1); HG_STORE(A, 1); HG_LOAD(A, 2); HG_LOAD(B, 3); }
    __syncthreads();
#define HG_COMPUTE(c_) { \
        const char* B = smem + ((c_) % 3) * BUF; const int w = wid; \
        f32x16 pt; _Pragma("unroll") for (int i = 0; i < 16; ++i) pt[i] = 0.f; \
        _Pragma("unroll") for (int ks = 0; ks < 8; ++ks) { \
            const bf16x8 a = *(const bf16x8*)(B + KP_OFF + r * 272 + ks * 32 + h * 16); \
            const bf16x8 bq = *(const bf16x8*)(B + QP_OFF + r * 272 + ks * 32 + h * 16); \
            pt = __builtin_amdgcn_mfma_f32_32x32x16_bf16(a, bq, pt, 0, 0, 0); } \
        _Pragma("unroll") for (int i = 0; i < 16; ++i) if (crow(i, h) > r) pt[i] = 0.f; \
        f32x16 o; _Pragma("unroll") for (int i = 0; i < 16; ++i) o[i] = 0.f; \
        _Pragma("unroll") for (int sp = 0; sp < 2; ++sp) { \
            const char* vb = B + V_OFF + (16 * sp) * 272 + (32 * w) * 2 + tr_krw; \
            const bf16x8 bv = cat8(lds_tr(vb), lds_tr(vb + 8 * 272)); \
            o = __builtin_amdgcn_mfma_f32_32x32x16_bf16(pack8(pt, 8 * sp), bv, o, 0, 0, 0); } \
        _Pragma("unroll") for (int kb = 0; kb < 4; ++kb) _Pragma("unroll") for (int sp = 0; sp < 2; ++sp) { \
            const char* qb = B + QP_OFF + r * 272 + kb * 64 + sp * 32 + h * 8; \
            const bf16x8 aq = cat8(*(const s16x4*)qb, *(const s16x4*)(qb + 16)); \
            o = __builtin_amdgcn_mfma_f32_32x32x16_bf16(aq, pack8(S[kb], 8 * sp), o, 0, 0, 0); } \
        { float* ob_ = (float*)(smem + OB_OFF + ((c_) & 1) * OB_BYTES); _Pragma("unroll") for (int i = 0; i < 16; ++i) ob_[crow(i, h) * OB_STRIDE + 32 * w + r] = o[i]; } \
        bf16x8 bvn[2]; \
        _Pragma("unroll") for (int ks = 0; ks < 2; ++ks) { const char* vb = B + V_OFF + (16 * ks) * 272 + (32 * w) * 2 + tr_nat; bvn[ks] = cat8(lds_tr(vb), lds_tr(vb + 4 * 272)); } \
        _Pragma("unroll") for (int kb = 0; kb < 4; ++kb) { \
            _Pragma("unroll") for (int ks = 0; ks < 2; ++ks) { \
                const char* kp = B + KP_OFF + (16 * ks) * 272 + (32 * kb) * 2 + tr_nat; \
                const bf16x8 a = cat8(lds_tr(kp), lds_tr(kp + 4 * 272)); \
                S[kb] = __builtin_amdgcn_mfma_f32_32x32x16_bf16(a, bvn[ks], S[kb], 0, 0, 0); } \
            _Pragma("unroll") for (int j = 0; j < 4; ++j) { \
                const f32x4 g4 = *(const f32x4*)(B + G_OFF + (kb * 32 + 8 * j + 4 * h) * 4); \
                S[kb][4 * j] *= g4.x; S[kb][4 * j + 1] *= g4.y; S[kb][4 * j + 2] *= g4.z; S[kb][4 * j + 3] *= g4.w; } } }
    f32x4 nw0, nw1, nw2, nw3;
    nw0 = nw1 = nw2 = nw3 = (f32x4){0.f, 0.f, 0.f, 0.f};
    if (helper) { const float* nwp = p.hg_nw + hd * HDK + (ht & 7) * 16; nw0 = *(const f32x4*)nwp; nw1 = *(const f32x4*)(nwp + 4); nw2 = *(const f32x4*)(nwp + 8); nw3 = *(const f32x4*)(nwp + 12); }
#define HG_NORM(cc_) { const int t_ = ht >> 3, sg_ = ht & 7; \
        const float* ob_ = (const float*)(smem + OB_OFF + ((cc_) & 1) * OB_BYTES) + t_ * OB_STRIDE + sg_ * 16; \
        const f32x4 o0 = *(const f32x4*)ob_, o1 = *(const f32x4*)(ob_ + 4), o2 = *(const f32x4*)(ob_ + 8), o3 = *(const f32x4*)(ob_ + 12); \
        const u32x4 g0 = *(const u32x4*)(PG + (size_t)((cc_) * 32 + t_) * INC + sg_ * 16), g1 = *(const u32x4*)(PG + (size_t)((cc_) * 32 + t_) * INC + sg_ * 16 + 8); \
        float ss = (o0.x * o0.x + o0.y * o0.y + o0.z * o0.z + o0.w * o0.w) + (o1.x * o1.x + o1.y * o1.y + o1.z * o1.z + o1.w * o1.w) + (o2.x * o2.x + o2.y * o2.y + o2.z * o2.z + o2.w * o2.w) + (o3.x * o3.x + o3.y * o3.y + o3.z * o3.z + o3.w * o3.w); \
        ss += __shfl_xor(ss, 1); ss += __shfl_xor(ss, 2); ss += __shfl_xor(ss, 4); \
        const float rs_ = rsqrtf(ss * (1.0f / 128.0f) + RMS_EPS); \
        const f32x4 v0 = o0 * rs_ * nw0, v1 = o1 * rs_ * nw1, v2 = o2 * rs_ * nw2, v3 = o3 * rs_ * nw3; \
        u32x4 w0, w1; \
        w0.x = pack2(v0.x * bflo(g0.x), v0.y * bfhi(g0.x)); w0.y = pack2(v0.z * bflo(g0.y), v0.w * bfhi(g0.y)); w0.z = pack2(v1.x * bflo(g0.z), v1.y * bfhi(g0.z)); w0.w = pack2(v1.z * bflo(g0.w), v1.w * bfhi(g0.w)); \
        w1.x = pack2(v2.x * bflo(g1.x), v2.y * bfhi(g1.x)); w1.y = pack2(v2.z * bflo(g1.y), v2.w * bfhi(g1.y)); w1.z = pack2(v3.x * bflo(g1.z), v3.y * bfhi(g1.z)); w1.w = pack2(v3.z * bflo(g1.w), v3.w * bfhi(g1.w)); \
        bf16_t* dst_ = A2out + (size_t)((cc_) * 32 + t_) * DM + sg_ * 16; \
        *(u32x4*)dst_ = w0; *(u32x4*)(dst_ + 8) = w1; }
    for (int c = 0; c < 64; c += 2) {
        if (helper) { if (c + 2 < 64) HG_STORE(A, (c + 2) % 3); if (c + 4 < 64) HG_LOAD(A, c + 4); if (c > 0) HG_NORM(c - 1); } else HG_COMPUTE(c);
        __syncthreads();
        if (helper) { if (c + 3 < 64) HG_STORE(B, (c + 3) % 3); if (c + 5 < 64) HG_LOAD(B, c + 5); HG_NORM(c); } else HG_COMPUTE(c + 1);
        __syncthreads();
    }
    if (helper) HG_NORM(63);
    __syncthreads();
#undef HG_LOAD
#undef HG_STORE
#undef HG_COMPUTE
#undef HG_NORM
}
template <int NJ>
DI void s5_gemm2_tile(const bf16x8 (&af)[16], const bf16_t* KTl, const bf16_t* Xin, const bf16_t* MBg, bf16_t* Yout, bf16_t* stg, const int mi, const int r, const int h) {
    f32x16 y;
#pragma unroll
    for (int i = 0; i < 16; ++i) y[i] = 0.f;
    const int tsel = r >> 4, iq = r & 15;
    bf16x8 bm[8];
#pragma unroll
    for (int ks = 0; ks < 8; ++ks) bm[ks] = *(const bf16x8*)(MBg + (size_t)((NJ * 8 + ks) * 64 + h * 32 + r) * 8);
#pragma unroll
    for (int ks = 0; ks <= 2 * NJ; ++ks) {
        const bf16x8 bk = *(const bf16x8*)(KTl + ((2 * NJ + tsel - ks) * 16 + iq) * 16 + 8 * h);
        y = __builtin_amdgcn_mfma_f32_32x32x16_bf16(af[ks], bk, y, 0, 0, 0);
    }
    {
        bf16x8 bk = *(const bf16x8*)(KTl + iq * 16 + 8 * h);
        if (tsel == 0) bk = (bf16x8){0, 0, 0, 0, 0, 0, 0, 0};
        y = __builtin_amdgcn_mfma_f32_32x32x16_bf16(af[2 * NJ + 1], bk, y, 0, 0, 0);
    }
#pragma unroll
    for (int ks = 0; ks < 8; ++ks) {
        const bf16x8 a = *(const bf16x8*)(Xin + (mi * 32 + r) * 136 + ks * 16 + 8 * h);
        y = __builtin_amdgcn_mfma_f32_32x32x16_bf16(a, bm[ks], y, 0, 0, 0);
    }
#pragma unroll
    for (int i = 0; i < 16; ++i) stg[((crow(i, h) * 2 + tsel) * 16) + iq] = f2bf(gelu_as(y[i]));
    {
        const int lane = h * 32 + r, cl = lane >> 1, ts = lane & 1;
        const u32x4 lo = *(const u32x4*)(stg + lane * 16), hi = *(const u32x4*)(stg + lane * 16 + 8);
        bf16_t* dst = Yout + (size_t)((mi * 32 + cl) * 16 + 2 * NJ + ts) * DSS;
        *(u32x4*)dst = lo; *(u32x4*)(dst + 8) = hi;
    }
}
DI void s5_gemm_item(const Params& p, int b, int g, char* smem) {
    float* E = (float*)smem;
    bf16_t* Xin = (bf16_t*)(smem + 128 * 132 * 4);
    bf16_t* KTl = Xin + 128 * 136;
    const int tid = my_tid(), lane = tid & 63, wid = tid >> 6, r = lane & 31, h = lane >> 5;
    const int mi = wid >> 1, wh = wid & 1;
    const bf16_t* P = (const bf16_t*)(p.ws + OFF_PROJ);
    *(u32x4*)(KTl + tid * 8) = *(const u32x4*)((const bf16_t*)(p.ws + OFF_S5K) + (size_t)g * 4096 + tid * 8);
    bf16x8 af[16];
    {
        const bf16_t* ub = P + (size_t)(b * SEQ + (mi * 32 + r) * 16) * INC + 2048 + g * 16 + 8 * h;
#pragma unroll
        for (int ks = 0; ks < 16; ++ks) af[ks] = *(const bf16x8*)(ub + (size_t)ks * INC);
    }
#ifndef S5_REP_G1
#define S5_REP_G1 1
#define S5_REP_SC 1
#define S5_REP_G2 1
#endif
    for (int rp1 = 0; rp1 < S5_REP_G1; ++rp1)
    {
        f32x16 e0, e1;
#pragma unroll
        for (int i = 0; i < 16; ++i) { e0[i] = 0.f; e1[i] = 0.f; }
        const bf16_t* nb0 = (const bf16_t*)(p.ws + OFF_S5N) + (size_t)g * 128 * 256 + (size_t)(wh * 2) * 16 * 512 + lane * 8;
#pragma unroll
        for (int ks = 0; ks < 16; ++ks) {
            const bf16x8 b0 = *(const bf16x8*)(nb0 + ks * 512), b1 = *(const bf16x8*)(nb0 + 16 * 512 + ks * 512);
            e0 = __builtin_amdgcn_mfma_f32_32x32x16_bf16(af[ks], b0, e0, 0, 0, 0);
            e1 = __builtin_amdgcn_mfma_f32_32x32x16_bf16(af[ks], b1, e1, 0, 0, 0);
        }
#pragma unroll
        for (int i = 0; i < 16; ++i) { float* er = E + (mi * 32 + crow(i, h)) * 132 + wh * 64 + r; er[0] = e0[i]; er[32] = e1[i]; }
    }
    __syncthreads();
    for (int rp2 = 0; rp2 < S5_REP_SC; ++rp2)
    if (wid == 0) {
        const float* L = (const float*)(p.ws + OFF_S5L) + (g * 64 + lane) * 2;
        const float lr = L[0], li = L[1];
        float xr = 0.f, xi = 0.f;
#pragma unroll 8
        for (int c = 0; c < 128; ++c) {
            const float er = E[c * 132 + lane], ei = E[c * 132 + 64 + lane];
            Xin[c * 136 + lane] = f2bf(xr); Xin[c * 136 + 64 + lane] = f2bf(xi);
            const float nr = lr * xr - li * xi + er, ni = lr * xi + li * xr + ei;
            xr = nr; xi = ni;
        }
    }
    __syncthreads();
    const bf16_t* MBg = (const bf16_t*)(p.ws + OFF_S5M) + (size_t)g * 256 * 128;
    bf16_t* Yout = (bf16_t*)(p.ws + OFF_YSSM) + (size_t)b * SEQ * DSS + g * 16;
    bf16_t* stg = (bf16_t*)smem + wid * 1024;
    for (int rp3 = 0; rp3 < S5_REP_G2; ++rp3)
    if (wh) {
        s5_gemm2_tile<1>(af, KTl, Xin, MBg, Yout, stg, mi, r, h); s5_gemm2_tile<6>(af, KTl, Xin, MBg, Yout, stg, mi, r, h);
        s5_gemm2_tile<3>(af, KTl, Xin, MBg, Yout, stg, mi, r, h); s5_gemm2_tile<4>(af, KTl, Xin, MBg, Yout, stg, mi, r, h);
    } else {
        s5_gemm2_tile<0>(af, KTl, Xin, MBg, Yout, stg, mi, r, h); s5_gemm2_tile<7>(af, KTl, Xin, MBg, Yout, stg, mi, r, h);
        s5_gemm2_tile<2>(af, KTl, Xin, MBg, Yout, stg, mi, r, h); s5_gemm2_tile<5>(af, KTl, Xin, MBg, Yout, stg, mi, r, h);
    }
    __syncthreads();
}
DI void phase_mix(const Params& p, int bid, int nb, char* smem) {
    if (nb == 256) {
#ifndef PROBE_HGX
#define PROBE_HGX 1
#endif
        if (bid < 64) { for (int rep = 0; rep < PROBE_HGX; ++rep) hgrn_mfma_item(p, bid, smem); return; }
        const int j = bid - 64, x = j & 7, lb = j >> 3;
#ifndef PROBE_S5X
#define PROBE_S5X 1
#endif
        for (int rep = 0; rep < PROBE_S5X; ++rep)
        for (int q = lb; q < 64; q += 24) s5_gemm_item(p, q & 15, x * 4 + (q >> 4), smem);
    } else {
        for (int it = bid; it < 64; it += nb) hgrn_mfma_item(p, it, smem);
        for (int q = bid; q < 512; q += nb) s5_gemm_item(p, q & 15, q >> 4, smem);
    }
}

DI void phase_glu(const Params& p, int bid, int nb, char* smem) {
    pg8::Gemm g{(const bf16_t*)(p.ws + OFF_YSSM), (const bf16_t*)(p.ws + OFF_GLU), NTOK, 512, 512};
    pg8::StaticOrder S; S.init(NTOK, 512, nb, bid);
    pg8::EpiGluA2 E{(bf16_t*)(p.ws + OFF_A2), (const bf16_t*)(p.ws + OFF_YSSM), p.glu_b, p.ssm_nw, (float*)(p.ws + OFF_STAT) + 2 * NTOK};
    pg8::gemm_phase<pg8::EpiGluA2, pg8::StaticOrder, false>((PG8_LAS unsigned char*)smem, g, S, E, nullptr);
}
DI void phase_a2(const Params& p, int bid, int nb) {
    const float* Y2 = (const float*)(p.ws + OFF_H);
    const bf16_t* P = (const bf16_t*)(p.ws + OFF_PROJ);
    bf16_t* A2 = (bf16_t*)(p.ws + OFF_A2);
    const int lane = my_tid() & 63, wid = my_tid() >> 6;
    for (int tok = bid * 8 + wid; tok < NTOK; tok += nb * 8) {
        const int c0 = lane * 8;
        {
            const float4 a = *(const float4*)(Y2 + (size_t)tok * DSS + c0), b = *(const float4*)(Y2 + (size_t)tok * DSS + c0 + 4);
            float ss = a.x * a.x + a.y * a.y + a.z * a.z + a.w * a.w + b.x * b.x + b.y * b.y + b.z * b.z + b.w * b.w;
#pragma unroll
            for (int m = 1; m < 64; m <<= 1) ss += __shfl_xor(ss, m);
            const float rs = rsqrtf(ss * (1.0f / 512.0f) + RMS_EPS);
            const float4 w0 = *(const float4*)(p.ssm_nw + c0), w1 = *(const float4*)(p.ssm_nw + c0 + 4);
            uint4 o;
            o.x = pack2(a.x * rs * w0.x, a.y * rs * w0.y); o.y = pack2(a.z * rs * w0.z, a.w * rs * w0.w);
            o.z = pack2(b.x * rs * w1.x, b.y * rs * w1.y); o.w = pack2(b.z * rs * w1.z, b.w * rs * w1.w);
            *(uint4*)(A2 + (size_t)tok * DM + 512 + c0) = o;
        }
    }
}

DI void phase_outproj(const Params& p, int bid, int nb, char* smem) {
    pg8::Gemm g{(const bf16_t*)(p.ws + OFF_A2), (const bf16_t*)(p.ws + OFF_WOUT), NTOK, DM, DM};
    pg8::StaticOrder S; S.init(NTOK, DM, nb, bid);
    pg8::EpiResid E{(bf16_t*)(p.ws + OFF_R1), p.x, (const float*)(p.ws + OFF_MOD) + 2048, DEEP_ALPHA, (bf16_t*)(p.ws + OFF_H), (const float*)(p.ws + OFF_AB), (float*)(p.ws + OFF_STAT), (const float*)(p.ws + OFF_STAT) + 2 * NTOK, RMS_EPS};
    pg8::gemm_phase<pg8::EpiResid, pg8::StaticOrder, false>((PG8_LAS unsigned char*)smem, g, S, E, nullptr);
}
DI void phase_ln1(const Params& p, int bid, int nb) {
    const float* mod = (const float*)(p.ws + OFF_MOD);
    bf16_t* H2 = (bf16_t*)(p.ws + OFF_H);
    const int lane = my_tid() & 63, wid = my_tid() >> 6;
    for (int tok = bid * 8 + wid; tok < NTOK; tok += nb * 8) {
        const int b = tok / SEQ;
        float* row = p.out + (size_t)tok * DM;
        float4 v[4];
        float s = 0.f;
#pragma unroll
        for (int j = 0; j < 4; ++j) { v[j] = *(const float4*)(row + j * 256 + lane * 4); s += v[j].x + v[j].y + v[j].z + v[j].w; }
#pragma unroll
        for (int m = 1; m < 64; m <<= 1) s += __shfl_xor(s, m);
        const float mu = s * (1.0f / 1024.0f);
        float q = 0.f;
#pragma unroll
        for (int j = 0; j < 4; ++j) { const float a = v[j].x - mu, bb = v[j].y - mu, cc = v[j].z - mu, d = v[j].w - mu; q += a * a + bb * bb + cc * cc + d * d; }
#pragma unroll
        for (int m = 1; m < 64; m <<= 1) q += __shfl_xor(q, m);
        const float rstd = rsqrtf(q * (1.0f / 1024.0f) + LN_EPS);
        const float* sh2 = mod + b * 6144 + 3072;
        const float* sc2 = mod + b * 6144 + 4096;
#pragma unroll
        for (int j = 0; j < 4; ++j) {
            const int c = j * 256 + lane * 4;
            const float4 w = *(const float4*)(p.ln1w + c), bi = *(const float4*)(p.ln1b + c), sc = *(const float4*)(sc2 + c), sh = *(const float4*)(sh2 + c);
            float4 o;
            o.x = (v[j].x - mu) * rstd * w.x + bi.x; o.y = (v[j].y - mu) * rstd * w.y + bi.y; o.z = (v[j].z - mu) * rstd * w.z + bi.z; o.w = (v[j].w - mu) * rstd * w.w + bi.w;
            *(float4*)(row + c) = o;
            uint2 hh; hh.x = pack2(o.x * (1.f + sc.x) + sh.x, o.y * (1.f + sc.y) + sh.y); hh.y = pack2(o.z * (1.f + sc.z) + sh.z, o.w * (1.f + sc.w) + sh.w);
            *(uint2*)(H2 + (size_t)tok * DM + c) = hh;
        }
    }
}

DI void phase_q(const Params& p, int bid, int nb, char* smem) {
    pg8::Gemm g{(const bf16_t*)(p.ws + OFF_H), (const bf16_t*)(p.ws + OFF_WQ), NTOK, 2048, DM};
    pg8::StaticOrder S; S.init(NTOK, 2048, nb, bid);
    pg8::EpiQLN E{(bf16_t*)(p.ws + OFF_PROJ), (const float*)(p.ws + OFF_STAT), (const float*)(p.ws + OFF_CAB), (const float*)(p.ws + OFF_CAB) + NB * 2048, LN_EPS};
    pg8::gemm_phase<pg8::EpiQLN, pg8::StaticOrder, false>((PG8_LAS unsigned char*)smem, g, S, E, nullptr);
}
DI void phase_topk(const Params& p, int bid, int nb, char* smem) {
    const bf16_t* Q = (const bf16_t*)(p.ws + OFF_PROJ);
    const bf16_t* SK = (const bf16_t*)(p.ws + OFF_SUBK);
    unsigned* TOPL = (unsigned*)(p.ws + OFF_TOPL);
    float* sc = (float*)(smem + 36864);
    constexpr int NTM = NTOK / 128;
    for (int t = bid; t < NTM * 16; t += nb) {
        const int mt = t >> 4, hp = t & 15;
        gemm_block<2, 1, 2, 4>(Q + (size_t)mt * 128 * 2048 + hp * 128, 2048, SK + (size_t)hp * 128 * 128, 128, 128, smem,
                               [&](int r, int c, float v) { sc[r * 129 + c] = v; });
        __syncthreads();
        if (my_tid() < 128) {
            const int r = my_tid();
            float tk[16];
#pragma unroll
            for (int j = 0; j < 16; ++j) tk[j] = -3.0e38f;
            for (int n = 0; n < 128; ++n) {
                float xv = __uint_as_float((__float_as_uint(sc[r * 129 + n]) & ~0x7fu) | (unsigned)n);
#pragma unroll
                for (int j = 0; j < 16; ++j) { const float hi = fmaxf(tk[j], xv), lo = fminf(tk[j], xv); tk[j] = hi; xv = lo; }
            }
            uint4* dst = (uint4*)(TOPL + ((size_t)(mt * 128 + r) * 16 + hp) * 16);
            dst[0] = make_uint4(__float_as_uint(tk[0]), __float_as_uint(tk[1]), __float_as_uint(tk[2]), __float_as_uint(tk[3]));
            dst[1] = make_uint4(__float_as_uint(tk[4]), __float_as_uint(tk[5]), __float_as_uint(tk[6]), __float_as_uint(tk[7]));
            dst[2] = make_uint4(__float_as_uint(tk[8]), __float_as_uint(tk[9]), __float_as_uint(tk[10]), __float_as_uint(tk[11]));
            dst[3] = make_uint4(__float_as_uint(tk[12]), __float_as_uint(tk[13]), __float_as_uint(tk[14]), __float_as_uint(tk[15]));
        }
        __syncthreads();
    }
}
DI void phase_combine(const Params& p, int bid, int nb) {
    const unsigned* TOPL = (const unsigned*)(p.ws + OFF_TOPL);
    uint2* EX = (uint2*)(p.ws + OFF_EXPS);
    const float* SU = (const float*)(p.ws + OFF_SU);
    const float* SV = (const float*)(p.ws + OFF_SV);
    for (int i = bid * NTH + my_tid(); i < NTOK * PHEADS; i += nb * NTH) {
        const unsigned* l1 = TOPL + (size_t)i * 32;
        const unsigned* l2 = l1 + 16;
        float s2[16];
        {
            const uint4 a = ((const uint4*)l2)[0], b = ((const uint4*)l2)[1], c = ((const uint4*)l2)[2], d = ((const uint4*)l2)[3];
            const unsigned w[16] = {a.x, a.y, a.z, a.w, b.x, b.y, b.z, b.w, c.x, c.y, c.z, c.w, d.x, d.y, d.z, d.w};
#pragma unroll
            for (int j = 0; j < 16; ++j) s2[j] = __uint_as_float(w[j] & ~0x7fu);
        }
        float tk[16];
#pragma unroll
        for (int j = 0; j < 16; ++j) tk[j] = -3.0e38f;
        for (int a = 0; a < 16; ++a) {
            const float s1 = __uint_as_float(l1[a] & ~0x7fu);
#pragma unroll
            for (int b = 0; b < 16; ++b) {
                float xv = __uint_as_float((__float_as_uint(s1 + s2[b]) & ~0xffu) | (unsigned)(a * 16 + b));
#pragma unroll
                for (int j = 0; j < 16; ++j) { const float hi = fmaxf(tk[j], xv), lo = fminf(tk[j], xv); tk[j] = hi; xv = lo; }
            }
        }
        float e[16], sum = 0.f;
        const float mx = __uint_as_float(__float_as_uint(tk[0]) & ~0xffu);
#pragma unroll
        for (int j = 0; j < 16; ++j) { e[j] = __expf(__uint_as_float(__float_as_uint(tk[j]) & ~0xffu) - mx); sum += e[j]; }
        const float inv = 1.0f / sum;
#pragma unroll
        for (int j = 0; j < 16; ++j) {
            const unsigned ab = __float_as_uint(tk[j]) & 0xffu;
            const unsigned i1 = l1[ab >> 4] & 0x7fu, i2 = l2[ab & 15] & 0x7fu;
            const unsigned eid = i1 * 128u + i2;
            EX[(size_t)i * 16 + j] = make_uint2(eid | (((__float_as_uint(SU[eid]) >> 23) & 0xffu) << 16), __float_as_uint(e[j] * inv * SV[eid]));
        }
    }
}

DI void ce_desc(float& a, float& b) { const float hi = fmaxf(a, b), lo = fminf(a, b); a = hi; b = lo; }
template <int N> DI void bitonic_sort_desc(float (&v)[N]) {
#pragma unroll
    for (int k = 2; k <= N; k <<= 1)
#pragma unroll
        for (int j = k >> 1; j > 0; j >>= 1)
#pragma unroll
            for (int i = 0; i < N; ++i) { const int l = i ^ j; if (l > i) { if ((i & k) == 0 || k == N) ce_desc(v[i], v[l]); else ce_desc(v[l], v[i]); } }
}
DI void merge_top16(float (&a)[16], const float (&b)[16]) {
#pragma unroll
    for (int i = 0; i < 16; ++i) a[i] = fmaxf(a[i], b[15 - i]);
#pragma unroll
    for (int j = 8; j > 0; j >>= 1)
#pragma unroll
        for (int i = 0; i < 16; ++i) { const int l = i ^ j; if (l > i) ce_desc(a[i], a[l]); }
}
DI void xlane_merge16(float (&a)[16]) {
    float o[16];
#pragma unroll
    for (int i = 0; i < 16; ++i) o[i] = __shfl_xor(a[i], 32);
    merge_top16(a, o);
}
DI void retrieve_topk_hp(const bf16_t* Q, const char* skl, const int tok, const int hp_next, const int r, const int h, unsigned char* lutp, float (&out)[16], bf16x8 (&bq)[8]) {
                f32x16 acc[4];
#pragma unroll
                for (int mi = 0; mi < 4; ++mi)
#pragma unroll
                    for (int i = 0; i < 16; ++i) acc[mi][i] = 0.f;
                const char* kb = skl + r * 272 + h * 16;
#pragma unroll
                for (int ks = 0; ks < 8; ++ks) {
#pragma unroll
                    for (int mi = 0; mi < 4; ++mi) {
                        const bf16x8 a = *(const bf16x8*)(kb + mi * 32 * 272 + ks * 32);
                        acc[mi] = __builtin_amdgcn_mfma_f32_32x32x16_bf16(a, bq[ks], acc[mi], 0, 0, 0);
                    }
                }
                {
                    const bf16_t* qb = Q + (size_t)tok * 2048 + hp_next * 128 + 8 * h;
#pragma unroll
                    for (int ks = 0; ks < 8; ++ks) bq[ks] = *(const bf16x8*)(qb + ks * 16);
                }
                float v0[16], v1[16], v2[16], v3[16];
#pragma unroll
                for (int i = 0; i < 16; ++i) {
                    const unsigned n = (unsigned)crow(i, h);
                    v0[i] = __uint_as_float((__float_as_uint(acc[0][i]) & ~0x7fu) | n);
                    v1[i] = __uint_as_float((__float_as_uint(acc[1][i]) & ~0x7fu) | (n + 32u));
                    v2[i] = __uint_as_float((__float_as_uint(acc[2][i]) & ~0x7fu) | (n + 64u));
                    v3[i] = __uint_as_float((__float_as_uint(acc[3][i]) & ~0x7fu) | (n + 96u));
                }
                bitonic_sort_desc<16>(v0); bitonic_sort_desc<16>(v1); bitonic_sort_desc<16>(v2); bitonic_sort_desc<16>(v3);
                merge_top16(v0, v1); merge_top16(v2, v3); merge_top16(v0, v2);
                xlane_merge16(v0);
#pragma unroll
                for (int i = 0; i < 16; ++i) out[i] = v0[i];
                u32x4 ix;
                ix.x = (__float_as_uint(v0[0]) & 0x7fu) | ((__float_as_uint(v0[1]) & 0x7fu) << 8) | ((__float_as_uint(v0[2]) & 0x7fu) << 16) | ((__float_as_uint(v0[3]) & 0x7fu) << 24);
                ix.y = (__float_as_uint(v0[4]) & 0x7fu) | ((__float_as_uint(v0[5]) & 0x7fu) << 8) | ((__float_as_uint(v0[6]) & 0x7fu) << 16) | ((__float_as_uint(v0[7]) & 0x7fu) << 24);
                ix.z = (__float_as_uint(v0[8]) & 0x7fu) | ((__float_as_uint(v0[9]) & 0x7fu) << 8) | ((__float_as_uint(v0[10]) & 0x7fu) << 16) | ((__float_as_uint(v0[11]) & 0x7fu) << 24);
                ix.w = (__float_as_uint(v0[12]) & 0x7fu) | ((__float_as_uint(v0[13]) & 0x7fu) << 8) | ((__float_as_uint(v0[14]) & 0x7fu) << 16) | ((__float_as_uint(v0[15]) & 0x7fu) << 24);
                *(u32x4*)lutp = ix;
}
DI void phase_retrieve(const Params& p, int bid, int nb, char* smem) {
    const bf16_t* Q = (const bf16_t*)(p.ws + OFF_PROJ);
    const bf16_t* SK = (const bf16_t*)(p.ws + OFF_SUBK);
    const float* SU = (const float*)(p.ws + OFF_SU);
    const float* SV = (const float*)(p.ws + OFF_SV);
    uint2* EX = (uint2*)(p.ws + OFF_EXPS);
    const int tid = my_tid(), lane = tid & 63, wid = tid >> 6, r = lane & 31, h = lane >> 5;
    unsigned char* lut = (unsigned char*)smem + wid * 2048 + lane * 32;
    char* skb0 = smem + 16384;
    char* skb1 = skb0 + 128 * 272;
    u32x4 sr0, sr1, sr2, sr3;
#define SK_LOAD(hp_) { const bf16_t* g_ = SK + (size_t)(hp_) * 16384 + tid * 8; sr0 = *(const u32x4*)g_; sr1 = *(const u32x4*)(g_ + 4096); sr2 = *(const u32x4*)(g_ + 8192); sr3 = *(const u32x4*)(g_ + 12288); }
#define SK_STORE(buf_) { char* d_ = (buf_) + (tid >> 4) * 272 + (tid & 15) * 16; *(u32x4*)d_ = sr0; *(u32x4*)(d_ + 32 * 272) = sr1; *(u32x4*)(d_ + 64 * 272) = sr2; *(u32x4*)(d_ + 96 * 272) = sr3; }
    for (int it = bid; it < (NTOK / 256) * 2; it += nb) {
        const int hq = it & 1, tok = (it >> 1) * 256 + wid * 32 + r;
        __syncthreads();
        SK_LOAD(hq * 8); SK_STORE(skb0);
        bf16x8 bq[8];
        {
            const bf16_t* qb = Q + (size_t)tok * 2048 + (hq * 8) * 128 + 8 * h;
#pragma unroll
            for (int ks = 0; ks < 8; ++ks) bq[ks] = *(const bf16x8*)(qb + ks * 16);
        }
        __syncthreads();
#pragma unroll 1
        for (int hd = hq * 4; hd < hq * 4 + 4; ++hd) {
            float L0[16], L1[16];
            SK_LOAD(hd * 2 + 1);
            retrieve_topk_hp(Q, skb0, tok, hd * 2 + 1, r, h, lut, L0, bq);
            SK_STORE(skb1);
            __syncthreads();
            if (hd + 1 < hq * 4 + 4) SK_LOAD(hd * 2 + 2);
            retrieve_topk_hp(Q, skb1, tok, (hd + 1 < hq * 4 + 4) ? hd * 2 + 2 : hd * 2 + 1, r, h, lut + 16, L1, bq);
            if (hd + 1 < hq * 4 + 4) SK_STORE(skb0);
            __syncthreads();
            float c[32];
            {
                constexpr int PA[50] = {0, 0, 0, 0, 0, 0, 0, 0, 0, 0, 0, 0, 0, 0, 0, 0, 1, 1, 1, 1, 1, 1, 1, 1, 2, 2, 2, 2, 2, 3, 3, 3, 3, 4, 4, 4, 5, 5, 6, 6, 7, 7, 8, 9, 10, 11, 12, 13, 14, 15};
                constexpr int PB[50] = {0, 1, 2, 3, 4, 5, 6, 7, 8, 9, 10, 11, 12, 13, 14, 15, 0, 1, 2, 3, 4, 5, 6, 7, 0, 1, 2, 3, 4, 0, 1, 2, 3, 0, 1, 2, 0, 1, 0, 1, 0, 1, 0, 0, 0, 0, 0, 0, 0, 0};
#pragma unroll
                for (int q = 0; q < 25; ++q) {
                    const float s0 = __uint_as_float(__float_as_uint(L0[PA[2 * q]]) & ~0x7fu) + __uint_as_float(__float_as_uint(L1[PB[2 * q]]) & ~0x7fu);
                    const float s1 = __uint_as_float(__float_as_uint(L0[PA[2 * q + 1]]) & ~0x7fu) + __uint_as_float(__float_as_uint(L1[PB[2 * q + 1]]) & ~0x7fu);
                    const float p0 = __uint_as_float((__float_as_uint(s0) & ~0xffu) | (unsigned)(PA[2 * q] * 16 + PB[2 * q]));
                    const float p1 = __uint_as_float((__float_as_uint(s1) & ~0xffu) | (unsigned)(PA[2 * q + 1] * 16 + PB[2 * q + 1]));
                    c[q] = h ? p1 : p0;
                }
#pragma unroll
                for (int i = 25; i < 32; ++i) c[i] = -3.0e38f;
            }
            bitonic_sort_desc<32>(c);
            float t16[16];
#pragma unroll
            for (int i = 0; i < 16; ++i) t16[i] = c[i];
            xlane_merge16(t16);
            const float mx = __uint_as_float(__float_as_uint(t16[0]) & ~0xffu);
            float e[16], sum = 0.f;
#pragma unroll
            for (int j = 0; j < 16; ++j) { e[j] = __expf(__uint_as_float(__float_as_uint(t16[j]) & ~0xffu) - mx); sum += e[j]; }
            const float inv = 1.0f / sum;
            uint2* dst = EX + ((size_t)tok * 8 + hd) * 16 + 8 * h;
#pragma unroll
            for (int j = 0; j < 8; ++j) {
                float tlo = t16[j], thi = t16[8 + j], elo = e[j], ehi = e[8 + j];
                asm volatile("" : "+v"(tlo), "+v"(thi), "+v"(elo), "+v"(ehi));
                const float tv = h ? thi : tlo, ev = h ? ehi : elo;
                const unsigned ab = __float_as_uint(tv) & 0xffu;
                const unsigned eid = (unsigned)lut[ab >> 4] * 128u + (unsigned)lut[16 + (ab & 15u)];
                dst[j] = make_uint2(eid | (pack2(0.f, SU[eid]) & 0xffff0000u), __float_as_uint(ev * inv * SV[eid]));
            }
        }
    }
#undef SK_LOAD
#undef SK_STORE
}

DI float dot16_fp8(const u32x4 w, const f32x2 (&h)[8]) {
    f32x2 acc = __builtin_amdgcn_cvt_pk_f32_fp8((int)w.x, false) * h[0];
    acc += __builtin_amdgcn_cvt_pk_f32_fp8((int)w.x, true) * h[1];
    acc += __builtin_amdgcn_cvt_pk_f32_fp8((int)w.y, false) * h[2];
    acc += __builtin_amdgcn_cvt_pk_f32_fp8((int)w.y, true) * h[3];
    acc += __builtin_amdgcn_cvt_pk_f32_fp8((int)w.z, false) * h[4];
    acc += __builtin_amdgcn_cvt_pk_f32_fp8((int)w.z, true) * h[5];
    acc += __builtin_amdgcn_cvt_pk_f32_fp8((int)w.w, false) * h[6];
    acc += __builtin_amdgcn_cvt_pk_f32_fp8((int)w.w, true) * h[7];
    return acc.x + acc.y;
}
DI void axpy16_fp8(const float a, const u32x4 w, f32x2 (&o)[8]) {
    const f32x2 aa = {a, a};
    o[0] += aa * __builtin_amdgcn_cvt_pk_f32_fp8((int)w.x, false); o[1] += aa * __builtin_amdgcn_cvt_pk_f32_fp8((int)w.x, true);
    o[2] += aa * __builtin_amdgcn_cvt_pk_f32_fp8((int)w.y, false); o[3] += aa * __builtin_amdgcn_cvt_pk_f32_fp8((int)w.y, true);
    o[4] += aa * __builtin_amdgcn_cvt_pk_f32_fp8((int)w.z, false); o[5] += aa * __builtin_amdgcn_cvt_pk_f32_fp8((int)w.z, true);
    o[6] += aa * __builtin_amdgcn_cvt_pk_f32_fp8((int)w.w, false); o[7] += aa * __builtin_amdgcn_cvt_pk_f32_fp8((int)w.w, true);
}
DI float butterfly64(float (&pz)[64], const int lane) {
    const bool b5 = lane & 32, b4 = lane & 16, b3 = lane & 8, b2 = lane & 4, b1 = lane & 2, b0 = lane & 1;
    float q32[32], q16[16], q8[8], q4[4], q2[2];
#pragma unroll
    for (int j = 0; j < 32; ++j) q32[j] = (b5 ? pz[32 + j] : pz[j]) + __shfl_xor(b5 ? pz[j] : pz[32 + j], 32);
#pragma unroll
    for (int j = 0; j < 16; ++j) q16[j] = (b4 ? q32[16 + j] : q32[j]) + __shfl_xor(b4 ? q32[j] : q32[16 + j], 16);
#pragma unroll
    for (int j = 0; j < 8; ++j) q8[j] = (b3 ? q16[8 + j] : q16[j]) + __shfl_xor(b3 ? q16[j] : q16[8 + j], 8);
#pragma unroll
    for (int j = 0; j < 4; ++j) q4[j] = (b2 ? q8[4 + j] : q8[j]) + __shfl_xor(b2 ? q8[j] : q8[4 + j], 4);
#pragma unroll
    for (int j = 0; j < 2; ++j) q2[j] = (b1 ? q4[2 + j] : q4[j]) + __shfl_xor(b1 ? q4[j] : q4[2 + j], 2);
    return (b0 ? q2[1] : q2[0]) + __shfl_xor(b0 ? q2[0] : q2[1], 1);
}
DI float bfly8(float (&pz)[8], const int lane) {
    const bool b2 = lane & 4, b1 = lane & 2, b0 = lane & 1;
    float q4[4], q2[2];
#pragma unroll
    for (int i = 0; i < 4; ++i) q4[i] = (b2 ? pz[4 + i] : pz[i]) + __shfl_xor(b2 ? pz[i] : pz[4 + i], 4);
#pragma unroll
    for (int i = 0; i < 2; ++i) q2[i] = (b1 ? q4[2 + i] : q4[i]) + __shfl_xor(b1 ? q4[i] : q4[2 + i], 2);
    float q = (b0 ? q2[1] : q2[0]) + __shfl_xor(b0 ? q2[0] : q2[1], 1);
    q += __shfl_xor(q, 8); q += __shfl_xor(q, 16); q += __shfl_xor(q, 32);
    return q;
}
DI float bfly16(float (&pz)[16], const int lane) {
    const bool b3 = lane & 8, b2 = lane & 4, b1 = lane & 2, b0 = lane & 1;
    float q8[8], q4[4], q2[2];
#pragma unroll
    for (int i = 0; i < 8; ++i) q8[i] = (b3 ? pz[8 + i] : pz[i]) + __shfl_xor(b3 ? pz[i] : pz[8 + i], 8);
#pragma unroll
    for (int i = 0; i < 4; ++i) q4[i] = (b2 ? q8[4 + i] : q8[i]) + __shfl_xor(b2 ? q8[i] : q8[4 + i], 4);
#pragma unroll
    for (int i = 0; i < 2; ++i) q2[i] = (b1 ? q4[2 + i] : q4[i]) + __shfl_xor(b1 ? q4[i] : q4[2 + i], 2);
    float q = (b0 ? q2[1] : q2[0]) + __shfl_xor(b0 ? q2[0] : q2[1], 1);
    q += __shfl_xor(q, 16); q += __shfl_xor(q, 32);
    return q;
}
DI void gs_issue(const __amdgpu_buffer_rsrc_t T, const uint2* ent, const unsigned d, const int lane, u32x4 (&w)[8], unsigned& ca) {
    const int cnt = (int)((d >> 16) & 0xfu), k = lane & 7;
    const uint2 e = ent[(d & 0xffffu) + (unsigned)(k < cnt ? k : cnt - 1)];
    ca = (k < cnt && !(d >> 31)) ? e.y : 0u;
#pragma unroll
    for (int q = 0; q < 8; ++q) {
        const int eid = __builtin_amdgcn_readlane((int)e.x, q) & 0x3fff;
        w[q] = __builtin_amdgcn_raw_buffer_load_b128(T, lane * 16, eid * DM, 0);
    }
}
DI float dot16_i8(const u32x4 w, const u32x4 h) {
    int acc = __builtin_amdgcn_sdot4((int)w.x, (int)h.x, 0, false);
    acc = __builtin_amdgcn_sdot4((int)w.y, (int)h.y, acc, false);
    acc = __builtin_amdgcn_sdot4((int)w.z, (int)h.z, acc, false);
    acc = __builtin_amdgcn_sdot4((int)w.w, (int)h.w, acc, false);
    return (float)acc;
}
DI void gs_desc(const uint2* ent, const unsigned d, const int lane, unsigned& ex) {
    const int cnt = (int)((d >> 16) & 0xfu), k = lane & 7;
    ex = ent[(d & 0xffffu) + (unsigned)(k < cnt ? k : cnt - 1)].x;
}
DI void gs_loads(const __amdgpu_buffer_rsrc_t T, const unsigned ex, const int lane, u32x4 (&w)[8]) {
#pragma unroll
    for (int q = 0; q < 8; ++q) {
        const int eid = __builtin_amdgcn_readlane((int)ex, q) & 0x3fff;
        w[q] = __builtin_amdgcn_raw_buffer_load_b128(T, lane * 16, eid * DM, 0);
    }
}
DI void gs_upartial(const u32x4 (&w)[8], const u32x4 h2q, float (&pz)[16], const int base) {
#pragma unroll
    for (int k = 0; k < 8; ++k) pz[base + k] = dot16_i8(w[k], h2q);
}
DI void gs_ustore(float (&pz)[16], float* zb, const unsigned da, const unsigned db, const int lane) {
    const float z = bfly16(pz, lane);
    const unsigned d = (lane & 8) ? db : da;
    const int k = lane & 7;
    if (lane < 16 && k < (int)((d >> 16) & 0xfu) && !(d >> 31)) zb[(d & 0xffffu) + k] = z;
}
DI void axpy16_u8(const float a, const u32x4 w, float (&o)[16]) {
    o[0] += a * (float)(w.x & 0xffu); o[1] += a * (float)((w.x >> 8) & 0xffu); o[2] += a * (float)((w.x >> 16) & 0xffu); o[3] += a * (float)(w.x >> 24);
    o[4] += a * (float)(w.y & 0xffu); o[5] += a * (float)((w.y >> 8) & 0xffu); o[6] += a * (float)((w.y >> 16) & 0xffu); o[7] += a * (float)(w.y >> 24);
    o[8] += a * (float)(w.z & 0xffu); o[9] += a * (float)((w.z >> 8) & 0xffu); o[10] += a * (float)((w.z >> 16) & 0xffu); o[11] += a * (float)(w.z >> 24);
    o[12] += a * (float)(w.w & 0xffu); o[13] += a * (float)((w.w >> 8) & 0xffu); o[14] += a * (float)((w.w >> 16) & 0xffu); o[15] += a * (float)(w.w >> 24);
}
DI void gs_vcompute(const u32x4 (&w)[8], const unsigned ca, float (&acc)[16]) {
#pragma unroll
    for (int k = 0; k < 8; ++k) { axpy16_u8(__uint_as_float((unsigned)__builtin_amdgcn_readlane((int)ca, k)), w[k], acc); __builtin_amdgcn_sched_barrier(0); }
}
constexpr int GT = 4;
constexpr int WL_ENT = GT * 1024, WL_Z = GT * 512, WL_OFFS = ((GT * 9 * 4 + 63) / 64) * 64, WL_SCHED = ((GT * 20 + 3) * 4 + 63) / 64 * 64, WL_BYTES = WL_ENT + WL_Z + WL_OFFS + WL_SCHED;
static_assert(8 * WL_BYTES <= 128 * 1024, "gather LDS");
template <int J> DI void gs_usel(const u32x4 (&w)[8], const u32x4 (&h2q)[GT], float (&pz)[16], const int base, const unsigned j) {
    if constexpr (J + 1 < GT) { if (j == (unsigned)J) gs_upartial(w, h2q[J], pz, base); else gs_usel<J + 1>(w, h2q, pz, base, j); } else gs_upartial(w, h2q[J], pz, base);
}
template <int J> DI void gs_vsel(const u32x4 (&w)[8], const unsigned ca, float (&acc)[GT][16], const unsigned j) {
    if constexpr (J + 1 < GT) { if (j == (unsigned)J) gs_vcompute(w, ca, acc[J]); else gs_vsel<J + 1>(w, ca, acc, j); } else gs_vcompute(w, ca, acc[J]);
}
constexpr int NSL = 4, SLSH = 12;
DI void xcd_pace(unsigned* cnt, const unsigned nloc, unsigned& step) {
    __syncthreads();
    if (__builtin_amdgcn_workitem_id_x() == 0) {
        __hip_atomic_fetch_add(cnt, 1u, __ATOMIC_RELAXED, __HIP_MEMORY_SCOPE_AGENT);
        const unsigned target = nloc * (step + 1u);
        unsigned sp = 0;
        while (__hip_atomic_load(cnt, __ATOMIC_RELAXED, __HIP_MEMORY_SCOPE_AGENT) < target) { __builtin_amdgcn_s_sleep(1); if (++sp > (1u << 22)) break; }
    }
    ++step;
    __syncthreads();
}
DI void phase_gather(const Params& p, int bid, int nb, char* smem, unsigned* pace_cnt, const unsigned pace_n) {
    unsigned pstep = 0;
    const float* mod = (const float*)(p.ws + OFF_MOD);
    const float* AB = (const float*)(p.ws + OFF_AB);
    const float* STAT = (const float*)(p.ws + OFF_STAT);
    const uint2* EX = (const uint2*)(p.ws + OFF_EXPS);
    const __amdgpu_buffer_rsrc_t UT = __builtin_amdgcn_make_buffer_rsrc((void*)(p.ws + OFF_UT), 0, NEXP * DM, 0x00020000);
    const __amdgpu_buffer_rsrc_t VT = __builtin_amdgcn_make_buffer_rsrc((void*)(p.ws + OFF_VT), 0, NEXP * DM, 0x00020000);
    const int lane = my_tid() & 63, wid = my_tid() >> 6, c0 = lane * 16;
    char* wl = smem + wid * WL_BYTES;
    uint2* ent = (uint2*)wl; float* zb = (float*)(wl + WL_ENT); int* offs = (int*)(wl + WL_ENT + WL_Z); unsigned* sched = (unsigned*)(wl + WL_ENT + WL_Z + WL_OFFS);
#pragma unroll 1
    for (int t0 = (bid * 8 + wid) * GT; t0 < NTOK; t0 += nb * 8 * GT) {
        u32x4 h2q[GT]; float hsc[GT]; float acc[GT][16];
        f32x4 scv[4], shv[4];
        {
            const int b = t0 / SEQ;
#pragma unroll
            for (int q = 0; q < 4; ++q) { scv[q] = *(const f32x4*)(AB + (size_t)b * DM + c0 + q * 4); shv[q] = *(const f32x4*)(AB + (size_t)(NB + b) * DM + c0 + q * 4); }
        }
#pragma unroll
        for (int j = 0; j < GT; ++j) {
            const int tok = t0 + j;
            const bf16_t* row = (const bf16_t*)(p.ws + OFF_R1) + (size_t)tok * DM + c0;
            __builtin_amdgcn_sched_barrier(0);
            const float mu_j = STAT[tok] * (1.0f / 1024.0f), rs_j = rsqrtf(fmaxf(STAT[NTOK + tok] * (1.0f / 1024.0f) - mu_j * mu_j, 0.f) + LN_EPS);
            {
                f32x4 hv[4];
                float m = 0.f;
                const u32x4 ra = *(const u32x4*)row, rb = *(const u32x4*)(row + 8);
                hv[0] = (f32x4){bflo(ra.x), bfhi(ra.x), bflo(ra.y), bfhi(ra.y)}; hv[1] = (f32x4){bflo(ra.z), bfhi(ra.z), bflo(ra.w), bfhi(ra.w)};
                hv[2] = (f32x4){bflo(rb.x), bfhi(rb.x), bflo(rb.y), bfhi(rb.y)}; hv[3] = (f32x4){bflo(rb.z), bfhi(rb.z), bflo(rb.w), bfhi(rb.w)};
#pragma unroll
                for (int q = 0; q < 4; ++q) { hv[q] = (hv[q] - mu_j) * rs_j * scv[q] + shv[q]; m = fmaxf(m, fmaxf(fmaxf(fabsf(hv[q].x), fabsf(hv[q].y)), fmaxf(fabsf(hv[q].z), fabsf(hv[q].w)))); }
#pragma unroll
                for (int sft = 1; sft < 64; sft <<= 1) m = fmaxf(m, __shfl_xor(m, sft));
                const float qs = m > 1e-30f ? 127.0f / m : 1.0f;
                hsc[j] = m > 1e-30f ? m * (1.0f / 127.0f) : 1.0f;
                unsigned hw[4];
#pragma unroll
                for (int q = 0; q < 4; ++q)
                    hw[q] = ((unsigned)(int)rintf(hv[q].x * qs) & 0xffu) | (((unsigned)(int)rintf(hv[q].y * qs) & 0xffu) << 8) | (((unsigned)(int)rintf(hv[q].z * qs) & 0xffu) << 16) | (((unsigned)(int)rintf(hv[q].w * qs) & 0xffu) << 24);
                h2q[j] = (u32x4){hw[0], hw[1], hw[2], hw[3]};
            }
            const uint2 e0 = EX[(size_t)tok * 128 + lane], e1 = EX[(size_t)tok * 128 + 64 + lane];
            const int s0 = (int)((e0.x & 0x3fffu) >> SLSH), s1 = (int)((e1.x & 0x3fffu) >> SLSH);
            int run = 0, pos0 = 0, pos1 = 0;
#pragma unroll
            for (int s = 0; s < NSL; ++s) {
                const unsigned long long m0 = __ballot(s0 == s), m1 = __ballot(s1 == s);
                const int c0n = __popcll(m0), c1n = __popcll(m1);
                const int below0 = (int)__builtin_amdgcn_mbcnt_hi((unsigned)(m0 >> 32), __builtin_amdgcn_mbcnt_lo((unsigned)m0, 0u));
                const int below1 = (int)__builtin_amdgcn_mbcnt_hi((unsigned)(m1 >> 32), __builtin_amdgcn_mbcnt_lo((unsigned)m1, 0u));
                if (lane == 0) offs[j * 9 + s] = run;
                pos0 = (s0 == s) ? run + below0 : pos0;
                pos1 = (s1 == s) ? run + c0n + below1 : pos1;
                run += c0n + c1n;
            }
            if (lane == 0) offs[j * 9 + NSL] = 128;
            ent[j * 128 + pos0] = e0; ent[j * 128 + pos1] = e1;
        }
        int nbat;
        {
            const int gs = (lane / GT) % NSL, gj = lane % GT;
            const int gb = offs[gj * 9 + gs], ge = offs[gj * 9 + gs + 1], cnt = lane < NSL * GT ? ge - gb : 0, nbt = (cnt + 7) >> 3;
            int incl = nbt;
#pragma unroll
            for (int m = 1; m < 32; m <<= 1) { const int o = __shfl_up(incl, m); if ((lane & 31) >= m) incl += o; }
            nbat = __builtin_amdgcn_readlane(incl, NSL * GT - 1);
            const int st = incl - nbt;
            for (int q = 0; q < nbt; ++q) { const int rem = cnt - 8 * q; sched[st + q] = (unsigned)(gj * 128 + gb + 8 * q) | ((unsigned)(rem < 8 ? rem : 8) << 16); }
            if (lane < 3) sched[nbat + lane] = 0x80010000u;
        }
        xcd_pace(pace_cnt, pace_n, pstep);
#ifndef PROBE_UX
#define PROBE_UX 1
#endif
        for (int rep = 0; rep < PROBE_UX; ++rep)
        {
            u32x4 wa[8], wb[8];
#define GS_UP(W_, D_, B_) gs_usel<0>(W_, h2q, pz, B_, ((D_) & 0xffffu) >> 7)
#define GS_RD(i_) ((unsigned)__builtin_amdgcn_readfirstlane((int)sched[(i_)]))
            unsigned da = GS_RD(0), db = GS_RD(1), dn = GS_RD(2), ea, eb, en;
            gs_desc(ent, da, lane, ea); gs_desc(ent, db, lane, eb); gs_desc(ent, dn, lane, en);
            gs_loads(UT, ea, lane, wa);
#pragma unroll 1
            for (int i = 0; i < nbat; i += 2) {
                float pz[16];
                gs_loads(UT, eb, lane, wb);
                __builtin_amdgcn_sched_barrier(0);
                GS_UP(wa, da, 0);
                const unsigned dcur_a = da, dcur_b = db;
                da = dn; ea = en; dn = GS_RD(i + 3); gs_desc(ent, dn, lane, en);
                gs_loads(UT, ea, lane, wa);
                __builtin_amdgcn_sched_barrier(0);
                GS_UP(wb, dcur_b, 8);
                db = dn; eb = en; dn = GS_RD(i + 4); gs_desc(ent, dn, lane, en);
                gs_ustore(pz, zb, dcur_a, dcur_b, lane);
            }
#undef GS_UP
#undef GS_RD
        }
        float asum[GT];
#pragma unroll
        for (int j = 0; j < GT; ++j) {
            float as = 0.f;
#pragma unroll
            for (int q = 0; q < 2; ++q) {
                const int pos = j * 128 + q * 64 + lane;
                const uint2 e = ent[pos];
                const float z = zb[pos] * __uint_as_float(e.x & 0xffff0000u) * hsc[j];
                const float a = gelu_as(z) * __uint_as_float(e.y);
                ent[pos].y = __float_as_uint(a);
                as += a;
            }
#pragma unroll
            for (int sft = 1; sft < 64; sft <<= 1) as += __shfl_xor(as, sft);
            asum[j] = as;
        }
#pragma unroll
        for (int j = 0; j < GT; ++j)
#pragma unroll
            for (int q = 0; q < 16; ++q) acc[j][q] = 0.f;
        {
            u32x4 wa[8]; unsigned ca;
#pragma unroll 1
            for (int i = 0; i < nbat; ++i) {
                const unsigned da = (unsigned)__builtin_amdgcn_readfirstlane((int)sched[i]);
                gs_issue(VT, ent, da, lane, wa, ca);
                __builtin_amdgcn_sched_barrier(0);
                gs_vsel<0>(wa, ca, acc, (da & 0xffffu) >> 7);
            }
        }
#pragma unroll
        for (int j = 0; j < GT; ++j) {
            asm volatile("" ::: "memory");
            __builtin_amdgcn_sched_barrier(0);
            const int tok = t0 + j, b = tok / SEQ;
            int c0 = lane * 16; asm volatile("" : "+v"(c0));
            const float mu_j = STAT[tok] * (1.0f / 1024.0f), rs_j = rsqrtf(fmaxf(STAT[NTOK + tok] * (1.0f / 1024.0f) - mu_j * mu_j, 0.f) + LN_EPS);
            float* row = p.out + (size_t)tok * DM + c0;
            const bf16_t* r1row = (const bf16_t*)(p.ws + OFF_R1) + (size_t)tok * DM + c0;
            const float* g2 = mod + b * 6144 + 5120 + c0;
            f32x2 r[8];
            float sm = 0.f;
            const u32x4 ra = *(const u32x4*)r1row, rb = *(const u32x4*)(r1row + 8);
            const f32x4 r1v[4] = {(f32x4){bflo(ra.x), bfhi(ra.x), bflo(ra.y), bfhi(ra.y)}, (f32x4){bflo(ra.z), bfhi(ra.z), bflo(ra.w), bfhi(ra.w)},
                                  (f32x4){bflo(rb.x), bfhi(rb.x), bflo(rb.y), bfhi(rb.y)}, (f32x4){bflo(rb.z), bfhi(rb.z), bflo(rb.w), bfhi(rb.w)}};
#pragma unroll
            for (int q = 0; q < 4; ++q) {
                const f32x4 xv = (r1v[q] - mu_j) * rs_j * *(const f32x4*)(p.ln1w + c0 + q * 4) + *(const f32x4*)(p.ln1b + c0 + q * 4), gg = *(const f32x4*)(g2 + q * 4);
                const float off = 128.0f * asum[j];
                r[2 * q] = DEEP_ALPHA * (f32x2){xv.x, xv.y} + (f32x2){1.f + gg.x, 1.f + gg.y} * (f32x2){acc[j][4 * q] - off, acc[j][4 * q + 1] - off};
                r[2 * q + 1] = DEEP_ALPHA * (f32x2){xv.z, xv.w} + (f32x2){1.f + gg.z, 1.f + gg.w} * (f32x2){acc[j][4 * q + 2] - off, acc[j][4 * q + 3] - off};
                sm += r[2 * q].x + r[2 * q].y + r[2 * q + 1].x + r[2 * q + 1].y;
            }
#pragma unroll
            for (int m = 1; m < 64; m <<= 1) sm += __shfl_xor(sm, m);
            const float mu = sm * (1.0f / 1024.0f);
            float qq = 0.f;
#pragma unroll
            for (int i = 0; i < 8; ++i) { const f32x2 dd = r[i] - mu; qq += dd.x * dd.x + dd.y * dd.y; }
#pragma unroll
            for (int m = 1; m < 64; m <<= 1) qq += __shfl_xor(qq, m);
            const float rstd = rsqrtf(qq * (1.0f / 1024.0f) + LN_EPS);
#pragma unroll
            for (int q = 0; q < 4; ++q) {
                const f32x4 w4 = *(const f32x4*)(p.ln2w + c0 + q * 4), bi = *(const f32x4*)(p.ln2b + c0 + q * 4);
                f32x4 ov;
                ov.x = (r[2 * q].x - mu) * rstd * w4.x + bi.x; ov.y = (r[2 * q].y - mu) * rstd * w4.y + bi.y;
                ov.z = (r[2 * q + 1].x - mu) * rstd * w4.z + bi.z; ov.w = (r[2 * q + 1].y - mu) * rstd * w4.w + bi.w;
                *(f32x4*)(row + q * 4) = ov;
            }
        }
    }
}

#define XB_TMO      128
#define XB_XCNT(j)  (256  + 64 * (j))
#define XB_XSUB(j)  (1280 + 64 * (j))
#define XB_XGEN(j)  (2304 + 64 * (j))
#define XB_TOP      3328
#define XB_TOPGEN   3392
#define XCD_BAR_WORDS 3456
#define XB_SPIN_CAP (1u << 22)
#define LAS __attribute__((address_space(3)))
DI unsigned xb_ld(unsigned* p) { return __hip_atomic_load(p, __ATOMIC_RELAXED, __HIP_MEMORY_SCOPE_AGENT); }
DI unsigned xb_add(unsigned* p, unsigned v) { return __hip_atomic_fetch_add(p, v, __ATOMIC_RELAXED, __HIP_MEMORY_SCOPE_AGENT); }
DI unsigned xb_xcc_id() { return (unsigned)__builtin_amdgcn_s_getreg((3 << 11) | 20) & 0xFu; }
#define XB_SPIN(cond, bar) do { unsigned _sp = 0; while (cond) { __builtin_amdgcn_s_sleep(1); \
    if ((++_sp & 255u) == 0u) { if (xb_ld(&(bar)[XB_TMO])) break; if (_sp > XB_SPIN_CAP) { atomicAdd(&(bar)[XB_TMO], 1u); break; } } } } while (0)
struct XcdBarrier { unsigned* bar; unsigned x; volatile LAS unsigned* st; };
DI XcdBarrier xcd_barrier_post(unsigned* bar, volatile LAS unsigned* st) {
    XcdBarrier b; b.bar = bar; b.x = xb_xcc_id(); b.st = st;
    if (__builtin_amdgcn_workitem_id_x() == 0) (void)xb_add(&bar[XB_XCNT(b.x)], 1u);
    return b;
}
DI void xcd_barrier_complete(unsigned* bar, unsigned x, unsigned& nloc, unsigned& nx) {
    const unsigned G = gridDim.x * gridDim.y * gridDim.z;
    unsigned sum, cnt, mine, sp = 0u;
    for (;;) {
        sum = 0u; cnt = 0u; mine = 0u;
#pragma unroll
        for (unsigned j = 0; j < 16; ++j) { const unsigned c = xb_ld(&bar[XB_XCNT(j)]); sum += c; cnt += (c > 0u) ? 1u : 0u; mine = (j == x) ? c : mine; }
        if (sum == G) break;
        __builtin_amdgcn_s_sleep(1);
        if ((++sp & 255u) == 0u) { if (xb_ld(&bar[XB_TMO])) break; if (sp > XB_SPIN_CAP) { atomicAdd(&bar[XB_TMO], 1u); break; } }
    }
    nloc = mine > 0u ? mine : 1u; nx = cnt > 0u ? cnt : 1u;
}
DI void xcd_barrier(const XcdBarrier& b) {
    asm volatile("s_waitcnt vmcnt(0)" ::: "memory");
    __syncthreads();
    if (__builtin_amdgcn_workitem_id_x() == 0) {
        unsigned* bar = b.bar;
        unsigned bx = b.x; asm volatile("" : "+s"(bx));
        __builtin_amdgcn_s_waitcnt(0);
        unsigned nloc = b.st[0], nx = b.st[1];
        if (nloc == 0u) { xcd_barrier_complete(bar, bx, nloc, nx); b.st[0] = nloc; b.st[1] = nx; }
        const unsigned old = xb_add(&bar[XB_XSUB(bx)], 1u);
        const unsigned gen = old / nloc;
        if (old + 1u == (gen + 1u) * nloc) {
            __builtin_amdgcn_fence(__ATOMIC_RELEASE, "agent");
            asm volatile("s_waitcnt vmcnt(0)" ::: "memory");
            const unsigned og = xb_add(&bar[XB_TOP], 1u);
            const unsigned tg = og / nx;
            if (og + 1u == (tg + 1u) * nx) xb_add(&bar[XB_TOPGEN], 1u);
            else XB_SPIN(xb_ld(&bar[XB_TOPGEN]) == tg, bar);
            __builtin_amdgcn_fence(__ATOMIC_ACQUIRE, "agent");
            xb_add(&bar[XB_XGEN(bx)], 1u);
            asm volatile("s_waitcnt vmcnt(0)" ::: "memory");
        } else {
            XB_SPIN(xb_ld(&bar[XB_XGEN(bx)]) == gen, bar);
            __builtin_amdgcn_fence(__ATOMIC_ACQUIRE, "agent");
            asm volatile("s_waitcnt vmcnt(0)" ::: "memory");
        }
    }
    __syncthreads();
}

__global__ void __launch_bounds__(NTH) k_mega(Params p) {
    __shared__ __attribute__((aligned(16))) char smem[SMEM_BYTES];
    volatile LAS unsigned* xst = (volatile LAS unsigned*)(smem + SMEM_BYTES - 16);
    if (__builtin_amdgcn_workitem_id_x() == 0) { xst[0] = 0u; xst[1] = 0u; }
    __syncthreads();
    const XcdBarrier xb = xcd_barrier_post((unsigned*)(p.ws + OFF_BAR), xst);
    const int bid = blockIdx.x, nb = gridDim.x;
#ifndef PROBE_MASK
#define PROBE_MASK 0
#endif
#define REP(bit) for (int rep_ = 0; rep_ < ((PROBE_MASK & (bit)) ? 2 : 1); ++rep_)
    phase_prep_a(p, smem);           xcd_barrier(xb);
    phase_prep_b(p, smem);           xcd_barrier(xb);
    REP(1)  { phase_proj(p, bid, nb, smem);    xcd_barrier(xb); }
    REP(2)  { phase_mix(p, bid, nb, smem);     xcd_barrier(xb); }
    REP(4)  { phase_glu(p, bid, nb, smem);     xcd_barrier(xb); }
    REP(4)  { phase_outproj(p, bid, nb, smem); xcd_barrier(xb); }
    REP(8)  { phase_q(p, bid, nb, smem);       xcd_barrier(xb); }
    REP(16) { phase_retrieve(p, bid, nb, smem); xcd_barrier(xb); }
    phase_gather(p, bid, nb, smem, (unsigned*)(p.ws + OFF_BAR) + 16 * xb_xcc_id(), (unsigned)__builtin_amdgcn_readfirstlane((int)xst[0]));
}

extern "C" void kernel_launch(void* const* d_in, const int* in_sizes, int n_in, void* d_out, int out_size, void* d_ws, size_t ws_size, hipStream_t stream) {
    if (n_in != 27 || ws_size < WS_END) { fprintf(stderr, "kernel_launch: unexpected n_in %d or ws_size %zu (< %zu)\n", n_in, ws_size, (size_t)WS_END); return; }
    static int grid_blocks = 0;
    if (!grid_blocks) {
        int dev = 0, cus = 0, per_cu = 0;
        (void)hipGetDevice(&dev);
        (void)hipDeviceGetAttribute(&cus, hipDeviceAttributeMultiprocessorCount, dev);
        (void)hipOccupancyMaxActiveBlocksPerMultiprocessor(&per_cu, k_mega, NTH, 0);
        if (cus <= 0) cus = 256;
        if (per_cu < 1) { fprintf(stderr, "kernel_launch: occupancy query says %d blocks/CU\n", per_cu); per_cu = 1; }
        grid_blocks = cus;
    }
    Params p{};
    const float** f = (const float**)&p;
    for (int i = 0; i < 27; ++i) f[i] = (const float*)d_in[i];
    p.out = (float*)d_out; p.ws = (char*)d_ws;
    hipError_t e = hipMemsetAsync((char*)d_ws + OFF_BAR, 0, (size_t)3456 * 4, stream);
    if (e == hipSuccess) { hipLaunchKernelGGL(k_mega, dim3(grid_blocks), dim3(NTH), 0, stream, p); e = hipPeekAtLastError(); }
    if (e != hipSuccess) fprintf(stderr, "launch failed: %s (grid %d)\n", hipGetErrorString(e), grid_blocks);
}
```

```cpp
#include <hip/hip_runtime.h>
#include <hip/hip_cooperative_groups.h>
#include <stdint.h>
#include <stdio.h>

namespace cg = cooperative_groups;
#define DI __device__ __forceinline__
typedef unsigned short bf16_t;
typedef short bf16x8 __attribute__((ext_vector_type(8)));
typedef float f32x16 __attribute__((ext_vector_type(16)));
typedef unsigned u32x4 __attribute__((ext_vector_type(4)));
typedef float f32x4 __attribute__((ext_vector_type(4)));
typedef float f32x2 __attribute__((ext_vector_type(2)));

constexpr int NTH = 512;
constexpr int NB = 16, SEQ = 2048, DM = 1024, NTOK = NB * SEQ;
constexpr int DHG = 512, HGH = 4, HDK = 128;
constexpr int DSS = 512, SSG = 32, SSC = 16, SSP = 64;
constexpr int INC = 2560;
constexpr int PHEADS = 8, NKEYS = 128, TOPK = 16, NEXP = 16384;
constexpr float DEEP_ALPHA = 1.189207115002721f;
constexpr float LN_EPS = 1e-5f, RMS_EPS = 1e-6f;
constexpr int SMEM_BYTES = 128 * 1024 + 256;

constexpr size_t al256(size_t x) { return (x + 255) & ~(size_t)255; }
constexpr size_t OFF_MOD = 0;
constexpr size_t OFF_LB = al256(OFF_MOD + (size_t)NB * 6144 * 4);
constexpr size_t OFF_LAM = al256(OFF_LB + 512 * 4);
constexpr size_t OFF_BB = al256(OFF_LAM + 32 * 64 * 2 * 4);
constexpr size_t OFF_WIN = al256(OFF_BB + 32 * 64 * 16 * 2 * 4);
constexpr size_t OFF_GLU = al256(OFF_WIN + (size_t)INC * DM * 2);
constexpr size_t OFF_WOUT = al256(OFF_GLU + (size_t)512 * 512 * 2);
constexpr size_t OFF_WQ = al256(OFF_WOUT + (size_t)DM * DM * 2);
constexpr size_t OFF_SUBK = al256(OFF_WQ + (size_t)2048 * DM * 2);
constexpr size_t OFF_SU = al256(OFF_SUBK + (size_t)16 * 128 * 128 * 2);
constexpr size_t OFF_SV = al256(OFF_SU + (size_t)NEXP * 4);
constexpr size_t OFF_UT = al256(OFF_SV + (size_t)NEXP * 4);
constexpr size_t OFF_VT = al256(OFF_UT + (size_t)NEXP * DM * 2);
constexpr size_t OFF_H = al256(OFF_VT + (size_t)NEXP * DM * 2);
constexpr size_t OFF_PROJ = al256(OFF_H + (size_t)NTOK * DM * 2);
constexpr size_t OFF_ORAW = al256(OFF_PROJ + (size_t)NTOK * INC * 2);
constexpr size_t OFF_YSSM = al256(OFF_ORAW + (size_t)NTOK * DHG * 4);
constexpr size_t OFF_A2 = al256(OFF_YSSM + (size_t)NTOK * DSS * 2);
constexpr size_t OFF_HG = al256(OFF_A2 + (size_t)NTOK * DM * 2);
constexpr size_t OFF_S5K = al256(OFF_HG + (size_t)4096 * 128 * 4);
constexpr size_t OFF_S5N = al256(OFF_S5K + (size_t)32 * 4096 * 2);
constexpr size_t OFF_S5M = al256(OFF_S5N + (size_t)32 * 128 * 256 * 2);
constexpr size_t OFF_S5L = al256(OFF_S5M + (size_t)32 * 256 * 128 * 2);
constexpr size_t OFF_STAT = al256(OFF_S5L + (size_t)32 * 64 * 2 * 4);
constexpr size_t OFF_AB = al256(OFF_STAT + (size_t)NTOK * 3 * 4);
constexpr size_t OFF_CAB = al256(OFF_AB + (size_t)2 * NB * DM * 4);
constexpr size_t OFF_BAR = al256(OFF_CAB + (size_t)2 * NB * 2048 * 4);
constexpr size_t WS_END = al256(OFF_BAR + (size_t)3456 * 4);
constexpr size_t OFF_HQ = OFF_ORAW, OFF_HK = OFF_ORAW + (size_t)NTOK * DHG * 2;
constexpr size_t OFF_TOPL = OFF_ORAW;
constexpr size_t OFF_EXPS = OFF_YSSM;
constexpr size_t OFF_R1 = OFF_ORAW;

struct Params {
    const float *x, *c, *ada_w, *ada_b, *w_in, *hg_lb, *hg_nw, *a_re, *a_im, *log_dt, *b_re, *b_im, *c_re, *c_im, *dsk,
        *glu_w, *glu_b, *ssm_nw, *w_out, *ln1w, *ln1b, *w_q, *subk, *pu, *pv, *ln2w, *ln2b;
    float* out;
    char* ws;
};

DI int my_tid() { int t = (int)__builtin_amdgcn_workitem_id_x(); asm volatile("" : "+v"(t)); return t; }
DI bf16_t f2bf(float x) { unsigned u = __float_as_uint(x); u += 0x7fffu + ((u >> 16) & 1u); return (bf16_t)(u >> 16); }
DI float bf2f(bf16_t b) { return __uint_as_float(((unsigned)b) << 16); }
DI float bflo(unsigned w) { return __uint_as_float(w << 16); }
DI float bfhi(unsigned w) { return __uint_as_float(w & 0xffff0000u); }
typedef __bf16 hwbf16x2 __attribute__((ext_vector_type(2)));
DI unsigned pack2(float a, float b) { const f32x2 v = {a, b}; return __builtin_bit_cast(unsigned, __builtin_convertvector(v, hwbf16x2)); }
DI bf16x8 pack8(const f32x16& x, const int base) {
    u32x4 o; o.x = pack2(x[base], x[base + 1]); o.y = pack2(x[base + 2], x[base + 3]); o.z = pack2(x[base + 4], x[base + 5]); o.w = pack2(x[base + 6], x[base + 7]);
    return __builtin_bit_cast(bf16x8, o);
}
DI float sigmoidf_(float x) { return 1.0f / (1.0f + __expf(-x)); }
DI float siluf_(float x) { return x * sigmoidf_(x); }
DI float geluf_(float x) { return 0.5f * x * (1.0f + erff(x * 0.70710678118654752f)); }
DI float gelu_as(float v) {
    const float t = __builtin_amdgcn_rcpf(fabsf(v) * 0.2316418882f + 1.0f);
    float q = t * 0.5307027145f + (-0.7265760135f); q = q * t + 0.7107068705f; q = q * t + (-0.142248368f); q = q * t + 0.127414796f; q = q * t;
    const float m = v * (q * __builtin_amdgcn_exp2f(v * v * (-0.72134752044f)));
    return v < 0.f ? m : v - m;
}

template <int MT, int NT_, int WM, int WN, class Epi>
DI void gemm_block(const bf16_t* __restrict__ A, int lda, const bf16_t* __restrict__ Bt, int ldb, int K, char* smem, Epi epi) {
    constexpr int BM = WM * MT * 32, BN = WN * NT_ * 32, LS = 72;
    static_assert(WM * WN == 8, "8 waves");
    bf16_t* As = (bf16_t*)smem;
    bf16_t* Bs = As + BM * LS;
    const int tid = my_tid(), lane = tid & 63, wid = tid >> 6, r = lane & 31, h = lane >> 5;
    const int wm = wid / WN, wn = wid % WN;
    constexpr int PA = BM * 8 / NTH, PB = BN * 8 / NTH;
    u32x4 ra[PA], rb[PB];
    f32x16 acc[MT][NT_];
#pragma unroll
    for (int mi = 0; mi < MT; ++mi)
#pragma unroll
        for (int ni = 0; ni < NT_; ++ni)
#pragma unroll
            for (int i = 0; i < 16; ++i) acc[mi][ni][i] = 0.f;
#define GEMM_GLOAD(kt_) { \
    _Pragma("unroll") for (int q = 0; q < PA; ++q) { const int idx = tid + q * NTH, row = idx >> 3, ch = idx & 7; ra[q] = *(const u32x4*)(A + (size_t)row * lda + (kt_) * 64 + ch * 8); } \
    _Pragma("unroll") for (int q = 0; q < PB; ++q) { const int idx = tid + q * NTH, row = idx >> 3, ch = idx & 7; rb[q] = *(const u32x4*)(Bt + (size_t)row * ldb + (kt_) * 64 + ch * 8); } }
#define GEMM_LSTORE() { \
    _Pragma("unroll") for (int q = 0; q < PA; ++q) { const int idx = tid + q * NTH, row = idx >> 3, ch = idx & 7; *(u32x4*)(As + row * LS + ch * 8) = ra[q]; } \
    _Pragma("unroll") for (int q = 0; q < PB; ++q) { const int idx = tid + q * NTH, row = idx >> 3, ch = idx & 7; *(u32x4*)(Bs + row * LS + ch * 8) = rb[q]; } }
    GEMM_GLOAD(0); GEMM_LSTORE(); __syncthreads();
    const int nk = K / 64;
    for (int kt = 0; kt < nk; ++kt) {
        if (kt + 1 < nk) GEMM_GLOAD(kt + 1);
#pragma unroll
        for (int ks = 0; ks < 4; ++ks) {
            bf16x8 a[MT], b[NT_];
#pragma unroll
            for (int mi = 0; mi < MT; ++mi) a[mi] = *(const bf16x8*)(As + (wm * MT * 32 + mi * 32 + r) * LS + ks * 16 + h * 8);
#pragma unroll
            for (int ni = 0; ni < NT_; ++ni) b[ni] = *(const bf16x8*)(Bs + (wn * NT_ * 32 + ni * 32 + r) * LS + ks * 16 + h * 8);
#pragma unroll
            for (int mi = 0; mi < MT; ++mi)
#pragma unroll
                for (int ni = 0; ni < NT_; ++ni) acc[mi][ni] = __builtin_amdgcn_mfma_f32_32x32x16_bf16(a[mi], b[ni], acc[mi][ni], 0, 0, 0);
        }
        __syncthreads();
        if (kt + 1 < nk) { GEMM_LSTORE(); __syncthreads(); }
    }
#pragma unroll
    for (int mi = 0; mi < MT; ++mi)
#pragma unroll
        for (int ni = 0; ni < NT_; ++ni)
#pragma unroll
            for (int i = 0; i < 16; ++i) epi(wm * MT * 32 + mi * 32 + (i & 3) + 8 * (i >> 2) + 4 * h, wn * NT_ * 32 + ni * 32 + r, acc[mi][ni][i]);
}

namespace pg8 {
#define PG8_LAS __attribute__((address_space(3)))
typedef unsigned short bf16_t;
typedef short bf16x8 __attribute__((ext_vector_type(8)));
typedef float f32x4 __attribute__((ext_vector_type(4)));
typedef unsigned u32x4 __attribute__((ext_vector_type(4)));
constexpr int BM = 256, BK = 64, HALF = 128, HTB = HALF * BK * 2  , STAGE_BYTES = 8 * HTB, NXCD = 8, WGM = 8;

__host__ __device__ __forceinline__ int lds_byte(int r, int c) { const int st = (r >> 4) * 2 + (c >> 5), rr = r & 15, cc = c & 31, ob = rr * 64 + cc * 2; return st * 1024 + (ob ^ (((ob >> 9) & 1) << 5)); }
__host__ __device__ __forceinline__ void stage_rc(int b, int& R, int& C) { const int st = b / 1024, sb = b % 1024, swz = sb ^ (((sb >> 9) & 1) << 5); R = (st >> 1) * 16 + swz / 64; C = (st & 1) * 32 + (swz % 64) / 2; }
__host__ __device__ __forceinline__ int perm32(int rho) { const int n = rho >> 4, i = rho & 15; return 8 * (i >> 2) + 4 * n + (i & 3); }

struct Unit { int pm, pn; };
struct Gemm { const bf16_t* A; const bf16_t* Bt; int M, N, K; };

struct StaticOrder {
    int nM, nN, nwg, G, c;
    __host__ __device__ void init(int M, int N, int G_, int c_) { nM = M / BM; nN = N / BM; nwg = nM * nN; G = G_; c = c_; }
    __host__ __device__ bool next(int i, Unit& u) const {
        const long L = (long)i * G + c; if (L >= nwg) return false;
        int wgid = (int)L; { const int q = nwg / NXCD, r = nwg % NXCD, xcd = wgid % NXCD, off = wgid / NXCD; wgid = (xcd < r ? xcd * (q + 1) : r * (q + 1) + (xcd - r) * q) + off; }
        const int nig = WGM * nN, gid = wgid / nig, fm = gid * WGM, gsz = (nM - fm) < WGM ? (nM - fm) : WGM;
        u.pm = fm + ((wgid % nig) % gsz); u.pn = (wgid % nig) / gsz; return true;
    }
    __device__ __forceinline__ void a_ready(const Unit&) const {}
    __device__ __forceinline__ void done(const Unit&) const {}
};
template <class Epi, class Sched, bool STAMP = false>
__device__ __forceinline__ void gemm_phase(PG8_LAS unsigned char* lds, const Gemm g, const Sched& S, const Epi& E, unsigned long long* stamps) {
    int tid_ = (int)__builtin_amdgcn_workitem_id_x(); asm volatile("" : "+v"(tid_));
    const int tid = tid_, wid = __builtin_amdgcn_readfirstlane(tid >> 6), lane = tid & 63, wr = wid >> 2, wc = wid & 3, fr = lane & 15, fq = lane >> 4;
    const int K = g.K, nt = K / BK;
    int ts_lo = 0, ts_hi = 0, nts = 0; const unsigned long long rt_entry = STAMP ? (unsigned long long)wall_clock64() : 0ull;
#define PG8_STAMP() do { if (STAMP && wid == 0 && nts < 64) { const unsigned long long _c = (unsigned long long)clock64(); \
        ts_lo = (lane == nts) ? (int)(unsigned)_c : ts_lo; ts_hi = (lane == nts) ? (int)(unsigned)(_c >> 32) : ts_hi; ++nts; } } while (0)
    PG8_STAMP();
    unsigned voffA[2], voffB[2];
#pragma unroll
    for (int i = 0; i < 2; ++i) { int R, C; stage_rc(tid * 16 + i * 8192, R, C); const int Rb = Epi::PERM ? ((R & ~31) + perm32(R & 31)) : R;
        voffA[i] = (unsigned)(R * K + C) * 2u; voffB[i] = (unsigned)(Rb * K + C) * 2u; }
    const size_t kstep = (size_t)(BK * 2);
    const size_t hstep = (size_t)HALF * K * 2;
    const size_t tstep = 2 * hstep;
    const unsigned ldsw = (unsigned)wid * 1024u;
    const int aoff = lds_byte(wr * 64 + fr, fq * 8), boff = lds_byte(wc * 32 + fr, fq * 8);
#define PG8_SA(b, h) (((b) * 2 + (h)) * HTB)
#define PG8_SB(b, h) ((4 + (b) * 2 + (h)) * HTB)
#define PG8_STAGE(bufoff, gbase, voff) do { _Pragma("unroll") for (int _i = 0; _i < 2; ++_i) \
        __builtin_amdgcn_global_load_lds((const unsigned*)((const char*)(gbase) + (voff)[_i]), (PG8_LAS unsigned*)(lds + (bufoff) + ldsw + _i * 8192), 16, 0, 0); } while (0)
#define PG8_LDA(dst, b, h) do { _Pragma("unroll") for (int m = 0; m < 4; ++m) _Pragma("unroll") for (int k = 0; k < 2; ++k) dst[m][k] = *(const PG8_LAS bf16x8*)(lds + PG8_SA(b, h) + aoff + m * 2048 + k * 1024); } while (0)
#define PG8_LDB(dst, b, h) do { _Pragma("unroll") for (int n = 0; n < 2; ++n) _Pragma("unroll") for (int k = 0; k < 2; ++k) dst[n][k] = *(const PG8_LAS bf16x8*)(lds + PG8_SB(b, h) + boff + n * 2048 + k * 1024); } while (0)
#define PG8_MMA(ai, bj, At, Bt) do { __builtin_amdgcn_s_setprio(1); _Pragma("unroll") for (int m = 0; m < 4; ++m) _Pragma("unroll") for (int n = 0; n < 2; ++n) _Pragma("unroll") for (int k = 0; k < 2; ++k) \
        acc[ai][bj][m][n] = __builtin_amdgcn_mfma_f32_16x16x32_bf16(Bt[n][k], At[m][k], acc[ai][bj][m][n], 0, 0, 0); __builtin_amdgcn_s_setprio(0); } while (0)
#define PG8_WAIT_V(n) asm volatile("s_waitcnt vmcnt(" #n ")" ::: "memory")
#define PG8_WAIT_L(n) asm volatile("s_waitcnt lgkmcnt(" #n ")" ::: "memory")
#define PG8_BAR __builtin_amdgcn_s_barrier()
#define PG8_SCHED __builtin_amdgcn_sched_barrier(0)
    Unit cur, nxt; int ui = 0;
    if (!S.next(0, cur)) return;
    f32x4 acc[2][2][4][2];
#pragma unroll
    for (int a = 0; a < 2; ++a)
#pragma unroll
        for (int b = 0; b < 2; ++b)
#pragma unroll
            for (int m = 0; m < 4; ++m)
#pragma unroll
                for (int n = 0; n < 2; ++n) acc[a][b][m][n] = (f32x4){0.f, 0.f, 0.f, 0.f};
    bf16x8 At[4][2], B0[2][2], B1[2][2];
    const char* cA = (const char*)g.A + (size_t)cur.pm * tstep; const char* cB = (const char*)g.Bt + (size_t)cur.pn * tstep;
    S.a_ready(cur);
    PG8_STAGE(PG8_SB(0, 0), cB, voffB); PG8_STAGE(PG8_SA(0, 0), cA, voffA); PG8_STAGE(PG8_SB(0, 1), cB + hstep, voffB); PG8_STAGE(PG8_SA(0, 1), cA + hstep, voffA);
    if (wr == 1) PG8_BAR;
    PG8_WAIT_V(4); PG8_BAR;
    PG8_STAGE(PG8_SB(1, 0), cB + kstep, voffB); PG8_STAGE(PG8_SA(1, 0), cA + kstep, voffA); PG8_STAGE(PG8_SB(1, 1), cB + hstep + kstep, voffB);
    PG8_WAIT_V(6); PG8_BAR;
    PG8_STAMP();
    for (;;) {
        const bool has_next = S.next(ui + 1, nxt);
        const char* nA = has_next ? (const char*)g.A + (size_t)nxt.pm * tstep : cA; const char* nB = has_next ? (const char*)g.Bt + (size_t)nxt.pn * tstep : cB;
        for (int t = 0; t < nt; t += 2) {
            const bool last = (t == nt - 2);
            const char* a1 = cA + (size_t)(t + 1) * kstep;
            const char* a2 = last ? nA : cA + (size_t)(t + 2) * kstep; const char* b2 = last ? nB : cB + (size_t)(t + 2) * kstep;
            const char* a3 = a2 + kstep; const char* b3 = b2 + kstep;
            if (last && has_next) S.a_ready(nxt);
            if constexpr (Epi::MIDSCALE) { if (t == nt / 2) E.midscale(acc, cur, wr, fr); }
            PG8_LDB(B0, 0, 0); PG8_SCHED; PG8_LDA(At, 0, 0); PG8_STAGE(PG8_SA(1, 1), a1 + hstep, voffA);
            PG8_WAIT_L(8); PG8_BAR; PG8_WAIT_L(0); PG8_MMA(0, 0, At, B0); PG8_BAR; PG8_SCHED;
            PG8_LDB(B1, 0, 1); PG8_STAGE(PG8_SB(0, 0), b2, voffB);
            PG8_BAR; PG8_WAIT_L(0); PG8_MMA(0, 1, At, B1); PG8_BAR;
            PG8_LDA(At, 0, 1); PG8_STAGE(PG8_SA(0, 0), a2, voffA);
            PG8_BAR; PG8_WAIT_L(0); PG8_MMA(1, 0, At, B0); PG8_BAR; PG8_SCHED;
            PG8_STAGE(PG8_SB(0, 1), b2 + hstep, voffB);
            PG8_WAIT_V(6); PG8_BAR; PG8_MMA(1, 1, At, B1); PG8_BAR;
            PG8_LDB(B0, 1, 0); PG8_SCHED; PG8_LDA(At, 1, 0); PG8_STAGE(PG8_SA(0, 1), a2 + hstep, voffA);
            PG8_WAIT_L(8); PG8_BAR; PG8_WAIT_L(0); PG8_MMA(0, 0, At, B0); PG8_BAR; PG8_SCHED;
            PG8_LDB(B1, 1, 1); PG8_STAGE(PG8_SB(1, 0), b3, voffB);
            PG8_BAR; PG8_WAIT_L(0); PG8_MMA(0, 1, At, B1); PG8_BAR;
            PG8_LDA(At, 1, 1); PG8_STAGE(PG8_SA(1, 0), a3, voffA);
            PG8_BAR; PG8_WAIT_L(0); PG8_MMA(1, 0, At, B0); PG8_BAR; PG8_SCHED;
            PG8_STAGE(PG8_SB(1, 1), b3 + hstep, voffB);
            PG8_WAIT_V(6); PG8_BAR; PG8_MMA(1, 1, At, B1); PG8_BAR;
        }
        PG8_STAMP();
        if constexpr (!Epi::AFTER_DRAIN) { E(acc, cur, wr, wc, fr, fq); S.done(cur); }
        PG8_STAMP();
        if (!has_next) break;
#pragma unroll
        for (int a = 0; a < 2; ++a)
#pragma unroll
            for (int b = 0; b < 2; ++b)
#pragma unroll
                for (int m = 0; m < 4; ++m)
#pragma unroll
                    for (int n = 0; n < 2; ++n) acc[a][b][m][n] = (f32x4){0.f, 0.f, 0.f, 0.f};
        cur = nxt; cA = nA; cB = nB; ++ui;
    }
    PG8_WAIT_V(0);
    if (wr == 0) PG8_BAR;
    PG8_BAR;
    if constexpr (Epi::AFTER_DRAIN) { E.fused(acc, cur, wr, wc, fr, fq, lds, wid, lane); S.done(cur); }
    PG8_STAMP();
    if (STAMP && wid == 0) { stamps[lane] = lane < nts ? (((unsigned long long)(unsigned)ts_hi << 32) | (unsigned)ts_lo) : 0ull;
        if (lane == 62) stamps[62] = rt_entry; if (lane == 63) stamps[63] = (unsigned long long)wall_clock64(); }
#undef PG8_STAMP
#undef PG8_SA
#undef PG8_SB
#undef PG8_STAGE
#undef PG8_LDA
#undef PG8_LDB
#undef PG8_MMA
#undef PG8_WAIT_V
#undef PG8_WAIT_L
#undef PG8_BAR
#undef PG8_SCHED
}

__device__ __forceinline__ unsigned pk_bf16(float lo, float hi) { typedef float v2f __attribute__((ext_vector_type(2))); typedef __bf16 v2b __attribute__((ext_vector_type(2))); const v2f v = {lo, hi}; return __builtin_bit_cast(unsigned, __builtin_convertvector(v, v2b)); }
__device__ __forceinline__ float silu1(float x) { return x * __builtin_amdgcn_rcpf(1.0f + __expf(-x)); }
struct EpiBf16Act {
    static constexpr bool PERM = true, AFTER_DRAIN = false, MIDSCALE = false;
    bf16_t* O; int ldc; unsigned silu_mask;
    __device__ __forceinline__ void operator()(const f32x4 (&acc)[2][2][4][2], const Unit& u, int wr, int wc, int fr, int fq) const {
        const int row0 = u.pm * BM + wr * 64 + fr, col0 = u.pn * BM + wc * 32 + 8 * fq;
        const bool act = (silu_mask >> u.pn) & 1u;
#pragma unroll
        for (int ai = 0; ai < 2; ++ai)
#pragma unroll
            for (int m = 0; m < 4; ++m) { bf16_t* rowp = O + (size_t)(row0 + ai * HALF + m * 16) * ldc + col0;
#pragma unroll
                for (int bj = 0; bj < 2; ++bj) { f32x4 v0 = acc[ai][bj][m][0], v1 = acc[ai][bj][m][1];
                    if (act) {
#pragma unroll
                        for (int j = 0; j < 4; ++j) { v0[j] = silu1(v0[j]); v1[j] = silu1(v1[j]); } }
                    u32x4 w; w.x = pk_bf16(v0[0], v0[1]); w.y = pk_bf16(v0[2], v0[3]); w.z = pk_bf16(v1[0], v1[1]); w.w = pk_bf16(v1[2], v1[3]);
                    *(u32x4*)(rowp + bj * HALF) = w; } }
    }
};
struct EpiProj {
    static constexpr bool PERM = true, AFTER_DRAIN = false, MIDSCALE = false;
    bf16_t* O; bf16_t* HQ; bf16_t* HK; float* HG; const float* LB;
    __device__ __forceinline__ void operator()(const f32x4 (&acc)[2][2][4][2], const Unit& u, int wr, int wc, int fr, int fq) const {
        if (u.pn >= 4) {
            const int row0 = u.pm * BM + wr * 64 + fr, col0 = u.pn * BM + wc * 32 + 8 * fq;
            const bool act = (u.pn == 6) || (u.pn == 7);
#pragma unroll
            for (int ai = 0; ai < 2; ++ai)
#pragma unroll
                for (int m = 0; m < 4; ++m) { bf16_t* rowp = O + (size_t)(row0 + ai * HALF + m * 16) * 2560 + col0;
#pragma unroll
                    for (int bj = 0; bj < 2; ++bj) { f32x4 v0 = acc[ai][bj][m][0], v1 = acc[ai][bj][m][1];
                        if (act) {
#pragma unroll
                            for (int j = 0; j < 4; ++j) { v0[j] = silu1(v0[j]); v1[j] = silu1(v1[j]); } }
                        u32x4 w; w.x = pk_bf16(v0[0], v0[1]); w.y = pk_bf16(v0[2], v0[3]); w.z = pk_bf16(v1[0], v1[1]); w.w = pk_bf16(v1[2], v1[3]);
                        *(u32x4*)(rowp + bj * HALF) = w; } }
            return;
        }
        const int hd = u.pn, bat = (u.pm * BM) / 2048, cb = (u.pm & 7) * 8, k0 = wc * 32 + 8 * fq, lane = fq * 16 + fr;
        float lb[8];
        { const f32x4 l0 = *(const f32x4*)(LB + hd * 128 + k0), l1 = *(const f32x4*)(LB + hd * 128 + k0 + 4);
          lb[0] = l0[0]; lb[1] = l0[1]; lb[2] = l0[2]; lb[3] = l0[3]; lb[4] = l1[0]; lb[5] = l1[1]; lb[6] = l1[2]; lb[7] = l1[3]; }
#pragma unroll
        for (int ac = 0; ac < 4; ++ac) {
            const int ai = ac >> 1, cp = ac & 1;
            __builtin_amdgcn_sched_barrier(0);
            const size_t tile = ((size_t)(bat * 4 + hd) * 64 + cb + 4 * ai + 2 * wr + cp);
#pragma unroll
            for (int eh = 0; eh < 2; ++eh) {
                __builtin_amdgcn_sched_barrier(0);
                float tot0[4];
                bf16_t* hq = HQ + tile * 4096 + k0 + 4 * eh;
                bf16_t* hk = HK + tile * 4096 + k0 + 4 * eh;
#pragma unroll
                for (int mm = 0; mm < 2; ++mm) {
                    const f32x4 q4 = acc[ai][0][2 * cp + mm][eh], f4 = acc[ai][1][2 * cp + mm][eh];
                    float qo[4], ko[4], bl[4];
#pragma unroll
                    for (int e = 0; e < 4; ++e) {
                        const float lbe = lb[4 * eh + e];
                        const float f = lbe + (1.0f - lbe) * __builtin_amdgcn_rcpf(1.0f + __expf(-f4[e]));
                        float sc = __logf(f);
                        sc += __builtin_bit_cast(float, __builtin_amdgcn_update_dpp(0, __builtin_bit_cast(int, sc), 0x111, 0xf, 0xf, true));
                        sc += __builtin_bit_cast(float, __builtin_amdgcn_update_dpp(0, __builtin_bit_cast(int, sc), 0x112, 0xf, 0xf, true));
                        sc += __builtin_bit_cast(float, __builtin_amdgcn_update_dpp(0, __builtin_bit_cast(int, sc), 0x114, 0xf, 0xf, true));
                        sc += __builtin_bit_cast(float, __builtin_amdgcn_update_dpp(0, __builtin_bit_cast(int, sc), 0x118, 0xf, 0xf, true));
                        if (mm == 1) sc += tot0[e];
                        bl[e] = sc;
                        qo[e] = silu1(q4[e]) * __expf(sc); ko[e] = (1.0f - f) * __expf(fminf(-sc, 80.0f));
                    }
                    *(uint2*)(hq + (size_t)(mm * 16 + fr) * 128) = make_uint2(pk_bf16(qo[0], qo[1]), pk_bf16(qo[2], qo[3]));
                    *(uint2*)(hk + (size_t)(mm * 16 + fr) * 128) = make_uint2(pk_bf16(ko[0], ko[1]), pk_bf16(ko[2], ko[3]));
                    if (mm == 0) {
#pragma unroll
                        for (int e = 0; e < 4; ++e) tot0[e] = __shfl(bl[e], (lane & 48) | 15);
                    } else if (fr == 15) *(f32x4*)(HG + tile * 128 + k0 + 4 * eh) = (f32x4){__expf(bl[0]), __expf(bl[1]), __expf(bl[2]), __expf(bl[3])};
                    __builtin_amdgcn_sched_barrier(0);
                }
            }
        }
    }
};
struct EpiResid {
    static constexpr bool PERM = true, AFTER_DRAIN = false, MIDSCALE = true;
    bf16_t* R1; const float* X; const float* mod_g;
    static constexpr int NTOK_ = 32768;
    float alpha; bf16_t* AP; const float* avec; float* stat;
    const float* ssq; float rms_eps;
    __device__ __forceinline__ void midscale(f32x4 (&acc)[2][2][4][2], const Unit& u, int wr, int fr) const {
        const float* sp = ssq + u.pm * BM + wr * 64 + fr;
#pragma unroll
        for (int ai = 0; ai < 2; ++ai)
#pragma unroll
            for (int m = 0; m < 4; ++m) {
                const float rs = rsqrtf(sp[ai * HALF + m * 16] * (1.0f / 512.0f) + rms_eps);
#pragma unroll
                for (int bj = 0; bj < 2; ++bj)
#pragma unroll
                    for (int n = 0; n < 2; ++n) acc[ai][bj][m][n] *= rs;
            }
    }
    __device__ __forceinline__ void operator()(const f32x4 (&acc)[2][2][4][2], const Unit& u, int wr, int wc, int fr, int fq) const {
        const int row0 = u.pm * BM + wr * 64 + fr, col0 = u.pn * BM + wc * 32 + 8 * fq, bat = (u.pm * BM) / 2048;
        const float* gb = mod_g + (size_t)bat * 6144 + col0;
        const float* ab = avec + (size_t)bat * 1024 + col0;
        float s1[2][4], s2[2][4];
#pragma unroll
        for (int ai = 0; ai < 2; ++ai)
#pragma unroll
            for (int m = 0; m < 4; ++m) { s1[ai][m] = 0.f; s2[ai][m] = 0.f; }
        f32x4 xq[2][2];
        const unsigned robase = (unsigned)row0 * 1024u + (unsigned)col0;
#define RESID_RO(G_) (robase + (unsigned)((((G_) >> 2) & 1) * HALF + ((G_) & 3) * 16) * 1024u + (unsigned)(((G_) >> 3) * HALF))
#define RESID_LOADX(G_, S_) { const unsigned bo_ = RESID_RO(G_) << 2; xq[S_][0] = *(const f32x4*)((const char*)X + bo_); xq[S_][1] = *(const f32x4*)((const char*)X + bo_ + 16); }
        RESID_LOADX(0, 0);
#pragma unroll
        for (int bj = 0; bj < 2; ++bj) {
            const f32x4 g0 = *(const f32x4*)(gb + bj * HALF) + 1.0f, g1 = *(const f32x4*)(gb + bj * HALF + 4) + 1.0f;
            const f32x4 a0 = *(const f32x4*)(ab + bj * HALF), a1 = *(const f32x4*)(ab + bj * HALF + 4);
#pragma unroll
            for (int sub = 0; sub < 8; ++sub) {
                const int grp = bj * 8 + sub, ai = sub >> 2, m = sub & 3;
                if (grp + 1 < 16) { if ((grp & 1) == 0) RESID_LOADX(grp + 1, 1) else RESID_LOADX(grp + 1, 0) }
                {
                    const unsigned bo = RESID_RO(grp) << 1;
                    const f32x4 x0 = xq[grp & 1][0], x1 = xq[grp & 1][1];
                    const f32x4 r0 = alpha * x0 + g0 * acc[ai][bj][m][0], r1 = alpha * x1 + g1 * acc[ai][bj][m][1];
                    u32x4 w; w.x = pk_bf16(r0[0], r0[1]); w.y = pk_bf16(r0[2], r0[3]); w.z = pk_bf16(r1[0], r1[1]); w.w = pk_bf16(r1[2], r1[3]);
                    *(u32x4*)((char*)R1 + bo) = w;
                    const f32x4 p0 = r0 * a0, p1 = r1 * a1;
                    w.x = pk_bf16(p0[0], p0[1]); w.y = pk_bf16(p0[2], p0[3]); w.z = pk_bf16(p1[0], p1[1]); w.w = pk_bf16(p1[2], p1[3]);
                    *(u32x4*)((char*)AP + bo) = w;
                    s1[ai][m] += ((r0[0] + r0[1]) + (r0[2] + r0[3])) + ((r1[0] + r1[1]) + (r1[2] + r1[3]));
                    s2[ai][m] += ((r0[0] * r0[0] + r0[1] * r0[1]) + (r0[2] * r0[2] + r0[3] * r0[3])) + ((r1[0] * r1[0] + r1[1] * r1[1]) + (r1[2] * r1[2] + r1[3] * r1[3]));
                }
            }
        }
#undef RESID_LOADX
#undef RESID_RO
        const bool hi5 = fq & 2, hi4 = fq & 1;
#pragma unroll
        for (int ai = 0; ai < 2; ++ai) {
            const float a1 = (hi5 ? s1[ai][2] : s1[ai][0]) + __shfl_xor(hi5 ? s1[ai][0] : s1[ai][2], 32), b1 = (hi5 ? s1[ai][3] : s1[ai][1]) + __shfl_xor(hi5 ? s1[ai][1] : s1[ai][3], 32);
            const float a2 = (hi5 ? s2[ai][2] : s2[ai][0]) + __shfl_xor(hi5 ? s2[ai][0] : s2[ai][2], 32), b2 = (hi5 ? s2[ai][3] : s2[ai][1]) + __shfl_xor(hi5 ? s2[ai][1] : s2[ai][3], 32);
            const float t1 = (hi4 ? b1 : a1) + __shfl_xor(hi4 ? a1 : b1, 16), t2 = (hi4 ? b2 : a2) + __shfl_xor(hi4 ? a2 : b2, 16);
            const int srow = u.pm * BM + wr * 64 + ai * HALF + fq * 16 + fr;
            atomicAdd(stat + srow, t1); atomicAdd(stat + NTOK_ + srow, t2);
        }
    }
};
struct EpiQLN {
    static constexpr bool PERM = true, AFTER_DRAIN = false, MIDSCALE = false;
    bf16_t* O; const float* stat; const float* ca; const float* cb; float eps;
    __device__ __forceinline__ void operator()(const f32x4 (&acc)[2][2][4][2], const Unit& u, int wr, int wc, int fr, int fq) const {
        const int row0 = u.pm * BM + wr * 64 + fr, col0 = u.pn * BM + wc * 32 + 8 * fq, bat = (u.pm * BM) / 2048;
        const float* cap = ca + (size_t)bat * 2048 + col0;
        const float* cbp = cb + (size_t)bat * 2048 + col0;
        float s1[2][4], s2[2][4];
#pragma unroll
        for (int ai = 0; ai < 2; ++ai)
#pragma unroll
            for (int m = 0; m < 4; ++m) { const int row = row0 + ai * HALF + m * 16; s1[ai][m] = stat[row]; s2[ai][m] = stat[32768 + row]; }
        f32x4 av[2][2], bv[2][2];
#pragma unroll
        for (int bj = 0; bj < 2; ++bj) { av[bj][0] = *(const f32x4*)(cap + bj * HALF); av[bj][1] = *(const f32x4*)(cap + bj * HALF + 4); bv[bj][0] = *(const f32x4*)(cbp + bj * HALF); bv[bj][1] = *(const f32x4*)(cbp + bj * HALF + 4); }
#pragma unroll
        for (int ai = 0; ai < 2; ++ai)
#pragma unroll
            for (int m = 0; m < 4; ++m) {
                const int row = row0 + ai * HALF + m * 16;
                const float mu = s1[ai][m] * (1.0f / 1024.0f), rstd = rsqrtf(fmaxf(s2[ai][m] * (1.0f / 1024.0f) - mu * mu, 0.f) + eps);
#pragma unroll
                for (int bj = 0; bj < 2; ++bj) {
                    const f32x4 v0 = rstd * (acc[ai][bj][m][0] - mu * av[bj][0]) + bv[bj][0], v1 = rstd * (acc[ai][bj][m][1] - mu * av[bj][1]) + bv[bj][1];
                    u32x4 w; w.x = pk_bf16(v0[0], v0[1]); w.y = pk_bf16(v0[2], v0[3]); w.z = pk_bf16(v1[0], v1[1]); w.w = pk_bf16(v1[2], v1[3]);
                    *(u32x4*)((char*)O + (((unsigned)row * 2048u + (unsigned)(col0 + bj * HALF)) << 1)) = w;
                }
            }
    }
};
struct EpiGluA2 {
    static constexpr bool PERM = true, AFTER_DRAIN = false, MIDSCALE = false;
    bf16_t* A2; const bf16_t* Y; const float* bias; const float* nw; float* ssq;
    __device__ __forceinline__ void operator()(const f32x4 (&acc)[2][2][4][2], const Unit& u, int wr, int wc, int fr, int fq) const {
        const int row0 = u.pm * BM + wr * 64 + fr, col0 = u.pn * BM + wc * 32 + 8 * fq;
        float s2[2][4];
#pragma unroll
        for (int ai = 0; ai < 2; ++ai)
#pragma unroll
            for (int m = 0; m < 4; ++m) s2[ai][m] = 0.f;
#pragma unroll
        for (int bj = 0; bj < 2; ++bj) {
            const f32x4 bv0 = *(const f32x4*)(bias + col0 + bj * HALF), bv1 = *(const f32x4*)(bias + col0 + bj * HALF + 4);
            const f32x4 wv0 = *(const f32x4*)(nw + col0 + bj * HALF), wv1 = *(const f32x4*)(nw + col0 + bj * HALF + 4);
#pragma unroll
            for (int ai = 0; ai < 2; ++ai) {
                u32x4 yv[4];
#pragma unroll
                for (int m = 0; m < 4; ++m) yv[m] = *(const u32x4*)((const char*)Y + (((unsigned)(row0 + ai * HALF + m * 16) * 512u + (unsigned)(col0 + bj * HALF)) << 1));
#pragma unroll
                for (int m = 0; m < 4; ++m) { const int row = row0 + ai * HALF + m * 16;
                    const u32x4 yw = yv[m];
                    const f32x4 z0 = acc[ai][bj][m][0] + bv0, z1 = acc[ai][bj][m][1] + bv1;
                    f32x4 o0, o1;
                    o0[0] = __uint_as_float(yw.x << 16) * __builtin_amdgcn_rcpf(1.0f + __expf(-z0[0])); o0[1] = __uint_as_float(yw.x & 0xffff0000u) * __builtin_amdgcn_rcpf(1.0f + __expf(-z0[1]));
                    o0[2] = __uint_as_float(yw.y << 16) * __builtin_amdgcn_rcpf(1.0f + __expf(-z0[2])); o0[3] = __uint_as_float(yw.y & 0xffff0000u) * __builtin_amdgcn_rcpf(1.0f + __expf(-z0[3]));
                    o1[0] = __uint_as_float(yw.z << 16) * __builtin_amdgcn_rcpf(1.0f + __expf(-z1[0])); o1[1] = __uint_as_float(yw.z & 0xffff0000u) * __builtin_amdgcn_rcpf(1.0f + __expf(-z1[1]));
                    o1[2] = __uint_as_float(yw.w << 16) * __builtin_amdgcn_rcpf(1.0f + __expf(-z1[2])); o1[3] = __uint_as_float(yw.w & 0xffff0000u) * __builtin_amdgcn_rcpf(1.0f + __expf(-z1[3]));
                    s2[ai][m] += (o0[0] * o0[0] + o0[1] * o0[1]) + (o0[2] * o0[2] + o0[3] * o0[3]) + (o1[0] * o1[0] + o1[1] * o1[1]) + (o1[2] * o1[2] + o1[3] * o1[3]);
                    const f32x4 p0 = o0 * wv0, p1 = o1 * wv1;
                    u32x4 w; w.x = pk_bf16(p0[0], p0[1]); w.y = pk_bf16(p0[2], p0[3]); w.z = pk_bf16(p1[0], p1[1]); w.w = pk_bf16(p1[2], p1[3]);
                    *(u32x4*)((char*)A2 + (((unsigned)row * 1024u + (unsigned)(col0 + bj * HALF)) << 1)) = w;
                }
            }
        }
        const bool hi5 = fq & 2, hi4 = fq & 1;
#pragma unroll
        for (int ai = 0; ai < 2; ++ai) {
            const float a2 = (hi5 ? s2[ai][2] : s2[ai][0]) + __shfl_xor(hi5 ? s2[ai][0] : s2[ai][2], 32), b2 = (hi5 ? s2[ai][3] : s2[ai][1]) + __shfl_xor(hi5 ? s2[ai][1] : s2[ai][3], 32);
            const float t2 = (hi4 ? b2 : a2) + __shfl_xor(hi4 ? a2 : b2, 16);
            atomicAdd(ssq + u.pm * BM + wr * 64 + ai * HALF + fq * 16 + fr, t2);
        }
    }
};
}

DI void prep_mod_item(const Params& p, int item, char* smem) {
    float* condT = (float*)smem;
    float* red = condT + DM * 16;
    const int tid = my_tid();
    for (int i = tid; i < NB * DM; i += NTH) { const int b = i >> 10, k = i & 1023; condT[k * 16 + b] = siluf_(p.c[i]); }
    __syncthreads();
    const int ks = tid >> 5, col = tid & 31;
    float acc[16];
#pragma unroll
    for (int b = 0; b < 16; ++b) acc[b] = 0.f;
    const float* w = p.ada_w + (size_t)(ks * 64) * 6144 + item * 32 + col;
#pragma unroll 1
    for (int seg = 0; seg < 4; ++seg) {
        float wreg[16];
#pragma unroll
        for (int k = 0; k < 16; ++k) wreg[k] = w[(size_t)(seg * 16 + k) * 6144];
#pragma unroll
        for (int k = 0; k < 16; ++k) {
            const float wv = wreg[k];
            const f32x4* cb = (const f32x4*)(condT + (ks * 64 + seg * 16 + k) * 16);
            const f32x4 c0 = cb[0], c1 = cb[1], c2 = cb[2], c3 = cb[3];
            acc[0] += c0.x * wv; acc[1] += c0.y * wv; acc[2] += c0.z * wv; acc[3] += c0.w * wv;
            acc[4] += c1.x * wv; acc[5] += c1.y * wv; acc[6] += c1.z * wv; acc[7] += c1.w * wv;
            acc[8] += c2.x * wv; acc[9] += c2.y * wv; acc[10] += c2.z * wv; acc[11] += c2.w * wv;
            acc[12] += c3.x * wv; acc[13] += c3.y * wv; acc[14] += c3.z * wv; acc[15] += c3.w * wv;
        }
    }
#pragma unroll
    for (int b = 0; b < 16; ++b) red[(ks * 32 + col) * 16 + b] = acc[b];
    __syncthreads();
    {
        const int b = tid >> 5;
        float sum = p.ada_b[item * 32 + col];
#pragma unroll
        for (int q = 0; q < 16; ++q) sum += red[(q * 32 + col) * 16 + b];
        ((float*)(p.ws + OFF_MOD))[b * 6144 + item * 32 + col] = sum;
    }
    __syncthreads();
}
DI void prep_s5_gemm_item(const Params& p, int g, int part, char* smem) {
    f32x2* pw = (f32x2*)smem;
    f32x2* bbL = pw + 17 * 64;
    f32x2* cL = bbL + 64 * 16;
    const int tid = my_tid();
    const float dt = expf(p.log_dt[g]);
#pragma unroll 1
    for (int idx = tid; idx < 17 * 64; idx += NTH) {
        const int j = idx >> 6, pp = idx & 63;
        const float ar = p.a_re[g * 64 + pp], ai = p.a_im[g * 64 + pp];
        const float mag = expf(ar * dt * (float)j), ang = ai * dt * (float)j;
        pw[idx] = (f32x2){mag * cosf(ang), mag * sinf(ang)};
    }
    for (int idx = tid; idx < 16 * 64; idx += NTH) { const int i = idx >> 6, pp = idx & 63; cL[idx] = (f32x2){p.c_re[(g * 16 + i) * 64 + pp], p.c_im[(g * 16 + i) * 64 + pp]}; }
    __syncthreads();
    for (int idx = tid; idx < 64 * 16; idx += NTH) {
        const int pp = idx >> 4, i = idx & 15;
        const float ar = p.a_re[g * 64 + pp], ai = p.a_im[g * 64 + pp];
        const f32x2 lam = pw[64 + pp];
        const float den = ar * ar + ai * ai, nr = lam.x - 1.0f, ni = lam.y;
        const float zr = (nr * ar + ni * ai) / den, zi = (ni * ar - nr * ai) / den;
        const float br = p.b_re[(g * 64 + pp) * 16 + i], bi = p.b_im[(g * 64 + pp) * 16 + i];
        bbL[idx] = (f32x2){zr * br - zi * bi, zr * bi + zi * br};
    }
    __syncthreads();
    bf16_t* NBg = (bf16_t*)(p.ws + OFF_S5N) + (size_t)g * 128 * 256;
    if (part == 0)
#pragma unroll 1
    for (int ch = tid; ch < 128 * 256 / 8; ch += NTH) {
        const int pq = ch >> 5, t = (ch >> 1) & 15, i0 = (ch & 1) * 8, pp = pq & 63;
        const f32x2 w = pw[(15 - t) * 64 + pp];
        float v[8];
#pragma unroll
        for (int e = 0; e < 8; ++e) { const f32x2 bb = bbL[pp * 16 + i0 + e]; v[e] = pq < 64 ? (w.x * bb.x - w.y * bb.y) : (w.x * bb.y + w.y * bb.x); }
        u32x4 o; o.x = pack2(v[0], v[1]); o.y = pack2(v[2], v[3]); o.z = pack2(v[4], v[5]); o.w = pack2(v[6], v[7]);
        *(u32x4*)(NBg + (size_t)((((pq >> 5) * 16 + t) * 64) + (i0 >> 3) * 32 + (pq & 31)) * 8) = o;
    }
    bf16_t* MBg = (bf16_t*)(p.ws + OFF_S5M) + (size_t)g * 256 * 128;
    if (part == 1)
#pragma unroll 1
    for (int ch = tid; ch < 256 * 128 / 8; ch += NTH) {
        const int ti = ch >> 4, p0 = (ch & 15) * 8, tq = ti >> 4, iq = ti & 15;
        float v[8];
#pragma unroll
        for (int e = 0; e < 8; ++e) {
            const int pq = p0 + e, pp = pq & 63;
            const f32x2 c = cL[iq * 64 + pp], w = pw[(tq + 1) * 64 + pp];
            v[e] = pq < 64 ? (c.x * w.x - c.y * w.y) : -(c.x * w.y + c.y * w.x);
        }
        u32x4 o; o.x = pack2(v[0], v[1]); o.y = pack2(v[2], v[3]); o.z = pack2(v[4], v[5]); o.w = pack2(v[6], v[7]);
        *(u32x4*)(MBg + (size_t)((((ti >> 5) * 8 + (p0 >> 4)) * 64) + ((p0 >> 3) & 1) * 32 + (ti & 31)) * 8) = o;
    }
    bf16_t* KTg = (bf16_t*)(p.ws + OFF_S5K) + (size_t)g * 4096;
    if (part >= 2)
#pragma unroll 1
    for (int idx = (part - 2) * 2048 + tid; idx < (part - 1) * 2048; idx += NTH) {
        const int lag = idx >> 8, iq = (idx >> 4) & 15, i = idx & 15;
        float acc = (lag == 0 && iq == i) ? p.dsk[g * 16 + iq] : 0.f;
#pragma unroll 4
        for (int pp = 0; pp < 64; ++pp) {
            const f32x2 c = cL[iq * 64 + pp], w = pw[lag * 64 + pp], bb = bbL[pp * 16 + i];
            const float mr = c.x * w.x - c.y * w.y, mi_ = c.x * w.y + c.y * w.x;
            acc += mr * bb.x - mi_ * bb.y;
        }
        KTg[idx] = f2bf(acc);
    }
    if (part == 3 && tid < 64) { float* L = (float*)(p.ws + OFF_S5L) + (g * 64 + tid) * 2; const f32x2 w = pw[16 * 64 + tid]; L[0] = w.x; L[1] = w.y; }
    __syncthreads();
}
DI void prep_s5_item(const Params& p, int g) {
    const int tid = my_tid();
    if (tid < SSP) {
        const int pi = g * SSP + tid;
        const float dt = expf(p.log_dt[g]);
        const float ar = p.a_re[pi], ai = p.a_im[pi];
        const float mag = expf(ar * dt);
        const float lr = mag * cosf(ai * dt), li = mag * sinf(ai * dt);
        const float den = ar * ar + ai * ai, nr = lr - 1.0f, ni = li;
        const float zr = (nr * ar + ni * ai) / den, zi = (ni * ar - nr * ai) / den;
        float* lam = (float*)(p.ws + OFF_LAM) + pi * 2;
        lam[0] = lr; lam[1] = li;
        float* bb = (float*)(p.ws + OFF_BB) + (size_t)pi * 32;
        for (int i = 0; i < SSC; ++i) {
            const float br = p.b_re[pi * SSC + i], bi = p.b_im[pi * SSC + i];
            bb[i * 2] = zr * br - zi * bi; bb[i * 2 + 1] = zr * bi + zi * br;
        }
    }
}
DI void prep_transpose_tile(const float* __restrict__ W, bf16_t* __restrict__ Wt, int K, int N, int kt, int nt, char* smem, int dst_row0 = -1, int kswap = 0) {
    float* tile = (float*)smem;
    const int tid = my_tid();
#pragma unroll
    for (int q = 0; q < 2; ++q) {
        const int kk = (tid >> 4) + q * 32, c4 = (tid & 15) * 4;
        const float4 v = *(const float4*)(W + (size_t)(kt * 64 + kk) * N + nt * 64 + c4);
        tile[kk * 65 + c4] = v.x; tile[kk * 65 + c4 + 1] = v.y; tile[kk * 65 + c4 + 2] = v.z; tile[kk * 65 + c4 + 3] = v.w;
    }
    __syncthreads();
    const int n = tid >> 3, kc = tid & 7;
    uint4 o;
    o.x = pack2(tile[(kc * 8 + 0) * 65 + n], tile[(kc * 8 + 1) * 65 + n]);
    o.y = pack2(tile[(kc * 8 + 2) * 65 + n], tile[(kc * 8 + 3) * 65 + n]);
    o.z = pack2(tile[(kc * 8 + 4) * 65 + n], tile[(kc * 8 + 5) * 65 + n]);
    o.w = pack2(tile[(kc * 8 + 6) * 65 + n], tile[(kc * 8 + 7) * 65 + n]);
    *(uint4*)(Wt + (size_t)((dst_row0 < 0 ? nt * 64 : dst_row0) + n) * K + ((kt * 64 + kswap) & (K - 1)) + kc * 8) = o;
    __syncthreads();
}
DI void cvt_bf16_stream(const float* __restrict__ src, bf16_t* __restrict__ dst, size_t n8, int bid, int nb) {
    for (size_t i = (size_t)bid * NTH + my_tid(); i < n8; i += (size_t)nb * NTH) {
        const float4 a = *(const float4*)(src + i * 8), b = *(const float4*)(src + i * 8 + 4);
        uint4 o; o.x = pack2(a.x, a.y); o.y = pack2(a.z, a.w); o.z = pack2(b.x, b.y); o.w = pack2(b.z, b.w);
        *(uint4*)(dst + i * 8) = o;
    }
}
DI void cvt_fp8_rows(const float* __restrict__ src, unsigned char* __restrict__ dst, float* __restrict__ inv, int bid, int nb) {
    const int lane = my_tid() & 63, wid = my_tid() >> 6;
    for (int row = bid * 8 + wid; row < NEXP; row += nb * 8) {
        const float* sp = src + (size_t)row * DM + lane * 16;
        const f32x4 a = *(const f32x4*)sp, b = *(const f32x4*)(sp + 4), c = *(const f32x4*)(sp + 8), d = *(const f32x4*)(sp + 12);
        float m = fmaxf(fmaxf(fmaxf(fabsf(a.x), fabsf(a.y)), fmaxf(fabsf(a.z), fabsf(a.w))), fmaxf(fmaxf(fabsf(b.x), fabsf(b.y)), fmaxf(fabsf(b.z), fabsf(b.w))));
        m = fmaxf(m, fmaxf(fmaxf(fmaxf(fabsf(c.x), fabsf(c.y)), fmaxf(fabsf(c.z), fabsf(c.w))), fmaxf(fmaxf(fabsf(d.x), fabsf(d.y)), fmaxf(fabsf(d.z), fabsf(d.w)))));
#pragma unroll
        for (int s = 1; s < 64; s <<= 1) m = fmaxf(m, __shfl_xor(m, s));
        float sc = 1.f, isc = 1.f;
        if (m > 1e-30f) {
            int k = (int)floorf(log2f(448.0f / m));
            k = k < -60 ? -60 : (k > 60 ? 60 : k);
            sc = ldexpf(1.0f, k); isc = ldexpf(1.0f, -k);
            if (m * sc > 448.0f) { sc *= 0.5f; isc *= 2.0f; }
        }
        u32x4 o;
        int w;
        w = __builtin_amdgcn_cvt_pk_fp8_f32(a.x * sc, a.y * sc, 0, false); w = __builtin_amdgcn_cvt_pk_fp8_f32(a.z * sc, a.w * sc, w, true); o.x = (unsigned)w;
        w = __builtin_amdgcn_cvt_pk_fp8_f32(b.x * sc, b.y * sc, 0, false); w = __builtin_amdgcn_cvt_pk_fp8_f32(b.z * sc, b.w * sc, w, true); o.y = (unsigned)w;
        w = __builtin_amdgcn_cvt_pk_fp8_f32(c.x * sc, c.y * sc, 0, false); w = __builtin_amdgcn_cvt_pk_fp8_f32(c.z * sc, c.w * sc, w, true); o.z = (unsigned)w;
        w = __builtin_amdgcn_cvt_pk_fp8_f32(d.x * sc, d.y * sc, 0, false); w = __builtin_amdgcn_cvt_pk_fp8_f32(d.z * sc, d.w * sc, w, true); o.w = (unsigned)w;
        *(u32x4*)(dst + (size_t)row * DM + lane * 16) = o;
        if (lane == 0) inv[row] = isc;
    }
}
DI void cvt_fp4_rows(const float* __restrict__ src, unsigned char* __restrict__ dst, float* __restrict__ inv, int bid, int nb) {
    const int lane = my_tid() & 63, wid = my_tid() >> 6;
    for (int row = bid * 8 + wid; row < NEXP; row += nb * 8) {
        const float* sp = src + (size_t)row * DM + lane * 16;
        const f32x4 a = *(const f32x4*)sp, b = *(const f32x4*)(sp + 4), c = *(const f32x4*)(sp + 8), d = *(const f32x4*)(sp + 12);
        float m = fmaxf(fmaxf(fmaxf(fabsf(a.x), fabsf(a.y)), fmaxf(fabsf(a.z), fabsf(a.w))), fmaxf(fmaxf(fabsf(b.x), fabsf(b.y)), fmaxf(fabsf(b.z), fabsf(b.w))));
        m = fmaxf(m, fmaxf(fmaxf(fmaxf(fabsf(c.x), fabsf(c.y)), fmaxf(fabsf(c.z), fabsf(c.w))), fmaxf(fmaxf(fabsf(d.x), fabsf(d.y)), fmaxf(fabsf(d.z), fabsf(d.w)))));
#pragma unroll
        for (int s = 1; s < 64; s <<= 1) m = fmaxf(m, __shfl_xor(m, s));
        const float sc = m > 1e-30f ? 6.0f / m : 1.0f, isc = m > 1e-30f ? m * (1.0f / 6.0f) : 1.0f;
        unsigned w0 = 0u, w1 = 0u;
        w0 = __builtin_amdgcn_cvt_scalef32_pk_fp4_f32(w0, a.x * sc, a.y * sc, 1.0f, 0); w0 = __builtin_amdgcn_cvt_scalef32_pk_fp4_f32(w0, a.z * sc, a.w * sc, 1.0f, 1);
        w0 = __builtin_amdgcn_cvt_scalef32_pk_fp4_f32(w0, b.x * sc, b.y * sc, 1.0f, 2); w0 = __builtin_amdgcn_cvt_scalef32_pk_fp4_f32(w0, b.z * sc, b.w * sc, 1.0f, 3);
        w1 = __builtin_amdgcn_cvt_scalef32_pk_fp4_f32(w1, c.x * sc, c.y * sc, 1.0f, 0); w1 = __builtin_amdgcn_cvt_scalef32_pk_fp4_f32(w1, c.z * sc, c.w * sc, 1.0f, 1);
        w1 = __builtin_amdgcn_cvt_scalef32_pk_fp4_f32(w1, d.x * sc, d.y * sc, 1.0f, 2); w1 = __builtin_amdgcn_cvt_scalef32_pk_fp4_f32(w1, d.z * sc, d.w * sc, 1.0f, 3);
        *(uint2*)(dst + (size_t)row * (DM / 2) + lane * 8) = make_uint2(w0, w1);
        if (lane == 0) inv[row] = isc;
    }
}
template <int OFFS>
DI void cvt_i8_rows(const float* __restrict__ src, unsigned char* __restrict__ dst, float* __restrict__ inv, int bid, int nb) {
    const int lane = my_tid() & 63, wid = my_tid() >> 6;
    for (int row = bid * 8 + wid; row < NEXP; row += nb * 8) {
        const float* sp = src + (size_t)row * DM + lane * 16;
        const f32x4 a = *(const f32x4*)sp, b = *(const f32x4*)(sp + 4), c = *(const f32x4*)(sp + 8), d = *(const f32x4*)(sp + 12);
        float m = fmaxf(fmaxf(fmaxf(fabsf(a.x), fabsf(a.y)), fmaxf(fabsf(a.z), fabsf(a.w))), fmaxf(fmaxf(fabsf(b.x), fabsf(b.y)), fmaxf(fabsf(b.z), fabsf(b.w))));
        m = fmaxf(m, fmaxf(fmaxf(fmaxf(fabsf(c.x), fabsf(c.y)), fmaxf(fabsf(c.z), fabsf(c.w))), fmaxf(fmaxf(fabsf(d.x), fabsf(d.y)), fmaxf(fabsf(d.z), fabsf(d.w)))));
#pragma unroll
        for (int s = 1; s < 64; s <<= 1) m = fmaxf(m, __shfl_xor(m, s));
        const float sc = m > 1e-30f ? 127.0f / m : 1.0f, isc = m > 1e-30f ? m * (1.0f / 127.0f) : 1.0f;
        const float v[16] = {a.x, a.y, a.z, a.w, b.x, b.y, b.z, b.w, c.x, c.y, c.z, c.w, d.x, d.y, d.z, d.w};
        unsigned w[4];
#pragma unroll
        for (int q = 0; q < 4; ++q) {
            unsigned pk = 0u;
#pragma unroll
            for (int e = 0; e < 4; ++e) { const int qi = (int)rintf(v[q * 4 + e] * sc) + OFFS; pk |= ((unsigned)qi & 0xffu) << (8 * e); }
            w[q] = pk;
        }
        *(u32x4*)(dst + (size_t)row * DM + lane * 16) = (u32x4){w[0], w[1], w[2], w[3]};
        if (lane == 0) inv[row] = isc;
    }
}
DI void prep_cab_item(const Params& p, int item, char* smem) {
    float* vT = (float*)smem;
    float* red = vT + DM * 16;
    const float* mod = (const float*)(p.ws + OFF_MOD);
    const int tid = my_tid(), ks = tid >> 5, col = tid & 31;
    const float* w = p.w_q + (size_t)(ks * 64) * 2048 + item * 32 + col;
#pragma unroll 1
    for (int which = 0; which < 2; ++which) {
        for (int i = tid; i < NB * DM; i += NTH) {
            const int b = i >> 10, k = i & 1023;
            const float sc = 1.0f + mod[b * 6144 + 4096 + k];
            const float v = which == 0 ? p.ln1w[k] * sc : p.ln1b[k] * sc + mod[b * 6144 + 3072 + k];
            vT[k * 16 + b] = v;
            if (item == 0) ((float*)(p.ws + OFF_AB))[(size_t)which * NB * DM + i] = v;
        }
        __syncthreads();
        float acc[16];
#pragma unroll
        for (int b = 0; b < 16; ++b) acc[b] = 0.f;
#pragma unroll 1
        for (int seg = 0; seg < 4; ++seg) {
            float wreg[16];
#pragma unroll
            for (int k = 0; k < 16; ++k) wreg[k] = w[(size_t)(seg * 16 + k) * 2048];
#pragma unroll
            for (int k = 0; k < 16; ++k) {
                const float wv = wreg[k];
                const f32x4* cb = (const f32x4*)(vT + (ks * 64 + seg * 16 + k) * 16);
                const f32x4 c0 = cb[0], c1 = cb[1], c2 = cb[2], c3 = cb[3];
                acc[0] += c0.x * wv; acc[1] += c0.y * wv; acc[2] += c0.z * wv; acc[3] += c0.w * wv;
                acc[4] += c1.x * wv; acc[5] += c1.y * wv; acc[6] += c1.z * wv; acc[7] += c1.w * wv;
                acc[8] += c2.x * wv; acc[9] += c2.y * wv; acc[10] += c2.z * wv; acc[11] += c2.w * wv;
                acc[12] += c3.x * wv; acc[13] += c3.y * wv; acc[14] += c3.z * wv; acc[15] += c3.w * wv;
            }
        }
#pragma unroll
        for (int b = 0; b < 16; ++b) red[(ks * 32 + col) * 16 + b] = acc[b];
        __syncthreads();
        {
            const int b = tid >> 5;
            float sum = 0.f;
#pragma unroll
            for (int q = 0; q < 16; ++q) sum += red[(q * 32 + col) * 16 + b];
            ((float*)(p.ws + OFF_CAB))[(size_t)which * NB * 2048 + b * 2048 + item * 32 + col] = sum;
        }
        __syncthreads();
    }
}
DI void phase_h(const Params& p, int bid, int nb) {
    const float* mod = (const float*)(p.ws + OFF_MOD);
    bf16_t* H = (bf16_t*)(p.ws + OFF_H);
    const size_t n8 = (size_t)NTOK * DM / 8;
    for (size_t i = (size_t)bid * NTH + my_tid(); i < n8; i += (size_t)nb * NTH) {
        const int row = (int)(i >> 7), c0 = (int)(i & 127) * 8, b = row / SEQ;
        const float* sh = mod + b * 6144 + c0;
        const float* sc = sh + 1024;
        const float4 a = *(const float4*)(p.x + i * 8), bq = *(const float4*)(p.x + i * 8 + 4);
        const float4 s0 = *(const float4*)sc, s1 = *(const float4*)(sc + 4), h0 = *(const float4*)sh, h1 = *(const float4*)(sh + 4);
        uint4 o;
        o.x = pack2(a.x * (1.f + s0.x) + h0.x, a.y * (1.f + s0.y) + h0.y);
        o.y = pack2(a.z * (1.f + s0.z) + h0.z, a.w * (1.f + s0.w) + h0.w);
        o.z = pack2(bq.x * (1.f + s1.x) + h1.x, bq.y * (1.f + s1.y) + h1.y);
        o.w = pack2(bq.z * (1.f + s1.z) + h1.z, bq.w * (1.f + s1.w) + h1.w);
        *(uint4*)(H + i * 8) = o;
    }
}

DI int wq_next(unsigned* ctr, char* smem) {
    volatile unsigned* slot = (volatile unsigned*)(smem + SMEM_BYTES - 8);
    __syncthreads();
    if (__builtin_amdgcn_workitem_id_x() == 0) *slot = __hip_atomic_fetch_add(ctr, 1u, __ATOMIC_RELAXED, __HIP_MEMORY_SCOPE_AGENT);
    __syncthreads();
    return (int)*slot;
}
DI void phase_prep_a(const Params& p, char* smem) {
    unsigned* ctr = (unsigned*)(p.ws + OFF_BAR) + 120;
    constexpr int U_S5 = 192, U_LB = 320, U_TR = 321, U_UT = U_TR + 368, U_VT = U_UT + 128, U_MISC = U_VT + 128, U_END = U_MISC + 8;
    for (int raw = wq_next(ctr, smem); raw < U_END; raw = wq_next(ctr, smem)) {
        const int u = raw < 512 ? ((raw & 1) ? (raw >> 1) : U_UT + (raw >> 1)) : (raw < U_MISC ? 256 + (raw - 512) : raw);
        if (u < U_S5) prep_mod_item(p, u, smem);
        else if (u < U_LB) prep_s5_gemm_item(p, (u - U_S5) >> 2, (u - U_S5) & 3, smem);
        else if (u < U_TR) {
            const int j = my_tid();
            const float a0 = p.hg_lb[j], a1 = p.hg_lb[512 + j], m = fmaxf(a0, a1);
            const float e0 = expf(a0 - m), e1 = expf(a1 - m);
            ((float*)(p.ws + OFF_LB))[j] = e0 / (e0 + e1);
        } else if (u < U_UT) {
            for (int it = (u - U_TR) * 4; it < (u - U_TR) * 4 + 4; ++it) {
                constexpr int T_WIN = 16 * 40, T_GLU = 8 * 8, T_WOUT = 16 * 16;
                constexpr int I_GLU = T_WIN, I_WOUT = I_GLU + T_GLU, I_WQ = I_WOUT + T_WOUT;
                if (it < I_GLU) { const int t = it, n0 = (t % 40) * 64;
                    const int d0 = n0 < 512 ? (n0 >> 7) * 256 + (n0 & 127) : (n0 < 1024 ? ((n0 - 512) >> 7) * 256 + 128 + (n0 & 127) : n0);
                    prep_transpose_tile(p.w_in, (bf16_t*)(p.ws + OFF_WIN), DM, INC, t / 40, t % 40, smem, d0); }
                else if (it < I_WOUT) { const int t = it - I_GLU; prep_transpose_tile(p.glu_w, (bf16_t*)(p.ws + OFF_GLU), 512, 512, t / 8, t % 8, smem); }
                else if (it < I_WQ) { const int t = it - I_WOUT; prep_transpose_tile(p.w_out, (bf16_t*)(p.ws + OFF_WOUT), DM, DM, t / 16, t % 16, smem, -1, 512); }
                else { const int t = it - I_WQ; prep_transpose_tile(p.w_q, (bf16_t*)(p.ws + OFF_WQ), DM, 2048, t / 32, t % 32, smem); }
            }
        } else if (u < U_VT) cvt_i8_rows<0>(p.pu, (unsigned char*)(p.ws + OFF_UT), (float*)(p.ws + OFF_SU), u - U_UT, 128);
        else if (u < U_MISC) cvt_i8_rows<128>(p.pv, (unsigned char*)(p.ws + OFF_VT), (float*)(p.ws + OFF_SV), u - U_VT, 128);
        else {
            const int q = u - U_MISC;
            cvt_bf16_stream(p.subk, (bf16_t*)(p.ws + OFF_SUBK), (size_t)16 * 128 * 128 / 8, q, 8);
            for (size_t i = (size_t)q * NTH + my_tid(); i < (size_t)NTOK * 3 / 4; i += (size_t)8 * NTH) ((f32x4*)(p.ws + OFF_STAT))[i] = (f32x4){0.f, 0.f, 0.f, 0.f};
        }
    }
}
DI void phase_prep_b(const Params& p, char* smem) {
    unsigned* ctr = (unsigned*)(p.ws + OFF_BAR) + 121;
    for (int u = wq_next(ctr, smem); u < 64 + 256; u = wq_next(ctr, smem)) {
        if (u < 64) prep_cab_item(p, u, smem); else phase_h(p, u - 64, 256);
    }
}

DI void phase_proj(const Params& p, int bid, int nb, char* smem) {
    pg8::Gemm g{(const bf16_t*)(p.ws + OFF_H), (const bf16_t*)(p.ws + OFF_WIN), NTOK, INC, DM};
    pg8::StaticOrder S; S.init(NTOK, INC, nb, bid);
    pg8::EpiProj E{(bf16_t*)(p.ws + OFF_PROJ), (bf16_t*)(p.ws + OFF_HQ), (bf16_t*)(p.ws + OFF_HK), (float*)(p.ws + OFF_HG), (const float*)(p.ws + OFF_LB)};
    pg8::gemm_phase<pg8::EpiProj, pg8::StaticOrder, false>((PG8_LAS unsigned char*)smem, g, S, E, nullptr);
}

DI void hgrn_item(const Params& p, int item, char* smem) {
    const int vs = item & 7, hd = (item >> 3) & 3, b = item >> 5;
    const bf16_t* P = (const bf16_t*)(p.ws + OFF_PROJ);
    const float* lb = (const float*)(p.ws + OFF_LB) + hd * HDK;
    float* ORAW = (float*)(p.ws + OFF_ORAW);
    float* sq = (float*)smem;
    float* sf = sq + 32 * 128;
    float* sv = sf + 32 * 128;
    float* sp = sv + 32 * 16;
    const int tid = my_tid(), lane = tid & 63, wid = tid >> 6, kq = tid >> 4, v = tid & 15;
    float S0 = 0.f, S1 = 0.f, S2 = 0.f, S3 = 0.f;
    for (int t0 = 0; t0 < SEQ; t0 += 32) {
        for (int i = tid; i < 32 * 128; i += NTH) {
            const int t = i >> 7, k = i & 127;
            const bf16_t* row = P + (size_t)(b * SEQ + t0 + t) * INC + hd * HDK + k;
            sq[i] = bf2f(row[0]);
            const float l = lb[k];
            sf[i] = l + (1.0f - l) * sigmoidf_(bf2f(row[512]));
        }
        { const int t = tid >> 4; sv[tid] = bf2f(P[(size_t)(b * SEQ + t0 + t) * INC + 1024 + hd * HDK + vs * 16 + v]); }
        __syncthreads();
        for (int t = 0; t < 32; ++t) {
            const float4 f4 = *(const float4*)(sf + t * 128 + kq * 4), q4 = *(const float4*)(sq + t * 128 + kq * 4);
            const float vv = sv[t * 16 + v];
            S0 = f4.x * S0 + (1.0f - f4.x) * vv; S1 = f4.y * S1 + (1.0f - f4.y) * vv;
            S2 = f4.z * S2 + (1.0f - f4.z) * vv; S3 = f4.w * S3 + (1.0f - f4.w) * vv;
            float part = q4.x * S0 + q4.y * S1 + q4.z * S2 + q4.w * S3;
            part += __shfl_xor(part, 16); part += __shfl_xor(part, 32);
            if (lane < 16) sp[(t * 8 + wid) * 16 + v] = part;
        }
        __syncthreads();
        {
            const int t = tid >> 4;
            float o = 0.f;
#pragma unroll
            for (int w = 0; w < 8; ++w) o += sp[(t * 8 + w) * 16 + v];
            ORAW[(size_t)(b * SEQ + t0 + t) * DHG + hd * HDK + vs * 16 + v] = o;
        }
        __syncthreads();
    }
}
DI void s5_item(const Params& p, int item, char* smem) {
    const int oct = item & 3, b = item >> 2;
    const int tid = my_tid(), lane = tid & 63, wid = tid >> 6, g = oct * 8 + wid;
    const bf16_t* P = (const bf16_t*)(p.ws + OFF_PROJ);
    bf16_t* Y = (bf16_t*)(p.ws + OFF_YSSM);
    float* su = (float*)smem + wid * 64 * 16;
    const float* lam = (const float*)(p.ws + OFF_LAM) + (g * SSP + lane) * 2;
    const float lr = lam[0], li = lam[1];
    const float* bb = (const float*)(p.ws + OFF_BB) + (size_t)(g * SSP + lane) * 32;
    float bbr[16], bbi[16], cr[16], ci[16];
#pragma unroll
    for (int i = 0; i < 16; ++i) { bbr[i] = bb[2 * i]; bbi[i] = bb[2 * i + 1]; cr[i] = p.c_re[(g * SSC + i) * SSP + lane]; ci[i] = p.c_im[(g * SSC + i) * SSP + lane]; }
    const int ch = (lane >> 2) & 15;
    const float dch = p.dsk[g * SSC + ch];
    float xr = 0.f, xi = 0.f;
    for (int t0 = 0; t0 < SEQ; t0 += 64) {
        {
            const uint4* src = (const uint4*)(P + (size_t)(b * SEQ + t0 + lane) * INC + 2048 + g * SSC);
            const uint4 a = src[0], c = src[1];
            float* d = su + lane * 16;
            d[0] = bflo(a.x); d[1] = bfhi(a.x); d[2] = bflo(a.y); d[3] = bfhi(a.y); d[4] = bflo(a.z); d[5] = bfhi(a.z); d[6] = bflo(a.w); d[7] = bfhi(a.w);
            d[8] = bflo(c.x); d[9] = bfhi(c.x); d[10] = bflo(c.y); d[11] = bfhi(c.y); d[12] = bflo(c.z); d[13] = bfhi(c.z); d[14] = bflo(c.w); d[15] = bfhi(c.w);
        }
        __syncthreads();
        for (int t = 0; t < 64; ++t) {
            float u[16];
            const float4* us = (const float4*)(su + t * 16);
            const float4 u0 = us[0], u1 = us[1], u2 = us[2], u3 = us[3];
            u[0] = u0.x; u[1] = u0.y; u[2] = u0.z; u[3] = u0.w; u[4] = u1.x; u[5] = u1.y; u[6] = u1.z; u[7] = u1.w;
            u[8] = u2.x; u[9] = u2.y; u[10] = u2.z; u[11] = u2.w; u[12] = u3.x; u[13] = u3.y; u[14] = u3.z; u[15] = u3.w;
            float bur = 0.f, bui = 0.f;
#pragma unroll
            for (int i = 0; i < 16; ++i) { bur += bbr[i] * u[i]; bui += bbi[i] * u[i]; }
            const float nxr = lr * xr - li * xi + bur, nxi = lr * xi + li * xr + bui;
            xr = nxr; xi = nxi;
            float y[16];
#pragma unroll
            for (int i = 0; i < 16; ++i) y[i] = cr[i] * xr - ci[i] * xi;
            const bool b5 = lane & 32, b4 = lane & 16, b3 = lane & 8, b2 = lane & 4;
            float y8[8], y4[4], y2[2];
#pragma unroll
            for (int j = 0; j < 8; ++j) { const float keep = b5 ? y[8 + j] : y[j], send = b5 ? y[j] : y[8 + j]; y8[j] = keep + __shfl_xor(send, 32); }
#pragma unroll
            for (int j = 0; j < 4; ++j) { const float keep = b4 ? y8[4 + j] : y8[j], send = b4 ? y8[j] : y8[4 + j]; y4[j] = keep + __shfl_xor(send, 16); }
#pragma unroll
            for (int j = 0; j < 2; ++j) { const float keep = b3 ? y4[2 + j] : y4[j], send = b3 ? y4[j] : y4[2 + j]; y2[j] = keep + __shfl_xor(send, 8); }
            float y1;
            { const float keep = b2 ? y2[1] : y2[0], send = b2 ? y2[0] : y2[1]; y1 = keep + __shfl_xor(send, 4); }
            y1 += __shfl_xor(y1, 1); y1 += __shfl_xor(y1, 2);
            if ((lane & 3) == 0) {
                const float uu = su[t * 16 + ch];
                Y[(size_t)(b * SEQ + t0 + t) * DSS + g * SSC + ch] = f2bf(geluf_(y1 + dch * uu));
            }
        }
        __syncthreads();
    }
}
DI int crow(int i, int h) { return (i & 3) + 8 * (i >> 2) + 4 * h; }
DI void phase_hgprep(const Params& p, int bid, int nb) {
    const bf16_t* P = (const bf16_t*)(p.ws + OFF_PROJ);
    const float* lbp = (const float*)(p.ws + OFF_LB);
    const int tid = my_tid(), lane = tid & 63, wid = tid >> 6, tq = lane >> 4, cg = lane & 15;
#pragma unroll 1
    for (int it = bid * 8 + wid; it < 8192; it += nb * 8) {
        const int tile = it >> 1, c = tile & 63, hd = (tile >> 6) & 3, b = tile >> 8, k0 = (it & 1) * 64 + cg * 4;
        const bf16_t* base = P + (size_t)(b * SEQ + c * 32 + tq * 8) * INC + hd * HDK + k0;
        uint2 qw[8], fw[8];
#pragma unroll
        for (int tt = 0; tt < 8; ++tt) { qw[tt] = *(const uint2*)(base + (size_t)tt * INC); fw[tt] = *(const uint2*)(base + (size_t)tt * INC + 512); }
        const f32x4 l4 = *(const f32x4*)(lbp + hd * HDK + k0);
        const float lb4[4] = {l4.x, l4.y, l4.z, l4.w};
        float bl[8][4], kk[8][4], run[4];
#pragma unroll
        for (int e = 0; e < 4; ++e) run[e] = 0.f;
#pragma unroll
        for (int tt = 0; tt < 8; ++tt) {
            const float fl[4] = {bflo(fw[tt].x), bfhi(fw[tt].x), bflo(fw[tt].y), bfhi(fw[tt].y)};
#pragma unroll
            for (int e = 0; e < 4; ++e) {
                const float f = lb4[e] + (1.0f - lb4[e]) * sigmoidf_(fl[e]);
                run[e] += __logf(f); bl[tt][e] = run[e]; kk[tt][e] = 1.0f - f;
            }
        }
        float off[4], tot[4];
#pragma unroll
        for (int e = 0; e < 4; ++e) {
            const float t0 = __shfl(run[e], cg), t1 = __shfl(run[e], cg + 16), t2 = __shfl(run[e], cg + 32), t3 = __shfl(run[e], cg + 48);
            off[e] = (tq > 0 ? t0 : 0.f) + (tq > 1 ? t1 : 0.f) + (tq > 2 ? t2 : 0.f);
            tot[e] = (t0 + t1) + (t2 + t3);
        }
        bf16_t* HQ = (bf16_t*)(p.ws + OFF_HQ) + (size_t)tile * 4096 + (tq * 8) * 128 + k0;
        bf16_t* HK = (bf16_t*)(p.ws + OFF_HK) + (size_t)tile * 4096 + (tq * 8) * 128 + k0;
#pragma unroll
        for (int tt = 0; tt < 8; ++tt) {
            const float qv[4] = {bflo(qw[tt].x), bfhi(qw[tt].x), bflo(qw[tt].y), bfhi(qw[tt].y)};
            float qo[4], ko[4];
#pragma unroll
            for (int e = 0; e < 4; ++e) { const float bb = off[e] + bl[tt][e]; qo[e] = qv[e] * __expf(bb); ko[e] = kk[tt][e] * __expf(fminf(-bb, 80.0f)); }
            *(uint2*)(HQ + tt * 128) = make_uint2(pack2(qo[0], qo[1]), pack2(qo[2], qo[3]));
            *(uint2*)(HK + tt * 128) = make_uint2(pack2(ko[0], ko[1]), pack2(ko[2], ko[3]));
        }
        if (tq == 0) *(f32x4*)((float*)(p.ws + OFF_HG) + (size_t)tile * 128 + k0) = (f32x4){__expf(tot[0]), __expf(tot[1]), __expf(tot[2]), __expf(tot[3])};
    }
}
typedef short s16x4 __attribute__((ext_vector_type(4)));
DI bf16x8 cat8(const s16x4 lo, const s16x4 hi) { return (bf16x8){lo.x, lo.y, lo.z, lo.w, hi.x, hi.y, hi.z, hi.w}; }
DI s16x4 lds_tr(const char* a) { return __builtin_amdgcn_ds_read_tr16_b64_v4i16((__attribute__((address_space(3))) s16x4*)a); }
DI void hgrn_mfma_item(const Params& p, int item, char* smem) {
    constexpr int QP_OFF = 0, KP_OFF = 8704, V_OFF = 17408, G_OFF = 26112, BUF = 26624, OB_OFF = 3 * BUF, OB_STRIDE = 132, OB_BYTES = 32 * OB_STRIDE * 4;
    const int tid = my_tid(), lane = tid & 63, wid = tid >> 6, r = lane & 31, h = lane >> 5;
    const int b = item >> 2, hd = item & 3;
    const size_t tile0 = (size_t)item * 64;
    const bf16_t* HQ = (const bf16_t*)(p.ws + OFF_HQ) + tile0 * 4096;
    const bf16_t* HK = (const bf16_t*)(p.ws + OFF_HK) + tile0 * 4096;
    const bf16_t* PV = (const bf16_t*)(p.ws + OFF_PROJ) + (size_t)b * SEQ * INC + 1024 + hd * HDK;
    const float* HG = (const float*)(p.ws + OFF_HG) + tile0 * 128;
    bf16_t* A2out = (bf16_t*)(p.ws + OFF_A2) + (size_t)b * SEQ * DM + 512 + hd * HDK;
    const bf16_t* PG = (const bf16_t*)(p.ws + OFF_PROJ) + (size_t)b * SEQ * INC + 1536 + hd * HDK;
    const bool helper = wid >= 4;
    const int ht = tid - 256;
    const int i0 = ht, i1 = ht + 256;
    const int lo0 = (i0 >> 4) * 272 + (i0 & 15) * 16, lo1 = (i1 >> 4) * 272 + (i1 & 15) * 16;
    u32x4 A0, A1, A2, A3, A4, A5, A6, B0, B1, B2, B3, B4, B5, B6;
    A0 = A1 = A2 = A3 = A4 = A5 = A6 = B0 = B1 = B2 = B3 = B4 = B5 = B6 = (u32x4){0, 0, 0, 0};
    f32x16 S[4];
#pragma unroll
    for (int kb = 0; kb < 4; ++kb)
#pragma unroll
        for (int i = 0; i < 16; ++i) S[kb][i] = 0.f;
#define HG_LOAD(X, c_) { const size_t o_ = (size_t)(c_) * 4096; \
        X##0 = *(const u32x4*)(HQ + o_ + i0 * 8); X##1 = *(const u32x4*)(HQ + o_ + i1 * 8); \
        X##2 = *(const u32x4*)(HK + o_ + i0 * 8); X##3 = *(const u32x4*)(HK + o_ + i1 * 8); \
        X##4 = *(const u32x4*)(PV + (size_t)((c_) * 32 + (i0 >> 4)) * INC + (i0 & 15) * 8); X##5 = *(const u32x4*)(PV + (size_t)((c_) * 32 + (i1 >> 4)) * INC + (i1 & 15) * 8); \
        X##6 = *(const u32x4*)(HG + (size_t)(c_) * 128 + (ht & 31) * 4); }
#define HG_STORE(X, buf_) { char* B_ = smem + (buf_) * BUF; \
        *(u32x4*)(B_ + QP_OFF + lo0) = X##0; *(u32x4*)(B_ + QP_OFF + lo1) = X##1; \
        *(u32x4*)(B_ + KP_OFF + lo0) = X##2; *(u32x4*)(B_ + KP_OFF + lo1) = X##3; \
        *(u32x4*)(B_ + V_OFF + lo0) = X##4; *(u32x4*)(B_ + V_OFF + lo1) = X##5; \
        if (ht < 32) *(u32x4*)(B_ + G_OFF + ht * 16) = X##6; }
    const int tq = (lane >> 2) & 3, tp = lane & 3, tg = lane >> 4;
    const int tr_nat = (8 * (tg >> 1) + tq) * 272 + (16 * (tg & 1) + 4 * tp) * 2;
    const int tr_krw = (4 * (tg >> 1) + tq) * 272 + (16 * (tg & 1) + 4 * tp) * 2;
    if (helper) { HG_LOAD(A, 0); HG_STORE(A, 0); HG_LOAD(A, 1); HG_STORE(A, 1); HG_LOAD(A, 2); HG_LOAD(B, 3); }
    __syncthreads();
#define HG_RD_A(ks_) (*(const bf16x8*)(B + KP_OFF + r * 272 + (ks_) * 32 + h * 16))
#define HG_RD_BQ(ks_) (*(const bf16x8*)(B + QP_OFF + r * 272 + (ks_) * 32 + h * 16))
#define HG_RD_AQ(ks_) cat8(*(const s16x4*)(B + QP_OFF + r * 272 + ((ks_) >> 1) * 64 + ((ks_) & 1) * 32 + h * 8), *(const s16x4*)(B + QP_OFF + r * 272 + ((ks_) >> 1) * 64 + ((ks_) & 1) * 32 + h * 8 + 16))
#define HG_RD_KT(kb_, ks_) cat8(lds_tr(B + KP_OFF + (16 * (ks_)) * 272 + (32 * (kb_)) * 2 + tr_nat), lds_tr(B + KP_OFF + (16 * (ks_)) * 272 + (32 * (kb_)) * 2 + tr_nat + 4 * 272))
#define HG_COMPUTE(c_) { \
        const char* B = smem + ((c_) % 3) * BUF; const int w = wid; \
          \
        f32x16 pt, o; _Pragma("unroll") for (int i = 0; i < 16; ++i) { pt[i] = 0.f; o[i] = 0.f; } \
        bf16x8 fa[2], fb[2], fq[2]; \
        fa[0] = HG_RD_A(0); fb[0] = HG_RD_BQ(0); fq[0] = HG_RD_AQ(0); \
        _Pragma("unroll") for (int ks = 0; ks < 8; ++ks) { \
            if (ks + 1 < 8) { fa[(ks + 1) & 1] = HG_RD_A(ks + 1); fb[(ks + 1) & 1] = HG_RD_BQ(ks + 1); fq[(ks + 1) & 1] = HG_RD_AQ(ks + 1); } \
            __builtin_amdgcn_sched_barrier(0); \
            pt = __builtin_amdgcn_mfma_f32_32x32x16_bf16(fa[ks & 1], fb[ks & 1], pt, 0, 0, 0); \
            o = __builtin_amdgcn_mfma_f32_32x32x16_bf16(fq[ks & 1], pack8(S[ks >> 1], 8 * (ks & 1)), o, 0, 0, 0); \
            __builtin_amdgcn_sched_barrier(0); } \
        bf16x8 bv[2], bvn[2]; \
        _Pragma("unroll") for (int sp = 0; sp < 2; ++sp) { const char* vb = B + V_OFF + (16 * sp) * 272 + (32 * w) * 2 + tr_krw; bv[sp] = cat8(lds_tr(vb), lds_tr(vb + 8 * 272)); } \
        _Pragma("unroll") for (int ks = 0; ks < 2; ++ks) { const char* vb = B + V_OFF + (16 * ks) * 272 + (32 * w) * 2 + tr_nat; bvn[ks] = cat8(lds_tr(vb), lds_tr(vb + 4 * 272)); } \
        bf16x8 kt[2]; kt[0] = HG_RD_KT(0, 0); \
        __builtin_amdgcn_sched_barrier(0); \
        _Pragma("unroll") for (int i = 0; i < 16; ++i) if (crow(i, h) > r) pt[i] = 0.f; \
        _Pragma("unroll") for (int sp = 0; sp < 2; ++sp) o = __builtin_amdgcn_mfma_f32_32x32x16_bf16(pack8(pt, 8 * sp), bv[sp], o, 0, 0, 0); \
          \
        _Pragma("unroll") for (int kb = 0; kb < 4; ++kb) { \
            f32x4 g4[4]; \
            _Pragma("unroll") for (int j = 0; j < 4; ++j) g4[j] = *(const f32x4*)(B + G_OFF + (kb * 32 + 8 * j + 4 * h) * 4); \
            _Pragma("unroll") for (int ks = 0; ks < 2; ++ks) { \
                const int nx = kb * 2 + ks + 1; \
                if (nx < 8) kt[nx & 1] = HG_RD_KT(nx >> 1, nx & 1); \
                __builtin_amdgcn_sched_barrier(0); \
                S[kb] = __builtin_amdgcn_mfma_f32_32x32x16_bf16(kt[(nx - 1) & 1], bvn[ks], S[kb], 0, 0, 0); \
                __builtin_amdgcn_sched_barrier(0); } \
            _Pragma("unroll") for (int j = 0; j < 4; ++j) { \
                S[kb][4 * j] *= g4[j].x; S[kb][4 * j + 1] *= g4[j].y; S[kb][4 * j + 2] *= g4[j].z; S[kb][4 * j + 3] *= g4[j].w; } } \
        { float* ob_ = (float*)(smem + OB_OFF + ((c_) & 1) * OB_BYTES); _Pragma("unroll") for (int i = 0; i < 16; ++i) ob_[crow(i, h) * OB_STRIDE + 32 * w + r] = o[i]; } }
    f32x4 nw0, nw1, nw2, nw3;
    nw0 = nw1 = nw2 = nw3 = (f32x4){0.f, 0.f, 0.f, 0.f};
    if (helper) { const float* nwp = p.hg_nw + hd * HDK + (ht & 7) * 16; nw0 = *(const f32x4*)nwp; nw1 = *(const f32x4*)(nwp + 4); nw2 = *(const f32x4*)(nwp + 8); nw3 = *(const f32x4*)(nwp + 12); }
#define HG_NORM(cc_, PF_) { const int t_ = ht >> 3, sg_ = ht & 7; \
        const float* ob_ = (const float*)(smem + OB_OFF + ((cc_) & 1) * OB_BYTES) + t_ * OB_STRIDE + sg_ * 16; \
        const f32x4 o0 = *(const f32x4*)ob_, o1 = *(const f32x4*)(ob_ + 4), o2 = *(const f32x4*)(ob_ + 8), o3 = *(const f32x4*)(ob_ + 12); \
        const u32x4 g0 = gp0, g1 = gp1;                                     \
        if (PF_) { gp0 = *(const u32x4*)(PG + (size_t)(((cc_) + 1) * 32 + t_) * INC + sg_ * 16); gp1 = *(const u32x4*)(PG + (size_t)(((cc_) + 1) * 32 + t_) * INC + sg_ * 16 + 8); } \
        float ss = (o0.x * o0.x + o0.y * o0.y + o0.z * o0.z + o0.w * o0.w) + (o1.x * o1.x + o1.y * o1.y + o1.z * o1.z + o1.w * o1.w) + (o2.x * o2.x + o2.y * o2.y + o2.z * o2.z + o2.w * o2.w) + (o3.x * o3.x + o3.y * o3.y + o3.z * o3.z + o3.w * o3.w); \
        ss += __shfl_xor(ss, 1); ss += __shfl_xor(ss, 2); ss += __shfl_xor(ss, 4); \
        const float rs_ = rsqrtf(ss * (1.0f / 128.0f) + RMS_EPS); \
        const f32x4 v0 = o0 * rs_ * nw0, v1 = o1 * rs_ * nw1, v2 = o2 * rs_ * nw2, v3 = o3 * rs_ * nw3; \
        u32x4 w0, w1; \
        w0.x = pack2(v0.x * bflo(g0.x), v0.y * bfhi(g0.x)); w0.y = pack2(v0.z * bflo(g0.y), v0.w * bfhi(g0.y)); w0.z = pack2(v1.x * bflo(g0.z), v1.y * bfhi(g0.z)); w0.w = pack2(v1.z * bflo(g0.w), v1.w * bfhi(g0.w)); \
        w1.x = pack2(v2.x * bflo(g1.x), v2.y * bfhi(g1.x)); w1.y = pack2(v2.z * bflo(g1.y), v2.w * bfhi(g1.y)); w1.z = pack2(v3.x * bflo(g1.z), v3.y * bfhi(g1.z)); w1.w = pack2(v3.z * bflo(g1.w), v3.w * bfhi(g1.w)); \
        bf16_t* dst_ = A2out + (size_t)((cc_) * 32 + t_) * DM + sg_ * 16; \
        *(u32x4*)dst_ = w0; *(u32x4*)(dst_ + 8) = w1; }
#define HG_BAR() do { asm volatile("s_waitcnt lgkmcnt(0)" ::: "memory"); __builtin_amdgcn_s_barrier(); asm volatile("" ::: "memory"); } while (0)
    if (helper) {
        u32x4 gp0, gp1;
        gp0 = *(const u32x4*)(PG + (size_t)(ht >> 3) * INC + (ht & 7) * 16); gp1 = *(const u32x4*)(PG + (size_t)(ht >> 3) * INC + (ht & 7) * 16 + 8);
        HG_STORE(A, 2); HG_LOAD(A, 4); HG_BAR();
        HG_STORE(B, 0); HG_LOAD(B, 5); HG_NORM(0, true); HG_BAR();
#pragma unroll 1
        for (int c = 2; c <= 58; c += 2) {
            HG_STORE(A, (c + 2) % 3); HG_LOAD(A, c + 4); HG_NORM(c - 1, true); HG_BAR();
            HG_STORE(B, (c + 3) % 3); HG_LOAD(B, c + 5); HG_NORM(c, true); HG_BAR();
        }
        HG_STORE(A, 62 % 3); HG_NORM(59, true); HG_BAR();
        HG_STORE(B, 63 % 3); HG_NORM(60, true); HG_BAR();
        HG_NORM(61, true); HG_BAR();
        HG_NORM(62, true); HG_BAR();
        HG_NORM(63, false);
    } else {
#pragma unroll 1
        for (int c = 0; c < 64; c += 2) { HG_COMPUTE(c); HG_BAR(); HG_COMPUTE(c + 1); HG_BAR(); }
    }
#undef HG_BAR
    __syncthreads();
#undef HG_LOAD
#undef HG_STORE
#undef HG_COMPUTE
#undef HG_RD_A
#undef HG_RD_BQ
#undef HG_RD_AQ
#undef HG_RD_KT
#undef HG_NORM
}
template <int NJ>
DI void s5_load_bm(bf16x8 (&bm)[8], const bf16_t* MBg, const int r, const int h) {
#pragma unroll
    for (int ks = 0; ks < 8; ++ks) bm[ks] = *(const bf16x8*)(MBg + (size_t)((NJ * 8 + ks) * 64 + h * 32 + r) * 8);
}
template <int NJ>
DI void s5_gemm2_tile(const bf16x8 (&af)[16], const bf16x8 (&bm)[8], const bf16_t* KTl, const bf16_t* Xin, bf16_t* Yout, bf16_t* stg, const int mi, const int r, const int h) {
    f32x16 y, y2;
#pragma unroll
    for (int i = 0; i < 16; ++i) { y[i] = 0.f; y2[i] = 0.f; }
    const int tsel = r >> 4, iq = r & 15;
    constexpr int NT = 2 * NJ + 2;
    bf16x8 bk[2], xa[2];
    bk[0] = *(const bf16x8*)(KTl + ((2 * NJ + tsel) * 16 + iq) * 16 + 8 * h);
#pragma unroll
    for (int ks = 0; ks < NT; ++ks) {
        if (ks + 1 < NT) {
            if (ks + 1 <= 2 * NJ) bk[(ks + 1) & 1] = *(const bf16x8*)(KTl + ((2 * NJ + tsel - (ks + 1)) * 16 + iq) * 16 + 8 * h);
            else { bf16x8 t = *(const bf16x8*)(KTl + iq * 16 + 8 * h); if (tsel == 0) t = (bf16x8){0, 0, 0, 0, 0, 0, 0, 0}; bk[(ks + 1) & 1] = t; }
        } else xa[0] = *(const bf16x8*)(Xin + (mi * 32 + r) * 136 + 8 * h);
        __builtin_amdgcn_sched_barrier(0);
        if (ks & 1) y2 = __builtin_amdgcn_mfma_f32_32x32x16_bf16(af[ks], bk[ks & 1], y2, 0, 0, 0);
        else y = __builtin_amdgcn_mfma_f32_32x32x16_bf16(af[ks], bk[ks & 1], y, 0, 0, 0);
        __builtin_amdgcn_sched_barrier(0);
    }
#pragma unroll
    for (int ks = 0; ks < 8; ++ks) {
        if (ks + 1 < 8) xa[(ks + 1) & 1] = *(const bf16x8*)(Xin + (mi * 32 + r) * 136 + (ks + 1) * 16 + 8 * h);
        __builtin_amdgcn_sched_barrier(0);
        if (ks & 1) y2 = __builtin_amdgcn_mfma_f32_32x32x16_bf16(xa[ks & 1], bm[ks], y2, 0, 0, 0);
        else y = __builtin_amdgcn_mfma_f32_32x32x16_bf16(xa[ks & 1], bm[ks], y, 0, 0, 0);
        __builtin_amdgcn_sched_barrier(0);
    }
#pragma unroll
    for (int i = 0; i < 16; ++i) stg[((crow(i, h) * 2 + tsel) * 16) + iq] = f2bf(gelu_as(y[i] + y2[i]));
    {
        const int lane = h * 32 + r, cl = lane >> 1, ts = lane & 1;
        const u32x4 lo = *(const u32x4*)(stg + lane * 16), hi = *(const u32x4*)(stg + lane * 16 + 8);
        bf16_t* dst = Yout + (size_t)((mi * 32 + cl) * 16 + 2 * NJ + ts) * DSS;
        *(u32x4*)dst = lo; *(u32x4*)(dst + 8) = hi;
    }
}
DI void s5_gemm_item(const Params& p, int b, int g, char* smem) {
    float* E = (float*)smem;
    bf16_t* Xin = (bf16_t*)(smem + 128 * 132 * 4);
    bf16_t* KTl = Xin + 128 * 136;
    const int tid = my_tid(), lane = tid & 63, wid = tid >> 6, r = lane & 31, h = lane >> 5;
    const int mi = wid >> 1, wh = wid & 1;
    const bf16_t* P = (const bf16_t*)(p.ws + OFF_PROJ);
    *(u32x4*)(KTl + tid * 8) = *(const u32x4*)((const bf16_t*)(p.ws + OFF_S5K) + (size_t)g * 4096 + tid * 8);
    bf16x8 af[16];
    {
        const bf16_t* ub = P + (size_t)(b * SEQ + (mi * 32 + r) * 16) * INC + 2048 + g * 16 + 8 * h;
#pragma unroll
        for (int ks = 0; ks < 16; ++ks) af[ks] = *(const bf16x8*)(ub + (size_t)ks * INC);
    }
#ifndef S5_REP_G1
#define S5_REP_G1 1
#define S5_REP_SC 1
#define S5_REP_G2 1
#endif
    for (int rp1 = 0; rp1 < S5_REP_G1; ++rp1)
    {
        f32x16 e0, e1;
#pragma unroll
        for (int i = 0; i < 16; ++i) { e0[i] = 0.f; e1[i] = 0.f; }
        const bf16_t* nb0 = (const bf16_t*)(p.ws + OFF_S5N) + (size_t)g * 128 * 256 + (size_t)(wh * 2) * 16 * 512 + lane * 8;
#pragma unroll
        for (int ks = 0; ks < 16; ++ks) {
            const bf16x8 b0 = *(const bf16x8*)(nb0 + ks * 512), b1 = *(const bf16x8*)(nb0 + 16 * 512 + ks * 512);
            e0 = __builtin_amdgcn_mfma_f32_32x32x16_bf16(af[ks], b0, e0, 0, 0, 0);
            e1 = __builtin_amdgcn_mfma_f32_32x32x16_bf16(af[ks], b1, e1, 0, 0, 0);
        }
#pragma unroll
        for (int i = 0; i < 16; ++i) { float* er = E + (mi * 32 + crow(i, h)) * 132 + wh * 64 + r; er[0] = e0[i]; er[32] = e1[i]; }
    }
    __syncthreads();
    for (int rp2 = 0; rp2 < S5_REP_SC; ++rp2)
    if (wid == 0) {
        const float* L = (const float*)(p.ws + OFF_S5L) + (g * 64 + lane) * 2;
        const float lr = L[0], li = L[1];
        float xr = 0.f, xi = 0.f;
#pragma unroll 8
        for (int c = 0; c < 128; ++c) {
            const float er = E[c * 132 + lane], ei = E[c * 132 + 64 + lane];
            Xin[c * 136 + lane] = f2bf(xr); Xin[c * 136 + 64 + lane] = f2bf(xi);
            const float nr = lr * xr - li * xi + er, ni = lr * xi + li * xr + ei;
            xr = nr; xi = ni;
        }
    }
    __syncthreads();
    const bf16_t* MBg = (const bf16_t*)(p.ws + OFF_S5M) + (size_t)g * 256 * 128;
    bf16_t* Yout = (bf16_t*)(p.ws + OFF_YSSM) + (size_t)b * SEQ * DSS + g * 16;
    bf16_t* stg = (bf16_t*)smem + wid * 1024;
    for (int rp3 = 0; rp3 < S5_REP_G2; ++rp3)
    {
        bf16x8 bmA[8], bmB[8];
#define S5_RUN4(T0, T1, T2, T3) { s5_load_bm<T0>(bmA, MBg, r, h); s5_load_bm<T1>(bmB, MBg, r, h); \
        s5_gemm2_tile<T0>(af, bmA, KTl, Xin, Yout, stg, mi, r, h); s5_load_bm<T2>(bmA, MBg, r, h); \
        s5_gemm2_tile<T1>(af, bmB, KTl, Xin, Yout, stg, mi, r, h); s5_load_bm<T3>(bmB, MBg, r, h); \
        s5_gemm2_tile<T2>(af, bmA, KTl, Xin, Yout, stg, mi, r, h); s5_gemm2_tile<T3>(af, bmB, KTl, Xin, Yout, stg, mi, r, h); }
        if (wh) S5_RUN4(1, 6, 3, 4) else S5_RUN4(0, 7, 2, 5)
#undef S5_RUN4
    }
    __syncthreads();
}
DI void phase_mix(const Params& p, int bid, int nb, char* smem) {
    if (nb == 256) {
#ifndef PROBE_HGX
#define PROBE_HGX 1
#endif
        if (bid < 64) { for (int rep = 0; rep < PROBE_HGX; ++rep) hgrn_mfma_item(p, bid, smem); return; }
        const int j = bid - 64, x = j & 7, lb = j >> 3;
#ifndef PROBE_S5X
#define PROBE_S5X 1
#endif
        for (int rep = 0; rep < PROBE_S5X; ++rep)
        for (int q = lb; q < 64; q += 24) s5_gemm_item(p, q & 15, x * 4 + (q >> 4), smem);
    } else {
        for (int it = bid; it < 64; it += nb) hgrn_mfma_item(p, it, smem);
        for (int q = bid; q < 512; q += nb) s5_gemm_item(p, q & 15, q >> 4, smem);
    }
}

DI void phase_glu(const Params& p, int bid, int nb, char* smem) {
    pg8::Gemm g{(const bf16_t*)(p.ws + OFF_YSSM), (const bf16_t*)(p.ws + OFF_GLU), NTOK, 512, 512};
    pg8::StaticOrder S; S.init(NTOK, 512, nb, bid);
    pg8::EpiGluA2 E{(bf16_t*)(p.ws + OFF_A2), (const bf16_t*)(p.ws + OFF_YSSM), p.glu_b, p.ssm_nw, (float*)(p.ws + OFF_STAT) + 2 * NTOK};
    pg8::gemm_phase<pg8::EpiGluA2, pg8::StaticOrder, false>((PG8_LAS unsigned char*)smem, g, S, E, nullptr);
}
DI void phase_a2(const Params& p, int bid, int nb) {
    const float* Y2 = (const float*)(p.ws + OFF_H);
    const bf16_t* P = (const bf16_t*)(p.ws + OFF_PROJ);
    bf16_t* A2 = (bf16_t*)(p.ws + OFF_A2);
    const int lane = my_tid() & 63, wid = my_tid() >> 6;
    for (int tok = bid * 8 + wid; tok < NTOK; tok += nb * 8) {
        const int c0 = lane * 8;
        {
            const float4 a = *(const float4*)(Y2 + (size_t)tok * DSS + c0), b = *(const float4*)(Y2 + (size_t)tok * DSS + c0 + 4);
            float ss = a.x * a.x + a.y * a.y + a.z * a.z + a.w * a.w + b.x * b.x + b.y * b.y + b.z * b.z + b.w * b.w;
#pragma unroll
            for (int m = 1; m < 64; m <<= 1) ss += __shfl_xor(ss, m);
            const float rs = rsqrtf(ss * (1.0f / 512.0f) + RMS_EPS);
            const float4 w0 = *(const float4*)(p.ssm_nw + c0), w1 = *(const float4*)(p.ssm_nw + c0 + 4);
            uint4 o;
            o.x = pack2(a.x * rs * w0.x, a.y * rs * w0.y); o.y = pack2(a.z * rs * w0.z, a.w * rs * w0.w);
            o.z = pack2(b.x * rs * w1.x, b.y * rs * w1.y); o.w = pack2(b.z * rs * w1.z, b.w * rs * w1.w);
            *(uint4*)(A2 + (size_t)tok * DM + 512 + c0) = o;
        }
    }
}

DI void phase_outproj(const Params& p, int bid, int nb, char* smem) {
    pg8::Gemm g{(const bf16_t*)(p.ws + OFF_A2), (const bf16_t*)(p.ws + OFF_WOUT), NTOK, DM, DM};
    pg8::StaticOrder S; S.init(NTOK, DM, nb, bid);
    pg8::EpiResid E{(bf16_t*)(p.ws + OFF_R1), p.x, (const float*)(p.ws + OFF_MOD) + 2048, DEEP_ALPHA, (bf16_t*)(p.ws + OFF_H), (const float*)(p.ws + OFF_AB), (float*)(p.ws + OFF_STAT), (const float*)(p.ws + OFF_STAT) + 2 * NTOK, RMS_EPS};
    pg8::gemm_phase<pg8::EpiResid, pg8::StaticOrder, false>((PG8_LAS unsigned char*)smem, g, S, E, nullptr);
}
DI void phase_ln1(const Params& p, int bid, int nb) {
    const float* mod = (const float*)(p.ws + OFF_MOD);
    bf16_t* H2 = (bf16_t*)(p.ws + OFF_H);
    const int lane = my_tid() & 63, wid = my_tid() >> 6;
    for (int tok = bid * 8 + wid; tok < NTOK; tok += nb * 8) {
        const int b = tok / SEQ;
        float* row = p.out + (size_t)tok * DM;
        float4 v[4];
        float s = 0.f;
#pragma unroll
        for (int j = 0; j < 4; ++j) { v[j] = *(const float4*)(row + j * 256 + lane * 4); s += v[j].x + v[j].y + v[j].z + v[j].w; }
#pragma unroll
        for (int m = 1; m < 64; m <<= 1) s += __shfl_xor(s, m);
        const float mu = s * (1.0f / 1024.0f);
        float q = 0.f;
#pragma unroll
        for (int j = 0; j < 4; ++j) { const float a = v[j].x - mu, bb = v[j].y - mu, cc = v[j].z - mu, d = v[j].w - mu; q += a * a + bb * bb + cc * cc + d * d; }
#pragma unroll
        for (int m = 1; m < 64; m <<= 1) q += __shfl_xor(q, m);
        const float rstd = rsqrtf(q * (1.0f / 1024.0f) + LN_EPS);
        const float* sh2 = mod + b * 6144 + 3072;
        const float* sc2 = mod + b * 6144 + 4096;
#pragma unroll
        for (int j = 0; j < 4; ++j) {
            const int c = j * 256 + lane * 4;
            const float4 w = *(const float4*)(p.ln1w + c), bi = *(const float4*)(p.ln1b + c), sc = *(const float4*)(sc2 + c), sh = *(const float4*)(sh2 + c);
            float4 o;
            o.x = (v[j].x - mu) * rstd * w.x + bi.x; o.y = (v[j].y - mu) * rstd * w.y + bi.y; o.z = (v[j].z - mu) * rstd * w.z + bi.z; o.w = (v[j].w - mu) * rstd * w.w + bi.w;
            *(float4*)(row + c) = o;
            uint2 hh; hh.x = pack2(o.x * (1.f + sc.x) + sh.x, o.y * (1.f + sc.y) + sh.y); hh.y = pack2(o.z * (1.f + sc.z) + sh.z, o.w * (1.f + sc.w) + sh.w);
            *(uint2*)(H2 + (size_t)tok * DM + c) = hh;
        }
    }
}

DI void phase_q(const Params& p, int bid, int nb, char* smem) {
    pg8::Gemm g{(const bf16_t*)(p.ws + OFF_H), (const bf16_t*)(p.ws + OFF_WQ), NTOK, 2048, DM};
    pg8::StaticOrder S; S.init(NTOK, 2048, nb, bid);
    pg8::EpiQLN E{(bf16_t*)(p.ws + OFF_PROJ), (const float*)(p.ws + OFF_STAT), (const float*)(p.ws + OFF_CAB), (const float*)(p.ws + OFF_CAB) + NB * 2048, LN_EPS};
    pg8::gemm_phase<pg8::EpiQLN, pg8::StaticOrder, false>((PG8_LAS unsigned char*)smem, g, S, E, nullptr);
}
DI void phase_topk(const Params& p, int bid, int nb, char* smem) {
    const bf16_t* Q = (const bf16_t*)(p.ws + OFF_PROJ);
    const bf16_t* SK = (const bf16_t*)(p.ws + OFF_SUBK);
    unsigned* TOPL = (unsigned*)(p.ws + OFF_TOPL);
    float* sc = (float*)(smem + 36864);
    constexpr int NTM = NTOK / 128;
    for (int t = bid; t < NTM * 16; t += nb) {
        const int mt = t >> 4, hp = t & 15;
        gemm_block<2, 1, 2, 4>(Q + (size_t)mt * 128 * 2048 + hp * 128, 2048, SK + (size_t)hp * 128 * 128, 128, 128, smem,
                               [&](int r, int c, float v) { sc[r * 129 + c] = v; });
        __syncthreads();
        if (my_tid() < 128) {
            const int r = my_tid();
            float tk[16];
#pragma unroll
            for (int j = 0; j < 16; ++j) tk[j] = -3.0e38f;
            for (int n = 0; n < 128; ++n) {
                float xv = __uint_as_float((__float_as_uint(sc[r * 129 + n]) & ~0x7fu) | (unsigned)n);
#pragma unroll
                for (int j = 0; j < 16; ++j) { const float hi = fmaxf(tk[j], xv), lo = fminf(tk[j], xv); tk[j] = hi; xv = lo; }
            }
            uint4* dst = (uint4*)(TOPL + ((size_t)(mt * 128 + r) * 16 + hp) * 16);
            dst[0] = make_uint4(__float_as_uint(tk[0]), __float_as_uint(tk[1]), __float_as_uint(tk[2]), __float_as_uint(tk[3]));
            dst[1] = make_uint4(__float_as_uint(tk[4]), __float_as_uint(tk[5]), __float_as_uint(tk[6]), __float_as_uint(tk[7]));
            dst[2] = make_uint4(__float_as_uint(tk[8]), __float_as_uint(tk[9]), __float_as_uint(tk[10]), __float_as_uint(tk[11]));
            dst[3] = make_uint4(__float_as_uint(tk[12]), __float_as_uint(tk[13]), __float_as_uint(tk[14]), __float_as_uint(tk[15]));
        }
        __syncthreads();
    }
}
DI void phase_combine(const Params& p, int bid, int nb) {
    const unsigned* TOPL = (const unsigned*)(p.ws + OFF_TOPL);
    uint2* EX = (uint2*)(p.ws + OFF_EXPS);
    const float* SU = (const float*)(p.ws + OFF_SU);
    const float* SV = (const float*)(p.ws + OFF_SV);
    for (int i = bid * NTH + my_tid(); i < NTOK * PHEADS; i += nb * NTH) {
        const unsigned* l1 = TOPL + (size_t)i * 32;
        const unsigned* l2 = l1 + 16;
        float s2[16];
        {
            const uint4 a = ((const uint4*)l2)[0], b = ((const uint4*)l2)[1], c = ((const uint4*)l2)[2], d = ((const uint4*)l2)[3];
            const unsigned w[16] = {a.x, a.y, a.z, a.w, b.x, b.y, b.z, b.w, c.x, c.y, c.z, c.w, d.x, d.y, d.z, d.w};
#pragma unroll
            for (int j = 0; j < 16; ++j) s2[j] = __uint_as_float(w[j] & ~0x7fu);
        }
        float tk[16];
#pragma unroll
        for (int j = 0; j < 16; ++j) tk[j] = -3.0e38f;
        for (int a = 0; a < 16; ++a) {
            const float s1 = __uint_as_float(l1[a] & ~0x7fu);
#pragma unroll
            for (int b = 0; b < 16; ++b) {
                float xv = __uint_as_float((__float_as_uint(s1 + s2[b]) & ~0xffu) | (unsigned)(a * 16 + b));
#pragma unroll
                for (int j = 0; j < 16; ++j) { const float hi = fmaxf(tk[j], xv), lo = fminf(tk[j], xv); tk[j] = hi; xv = lo; }
            }
        }
        float e[16], sum = 0.f;
        const float mx = __uint_as_float(__float_as_uint(tk[0]) & ~0xffu);
#pragma unroll
        for (int j = 0; j < 16; ++j) { e[j] = __expf(__uint_as_float(__float_as_uint(tk[j]) & ~0xffu) - mx); sum += e[j]; }
        const float inv = 1.0f / sum;
#pragma unroll
        for (int j = 0; j < 16; ++j) {
            const unsigned ab = __float_as_uint(tk[j]) & 0xffu;
            const unsigned i1 = l1[ab >> 4] & 0x7fu, i2 = l2[ab & 15] & 0x7fu;
            const unsigned eid = i1 * 128u + i2;
            EX[(size_t)i * 16 + j] = make_uint2(eid | (((__float_as_uint(SU[eid]) >> 23) & 0xffu) << 16), __float_as_uint(e[j] * inv * SV[eid]));
        }
    }
}

DI void ce_desc(float& a, float& b) { const float hi = fmaxf(a, b), lo = fminf(a, b); a = hi; b = lo; }
template <int N> DI void bitonic_sort_desc(float (&v)[N]) {
#pragma unroll
    for (int k = 2; k <= N; k <<= 1)
#pragma unroll
        for (int j = k >> 1; j > 0; j >>= 1)
#pragma unroll
            for (int i = 0; i < N; ++i) { const int l = i ^ j; if (l > i) { if ((i & k) == 0 || k == N) ce_desc(v[i], v[l]); else ce_desc(v[l], v[i]); } }
}
DI void merge_top16(float (&a)[16], const float (&b)[16]) {
#pragma unroll
    for (int i = 0; i < 16; ++i) a[i] = fmaxf(a[i], b[15 - i]);
#pragma unroll
    for (int j = 8; j > 0; j >>= 1)
#pragma unroll
        for (int i = 0; i < 16; ++i) { const int l = i ^ j; if (l > i) ce_desc(a[i], a[l]); }
}
DI void xlane_merge16(float (&a)[16]) {
    float o[16];
#pragma unroll
    for (int i = 0; i < 16; ++i) o[i] = __shfl_xor(a[i], 32);
    merge_top16(a, o);
}
DI void retrieve_topk_hp(const bf16_t* Q, const char* skl, const int tok, const int hp_next, const int r, const int h, unsigned char* lutp, float (&out)[16], bf16x8 (&bq)[8]) {
                f32x16 acc[4];
#pragma unroll
                for (int mi = 0; mi < 4; ++mi)
#pragma unroll
                    for (int i = 0; i < 16; ++i) acc[mi][i] = 0.f;
                const char* kb = skl + r * 272 + h * 16;
#pragma unroll
                for (int ks = 0; ks < 8; ++ks) {
#pragma unroll
                    for (int mi = 0; mi < 4; ++mi) {
                        const bf16x8 a = *(const bf16x8*)(kb + mi * 32 * 272 + ks * 32);
                        acc[mi] = __builtin_amdgcn_mfma_f32_32x32x16_bf16(a, bq[ks], acc[mi], 0, 0, 0);
                    }
                }
                {
                    const bf16_t* qb = Q + (size_t)tok * 2048 + hp_next * 128 + 8 * h;
#pragma unroll
                    for (int ks = 0; ks < 8; ++ks) bq[ks] = *(const bf16x8*)(qb + ks * 16);
                }
                float v0[16], v1[16], v2[16], v3[16];
#pragma unroll
                for (int i = 0; i < 16; ++i) {
                    const unsigned n = (unsigned)crow(i, h);
                    v0[i] = __uint_as_float((__float_as_uint(acc[0][i]) & ~0x7fu) | n);
                    v1[i] = __uint_as_float((__float_as_uint(acc[1][i]) & ~0x7fu) | (n + 32u));
                    v2[i] = __uint_as_float((__float_as_uint(acc[2][i]) & ~0x7fu) | (n + 64u));
                    v3[i] = __uint_as_float((__float_as_uint(acc[3][i]) & ~0x7fu) | (n + 96u));
                }
                bitonic_sort_desc<16>(v0); bitonic_sort_desc<16>(v1); bitonic_sort_desc<16>(v2); bitonic_sort_desc<16>(v3);
                merge_top16(v0, v1); merge_top16(v2, v3); merge_top16(v0, v2);
                xlane_merge16(v0);
#pragma unroll
                for (int i = 0; i < 16; ++i) out[i] = v0[i];
                u32x4 ix;
                ix.x = (__float_as_uint(v0[0]) & 0x7fu) | ((__float_as_uint(v0[1]) & 0x7fu) << 8) | ((__float_as_uint(v0[2]) & 0x7fu) << 16) | ((__float_as_uint(v0[3]) & 0x7fu) << 24);
                ix.y = (__float_as_uint(v0[4]) & 0x7fu) | ((__float_as_uint(v0[5]) & 0x7fu) << 8) | ((__float_as_uint(v0[6]) & 0x7fu) << 16) | ((__float_as_uint(v0[7]) & 0x7fu) << 24);
                ix.z = (__float_as_uint(v0[8]) & 0x7fu) | ((__float_as_uint(v0[9]) & 0x7fu) << 8) | ((__float_as_uint(v0[10]) & 0x7fu) << 16) | ((__float_as_uint(v0[11]) & 0x7fu) << 24);
                ix.w = (__float_as_uint(v0[12]) & 0x7fu) | ((__float_as_uint(v0[13]) & 0x7fu) << 8) | ((__float_as_uint(v0[14]) & 0x7fu) << 16) | ((__float_as_uint(v0[15]) & 0x7fu) << 24);
                *(u32x4*)lutp = ix;
}
DI void phase_retrieve(const Params& p, int bid, int nb, char* smem) {
    const bf16_t* Q = (const bf16_t*)(p.ws + OFF_PROJ);
    const bf16_t* SK = (const bf16_t*)(p.ws + OFF_SUBK);
    const float* SU = (const float*)(p.ws + OFF_SU);
    const float* SV = (const float*)(p.ws + OFF_SV);
    uint2* EX = (uint2*)(p.ws + OFF_EXPS);
    const int tid = my_tid(), lane = tid & 63, wid = tid >> 6, r = lane & 31, h = lane >> 5;
    unsigned char* lut = (unsigned char*)smem + wid * 2048 + lane * 32;
    char* skb0 = smem + 16384;
    char* skb1 = skb0 + 128 * 272;
    u32x4 sr0, sr1, sr2, sr3;
#define SK_LOAD(hp_) { const bf16_t* g_ = SK + (size_t)(hp_) * 16384 + tid * 8; sr0 = *(const u32x4*)g_; sr1 = *(const u32x4*)(g_ + 4096); sr2 = *(const u32x4*)(g_ + 8192); sr3 = *(const u32x4*)(g_ + 12288); }
#define SK_STORE(buf_) { char* d_ = (buf_) + (tid >> 4) * 272 + (tid & 15) * 16; *(u32x4*)d_ = sr0; *(u32x4*)(d_ + 32 * 272) = sr1; *(u32x4*)(d_ + 64 * 272) = sr2; *(u32x4*)(d_ + 96 * 272) = sr3; }
    for (int it = bid; it < (NTOK / 256) * 2; it += nb) {
        const int hq = it & 1, tok = (it >> 1) * 256 + wid * 32 + r;
        __syncthreads();
        SK_LOAD(hq * 8); SK_STORE(skb0);
        bf16x8 bq[8];
        {
            const bf16_t* qb = Q + (size_t)tok * 2048 + (hq * 8) * 128 + 8 * h;
#pragma unroll
            for (int ks = 0; ks < 8; ++ks) bq[ks] = *(const bf16x8*)(qb + ks * 16);
        }
        __syncthreads();
#pragma unroll 1
        for (int hd = hq * 4; hd < hq * 4 + 4; ++hd) {
            float L0[16], L1[16];
            SK_LOAD(hd * 2 + 1);
            retrieve_topk_hp(Q, skb0, tok, hd * 2 + 1, r, h, lut, L0, bq);
            SK_STORE(skb1);
            __syncthreads();
            if (hd + 1 < hq * 4 + 4) SK_LOAD(hd * 2 + 2);
            retrieve_topk_hp(Q, skb1, tok, (hd + 1 < hq * 4 + 4) ? hd * 2 + 2 : hd * 2 + 1, r, h, lut + 16, L1, bq);
            if (hd + 1 < hq * 4 + 4) SK_STORE(skb0);
            __syncthreads();
            float c[32];
            {
                constexpr int PA[50] = {0, 0, 0, 0, 0, 0, 0, 0, 0, 0, 0, 0, 0, 0, 0, 0, 1, 1, 1, 1, 1, 1, 1, 1, 2, 2, 2, 2, 2, 3, 3, 3, 3, 4, 4, 4, 5, 5, 6, 6, 7, 7, 8, 9, 10, 11, 12, 13, 14, 15};
                constexpr int PB[50] = {0, 1, 2, 3, 4, 5, 6, 7, 8, 9, 10, 11, 12, 13, 14, 15, 0, 1, 2, 3, 4, 5, 6, 7, 0, 1, 2, 3, 4, 0, 1, 2, 3, 0, 1, 2, 0, 1, 0, 1, 0, 1, 0, 0, 0, 0, 0, 0, 0, 0};
#pragma unroll
                for (int q = 0; q < 25; ++q) {
                    const float s0 = __uint_as_float(__float_as_uint(L0[PA[2 * q]]) & ~0x7fu) + __uint_as_float(__float_as_uint(L1[PB[2 * q]]) & ~0x7fu);
                    const float s1 = __uint_as_float(__float_as_uint(L0[PA[2 * q + 1]]) & ~0x7fu) + __uint_as_float(__float_as_uint(L1[PB[2 * q + 1]]) & ~0x7fu);
                    const float p0 = __uint_as_float((__float_as_uint(s0) & ~0xffu) | (unsigned)(PA[2 * q] * 16 + PB[2 * q]));
                    const float p1 = __uint_as_float((__float_as_uint(s1) & ~0xffu) | (unsigned)(PA[2 * q + 1] * 16 + PB[2 * q + 1]));
                    c[q] = h ? p1 : p0;
                }
#pragma unroll
                for (int i = 25; i < 32; ++i) c[i] = -3.0e38f;
            }
            bitonic_sort_desc<32>(c);
            float t16[16];
#pragma unroll
            for (int i = 0; i < 16; ++i) t16[i] = c[i];
            xlane_merge16(t16);
            const float mx = __uint_as_float(__float_as_uint(t16[0]) & ~0xffu);
            float e[16], sum = 0.f;
#pragma unroll
            for (int j = 0; j < 16; ++j) { e[j] = __expf(__uint_as_float(__float_as_uint(t16[j]) & ~0xffu) - mx); sum += e[j]; }
            const float inv = 1.0f / sum;
            uint2* dst = EX + ((size_t)tok * 8 + hd) * 16 + 8 * h;
            unsigned eidv[8]; float suv[8], svv[8], evv[8];
#pragma unroll
            for (int j = 0; j < 8; ++j) {
                float tlo = t16[j], thi = t16[8 + j], elo = e[j], ehi = e[8 + j];
                asm volatile("" : "+v"(tlo), "+v"(thi), "+v"(elo), "+v"(ehi));
                const float tv = h ? thi : tlo;
                evv[j] = h ? ehi : elo;
                const unsigned ab = __float_as_uint(tv) & 0xffu;
                eidv[j] = (unsigned)lut[ab >> 4] * 128u + (unsigned)lut[16 + (ab & 15u)];
                suv[j] = SU[eidv[j]]; svv[j] = SV[eidv[j]];
            }
#pragma unroll
            for (int j = 0; j < 8; ++j) dst[j] = make_uint2(eidv[j] | (pack2(0.f, suv[j]) & 0xffff0000u), __float_as_uint(evv[j] * inv * svv[j]));
        }
    }
#undef SK_LOAD
#undef SK_STORE
}

DI float dot16_fp8(const u32x4 w, const f32x2 (&h)[8]) {
    f32x2 acc = __builtin_amdgcn_cvt_pk_f32_fp8((int)w.x, false) * h[0];
    acc += __builtin_amdgcn_cvt_pk_f32_fp8((int)w.x, true) * h[1];
    acc += __builtin_amdgcn_cvt_pk_f32_fp8((int)w.y, false) * h[2];
    acc += __builtin_amdgcn_cvt_pk_f32_fp8((int)w.y, true) * h[3];
    acc += __builtin_amdgcn_cvt_pk_f32_fp8((int)w.z, false) * h[4];
    acc += __builtin_amdgcn_cvt_pk_f32_fp8((int)w.z, true) * h[5];
    acc += __builtin_amdgcn_cvt_pk_f32_fp8((int)w.w, false) * h[6];
    acc += __builtin_amdgcn_cvt_pk_f32_fp8((int)w.w, true) * h[7];
    return acc.x + acc.y;
}
DI void axpy16_fp8(const float a, const u32x4 w, f32x2 (&o)[8]) {
    const f32x2 aa = {a, a};
    o[0] += aa * __builtin_amdgcn_cvt_pk_f32_fp8((int)w.x, false); o[1] += aa * __builtin_amdgcn_cvt_pk_f32_fp8((int)w.x, true);
    o[2] += aa * __builtin_amdgcn_cvt_pk_f32_fp8((int)w.y, false); o[3] += aa * __builtin_amdgcn_cvt_pk_f32_fp8((int)w.y, true);
    o[4] += aa * __builtin_amdgcn_cvt_pk_f32_fp8((int)w.z, false); o[5] += aa * __builtin_amdgcn_cvt_pk_f32_fp8((int)w.z, true);
    o[6] += aa * __builtin_amdgcn_cvt_pk_f32_fp8((int)w.w, false); o[7] += aa * __builtin_amdgcn_cvt_pk_f32_fp8((int)w.w, true);
}
DI float butterfly64(float (&pz)[64], const int lane) {
    const bool b5 = lane & 32, b4 = lane & 16, b3 = lane & 8, b2 = lane & 4, b1 = lane & 2, b0 = lane & 1;
    float q32[32], q16[16], q8[8], q4[4], q2[2];
#pragma unroll
    for (int j = 0; j < 32; ++j) q32[j] = (b5 ? pz[32 + j] : pz[j]) + __shfl_xor(b5 ? pz[j] : pz[32 + j], 32);
#pragma unroll
    for (int j = 0; j < 16; ++j) q16[j] = (b4 ? q32[16 + j] : q32[j]) + __shfl_xor(b4 ? q32[j] : q32[16 + j], 16);
#pragma unroll
    for (int j = 0; j < 8; ++j) q8[j] = (b3 ? q16[8 + j] : q16[j]) + __shfl_xor(b3 ? q16[j] : q16[8 + j], 8);
#pragma unroll
    for (int j = 0; j < 4; ++j) q4[j] = (b2 ? q8[4 + j] : q8[j]) + __shfl_xor(b2 ? q8[j] : q8[4 + j], 4);
#pragma unroll
    for (int j = 0; j < 2; ++j) q2[j] = (b1 ? q4[2 + j] : q4[j]) + __shfl_xor(b1 ? q4[j] : q4[2 + j], 2);
    return (b0 ? q2[1] : q2[0]) + __shfl_xor(b0 ? q2[0] : q2[1], 1);
}
DI float bfly8(float (&pz)[8], const int lane) {
    const bool b2 = lane & 4, b1 = lane & 2, b0 = lane & 1;
    float q4[4], q2[2];
#pragma unroll
    for (int i = 0; i < 4; ++i) q4[i] = (b2 ? pz[4 + i] : pz[i]) + __shfl_xor(b2 ? pz[i] : pz[4 + i], 4);
#pragma unroll
    for (int i = 0; i < 2; ++i) q2[i] = (b1 ? q4[2 + i] : q4[i]) + __shfl_xor(b1 ? q4[i] : q4[2 + i], 2);
    float q = (b0 ? q2[1] : q2[0]) + __shfl_xor(b0 ? q2[0] : q2[1], 1);
    q += __shfl_xor(q, 8); q += __shfl_xor(q, 16); q += __shfl_xor(q, 32);
    return q;
}
DI float bfly16(float (&pz)[16], const int lane) {
    const bool b3 = lane & 8, b2 = lane & 4, b1 = lane & 2, b0 = lane & 1;
    float q8[8], q4[4], q2[2];
#pragma unroll
    for (int i = 0; i < 8; ++i) q8[i] = (b3 ? pz[8 + i] : pz[i]) + __shfl_xor(b3 ? pz[i] : pz[8 + i], 8);
#pragma unroll
    for (int i = 0; i < 4; ++i) q4[i] = (b2 ? q8[4 + i] : q8[i]) + __shfl_xor(b2 ? q8[i] : q8[4 + i], 4);
#pragma unroll
    for (int i = 0; i < 2; ++i) q2[i] = (b1 ? q4[2 + i] : q4[i]) + __shfl_xor(b1 ? q4[i] : q4[2 + i], 2);
    float q = (b0 ? q2[1] : q2[0]) + __shfl_xor(b0 ? q2[0] : q2[1], 1);
    q += __shfl_xor(q, 16); q += __shfl_xor(q, 32);
    return q;
}
DI void gs_issue(const __amdgpu_buffer_rsrc_t T, const uint2* ent, const unsigned d, const int lane, u32x4 (&w)[8], unsigned& ca) {
    const int cnt = (int)((d >> 16) & 0xfu), k = lane & 7;
    const uint2 e = ent[(d & 0xffffu) + (unsigned)(k < cnt ? k : cnt - 1)];
    ca = (k < cnt && !(d >> 31)) ? e.y : 0u;
#pragma unroll
    for (int q = 0; q < 8; ++q) {
        const int eid = __builtin_amdgcn_readlane((int)e.x, q) & 0x3fff;
        w[q] = __builtin_amdgcn_raw_buffer_load_b128(T, lane * 16, eid * DM, 0);
    }
}
DI float dot16_i8(const u32x4 w, const u32x4 h) {
    int acc = __builtin_amdgcn_sdot4((int)w.x, (int)h.x, 0, false);
    acc = __builtin_amdgcn_sdot4((int)w.y, (int)h.y, acc, false);
    acc = __builtin_amdgcn_sdot4((int)w.z, (int)h.z, acc, false);
    acc = __builtin_amdgcn_sdot4((int)w.w, (int)h.w, acc, false);
    return (float)acc;
}
DI void gs_desc(const uint2* ent, const unsigned d, const int lane, unsigned& ex) {
    const int cnt = (int)((d >> 16) & 0xfu), k = lane & 7;
    ex = ent[(d & 0xffffu) + (unsigned)(k < cnt ? k : cnt - 1)].x;
}
DI void gs_loads(const __amdgpu_buffer_rsrc_t T, const unsigned ex, const int lane, u32x4 (&w)[8]) {
#pragma unroll
    for (int q = 0; q < 8; ++q) {
        const int eid = __builtin_amdgcn_readlane((int)ex, q) & 0x3fff;
        w[q] = __builtin_amdgcn_raw_buffer_load_b128(T, lane * 16, eid * DM, 0);
    }
}
DI void gs_upartial(const u32x4 (&w)[8], const u32x4 h2q, float (&pz)[16], const int base) {
#pragma unroll
    for (int k = 0; k < 8; ++k) pz[base + k] = dot16_i8(w[k], h2q);
}
DI void gs_ustore(float (&pz)[16], float* zb, const unsigned da, const unsigned db, const int lane) {
    const float z = bfly16(pz, lane);
    const unsigned d = (lane & 8) ? db : da;
    const int k = lane & 7;
    if (lane < 16 && k < (int)((d >> 16) & 0xfu) && !(d >> 31)) zb[(d & 0xffffu) + k] = z;
}
DI void axpy16_u8(const float a, const u32x4 w, float (&o)[16]) {
    o[0] += a * (float)(w.x & 0xffu); o[1] += a * (float)((w.x >> 8) & 0xffu); o[2] += a * (float)((w.x >> 16) & 0xffu); o[3] += a * (float)(w.x >> 24);
    o[4] += a * (float)(w.y & 0xffu); o[5] += a * (float)((w.y >> 8) & 0xffu); o[6] += a * (float)((w.y >> 16) & 0xffu); o[7] += a * (float)(w.y >> 24);
    o[8] += a * (float)(w.z & 0xffu); o[9] += a * (float)((w.z >> 8) & 0xffu); o[10] += a * (float)((w.z >> 16) & 0xffu); o[11] += a * (float)(w.z >> 24);
    o[12] += a * (float)(w.w & 0xffu); o[13] += a * (float)((w.w >> 8) & 0xffu); o[14] += a * (float)((w.w >> 16) & 0xffu); o[15] += a * (float)(w.w >> 24);
}
DI void gs_vcompute(const u32x4 (&w)[8], const unsigned ca, float (&acc)[16]) {
#pragma unroll
    for (int k = 0; k < 8; ++k) { axpy16_u8(__uint_as_float((unsigned)__builtin_amdgcn_readlane((int)ca, k)), w[k], acc); __builtin_amdgcn_sched_barrier(0); }
}
constexpr int GT = 4;
constexpr int WL_ENT = GT * 1024, WL_Z = GT * 512, WL_OFFS = ((GT * 9 * 4 + 63) / 64) * 64, WL_SCHED = ((GT * 20 + 3) * 4 + 63) / 64 * 64, WL_BYTES = WL_ENT + WL_Z + WL_OFFS + WL_SCHED;
static_assert(8 * WL_BYTES <= 128 * 1024, "gather LDS");
template <int J> DI void gs_usel(const u32x4 (&w)[8], const u32x4 (&h2q)[GT], float (&pz)[16], const int base, const unsigned j) {
    if constexpr (J + 1 < GT) { if (j == (unsigned)J) gs_upartial(w, h2q[J], pz, base); else gs_usel<J + 1>(w, h2q, pz, base, j); } else gs_upartial(w, h2q[J], pz, base);
}
template <int J> DI void gs_vsel(const u32x4 (&w)[8], const unsigned ca, float (&acc)[GT][16], const unsigned j) {
    if constexpr (J + 1 < GT) { if (j == (unsigned)J) gs_vcompute(w, ca, acc[J]); else gs_vsel<J + 1>(w, ca, acc, j); } else gs_vcompute(w, ca, acc[J]);
}
constexpr int NSL = 4, SLSH = 12;
DI void xcd_pace(unsigned* cnt, const unsigned nloc, unsigned& step) {
    __syncthreads();
    if (__builtin_amdgcn_workitem_id_x() == 0) {
        __hip_atomic_fetch_add(cnt, 1u, __ATOMIC_RELAXED, __HIP_MEMORY_SCOPE_AGENT);
        const unsigned target = nloc * (step + 1u);
        unsigned sp = 0;
        while (__hip_atomic_load(cnt, __ATOMIC_RELAXED, __HIP_MEMORY_SCOPE_AGENT) < target) { __builtin_amdgcn_s_sleep(1); if (++sp > (1u << 22)) break; }
    }
    ++step;
    __syncthreads();
}
DI void phase_gather(const Params& p, int bid, int nb, char* smem, unsigned* pace_cnt, const unsigned pace_n) {
    unsigned pstep = 0;
    const float* mod = (const float*)(p.ws + OFF_MOD);
    const float* AB = (const float*)(p.ws + OFF_AB);
    const float* STAT = (const float*)(p.ws + OFF_STAT);
    const uint2* EX = (const uint2*)(p.ws + OFF_EXPS);
    const __amdgpu_buffer_rsrc_t UT = __builtin_amdgcn_make_buffer_rsrc((void*)(p.ws + OFF_UT), 0, NEXP * DM, 0x00020000);
    const __amdgpu_buffer_rsrc_t VT = __builtin_amdgcn_make_buffer_rsrc((void*)(p.ws + OFF_VT), 0, NEXP * DM, 0x00020000);
    const int lane = my_tid() & 63, wid = my_tid() >> 6, c0 = lane * 16;
    char* wl = smem + wid * WL_BYTES;
    uint2* ent = (uint2*)wl; float* zb = (float*)(wl + WL_ENT); int* offs = (int*)(wl + WL_ENT + WL_Z); unsigned* sched = (unsigned*)(wl + WL_ENT + WL_Z + WL_OFFS);
#pragma unroll 1
    for (int t0 = (bid * 8 + wid) * GT; t0 < NTOK; t0 += nb * 8 * GT) {
        u32x4 h2q[GT]; float hsc[GT]; float acc[GT][16];
        f32x4 scv[4], shv[4];
        {
            const int b = t0 / SEQ;
#pragma unroll
            for (int q = 0; q < 4; ++q) { scv[q] = *(const f32x4*)(AB + (size_t)b * DM + c0 + q * 4); shv[q] = *(const f32x4*)(AB + (size_t)(NB + b) * DM + c0 + q * 4); }
        }
#pragma unroll
        for (int j = 0; j < GT; ++j) {
            const int tok = t0 + j;
            const bf16_t* row = (const bf16_t*)(p.ws + OFF_R1) + (size_t)tok * DM + c0;
            __builtin_amdgcn_sched_barrier(0);
            const float mu_j = STAT[tok] * (1.0f / 1024.0f), rs_j = rsqrtf(fmaxf(STAT[NTOK + tok] * (1.0f / 1024.0f) - mu_j * mu_j, 0.f) + LN_EPS);
            {
                f32x4 hv[4];
                float m = 0.f;
                const u32x4 ra = *(const u32x4*)row, rb = *(const u32x4*)(row + 8);
                hv[0] = (f32x4){bflo(ra.x), bfhi(ra.x), bflo(ra.y), bfhi(ra.y)}; hv[1] = (f32x4){bflo(ra.z), bfhi(ra.z), bflo(ra.w), bfhi(ra.w)};
                hv[2] = (f32x4){bflo(rb.x), bfhi(rb.x), bflo(rb.y), bfhi(rb.y)}; hv[3] = (f32x4){bflo(rb.z), bfhi(rb.z), bflo(rb.w), bfhi(rb.w)};
#pragma unroll
                for (int q = 0; q < 4; ++q) { hv[q] = (hv[q] - mu_j) * rs_j * scv[q] + shv[q]; m = fmaxf(m, fmaxf(fmaxf(fabsf(hv[q].x), fabsf(hv[q].y)), fmaxf(fabsf(hv[q].z), fabsf(hv[q].w)))); }
#pragma unroll
                for (int sft = 1; sft < 64; sft <<= 1) m = fmaxf(m, __shfl_xor(m, sft));
                const float qs = m > 1e-30f ? 127.0f / m : 1.0f;
                hsc[j] = m > 1e-30f ? m * (1.0f / 127.0f) : 1.0f;
                unsigned hw[4];
#pragma unroll
                for (int q = 0; q < 4; ++q)
                    hw[q] = ((unsigned)(int)rintf(hv[q].x * qs) & 0xffu) | (((unsigned)(int)rintf(hv[q].y * qs) & 0xffu) << 8) | (((unsigned)(int)rintf(hv[q].z * qs) & 0xffu) << 16) | (((unsigned)(int)rintf(hv[q].w * qs) & 0xffu) << 24);
                h2q[j] = (u32x4){hw[0], hw[1], hw[2], hw[3]};
            }
            const uint2 e0 = EX[(size_t)tok * 128 + lane], e1 = EX[(size_t)tok * 128 + 64 + lane];
            const int s0 = (int)((e0.x & 0x3fffu) >> SLSH), s1 = (int)((e1.x & 0x3fffu) >> SLSH);
            int run = 0, pos0 = 0, pos1 = 0;
#pragma unroll
            for (int s = 0; s < NSL; ++s) {
                const unsigned long long m0 = __ballot(s0 == s), m1 = __ballot(s1 == s);
                const int c0n = __popcll(m0), c1n = __popcll(m1);
                const int below0 = (int)__builtin_amdgcn_mbcnt_hi((unsigned)(m0 >> 32), __builtin_amdgcn_mbcnt_lo((unsigned)m0, 0u));
                const int below1 = (int)__builtin_amdgcn_mbcnt_hi((unsigned)(m1 >> 32), __builtin_amdgcn_mbcnt_lo((unsigned)m1, 0u));
                if (lane == 0) offs[j * 9 + s] = run;
                pos0 = (s0 == s) ? run + below0 : pos0;
                pos1 = (s1 == s) ? run + c0n + below1 : pos1;
                run += c0n + c1n;
            }
            if (lane == 0) offs[j * 9 + NSL] = 128;
            ent[j * 128 + pos0] = e0; ent[j * 128 + pos1] = e1;
        }
        int nbat;
        {
            const int gs = (lane / GT) % NSL, gj = lane % GT;
            const int gb = offs[gj * 9 + gs], ge = offs[gj * 9 + gs + 1], cnt = lane < NSL * GT ? ge - gb : 0, nbt = (cnt + 7) >> 3;
            int incl = nbt;
#pragma unroll
            for (int m = 1; m < 32; m <<= 1) { const int o = __shfl_up(incl, m); if ((lane & 31) >= m) incl += o; }
            nbat = __builtin_amdgcn_readlane(incl, NSL * GT - 1);
            const int st = incl - nbt;
            for (int q = 0; q < nbt; ++q) { const int rem = cnt - 8 * q; sched[st + q] = (unsigned)(gj * 128 + gb + 8 * q) | ((unsigned)(rem < 8 ? rem : 8) << 16); }
            if (lane < 3) sched[nbat + lane] = 0x80010000u;
        }
        xcd_pace(pace_cnt, pace_n, pstep);
#ifndef PROBE_UX
#define PROBE_UX 1
#endif
        for (int rep = 0; rep < PROBE_UX; ++rep)
        {
            u32x4 wa[8], wb[8];
#define GS_UP(W_, D_, B_) gs_usel<0>(W_, h2q, pz, B_, ((D_) & 0xffffu) >> 7)
#define GS_RD(i_) ((unsigned)__builtin_amdgcn_readfirstlane((int)sched[(i_)]))
            unsigned da = GS_RD(0), db = GS_RD(1), dn = GS_RD(2), ea, eb, en;
            gs_desc(ent, da, lane, ea); gs_desc(ent, db, lane, eb); gs_desc(ent, dn, lane, en);
            gs_loads(UT, ea, lane, wa);
#pragma unroll 1
            for (int i = 0; i < nbat; i += 2) {
                float pz[16];
                gs_loads(UT, eb, lane, wb);
                __builtin_amdgcn_sched_barrier(0);
                GS_UP(wa, da, 0);
                const unsigned dcur_a = da, dcur_b = db;
                da = dn; ea = en; dn = GS_RD(i + 3); gs_desc(ent, dn, lane, en);
                gs_loads(UT, ea, lane, wa);
                __builtin_amdgcn_sched_barrier(0);
                GS_UP(wb, dcur_b, 8);
                db = dn; eb = en; dn = GS_RD(i + 4); gs_desc(ent, dn, lane, en);
                gs_ustore(pz, zb, dcur_a, dcur_b, lane);
            }
#undef GS_UP
#undef GS_RD
        }
        float asum[GT];
#pragma unroll
        for (int j = 0; j < GT; ++j) {
            float as = 0.f;
#pragma unroll
            for (int q = 0; q < 2; ++q) {
                const int pos = j * 128 + q * 64 + lane;
                const uint2 e = ent[pos];
                const float z = zb[pos] * __uint_as_float(e.x & 0xffff0000u) * hsc[j];
                const float a = gelu_as(z) * __uint_as_float(e.y);
                ent[pos].y = __float_as_uint(a);
                as += a;
            }
#pragma unroll
            for (int sft = 1; sft < 64; sft <<= 1) as += __shfl_xor(as, sft);
            asum[j] = as;
        }
#pragma unroll
        for (int j = 0; j < GT; ++j)
#pragma unroll
            for (int q = 0; q < 16; ++q) acc[j][q] = 0.f;
        {
            u32x4 wa[8]; unsigned ca;
#pragma unroll 1
            for (int i = 0; i < nbat; ++i) {
                const unsigned da = (unsigned)__builtin_amdgcn_readfirstlane((int)sched[i]);
                gs_issue(VT, ent, da, lane, wa, ca);
                __builtin_amdgcn_sched_barrier(0);
                gs_vsel<0>(wa, ca, acc, (da & 0xffffu) >> 7);
            }
        }
#pragma unroll
        for (int j = 0; j < GT; ++j) {
            asm volatile("" ::: "memory");
            __builtin_amdgcn_sched_barrier(0);
            const int tok = t0 + j, b = tok / SEQ;
            int c0 = lane * 16; asm volatile("" : "+v"(c0));
            const float mu_j = STAT[tok] * (1.0f / 1024.0f), rs_j = rsqrtf(fmaxf(STAT[NTOK + tok] * (1.0f / 1024.0f) - mu_j * mu_j, 0.f) + LN_EPS);
            float* row = p.out + (size_t)tok * DM + c0;
            const bf16_t* r1row = (const bf16_t*)(p.ws + OFF_R1) + (size_t)tok * DM + c0;
            const float* g2 = mod + b * 6144 + 5120 + c0;
            f32x2 r[8];
            float sm = 0.f;
            const u32x4 ra = *(const u32x4*)r1row, rb = *(const u32x4*)(r1row + 8);
            const f32x4 r1v[4] = {(f32x4){bflo(ra.x), bfhi(ra.x), bflo(ra.y), bfhi(ra.y)}, (f32x4){bflo(ra.z), bfhi(ra.z), bflo(ra.w), bfhi(ra.w)},
                                  (f32x4){bflo(rb.x), bfhi(rb.x), bflo(rb.y), bfhi(rb.y)}, (f32x4){bflo(rb.z), bfhi(rb.z), bflo(rb.w), bfhi(rb.w)}};
#pragma unroll
            for (int q = 0; q < 4; ++q) {
                const f32x4 xv = (r1v[q] - mu_j) * rs_j * *(const f32x4*)(p.ln1w + c0 + q * 4) + *(const f32x4*)(p.ln1b + c0 + q * 4), gg = *(const f32x4*)(g2 + q * 4);
                const float off = 128.0f * asum[j];
                r[2 * q] = DEEP_ALPHA * (f32x2){xv.x, xv.y} + (f32x2){1.f + gg.x, 1.f + gg.y} * (f32x2){acc[j][4 * q] - off, acc[j][4 * q + 1] - off};
                r[2 * q + 1] = DEEP_ALPHA * (f32x2){xv.z, xv.w} + (f32x2){1.f + gg.z, 1.f + gg.w} * (f32x2){acc[j][4 * q + 2] - off, acc[j][4 * q + 3] - off};
                sm += r[2 * q].x + r[2 * q].y + r[2 * q + 1].x + r[2 * q + 1].y;
            }
#pragma unroll
            for (int m = 1; m < 64; m <<= 1) sm += __shfl_xor(sm, m);
            const float mu = sm * (1.0f / 1024.0f);
            float qq = 0.f;
#pragma unroll
            for (int i = 0; i < 8; ++i) { const f32x2 dd = r[i] - mu; qq += dd.x * dd.x + dd.y * dd.y; }
#pragma unroll
            for (int m = 1; m < 64; m <<= 1) qq += __shfl_xor(qq, m);
            const float rstd = rsqrtf(qq * (1.0f / 1024.0f) + LN_EPS);
#pragma unroll
            for (int q = 0; q < 4; ++q) {
                const f32x4 w4 = *(const f32x4*)(p.ln2w + c0 + q * 4), bi = *(const f32x4*)(p.ln2b + c0 + q * 4);
                f32x4 ov;
                ov.x = (r[2 * q].x - mu) * rstd * w4.x + bi.x; ov.y = (r[2 * q].y - mu) * rstd * w4.y + bi.y;
                ov.z = (r[2 * q + 1].x - mu) * rstd * w4.z + bi.z; ov.w = (r[2 * q + 1].y - mu) * rstd * w4.w + bi.w;
                *(f32x4*)(row + q * 4) = ov;
            }
        }
    }
}

#define XB_TMO      128
#define XB_XCNT(j)  (256  + 64 * (j))
#define XB_XSUB(j)  (1280 + 64 * (j))
#define XB_XGEN(j)  (2304 + 64 * (j))
#define XB_TOP      3328
#define XB_TOPGEN   3392
#define XCD_BAR_WORDS 3456
#define XB_SPIN_CAP (1u << 22)
#define LAS __attribute__((address_space(3)))
DI unsigned xb_ld(unsigned* p) { return __hip_atomic_load(p, __ATOMIC_RELAXED, __HIP_MEMORY_SCOPE_AGENT); }
DI unsigned xb_add(unsigned* p, unsigned v) { return __hip_atomic_fetch_add(p, v, __ATOMIC_RELAXED, __HIP_MEMORY_SCOPE_AGENT); }
DI unsigned xb_xcc_id() { return (unsigned)__builtin_amdgcn_s_getreg((3 << 11) | 20) & 0xFu; }
#define XB_SPIN(cond, bar) do { unsigned _sp = 0; while (cond) { __builtin_amdgcn_s_sleep(1); \
    if ((++_sp & 255u) == 0u) { if (xb_ld(&(bar)[XB_TMO])) break; if (_sp > XB_SPIN_CAP) { atomicAdd(&(bar)[XB_TMO], 1u); break; } } } } while (0)
struct XcdBarrier { unsigned* bar; unsigned x; volatile LAS unsigned* st; };
DI XcdBarrier xcd_barrier_post(unsigned* bar, volatile LAS unsigned* st) {
    XcdBarrier b; b.bar = bar; b.x = xb_xcc_id(); b.st = st;
    if (__builtin_amdgcn_workitem_id_x() == 0) (void)xb_add(&bar[XB_XCNT(b.x)], 1u);
    return b;
}
DI void xcd_barrier_complete(unsigned* bar, unsigned x, unsigned& nloc, unsigned& nx) {
    const unsigned G = gridDim.x * gridDim.y * gridDim.z;
    unsigned sum, cnt, mine, sp = 0u;
    for (;;) {
        sum = 0u; cnt = 0u; mine = 0u;
#pragma unroll
        for (unsigned j = 0; j < 16; ++j) { const unsigned c = xb_ld(&bar[XB_XCNT(j)]); sum += c; cnt += (c > 0u) ? 1u : 0u; mine = (j == x) ? c : mine; }
        if (sum == G) break;
        __builtin_amdgcn_s_sleep(1);
        if ((++sp & 255u) == 0u) { if (xb_ld(&bar[XB_TMO])) break; if (sp > XB_SPIN_CAP) { atomicAdd(&bar[XB_TMO], 1u); break; } }
    }
    nloc = mine > 0u ? mine : 1u; nx = cnt > 0u ? cnt : 1u;
}
DI void xcd_barrier(const XcdBarrier& b) {
    asm volatile("s_waitcnt vmcnt(0)" ::: "memory");
    __syncthreads();
    if (__builtin_amdgcn_workitem_id_x() == 0) {
        unsigned* bar = b.bar;
        unsigned bx = b.x; asm volatile("" : "+s"(bx));
        __builtin_amdgcn_s_waitcnt(0);
        unsigned nloc = b.st[0], nx = b.st[1];
        if (nloc == 0u) { xcd_barrier_complete(bar, bx, nloc, nx); b.st[0] = nloc; b.st[1] = nx; }
        const unsigned old = xb_add(&bar[XB_XSUB(bx)], 1u);
        const unsigned gen = old / nloc;
        if (old + 1u == (gen + 1u) * nloc) {
            __builtin_amdgcn_fence(__ATOMIC_RELEASE, "agent");
            asm volatile("s_waitcnt vmcnt(0)" ::: "memory");
            const unsigned og = xb_add(&bar[XB_TOP], 1u);
            const unsigned tg = og / nx;
            if (og + 1u == (tg + 1u) * nx) xb_add(&bar[XB_TOPGEN], 1u);
            else XB_SPIN(xb_ld(&bar[XB_TOPGEN]) == tg, bar);
            __builtin_amdgcn_fence(__ATOMIC_ACQUIRE, "agent");
            xb_add(&bar[XB_XGEN(bx)], 1u);
            asm volatile("s_waitcnt vmcnt(0)" ::: "memory");
        } else {
            XB_SPIN(xb_ld(&bar[XB_XGEN(bx)]) == gen, bar);
            __builtin_amdgcn_fence(__ATOMIC_ACQUIRE, "agent");
            asm volatile("s_waitcnt vmcnt(0)" ::: "memory");
        }
    }
    __syncthreads();
}

__global__ void __launch_bounds__(NTH) k_mega(Params p) {
    __shared__ __attribute__((aligned(16))) char smem[SMEM_BYTES];
    volatile LAS unsigned* xst = (volatile LAS unsigned*)(smem + SMEM_BYTES - 16);
    if (__builtin_amdgcn_workitem_id_x() == 0) { xst[0] = 0u; xst[1] = 0u; }
    __syncthreads();
    const XcdBarrier xb = xcd_barrier_post((unsigned*)(p.ws + OFF_BAR), xst);
    const int bid = blockIdx.x, nb = gridDim.x;
#ifndef PROBE_MASK
#define PROBE_MASK 0
#endif
#define REP(bit) for (int rep_ = 0; rep_ < ((PROBE_MASK & (bit)) ? 2 : 1); ++rep_)
    phase_prep_a(p, smem);           xcd_barrier(xb);
    phase_prep_b(p, smem);           xcd_barrier(xb);
    REP(1)  { phase_proj(p, bid, nb, smem);    xcd_barrier(xb); }
    REP(2)  { phase_mix(p, bid, nb, smem);     xcd_barrier(xb); }
    REP(4)  { phase_glu(p, bid, nb, smem);     xcd_barrier(xb); }
    REP(4)  { phase_outproj(p, bid, nb, smem); xcd_barrier(xb); }
    REP(8)  { phase_q(p, bid, nb, smem);       xcd_barrier(xb); }
    REP(16) { phase_retrieve(p, bid, nb, smem); xcd_barrier(xb); }
    phase_gather(p, bid, nb, smem, (unsigned*)(p.ws + OFF_BAR) + 16 * xb_xcc_id(), (unsigned)__builtin_amdgcn_readfirstlane((int)xst[0]));
}

extern "C" void kernel_launch(void* const* d_in, const int* in_sizes, int n_in, void* d_out, int out_size, void* d_ws, size_t ws_size, hipStream_t stream) {
    if (n_in != 27 || ws_size < WS_END) { fprintf(stderr, "kernel_launch: unexpected n_in %d or ws_size %zu (< %zu)\n", n_in, ws_size, (size_t)WS_END); return; }
    static int grid_blocks = 0;
    if (!grid_blocks) {
        int dev = 0, cus = 0, per_cu = 0;
        (void)hipGetDevice(&dev);
        (void)hipDeviceGetAttribute(&cus, hipDeviceAttributeMultiprocessorCount, dev);
        (void)hipOccupancyMaxActiveBlocksPerMultiprocessor(&per_cu, k_mega, NTH, 0);
        if (cus <= 0) cus = 256;
        if (per_cu < 1) { fprintf(stderr, "kernel_launch: occupancy query says %d blocks/CU\n", per_cu); per_cu = 1; }
        grid_blocks = cus;
    }
    Params p{};
    const float** f = (const float**)&p;
    for (int i = 0; i < 27; ++i) f[i] = (const float*)d_in[i];
    p.out = (float*)d_out; p.ws = (char*)d_ws;
    hipError_t e = hipMemsetAsync((char*)d_ws + OFF_BAR, 0, (size_t)3456 * 4, stream);
    if (e == hipSuccess) { hipLaunchKernelGGL(k_mega, dim3(grid_blocks), dim3(NTH), 0, stream, p); e = hipPeekAtLastError(); }
    if (e != hipSuccess) fprintf(stderr, "launch failed: %s (grid %d)\n", hipGetErrorString(e), grid_blocks);
}
```

```cpp
#include <hip/hip_runtime.h>
#include <hip/hip_cooperative_groups.h>
#include <stdint.h>
#include <stdio.h>

namespace cg = cooperative_groups;
#define DI __device__ __forceinline__
typedef unsigned short bf16_t;
typedef short bf16x8 __attribute__((ext_vector_type(8)));
typedef float f32x16 __attribute__((ext_vector_type(16)));
typedef unsigned u32x4 __attribute__((ext_vector_type(4)));
typedef float f32x4 __attribute__((ext_vector_type(4)));
typedef float f32x2 __attribute__((ext_vector_type(2)));

constexpr int NTH = 512;
constexpr int NB = 16, SEQ = 2048, DM = 1024, NTOK = NB * SEQ;
constexpr int DHG = 512, HGH = 4, HDK = 128;
constexpr int DSS = 512, SSG = 32, SSC = 16, SSP = 64;
constexpr int INC = 2560;
constexpr int PHEADS = 8, NKEYS = 128, TOPK = 16, NEXP = 16384;
constexpr float DEEP_ALPHA = 1.189207115002721f;
constexpr float LN_EPS = 1e-5f, RMS_EPS = 1e-6f;
constexpr int SMEM_BYTES = 128 * 1024 + 256;

constexpr size_t al256(size_t x) { return (x + 255) & ~(size_t)255; }
constexpr size_t OFF_MOD = 0;
constexpr size_t OFF_LB = al256(OFF_MOD + (size_t)NB * 6144 * 4);
constexpr size_t OFF_LAM = al256(OFF_LB + 512 * 4);
constexpr size_t OFF_BB = al256(OFF_LAM + 32 * 64 * 2 * 4);
constexpr size_t OFF_WIN = al256(OFF_BB + 32 * 64 * 16 * 2 * 4);
constexpr size_t OFF_GLU = al256(OFF_WIN + (size_t)INC * DM * 2);
constexpr size_t OFF_WOUT = al256(OFF_GLU + (size_t)512 * 512 * 2);
constexpr size_t OFF_WQ = al256(OFF_WOUT + (size_t)DM * DM * 2);
constexpr size_t OFF_SUBK = al256(OFF_WQ + (size_t)2048 * DM * 2);
constexpr size_t OFF_SU = al256(OFF_SUBK + (size_t)16 * 128 * 128 * 2);
constexpr size_t OFF_SV = al256(OFF_SU + (size_t)NEXP * 4);
constexpr size_t OFF_UT = al256(OFF_SV + (size_t)NEXP * 4);
constexpr size_t OFF_VT = al256(OFF_UT + (size_t)NEXP * DM * 2);
constexpr size_t OFF_H = al256(OFF_VT + (size_t)NEXP * DM * 2);
constexpr size_t OFF_PROJ = al256(OFF_H + (size_t)NTOK * DM * 2);
constexpr size_t OFF_ORAW = al256(OFF_PROJ + (size_t)NTOK * INC * 2);
constexpr size_t OFF_YSSM = al256(OFF_ORAW + (size_t)NTOK * DHG * 4);
constexpr size_t OFF_A2 = al256(OFF_YSSM + (size_t)NTOK * DSS * 2);
constexpr size_t OFF_HG = al256(OFF_A2 + (size_t)NTOK * DM * 2);
constexpr size_t OFF_S5K = al256(OFF_HG + (size_t)4096 * 128 * 4);
constexpr size_t OFF_S5N = al256(OFF_S5K + (size_t)32 * 4096 * 2);
constexpr size_t OFF_S5M = al256(OFF_S5N + (size_t)32 * 128 * 256 * 2);
constexpr size_t OFF_S5L = al256(OFF_S5M + (size_t)32 * 256 * 128 * 2);
constexpr size_t OFF_STAT = al256(OFF_S5L + (size_t)32 * 64 * 2 * 4);
constexpr size_t OFF_AB = al256(OFF_STAT + (size_t)NTOK * 3 * 4);
constexpr size_t OFF_CAB = al256(OFF_AB + (size_t)2 * NB * DM * 4);
constexpr size_t OFF_BAR = al256(OFF_CAB + (size_t)2 * NB * 2048 * 4);
constexpr size_t WS_END = al256(OFF_BAR + (size_t)3456 * 4);
constexpr size_t OFF_HQ = OFF_ORAW, OFF_HK = OFF_ORAW + (size_t)NTOK * DHG * 2;
constexpr size_t OFF_EXPS = OFF_YSSM;
constexpr size_t OFF_R1 = OFF_ORAW;

struct Params {
    const float *x, *c, *ada_w, *ada_b, *w_in, *hg_lb, *hg_nw, *a_re, *a_im, *log_dt, *b_re, *b_im, *c_re, *c_im, *dsk,
        *glu_w, *glu_b, *ssm_nw, *w_out, *ln1w, *ln1b, *w_q, *subk, *pu, *pv, *ln2w, *ln2b;
    float* out;
    char* ws;
};

DI int my_tid() { int t = (int)__builtin_amdgcn_workitem_id_x(); asm volatile("" : "+v"(t)); return t; }
DI bf16_t f2bf(float x) { unsigned u = __float_as_uint(x); u += 0x7fffu + ((u >> 16) & 1u); return (bf16_t)(u >> 16); }
DI float bf2f(bf16_t b) { return __uint_as_float(((unsigned)b) << 16); }
DI float bflo(unsigned w) { return __uint_as_float(w << 16); }
DI float bfhi(unsigned w) { return __uint_as_float(w & 0xffff0000u); }
typedef __bf16 hwbf16x2 __attribute__((ext_vector_type(2)));
DI unsigned pack2(float a, float b) { const f32x2 v = {a, b}; return __builtin_bit_cast(unsigned, __builtin_convertvector(v, hwbf16x2)); }
DI bf16x8 pack8(const f32x16& x, const int base) {
    u32x4 o; o.x = pack2(x[base], x[base + 1]); o.y = pack2(x[base + 2], x[base + 3]); o.z = pack2(x[base + 4], x[base + 5]); o.w = pack2(x[base + 6], x[base + 7]);
    return __builtin_bit_cast(bf16x8, o);
}
DI float sigmoidf_(float x) { return 1.0f / (1.0f + __expf(-x)); }
DI float siluf_(float x) { return x * sigmoidf_(x); }
DI float geluf_(float x) { return 0.5f * x * (1.0f + erff(x * 0.70710678118654752f)); }
DI float gelu_as(float v) {
    const float t = __builtin_amdgcn_rcpf(fabsf(v) * 0.2316418882f + 1.0f);
    float q = t * 0.5307027145f + (-0.7265760135f); q = q * t + 0.7107068705f; q = q * t + (-0.142248368f); q = q * t + 0.127414796f; q = q * t;
    const float m = v * (q * __builtin_amdgcn_exp2f(v * v * (-0.72134752044f)));
    return v < 0.f ? m : v - m;
}


namespace pg8 {
#define PG8_LAS __attribute__((address_space(3)))
typedef unsigned short bf16_t;
typedef short bf16x8 __attribute__((ext_vector_type(8)));
typedef float f32x4 __attribute__((ext_vector_type(4)));
typedef unsigned u32x4 __attribute__((ext_vector_type(4)));
constexpr int BM = 256, BK = 64, HALF = 128, HTB = HALF * BK * 2  , STAGE_BYTES = 8 * HTB, NXCD = 8, WGM = 8;

__host__ __device__ __forceinline__ int lds_byte(int r, int c) { const int st = (r >> 4) * 2 + (c >> 5), rr = r & 15, cc = c & 31, ob = rr * 64 + cc * 2; return st * 1024 + (ob ^ (((ob >> 9) & 1) << 5)); }
__host__ __device__ __forceinline__ void stage_rc(int b, int& R, int& C) { const int st = b / 1024, sb = b % 1024, swz = sb ^ (((sb >> 9) & 1) << 5); R = (st >> 1) * 16 + swz / 64; C = (st & 1) * 32 + (swz % 64) / 2; }
__host__ __device__ __forceinline__ int perm32(int rho) { const int n = rho >> 4, i = rho & 15; return 8 * (i >> 2) + 4 * n + (i & 3); }

struct Unit { int pm, pn; };
struct Gemm { const bf16_t* A; const bf16_t* Bt; int M, N, K; };

struct StaticOrder {
    int nM, nN, nwg, G, c;
    __host__ __device__ void init(int M, int N, int G_, int c_) { nM = M / BM; nN = N / BM; nwg = nM * nN; G = G_; c = c_; }
    __host__ __device__ bool next(int i, Unit& u) const {
        const long L = (long)i * G + c; if (L >= nwg) return false;
        int wgid = (int)L; { const int q = nwg / NXCD, r = nwg % NXCD, xcd = wgid % NXCD, off = wgid / NXCD; wgid = (xcd < r ? xcd * (q + 1) : r * (q + 1) + (xcd - r) * q) + off; }
        const int nig = WGM * nN, gid = wgid / nig, fm = gid * WGM, gsz = (nM - fm) < WGM ? (nM - fm) : WGM;
        u.pm = fm + ((wgid % nig) % gsz); u.pn = (wgid % nig) / gsz; return true;
    }
    __device__ __forceinline__ void a_ready(const Unit&) const {}
    __device__ __forceinline__ void done(const Unit&) const {}
};
template <class Epi, class Sched, bool STAMP = false>
__device__ __forceinline__ void gemm_phase(PG8_LAS unsigned char* lds, const Gemm g, const Sched& S, const Epi& E, unsigned long long* stamps) {
    int tid_ = (int)__builtin_amdgcn_workitem_id_x(); asm volatile("" : "+v"(tid_));
    const int tid = tid_, wid = __builtin_amdgcn_readfirstlane(tid >> 6), lane = tid & 63, wr = wid >> 2, wc = wid & 3, fr = lane & 15, fq = lane >> 4;
    const int K = g.K, nt = K / BK;
    int ts_lo = 0, ts_hi = 0, nts = 0; const unsigned long long rt_entry = STAMP ? (unsigned long long)wall_clock64() : 0ull;
#define PG8_STAMP() do { if (STAMP && wid == 0 && nts < 64) { const unsigned long long _c = (unsigned long long)clock64(); \
        ts_lo = (lane == nts) ? (int)(unsigned)_c : ts_lo; ts_hi = (lane == nts) ? (int)(unsigned)(_c >> 32) : ts_hi; ++nts; } } while (0)
    PG8_STAMP();
    unsigned voffA[2], voffB[2];
#pragma unroll
    for (int i = 0; i < 2; ++i) { int R, C; stage_rc(tid * 16 + i * 8192, R, C); const int Rb = Epi::PERM ? ((R & ~31) + perm32(R & 31)) : R;
        voffA[i] = (unsigned)(R * K + C) * 2u; voffB[i] = (unsigned)(Rb * K + C) * 2u; }
    const size_t kstep = (size_t)(BK * 2);
    const size_t hstep = (size_t)HALF * K * 2;
    const size_t tstep = 2 * hstep;
    const unsigned ldsw = (unsigned)wid * 1024u;
    const int aoff = lds_byte(wr * 64 + fr, fq * 8), boff = lds_byte(wc * 32 + fr, fq * 8);
#define PG8_SA(b, h) (((b) * 2 + (h)) * HTB)
#define PG8_SB(b, h) ((4 + (b) * 2 + (h)) * HTB)
#define PG8_STAGE(bufoff, gbase, voff) do { _Pragma("unroll") for (int _i = 0; _i < 2; ++_i) \
        __builtin_amdgcn_global_load_lds((const unsigned*)((const char*)(gbase) + (voff)[_i]), (PG8_LAS unsigned*)(lds + (bufoff) + ldsw + _i * 8192), 16, 0, 0); } while (0)
#define PG8_LDA(dst, b, h) do { _Pragma("unroll") for (int m = 0; m < 4; ++m) _Pragma("unroll") for (int k = 0; k < 2; ++k) dst[m][k] = *(const PG8_LAS bf16x8*)(lds + PG8_SA(b, h) + aoff + m * 2048 + k * 1024); } while (0)
#define PG8_LDB(dst, b, h) do { _Pragma("unroll") for (int n = 0; n < 2; ++n) _Pragma("unroll") for (int k = 0; k < 2; ++k) dst[n][k] = *(const PG8_LAS bf16x8*)(lds + PG8_SB(b, h) + boff + n * 2048 + k * 1024); } while (0)
#define PG8_MMA(ai, bj, At, Bt) do { __builtin_amdgcn_s_setprio(1); _Pragma("unroll") for (int m = 0; m < 4; ++m) _Pragma("unroll") for (int n = 0; n < 2; ++n) _Pragma("unroll") for (int k = 0; k < 2; ++k) \
        acc[ai][bj][m][n] = __builtin_amdgcn_mfma_f32_16x16x32_bf16(Bt[n][k], At[m][k], acc[ai][bj][m][n], 0, 0, 0); __builtin_amdgcn_s_setprio(0); } while (0)
#define PG8_WAIT_V(n) asm volatile("s_waitcnt vmcnt(" #n ")" ::: "memory")
#define PG8_WAIT_L(n) asm volatile("s_waitcnt lgkmcnt(" #n ")" ::: "memory")
#define PG8_BAR __builtin_amdgcn_s_barrier()
#define PG8_SCHED __builtin_amdgcn_sched_barrier(0)
    Unit cur, nxt; int ui = 0;
    if (!S.next(0, cur)) return;
    f32x4 acc[2][2][4][2];
#pragma unroll
    for (int a = 0; a < 2; ++a)
#pragma unroll
        for (int b = 0; b < 2; ++b)
#pragma unroll
            for (int m = 0; m < 4; ++m)
#pragma unroll
                for (int n = 0; n < 2; ++n) acc[a][b][m][n] = (f32x4){0.f, 0.f, 0.f, 0.f};
    bf16x8 At[4][2], B0[2][2], B1[2][2];
    const char* cA = (const char*)g.A + (size_t)cur.pm * tstep; const char* cB = (const char*)g.Bt + (size_t)cur.pn * tstep;
    S.a_ready(cur);
    PG8_STAGE(PG8_SB(0, 0), cB, voffB); PG8_STAGE(PG8_SA(0, 0), cA, voffA); PG8_STAGE(PG8_SB(0, 1), cB + hstep, voffB); PG8_STAGE(PG8_SA(0, 1), cA + hstep, voffA);
    if (wr == 1) PG8_BAR;
    PG8_WAIT_V(4); PG8_BAR;
    PG8_STAGE(PG8_SB(1, 0), cB + kstep, voffB); PG8_STAGE(PG8_SA(1, 0), cA + kstep, voffA); PG8_STAGE(PG8_SB(1, 1), cB + hstep + kstep, voffB);
    PG8_WAIT_V(6); PG8_BAR;
    PG8_STAMP();
    for (;;) {
        const bool has_next = S.next(ui + 1, nxt);
        const char* nA = has_next ? (const char*)g.A + (size_t)nxt.pm * tstep : cA; const char* nB = has_next ? (const char*)g.Bt + (size_t)nxt.pn * tstep : cB;
        for (int t = 0; t < nt; t += 2) {
            const bool last = (t == nt - 2);
            const char* a1 = cA + (size_t)(t + 1) * kstep;
            const char* a2 = last ? nA : cA + (size_t)(t + 2) * kstep; const char* b2 = last ? nB : cB + (size_t)(t + 2) * kstep;
            const char* a3 = a2 + kstep; const char* b3 = b2 + kstep;
            if (last && has_next) S.a_ready(nxt);
            if constexpr (Epi::MIDSCALE) { if (t == nt / 2) E.midscale(acc, cur, wr, fr); }
            PG8_LDB(B0, 0, 0); PG8_SCHED; PG8_LDA(At, 0, 0); PG8_STAGE(PG8_SA(1, 1), a1 + hstep, voffA);
            PG8_WAIT_L(8); PG8_BAR; PG8_WAIT_L(0); PG8_MMA(0, 0, At, B0); PG8_BAR; PG8_SCHED;
            PG8_LDB(B1, 0, 1); PG8_STAGE(PG8_SB(0, 0), b2, voffB);
            PG8_BAR; PG8_WAIT_L(0); PG8_MMA(0, 1, At, B1); PG8_BAR;
            PG8_LDA(At, 0, 1); PG8_STAGE(PG8_SA(0, 0), a2, voffA);
            PG8_BAR; PG8_WAIT_L(0); PG8_MMA(1, 0, At, B0); PG8_BAR; PG8_SCHED;
            PG8_STAGE(PG8_SB(0, 1), b2 + hstep, voffB);
            PG8_WAIT_V(6); PG8_BAR; PG8_MMA(1, 1, At, B1); PG8_BAR;
            PG8_LDB(B0, 1, 0); PG8_SCHED; PG8_LDA(At, 1, 0); PG8_STAGE(PG8_SA(0, 1), a2 + hstep, voffA);
            PG8_WAIT_L(8); PG8_BAR; PG8_WAIT_L(0); PG8_MMA(0, 0, At, B0); PG8_BAR; PG8_SCHED;
            PG8_LDB(B1, 1, 1); PG8_STAGE(PG8_SB(1, 0), b3, voffB);
            PG8_BAR; PG8_WAIT_L(0); PG8_MMA(0, 1, At, B1); PG8_BAR;
            PG8_LDA(At, 1, 1); PG8_STAGE(PG8_SA(1, 0), a3, voffA);
            PG8_BAR; PG8_WAIT_L(0); PG8_MMA(1, 0, At, B0); PG8_BAR; PG8_SCHED;
            PG8_STAGE(PG8_SB(1, 1), b3 + hstep, voffB);
            PG8_WAIT_V(6); PG8_BAR; PG8_MMA(1, 1, At, B1); PG8_BAR;
        }
        PG8_STAMP();
        if constexpr (!Epi::AFTER_DRAIN) { E(acc, cur, wr, wc, fr, fq); S.done(cur); }
        PG8_STAMP();
        if (!has_next) break;
#pragma unroll
        for (int a = 0; a < 2; ++a)
#pragma unroll
            for (int b = 0; b < 2; ++b)
#pragma unroll
                for (int m = 0; m < 4; ++m)
#pragma unroll
                    for (int n = 0; n < 2; ++n) acc[a][b][m][n] = (f32x4){0.f, 0.f, 0.f, 0.f};
        cur = nxt; cA = nA; cB = nB; ++ui;
    }
    PG8_WAIT_V(0);
    if (wr == 0) PG8_BAR;
    PG8_BAR;
    if constexpr (Epi::AFTER_DRAIN) { E.fused(acc, cur, wr, wc, fr, fq, lds, wid, lane); S.done(cur); }
    PG8_STAMP();
    if (STAMP && wid == 0) { stamps[lane] = lane < nts ? (((unsigned long long)(unsigned)ts_hi << 32) | (unsigned)ts_lo) : 0ull;
        if (lane == 62) stamps[62] = rt_entry; if (lane == 63) stamps[63] = (unsigned long long)wall_clock64(); }
#undef PG8_STAMP
#undef PG8_SA
#undef PG8_SB
#undef PG8_STAGE
#undef PG8_LDA
#undef PG8_LDB
#undef PG8_MMA
#undef PG8_WAIT_V
#undef PG8_WAIT_L
#undef PG8_BAR
#undef PG8_SCHED
}

__device__ __forceinline__ unsigned pk_bf16(float lo, float hi) { typedef float v2f __attribute__((ext_vector_type(2))); typedef __bf16 v2b __attribute__((ext_vector_type(2))); const v2f v = {lo, hi}; return __builtin_bit_cast(unsigned, __builtin_convertvector(v, v2b)); }
__device__ __forceinline__ float silu1(float x) { return x * __builtin_amdgcn_rcpf(1.0f + __expf(-x)); }
struct EpiBf16Act {
    static constexpr bool PERM = true, AFTER_DRAIN = false, MIDSCALE = false;
    bf16_t* O; int ldc; unsigned silu_mask;
    __device__ __forceinline__ void operator()(const f32x4 (&acc)[2][2][4][2], const Unit& u, int wr, int wc, int fr, int fq) const {
        const int row0 = u.pm * BM + wr * 64 + fr, col0 = u.pn * BM + wc * 32 + 8 * fq;
        const bool act = (silu_mask >> u.pn) & 1u;
#pragma unroll
        for (int ai = 0; ai < 2; ++ai)
#pragma unroll
            for (int m = 0; m < 4; ++m) { bf16_t* rowp = O + (size_t)(row0 + ai * HALF + m * 16) * ldc + col0;
#pragma unroll
                for (int bj = 0; bj < 2; ++bj) { f32x4 v0 = acc[ai][bj][m][0], v1 = acc[ai][bj][m][1];
                    if (act) {
#pragma unroll
                        for (int j = 0; j < 4; ++j) { v0[j] = silu1(v0[j]); v1[j] = silu1(v1[j]); } }
                    u32x4 w; w.x = pk_bf16(v0[0], v0[1]); w.y = pk_bf16(v0[2], v0[3]); w.z = pk_bf16(v1[0], v1[1]); w.w = pk_bf16(v1[2], v1[3]);
                    *(u32x4*)(rowp + bj * HALF) = w; } }
    }
};
struct EpiProj {
    static constexpr bool PERM = true, AFTER_DRAIN = false, MIDSCALE = false;
    bf16_t* O; bf16_t* HQ; bf16_t* HK; float* HG; const float* LB;
    __device__ __forceinline__ void operator()(const f32x4 (&acc)[2][2][4][2], const Unit& u, int wr, int wc, int fr, int fq) const {
        if (u.pn >= 4) {
            const int row0 = u.pm * BM + wr * 64 + fr, col0 = u.pn * BM + wc * 32 + 8 * fq;
            const bool act = (u.pn == 6) || (u.pn == 7);
#pragma unroll
            for (int ai = 0; ai < 2; ++ai)
#pragma unroll
                for (int m = 0; m < 4; ++m) { bf16_t* rowp = O + (size_t)(row0 + ai * HALF + m * 16) * 2560 + col0;
#pragma unroll
                    for (int bj = 0; bj < 2; ++bj) { f32x4 v0 = acc[ai][bj][m][0], v1 = acc[ai][bj][m][1];
                        if (act) {
#pragma unroll
                            for (int j = 0; j < 4; ++j) { v0[j] = silu1(v0[j]); v1[j] = silu1(v1[j]); } }
                        u32x4 w; w.x = pk_bf16(v0[0], v0[1]); w.y = pk_bf16(v0[2], v0[3]); w.z = pk_bf16(v1[0], v1[1]); w.w = pk_bf16(v1[2], v1[3]);
                        *(u32x4*)(rowp + bj * HALF) = w; } }
            return;
        }
        const int hd = u.pn, bat = (u.pm * BM) / 2048, cb = (u.pm & 7) * 8, k0 = wc * 32 + 8 * fq, lane = fq * 16 + fr;
        float lb[8];
        { const f32x4 l0 = *(const f32x4*)(LB + hd * 128 + k0), l1 = *(const f32x4*)(LB + hd * 128 + k0 + 4);
          lb[0] = l0[0]; lb[1] = l0[1]; lb[2] = l0[2]; lb[3] = l0[3]; lb[4] = l1[0]; lb[5] = l1[1]; lb[6] = l1[2]; lb[7] = l1[3]; }
#pragma unroll
        for (int ac = 0; ac < 4; ++ac) {
            const int ai = ac >> 1, cp = ac & 1;
            __builtin_amdgcn_sched_barrier(0);
            const size_t tile = ((size_t)(bat * 4 + hd) * 64 + cb + 4 * ai + 2 * wr + cp);
            uint2 pq[2], pk[2];
#pragma unroll
            for (int eh = 0; eh < 2; ++eh) {
                __builtin_amdgcn_sched_barrier(0);
                float tot0[4];
                bf16_t* hq = HQ + tile * 4096 + k0;
                bf16_t* hk = HK + tile * 4096 + k0;
#pragma unroll
                for (int mm = 0; mm < 2; ++mm) {
                    const f32x4 q4 = acc[ai][0][2 * cp + mm][eh], f4 = acc[ai][1][2 * cp + mm][eh];
                    float qo[4], ko[4], bl[4];
#pragma unroll
                    for (int e = 0; e < 4; ++e) {
                        const float lbe = lb[4 * eh + e];
                        const float f = lbe + (1.0f - lbe) * __builtin_amdgcn_rcpf(1.0f + __expf(-f4[e]));
                        float sc = __builtin_amdgcn_logf(f);
                        sc += __builtin_bit_cast(float, __builtin_amdgcn_update_dpp(0, __builtin_bit_cast(int, sc), 0x111, 0xf, 0xf, true));
                        sc += __builtin_bit_cast(float, __builtin_amdgcn_update_dpp(0, __builtin_bit_cast(int, sc), 0x112, 0xf, 0xf, true));
                        sc += __builtin_bit_cast(float, __builtin_amdgcn_update_dpp(0, __builtin_bit_cast(int, sc), 0x114, 0xf, 0xf, true));
                        sc += __builtin_bit_cast(float, __builtin_amdgcn_update_dpp(0, __builtin_bit_cast(int, sc), 0x118, 0xf, 0xf, true));
                        if (mm == 1) sc += tot0[e];
                        bl[e] = sc;
                        qo[e] = silu1(q4[e]) * __builtin_amdgcn_exp2f(sc); ko[e] = (1.0f - f) * __builtin_amdgcn_exp2f(fminf(-sc, 115.4156f));
                    }
                    if (eh == 0) { pq[mm] = make_uint2(pk_bf16(qo[0], qo[1]), pk_bf16(qo[2], qo[3])); pk[mm] = make_uint2(pk_bf16(ko[0], ko[1]), pk_bf16(ko[2], ko[3])); }
                    else {
                        *(u32x4*)(hq + (size_t)(mm * 16 + fr) * 128) = (u32x4){pq[mm].x, pq[mm].y, pk_bf16(qo[0], qo[1]), pk_bf16(qo[2], qo[3])};
                        *(u32x4*)(hk + (size_t)(mm * 16 + fr) * 128) = (u32x4){pk[mm].x, pk[mm].y, pk_bf16(ko[0], ko[1]), pk_bf16(ko[2], ko[3])};
                    }
                    if (mm == 0) {
#pragma unroll
                        for (int e = 0; e < 4; ++e) tot0[e] = __shfl(bl[e], (lane & 48) | 15);
                    } else if (fr == 15) *(f32x4*)(HG + tile * 128 + k0 + 4 * eh) = (f32x4){__builtin_amdgcn_exp2f(bl[0]), __builtin_amdgcn_exp2f(bl[1]), __builtin_amdgcn_exp2f(bl[2]), __builtin_amdgcn_exp2f(bl[3])};
                    __builtin_amdgcn_sched_barrier(0);
                }
            }
        }
    }
};
struct EpiResid {
    static constexpr bool PERM = true, AFTER_DRAIN = false, MIDSCALE = true;
    bf16_t* R1; const float* X; const float* mod_g;
    static constexpr int NTOK_ = 32768;
    float alpha; bf16_t* AP; const float* avec; float* stat;
    const float* ssq; float rms_eps;
    __device__ __forceinline__ void midscale(f32x4 (&acc)[2][2][4][2], const Unit& u, int wr, int fr) const {
        const float* sp = ssq + u.pm * BM + wr * 64 + fr;
#pragma unroll
        for (int ai = 0; ai < 2; ++ai)
#pragma unroll
            for (int m = 0; m < 4; ++m) {
                const float rs = rsqrtf(sp[ai * HALF + m * 16] * (1.0f / 512.0f) + rms_eps);
#pragma unroll
                for (int bj = 0; bj < 2; ++bj)
#pragma unroll
                    for (int n = 0; n < 2; ++n) acc[ai][bj][m][n] *= rs;
            }
    }
    __device__ __forceinline__ void operator()(const f32x4 (&acc)[2][2][4][2], const Unit& u, int wr, int wc, int fr, int fq) const {
        const int row0 = u.pm * BM + wr * 64 + fr, col0 = u.pn * BM + wc * 32 + 8 * fq, bat = (u.pm * BM) / 2048;
        const float* gb = mod_g + (size_t)bat * 6144 + col0;
        const float* ab = avec + (size_t)bat * 1024 + col0;
        float s1[2][4], s2[2][4];
#pragma unroll
        for (int ai = 0; ai < 2; ++ai)
#pragma unroll
            for (int m = 0; m < 4; ++m) { s1[ai][m] = 0.f; s2[ai][m] = 0.f; }
        f32x4 xq[2][2];
        const unsigned robase = (unsigned)row0 * 1024u + (unsigned)col0;
#define RESID_RO(G_) (robase + (unsigned)((((G_) >> 2) & 1) * HALF + ((G_) & 3) * 16) * 1024u + (unsigned)(((G_) >> 3) * HALF))
#define RESID_LOADX(G_, S_) { const unsigned bo_ = RESID_RO(G_) << 2; xq[S_][0] = *(const f32x4*)((const char*)X + bo_); xq[S_][1] = *(const f32x4*)((const char*)X + bo_ + 16); }
        RESID_LOADX(0, 0);
#pragma unroll
        for (int bj = 0; bj < 2; ++bj) {
            const f32x4 g0 = *(const f32x4*)(gb + bj * HALF) + 1.0f, g1 = *(const f32x4*)(gb + bj * HALF + 4) + 1.0f;
            const f32x4 a0 = *(const f32x4*)(ab + bj * HALF), a1 = *(const f32x4*)(ab + bj * HALF + 4);
#pragma unroll
            for (int sub = 0; sub < 8; ++sub) {
                const int grp = bj * 8 + sub, ai = sub >> 2, m = sub & 3;
                if (grp + 1 < 16) { if ((grp & 1) == 0) RESID_LOADX(grp + 1, 1) else RESID_LOADX(grp + 1, 0) }
                {
                    const unsigned bo = RESID_RO(grp) << 1;
                    const f32x4 x0 = xq[grp & 1][0], x1 = xq[grp & 1][1];
                    const f32x4 r0 = alpha * x0 + g0 * acc[ai][bj][m][0], r1 = alpha * x1 + g1 * acc[ai][bj][m][1];
                    u32x4 w; w.x = pk_bf16(r0[0], r0[1]); w.y = pk_bf16(r0[2], r0[3]); w.z = pk_bf16(r1[0], r1[1]); w.w = pk_bf16(r1[2], r1[3]);
                    *(u32x4*)((char*)R1 + bo) = w;
                    const f32x4 p0 = r0 * a0, p1 = r1 * a1;
                    w.x = pk_bf16(p0[0], p0[1]); w.y = pk_bf16(p0[2], p0[3]); w.z = pk_bf16(p1[0], p1[1]); w.w = pk_bf16(p1[2], p1[3]);
                    *(u32x4*)((char*)AP + bo) = w;
                    s1[ai][m] += ((r0[0] + r0[1]) + (r0[2] + r0[3])) + ((r1[0] + r1[1]) + (r1[2] + r1[3]));
                    s2[ai][m] += ((r0[0] * r0[0] + r0[1] * r0[1]) + (r0[2] * r0[2] + r0[3] * r0[3])) + ((r1[0] * r1[0] + r1[1] * r1[1]) + (r1[2] * r1[2] + r1[3] * r1[3]));
                }
            }
        }
#undef RESID_LOADX
#undef RESID_RO
        const bool hi5 = fq & 2, hi4 = fq & 1;
#pragma unroll
        for (int ai = 0; ai < 2; ++ai) {
            const float a1 = (hi5 ? s1[ai][2] : s1[ai][0]) + __shfl_xor(hi5 ? s1[ai][0] : s1[ai][2], 32), b1 = (hi5 ? s1[ai][3] : s1[ai][1]) + __shfl_xor(hi5 ? s1[ai][1] : s1[ai][3], 32);
            const float a2 = (hi5 ? s2[ai][2] : s2[ai][0]) + __shfl_xor(hi5 ? s2[ai][0] : s2[ai][2], 32), b2 = (hi5 ? s2[ai][3] : s2[ai][1]) + __shfl_xor(hi5 ? s2[ai][1] : s2[ai][3], 32);
            const float t1 = (hi4 ? b1 : a1) + __shfl_xor(hi4 ? a1 : b1, 16), t2 = (hi4 ? b2 : a2) + __shfl_xor(hi4 ? a2 : b2, 16);
            const int srow = u.pm * BM + wr * 64 + ai * HALF + fq * 16 + fr;
            atomicAdd(stat + srow, t1); atomicAdd(stat + NTOK_ + srow, t2);
        }
    }
};
struct EpiQLN {
    static constexpr bool PERM = true, AFTER_DRAIN = false, MIDSCALE = false;
    bf16_t* O; const float* stat; const float* ca; const float* cb; float eps;
    __device__ __forceinline__ void operator()(const f32x4 (&acc)[2][2][4][2], const Unit& u, int wr, int wc, int fr, int fq) const {
        const int row0 = u.pm * BM + wr * 64 + fr, col0 = u.pn * BM + wc * 32 + 8 * fq, bat = (u.pm * BM) / 2048;
        const float* cap = ca + (size_t)bat * 2048 + col0;
        const float* cbp = cb + (size_t)bat * 2048 + col0;
        float s1[2][4], s2[2][4];
#pragma unroll
        for (int ai = 0; ai < 2; ++ai)
#pragma unroll
            for (int m = 0; m < 4; ++m) { const int row = row0 + ai * HALF + m * 16; s1[ai][m] = stat[row]; s2[ai][m] = stat[32768 + row]; }
        f32x4 av[2][2], bv[2][2];
#pragma unroll
        for (int bj = 0; bj < 2; ++bj) { av[bj][0] = *(const f32x4*)(cap + bj * HALF); av[bj][1] = *(const f32x4*)(cap + bj * HALF + 4); bv[bj][0] = *(const f32x4*)(cbp + bj * HALF); bv[bj][1] = *(const f32x4*)(cbp + bj * HALF + 4); }
#pragma unroll
        for (int ai = 0; ai < 2; ++ai)
#pragma unroll
            for (int m = 0; m < 4; ++m) {
                const int row = row0 + ai * HALF + m * 16;
                const float mu = s1[ai][m] * (1.0f / 1024.0f), rstd = rsqrtf(fmaxf(s2[ai][m] * (1.0f / 1024.0f) - mu * mu, 0.f) + eps);
#pragma unroll
                for (int bj = 0; bj < 2; ++bj) {
                    const f32x4 v0 = rstd * (acc[ai][bj][m][0] - mu * av[bj][0]) + bv[bj][0], v1 = rstd * (acc[ai][bj][m][1] - mu * av[bj][1]) + bv[bj][1];
                    u32x4 w; w.x = pk_bf16(v0[0], v0[1]); w.y = pk_bf16(v0[2], v0[3]); w.z = pk_bf16(v1[0], v1[1]); w.w = pk_bf16(v1[2], v1[3]);
                    *(u32x4*)((char*)O + (((unsigned)row * 2048u + (unsigned)(col0 + bj * HALF)) << 1)) = w;
                }
            }
    }
};
struct EpiGluA2 {
    static constexpr bool PERM = true, AFTER_DRAIN = false, MIDSCALE = false;
    bf16_t* A2; const bf16_t* Y; const float* bias; const float* nw; float* ssq;
    __device__ __forceinline__ void operator()(const f32x4 (&acc)[2][2][4][2], const Unit& u, int wr, int wc, int fr, int fq) const {
        const int row0 = u.pm * BM + wr * 64 + fr, col0 = u.pn * BM + wc * 32 + 8 * fq;
        float s2[2][4];
#pragma unroll
        for (int ai = 0; ai < 2; ++ai)
#pragma unroll
            for (int m = 0; m < 4; ++m) s2[ai][m] = 0.f;
#pragma unroll
        for (int bj = 0; bj < 2; ++bj) {
            const f32x4 bv0 = *(const f32x4*)(bias + col0 + bj * HALF), bv1 = *(const f32x4*)(bias + col0 + bj * HALF + 4);
            const f32x4 wv0 = *(const f32x4*)(nw + col0 + bj * HALF), wv1 = *(const f32x4*)(nw + col0 + bj * HALF + 4);
#pragma unroll
            for (int ai = 0; ai < 2; ++ai) {
                u32x4 yv[4];
#pragma unroll
                for (int m = 0; m < 4; ++m) yv[m] = *(const u32x4*)((const char*)Y + (((unsigned)(row0 + ai * HALF + m * 16) * 512u + (unsigned)(col0 + bj * HALF)) << 1));
#pragma unroll
                for (int m = 0; m < 4; ++m) { const int row = row0 + ai * HALF + m * 16;
                    const u32x4 yw = yv[m];
                    const f32x4 z0 = acc[ai][bj][m][0] + bv0, z1 = acc[ai][bj][m][1] + bv1;
                    f32x4 o0, o1;
                    o0[0] = __uint_as_float(yw.x << 16) * __builtin_amdgcn_rcpf(1.0f + __expf(-z0[0])); o0[1] = __uint_as_float(yw.x & 0xffff0000u) * __builtin_amdgcn_rcpf(1.0f + __expf(-z0[1]));
                    o0[2] = __uint_as_float(yw.y << 16) * __builtin_amdgcn_rcpf(1.0f + __expf(-z0[2])); o0[3] = __uint_as_float(yw.y & 0xffff0000u) * __builtin_amdgcn_rcpf(1.0f + __expf(-z0[3]));
                    o1[0] = __uint_as_float(yw.z << 16) * __builtin_amdgcn_rcpf(1.0f + __expf(-z1[0])); o1[1] = __uint_as_float(yw.z & 0xffff0000u) * __builtin_amdgcn_rcpf(1.0f + __expf(-z1[1]));
                    o1[2] = __uint_as_float(yw.w << 16) * __builtin_amdgcn_rcpf(1.0f + __expf(-z1[2])); o1[3] = __uint_as_float(yw.w & 0xffff0000u) * __builtin_amdgcn_rcpf(1.0f + __expf(-z1[3]));
                    s2[ai][m] += (o0[0] * o0[0] + o0[1] * o0[1]) + (o0[2] * o0[2] + o0[3] * o0[3]) + (o1[0] * o1[0] + o1[1] * o1[1]) + (o1[2] * o1[2] + o1[3] * o1[3]);
                    const f32x4 p0 = o0 * wv0, p1 = o1 * wv1;
                    u32x4 w; w.x = pk_bf16(p0[0], p0[1]); w.y = pk_bf16(p0[2], p0[3]); w.z = pk_bf16(p1[0], p1[1]); w.w = pk_bf16(p1[2], p1[3]);
                    *(u32x4*)((char*)A2 + (((unsigned)row * 1024u + (unsigned)(col0 + bj * HALF)) << 1)) = w;
                }
            }
        }
        const bool hi5 = fq & 2, hi4 = fq & 1;
#pragma unroll
        for (int ai = 0; ai < 2; ++ai) {
            const float a2 = (hi5 ? s2[ai][2] : s2[ai][0]) + __shfl_xor(hi5 ? s2[ai][0] : s2[ai][2], 32), b2 = (hi5 ? s2[ai][3] : s2[ai][1]) + __shfl_xor(hi5 ? s2[ai][1] : s2[ai][3], 32);
            const float t2 = (hi4 ? b2 : a2) + __shfl_xor(hi4 ? a2 : b2, 16);
            atomicAdd(ssq + u.pm * BM + wr * 64 + ai * HALF + fq * 16 + fr, t2);
        }
    }
};
}

DI void prep_mod_item(const Params& p, int item, char* smem) {
    float* condT = (float*)smem;
    float* red = condT + DM * 16;
    const int tid = my_tid();
    for (int i = tid; i < NB * DM; i += NTH) { const int b = i >> 10, k = i & 1023; condT[k * 16 + b] = siluf_(p.c[i]); }
    __syncthreads();
    const int ks = tid >> 5, col = tid & 31;
    float acc[16];
#pragma unroll
    for (int b = 0; b < 16; ++b) acc[b] = 0.f;
    const float* w = p.ada_w + (size_t)(ks * 64) * 6144 + item * 32 + col;
#pragma unroll 1
    for (int seg = 0; seg < 4; ++seg) {
        float wreg[16];
#pragma unroll
        for (int k = 0; k < 16; ++k) wreg[k] = w[(size_t)(seg * 16 + k) * 6144];
#pragma unroll
        for (int k = 0; k < 16; ++k) {
            const float wv = wreg[k];
            const f32x4* cb = (const f32x4*)(condT + (ks * 64 + seg * 16 + k) * 16);
            const f32x4 c0 = cb[0], c1 = cb[1], c2 = cb[2], c3 = cb[3];
            acc[0] += c0.x * wv; acc[1] += c0.y * wv; acc[2] += c0.z * wv; acc[3] += c0.w * wv;
            acc[4] += c1.x * wv; acc[5] += c1.y * wv; acc[6] += c1.z * wv; acc[7] += c1.w * wv;
            acc[8] += c2.x * wv; acc[9] += c2.y * wv; acc[10] += c2.z * wv; acc[11] += c2.w * wv;
            acc[12] += c3.x * wv; acc[13] += c3.y * wv; acc[14] += c3.z * wv; acc[15] += c3.w * wv;
        }
    }
#pragma unroll
    for (int b = 0; b < 16; ++b) red[(ks * 32 + col) * 16 + b] = acc[b];
    __syncthreads();
    {
        const int b = tid >> 5;
        float sum = p.ada_b[item * 32 + col];
#pragma unroll
        for (int q = 0; q < 16; ++q) sum += red[(q * 32 + col) * 16 + b];
        ((float*)(p.ws + OFF_MOD))[b * 6144 + item * 32 + col] = sum;
    }
    __syncthreads();
}
DI void prep_s5_gemm_item(const Params& p, int g, int part, char* smem) {
    f32x2* pw = (f32x2*)smem;
    f32x2* bbL = pw + 17 * 64;
    f32x2* cL = bbL + 64 * 16;
    const int tid = my_tid();
    const float dt = expf(p.log_dt[g]);
#pragma unroll 1
    for (int idx = tid; idx < 17 * 64; idx += NTH) {
        const int j = idx >> 6, pp = idx & 63;
        const float ar = p.a_re[g * 64 + pp], ai = p.a_im[g * 64 + pp];
        const float mag = expf(ar * dt * (float)j), ang = ai * dt * (float)j;
        pw[idx] = (f32x2){mag * cosf(ang), mag * sinf(ang)};
    }
    for (int idx = tid; idx < 16 * 64; idx += NTH) { const int i = idx >> 6, pp = idx & 63; cL[idx] = (f32x2){p.c_re[(g * 16 + i) * 64 + pp], p.c_im[(g * 16 + i) * 64 + pp]}; }
    __syncthreads();
    for (int idx = tid; idx < 64 * 16; idx += NTH) {
        const int pp = idx >> 4, i = idx & 15;
        const float ar = p.a_re[g * 64 + pp], ai = p.a_im[g * 64 + pp];
        const f32x2 lam = pw[64 + pp];
        const float den = ar * ar + ai * ai, nr = lam.x - 1.0f, ni = lam.y;
        const float zr = (nr * ar + ni * ai) / den, zi = (ni * ar - nr * ai) / den;
        const float br = p.b_re[(g * 64 + pp) * 16 + i], bi = p.b_im[(g * 64 + pp) * 16 + i];
        bbL[idx] = (f32x2){zr * br - zi * bi, zr * bi + zi * br};
    }
    __syncthreads();
    bf16_t* NBg = (bf16_t*)(p.ws + OFF_S5N) + (size_t)g * 128 * 256;
    if (part == 0)
#pragma unroll 1
    for (int ch = tid; ch < 128 * 256 / 8; ch += NTH) {
        const int pq = ch >> 5, t = (ch >> 1) & 15, i0 = (ch & 1) * 8, pp = pq & 63;
        const f32x2 w = pw[(15 - t) * 64 + pp];
        float v[8];
#pragma unroll
        for (int e = 0; e < 8; ++e) { const f32x2 bb = bbL[pp * 16 + i0 + e]; v[e] = pq < 64 ? (w.x * bb.x - w.y * bb.y) : (w.x * bb.y + w.y * bb.x); }
        u32x4 o; o.x = pack2(v[0], v[1]); o.y = pack2(v[2], v[3]); o.z = pack2(v[4], v[5]); o.w = pack2(v[6], v[7]);
        *(u32x4*)(NBg + (size_t)((((pq >> 5) * 16 + t) * 64) + (i0 >> 3) * 32 + (pq & 31)) * 8) = o;
    }
    bf16_t* MBg = (bf16_t*)(p.ws + OFF_S5M) + (size_t)g * 256 * 128;
    if (part == 1)
#pragma unroll 1
    for (int ch = tid; ch < 256 * 128 / 8; ch += NTH) {
        const int ti = ch >> 4, p0 = (ch & 15) * 8, tq = ti >> 4, iq = ti & 15;
        float v[8];
#pragma unroll
        for (int e = 0; e < 8; ++e) {
            const int pq = p0 + e, pp = pq & 63;
            const f32x2 c = cL[iq * 64 + pp], w = pw[(tq + 1) * 64 + pp];
            v[e] = pq < 64 ? (c.x * w.x - c.y * w.y) : -(c.x * w.y + c.y * w.x);
        }
        u32x4 o; o.x = pack2(v[0], v[1]); o.y = pack2(v[2], v[3]); o.z = pack2(v[4], v[5]); o.w = pack2(v[6], v[7]);
        *(u32x4*)(MBg + (size_t)((((ti >> 5) * 8 + (p0 >> 4)) * 64) + ((p0 >> 3) & 1) * 32 + (ti & 31)) * 8) = o;
    }
    bf16_t* KTg = (bf16_t*)(p.ws + OFF_S5K) + (size_t)g * 4096;
    if (part >= 2)
#pragma unroll 1
    for (int idx = (part - 2) * 2048 + tid; idx < (part - 1) * 2048; idx += NTH) {
        const int lag = idx >> 8, iq = (idx >> 4) & 15, i = idx & 15;
        float acc = (lag == 0 && iq == i) ? p.dsk[g * 16 + iq] : 0.f;
#pragma unroll 4
        for (int pp = 0; pp < 64; ++pp) {
            const f32x2 c = cL[iq * 64 + pp], w = pw[lag * 64 + pp], bb = bbL[pp * 16 + i];
            const float mr = c.x * w.x - c.y * w.y, mi_ = c.x * w.y + c.y * w.x;
            acc += mr * bb.x - mi_ * bb.y;
        }
        KTg[idx] = f2bf(acc);
    }
    if (part == 3 && tid < 64) { float* L = (float*)(p.ws + OFF_S5L) + (g * 64 + tid) * 2; const f32x2 w = pw[16 * 64 + tid]; L[0] = w.x; L[1] = w.y; }
    __syncthreads();
}
DI void prep_transpose_tile(const float* __restrict__ W, bf16_t* __restrict__ Wt, int K, int N, int kt, int nt, char* smem, int dst_row0 = -1, int kswap = 0) {
    float* tile = (float*)smem;
    const int tid = my_tid();
#pragma unroll
    for (int q = 0; q < 2; ++q) {
        const int kk = (tid >> 4) + q * 32, c4 = (tid & 15) * 4;
        const float4 v = *(const float4*)(W + (size_t)(kt * 64 + kk) * N + nt * 64 + c4);
        tile[kk * 65 + c4] = v.x; tile[kk * 65 + c4 + 1] = v.y; tile[kk * 65 + c4 + 2] = v.z; tile[kk * 65 + c4 + 3] = v.w;
    }
    __syncthreads();
    const int n = tid >> 3, kc = tid & 7;
    uint4 o;
    o.x = pack2(tile[(kc * 8 + 0) * 65 + n], tile[(kc * 8 + 1) * 65 + n]);
    o.y = pack2(tile[(kc * 8 + 2) * 65 + n], tile[(kc * 8 + 3) * 65 + n]);
    o.z = pack2(tile[(kc * 8 + 4) * 65 + n], tile[(kc * 8 + 5) * 65 + n]);
    o.w = pack2(tile[(kc * 8 + 6) * 65 + n], tile[(kc * 8 + 7) * 65 + n]);
    *(uint4*)(Wt + (size_t)((dst_row0 < 0 ? nt * 64 : dst_row0) + n) * K + ((kt * 64 + kswap) & (K - 1)) + kc * 8) = o;
    __syncthreads();
}
DI void cvt_bf16_stream(const float* __restrict__ src, bf16_t* __restrict__ dst, size_t n8, int bid, int nb) {
    for (size_t i = (size_t)bid * NTH + my_tid(); i < n8; i += (size_t)nb * NTH) {
        const float4 a = *(const float4*)(src + i * 8), b = *(const float4*)(src + i * 8 + 4);
        uint4 o; o.x = pack2(a.x, a.y); o.y = pack2(a.z, a.w); o.z = pack2(b.x, b.y); o.w = pack2(b.z, b.w);
        *(uint4*)(dst + i * 8) = o;
    }
}
template <int OFFS>
DI void cvt_i8_rows(const float* __restrict__ src, unsigned char* __restrict__ dst, float* __restrict__ inv, int bid, int nb) {
    const int lane = my_tid() & 63, wid = my_tid() >> 6;
    for (int row = bid * 8 + wid; row < NEXP; row += nb * 8) {
        const float* sp = src + (size_t)row * DM + lane * 4;
        const f32x4 a = *(const f32x4*)sp, b = *(const f32x4*)(sp + 256), c = *(const f32x4*)(sp + 512), d = *(const f32x4*)(sp + 768);
        float m = fmaxf(fmaxf(fmaxf(fabsf(a.x), fabsf(a.y)), fmaxf(fabsf(a.z), fabsf(a.w))), fmaxf(fmaxf(fabsf(b.x), fabsf(b.y)), fmaxf(fabsf(b.z), fabsf(b.w))));
        m = fmaxf(m, fmaxf(fmaxf(fmaxf(fabsf(c.x), fabsf(c.y)), fmaxf(fabsf(c.z), fabsf(c.w))), fmaxf(fmaxf(fabsf(d.x), fabsf(d.y)), fmaxf(fabsf(d.z), fabsf(d.w)))));
#pragma unroll
        for (int s = 1; s < 64; s <<= 1) m = fmaxf(m, __shfl_xor(m, s));
        const float sc = m > 1e-30f ? 127.0f / m : 1.0f, isc = m > 1e-30f ? m * (1.0f / 127.0f) : 1.0f;
        const float v[16] = {a.x, a.y, a.z, a.w, b.x, b.y, b.z, b.w, c.x, c.y, c.z, c.w, d.x, d.y, d.z, d.w};
        unsigned char* dp = dst + (size_t)row * DM + lane * 4;
#pragma unroll
        for (int q = 0; q < 4; ++q) {
            unsigned pk = 0u;
#pragma unroll
            for (int e = 0; e < 4; ++e) { const int qi = (int)rintf(v[q * 4 + e] * sc) + OFFS; pk |= ((unsigned)qi & 0xffu) << (8 * e); }
            *(unsigned*)(dp + q * 256) = pk;
        }
        if (lane == 0) inv[row] = isc;
    }
}
DI void prep_cab_item(const Params& p, int item, int which0, char* smem) {
    float* vT = (float*)smem;
    float* red = vT + DM * 16;
    const float* mod = (const float*)(p.ws + OFF_MOD);
    const int tid = my_tid(), ks = tid >> 5, col = tid & 31;
    const float* w = p.w_q + (size_t)(ks * 64) * 2048 + item * 32 + col;
#pragma unroll 1
    for (int which = which0; which < which0 + 1; ++which) {
        for (int i = tid; i < NB * DM; i += NTH) {
            const int b = i >> 10, k = i & 1023;
            const float sc = 1.0f + mod[b * 6144 + 4096 + k];
            const float v = which == 0 ? p.ln1w[k] * sc : p.ln1b[k] * sc + mod[b * 6144 + 3072 + k];
            vT[k * 16 + b] = v;
            if (item == 0) ((float*)(p.ws + OFF_AB))[(size_t)which * NB * DM + i] = v;
        }
        __syncthreads();
        float acc[16];
#pragma unroll
        for (int b = 0; b < 16; ++b) acc[b] = 0.f;
        float wnx[16];
#pragma unroll
        for (int k = 0; k < 16; ++k) wnx[k] = w[(size_t)k * 2048];
#pragma unroll 1
        for (int seg = 0; seg < 4; ++seg) {
            float wreg[16];
#pragma unroll
            for (int k = 0; k < 16; ++k) wreg[k] = wnx[k];
            if (seg + 1 < 4) {
#pragma unroll
                for (int k = 0; k < 16; ++k) wnx[k] = w[(size_t)((seg + 1) * 16 + k) * 2048];
            }
#pragma unroll
            for (int k = 0; k < 16; ++k) {
                const float wv = wreg[k];
                const f32x4* cb = (const f32x4*)(vT + (ks * 64 + seg * 16 + k) * 16);
                const f32x4 c0 = cb[0], c1 = cb[1], c2 = cb[2], c3 = cb[3];
                acc[0] += c0.x * wv; acc[1] += c0.y * wv; acc[2] += c0.z * wv; acc[3] += c0.w * wv;
                acc[4] += c1.x * wv; acc[5] += c1.y * wv; acc[6] += c1.z * wv; acc[7] += c1.w * wv;
                acc[8] += c2.x * wv; acc[9] += c2.y * wv; acc[10] += c2.z * wv; acc[11] += c2.w * wv;
                acc[12] += c3.x * wv; acc[13] += c3.y * wv; acc[14] += c3.z * wv; acc[15] += c3.w * wv;
            }
        }
#pragma unroll
        for (int b = 0; b < 16; ++b) red[(ks * 32 + col) * 16 + b] = acc[b];
        __syncthreads();
        {
            const int b = tid >> 5;
            float sum = 0.f;
#pragma unroll
            for (int q = 0; q < 16; ++q) sum += red[(q * 32 + col) * 16 + b];
            ((float*)(p.ws + OFF_CAB))[(size_t)which * NB * 2048 + b * 2048 + item * 32 + col] = sum;
        }
        __syncthreads();
    }
}
DI void phase_h(const Params& p, int bid, int nb) {
    const float* mod = (const float*)(p.ws + OFF_MOD);
    bf16_t* H = (bf16_t*)(p.ws + OFF_H);
    const size_t n8 = (size_t)NTOK * DM / 8;
    for (size_t i = (size_t)bid * NTH + my_tid(); i < n8; i += (size_t)nb * NTH) {
        const int row = (int)(i >> 7), c0 = (int)(i & 127) * 8, b = row / SEQ;
        const float* sh = mod + b * 6144 + c0;
        const float* sc = sh + 1024;
        const float4 a = *(const float4*)(p.x + i * 8), bq = *(const float4*)(p.x + i * 8 + 4);
        const float4 s0 = *(const float4*)sc, s1 = *(const float4*)(sc + 4), h0 = *(const float4*)sh, h1 = *(const float4*)(sh + 4);
        uint4 o;
        o.x = pack2(a.x * (1.f + s0.x) + h0.x, a.y * (1.f + s0.y) + h0.y);
        o.y = pack2(a.z * (1.f + s0.z) + h0.z, a.w * (1.f + s0.w) + h0.w);
        o.z = pack2(bq.x * (1.f + s1.x) + h1.x, bq.y * (1.f + s1.y) + h1.y);
        o.w = pack2(bq.z * (1.f + s1.z) + h1.z, bq.w * (1.f + s1.w) + h1.w);
        *(uint4*)(H + i * 8) = o;
    }
}

DI int wq_next(unsigned* ctr, char* smem) {
    volatile unsigned* slot = (volatile unsigned*)(smem + SMEM_BYTES - 8);
    __syncthreads();
    if (__builtin_amdgcn_workitem_id_x() == 0) *slot = __hip_atomic_fetch_add(ctr, 1u, __ATOMIC_RELAXED, __HIP_MEMORY_SCOPE_AGENT);
    __syncthreads();
    return (int)*slot;
}
DI void phase_prep_a(const Params& p, char* smem) {
    unsigned* ctr = (unsigned*)(p.ws + OFF_BAR) + 120;
    constexpr int U_S5 = 192, U_LB = 320, U_TR = 321, U_UT = U_TR + 368, U_VT = U_UT + 128, U_MISC = U_VT + 128, U_END = U_MISC + 8;
    for (int raw = wq_next(ctr, smem); raw < U_END; raw = wq_next(ctr, smem)) {
        const int u = raw < 512 ? ((raw & 1) ? (raw >> 1) : U_UT + (raw >> 1)) : (raw < U_MISC ? 256 + (raw - 512) : raw);
        if (u < U_S5) prep_mod_item(p, u, smem);
        else if (u < U_LB) prep_s5_gemm_item(p, (u - U_S5) >> 2, (u - U_S5) & 3, smem);
        else if (u < U_TR) {
            const int j = my_tid();
            const float a0 = p.hg_lb[j], a1 = p.hg_lb[512 + j], m = fmaxf(a0, a1);
            const float e0 = expf(a0 - m), e1 = expf(a1 - m);
            ((float*)(p.ws + OFF_LB))[j] = e0 / (e0 + e1);
        } else if (u < U_UT) {
            for (int it = (u - U_TR) * 4; it < (u - U_TR) * 4 + 4; ++it) {
                constexpr int T_WIN = 16 * 40, T_GLU = 8 * 8, T_WOUT = 16 * 16;
                constexpr int I_GLU = T_WIN, I_WOUT = I_GLU + T_GLU, I_WQ = I_WOUT + T_WOUT;
                if (it < I_GLU) { const int t = it, n0 = (t % 40) * 64;
                    const int d0 = n0 < 512 ? (n0 >> 7) * 256 + (n0 & 127) : (n0 < 1024 ? ((n0 - 512) >> 7) * 256 + 128 + (n0 & 127) : n0);
                    prep_transpose_tile(p.w_in, (bf16_t*)(p.ws + OFF_WIN), DM, INC, t / 40, t % 40, smem, d0); }
                else if (it < I_WOUT) { const int t = it - I_GLU; prep_transpose_tile(p.glu_w, (bf16_t*)(p.ws + OFF_GLU), 512, 512, t / 8, t % 8, smem); }
                else if (it < I_WQ) { const int t = it - I_WOUT; prep_transpose_tile(p.w_out, (bf16_t*)(p.ws + OFF_WOUT), DM, DM, t / 16, t % 16, smem, -1, 512); }
                else { const int t = it - I_WQ; prep_transpose_tile(p.w_q, (bf16_t*)(p.ws + OFF_WQ), DM, 2048, t / 32, t % 32, smem); }
            }
        } else if (u < U_VT) cvt_i8_rows<0>(p.pu, (unsigned char*)(p.ws + OFF_UT), (float*)(p.ws + OFF_SU), u - U_UT, 128);
        else if (u < U_MISC) cvt_i8_rows<0>(p.pv, (unsigned char*)(p.ws + OFF_VT), (float*)(p.ws + OFF_SV), u - U_VT, 128);
        else {
            const int q = u - U_MISC;
            cvt_bf16_stream(p.subk, (bf16_t*)(p.ws + OFF_SUBK), (size_t)16 * 128 * 128 / 8, q, 8);
            for (size_t i = (size_t)q * NTH + my_tid(); i < (size_t)NTOK * 3 / 4; i += (size_t)8 * NTH) ((f32x4*)(p.ws + OFF_STAT))[i] = (f32x4){0.f, 0.f, 0.f, 0.f};
        }
    }
}
DI void phase_prep_b(const Params& p, char* smem) {
    unsigned* ctr = (unsigned*)(p.ws + OFF_BAR) + 121;
    for (int u = wq_next(ctr, smem); u < 128 + 256; u = wq_next(ctr, smem)) {
        if (u < 128) prep_cab_item(p, u >> 1, u & 1, smem); else phase_h(p, u - 128, 256);
    }
}

DI void phase_proj(const Params& p, int bid, int nb, char* smem) {
    pg8::Gemm g{(const bf16_t*)(p.ws + OFF_H), (const bf16_t*)(p.ws + OFF_WIN), NTOK, INC, DM};
    pg8::StaticOrder S; S.init(NTOK, INC, nb, bid);
    pg8::EpiProj E{(bf16_t*)(p.ws + OFF_PROJ), (bf16_t*)(p.ws + OFF_HQ), (bf16_t*)(p.ws + OFF_HK), (float*)(p.ws + OFF_HG), (const float*)(p.ws + OFF_LB)};
    pg8::gemm_phase<pg8::EpiProj, pg8::StaticOrder, false>((PG8_LAS unsigned char*)smem, g, S, E, nullptr);
}

DI int crow(int i, int h) { return (i & 3) + 8 * (i >> 2) + 4 * h; }
typedef short s16x4 __attribute__((ext_vector_type(4)));
DI bf16x8 cat8(const s16x4 lo, const s16x4 hi) { return (bf16x8){lo.x, lo.y, lo.z, lo.w, hi.x, hi.y, hi.z, hi.w}; }
DI s16x4 lds_tr(const char* a) { return __builtin_amdgcn_ds_read_tr16_b64_v4i16((__attribute__((address_space(3))) s16x4*)a); }
DI void hgrn_mfma_item(const Params& p, int item, char* smem) {
    constexpr int QP_OFF = 0, KP_OFF = 8704, V_OFF = 17408, G_OFF = 26112, BUF = 26624, OB_OFF = 3 * BUF, OB_STRIDE = 132, OB_BYTES = 32 * OB_STRIDE * 4;
    const int tid = my_tid(), lane = tid & 63, wid = tid >> 6, r = lane & 31, h = lane >> 5;
    const int b = item >> 2, hd = item & 3;
    const size_t tile0 = (size_t)item * 64;
    const bf16_t* HQ = (const bf16_t*)(p.ws + OFF_HQ) + tile0 * 4096;
    const bf16_t* HK = (const bf16_t*)(p.ws + OFF_HK) + tile0 * 4096;
    const bf16_t* PV = (const bf16_t*)(p.ws + OFF_PROJ) + (size_t)b * SEQ * INC + 1024 + hd * HDK;
    const float* HG = (const float*)(p.ws + OFF_HG) + tile0 * 128;
    bf16_t* A2out = (bf16_t*)(p.ws + OFF_A2) + (size_t)b * SEQ * DM + 512 + hd * HDK;
    const bf16_t* PG = (const bf16_t*)(p.ws + OFF_PROJ) + (size_t)b * SEQ * INC + 1536 + hd * HDK;
    const bool helper = wid >= 4;
    const int ht = tid - 256;
    const int i0 = ht, i1 = ht + 256;
    const int lo0 = (i0 >> 4) * 272 + (i0 & 15) * 16, lo1 = (i1 >> 4) * 272 + (i1 & 15) * 16;
    u32x4 A0, A1, A2, A3, A4, A5, A6, B0, B1, B2, B3, B4, B5, B6;
    A0 = A1 = A2 = A3 = A4 = A5 = A6 = B0 = B1 = B2 = B3 = B4 = B5 = B6 = (u32x4){0, 0, 0, 0};
    f32x16 S[4];
#pragma unroll
    for (int kb = 0; kb < 4; ++kb)
#pragma unroll
        for (int i = 0; i < 16; ++i) S[kb][i] = 0.f;
#define HG_LOAD(X, c_) { const size_t o_ = (size_t)(c_) * 4096; \
        X##0 = *(const u32x4*)(HQ + o_ + i0 * 8); X##1 = *(const u32x4*)(HQ + o_ + i1 * 8); \
        X##2 = *(const u32x4*)(HK + o_ + i0 * 8); X##3 = *(const u32x4*)(HK + o_ + i1 * 8); \
        X##4 = *(const u32x4*)(PV + (size_t)((c_) * 32 + (i0 >> 4)) * INC + (i0 & 15) * 8); X##5 = *(const u32x4*)(PV + (size_t)((c_) * 32 + (i1 >> 4)) * INC + (i1 & 15) * 8); \
        X##6 = *(const u32x4*)(HG + (size_t)(c_) * 128 + (ht & 31) * 4); }
#define HG_STORE(X, buf_) { char* B_ = smem + (buf_) * BUF; \
        *(u32x4*)(B_ + QP_OFF + lo0) = X##0; *(u32x4*)(B_ + QP_OFF + lo1) = X##1; \
        *(u32x4*)(B_ + KP_OFF + lo0) = X##2; *(u32x4*)(B_ + KP_OFF + lo1) = X##3; \
        *(u32x4*)(B_ + V_OFF + lo0) = X##4; *(u32x4*)(B_ + V_OFF + lo1) = X##5; \
        if (ht < 32) *(u32x4*)(B_ + G_OFF + ht * 16) = X##6; }
    const int tq = (lane >> 2) & 3, tp = lane & 3, tg = lane >> 4;
    const int tr_nat = (8 * (tg >> 1) + tq) * 272 + (16 * (tg & 1) + 4 * tp) * 2;
    const int tr_krw = (4 * (tg >> 1) + tq) * 272 + (16 * (tg & 1) + 4 * tp) * 2;
    if (helper) { HG_LOAD(A, 0); HG_STORE(A, 0); HG_LOAD(A, 1); HG_STORE(A, 1); HG_LOAD(A, 2); HG_LOAD(B, 3); }
    __syncthreads();
#define HG_RD_A(ks_) (*(const bf16x8*)(B + KP_OFF + r * 272 + (ks_) * 32 + h * 16))
#define HG_RD_BQ(ks_) (*(const bf16x8*)(B + QP_OFF + r * 272 + (ks_) * 32 + h * 16))
#define HG_RD_AQ(ks_) cat8(*(const s16x4*)(B + QP_OFF + r * 272 + ((ks_) >> 1) * 64 + ((ks_) & 1) * 32 + h * 8), *(const s16x4*)(B + QP_OFF + r * 272 + ((ks_) >> 1) * 64 + ((ks_) & 1) * 32 + h * 8 + 16))
#define HG_RD_KT(kb_, ks_) cat8(lds_tr(B + KP_OFF + (16 * (ks_)) * 272 + (32 * (kb_)) * 2 + tr_nat), lds_tr(B + KP_OFF + (16 * (ks_)) * 272 + (32 * (kb_)) * 2 + tr_nat + 4 * 272))
#define HG_COMPUTE(c_) { \
        const char* B = smem + ((c_) % 3) * BUF; const int w = wid; \
          \
        f32x16 pt, o; _Pragma("unroll") for (int i = 0; i < 16; ++i) { pt[i] = 0.f; o[i] = 0.f; } \
        bf16x8 fa[2], fb[2], fq[2]; \
        fa[0] = HG_RD_A(0); fb[0] = HG_RD_BQ(0); fq[0] = HG_RD_AQ(0); \
        _Pragma("unroll") for (int ks = 0; ks < 8; ++ks) { \
            if (ks + 1 < 8) { fa[(ks + 1) & 1] = HG_RD_A(ks + 1); fb[(ks + 1) & 1] = HG_RD_BQ(ks + 1); fq[(ks + 1) & 1] = HG_RD_AQ(ks + 1); } \
            __builtin_amdgcn_sched_barrier(0); \
            pt = __builtin_amdgcn_mfma_f32_32x32x16_bf16(fa[ks & 1], fb[ks & 1], pt, 0, 0, 0); \
            o = __builtin_amdgcn_mfma_f32_32x32x16_bf16(fq[ks & 1], pack8(S[ks >> 1], 8 * (ks & 1)), o, 0, 0, 0); \
            __builtin_amdgcn_sched_barrier(0); } \
        bf16x8 bv[2], bvn[2]; \
        _Pragma("unroll") for (int sp = 0; sp < 2; ++sp) { const char* vb = B + V_OFF + (16 * sp) * 272 + (32 * w) * 2 + tr_krw; bv[sp] = cat8(lds_tr(vb), lds_tr(vb + 8 * 272)); } \
        _Pragma("unroll") for (int ks = 0; ks < 2; ++ks) { const char* vb = B + V_OFF + (16 * ks) * 272 + (32 * w) * 2 + tr_nat; bvn[ks] = cat8(lds_tr(vb), lds_tr(vb + 4 * 272)); } \
        bf16x8 kt[2]; kt[0] = HG_RD_KT(0, 0); \
        __builtin_amdgcn_sched_barrier(0); \
        _Pragma("unroll") for (int i = 0; i < 16; ++i) if (crow(i, h) > r) pt[i] = 0.f; \
        _Pragma("unroll") for (int sp = 0; sp < 2; ++sp) o = __builtin_amdgcn_mfma_f32_32x32x16_bf16(pack8(pt, 8 * sp), bv[sp], o, 0, 0, 0); \
          \
        _Pragma("unroll") for (int kb = 0; kb < 4; ++kb) { \
            f32x4 g4[4]; \
            _Pragma("unroll") for (int j = 0; j < 4; ++j) g4[j] = *(const f32x4*)(B + G_OFF + (kb * 32 + 8 * j + 4 * h) * 4); \
            _Pragma("unroll") for (int ks = 0; ks < 2; ++ks) { \
                const int nx = kb * 2 + ks + 1; \
                if (nx < 8) kt[nx & 1] = HG_RD_KT(nx >> 1, nx & 1); \
                __builtin_amdgcn_sched_barrier(0); \
                S[kb] = __builtin_amdgcn_mfma_f32_32x32x16_bf16(kt[(nx - 1) & 1], bvn[ks], S[kb], 0, 0, 0); \
                __builtin_amdgcn_sched_barrier(0); } \
            _Pragma("unroll") for (int j = 0; j < 4; ++j) { \
                S[kb][4 * j] *= g4[j].x; S[kb][4 * j + 1] *= g4[j].y; S[kb][4 * j + 2] *= g4[j].z; S[kb][4 * j + 3] *= g4[j].w; } } \
        { float* ob_ = (float*)(smem + OB_OFF + ((c_) & 1) * OB_BYTES); _Pragma("unroll") for (int i = 0; i < 16; ++i) ob_[crow(i, h) * OB_STRIDE + 32 * w + r] = o[i]; } }
    f32x4 nw0, nw1, nw2, nw3;
    nw0 = nw1 = nw2 = nw3 = (f32x4){0.f, 0.f, 0.f, 0.f};
    if (helper) { const float* nwp = p.hg_nw + hd * HDK + (ht & 7) * 16; nw0 = *(const f32x4*)nwp; nw1 = *(const f32x4*)(nwp + 4); nw2 = *(const f32x4*)(nwp + 8); nw3 = *(const f32x4*)(nwp + 12); }
#define HG_NORM(cc_, PF_) { const int t_ = ht >> 3, sg_ = ht & 7; \
        const float* ob_ = (const float*)(smem + OB_OFF + ((cc_) & 1) * OB_BYTES) + t_ * OB_STRIDE + sg_ * 16; \
        const f32x4 o0 = *(const f32x4*)ob_, o1 = *(const f32x4*)(ob_ + 4), o2 = *(const f32x4*)(ob_ + 8), o3 = *(const f32x4*)(ob_ + 12); \
        const u32x4 g0 = gp0, g1 = gp1;                                     \
        if (PF_) { gp0 = *(const u32x4*)(PG + (size_t)(((cc_) + 1) * 32 + t_) * INC + sg_ * 16); gp1 = *(const u32x4*)(PG + (size_t)(((cc_) + 1) * 32 + t_) * INC + sg_ * 16 + 8); } \
        float ss = (o0.x * o0.x + o0.y * o0.y + o0.z * o0.z + o0.w * o0.w) + (o1.x * o1.x + o1.y * o1.y + o1.z * o1.z + o1.w * o1.w) + (o2.x * o2.x + o2.y * o2.y + o2.z * o2.z + o2.w * o2.w) + (o3.x * o3.x + o3.y * o3.y + o3.z * o3.z + o3.w * o3.w); \
        ss += __shfl_xor(ss, 1); ss += __shfl_xor(ss, 2); ss += __shfl_xor(ss, 4); \
        const float rs_ = rsqrtf(ss * (1.0f / 128.0f) + RMS_EPS); \
        const f32x4 v0 = o0 * rs_ * nw0, v1 = o1 * rs_ * nw1, v2 = o2 * rs_ * nw2, v3 = o3 * rs_ * nw3; \
        u32x4 w0, w1; \
        w0.x = pack2(v0.x * bflo(g0.x), v0.y * bfhi(g0.x)); w0.y = pack2(v0.z * bflo(g0.y), v0.w * bfhi(g0.y)); w0.z = pack2(v1.x * bflo(g0.z), v1.y * bfhi(g0.z)); w0.w = pack2(v1.z * bflo(g0.w), v1.w * bfhi(g0.w)); \
        w1.x = pack2(v2.x * bflo(g1.x), v2.y * bfhi(g1.x)); w1.y = pack2(v2.z * bflo(g1.y), v2.w * bfhi(g1.y)); w1.z = pack2(v3.x * bflo(g1.z), v3.y * bfhi(g1.z)); w1.w = pack2(v3.z * bflo(g1.w), v3.w * bfhi(g1.w)); \
        bf16_t* dst_ = A2out + (size_t)((cc_) * 32 + t_) * DM + sg_ * 16; \
        *(u32x4*)dst_ = w0; *(u32x4*)(dst_ + 8) = w1; }
#define HG_BAR() do { asm volatile("s_waitcnt lgkmcnt(0)" ::: "memory"); __builtin_amdgcn_s_barrier(); asm volatile("" ::: "memory"); } while (0)
    if (helper) {
        u32x4 gp0, gp1;
        gp0 = *(const u32x4*)(PG + (size_t)(ht >> 3) * INC + (ht & 7) * 16); gp1 = *(const u32x4*)(PG + (size_t)(ht >> 3) * INC + (ht & 7) * 16 + 8);
        HG_STORE(A, 2); HG_LOAD(A, 4); HG_BAR();
        HG_STORE(B, 0); HG_LOAD(B, 5); HG_NORM(0, true); HG_BAR();
#pragma unroll 1
        for (int c = 2; c <= 58; c += 2) {
            HG_STORE(A, (c + 2) % 3); HG_LOAD(A, c + 4); HG_NORM(c - 1, true); HG_BAR();
            HG_STORE(B, (c + 3) % 3); HG_LOAD(B, c + 5); HG_NORM(c, true); HG_BAR();
        }
        HG_STORE(A, 62 % 3); HG_NORM(59, true); HG_BAR();
        HG_STORE(B, 63 % 3); HG_NORM(60, true); HG_BAR();
        HG_NORM(61, true); HG_BAR();
        HG_NORM(62, true); HG_BAR();
        HG_NORM(63, false);
    } else {
#pragma unroll 1
        for (int c = 0; c < 64; c += 2) { HG_COMPUTE(c); HG_BAR(); HG_COMPUTE(c + 1); HG_BAR(); }
    }
#undef HG_BAR
    __syncthreads();
#undef HG_LOAD
#undef HG_STORE
#undef HG_COMPUTE
#undef HG_RD_A
#undef HG_RD_BQ
#undef HG_RD_AQ
#undef HG_RD_KT
#undef HG_NORM
}
template <int NJ>
DI void s5_load_bm(bf16x8 (&bm)[8], const bf16_t* MBg, const int r, const int h) {
#pragma unroll
    for (int ks = 0; ks < 8; ++ks) bm[ks] = *(const bf16x8*)(MBg + (size_t)((NJ * 8 + ks) * 64 + h * 32 + r) * 8);
}
template <int NJ>
DI void s5_gemm2_tile(const bf16x8 (&af)[16], const bf16x8 (&bm)[8], const bf16_t* KTl, const bf16_t* Xin, bf16_t* Yout, bf16_t* stg, const int mi, const int r, const int h) {
    f32x16 y, y2;
#pragma unroll
    for (int i = 0; i < 16; ++i) { y[i] = 0.f; y2[i] = 0.f; }
    const int tsel = r >> 4, iq = r & 15;
    constexpr int NT = 2 * NJ + 2;
    bf16x8 bk[2], xa[2];
    bk[0] = *(const bf16x8*)(KTl + ((2 * NJ + tsel) * 16 + iq) * 16 + 8 * h);
#pragma unroll
    for (int ks = 0; ks < NT; ++ks) {
        if (ks + 1 < NT) {
            if (ks + 1 <= 2 * NJ) bk[(ks + 1) & 1] = *(const bf16x8*)(KTl + ((2 * NJ + tsel - (ks + 1)) * 16 + iq) * 16 + 8 * h);
            else { bf16x8 t = *(const bf16x8*)(KTl + iq * 16 + 8 * h); if (tsel == 0) t = (bf16x8){0, 0, 0, 0, 0, 0, 0, 0}; bk[(ks + 1) & 1] = t; }
        } else xa[0] = *(const bf16x8*)(Xin + (mi * 32 + r) * 136 + 8 * h);
        __builtin_amdgcn_sched_barrier(0);
        if (ks & 1) y2 = __builtin_amdgcn_mfma_f32_32x32x16_bf16(af[ks], bk[ks & 1], y2, 0, 0, 0);
        else y = __builtin_amdgcn_mfma_f32_32x32x16_bf16(af[ks], bk[ks & 1], y, 0, 0, 0);
        __builtin_amdgcn_sched_barrier(0);
    }
#pragma unroll
    for (int ks = 0; ks < 8; ++ks) {
        if (ks + 1 < 8) xa[(ks + 1) & 1] = *(const bf16x8*)(Xin + (mi * 32 + r) * 136 + (ks + 1) * 16 + 8 * h);
        __builtin_amdgcn_sched_barrier(0);
        if (ks & 1) y2 = __builtin_amdgcn_mfma_f32_32x32x16_bf16(xa[ks & 1], bm[ks], y2, 0, 0, 0);
        else y = __builtin_amdgcn_mfma_f32_32x32x16_bf16(xa[ks & 1], bm[ks], y, 0, 0, 0);
        __builtin_amdgcn_sched_barrier(0);
    }
#pragma unroll
    for (int i = 0; i < 16; ++i) stg[((crow(i, h) * 2 + tsel) * 16) + iq] = f2bf(gelu_as(y[i] + y2[i]));
    {
        const int lane = h * 32 + r, cl = lane >> 1, ts = lane & 1;
        const u32x4 lo = *(const u32x4*)(stg + lane * 16), hi = *(const u32x4*)(stg + lane * 16 + 8);
        bf16_t* dst = Yout + (size_t)((mi * 32 + cl) * 16 + 2 * NJ + ts) * DSS;
        *(u32x4*)dst = lo; *(u32x4*)(dst + 8) = hi;
    }
}
DI void s5_gemm_item(const Params& p, int b, int g, char* smem) {
    float* E = (float*)smem;
    bf16_t* Xin = (bf16_t*)(smem + 128 * 132 * 4);
    bf16_t* KTl = Xin + 128 * 136;
    const int tid = my_tid(), lane = tid & 63, wid = tid >> 6, r = lane & 31, h = lane >> 5;
    const int mi = wid >> 1, wh = wid & 1;
    const bf16_t* P = (const bf16_t*)(p.ws + OFF_PROJ);
    *(u32x4*)(KTl + tid * 8) = *(const u32x4*)((const bf16_t*)(p.ws + OFF_S5K) + (size_t)g * 4096 + tid * 8);
    bf16x8 af[16];
    {
        const bf16_t* ub = P + (size_t)(b * SEQ + (mi * 32 + r) * 16) * INC + 2048 + g * 16 + 8 * h;
#pragma unroll
        for (int ks = 0; ks < 16; ++ks) af[ks] = *(const bf16x8*)(ub + (size_t)ks * INC);
    }
#ifndef S5_REP_G1
#define S5_REP_G1 1
#define S5_REP_SC 1
#define S5_REP_G2 1
#endif
    for (int rp1 = 0; rp1 < S5_REP_G1; ++rp1)
    {
        f32x16 e0, e1;
#pragma unroll
        for (int i = 0; i < 16; ++i) { e0[i] = 0.f; e1[i] = 0.f; }
        const bf16_t* nb0 = (const bf16_t*)(p.ws + OFF_S5N) + (size_t)g * 128 * 256 + (size_t)(wh * 2) * 16 * 512 + lane * 8;
#pragma unroll
        for (int ks = 0; ks < 16; ++ks) {
            const bf16x8 b0 = *(const bf16x8*)(nb0 + ks * 512), b1 = *(const bf16x8*)(nb0 + 16 * 512 + ks * 512);
            e0 = __builtin_amdgcn_mfma_f32_32x32x16_bf16(af[ks], b0, e0, 0, 0, 0);
            e1 = __builtin_amdgcn_mfma_f32_32x32x16_bf16(af[ks], b1, e1, 0, 0, 0);
        }
#pragma unroll
        for (int i = 0; i < 16; ++i) { float* er = E + (mi * 32 + crow(i, h)) * 132 + wh * 64 + r; er[0] = e0[i]; er[32] = e1[i]; }
    }
    __syncthreads();
    const bf16_t* MBg = (const bf16_t*)(p.ws + OFF_S5M) + (size_t)g * 256 * 128;
    bf16x8 bmA[8], bmB[8];
    if (wh) { s5_load_bm<1>(bmA, MBg, r, h); s5_load_bm<6>(bmB, MBg, r, h); } else { s5_load_bm<0>(bmA, MBg, r, h); s5_load_bm<7>(bmB, MBg, r, h); }
    for (int rp2 = 0; rp2 < S5_REP_SC; ++rp2)
    if (wid == 0) {
        const float* L = (const float*)(p.ws + OFF_S5L) + (g * 64 + lane) * 2;
        const float lr = L[0], li = L[1];
        float xr = 0.f, xi = 0.f;
#pragma unroll 8
        for (int c = 0; c < 128; ++c) {
            const float er = E[c * 132 + lane], ei = E[c * 132 + 64 + lane];
            Xin[c * 136 + lane] = f2bf(xr); Xin[c * 136 + 64 + lane] = f2bf(xi);
            const float nr = lr * xr - li * xi + er, ni = lr * xi + li * xr + ei;
            xr = nr; xi = ni;
        }
    }
    __syncthreads();
    bf16_t* Yout = (bf16_t*)(p.ws + OFF_YSSM) + (size_t)b * SEQ * DSS + g * 16;
    bf16_t* stg = (bf16_t*)smem + wid * 1024;
    {
#define S5_RUN4(T0, T1, T2, T3) { \
        s5_gemm2_tile<T0>(af, bmA, KTl, Xin, Yout, stg, mi, r, h); s5_load_bm<T2>(bmA, MBg, r, h); \
        s5_gemm2_tile<T1>(af, bmB, KTl, Xin, Yout, stg, mi, r, h); s5_load_bm<T3>(bmB, MBg, r, h); \
        s5_gemm2_tile<T2>(af, bmA, KTl, Xin, Yout, stg, mi, r, h); s5_gemm2_tile<T3>(af, bmB, KTl, Xin, Yout, stg, mi, r, h); }
        if (wh) S5_RUN4(1, 6, 3, 4) else S5_RUN4(0, 7, 2, 5)
#undef S5_RUN4
    }
    __syncthreads();
}
DI void phase_mix(const Params& p, int bid, int nb, char* smem) {
    if (nb == 256) {
#ifndef PROBE_HGX
#define PROBE_HGX 1
#endif
        if (bid < 64) { for (int rep = 0; rep < PROBE_HGX; ++rep) hgrn_mfma_item(p, bid, smem); return; }
        const int j = bid - 64, x = j & 7, lb = j >> 3;
#ifndef PROBE_S5X
#define PROBE_S5X 1
#endif
        for (int rep = 0; rep < PROBE_S5X; ++rep)
        for (int q = lb; q < 64; q += 24) s5_gemm_item(p, q & 15, x * 4 + (q >> 4), smem);
    } else {
        for (int it = bid; it < 64; it += nb) hgrn_mfma_item(p, it, smem);
        for (int q = bid; q < 512; q += nb) s5_gemm_item(p, q & 15, q >> 4, smem);
    }
}

DI void phase_glu(const Params& p, int bid, int nb, char* smem) {
    pg8::Gemm g{(const bf16_t*)(p.ws + OFF_YSSM), (const bf16_t*)(p.ws + OFF_GLU), NTOK, 512, 512};
    pg8::StaticOrder S; S.init(NTOK, 512, nb, bid);
    pg8::EpiGluA2 E{(bf16_t*)(p.ws + OFF_A2), (const bf16_t*)(p.ws + OFF_YSSM), p.glu_b, p.ssm_nw, (float*)(p.ws + OFF_STAT) + 2 * NTOK};
    pg8::gemm_phase<pg8::EpiGluA2, pg8::StaticOrder, false>((PG8_LAS unsigned char*)smem, g, S, E, nullptr);
}

DI void phase_outproj(const Params& p, int bid, int nb, char* smem) {
    pg8::Gemm g{(const bf16_t*)(p.ws + OFF_A2), (const bf16_t*)(p.ws + OFF_WOUT), NTOK, DM, DM};
    pg8::StaticOrder S; S.init(NTOK, DM, nb, bid);
    pg8::EpiResid E{(bf16_t*)(p.ws + OFF_R1), p.x, (const float*)(p.ws + OFF_MOD) + 2048, DEEP_ALPHA, (bf16_t*)(p.ws + OFF_H), (const float*)(p.ws + OFF_AB), (float*)(p.ws + OFF_STAT), (const float*)(p.ws + OFF_STAT) + 2 * NTOK, RMS_EPS};
    pg8::gemm_phase<pg8::EpiResid, pg8::StaticOrder, false>((PG8_LAS unsigned char*)smem, g, S, E, nullptr);
}

DI void phase_q(const Params& p, int bid, int nb, char* smem) {
    pg8::Gemm g{(const bf16_t*)(p.ws + OFF_H), (const bf16_t*)(p.ws + OFF_WQ), NTOK, 2048, DM};
    pg8::StaticOrder S; S.init(NTOK, 2048, nb, bid);
    pg8::EpiQLN E{(bf16_t*)(p.ws + OFF_PROJ), (const float*)(p.ws + OFF_STAT), (const float*)(p.ws + OFF_CAB), (const float*)(p.ws + OFF_CAB) + NB * 2048, LN_EPS};
    pg8::gemm_phase<pg8::EpiQLN, pg8::StaticOrder, false>((PG8_LAS unsigned char*)smem, g, S, E, nullptr);
}

DI void ce_desc(float& a, float& b) { const float hi = fmaxf(a, b), lo = fminf(a, b); a = hi; b = lo; }
template <int N> DI void bitonic_sort_desc(float (&v)[N]) {
#pragma unroll
    for (int k = 2; k <= N; k <<= 1)
#pragma unroll
        for (int j = k >> 1; j > 0; j >>= 1)
#pragma unroll
            for (int i = 0; i < N; ++i) { const int l = i ^ j; if (l > i) { if ((i & k) == 0 || k == N) ce_desc(v[i], v[l]); else ce_desc(v[l], v[i]); } }
}
DI void sort16_desc(float (&v)[16]) {
    constexpr int A[60] = {0, 1, 2, 3, 4, 5, 7, 9,  0, 1, 2, 3, 6, 8, 10, 11,  0, 2, 4, 6, 7, 10, 12, 14,  0, 1, 4, 5, 6, 8, 12, 13,  1, 3, 4, 5, 8, 9, 13,  1, 2, 5, 7, 9, 11,  2, 3, 9, 11,  3, 6, 7, 10,  3, 5, 7, 9, 11,  6, 8};
    constexpr int B[60] = {13, 12, 15, 14, 8, 6, 11, 10,  5, 7, 9, 4, 13, 14, 15, 12,  1, 3, 5, 8, 9, 11, 13, 15,  2, 3, 10, 11, 7, 9, 14, 15,  2, 12, 6, 7, 10, 11, 14,  4, 6, 8, 10, 13, 14,  4, 6, 12, 13,  5, 8, 9, 12,  4, 6, 8, 10, 12,  7, 9};
#pragma unroll
    for (int i = 0; i < 60; ++i) ce_desc(v[A[i]], v[B[i]]);
}
DI void merge_top16(float (&a)[16], const float (&b)[16]) {
#pragma unroll
    for (int i = 0; i < 16; ++i) a[i] = fmaxf(a[i], b[15 - i]);
#pragma unroll
    for (int j = 8; j > 0; j >>= 1)
#pragma unroll
        for (int i = 0; i < 16; ++i) { const int l = i ^ j; if (l > i) ce_desc(a[i], a[l]); }
}
DI void xlane_merge16(float (&a)[16]) {
    float o[16];
#pragma unroll
    for (int i = 0; i < 16; ++i) o[i] = __shfl_xor(a[i], 32);
    merge_top16(a, o);
}
DI void retrieve_topk_hp(const bf16_t* Q, const char* skl, const int tok, const int hp_next, const int r, const int h, unsigned char* lutp, float (&out)[16], bf16x8 (&bq)[8]) {
                f32x16 acc[4];
#pragma unroll
                for (int mi = 0; mi < 4; ++mi)
#pragma unroll
                    for (int i = 0; i < 16; ++i) acc[mi][i] = 0.f;
                const char* kb = skl + r * 272 + h * 16;
#pragma unroll
                for (int ks = 0; ks < 8; ++ks) {
#pragma unroll
                    for (int mi = 0; mi < 4; ++mi) {
                        const bf16x8 a = *(const bf16x8*)(kb + mi * 32 * 272 + ks * 32);
                        acc[mi] = __builtin_amdgcn_mfma_f32_32x32x16_bf16(a, bq[ks], acc[mi], 0, 0, 0);
                    }
                }
                {
                    const bf16_t* qb = Q + (size_t)tok * 2048 + hp_next * 128 + 8 * h;
#pragma unroll
                    for (int ks = 0; ks < 8; ++ks) bq[ks] = *(const bf16x8*)(qb + ks * 16);
                }
                float v0[16], v1[16], v2[16], v3[16];
#pragma unroll
                for (int i = 0; i < 16; ++i) {
                    const unsigned n = (unsigned)crow(i, h);
                    v0[i] = __uint_as_float((__float_as_uint(acc[0][i]) & ~0x7fu) | n);
                    v1[i] = __uint_as_float((__float_as_uint(acc[1][i]) & ~0x7fu) | (n + 32u));
                    v2[i] = __uint_as_float((__float_as_uint(acc[2][i]) & ~0x7fu) | (n + 64u));
                    v3[i] = __uint_as_float((__float_as_uint(acc[3][i]) & ~0x7fu) | (n + 96u));
                }
                sort16_desc(v0); sort16_desc(v1); sort16_desc(v2); sort16_desc(v3);
                merge_top16(v0, v1); merge_top16(v2, v3); merge_top16(v0, v2);
                xlane_merge16(v0);
#pragma unroll
                for (int i = 0; i < 16; ++i) out[i] = v0[i];
                u32x4 ix;
                ix.x = (__float_as_uint(v0[0]) & 0x7fu) | ((__float_as_uint(v0[1]) & 0x7fu) << 8) | ((__float_as_uint(v0[2]) & 0x7fu) << 16) | ((__float_as_uint(v0[3]) & 0x7fu) << 24);
                ix.y = (__float_as_uint(v0[4]) & 0x7fu) | ((__float_as_uint(v0[5]) & 0x7fu) << 8) | ((__float_as_uint(v0[6]) & 0x7fu) << 16) | ((__float_as_uint(v0[7]) & 0x7fu) << 24);
                ix.z = (__float_as_uint(v0[8]) & 0x7fu) | ((__float_as_uint(v0[9]) & 0x7fu) << 8) | ((__float_as_uint(v0[10]) & 0x7fu) << 16) | ((__float_as_uint(v0[11]) & 0x7fu) << 24);
                ix.w = (__float_as_uint(v0[12]) & 0x7fu) | ((__float_as_uint(v0[13]) & 0x7fu) << 8) | ((__float_as_uint(v0[14]) & 0x7fu) << 16) | ((__float_as_uint(v0[15]) & 0x7fu) << 24);
                *(u32x4*)lutp = ix;
}
DI void phase_retrieve(const Params& p, int bid, int nb, char* smem) {
    const bf16_t* Q = (const bf16_t*)(p.ws + OFF_PROJ);
    const bf16_t* SK = (const bf16_t*)(p.ws + OFF_SUBK);
    const float* SU = (const float*)(p.ws + OFF_SU);
    const float* SV = (const float*)(p.ws + OFF_SV);
    uint2* EX = (uint2*)(p.ws + OFF_EXPS);
    const int tid = my_tid(), lane = tid & 63, wid = tid >> 6, r = lane & 31, h = lane >> 5;
    unsigned char* lut = (unsigned char*)smem + wid * 2048 + lane * 32;
    char* skb0 = smem + 16384;
    char* skb1 = skb0 + 128 * 272;
    u32x4 sr0, sr1, sr2, sr3;
#define SK_LOAD(hp_) { const bf16_t* g_ = SK + (size_t)(hp_) * 16384 + tid * 8; sr0 = *(const u32x4*)g_; sr1 = *(const u32x4*)(g_ + 4096); sr2 = *(const u32x4*)(g_ + 8192); sr3 = *(const u32x4*)(g_ + 12288); }
#define SK_STORE(buf_) { char* d_ = (buf_) + (tid >> 4) * 272 + (tid & 15) * 16; *(u32x4*)d_ = sr0; *(u32x4*)(d_ + 32 * 272) = sr1; *(u32x4*)(d_ + 64 * 272) = sr2; *(u32x4*)(d_ + 96 * 272) = sr3; }
    for (int it = bid; it < (NTOK / 256) * 2; it += nb) {
        const int hq = it & 1, tok = (it >> 1) * 256 + wid * 32 + r;
        __syncthreads();
        SK_LOAD(hq * 8); SK_STORE(skb0);
        bf16x8 bq[8];
        {
            const bf16_t* qb = Q + (size_t)tok * 2048 + (hq * 8) * 128 + 8 * h;
#pragma unroll
            for (int ks = 0; ks < 8; ++ks) bq[ks] = *(const bf16x8*)(qb + ks * 16);
        }
        __syncthreads();
#pragma unroll 1
        for (int hd = hq * 4; hd < hq * 4 + 4; ++hd) {
            float L0[16], L1[16];
            SK_LOAD(hd * 2 + 1);
            retrieve_topk_hp(Q, skb0, tok, hd * 2 + 1, r, h, lut, L0, bq);
            SK_STORE(skb1);
            __syncthreads();
            if (hd + 1 < hq * 4 + 4) SK_LOAD(hd * 2 + 2);
            retrieve_topk_hp(Q, skb1, tok, (hd + 1 < hq * 4 + 4) ? hd * 2 + 2 : hd * 2 + 1, r, h, lut + 16, L1, bq);
            if (hd + 1 < hq * 4 + 4) SK_STORE(skb0);
            __syncthreads();
            float c[32];
            {
                constexpr int PA[50] = {0, 0, 0, 0, 0, 0, 0, 0, 0, 0, 0, 0, 0, 0, 0, 0, 1, 1, 1, 1, 1, 1, 1, 1, 2, 2, 2, 2, 2, 3, 3, 3, 3, 4, 4, 4, 5, 5, 6, 6, 7, 7, 8, 9, 10, 11, 12, 13, 14, 15};
                constexpr int PB[50] = {0, 1, 2, 3, 4, 5, 6, 7, 8, 9, 10, 11, 12, 13, 14, 15, 0, 1, 2, 3, 4, 5, 6, 7, 0, 1, 2, 3, 4, 0, 1, 2, 3, 0, 1, 2, 0, 1, 0, 1, 0, 1, 0, 0, 0, 0, 0, 0, 0, 0};
#pragma unroll
                for (int q = 0; q < 25; ++q) {
                    const float s0 = __uint_as_float(__float_as_uint(L0[PA[2 * q]]) & ~0x7fu) + __uint_as_float(__float_as_uint(L1[PB[2 * q]]) & ~0x7fu);
                    const float s1 = __uint_as_float(__float_as_uint(L0[PA[2 * q + 1]]) & ~0x7fu) + __uint_as_float(__float_as_uint(L1[PB[2 * q + 1]]) & ~0x7fu);
                    const float p0 = __uint_as_float((__float_as_uint(s0) & ~0xffu) | (unsigned)(PA[2 * q] * 16 + PB[2 * q]));
                    const float p1 = __uint_as_float((__float_as_uint(s1) & ~0xffu) | (unsigned)(PA[2 * q + 1] * 16 + PB[2 * q + 1]));
                    c[q] = h ? p1 : p0;
                }
#pragma unroll
                for (int i = 25; i < 32; ++i) c[i] = -3.0e38f;
            }
            float t16[16], chi[16];
#pragma unroll
            for (int i = 0; i < 16; ++i) { t16[i] = c[i]; chi[i] = c[16 + i]; }
            sort16_desc(t16); sort16_desc(chi);
            merge_top16(t16, chi);
            xlane_merge16(t16);
            const float mx = __uint_as_float(__float_as_uint(t16[0]) & ~0xffu);
            float e[16], sum = 0.f;
#pragma unroll
            for (int j = 0; j < 16; ++j) { e[j] = __expf(__uint_as_float(__float_as_uint(t16[j]) & ~0xffu) - mx); sum += e[j]; }
            const float inv = 1.0f / sum;
            uint2* dst = EX + ((size_t)tok * 8 + hd) * 16 + 8 * h;
            unsigned eidv[8]; float suv[8], svv[8], evv[8];
#pragma unroll
            for (int j = 0; j < 8; ++j) {
                float tlo = t16[j], thi = t16[8 + j], elo = e[j], ehi = e[8 + j];
                asm volatile("" : "+v"(tlo), "+v"(thi), "+v"(elo), "+v"(ehi));
                const float tv = h ? thi : tlo;
                evv[j] = h ? ehi : elo;
                const unsigned ab = __float_as_uint(tv) & 0xffu;
                eidv[j] = (unsigned)lut[ab >> 4] * 128u + (unsigned)lut[16 + (ab & 15u)];
                suv[j] = SU[eidv[j]]; svv[j] = SV[eidv[j]];
            }
#pragma unroll
            for (int j = 0; j < 8; ++j) dst[j] = make_uint2(eidv[j] | (pack2(0.f, suv[j]) & 0xffff0000u), __float_as_uint(evv[j] * inv * svv[j]));
        }
    }
#undef SK_LOAD
#undef SK_STORE
}

template <int CTRL> DI int dppi(const int x) { return __builtin_amdgcn_update_dpp(0, x, CTRL, 0xf, 0xf, true); }
DI int ix4(const int x) { const int t = __builtin_amdgcn_update_dpp(0, x, 0x104, 0xf, 0x5, true); return __builtin_amdgcn_update_dpp(t, x, 0x114, 0xf, 0xA, true); }
DI int bfly16i(int (&pz)[16], const int lane) {
    const bool b3 = lane & 8, b2 = lane & 4, b1 = lane & 2, b0 = lane & 1;
    int q8[8], q4[4], q2[2];
#pragma unroll
    for (int i = 0; i < 8; ++i) q8[i] = (b3 ? pz[8 + i] : pz[i]) + dppi<0x128>(b3 ? pz[i] : pz[8 + i]);
#pragma unroll
    for (int i = 0; i < 4; ++i) q4[i] = (b2 ? q8[4 + i] : q8[i]) + ix4(b2 ? q8[i] : q8[4 + i]);
#pragma unroll
    for (int i = 0; i < 2; ++i) q2[i] = (b1 ? q4[2 + i] : q4[i]) + dppi<0x4E>(b1 ? q4[i] : q4[2 + i]);
    int q = (b0 ? q2[1] : q2[0]) + dppi<0xB1>(b0 ? q2[0] : q2[1]);
    { const auto r = __builtin_amdgcn_permlane16_swap((unsigned)q, (unsigned)q, false, false); q = (int)r[0] + (int)r[1]; }
    { const auto r = __builtin_amdgcn_permlane32_swap((unsigned)q, (unsigned)q, false, false); q = (int)r[0] + (int)r[1]; }
    return q;
}
DI float bfly16(float (&pz)[16], const int lane) {
    const bool b3 = lane & 8, b2 = lane & 4, b1 = lane & 2, b0 = lane & 1;
    float q8[8], q4[4], q2[2];
#pragma unroll
    for (int i = 0; i < 8; ++i) q8[i] = (b3 ? pz[8 + i] : pz[i]) + __shfl_xor(b3 ? pz[i] : pz[8 + i], 8);
#pragma unroll
    for (int i = 0; i < 4; ++i) q4[i] = (b2 ? q8[4 + i] : q8[i]) + __shfl_xor(b2 ? q8[i] : q8[4 + i], 4);
#pragma unroll
    for (int i = 0; i < 2; ++i) q2[i] = (b1 ? q4[2 + i] : q4[i]) + __shfl_xor(b1 ? q4[i] : q4[2 + i], 2);
    float q = (b0 ? q2[1] : q2[0]) + __shfl_xor(b0 ? q2[0] : q2[1], 1);
    q += __shfl_xor(q, 16); q += __shfl_xor(q, 32);
    return q;
}
DI void gs_issue(const __amdgpu_buffer_rsrc_t T, const uint2* ent, const unsigned d, const int lane, u32x4 (&w)[8], unsigned& ca) {
    const int cnt = (int)((d >> 16) & 0xfu), k = lane & 7;
    const uint2 e = ent[(d & 0xffffu) + (unsigned)(k < cnt ? k : cnt - 1)];
    ca = (k < cnt && !(d >> 31)) ? e.y : 0u;
#pragma unroll
    for (int q = 0; q < 8; ++q) {
        const int eid = __builtin_amdgcn_readlane((int)e.x, q) & 0x3fff;
        w[q] = __builtin_amdgcn_raw_buffer_load_b128(T, lane * 16, eid * DM, 0);
    }
}
DI int dot16_i8(const u32x4 w, const u32x4 h) {
    int acc;
    asm("v_dot4_i32_i8 %0, %1, %2, 0" : "=v"(acc) : "v"(w.x), "v"(h.x));
    acc = __builtin_amdgcn_sdot4((int)w.y, (int)h.y, acc, false);
    acc = __builtin_amdgcn_sdot4((int)w.z, (int)h.z, acc, false);
    acc = __builtin_amdgcn_sdot4((int)w.w, (int)h.w, acc, false);
    return acc;
}
DI void gs_desc(const uint2* ent, const unsigned d, const int lane, unsigned& ex) {
    const int cnt = (int)((d >> 16) & 0xfu), k = lane & 7;
    ex = ent[(d & 0xffffu) + (unsigned)(k < cnt ? k : cnt - 1)].x;
}
DI void gs_loads(const __amdgpu_buffer_rsrc_t T, const unsigned ex, const int lane, u32x4 (&w)[8]) {
    int so[8];
#pragma unroll
    for (int q = 0; q < 8; ++q) so[q] = __builtin_amdgcn_readlane((int)ex, q);
    __builtin_amdgcn_sched_barrier(0);
#pragma unroll
    for (int q = 0; q < 8; ++q) w[q] = __builtin_amdgcn_raw_buffer_load_b128(T, lane * 16, so[q], 0);
}
DI void gs_upartial(const u32x4 (&w)[8], const u32x4 h2q, float (&pz)[16], const int base) {
#pragma unroll
    for (int k = 0; k < 8; ++k) pz[base + k] = (float)dot16_i8(w[k], h2q);
}
DI void gs_ustore(float (&pz)[16], float* zb, const unsigned da, const unsigned db, const int lane) {
    const float z = bfly16(pz, lane);
    const unsigned d = (lane & 8) ? db : da;
    const int k = lane & 7;
    if (lane < 16 && k < (int)((d >> 16) & 0xfu) && !(d >> 31)) zb[(d & 0xffffu) + k] = z;
}
DI void axpy16_u8(const float a, const u32x4 w, float (&o)[16]) {
    o[0] += a * (float)(w.x & 0xffu); o[1] += a * (float)((w.x >> 8) & 0xffu); o[2] += a * (float)((w.x >> 16) & 0xffu); o[3] += a * (float)(w.x >> 24);
    o[4] += a * (float)(w.y & 0xffu); o[5] += a * (float)((w.y >> 8) & 0xffu); o[6] += a * (float)((w.y >> 16) & 0xffu); o[7] += a * (float)(w.y >> 24);
    o[8] += a * (float)(w.z & 0xffu); o[9] += a * (float)((w.z >> 8) & 0xffu); o[10] += a * (float)((w.z >> 16) & 0xffu); o[11] += a * (float)(w.z >> 24);
    o[12] += a * (float)(w.w & 0xffu); o[13] += a * (float)((w.w >> 8) & 0xffu); o[14] += a * (float)((w.w >> 16) & 0xffu); o[15] += a * (float)(w.w >> 24);
}
DI void gs_vcompute(const u32x4 (&w)[8], const unsigned ca, float (&acc)[16]) {
#pragma unroll
    for (int k = 0; k < 8; ++k) { axpy16_u8(__uint_as_float((unsigned)__builtin_amdgcn_readlane((int)ca, k)), w[k], acc); __builtin_amdgcn_sched_barrier(0); }
}
typedef int i32x4 __attribute__((ext_vector_type(4)));
DI void gs_vmfma(const u32x4 (&w)[8], const unsigned ca, const unsigned jj0, const unsigned jj1, const int lane, i32x4 (&acc)[16]) {
    unsigned cw[2];
#pragma unroll
    for (int G = 0; G < 2; ++G)
        cw[G] = (unsigned)__builtin_amdgcn_readlane((int)ca, 4 * G) | ((unsigned)__builtin_amdgcn_readlane((int)ca, 4 * G + 1) << 8) |
                ((unsigned)__builtin_amdgcn_readlane((int)ca, 4 * G + 2) << 16) | ((unsigned)__builtin_amdgcn_readlane((int)ca, 4 * G + 3) << 24);
#pragma unroll
    for (int G = 0; G < 2; ++G) {
        const int A = ((unsigned)(lane & 3) == (G ? jj1 : jj0)) ? (int)cw[G] : 0;
#pragma unroll
        for (int g = 0; g < 4; ++g) {
            const unsigned r0 = w[4 * G][g], r1 = w[4 * G + 1][g], r2 = w[4 * G + 2][g], r3 = w[4 * G + 3][g];
            const unsigned a_lo = __builtin_amdgcn_perm(r1, r0, 0x05010400u), a_hi = __builtin_amdgcn_perm(r1, r0, 0x07030602u);
            const unsigned b_lo = __builtin_amdgcn_perm(r3, r2, 0x05010400u), b_hi = __builtin_amdgcn_perm(r3, r2, 0x07030602u);
            const unsigned t0 = __builtin_amdgcn_perm(b_lo, a_lo, 0x05040100u), t1 = __builtin_amdgcn_perm(b_lo, a_lo, 0x07060302u);
            const unsigned t2 = __builtin_amdgcn_perm(b_hi, a_hi, 0x05040100u), t3 = __builtin_amdgcn_perm(b_hi, a_hi, 0x07060302u);
            acc[4 * g + 0] = __builtin_amdgcn_mfma_i32_4x4x4i8(A, (int)t0, acc[4 * g + 0], 0, 0, 0);
            acc[4 * g + 1] = __builtin_amdgcn_mfma_i32_4x4x4i8(A, (int)t1, acc[4 * g + 1], 0, 0, 0);
            acc[4 * g + 2] = __builtin_amdgcn_mfma_i32_4x4x4i8(A, (int)t2, acc[4 * g + 2], 0, 0, 0);
            acc[4 * g + 3] = __builtin_amdgcn_mfma_i32_4x4x4i8(A, (int)t3, acc[4 * g + 3], 0, 0, 0);
        }
    }
}
DI unsigned gq_pick(const unsigned q0, const unsigned q1, const int lane) { return (lane & 4) ? q1 : q0; }
DI void gq_desc(const uint2* ent, const unsigned q0, const unsigned q1, const int lane, unsigned& ex) {
    const unsigned d = gq_pick(q0, q1, lane); const int cnt = (int)((d >> 16) & 7u), r = lane & 3;
    ex = (ent[(d & 0xffffu) + (unsigned)(r < cnt ? r : cnt - 1)].x & 0x3fffu) << 10;
}
template <int H> DI void gq_upartial(const u32x4 (&w)[8], const u32x4 h2q, int (&pz)[16], const int base) {
#pragma unroll
    for (int k = 4 * H; k < 4 * H + 4; ++k) pz[base + k] = dot16_i8(w[k], h2q);
}
DI void gq_ustore(int (&pz)[16], float* zb, const unsigned a0, const unsigned a1, const unsigned b0, const unsigned b1, const int lane) {
    const float z = (float)bfly16i(pz, lane);
    const unsigned d = (lane & 8) ? gq_pick(b0, b1, lane) : gq_pick(a0, a1, lane);
    const int r = lane & 3;
    if (lane < 16 && r < (int)((d >> 16) & 7u) && !(d >> 31)) zb[(d & 0xffffu) + r] = z;
}
DI void gq_issue(const __amdgpu_buffer_rsrc_t T, const uint2* ent, const unsigned q0, const unsigned q1, const int lane, u32x4 (&w)[8], unsigned& ca) {
    const unsigned d = gq_pick(q0, q1, lane); const int cnt = (int)((d >> 16) & 7u), r = lane & 3;
    const uint2 e = ent[(d & 0xffffu) + (unsigned)(r < cnt ? r : cnt - 1)];
    ca = (r < cnt && !(d >> 31)) ? (e.y & 0xffu) : 0u;
    const unsigned eo = (e.x & 0x3fffu) << 10;
    int so[8];
#pragma unroll
    for (int q = 0; q < 8; ++q) so[q] = __builtin_amdgcn_readlane((int)eo, q);
    __builtin_amdgcn_sched_barrier(0);
#pragma unroll
    for (int q = 0; q < 8; ++q) w[q] = __builtin_amdgcn_raw_buffer_load_b128(T, lane * 16, so[q], 0);
}
constexpr int GT = 4;
constexpr int GU = 8;
constexpr int WL_ENT = GU * 1024, WL_Z = GU * 512, WL_OFFS = ((GU * 9 * 4 + 63) / 64) * 64, WL_SCHU = ((GU * 40 + 10) * 4 + 63) / 64 * 64, WL_SCHV = ((GT * 40 + 10) * 4 + 63) / 64 * 64;
constexpr int WL_BYTES = WL_ENT + WL_Z + WL_OFFS + WL_SCHU + WL_SCHV;
static_assert(8 * WL_BYTES <= 128 * 1024, "gather LDS");
template <int J> DI void gs_usel(const u32x4 (&w)[8], const u32x4 (&h2q)[GU], float (&pz)[16], const int base, const unsigned j) {
    if constexpr (J + 1 < GU) { if (j == (unsigned)J) gs_upartial(w, h2q[J], pz, base); else gs_usel<J + 1>(w, h2q, pz, base, j); } else gs_upartial(w, h2q[J], pz, base);
}
template <int J> DI void gs_hsel(const u32x4 (&h2q)[GU], const unsigned j, u32x4& out) {
    if constexpr (J + 1 < GU) { if (j == (unsigned)J) out = h2q[J]; else gs_hsel<J + 1>(h2q, j, out); } else out = h2q[J];
}
template <int J> DI void gs_vsel(const u32x4 (&w)[8], const unsigned ca, float (&acc)[GT][16], const unsigned j) {
    if constexpr (J + 1 < GT) { if (j == (unsigned)J) gs_vcompute(w, ca, acc[J]); else gs_vsel<J + 1>(w, ca, acc, j); } else gs_vcompute(w, ca, acc[J]);
}
constexpr int NSL = 8, SLSH = 11;
template <int NT> DI int gs_schedule(const int* offs, unsigned* sched, const int j0, const int lane) {
    const int gs = (lane / NT) % NSL, gj = j0 + lane % NT;
    const int gb = offs[gj * 9 + gs], ge = offs[gj * 9 + gs + 1], cnt = lane < NSL * NT ? ge - gb : 0, nbt = (cnt + 7) >> 3;
    int incl = nbt;
#pragma unroll
    for (int m = 1; m < 64; m <<= 1) { const int o = __shfl_up(incl, m); if (lane >= m) incl += o; }
    const int nbat = __builtin_amdgcn_readlane(incl, NSL * NT - 1);
    const int st = incl - nbt;
    for (int q = 0; q < nbt; ++q) { const int rem = cnt - 8 * q; sched[st + q] = (unsigned)(gj * 128 + gb + 8 * q) | ((unsigned)(rem < 8 ? rem : 8) << 16); }
    if (lane < 3) sched[nbat + lane] = 0x80010000u;
    return nbat;
}
template <int NT> DI int gq_schedule(const int* offs, unsigned* sched, const int j0, const int lane) {
    const int gs = (lane / NT) % NSL, gj = j0 + lane % NT;
    const int gb = offs[gj * 9 + gs], ge = offs[gj * 9 + gs + 1], cnt = lane < NSL * NT ? ge - gb : 0, nq = (cnt + 3) >> 2;
    int incl = nq;
#pragma unroll
    for (int m = 1; m < 64; m <<= 1) { const int o = __shfl_up(incl, m); if (lane >= m) incl += o; }
    const int total = __builtin_amdgcn_readlane(incl, NSL * NT - 1);
    const int st = incl - nq;
    for (int q = 0; q < nq; ++q) { const int rem = cnt - 4 * q; sched[st + q] = (unsigned)(gj * 128 + gb + 4 * q) | ((unsigned)(rem < 4 ? rem : 4) << 16); }
    if (lane < 10) sched[total + lane] = 0x80010000u;
    return total;
}
DI void xcd_pace(unsigned* cnt, const unsigned nloc, unsigned& step) {
    __syncthreads();
    if (__builtin_amdgcn_workitem_id_x() == 0) {
        __hip_atomic_fetch_add(cnt, 1u, __ATOMIC_RELAXED, __HIP_MEMORY_SCOPE_AGENT);
        const unsigned target = nloc * (step + 1u);
        unsigned sp = 0;
        while (__hip_atomic_load(cnt, __ATOMIC_RELAXED, __HIP_MEMORY_SCOPE_AGENT) < target) { __builtin_amdgcn_s_sleep(1); if (++sp > (1u << 22)) break; }
    }
    ++step;
    __syncthreads();
}
DI void phase_gather(const Params& p, int bid, int nb, char* smem, unsigned* pace_cnt, const unsigned pace_n) {
    unsigned pstep = 0;
    const float* mod = (const float*)(p.ws + OFF_MOD);
    const float* AB = (const float*)(p.ws + OFF_AB);
    const float* STAT = (const float*)(p.ws + OFF_STAT);
    const uint2* EX = (const uint2*)(p.ws + OFF_EXPS);
    const __amdgpu_buffer_rsrc_t UT = __builtin_amdgcn_make_buffer_rsrc((void*)(p.ws + OFF_UT), 0, NEXP * DM, 0x00020000);
    const __amdgpu_buffer_rsrc_t VT = __builtin_amdgcn_make_buffer_rsrc((void*)(p.ws + OFF_VT), 0, NEXP * DM, 0x00020000);
    const int lane = my_tid() & 63, wid = my_tid() >> 6, c0 = lane * 16;
    char* wl = smem + wid * WL_BYTES;
    uint2* ent = (uint2*)wl; float* zb = (float*)(wl + WL_ENT); int* offs = (int*)(wl + WL_ENT + WL_Z);
    unsigned* schu = (unsigned*)(wl + WL_ENT + WL_Z + WL_OFFS); unsigned* schv = (unsigned*)(wl + WL_ENT + WL_Z + WL_OFFS + WL_SCHU);
#pragma unroll 1
    for (int t0 = (bid * 8 + wid) * GU; t0 < NTOK; t0 += nb * 8 * GU) {
        u32x4 h2q[GU]; float hsc[GU];
        f32x4 scv[4], shv[4];
        {
            const int b = t0 / SEQ;
#pragma unroll
            for (int q = 0; q < 4; ++q) { scv[q] = *(const f32x4*)(AB + (size_t)b * DM + c0 + q * 4); shv[q] = *(const f32x4*)(AB + (size_t)(NB + b) * DM + c0 + q * 4); }
        }
#pragma unroll
        for (int hf = 0; hf < GU / GT; ++hf) {
            u32x4 pra[GT], prb[GT]; uint2 pe0[GT], pe1[GT]; float ps1[GT], ps2[GT];
#pragma unroll
            for (int jj = 0; jj < GT; ++jj) {
                const int tok = t0 + hf * GT + jj;
                const bf16_t* row = (const bf16_t*)(p.ws + OFF_R1) + (size_t)tok * DM + c0;
                pra[jj] = *(const u32x4*)row; prb[jj] = *(const u32x4*)(row + 8);
                ps1[jj] = STAT[tok]; ps2[jj] = STAT[NTOK + tok];
                pe0[jj] = EX[(size_t)tok * 128 + lane]; pe1[jj] = EX[(size_t)tok * 128 + 64 + lane];
            }
#pragma unroll
            for (int jj = 0; jj < GT; ++jj) {
                const int j = hf * GT + jj;
                const float mu_j = ps1[jj] * (1.0f / 1024.0f), rs_j = rsqrtf(fmaxf(ps2[jj] * (1.0f / 1024.0f) - mu_j * mu_j, 0.f) + LN_EPS);
                {
                    f32x4 hv[4];
                    float m = 0.f;
                    const u32x4 ra = pra[jj], rb = prb[jj];
                    hv[0] = (f32x4){bflo(ra.x), bfhi(ra.x), bflo(ra.y), bfhi(ra.y)}; hv[1] = (f32x4){bflo(ra.z), bfhi(ra.z), bflo(ra.w), bfhi(ra.w)};
                    hv[2] = (f32x4){bflo(rb.x), bfhi(rb.x), bflo(rb.y), bfhi(rb.y)}; hv[3] = (f32x4){bflo(rb.z), bfhi(rb.z), bflo(rb.w), bfhi(rb.w)};
#pragma unroll
                    for (int q = 0; q < 4; ++q) { hv[q] = (hv[q] - mu_j) * rs_j * scv[q] + shv[q]; m = fmaxf(m, fmaxf(fmaxf(fabsf(hv[q].x), fabsf(hv[q].y)), fmaxf(fabsf(hv[q].z), fabsf(hv[q].w)))); }
#pragma unroll
                    for (int sft = 1; sft < 64; sft <<= 1) m = fmaxf(m, __shfl_xor(m, sft));
                    const float qs = m > 1e-30f ? 127.0f / m : 1.0f;
                    hsc[j] = m > 1e-30f ? m * (1.0f / 127.0f) : 1.0f;
                    unsigned hw[4];
#pragma unroll
                    for (int q = 0; q < 4; ++q)
                        hw[q] = ((unsigned)(int)rintf(hv[q].x * qs) & 0xffu) | (((unsigned)(int)rintf(hv[q].y * qs) & 0xffu) << 8) | (((unsigned)(int)rintf(hv[q].z * qs) & 0xffu) << 16) | (((unsigned)(int)rintf(hv[q].w * qs) & 0xffu) << 24);
                    h2q[j] = (u32x4){hw[0], hw[1], hw[2], hw[3]};
                }
                const uint2 e0 = pe0[jj], e1 = pe1[jj];
                const int s0 = (int)((e0.x & 0x3fffu) >> SLSH), s1 = (int)((e1.x & 0x3fffu) >> SLSH);
                int run = 0, pos0 = 0, pos1 = 0;
#pragma unroll
                for (int s = 0; s < NSL; ++s) {
                    const unsigned long long m0 = __ballot(s0 == s), m1 = __ballot(s1 == s);
                    const int c0n = __popcll(m0), c1n = __popcll(m1);
                    const int below0 = (int)__builtin_amdgcn_mbcnt_hi((unsigned)(m0 >> 32), __builtin_amdgcn_mbcnt_lo((unsigned)m0, 0u));
                    const int below1 = (int)__builtin_amdgcn_mbcnt_hi((unsigned)(m1 >> 32), __builtin_amdgcn_mbcnt_lo((unsigned)m1, 0u));
                    if (lane == 0) offs[j * 9 + s] = run;
                    pos0 = (s0 == s) ? run + below0 : pos0;
                    pos1 = (s1 == s) ? run + c0n + below1 : pos1;
                    run += c0n + c1n;
                }
                if (lane == 0) offs[j * 9 + NSL] = 128;
                ent[j * 128 + pos0] = e0; ent[j * 128 + pos1] = e1;
            }
        }
        {
                const int nbu = (gq_schedule<GU>(offs, schu, 0, lane) + 1) >> 1;
            xcd_pace(pace_cnt, pace_n, pstep);
            u32x4 wa[8], wb[8];
            u32x4 ha0 = h2q[0], ha1 = h2q[0], hb0 = h2q[0], hb1 = h2q[0]; unsigned ta0 = 0u, ta1 = 0u, tb0 = 0u, tb1 = 0u;
#define GQ_HSEL(H_, TK_, Q_) { const unsigned t_ = ((Q_) & 0xffffu) >> 7; if (t_ != TK_) { TK_ = t_; gs_hsel<0>(h2q, t_, H_); } }
#define GQ_RD(i_) ((unsigned)__builtin_amdgcn_readfirstlane((int)schu[(i_)]))
#define GQ_RD2(N0_, N1_, I_) { const uint2 t_ = *(const uint2*)(schu + (I_)); N0_ = (unsigned)__builtin_amdgcn_readfirstlane((int)t_.x); N1_ = (unsigned)__builtin_amdgcn_readfirstlane((int)t_.y); }
            unsigned a0, a1, b0, b1, n0, n1, ea, eb, en;
            GQ_RD2(a0, a1, 0); GQ_RD2(b0, b1, 2); GQ_RD2(n0, n1, 4);
            gq_desc(ent, a0, a1, lane, ea); gq_desc(ent, b0, b1, lane, eb); gq_desc(ent, n0, n1, lane, en);
            gs_loads(UT, ea, lane, wa);
#pragma unroll 1
            for (int i = 0; i < nbu; i += 2) {
                int pz[16];
                gs_loads(UT, eb, lane, wb);
                GQ_HSEL(ha0, ta0, a0); GQ_HSEL(ha1, ta1, a1); GQ_HSEL(hb0, tb0, b0); GQ_HSEL(hb1, tb1, b1);
                __builtin_amdgcn_sched_barrier(0);
                gq_upartial<0>(wa, ha0, pz, 0); gq_upartial<1>(wa, ha1, pz, 0);
                const unsigned ca0 = a0, ca1 = a1, cb0 = b0, cb1 = b1;
                a0 = n0; a1 = n1; ea = en; GQ_RD2(n0, n1, 2 * i + 6); gq_desc(ent, n0, n1, lane, en);
                gs_loads(UT, ea, lane, wa);
                __builtin_amdgcn_sched_barrier(0);
                gq_upartial<0>(wb, hb0, pz, 8); gq_upartial<1>(wb, hb1, pz, 8);
                b0 = n0; b1 = n1; eb = en; GQ_RD2(n0, n1, 2 * i + 8); gq_desc(ent, n0, n1, lane, en);
                gq_ustore(pz, zb, ca0, ca1, cb0, cb1, lane);
            }
#undef GQ_HSEL
#undef GQ_RD
#undef GQ_RD2
        }
        float asc[GU];
#pragma unroll
        for (int j = 0; j < GU; ++j) {
            float av[2], am = 0.f;
#pragma unroll
            for (int q = 0; q < 2; ++q) {
                const int pos = j * 128 + q * 64 + lane;
                const uint2 e = ent[pos];
                const float z = zb[pos] * __uint_as_float(e.x & 0xffff0000u) * hsc[j];
                av[q] = gelu_as(z) * __uint_as_float(e.y);
                am = fmaxf(am, fabsf(av[q]));
            }
#pragma unroll
            for (int sft = 1; sft < 64; sft <<= 1) am = fmaxf(am, __shfl_xor(am, sft));
            const float qs = am > 1e-30f ? 127.0f / am : 0.f;
            asc[j] = am * (1.0f / 127.0f);
#pragma unroll
            for (int q = 0; q < 2; ++q) ent[j * 128 + q * 64 + lane].y = (unsigned)(int)rintf(av[q] * qs);
        }
#pragma unroll 1
        for (int hf = 0; hf < GU / GT; ++hf) {
            float as4[GT];
#pragma unroll
            for (int jj = 0; jj < GT; ++jj) as4[jj] = hf ? asc[GT + jj] : asc[jj];
            const int nbv = (gq_schedule<GT>(offs, schv, hf * GT, lane) + 1) >> 1;
            const int tq0 = t0 + hf * GT;
            i32x4 acci[16];
#pragma unroll
            for (int q = 0; q < 16; ++q) acci[q] = (i32x4){0, 0, 0, 0};
            {
                u32x4 wa[8], wb[8]; unsigned ca_a, ca_b;
#define GQ_RD(i_) ((unsigned)__builtin_amdgcn_readfirstlane((int)schv[(i_)]))
#define GQ_TOK(q_) ((((q_) & 0xffffu) >> 7) & (GT - 1))
#define GQ_RD2(N0_, N1_, I_) { const uint2 t_ = *(const uint2*)(schv + (I_)); N0_ = (unsigned)__builtin_amdgcn_readfirstlane((int)t_.x); N1_ = (unsigned)__builtin_amdgcn_readfirstlane((int)t_.y); }
                unsigned a0, a1, b0, b1;
                GQ_RD2(a0, a1, 0);
                gq_issue(VT, ent, a0, a1, lane, wa, ca_a);
#pragma unroll 1
                for (int i = 0; i < nbv; i += 2) {
                    GQ_RD2(b0, b1, 2 * i + 2);
                    gq_issue(VT, ent, b0, b1, lane, wb, ca_b);
                    __builtin_amdgcn_sched_barrier(0);
                    gs_vmfma(wa, ca_a, GQ_TOK(a0), GQ_TOK(a1), lane, acci);
                    GQ_RD2(a0, a1, 2 * i + 4);
                    gq_issue(VT, ent, a0, a1, lane, wa, ca_a);
                    __builtin_amdgcn_sched_barrier(0);
                    gs_vmfma(wb, ca_b, GQ_TOK(b0), GQ_TOK(b1), lane, acci);
                }
#undef GQ_RD
#undef GQ_RD2
#undef GQ_TOK
            }
            float acc[GT][16];
#pragma unroll
            for (int j = 0; j < GT; ++j)
#pragma unroll
                for (int q = 0; q < 16; ++q) acc[j][q] = (float)acci[q][j] * as4[j];
            {
                int c0 = lane * 16; asm volatile("" : "+v"(c0));
                const int b = tq0 / SEQ;
                u32x4 ra[GT], rb[GT]; float s1v[GT], s2v[GT];
#pragma unroll
                for (int j = 0; j < GT; ++j) {
                    const bf16_t* r1row = (const bf16_t*)(p.ws + OFF_R1) + (size_t)(tq0 + j) * DM + c0;
                    ra[j] = *(const u32x4*)r1row; rb[j] = *(const u32x4*)(r1row + 8);
                    s1v[j] = STAT[tq0 + j]; s2v[j] = STAT[NTOK + tq0 + j];
                }
                float mu2[GT], rstd2[GT];
                {
                    f32x4 w1[4], b1[4], gg[4];
                    const float* g2 = mod + b * 6144 + 5120 + c0;
#pragma unroll
                    for (int q = 0; q < 4; ++q) { w1[q] = *(const f32x4*)(p.ln1w + c0 + q * 4); b1[q] = *(const f32x4*)(p.ln1b + c0 + q * 4); gg[q] = *(const f32x4*)(g2 + q * 4) + 1.0f; }
#pragma unroll
                    for (int j = 0; j < GT; ++j) {
                        const float mu_j = s1v[j] * (1.0f / 1024.0f), rs_j = rsqrtf(fmaxf(s2v[j] * (1.0f / 1024.0f) - mu_j * mu_j, 0.f) + LN_EPS);
                        const f32x4 r1v[4] = {(f32x4){bflo(ra[j].x), bfhi(ra[j].x), bflo(ra[j].y), bfhi(ra[j].y)}, (f32x4){bflo(ra[j].z), bfhi(ra[j].z), bflo(ra[j].w), bfhi(ra[j].w)},
                                              (f32x4){bflo(rb[j].x), bfhi(rb[j].x), bflo(rb[j].y), bfhi(rb[j].y)}, (f32x4){bflo(rb[j].z), bfhi(rb[j].z), bflo(rb[j].w), bfhi(rb[j].w)}};
                        const float off = 0.f;
                        float sm = 0.f;
#pragma unroll
                        for (int q = 0; q < 4; ++q) {
                            const f32x4 xv = (r1v[q] - mu_j) * rs_j * w1[q] + b1[q];
                            const f32x4 av = {acc[j][4 * q] - off, acc[j][4 * q + 1] - off, acc[j][4 * q + 2] - off, acc[j][4 * q + 3] - off};
                            const f32x4 rr = DEEP_ALPHA * xv + gg[q] * av;
                            acc[j][4 * q] = rr.x; acc[j][4 * q + 1] = rr.y; acc[j][4 * q + 2] = rr.z; acc[j][4 * q + 3] = rr.w;
                            sm += (rr.x + rr.y) + (rr.z + rr.w);
                        }
#pragma unroll
                        for (int m = 1; m < 64; m <<= 1) sm += __shfl_xor(sm, m);
                        const float mu = sm * (1.0f / 1024.0f);
                        float qq = 0.f;
#pragma unroll
                        for (int i = 0; i < 16; ++i) { const float dd = acc[j][i] - mu; qq += dd * dd; }
#pragma unroll
                        for (int m = 1; m < 64; m <<= 1) qq += __shfl_xor(qq, m);
                        mu2[j] = mu; rstd2[j] = rsqrtf(qq * (1.0f / 1024.0f) + LN_EPS);
                    }
                }
                {
                    f32x4 w2[4], b2[4];
#pragma unroll
                    for (int q = 0; q < 4; ++q) { w2[q] = *(const f32x4*)(p.ln2w + c0 + q * 4); b2[q] = *(const f32x4*)(p.ln2b + c0 + q * 4); }
#pragma unroll
                    for (int j = 0; j < GT; ++j) {
                        float* row = p.out + (size_t)(tq0 + j) * DM + c0;
#pragma unroll
                        for (int q = 0; q < 4; ++q) {
                            const f32x4 rr = {acc[j][4 * q], acc[j][4 * q + 1], acc[j][4 * q + 2], acc[j][4 * q + 3]};
                            *(f32x4*)(row + q * 4) = (rr - mu2[j]) * rstd2[j] * w2[q] + b2[q];
                        }
                    }
                }
            }
        }
    }
}

#define XB_TMO      128
#define XB_XCNT(j)  (256  + 64 * (j))
#define XB_XSUB(j)  (1280 + 64 * (j))
#define XB_XGEN(j)  (2304 + 64 * (j))
#define XB_TOP      3328
#define XB_TOPGEN   3392
#define XCD_BAR_WORDS 3456
#define XB_SPIN_CAP (1u << 22)
#define LAS __attribute__((address_space(3)))
DI unsigned xb_ld(unsigned* p) { return __hip_atomic_load(p, __ATOMIC_RELAXED, __HIP_MEMORY_SCOPE_AGENT); }
DI unsigned xb_add(unsigned* p, unsigned v) { return __hip_atomic_fetch_add(p, v, __ATOMIC_RELAXED, __HIP_MEMORY_SCOPE_AGENT); }
DI unsigned xb_xcc_id() { return (unsigned)__builtin_amdgcn_s_getreg((3 << 11) | 20) & 0xFu; }
#define XB_SPIN(cond, bar) do { unsigned _sp = 0; while (cond) { __builtin_amdgcn_s_sleep(1); \
    if ((++_sp & 255u) == 0u) { if (xb_ld(&(bar)[XB_TMO])) break; if (_sp > XB_SPIN_CAP) { atomicAdd(&(bar)[XB_TMO], 1u); break; } } } } while (0)
struct XcdBarrier { unsigned* bar; unsigned x; volatile LAS unsigned* st; };
DI XcdBarrier xcd_barrier_post(unsigned* bar, volatile LAS unsigned* st) {
    XcdBarrier b; b.bar = bar; b.x = xb_xcc_id(); b.st = st;
    if (__builtin_amdgcn_workitem_id_x() == 0) (void)xb_add(&bar[XB_XCNT(b.x)], 1u);
    return b;
}
DI void xcd_barrier_complete(unsigned* bar, unsigned x, unsigned& nloc, unsigned& nx) {
    const unsigned G = gridDim.x * gridDim.y * gridDim.z;
    unsigned sum, cnt, mine, sp = 0u;
    for (;;) {
        sum = 0u; cnt = 0u; mine = 0u;
#pragma unroll
        for (unsigned j = 0; j < 16; ++j) { const unsigned c = xb_ld(&bar[XB_XCNT(j)]); sum += c; cnt += (c > 0u) ? 1u : 0u; mine = (j == x) ? c : mine; }
        if (sum == G) break;
        __builtin_amdgcn_s_sleep(1);
        if ((++sp & 255u) == 0u) { if (xb_ld(&bar[XB_TMO])) break; if (sp > XB_SPIN_CAP) { atomicAdd(&bar[XB_TMO], 1u); break; } }
    }
    nloc = mine > 0u ? mine : 1u; nx = cnt > 0u ? cnt : 1u;
}
DI void xcd_barrier(const XcdBarrier& b) {
    asm volatile("s_waitcnt vmcnt(0)" ::: "memory");
    __syncthreads();
    if (__builtin_amdgcn_workitem_id_x() == 0) {
        unsigned* bar = b.bar;
        unsigned bx = b.x; asm volatile("" : "+s"(bx));
        __builtin_amdgcn_s_waitcnt(0);
        unsigned nloc = b.st[0], nx = b.st[1];
        if (nloc == 0u) { xcd_barrier_complete(bar, bx, nloc, nx); b.st[0] = nloc; b.st[1] = nx; }
        const unsigned old = xb_add(&bar[XB_XSUB(bx)], 1u);
        const unsigned gen = old / nloc;
        if (old + 1u == (gen + 1u) * nloc) {
            __builtin_amdgcn_fence(__ATOMIC_RELEASE, "agent");
            asm volatile("s_waitcnt vmcnt(0)" ::: "memory");
            const unsigned og = xb_add(&bar[XB_TOP], 1u);
            const unsigned tg = og / nx;
            if (og + 1u == (tg + 1u) * nx) xb_add(&bar[XB_TOPGEN], 1u);
            else XB_SPIN(xb_ld(&bar[XB_TOPGEN]) == tg, bar);
            __builtin_amdgcn_fence(__ATOMIC_ACQUIRE, "agent");
            xb_add(&bar[XB_XGEN(bx)], 1u);
            asm volatile("s_waitcnt vmcnt(0)" ::: "memory");
        } else {
            XB_SPIN(xb_ld(&bar[XB_XGEN(bx)]) == gen, bar);
            __builtin_amdgcn_fence(__ATOMIC_ACQUIRE, "agent");
            asm volatile("s_waitcnt vmcnt(0)" ::: "memory");
        }
    }
    __syncthreads();
}

__global__ void __launch_bounds__(NTH) k_mega(Params p) {
    __shared__ __attribute__((aligned(16))) char smem[SMEM_BYTES];
    volatile LAS unsigned* xst = (volatile LAS unsigned*)(smem + SMEM_BYTES - 16);
    if (__builtin_amdgcn_workitem_id_x() == 0) { xst[0] = 0u; xst[1] = 0u; }
    __syncthreads();
    const XcdBarrier xb = xcd_barrier_post((unsigned*)(p.ws + OFF_BAR), xst);
    const int bid = blockIdx.x, nb = gridDim.x;
#ifndef PROBE_MASK
#define PROBE_MASK 0
#endif
#define REP(bit) for (int rep_ = 0; rep_ < ((PROBE_MASK & (bit)) ? 2 : 1); ++rep_)
    phase_prep_a(p, smem);           xcd_barrier(xb);
    phase_prep_b(p, smem);           xcd_barrier(xb);
    REP(1)  { phase_proj(p, bid, nb, smem);    xcd_barrier(xb); }
    REP(2)  { phase_mix(p, bid, nb, smem);     xcd_barrier(xb); }
    REP(4)  { phase_glu(p, bid, nb, smem);     xcd_barrier(xb); }
    REP(4)  { phase_outproj(p, bid, nb, smem); xcd_barrier(xb); }
    REP(8)  { phase_q(p, bid, nb, smem);       xcd_barrier(xb); }
    REP(16) { phase_retrieve(p, bid, nb, smem); xcd_barrier(xb); }
    phase_gather(p, bid, nb, smem, (unsigned*)(p.ws + OFF_BAR) + 16 * xb_xcc_id(), (unsigned)__builtin_amdgcn_readfirstlane((int)xst[0]));
}

extern "C" void kernel_launch(void* const* d_in, const int* in_sizes, int n_in, void* d_out, int out_size, void* d_ws, size_t ws_size, hipStream_t stream) {
    if (n_in != 27 || ws_size < WS_END) { fprintf(stderr, "kernel_launch: unexpected n_in %d or ws_size %zu (< %zu)\n", n_in, ws_size, (size_t)WS_END); return; }
    static int grid_blocks = 0;
    if (!grid_blocks) {
        int dev = 0, cus = 0, per_cu = 0;
        (void)hipGetDevice(&dev);
        (void)hipDeviceGetAttribute(&cus, hipDeviceAttributeMultiprocessorCount, dev);
        (void)hipOccupancyMaxActiveBlocksPerMultiprocessor(&per_cu, k_mega, NTH, 0);
        if (cus <= 0) cus = 256;
        if (per_cu < 1) { fprintf(stderr, "kernel_launch: occupancy query says %d blocks/CU\n", per_cu); per_cu = 1; }
        grid_blocks = cus;
    }
    Params p{};
    const float** f = (const float**)&p;
    for (int i = 0; i < 27; ++i) f[i] = (const float*)d_in[i];
    p.out = (float*)d_out; p.ws = (char*)d_ws;
    hipError_t e = hipMemsetAsync((char*)d_ws + OFF_BAR, 0, (size_t)3456 * 4, stream);
    if (e == hipSuccess) { hipLaunchKernelGGL(k_mega, dim3(grid_blocks), dim3(NTH), 0, stream, p); e = hipPeekAtLastError(); }
    if (e != hipSuccess) fprintf(stderr, "launch failed: %s (grid %d)\n", hipGetErrorString(e), grid_blocks);
}
```
